# Optimizing an MI355X kernel written in HIP

```python
import jax, jax.numpy as jnp
from jax import lax
import numpy as np

D_MODEL = 1024
BATCH = 8
SEQ = 8192
DEPTH = 4

N_MEM = 256
HEAD_DIM = 64
GROUP_W = D_MODEL // 4
N_HEADS = GROUP_W // HEAD_DIM
D_MIX = 4 * GROUP_W
GLA_DK = HEAD_DIM // 2
GLA_DV = HEAD_DIM
GLA_QK = N_HEADS * GLA_DK
GLA_V = N_HEADS * GLA_DV
GLA_GATE_RANK = 16
GLA_TAU = 16.0
CONV_W = 4
CHUNK = 64
GLA_COLS = 2 * GLA_QK + GLA_V + GLA_GATE_RANK + GLA_V
HG_DK = HEAD_DIM
HG_DV = HEAD_DIM
HG_K = N_HEADS * HG_DK
HG_V = N_HEADS * HG_DV
HG_COLS = 2 * HG_K + 2 * HG_V
RW_W = N_HEADS * HEAD_DIM
RW_DECAY_RANK = 64
RW_A_RANK = 64
RW_GATE_RANK = 128
RW_LN_EPS = 64e-5
RW_COLS = 3 * RW_W + RW_DECAY_RANK + RW_A_RANK + RW_GATE_RANK
MEM_HEADS = 4
MEM_W = MEM_HEADS * HEAD_DIM
P_IN = GLA_COLS + HG_COLS + RW_COLS + MEM_W
N_EXPERTS = 32
TOP_K = 4
D_EXPERT = D_MODEL
SWIGLU_ALPHA = 1.702
SWIGLU_LIMIT = 7.0
MOE_BLOCK = 128
DN_ALPHA = (2.0 * DEPTH) ** 0.25
DN_BETA = (8.0 * DEPTH) ** -0.25
LN_EPS = 1e-5
RMS_EPS = 1e-6
GATE_FLOOR = 1e-30

kernel_name = 'hybrid_gla_hgrn2_rwkv7_mem_moe_deepnorm'


def _layer_norm(x, g, b):
    xf = x.astype(jnp.float32)
    mu = jnp.mean(xf, -1, keepdims=True)
    var = jnp.mean(jnp.square(xf - mu), -1, keepdims=True)
    return ((xf - mu) * lax.rsqrt(var + LN_EPS) * g + b).astype(x.dtype)


def _head_rms(o, g):
    B, T, H, d = o.shape
    o = o * lax.rsqrt(jnp.mean(jnp.square(o), -1, keepdims=True) + RMS_EPS)
    return o.reshape(B, T, H * d) * g


def _causal_dwconv(u, w):
    C = u.shape[-1]
    return lax.conv_general_dilated(u, w[:, None, :].astype(u.dtype), window_strides=(1,),
                                    padding=[(CONV_W - 1, 0)],
                                    dimension_numbers=('NWC', 'WIO', 'NWC'),
                                    feature_group_count=C)


def _chunk_gated_linear_attention(q, k, v, log_g):
    B, T, H, dk = q.shape
    dv = v.shape[-1]
    n = T // CHUNK

    def to_chunks(a):
        return a.astype(jnp.float32).reshape(B, n, CHUNK, H, a.shape[-1]).transpose(1, 0, 3, 2, 4)

    qc, kc, vc, gc = (to_chunks(a) for a in (q, k, v, log_g))
    bc = jnp.cumsum(gc, axis=3)
    causal = jnp.tril(jnp.ones((CHUNK, CHUNK), bool))[:, :, None]

    def step(S, inp):
        q_, k_, v_, b_ = inp
        rel = b_[:, :, :, None, :] - b_[:, :, None, :, :]
        dec = jnp.where(causal, jnp.exp(jnp.where(causal, rel, 0.0)), 0.0)
        att = jnp.einsum('bhid,bhjd,bhijd->bhij', q_, k_, dec)
        o = jnp.einsum('bhij,bhjv->bhiv', att, v_) + jnp.einsum('bhid,bhdv->bhiv', q_ * jnp.exp(b_), S)
        b_end = b_[:, :, -1:, :]
        S = S * jnp.exp(b_end)[:, :, 0, :, None] + jnp.einsum('bhjd,bhjv->bhdv', k_ * jnp.exp(b_end - b_), v_)
        return S, o

    S0 = jnp.zeros((B, H, dk, dv), jnp.float32)
    _, o = lax.scan(step, S0, (qc, kc, vc, bc))
    return o.transpose(1, 0, 3, 2, 4).reshape(B, T, H, dv)


def _rwkv7_scan(r, w, k, v, a, b):
    B, T, H, N = r.shape

    def step(S, inp):
        r_t, w_t, k_t, v_t, a_t, b_t = inp
        sa = jnp.einsum('bhij,bhj->bhi', S, a_t)
        S = S * w_t[:, :, None, :] + sa[..., None] * b_t[:, :, None, :] + v_t[..., None] * k_t[:, :, None, :]
        return S, jnp.einsum('bhij,bhj->bhi', S, r_t)

    xs = tuple(jnp.swapaxes(t, 0, 1) for t in (r, w, k, v, a, b))
    _, y = lax.scan(step, jnp.zeros((B, H, N, N), jnp.float32), xs)
    return jnp.swapaxes(y, 0, 1)


def _mixer(x, mem, w_in, gla_conv, gla_gate_w2, gla_gate_b, gla_norm_g, hg_lb, hg_norm_g,
           rw_mu, rw_w0, rw_w2, rw_a0, rw_a2, rw_g2, rw_k_k, rw_k_a, rw_r_k, rw_ln_w, rw_ln_b,
           w_mem_k, w_mem_v, w_out):
    B, T, _ = x.shape
    H = N_HEADS
    f32 = jnp.float32
    p = (x @ w_in).astype(f32)
    p_gla, p_hg, p_rw, q_mem = jnp.split(p, [GLA_COLS, GLA_COLS + HG_COLS, GLA_COLS + HG_COLS + RW_COLS], axis=-1)

    qkv = jax.nn.silu(_causal_dwconv(p_gla[..., :2 * GLA_QK + GLA_V], gla_conv))
    gq, gk, gv = jnp.split(qkv, [GLA_QK, 2 * GLA_QK], axis=-1)
    g_lr, g_out = jnp.split(p_gla[..., 2 * GLA_QK + GLA_V:], [GLA_GATE_RANK], axis=-1)
    log_alpha = jax.nn.log_sigmoid(g_lr @ gla_gate_w2 + gla_gate_b) / GLA_TAU
    o = _chunk_gated_linear_attention(gq.reshape(B, T, H, GLA_DK) * GLA_DK ** -0.5,
                                      gk.reshape(B, T, H, GLA_DK),
                                      gv.reshape(B, T, H, GLA_DV),
                                      log_alpha.reshape(B, T, H, GLA_DK))
    o_gla = _head_rms(o, gla_norm_g) * jax.nn.silu(g_out)

    hq, hf, hi, hgate = jnp.split(p_hg, [HG_K, 2 * HG_K, 2 * HG_K + HG_V], axis=-1)
    f_gate = hg_lb + (1.0 - hg_lb) * jax.nn.sigmoid(hf)
    log_f = jnp.log(jnp.maximum(f_gate, GATE_FLOOR))
    k_in = (1.0 - hg_lb) * jax.nn.sigmoid(-hf)
    o = _chunk_gated_linear_attention(jax.nn.silu(hq).reshape(B, T, H, HG_DK),
                                      k_in.reshape(B, T, H, HG_DK),
                                      hi.reshape(B, T, H, HG_DV),
                                      log_f.reshape(B, T, H, HG_DK))
    o_hg = _head_rms(o, hg_norm_g) * jax.nn.silu(hgate)

    prev = jnp.pad(p_rw, ((0, 0), (1, 0), (0, 0)))[:, :-1]
    p_rw = p_rw + (prev - p_rw) * rw_mu
    rr, rk, rv, w_lr, a_lr, g_lr2 = jnp.split(
        p_rw, np.cumsum([RW_W, RW_W, RW_W, RW_DECAY_RANK, RW_A_RANK]).tolist(), axis=-1)
    w_log = -jax.nn.softplus(-(rw_w0 + jnp.tanh(w_lr) @ rw_w2)) - 0.5
    decay = jnp.exp(-jnp.exp(w_log))
    a = jax.nn.sigmoid(rw_a0 + a_lr @ rw_a2)
    g = jax.nn.sigmoid(g_lr2) @ rw_g2
    heads = lambda t: t.reshape(B, T, H, HEAD_DIM)
    kk = heads(rk * rw_k_k)
    kk = kk / jnp.maximum(jnp.sqrt(jnp.sum(jnp.square(kk), -1, keepdims=True)), 1e-12)
    hk = heads(rk * (1.0 + (a - 1.0) * rw_k_a))
    hr, hv, ha = heads(rr), heads(rv), heads(a)
    y = _rwkv7_scan(hr, heads(decay), hk, hv, -kk, kk * ha)
    mu = jnp.mean(y, -1, keepdims=True)
    var = jnp.mean(jnp.square(y - mu), -1, keepdims=True)
    y = ((y - mu) * lax.rsqrt(var + RW_LN_EPS)).reshape(B, T, RW_W) * rw_ln_w + rw_ln_b
    bonus = (jnp.sum(hr * hk * rw_r_k, -1, keepdims=True) * hv).reshape(B, T, RW_W)
    o_rw = (y + bonus) * g

    M = mem.shape[1]
    mk = (mem @ w_mem_k).astype(f32).reshape(B, M, MEM_HEADS, HEAD_DIM)
    mv = (mem @ w_mem_v).astype(f32).reshape(B, M, MEM_HEADS, HEAD_DIM)
    s = jnp.einsum('bthd,bmhd->bhtm', q_mem.reshape(B, T, MEM_HEADS, HEAD_DIM), mk) * HEAD_DIM ** -0.5
    o_mem = jnp.einsum('bhtm,bmhd->bthd', jax.nn.softmax(s, axis=-1), mv).reshape(B, T, MEM_W)

    o = jnp.concatenate([o_gla, o_hg, o_rw, o_mem], axis=-1).astype(x.dtype)
    return o @ w_out


def _moe(x, router_w, router_b, w_gu, b_gu, w_down, b_down):
    B, T, D = x.shape
    n_tok = B * T
    h = x.reshape(n_tok, D)
    logits = (h @ router_w + router_b).astype(jnp.float32)
    top_val, top_idx = lax.top_k(logits, TOP_K)
    gates = jax.nn.softmax(top_val, axis=-1)
    n_assign = n_tok * TOP_K
    flat_e = top_idx.reshape(-1).astype(jnp.int32)
    flat_tok = jnp.arange(n_assign, dtype=jnp.int32) // TOP_K
    order = jnp.argsort(flat_e)
    sorted_e = flat_e[order]
    sorted_tok = flat_tok[order]
    sorted_gate = gates.reshape(-1)[order]
    counts = jnp.bincount(flat_e, length=N_EXPERTS).astype(jnp.int32)
    padded = (counts + MOE_BLOCK - 1) // MOE_BLOCK * MOE_BLOCK
    start = jnp.cumsum(counts) - counts
    pad_end = jnp.cumsum(padded)
    pad_start = pad_end - padded
    dest = pad_start[sorted_e] + jnp.arange(n_assign, dtype=jnp.int32) - start[sorted_e]
    n_blocks = -(-n_assign // MOE_BLOCK) + N_EXPERTS
    slot_tok = jnp.full((n_blocks * MOE_BLOCK,), n_tok, jnp.int32).at[dest].set(sorted_tok)
    h_pad = jnp.concatenate([h, jnp.zeros((1, D), h.dtype)], axis=0)
    xb = h_pad[slot_tok].reshape(n_blocks, MOE_BLOCK, D)
    block_e = jnp.minimum(jnp.searchsorted(pad_end, jnp.arange(n_blocks, dtype=jnp.int32) * MOE_BLOCK, side='right'),
                          N_EXPERTS - 1)

    def expert_block(args):
        xe, e = args
        hh = xe @ w_gu[e] + b_gu[e]
        gate = jnp.minimum(hh[:, ::2], SWIGLU_LIMIT)
        up = jnp.clip(hh[:, 1::2], -SWIGLU_LIMIT, SWIGLU_LIMIT)
        glu = gate * jax.nn.sigmoid(gate * SWIGLU_ALPHA)
        return ((up + 1.0) * glu) @ w_down[e] + b_down[e]

    yb = lax.map(expert_block, (xb, block_e)).reshape(n_blocks * MOE_BLOCK, D)
    y_sorted = yb[dest] * sorted_gate[:, None].astype(yb.dtype)
    y = jax.ops.segment_sum(y_sorted, sorted_tok, num_segments=n_tok)
    return y.reshape(B, T, D).astype(x.dtype)


def setup_inputs(seed: int = 0) -> dict:
    key = jax.random.key(seed)
    keys = jax.random.split(key, 40)
    L, D, E, F = DEPTH, D_MODEL, N_EXPERTS, D_EXPERT

    def nrm(i, shape, scale):
        return jax.random.normal(keys[i], shape, jnp.float32) * scale

    def unif(i, shape, lo, hi):
        return jax.random.uniform(keys[i], shape, jnp.float32, lo, hi)

    return {
        'x': nrm(0, (BATCH, SEQ, D), 1.0),
        'mem': nrm(1, (BATCH, N_MEM, D), 1.0),
        'w_in': nrm(2, (L, D, P_IN), D ** -0.5),
        'gla_conv': nrm(3, (L, CONV_W, 2 * GLA_QK + GLA_V), CONV_W ** -0.5),
        'gla_gate_w2': nrm(4, (L, GLA_GATE_RANK, GLA_QK), GLA_GATE_RANK ** -0.5),
        'gla_gate_b': nrm(5, (L, GLA_QK), 0.1),
        'gla_norm_g': 1.0 + nrm(6, (L, GLA_V), 0.02),
        'hg_lower_bound': 1.0 + nrm(7, (L, HG_K), 0.1),
        'hg_norm_g': 1.0 + nrm(8, (L, HG_V), 0.02),
        'rw_mu': unif(9, (L, RW_COLS), 0.0, 1.0),
        'rw_w0': unif(10, (L, RW_W), -5.0, -1.0),
        'rw_w2': nrm(11, (L, RW_DECAY_RANK, RW_W), 0.5 * RW_DECAY_RANK ** -0.5),
        'rw_a0': nrm(12, (L, RW_W), 0.5),
        'rw_a2': nrm(13, (L, RW_A_RANK, RW_W), 0.5 * RW_A_RANK ** -0.5),
        'rw_g2': nrm(14, (L, RW_GATE_RANK, RW_W), RW_GATE_RANK ** -0.5),
        'rw_k_k': 0.85 + nrm(15, (L, RW_W), 0.05),
        'rw_k_a': 1.0 + nrm(16, (L, RW_W), 0.05),
        'rw_r_k': nrm(17, (L, N_HEADS, HEAD_DIM), 0.1),
        'rw_ln_w': 1.0 + nrm(18, (L, RW_W), 0.02),
        'rw_ln_b': nrm(19, (L, RW_W), 0.02),
        'w_mem_k': nrm(20, (L, D, MEM_W), D ** -0.5),
        'w_mem_v': nrm(21, (L, D, MEM_W), D ** -0.5),
        'w_out': nrm(22, (L, D_MIX, D), DN_BETA * D_MIX ** -0.5),
        'ln1_g': 1.0 + nrm(23, (L, D), 0.02),
        'ln1_b': nrm(24, (L, D), 0.02),
        'router_w': nrm(25, (L, D, E), D ** -0.5),
        'router_b': nrm(26, (L, E), 0.01),
        'w_gu': nrm(27, (L, E, D, 2 * F), D ** -0.5),
        'b_gu': nrm(28, (L, E, 2 * F), 0.01),
        'w_down': nrm(29, (L, E, F, D), DN_BETA * F ** -0.5),
        'b_down': nrm(30, (L, E, D), 0.01),
        'ln2_g': 1.0 + nrm(31, (L, D), 0.02),
        'ln2_b': nrm(32, (L, D), 0.02),
    }


def reference(x, mem, w_in, gla_conv, gla_gate_w2, gla_gate_b, gla_norm_g, hg_lower_bound, hg_norm_g,
              rw_mu, rw_w0, rw_w2, rw_a0, rw_a2, rw_g2, rw_k_k, rw_k_a, rw_r_k, rw_ln_w, rw_ln_b,
              w_mem_k, w_mem_v, w_out, ln1_g, ln1_b, router_w, router_b, w_gu, b_gu, w_down, b_down,
              ln2_g, ln2_b):
    lb = jax.nn.softmax(hg_lower_bound.astype(jnp.float32), axis=0)
    lb = jnp.cumsum(lb, axis=0) - lb[0]
    for l in range(DEPTH):
        h = _mixer(x, mem, w_in[l], gla_conv[l], gla_gate_w2[l], gla_gate_b[l], gla_norm_g[l], lb[l], hg_norm_g[l],
                   rw_mu[l], rw_w0[l], rw_w2[l], rw_a0[l], rw_a2[l], rw_g2[l], rw_k_k[l], rw_k_a[l], rw_r_k[l],
                   rw_ln_w[l], rw_ln_b[l], w_mem_k[l], w_mem_v[l], w_out[l])
        x = _layer_norm(DN_ALPHA * x + h, ln1_g[l], ln1_b[l])
        m = _moe(x, router_w[l], router_b[l], w_gu[l], b_gu[l], w_down[l], b_down[l])
        x = _layer_norm(DN_ALPHA * x + m, ln2_g[l], ln2_b[l])
    return x
```

```cpp
#include <hip/hip_runtime.h>
#include <cstdio>
#include <cstdint>

#ifndef MK_PER_PHASE
#define MK_PER_PHASE 0
#endif

#define LAS __attribute__((address_space(3)))
#define GAS __attribute__((address_space(1)))
typedef unsigned short bf16;
typedef short bf16x8 __attribute__((ext_vector_type(8)));
typedef short s16x4 __attribute__((ext_vector_type(4)));
typedef float f32x4 __attribute__((ext_vector_type(4)));
typedef float f32x2 __attribute__((ext_vector_type(2)));
typedef float f32x16 __attribute__((ext_vector_type(16)));
typedef unsigned u32x4 __attribute__((ext_vector_type(4)));
typedef unsigned u32x2 __attribute__((ext_vector_type(2)));

constexpr int NB = 8, T = 8192, D = 1024, NL = 4, NTOK = NB * T;
constexpr int PIN = 3088, PINP = 3328;
constexpr int NE = 32, FF = 1024, NMEM = 256;
constexpr int NASSIGN = NTOK * 4;
constexpr int MAXTILES = NASSIGN / 256 + NE;
constexpr int MAXSLOTS = MAXTILES * 256;
constexpr int PC_GQ = 0, PC_GK = 128, PC_GV = 256, PC_GOUT = 512, PC_HQ = 768, PC_HF = 1024, PC_HI = 1280, PC_HG = 1536;
constexpr int PC_RW = 1792, PC_MQ = 2816, PC_GLR = 3072;
constexpr float DN_ALPHA = 1.6817928305074292f;
constexpr float LN_EPS = 1e-5f, RMS_EPS = 1e-6f, RW_LN_EPS = 64e-5f;

constexpr size_t MiB = 1u << 20;
constexpr size_t WS_CTL = 0, CTL_ZERO_BYTES = 1 * MiB;
constexpr size_t WS_WIN = 1 * MiB;
constexpr size_t WS_WOUT = WS_WIN + 26 * MiB;
constexpr size_t WS_WMEM = WS_WOUT + 8 * MiB;
constexpr size_t WS_WGU = WS_WMEM + 4 * MiB;
constexpr size_t WS_WD = WS_WGU + 512 * MiB;
constexpr size_t WS_BGU = WS_WD + 256 * MiB;
constexpr size_t WS_LORA = WS_BGU + 1 * MiB;
constexpr size_t WS_MEMB = WS_LORA + 1 * MiB;
constexpr size_t WS_MKV = WS_MEMB + 4 * MiB;
constexpr size_t WS_XB = WS_MKV + 8 * MiB;
constexpr size_t WS_X1B = WS_XB + 128 * MiB;
constexpr size_t WS_XF = WS_X1B + 128 * MiB;
constexpr size_t WS_X1F = WS_XF + 256 * MiB;
constexpr size_t WS_O = WS_X1F + 256 * MiB;
constexpr size_t WS_HMIX = WS_O + 128 * MiB;
constexpr size_t WS_ROUTE = WS_HMIX + 128 * MiB;
constexpr size_t WS_GBUF = WS_ROUTE + 6 * MiB;
constexpr size_t WS_BONUS = WS_GBUF + 32 * MiB;
constexpr size_t WS_BIG = WS_BONUS + 1 * MiB;
constexpr size_t WS_P = WS_BIG;
constexpr size_t WS_SCAN0 = WS_P + 416 * MiB;
constexpr size_t WS_SCAN1 = WS_SCAN0 + 160 * MiB;
constexpr size_t WS_SCAN2 = WS_SCAN1 + 256 * MiB;
constexpr size_t WS_ORAW = WS_SCAN2 + 384 * MiB;
constexpr size_t WS_HB = WS_BIG;
constexpr size_t WS_YB = WS_HB + 528 * MiB;
constexpr size_t WS_CHK = WS_ORAW;
constexpr size_t WS_HQ = WS_CHK, WS_HK = WS_HQ + 32 * MiB, WS_HVT = WS_HK + 32 * MiB, WS_HDS = WS_HVT + 32 * MiB, WS_HS = WS_HDS + 128 * MiB, WS_HBE = WS_HS + 64 * MiB;
constexpr size_t WS_GQ = WS_HBE + 2 * MiB, WS_GK = WS_GQ + 16 * MiB, WS_GVT = WS_GK + 16 * MiB, WS_GDS = WS_GVT + 32 * MiB, WS_GS = WS_GDS + 64 * MiB, WS_GBE = WS_GS + 32 * MiB;
constexpr size_t WS_RR = WS_GBE + 1 * MiB, WS_RB = WS_RR + 32 * MiB, WS_RK = WS_RB + 32 * MiB, WS_RW = WS_RK + 32 * MiB, WS_RVT = WS_RW + 32 * MiB;
constexpr size_t WS_RU = WS_RVT + 32 * MiB, WS_RP = WS_RU + 64 * MiB, WS_RQ = WS_RP + 64 * MiB, WS_RS = WS_RQ + 128 * MiB;
constexpr size_t WS_END = WS_RS + 64 * MiB;
static_assert(WS_YB + 528 * MiB <= WS_END, "overlay");
static_assert(WS_END <= (size_t)4096 * MiB, "workspace");
constexpr int CW_TMO = 0;
constexpr int CW_BAR = 4096;
constexpr int CW_HIST = 16384;
constexpr int CW_NT = 32768;
constexpr int CW_TILEE = 32768 + 64;
constexpr int CW_PADSTART = 40960;

constexpr int RING_BYTES = 131072;
constexpr int LDSCTL_OFF = 162816, MISC_OFF = LDSCTL_OFF + 320;
constexpr int LDS_BYTES = 163840;
constexpr int NWAVES = 8, NTHR = 512;

#define RLX_AGENT __ATOMIC_RELAXED, __HIP_MEMORY_SCOPE_AGENT
#define LDS_WAIT() asm volatile("s_waitcnt lgkmcnt(0)" ::: "memory")
#define VM_WAIT() asm volatile("s_waitcnt vmcnt(0)" ::: "memory")

__device__ __forceinline__ unsigned f2bf(float f) { unsigned u = __builtin_bit_cast(unsigned, f); return (u + 0x7fffu + ((u >> 16) & 1u)) >> 16; }
__device__ __forceinline__ unsigned pk2(float lo, float hi) { return f2bf(lo) | (f2bf(hi) << 16); }
__device__ __forceinline__ float bf2f(unsigned short b) { return __builtin_bit_cast(float, (unsigned)b << 16); }
__device__ __forceinline__ float bflo(unsigned w) { return __builtin_bit_cast(float, w << 16); }
__device__ __forceinline__ float bfhi(unsigned w) { return __builtin_bit_cast(float, w & 0xffff0000u); }
typedef __bf16 bf16x2_t __attribute__((ext_vector_type(2)));
__device__ __forceinline__ unsigned cvt_pk_bf16(float lo, float hi) { const f32x2 v = {lo, hi}; const bf16x2_t b = __builtin_convertvector(v, bf16x2_t); return __builtin_bit_cast(unsigned, b); }
__device__ __forceinline__ float fast_exp(float x) { return __builtin_amdgcn_exp2f(x * 1.4426950408889634f); }
__device__ __forceinline__ float fast_sigmoid(float x) { return __builtin_amdgcn_rcpf(1.0f + fast_exp(-x)); }
__device__ __forceinline__ float silu_f(float x) { return x * fast_sigmoid(x); }
__device__ __forceinline__ int opaque_tid() { int t = threadIdx.x; asm volatile("" : "+v"(t)); return t; }
__device__ __forceinline__ int opaque_s(int v) { asm volatile("" : "+s"(v)); return v; }
__device__ __forceinline__ float wave_sum(float v) {
#pragma unroll
    for (int o = 1; o < 64; o <<= 1) v += __shfl_xor(v, o);
    return v;
}

namespace pg8 {
constexpr int BM = 256, BK = 64, HALF = 128, HTB = HALF * BK * 2, STAGE_BYTES = 8 * HTB, NXCD = 8, WGM = 8;
__host__ __device__ __forceinline__ int lds_byte(int r, int c) { const int st = (r >> 4) * 2 + (c >> 5), rr = r & 15, cc = c & 31, ob = rr * 64 + cc * 2; return st * 1024 + (ob ^ (((ob >> 9) & 1) << 5)); }
__host__ __device__ __forceinline__ void stage_rc(int b, int& R, int& C) { const int st = b / 1024, sb = b % 1024, swz = sb ^ (((sb >> 9) & 1) << 5); R = (st >> 1) * 16 + swz / 64; C = (st & 1) * 32 + (swz % 64) / 2; }
__host__ __device__ __forceinline__ int perm32(int rho) { const int n = rho >> 4, i = rho & 15; return 8 * (i >> 2) + 4 * n + (i & 3); }

struct Unit { int pm, pn, e; const char* A; const char* B; };

__device__ __forceinline__ bool static_tile(int i, int G, int c, int nM, int nN, int& pm, int& pn) {
    const int nwg = nM * nN; const long L = (long)i * G + c; if (L >= nwg) return false;
    int wgid = (int)L; { const int q = nwg / NXCD, r = nwg % NXCD, xcd = wgid % NXCD, off = wgid / NXCD; wgid = (xcd < r ? xcd * (q + 1) : r * (q + 1) + (xcd - r) * q) + off; }
    const int nig = WGM * nN, gid = wgid / nig, fm = gid * WGM, gsz = (nM - fm) < WGM ? (nM - fm) : WGM;
    pm = fm + ((wgid % nig) % gsz); pn = (wgid % nig) / gsz; return true;
}
struct DenseOrder {
    static constexpr bool GATHER = false;
    const char* A; const char* B; int nM, nN, G, c; size_t tstep;
    __device__ __forceinline__ void init(const void* A_, const void* B_, int M, int N, int K, int G_, int c_) { A = (const char*)A_; B = (const char*)B_; nM = M / BM; nN = N / BM; G = G_; c = c_; tstep = (size_t)BM * K * 2; }
    __device__ __forceinline__ bool next(int i, Unit& u) const { if (!static_tile(i, G, c, nM, nN, u.pm, u.pn)) return false; u.e = 0; u.A = A + (size_t)u.pm * tstep; u.B = B + (size_t)u.pn * tstep; return true; }
    __device__ __forceinline__ unsigned row_tok(const Unit&, int) const { return 0; }
};
template <bool GATHER_> struct MoeOrder {
    static constexpr bool GATHER = GATHER_;
    const char* A; const char* B; const int* tile_e; const int* slot_tok; int nM, nN, G, c; size_t tstep, estep;
    __device__ __forceinline__ void init(const void* A_, const void* B_, const int* tile_e_, const int* slot_tok_, int ntiles, int Nper, int K, int G_, int c_) {
        A = (const char*)A_; B = (const char*)B_; tile_e = tile_e_; slot_tok = slot_tok_; nM = ntiles; nN = Nper / BM; G = G_; c = c_; tstep = (size_t)BM * K * 2; estep = (size_t)Nper * K * 2; }
    __device__ __forceinline__ bool next(int i, Unit& u) const { if (!static_tile(i, G, c, nM, nN, u.pm, u.pn)) return false;
        u.e = __builtin_amdgcn_readfirstlane(tile_e[u.pm]); u.A = GATHER_ ? A : A + (size_t)u.pm * tstep; u.B = B + (size_t)u.e * estep + (size_t)u.pn * tstep; return true; }
    __device__ __forceinline__ unsigned row_tok(const Unit& u, int r) const { return (unsigned)slot_tok[u.pm * BM + r]; }
};

struct EpiBf16 {
    static constexpr bool PERM = true;
    bf16* O; int ldc;
    __device__ __forceinline__ void operator()(const f32x4 (&acc)[2][2][4][2], const Unit& u, int wr, int wc, int fr, int fq) const {
        const int row0 = u.pm * BM + wr * 64 + fr, col0 = u.pn * BM + wc * 32 + 8 * fq;
#pragma unroll
        for (int ai = 0; ai < 2; ++ai)
#pragma unroll
            for (int m = 0; m < 4; ++m) { bf16* rowp = O + (size_t)(row0 + ai * HALF + m * 16) * ldc + col0;
#pragma unroll
                for (int bj = 0; bj < 2; ++bj) { const f32x4 v0 = acc[ai][bj][m][0], v1 = acc[ai][bj][m][1];
                    u32x4 w; w.x = cvt_pk_bf16(v0[0], v0[1]); w.y = cvt_pk_bf16(v0[2], v0[3]); w.z = cvt_pk_bf16(v1[0], v1[1]); w.w = cvt_pk_bf16(v1[2], v1[3]);
                    *(u32x4*)(rowp + bj * HALF) = w; } }
    }
};
struct EpiSwiglu {
    static constexpr bool PERM = false;
    bf16* H; const float* bias;
    __device__ __forceinline__ void operator()(const f32x4 (&acc)[2][2][4][2], const Unit& u, int wr, int wc, int fr, int fq) const {
        const int row0 = u.pm * BM + wr * 64 + fr, colh = u.pn * 128 + wc * 32 + 8 * fq;
        const float* bp = bias + (size_t)u.e * 2048 + u.pn * 256 + wc * 32 + 4 * fq;
        f32x4 bv[2][2];
#pragma unroll
        for (int bj = 0; bj < 2; ++bj)
#pragma unroll
            for (int n = 0; n < 2; ++n) bv[bj][n] = *(const f32x4*)(bp + bj * HALF + n * 16);
#pragma unroll
        for (int ai = 0; ai < 2; ++ai)
#pragma unroll
            for (int m = 0; m < 4; ++m) { bf16* rowp = H + (size_t)(row0 + ai * HALF + m * 16) * FF + colh;
                float o[8];
#pragma unroll
                for (int n = 0; n < 2; ++n) { const f32x4 g4 = acc[ai][0][m][n] + bv[0][n], u4 = acc[ai][1][m][n] + bv[1][n];
#pragma unroll
                    for (int j = 0; j < 4; ++j) { const float g = fminf(g4[j], 7.0f), up = fminf(fmaxf(u4[j], -7.0f), 7.0f);
                        const float glu = g * __builtin_amdgcn_rcpf(1.0f + __builtin_amdgcn_exp2f(g * (-1.702f * 1.4426950408889634f)));
                        o[n * 4 + j] = (up + 1.0f) * glu; } }
                u32x4 w; w.x = cvt_pk_bf16(o[0], o[1]); w.y = cvt_pk_bf16(o[2], o[3]); w.z = cvt_pk_bf16(o[4], o[5]); w.w = cvt_pk_bf16(o[6], o[7]);
                *(u32x4*)rowp = w; }
    }
};
struct EpiDown {
    static constexpr bool PERM = true;
    bf16* Y; const float* bias; const float* slot_gate;
    __device__ __forceinline__ void operator()(const f32x4 (&acc)[2][2][4][2], const Unit& u, int wr, int wc, int fr, int fq) const {
        const int row0 = u.pm * BM + wr * 64 + fr, col0 = u.pn * BM + wc * 32 + 8 * fq;
        const float* bp = bias + (size_t)u.e * 1024 + col0;
        f32x4 bv[2][2];
#pragma unroll
        for (int bj = 0; bj < 2; ++bj)
#pragma unroll
            for (int n = 0; n < 2; ++n) bv[bj][n] = *(const f32x4*)(bp + bj * HALF + 4 * n);
#pragma unroll
        for (int ai = 0; ai < 2; ++ai)
#pragma unroll
            for (int m = 0; m < 4; ++m) { const int row = row0 + ai * HALF + m * 16; const float g = slot_gate[row]; bf16* rowp = Y + (size_t)row * D + col0;
#pragma unroll
                for (int bj = 0; bj < 2; ++bj) { const f32x4 v0 = (acc[ai][bj][m][0] + bv[bj][0]) * g, v1 = (acc[ai][bj][m][1] + bv[bj][1]) * g;
                    u32x4 w; w.x = cvt_pk_bf16(v0[0], v0[1]); w.y = cvt_pk_bf16(v0[2], v0[3]); w.z = cvt_pk_bf16(v1[0], v1[1]); w.w = cvt_pk_bf16(v1[2], v1[3]);
                    *(u32x4*)(rowp + bj * HALF) = w; } }
    }
};

template <class Epi, class Sched, bool ALIGN_EPI = true>
__device__ __forceinline__ void gemm_phase(LAS unsigned char* lds, const int K, const Sched& S, const Epi& E) {
    constexpr bool GA = Sched::GATHER;
    const int tid = opaque_tid(), wid = __builtin_amdgcn_readfirstlane(tid >> 6), lane = tid & 63, wr = wid >> 2, wc = wid & 3, fr = lane & 15, fq = lane >> 4;
    const int nt = K / BK;
    unsigned voffA[2], voffB[2]; int Rr[2]; unsigned Cb[2];
#pragma unroll
    for (int i = 0; i < 2; ++i) { int R, C; stage_rc(tid * 16 + i * 8192, R, C); const int Rb = Epi::PERM ? ((R & ~31) + perm32(R & 31)) : R;
        voffA[i] = (unsigned)(R * K + C) * 2u; voffB[i] = (unsigned)(Rb * K + C) * 2u; Rr[i] = R; Cb[i] = (unsigned)C * 2u; }
    const size_t kstep = (size_t)(BK * 2);
    const size_t hstep = (size_t)HALF * K * 2;
    const unsigned ldsw = (unsigned)wid * 1024u;
    const int aoff = lds_byte(wr * 64 + fr, fq * 8), boff = lds_byte(wc * 32 + fr, fq * 8);
    unsigned cOff[2][2], nOff[2][2], sOff[2][2];
#define PG8_SA(b, h) (((b) * 2 + (h)) * HTB)
#define PG8_SB(b, h) ((4 + (b) * 2 + (h)) * HTB)
#define PG8_STAGE(bufoff, gbase, voff) do { _Pragma("unroll") for (int _i = 0; _i < 2; ++_i) \
        __builtin_amdgcn_global_load_lds((const unsigned*)((const char*)(gbase) + (voff)[_i]), (LAS unsigned*)(lds + (bufoff) + ldsw + _i * 8192), 16, 0, 0); } while (0)
#define PG8_STAGE_A(bufoff, gbase, half, OFF) do { if constexpr (GA) { PG8_STAGE(bufoff, gbase, (OFF)[half]); } else { PG8_STAGE(bufoff, (gbase) + (half) * hstep, voffA); } } while (0)
#define PG8_LDA(dst, b, h) do { _Pragma("unroll") for (int m = 0; m < 4; ++m) _Pragma("unroll") for (int k = 0; k < 2; ++k) dst[m][k] = *(const LAS bf16x8*)(lds + PG8_SA(b, h) + aoff + m * 2048 + k * 1024); } while (0)
#define PG8_LDB(dst, b, h) do { _Pragma("unroll") for (int n = 0; n < 2; ++n) _Pragma("unroll") for (int k = 0; k < 2; ++k) dst[n][k] = *(const LAS bf16x8*)(lds + PG8_SB(b, h) + boff + n * 2048 + k * 1024); } while (0)
#define PG8_MMA(ai, bj, At, Bt) do { __builtin_amdgcn_s_setprio(1); _Pragma("unroll") for (int m = 0; m < 4; ++m) _Pragma("unroll") for (int n = 0; n < 2; ++n) _Pragma("unroll") for (int k = 0; k < 2; ++k) \
        acc[ai][bj][m][n] = __builtin_amdgcn_mfma_f32_16x16x32_bf16(Bt[n][k], At[m][k], acc[ai][bj][m][n], 0, 0, 0); __builtin_amdgcn_s_setprio(0); } while (0)
#define PG8_WAIT_V(n) asm volatile("s_waitcnt vmcnt(" #n ")" ::: "memory")
#define PG8_WAIT_L(n) asm volatile("s_waitcnt lgkmcnt(" #n ")" ::: "memory")
#define PG8_BAR __builtin_amdgcn_s_barrier()
#define PG8_SCHED __builtin_amdgcn_sched_barrier(0)
#define PG8_GOFF(dst, u) do { if constexpr (GA) { _Pragma("unroll") for (int _h = 0; _h < 2; ++_h) _Pragma("unroll") for (int _i = 0; _i < 2; ++_i) \
        dst[_h][_i] = S.row_tok(u, _h * HALF + Rr[_i]) * (unsigned)(K * 2) + Cb[_i]; } } while (0)
    Unit cur, nxt; int ui = 0;
    if (!S.next(0, cur)) return;
    f32x4 acc[2][2][4][2];
#pragma unroll
    for (int a = 0; a < 2; ++a)
#pragma unroll
        for (int b = 0; b < 2; ++b)
#pragma unroll
            for (int m = 0; m < 4; ++m)
#pragma unroll
                for (int n = 0; n < 2; ++n) acc[a][b][m][n] = (f32x4){0.f, 0.f, 0.f, 0.f};
    bf16x8 At[4][2], B0[2][2], B1[2][2];
    const char* cA = cur.A; const char* cB = cur.B;
    PG8_GOFF(cOff, cur);
#pragma unroll
    for (int h = 0; h < 2; ++h)
#pragma unroll
        for (int i = 0; i < 2; ++i) { nOff[h][i] = 0u; sOff[h][i] = 0u; }
    if constexpr (GA) { VM_WAIT(); }
    PG8_STAGE(PG8_SB(0, 0), cB, voffB); PG8_STAGE(PG8_SB(0, 1), cB + hstep, voffB); PG8_STAGE_A(PG8_SA(0, 0), cA, 0, cOff); PG8_STAGE_A(PG8_SA(0, 1), cA, 1, cOff);
    if (wr == 1) PG8_BAR;
    PG8_WAIT_V(2); PG8_BAR;
    PG8_STAGE(PG8_SB(1, 0), cB + kstep, voffB); PG8_STAGE_A(PG8_SA(1, 0), cA + kstep, 0, cOff); PG8_STAGE(PG8_SB(1, 1), cB + hstep + kstep, voffB);
    PG8_WAIT_V(6); PG8_BAR;
    for (;;) {
        const bool has_next = S.next(ui + 1, nxt);
        const char* nA = has_next ? nxt.A : cA; const char* nB = has_next ? nxt.B : cB;
        if constexpr (GA) { if (has_next) { PG8_GOFF(nOff, nxt); } else {
#pragma unroll
            for (int h = 0; h < 2; ++h)
#pragma unroll
                for (int i = 0; i < 2; ++i) nOff[h][i] = cOff[h][i]; } }
        for (int t = 0; t < nt; t += 2) {
            const bool last = (t == nt - 2);
            const char* a1 = cA + (size_t)(t + 1) * kstep;
            const char* a2 = last ? nA : cA + (size_t)(t + 2) * kstep; const char* b2 = last ? nB : cB + (size_t)(t + 2) * kstep;
            const char* a3 = a2 + kstep; const char* b3 = b2 + kstep;
            if constexpr (GA) {
#pragma unroll
                for (int h = 0; h < 2; ++h)
#pragma unroll
                    for (int i = 0; i < 2; ++i) sOff[h][i] = last ? nOff[h][i] : cOff[h][i]; }
            PG8_LDB(B0, 0, 0); PG8_LDB(B1, 0, 1); PG8_SCHED; PG8_LDA(At, 0, 0); PG8_STAGE_A(PG8_SA(1, 1), a1, 1, cOff);
            PG8_WAIT_V(8); PG8_WAIT_L(0); PG8_BAR; PG8_MMA(0, 0, At, B0); PG8_MMA(0, 1, At, B1); PG8_BAR; PG8_SCHED;
            PG8_LDA(At, 0, 1); PG8_STAGE(PG8_SB(0, 0), b2, voffB); PG8_STAGE(PG8_SB(0, 1), b2 + hstep, voffB); PG8_STAGE_A(PG8_SA(0, 0), a2, 0, sOff);
            PG8_WAIT_V(8); PG8_WAIT_L(0); PG8_BAR; PG8_MMA(1, 0, At, B0); PG8_MMA(1, 1, At, B1); PG8_BAR; PG8_SCHED;
            PG8_LDB(B0, 1, 0); PG8_LDB(B1, 1, 1); PG8_SCHED; PG8_LDA(At, 1, 0); PG8_STAGE_A(PG8_SA(0, 1), a2, 1, sOff);
            PG8_WAIT_V(8); PG8_WAIT_L(0); PG8_BAR; PG8_MMA(0, 0, At, B0); PG8_MMA(0, 1, At, B1); PG8_BAR; PG8_SCHED;
            PG8_LDA(At, 1, 1); PG8_STAGE(PG8_SB(1, 0), b3, voffB); PG8_STAGE(PG8_SB(1, 1), b3 + hstep, voffB); PG8_STAGE_A(PG8_SA(1, 0), a3, 0, sOff);
            PG8_WAIT_V(8); PG8_WAIT_L(0); PG8_BAR; PG8_MMA(1, 0, At, B0); PG8_MMA(1, 1, At, B1); PG8_BAR; PG8_SCHED;
        }
        if constexpr (ALIGN_EPI) { if (wr == 0) PG8_BAR; }
        E(acc, cur, wr, wc, fr, fq);
        if (!has_next) break;
#pragma unroll
        for (int a = 0; a < 2; ++a)
#pragma unroll
            for (int b = 0; b < 2; ++b)
#pragma unroll
                for (int m = 0; m < 4; ++m)
#pragma unroll
                    for (int n = 0; n < 2; ++n) acc[a][b][m][n] = (f32x4){0.f, 0.f, 0.f, 0.f};
        cur = nxt; cA = nA; cB = nB; ++ui;
        if constexpr (GA) {
#pragma unroll
            for (int h = 0; h < 2; ++h)
#pragma unroll
                for (int i = 0; i < 2; ++i) cOff[h][i] = nOff[h][i]; }
        if constexpr (ALIGN_EPI) { if (wr == 1) PG8_BAR; }
    }
    PG8_WAIT_V(0);
    if constexpr (!ALIGN_EPI) { if (wr == 0) PG8_BAR; }
    PG8_BAR;
#undef PG8_SA
#undef PG8_SB
#undef PG8_STAGE
#undef PG8_STAGE_A
#undef PG8_LDA
#undef PG8_LDB
#undef PG8_MMA
#undef PG8_WAIT_V
#undef PG8_WAIT_L
#undef PG8_BAR
#undef PG8_SCHED
#undef PG8_GOFF
}
}

#define XB_TMO      128
#define XB_XCNT(j)  (256  + 64 * (j))
#define XB_XSUB(j)  (1280 + 64 * (j))
#define XB_XGEN(j)  (2304 + 64 * (j))
#define XB_TOP      3328
#define XB_TOPGEN   3392
#define XCD_BAR_WORDS 3456
#define XB_SPIN_CAP (1u << 18)
__device__ __forceinline__ unsigned xb_ld(unsigned* p)              { return __hip_atomic_load(p, __ATOMIC_RELAXED, __HIP_MEMORY_SCOPE_AGENT); }
__device__ __forceinline__ unsigned xb_add(unsigned* p, unsigned v) { return __hip_atomic_fetch_add(p, v, __ATOMIC_RELAXED, __HIP_MEMORY_SCOPE_AGENT); }
__device__ __forceinline__ unsigned xb_xcc_id() { return (unsigned)__builtin_amdgcn_s_getreg((3 << 11) | 20) & 0xFu; }
#define XB_SPIN(cond, bar) do { unsigned _sp = 0; while (cond) { __builtin_amdgcn_s_sleep(1); \
    if ((++_sp & 255u) == 0u) { if (xb_ld(&(bar)[XB_TMO])) break; if (_sp > XB_SPIN_CAP) { atomicAdd(&(bar)[XB_TMO], 1u); break; } } } } while (0)
struct XcdBarrier { unsigned* bar; unsigned x; volatile LAS unsigned* st; };
__device__ __forceinline__ XcdBarrier xcd_barrier_post(unsigned* bar, volatile LAS unsigned* st) {
    XcdBarrier b; b.bar = bar; b.x = xb_xcc_id(); b.st = st;
    if (threadIdx.x == 0) (void)xb_add(&bar[XB_XCNT(b.x)], 1u);
    return b;
}
__device__ __forceinline__ void xcd_barrier_complete(unsigned* bar, unsigned x, unsigned& nloc, unsigned& nx) {
    const unsigned G = gridDim.x * gridDim.y * gridDim.z;
    unsigned sum, cnt, mine, sp = 0u;
    for (;;) {
        sum = 0u; cnt = 0u; mine = 0u;
#pragma unroll
        for (unsigned j = 0; j < 16; ++j) { const unsigned c = xb_ld(&bar[XB_XCNT(j)]); sum += c; cnt += (c > 0u) ? 1u : 0u; mine = (j == x) ? c : mine; }
        if (sum == G) break;
        __builtin_amdgcn_s_sleep(1);
        if ((++sp & 255u) == 0u) { if (xb_ld(&bar[XB_TMO])) break; if (sp > XB_SPIN_CAP) { atomicAdd(&bar[XB_TMO], 1u); break; } }
    }
    nloc = mine > 0u ? mine : 1u; nx = cnt > 0u ? cnt : 1u;
}
__device__ __forceinline__ void xcd_barrier(const XcdBarrier& b) {
    asm volatile("s_waitcnt vmcnt(0)" ::: "memory");
    __syncthreads();
    if (threadIdx.x == 0) {
        unsigned* bar = b.bar;
        __builtin_amdgcn_s_waitcnt(0);
        unsigned nloc = b.st[0], nx = b.st[1];
        if (nloc == 0u) { xcd_barrier_complete(bar, b.x, nloc, nx); b.st[0] = nloc; b.st[1] = nx; }
        const unsigned old = xb_add(&bar[XB_XSUB(b.x)], 1u);
        const unsigned gen = old / nloc;
        if (old + 1u == (gen + 1u) * nloc) {
            __builtin_amdgcn_fence(__ATOMIC_RELEASE, "agent");
            asm volatile("s_waitcnt vmcnt(0)" ::: "memory");
            const unsigned og = xb_add(&bar[XB_TOP], 1u);
            const unsigned tg = og / nx;
            if (og + 1u == (tg + 1u) * nx) xb_add(&bar[XB_TOPGEN], 1u);
            else XB_SPIN(xb_ld(&bar[XB_TOPGEN]) == tg, bar);
            __builtin_amdgcn_fence(__ATOMIC_ACQUIRE, "agent");
            xb_add(&bar[XB_XGEN(b.x)], 1u);
            asm volatile("s_waitcnt vmcnt(0)" ::: "memory");
        } else {
            XB_SPIN(xb_ld(&bar[XB_XGEN(b.x)]) == gen, bar);
            __builtin_amdgcn_fence(__ATOMIC_ACQUIRE, "agent");
            asm volatile("s_waitcnt vmcnt(0)" ::: "memory");
        }
    }
    __syncthreads();
}

struct Args {
    const float* in[33];
    float* out; unsigned char* ws;
    int ph_lo, ph_hi;
};
enum { I_X = 0, I_MEM, I_WIN, I_GLACONV, I_GLAW2, I_GLAB, I_GLANG, I_HGLB, I_HGNG, I_RWMU, I_RWW0, I_RWW2, I_RWA0, I_RWA2, I_RWG2, I_RWKK, I_RWKA, I_RWRK, I_RWLNW, I_RWLNB,
       I_WMK, I_WMV, I_WOUT, I_LN1G, I_LN1B, I_RTW, I_RTB, I_WGU, I_BGU, I_WDN, I_BDN, I_LN2G, I_LN2B };


template <int OFF> __device__ __forceinline__ unsigned long long ka_u64() { unsigned long long v; asm volatile("s_load_dwordx2 %0, %1, %2\n\ts_waitcnt lgkmcnt(0)" : "=s"(v) : "s"(__builtin_amdgcn_kernarg_segment_ptr()), "n"(OFF)); return v; }
#define KIN(i) ((const float*)(const GAS float*)ka_u64<8 * (i)>())
#define KOUT() ((float*)(GAS float*)ka_u64<264>())
#define KWS() ((unsigned char*)(GAS unsigned char*)ka_u64<272>())

template <class Map>
__device__ __forceinline__ void tr_item(const float* __restrict__ W, int K, int N, bf16* __restrict__ WT, LAS float* scr, int kb, int nb, int lane, Map map) {
    const int k0 = 64 * kb, n0 = 64 * nb, col = n0 + lane; const bool valid = col < N;
    const float* src = W + (size_t)k0 * N + (valid ? col : 0);
#pragma unroll 16
    for (int kk = 0; kk < 64; ++kk) { const float v = valid ? src[(size_t)kk * N] : 0.f; scr[kk * 65 + lane] = v; }
    LDS_WAIT(); asm volatile("" ::: "memory");
    const int c = lane & 7;
#pragma unroll
    for (int j = 0; j < 8; ++j) { const int n = (lane >> 3) + 8 * j;
        if (n0 + n < N) { const int orow = map(n0 + n); const LAS float* s = scr + (8 * c) * 65 + n;
            u32x4 o; o.x = pk2(s[0 * 65], s[1 * 65]); o.y = pk2(s[2 * 65], s[3 * 65]); o.z = pk2(s[4 * 65], s[5 * 65]); o.w = pk2(s[6 * 65], s[7 * 65]);
            *(u32x4*)(WT + (size_t)orow * K + k0 + 8 * c) = o; } }
    LDS_WAIT(); asm volatile("" ::: "memory");
}
struct MapIdent { int off; __device__ __forceinline__ int operator()(int c) const { return c + off; } };
struct MapWin { __device__ __forceinline__ int operator()(int c) const { return c < 512 ? c : (c < 528 ? c + 2560 : c - 16); } };
__device__ __forceinline__ int gu_row(int c) { const int f = c >> 1, bj = c & 1, pn = f >> 7, fl = f & 127, wc = fl >> 5, fq = (fl >> 3) & 3, n = (fl >> 2) & 1, j = fl & 3; return 256 * pn + 128 * bj + 32 * wc + 16 * n + 4 * fq + j; }
struct MapGu { __device__ __forceinline__ int operator()(int c) const { return gu_row(c); } };

__device__ __forceinline__ void prologue_phase(LAS unsigned char* lds, int vcu, int G) {
    const int tid = opaque_tid(), lane = tid & 63, wave = __builtin_amdgcn_readfirstlane(tid >> 6);
    LAS float* scr = (LAS float*)(lds + wave * 16640); static_assert(8 * 16640 <= LDSCTL_OFF, "prologue scratch below the LDS control words");
    const int gw = vcu * NWAVES + wave, NGW = G * NWAVES;
    unsigned char* ws = KWS();
    constexpr int IT_GU = NL * NE * 512, IT_DN = NL * NE * 256, IT_IN = NL * 16 * 49, IT_OUT = NL * 256, IT_MEM = NL * 2 * 64, IT_L64 = NL * 2 * 4, IT_L128 = NL * 2 * 4;
    constexpr int IT_TOTAL = IT_GU + IT_DN + IT_IN + IT_OUT + IT_MEM + IT_L64 + IT_L128;
    for (int it = gw; it < IT_TOTAL; it += NGW) {
        int r = it;
        if (r < IT_GU) { const int le = r >> 9, q = r & 511, kb = q >> 5, nb = q & 31;
            tr_item(KIN(I_WGU) + (size_t)le * 1024 * 2048, 1024, 2048, (bf16*)(ws + WS_WGU) + (size_t)le * 2048 * 1024, scr, kb, nb, lane, MapGu{}); continue; } r -= IT_GU;
        if (r < IT_DN) { const int le = r >> 8, q = r & 255, kb = q >> 4, nb = q & 15;
            tr_item(KIN(I_WDN) + (size_t)le * 1024 * 1024, 1024, 1024, (bf16*)(ws + WS_WD) + (size_t)le * 1024 * 1024, scr, kb, nb, lane, MapIdent{0}); continue; } r -= IT_DN;
        if (r < IT_IN) { const int l = r / (16 * 49), q = r % (16 * 49), kb = q / 49, nb = q % 49;
            tr_item(KIN(I_WIN) + (size_t)l * 1024 * PIN, 1024, PIN, (bf16*)(ws + WS_WIN) + (size_t)l * PINP * 1024, scr, kb, nb, lane, MapWin{}); continue; } r -= IT_IN;
        if (r < IT_OUT) { const int l = r >> 8, q = r & 255, kb = q >> 4, nb = q & 15;
            tr_item(KIN(I_WOUT) + (size_t)l * 1024 * 1024, 1024, 1024, (bf16*)(ws + WS_WOUT) + (size_t)l * 1024 * 1024, scr, kb, nb, lane, MapIdent{0}); continue; } r -= IT_OUT;
        if (r < IT_MEM) { const int l = r >> 7, q = r & 127, kv = q >> 6, kb = (q >> 2) & 15, nb = q & 3;
            tr_item((kv ? KIN(I_WMV) : KIN(I_WMK)) + (size_t)l * 1024 * 256, 1024, 256, (bf16*)(ws + WS_WMEM), scr, kb, nb, lane, MapIdent{l * 512 + kv * 256}); continue; } r -= IT_MEM;
        if (r < IT_L64) { const int l = r >> 3, q = r & 7, wa = q >> 2, nb = q & 3;
            tr_item((wa ? KIN(I_RWA2) : KIN(I_RWW2)) + (size_t)l * 64 * 256, 64, 256, (bf16*)(ws + WS_LORA) + (size_t)wa * (NL * 256 * 64) + (size_t)l * 256 * 64, scr, 0, nb, lane, MapIdent{0}); continue; } r -= IT_L64;
        { const int l = r >> 3, q = r & 7, kb = q >> 2, nb = q & 3;
            tr_item(KIN(I_RWG2) + (size_t)l * 128 * 256, 128, 256, (bf16*)(ws + WS_LORA) + (size_t)2 * (NL * 256 * 64) + (size_t)l * 256 * 128, scr, kb, nb, lane, MapIdent{0}); }
    }
    { const size_t gt = (size_t)vcu * NTHR + tid, GT = (size_t)G * NTHR; constexpr size_t per = (size_t)(PINP - PIN) * 1024 / 8;
        for (size_t i = gt; i < per * NL; i += GT) { const size_t l = i / per, j = i % per; *(u32x4*)((bf16*)(ws + WS_WIN) + l * PINP * 1024 + (size_t)PIN * 1024 + j * 8) = (u32x4){0u, 0u, 0u, 0u}; }
        for (size_t i = gt; i < (size_t)NL * NE * 2048; i += GT) { const size_t le = i >> 11; const int c = (int)(i & 2047); ((float*)(ws + WS_BGU))[le * 2048 + gu_row(c)] = KIN(I_BGU)[i]; }
        const f32x4* xs = (const f32x4*)KIN(I_X); u32x4* xd = (u32x4*)(ws + WS_XB);
        for (size_t i = gt; i < (size_t)NTOK * D / 8; i += GT) { const f32x4 v0 = xs[2 * i], v1 = xs[2 * i + 1]; xd[i] = (u32x4){pk2(v0[0], v0[1]), pk2(v0[2], v0[3]), pk2(v1[0], v1[1]), pk2(v1[2], v1[3])}; }
        const f32x4* ms = (const f32x4*)KIN(I_MEM); u32x4* md = (u32x4*)(ws + WS_MEMB);
        for (size_t i = gt; i < (size_t)NB * NMEM * D / 8; i += GT) { const f32x4 v0 = ms[2 * i], v1 = ms[2 * i + 1]; md[i] = (u32x4){pk2(v0[0], v0[1]), pk2(v0[2], v0[3]), pk2(v1[0], v1[1]), pk2(v1[2], v1[3])}; }
    }
}


__device__ __forceinline__ float log1pexp_neg_abs(float z) { return __builtin_amdgcn_logf(1.0f + fast_exp(-fabsf(z))) * 0.6931471805599453f; }
__device__ __forceinline__ float tanh_f(float x) { const float e = fast_exp(-2.0f * fabsf(x)); const float t = (1.0f - e) * __builtin_amdgcn_rcpf(1.0f + e); return x < 0.f ? -t : t; }

__device__ __forceinline__ void gla_prep_unit(LAS unsigned char* lds, int l, int b, int t0) {
    const int tid = opaque_tid();
    const bf16* P = (const bf16*)(KWS() + WS_P);
    float* SC = (float*)(KWS() + WS_SCAN0);
    LAS bf16* U = (LAS bf16*)lds;
    LAS float* GL = (LAS float*)(lds + 67 * 512 * 2);
    for (int i = tid; i < 67 * 64; i += NTHR) { const int row = i >> 6, c8 = i & 63; const int t = t0 - 3 + row;
        u32x4 v = (u32x4){0u, 0u, 0u, 0u}; if (t >= 0) v = *(const u32x4*)(P + (size_t)(b * T + t) * PINP + c8 * 8);
        *(LAS u32x4*)(U + row * 512 + c8 * 8) = v; }
    { const int i = tid * 2, tok = i >> 4, r = i & 15; const unsigned w = *(const unsigned*)(P + (size_t)(b * T + t0 + tok) * PINP + PC_GLR + r); GL[tok * 16 + r] = bflo(w); GL[tok * 16 + r + 1] = bfhi(w); }
    __syncthreads();
    {
        const int c = tid; const float* cw = KIN(I_GLACONV) + (size_t)l * 4 * 512 + c;
        const float w0 = cw[0], w1 = cw[512], w2 = cw[1024], w3 = cw[1536];
        float u0 = bf2f(U[0 * 512 + c]), u1 = bf2f(U[1 * 512 + c]), u2 = bf2f(U[2 * 512 + c]);
        int head, off; float sc = 1.0f;
        if (c < 128) { head = c >> 5; off = 64 + (c & 31); sc = 0.17677669529663687f; } else if (c < 256) { head = (c - 128) >> 5; off = 32 + (c & 31); } else { head = (c - 256) >> 6; off = 96 + (c & 63); }
        float* dst = SC + ((size_t)(b * 4 + head) * T + t0) * 160 + off;
        for (int t = 0; t < 64; ++t) { const float u3 = bf2f(U[(t + 3) * 512 + c]); const float y = w0 * u0 + w1 * u1 + w2 * u2 + w3 * u3; dst[(size_t)t * 160] = silu_f(y) * sc; u0 = u1; u1 = u2; u2 = u3; }
    }
    {
        const int c = tid & 127, tq = tid >> 7; const float* w2p = KIN(I_GLAW2) + (size_t)l * 16 * 128 + c; float wc[16];
#pragma unroll
        for (int r = 0; r < 16; ++r) wc[r] = w2p[r * 128];
        const float gb = KIN(I_GLAB)[l * 128 + c];
        float* dst = SC + ((size_t)(b * 4 + (c >> 5)) * T + t0) * 160 + (c & 31);
        for (int t = tq; t < 64; t += 4) { float z = gb;
#pragma unroll
            for (int r = 0; r < 16; ++r) z += GL[t * 16 + r] * wc[r];
            const float ls = fminf(z, 0.f) - log1pexp_neg_abs(z);
            dst[(size_t)t * 160] = ls * 0.0625f; }
    }
    __syncthreads();
}

__device__ __forceinline__ void hg_prep_unit(int l, int b, int t0) {
    const int tid = opaque_tid(), c = tid & 255, tq = tid >> 8;
    const bf16* P = (const bf16*)(KWS() + WS_P);
    float* SC = (float*)(KWS() + WS_SCAN1);
    float lb;
    { const float* hp = KIN(I_HGLB) + c; const float v0 = hp[0], v1 = hp[256], v2 = hp[512], v3 = hp[768]; const float m = fmaxf(fmaxf(v0, v1), fmaxf(v2, v3));
      const float e0 = __expf(v0 - m), e1 = __expf(v1 - m), e2 = __expf(v2 - m), e3 = __expf(v3 - m); const float inv = 1.0f / (e0 + e1 + e2 + e3);
      lb = (l >= 1 ? e1 : 0.f) + (l >= 2 ? e2 : 0.f) + (l >= 3 ? e3 : 0.f); lb *= inv; }
    const float oml = 1.0f - lb;
    float* dst = SC + ((size_t)(b * 4 + (c >> 6)) * T + t0) * 256 + (c & 63);
    for (int t = tq; t < 64; t += 2) { const bf16* row = P + (size_t)(b * T + t0 + t) * PINP;
        const float hq = bf2f(row[PC_HQ + c]), hf = bf2f(row[PC_HF + c]), hi = bf2f(row[PC_HI + c]);
        const float s = fast_sigmoid(hf), sn = fast_sigmoid(-hf);
        float* d = dst + (size_t)t * 256;
        d[0] = __builtin_amdgcn_logf(fmaxf(lb + oml * s, 1e-30f)) * 0.6931471805599453f; d[64] = oml * sn; d[128] = silu_f(hq); d[192] = hi; }
}

__device__ __forceinline__ void rw_prep_unit(LAS unsigned char* lds, int l, int b, int t0) {
    const int tid = opaque_tid(), lane = tid & 63, wave = __builtin_amdgcn_readfirstlane(tid >> 6);
    const bf16* P = (const bf16*)(KWS() + WS_P);
    float* SC = (float*)(KWS() + WS_SCAN2);
    LAS bf16* XL = (LAS bf16*)lds;
    LAS float* AL = (LAS float*)(lds + 32 * 264 * 2);
    const float* mu = KIN(I_RWMU) + (size_t)l * 1024;
    for (int i = tid; i < 32 * 256; i += NTHR) { const int tok = i >> 8, cc = i & 255; const int t = t0 + tok;
        const bf16* row = P + (size_t)(b * T + t) * PINP + PC_RW + 768 + cc;
        const float cur = bf2f(row[0]), prev = t > 0 ? bf2f(*(row - PINP)) : 0.f;
        float x = cur + (prev - cur) * mu[768 + cc];
        if (cc < 64) x = tanh_f(x); else if (cc >= 128) x = fast_sigmoid(x);
        XL[tok * 264 + cc] = (bf16)f2bf(x); }
    __syncthreads();
    {
        const int r32 = lane & 31, hh = lane >> 5, c = wave * 32 + r32;
        const bf16* w2T = (const bf16*)(KWS() + WS_LORA) + (size_t)l * 256 * 64 + (size_t)c * 64;
        const bf16* a2T = (const bf16*)(KWS() + WS_LORA) + (size_t)(NL * 256 * 64) + (size_t)l * 256 * 64 + (size_t)c * 64;
        const bf16* g2T = (const bf16*)(KWS() + WS_LORA) + (size_t)2 * (NL * 256 * 64) + (size_t)l * 256 * 128 + (size_t)c * 128;
        const LAS bf16* xa = XL + r32 * 264 + 8 * hh;
        {
            f32x16 acc;
#pragma unroll
            for (int i = 0; i < 16; ++i) acc[i] = 0.f;
#pragma unroll
            for (int s = 0; s < 4; ++s) { const bf16x8 A = *(const LAS bf16x8*)(xa + 16 * s); const bf16x8 Bw = *(const bf16x8*)(w2T + 16 * s + 8 * hh);
                acc = __builtin_amdgcn_mfma_f32_32x32x16_bf16(A, Bw, acc, 0, 0, 0); }
            const float w0c = KIN(I_RWW0)[l * 256 + c];
            float* dw = SC + ((size_t)(b * 4 + (c >> 6)) * T + t0) * 384 + (c & 63);
#pragma unroll
            for (int r = 0; r < 16; ++r) { const int tok = (r & 3) + 8 * (r >> 2) + 4 * hh;
                const float zw = w0c + acc[r]; const float wlog = -(fmaxf(-zw, 0.f) + log1pexp_neg_abs(zw)) - 0.5f;
                dw[(size_t)tok * 384] = -fast_exp(wlog); }
        }
        __builtin_amdgcn_sched_barrier(0);
        {
            f32x16 acc;
#pragma unroll
            for (int i = 0; i < 16; ++i) acc[i] = 0.f;
#pragma unroll
            for (int s = 0; s < 4; ++s) { const bf16x8 A = *(const LAS bf16x8*)(xa + 64 + 16 * s); const bf16x8 Bw = *(const bf16x8*)(a2T + 16 * s + 8 * hh);
                acc = __builtin_amdgcn_mfma_f32_32x32x16_bf16(A, Bw, acc, 0, 0, 0); }
            const float a0c = KIN(I_RWA0)[l * 256 + c];
#pragma unroll
            for (int r = 0; r < 16; ++r) { const int tok = (r & 3) + 8 * (r >> 2) + 4 * hh; AL[tok * 260 + c] = fast_sigmoid(a0c + acc[r]); }
        }
        __builtin_amdgcn_sched_barrier(0);
        {
            f32x16 acc;
#pragma unroll
            for (int i = 0; i < 16; ++i) acc[i] = 0.f;
#pragma unroll
            for (int s = 0; s < 8; ++s) { const bf16x8 A = *(const LAS bf16x8*)(xa + 128 + 16 * s); const bf16x8 Bw = *(const bf16x8*)(g2T + 16 * s + 8 * hh);
                acc = __builtin_amdgcn_mfma_f32_32x32x16_bf16(A, Bw, acc, 0, 0, 0); }
            bf16* gb = (bf16*)(KWS() + WS_GBUF) + (size_t)(b * T + t0) * 256 + c;
#pragma unroll
            for (int r = 0; r < 16; ++r) { const int tok = (r & 3) + 8 * (r >> 2) + 4 * hh; gb[(size_t)tok * 256] = (bf16)f2bf(acc[r]); }
        }
    }
    __syncthreads();
    {
        const int c = tid & 255, tq = tid >> 8, head = c >> 6, d = c & 63;
        const float mr = mu[c], mk = mu[256 + c], mv = mu[512 + c];
        const float kkc = KIN(I_RWKK)[l * 256 + c], kac = KIN(I_RWKA)[l * 256 + c], rkc = KIN(I_RWRK)[l * 256 + c];
        float* ds = SC + ((size_t)(b * 4 + head) * T + t0) * 384 + d; float* bonp = (float*)(KWS() + WS_BONUS);
        for (int tok = tq; tok < 32; tok += 2) { const int t = t0 + tok; const bf16* row = P + (size_t)(b * T + t) * PINP + PC_RW + c;
            float r = bf2f(row[0]), k = bf2f(row[256]), v = bf2f(row[512]);
            if (t > 0) { const bf16* pr = row - PINP; r += (bf2f(pr[0]) - r) * mr; k += (bf2f(pr[256]) - k) * mk; v += (bf2f(pr[512]) - v) * mv; }
            else { r -= r * mr; k -= k * mk; v -= v * mv; }
            const float av = AL[tok * 260 + c];
            const float kkr = k * kkc, hk = k * (1.0f + (av - 1.0f) * kac);
            const float ss = wave_sum(kkr * kkr); const float kk = kkr / fmaxf(sqrtf(ss), 1e-12f);
            const float bon = wave_sum(r * hk * rkc);
            float* o = ds + (size_t)tok * 384;
            o[64] = hk; o[128] = r; o[192] = v; o[256] = -kk; o[320] = kk * av;
            if (d == 0) bonp[(size_t)(b * T + t) * 4 + head] = bon; }
    }
    __syncthreads();
}

__device__ __forceinline__ void prep_phase(LAS unsigned char* lds, int l, int vcu, int G) {
    for (int u = vcu; u < 4096; u += G) {
        if (u < 1024) { gla_prep_unit(lds, l, u >> 7, (u & 127) * 64); }
        else if (u < 2048) { const int q = u - 1024; hg_prep_unit(l, q >> 7, (q & 127) * 64); }
        else { const int q = u - 2048; rw_prep_unit(lds, l, q >> 8, (q & 255) * 32); }
    }
}

constexpr int NCH = T / 32;
__device__ __forceinline__ int rho16(int r, int hh) { return (r & 3) + 8 * (r >> 2) + 4 * hh; }
template <int DK>
__device__ __forceinline__ void c1_gh_task(LAS unsigned char* ldsw, int lane, const float* __restrict__ rec, bf16* __restrict__ Qg, bf16* __restrict__ Kg, bf16* __restrict__ VTg, float* __restrict__ DSg, float* __restrict__ BEg) {
    constexpr int REC = 3 * DK + 64;
    LAS bf16* KT = (LAS bf16*)ldsw;
    LAS bf16* VT = (LAS bf16*)(ldsw + DK * 80);
    const int d = lane & (DK - 1); const bool act = lane < DK;
    float b = 0.f;
#pragma unroll 1
    for (int j8 = 0; j8 < 4; ++j8) {
        u32x4 kp, vp;
#pragma unroll
        for (int jj = 0; jj < 4; ++jj) { float kt2[2], vv2[2];
#pragma unroll
            for (int e = 0; e < 2; ++e) { const int j = j8 * 8 + jj * 2 + e; const float* r = rec + (size_t)j * REC;
                const float w = r[d], k = r[DK + d], q = r[2 * DK + d];
                b = fmaxf(b + w, -80.0f);
                const float qt = q * fast_exp(b), kt = k * fast_exp(-b);
                if (act) { Qg[j * DK + d] = (bf16)f2bf(qt); Kg[j * DK + d] = (bf16)f2bf(kt); }
                kt2[e] = kt; vv2[e] = r[3 * DK + lane]; }
            kp[jj] = pk2(kt2[0], kt2[1]); vp[jj] = pk2(vv2[0], vv2[1]); }
        if (act) *(LAS u32x4*)(KT + d * 40 + j8 * 8) = kp;
        *(LAS u32x4*)(VT + lane * 40 + j8 * 8) = vp; *(u32x4*)(VTg + lane * 32 + j8 * 8) = vp;
    }
    const float ebend = fast_exp(b); if (act) BEg[d] = ebend;
    LDS_WAIT(); asm volatile("" ::: "memory");
    const int r32 = lane & 31, hh = lane >> 5;
#pragma unroll
    for (int vt = 0; vt < 2; ++vt)
#pragma unroll
        for (int dt = 0; dt < DK / 32; ++dt) { f32x16 acc;
#pragma unroll
            for (int i = 0; i < 16; ++i) acc[i] = 0.f;
#pragma unroll
            for (int s = 0; s < 2; ++s) { const bf16x8 A = *(const LAS bf16x8*)(VT + (32 * vt + r32) * 40 + 16 * s + 8 * hh), B = *(const LAS bf16x8*)(KT + (32 * dt + r32) * 40 + 16 * s + 8 * hh);
                acc = __builtin_amdgcn_mfma_f32_32x32x16_bf16(A, B, acc, 0, 0, 0); }
            const float ebd = __shfl(ebend, 32 * dt + r32);
#pragma unroll
            for (int r = 0; r < 16; ++r) DSg[(32 * vt + rho16(r, hh)) * DK + 32 * dt + r32] = acc[r] * ebd; }
    LDS_WAIT(); asm volatile("" ::: "memory");
}
template <int DK>
__device__ __forceinline__ void m2_gh_elem(int e, const float* __restrict__ DS, const float* __restrict__ BE, bf16* __restrict__ SG) {
    constexpr int EPB = 64 * DK; const int bh = e / EPB, idx = e % EPB, d = idx % DK; const size_t un0 = (size_t)bh * NCH;
    float S = 0.f;
#pragma unroll 1
    for (int c0 = 0; c0 < NCH; c0 += 8) { float ds[8], be[8];
#pragma unroll
        for (int u = 0; u < 8; ++u) { ds[u] = DS[(un0 + c0 + u) * EPB + idx]; be[u] = BE[(un0 + c0 + u) * DK + d]; }
#pragma unroll
        for (int u = 0; u < 8; ++u) { SG[(un0 + c0 + u) * EPB + idx] = (bf16)f2bf(S); S = S * be[u] + ds[u]; } }
}
template <int DK>
__device__ __forceinline__ void m3_gh_task(int lane, const bf16* __restrict__ Qg, const bf16* __restrict__ Kg, const bf16* __restrict__ VTg, const bf16* __restrict__ Sg,
                                           const bf16* __restrict__ gate  , const float* __restrict__ ng  , bf16* __restrict__ orow  ) {
    const int r32 = lane & 31, hh = lane >> 5;
    bf16x8 qf[DK / 16];
    f32x16 at;
#pragma unroll
    for (int i = 0; i < 16; ++i) at[i] = 0.f;
#pragma unroll
    for (int s = 0; s < DK / 16; ++s) { qf[s] = *(const bf16x8*)(Qg + r32 * DK + 16 * s + 8 * hh); const bf16x8 kf = *(const bf16x8*)(Kg + r32 * DK + 16 * s + 8 * hh);
        at = __builtin_amdgcn_mfma_f32_32x32x16_bf16(kf, qf[s], at, 0, 0, 0); }
#pragma unroll
    for (int r = 0; r < 16; ++r) if (rho16(r, hh) > r32) at[r] = 0.f;
    f32x16 o[2];
#pragma unroll
    for (int vt = 0; vt < 2; ++vt)
#pragma unroll
        for (int i = 0; i < 16; ++i) o[vt][i] = 0.f;
#pragma unroll
    for (int s = 0; s < 2; ++s) { union { bf16x8 v; unsigned w[4]; } pf;
#pragma unroll
        for (int j = 0; j < 4; ++j) pf.w[j] = cvt_pk_bf16(at[8 * s + 2 * j], at[8 * s + 2 * j + 1]);
#pragma unroll
        for (int vt = 0; vt < 2; ++vt) { const bf16* vp = VTg + (32 * vt + r32) * 32 + 16 * s + 4 * hh;
            union { bf16x8 v; s16x4 h2[2]; } vf; vf.h2[0] = *(const s16x4*)vp; vf.h2[1] = *(const s16x4*)(vp + 8);
            o[vt] = __builtin_amdgcn_mfma_f32_32x32x16_bf16(vf.v, pf.v, o[vt], 0, 0, 0); } }
#pragma unroll
    for (int vt = 0; vt < 2; ++vt)
#pragma unroll
        for (int s = 0; s < DK / 16; ++s) { const bf16x8 sf = *(const bf16x8*)(Sg + (32 * vt + r32) * DK + 16 * s + 8 * hh);
            o[vt] = __builtin_amdgcn_mfma_f32_32x32x16_bf16(sf, qf[s], o[vt], 0, 0, 0); }
    float ss = 0.f;
#pragma unroll
    for (int vt = 0; vt < 2; ++vt)
#pragma unroll
        for (int i = 0; i < 16; ++i) ss += o[vt][i] * o[vt][i];
    ss += __shfl_xor(ss, 32);
    const float rstd = 1.0f / sqrtf(ss * (1.0f / 64.0f) + RMS_EPS);
    const bf16* grow = gate + (size_t)r32 * PINP; bf16* od = orow + (size_t)r32 * D;
#pragma unroll
    for (int vt = 0; vt < 2; ++vt)
#pragma unroll
        for (int g = 0; g < 4; ++g) { const int v0 = 32 * vt + 8 * g + 4 * hh; const u32x2 gw = *(const u32x2*)(grow + v0); const f32x4 n4 = *(const f32x4*)(ng + v0);
            const float y0 = o[vt][4 * g] * rstd * n4[0] * silu_f(bflo(gw.x)), y1 = o[vt][4 * g + 1] * rstd * n4[1] * silu_f(bfhi(gw.x));
            const float y2 = o[vt][4 * g + 2] * rstd * n4[2] * silu_f(bflo(gw.y)), y3 = o[vt][4 * g + 3] * rstd * n4[3] * silu_f(bfhi(gw.y));
            *(u32x2*)(od + v0) = (u32x2){pk2(y0, y1), pk2(y2, y3)}; }
}

constexpr int RWC_HEADB = 34816;
__device__ __forceinline__ void rw_c1_unit(LAS unsigned char* lds, int b, int c) {
    const int tid = opaque_tid(), lane = tid & 63, wave = __builtin_amdgcn_readfirstlane(tid >> 6), h = wave >> 1, p = wave & 1, r32 = lane & 31, hh = lane >> 5;
    unsigned char* ws = KWS();
    const int bh = b * 4 + h; const size_t un = (size_t)bh * NCH + c;
    const float* rec = (const float*)(ws + WS_SCAN2) + ((size_t)bh * T + c * 32) * 384;
    LAS unsigned char* L = lds + h * RWC_HEADB;
    LAS bf16* AT = (LAS bf16*)L;
    LAS bf16* BT = (LAS bf16*)(L + 4608);
    LAS bf16* KT = (LAS bf16*)(L + 9216);
    LAS bf16* ATT = (LAS bf16*)(L + 13824);
    LAS bf16* BHT = (LAS bf16*)(L + 18944);
    LAS bf16* KHT = (LAS bf16*)(L + 24064);
    LAS bf16* VT = (LAS bf16*)(L + 29184);
    LAS float* GC = (LAS float*)(L + 34304);
    LAS float* MAB = (LAS float*)(L + 4608);
    LAS bf16* MAK = (LAS bf16*)(L + 9216);
    LAS bf16* TM = (LAS bf16*)L;
    if (p == 0) {
        const int d = lane; float lg = 0.f;
        bf16* RGp = (bf16*)(ws + WS_RR) + un * 2048 + d; bf16* BGp = (bf16*)(ws + WS_RB) + un * 2048 + d; bf16* KGp = (bf16*)(ws + WS_RK) + un * 2048 + d;
#pragma unroll 1
        for (int t8 = 0; t8 < 4; ++t8) { u32x4 ap;
#pragma unroll
            for (int jj = 0; jj < 4; ++jj) { float at2[2];
#pragma unroll
                for (int e = 0; e < 2; ++e) { const int t = t8 * 8 + jj * 2 + e; const float* r = rec + (size_t)t * 384;
                    const float lw = r[d], k = r[64 + d], rr = r[128 + d], a = r[256 + d], bb = r[320 + d];
                    const float lgp = lg; lg += lw;
                    const float at = a * fast_exp(lgp), rt = rr * fast_exp(lg), ei = fast_exp(-lg), bt = bb * ei, kt = k * ei;
                    AT[t * 72 + d] = (bf16)f2bf(at); BT[t * 72 + d] = (bf16)f2bf(bt); KT[t * 72 + d] = (bf16)f2bf(kt);
                    RGp[t * 64] = (bf16)f2bf(rt); BGp[t * 64] = (bf16)f2bf(bt); KGp[t * 64] = (bf16)f2bf(kt);
                    at2[e] = at; }
                ap[jj] = pk2(at2[0], at2[1]); }
            *(LAS u32x4*)(ATT + d * 40 + t8 * 8) = ap; }
        const float lgend = lg; GC[d] = fast_exp(lgend);
        lg = 0.f;
#pragma unroll 1
        for (int t8 = 0; t8 < 4; ++t8) { u32x4 bp, kp;
#pragma unroll
            for (int jj = 0; jj < 4; ++jj) { float b2[2], k2[2];
#pragma unroll
                for (int e = 0; e < 2; ++e) { const int t = t8 * 8 + jj * 2 + e; const float* r = rec + (size_t)t * 384;
                    lg += r[d]; const float eh = fast_exp(lgend - lg); b2[e] = r[320 + d] * eh; k2[e] = r[64 + d] * eh; }
                bp[jj] = pk2(b2[0], b2[1]); kp[jj] = pk2(k2[0], k2[1]); }
            *(LAS u32x4*)(BHT + d * 40 + t8 * 8) = bp; *(LAS u32x4*)(KHT + d * 40 + t8 * 8) = kp; }
    } else {
        bf16* VTg = (bf16*)(ws + WS_RVT) + un * 2048 + lane * 32;
#pragma unroll 1
        for (int t8 = 0; t8 < 4; ++t8) { u32x4 vp;
#pragma unroll
            for (int jj = 0; jj < 4; ++jj) { const float v0 = rec[(size_t)(t8 * 8 + jj * 2) * 384 + 192 + lane], v1 = rec[(size_t)(t8 * 8 + jj * 2 + 1) * 384 + 192 + lane]; vp[jj] = pk2(v0, v1); }
            *(LAS u32x4*)(VT + lane * 40 + t8 * 8) = vp; *(u32x4*)(VTg + t8 * 8) = vp; }
    }
    __syncthreads();
    f32x16 accR[2];
    {
        f32x16 acc;
#pragma unroll
        for (int i = 0; i < 16; ++i) acc[i] = 0.f;
        const LAS bf16* Bsrc = p == 0 ? BT : KT;
#pragma unroll
        for (int s = 0; s < 4; ++s) { const bf16x8 A = *(const LAS bf16x8*)(AT + r32 * 72 + 16 * s + 8 * hh), B = *(const LAS bf16x8*)(Bsrc + r32 * 72 + 16 * s + 8 * hh);
            acc = __builtin_amdgcn_mfma_f32_32x32x16_bf16(A, B, acc, 0, 0, 0); }
        if (p == 0) {
#pragma unroll
            for (int r = 0; r < 16; ++r) { const int t = rho16(r, hh); MAB[t * 36 + r32] = (r32 < t) ? acc[r] : 0.f; }
        } else {
#pragma unroll
            for (int r = 0; r < 16; ++r) { const int t = rho16(r, hh); MAK[t * 40 + r32] = (bf16)f2bf((r32 < t) ? acc[r] : 0.f); }
        }
    }
    __syncthreads();
    if (p == 0) {
        const int cidx = r32; float tc[32];
#pragma unroll
        for (int t = 0; t < 32; ++t) { float acc0 = (t == cidx) ? 1.0f : 0.f, acc1 = 0.f;
#pragma unroll
            for (int s4 = 0; s4 < (t + 3) / 4; ++s4) { const f32x4 m4 = *(const LAS f32x4*)(MAB + t * 36 + 4 * s4);
#pragma unroll
                for (int e = 0; e < 4; ++e) { const int s = 4 * s4 + e; if (s < t) { if (e & 1) acc1 = fmaf(m4[e], tc[s], acc1); else acc0 = fmaf(m4[e], tc[s], acc0); } } }
            tc[t] = acc0 + acc1; }
#pragma unroll
        for (int t = 0; t < 32; ++t) if (hh == 0) TM[t * 40 + cidx] = (bf16)f2bf(tc[t]);
    } else {
#pragma unroll
        for (int vt = 0; vt < 2; ++vt) {
#pragma unroll
            for (int i = 0; i < 16; ++i) accR[vt][i] = 0.f;
#pragma unroll
            for (int s = 0; s < 2; ++s) { const bf16x8 A = *(const LAS bf16x8*)(MAK + r32 * 40 + 16 * s + 8 * hh), B = *(const LAS bf16x8*)(VT + (32 * vt + r32) * 40 + 16 * s + 8 * hh);
                accR[vt] = __builtin_amdgcn_mfma_f32_32x32x16_bf16(A, B, accR[vt], 0, 0, 0); } }
    }
    __syncthreads();
    if (p == 0) {
        f32x16 accW[2];
#pragma unroll
        for (int dt = 0; dt < 2; ++dt) {
#pragma unroll
            for (int i = 0; i < 16; ++i) accW[dt][i] = 0.f;
#pragma unroll
            for (int s = 0; s < 2; ++s) { const bf16x8 A = *(const LAS bf16x8*)(TM + r32 * 40 + 16 * s + 8 * hh), B = *(const LAS bf16x8*)(ATT + (32 * dt + r32) * 40 + 16 * s + 8 * hh);
                accW[dt] = __builtin_amdgcn_mfma_f32_32x32x16_bf16(A, B, accW[dt], 0, 0, 0); } }
        bf16* WGp = (bf16*)(ws + WS_RW) + un * 2048;
#pragma unroll
        for (int dt = 0; dt < 2; ++dt)
#pragma unroll
            for (int r = 0; r < 16; ++r) WGp[rho16(r, hh) * 64 + 32 * dt + r32] = (bf16)f2bf(accW[dt][r]);
        bf16* PFp = (bf16*)(ws + WS_RP) + un * 4096;
        const int xs = r32 >> 4, xx = r32 & 15, hhA = (xx >> 2) & 1, jA = 4 * (xx >> 3) + (xx & 3);
#pragma unroll
        for (int dt = 0; dt < 2; ++dt)
#pragma unroll
            for (int dt2 = 0; dt2 < 2; ++dt2) { f32x16 acc;
#pragma unroll
                for (int i = 0; i < 16; ++i) acc[i] = 0.f;
#pragma unroll
                for (int s = 0; s < 2; ++s) { const LAS bf16* bp = BHT + (32 * dt + r32) * 40 + 16 * s + 4 * hh;
                    union { bf16x8 v; s16x4 h2[2]; } af; af.h2[0] = *(const LAS s16x4*)bp; af.h2[1] = *(const LAS s16x4*)(bp + 8);
                    union { bf16x8 v; unsigned w[4]; } bf;
#pragma unroll
                    for (int j = 0; j < 4; ++j) bf.w[j] = cvt_pk_bf16(accW[dt2][8 * s + 2 * j], accW[dt2][8 * s + 2 * j + 1]);
                    acc = __builtin_amdgcn_mfma_f32_32x32x16_bf16(af.v, bf.v, acc, 0, 0, 0); }
                if (dt == dt2) { const float gc = GC[32 * dt + r32];
#pragma unroll
                    for (int r = 0; r < 16; ++r) if (rho16(r, hh) == r32) acc[r] += gc; }
                bf16* pf = PFp + ((size_t)((dt * 2 + dt2) * 2 + xs) * 64 + 32 * hhA) * 8 + jA;
#pragma unroll
                for (int r = 0; r < 16; ++r) pf[rho16(r, hh) * 8] = (bf16)f2bf(acc[r]); }
    } else {
        f32x16 accU[2];
#pragma unroll
        for (int vt = 0; vt < 2; ++vt) {
#pragma unroll
            for (int i = 0; i < 16; ++i) accU[vt][i] = 0.f;
#pragma unroll
            for (int s = 0; s < 2; ++s) { const LAS bf16* tp = TM + r32 * 40 + 16 * s + 4 * hh;
                union { bf16x8 v; s16x4 h2[2]; } af; af.h2[0] = *(const LAS s16x4*)tp; af.h2[1] = *(const LAS s16x4*)(tp + 8);
                union { bf16x8 v; unsigned w[4]; } bf;
#pragma unroll
                for (int j = 0; j < 4; ++j) bf.w[j] = cvt_pk_bf16(accR[vt][8 * s + 2 * j], accR[vt][8 * s + 2 * j + 1]);
                accU[vt] = __builtin_amdgcn_mfma_f32_32x32x16_bf16(af.v, bf.v, accU[vt], 0, 0, 0); } }
        float* UGp = (float*)(ws + WS_RU) + un * 2048;
#pragma unroll
        for (int vt = 0; vt < 2; ++vt)
#pragma unroll
            for (int g = 0; g < 4; ++g) *(f32x4*)(UGp + ((vt * 4 + g) * 64 + lane) * 4) = (f32x4){accU[vt][4 * g], accU[vt][4 * g + 1], accU[vt][4 * g + 2], accU[vt][4 * g + 3]};
        float* QFp = (float*)(ws + WS_RQ) + un * 4096;
#pragma unroll
        for (int vt = 0; vt < 2; ++vt)
#pragma unroll
            for (int dt = 0; dt < 2; ++dt) { f32x16 acc;
#pragma unroll
                for (int i = 0; i < 16; ++i) acc[i] = 0.f;
#pragma unroll
                for (int s = 0; s < 2; ++s) { const LAS bf16* bp = BHT + (32 * dt + r32) * 40 + 16 * s + 4 * hh;
                    union { bf16x8 v; s16x4 h2[2]; } af; af.h2[0] = *(const LAS s16x4*)bp; af.h2[1] = *(const LAS s16x4*)(bp + 8);
                    union { bf16x8 v; unsigned w[4]; } bf;
#pragma unroll
                    for (int j = 0; j < 4; ++j) bf.w[j] = cvt_pk_bf16(accU[vt][8 * s + 2 * j], accU[vt][8 * s + 2 * j + 1]);
                    acc = __builtin_amdgcn_mfma_f32_32x32x16_bf16(af.v, bf.v, acc, 0, 0, 0);
                    const bf16x8 A2 = *(const LAS bf16x8*)(KHT + (32 * dt + r32) * 40 + 16 * s + 8 * hh), B2 = *(const LAS bf16x8*)(VT + (32 * vt + r32) * 40 + 16 * s + 8 * hh);
                    acc = __builtin_amdgcn_mfma_f32_32x32x16_bf16(A2, B2, acc, 0, 0, 0); }
#pragma unroll
                for (int g = 0; g < 4; ++g) *(f32x4*)(QFp + (((vt * 2 + dt) * 4 + g) * 64 + lane) * 4) = (f32x4){acc[4 * g], acc[4 * g + 1], acc[4 * g + 2], acc[4 * g + 3]}; }
    }
    __syncthreads();
}
__device__ __forceinline__ void rw_m2_wave(int lane, int bh, int vt) {
    unsigned char* ws = KWS();
    const int r32 = lane & 31, hh = lane >> 5;
    const bf16* PF = (const bf16*)(ws + WS_RP) + (size_t)bh * NCH * 4096 + lane * 8;
    const float* QF = (const float*)(ws + WS_RQ) + (size_t)bh * NCH * 4096 + (size_t)vt * 2 * 4 * 64 * 4 + lane * 4;
    bf16* SG = (bf16*)(ws + WS_RS) + (size_t)bh * NCH * 4096 + (size_t)(32 * vt + r32) * 64 + 4 * hh;
    f32x16 S[2];
#pragma unroll
    for (int dt = 0; dt < 2; ++dt)
#pragma unroll
        for (int i = 0; i < 16; ++i) S[dt][i] = 0.f;
    bf16x8 pfr[8]; f32x4 qv[8];
#pragma unroll
    for (int f = 0; f < 8; ++f) { pfr[f] = *(const bf16x8*)(PF + f * 512); qv[f] = *(const f32x4*)(QF + f * 256); }
#pragma unroll 1
    for (int c = 0; c < NCH; ++c) {
        bf16* sg = SG + (size_t)c * 4096;
#pragma unroll
        for (int dt = 0; dt < 2; ++dt)
#pragma unroll
            for (int g = 0; g < 4; ++g) *(u32x2*)(sg + 32 * dt + 8 * g) = (u32x2){cvt_pk_bf16(S[dt][4 * g], S[dt][4 * g + 1]), cvt_pk_bf16(S[dt][4 * g + 2], S[dt][4 * g + 3])};
        union { bf16x8 v; unsigned w[4]; } sb[2][2];
#pragma unroll
        for (int dt2 = 0; dt2 < 2; ++dt2)
#pragma unroll
            for (int s = 0; s < 2; ++s)
#pragma unroll
                for (int j = 0; j < 4; ++j) sb[dt2][s].w[j] = cvt_pk_bf16(S[dt2][8 * s + 2 * j], S[dt2][8 * s + 2 * j + 1]);
        f32x16 N[2];
#pragma unroll
        for (int dt = 0; dt < 2; ++dt) {
#pragma unroll
            for (int g = 0; g < 4; ++g) { N[dt][4 * g] = qv[dt * 4 + g][0]; N[dt][4 * g + 1] = qv[dt * 4 + g][1]; N[dt][4 * g + 2] = qv[dt * 4 + g][2]; N[dt][4 * g + 3] = qv[dt * 4 + g][3]; }
#pragma unroll
            for (int dt2 = 0; dt2 < 2; ++dt2)
#pragma unroll
                for (int s = 0; s < 2; ++s) N[dt] = __builtin_amdgcn_mfma_f32_32x32x16_bf16(pfr[(dt * 2 + dt2) * 2 + s], sb[dt2][s].v, N[dt], 0, 0, 0); }
        const int cn = (c + 1 < NCH) ? c + 1 : c;
#pragma unroll
        for (int f = 0; f < 8; ++f) { pfr[f] = *(const bf16x8*)(PF + (size_t)cn * 4096 + f * 512); qv[f] = *(const f32x4*)(QF + (size_t)cn * 4096 + f * 256); }
        S[0] = N[0]; S[1] = N[1];
    }
}
__device__ __forceinline__ void rw_m3_task(int lane, int l, int bh, int c) {
    unsigned char* ws = KWS();
    const int r32 = lane & 31, hh = lane >> 5, b = bh >> 2, h = bh & 3; const size_t un = (size_t)bh * NCH + c; const size_t tok0 = (size_t)b * T + c * 32;
    const bf16* RGp = (const bf16*)(ws + WS_RR) + un * 2048 + r32 * 64 + 8 * hh; const bf16* BGp = (const bf16*)(ws + WS_RB) + un * 2048 + r32 * 64 + 8 * hh;
    const bf16* KGp = (const bf16*)(ws + WS_RK) + un * 2048 + r32 * 64 + 8 * hh; const bf16* WGp = (const bf16*)(ws + WS_RW) + un * 2048 + r32 * 64 + 8 * hh;
    const bf16* SGp = (const bf16*)(ws + WS_RS) + un * 4096 + r32 * 64 + 8 * hh; const bf16* VTp = (const bf16*)(ws + WS_RVT) + un * 2048 + r32 * 32 + 4 * hh;
    const float* UGp = (const float*)(ws + WS_RU) + un * 2048 + lane * 4;
    bf16x8 rf[4], sf[2][4];
#pragma unroll
    for (int s = 0; s < 4; ++s) { rf[s] = *(const bf16x8*)(RGp + 16 * s); sf[0][s] = *(const bf16x8*)(SGp + 16 * s); sf[1][s] = *(const bf16x8*)(SGp + 32 * 64 + 16 * s); }
    f32x16 U[2], Y[2], mb, mk;
#pragma unroll
    for (int vt = 0; vt < 2; ++vt)
#pragma unroll
        for (int g = 0; g < 4; ++g) { const f32x4 u4 = *(const f32x4*)(UGp + (vt * 4 + g) * 256); U[vt][4 * g] = u4[0]; U[vt][4 * g + 1] = u4[1]; U[vt][4 * g + 2] = u4[2]; U[vt][4 * g + 3] = u4[3]; }
#pragma unroll
    for (int i = 0; i < 16; ++i) { mb[i] = 0.f; mk[i] = 0.f; Y[0][i] = 0.f; Y[1][i] = 0.f; }
#pragma unroll
    for (int s = 0; s < 4; ++s) { const bf16x8 wf = *(const bf16x8*)(WGp + 16 * s), bfr = *(const bf16x8*)(BGp + 16 * s), kfr = *(const bf16x8*)(KGp + 16 * s);
        U[0] = __builtin_amdgcn_mfma_f32_32x32x16_bf16(wf, sf[0][s], U[0], 0, 0, 0); U[1] = __builtin_amdgcn_mfma_f32_32x32x16_bf16(wf, sf[1][s], U[1], 0, 0, 0);
        mb = __builtin_amdgcn_mfma_f32_32x32x16_bf16(bfr, rf[s], mb, 0, 0, 0); mk = __builtin_amdgcn_mfma_f32_32x32x16_bf16(kfr, rf[s], mk, 0, 0, 0);
        Y[0] = __builtin_amdgcn_mfma_f32_32x32x16_bf16(sf[0][s], rf[s], Y[0], 0, 0, 0); Y[1] = __builtin_amdgcn_mfma_f32_32x32x16_bf16(sf[1][s], rf[s], Y[1], 0, 0, 0); }
#pragma unroll
    for (int r = 0; r < 16; ++r) if (rho16(r, hh) > r32) { mb[r] = 0.f; mk[r] = 0.f; }
#pragma unroll
    for (int s = 0; s < 2; ++s) { union { bf16x8 v; unsigned w[4]; } fb, fk;
#pragma unroll
        for (int j = 0; j < 4; ++j) { fb.w[j] = cvt_pk_bf16(mb[8 * s + 2 * j], mb[8 * s + 2 * j + 1]); fk.w[j] = cvt_pk_bf16(mk[8 * s + 2 * j], mk[8 * s + 2 * j + 1]); }
#pragma unroll
        for (int vt = 0; vt < 2; ++vt) { union { bf16x8 v; unsigned w[4]; } fu;
#pragma unroll
            for (int j = 0; j < 4; ++j) fu.w[j] = cvt_pk_bf16(U[vt][8 * s + 2 * j], U[vt][8 * s + 2 * j + 1]);
            Y[vt] = __builtin_amdgcn_mfma_f32_32x32x16_bf16(fu.v, fb.v, Y[vt], 0, 0, 0);
            const bf16* vp = VTp + (size_t)vt * 32 * 32 + 16 * s;
            union { bf16x8 v; s16x4 h2[2]; } vf; vf.h2[0] = *(const s16x4*)vp; vf.h2[1] = *(const s16x4*)(vp + 8);
            Y[vt] = __builtin_amdgcn_mfma_f32_32x32x16_bf16(vf.v, fk.v, Y[vt], 0, 0, 0); } }
    float sm = 0.f;
#pragma unroll
    for (int vt = 0; vt < 2; ++vt)
#pragma unroll
        for (int i = 0; i < 16; ++i) sm += Y[vt][i];
    sm += __shfl_xor(sm, 32); const float mu = sm * (1.0f / 64.0f);
    float q = 0.f;
#pragma unroll
    for (int vt = 0; vt < 2; ++vt)
#pragma unroll
        for (int i = 0; i < 16; ++i) { const float dd = Y[vt][i] - mu; q += dd * dd; }
    q += __shfl_xor(q, 32); const float rstd = 1.0f / sqrtf(q * (1.0f / 64.0f) + RW_LN_EPS);
    const size_t tok = tok0 + r32;
    const float bon = ((const float*)(ws + WS_BONUS))[tok * 4 + h];
    const float* vrec = (const float*)(ws + WS_SCAN2) + ((size_t)bh * T + c * 32 + r32) * 384 + 192;
    const bf16* gp = (const bf16*)(ws + WS_GBUF) + tok * 256 + h * 64; bf16* od = (bf16*)(ws + WS_O) + tok * D + 512 + h * 64;
    const float* lnw = KIN(I_RWLNW) + l * 256 + h * 64; const float* lnb = KIN(I_RWLNB) + l * 256 + h * 64;
#pragma unroll
    for (int vt = 0; vt < 2; ++vt)
#pragma unroll
        for (int g = 0; g < 4; ++g) { const int v0 = 32 * vt + 8 * g + 4 * hh; const f32x4 w4 = *(const f32x4*)(lnw + v0), b4 = *(const f32x4*)(lnb + v0), vv = *(const f32x4*)(vrec + v0); const u32x2 gw = *(const u32x2*)(gp + v0);
            const float y0 = ((Y[vt][4 * g] - mu) * rstd * w4[0] + b4[0] + bon * vv[0]) * bflo(gw.x), y1 = ((Y[vt][4 * g + 1] - mu) * rstd * w4[1] + b4[1] + bon * vv[1]) * bfhi(gw.x);
            const float y2 = ((Y[vt][4 * g + 2] - mu) * rstd * w4[2] + b4[2] + bon * vv[2]) * bflo(gw.y), y3 = ((Y[vt][4 * g + 3] - mu) * rstd * w4[3] + b4[3] + bon * vv[3]) * bfhi(gw.y);
            *(u32x2*)(od + v0) = (u32x2){pk2(y0, y1), pk2(y2, y3)}; }
}

__device__ __forceinline__ void c1_phase(LAS unsigned char* lds, int vcu, int G) {
    const int tid = opaque_tid(), lane = tid & 63, wave = __builtin_amdgcn_readfirstlane(tid >> 6);
    LAS unsigned char* ldsw = lds + wave * 16384;
    unsigned char* ws = KWS();
    const int gw = vcu * NWAVES + wave, NGW = G * NWAVES;
    for (int u = vcu; u < NB * NCH; u += G) rw_c1_unit(lds, u >> 8, u & 255);
    for (int task = gw; task < 16384; task += NGW) {
        const int un = task & 8191, bh = un >> 8, c = un & 255;
        if (task < 8192) c1_gh_task<64>(ldsw, lane, (const float*)(ws + WS_SCAN1) + ((size_t)bh * T + c * 32) * 256, (bf16*)(ws + WS_HQ) + (size_t)un * 2048, (bf16*)(ws + WS_HK) + (size_t)un * 2048,
                                          (bf16*)(ws + WS_HVT) + (size_t)un * 2048, (float*)(ws + WS_HDS) + (size_t)un * 4096, (float*)(ws + WS_HBE) + (size_t)un * 64);
        else c1_gh_task<32>(ldsw, lane, (const float*)(ws + WS_SCAN0) + ((size_t)bh * T + c * 32) * 160, (bf16*)(ws + WS_GQ) + (size_t)un * 1024, (bf16*)(ws + WS_GK) + (size_t)un * 1024,
                            (bf16*)(ws + WS_GVT) + (size_t)un * 2048, (float*)(ws + WS_GDS) + (size_t)un * 2048, (float*)(ws + WS_GBE) + (size_t)un * 32);
    }
}
__device__ __forceinline__ void m3_gh_phase(int l, int vcu, int G) {
    const int tid = opaque_tid(), lane = tid & 63, wave = __builtin_amdgcn_readfirstlane(tid >> 6);
    unsigned char* ws = KWS();
    const int gw = vcu * NWAVES + wave, NGW = G * NWAVES;
    const bf16* P = (const bf16*)(ws + WS_P); bf16* O = (bf16*)(ws + WS_O);
    const float* gng = KIN(I_GLANG) + l * 256; const float* hng = KIN(I_HGNG) + l * 256;
    for (int task = gw; task < 24576; task += NGW) {
        const int un = task & 8191, bh = un >> 8, c = un & 255, b = bh >> 2, h = bh & 3; const size_t tok0 = (size_t)b * T + c * 32;
        if (task >= 16384) { rw_m3_task(lane, l, bh, c); continue; }
        if (task < 8192) m3_gh_task<64>(lane, (const bf16*)(ws + WS_HQ) + (size_t)un * 2048, (const bf16*)(ws + WS_HK) + (size_t)un * 2048, (const bf16*)(ws + WS_HVT) + (size_t)un * 2048, (const bf16*)(ws + WS_HS) + (size_t)un * 4096,
                                         P + tok0 * PINP + PC_HG + h * 64, hng + h * 64, O + tok0 * D + 256 + h * 64);
        else m3_gh_task<32>(lane, (const bf16*)(ws + WS_GQ) + (size_t)un * 1024, (const bf16*)(ws + WS_GK) + (size_t)un * 1024, (const bf16*)(ws + WS_GVT) + (size_t)un * 2048, (const bf16*)(ws + WS_GS) + (size_t)un * 2048,
                            P + tok0 * PINP + PC_GOUT + h * 64, gng + h * 64, O + tok0 * D + h * 64);
    }
}

__device__ __forceinline__ void xattn_units(LAS unsigned char* lds, int l, int first, int last, int stride) {
    const int tid = opaque_tid(), lane = tid & 63, wave = __builtin_amdgcn_readfirstlane(tid >> 6), r32 = lane & 31, hh = lane >> 5;
    const bf16* P = (const bf16*)(KWS() + WS_P); const bf16* MKV = (const bf16*)(KWS() + WS_MKV); bf16* O = (bf16*)(KWS() + WS_O);
    LAS bf16* KL = (LAS bf16*)lds;
    LAS bf16* VT = (LAS bf16*)(lds + 256 * 72 * 2);
    int cur_bh = -1;
    for (int u = first; u < last; u += stride) {
        const int bh = u >> 5, qb = u & 31, b = bh >> 2, h = bh & 3;
        if (bh != cur_bh) {
            __syncthreads();
            for (int i = tid; i < 256 * 8; i += NTHR) { const int key = i >> 3, c8 = i & 7;
                const bf16* src = MKV + (size_t)(b * 256 + key) * 2048 + l * 512 + h * 64 + c8 * 8;
                *(LAS u32x4*)(KL + key * 72 + c8 * 8) = *(const u32x4*)src;
                const u32x4 vv = *(const u32x4*)(src + 256);
                LAS bf16* vd = VT + (c8 * 8) * 264 + key;
                vd[0 * 264] = (bf16)(vv.x & 0xffff); vd[1 * 264] = (bf16)(vv.x >> 16); vd[2 * 264] = (bf16)(vv.y & 0xffff); vd[3 * 264] = (bf16)(vv.y >> 16);
                vd[4 * 264] = (bf16)(vv.z & 0xffff); vd[5 * 264] = (bf16)(vv.z >> 16); vd[6 * 264] = (bf16)(vv.w & 0xffff); vd[7 * 264] = (bf16)(vv.w >> 16); }
            __syncthreads();
            cur_bh = bh;
        }
        const int q = b * T + qb * 256 + wave * 32 + r32;
        bf16x8 qf[4];
#pragma unroll
        for (int s = 0; s < 4; ++s) qf[s] = *(const bf16x8*)(P + (size_t)q * PINP + PC_MQ + h * 64 + 16 * s + 8 * hh);
        f32x16 sc[8];
#pragma unroll
        for (int kt = 0; kt < 8; ++kt) {
#pragma unroll
            for (int i = 0; i < 16; ++i) sc[kt][i] = 0.f;
#pragma unroll
            for (int s = 0; s < 4; ++s) { const bf16x8 kf = *(const LAS bf16x8*)(KL + (kt * 32 + r32) * 72 + 16 * s + 8 * hh);
                sc[kt] = __builtin_amdgcn_mfma_f32_32x32x16_bf16(kf, qf[s], sc[kt], 0, 0, 0); }
        }
        float m = -3.0e38f;
#pragma unroll
        for (int kt = 0; kt < 8; ++kt)
#pragma unroll
            for (int i = 0; i < 16; ++i) m = fmaxf(m, sc[kt][i]);
        m = fmaxf(m, __shfl_xor(m, 32));
        float sum = 0.f;
        const float c2 = 0.125f * 1.4426950408889634f;
#pragma unroll
        for (int kt = 0; kt < 8; ++kt)
#pragma unroll
            for (int i = 0; i < 16; ++i) { const float e = __builtin_amdgcn_exp2f((sc[kt][i] - m) * c2); sc[kt][i] = e; sum += e; }
        sum += __shfl_xor(sum, 32);
        const float inv = 1.0f / sum;
        f32x16 oa[2];
#pragma unroll
        for (int vt = 0; vt < 2; ++vt)
#pragma unroll
            for (int i = 0; i < 16; ++i) oa[vt][i] = 0.f;
#pragma unroll
        for (int kt = 0; kt < 8; ++kt)
#pragma unroll
            for (int s = 0; s < 2; ++s) {
                union { bf16x8 v; unsigned w[4]; } pf;
#pragma unroll
                for (int j = 0; j < 4; ++j) pf.w[j] = cvt_pk_bf16(sc[kt][8 * s + 2 * j], sc[kt][8 * s + 2 * j + 1]);
#pragma unroll
                for (int vt = 0; vt < 2; ++vt) {
                    const LAS bf16* vp = VT + (vt * 32 + r32) * 264 + kt * 32 + 16 * s + 4 * hh;
                    union { bf16x8 v; s16x4 h2[2]; } vf; vf.h2[0] = *(const LAS s16x4*)vp; vf.h2[1] = *(const LAS s16x4*)(vp + 8);
                    oa[vt] = __builtin_amdgcn_mfma_f32_32x32x16_bf16(vf.v, pf.v, oa[vt], 0, 0, 0); }
            }
        bf16* orow = O + (size_t)q * D + 768 + h * 64;
#pragma unroll
        for (int vt = 0; vt < 2; ++vt)
#pragma unroll
            for (int g = 0; g < 4; ++g) { u32x2 w; w.x = cvt_pk_bf16(oa[vt][4 * g] * inv, oa[vt][4 * g + 1] * inv); w.y = cvt_pk_bf16(oa[vt][4 * g + 2] * inv, oa[vt][4 * g + 3] * inv);
                *(u32x2*)(orow + vt * 32 + 8 * g + 4 * hh) = w; }
    }
    __syncthreads();
}

__device__ __forceinline__ void m2_phase(LAS unsigned char* lds, int l, int bx, int G) {
    unsigned char* ws = KWS();
    const int tid = opaque_tid(), lane = tid & 63, wave = __builtin_amdgcn_readfirstlane(tid >> 6);
    const int nrw = (G >= 16) ? 8 : 0;
    if (nrw == 0 || bx < nrw) { for (int q = bx * NWAVES + wave; q < 64; q += (nrw ? nrw : G) * NWAVES) rw_m2_wave(lane, q >> 1, q & 1); }
    if (nrw == 0 || bx >= nrw) {
        const int nb = G - nrw, r = bx - nrw;
        for (int e = r * NTHR + tid; e < 196608; e += nb * NTHR) {
            if (e < 131072) m2_gh_elem<64>(e, (const float*)(ws + WS_HDS), (const float*)(ws + WS_HBE), (bf16*)(ws + WS_HS));
            else m2_gh_elem<32>(e - 131072, (const float*)(ws + WS_GDS), (const float*)(ws + WS_GBE), (bf16*)(ws + WS_GS)); }
        const int per = (1024 + nb - 1) / nb, lo = r * per, hi = (lo + per < 1024) ? lo + per : 1024;
        xattn_units(lds, l, lo, hi, 1);
    }
}

__device__ __forceinline__ void ln1_router_phase(LAS unsigned char* lds, int l, int bx, int G) {
    const int tid = opaque_tid(), lane = tid & 63, wave = __builtin_amdgcn_readfirstlane(tid >> 6);
    LAS float* X = (LAS float*)lds;
    LAS float* PART = (LAS float*)(lds + 16 * 1028 * 4);
    LAS int* HIST = (LAS int*)(lds + 16 * 1028 * 4 + 8 * 16 * 32 * 4);
    const float* xin = (l == 0) ? KIN(I_X) : (const float*)(KWS() + WS_XF);
    const bf16* HM = (const bf16*)(KWS() + WS_HMIX);
    float* X1F = (float*)(KWS() + WS_X1F); bf16* X1B = (bf16*)(KWS() + WS_X1B);
    const float* g1 = KIN(I_LN1G) + l * D; const float* b1 = KIN(I_LN1B) + l * D;
    const float* rw = KIN(I_RTW) + (size_t)l * D * NE; const float* rb = KIN(I_RTB) + l * NE;
    int* tok_e = (int*)(KWS() + WS_ROUTE); float* tok_g = (float*)(KWS() + WS_ROUTE + 1 * MiB);
    if (tid < 32) HIST[tid] = 0;
    float rwB[2][32];
    { const int q = lane >> 4, e = lane & 15;
#pragma unroll
      for (int s = 0; s < 32; ++s) { const float* p = rw + (size_t)(128 * wave + 32 * q + s) * NE + e; rwB[0][s] = p[0]; rwB[1][s] = p[16]; } }
    __syncthreads();
    for (int it = bx; it < NTOK / 16; it += G) {
#pragma unroll
        for (int tt = 0; tt < 2; ++tt) { const int ti = wave * 2 + tt; const size_t tok = (size_t)it * 16 + ti;
            const f32x4* xr = (const f32x4*)(xin + tok * D) + lane; const u32x2* hr = (const u32x2*)(HM + tok * D) + lane;
            f32x4 v[4]; float s = 0.f;
#pragma unroll
            for (int j = 0; j < 4; ++j) { const f32x4 xv = xr[64 * j]; const u32x2 hw = hr[64 * j];
                v[j][0] = DN_ALPHA * xv[0] + bflo(hw.x); v[j][1] = DN_ALPHA * xv[1] + bfhi(hw.x); v[j][2] = DN_ALPHA * xv[2] + bflo(hw.y); v[j][3] = DN_ALPHA * xv[3] + bfhi(hw.y);
                s += (v[j][0] + v[j][1]) + (v[j][2] + v[j][3]); }
            const float mean = wave_sum(s) * (1.0f / D); float s2 = 0.f;
#pragma unroll
            for (int j = 0; j < 4; ++j) { v[j] = v[j] - mean; s2 += (v[j][0] * v[j][0] + v[j][1] * v[j][1]) + (v[j][2] * v[j][2] + v[j][3] * v[j][3]); }
            const float rstd = 1.0f / sqrtf(wave_sum(s2) * (1.0f / D) + LN_EPS);
#pragma unroll
            for (int j = 0; j < 4; ++j) { const f32x4 gg = *((const f32x4*)g1 + lane + 64 * j), bb = *((const f32x4*)b1 + lane + 64 * j);
                const f32x4 y = v[j] * rstd * gg + bb;
                *((f32x4*)(X1F + tok * D) + lane + 64 * j) = y;
                *((u32x2*)(X1B + tok * D) + lane + 64 * j) = (u32x2){pk2(y[0], y[1]), pk2(y[2], y[3])};
                *(LAS f32x4*)(X + ti * 1028 + 4 * lane + 256 * j) = y; }
        }
        __syncthreads();
        {
            const int q = lane >> 4, r = lane & 15;
            f32x4 acc0 = (f32x4){0.f, 0.f, 0.f, 0.f}, acc1 = (f32x4){0.f, 0.f, 0.f, 0.f};
            const LAS float* xa = X + r * 1028 + 128 * wave + 32 * q;
#pragma unroll
            for (int s4 = 0; s4 < 8; ++s4) { const f32x4 av = *(const LAS f32x4*)(xa + 4 * s4);
#pragma unroll
                for (int j = 0; j < 4; ++j) { acc0 = __builtin_amdgcn_mfma_f32_16x16x4f32(av[j], rwB[0][4 * s4 + j], acc0, 0, 0, 0); acc1 = __builtin_amdgcn_mfma_f32_16x16x4f32(av[j], rwB[1][4 * s4 + j], acc1, 0, 0, 0); } }
#pragma unroll
            for (int i = 0; i < 4; ++i) { PART[(wave * 16 + 4 * q + i) * 32 + r] = acc0[i]; PART[(wave * 16 + 4 * q + i) * 32 + 16 + r] = acc1[i]; }
        }
        __syncthreads();
        {
            const int ti = tid >> 5, e = tid & 31;
            float lg = rb[e];
#pragma unroll
            for (int w = 0; w < 8; ++w) lg += PART[(w * 16 + ti) * 32 + e];
            float tv[4]; int te[4]; float cur = lg;
#pragma unroll
            for (int k = 0; k < 4; ++k) { float bv = cur; int bi = e;
#pragma unroll
                for (int o = 16; o >= 1; o >>= 1) { const float ov = __shfl_xor(bv, o); const int oi = __shfl_xor(bi, o); if (ov > bv || (ov == bv && oi < bi)) { bv = ov; bi = oi; } }
                tv[k] = bv; te[k] = bi; if (e == bi) cur = -3.0e38f; }
            const float e1 = __expf(tv[1] - tv[0]), e2 = __expf(tv[2] - tv[0]), e3 = __expf(tv[3] - tv[0]); const float inv = 1.0f / (1.0f + e1 + e2 + e3);
            const size_t tok = (size_t)it * 16 + ti;
            if (e < 4) { const int ek = e == 0 ? te[0] : e == 1 ? te[1] : e == 2 ? te[2] : te[3]; const float gk = (e == 0 ? 1.0f : e == 1 ? e1 : e == 2 ? e2 : e3) * inv;
                tok_e[tok * 4 + e] = ek; tok_g[tok * 4 + e] = gk; __hip_atomic_fetch_add(&HIST[ek], 1, __ATOMIC_RELAXED, __HIP_MEMORY_SCOPE_WORKGROUP); }
        }
        __syncthreads();
    }
    __syncthreads();
    if (tid < 32) ((int*)(KWS() + WS_CTL))[CW_HIST + bx * 32 + tid] = HIST[tid];
}

__device__ __forceinline__ void slots_phase(LAS unsigned char* lds, int bx, int G) {
    const int tid = opaque_tid();
    int* ctl = (int*)(KWS() + WS_CTL);
    LAS int* RED = (LAS int*)lds;
    LAS int* TOT = RED + 1024;
    const int* tok_e = (const int*)(KWS() + WS_ROUTE); const float* tok_g = (const float*)(KWS() + WS_ROUTE + 1 * MiB);
    int* tok_slot = (int*)(KWS() + WS_ROUTE + 2 * MiB); int* slot_tok = (int*)(KWS() + WS_ROUTE + 3 * MiB); float* slot_gate = (float*)(KWS() + WS_ROUTE + 3 * MiB + 1536 * 1024);
    { const int e = tid & 31, part = tid >> 5; int tot = 0, pre = 0;
      for (int b2 = part; b2 < G; b2 += 16) { const int h = ctl[CW_HIST + b2 * 32 + e]; tot += h; if (b2 < bx) pre += h; }
      RED[(part * 32 + e) * 2] = tot; RED[(part * 32 + e) * 2 + 1] = pre; }
    __syncthreads();
    if (tid < 32) { int tot = 0, pre = 0; for (int p = 0; p < 16; ++p) { tot += RED[(p * 32 + tid) * 2]; pre += RED[(p * 32 + tid) * 2 + 1]; } TOT[tid] = tot; TOT[32 + tid] = pre; TOT[96 + tid] = 0; }
    __syncthreads();
    if (tid == 0) { int ps = 0;
#pragma unroll 1
        for (int e = 0; e < 32; ++e) { TOT[64 + e] = ps; ps += (TOT[e] + 255) & ~255; }
        TOT[128] = ps >> 8; if (bx == 0) ctl[CW_NT] = ps >> 8; }
    __syncthreads();
    if (bx == 0) { const int nt = TOT[128];
        for (int t = tid; t < nt; t += NTHR) { int e = 0;
#pragma unroll 1
            for (int k = 1; k < 32; ++k) if (TOT[64 + k] <= t * 256) e = k;
            ctl[CW_TILEE + t] = e; } }
    for (int e = bx; e < 32; e += G) { const int s0 = TOT[64 + e] + TOT[e], s1 = TOT[64 + e] + ((TOT[e] + 255) & ~255); for (int s = s0 + tid; s < s1; s += NTHR) { slot_tok[s] = 0; slot_gate[s] = 0.f; } }
    for (int it = bx; it < NTOK / 16; it += G) {
        if (tid < 64) { const int asg = it * 64 + tid; const int e = tok_e[asg]; const int rank = __hip_atomic_fetch_add(&TOT[96 + e], 1, __ATOMIC_RELAXED, __HIP_MEMORY_SCOPE_WORKGROUP); const int slot = TOT[64 + e] + TOT[32 + e] + rank;
            tok_slot[asg] = slot; slot_tok[slot] = asg >> 2; slot_gate[slot] = tok_g[asg]; }
    }
}

__device__ __forceinline__ void combine_phase(int l, int vcu, int G) {
    const int tid = opaque_tid(), lane = tid & 63, wave = __builtin_amdgcn_readfirstlane(tid >> 6);
    const int gw = vcu * NWAVES + wave, NGW = G * NWAVES;
    const float* X1F = (const float*)(KWS() + WS_X1F); const bf16* YB = (const bf16*)(KWS() + WS_YB); const int* tok_slot = (const int*)(KWS() + WS_ROUTE + 2 * MiB);
    float* xo = (l == NL - 1) ? KOUT() : (float*)(KWS() + WS_XF); bf16* XB = (bf16*)(KWS() + WS_XB);
    const float* g2 = KIN(I_LN2G) + l * D; const float* b2 = KIN(I_LN2B) + l * D;
    for (int tok = gw; tok < NTOK; tok += NGW) {
        const int s0 = tok_slot[tok * 4], s1 = tok_slot[tok * 4 + 1], s2i = tok_slot[tok * 4 + 2], s3 = tok_slot[tok * 4 + 3];
        const f32x4* xr = (const f32x4*)(X1F + (size_t)tok * D) + lane;
        const u32x2* y0 = (const u32x2*)(YB + (size_t)s0 * D) + lane; const u32x2* y1 = (const u32x2*)(YB + (size_t)s1 * D) + lane;
        const u32x2* y2 = (const u32x2*)(YB + (size_t)s2i * D) + lane; const u32x2* y3 = (const u32x2*)(YB + (size_t)s3 * D) + lane;
        f32x4 v[4]; float s = 0.f;
#pragma unroll
        for (int j = 0; j < 4; ++j) { const f32x4 xv = xr[64 * j]; const u32x2 a0 = y0[64 * j], a1 = y1[64 * j], a2 = y2[64 * j], a3 = y3[64 * j];
            v[j][0] = DN_ALPHA * xv[0] + ((bflo(a0.x) + bflo(a1.x)) + (bflo(a2.x) + bflo(a3.x))); v[j][1] = DN_ALPHA * xv[1] + ((bfhi(a0.x) + bfhi(a1.x)) + (bfhi(a2.x) + bfhi(a3.x)));
            v[j][2] = DN_ALPHA * xv[2] + ((bflo(a0.y) + bflo(a1.y)) + (bflo(a2.y) + bflo(a3.y))); v[j][3] = DN_ALPHA * xv[3] + ((bfhi(a0.y) + bfhi(a1.y)) + (bfhi(a2.y) + bfhi(a3.y)));
            s += (v[j][0] + v[j][1]) + (v[j][2] + v[j][3]); }
        const float mean = wave_sum(s) * (1.0f / D); float q = 0.f;
#pragma unroll
        for (int j = 0; j < 4; ++j) { v[j] = v[j] - mean; q += (v[j][0] * v[j][0] + v[j][1] * v[j][1]) + (v[j][2] * v[j][2] + v[j][3] * v[j][3]); }
        const float rstd = 1.0f / sqrtf(wave_sum(q) * (1.0f / D) + LN_EPS);
#pragma unroll
        for (int j = 0; j < 4; ++j) { const f32x4 gg = *((const f32x4*)g2 + lane + 64 * j), bb = *((const f32x4*)b2 + lane + 64 * j);
            const f32x4 y = v[j] * rstd * gg + bb;
            *((f32x4*)(xo + (size_t)tok * D) + lane + 64 * j) = y;
            *((u32x2*)(XB + (size_t)tok * D) + lane + 64 * j) = (u32x2){pk2(y[0], y[1]), pk2(y[2], y[3])}; }
    }
}


constexpr int PH_PER_LAYER = 11, NPHASES = 2 + NL * PH_PER_LAYER;
__global__ void __launch_bounds__(NTHR, 2) trunk_fwd(Args args) {
    extern __shared__ __attribute__((aligned(16))) unsigned char lds_raw[];
    LAS unsigned char* lds = (LAS unsigned char*)lds_raw;
    volatile LAS unsigned* MISC = (volatile LAS unsigned*)(lds + MISC_OFF);
    const int tid = threadIdx.x;
    const int G = gridDim.x, bx = blockIdx.x;
    const int vcu = (G % 8 == 0) ? (bx % 8) * (G / 8) + bx / 8 : bx;
    unsigned char* ws = KWS();
    unsigned* ctl = (unsigned*)(ws + WS_CTL);
    for (int u = tid; u < (LDS_BYTES - LDSCTL_OFF) / 4; u += NTHR) ((LAS unsigned*)(lds + LDSCTL_OFF))[u] = 0u;
    __syncthreads();
    XcdBarrier bar; bar.bar = ctl + CW_BAR; bar.x = 0; bar.st = nullptr;
#if !MK_PER_PHASE
    bar = xcd_barrier_post(ctl + CW_BAR, MISC + 8);
#define GRID_BAR() xcd_barrier(bar)
#else
#define GRID_BAR() do { } while (0)
#endif
    const int lo = (int)(unsigned)ka_u64<280>(), hi = (int)(unsigned)(ka_u64<280>() >> 32);
#ifndef PH_MASK
#define PH_MASK 0x1FFF
#endif
#define PHEN(n) (((PH_MASK) >> (n)) & 1)
#define IN(k) (lo <= (k) && (k) < hi)
#ifndef REP_MASK
#define REP_MASK 0
#endif
#define PHREP(n) (((REP_MASK) >> (n)) & 1)
#define SEAM(k) do { if (rep > 0 || IN((k) + 1)) GRID_BAR(); } while (0)

#define OG opaque_s(G)
#define OBX opaque_s(bx)
#define OVCU opaque_s(vcu)
#define OL opaque_s(l)
    if (PHEN(0) && IN(0)) for (int rep = PHREP(0); rep >= 0; --rep) { prologue_phase(lds, OVCU, OG); SEAM(0); }
    if (PHEN(1) && IN(1)) for (int rep = PHREP(1); rep >= 0; --rep) {
        pg8::DenseOrder S; S.init(KWS() + WS_MEMB, KWS() + WS_WMEM, NB * NMEM, 2048, D, OG, OBX);
        pg8::EpiBf16 E{(bf16*)(KWS() + WS_MKV), 2048};
        pg8::gemm_phase<pg8::EpiBf16, pg8::DenseOrder>(lds, D, S, E);
        SEAM(1);
    }
    for (int l = 0; l < NL; ++l) {
        const int p0 = 2 + l * PH_PER_LAYER;
        if (PHEN(2) && IN(p0 + 0)) for (int rep = PHREP(2); rep >= 0; --rep) {
            pg8::DenseOrder S; S.init(KWS() + WS_XB, KWS() + WS_WIN + (size_t)OL * PINP * D * 2, NTOK, PINP, D, OG, OBX);
            pg8::EpiBf16 E{(bf16*)(KWS() + WS_P), PINP};
            pg8::gemm_phase<pg8::EpiBf16, pg8::DenseOrder>(lds, D, S, E);
            SEAM(p0 + 0);
        }
        if (PHEN(3) && IN(p0 + 1)) for (int rep = PHREP(3); rep >= 0; --rep) { prep_phase(lds, OL, OVCU, OG); SEAM(p0 + 1); }
        if (PHEN(4) && IN(p0 + 2)) for (int rep = PHREP(4); rep >= 0; --rep) { c1_phase(lds, OVCU, OG); SEAM(p0 + 2); }
        if (PHEN(5) && IN(p0 + 3)) for (int rep = PHREP(5); rep >= 0; --rep) { m2_phase(lds, OL, OBX, OG); SEAM(p0 + 3); }
        if (PHEN(6) && IN(p0 + 4)) for (int rep = PHREP(6); rep >= 0; --rep) { m3_gh_phase(OL, OVCU, OG); SEAM(p0 + 4); }
        if (PHEN(7) && IN(p0 + 5)) for (int rep = PHREP(7); rep >= 0; --rep) {
            pg8::DenseOrder S; S.init(KWS() + WS_O, KWS() + WS_WOUT + (size_t)OL * D * D * 2, NTOK, D, D, OG, OBX);
            pg8::EpiBf16 E{(bf16*)(KWS() + WS_HMIX), D};
            pg8::gemm_phase<pg8::EpiBf16, pg8::DenseOrder>(lds, D, S, E);
            SEAM(p0 + 5);
        }
        if (PHEN(8) && IN(p0 + 6)) for (int rep = PHREP(8); rep >= 0; --rep) { ln1_router_phase(lds, OL, OBX, OG); SEAM(p0 + 6); }
        if (PHEN(9) && IN(p0 + 7)) for (int rep = PHREP(9); rep >= 0; --rep) { slots_phase(lds, OBX, OG); SEAM(p0 + 7); }
        if (PHEN(10) && IN(p0 + 8)) for (int rep = PHREP(10); rep >= 0; --rep) {
            const int ntiles = __builtin_amdgcn_readfirstlane(((const int*)(KWS() + WS_CTL))[CW_NT]);
            pg8::MoeOrder<true> S; S.init(KWS() + WS_X1B, KWS() + WS_WGU + (size_t)OL * NE * 2048 * D * 2, (const int*)(KWS() + WS_CTL) + CW_TILEE, (const int*)(KWS() + WS_ROUTE + 3 * MiB), ntiles, 2048, D, OG, OBX);
            pg8::EpiSwiglu E{(bf16*)(KWS() + WS_HB), (const float*)(KWS() + WS_BGU) + (size_t)OL * NE * 2048};
            pg8::gemm_phase<pg8::EpiSwiglu, pg8::MoeOrder<true>>(lds, D, S, E);
            SEAM(p0 + 8);
        }
        if (PHEN(11) && IN(p0 + 9)) for (int rep = PHREP(11); rep >= 0; --rep) {
            const int ntiles = __builtin_amdgcn_readfirstlane(((const int*)(KWS() + WS_CTL))[CW_NT]);
            pg8::MoeOrder<false> S; S.init(KWS() + WS_HB, KWS() + WS_WD + (size_t)OL * NE * D * FF * 2, (const int*)(KWS() + WS_CTL) + CW_TILEE, (const int*)(KWS() + WS_ROUTE + 3 * MiB), ntiles, D, FF, OG, OBX);
            pg8::EpiDown E{(bf16*)(KWS() + WS_YB), KIN(I_BDN) + (size_t)OL * NE * D, (const float*)(KWS() + WS_ROUTE + 3 * MiB + 1536 * 1024)};
            pg8::gemm_phase<pg8::EpiDown, pg8::MoeOrder<false>>(lds, FF, S, E);
            SEAM(p0 + 9);
        }
        if (PHEN(12) && IN(p0 + 10)) for (int rep = PHREP(12); rep >= 0; --rep) { combine_phase(OL, OVCU, OG); if (rep > 0 || l + 1 < NL) SEAM(p0 + 10); }
    }
#undef IN
#undef SEAM
}

extern "C" void kernel_launch(void* const* d_in, const int* in_sizes, int n_in, void* d_out, int out_size, void* d_ws, size_t ws_size, hipStream_t stream) {
    static int grid = 0;
    if (grid == 0) {
        if (n_in != 33 || ws_size < WS_END) { fprintf(stderr, "kernel_launch: unexpected inputs (n_in %d, ws %zu need %zu)\n", n_in, ws_size, (size_t)WS_END); grid = -1; return; }
        int dev = 0, cus = 0;
        if (hipGetDevice(&dev) != hipSuccess || hipDeviceGetAttribute(&cus, hipDeviceAttributeMultiprocessorCount, dev) != hipSuccess) { grid = -1; return; }
        if (hipFuncSetAttribute((const void*)trunk_fwd, hipFuncAttributeMaxDynamicSharedMemorySize, LDS_BYTES) != hipSuccess) { grid = -1; return; }
        int per_cu = 0; (void)hipOccupancyMaxActiveBlocksPerMultiprocessor(&per_cu, (const void*)trunk_fwd, NTHR, LDS_BYTES); (void)hipGetLastError();
        grid = cus;
    }
    if (grid < 0) return;
    (void)hipMemsetAsync((char*)d_ws + WS_CTL, 0, CTL_ZERO_BYTES, stream);
    Args a{};
    for (int i = 0; i < 33; ++i) a.in[i] = (const float*)d_in[i];
    a.out = (float*)d_out; a.ws = (unsigned char*)d_ws;
#if MK_PER_PHASE
    for (int p = 0; p < NPHASES; ++p) { a.ph_lo = p; a.ph_hi = p + 1; hipLaunchKernelGGL(trunk_fwd, dim3(grid), dim3(NTHR), LDS_BYTES, stream, a); }
#else
    a.ph_lo = 0; a.ph_hi = NPHASES;
    hipLaunchKernelGGL(trunk_fwd, dim3(grid), dim3(NTHR), LDS_BYTES, stream, a);
#endif
}
```

```cpp
#include <hip/hip_runtime.h>
#include <cstdio>
#include <cstdint>

#ifndef MK_PER_PHASE
#define MK_PER_PHASE 0
#endif

#define LAS __attribute__((address_space(3)))
#define GAS __attribute__((address_space(1)))
typedef unsigned short bf16;
typedef short bf16x8 __attribute__((ext_vector_type(8)));
typedef short s16x4 __attribute__((ext_vector_type(4)));
typedef float f32x4 __attribute__((ext_vector_type(4)));
typedef float f32x2 __attribute__((ext_vector_type(2)));
typedef float f32x16 __attribute__((ext_vector_type(16)));
typedef unsigned u32x4 __attribute__((ext_vector_type(4)));
typedef unsigned u32x2 __attribute__((ext_vector_type(2)));

constexpr int NB = 8, T = 8192, D = 1024, NL = 4, NTOK = NB * T;
constexpr int PIN = 3088, PINP = 3328;
constexpr int NE = 32, FF = 1024, NMEM = 256;
constexpr int NASSIGN = NTOK * 4;
constexpr int MAXTILES = NASSIGN / 256 + NE;
constexpr int MAXSLOTS = MAXTILES * 256;
constexpr int PC_GQ = 0, PC_GK = 128, PC_GV = 256, PC_GOUT = 512, PC_HQ = 768, PC_HF = 1024, PC_HI = 1280, PC_HG = 1536;
constexpr int PC_RW = 1792, PC_MQ = 2816, PC_GLR = 3072;
constexpr float DN_ALPHA = 1.6817928305074292f;
constexpr float LN_EPS = 1e-5f, RMS_EPS = 1e-6f, RW_LN_EPS = 64e-5f;

constexpr size_t MiB = 1u << 20;
constexpr size_t WS_CTL = 0, CTL_ZERO_BYTES = 1 * MiB;
constexpr size_t WS_WIN = 1 * MiB;
constexpr size_t WS_WOUT = WS_WIN + 26 * MiB;
constexpr size_t WS_WMEM = WS_WOUT + 8 * MiB;
constexpr size_t WS_WGU = WS_WMEM + 4 * MiB;
constexpr size_t WS_WD = WS_WGU + 512 * MiB;
constexpr size_t WS_BGU = WS_WD + 256 * MiB;
constexpr size_t WS_LORA = WS_BGU + 1 * MiB;
constexpr size_t WS_MEMB = WS_LORA + 1 * MiB;
constexpr size_t WS_MKV = WS_MEMB + 4 * MiB;
constexpr size_t WS_XB = WS_MKV + 8 * MiB;
constexpr size_t WS_X1B = WS_XB + 128 * MiB;
constexpr size_t WS_XF = WS_X1B + 128 * MiB;
constexpr size_t WS_X1F = WS_XF + 256 * MiB;
constexpr size_t WS_O = WS_X1F + 256 * MiB;
constexpr size_t WS_HMIX = WS_O + 128 * MiB;
constexpr size_t WS_ROUTE = WS_HMIX + 128 * MiB;
constexpr size_t WS_GBUF = WS_ROUTE + 6 * MiB;
constexpr size_t WS_BONUS = WS_GBUF + 32 * MiB;
constexpr size_t WS_BIG = WS_BONUS + 1 * MiB;
constexpr size_t WS_P = WS_BIG;
constexpr size_t WS_SCAN0 = WS_P + 416 * MiB;
constexpr size_t WS_SCAN1 = WS_SCAN0 + 160 * MiB;
constexpr size_t WS_SCAN2 = WS_SCAN1 + 256 * MiB;
constexpr size_t WS_ORAW = WS_SCAN2 + 384 * MiB;
constexpr size_t WS_HB = WS_BIG;
constexpr size_t WS_YB = WS_HB + 528 * MiB;
constexpr size_t WS_CHK = WS_ORAW;
constexpr size_t WS_HQ = WS_CHK, WS_HK = WS_HQ + 32 * MiB, WS_HVT = WS_HK + 32 * MiB, WS_HDS = WS_HVT + 32 * MiB, WS_HS = WS_HDS + 128 * MiB, WS_HBE = WS_HS + 64 * MiB;
constexpr size_t WS_GQ = WS_HBE + 2 * MiB, WS_GK = WS_GQ + 16 * MiB, WS_GVT = WS_GK + 16 * MiB, WS_GDS = WS_GVT + 32 * MiB, WS_GS = WS_GDS + 64 * MiB, WS_GBE = WS_GS + 32 * MiB;
constexpr size_t WS_RR = WS_GBE + 1 * MiB, WS_RB = WS_RR + 32 * MiB, WS_RK = WS_RB + 32 * MiB, WS_RW = WS_RK + 32 * MiB, WS_RVT = WS_RW + 32 * MiB;
constexpr size_t WS_RU = WS_RVT + 32 * MiB, WS_RP = WS_RU + 64 * MiB, WS_RQ = WS_RP + 64 * MiB, WS_RS = WS_RQ + 128 * MiB;
constexpr size_t WS_END = WS_RS + 64 * MiB;
static_assert(WS_YB + 528 * MiB <= WS_END, "overlay");
static_assert(WS_END <= (size_t)4096 * MiB, "workspace");
constexpr int CW_TMO = 0;
constexpr int CW_BAR = 4096;
constexpr int CW_HIST = 16384;
constexpr int CW_NT = 32768;
constexpr int CW_TILEE = 32768 + 64;
constexpr int CW_PADSTART = 40960;

constexpr int RING_BYTES = 131072;
constexpr int LDSCTL_OFF = 162816, MISC_OFF = LDSCTL_OFF + 320;
constexpr int LDS_BYTES = 163840;
constexpr int NWAVES = 8, NTHR = 512;

#define RLX_AGENT __ATOMIC_RELAXED, __HIP_MEMORY_SCOPE_AGENT
#define LDS_WAIT() asm volatile("s_waitcnt lgkmcnt(0)" ::: "memory")
#define VM_WAIT() asm volatile("s_waitcnt vmcnt(0)" ::: "memory")

__device__ __forceinline__ unsigned f2bf(float f) { unsigned u = __builtin_bit_cast(unsigned, f); return (u + 0x7fffu + ((u >> 16) & 1u)) >> 16; }
__device__ __forceinline__ unsigned pk2(float lo, float hi) { return f2bf(lo) | (f2bf(hi) << 16); }
__device__ __forceinline__ float bf2f(unsigned short b) { return __builtin_bit_cast(float, (unsigned)b << 16); }
__device__ __forceinline__ float bflo(unsigned w) { return __builtin_bit_cast(float, w << 16); }
__device__ __forceinline__ float bfhi(unsigned w) { return __builtin_bit_cast(float, w & 0xffff0000u); }
typedef __bf16 bf16x2_t __attribute__((ext_vector_type(2)));
__device__ __forceinline__ unsigned cvt_pk_bf16(float lo, float hi) { const f32x2 v = {lo, hi}; const bf16x2_t b = __builtin_convertvector(v, bf16x2_t); return __builtin_bit_cast(unsigned, b); }
__device__ __forceinline__ float fast_exp(float x) { return __builtin_amdgcn_exp2f(x * 1.4426950408889634f); }
__device__ __forceinline__ float fast_sigmoid(float x) { return __builtin_amdgcn_rcpf(1.0f + fast_exp(-x)); }
__device__ __forceinline__ float silu_f(float x) { return x * fast_sigmoid(x); }
__device__ __forceinline__ int opaque_tid() { int t = threadIdx.x; asm volatile("" : "+v"(t)); return t; }
__device__ __forceinline__ int opaque_s(int v) { asm volatile("" : "+s"(v)); return v; }
__device__ __forceinline__ float wave_sum(float v) {
#pragma unroll
    for (int o = 1; o < 64; o <<= 1) v += __shfl_xor(v, o);
    return v;
}

namespace pg8 {
constexpr int BM = 256, BK = 64, HALF = 128, HTB = HALF * BK * 2, STAGE_BYTES = 8 * HTB, NXCD = 8, WGM = 8;
__host__ __device__ __forceinline__ int lds_byte(int r, int c) { const int st = (r >> 4) * 2 + (c >> 5), rr = r & 15, cc = c & 31, ob = rr * 64 + cc * 2; return st * 1024 + (ob ^ (((ob >> 9) & 1) << 5)); }
__host__ __device__ __forceinline__ void stage_rc(int b, int& R, int& C) { const int st = b / 1024, sb = b % 1024, swz = sb ^ (((sb >> 9) & 1) << 5); R = (st >> 1) * 16 + swz / 64; C = (st & 1) * 32 + (swz % 64) / 2; }
__host__ __device__ __forceinline__ int perm32(int rho) { const int n = rho >> 4, i = rho & 15; return 8 * (i >> 2) + 4 * n + (i & 3); }

struct Unit { int pm, pn, e; const char* A; const char* B; };

__device__ __forceinline__ bool static_tile(int i, int G, int c, int nM, int nN, int& pm, int& pn) {
    const int nwg = nM * nN; const long L = (long)i * G + c; if (L >= nwg) return false;
    int wgid = (int)L; { const int q = nwg / NXCD, r = nwg % NXCD, xcd = wgid % NXCD, off = wgid / NXCD; wgid = (xcd < r ? xcd * (q + 1) : r * (q + 1) + (xcd - r) * q) + off; }
    const int nig = WGM * nN, gid = wgid / nig, fm = gid * WGM, gsz = (nM - fm) < WGM ? (nM - fm) : WGM;
    pm = fm + ((wgid % nig) % gsz); pn = (wgid % nig) / gsz; return true;
}
struct DenseOrder {
    static constexpr bool GATHER = false;
    const char* A; const char* B; int nM, nN, G, c; size_t tstep;
    __device__ __forceinline__ void init(const void* A_, const void* B_, int M, int N, int K, int G_, int c_) { A = (const char*)A_; B = (const char*)B_; nM = M / BM; nN = N / BM; G = G_; c = c_; tstep = (size_t)BM * K * 2; }
    __device__ __forceinline__ bool next(int i, Unit& u) const { if (!static_tile(i, G, c, nM, nN, u.pm, u.pn)) return false; u.e = 0; u.A = A + (size_t)u.pm * tstep; u.B = B + (size_t)u.pn * tstep; return true; }
    __device__ __forceinline__ unsigned row_tok(const Unit&, int) const { return 0; }
};
template <bool GATHER_> struct MoeOrder {
    static constexpr bool GATHER = GATHER_;
    const char* A; const char* B; const int* tile_e; const int* slot_tok; int nM, nN, G, c; size_t tstep, estep;
    __device__ __forceinline__ void init(const void* A_, const void* B_, const int* tile_e_, const int* slot_tok_, int ntiles, int Nper, int K, int G_, int c_) {
        A = (const char*)A_; B = (const char*)B_; tile_e = tile_e_; slot_tok = slot_tok_; nM = ntiles; nN = Nper / BM; G = G_; c = c_; tstep = (size_t)BM * K * 2; estep = (size_t)Nper * K * 2; }
    __device__ __forceinline__ bool next(int i, Unit& u) const { if (!static_tile(i, G, c, nM, nN, u.pm, u.pn)) return false;
        u.e = __builtin_amdgcn_readfirstlane(tile_e[u.pm]); u.A = GATHER_ ? A : A + (size_t)u.pm * tstep; u.B = B + (size_t)u.e * estep + (size_t)u.pn * tstep; return true; }
    __device__ __forceinline__ unsigned row_tok(const Unit& u, int r) const { return (unsigned)slot_tok[u.pm * BM + r]; }
};

struct EpiBf16 {
    static constexpr bool PERM = true;
    bf16* O; int ldc;
    __device__ __forceinline__ void operator()(const f32x4 (&acc)[2][2][4][2], const Unit& u, int wr, int wc, int fr, int fq) const {
        const int row0 = u.pm * BM + wr * 64 + fr, col0 = u.pn * BM + wc * 32 + 8 * fq;
#pragma unroll
        for (int ai = 0; ai < 2; ++ai)
#pragma unroll
            for (int m = 0; m < 4; ++m) { bf16* rowp = O + (size_t)(row0 + ai * HALF + m * 16) * ldc + col0;
#pragma unroll
                for (int bj = 0; bj < 2; ++bj) { const f32x4 v0 = acc[ai][bj][m][0], v1 = acc[ai][bj][m][1];
                    u32x4 w; w.x = cvt_pk_bf16(v0[0], v0[1]); w.y = cvt_pk_bf16(v0[2], v0[3]); w.z = cvt_pk_bf16(v1[0], v1[1]); w.w = cvt_pk_bf16(v1[2], v1[3]);
                    *(u32x4*)(rowp + bj * HALF) = w; } }
    }
};
struct EpiSwiglu {
    static constexpr bool PERM = false;
    bf16* H; const float* bias;
    __device__ __forceinline__ void operator()(const f32x4 (&acc)[2][2][4][2], const Unit& u, int wr, int wc, int fr, int fq) const {
        const int row0 = u.pm * BM + wr * 64 + fr, colh = u.pn * 128 + wc * 32 + 8 * fq;
        const float* bp = bias + (size_t)u.e * 2048 + u.pn * 256 + wc * 32 + 4 * fq;
        f32x4 bv[2][2];
#pragma unroll
        for (int bj = 0; bj < 2; ++bj)
#pragma unroll
            for (int n = 0; n < 2; ++n) bv[bj][n] = *(const f32x4*)(bp + bj * HALF + n * 16);
#pragma unroll
        for (int ai = 0; ai < 2; ++ai)
#pragma unroll
            for (int m = 0; m < 4; ++m) { bf16* rowp = H + (size_t)(row0 + ai * HALF + m * 16) * FF + colh;
                float o[8];
#pragma unroll
                for (int n = 0; n < 2; ++n) { const f32x4 g4 = acc[ai][0][m][n] + bv[0][n], u4 = acc[ai][1][m][n] + bv[1][n];
#pragma unroll
                    for (int j = 0; j < 4; ++j) { const float g = fminf(g4[j], 7.0f), up = fminf(fmaxf(u4[j], -7.0f), 7.0f);
                        const float glu = g * __builtin_amdgcn_rcpf(1.0f + __builtin_amdgcn_exp2f(g * (-1.702f * 1.4426950408889634f)));
                        o[n * 4 + j] = (up + 1.0f) * glu; } }
                u32x4 w; w.x = cvt_pk_bf16(o[0], o[1]); w.y = cvt_pk_bf16(o[2], o[3]); w.z = cvt_pk_bf16(o[4], o[5]); w.w = cvt_pk_bf16(o[6], o[7]);
                *(u32x4*)rowp = w; }
    }
};
struct EpiDown {
    static constexpr bool PERM = true;
    bf16* Y; const float* bias; const float* slot_gate;
    __device__ __forceinline__ void operator()(const f32x4 (&acc)[2][2][4][2], const Unit& u, int wr, int wc, int fr, int fq) const {
        const int row0 = u.pm * BM + wr * 64 + fr, col0 = u.pn * BM + wc * 32 + 8 * fq;
        const float* bp = bias + (size_t)u.e * 1024 + col0;
        f32x4 bv[2][2];
#pragma unroll
        for (int bj = 0; bj < 2; ++bj)
#pragma unroll
            for (int n = 0; n < 2; ++n) bv[bj][n] = *(const f32x4*)(bp + bj * HALF + 4 * n);
#pragma unroll
        for (int ai = 0; ai < 2; ++ai)
#pragma unroll
            for (int m = 0; m < 4; ++m) { const int row = row0 + ai * HALF + m * 16; const float g = slot_gate[row]; bf16* rowp = Y + (size_t)row * D + col0;
#pragma unroll
                for (int bj = 0; bj < 2; ++bj) { const f32x4 v0 = (acc[ai][bj][m][0] + bv[bj][0]) * g, v1 = (acc[ai][bj][m][1] + bv[bj][1]) * g;
                    u32x4 w; w.x = cvt_pk_bf16(v0[0], v0[1]); w.y = cvt_pk_bf16(v0[2], v0[3]); w.z = cvt_pk_bf16(v1[0], v1[1]); w.w = cvt_pk_bf16(v1[2], v1[3]);
                    *(u32x4*)(rowp + bj * HALF) = w; } }
    }
};

template <class Epi, class Sched, bool ALIGN_EPI = true>
__device__ __forceinline__ void gemm_phase(LAS unsigned char* lds, const int K, const Sched& S, const Epi& E) {
    constexpr bool GA = Sched::GATHER;
    const int tid = opaque_tid(), wid = __builtin_amdgcn_readfirstlane(tid >> 6), lane = tid & 63, wr = wid >> 2, wc = wid & 3, fr = lane & 15, fq = lane >> 4;
    const int nt = K / BK;
    unsigned voffA[2], voffB[2]; int Rr[2]; unsigned Cb[2];
#pragma unroll
    for (int i = 0; i < 2; ++i) { int R, C; stage_rc(tid * 16 + i * 8192, R, C); const int Rb = Epi::PERM ? ((R & ~31) + perm32(R & 31)) : R;
        voffA[i] = (unsigned)(R * K + C) * 2u; voffB[i] = (unsigned)(Rb * K + C) * 2u; Rr[i] = R; Cb[i] = (unsigned)C * 2u; }
    const size_t kstep = (size_t)(BK * 2);
    const size_t hstep = (size_t)HALF * K * 2;
    const unsigned ldsw = (unsigned)wid * 1024u;
    const int aoff = lds_byte(wr * 64 + fr, fq * 8), boff = lds_byte(wc * 32 + fr, fq * 8);
    unsigned cOff[2][2], nOff[2][2], sOff[2][2];
#define PG8_SA(b, h) (((b) * 2 + (h)) * HTB)
#define PG8_SB(b, h) ((4 + (b) * 2 + (h)) * HTB)
#define PG8_STAGE(bufoff, gbase, voff) do { _Pragma("unroll") for (int _i = 0; _i < 2; ++_i) \
        __builtin_amdgcn_global_load_lds((const unsigned*)((const char*)(gbase) + (voff)[_i]), (LAS unsigned*)(lds + (bufoff) + ldsw + _i * 8192), 16, 0, 0); } while (0)
#define PG8_STAGE_A(bufoff, gbase, half, OFF) do { if constexpr (GA) { PG8_STAGE(bufoff, gbase, (OFF)[half]); } else { PG8_STAGE(bufoff, (gbase) + (half) * hstep, voffA); } } while (0)
#define PG8_LDA(dst, b, h) do { _Pragma("unroll") for (int m = 0; m < 4; ++m) _Pragma("unroll") for (int k = 0; k < 2; ++k) dst[m][k] = *(const LAS bf16x8*)(lds + PG8_SA(b, h) + aoff + m * 2048 + k * 1024); } while (0)
#define PG8_LDB(dst, b, h) do { _Pragma("unroll") for (int n = 0; n < 2; ++n) _Pragma("unroll") for (int k = 0; k < 2; ++k) dst[n][k] = *(const LAS bf16x8*)(lds + PG8_SB(b, h) + boff + n * 2048 + k * 1024); } while (0)
#define PG8_MMA(ai, bj, At, Bt) do { __builtin_amdgcn_s_setprio(1); _Pragma("unroll") for (int m = 0; m < 4; ++m) _Pragma("unroll") for (int n = 0; n < 2; ++n) _Pragma("unroll") for (int k = 0; k < 2; ++k) \
        acc[ai][bj][m][n] = __builtin_amdgcn_mfma_f32_16x16x32_bf16(Bt[n][k], At[m][k], acc[ai][bj][m][n], 0, 0, 0); __builtin_amdgcn_s_setprio(0); } while (0)
#define PG8_WAIT_V(n) asm volatile("s_waitcnt vmcnt(" #n ")" ::: "memory")
#define PG8_WAIT_L(n) asm volatile("s_waitcnt lgkmcnt(" #n ")" ::: "memory")
#define PG8_BAR __builtin_amdgcn_s_barrier()
#define PG8_SCHED __builtin_amdgcn_sched_barrier(0)
#define PG8_GOFF(dst, u) do { if constexpr (GA) { _Pragma("unroll") for (int _h = 0; _h < 2; ++_h) _Pragma("unroll") for (int _i = 0; _i < 2; ++_i) \
        dst[_h][_i] = S.row_tok(u, _h * HALF + Rr[_i]) * (unsigned)(K * 2) + Cb[_i]; } } while (0)
    Unit cur, nxt; int ui = 0;
    if (!S.next(0, cur)) return;
    f32x4 acc[2][2][4][2];
#pragma unroll
    for (int a = 0; a < 2; ++a)
#pragma unroll
        for (int b = 0; b < 2; ++b)
#pragma unroll
            for (int m = 0; m < 4; ++m)
#pragma unroll
                for (int n = 0; n < 2; ++n) acc[a][b][m][n] = (f32x4){0.f, 0.f, 0.f, 0.f};
    bf16x8 At[4][2], B0[2][2], B1[2][2];
    const char* cA = cur.A; const char* cB = cur.B;
    PG8_GOFF(cOff, cur);
#pragma unroll
    for (int h = 0; h < 2; ++h)
#pragma unroll
        for (int i = 0; i < 2; ++i) { nOff[h][i] = 0u; sOff[h][i] = 0u; }
    if constexpr (GA) { VM_WAIT(); }
    PG8_STAGE(PG8_SB(0, 0), cB, voffB); PG8_STAGE(PG8_SB(0, 1), cB + hstep, voffB); PG8_STAGE_A(PG8_SA(0, 0), cA, 0, cOff); PG8_STAGE_A(PG8_SA(0, 1), cA, 1, cOff);
    if (wr == 1) PG8_BAR;
    PG8_WAIT_V(2); PG8_BAR;
    PG8_STAGE(PG8_SB(1, 0), cB + kstep, voffB); PG8_STAGE_A(PG8_SA(1, 0), cA + kstep, 0, cOff); PG8_STAGE(PG8_SB(1, 1), cB + hstep + kstep, voffB);
    PG8_WAIT_V(6); PG8_BAR;
    for (;;) {
        const bool has_next = S.next(ui + 1, nxt);
        const char* nA = has_next ? nxt.A : cA; const char* nB = has_next ? nxt.B : cB;
        if constexpr (GA) { if (has_next) { PG8_GOFF(nOff, nxt); } else {
#pragma unroll
            for (int h = 0; h < 2; ++h)
#pragma unroll
                for (int i = 0; i < 2; ++i) nOff[h][i] = cOff[h][i]; } }
        for (int t = 0; t < nt; t += 2) {
            const bool last = (t == nt - 2);
            const char* a1 = cA + (size_t)(t + 1) * kstep;
            const char* a2 = last ? nA : cA + (size_t)(t + 2) * kstep; const char* b2 = last ? nB : cB + (size_t)(t + 2) * kstep;
            const char* a3 = a2 + kstep; const char* b3 = b2 + kstep;
            if constexpr (GA) {
#pragma unroll
                for (int h = 0; h < 2; ++h)
#pragma unroll
                    for (int i = 0; i < 2; ++i) sOff[h][i] = last ? nOff[h][i] : cOff[h][i]; }
            PG8_LDB(B0, 0, 0); PG8_LDB(B1, 0, 1); PG8_SCHED; PG8_LDA(At, 0, 0); PG8_STAGE_A(PG8_SA(1, 1), a1, 1, cOff);
            PG8_WAIT_V(8); PG8_WAIT_L(0); PG8_BAR; PG8_MMA(0, 0, At, B0); PG8_MMA(0, 1, At, B1); PG8_BAR; PG8_SCHED;
            PG8_LDA(At, 0, 1); PG8_STAGE(PG8_SB(0, 0), b2, voffB); PG8_STAGE(PG8_SB(0, 1), b2 + hstep, voffB); PG8_STAGE_A(PG8_SA(0, 0), a2, 0, sOff);
            PG8_WAIT_V(8); PG8_WAIT_L(0); PG8_BAR; PG8_MMA(1, 0, At, B0); PG8_MMA(1, 1, At, B1); PG8_BAR; PG8_SCHED;
            PG8_LDB(B0, 1, 0); PG8_LDB(B1, 1, 1); PG8_SCHED; PG8_LDA(At, 1, 0); PG8_STAGE_A(PG8_SA(0, 1), a2, 1, sOff);
            PG8_WAIT_V(8); PG8_WAIT_L(0); PG8_BAR; PG8_MMA(0, 0, At, B0); PG8_MMA(0, 1, At, B1); PG8_BAR; PG8_SCHED;
            PG8_LDA(At, 1, 1); PG8_STAGE(PG8_SB(1, 0), b3, voffB); PG8_STAGE(PG8_SB(1, 1), b3 + hstep, voffB); PG8_STAGE_A(PG8_SA(1, 0), a3, 0, sOff);
            PG8_WAIT_V(8); PG8_WAIT_L(0); PG8_BAR; PG8_MMA(1, 0, At, B0); PG8_MMA(1, 1, At, B1); PG8_BAR; PG8_SCHED;
        }
        if constexpr (ALIGN_EPI) { if (wr == 0) PG8_BAR; }
        E(acc, cur, wr, wc, fr, fq);
        if (!has_next) break;
#pragma unroll
        for (int a = 0; a < 2; ++a)
#pragma unroll
            for (int b = 0; b < 2; ++b)
#pragma unroll
                for (int m = 0; m < 4; ++m)
#pragma unroll
                    for (int n = 0; n < 2; ++n) acc[a][b][m][n] = (f32x4){0.f, 0.f, 0.f, 0.f};
        cur = nxt; cA = nA; cB = nB; ++ui;
        if constexpr (GA) {
#pragma unroll
            for (int h = 0; h < 2; ++h)
#pragma unroll
                for (int i = 0; i < 2; ++i) cOff[h][i] = nOff[h][i]; }
        if constexpr (ALIGN_EPI) { if (wr == 1) PG8_BAR; }
    }
    PG8_WAIT_V(0);
    if constexpr (!ALIGN_EPI) { if (wr == 0) PG8_BAR; }
    PG8_BAR;
#undef PG8_SA
#undef PG8_SB
#undef PG8_STAGE
#undef PG8_STAGE_A
#undef PG8_LDA
#undef PG8_LDB
#undef PG8_MMA
#undef PG8_WAIT_V
#undef PG8_WAIT_L
#undef PG8_BAR
#undef PG8_SCHED
#undef PG8_GOFF
}
}

#define XB_TMO      128
#define XB_XCNT(j)  (256  + 64 * (j))
#define XB_XSUB(j)  (1280 + 64 * (j))
#define XB_XGEN(j)  (2304 + 64 * (j))
#define XB_TOP      3328
#define XB_TOPGEN   3392
#define XCD_BAR_WORDS 3456
#define XB_SPIN_CAP (1u << 18)
__device__ __forceinline__ unsigned xb_ld(unsigned* p)              { return __hip_atomic_load(p, __ATOMIC_RELAXED, __HIP_MEMORY_SCOPE_AGENT); }
__device__ __forceinline__ unsigned xb_add(unsigned* p, unsigned v) { return __hip_atomic_fetch_add(p, v, __ATOMIC_RELAXED, __HIP_MEMORY_SCOPE_AGENT); }
__device__ __forceinline__ unsigned xb_xcc_id() { return (unsigned)__builtin_amdgcn_s_getreg((3 << 11) | 20) & 0xFu; }
#define XB_SPIN(cond, bar) do { unsigned _sp = 0; while (cond) { __builtin_amdgcn_s_sleep(1); \
    if ((++_sp & 255u) == 0u) { if (xb_ld(&(bar)[XB_TMO])) break; if (_sp > XB_SPIN_CAP) { atomicAdd(&(bar)[XB_TMO], 1u); break; } } } } while (0)
struct XcdBarrier { unsigned* bar; unsigned x; volatile LAS unsigned* st; };
__device__ __forceinline__ XcdBarrier xcd_barrier_post(unsigned* bar, volatile LAS unsigned* st) {
    XcdBarrier b; b.bar = bar; b.x = xb_xcc_id(); b.st = st;
    if (threadIdx.x == 0) (void)xb_add(&bar[XB_XCNT(b.x)], 1u);
    return b;
}
__device__ __forceinline__ void xcd_barrier_complete(unsigned* bar, unsigned x, unsigned& nloc, unsigned& nx) {
    const unsigned G = gridDim.x * gridDim.y * gridDim.z;
    unsigned sum, cnt, mine, sp = 0u;
    for (;;) {
        sum = 0u; cnt = 0u; mine = 0u;
#pragma unroll
        for (unsigned j = 0; j < 16; ++j) { const unsigned c = xb_ld(&bar[XB_XCNT(j)]); sum += c; cnt += (c > 0u) ? 1u : 0u; mine = (j == x) ? c : mine; }
        if (sum == G) break;
        __builtin_amdgcn_s_sleep(1);
        if ((++sp & 255u) == 0u) { if (xb_ld(&bar[XB_TMO])) break; if (sp > XB_SPIN_CAP) { atomicAdd(&bar[XB_TMO], 1u); break; } }
    }
    nloc = mine > 0u ? mine : 1u; nx = cnt > 0u ? cnt : 1u;
}
__device__ __forceinline__ void xcd_barrier(const XcdBarrier& b) {
    asm volatile("s_waitcnt vmcnt(0)" ::: "memory");
    __syncthreads();
    if (threadIdx.x == 0) {
        unsigned* bar = b.bar;
        __builtin_amdgcn_s_waitcnt(0);
        unsigned nloc = b.st[0], nx = b.st[1];
        if (nloc == 0u) { xcd_barrier_complete(bar, b.x, nloc, nx); b.st[0] = nloc; b.st[1] = nx; }
        const unsigned old = xb_add(&bar[XB_XSUB(b.x)], 1u);
        const unsigned gen = old / nloc;
        if (old + 1u == (gen + 1u) * nloc) {
            __builtin_amdgcn_fence(__ATOMIC_RELEASE, "agent");
            asm volatile("s_waitcnt vmcnt(0)" ::: "memory");
            const unsigned og = xb_add(&bar[XB_TOP], 1u);
            const unsigned tg = og / nx;
            if (og + 1u == (tg + 1u) * nx) xb_add(&bar[XB_TOPGEN], 1u);
            else XB_SPIN(xb_ld(&bar[XB_TOPGEN]) == tg, bar);
            __builtin_amdgcn_fence(__ATOMIC_ACQUIRE, "agent");
            xb_add(&bar[XB_XGEN(b.x)], 1u);
            asm volatile("s_waitcnt vmcnt(0)" ::: "memory");
        } else {
            XB_SPIN(xb_ld(&bar[XB_XGEN(b.x)]) == gen, bar);
            __builtin_amdgcn_fence(__ATOMIC_ACQUIRE, "agent");
            asm volatile("s_waitcnt vmcnt(0)" ::: "memory");
        }
    }
    __syncthreads();
}

struct Args {
    const float* in[33];
    float* out; unsigned char* ws;
    int ph_lo, ph_hi;
};
enum { I_X = 0, I_MEM, I_WIN, I_GLACONV, I_GLAW2, I_GLAB, I_GLANG, I_HGLB, I_HGNG, I_RWMU, I_RWW0, I_RWW2, I_RWA0, I_RWA2, I_RWG2, I_RWKK, I_RWKA, I_RWRK, I_RWLNW, I_RWLNB,
       I_WMK, I_WMV, I_WOUT, I_LN1G, I_LN1B, I_RTW, I_RTB, I_WGU, I_BGU, I_WDN, I_BDN, I_LN2G, I_LN2B };


template <int OFF> __device__ __forceinline__ unsigned long long ka_u64() { unsigned long long v; asm volatile("s_load_dwordx2 %0, %1, %2\n\ts_waitcnt lgkmcnt(0)" : "=s"(v) : "s"(__builtin_amdgcn_kernarg_segment_ptr()), "n"(OFF)); return v; }
#define KIN(i) ((const float*)(const GAS float*)ka_u64<8 * (i)>())
#define KOUT() ((float*)(GAS float*)ka_u64<264>())
#define KWS() ((unsigned char*)(GAS unsigned char*)ka_u64<272>())

template <class Map>
__device__ __forceinline__ void tr_item(const float* __restrict__ W, int K, int N, bf16* __restrict__ WT, LAS float* scr, int kb, int nb, int lane, Map map) {
    const int k0 = 64 * kb, n0 = 64 * nb, col = n0 + lane; const bool valid = col < N;
    const float* src = W + (size_t)k0 * N + (valid ? col : 0);
#pragma unroll 16
    for (int kk = 0; kk < 64; ++kk) { const float v = valid ? src[(size_t)kk * N] : 0.f; scr[kk * 65 + lane] = v; }
    LDS_WAIT(); asm volatile("" ::: "memory");
    const int c = lane & 7;
#pragma unroll
    for (int j = 0; j < 8; ++j) { const int n = (lane >> 3) + 8 * j;
        if (n0 + n < N) { const int orow = map(n0 + n); const LAS float* s = scr + (8 * c) * 65 + n;
            u32x4 o; o.x = pk2(s[0 * 65], s[1 * 65]); o.y = pk2(s[2 * 65], s[3 * 65]); o.z = pk2(s[4 * 65], s[5 * 65]); o.w = pk2(s[6 * 65], s[7 * 65]);
            *(u32x4*)(WT + (size_t)orow * K + k0 + 8 * c) = o; } }
    LDS_WAIT(); asm volatile("" ::: "memory");
}
struct MapIdent { int off; __device__ __forceinline__ int operator()(int c) const { return c + off; } };
struct MapWin { __device__ __forceinline__ int operator()(int c) const { return c < 512 ? c : (c < 528 ? c + 2560 : c - 16); } };
__device__ __forceinline__ int gu_row(int c) { const int f = c >> 1, bj = c & 1, pn = f >> 7, fl = f & 127, wc = fl >> 5, fq = (fl >> 3) & 3, n = (fl >> 2) & 1, j = fl & 3; return 256 * pn + 128 * bj + 32 * wc + 16 * n + 4 * fq + j; }
struct MapGu { __device__ __forceinline__ int operator()(int c) const { return gu_row(c); } };

__device__ __forceinline__ void prologue_phase(LAS unsigned char* lds, int vcu, int G) {
    const int tid = opaque_tid(), lane = tid & 63, wave = __builtin_amdgcn_readfirstlane(tid >> 6);
    LAS float* scr = (LAS float*)(lds + wave * 16640); static_assert(8 * 16640 <= LDSCTL_OFF, "prologue scratch below the LDS control words");
    const int gw = vcu * NWAVES + wave, NGW = G * NWAVES;
    unsigned char* ws = KWS();
    constexpr int IT_GU = NL * NE * 512, IT_DN = NL * NE * 256, IT_IN = NL * 16 * 49, IT_OUT = NL * 256, IT_MEM = NL * 2 * 64, IT_L64 = NL * 2 * 4, IT_L128 = NL * 2 * 4;
    constexpr int IT_TOTAL = IT_GU + IT_DN + IT_IN + IT_OUT + IT_MEM + IT_L64 + IT_L128;
    for (int it = gw; it < IT_TOTAL; it += NGW) {
        int r = it;
        if (r < IT_GU) { const int le = r >> 9, q = r & 511, kb = q >> 5, nb = q & 31;
            tr_item(KIN(I_WGU) + (size_t)le * 1024 * 2048, 1024, 2048, (bf16*)(ws + WS_WGU) + (size_t)le * 2048 * 1024, scr, kb, nb, lane, MapGu{}); continue; } r -= IT_GU;
        if (r < IT_DN) { const int le = r >> 8, q = r & 255, kb = q >> 4, nb = q & 15;
            tr_item(KIN(I_WDN) + (size_t)le * 1024 * 1024, 1024, 1024, (bf16*)(ws + WS_WD) + (size_t)le * 1024 * 1024, scr, kb, nb, lane, MapIdent{0}); continue; } r -= IT_DN;
        if (r < IT_IN) { const int l = r / (16 * 49), q = r % (16 * 49), kb = q / 49, nb = q % 49;
            tr_item(KIN(I_WIN) + (size_t)l * 1024 * PIN, 1024, PIN, (bf16*)(ws + WS_WIN) + (size_t)l * PINP * 1024, scr, kb, nb, lane, MapWin{}); continue; } r -= IT_IN;
        if (r < IT_OUT) { const int l = r >> 8, q = r & 255, kb = q >> 4, nb = q & 15;
            tr_item(KIN(I_WOUT) + (size_t)l * 1024 * 1024, 1024, 1024, (bf16*)(ws + WS_WOUT) + (size_t)l * 1024 * 1024, scr, kb, nb, lane, MapIdent{0}); continue; } r -= IT_OUT;
        if (r < IT_MEM) { const int l = r >> 7, q = r & 127, kv = q >> 6, kb = (q >> 2) & 15, nb = q & 3;
            tr_item((kv ? KIN(I_WMV) : KIN(I_WMK)) + (size_t)l * 1024 * 256, 1024, 256, (bf16*)(ws + WS_WMEM), scr, kb, nb, lane, MapIdent{l * 512 + kv * 256}); continue; } r -= IT_MEM;
        if (r < IT_L64) { const int l = r >> 3, q = r & 7, wa = q >> 2, nb = q & 3;
            tr_item((wa ? KIN(I_RWA2) : KIN(I_RWW2)) + (size_t)l * 64 * 256, 64, 256, (bf16*)(ws + WS_LORA) + (size_t)wa * (NL * 256 * 64) + (size_t)l * 256 * 64, scr, 0, nb, lane, MapIdent{0}); continue; } r -= IT_L64;
        { const int l = r >> 3, q = r & 7, kb = q >> 2, nb = q & 3;
            tr_item(KIN(I_RWG2) + (size_t)l * 128 * 256, 128, 256, (bf16*)(ws + WS_LORA) + (size_t)2 * (NL * 256 * 64) + (size_t)l * 256 * 128, scr, kb, nb, lane, MapIdent{0}); }
    }
    { const size_t gt = (size_t)vcu * NTHR + tid, GT = (size_t)G * NTHR; constexpr size_t per = (size_t)(PINP - PIN) * 1024 / 8;
        for (size_t i = gt; i < per * NL; i += GT) { const size_t l = i / per, j = i % per; *(u32x4*)((bf16*)(ws + WS_WIN) + l * PINP * 1024 + (size_t)PIN * 1024 + j * 8) = (u32x4){0u, 0u, 0u, 0u}; }
        for (size_t i = gt; i < (size_t)NL * NE * 2048; i += GT) { const size_t le = i >> 11; const int c = (int)(i & 2047); ((float*)(ws + WS_BGU))[le * 2048 + gu_row(c)] = KIN(I_BGU)[i]; }
        const f32x4* xs = (const f32x4*)KIN(I_X); u32x4* xd = (u32x4*)(ws + WS_XB);
        for (size_t i = gt; i < (size_t)NTOK * D / 8; i += GT) { const f32x4 v0 = xs[2 * i], v1 = xs[2 * i + 1]; xd[i] = (u32x4){pk2(v0[0], v0[1]), pk2(v0[2], v0[3]), pk2(v1[0], v1[1]), pk2(v1[2], v1[3])}; }
        const f32x4* ms = (const f32x4*)KIN(I_MEM); u32x4* md = (u32x4*)(ws + WS_MEMB);
        for (size_t i = gt; i < (size_t)NB * NMEM * D / 8; i += GT) { const f32x4 v0 = ms[2 * i], v1 = ms[2 * i + 1]; md[i] = (u32x4){pk2(v0[0], v0[1]), pk2(v0[2], v0[3]), pk2(v1[0], v1[1]), pk2(v1[2], v1[3])}; }
    }
}


__device__ __forceinline__ float log1pexp_neg_abs(float z) { return __builtin_amdgcn_logf(1.0f + fast_exp(-fabsf(z))) * 0.6931471805599453f; }
__device__ __forceinline__ float tanh_f(float x) { const float e = fast_exp(-2.0f * fabsf(x)); const float t = (1.0f - e) * __builtin_amdgcn_rcpf(1.0f + e); return x < 0.f ? -t : t; }

__device__ __forceinline__ void gla_prep_unit(LAS unsigned char* lds, int l, int b, int t0) {
    const int tid = opaque_tid();
    const bf16* P = (const bf16*)(KWS() + WS_P);
    float* SC = (float*)(KWS() + WS_SCAN0);
    LAS bf16* U = (LAS bf16*)lds;
    LAS float* GL = (LAS float*)(lds + 67 * 512 * 2);
    for (int i = tid; i < 67 * 64; i += NTHR) { const int row = i >> 6, c8 = i & 63; const int t = t0 - 3 + row;
        u32x4 v = (u32x4){0u, 0u, 0u, 0u}; if (t >= 0) v = *(const u32x4*)(P + (size_t)(b * T + t) * PINP + c8 * 8);
        *(LAS u32x4*)(U + row * 512 + c8 * 8) = v; }
    { const int i = tid * 2, tok = i >> 4, r = i & 15; const unsigned w = *(const unsigned*)(P + (size_t)(b * T + t0 + tok) * PINP + PC_GLR + r); GL[tok * 16 + r] = bflo(w); GL[tok * 16 + r + 1] = bfhi(w); }
    __syncthreads();
    {
        const int c = tid; const float* cw = KIN(I_GLACONV) + (size_t)l * 4 * 512 + c;
        const float w0 = cw[0], w1 = cw[512], w2 = cw[1024], w3 = cw[1536];
        float u0 = bf2f(U[0 * 512 + c]), u1 = bf2f(U[1 * 512 + c]), u2 = bf2f(U[2 * 512 + c]);
        int head, off; float sc = 1.0f;
        if (c < 128) { head = c >> 5; off = 64 + (c & 31); sc = 0.17677669529663687f; } else if (c < 256) { head = (c - 128) >> 5; off = 32 + (c & 31); } else { head = (c - 256) >> 6; off = 96 + (c & 63); }
        float* dst = SC + ((size_t)(b * 4 + head) * T + t0) * 160 + off;
        for (int t = 0; t < 64; ++t) { const float u3 = bf2f(U[(t + 3) * 512 + c]); const float y = w0 * u0 + w1 * u1 + w2 * u2 + w3 * u3; dst[(size_t)t * 160] = silu_f(y) * sc; u0 = u1; u1 = u2; u2 = u3; }
    }
    {
        const int c = tid & 127, tq = tid >> 7; const float* w2p = KIN(I_GLAW2) + (size_t)l * 16 * 128 + c; float wc[16];
#pragma unroll
        for (int r = 0; r < 16; ++r) wc[r] = w2p[r * 128];
        const float gb = KIN(I_GLAB)[l * 128 + c];
        float* dst = SC + ((size_t)(b * 4 + (c >> 5)) * T + t0) * 160 + (c & 31);
        for (int t = tq; t < 64; t += 4) { float z = gb;
#pragma unroll
            for (int r = 0; r < 16; ++r) z += GL[t * 16 + r] * wc[r];
            const float ls = fminf(z, 0.f) - log1pexp_neg_abs(z);
            dst[(size_t)t * 160] = ls * 0.0625f; }
    }
    __syncthreads();
}

__device__ __forceinline__ void hg_prep_unit(int l, int b, int t0) {
    const int tid = opaque_tid(), c = tid & 255, tq = tid >> 8;
    const bf16* P = (const bf16*)(KWS() + WS_P);
    float* SC = (float*)(KWS() + WS_SCAN1);
    float lb;
    { const float* hp = KIN(I_HGLB) + c; const float v0 = hp[0], v1 = hp[256], v2 = hp[512], v3 = hp[768]; const float m = fmaxf(fmaxf(v0, v1), fmaxf(v2, v3));
      const float e0 = __expf(v0 - m), e1 = __expf(v1 - m), e2 = __expf(v2 - m), e3 = __expf(v3 - m); const float inv = 1.0f / (e0 + e1 + e2 + e3);
      lb = (l >= 1 ? e1 : 0.f) + (l >= 2 ? e2 : 0.f) + (l >= 3 ? e3 : 0.f); lb *= inv; }
    const float oml = 1.0f - lb;
    float* dst = SC + ((size_t)(b * 4 + (c >> 6)) * T + t0) * 256 + (c & 63);
    for (int t = tq; t < 64; t += 2) { const bf16* row = P + (size_t)(b * T + t0 + t) * PINP;
        const float hq = bf2f(row[PC_HQ + c]), hf = bf2f(row[PC_HF + c]), hi = bf2f(row[PC_HI + c]);
        const float s = fast_sigmoid(hf), sn = fast_sigmoid(-hf);
        float* d = dst + (size_t)t * 256;
        d[0] = __builtin_amdgcn_logf(fmaxf(lb + oml * s, 1e-30f)) * 0.6931471805599453f; d[64] = oml * sn; d[128] = silu_f(hq); d[192] = hi; }
}

__device__ __forceinline__ void rw_prep_unit(LAS unsigned char* lds, int l, int b, int t0) {
    const int tid = opaque_tid(), lane = tid & 63, wave = __builtin_amdgcn_readfirstlane(tid >> 6);
    const bf16* P = (const bf16*)(KWS() + WS_P);
    float* SC = (float*)(KWS() + WS_SCAN2);
    LAS bf16* XL = (LAS bf16*)lds;
    LAS float* AL = (LAS float*)(lds + 32 * 264 * 2);
    const float* mu = KIN(I_RWMU) + (size_t)l * 1024;
    for (int i = tid; i < 32 * 256; i += NTHR) { const int tok = i >> 8, cc = i & 255; const int t = t0 + tok;
        const bf16* row = P + (size_t)(b * T + t) * PINP + PC_RW + 768 + cc;
        const float cur = bf2f(row[0]), prev = t > 0 ? bf2f(*(row - PINP)) : 0.f;
        float x = cur + (prev - cur) * mu[768 + cc];
        if (cc < 64) x = tanh_f(x); else if (cc >= 128) x = fast_sigmoid(x);
        XL[tok * 264 + cc] = (bf16)f2bf(x); }
    __syncthreads();
    {
        const int r32 = lane & 31, hh = lane >> 5, c = wave * 32 + r32;
        const bf16* w2T = (const bf16*)(KWS() + WS_LORA) + (size_t)l * 256 * 64 + (size_t)c * 64;
        const bf16* a2T = (const bf16*)(KWS() + WS_LORA) + (size_t)(NL * 256 * 64) + (size_t)l * 256 * 64 + (size_t)c * 64;
        const bf16* g2T = (const bf16*)(KWS() + WS_LORA) + (size_t)2 * (NL * 256 * 64) + (size_t)l * 256 * 128 + (size_t)c * 128;
        const LAS bf16* xa = XL + r32 * 264 + 8 * hh;
        {
            f32x16 acc;
#pragma unroll
            for (int i = 0; i < 16; ++i) acc[i] = 0.f;
#pragma unroll
            for (int s = 0; s < 4; ++s) { const bf16x8 A = *(const LAS bf16x8*)(xa + 16 * s); const bf16x8 Bw = *(const bf16x8*)(w2T + 16 * s + 8 * hh);
                acc = __builtin_amdgcn_mfma_f32_32x32x16_bf16(A, Bw, acc, 0, 0, 0); }
            const float w0c = KIN(I_RWW0)[l * 256 + c];
            float* dw = SC + ((size_t)(b * 4 + (c >> 6)) * T + t0) * 384 + (c & 63);
#pragma unroll
            for (int r = 0; r < 16; ++r) { const int tok = (r & 3) + 8 * (r >> 2) + 4 * hh;
                const float zw = w0c + acc[r]; const float wlog = -(fmaxf(-zw, 0.f) + log1pexp_neg_abs(zw)) - 0.5f;
                dw[(size_t)tok * 384] = -fast_exp(wlog); }
        }
        __builtin_amdgcn_sched_barrier(0);
        {
            f32x16 acc;
#pragma unroll
            for (int i = 0; i < 16; ++i) acc[i] = 0.f;
#pragma unroll
            for (int s = 0; s < 4; ++s) { const bf16x8 A = *(const LAS bf16x8*)(xa + 64 + 16 * s); const bf16x8 Bw = *(const bf16x8*)(a2T + 16 * s + 8 * hh);
                acc = __builtin_amdgcn_mfma_f32_32x32x16_bf16(A, Bw, acc, 0, 0, 0); }
            const float a0c = KIN(I_RWA0)[l * 256 + c];
#pragma unroll
            for (int r = 0; r < 16; ++r) { const int tok = (r & 3) + 8 * (r >> 2) + 4 * hh; AL[tok * 260 + c] = fast_sigmoid(a0c + acc[r]); }
        }
        __builtin_amdgcn_sched_barrier(0);
        {
            f32x16 acc;
#pragma unroll
            for (int i = 0; i < 16; ++i) acc[i] = 0.f;
#pragma unroll
            for (int s = 0; s < 8; ++s) { const bf16x8 A = *(const LAS bf16x8*)(xa + 128 + 16 * s); const bf16x8 Bw = *(const bf16x8*)(g2T + 16 * s + 8 * hh);
                acc = __builtin_amdgcn_mfma_f32_32x32x16_bf16(A, Bw, acc, 0, 0, 0); }
            bf16* gb = (bf16*)(KWS() + WS_GBUF) + (size_t)(b * T + t0) * 256 + c;
#pragma unroll
            for (int r = 0; r < 16; ++r) { const int tok = (r & 3) + 8 * (r >> 2) + 4 * hh; gb[(size_t)tok * 256] = (bf16)f2bf(acc[r]); }
        }
    }
    __syncthreads();
    {
        const int c = tid & 255, tq = tid >> 8, head = c >> 6, d = c & 63;
        const float mr = mu[c], mk = mu[256 + c], mv = mu[512 + c];
        const float kkc = KIN(I_RWKK)[l * 256 + c], kac = KIN(I_RWKA)[l * 256 + c], rkc = KIN(I_RWRK)[l * 256 + c];
        float* ds = SC + ((size_t)(b * 4 + head) * T + t0) * 384 + d; float* bonp = (float*)(KWS() + WS_BONUS);
        for (int tok = tq; tok < 32; tok += 2) { const int t = t0 + tok; const bf16* row = P + (size_t)(b * T + t) * PINP + PC_RW + c;
            float r = bf2f(row[0]), k = bf2f(row[256]), v = bf2f(row[512]);
            if (t > 0) { const bf16* pr = row - PINP; r += (bf2f(pr[0]) - r) * mr; k += (bf2f(pr[256]) - k) * mk; v += (bf2f(pr[512]) - v) * mv; }
            else { r -= r * mr; k -= k * mk; v -= v * mv; }
            const float av = AL[tok * 260 + c];
            const float kkr = k * kkc, hk = k * (1.0f + (av - 1.0f) * kac);
            const float ss = wave_sum(kkr * kkr); const float kk = kkr / fmaxf(sqrtf(ss), 1e-12f);
            const float bon = wave_sum(r * hk * rkc);
            float* o = ds + (size_t)tok * 384;
            o[64] = hk; o[128] = r; o[192] = v; o[256] = -kk; o[320] = kk * av;
            if (d == 0) bonp[(size_t)(b * T + t) * 4 + head] = bon; }
    }
    __syncthreads();
}

__device__ __forceinline__ void prep_phase(LAS unsigned char* lds, int l, int vcu, int G) {
    for (int u = vcu; u < 4096; u += G) {
        if (u < 1024) { gla_prep_unit(lds, l, u >> 7, (u & 127) * 64); }
        else if (u < 2048) { const int q = u - 1024; hg_prep_unit(l, q >> 7, (q & 127) * 64); }
        else { const int q = u - 2048; rw_prep_unit(lds, l, q >> 8, (q & 255) * 32); }
    }
}

constexpr int NCH = T / 32;
__device__ __forceinline__ int rho16(int r, int hh) { return (r & 3) + 8 * (r >> 2) + 4 * hh; }
template <int DK>
__device__ __forceinline__ void c1_gh_task(LAS unsigned char* ldsw, int lane, const float* __restrict__ rec, bf16* __restrict__ Qg, bf16* __restrict__ Kg, bf16* __restrict__ VTg, float* __restrict__ DSg, float* __restrict__ BEg) {
    constexpr int REC = 3 * DK + 64;
    LAS bf16* KT = (LAS bf16*)ldsw;
    LAS bf16* VT = (LAS bf16*)(ldsw + DK * 80);
    const int d = lane & (DK - 1); const bool act = lane < DK;
    float b = 0.f;
#pragma unroll 1
    for (int j8 = 0; j8 < 4; ++j8) {
        u32x4 kp, vp;
#pragma unroll
        for (int jj = 0; jj < 4; ++jj) { float kt2[2], vv2[2];
#pragma unroll
            for (int e = 0; e < 2; ++e) { const int j = j8 * 8 + jj * 2 + e; const float* r = rec + (size_t)j * REC;
                const float w = r[d], k = r[DK + d], q = r[2 * DK + d];
                b = fmaxf(b + w, -80.0f);
                const float qt = q * fast_exp(b), kt = k * fast_exp(-b);
                if (act) { Qg[j * DK + d] = (bf16)f2bf(qt); Kg[j * DK + d] = (bf16)f2bf(kt); }
                kt2[e] = kt; vv2[e] = r[3 * DK + lane]; }
            kp[jj] = pk2(kt2[0], kt2[1]); vp[jj] = pk2(vv2[0], vv2[1]); }
        if (act) *(LAS u32x4*)(KT + d * 40 + j8 * 8) = kp;
        *(LAS u32x4*)(VT + lane * 40 + j8 * 8) = vp; *(u32x4*)(VTg + lane * 32 + j8 * 8) = vp;
    }
    const float ebend = fast_exp(b); if (act) BEg[d] = ebend;
    LDS_WAIT(); asm volatile("" ::: "memory");
    const int r32 = lane & 31, hh = lane >> 5;
#pragma unroll
    for (int vt = 0; vt < 2; ++vt)
#pragma unroll
        for (int dt = 0; dt < DK / 32; ++dt) { f32x16 acc;
#pragma unroll
            for (int i = 0; i < 16; ++i) acc[i] = 0.f;
#pragma unroll
            for (int s = 0; s < 2; ++s) { const bf16x8 A = *(const LAS bf16x8*)(VT + (32 * vt + r32) * 40 + 16 * s + 8 * hh), B = *(const LAS bf16x8*)(KT + (32 * dt + r32) * 40 + 16 * s + 8 * hh);
                acc = __builtin_amdgcn_mfma_f32_32x32x16_bf16(A, B, acc, 0, 0, 0); }
            const float ebd = __shfl(ebend, 32 * dt + r32);
#pragma unroll
            for (int r = 0; r < 16; ++r) DSg[(32 * vt + rho16(r, hh)) * DK + 32 * dt + r32] = acc[r] * ebd; }
    LDS_WAIT(); asm volatile("" ::: "memory");
}
template <int DK>
__device__ __forceinline__ void m2_gh_elem(int e, const float* __restrict__ DS, const float* __restrict__ BE, bf16* __restrict__ SG) {
    constexpr int EPB = 64 * DK; const int bh = e / EPB, idx = e % EPB, d = idx % DK; const size_t un0 = (size_t)bh * NCH;
    float S = 0.f;
#pragma unroll 1
    for (int c0 = 0; c0 < NCH; c0 += 8) { float ds[8], be[8];
#pragma unroll
        for (int u = 0; u < 8; ++u) { ds[u] = DS[(un0 + c0 + u) * EPB + idx]; be[u] = BE[(un0 + c0 + u) * DK + d]; }
#pragma unroll
        for (int u = 0; u < 8; ++u) { SG[(un0 + c0 + u) * EPB + idx] = (bf16)f2bf(S); S = S * be[u] + ds[u]; } }
}
template <int DK>
__device__ __forceinline__ void m3_gh_task(int lane, const bf16* __restrict__ Qg, const bf16* __restrict__ Kg, const bf16* __restrict__ VTg, const bf16* __restrict__ Sg,
                                           const bf16* __restrict__ gate  , const float* __restrict__ ng  , bf16* __restrict__ orow  ) {
    const int r32 = lane & 31, hh = lane >> 5;
    bf16x8 qf[DK / 16];
    f32x16 at;
#pragma unroll
    for (int i = 0; i < 16; ++i) at[i] = 0.f;
#pragma unroll
    for (int s = 0; s < DK / 16; ++s) { qf[s] = *(const bf16x8*)(Qg + r32 * DK + 16 * s + 8 * hh); const bf16x8 kf = *(const bf16x8*)(Kg + r32 * DK + 16 * s + 8 * hh);
        at = __builtin_amdgcn_mfma_f32_32x32x16_bf16(kf, qf[s], at, 0, 0, 0); }
#pragma unroll
    for (int r = 0; r < 16; ++r) if (rho16(r, hh) > r32) at[r] = 0.f;
    f32x16 o[2];
#pragma unroll
    for (int vt = 0; vt < 2; ++vt)
#pragma unroll
        for (int i = 0; i < 16; ++i) o[vt][i] = 0.f;
#pragma unroll
    for (int s = 0; s < 2; ++s) { union { bf16x8 v; unsigned w[4]; } pf;
#pragma unroll
        for (int j = 0; j < 4; ++j) pf.w[j] = cvt_pk_bf16(at[8 * s + 2 * j], at[8 * s + 2 * j + 1]);
#pragma unroll
        for (int vt = 0; vt < 2; ++vt) { const bf16* vp = VTg + (32 * vt + r32) * 32 + 16 * s + 4 * hh;
            union { bf16x8 v; s16x4 h2[2]; } vf; vf.h2[0] = *(const s16x4*)vp; vf.h2[1] = *(const s16x4*)(vp + 8);
            o[vt] = __builtin_amdgcn_mfma_f32_32x32x16_bf16(vf.v, pf.v, o[vt], 0, 0, 0); } }
#pragma unroll
    for (int vt = 0; vt < 2; ++vt)
#pragma unroll
        for (int s = 0; s < DK / 16; ++s) { const bf16x8 sf = *(const bf16x8*)(Sg + (32 * vt + r32) * DK + 16 * s + 8 * hh);
            o[vt] = __builtin_amdgcn_mfma_f32_32x32x16_bf16(sf, qf[s], o[vt], 0, 0, 0); }
    float ss = 0.f;
#pragma unroll
    for (int vt = 0; vt < 2; ++vt)
#pragma unroll
        for (int i = 0; i < 16; ++i) ss += o[vt][i] * o[vt][i];
    ss += __shfl_xor(ss, 32);
    const float rstd = 1.0f / sqrtf(ss * (1.0f / 64.0f) + RMS_EPS);
    const bf16* grow = gate + (size_t)r32 * PINP; bf16* od = orow + (size_t)r32 * D;
#pragma unroll
    for (int vt = 0; vt < 2; ++vt)
#pragma unroll
        for (int g = 0; g < 4; ++g) { const int v0 = 32 * vt + 8 * g + 4 * hh; const u32x2 gw = *(const u32x2*)(grow + v0); const f32x4 n4 = *(const f32x4*)(ng + v0);
            const float y0 = o[vt][4 * g] * rstd * n4[0] * silu_f(bflo(gw.x)), y1 = o[vt][4 * g + 1] * rstd * n4[1] * silu_f(bfhi(gw.x));
            const float y2 = o[vt][4 * g + 2] * rstd * n4[2] * silu_f(bflo(gw.y)), y3 = o[vt][4 * g + 3] * rstd * n4[3] * silu_f(bfhi(gw.y));
            *(u32x2*)(od + v0) = (u32x2){pk2(y0, y1), pk2(y2, y3)}; }
}

constexpr int RWC_HEADB = 34816;
__device__ __forceinline__ void rw_c1_unit(LAS unsigned char* lds, int b, int c) {
    const int tid = opaque_tid(), lane = tid & 63, wave = __builtin_amdgcn_readfirstlane(tid >> 6), h = wave >> 1, p = wave & 1, r32 = lane & 31, hh = lane >> 5;
    unsigned char* ws = KWS();
    const int bh = b * 4 + h; const size_t un = (size_t)bh * NCH + c;
    const float* rec = (const float*)(ws + WS_SCAN2) + ((size_t)bh * T + c * 32) * 384;
    LAS unsigned char* L = lds + h * RWC_HEADB;
    LAS bf16* AT = (LAS bf16*)L;
    LAS bf16* BT = (LAS bf16*)(L + 4608);
    LAS bf16* KT = (LAS bf16*)(L + 9216);
    LAS bf16* ATT = (LAS bf16*)(L + 13824);
    LAS bf16* BHT = (LAS bf16*)(L + 18944);
    LAS bf16* KHT = (LAS bf16*)(L + 24064);
    LAS bf16* VT = (LAS bf16*)(L + 29184);
    LAS float* GC = (LAS float*)(L + 34304);
    LAS float* MAB = (LAS float*)(L + 4608);
    LAS bf16* MAK = (LAS bf16*)(L + 9216);
    LAS bf16* TM = (LAS bf16*)L;
    if (p == 0) {
        const int d = lane; float lg = 0.f;
        bf16* RGp = (bf16*)(ws + WS_RR) + un * 2048 + d; bf16* BGp = (bf16*)(ws + WS_RB) + un * 2048 + d; bf16* KGp = (bf16*)(ws + WS_RK) + un * 2048 + d;
#pragma unroll 1
        for (int t8 = 0; t8 < 4; ++t8) { u32x4 ap;
#pragma unroll
            for (int jj = 0; jj < 4; ++jj) { float at2[2];
#pragma unroll
                for (int e = 0; e < 2; ++e) { const int t = t8 * 8 + jj * 2 + e; const float* r = rec + (size_t)t * 384;
                    const float lw = r[d], k = r[64 + d], rr = r[128 + d], a = r[256 + d], bb = r[320 + d];
                    const float lgp = lg; lg += lw;
                    const float at = a * fast_exp(lgp), rt = rr * fast_exp(lg), ei = fast_exp(-lg), bt = bb * ei, kt = k * ei;
                    AT[t * 72 + d] = (bf16)f2bf(at); BT[t * 72 + d] = (bf16)f2bf(bt); KT[t * 72 + d] = (bf16)f2bf(kt);
                    RGp[t * 64] = (bf16)f2bf(rt); BGp[t * 64] = (bf16)f2bf(bt); KGp[t * 64] = (bf16)f2bf(kt);
                    at2[e] = at; }
                ap[jj] = pk2(at2[0], at2[1]); }
            *(LAS u32x4*)(ATT + d * 40 + t8 * 8) = ap; }
        const float lgend = lg; GC[d] = fast_exp(lgend);
        lg = 0.f;
#pragma unroll 1
        for (int t8 = 0; t8 < 4; ++t8) { u32x4 bp, kp;
#pragma unroll
            for (int jj = 0; jj < 4; ++jj) { float b2[2], k2[2];
#pragma unroll
                for (int e = 0; e < 2; ++e) { const int t = t8 * 8 + jj * 2 + e; const float* r = rec + (size_t)t * 384;
                    lg += r[d]; const float eh = fast_exp(lgend - lg); b2[e] = r[320 + d] * eh; k2[e] = r[64 + d] * eh; }
                bp[jj] = pk2(b2[0], b2[1]); kp[jj] = pk2(k2[0], k2[1]); }
            *(LAS u32x4*)(BHT + d * 40 + t8 * 8) = bp; *(LAS u32x4*)(KHT + d * 40 + t8 * 8) = kp; }
    } else {
        bf16* VTg = (bf16*)(ws + WS_RVT) + un * 2048 + lane * 32;
#pragma unroll 1
        for (int t8 = 0; t8 < 4; ++t8) { u32x4 vp;
#pragma unroll
            for (int jj = 0; jj < 4; ++jj) { const float v0 = rec[(size_t)(t8 * 8 + jj * 2) * 384 + 192 + lane], v1 = rec[(size_t)(t8 * 8 + jj * 2 + 1) * 384 + 192 + lane]; vp[jj] = pk2(v0, v1); }
            *(LAS u32x4*)(VT + lane * 40 + t8 * 8) = vp; *(u32x4*)(VTg + t8 * 8) = vp; }
    }
    __syncthreads();
    f32x16 accR[2];
    {
        f32x16 acc;
#pragma unroll
        for (int i = 0; i < 16; ++i) acc[i] = 0.f;
        const LAS bf16* Bsrc = p == 0 ? BT : KT;
#pragma unroll
        for (int s = 0; s < 4; ++s) { const bf16x8 A = *(const LAS bf16x8*)(AT + r32 * 72 + 16 * s + 8 * hh), B = *(const LAS bf16x8*)(Bsrc + r32 * 72 + 16 * s + 8 * hh);
            acc = __builtin_amdgcn_mfma_f32_32x32x16_bf16(A, B, acc, 0, 0, 0); }
        if (p == 0) {
#pragma unroll
            for (int r = 0; r < 16; ++r) { const int t = rho16(r, hh); MAB[t * 36 + r32] = (r32 < t) ? acc[r] : 0.f; }
        } else {
#pragma unroll
            for (int r = 0; r < 16; ++r) { const int t = rho16(r, hh); MAK[t * 40 + r32] = (bf16)f2bf((r32 < t) ? acc[r] : 0.f); }
        }
    }
    __syncthreads();
    if (p == 0) {
        const int cidx = r32; float tc[32];
#pragma unroll
        for (int t = 0; t < 32; ++t) { float acc0 = (t == cidx) ? 1.0f : 0.f, acc1 = 0.f;
#pragma unroll
            for (int s4 = 0; s4 < (t + 3) / 4; ++s4) { const f32x4 m4 = *(const LAS f32x4*)(MAB + t * 36 + 4 * s4);
#pragma unroll
                for (int e = 0; e < 4; ++e) { const int s = 4 * s4 + e; if (s < t) { if (e & 1) acc1 = fmaf(m4[e], tc[s], acc1); else acc0 = fmaf(m4[e], tc[s], acc0); } } }
            tc[t] = acc0 + acc1; }
#pragma unroll
        for (int t = 0; t < 32; ++t) if (hh == 0) TM[t * 40 + cidx] = (bf16)f2bf(tc[t]);
    } else {
#pragma unroll
        for (int vt = 0; vt < 2; ++vt) {
#pragma unroll
            for (int i = 0; i < 16; ++i) accR[vt][i] = 0.f;
#pragma unroll
            for (int s = 0; s < 2; ++s) { const bf16x8 A = *(const LAS bf16x8*)(MAK + r32 * 40 + 16 * s + 8 * hh), B = *(const LAS bf16x8*)(VT + (32 * vt + r32) * 40 + 16 * s + 8 * hh);
                accR[vt] = __builtin_amdgcn_mfma_f32_32x32x16_bf16(A, B, accR[vt], 0, 0, 0); } }
    }
    __syncthreads();
    if (p == 0) {
        f32x16 accW[2];
#pragma unroll
        for (int dt = 0; dt < 2; ++dt) {
#pragma unroll
            for (int i = 0; i < 16; ++i) accW[dt][i] = 0.f;
#pragma unroll
            for (int s = 0; s < 2; ++s) { const bf16x8 A = *(const LAS bf16x8*)(TM + r32 * 40 + 16 * s + 8 * hh), B = *(const LAS bf16x8*)(ATT + (32 * dt + r32) * 40 + 16 * s + 8 * hh);
                accW[dt] = __builtin_amdgcn_mfma_f32_32x32x16_bf16(A, B, accW[dt], 0, 0, 0); } }
        bf16* WGp = (bf16*)(ws + WS_RW) + un * 2048;
#pragma unroll
        for (int dt = 0; dt < 2; ++dt)
#pragma unroll
            for (int r = 0; r < 16; ++r) WGp[rho16(r, hh) * 64 + 32 * dt + r32] = (bf16)f2bf(accW[dt][r]);
        bf16* PFp = (bf16*)(ws + WS_RP) + un * 4096;
        const int xs = r32 >> 4, xx = r32 & 15, hhA = (xx >> 2) & 1, jA = 4 * (xx >> 3) + (xx & 3);
#pragma unroll
        for (int dt = 0; dt < 2; ++dt)
#pragma unroll
            for (int dt2 = 0; dt2 < 2; ++dt2) { f32x16 acc;
#pragma unroll
                for (int i = 0; i < 16; ++i) acc[i] = 0.f;
#pragma unroll
                for (int s = 0; s < 2; ++s) { const LAS bf16* bp = BHT + (32 * dt + r32) * 40 + 16 * s + 4 * hh;
                    union { bf16x8 v; s16x4 h2[2]; } af; af.h2[0] = *(const LAS s16x4*)bp; af.h2[1] = *(const LAS s16x4*)(bp + 8);
                    union { bf16x8 v; unsigned w[4]; } bf;
#pragma unroll
                    for (int j = 0; j < 4; ++j) bf.w[j] = cvt_pk_bf16(accW[dt2][8 * s + 2 * j], accW[dt2][8 * s + 2 * j + 1]);
                    acc = __builtin_amdgcn_mfma_f32_32x32x16_bf16(af.v, bf.v, acc, 0, 0, 0); }
                if (dt == dt2) { const float gc = GC[32 * dt + r32];
#pragma unroll
                    for (int r = 0; r < 16; ++r) if (rho16(r, hh) == r32) acc[r] += gc; }
                bf16* pf = PFp + ((size_t)((dt * 2 + dt2) * 2 + xs) * 64 + 32 * hhA) * 8 + jA;
#pragma unroll
                for (int r = 0; r < 16; ++r) pf[rho16(r, hh) * 8] = (bf16)f2bf(acc[r]); }
    } else {
        f32x16 accU[2];
#pragma unroll
        for (int vt = 0; vt < 2; ++vt) {
#pragma unroll
            for (int i = 0; i < 16; ++i) accU[vt][i] = 0.f;
#pragma unroll
            for (int s = 0; s < 2; ++s) { const LAS bf16* tp = TM + r32 * 40 + 16 * s + 4 * hh;
                union { bf16x8 v; s16x4 h2[2]; } af; af.h2[0] = *(const LAS s16x4*)tp; af.h2[1] = *(const LAS s16x4*)(tp + 8);
                union { bf16x8 v; unsigned w[4]; } bf;
#pragma unroll
                for (int j = 0; j < 4; ++j) bf.w[j] = cvt_pk_bf16(accR[vt][8 * s + 2 * j], accR[vt][8 * s + 2 * j + 1]);
                accU[vt] = __builtin_amdgcn_mfma_f32_32x32x16_bf16(af.v, bf.v, accU[vt], 0, 0, 0); } }
        float* UGp = (float*)(ws + WS_RU) + un * 2048;
#pragma unroll
        for (int vt = 0; vt < 2; ++vt)
#pragma unroll
            for (int g = 0; g < 4; ++g) *(f32x4*)(UGp + ((vt * 4 + g) * 64 + lane) * 4) = (f32x4){accU[vt][4 * g], accU[vt][4 * g + 1], accU[vt][4 * g + 2], accU[vt][4 * g + 3]};
        float* QFp = (float*)(ws + WS_RQ) + un * 4096;
#pragma unroll
        for (int vt = 0; vt < 2; ++vt)
#pragma unroll
            for (int dt = 0; dt < 2; ++dt) { f32x16 acc;
#pragma unroll
                for (int i = 0; i < 16; ++i) acc[i] = 0.f;
#pragma unroll
                for (int s = 0; s < 2; ++s) { const LAS bf16* bp = BHT + (32 * dt + r32) * 40 + 16 * s + 4 * hh;
                    union { bf16x8 v; s16x4 h2[2]; } af; af.h2[0] = *(const LAS s16x4*)bp; af.h2[1] = *(const LAS s16x4*)(bp + 8);
                    union { bf16x8 v; unsigned w[4]; } bf;
#pragma unroll
                    for (int j = 0; j < 4; ++j) bf.w[j] = cvt_pk_bf16(accU[vt][8 * s + 2 * j], accU[vt][8 * s + 2 * j + 1]);
                    acc = __builtin_amdgcn_mfma_f32_32x32x16_bf16(af.v, bf.v, acc, 0, 0, 0);
                    const bf16x8 A2 = *(const LAS bf16x8*)(KHT + (32 * dt + r32) * 40 + 16 * s + 8 * hh), B2 = *(const LAS bf16x8*)(VT + (32 * vt + r32) * 40 + 16 * s + 8 * hh);
                    acc = __builtin_amdgcn_mfma_f32_32x32x16_bf16(A2, B2, acc, 0, 0, 0); }
#pragma unroll
                for (int g = 0; g < 4; ++g) *(f32x4*)(QFp + (((vt * 2 + dt) * 4 + g) * 64 + lane) * 4) = (f32x4){acc[4 * g], acc[4 * g + 1], acc[4 * g + 2], acc[4 * g + 3]}; }
    }
    __syncthreads();
}
__device__ __forceinline__ void rw_m2_wave(int lane, int bh, int vt) {
    unsigned char* ws = KWS();
    const bf16* PF = (const bf16*)(ws + WS_RP) + (size_t)bh * NCH * 4096 + lane * 8;
    const float* QF = (const float*)(ws + WS_RQ) + (size_t)bh * NCH * 4096 + (size_t)vt * 2048 + lane * 4;
    bf16* SG = (bf16*)(ws + WS_RS) + (size_t)bh * NCH * 4096 + (size_t)vt * 2048 + lane * 8;
    f32x16 S[2];
#pragma unroll
    for (int dt = 0; dt < 2; ++dt)
#pragma unroll
        for (int i = 0; i < 16; ++i) S[dt][i] = 0.f;
    bf16x8 pA[8], pB[8]; f32x4 qA[8], qB[8];
#define RWM2_LOAD(P_, Q_, c_) do { const int _c = (c_) < NCH ? (c_) : NCH - 1; _Pragma("unroll") for (int f = 0; f < 8; ++f) { P_[f] = *(const bf16x8*)(PF + (size_t)_c * 4096 + f * 512); Q_[f] = *(const f32x4*)(QF + (size_t)_c * 4096 + f * 256); } } while (0)
#define RWM2_STEP(P_, Q_, c_) do { \
        union { bf16x8 v; unsigned w[4]; } sb[2][2]; \
        _Pragma("unroll") for (int dt2 = 0; dt2 < 2; ++dt2) _Pragma("unroll") for (int s = 0; s < 2; ++s) { \
            _Pragma("unroll") for (int j = 0; j < 4; ++j) sb[dt2][s].w[j] = cvt_pk_bf16(S[dt2][8 * s + 2 * j], S[dt2][8 * s + 2 * j + 1]); \
            *(bf16x8*)(SG + (size_t)(c_) * 4096 + (dt2 * 2 + s) * 512) = sb[dt2][s].v; } \
        f32x16 N[2]; \
        _Pragma("unroll") for (int dt = 0; dt < 2; ++dt) { \
            _Pragma("unroll") for (int g = 0; g < 4; ++g) { N[dt][4 * g] = Q_[dt * 4 + g][0]; N[dt][4 * g + 1] = Q_[dt * 4 + g][1]; N[dt][4 * g + 2] = Q_[dt * 4 + g][2]; N[dt][4 * g + 3] = Q_[dt * 4 + g][3]; } \
            _Pragma("unroll") for (int dt2 = 0; dt2 < 2; ++dt2) _Pragma("unroll") for (int s = 0; s < 2; ++s) N[dt] = __builtin_amdgcn_mfma_f32_32x32x16_bf16(P_[(dt * 2 + dt2) * 2 + s], sb[dt2][s].v, N[dt], 0, 0, 0); } \
        S[0] = N[0]; S[1] = N[1]; } while (0)
    RWM2_LOAD(pA, qA, 0); RWM2_LOAD(pB, qB, 1);
#pragma unroll 1
    for (int c = 0; c < NCH; c += 2) {
        RWM2_STEP(pA, qA, c); RWM2_LOAD(pA, qA, c + 2);
        RWM2_STEP(pB, qB, c + 1); RWM2_LOAD(pB, qB, c + 3);
    }
#undef RWM2_LOAD
#undef RWM2_STEP
}
__device__ __forceinline__ bf16x8 ld_perm8(const bf16* p) { union { bf16x8 v; s16x4 h2[2]; } f; f.h2[0] = *(const s16x4*)p; f.h2[1] = *(const s16x4*)(p + 8); return f.v; }
__device__ __forceinline__ void rw_m3_task(int lane, int l, int bh, int c) {
    unsigned char* ws = KWS();
    const int r32 = lane & 31, hh = lane >> 5, b = bh >> 2, h = bh & 3; const size_t un = (size_t)bh * NCH + c; const size_t tok0 = (size_t)b * T + c * 32;
    const bf16* RGp = (const bf16*)(ws + WS_RR) + un * 2048 + r32 * 64 + 4 * hh; const bf16* BGp = (const bf16*)(ws + WS_RB) + un * 2048 + r32 * 64 + 4 * hh;
    const bf16* KGp = (const bf16*)(ws + WS_RK) + un * 2048 + r32 * 64 + 4 * hh; const bf16* WGp = (const bf16*)(ws + WS_RW) + un * 2048 + r32 * 64 + 4 * hh;
    const bf16* SGp = (const bf16*)(ws + WS_RS) + un * 4096 + lane * 8; const bf16* VTp = (const bf16*)(ws + WS_RVT) + un * 2048 + r32 * 32 + 4 * hh;
    const float* UGp = (const float*)(ws + WS_RU) + un * 2048 + lane * 4;
    f32x16 U[2], Y[2], mb, mk;
#pragma unroll
    for (int vt = 0; vt < 2; ++vt)
#pragma unroll
        for (int g = 0; g < 4; ++g) { const f32x4 u4 = *(const f32x4*)(UGp + (vt * 4 + g) * 256); U[vt][4 * g] = u4[0]; U[vt][4 * g + 1] = u4[1]; U[vt][4 * g + 2] = u4[2]; U[vt][4 * g + 3] = u4[3]; }
#pragma unroll
    for (int i = 0; i < 16; ++i) { mb[i] = 0.f; mk[i] = 0.f; Y[0][i] = 0.f; Y[1][i] = 0.f; }
#pragma unroll
    for (int ks = 0; ks < 4; ++ks) {
        const bf16x8 rf = ld_perm8(RGp + 16 * ks), wf = ld_perm8(WGp + 16 * ks), bfr = ld_perm8(BGp + 16 * ks), kfr = ld_perm8(KGp + 16 * ks);
        const bf16x8 s0 = *(const bf16x8*)(SGp + ks * 512), s1 = *(const bf16x8*)(SGp + 2048 + ks * 512);
        U[0] = __builtin_amdgcn_mfma_f32_32x32x16_bf16(wf, s0, U[0], 0, 0, 0); U[1] = __builtin_amdgcn_mfma_f32_32x32x16_bf16(wf, s1, U[1], 0, 0, 0);
        mb = __builtin_amdgcn_mfma_f32_32x32x16_bf16(bfr, rf, mb, 0, 0, 0); mk = __builtin_amdgcn_mfma_f32_32x32x16_bf16(kfr, rf, mk, 0, 0, 0);
        Y[0] = __builtin_amdgcn_mfma_f32_32x32x16_bf16(s0, rf, Y[0], 0, 0, 0); Y[1] = __builtin_amdgcn_mfma_f32_32x32x16_bf16(s1, rf, Y[1], 0, 0, 0); }
#pragma unroll
    for (int r = 0; r < 16; ++r) if (rho16(r, hh) > r32) { mb[r] = 0.f; mk[r] = 0.f; }
#pragma unroll
    for (int s = 0; s < 2; ++s) { union { bf16x8 v; unsigned w[4]; } fb, fk;
#pragma unroll
        for (int j = 0; j < 4; ++j) { fb.w[j] = cvt_pk_bf16(mb[8 * s + 2 * j], mb[8 * s + 2 * j + 1]); fk.w[j] = cvt_pk_bf16(mk[8 * s + 2 * j], mk[8 * s + 2 * j + 1]); }
#pragma unroll
        for (int vt = 0; vt < 2; ++vt) { union { bf16x8 v; unsigned w[4]; } fu;
#pragma unroll
            for (int j = 0; j < 4; ++j) fu.w[j] = cvt_pk_bf16(U[vt][8 * s + 2 * j], U[vt][8 * s + 2 * j + 1]);
            Y[vt] = __builtin_amdgcn_mfma_f32_32x32x16_bf16(fu.v, fb.v, Y[vt], 0, 0, 0);
            const bf16* vp = VTp + (size_t)vt * 32 * 32 + 16 * s;
            union { bf16x8 v; s16x4 h2[2]; } vf; vf.h2[0] = *(const s16x4*)vp; vf.h2[1] = *(const s16x4*)(vp + 8);
            Y[vt] = __builtin_amdgcn_mfma_f32_32x32x16_bf16(vf.v, fk.v, Y[vt], 0, 0, 0); } }
    float sm = 0.f;
#pragma unroll
    for (int vt = 0; vt < 2; ++vt)
#pragma unroll
        for (int i = 0; i < 16; ++i) sm += Y[vt][i];
    sm += __shfl_xor(sm, 32); const float mu = sm * (1.0f / 64.0f);
    float q = 0.f;
#pragma unroll
    for (int vt = 0; vt < 2; ++vt)
#pragma unroll
        for (int i = 0; i < 16; ++i) { const float dd = Y[vt][i] - mu; q += dd * dd; }
    q += __shfl_xor(q, 32); const float rstd = 1.0f / sqrtf(q * (1.0f / 64.0f) + RW_LN_EPS);
    const size_t tok = tok0 + r32;
    const float bon = ((const float*)(ws + WS_BONUS))[tok * 4 + h];
    const float* vrec = (const float*)(ws + WS_SCAN2) + ((size_t)bh * T + c * 32 + r32) * 384 + 192;
    const bf16* gp = (const bf16*)(ws + WS_GBUF) + tok * 256 + h * 64; bf16* od = (bf16*)(ws + WS_O) + tok * D + 512 + h * 64;
    const float* lnw = KIN(I_RWLNW) + l * 256 + h * 64; const float* lnb = KIN(I_RWLNB) + l * 256 + h * 64;
#pragma unroll
    for (int vt = 0; vt < 2; ++vt)
#pragma unroll
        for (int g = 0; g < 4; ++g) { const int v0 = 32 * vt + 8 * g + 4 * hh; const f32x4 w4 = *(const f32x4*)(lnw + v0), b4 = *(const f32x4*)(lnb + v0), vv = *(const f32x4*)(vrec + v0); const u32x2 gw = *(const u32x2*)(gp + v0);
            const float y0 = ((Y[vt][4 * g] - mu) * rstd * w4[0] + b4[0] + bon * vv[0]) * bflo(gw.x), y1 = ((Y[vt][4 * g + 1] - mu) * rstd * w4[1] + b4[1] + bon * vv[1]) * bfhi(gw.x);
            const float y2 = ((Y[vt][4 * g + 2] - mu) * rstd * w4[2] + b4[2] + bon * vv[2]) * bflo(gw.y), y3 = ((Y[vt][4 * g + 3] - mu) * rstd * w4[3] + b4[3] + bon * vv[3]) * bfhi(gw.y);
            *(u32x2*)(od + v0) = (u32x2){pk2(y0, y1), pk2(y2, y3)}; }
}

__device__ __forceinline__ void c1_phase(LAS unsigned char* lds, int vcu, int G) {
    const int tid = opaque_tid(), lane = tid & 63, wave = __builtin_amdgcn_readfirstlane(tid >> 6);
    LAS unsigned char* ldsw = lds + wave * 16384;
    unsigned char* ws = KWS();
    const int gw = vcu * NWAVES + wave, NGW = G * NWAVES;
    for (int u = vcu; u < NB * NCH; u += G) rw_c1_unit(lds, u >> 8, u & 255);
    for (int task = gw; task < 16384; task += NGW) {
        const int un = task & 8191, bh = un >> 8, c = un & 255;
        if (task < 8192) c1_gh_task<64>(ldsw, lane, (const float*)(ws + WS_SCAN1) + ((size_t)bh * T + c * 32) * 256, (bf16*)(ws + WS_HQ) + (size_t)un * 2048, (bf16*)(ws + WS_HK) + (size_t)un * 2048,
                                          (bf16*)(ws + WS_HVT) + (size_t)un * 2048, (float*)(ws + WS_HDS) + (size_t)un * 4096, (float*)(ws + WS_HBE) + (size_t)un * 64);
        else c1_gh_task<32>(ldsw, lane, (const float*)(ws + WS_SCAN0) + ((size_t)bh * T + c * 32) * 160, (bf16*)(ws + WS_GQ) + (size_t)un * 1024, (bf16*)(ws + WS_GK) + (size_t)un * 1024,
                            (bf16*)(ws + WS_GVT) + (size_t)un * 2048, (float*)(ws + WS_GDS) + (size_t)un * 2048, (float*)(ws + WS_GBE) + (size_t)un * 32);
    }
}
__device__ __forceinline__ void m3_gh_phase(int l, int vcu, int G) {
    const int tid = opaque_tid(), lane = tid & 63, wave = __builtin_amdgcn_readfirstlane(tid >> 6);
    unsigned char* ws = KWS();
    const int gw = vcu * NWAVES + wave, NGW = G * NWAVES;
    const bf16* P = (const bf16*)(ws + WS_P); bf16* O = (bf16*)(ws + WS_O);
    const float* gng = KIN(I_GLANG) + l * 256; const float* hng = KIN(I_HGNG) + l * 256;
    for (int task = gw; task < 24576; task += NGW) {
        const int un = task & 8191, bh = un >> 8, c = un & 255, b = bh >> 2, h = bh & 3; const size_t tok0 = (size_t)b * T + c * 32;
        if (task >= 16384) { rw_m3_task(lane, l, bh, c); continue; }
        if (task < 8192) m3_gh_task<64>(lane, (const bf16*)(ws + WS_HQ) + (size_t)un * 2048, (const bf16*)(ws + WS_HK) + (size_t)un * 2048, (const bf16*)(ws + WS_HVT) + (size_t)un * 2048, (const bf16*)(ws + WS_HS) + (size_t)un * 4096,
                                         P + tok0 * PINP + PC_HG + h * 64, hng + h * 64, O + tok0 * D + 256 + h * 64);
        else m3_gh_task<32>(lane, (const bf16*)(ws + WS_GQ) + (size_t)un * 1024, (const bf16*)(ws + WS_GK) + (size_t)un * 1024, (const bf16*)(ws + WS_GVT) + (size_t)un * 2048, (const bf16*)(ws + WS_GS) + (size_t)un * 2048,
                            P + tok0 * PINP + PC_GOUT + h * 64, gng + h * 64, O + tok0 * D + h * 64);
    }
}

__device__ __forceinline__ void xattn_units(LAS unsigned char* lds, int l, int first, int last, int stride) {
    const int tid = opaque_tid(), lane = tid & 63, wave = __builtin_amdgcn_readfirstlane(tid >> 6), r32 = lane & 31, hh = lane >> 5;
    const bf16* P = (const bf16*)(KWS() + WS_P); const bf16* MKV = (const bf16*)(KWS() + WS_MKV); bf16* O = (bf16*)(KWS() + WS_O);
    LAS bf16* KL = (LAS bf16*)lds;
    LAS bf16* VT = (LAS bf16*)(lds + 256 * 72 * 2);
    int cur_bh = -1;
    for (int u = first; u < last; u += stride) {
        const int bh = u >> 5, qb = u & 31, b = bh >> 2, h = bh & 3;
        if (bh != cur_bh) {
            __syncthreads();
            for (int i = tid; i < 256 * 8; i += NTHR) { const int key = i >> 3, c8 = i & 7;
                const bf16* src = MKV + (size_t)(b * 256 + key) * 2048 + l * 512 + h * 64 + c8 * 8;
                *(LAS u32x4*)(KL + key * 72 + c8 * 8) = *(const u32x4*)src;
                const u32x4 vv = *(const u32x4*)(src + 256);
                LAS bf16* vd = VT + (c8 * 8) * 264 + key;
                vd[0 * 264] = (bf16)(vv.x & 0xffff); vd[1 * 264] = (bf16)(vv.x >> 16); vd[2 * 264] = (bf16)(vv.y & 0xffff); vd[3 * 264] = (bf16)(vv.y >> 16);
                vd[4 * 264] = (bf16)(vv.z & 0xffff); vd[5 * 264] = (bf16)(vv.z >> 16); vd[6 * 264] = (bf16)(vv.w & 0xffff); vd[7 * 264] = (bf16)(vv.w >> 16); }
            __syncthreads();
            cur_bh = bh;
        }
        const int q = b * T + qb * 256 + wave * 32 + r32;
        bf16x8 qf[4];
#pragma unroll
        for (int s = 0; s < 4; ++s) qf[s] = *(const bf16x8*)(P + (size_t)q * PINP + PC_MQ + h * 64 + 16 * s + 8 * hh);
        f32x16 sc[8];
#pragma unroll
        for (int kt = 0; kt < 8; ++kt) {
#pragma unroll
            for (int i = 0; i < 16; ++i) sc[kt][i] = 0.f;
#pragma unroll
            for (int s = 0; s < 4; ++s) { const bf16x8 kf = *(const LAS bf16x8*)(KL + (kt * 32 + r32) * 72 + 16 * s + 8 * hh);
                sc[kt] = __builtin_amdgcn_mfma_f32_32x32x16_bf16(kf, qf[s], sc[kt], 0, 0, 0); }
        }
        float m = -3.0e38f;
#pragma unroll
        for (int kt = 0; kt < 8; ++kt)
#pragma unroll
            for (int i = 0; i < 16; ++i) m = fmaxf(m, sc[kt][i]);
        m = fmaxf(m, __shfl_xor(m, 32));
        float sum = 0.f;
        const float c2 = 0.125f * 1.4426950408889634f;
#pragma unroll
        for (int kt = 0; kt < 8; ++kt)
#pragma unroll
            for (int i = 0; i < 16; ++i) { const float e = __builtin_amdgcn_exp2f((sc[kt][i] - m) * c2); sc[kt][i] = e; sum += e; }
        sum += __shfl_xor(sum, 32);
        const float inv = 1.0f / sum;
        f32x16 oa[2];
#pragma unroll
        for (int vt = 0; vt < 2; ++vt)
#pragma unroll
            for (int i = 0; i < 16; ++i) oa[vt][i] = 0.f;
#pragma unroll
        for (int kt = 0; kt < 8; ++kt)
#pragma unroll
            for (int s = 0; s < 2; ++s) {
                union { bf16x8 v; unsigned w[4]; } pf;
#pragma unroll
                for (int j = 0; j < 4; ++j) pf.w[j] = cvt_pk_bf16(sc[kt][8 * s + 2 * j], sc[kt][8 * s + 2 * j + 1]);
#pragma unroll
                for (int vt = 0; vt < 2; ++vt) {
                    const LAS bf16* vp = VT + (vt * 32 + r32) * 264 + kt * 32 + 16 * s + 4 * hh;
                    union { bf16x8 v; s16x4 h2[2]; } vf; vf.h2[0] = *(const LAS s16x4*)vp; vf.h2[1] = *(const LAS s16x4*)(vp + 8);
                    oa[vt] = __builtin_amdgcn_mfma_f32_32x32x16_bf16(vf.v, pf.v, oa[vt], 0, 0, 0); }
            }
        bf16* orow = O + (size_t)q * D + 768 + h * 64;
#pragma unroll
        for (int vt = 0; vt < 2; ++vt)
#pragma unroll
            for (int g = 0; g < 4; ++g) { u32x2 w; w.x = cvt_pk_bf16(oa[vt][4 * g] * inv, oa[vt][4 * g + 1] * inv); w.y = cvt_pk_bf16(oa[vt][4 * g + 2] * inv, oa[vt][4 * g + 3] * inv);
                *(u32x2*)(orow + vt * 32 + 8 * g + 4 * hh) = w; }
    }
    __syncthreads();
}

__device__ __forceinline__ void m2_phase(LAS unsigned char* lds, int l, int bx, int G) {
    unsigned char* ws = KWS();
    const int tid = opaque_tid(), lane = tid & 63, wave = __builtin_amdgcn_readfirstlane(tid >> 6);
    const int nrw = (G >= 128) ? 64 : 0;
    if (nrw) { if (bx < nrw && wave == 0) rw_m2_wave(lane, bx >> 1, bx & 1); }
    else { for (int q = bx * NWAVES + wave; q < 64; q += G * NWAVES) rw_m2_wave(lane, q >> 1, q & 1); }
    if (!(nrw && bx < nrw && wave == 0)) {
        const int nth = nrw ? (nrw * 448 + (G - nrw) * NTHR) : G * NTHR;
        const int gt = nrw ? (bx < nrw ? bx * 448 + (tid - 64) : nrw * 448 + (bx - nrw) * NTHR + tid) : bx * NTHR + tid;
        for (int e = gt; e < 196608; e += nth) {
            if (e < 131072) m2_gh_elem<64>(e, (const float*)(ws + WS_HDS), (const float*)(ws + WS_HBE), (bf16*)(ws + WS_HS));
            else m2_gh_elem<32>(e - 131072, (const float*)(ws + WS_GDS), (const float*)(ws + WS_GBE), (bf16*)(ws + WS_GS)); }
    }
    if (nrw == 0 || bx >= nrw) {
        const int nb = G - nrw, r = bx - nrw;
        const int per = (1024 + nb - 1) / nb, lo = r * per, hi = (lo + per < 1024) ? lo + per : 1024;
        xattn_units(lds, l, lo, hi, 1);
    }
}

__device__ __forceinline__ void ln1_router_phase(LAS unsigned char* lds, int l, int bx, int G) {
    const int tid = opaque_tid(), lane = tid & 63, wave = __builtin_amdgcn_readfirstlane(tid >> 6);
    LAS float* X = (LAS float*)lds;
    LAS float* PART = (LAS float*)(lds + 16 * 1028 * 4);
    LAS int* HIST = (LAS int*)(lds + 16 * 1028 * 4 + 8 * 16 * 32 * 4);
    const float* xin = (l == 0) ? KIN(I_X) : (const float*)(KWS() + WS_XF);
    const bf16* HM = (const bf16*)(KWS() + WS_HMIX);
    float* X1F = (float*)(KWS() + WS_X1F); bf16* X1B = (bf16*)(KWS() + WS_X1B);
    const float* g1 = KIN(I_LN1G) + l * D; const float* b1 = KIN(I_LN1B) + l * D;
    const float* rw = KIN(I_RTW) + (size_t)l * D * NE; const float* rb = KIN(I_RTB) + l * NE;
    int* tok_e = (int*)(KWS() + WS_ROUTE); float* tok_g = (float*)(KWS() + WS_ROUTE + 1 * MiB);
    if (tid < 32) HIST[tid] = 0;
    float rwB[2][32];
    { const int q = lane >> 4, e = lane & 15;
#pragma unroll
      for (int s = 0; s < 32; ++s) { const float* p = rw + (size_t)(128 * wave + 32 * q + s) * NE + e; rwB[0][s] = p[0]; rwB[1][s] = p[16]; } }
    __syncthreads();
    for (int it = bx; it < NTOK / 16; it += G) {
#pragma unroll
        for (int tt = 0; tt < 2; ++tt) { const int ti = wave * 2 + tt; const size_t tok = (size_t)it * 16 + ti;
            const f32x4* xr = (const f32x4*)(xin + tok * D) + lane; const u32x2* hr = (const u32x2*)(HM + tok * D) + lane;
            f32x4 v[4]; float s = 0.f;
#pragma unroll
            for (int j = 0; j < 4; ++j) { const f32x4 xv = xr[64 * j]; const u32x2 hw = hr[64 * j];
                v[j][0] = DN_ALPHA * xv[0] + bflo(hw.x); v[j][1] = DN_ALPHA * xv[1] + bfhi(hw.x); v[j][2] = DN_ALPHA * xv[2] + bflo(hw.y); v[j][3] = DN_ALPHA * xv[3] + bfhi(hw.y);
                s += (v[j][0] + v[j][1]) + (v[j][2] + v[j][3]); }
            const float mean = wave_sum(s) * (1.0f / D); float s2 = 0.f;
#pragma unroll
            for (int j = 0; j < 4; ++j) { v[j] = v[j] - mean; s2 += (v[j][0] * v[j][0] + v[j][1] * v[j][1]) + (v[j][2] * v[j][2] + v[j][3] * v[j][3]); }
            const float rstd = 1.0f / sqrtf(wave_sum(s2) * (1.0f / D) + LN_EPS);
#pragma unroll
            for (int j = 0; j < 4; ++j) { const f32x4 gg = *((const f32x4*)g1 + lane + 64 * j), bb = *((const f32x4*)b1 + lane + 64 * j);
                const f32x4 y = v[j] * rstd * gg + bb;
                *((f32x4*)(X1F + tok * D) + lane + 64 * j) = y;
                *((u32x2*)(X1B + tok * D) + lane + 64 * j) = (u32x2){pk2(y[0], y[1]), pk2(y[2], y[3])};
                *(LAS f32x4*)(X + ti * 1028 + 4 * lane + 256 * j) = y; }
        }
        __syncthreads();
        {
            const int q = lane >> 4, r = lane & 15;
            f32x4 acc0 = (f32x4){0.f, 0.f, 0.f, 0.f}, acc1 = (f32x4){0.f, 0.f, 0.f, 0.f};
            const LAS float* xa = X + r * 1028 + 128 * wave + 32 * q;
#pragma unroll
            for (int s4 = 0; s4 < 8; ++s4) { const f32x4 av = *(const LAS f32x4*)(xa + 4 * s4);
#pragma unroll
                for (int j = 0; j < 4; ++j) { acc0 = __builtin_amdgcn_mfma_f32_16x16x4f32(av[j], rwB[0][4 * s4 + j], acc0, 0, 0, 0); acc1 = __builtin_amdgcn_mfma_f32_16x16x4f32(av[j], rwB[1][4 * s4 + j], acc1, 0, 0, 0); } }
#pragma unroll
            for (int i = 0; i < 4; ++i) { PART[(wave * 16 + 4 * q + i) * 32 + r] = acc0[i]; PART[(wave * 16 + 4 * q + i) * 32 + 16 + r] = acc1[i]; }
        }
        __syncthreads();
        {
            const int ti = tid >> 5, e = tid & 31;
            float lg = rb[e];
#pragma unroll
            for (int w = 0; w < 8; ++w) lg += PART[(w * 16 + ti) * 32 + e];
            float tv[4]; int te[4]; float cur = lg;
#pragma unroll
            for (int k = 0; k < 4; ++k) { float bv = cur; int bi = e;
#pragma unroll
                for (int o = 16; o >= 1; o >>= 1) { const float ov = __shfl_xor(bv, o); const int oi = __shfl_xor(bi, o); if (ov > bv || (ov == bv && oi < bi)) { bv = ov; bi = oi; } }
                tv[k] = bv; te[k] = bi; if (e == bi) cur = -3.0e38f; }
            const float e1 = __expf(tv[1] - tv[0]), e2 = __expf(tv[2] - tv[0]), e3 = __expf(tv[3] - tv[0]); const float inv = 1.0f / (1.0f + e1 + e2 + e3);
            const size_t tok = (size_t)it * 16 + ti;
            if (e < 4) { const int ek = e == 0 ? te[0] : e == 1 ? te[1] : e == 2 ? te[2] : te[3]; const float gk = (e == 0 ? 1.0f : e == 1 ? e1 : e == 2 ? e2 : e3) * inv;
                tok_e[tok * 4 + e] = ek; tok_g[tok * 4 + e] = gk; __hip_atomic_fetch_add(&HIST[ek], 1, __ATOMIC_RELAXED, __HIP_MEMORY_SCOPE_WORKGROUP); }
        }
        __syncthreads();
    }
    __syncthreads();
    if (tid < 32) ((int*)(KWS() + WS_CTL))[CW_HIST + bx * 32 + tid] = HIST[tid];
}

__device__ __forceinline__ void slots_phase(LAS unsigned char* lds, int bx, int G) {
    const int tid = opaque_tid();
    int* ctl = (int*)(KWS() + WS_CTL);
    LAS int* RED = (LAS int*)lds;
    LAS int* TOT = RED + 1024;
    const int* tok_e = (const int*)(KWS() + WS_ROUTE); const float* tok_g = (const float*)(KWS() + WS_ROUTE + 1 * MiB);
    int* tok_slot = (int*)(KWS() + WS_ROUTE + 2 * MiB); int* slot_tok = (int*)(KWS() + WS_ROUTE + 3 * MiB); float* slot_gate = (float*)(KWS() + WS_ROUTE + 3 * MiB + 1536 * 1024);
    { const int e = tid & 31, part = tid >> 5; int tot = 0, pre = 0;
      for (int b2 = part; b2 < G; b2 += 16) { const int h = ctl[CW_HIST + b2 * 32 + e]; tot += h; if (b2 < bx) pre += h; }
      RED[(part * 32 + e) * 2] = tot; RED[(part * 32 + e) * 2 + 1] = pre; }
    __syncthreads();
    if (tid < 32) { int tot = 0, pre = 0; for (int p = 0; p < 16; ++p) { tot += RED[(p * 32 + tid) * 2]; pre += RED[(p * 32 + tid) * 2 + 1]; } TOT[tid] = tot; TOT[32 + tid] = pre; TOT[96 + tid] = 0; }
    __syncthreads();
    if (tid == 0) { int ps = 0;
#pragma unroll 1
        for (int e = 0; e < 32; ++e) { TOT[64 + e] = ps; ps += (TOT[e] + 255) & ~255; }
        TOT[128] = ps >> 8; if (bx == 0) ctl[CW_NT] = ps >> 8; }
    __syncthreads();
    if (bx == 0) { const int nt = TOT[128];
        for (int t = tid; t < nt; t += NTHR) { int e = 0;
#pragma unroll 1
            for (int k = 1; k < 32; ++k) if (TOT[64 + k] <= t * 256) e = k;
            ctl[CW_TILEE + t] = e; } }
    for (int e = bx; e < 32; e += G) { const int s0 = TOT[64 + e] + TOT[e], s1 = TOT[64 + e] + ((TOT[e] + 255) & ~255); for (int s = s0 + tid; s < s1; s += NTHR) { slot_tok[s] = 0; slot_gate[s] = 0.f; } }
    for (int it = bx; it < NTOK / 16; it += G) {
        if (tid < 64) { const int asg = it * 64 + tid; const int e = tok_e[asg]; const int rank = __hip_atomic_fetch_add(&TOT[96 + e], 1, __ATOMIC_RELAXED, __HIP_MEMORY_SCOPE_WORKGROUP); const int slot = TOT[64 + e] + TOT[32 + e] + rank;
            tok_slot[asg] = slot; slot_tok[slot] = asg >> 2; slot_gate[slot] = tok_g[asg]; }
    }
}

__device__ __forceinline__ void combine_phase(int l, int vcu, int G) {
    const int tid = opaque_tid(), lane = tid & 63, wave = __builtin_amdgcn_readfirstlane(tid >> 6);
    const int gw = vcu * NWAVES + wave, NGW = G * NWAVES;
    const float* X1F = (const float*)(KWS() + WS_X1F); const bf16* YB = (const bf16*)(KWS() + WS_YB); const int* tok_slot = (const int*)(KWS() + WS_ROUTE + 2 * MiB);
    float* xo = (l == NL - 1) ? KOUT() : (float*)(KWS() + WS_XF); bf16* XB = (bf16*)(KWS() + WS_XB);
    const float* g2 = KIN(I_LN2G) + l * D; const float* b2 = KIN(I_LN2B) + l * D;
    for (int tok = gw; tok < NTOK; tok += NGW) {
        const int s0 = tok_slot[tok * 4], s1 = tok_slot[tok * 4 + 1], s2i = tok_slot[tok * 4 + 2], s3 = tok_slot[tok * 4 + 3];
        const f32x4* xr = (const f32x4*)(X1F + (size_t)tok * D) + lane;
        const u32x2* y0 = (const u32x2*)(YB + (size_t)s0 * D) + lane; const u32x2* y1 = (const u32x2*)(YB + (size_t)s1 * D) + lane;
        const u32x2* y2 = (const u32x2*)(YB + (size_t)s2i * D) + lane; const u32x2* y3 = (const u32x2*)(YB + (size_t)s3 * D) + lane;
        f32x4 v[4]; float s = 0.f;
#pragma unroll
        for (int j = 0; j < 4; ++j) { const f32x4 xv = xr[64 * j]; const u32x2 a0 = y0[64 * j], a1 = y1[64 * j], a2 = y2[64 * j], a3 = y3[64 * j];
            v[j][0] = DN_ALPHA * xv[0] + ((bflo(a0.x) + bflo(a1.x)) + (bflo(a2.x) + bflo(a3.x))); v[j][1] = DN_ALPHA * xv[1] + ((bfhi(a0.x) + bfhi(a1.x)) + (bfhi(a2.x) + bfhi(a3.x)));
            v[j][2] = DN_ALPHA * xv[2] + ((bflo(a0.y) + bflo(a1.y)) + (bflo(a2.y) + bflo(a3.y))); v[j][3] = DN_ALPHA * xv[3] + ((bfhi(a0.y) + bfhi(a1.y)) + (bfhi(a2.y) + bfhi(a3.y)));
            s += (v[j][0] + v[j][1]) + (v[j][2] + v[j][3]); }
        const float mean = wave_sum(s) * (1.0f / D); float q = 0.f;
#pragma unroll
        for (int j = 0; j < 4; ++j) { v[j] = v[j] - mean; q += (v[j][0] * v[j][0] + v[j][1] * v[j][1]) + (v[j][2] * v[j][2] + v[j][3] * v[j][3]); }
        const float rstd = 1.0f / sqrtf(wave_sum(q) * (1.0f / D) + LN_EPS);
#pragma unroll
        for (int j = 0; j < 4; ++j) { const f32x4 gg = *((const f32x4*)g2 + lane + 64 * j), bb = *((const f32x4*)b2 + lane + 64 * j);
            const f32x4 y = v[j] * rstd * gg + bb;
            *((f32x4*)(xo + (size_t)tok * D) + lane + 64 * j) = y;
            *((u32x2*)(XB + (size_t)tok * D) + lane + 64 * j) = (u32x2){pk2(y[0], y[1]), pk2(y[2], y[3])}; }
    }
}


constexpr int PH_PER_LAYER = 11, NPHASES = 2 + NL * PH_PER_LAYER;
__global__ void __launch_bounds__(NTHR, 2) trunk_fwd(Args args) {
    extern __shared__ __attribute__((aligned(16))) unsigned char lds_raw[];
    LAS unsigned char* lds = (LAS unsigned char*)lds_raw;
    volatile LAS unsigned* MISC = (volatile LAS unsigned*)(lds + MISC_OFF);
    const int tid = threadIdx.x;
    const int G = gridDim.x, bx = blockIdx.x;
    const int vcu = (G % 8 == 0) ? (bx % 8) * (G / 8) + bx / 8 : bx;
    unsigned char* ws = KWS();
    unsigned* ctl = (unsigned*)(ws + WS_CTL);
    for (int u = tid; u < (LDS_BYTES - LDSCTL_OFF) / 4; u += NTHR) ((LAS unsigned*)(lds + LDSCTL_OFF))[u] = 0u;
    __syncthreads();
    XcdBarrier bar; bar.bar = ctl + CW_BAR; bar.x = 0; bar.st = nullptr;
#if !MK_PER_PHASE
    bar = xcd_barrier_post(ctl + CW_BAR, MISC + 8);
#define GRID_BAR() xcd_barrier(bar)
#else
#define GRID_BAR() do { } while (0)
#endif
    const int lo = (int)(unsigned)ka_u64<280>(), hi = (int)(unsigned)(ka_u64<280>() >> 32);
#ifndef PH_MASK
#define PH_MASK 0x1FFF
#endif
#define PHEN(n) (((PH_MASK) >> (n)) & 1)
#define IN(k) (lo <= (k) && (k) < hi)
#ifndef REP_MASK
#define REP_MASK 0
#endif
#define PHREP(n) (((REP_MASK) >> (n)) & 1)
#define SEAM(k) do { if (rep > 0 || IN((k) + 1)) GRID_BAR(); } while (0)

#define OG opaque_s(G)
#define OBX opaque_s(bx)
#define OVCU opaque_s(vcu)
#define OL opaque_s(l)
    if (PHEN(0) && IN(0)) for (int rep = PHREP(0); rep >= 0; --rep) { prologue_phase(lds, OVCU, OG); SEAM(0); }
    if (PHEN(1) && IN(1)) for (int rep = PHREP(1); rep >= 0; --rep) {
        pg8::DenseOrder S; S.init(KWS() + WS_MEMB, KWS() + WS_WMEM, NB * NMEM, 2048, D, OG, OBX);
        pg8::EpiBf16 E{(bf16*)(KWS() + WS_MKV), 2048};
        pg8::gemm_phase<pg8::EpiBf16, pg8::DenseOrder>(lds, D, S, E);
        SEAM(1);
    }
    for (int l = 0; l < NL; ++l) {
        const int p0 = 2 + l * PH_PER_LAYER;
        if (PHEN(2) && IN(p0 + 0)) for (int rep = PHREP(2); rep >= 0; --rep) {
            pg8::DenseOrder S; S.init(KWS() + WS_XB, KWS() + WS_WIN + (size_t)OL * PINP * D * 2, NTOK, PINP, D, OG, OBX);
            pg8::EpiBf16 E{(bf16*)(KWS() + WS_P), PINP};
            pg8::gemm_phase<pg8::EpiBf16, pg8::DenseOrder>(lds, D, S, E);
            SEAM(p0 + 0);
        }
        if (PHEN(3) && IN(p0 + 1)) for (int rep = PHREP(3); rep >= 0; --rep) { prep_phase(lds, OL, OVCU, OG); SEAM(p0 + 1); }
        if (PHEN(4) && IN(p0 + 2)) for (int rep = PHREP(4); rep >= 0; --rep) { c1_phase(lds, OVCU, OG); SEAM(p0 + 2); }
        if (PHEN(5) && IN(p0 + 3)) for (int rep = PHREP(5); rep >= 0; --rep) { m2_phase(lds, OL, OBX, OG); SEAM(p0 + 3); }
        if (PHEN(6) && IN(p0 + 4)) for (int rep = PHREP(6); rep >= 0; --rep) { m3_gh_phase(OL, OVCU, OG); SEAM(p0 + 4); }
        if (PHEN(7) && IN(p0 + 5)) for (int rep = PHREP(7); rep >= 0; --rep) {
            pg8::DenseOrder S; S.init(KWS() + WS_O, KWS() + WS_WOUT + (size_t)OL * D * D * 2, NTOK, D, D, OG, OBX);
            pg8::EpiBf16 E{(bf16*)(KWS() + WS_HMIX), D};
            pg8::gemm_phase<pg8::EpiBf16, pg8::DenseOrder>(lds, D, S, E);
            SEAM(p0 + 5);
        }
        if (PHEN(8) && IN(p0 + 6)) for (int rep = PHREP(8); rep >= 0; --rep) { ln1_router_phase(lds, OL, OBX, OG); SEAM(p0 + 6); }
        if (PHEN(9) && IN(p0 + 7)) for (int rep = PHREP(9); rep >= 0; --rep) { slots_phase(lds, OBX, OG); SEAM(p0 + 7); }
        if (PHEN(10) && IN(p0 + 8)) for (int rep = PHREP(10); rep >= 0; --rep) {
            const int ntiles = __builtin_amdgcn_readfirstlane(((const int*)(KWS() + WS_CTL))[CW_NT]);
            pg8::MoeOrder<true> S; S.init(KWS() + WS_X1B, KWS() + WS_WGU + (size_t)OL * NE * 2048 * D * 2, (const int*)(KWS() + WS_CTL) + CW_TILEE, (const int*)(KWS() + WS_ROUTE + 3 * MiB), ntiles, 2048, D, OG, OBX);
            pg8::EpiSwiglu E{(bf16*)(KWS() + WS_HB), (const float*)(KWS() + WS_BGU) + (size_t)OL * NE * 2048};
            pg8::gemm_phase<pg8::EpiSwiglu, pg8::MoeOrder<true>>(lds, D, S, E);
            SEAM(p0 + 8);
        }
        if (PHEN(11) && IN(p0 + 9)) for (int rep = PHREP(11); rep >= 0; --rep) {
            const int ntiles = __builtin_amdgcn_readfirstlane(((const int*)(KWS() + WS_CTL))[CW_NT]);
            pg8::MoeOrder<false> S; S.init(KWS() + WS_HB, KWS() + WS_WD + (size_t)OL * NE * D * FF * 2, (const int*)(KWS() + WS_CTL) + CW_TILEE, (const int*)(KWS() + WS_ROUTE + 3 * MiB), ntiles, D, FF, OG, OBX);
            pg8::EpiDown E{(bf16*)(KWS() + WS_YB), KIN(I_BDN) + (size_t)OL * NE * D, (const float*)(KWS() + WS_ROUTE + 3 * MiB + 1536 * 1024)};
            pg8::gemm_phase<pg8::EpiDown, pg8::MoeOrder<false>>(lds, FF, S, E);
            SEAM(p0 + 9);
        }
        if (PHEN(12) && IN(p0 + 10)) for (int rep = PHREP(12); rep >= 0; --rep) { combine_phase(OL, OVCU, OG); if (rep > 0 || l + 1 < NL) SEAM(p0 + 10); }
    }
#undef IN
#undef SEAM
}

extern "C" void kernel_launch(void* const* d_in, const int* in_sizes, int n_in, void* d_out, int out_size, void* d_ws, size_t ws_size, hipStream_t stream) {
    static int grid = 0;
    if (grid == 0) {
        if (n_in != 33 || ws_size < WS_END) { fprintf(stderr, "kernel_launch: unexpected inputs (n_in %d, ws %zu need %zu)\n", n_in, ws_size, (size_t)WS_END); grid = -1; return; }
        int dev = 0, cus = 0;
        if (hipGetDevice(&dev) != hipSuccess || hipDeviceGetAttribute(&cus, hipDeviceAttributeMultiprocessorCount, dev) != hipSuccess) { grid = -1; return; }
        if (hipFuncSetAttribute((const void*)trunk_fwd, hipFuncAttributeMaxDynamicSharedMemorySize, LDS_BYTES) != hipSuccess) { grid = -1; return; }
        int per_cu = 0; (void)hipOccupancyMaxActiveBlocksPerMultiprocessor(&per_cu, (const void*)trunk_fwd, NTHR, LDS_BYTES); (void)hipGetLastError();
        grid = cus;
    }
    if (grid < 0) return;
    (void)hipMemsetAsync((char*)d_ws + WS_CTL, 0, CTL_ZERO_BYTES, stream);
    Args a{};
    for (int i = 0; i < 33; ++i) a.in[i] = (const float*)d_in[i];
    a.out = (float*)d_out; a.ws = (unsigned char*)d_ws;
#if MK_PER_PHASE
    for (int p = 0; p < NPHASES; ++p) { a.ph_lo = p; a.ph_hi = p + 1; hipLaunchKernelGGL(trunk_fwd, dim3(grid), dim3(NTHR), LDS_BYTES, stream, a); }
#else
    a.ph_lo = 0; a.ph_hi = NPHASES;
    hipLaunchKernelGGL(trunk_fwd, dim3(grid), dim3(NTHR), LDS_BYTES, stream, a);
#endif
}
```

```cpp
#include <hip/hip_runtime.h>
#include <cstdio>
#include <cstdint>

#ifndef MK_PER_PHASE
#define MK_PER_PHASE 0
#endif

#ifndef REP_MASK
#define REP_MASK 0
#endif
#define PHREP(n) (((REP_MASK) >> (n)) & 1)
#define LAS __attribute__((address_space(3)))
#define GAS __attribute__((address_space(1)))
typedef unsigned short bf16;
typedef short bf16x8 __attribute__((ext_vector_type(8)));
typedef short s16x4 __attribute__((ext_vector_type(4)));
typedef float f32x4 __attribute__((ext_vector_type(4)));
typedef float f32x2 __attribute__((ext_vector_type(2)));
typedef float f32x16 __attribute__((ext_vector_type(16)));
typedef unsigned u32x4 __attribute__((ext_vector_type(4)));
typedef unsigned u32x2 __attribute__((ext_vector_type(2)));

constexpr int NB = 8, T = 8192, D = 1024, NL = 4, NTOK = NB * T;
constexpr int PIN = 3088, PINP = 3328;
constexpr int NE = 32, FF = 1024, NMEM = 256;
constexpr int NASSIGN = NTOK * 4;
constexpr int MAXTILES = NASSIGN / 256 + NE;
constexpr int MAXSLOTS = MAXTILES * 256;
constexpr int PC_GQ = 0, PC_GK = 128, PC_GV = 256, PC_GOUT = 512, PC_HQ = 768, PC_HF = 1024, PC_HI = 1280, PC_HG = 1536;
constexpr int PC_RW = 1792, PC_MQ = 2816, PC_GLR = 3072;
constexpr float DN_ALPHA = 1.6817928305074292f;
constexpr float LN_EPS = 1e-5f, RMS_EPS = 1e-6f, RW_LN_EPS = 64e-5f;

constexpr size_t MiB = 1u << 20;
constexpr size_t WS_CTL = 0, CTL_ZERO_BYTES = 1 * MiB;
constexpr size_t WS_WIN = 1 * MiB;
constexpr size_t WS_WOUT = WS_WIN + 26 * MiB;
constexpr size_t WS_WMEM = WS_WOUT + 8 * MiB;
constexpr size_t WS_WGU = WS_WMEM + 4 * MiB;
constexpr size_t WS_WD = WS_WGU + 512 * MiB;
constexpr size_t WS_BGU = WS_WD + 256 * MiB;
constexpr size_t WS_LORA = WS_BGU + 1 * MiB;
constexpr size_t WS_MEMB = WS_LORA + 1 * MiB;
constexpr size_t WS_MKV = WS_MEMB + 4 * MiB;
constexpr size_t WS_XB = WS_MKV + 8 * MiB;
constexpr size_t WS_X1B = WS_XB + 128 * MiB;
constexpr size_t WS_XF = WS_X1B + 128 * MiB;
constexpr size_t WS_X1F = WS_XF + 256 * MiB;
constexpr size_t WS_O = WS_X1F + 256 * MiB;
constexpr size_t WS_HMIX = WS_O + 128 * MiB;
constexpr size_t WS_ROUTE = WS_HMIX + 128 * MiB;
constexpr size_t WS_GBUF = WS_ROUTE + 6 * MiB;
constexpr size_t WS_BONUS = WS_GBUF + 32 * MiB;
constexpr size_t WS_BIG = WS_BONUS + 1 * MiB;
constexpr size_t WS_P = WS_BIG;
constexpr size_t WS_ORAW = WS_P + 416 * MiB;
constexpr size_t WS_HB = WS_BIG;
constexpr size_t WS_YB = WS_HB + 528 * MiB;
constexpr size_t WS_CHK = WS_ORAW;
constexpr size_t WS_HQ = WS_CHK, WS_HK = WS_HQ + 32 * MiB, WS_HVT = WS_HK + 32 * MiB, WS_HDS = WS_HVT + 32 * MiB, WS_HS = WS_HDS + 128 * MiB, WS_HBE = WS_HS + 64 * MiB;
constexpr size_t WS_GQ = WS_HBE + 2 * MiB, WS_GK = WS_GQ + 16 * MiB, WS_GVT = WS_GK + 16 * MiB, WS_GDS = WS_GVT + 32 * MiB, WS_GS = WS_GDS + 64 * MiB, WS_GBE = WS_GS + 32 * MiB;
constexpr size_t WS_RR = WS_GBE + 1 * MiB, WS_RB = WS_RR + 32 * MiB, WS_RK = WS_RB + 32 * MiB, WS_RW = WS_RK + 32 * MiB, WS_RVT = WS_RW + 32 * MiB;
constexpr size_t WS_RVG = WS_RVT + 32 * MiB;
constexpr size_t WS_RU = WS_RVG + 32 * MiB, WS_RP = WS_RU + 64 * MiB, WS_RQ = WS_RP + 64 * MiB, WS_RS = WS_RQ + 128 * MiB;
constexpr size_t WS_END = WS_RS + 64 * MiB;
static_assert(WS_YB + 528 * MiB <= WS_END, "overlay");
static_assert(WS_END <= (size_t)4096 * MiB, "workspace");
constexpr int CW_TMO = 0;
constexpr int CW_BAR = 4096;
constexpr int CW_HIST = 16384;
constexpr int CW_NT = 32768;
constexpr int CW_TILEE = 32768 + 64;
constexpr int CW_PADSTART = 40960;

constexpr int RING_BYTES = 131072;
constexpr int LDSCTL_OFF = 162816, MISC_OFF = LDSCTL_OFF + 320;
constexpr int LDS_BYTES = 163840;
constexpr int NWAVES = 8, NTHR = 512;

#define RLX_AGENT __ATOMIC_RELAXED, __HIP_MEMORY_SCOPE_AGENT
#define LDS_WAIT() asm volatile("s_waitcnt lgkmcnt(0)" ::: "memory")
#define VM_WAIT() asm volatile("s_waitcnt vmcnt(0)" ::: "memory")

__device__ __forceinline__ unsigned f2bf(float f) { unsigned u = __builtin_bit_cast(unsigned, f); return (u + 0x7fffu + ((u >> 16) & 1u)) >> 16; }
__device__ __forceinline__ unsigned pk2(float lo, float hi) { return f2bf(lo) | (f2bf(hi) << 16); }
__device__ __forceinline__ float bf2f(unsigned short b) { return __builtin_bit_cast(float, (unsigned)b << 16); }
__device__ __forceinline__ float bflo(unsigned w) { return __builtin_bit_cast(float, w << 16); }
__device__ __forceinline__ float bfhi(unsigned w) { return __builtin_bit_cast(float, w & 0xffff0000u); }
typedef __bf16 bf16x2_t __attribute__((ext_vector_type(2)));
__device__ __forceinline__ unsigned cvt_pk_bf16(float lo, float hi) { const f32x2 v = {lo, hi}; const bf16x2_t b = __builtin_convertvector(v, bf16x2_t); return __builtin_bit_cast(unsigned, b); }
__device__ __forceinline__ float fast_exp(float x) { return __builtin_amdgcn_exp2f(x * 1.4426950408889634f); }
__device__ __forceinline__ float fast_sigmoid(float x) { return __builtin_amdgcn_rcpf(1.0f + fast_exp(-x)); }
__device__ __forceinline__ float silu_f(float x) { return x * fast_sigmoid(x); }
__device__ __forceinline__ int opaque_tid() { int t = threadIdx.x; asm volatile("" : "+v"(t)); return t; }
__device__ __forceinline__ int opaque_s(int v) { asm volatile("" : "+s"(v)); return v; }
__device__ __forceinline__ float wave_sum(float v) {
#pragma unroll
    for (int o = 1; o < 64; o <<= 1) v += __shfl_xor(v, o);
    return v;
}

namespace pg8 {
constexpr int BM = 256, BK = 64, HALF = 128, HTB = HALF * BK * 2, STAGE_BYTES = 8 * HTB, NXCD = 8, WGM = 8;
__host__ __device__ __forceinline__ int lds_byte(int r, int c) { const int st = (r >> 4) * 2 + (c >> 5), rr = r & 15, cc = c & 31, ob = rr * 64 + cc * 2; return st * 1024 + (ob ^ (((ob >> 9) & 1) << 5)); }
__host__ __device__ __forceinline__ void stage_rc(int b, int& R, int& C) { const int st = b / 1024, sb = b % 1024, swz = sb ^ (((sb >> 9) & 1) << 5); R = (st >> 1) * 16 + swz / 64; C = (st & 1) * 32 + (swz % 64) / 2; }
__host__ __device__ __forceinline__ int perm32(int rho) { const int n = rho >> 4, i = rho & 15; return 8 * (i >> 2) + 4 * n + (i & 3); }

struct Unit { int pm, pn, e; const char* A; const char* B; };

__device__ __forceinline__ bool static_tile(int i, int G, int c, int nM, int nN, int& pm, int& pn) {
    const int nwg = nM * nN; const long L = (long)i * G + c; if (L >= nwg) return false;
    int wgid = (int)L; { const int q = nwg / NXCD, r = nwg % NXCD, xcd = wgid % NXCD, off = wgid / NXCD; wgid = (xcd < r ? xcd * (q + 1) : r * (q + 1) + (xcd - r) * q) + off; }
    const int nig = WGM * nN, gid = wgid / nig, fm = gid * WGM, gsz = (nM - fm) < WGM ? (nM - fm) : WGM;
    pm = fm + ((wgid % nig) % gsz); pn = (wgid % nig) / gsz; return true;
}
struct DenseOrder {
    static constexpr bool GATHER = false;
    const char* A; const char* B; int nM, nN, G, c; size_t tstep;
    __device__ __forceinline__ void init(const void* A_, const void* B_, int M, int N, int K, int G_, int c_) { A = (const char*)A_; B = (const char*)B_; nM = M / BM; nN = N / BM; G = G_; c = c_; tstep = (size_t)BM * K * 2; }
    __device__ __forceinline__ bool next(int i, Unit& u) const { if (!static_tile(i, G, c, nM, nN, u.pm, u.pn)) return false; u.e = 0; u.A = A + (size_t)u.pm * tstep; u.B = B + (size_t)u.pn * tstep; return true; }
    __device__ __forceinline__ unsigned row_tok(const Unit&, int) const { return 0; }
};
template <bool GATHER_> struct MoeOrder {
    static constexpr bool GATHER = GATHER_;
    const char* A; const char* B; const int* tile_e; const int* slot_tok; int nM, nN, G, c; size_t tstep, estep;
    __device__ __forceinline__ void init(const void* A_, const void* B_, const int* tile_e_, const int* slot_tok_, int ntiles, int Nper, int K, int G_, int c_) {
        A = (const char*)A_; B = (const char*)B_; tile_e = tile_e_; slot_tok = slot_tok_; nM = ntiles; nN = Nper / BM; G = G_; c = c_; tstep = (size_t)BM * K * 2; estep = (size_t)Nper * K * 2; }
    __device__ __forceinline__ bool next(int i, Unit& u) const { if (!static_tile(i, G, c, nM, nN, u.pm, u.pn)) return false;
        u.e = __builtin_amdgcn_readfirstlane(tile_e[u.pm]); u.A = GATHER_ ? A : A + (size_t)u.pm * tstep; u.B = B + (size_t)u.e * estep + (size_t)u.pn * tstep; return true; }
    __device__ __forceinline__ unsigned row_tok(const Unit& u, int r) const { return (unsigned)slot_tok[u.pm * BM + r]; }
};

struct EpiBf16 {
    static constexpr bool PERM = true;
    bf16* O; int ldc;
    __device__ __forceinline__ void operator()(const f32x4 (&acc)[2][2][4][2], const Unit& u, int wr, int wc, int fr, int fq) const {
        const int row0 = u.pm * BM + wr * 64 + fr, col0 = u.pn * BM + wc * 32 + 8 * fq;
#pragma unroll
        for (int ai = 0; ai < 2; ++ai)
#pragma unroll
            for (int m = 0; m < 4; ++m) { bf16* rowp = O + (size_t)(row0 + ai * HALF + m * 16) * ldc + col0;
#pragma unroll
                for (int bj = 0; bj < 2; ++bj) { const f32x4 v0 = acc[ai][bj][m][0], v1 = acc[ai][bj][m][1];
                    u32x4 w; w.x = cvt_pk_bf16(v0[0], v0[1]); w.y = cvt_pk_bf16(v0[2], v0[3]); w.z = cvt_pk_bf16(v1[0], v1[1]); w.w = cvt_pk_bf16(v1[2], v1[3]);
                    *(u32x4*)(rowp + bj * HALF) = w; } }
    }
};
struct EpiSwiglu {
    static constexpr bool PERM = false;
    bf16* H; const float* bias;
    __device__ __forceinline__ void operator()(const f32x4 (&acc)[2][2][4][2], const Unit& u, int wr, int wc, int fr, int fq) const {
        const int row0 = u.pm * BM + wr * 64 + fr, colh = u.pn * 128 + wc * 32 + 8 * fq;
        const float* bp = bias + (size_t)u.e * 2048 + u.pn * 256 + wc * 32 + 4 * fq;
        f32x4 bv[2][2];
#pragma unroll
        for (int bj = 0; bj < 2; ++bj)
#pragma unroll
            for (int n = 0; n < 2; ++n) bv[bj][n] = *(const f32x4*)(bp + bj * HALF + n * 16);
#pragma unroll
        for (int ai = 0; ai < 2; ++ai)
#pragma unroll
            for (int m = 0; m < 4; ++m) { bf16* rowp = H + (size_t)(row0 + ai * HALF + m * 16) * FF + colh;
                float o[8];
#pragma unroll
                for (int n = 0; n < 2; ++n) { const f32x4 g4 = acc[ai][0][m][n] + bv[0][n], u4 = acc[ai][1][m][n] + bv[1][n];
#pragma unroll
                    for (int j = 0; j < 4; ++j) { const float g = fminf(g4[j], 7.0f), up = fminf(fmaxf(u4[j], -7.0f), 7.0f);
                        const float glu = g * __builtin_amdgcn_rcpf(1.0f + __builtin_amdgcn_exp2f(g * (-1.702f * 1.4426950408889634f)));
                        o[n * 4 + j] = (up + 1.0f) * glu; } }
                u32x4 w; w.x = cvt_pk_bf16(o[0], o[1]); w.y = cvt_pk_bf16(o[2], o[3]); w.z = cvt_pk_bf16(o[4], o[5]); w.w = cvt_pk_bf16(o[6], o[7]);
                *(u32x4*)rowp = w; }
    }
};
struct EpiDown {
    static constexpr bool PERM = true;
    bf16* Y; const float* bias; const float* slot_gate;
    __device__ __forceinline__ void operator()(const f32x4 (&acc)[2][2][4][2], const Unit& u, int wr, int wc, int fr, int fq) const {
        const int row0 = u.pm * BM + wr * 64 + fr, col0 = u.pn * BM + wc * 32 + 8 * fq;
        const float* bp = bias + (size_t)u.e * 1024 + col0;
        f32x4 bv[2][2];
#pragma unroll
        for (int bj = 0; bj < 2; ++bj)
#pragma unroll
            for (int n = 0; n < 2; ++n) bv[bj][n] = *(const f32x4*)(bp + bj * HALF + 4 * n);
#pragma unroll
        for (int ai = 0; ai < 2; ++ai)
#pragma unroll
            for (int m = 0; m < 4; ++m) { const int row = row0 + ai * HALF + m * 16; const float g = slot_gate[row]; bf16* rowp = Y + (size_t)row * D + col0;
#pragma unroll
                for (int bj = 0; bj < 2; ++bj) { const f32x4 v0 = (acc[ai][bj][m][0] + bv[bj][0]) * g, v1 = (acc[ai][bj][m][1] + bv[bj][1]) * g;
                    u32x4 w; w.x = cvt_pk_bf16(v0[0], v0[1]); w.y = cvt_pk_bf16(v0[2], v0[3]); w.z = cvt_pk_bf16(v1[0], v1[1]); w.w = cvt_pk_bf16(v1[2], v1[3]);
                    *(u32x4*)(rowp + bj * HALF) = w; } }
    }
};

template <class Epi, class Sched, bool ALIGN_EPI = true>
__device__ __forceinline__ void gemm_phase(LAS unsigned char* lds, const int K, const Sched& S, const Epi& E) {
    constexpr bool GA = Sched::GATHER;
    const int tid = opaque_tid(), wid = __builtin_amdgcn_readfirstlane(tid >> 6), lane = tid & 63, wr = wid >> 2, wc = wid & 3, fr = lane & 15, fq = lane >> 4;
    const int nt = K / BK;
    unsigned voffA[2], voffB[2]; int Rr[2]; unsigned Cb[2];
#pragma unroll
    for (int i = 0; i < 2; ++i) { int R, C; stage_rc(tid * 16 + i * 8192, R, C); const int Rb = Epi::PERM ? ((R & ~31) + perm32(R & 31)) : R;
        voffA[i] = (unsigned)(R * K + C) * 2u; voffB[i] = (unsigned)(Rb * K + C) * 2u; Rr[i] = R; Cb[i] = (unsigned)C * 2u; }
    const size_t kstep = (size_t)(BK * 2);
    const size_t hstep = (size_t)HALF * K * 2;
    const unsigned ldsw = (unsigned)wid * 1024u;
    const int aoff = lds_byte(wr * 64 + fr, fq * 8), boff = lds_byte(wc * 32 + fr, fq * 8);
    unsigned cOff[2][2], nOff[2][2], sOff[2][2];
#define PG8_SA(b, h) (((b) * 2 + (h)) * HTB)
#define PG8_SB(b, h) ((4 + (b) * 2 + (h)) * HTB)
#define PG8_STAGE(bufoff, gbase, voff) do { _Pragma("unroll") for (int _i = 0; _i < 2; ++_i) \
        __builtin_amdgcn_global_load_lds((const unsigned*)((const char*)(gbase) + (voff)[_i]), (LAS unsigned*)(lds + (bufoff) + ldsw + _i * 8192), 16, 0, 0); } while (0)
#define PG8_STAGE_A(bufoff, gbase, half, OFF) do { if constexpr (GA) { PG8_STAGE(bufoff, gbase, (OFF)[half]); } else { PG8_STAGE(bufoff, (gbase) + (half) * hstep, voffA); } } while (0)
#define PG8_LDA(dst, b, h) do { _Pragma("unroll") for (int m = 0; m < 4; ++m) _Pragma("unroll") for (int k = 0; k < 2; ++k) dst[m][k] = *(const LAS bf16x8*)(lds + PG8_SA(b, h) + aoff + m * 2048 + k * 1024); } while (0)
#define PG8_LDB(dst, b, h) do { _Pragma("unroll") for (int n = 0; n < 2; ++n) _Pragma("unroll") for (int k = 0; k < 2; ++k) dst[n][k] = *(const LAS bf16x8*)(lds + PG8_SB(b, h) + boff + n * 2048 + k * 1024); } while (0)
#define PG8_MMA(ai, bj, At, Bt) do { __builtin_amdgcn_s_setprio(1); _Pragma("unroll") for (int m = 0; m < 4; ++m) _Pragma("unroll") for (int n = 0; n < 2; ++n) _Pragma("unroll") for (int k = 0; k < 2; ++k) \
        acc[ai][bj][m][n] = __builtin_amdgcn_mfma_f32_16x16x32_bf16(Bt[n][k], At[m][k], acc[ai][bj][m][n], 0, 0, 0); __builtin_amdgcn_s_setprio(0); } while (0)
#define PG8_WAIT_V(n) asm volatile("s_waitcnt vmcnt(" #n ")" ::: "memory")
#define PG8_WAIT_L(n) asm volatile("s_waitcnt lgkmcnt(" #n ")" ::: "memory")
#define PG8_BAR __builtin_amdgcn_s_barrier()
#define PG8_SCHED __builtin_amdgcn_sched_barrier(0)
#define PG8_GOFF(dst, u) do { if constexpr (GA) { _Pragma("unroll") for (int _h = 0; _h < 2; ++_h) _Pragma("unroll") for (int _i = 0; _i < 2; ++_i) \
        dst[_h][_i] = S.row_tok(u, _h * HALF + Rr[_i]) * (unsigned)(K * 2) + Cb[_i]; } } while (0)
    Unit cur, nxt; int ui = 0;
    if (!S.next(0, cur)) return;
    f32x4 acc[2][2][4][2];
#pragma unroll
    for (int a = 0; a < 2; ++a)
#pragma unroll
        for (int b = 0; b < 2; ++b)
#pragma unroll
            for (int m = 0; m < 4; ++m)
#pragma unroll
                for (int n = 0; n < 2; ++n) acc[a][b][m][n] = (f32x4){0.f, 0.f, 0.f, 0.f};
    bf16x8 At[4][2], B0[2][2], B1[2][2];
    const char* cA = cur.A; const char* cB = cur.B;
    PG8_GOFF(cOff, cur);
#pragma unroll
    for (int h = 0; h < 2; ++h)
#pragma unroll
        for (int i = 0; i < 2; ++i) { nOff[h][i] = 0u; sOff[h][i] = 0u; }
    if constexpr (GA) { VM_WAIT(); }
    PG8_STAGE(PG8_SB(0, 0), cB, voffB); PG8_STAGE(PG8_SB(0, 1), cB + hstep, voffB); PG8_STAGE_A(PG8_SA(0, 0), cA, 0, cOff); PG8_STAGE_A(PG8_SA(0, 1), cA, 1, cOff);
    if (wr == 1) PG8_BAR;
    PG8_WAIT_V(2); PG8_BAR;
    PG8_STAGE(PG8_SB(1, 0), cB + kstep, voffB); PG8_STAGE_A(PG8_SA(1, 0), cA + kstep, 0, cOff); PG8_STAGE(PG8_SB(1, 1), cB + hstep + kstep, voffB);
    PG8_WAIT_V(6); PG8_BAR;
    for (;;) {
        const bool has_next = S.next(ui + 1, nxt);
        const char* nA = has_next ? nxt.A : cA; const char* nB = has_next ? nxt.B : cB;
        if constexpr (GA) { if (has_next) { PG8_GOFF(nOff, nxt); } else {
#pragma unroll
            for (int h = 0; h < 2; ++h)
#pragma unroll
                for (int i = 0; i < 2; ++i) nOff[h][i] = cOff[h][i]; } }
        for (int t = 0; t < nt; t += 2) {
            const bool last = (t == nt - 2);
            const char* a1 = cA + (size_t)(t + 1) * kstep;
            const char* a2 = last ? nA : cA + (size_t)(t + 2) * kstep; const char* b2 = last ? nB : cB + (size_t)(t + 2) * kstep;
            const char* a3 = a2 + kstep; const char* b3 = b2 + kstep;
            if constexpr (GA) {
#pragma unroll
                for (int h = 0; h < 2; ++h)
#pragma unroll
                    for (int i = 0; i < 2; ++i) sOff[h][i] = last ? nOff[h][i] : cOff[h][i]; }
            PG8_LDB(B0, 0, 0); PG8_LDB(B1, 0, 1); PG8_SCHED; PG8_LDA(At, 0, 0); PG8_STAGE_A(PG8_SA(1, 1), a1, 1, cOff);
            PG8_WAIT_V(8); PG8_WAIT_L(0); PG8_BAR; PG8_MMA(0, 0, At, B0); PG8_MMA(0, 1, At, B1); PG8_BAR; PG8_SCHED;
            PG8_LDA(At, 0, 1); PG8_STAGE(PG8_SB(0, 0), b2, voffB); PG8_STAGE(PG8_SB(0, 1), b2 + hstep, voffB); PG8_STAGE_A(PG8_SA(0, 0), a2, 0, sOff);
            PG8_WAIT_V(8); PG8_WAIT_L(0); PG8_BAR; PG8_MMA(1, 0, At, B0); PG8_MMA(1, 1, At, B1); PG8_BAR; PG8_SCHED;
            PG8_LDB(B0, 1, 0); PG8_LDB(B1, 1, 1); PG8_SCHED; PG8_LDA(At, 1, 0); PG8_STAGE_A(PG8_SA(0, 1), a2, 1, sOff);
            PG8_WAIT_V(8); PG8_WAIT_L(0); PG8_BAR; PG8_MMA(0, 0, At, B0); PG8_MMA(0, 1, At, B1); PG8_BAR; PG8_SCHED;
            PG8_LDA(At, 1, 1); PG8_STAGE(PG8_SB(1, 0), b3, voffB); PG8_STAGE(PG8_SB(1, 1), b3 + hstep, voffB); PG8_STAGE_A(PG8_SA(1, 0), a3, 0, sOff);
            PG8_WAIT_V(8); PG8_WAIT_L(0); PG8_BAR; PG8_MMA(1, 0, At, B0); PG8_MMA(1, 1, At, B1); PG8_BAR; PG8_SCHED;
        }
        if constexpr (ALIGN_EPI) { if (wr == 0) PG8_BAR; }
        E(acc, cur, wr, wc, fr, fq);
        if (!has_next) break;
#pragma unroll
        for (int a = 0; a < 2; ++a)
#pragma unroll
            for (int b = 0; b < 2; ++b)
#pragma unroll
                for (int m = 0; m < 4; ++m)
#pragma unroll
                    for (int n = 0; n < 2; ++n) acc[a][b][m][n] = (f32x4){0.f, 0.f, 0.f, 0.f};
        cur = nxt; cA = nA; cB = nB; ++ui;
        if constexpr (GA) {
#pragma unroll
            for (int h = 0; h < 2; ++h)
#pragma unroll
                for (int i = 0; i < 2; ++i) cOff[h][i] = nOff[h][i]; }
        if constexpr (ALIGN_EPI) { if (wr == 1) PG8_BAR; }
    }
    PG8_WAIT_V(0);
    if constexpr (!ALIGN_EPI) { if (wr == 0) PG8_BAR; }
    PG8_BAR;
#undef PG8_SA
#undef PG8_SB
#undef PG8_STAGE
#undef PG8_STAGE_A
#undef PG8_LDA
#undef PG8_LDB
#undef PG8_MMA
#undef PG8_WAIT_V
#undef PG8_WAIT_L
#undef PG8_BAR
#undef PG8_SCHED
#undef PG8_GOFF
}
}

#define XB_TMO      128
#define XB_XCNT(j)  (256  + 64 * (j))
#define XB_XSUB(j)  (1280 + 64 * (j))
#define XB_XGEN(j)  (2304 + 64 * (j))
#define XB_TOP      3328
#define XB_TOPGEN   3392
#define XCD_BAR_WORDS 3456
#define XB_SPIN_CAP (1u << 18)
__device__ __forceinline__ unsigned xb_ld(unsigned* p)              { return __hip_atomic_load(p, __ATOMIC_RELAXED, __HIP_MEMORY_SCOPE_AGENT); }
__device__ __forceinline__ unsigned xb_add(unsigned* p, unsigned v) { return __hip_atomic_fetch_add(p, v, __ATOMIC_RELAXED, __HIP_MEMORY_SCOPE_AGENT); }
__device__ __forceinline__ unsigned xb_xcc_id() { return (unsigned)__builtin_amdgcn_s_getreg((3 << 11) | 20) & 0xFu; }
#define XB_SPIN(cond, bar) do { unsigned _sp = 0; while (cond) { __builtin_amdgcn_s_sleep(1); \
    if ((++_sp & 255u) == 0u) { if (xb_ld(&(bar)[XB_TMO])) break; if (_sp > XB_SPIN_CAP) { atomicAdd(&(bar)[XB_TMO], 1u); break; } } } } while (0)
struct XcdBarrier { unsigned* bar; unsigned x; volatile LAS unsigned* st; };
__device__ __forceinline__ XcdBarrier xcd_barrier_post(unsigned* bar, volatile LAS unsigned* st) {
    XcdBarrier b; b.bar = bar; b.x = xb_xcc_id(); b.st = st;
    if (threadIdx.x == 0) (void)xb_add(&bar[XB_XCNT(b.x)], 1u);
    return b;
}
__device__ __forceinline__ void xcd_barrier_complete(unsigned* bar, unsigned x, unsigned& nloc, unsigned& nx) {
    const unsigned G = gridDim.x * gridDim.y * gridDim.z;
    unsigned sum, cnt, mine, sp = 0u;
    for (;;) {
        sum = 0u; cnt = 0u; mine = 0u;
#pragma unroll
        for (unsigned j = 0; j < 16; ++j) { const unsigned c = xb_ld(&bar[XB_XCNT(j)]); sum += c; cnt += (c > 0u) ? 1u : 0u; mine = (j == x) ? c : mine; }
        if (sum == G) break;
        __builtin_amdgcn_s_sleep(1);
        if ((++sp & 255u) == 0u) { if (xb_ld(&bar[XB_TMO])) break; if (sp > XB_SPIN_CAP) { atomicAdd(&bar[XB_TMO], 1u); break; } }
    }
    nloc = mine > 0u ? mine : 1u; nx = cnt > 0u ? cnt : 1u;
}
__device__ __forceinline__ void xcd_barrier(const XcdBarrier& b) {
    asm volatile("s_waitcnt vmcnt(0)" ::: "memory");
    __syncthreads();
    if (threadIdx.x == 0) {
        unsigned* bar = b.bar;
        __builtin_amdgcn_s_waitcnt(0);
        unsigned nloc = b.st[0], nx = b.st[1];
        if (nloc == 0u) { xcd_barrier_complete(bar, b.x, nloc, nx); b.st[0] = nloc; b.st[1] = nx; }
        const unsigned old = xb_add(&bar[XB_XSUB(b.x)], 1u);
        const unsigned gen = old / nloc;
        if (old + 1u == (gen + 1u) * nloc) {
            __builtin_amdgcn_fence(__ATOMIC_RELEASE, "agent");
            asm volatile("s_waitcnt vmcnt(0)" ::: "memory");
            const unsigned og = xb_add(&bar[XB_TOP], 1u);
            const unsigned tg = og / nx;
            if (og + 1u == (tg + 1u) * nx) xb_add(&bar[XB_TOPGEN], 1u);
            else XB_SPIN(xb_ld(&bar[XB_TOPGEN]) == tg, bar);
            __builtin_amdgcn_fence(__ATOMIC_ACQUIRE, "agent");
            xb_add(&bar[XB_XGEN(b.x)], 1u);
            asm volatile("s_waitcnt vmcnt(0)" ::: "memory");
        } else {
            XB_SPIN(xb_ld(&bar[XB_XGEN(b.x)]) == gen, bar);
            __builtin_amdgcn_fence(__ATOMIC_ACQUIRE, "agent");
            asm volatile("s_waitcnt vmcnt(0)" ::: "memory");
        }
    }
    __syncthreads();
}

struct Args {
    const float* in[33];
    float* out; unsigned char* ws;
    int ph_lo, ph_hi;
};
enum { I_X = 0, I_MEM, I_WIN, I_GLACONV, I_GLAW2, I_GLAB, I_GLANG, I_HGLB, I_HGNG, I_RWMU, I_RWW0, I_RWW2, I_RWA0, I_RWA2, I_RWG2, I_RWKK, I_RWKA, I_RWRK, I_RWLNW, I_RWLNB,
       I_WMK, I_WMV, I_WOUT, I_LN1G, I_LN1B, I_RTW, I_RTB, I_WGU, I_BGU, I_WDN, I_BDN, I_LN2G, I_LN2B };


template <int OFF> __device__ __forceinline__ unsigned long long ka_u64() { unsigned long long v; asm volatile("s_load_dwordx2 %0, %1, %2\n\ts_waitcnt lgkmcnt(0)" : "=s"(v) : "s"(__builtin_amdgcn_kernarg_segment_ptr()), "n"(OFF)); return v; }
#define KIN(i) ((const float*)(const GAS float*)ka_u64<8 * (i)>())
#define KOUT() ((float*)(GAS float*)ka_u64<264>())
#define KWS() ((unsigned char*)(GAS unsigned char*)ka_u64<272>())

template <class Map>
__device__ __forceinline__ void tr_item(const float* __restrict__ W, int K, int N, bf16* __restrict__ WT, LAS float* scr, int kb, int nb, int lane, Map map) {
    const int k0 = 64 * kb, n0 = 64 * nb, col = n0 + lane; const bool valid = col < N;
    const float* src = W + (size_t)k0 * N + (valid ? col : 0);
#pragma unroll 16
    for (int kk = 0; kk < 64; ++kk) { const float v = valid ? src[(size_t)kk * N] : 0.f; scr[kk * 65 + lane] = v; }
    LDS_WAIT(); asm volatile("" ::: "memory");
    const int c = lane & 7;
#pragma unroll
    for (int j = 0; j < 8; ++j) { const int n = (lane >> 3) + 8 * j;
        if (n0 + n < N) { const int orow = map(n0 + n); const LAS float* s = scr + (8 * c) * 65 + n;
            u32x4 o; o.x = pk2(s[0 * 65], s[1 * 65]); o.y = pk2(s[2 * 65], s[3 * 65]); o.z = pk2(s[4 * 65], s[5 * 65]); o.w = pk2(s[6 * 65], s[7 * 65]);
            *(u32x4*)(WT + (size_t)orow * K + k0 + 8 * c) = o; } }
    LDS_WAIT(); asm volatile("" ::: "memory");
}
struct MapIdent { int off; __device__ __forceinline__ int operator()(int c) const { return c + off; } };
struct MapWin { __device__ __forceinline__ int operator()(int c) const { return c < 512 ? c : (c < 528 ? c + 2560 : c - 16); } };
__device__ __forceinline__ int gu_row(int c) { const int f = c >> 1, bj = c & 1, pn = f >> 7, fl = f & 127, wc = fl >> 5, fq = (fl >> 3) & 3, n = (fl >> 2) & 1, j = fl & 3; return 256 * pn + 128 * bj + 32 * wc + 16 * n + 4 * fq + j; }
struct MapGu { __device__ __forceinline__ int operator()(int c) const { return gu_row(c); } };

__device__ __forceinline__ void prologue_phase(LAS unsigned char* lds, int vcu, int G) {
    const int tid = opaque_tid(), lane = tid & 63, wave = __builtin_amdgcn_readfirstlane(tid >> 6);
    LAS float* scr = (LAS float*)(lds + wave * 16640); static_assert(8 * 16640 <= LDSCTL_OFF, "prologue scratch below the LDS control words");
    const int gw = vcu * NWAVES + wave, NGW = G * NWAVES;
    unsigned char* ws = KWS();
    constexpr int IT_GU = NL * NE * 512, IT_DN = NL * NE * 256, IT_IN = NL * 16 * 49, IT_OUT = NL * 256, IT_MEM = NL * 2 * 64, IT_L64 = NL * 2 * 4, IT_L128 = NL * 2 * 4;
    constexpr int IT_TOTAL = IT_GU + IT_DN + IT_IN + IT_OUT + IT_MEM + IT_L64 + IT_L128;
    for (int it = gw; it < IT_TOTAL; it += NGW) {
        int r = it;
        if (r < IT_GU) { const int le = r >> 9, q = r & 511, kb = q >> 5, nb = q & 31;
            tr_item(KIN(I_WGU) + (size_t)le * 1024 * 2048, 1024, 2048, (bf16*)(ws + WS_WGU) + (size_t)le * 2048 * 1024, scr, kb, nb, lane, MapGu{}); continue; } r -= IT_GU;
        if (r < IT_DN) { const int le = r >> 8, q = r & 255, kb = q >> 4, nb = q & 15;
            tr_item(KIN(I_WDN) + (size_t)le * 1024 * 1024, 1024, 1024, (bf16*)(ws + WS_WD) + (size_t)le * 1024 * 1024, scr, kb, nb, lane, MapIdent{0}); continue; } r -= IT_DN;
        if (r < IT_IN) { const int l = r / (16 * 49), q = r % (16 * 49), kb = q / 49, nb = q % 49;
            tr_item(KIN(I_WIN) + (size_t)l * 1024 * PIN, 1024, PIN, (bf16*)(ws + WS_WIN) + (size_t)l * PINP * 1024, scr, kb, nb, lane, MapWin{}); continue; } r -= IT_IN;
        if (r < IT_OUT) { const int l = r >> 8, q = r & 255, kb = q >> 4, nb = q & 15;
            tr_item(KIN(I_WOUT) + (size_t)l * 1024 * 1024, 1024, 1024, (bf16*)(ws + WS_WOUT) + (size_t)l * 1024 * 1024, scr, kb, nb, lane, MapIdent{0}); continue; } r -= IT_OUT;
        if (r < IT_MEM) { const int l = r >> 7, q = r & 127, kv = q >> 6, kb = (q >> 2) & 15, nb = q & 3;
            tr_item((kv ? KIN(I_WMV) : KIN(I_WMK)) + (size_t)l * 1024 * 256, 1024, 256, (bf16*)(ws + WS_WMEM), scr, kb, nb, lane, MapIdent{l * 512 + kv * 256}); continue; } r -= IT_MEM;
        if (r < IT_L64) { const int l = r >> 3, q = r & 7, wa = q >> 2, nb = q & 3;
            tr_item((wa ? KIN(I_RWA2) : KIN(I_RWW2)) + (size_t)l * 64 * 256, 64, 256, (bf16*)(ws + WS_LORA) + (size_t)wa * (NL * 256 * 64) + (size_t)l * 256 * 64, scr, 0, nb, lane, MapIdent{0}); continue; } r -= IT_L64;
        { const int l = r >> 3, q = r & 7, kb = q >> 2, nb = q & 3;
            tr_item(KIN(I_RWG2) + (size_t)l * 128 * 256, 128, 256, (bf16*)(ws + WS_LORA) + (size_t)2 * (NL * 256 * 64) + (size_t)l * 256 * 128, scr, kb, nb, lane, MapIdent{0}); }
    }
    { const size_t gt = (size_t)vcu * NTHR + tid, GT = (size_t)G * NTHR; constexpr size_t per = (size_t)(PINP - PIN) * 1024 / 8;
        for (size_t i = gt; i < per * NL; i += GT) { const size_t l = i / per, j = i % per; *(u32x4*)((bf16*)(ws + WS_WIN) + l * PINP * 1024 + (size_t)PIN * 1024 + j * 8) = (u32x4){0u, 0u, 0u, 0u}; }
        for (size_t i = gt; i < (size_t)NL * NE * 2048; i += GT) { const size_t le = i >> 11; const int c = (int)(i & 2047); ((float*)(ws + WS_BGU))[le * 2048 + gu_row(c)] = KIN(I_BGU)[i]; }
        const f32x4* xs = (const f32x4*)KIN(I_X); u32x4* xd = (u32x4*)(ws + WS_XB);
        for (size_t i = gt; i < (size_t)NTOK * D / 8; i += GT) { const f32x4 v0 = xs[2 * i], v1 = xs[2 * i + 1]; xd[i] = (u32x4){pk2(v0[0], v0[1]), pk2(v0[2], v0[3]), pk2(v1[0], v1[1]), pk2(v1[2], v1[3])}; }
        const f32x4* ms = (const f32x4*)KIN(I_MEM); u32x4* md = (u32x4*)(ws + WS_MEMB);
        for (size_t i = gt; i < (size_t)NB * NMEM * D / 8; i += GT) { const f32x4 v0 = ms[2 * i], v1 = ms[2 * i + 1]; md[i] = (u32x4){pk2(v0[0], v0[1]), pk2(v0[2], v0[3]), pk2(v1[0], v1[1]), pk2(v1[2], v1[3])}; }
    }
}


__device__ __forceinline__ float log1pexp_neg_abs(float z) { return __builtin_amdgcn_logf(1.0f + fast_exp(-fabsf(z))) * 0.6931471805599453f; }
__device__ __forceinline__ float tanh_f(float x) { const float e = fast_exp(-2.0f * fabsf(x)); const float t = (1.0f - e) * __builtin_amdgcn_rcpf(1.0f + e); return x < 0.f ? -t : t; }

constexpr int NCH = T / 32;
__device__ __forceinline__ int rho16(int r, int hh) { return (r & 3) + 8 * (r >> 2) + 4 * hh; }
__device__ __forceinline__ void hg_fused_unit(LAS unsigned char* lds, int l, int b, int c) {
    const int tid = opaque_tid(), lane = tid & 63, wave = __builtin_amdgcn_readfirstlane(tid >> 6), r32 = lane & 31, hh = lane >> 5;
    unsigned char* ws = KWS();
    const bf16* P = (const bf16*)(ws + WS_P) + ((size_t)b * T + c * 32) * PINP;
    constexpr int HB = 8448;
    if (tid < 256) {
        const int ch = tid, h = ch >> 6, d = ch & 63; const size_t un = (size_t)(b * 4 + h) * NCH + c;
        float lb;
        { const float* hp = KIN(I_HGLB) + ch; const float v0 = hp[0], v1 = hp[256], v2 = hp[512], v3 = hp[768]; const float m = fmaxf(fmaxf(v0, v1), fmaxf(v2, v3));
          const float e0 = __expf(v0 - m), e1 = __expf(v1 - m), e2 = __expf(v2 - m), e3 = __expf(v3 - m); const float inv = 1.0f / (e0 + e1 + e2 + e3);
          lb = (l >= 1 ? e1 : 0.f) + (l >= 2 ? e2 : 0.f) + (l >= 3 ? e3 : 0.f); lb *= inv; }
        const float oml = 1.0f - lb;
        LAS bf16* KT = (LAS bf16*)(lds + h * HB); LAS float* BE = (LAS float*)(lds + h * HB + 8192);
        bf16* Qg = (bf16*)(ws + WS_HQ) + un * 2048 + d; bf16* Kg = (bf16*)(ws + WS_HK) + un * 2048 + d;
        float bc = 0.f;
#pragma unroll 1
        for (int t8 = 0; t8 < 4; ++t8) { u32x4 kp; float hq[8], hf[8];
#pragma unroll
            for (int e = 0; e < 8; ++e) { const bf16* row = P + (size_t)(t8 * 8 + e) * PINP; hq[e] = bf2f(row[PC_HQ + ch]); hf[e] = bf2f(row[PC_HF + ch]); }
#pragma unroll
            for (int jj = 0; jj < 4; ++jj) { float k2[2];
#pragma unroll
                for (int e = 0; e < 2; ++e) { const int t = t8 * 8 + jj * 2 + e; const float s = fast_sigmoid(hf[jj * 2 + e]), sn = fast_sigmoid(-hf[jj * 2 + e]);
                    bc = fmaxf(bc + __builtin_amdgcn_logf(fmaxf(lb + oml * s, 1e-30f)) * 0.6931471805599453f, -80.0f);
                    const float qt = silu_f(hq[jj * 2 + e]) * fast_exp(bc), kt = oml * sn * fast_exp(-bc);
                    Qg[t * 64] = (bf16)f2bf(qt); Kg[t * 64] = (bf16)f2bf(kt); k2[e] = kt; }
                kp[jj] = pk2(k2[0], k2[1]); }
            *(LAS u32x4*)(KT + d * 32 + t8 * 8) = kp; }
        const float ebend = fast_exp(bc); BE[d] = ebend; ((float*)(ws + WS_HBE))[un * 64 + d] = ebend;
    } else {
        const int cv = tid - 256, h = cv >> 6, vi = cv & 63; const size_t un = (size_t)(b * 4 + h) * NCH + c;
        LAS bf16* VT = (LAS bf16*)(lds + h * HB + 4096); bf16* VTg = (bf16*)(ws + WS_HVT) + un * 2048 + vi * 32;
#pragma unroll 1
        for (int t8 = 0; t8 < 4; ++t8) { u32x4 vp; float hv[8];
#pragma unroll
            for (int e = 0; e < 8; ++e) hv[e] = bf2f(P[(size_t)(t8 * 8 + e) * PINP + PC_HI + cv]);
#pragma unroll
            for (int jj = 0; jj < 4; ++jj) vp[jj] = pk2(hv[2 * jj], hv[2 * jj + 1]);
            *(LAS u32x4*)(VT + vi * 32 + t8 * 8) = vp; *(u32x4*)(VTg + t8 * 8) = vp; }
    }
    __syncthreads();
    { const int h = wave >> 1, vt = wave & 1; const size_t un = (size_t)(b * 4 + h) * NCH + c;
      const LAS bf16* KT = (const LAS bf16*)(lds + h * HB); const LAS bf16* VT = (const LAS bf16*)(lds + h * HB + 4096); const LAS float* BE = (const LAS float*)(lds + h * HB + 8192);
      float* DSg = (float*)(ws + WS_HDS) + un * 4096;
#pragma unroll
      for (int dt = 0; dt < 2; ++dt) { f32x16 acc;
#pragma unroll
          for (int i = 0; i < 16; ++i) acc[i] = 0.f;
#pragma unroll
          for (int s = 0; s < 2; ++s) { const bf16x8 A = *(const LAS bf16x8*)(VT + (32 * vt + r32) * 32 + 16 * s + 8 * hh), B = *(const LAS bf16x8*)(KT + (32 * dt + r32) * 32 + 16 * s + 8 * hh);
              acc = __builtin_amdgcn_mfma_f32_32x32x16_bf16(A, B, acc, 0, 0, 0); }
          const float ebd = BE[32 * dt + r32];
#pragma unroll
          for (int r = 0; r < 16; ++r) DSg[(32 * vt + rho16(r, hh)) * 64 + 32 * dt + r32] = acc[r] * ebd; } }
    __syncthreads();
}
__device__ __forceinline__ void gla_fused_unit(LAS unsigned char* lds, int l, int b, int c) {
    const int tid = opaque_tid(), lane = tid & 63, wave = __builtin_amdgcn_readfirstlane(tid >> 6), r32 = lane & 31, hh = lane >> 5;
    unsigned char* ws = KWS();
    const int t0 = c * 32;
    const bf16* P = (const bf16*)(ws + WS_P) + ((size_t)b * T + t0) * PINP;
    LAS float* GL = (LAS float*)lds;
    constexpr int HB = 6272, H0 = 2048;
    GL[tid] = bf2f(P[(size_t)(tid >> 4) * PINP + PC_GLR + (tid & 15)]);
    __syncthreads();
    if (tid < 128) {
        const int ch = tid, h = ch >> 5, d = ch & 31; const size_t un = (size_t)(b * 4 + h) * NCH + c;
        const float* cw = KIN(I_GLACONV) + (size_t)l * 4 * 512 + ch;
        const float q0 = cw[0], q1 = cw[512], q2 = cw[1024], q3 = cw[1536], k0 = cw[128], k1 = cw[640], k2w = cw[1152], k3 = cw[1664];
        const float* w2p = KIN(I_GLAW2) + (size_t)l * 16 * 128 + ch; float wc[16];
#pragma unroll
        for (int r = 0; r < 16; ++r) wc[r] = w2p[r * 128];
        const float gb = KIN(I_GLAB)[l * 128 + ch];
        float uq0 = 0.f, uq1 = 0.f, uq2 = 0.f, uk0 = 0.f, uk1 = 0.f, uk2 = 0.f;
        if (t0 > 0) { uq0 = bf2f(*(P - 3 * PINP + PC_GQ + ch)); uq1 = bf2f(*(P - 2 * PINP + PC_GQ + ch)); uq2 = bf2f(*(P - PINP + PC_GQ + ch));
                      uk0 = bf2f(*(P - 3 * PINP + PC_GK + ch)); uk1 = bf2f(*(P - 2 * PINP + PC_GK + ch)); uk2 = bf2f(*(P - PINP + PC_GK + ch)); }
        LAS bf16* KT = (LAS bf16*)(lds + H0 + h * HB); LAS float* BE = (LAS float*)(lds + H0 + h * HB + 6144);
        bf16* Qg = (bf16*)(ws + WS_GQ) + un * 1024 + d; bf16* Kg = (bf16*)(ws + WS_GK) + un * 1024 + d;
        float bc = 0.f;
#pragma unroll 1
        for (int t8 = 0; t8 < 4; ++t8) { u32x4 kp; float xq[8], xk[8];
#pragma unroll
            for (int e = 0; e < 8; ++e) { const bf16* row = P + (size_t)(t8 * 8 + e) * PINP; xq[e] = bf2f(row[PC_GQ + ch]); xk[e] = bf2f(row[PC_GK + ch]); }
#pragma unroll
            for (int jj = 0; jj < 4; ++jj) { float kk2[2];
#pragma unroll
                for (int e = 0; e < 2; ++e) { const int t = t8 * 8 + jj * 2 + e; const float uq3 = xq[jj * 2 + e], uk3 = xk[jj * 2 + e];
                    const float q = silu_f(q0 * uq0 + q1 * uq1 + q2 * uq2 + q3 * uq3) * 0.17677669529663687f, k = silu_f(k0 * uk0 + k1 * uk1 + k2w * uk2 + k3 * uk3);
                    uq0 = uq1; uq1 = uq2; uq2 = uq3; uk0 = uk1; uk1 = uk2; uk2 = uk3;
                    float z = gb;
#pragma unroll
                    for (int r = 0; r < 16; ++r) z += GL[t * 16 + r] * wc[r];
                    bc = fmaxf(bc + (fminf(z, 0.f) - log1pexp_neg_abs(z)) * 0.0625f, -80.0f);
                    const float qt = q * fast_exp(bc), kt = k * fast_exp(-bc);
                    Qg[t * 32] = (bf16)f2bf(qt); Kg[t * 32] = (bf16)f2bf(kt); kk2[e] = kt; }
                kp[jj] = pk2(kk2[0], kk2[1]); }
            *(LAS u32x4*)(KT + d * 32 + t8 * 8) = kp; }
        const float ebend = fast_exp(bc); BE[d] = ebend; ((float*)(ws + WS_GBE))[un * 32 + d] = ebend;
    } else if (tid < 384) {
        const int cv = tid - 128, h = cv >> 6, vi = cv & 63; const size_t un = (size_t)(b * 4 + h) * NCH + c;
        const float* cw = KIN(I_GLACONV) + (size_t)l * 4 * 512 + 256 + cv;
        const float w0 = cw[0], w1 = cw[512], w2 = cw[1024], w3 = cw[1536];
        float u0 = 0.f, u1 = 0.f, u2 = 0.f;
        if (t0 > 0) { u0 = bf2f(*(P - 3 * PINP + PC_GV + cv)); u1 = bf2f(*(P - 2 * PINP + PC_GV + cv)); u2 = bf2f(*(P - PINP + PC_GV + cv)); }
        LAS bf16* VT = (LAS bf16*)(lds + H0 + h * HB + 2048); bf16* VTg = (bf16*)(ws + WS_GVT) + un * 2048 + vi * 32;
#pragma unroll 1
        for (int t8 = 0; t8 < 4; ++t8) { u32x4 vp; float xv[8], yv[8];
#pragma unroll
            for (int e = 0; e < 8; ++e) xv[e] = bf2f(P[(size_t)(t8 * 8 + e) * PINP + PC_GV + cv]);
#pragma unroll
            for (int e = 0; e < 8; ++e) { const float u3 = xv[e]; yv[e] = silu_f(w0 * u0 + w1 * u1 + w2 * u2 + w3 * u3); u0 = u1; u1 = u2; u2 = u3; }
#pragma unroll
            for (int jj = 0; jj < 4; ++jj) vp[jj] = pk2(yv[2 * jj], yv[2 * jj + 1]);
            *(LAS u32x4*)(VT + vi * 32 + t8 * 8) = vp; *(u32x4*)(VTg + t8 * 8) = vp; }
    }
    __syncthreads();
    { const int h = wave >> 1, vt = wave & 1; const size_t un = (size_t)(b * 4 + h) * NCH + c;
      const LAS bf16* KT = (const LAS bf16*)(lds + H0 + h * HB); const LAS bf16* VT = (const LAS bf16*)(lds + H0 + h * HB + 2048); const LAS float* BE = (const LAS float*)(lds + H0 + h * HB + 6144);
      float* DSg = (float*)(ws + WS_GDS) + un * 2048;
      f32x16 acc;
#pragma unroll
      for (int i = 0; i < 16; ++i) acc[i] = 0.f;
#pragma unroll
      for (int s = 0; s < 2; ++s) { const bf16x8 A = *(const LAS bf16x8*)(VT + (32 * vt + r32) * 32 + 16 * s + 8 * hh), B = *(const LAS bf16x8*)(KT + r32 * 32 + 16 * s + 8 * hh);
          acc = __builtin_amdgcn_mfma_f32_32x32x16_bf16(A, B, acc, 0, 0, 0); }
      const float ebd = BE[r32];
#pragma unroll
      for (int r = 0; r < 16; ++r) DSg[(32 * vt + rho16(r, hh)) * 32 + r32] = acc[r] * ebd; }
    __syncthreads();
}
template <int DK>
__device__ __forceinline__ void m2_gh_elem(int e, const float* __restrict__ DS, const float* __restrict__ BE, bf16* __restrict__ SG) {
    constexpr int EPB = 64 * DK; const int bh = e / EPB, idx = e % EPB, d = idx % DK; const size_t un0 = (size_t)bh * NCH;
    float S = 0.f;
#pragma unroll 1
    for (int c0 = 0; c0 < NCH; c0 += 8) { float ds[8], be[8];
#pragma unroll
        for (int u = 0; u < 8; ++u) { ds[u] = DS[(un0 + c0 + u) * EPB + idx]; be[u] = BE[(un0 + c0 + u) * DK + d]; }
#pragma unroll
        for (int u = 0; u < 8; ++u) { SG[(un0 + c0 + u) * EPB + idx] = (bf16)f2bf(S); S = S * be[u] + ds[u]; } }
}
template <int DK>
__device__ __forceinline__ void m3_gh_task(int lane, const bf16* __restrict__ Qg, const bf16* __restrict__ Kg, const bf16* __restrict__ VTg, const bf16* __restrict__ Sg,
                                           const bf16* __restrict__ gate  , const float* __restrict__ ng  , bf16* __restrict__ orow  ) {
    const int r32 = lane & 31, hh = lane >> 5;
    bf16x8 qf[DK / 16];
    f32x16 at;
#pragma unroll
    for (int i = 0; i < 16; ++i) at[i] = 0.f;
#pragma unroll
    for (int s = 0; s < DK / 16; ++s) { qf[s] = *(const bf16x8*)(Qg + r32 * DK + 16 * s + 8 * hh); const bf16x8 kf = *(const bf16x8*)(Kg + r32 * DK + 16 * s + 8 * hh);
        at = __builtin_amdgcn_mfma_f32_32x32x16_bf16(kf, qf[s], at, 0, 0, 0); }
#pragma unroll
    for (int r = 0; r < 16; ++r) if (rho16(r, hh) > r32) at[r] = 0.f;
    f32x16 o[2];
#pragma unroll
    for (int vt = 0; vt < 2; ++vt)
#pragma unroll
        for (int i = 0; i < 16; ++i) o[vt][i] = 0.f;
#pragma unroll
    for (int s = 0; s < 2; ++s) { union { bf16x8 v; unsigned w[4]; } pf;
#pragma unroll
        for (int j = 0; j < 4; ++j) pf.w[j] = cvt_pk_bf16(at[8 * s + 2 * j], at[8 * s + 2 * j + 1]);
#pragma unroll
        for (int vt = 0; vt < 2; ++vt) { const bf16* vp = VTg + (32 * vt + r32) * 32 + 16 * s + 4 * hh;
            union { bf16x8 v; s16x4 h2[2]; } vf; vf.h2[0] = *(const s16x4*)vp; vf.h2[1] = *(const s16x4*)(vp + 8);
            o[vt] = __builtin_amdgcn_mfma_f32_32x32x16_bf16(vf.v, pf.v, o[vt], 0, 0, 0); } }
#pragma unroll
    for (int vt = 0; vt < 2; ++vt)
#pragma unroll
        for (int s = 0; s < DK / 16; ++s) { const bf16x8 sf = *(const bf16x8*)(Sg + (32 * vt + r32) * DK + 16 * s + 8 * hh);
            o[vt] = __builtin_amdgcn_mfma_f32_32x32x16_bf16(sf, qf[s], o[vt], 0, 0, 0); }
    float ss = 0.f;
#pragma unroll
    for (int vt = 0; vt < 2; ++vt)
#pragma unroll
        for (int i = 0; i < 16; ++i) ss += o[vt][i] * o[vt][i];
    ss += __shfl_xor(ss, 32);
    const float rstd = 1.0f / sqrtf(ss * (1.0f / 64.0f) + RMS_EPS);
    const bf16* grow = gate + (size_t)r32 * PINP; bf16* od = orow + (size_t)r32 * D;
#pragma unroll
    for (int vt = 0; vt < 2; ++vt)
#pragma unroll
        for (int g = 0; g < 4; ++g) { const int v0 = 32 * vt + 8 * g + 4 * hh; const u32x2 gw = *(const u32x2*)(grow + v0); const f32x4 n4 = *(const f32x4*)(ng + v0);
            const float y0 = o[vt][4 * g] * rstd * n4[0] * silu_f(bflo(gw.x)), y1 = o[vt][4 * g + 1] * rstd * n4[1] * silu_f(bfhi(gw.x));
            const float y2 = o[vt][4 * g + 2] * rstd * n4[2] * silu_f(bflo(gw.y)), y3 = o[vt][4 * g + 3] * rstd * n4[3] * silu_f(bfhi(gw.y));
            *(u32x2*)(od + v0) = (u32x2){pk2(y0, y1), pk2(y2, y3)}; }
}

constexpr int RWC_HEADB = 28928;
constexpr int RWC_AL = 4 * RWC_HEADB, RWC_LWL = RWC_AL + 32 * 264 * 2;
static_assert(RWC_LWL + 32 * 264 * 2 <= LDSCTL_OFF, "rw_fused_unit LDS");
__device__ __forceinline__ void rw_fused_unit(LAS unsigned char* lds, int l, int b, int c) {
    const int tid = opaque_tid(), lane = tid & 63, wave = __builtin_amdgcn_readfirstlane(tid >> 6), h = wave >> 1, p = wave & 1, r32 = lane & 31, hh = lane >> 5;
    unsigned char* ws = KWS();
    const int bh = b * 4 + h; const size_t un = (size_t)bh * NCH + c;
    const int t0 = c * 32;
    const bf16* P = (const bf16*)(ws + WS_P) + ((size_t)b * T + t0) * PINP + PC_RW;
    const float* mu = KIN(I_RWMU) + (size_t)l * 1024;
    LAS bf16* XL = (LAS bf16*)lds;
    LAS bf16* AL = (LAS bf16*)(lds + RWC_AL);
    LAS bf16* LWL = (LAS bf16*)(lds + RWC_LWL);
    for (int i = tid; i < 32 * 256; i += NTHR) { const int tok = i >> 8, cc = i & 255;
        const bf16* row = P + (size_t)tok * PINP + 768 + cc;
        const float cur = bf2f(row[0]), prev = (t0 + tok > 0) ? bf2f(*(row - PINP)) : 0.f;
        float x = cur + (prev - cur) * mu[768 + cc];
        if (cc < 64) x = tanh_f(x); else if (cc >= 128) x = fast_sigmoid(x);
        XL[tok * 264 + cc] = (bf16)f2bf(x); }
    __syncthreads();
    {
        const int ch = wave * 32 + r32;
        const bf16* w2T = (const bf16*)(ws + WS_LORA) + (size_t)l * 256 * 64 + (size_t)ch * 64;
        const bf16* a2T = (const bf16*)(ws + WS_LORA) + (size_t)(NL * 256 * 64) + (size_t)l * 256 * 64 + (size_t)ch * 64;
        const bf16* g2T = (const bf16*)(ws + WS_LORA) + (size_t)2 * (NL * 256 * 64) + (size_t)l * 256 * 128 + (size_t)ch * 128;
        const LAS bf16* xa = XL + r32 * 264 + 8 * hh;
        {
            f32x16 acc;
#pragma unroll
            for (int i = 0; i < 16; ++i) acc[i] = 0.f;
#pragma unroll
            for (int s = 0; s < 4; ++s) { const bf16x8 A = *(const LAS bf16x8*)(xa + 16 * s); const bf16x8 Bw = *(const bf16x8*)(w2T + 16 * s + 8 * hh);
                acc = __builtin_amdgcn_mfma_f32_32x32x16_bf16(A, Bw, acc, 0, 0, 0); }
            const float w0c = KIN(I_RWW0)[l * 256 + ch];
#pragma unroll
            for (int r = 0; r < 16; ++r) { const int tok = rho16(r, hh);
                const float zw = w0c + acc[r]; const float wlog = -(fmaxf(-zw, 0.f) + log1pexp_neg_abs(zw)) - 0.5f;
                LWL[tok * 264 + ch] = (bf16)f2bf(-fast_exp(wlog)); }
        }
        __builtin_amdgcn_sched_barrier(0);
        {
            f32x16 acc;
#pragma unroll
            for (int i = 0; i < 16; ++i) acc[i] = 0.f;
#pragma unroll
            for (int s = 0; s < 4; ++s) { const bf16x8 A = *(const LAS bf16x8*)(xa + 64 + 16 * s); const bf16x8 Bw = *(const bf16x8*)(a2T + 16 * s + 8 * hh);
                acc = __builtin_amdgcn_mfma_f32_32x32x16_bf16(A, Bw, acc, 0, 0, 0); }
            const float a0c = KIN(I_RWA0)[l * 256 + ch];
#pragma unroll
            for (int r = 0; r < 16; ++r) AL[rho16(r, hh) * 264 + ch] = (bf16)f2bf(fast_sigmoid(a0c + acc[r]));
        }
        __builtin_amdgcn_sched_barrier(0);
        {
            f32x16 acc;
#pragma unroll
            for (int i = 0; i < 16; ++i) acc[i] = 0.f;
#pragma unroll
            for (int s = 0; s < 8; ++s) { const bf16x8 A = *(const LAS bf16x8*)(xa + 128 + 16 * s); const bf16x8 Bw = *(const bf16x8*)(g2T + 16 * s + 8 * hh);
                acc = __builtin_amdgcn_mfma_f32_32x32x16_bf16(A, Bw, acc, 0, 0, 0); }
            bf16* gb = (bf16*)(ws + WS_GBUF) + ((size_t)b * T + t0) * 256 + ch;
#pragma unroll
            for (int r = 0; r < 16; ++r) gb[(size_t)rho16(r, hh) * 256] = (bf16)f2bf(acc[r]);
        }
    }
    __syncthreads();
    LAS unsigned char* L = lds + h * RWC_HEADB;
    LAS bf16* AT = (LAS bf16*)L;
    LAS bf16* BT = (LAS bf16*)(L + 4096);
    LAS bf16* KT = (LAS bf16*)(L + 8192);
    LAS bf16* ATT = (LAS bf16*)(L + 12288);
    LAS bf16* BHT = (LAS bf16*)(L + 16384);
    LAS bf16* KHT = (LAS bf16*)(L + 20480);
    LAS bf16* VT = (LAS bf16*)(L + 24576);
    LAS float* GC = (LAS float*)(L + 28672);
    LAS float* MAB = (LAS float*)(L + 4096);
    LAS bf16* MAK = (LAS bf16*)(L + 8192);
    LAS bf16* TM = (LAS bf16*)L;
    if (wave < 4) {
        const int hs = wave, d = lane, ch = hs * 64 + d; const size_t uns = (size_t)(b * 4 + hs) * NCH + c;
        LAS unsigned char* Ls = lds + hs * RWC_HEADB;
        LAS bf16* sAT = (LAS bf16*)Ls; LAS bf16* sBT = (LAS bf16*)(Ls + 4096); LAS bf16* sKT = (LAS bf16*)(Ls + 8192);
        LAS bf16* sATT = (LAS bf16*)(Ls + 12288); LAS bf16* sBHT = (LAS bf16*)(Ls + 16384); LAS bf16* sKHT = (LAS bf16*)(Ls + 20480); LAS float* sGC = (LAS float*)(Ls + 28672);
        const float mr = mu[ch], mk = mu[256 + ch];
        const float kkc = KIN(I_RWKK)[l * 256 + ch], kac = KIN(I_RWKA)[l * 256 + ch], rkc = KIN(I_RWRK)[l * 256 + ch];
        float lgend = 0.f;
#pragma unroll 8
        for (int t = 0; t < 32; ++t) lgend += bf2f(LWL[t * 264 + ch]);
        bf16* RGp = (bf16*)(ws + WS_RR) + uns * 2048 + d; bf16* BGp = (bf16*)(ws + WS_RB) + uns * 2048 + d; bf16* KGp = (bf16*)(ws + WS_RK) + uns * 2048 + d;
        float* bonp = (float*)(ws + WS_BONUS) + ((size_t)b * T + t0) * 4 + hs;
        float lg = 0.f;
        float rprev = 0.f, kprev = 0.f;
        if (t0 > 0) { rprev = bf2f(*(P - PINP + ch)); kprev = bf2f(*(P - PINP + 256 + ch)); }
#pragma unroll 1
        for (int t8 = 0; t8 < 4; ++t8) { u32x4 ap, bp, kp; float xr[8], xk[8];
#pragma unroll
            for (int e = 0; e < 8; ++e) { const bf16* row = P + (size_t)(t8 * 8 + e) * PINP; xr[e] = bf2f(row[ch]); xk[e] = bf2f(row[256 + ch]); }
#pragma unroll
            for (int jj = 0; jj < 4; ++jj) { float at2[2], bh2[2], kh2[2];
#pragma unroll
                for (int e = 0; e < 2; ++e) { const int t = t8 * 8 + jj * 2 + e;
                    const float rc = xr[jj * 2 + e], kc = xk[jj * 2 + e];
                    const float r = rc + (rprev - rc) * mr, k = kc + (kprev - kc) * mk; rprev = rc; kprev = kc;
                    const float av = bf2f(AL[t * 264 + ch]), lw = bf2f(LWL[t * 264 + ch]);
                    const float kkr = k * kkc, hk = k * (1.0f + (av - 1.0f) * kac);
                    const float ss = wave_sum(kkr * kkr); const float kk = kkr / fmaxf(sqrtf(ss), 1e-12f);
                    const float bon = wave_sum(r * hk * rkc);
                    const float aa = -kk, bb = kk * av;
                    const float lgp = lg; lg += lw;
                    const float at = aa * fast_exp(lgp), rt = r * fast_exp(lg), ei = fast_exp(-lg), bt = bb * ei, kt = hk * ei, eh = fast_exp(lgend - lg);
                    sAT[t * 64 + d] = (bf16)f2bf(at); sBT[t * 64 + d] = (bf16)f2bf(bt); sKT[t * 64 + d] = (bf16)f2bf(kt);
                    RGp[t * 64] = (bf16)f2bf(rt); BGp[t * 64] = (bf16)f2bf(bt); KGp[t * 64] = (bf16)f2bf(kt);
                    if (d == 0) bonp[t * 4] = bon;
                    at2[e] = at; bh2[e] = bb * eh; kh2[e] = hk * eh; }
                ap[jj] = pk2(at2[0], at2[1]); bp[jj] = pk2(bh2[0], bh2[1]); kp[jj] = pk2(kh2[0], kh2[1]); }
            *(LAS u32x4*)(sATT + d * 32 + t8 * 8) = ap; *(LAS u32x4*)(sBHT + d * 32 + t8 * 8) = bp; *(LAS u32x4*)(sKHT + d * 32 + t8 * 8) = kp; }
        sGC[d] = fast_exp(lgend);
    } else {
        const int cv = tid - 256, hs = cv >> 6, vi = cv & 63; const size_t uns = (size_t)(b * 4 + hs) * NCH + c;
        LAS bf16* sVT = (LAS bf16*)(lds + hs * RWC_HEADB + 24576);
        bf16* VTg = (bf16*)(ws + WS_RVT) + uns * 2048 + vi * 32; bf16* VGp = (bf16*)(ws + WS_RVG) + uns * 2048 + vi;
        const float mv = mu[512 + cv];
        float vprev = 0.f; if (t0 > 0) vprev = bf2f(*(P - PINP + 512 + cv));
#pragma unroll 1
        for (int t8 = 0; t8 < 4; ++t8) { u32x4 vp; float xv[8], yv[8];
#pragma unroll
            for (int e = 0; e < 8; ++e) xv[e] = bf2f(P[(size_t)(t8 * 8 + e) * PINP + 512 + cv]);
#pragma unroll
            for (int e = 0; e < 8; ++e) { yv[e] = xv[e] + (vprev - xv[e]) * mv; vprev = xv[e]; VGp[(t8 * 8 + e) * 64] = (bf16)f2bf(yv[e]); }
#pragma unroll
            for (int jj = 0; jj < 4; ++jj) vp[jj] = pk2(yv[2 * jj], yv[2 * jj + 1]);
            *(LAS u32x4*)(sVT + vi * 32 + t8 * 8) = vp; *(u32x4*)(VTg + t8 * 8) = vp; }
    }
    __syncthreads();
    f32x16 accR[2];
    {
        f32x16 acc;
#pragma unroll
        for (int i = 0; i < 16; ++i) acc[i] = 0.f;
        const LAS bf16* Bsrc = p == 0 ? BT : KT;
#pragma unroll
        for (int s = 0; s < 4; ++s) { const bf16x8 A = *(const LAS bf16x8*)(AT + r32 * 64 + 16 * s + 8 * hh), B = *(const LAS bf16x8*)(Bsrc + r32 * 64 + 16 * s + 8 * hh);
            acc = __builtin_amdgcn_mfma_f32_32x32x16_bf16(A, B, acc, 0, 0, 0); }
        if (p == 0) {
#pragma unroll
            for (int r = 0; r < 16; ++r) { const int t = rho16(r, hh); MAB[t * 32 + r32] = (r32 < t) ? acc[r] : 0.f; }
        } else {
#pragma unroll
            for (int r = 0; r < 16; ++r) { const int t = rho16(r, hh); MAK[t * 32 + r32] = (bf16)f2bf((r32 < t) ? acc[r] : 0.f); }
        }
    }
    __syncthreads();
    if (p == 0) {
        const int cidx = r32; float tc[32];
#pragma unroll
        for (int t = 0; t < 32; ++t) { float acc0 = (t == cidx) ? 1.0f : 0.f, acc1 = 0.f;
#pragma unroll
            for (int s4 = 0; s4 < (t + 3) / 4; ++s4) { const f32x4 m4 = *(const LAS f32x4*)(MAB + t * 32 + 4 * s4);
#pragma unroll
                for (int e = 0; e < 4; ++e) { const int s = 4 * s4 + e; if (s < t) { if (e & 1) acc1 = fmaf(m4[e], tc[s], acc1); else acc0 = fmaf(m4[e], tc[s], acc0); } } }
            tc[t] = acc0 + acc1; }
#pragma unroll
        for (int t = 0; t < 32; ++t) if (hh == 0) TM[t * 32 + cidx] = (bf16)f2bf(tc[t]);
    } else {
#pragma unroll
        for (int vt = 0; vt < 2; ++vt) {
#pragma unroll
            for (int i = 0; i < 16; ++i) accR[vt][i] = 0.f;
#pragma unroll
            for (int s = 0; s < 2; ++s) { const bf16x8 A = *(const LAS bf16x8*)(MAK + r32 * 32 + 16 * s + 8 * hh), B = *(const LAS bf16x8*)(VT + (32 * vt + r32) * 32 + 16 * s + 8 * hh);
                accR[vt] = __builtin_amdgcn_mfma_f32_32x32x16_bf16(A, B, accR[vt], 0, 0, 0); } }
    }
    __syncthreads();
    if (p == 0) {
        f32x16 accW[2];
#pragma unroll
        for (int dt = 0; dt < 2; ++dt) {
#pragma unroll
            for (int i = 0; i < 16; ++i) accW[dt][i] = 0.f;
#pragma unroll
            for (int s = 0; s < 2; ++s) { const bf16x8 A = *(const LAS bf16x8*)(TM + r32 * 32 + 16 * s + 8 * hh), B = *(const LAS bf16x8*)(ATT + (32 * dt + r32) * 32 + 16 * s + 8 * hh);
                accW[dt] = __builtin_amdgcn_mfma_f32_32x32x16_bf16(A, B, accW[dt], 0, 0, 0); } }
        bf16* WGp = (bf16*)(ws + WS_RW) + un * 2048;
#pragma unroll
        for (int dt = 0; dt < 2; ++dt)
#pragma unroll
            for (int r = 0; r < 16; ++r) WGp[rho16(r, hh) * 64 + 32 * dt + r32] = (bf16)f2bf(accW[dt][r]);
        bf16* PFp = (bf16*)(ws + WS_RP) + un * 4096;
        const int xs = r32 >> 4, xx = r32 & 15, hhA = (xx >> 2) & 1, jA = 4 * (xx >> 3) + (xx & 3);
#pragma unroll
        for (int dt = 0; dt < 2; ++dt)
#pragma unroll
            for (int dt2 = 0; dt2 < 2; ++dt2) { f32x16 acc;
#pragma unroll
                for (int i = 0; i < 16; ++i) acc[i] = 0.f;
#pragma unroll
                for (int s = 0; s < 2; ++s) { const LAS bf16* bp = BHT + (32 * dt + r32) * 32 + 16 * s + 4 * hh;
                    union { bf16x8 v; s16x4 h2[2]; } af; af.h2[0] = *(const LAS s16x4*)bp; af.h2[1] = *(const LAS s16x4*)(bp + 8);
                    union { bf16x8 v; unsigned w[4]; } bf;
#pragma unroll
                    for (int j = 0; j < 4; ++j) bf.w[j] = cvt_pk_bf16(accW[dt2][8 * s + 2 * j], accW[dt2][8 * s + 2 * j + 1]);
                    acc = __builtin_amdgcn_mfma_f32_32x32x16_bf16(af.v, bf.v, acc, 0, 0, 0); }
                if (dt == dt2) { const float gc = GC[32 * dt + r32];
#pragma unroll
                    for (int r = 0; r < 16; ++r) if (rho16(r, hh) == r32) acc[r] += gc; }
                bf16* pf = PFp + ((size_t)((dt * 2 + dt2) * 2 + xs) * 64 + 32 * hhA) * 8 + jA;
#pragma unroll
                for (int r = 0; r < 16; ++r) pf[rho16(r, hh) * 8] = (bf16)f2bf(acc[r]); }
    } else {
        f32x16 accU[2];
#pragma unroll
        for (int vt = 0; vt < 2; ++vt) {
#pragma unroll
            for (int i = 0; i < 16; ++i) accU[vt][i] = 0.f;
#pragma unroll
            for (int s = 0; s < 2; ++s) { const LAS bf16* tp = TM + r32 * 32 + 16 * s + 4 * hh;
                union { bf16x8 v; s16x4 h2[2]; } af; af.h2[0] = *(const LAS s16x4*)tp; af.h2[1] = *(const LAS s16x4*)(tp + 8);
                union { bf16x8 v; unsigned w[4]; } bf;
#pragma unroll
                for (int j = 0; j < 4; ++j) bf.w[j] = cvt_pk_bf16(accR[vt][8 * s + 2 * j], accR[vt][8 * s + 2 * j + 1]);
                accU[vt] = __builtin_amdgcn_mfma_f32_32x32x16_bf16(af.v, bf.v, accU[vt], 0, 0, 0); } }
        float* UGp = (float*)(ws + WS_RU) + un * 2048;
#pragma unroll
        for (int vt = 0; vt < 2; ++vt)
#pragma unroll
            for (int g = 0; g < 4; ++g) *(f32x4*)(UGp + ((vt * 4 + g) * 64 + lane) * 4) = (f32x4){accU[vt][4 * g], accU[vt][4 * g + 1], accU[vt][4 * g + 2], accU[vt][4 * g + 3]};
        float* QFp = (float*)(ws + WS_RQ) + un * 4096;
#pragma unroll
        for (int vt = 0; vt < 2; ++vt)
#pragma unroll
            for (int dt = 0; dt < 2; ++dt) { f32x16 acc;
#pragma unroll
                for (int i = 0; i < 16; ++i) acc[i] = 0.f;
#pragma unroll
                for (int s = 0; s < 2; ++s) { const LAS bf16* bp = BHT + (32 * dt + r32) * 32 + 16 * s + 4 * hh;
                    union { bf16x8 v; s16x4 h2[2]; } af; af.h2[0] = *(const LAS s16x4*)bp; af.h2[1] = *(const LAS s16x4*)(bp + 8);
                    union { bf16x8 v; unsigned w[4]; } bf;
#pragma unroll
                    for (int j = 0; j < 4; ++j) bf.w[j] = cvt_pk_bf16(accU[vt][8 * s + 2 * j], accU[vt][8 * s + 2 * j + 1]);
                    acc = __builtin_amdgcn_mfma_f32_32x32x16_bf16(af.v, bf.v, acc, 0, 0, 0);
                    const bf16x8 A2 = *(const LAS bf16x8*)(KHT + (32 * dt + r32) * 32 + 16 * s + 8 * hh), B2 = *(const LAS bf16x8*)(VT + (32 * vt + r32) * 32 + 16 * s + 8 * hh);
                    acc = __builtin_amdgcn_mfma_f32_32x32x16_bf16(A2, B2, acc, 0, 0, 0); }
#pragma unroll
                for (int g = 0; g < 4; ++g) *(f32x4*)(QFp + (((vt * 2 + dt) * 4 + g) * 64 + lane) * 4) = (f32x4){acc[4 * g], acc[4 * g + 1], acc[4 * g + 2], acc[4 * g + 3]}; }
    }
    __syncthreads();
}
__device__ __forceinline__ void rw_m2_wave(int lane, int bh, int vt) {
    unsigned char* ws = KWS();
    const bf16* PF = (const bf16*)(ws + WS_RP) + (size_t)bh * NCH * 4096 + lane * 8;
    const float* QF = (const float*)(ws + WS_RQ) + (size_t)bh * NCH * 4096 + (size_t)vt * 2048 + lane * 4;
    bf16* SG = (bf16*)(ws + WS_RS) + (size_t)bh * NCH * 4096 + (size_t)vt * 2048 + lane * 8;
    f32x16 S[2];
#pragma unroll
    for (int dt = 0; dt < 2; ++dt)
#pragma unroll
        for (int i = 0; i < 16; ++i) S[dt][i] = 0.f;
    bf16x8 pA[8], pB[8]; f32x4 qA[8], qB[8];
#define RWM2_LOAD(P_, Q_, c_) do { const int _c = (c_) < NCH ? (c_) : NCH - 1; _Pragma("unroll") for (int f = 0; f < 8; ++f) { P_[f] = *(const bf16x8*)(PF + (size_t)_c * 4096 + f * 512); Q_[f] = *(const f32x4*)(QF + (size_t)_c * 4096 + f * 256); } } while (0)
#define RWM2_STEP(P_, Q_, c_) do { \
        union { bf16x8 v; unsigned w[4]; } sb[2][2]; \
        _Pragma("unroll") for (int dt2 = 0; dt2 < 2; ++dt2) _Pragma("unroll") for (int s = 0; s < 2; ++s) { \
            _Pragma("unroll") for (int j = 0; j < 4; ++j) sb[dt2][s].w[j] = cvt_pk_bf16(S[dt2][8 * s + 2 * j], S[dt2][8 * s + 2 * j + 1]); \
            *(bf16x8*)(SG + (size_t)(c_) * 4096 + (dt2 * 2 + s) * 512) = sb[dt2][s].v; } \
        f32x16 N[2]; \
        _Pragma("unroll") for (int dt = 0; dt < 2; ++dt) { \
            _Pragma("unroll") for (int g = 0; g < 4; ++g) { N[dt][4 * g] = Q_[dt * 4 + g][0]; N[dt][4 * g + 1] = Q_[dt * 4 + g][1]; N[dt][4 * g + 2] = Q_[dt * 4 + g][2]; N[dt][4 * g + 3] = Q_[dt * 4 + g][3]; } \
            _Pragma("unroll") for (int dt2 = 0; dt2 < 2; ++dt2) _Pragma("unroll") for (int s = 0; s < 2; ++s) N[dt] = __builtin_amdgcn_mfma_f32_32x32x16_bf16(P_[(dt * 2 + dt2) * 2 + s], sb[dt2][s].v, N[dt], 0, 0, 0); } \
        S[0] = N[0]; S[1] = N[1]; } while (0)
    RWM2_LOAD(pA, qA, 0); RWM2_LOAD(pB, qB, 1);
#pragma unroll 1
    for (int c = 0; c < NCH; c += 2) {
        RWM2_STEP(pA, qA, c); RWM2_LOAD(pA, qA, c + 2);
        RWM2_STEP(pB, qB, c + 1); RWM2_LOAD(pB, qB, c + 3);
    }
#undef RWM2_LOAD
#undef RWM2_STEP
}
__device__ __forceinline__ bf16x8 ld_perm8(const bf16* p) { union { bf16x8 v; s16x4 h2[2]; } f; f.h2[0] = *(const s16x4*)p; f.h2[1] = *(const s16x4*)(p + 8); return f.v; }
__device__ __forceinline__ void rw_m3_task(int lane, int l, int bh, int c) {
    unsigned char* ws = KWS();
    const int r32 = lane & 31, hh = lane >> 5, b = bh >> 2, h = bh & 3; const size_t un = (size_t)bh * NCH + c; const size_t tok0 = (size_t)b * T + c * 32;
    const bf16* RGp = (const bf16*)(ws + WS_RR) + un * 2048 + r32 * 64 + 4 * hh; const bf16* BGp = (const bf16*)(ws + WS_RB) + un * 2048 + r32 * 64 + 4 * hh;
    const bf16* KGp = (const bf16*)(ws + WS_RK) + un * 2048 + r32 * 64 + 4 * hh; const bf16* WGp = (const bf16*)(ws + WS_RW) + un * 2048 + r32 * 64 + 4 * hh;
    const bf16* SGp = (const bf16*)(ws + WS_RS) + un * 4096 + lane * 8; const bf16* VTp = (const bf16*)(ws + WS_RVT) + un * 2048 + r32 * 32 + 4 * hh;
    const float* UGp = (const float*)(ws + WS_RU) + un * 2048 + lane * 4;
    f32x16 U[2], Y[2], mb, mk;
#pragma unroll
    for (int vt = 0; vt < 2; ++vt)
#pragma unroll
        for (int g = 0; g < 4; ++g) { const f32x4 u4 = *(const f32x4*)(UGp + (vt * 4 + g) * 256); U[vt][4 * g] = u4[0]; U[vt][4 * g + 1] = u4[1]; U[vt][4 * g + 2] = u4[2]; U[vt][4 * g + 3] = u4[3]; }
#pragma unroll
    for (int i = 0; i < 16; ++i) { mb[i] = 0.f; mk[i] = 0.f; Y[0][i] = 0.f; Y[1][i] = 0.f; }
#pragma unroll
    for (int ks = 0; ks < 4; ++ks) {
        const bf16x8 rf = ld_perm8(RGp + 16 * ks), wf = ld_perm8(WGp + 16 * ks), bfr = ld_perm8(BGp + 16 * ks), kfr = ld_perm8(KGp + 16 * ks);
        const bf16x8 s0 = *(const bf16x8*)(SGp + ks * 512), s1 = *(const bf16x8*)(SGp + 2048 + ks * 512);
        U[0] = __builtin_amdgcn_mfma_f32_32x32x16_bf16(wf, s0, U[0], 0, 0, 0); U[1] = __builtin_amdgcn_mfma_f32_32x32x16_bf16(wf, s1, U[1], 0, 0, 0);
        mb = __builtin_amdgcn_mfma_f32_32x32x16_bf16(bfr, rf, mb, 0, 0, 0); mk = __builtin_amdgcn_mfma_f32_32x32x16_bf16(kfr, rf, mk, 0, 0, 0);
        Y[0] = __builtin_amdgcn_mfma_f32_32x32x16_bf16(s0, rf, Y[0], 0, 0, 0); Y[1] = __builtin_amdgcn_mfma_f32_32x32x16_bf16(s1, rf, Y[1], 0, 0, 0); }
#pragma unroll
    for (int r = 0; r < 16; ++r) if (rho16(r, hh) > r32) { mb[r] = 0.f; mk[r] = 0.f; }
#pragma unroll
    for (int s = 0; s < 2; ++s) { union { bf16x8 v; unsigned w[4]; } fb, fk;
#pragma unroll
        for (int j = 0; j < 4; ++j) { fb.w[j] = cvt_pk_bf16(mb[8 * s + 2 * j], mb[8 * s + 2 * j + 1]); fk.w[j] = cvt_pk_bf16(mk[8 * s + 2 * j], mk[8 * s + 2 * j + 1]); }
#pragma unroll
        for (int vt = 0; vt < 2; ++vt) { union { bf16x8 v; unsigned w[4]; } fu;
#pragma unroll
            for (int j = 0; j < 4; ++j) fu.w[j] = cvt_pk_bf16(U[vt][8 * s + 2 * j], U[vt][8 * s + 2 * j + 1]);
            Y[vt] = __builtin_amdgcn_mfma_f32_32x32x16_bf16(fu.v, fb.v, Y[vt], 0, 0, 0);
            const bf16* vp = VTp + (size_t)vt * 32 * 32 + 16 * s;
            union { bf16x8 v; s16x4 h2[2]; } vf; vf.h2[0] = *(const s16x4*)vp; vf.h2[1] = *(const s16x4*)(vp + 8);
            Y[vt] = __builtin_amdgcn_mfma_f32_32x32x16_bf16(vf.v, fk.v, Y[vt], 0, 0, 0); } }
    float sm = 0.f;
#pragma unroll
    for (int vt = 0; vt < 2; ++vt)
#pragma unroll
        for (int i = 0; i < 16; ++i) sm += Y[vt][i];
    sm += __shfl_xor(sm, 32); const float mu = sm * (1.0f / 64.0f);
    float q = 0.f;
#pragma unroll
    for (int vt = 0; vt < 2; ++vt)
#pragma unroll
        for (int i = 0; i < 16; ++i) { const float dd = Y[vt][i] - mu; q += dd * dd; }
    q += __shfl_xor(q, 32); const float rstd = 1.0f / sqrtf(q * (1.0f / 64.0f) + RW_LN_EPS);
    const size_t tok = tok0 + r32;
    const float bon = ((const float*)(ws + WS_BONUS))[tok * 4 + h];
    const bf16* vrec = (const bf16*)(ws + WS_RVG) + un * 2048 + r32 * 64;
    const bf16* gp = (const bf16*)(ws + WS_GBUF) + tok * 256 + h * 64; bf16* od = (bf16*)(ws + WS_O) + tok * D + 512 + h * 64;
    const float* lnw = KIN(I_RWLNW) + l * 256 + h * 64; const float* lnb = KIN(I_RWLNB) + l * 256 + h * 64;
#pragma unroll
    for (int vt = 0; vt < 2; ++vt)
#pragma unroll
        for (int g = 0; g < 4; ++g) { const int v0 = 32 * vt + 8 * g + 4 * hh; const f32x4 w4 = *(const f32x4*)(lnw + v0), b4 = *(const f32x4*)(lnb + v0); const u32x2 vw = *(const u32x2*)(vrec + v0); const f32x4 vv = {bflo(vw.x), bfhi(vw.x), bflo(vw.y), bfhi(vw.y)}; const u32x2 gw = *(const u32x2*)(gp + v0);
            const float y0 = ((Y[vt][4 * g] - mu) * rstd * w4[0] + b4[0] + bon * vv[0]) * bflo(gw.x), y1 = ((Y[vt][4 * g + 1] - mu) * rstd * w4[1] + b4[1] + bon * vv[1]) * bfhi(gw.x);
            const float y2 = ((Y[vt][4 * g + 2] - mu) * rstd * w4[2] + b4[2] + bon * vv[2]) * bflo(gw.y), y3 = ((Y[vt][4 * g + 3] - mu) * rstd * w4[3] + b4[3] + bon * vv[3]) * bfhi(gw.y);
            *(u32x2*)(od + v0) = (u32x2){pk2(y0, y1), pk2(y2, y3)}; }
}

__device__ __forceinline__ void c1_phase(LAS unsigned char* lds, int l, int vcu, int G) {
    for (int u = vcu; u < NB * NCH; u += G) { const int b = u >> 8, c = u & 255;
        for (int q = 0; q <= PHREP(16); ++q) rw_fused_unit(lds, l, b, c);
        for (int q = 0; q <= PHREP(17); ++q) hg_fused_unit(lds, l, b, c);
        for (int q = 0; q <= PHREP(18); ++q) gla_fused_unit(lds, l, b, c); }
}
__device__ __forceinline__ void m3_gh_phase(int l, int vcu, int G) {
    const int tid = opaque_tid(), lane = tid & 63, wave = __builtin_amdgcn_readfirstlane(tid >> 6);
    unsigned char* ws = KWS();
    const int gw = vcu * NWAVES + wave, NGW = G * NWAVES;
    const bf16* P = (const bf16*)(ws + WS_P); bf16* O = (bf16*)(ws + WS_O);
    const float* gng = KIN(I_GLANG) + l * 256; const float* hng = KIN(I_HGNG) + l * 256;
    for (int task = gw; task < 24576; task += NGW) {
        const int un = task & 8191, bh = un >> 8, c = un & 255, b = bh >> 2, h = bh & 3; const size_t tok0 = (size_t)b * T + c * 32;
        if (task >= 16384) { rw_m3_task(lane, l, bh, c); continue; }
        if (task < 8192) m3_gh_task<64>(lane, (const bf16*)(ws + WS_HQ) + (size_t)un * 2048, (const bf16*)(ws + WS_HK) + (size_t)un * 2048, (const bf16*)(ws + WS_HVT) + (size_t)un * 2048, (const bf16*)(ws + WS_HS) + (size_t)un * 4096,
                                         P + tok0 * PINP + PC_HG + h * 64, hng + h * 64, O + tok0 * D + 256 + h * 64);
        else m3_gh_task<32>(lane, (const bf16*)(ws + WS_GQ) + (size_t)un * 1024, (const bf16*)(ws + WS_GK) + (size_t)un * 1024, (const bf16*)(ws + WS_GVT) + (size_t)un * 2048, (const bf16*)(ws + WS_GS) + (size_t)un * 2048,
                            P + tok0 * PINP + PC_GOUT + h * 64, gng + h * 64, O + tok0 * D + h * 64);
    }
}

__device__ __forceinline__ void xattn_units(LAS unsigned char* lds, int l, int first, int last, int stride) {
    const int tid = opaque_tid(), lane = tid & 63, wave = __builtin_amdgcn_readfirstlane(tid >> 6), r32 = lane & 31, hh = lane >> 5;
    const bf16* P = (const bf16*)(KWS() + WS_P); const bf16* MKV = (const bf16*)(KWS() + WS_MKV); bf16* O = (bf16*)(KWS() + WS_O);
    LAS bf16* KL = (LAS bf16*)lds;
    LAS bf16* VT = (LAS bf16*)(lds + 256 * 72 * 2);
    int cur_bh = -1;
    for (int u = first; u < last; u += stride) {
        const int bh = u >> 5, qb = u & 31, b = bh >> 2, h = bh & 3;
        if (bh != cur_bh) {
            __syncthreads();
            for (int i = tid; i < 256 * 8; i += NTHR) { const int key = i >> 3, c8 = i & 7;
                const bf16* src = MKV + (size_t)(b * 256 + key) * 2048 + l * 512 + h * 64 + c8 * 8;
                *(LAS u32x4*)(KL + key * 72 + c8 * 8) = *(const u32x4*)src;
                const u32x4 vv = *(const u32x4*)(src + 256);
                LAS bf16* vd = VT + (c8 * 8) * 264 + key;
                vd[0 * 264] = (bf16)(vv.x & 0xffff); vd[1 * 264] = (bf16)(vv.x >> 16); vd[2 * 264] = (bf16)(vv.y & 0xffff); vd[3 * 264] = (bf16)(vv.y >> 16);
                vd[4 * 264] = (bf16)(vv.z & 0xffff); vd[5 * 264] = (bf16)(vv.z >> 16); vd[6 * 264] = (bf16)(vv.w & 0xffff); vd[7 * 264] = (bf16)(vv.w >> 16); }
            __syncthreads();
            cur_bh = bh;
        }
        const int q = b * T + qb * 256 + wave * 32 + r32;
        bf16x8 qf[4];
#pragma unroll
        for (int s = 0; s < 4; ++s) qf[s] = *(const bf16x8*)(P + (size_t)q * PINP + PC_MQ + h * 64 + 16 * s + 8 * hh);
        f32x16 sc[8];
#pragma unroll
        for (int kt = 0; kt < 8; ++kt) {
#pragma unroll
            for (int i = 0; i < 16; ++i) sc[kt][i] = 0.f;
#pragma unroll
            for (int s = 0; s < 4; ++s) { const bf16x8 kf = *(const LAS bf16x8*)(KL + (kt * 32 + r32) * 72 + 16 * s + 8 * hh);
                sc[kt] = __builtin_amdgcn_mfma_f32_32x32x16_bf16(kf, qf[s], sc[kt], 0, 0, 0); }
        }
        float m = -3.0e38f;
#pragma unroll
        for (int kt = 0; kt < 8; ++kt)
#pragma unroll
            for (int i = 0; i < 16; ++i) m = fmaxf(m, sc[kt][i]);
        m = fmaxf(m, __shfl_xor(m, 32));
        float sum = 0.f;
        const float c2 = 0.125f * 1.4426950408889634f;
#pragma unroll
        for (int kt = 0; kt < 8; ++kt)
#pragma unroll
            for (int i = 0; i < 16; ++i) { const float e = __builtin_amdgcn_exp2f((sc[kt][i] - m) * c2); sc[kt][i] = e; sum += e; }
        sum += __shfl_xor(sum, 32);
        const float inv = 1.0f / sum;
        f32x16 oa[2];
#pragma unroll
        for (int vt = 0; vt < 2; ++vt)
#pragma unroll
            for (int i = 0; i < 16; ++i) oa[vt][i] = 0.f;
#pragma unroll
        for (int kt = 0; kt < 8; ++kt)
#pragma unroll
            for (int s = 0; s < 2; ++s) {
                union { bf16x8 v; unsigned w[4]; } pf;
#pragma unroll
                for (int j = 0; j < 4; ++j) pf.w[j] = cvt_pk_bf16(sc[kt][8 * s + 2 * j], sc[kt][8 * s + 2 * j + 1]);
#pragma unroll
                for (int vt = 0; vt < 2; ++vt) {
                    const LAS bf16* vp = VT + (vt * 32 + r32) * 264 + kt * 32 + 16 * s + 4 * hh;
                    union { bf16x8 v; s16x4 h2[2]; } vf; vf.h2[0] = *(const LAS s16x4*)vp; vf.h2[1] = *(const LAS s16x4*)(vp + 8);
                    oa[vt] = __builtin_amdgcn_mfma_f32_32x32x16_bf16(vf.v, pf.v, oa[vt], 0, 0, 0); }
            }
        bf16* orow = O + (size_t)q * D + 768 + h * 64;
#pragma unroll
        for (int vt = 0; vt < 2; ++vt)
#pragma unroll
            for (int g = 0; g < 4; ++g) { u32x2 w; w.x = cvt_pk_bf16(oa[vt][4 * g] * inv, oa[vt][4 * g + 1] * inv); w.y = cvt_pk_bf16(oa[vt][4 * g + 2] * inv, oa[vt][4 * g + 3] * inv);
                *(u32x2*)(orow + vt * 32 + 8 * g + 4 * hh) = w; }
    }
    __syncthreads();
}

__device__ __forceinline__ void m2_phase(LAS unsigned char* lds, int l, int bx, int G) {
    unsigned char* ws = KWS();
    const int tid = opaque_tid(), lane = tid & 63, wave = __builtin_amdgcn_readfirstlane(tid >> 6);
    const int nrw = (G >= 128) ? 64 : 0;
    if (nrw) { if (bx < nrw && wave == 0) rw_m2_wave(lane, bx >> 1, bx & 1); }
    else { for (int q = bx * NWAVES + wave; q < 64; q += G * NWAVES) rw_m2_wave(lane, q >> 1, q & 1); }
    if (!(nrw && bx < nrw && wave == 0)) {
        const int nth = nrw ? (nrw * 448 + (G - nrw) * NTHR) : G * NTHR;
        const int gt = nrw ? (bx < nrw ? bx * 448 + (tid - 64) : nrw * 448 + (bx - nrw) * NTHR + tid) : bx * NTHR + tid;
        for (int e = gt; e < 196608; e += nth) {
            if (e < 131072) m2_gh_elem<64>(e, (const float*)(ws + WS_HDS), (const float*)(ws + WS_HBE), (bf16*)(ws + WS_HS));
            else m2_gh_elem<32>(e - 131072, (const float*)(ws + WS_GDS), (const float*)(ws + WS_GBE), (bf16*)(ws + WS_GS)); }
    }
    if (nrw == 0 || bx >= nrw) {
        const int nb = G - nrw, r = bx - nrw;
        const int per = (1024 + nb - 1) / nb, lo = r * per, hi = (lo + per < 1024) ? lo + per : 1024;
        xattn_units(lds, l, lo, hi, 1);
    }
}

__device__ __forceinline__ void ln1_router_phase(LAS unsigned char* lds, int l, int bx, int G) {
    const int tid = opaque_tid(), lane = tid & 63, wave = __builtin_amdgcn_readfirstlane(tid >> 6);
    LAS float* X = (LAS float*)lds;
    LAS float* PART = (LAS float*)(lds + 16 * 1028 * 4);
    LAS int* HIST = (LAS int*)(lds + 16 * 1028 * 4 + 8 * 16 * 32 * 4);
    const float* xin = (l == 0) ? KIN(I_X) : (const float*)(KWS() + WS_XF);
    const bf16* HM = (const bf16*)(KWS() + WS_HMIX);
    float* X1F = (float*)(KWS() + WS_X1F); bf16* X1B = (bf16*)(KWS() + WS_X1B);
    const float* g1 = KIN(I_LN1G) + l * D; const float* b1 = KIN(I_LN1B) + l * D;
    const float* rw = KIN(I_RTW) + (size_t)l * D * NE; const float* rb = KIN(I_RTB) + l * NE;
    int* tok_e = (int*)(KWS() + WS_ROUTE); float* tok_g = (float*)(KWS() + WS_ROUTE + 1 * MiB);
    if (tid < 32) HIST[tid] = 0;
    float rwB[2][32];
    { const int q = lane >> 4, e = lane & 15;
#pragma unroll
      for (int s = 0; s < 32; ++s) { const float* p = rw + (size_t)(128 * wave + 32 * q + s) * NE + e; rwB[0][s] = p[0]; rwB[1][s] = p[16]; } }
    __syncthreads();
    for (int it = bx; it < NTOK / 16; it += G) {
#pragma unroll
        for (int tt = 0; tt < 2; ++tt) { const int ti = wave * 2 + tt; const size_t tok = (size_t)it * 16 + ti;
            const f32x4* xr = (const f32x4*)(xin + tok * D) + lane; const u32x2* hr = (const u32x2*)(HM + tok * D) + lane;
            f32x4 v[4]; float s = 0.f;
#pragma unroll
            for (int j = 0; j < 4; ++j) { const f32x4 xv = xr[64 * j]; const u32x2 hw = hr[64 * j];
                v[j][0] = DN_ALPHA * xv[0] + bflo(hw.x); v[j][1] = DN_ALPHA * xv[1] + bfhi(hw.x); v[j][2] = DN_ALPHA * xv[2] + bflo(hw.y); v[j][3] = DN_ALPHA * xv[3] + bfhi(hw.y);
                s += (v[j][0] + v[j][1]) + (v[j][2] + v[j][3]); }
            const float mean = wave_sum(s) * (1.0f / D); float s2 = 0.f;
#pragma unroll
            for (int j = 0; j < 4; ++j) { v[j] = v[j] - mean; s2 += (v[j][0] * v[j][0] + v[j][1] * v[j][1]) + (v[j][2] * v[j][2] + v[j][3] * v[j][3]); }
            const float rstd = 1.0f / sqrtf(wave_sum(s2) * (1.0f / D) + LN_EPS);
#pragma unroll
            for (int j = 0; j < 4; ++j) { const f32x4 gg = *((const f32x4*)g1 + lane + 64 * j), bb = *((const f32x4*)b1 + lane + 64 * j);
                const f32x4 y = v[j] * rstd * gg + bb;
                *((f32x4*)(X1F + tok * D) + lane + 64 * j) = y;
                *((u32x2*)(X1B + tok * D) + lane + 64 * j) = (u32x2){pk2(y[0], y[1]), pk2(y[2], y[3])};
                *(LAS f32x4*)(X + ti * 1028 + 4 * lane + 256 * j) = y; }
        }
        __syncthreads();
        {
            const int q = lane >> 4, r = lane & 15;
            f32x4 acc0 = (f32x4){0.f, 0.f, 0.f, 0.f}, acc1 = (f32x4){0.f, 0.f, 0.f, 0.f};
            const LAS float* xa = X + r * 1028 + 128 * wave + 32 * q;
#pragma unroll
            for (int s4 = 0; s4 < 8; ++s4) { const f32x4 av = *(const LAS f32x4*)(xa + 4 * s4);
#pragma unroll
                for (int j = 0; j < 4; ++j) { acc0 = __builtin_amdgcn_mfma_f32_16x16x4f32(av[j], rwB[0][4 * s4 + j], acc0, 0, 0, 0); acc1 = __builtin_amdgcn_mfma_f32_16x16x4f32(av[j], rwB[1][4 * s4 + j], acc1, 0, 0, 0); } }
#pragma unroll
            for (int i = 0; i < 4; ++i) { PART[(wave * 16 + 4 * q + i) * 32 + r] = acc0[i]; PART[(wave * 16 + 4 * q + i) * 32 + 16 + r] = acc1[i]; }
        }
        __syncthreads();
        {
            const int ti = tid >> 5, e = tid & 31;
            float lg = rb[e];
#pragma unroll
            for (int w = 0; w < 8; ++w) lg += PART[(w * 16 + ti) * 32 + e];
            float tv[4]; int te[4]; float cur = lg;
#pragma unroll
            for (int k = 0; k < 4; ++k) { float bv = cur; int bi = e;
#pragma unroll
                for (int o = 16; o >= 1; o >>= 1) { const float ov = __shfl_xor(bv, o); const int oi = __shfl_xor(bi, o); if (ov > bv || (ov == bv && oi < bi)) { bv = ov; bi = oi; } }
                tv[k] = bv; te[k] = bi; if (e == bi) cur = -3.0e38f; }
            const float e1 = __expf(tv[1] - tv[0]), e2 = __expf(tv[2] - tv[0]), e3 = __expf(tv[3] - tv[0]); const float inv = 1.0f / (1.0f + e1 + e2 + e3);
            const size_t tok = (size_t)it * 16 + ti;
            if (e < 4) { const int ek = e == 0 ? te[0] : e == 1 ? te[1] : e == 2 ? te[2] : te[3]; const float gk = (e == 0 ? 1.0f : e == 1 ? e1 : e == 2 ? e2 : e3) * inv;
                tok_e[tok * 4 + e] = ek; tok_g[tok * 4 + e] = gk; __hip_atomic_fetch_add(&HIST[ek], 1, __ATOMIC_RELAXED, __HIP_MEMORY_SCOPE_WORKGROUP); }
        }
        __syncthreads();
    }
    __syncthreads();
    if (tid < 32) ((int*)(KWS() + WS_CTL))[CW_HIST + bx * 32 + tid] = HIST[tid];
}

__device__ __forceinline__ void slots_phase(LAS unsigned char* lds, int bx, int G) {
    const int tid = opaque_tid();
    int* ctl = (int*)(KWS() + WS_CTL);
    LAS int* RED = (LAS int*)lds;
    LAS int* TOT = RED + 1024;
    const int* tok_e = (const int*)(KWS() + WS_ROUTE); const float* tok_g = (const float*)(KWS() + WS_ROUTE + 1 * MiB);
    int* tok_slot = (int*)(KWS() + WS_ROUTE + 2 * MiB); int* slot_tok = (int*)(KWS() + WS_ROUTE + 3 * MiB); float* slot_gate = (float*)(KWS() + WS_ROUTE + 3 * MiB + 1536 * 1024);
    { const int e = tid & 31, part = tid >> 5; int tot = 0, pre = 0;
      for (int b2 = part; b2 < G; b2 += 16) { const int h = ctl[CW_HIST + b2 * 32 + e]; tot += h; if (b2 < bx) pre += h; }
      RED[(part * 32 + e) * 2] = tot; RED[(part * 32 + e) * 2 + 1] = pre; }
    __syncthreads();
    if (tid < 32) { int tot = 0, pre = 0; for (int p = 0; p < 16; ++p) { tot += RED[(p * 32 + tid) * 2]; pre += RED[(p * 32 + tid) * 2 + 1]; } TOT[tid] = tot; TOT[32 + tid] = pre; TOT[96 + tid] = 0; }
    __syncthreads();
    if (tid == 0) { int ps = 0;
#pragma unroll 1
        for (int e = 0; e < 32; ++e) { TOT[64 + e] = ps; ps += (TOT[e] + 255) & ~255; }
        TOT[128] = ps >> 8; if (bx == 0) ctl[CW_NT] = ps >> 8; }
    __syncthreads();
    if (bx == 0) { const int nt = TOT[128];
        for (int t = tid; t < nt; t += NTHR) { int e = 0;
#pragma unroll 1
            for (int k = 1; k < 32; ++k) if (TOT[64 + k] <= t * 256) e = k;
            ctl[CW_TILEE + t] = e; } }
    for (int e = bx; e < 32; e += G) { const int s0 = TOT[64 + e] + TOT[e], s1 = TOT[64 + e] + ((TOT[e] + 255) & ~255); for (int s = s0 + tid; s < s1; s += NTHR) { slot_tok[s] = 0; slot_gate[s] = 0.f; } }
    for (int it = bx; it < NTOK / 16; it += G) {
        if (tid < 64) { const int asg = it * 64 + tid; const int e = tok_e[asg]; const int rank = __hip_atomic_fetch_add(&TOT[96 + e], 1, __ATOMIC_RELAXED, __HIP_MEMORY_SCOPE_WORKGROUP); const int slot = TOT[64 + e] + TOT[32 + e] + rank;
            tok_slot[asg] = slot; slot_tok[slot] = asg >> 2; slot_gate[slot] = tok_g[asg]; }
    }
}

__device__ __forceinline__ void combine_phase(int l, int vcu, int G) {
    const int tid = opaque_tid(), lane = tid & 63, wave = __builtin_amdgcn_readfirstlane(tid >> 6);
    const int gw = vcu * NWAVES + wave, NGW = G * NWAVES;
    const float* X1F = (const float*)(KWS() + WS_X1F); const bf16* YB = (const bf16*)(KWS() + WS_YB); const int* tok_slot = (const int*)(KWS() + WS_ROUTE + 2 * MiB);
    float* xo = (l == NL - 1) ? KOUT() : (float*)(KWS() + WS_XF); bf16* XB = (bf16*)(KWS() + WS_XB);
    const float* g2 = KIN(I_LN2G) + l * D; const float* b2 = KIN(I_LN2B) + l * D;
    for (int tok = gw; tok < NTOK; tok += NGW) {
        const int s0 = tok_slot[tok * 4], s1 = tok_slot[tok * 4 + 1], s2i = tok_slot[tok * 4 + 2], s3 = tok_slot[tok * 4 + 3];
        const f32x4* xr = (const f32x4*)(X1F + (size_t)tok * D) + lane;
        const u32x2* y0 = (const u32x2*)(YB + (size_t)s0 * D) + lane; const u32x2* y1 = (const u32x2*)(YB + (size_t)s1 * D) + lane;
        const u32x2* y2 = (const u32x2*)(YB + (size_t)s2i * D) + lane; const u32x2* y3 = (const u32x2*)(YB + (size_t)s3 * D) + lane;
        f32x4 v[4]; float s = 0.f;
#pragma unroll
        for (int j = 0; j < 4; ++j) { const f32x4 xv = xr[64 * j]; const u32x2 a0 = y0[64 * j], a1 = y1[64 * j], a2 = y2[64 * j], a3 = y3[64 * j];
            v[j][0] = DN_ALPHA * xv[0] + ((bflo(a0.x) + bflo(a1.x)) + (bflo(a2.x) + bflo(a3.x))); v[j][1] = DN_ALPHA * xv[1] + ((bfhi(a0.x) + bfhi(a1.x)) + (bfhi(a2.x) + bfhi(a3.x)));
            v[j][2] = DN_ALPHA * xv[2] + ((bflo(a0.y) + bflo(a1.y)) + (bflo(a2.y) + bflo(a3.y))); v[j][3] = DN_ALPHA * xv[3] + ((bfhi(a0.y) + bfhi(a1.y)) + (bfhi(a2.y) + bfhi(a3.y)));
            s += (v[j][0] + v[j][1]) + (v[j][2] + v[j][3]); }
        const float mean = wave_sum(s) * (1.0f / D); float q = 0.f;
#pragma unroll
        for (int j = 0; j < 4; ++j) { v[j] = v[j] - mean; q += (v[j][0] * v[j][0] + v[j][1] * v[j][1]) + (v[j][2] * v[j][2] + v[j][3] * v[j][3]); }
        const float rstd = 1.0f / sqrtf(wave_sum(q) * (1.0f / D) + LN_EPS);
#pragma unroll
        for (int j = 0; j < 4; ++j) { const f32x4 gg = *((const f32x4*)g2 + lane + 64 * j), bb = *((const f32x4*)b2 + lane + 64 * j);
            const f32x4 y = v[j] * rstd * gg + bb;
            *((f32x4*)(xo + (size_t)tok * D) + lane + 64 * j) = y;
            *((u32x2*)(XB + (size_t)tok * D) + lane + 64 * j) = (u32x2){pk2(y[0], y[1]), pk2(y[2], y[3])}; }
    }
}


constexpr int PH_PER_LAYER = 10, NPHASES = 2 + NL * PH_PER_LAYER;
__global__ void __launch_bounds__(NTHR, 2) trunk_fwd(Args args) {
    extern __shared__ __attribute__((aligned(16))) unsigned char lds_raw[];
    LAS unsigned char* lds = (LAS unsigned char*)lds_raw;
    volatile LAS unsigned* MISC = (volatile LAS unsigned*)(lds + MISC_OFF);
    const int tid = threadIdx.x;
    const int G = gridDim.x, bx = blockIdx.x;
    const int vcu = (G % 8 == 0) ? (bx % 8) * (G / 8) + bx / 8 : bx;
    unsigned char* ws = KWS();
    unsigned* ctl = (unsigned*)(ws + WS_CTL);
    for (int u = tid; u < (LDS_BYTES - LDSCTL_OFF) / 4; u += NTHR) ((LAS unsigned*)(lds + LDSCTL_OFF))[u] = 0u;
    __syncthreads();
    XcdBarrier bar; bar.bar = ctl + CW_BAR; bar.x = 0; bar.st = nullptr;
#if !MK_PER_PHASE
    bar = xcd_barrier_post(ctl + CW_BAR, MISC + 8);
#define GRID_BAR() xcd_barrier(bar)
#else
#define GRID_BAR() do { } while (0)
#endif
    const int lo = (int)(unsigned)ka_u64<280>(), hi = (int)(unsigned)(ka_u64<280>() >> 32);
#ifndef PH_MASK
#define PH_MASK 0x1FFF
#endif
#define PHEN(n) (((PH_MASK) >> (n)) & 1)
#define IN(k) (lo <= (k) && (k) < hi)
#define SEAM(k) do { if (rep > 0 || IN((k) + 1)) GRID_BAR(); } while (0)

#define OG opaque_s(G)
#define OBX opaque_s(bx)
#define OVCU opaque_s(vcu)
#define OL opaque_s(l)
    if (PHEN(0) && IN(0)) for (int rep = PHREP(0); rep >= 0; --rep) { prologue_phase(lds, OVCU, OG); SEAM(0); }
    if (PHEN(1) && IN(1)) for (int rep = PHREP(1); rep >= 0; --rep) {
        pg8::DenseOrder S; S.init(KWS() + WS_MEMB, KWS() + WS_WMEM, NB * NMEM, 2048, D, OG, OBX);
        pg8::EpiBf16 E{(bf16*)(KWS() + WS_MKV), 2048};
        pg8::gemm_phase<pg8::EpiBf16, pg8::DenseOrder>(lds, D, S, E);
        SEAM(1);
    }
    for (int l = 0; l < NL; ++l) {
        const int p0 = 2 + l * PH_PER_LAYER;
        if (PHEN(2) && IN(p0 + 0)) for (int rep = PHREP(2); rep >= 0; --rep) {
            pg8::DenseOrder S; S.init(KWS() + WS_XB, KWS() + WS_WIN + (size_t)OL * PINP * D * 2, NTOK, PINP, D, OG, OBX);
            pg8::EpiBf16 E{(bf16*)(KWS() + WS_P), PINP};
            pg8::gemm_phase<pg8::EpiBf16, pg8::DenseOrder>(lds, D, S, E);
            SEAM(p0 + 0);
        }
        if (PHEN(4) && IN(p0 + 1)) for (int rep = PHREP(4); rep >= 0; --rep) { c1_phase(lds, OL, OVCU, OG); SEAM(p0 + 1); }
        if (PHEN(5) && IN(p0 + 2)) for (int rep = PHREP(5); rep >= 0; --rep) { m2_phase(lds, OL, OBX, OG); SEAM(p0 + 2); }
        if (PHEN(6) && IN(p0 + 3)) for (int rep = PHREP(6); rep >= 0; --rep) { m3_gh_phase(OL, OVCU, OG); SEAM(p0 + 3); }
        if (PHEN(7) && IN(p0 + 4)) for (int rep = PHREP(7); rep >= 0; --rep) {
            pg8::DenseOrder S; S.init(KWS() + WS_O, KWS() + WS_WOUT + (size_t)OL * D * D * 2, NTOK, D, D, OG, OBX);
            pg8::EpiBf16 E{(bf16*)(KWS() + WS_HMIX), D};
            pg8::gemm_phase<pg8::EpiBf16, pg8::DenseOrder>(lds, D, S, E);
            SEAM(p0 + 4);
        }
        if (PHEN(8) && IN(p0 + 5)) for (int rep = PHREP(8); rep >= 0; --rep) { ln1_router_phase(lds, OL, OBX, OG); SEAM(p0 + 5); }
        if (PHEN(9) && IN(p0 + 6)) for (int rep = PHREP(9); rep >= 0; --rep) { slots_phase(lds, OBX, OG); SEAM(p0 + 6); }
        if (PHEN(10) && IN(p0 + 7)) for (int rep = PHREP(10); rep >= 0; --rep) {
            const int ntiles = __builtin_amdgcn_readfirstlane(((const int*)(KWS() + WS_CTL))[CW_NT]);
            pg8::MoeOrder<true> S; S.init(KWS() + WS_X1B, KWS() + WS_WGU + (size_t)OL * NE * 2048 * D * 2, (const int*)(KWS() + WS_CTL) + CW_TILEE, (const int*)(KWS() + WS_ROUTE + 3 * MiB), ntiles, 2048, D, OG, OBX);
            pg8::EpiSwiglu E{(bf16*)(KWS() + WS_HB), (const float*)(KWS() + WS_BGU) + (size_t)OL * NE * 2048};
            pg8::gemm_phase<pg8::EpiSwiglu, pg8::MoeOrder<true>>(lds, D, S, E);
            SEAM(p0 + 7);
        }
        if (PHEN(11) && IN(p0 + 8)) for (int rep = PHREP(11); rep >= 0; --rep) {
            const int ntiles = __builtin_amdgcn_readfirstlane(((const int*)(KWS() + WS_CTL))[CW_NT]);
            pg8::MoeOrder<false> S; S.init(KWS() + WS_HB, KWS() + WS_WD + (size_t)OL * NE * D * FF * 2, (const int*)(KWS() + WS_CTL) + CW_TILEE, (const int*)(KWS() + WS_ROUTE + 3 * MiB), ntiles, D, FF, OG, OBX);
            pg8::EpiDown E{(bf16*)(KWS() + WS_YB), KIN(I_BDN) + (size_t)OL * NE * D, (const float*)(KWS() + WS_ROUTE + 3 * MiB + 1536 * 1024)};
            pg8::gemm_phase<pg8::EpiDown, pg8::MoeOrder<false>>(lds, FF, S, E);
            SEAM(p0 + 8);
        }
        if (PHEN(12) && IN(p0 + 9)) for (int rep = PHREP(12); rep >= 0; --rep) { combine_phase(OL, OVCU, OG); if (rep > 0 || l + 1 < NL) SEAM(p0 + 9); }
    }
#undef IN
#undef SEAM
}

extern "C" void kernel_launch(void* const* d_in, const int* in_sizes, int n_in, void* d_out, int out_size, void* d_ws, size_t ws_size, hipStream_t stream) {
    static int grid = 0;
    if (grid == 0) {
        if (n_in != 33 || ws_size < WS_END) { fprintf(stderr, "kernel_launch: unexpected inputs (n_in %d, ws %zu need %zu)\n", n_in, ws_size, (size_t)WS_END); grid = -1; return; }
        int dev = 0, cus = 0;
        if (hipGetDevice(&dev) != hipSuccess || hipDeviceGetAttribute(&cus, hipDeviceAttributeMultiprocessorCount, dev) != hipSuccess) { grid = -1; return; }
        if (hipFuncSetAttribute((const void*)trunk_fwd, hipFuncAttributeMaxDynamicSharedMemorySize, LDS_BYTES) != hipSuccess) { grid = -1; return; }
        int per_cu = 0; (void)hipOccupancyMaxActiveBlocksPerMultiprocessor(&per_cu, (const void*)trunk_fwd, NTHR, LDS_BYTES); (void)hipGetLastError();
        grid = cus;
    }
    if (grid < 0) return;
    (void)hipMemsetAsync((char*)d_ws + WS_CTL, 0, CTL_ZERO_BYTES, stream);
    Args a{};
    for (int i = 0; i < 33; ++i) a.in[i] = (const float*)d_in[i];
    a.out = (float*)d_out; a.ws = (unsigned char*)d_ws;
#if MK_PER_PHASE
    for (int p = 0; p < NPHASES; ++p) { a.ph_lo = p; a.ph_hi = p + 1; hipLaunchKernelGGL(trunk_fwd, dim3(grid), dim3(NTHR), LDS_BYTES, stream, a); }
#else
    a.ph_lo = 0; a.ph_hi = NPHASES;
    hipLaunchKernelGGL(trunk_fwd, dim3(grid), dim3(NTHR), LDS_BYTES, stream, a);
#endif
}
```

```cpp
#include <hip/hip_runtime.h>
#include <cstdio>
#include <cstdint>

#ifndef MK_PER_PHASE
#define MK_PER_PHASE 0
#endif

#ifndef REP_MASK
#define REP_MASK 0
#endif
#define PHREP(n) (((REP_MASK) >> (n)) & 1)
#define LAS __attribute__((address_space(3)))
#define GAS __attribute__((address_space(1)))
typedef unsigned short bf16;
typedef short bf16x8 __attribute__((ext_vector_type(8)));
typedef short s16x4 __attribute__((ext_vector_type(4)));
typedef float f32x4 __attribute__((ext_vector_type(4)));
typedef float f32x2 __attribute__((ext_vector_type(2)));
typedef float f32x16 __attribute__((ext_vector_type(16)));
typedef unsigned u32x4 __attribute__((ext_vector_type(4)));
typedef unsigned u32x2 __attribute__((ext_vector_type(2)));

constexpr int NB = 8, T = 8192, D = 1024, NL = 4, NTOK = NB * T;
constexpr int PIN = 3088, PINP = 3328;
constexpr int NE = 32, FF = 1024, NMEM = 256;
constexpr int NASSIGN = NTOK * 4;
constexpr int MAXTILES = NASSIGN / 256 + NE;
constexpr int MAXSLOTS = MAXTILES * 256;
constexpr int PC_GQ = 0, PC_GK = 128, PC_GV = 256, PC_GOUT = 512, PC_HQ = 768, PC_HF = 1024, PC_HI = 1280, PC_HG = 1536;
constexpr int PC_RW = 1792, PC_MQ = 2816, PC_GLR = 3072;
constexpr float DN_ALPHA = 1.6817928305074292f;
constexpr float LN_EPS = 1e-5f, RMS_EPS = 1e-6f, RW_LN_EPS = 64e-5f;

constexpr size_t MiB = 1u << 20;
constexpr size_t WS_CTL = 0, CTL_ZERO_BYTES = 1 * MiB;
constexpr size_t WS_WIN = 1 * MiB;
constexpr size_t WS_WOUT = WS_WIN + 26 * MiB;
constexpr size_t WS_WMEM = WS_WOUT + 8 * MiB;
constexpr size_t WS_WGU = WS_WMEM + 4 * MiB;
constexpr size_t WS_WD = WS_WGU + 512 * MiB;
constexpr size_t WS_BGU = WS_WD + 256 * MiB;
constexpr size_t WS_LORA = WS_BGU + 1 * MiB;
constexpr size_t WS_MEMB = WS_LORA + 1 * MiB;
constexpr size_t WS_MKV = WS_MEMB + 4 * MiB;
constexpr size_t WS_XB = WS_MKV + 8 * MiB;
constexpr size_t WS_X1B = WS_XB + 128 * MiB;
constexpr size_t WS_XF = WS_X1B + 128 * MiB;
constexpr size_t WS_X1F = WS_XF + 256 * MiB;
constexpr size_t WS_O = WS_X1F + 256 * MiB;
constexpr size_t WS_HMIX = WS_O + 128 * MiB;
constexpr size_t WS_ROUTE = WS_HMIX + 128 * MiB;
constexpr size_t WS_GBUF = WS_ROUTE + 6 * MiB;
constexpr size_t WS_BONUS = WS_GBUF + 32 * MiB;
constexpr size_t WS_BIG = WS_BONUS + 1 * MiB;
constexpr size_t WS_P = WS_BIG;
constexpr size_t WS_ORAW = WS_P + 416 * MiB;
constexpr size_t WS_HB = WS_BIG;
constexpr size_t WS_YB = WS_HB + 528 * MiB;
constexpr size_t WS_CHK = WS_ORAW;
constexpr size_t WS_HQ = WS_CHK, WS_HK = WS_HQ + 32 * MiB, WS_HVT = WS_HK + 32 * MiB, WS_HDS = WS_HVT + 32 * MiB, WS_HS = WS_HDS + 128 * MiB, WS_HBE = WS_HS + 64 * MiB;
constexpr size_t WS_GQ = WS_HBE + 2 * MiB, WS_GK = WS_GQ + 16 * MiB, WS_GVT = WS_GK + 16 * MiB, WS_GDS = WS_GVT + 32 * MiB, WS_GS = WS_GDS + 64 * MiB, WS_GBE = WS_GS + 32 * MiB;
constexpr size_t WS_RR = WS_GBE + 1 * MiB, WS_RB = WS_RR + 32 * MiB, WS_RK = WS_RB + 32 * MiB, WS_RW = WS_RK + 32 * MiB, WS_RVT = WS_RW + 32 * MiB;
constexpr size_t WS_RVG = WS_RVT + 32 * MiB;
constexpr size_t WS_RU = WS_RVG + 32 * MiB, WS_RP = WS_RU + 64 * MiB, WS_RQ = WS_RP + 64 * MiB, WS_RS = WS_RQ + 128 * MiB;
constexpr size_t WS_END = WS_RS + 64 * MiB;
static_assert(WS_YB + 528 * MiB <= WS_END, "overlay");
static_assert(WS_END <= (size_t)4096 * MiB, "workspace");
constexpr int CW_TMO = 0;
constexpr int CW_BAR = 4096;
constexpr int CW_HIST = 16384;
constexpr int CW_NT = 32768;
constexpr int CW_TILEE = 32768 + 64;
constexpr int CW_PADSTART = 40960;

constexpr int RING_BYTES = 131072;
constexpr int LDSCTL_OFF = 162816, MISC_OFF = LDSCTL_OFF + 320;
constexpr int LDS_BYTES = 163840;
constexpr int NWAVES = 8, NTHR = 512;

#define RLX_AGENT __ATOMIC_RELAXED, __HIP_MEMORY_SCOPE_AGENT
#define LDS_WAIT() asm volatile("s_waitcnt lgkmcnt(0)" ::: "memory")
#define VM_WAIT() asm volatile("s_waitcnt vmcnt(0)" ::: "memory")

__device__ __forceinline__ unsigned f2bf(float f) { unsigned u = __builtin_bit_cast(unsigned, f); return (u + 0x7fffu + ((u >> 16) & 1u)) >> 16; }
__device__ __forceinline__ unsigned pk2(float lo, float hi) { return f2bf(lo) | (f2bf(hi) << 16); }
__device__ __forceinline__ float bf2f(unsigned short b) { return __builtin_bit_cast(float, (unsigned)b << 16); }
__device__ __forceinline__ float bflo(unsigned w) { return __builtin_bit_cast(float, w << 16); }
__device__ __forceinline__ float bfhi(unsigned w) { return __builtin_bit_cast(float, w & 0xffff0000u); }
typedef __bf16 bf16x2_t __attribute__((ext_vector_type(2)));
__device__ __forceinline__ unsigned cvt_pk_bf16(float lo, float hi) { const f32x2 v = {lo, hi}; const bf16x2_t b = __builtin_convertvector(v, bf16x2_t); return __builtin_bit_cast(unsigned, b); }
__device__ __forceinline__ float fast_exp(float x) { return __builtin_amdgcn_exp2f(x * 1.4426950408889634f); }
__device__ __forceinline__ float fast_sigmoid(float x) { return __builtin_amdgcn_rcpf(1.0f + fast_exp(-x)); }
__device__ __forceinline__ float silu_f(float x) { return x * fast_sigmoid(x); }
__device__ __forceinline__ int opaque_tid() { int t = threadIdx.x; asm volatile("" : "+v"(t)); return t; }
__device__ __forceinline__ int opaque_s(int v) { asm volatile("" : "+s"(v)); return v; }
__device__ __forceinline__ float wave_sum(float v) {
#pragma unroll
    for (int o = 1; o < 64; o <<= 1) v += __shfl_xor(v, o);
    return v;
}

namespace pg8 {
constexpr int BM = 256, BK = 64, HALF = 128, HTB = HALF * BK * 2, STAGE_BYTES = 8 * HTB, NXCD = 8, WGM = 8;
__host__ __device__ __forceinline__ int lds_byte(int r, int c) { const int st = (r >> 4) * 2 + (c >> 5), rr = r & 15, cc = c & 31, ob = rr * 64 + cc * 2; return st * 1024 + (ob ^ (((ob >> 9) & 1) << 5)); }
__host__ __device__ __forceinline__ void stage_rc(int b, int& R, int& C) { const int st = b / 1024, sb = b % 1024, swz = sb ^ (((sb >> 9) & 1) << 5); R = (st >> 1) * 16 + swz / 64; C = (st & 1) * 32 + (swz % 64) / 2; }
__host__ __device__ __forceinline__ int perm32(int rho) { const int n = rho >> 4, i = rho & 15; return 8 * (i >> 2) + 4 * n + (i & 3); }

struct Unit { int pm, pn, e; const char* A; const char* B; };

__device__ __forceinline__ bool static_tile(int i, int G, int c, int nM, int nN, int& pm, int& pn) {
    const int nwg = nM * nN; const long L = (long)i * G + c; if (L >= nwg) return false;
    int wgid = (int)L; { const int q = nwg / NXCD, r = nwg % NXCD, xcd = wgid % NXCD, off = wgid / NXCD; wgid = (xcd < r ? xcd * (q + 1) : r * (q + 1) + (xcd - r) * q) + off; }
    const int nig = WGM * nN, gid = wgid / nig, fm = gid * WGM, gsz = (nM - fm) < WGM ? (nM - fm) : WGM;
    pm = fm + ((wgid % nig) % gsz); pn = (wgid % nig) / gsz; return true;
}
struct DenseOrder {
    static constexpr bool GATHER = false;
    const char* A; const char* B; int nM, nN, G, c; size_t tstep;
    __device__ __forceinline__ void init(const void* A_, const void* B_, int M, int N, int K, int G_, int c_) { A = (const char*)A_; B = (const char*)B_; nM = M / BM; nN = N / BM; G = G_; c = c_; tstep = (size_t)BM * K * 2; }
    __device__ __forceinline__ bool next(int i, Unit& u) const { if (!static_tile(i, G, c, nM, nN, u.pm, u.pn)) return false; u.e = 0; u.A = A + (size_t)u.pm * tstep; u.B = B + (size_t)u.pn * tstep; return true; }
    __device__ __forceinline__ unsigned row_tok(const Unit&, int) const { return 0; }
};
template <bool GATHER_> struct MoeOrder {
    static constexpr bool GATHER = GATHER_;
    const char* A; const char* B; const int* tile_e; const int* slot_tok; int nM, nN, G, c; size_t tstep, estep;
    __device__ __forceinline__ void init(const void* A_, const void* B_, const int* tile_e_, const int* slot_tok_, int ntiles, int Nper, int K, int G_, int c_) {
        A = (const char*)A_; B = (const char*)B_; tile_e = tile_e_; slot_tok = slot_tok_; nM = ntiles; nN = Nper / BM; G = G_; c = c_; tstep = (size_t)BM * K * 2; estep = (size_t)Nper * K * 2; }
    __device__ __forceinline__ bool next(int i, Unit& u) const { if (!static_tile(i, G, c, nM, nN, u.pm, u.pn)) return false;
        u.e = __builtin_amdgcn_readfirstlane(tile_e[u.pm]); u.A = GATHER_ ? A : A + (size_t)u.pm * tstep; u.B = B + (size_t)u.e * estep + (size_t)u.pn * tstep; return true; }
    __device__ __forceinline__ unsigned row_tok(const Unit& u, int r) const { return (unsigned)slot_tok[u.pm * BM + r]; }
};

struct EpiBf16 {
    static constexpr bool PERM = true;
    bf16* O; int ldc;
    __device__ __forceinline__ void operator()(const f32x4 (&acc)[2][2][4][2], const Unit& u, int wr, int wc, int fr, int fq) const {
        const int row0 = u.pm * BM + wr * 64 + fr, col0 = u.pn * BM + wc * 32 + 8 * fq;
#pragma unroll
        for (int ai = 0; ai < 2; ++ai)
#pragma unroll
            for (int m = 0; m < 4; ++m) { bf16* rowp = O + (size_t)(row0 + ai * HALF + m * 16) * ldc + col0;
#pragma unroll
                for (int bj = 0; bj < 2; ++bj) { const f32x4 v0 = acc[ai][bj][m][0], v1 = acc[ai][bj][m][1];
                    u32x4 w; w.x = cvt_pk_bf16(v0[0], v0[1]); w.y = cvt_pk_bf16(v0[2], v0[3]); w.z = cvt_pk_bf16(v1[0], v1[1]); w.w = cvt_pk_bf16(v1[2], v1[3]);
                    *(u32x4*)(rowp + bj * HALF) = w; } }
    }
};
struct EpiSwiglu {
    static constexpr bool PERM = false;
    bf16* H; const float* bias;
    __device__ __forceinline__ void operator()(const f32x4 (&acc)[2][2][4][2], const Unit& u, int wr, int wc, int fr, int fq) const {
        const int row0 = u.pm * BM + wr * 64 + fr, colh = u.pn * 128 + wc * 32 + 8 * fq;
        const float* bp = bias + (size_t)u.e * 2048 + u.pn * 256 + wc * 32 + 4 * fq;
        f32x4 bv[2][2];
#pragma unroll
        for (int bj = 0; bj < 2; ++bj)
#pragma unroll
            for (int n = 0; n < 2; ++n) bv[bj][n] = *(const f32x4*)(bp + bj * HALF + n * 16);
#pragma unroll
        for (int ai = 0; ai < 2; ++ai)
#pragma unroll
            for (int m = 0; m < 4; ++m) { bf16* rowp = H + (size_t)(row0 + ai * HALF + m * 16) * FF + colh;
                float o[8];
#pragma unroll
                for (int n = 0; n < 2; ++n) { const f32x4 g4 = acc[ai][0][m][n] + bv[0][n], u4 = acc[ai][1][m][n] + bv[1][n];
#pragma unroll
                    for (int j = 0; j < 4; ++j) { const float g = fminf(g4[j], 7.0f), up = fminf(fmaxf(u4[j], -7.0f), 7.0f);
                        const float glu = g * __builtin_amdgcn_rcpf(1.0f + __builtin_amdgcn_exp2f(g * (-1.702f * 1.4426950408889634f)));
                        o[n * 4 + j] = (up + 1.0f) * glu; } }
                u32x4 w; w.x = cvt_pk_bf16(o[0], o[1]); w.y = cvt_pk_bf16(o[2], o[3]); w.z = cvt_pk_bf16(o[4], o[5]); w.w = cvt_pk_bf16(o[6], o[7]);
                *(u32x4*)rowp = w; }
    }
};
struct EpiDown {
    static constexpr bool PERM = true;
    bf16* Y; const float* bias; const float* slot_gate;
    __device__ __forceinline__ void operator()(const f32x4 (&acc)[2][2][4][2], const Unit& u, int wr, int wc, int fr, int fq) const {
        const int row0 = u.pm * BM + wr * 64 + fr, col0 = u.pn * BM + wc * 32 + 8 * fq;
        const float* bp = bias + (size_t)u.e * 1024 + col0;
        f32x4 bv[2][2];
#pragma unroll
        for (int bj = 0; bj < 2; ++bj)
#pragma unroll
            for (int n = 0; n < 2; ++n) bv[bj][n] = *(const f32x4*)(bp + bj * HALF + 4 * n);
#pragma unroll
        for (int ai = 0; ai < 2; ++ai)
#pragma unroll
            for (int m = 0; m < 4; ++m) { const int row = row0 + ai * HALF + m * 16; const float g = slot_gate[row]; bf16* rowp = Y + (size_t)row * D + col0;
#pragma unroll
                for (int bj = 0; bj < 2; ++bj) { const f32x4 v0 = (acc[ai][bj][m][0] + bv[bj][0]) * g, v1 = (acc[ai][bj][m][1] + bv[bj][1]) * g;
                    u32x4 w; w.x = cvt_pk_bf16(v0[0], v0[1]); w.y = cvt_pk_bf16(v0[2], v0[3]); w.z = cvt_pk_bf16(v1[0], v1[1]); w.w = cvt_pk_bf16(v1[2], v1[3]);
                    *(u32x4*)(rowp + bj * HALF) = w; } }
    }
};

template <class Epi, class Sched, bool ALIGN_EPI = true>
__device__ __forceinline__ void gemm_phase(LAS unsigned char* lds, const int K, const Sched& S, const Epi& E) {
    constexpr bool GA = Sched::GATHER;
    const int tid = opaque_tid(), wid = __builtin_amdgcn_readfirstlane(tid >> 6), lane = tid & 63, wr = wid >> 2, wc = wid & 3, fr = lane & 15, fq = lane >> 4;
    const int nt = K / BK;
    unsigned voffA[2], voffB[2]; int Rr[2]; unsigned Cb[2];
#pragma unroll
    for (int i = 0; i < 2; ++i) { int R, C; stage_rc(tid * 16 + i * 8192, R, C); const int Rb = Epi::PERM ? ((R & ~31) + perm32(R & 31)) : R;
        voffA[i] = (unsigned)(R * K + C) * 2u; voffB[i] = (unsigned)(Rb * K + C) * 2u; Rr[i] = R; Cb[i] = (unsigned)C * 2u; }
    const size_t kstep = (size_t)(BK * 2);
    const size_t hstep = (size_t)HALF * K * 2;
    const unsigned ldsw = (unsigned)wid * 1024u;
    const int aoff = lds_byte(wr * 64 + fr, fq * 8), boff = lds_byte(wc * 32 + fr, fq * 8);
    unsigned cOff[2][2], nOff[2][2], sOff[2][2];
#define PG8_SA(b, h) (((b) * 2 + (h)) * HTB)
#define PG8_SB(b, h) ((4 + (b) * 2 + (h)) * HTB)
#define PG8_STAGE(bufoff, gbase, voff) do { _Pragma("unroll") for (int _i = 0; _i < 2; ++_i) \
        __builtin_amdgcn_global_load_lds((const unsigned*)((const char*)(gbase) + (voff)[_i]), (LAS unsigned*)(lds + (bufoff) + ldsw + _i * 8192), 16, 0, 0); } while (0)
#define PG8_STAGE_A(bufoff, gbase, half, OFF) do { if constexpr (GA) { PG8_STAGE(bufoff, gbase, (OFF)[half]); } else { PG8_STAGE(bufoff, (gbase) + (half) * hstep, voffA); } } while (0)
#define PG8_LDA(dst, b, h) do { _Pragma("unroll") for (int m = 0; m < 4; ++m) _Pragma("unroll") for (int k = 0; k < 2; ++k) dst[m][k] = *(const LAS bf16x8*)(lds + PG8_SA(b, h) + aoff + m * 2048 + k * 1024); } while (0)
#define PG8_LDB(dst, b, h) do { _Pragma("unroll") for (int n = 0; n < 2; ++n) _Pragma("unroll") for (int k = 0; k < 2; ++k) dst[n][k] = *(const LAS bf16x8*)(lds + PG8_SB(b, h) + boff + n * 2048 + k * 1024); } while (0)
#define PG8_MMA(ai, bj, At, Bt) do { __builtin_amdgcn_s_setprio(1); _Pragma("unroll") for (int m = 0; m < 4; ++m) _Pragma("unroll") for (int n = 0; n < 2; ++n) _Pragma("unroll") for (int k = 0; k < 2; ++k) \
        acc[ai][bj][m][n] = __builtin_amdgcn_mfma_f32_16x16x32_bf16(Bt[n][k], At[m][k], acc[ai][bj][m][n], 0, 0, 0); __builtin_amdgcn_s_setprio(0); } while (0)
#define PG8_WAIT_V(n) asm volatile("s_waitcnt vmcnt(" #n ")" ::: "memory")
#define PG8_WAIT_L(n) asm volatile("s_waitcnt lgkmcnt(" #n ")" ::: "memory")
#define PG8_BAR __builtin_amdgcn_s_barrier()
#define PG8_SCHED __builtin_amdgcn_sched_barrier(0)
#define PG8_GOFF(dst, u) do { if constexpr (GA) { _Pragma("unroll") for (int _h = 0; _h < 2; ++_h) _Pragma("unroll") for (int _i = 0; _i < 2; ++_i) \
        dst[_h][_i] = S.row_tok(u, _h * HALF + Rr[_i]) * (unsigned)(K * 2) + Cb[_i]; } } while (0)
    Unit cur, nxt; int ui = 0;
    if (!S.next(0, cur)) return;
    f32x4 acc[2][2][4][2];
#pragma unroll
    for (int a = 0; a < 2; ++a)
#pragma unroll
        for (int b = 0; b < 2; ++b)
#pragma unroll
            for (int m = 0; m < 4; ++m)
#pragma unroll
                for (int n = 0; n < 2; ++n) acc[a][b][m][n] = (f32x4){0.f, 0.f, 0.f, 0.f};
    bf16x8 At[4][2], B0[2][2], B1[2][2];
    const char* cA = cur.A; const char* cB = cur.B;
    PG8_GOFF(cOff, cur);
#pragma unroll
    for (int h = 0; h < 2; ++h)
#pragma unroll
        for (int i = 0; i < 2; ++i) { nOff[h][i] = 0u; sOff[h][i] = 0u; }
    if constexpr (GA) { VM_WAIT(); }
    PG8_STAGE(PG8_SB(0, 0), cB, voffB); PG8_STAGE(PG8_SB(0, 1), cB + hstep, voffB); PG8_STAGE_A(PG8_SA(0, 0), cA, 0, cOff); PG8_STAGE_A(PG8_SA(0, 1), cA, 1, cOff);
    if (wr == 1) PG8_BAR;
    PG8_WAIT_V(2); PG8_BAR;
    PG8_STAGE(PG8_SB(1, 0), cB + kstep, voffB); PG8_STAGE_A(PG8_SA(1, 0), cA + kstep, 0, cOff); PG8_STAGE(PG8_SB(1, 1), cB + hstep + kstep, voffB);
    PG8_WAIT_V(6); PG8_BAR;
    for (;;) {
        const bool has_next = S.next(ui + 1, nxt);
        const char* nA = has_next ? nxt.A : cA; const char* nB = has_next ? nxt.B : cB;
        if constexpr (GA) { if (has_next) { PG8_GOFF(nOff, nxt); } else {
#pragma unroll
            for (int h = 0; h < 2; ++h)
#pragma unroll
                for (int i = 0; i < 2; ++i) nOff[h][i] = cOff[h][i]; } }
        for (int t = 0; t < nt; t += 2) {
            const bool last = (t == nt - 2);
            const char* a1 = cA + (size_t)(t + 1) * kstep;
            const char* a2 = last ? nA : cA + (size_t)(t + 2) * kstep; const char* b2 = last ? nB : cB + (size_t)(t + 2) * kstep;
            const char* a3 = a2 + kstep; const char* b3 = b2 + kstep;
            if constexpr (GA) {
#pragma unroll
                for (int h = 0; h < 2; ++h)
#pragma unroll
                    for (int i = 0; i < 2; ++i) sOff[h][i] = last ? nOff[h][i] : cOff[h][i]; }
            PG8_LDB(B0, 0, 0); PG8_LDB(B1, 0, 1); PG8_SCHED; PG8_LDA(At, 0, 0); PG8_STAGE_A(PG8_SA(1, 1), a1, 1, cOff);
            PG8_WAIT_V(8); PG8_WAIT_L(0); PG8_BAR; PG8_MMA(0, 0, At, B0); PG8_MMA(0, 1, At, B1); PG8_BAR; PG8_SCHED;
            PG8_LDA(At, 0, 1); PG8_STAGE(PG8_SB(0, 0), b2, voffB); PG8_STAGE(PG8_SB(0, 1), b2 + hstep, voffB); PG8_STAGE_A(PG8_SA(0, 0), a2, 0, sOff);
            PG8_WAIT_V(8); PG8_WAIT_L(0); PG8_BAR; PG8_MMA(1, 0, At, B0); PG8_MMA(1, 1, At, B1); PG8_BAR; PG8_SCHED;
            PG8_LDB(B0, 1, 0); PG8_LDB(B1, 1, 1); PG8_SCHED; PG8_LDA(At, 1, 0); PG8_STAGE_A(PG8_SA(0, 1), a2, 1, sOff);
            PG8_WAIT_V(8); PG8_WAIT_L(0); PG8_BAR; PG8_MMA(0, 0, At, B0); PG8_MMA(0, 1, At, B1); PG8_BAR; PG8_SCHED;
            PG8_LDA(At, 1, 1); PG8_STAGE(PG8_SB(1, 0), b3, voffB); PG8_STAGE(PG8_SB(1, 1), b3 + hstep, voffB); PG8_STAGE_A(PG8_SA(1, 0), a3, 0, sOff);
            PG8_WAIT_V(8); PG8_WAIT_L(0); PG8_BAR; PG8_MMA(1, 0, At, B0); PG8_MMA(1, 1, At, B1); PG8_BAR; PG8_SCHED;
        }
        if constexpr (ALIGN_EPI) { if (wr == 0) PG8_BAR; }
        E(acc, cur, wr, wc, fr, fq);
        if (!has_next) break;
#pragma unroll
        for (int a = 0; a < 2; ++a)
#pragma unroll
            for (int b = 0; b < 2; ++b)
#pragma unroll
                for (int m = 0; m < 4; ++m)
#pragma unroll
                    for (int n = 0; n < 2; ++n) acc[a][b][m][n] = (f32x4){0.f, 0.f, 0.f, 0.f};
        cur = nxt; cA = nA; cB = nB; ++ui;
        if constexpr (GA) {
#pragma unroll
            for (int h = 0; h < 2; ++h)
#pragma unroll
                for (int i = 0; i < 2; ++i) cOff[h][i] = nOff[h][i]; }
        if constexpr (ALIGN_EPI) { if (wr == 1) PG8_BAR; }
    }
    PG8_WAIT_V(0);
    if constexpr (!ALIGN_EPI) { if (wr == 0) PG8_BAR; }
    PG8_BAR;
#undef PG8_SA
#undef PG8_SB
#undef PG8_STAGE
#undef PG8_STAGE_A
#undef PG8_LDA
#undef PG8_LDB
#undef PG8_MMA
#undef PG8_WAIT_V
#undef PG8_WAIT_L
#undef PG8_BAR
#undef PG8_SCHED
#undef PG8_GOFF
}
}

#define XB_TMO      128
#define XB_XCNT(j)  (256  + 64 * (j))
#define XB_XSUB(j)  (1280 + 64 * (j))
#define XB_XGEN(j)  (2304 + 64 * (j))
#define XB_TOP      3328
#define XB_TOPGEN   3392
#define XCD_BAR_WORDS 3456
#define XB_SPIN_CAP (1u << 18)
__device__ __forceinline__ unsigned xb_ld(unsigned* p)              { return __hip_atomic_load(p, __ATOMIC_RELAXED, __HIP_MEMORY_SCOPE_AGENT); }
__device__ __forceinline__ unsigned xb_add(unsigned* p, unsigned v) { return __hip_atomic_fetch_add(p, v, __ATOMIC_RELAXED, __HIP_MEMORY_SCOPE_AGENT); }
__device__ __forceinline__ unsigned xb_xcc_id() { return (unsigned)__builtin_amdgcn_s_getreg((3 << 11) | 20) & 0xFu; }
#define XB_SPIN(cond, bar) do { unsigned _sp = 0; while (cond) { __builtin_amdgcn_s_sleep(1); \
    if ((++_sp & 255u) == 0u) { if (xb_ld(&(bar)[XB_TMO])) break; if (_sp > XB_SPIN_CAP) { atomicAdd(&(bar)[XB_TMO], 1u); break; } } } } while (0)
struct XcdBarrier { unsigned* bar; unsigned x; volatile LAS unsigned* st; };
__device__ __forceinline__ XcdBarrier xcd_barrier_post(unsigned* bar, volatile LAS unsigned* st) {
    XcdBarrier b; b.bar = bar; b.x = xb_xcc_id(); b.st = st;
    if (threadIdx.x == 0) (void)xb_add(&bar[XB_XCNT(b.x)], 1u);
    return b;
}
__device__ __forceinline__ void xcd_barrier_complete(unsigned* bar, unsigned x, unsigned& nloc, unsigned& nx) {
    const unsigned G = gridDim.x * gridDim.y * gridDim.z;
    unsigned sum, cnt, mine, sp = 0u;
    for (;;) {
        sum = 0u; cnt = 0u; mine = 0u;
#pragma unroll
        for (unsigned j = 0; j < 16; ++j) { const unsigned c = xb_ld(&bar[XB_XCNT(j)]); sum += c; cnt += (c > 0u) ? 1u : 0u; mine = (j == x) ? c : mine; }
        if (sum == G) break;
        __builtin_amdgcn_s_sleep(1);
        if ((++sp & 255u) == 0u) { if (xb_ld(&bar[XB_TMO])) break; if (sp > XB_SPIN_CAP) { atomicAdd(&bar[XB_TMO], 1u); break; } }
    }
    nloc = mine > 0u ? mine : 1u; nx = cnt > 0u ? cnt : 1u;
}
__device__ __forceinline__ void xcd_barrier(const XcdBarrier& b) {
    asm volatile("s_waitcnt vmcnt(0)" ::: "memory");
    __syncthreads();
    if (threadIdx.x == 0) {
        unsigned* bar = b.bar;
        __builtin_amdgcn_s_waitcnt(0);
        unsigned nloc = b.st[0], nx = b.st[1];
        if (nloc == 0u) { xcd_barrier_complete(bar, b.x, nloc, nx); b.st[0] = nloc; b.st[1] = nx; }
        const unsigned old = xb_add(&bar[XB_XSUB(b.x)], 1u);
        const unsigned gen = old / nloc;
        if (old + 1u == (gen + 1u) * nloc) {
            __builtin_amdgcn_fence(__ATOMIC_RELEASE, "agent");
            asm volatile("s_waitcnt vmcnt(0)" ::: "memory");
            const unsigned og = xb_add(&bar[XB_TOP], 1u);
            const unsigned tg = og / nx;
            if (og + 1u == (tg + 1u) * nx) xb_add(&bar[XB_TOPGEN], 1u);
            else XB_SPIN(xb_ld(&bar[XB_TOPGEN]) == tg, bar);
            __builtin_amdgcn_fence(__ATOMIC_ACQUIRE, "agent");
            xb_add(&bar[XB_XGEN(b.x)], 1u);
            asm volatile("s_waitcnt vmcnt(0)" ::: "memory");
        } else {
            XB_SPIN(xb_ld(&bar[XB_XGEN(b.x)]) == gen, bar);
            __builtin_amdgcn_fence(__ATOMIC_ACQUIRE, "agent");
            asm volatile("s_waitcnt vmcnt(0)" ::: "memory");
        }
    }
    __syncthreads();
}

struct Args {
    const float* in[33];
    float* out; unsigned char* ws;
    int ph_lo, ph_hi;
};
enum { I_X = 0, I_MEM, I_WIN, I_GLACONV, I_GLAW2, I_GLAB, I_GLANG, I_HGLB, I_HGNG, I_RWMU, I_RWW0, I_RWW2, I_RWA0, I_RWA2, I_RWG2, I_RWKK, I_RWKA, I_RWRK, I_RWLNW, I_RWLNB,
       I_WMK, I_WMV, I_WOUT, I_LN1G, I_LN1B, I_RTW, I_RTB, I_WGU, I_BGU, I_WDN, I_BDN, I_LN2G, I_LN2B };


template <int OFF> __device__ __forceinline__ unsigned long long ka_u64() { unsigned long long v; asm volatile("s_load_dwordx2 %0, %1, %2\n\ts_waitcnt lgkmcnt(0)" : "=s"(v) : "s"(__builtin_amdgcn_kernarg_segment_ptr()), "n"(OFF)); return v; }
#define KIN(i) ((const float*)(const GAS float*)ka_u64<8 * (i)>())
#define KOUT() ((float*)(GAS float*)ka_u64<264>())
#define KWS() ((unsigned char*)(GAS unsigned char*)ka_u64<272>())

template <class Map>
__device__ __forceinline__ void tr_item(const float* __restrict__ W, int K, int N, bf16* __restrict__ WT, LAS float* scr, int kb, int nb, int lane, Map map) {
    const int k0 = 64 * kb, n0 = 64 * nb, col = n0 + lane; const bool valid = col < N;
    const float* src = W + (size_t)k0 * N + (valid ? col : 0);
#pragma unroll 16
    for (int kk = 0; kk < 64; ++kk) { const float v = valid ? src[(size_t)kk * N] : 0.f; scr[kk * 65 + lane] = v; }
    LDS_WAIT(); asm volatile("" ::: "memory");
    const int c = lane & 7;
#pragma unroll
    for (int j = 0; j < 8; ++j) { const int n = (lane >> 3) + 8 * j;
        if (n0 + n < N) { const int orow = map(n0 + n); const LAS float* s = scr + (8 * c) * 65 + n;
            u32x4 o; o.x = pk2(s[0 * 65], s[1 * 65]); o.y = pk2(s[2 * 65], s[3 * 65]); o.z = pk2(s[4 * 65], s[5 * 65]); o.w = pk2(s[6 * 65], s[7 * 65]);
            *(u32x4*)(WT + (size_t)orow * K + k0 + 8 * c) = o; } }
    LDS_WAIT(); asm volatile("" ::: "memory");
}
struct MapIdent { int off; __device__ __forceinline__ int operator()(int c) const { return c + off; } };
struct MapWin { __device__ __forceinline__ int operator()(int c) const { return c < 512 ? c : (c < 528 ? c + 2560 : c - 16); } };
__device__ __forceinline__ int gu_row(int c) { const int f = c >> 1, bj = c & 1, pn = f >> 7, fl = f & 127, wc = fl >> 5, fq = (fl >> 3) & 3, n = (fl >> 2) & 1, j = fl & 3; return 256 * pn + 128 * bj + 32 * wc + 16 * n + 4 * fq + j; }
struct MapGu { __device__ __forceinline__ int operator()(int c) const { return gu_row(c); } };

__device__ __forceinline__ void prologue_phase(LAS unsigned char* lds, int vcu, int G) {
    const int tid = opaque_tid(), lane = tid & 63, wave = __builtin_amdgcn_readfirstlane(tid >> 6);
    LAS float* scr = (LAS float*)(lds + wave * 16640); static_assert(8 * 16640 <= LDSCTL_OFF, "prologue scratch below the LDS control words");
    const int gw = vcu * NWAVES + wave, NGW = G * NWAVES;
    unsigned char* ws = KWS();
    constexpr int IT_GU = NL * NE * 512, IT_DN = NL * NE * 256, IT_IN = NL * 16 * 49, IT_OUT = NL * 256, IT_MEM = NL * 2 * 64, IT_L64 = NL * 2 * 4, IT_L128 = NL * 2 * 4;
    constexpr int IT_TOTAL = IT_GU + IT_DN + IT_IN + IT_OUT + IT_MEM + IT_L64 + IT_L128;
    for (int it = gw; it < IT_TOTAL; it += NGW) {
        int r = it;
        if (r < IT_GU) { const int le = r >> 9, q = r & 511, kb = q >> 5, nb = q & 31;
            tr_item(KIN(I_WGU) + (size_t)le * 1024 * 2048, 1024, 2048, (bf16*)(ws + WS_WGU) + (size_t)le * 2048 * 1024, scr, kb, nb, lane, MapGu{}); continue; } r -= IT_GU;
        if (r < IT_DN) { const int le = r >> 8, q = r & 255, kb = q >> 4, nb = q & 15;
            tr_item(KIN(I_WDN) + (size_t)le * 1024 * 1024, 1024, 1024, (bf16*)(ws + WS_WD) + (size_t)le * 1024 * 1024, scr, kb, nb, lane, MapIdent{0}); continue; } r -= IT_DN;
        if (r < IT_IN) { const int l = r / (16 * 49), q = r % (16 * 49), kb = q / 49, nb = q % 49;
            tr_item(KIN(I_WIN) + (size_t)l * 1024 * PIN, 1024, PIN, (bf16*)(ws + WS_WIN) + (size_t)l * PINP * 1024, scr, kb, nb, lane, MapWin{}); continue; } r -= IT_IN;
        if (r < IT_OUT) { const int l = r >> 8, q = r & 255, kb = q >> 4, nb = q & 15;
            tr_item(KIN(I_WOUT) + (size_t)l * 1024 * 1024, 1024, 1024, (bf16*)(ws + WS_WOUT) + (size_t)l * 1024 * 1024, scr, kb, nb, lane, MapIdent{0}); continue; } r -= IT_OUT;
        if (r < IT_MEM) { const int l = r >> 7, q = r & 127, kv = q >> 6, kb = (q >> 2) & 15, nb = q & 3;
            tr_item((kv ? KIN(I_WMV) : KIN(I_WMK)) + (size_t)l * 1024 * 256, 1024, 256, (bf16*)(ws + WS_WMEM), scr, kb, nb, lane, MapIdent{l * 512 + kv * 256}); continue; } r -= IT_MEM;
        if (r < IT_L64) { const int l = r >> 3, q = r & 7, wa = q >> 2, nb = q & 3;
            tr_item((wa ? KIN(I_RWA2) : KIN(I_RWW2)) + (size_t)l * 64 * 256, 64, 256, (bf16*)(ws + WS_LORA) + (size_t)wa * (NL * 256 * 64) + (size_t)l * 256 * 64, scr, 0, nb, lane, MapIdent{0}); continue; } r -= IT_L64;
        { const int l = r >> 3, q = r & 7, kb = q >> 2, nb = q & 3;
            tr_item(KIN(I_RWG2) + (size_t)l * 128 * 256, 128, 256, (bf16*)(ws + WS_LORA) + (size_t)2 * (NL * 256 * 64) + (size_t)l * 256 * 128, scr, kb, nb, lane, MapIdent{0}); }
    }
    { const size_t gt = (size_t)vcu * NTHR + tid, GT = (size_t)G * NTHR; constexpr size_t per = (size_t)(PINP - PIN) * 1024 / 8;
        for (size_t i = gt; i < per * NL; i += GT) { const size_t l = i / per, j = i % per; *(u32x4*)((bf16*)(ws + WS_WIN) + l * PINP * 1024 + (size_t)PIN * 1024 + j * 8) = (u32x4){0u, 0u, 0u, 0u}; }
        for (size_t i = gt; i < (size_t)NL * NE * 2048; i += GT) { const size_t le = i >> 11; const int c = (int)(i & 2047); ((float*)(ws + WS_BGU))[le * 2048 + gu_row(c)] = KIN(I_BGU)[i]; }
        const f32x4* xs = (const f32x4*)KIN(I_X); u32x4* xd = (u32x4*)(ws + WS_XB);
        for (size_t i = gt; i < (size_t)NTOK * D / 8; i += GT) { const f32x4 v0 = xs[2 * i], v1 = xs[2 * i + 1]; xd[i] = (u32x4){pk2(v0[0], v0[1]), pk2(v0[2], v0[3]), pk2(v1[0], v1[1]), pk2(v1[2], v1[3])}; }
        const f32x4* ms = (const f32x4*)KIN(I_MEM); u32x4* md = (u32x4*)(ws + WS_MEMB);
        for (size_t i = gt; i < (size_t)NB * NMEM * D / 8; i += GT) { const f32x4 v0 = ms[2 * i], v1 = ms[2 * i + 1]; md[i] = (u32x4){pk2(v0[0], v0[1]), pk2(v0[2], v0[3]), pk2(v1[0], v1[1]), pk2(v1[2], v1[3])}; }
    }
}


__device__ __forceinline__ float log1pexp_neg_abs(float z) { return __builtin_amdgcn_logf(1.0f + fast_exp(-fabsf(z))) * 0.6931471805599453f; }
__device__ __forceinline__ float tanh_f(float x) { const float e = fast_exp(-2.0f * fabsf(x)); const float t = (1.0f - e) * __builtin_amdgcn_rcpf(1.0f + e); return x < 0.f ? -t : t; }

constexpr int NCH = T / 32;
__device__ __forceinline__ int rho16(int r, int hh) { return (r & 3) + 8 * (r >> 2) + 4 * hh; }
__device__ __forceinline__ void hg_fused_unit(LAS unsigned char* lds, int l, int b, int c) {
    const int tid = opaque_tid(), lane = tid & 63, wave = __builtin_amdgcn_readfirstlane(tid >> 6), r32 = lane & 31, hh = lane >> 5;
    unsigned char* ws = KWS();
    const bf16* P = (const bf16*)(ws + WS_P) + ((size_t)b * T + c * 32) * PINP;
    constexpr int HB = 8448;
    if (tid < 256) {
        const int ch = tid, h = ch >> 6, d = ch & 63; const size_t un = (size_t)(b * 4 + h) * NCH + c;
        float lb;
        { const float* hp = KIN(I_HGLB) + ch; const float v0 = hp[0], v1 = hp[256], v2 = hp[512], v3 = hp[768]; const float m = fmaxf(fmaxf(v0, v1), fmaxf(v2, v3));
          const float e0 = __expf(v0 - m), e1 = __expf(v1 - m), e2 = __expf(v2 - m), e3 = __expf(v3 - m); const float inv = 1.0f / (e0 + e1 + e2 + e3);
          lb = (l >= 1 ? e1 : 0.f) + (l >= 2 ? e2 : 0.f) + (l >= 3 ? e3 : 0.f); lb *= inv; }
        const float oml = 1.0f - lb;
        LAS bf16* KT = (LAS bf16*)(lds + h * HB); LAS float* BE = (LAS float*)(lds + h * HB + 8192);
        bf16* Qg = (bf16*)(ws + WS_HQ) + un * 2048 + d; bf16* Kg = (bf16*)(ws + WS_HK) + un * 2048 + d;
        float bc = 0.f;
        unsigned short hqr[32], hfr[32];
#pragma unroll
        for (int t = 0; t < 32; ++t) { const bf16* row = P + (size_t)t * PINP; hqr[t] = row[PC_HQ + ch]; hfr[t] = row[PC_HF + ch]; }
#pragma unroll
        for (int t8 = 0; t8 < 4; ++t8) { u32x4 kp;
#pragma unroll
            for (int jj = 0; jj < 4; ++jj) { float k2[2];
#pragma unroll
                for (int e = 0; e < 2; ++e) { const int t = t8 * 8 + jj * 2 + e; const float hf = bf2f(hfr[t]); const float s = fast_sigmoid(hf), sn = fast_sigmoid(-hf);
                    bc = fmaxf(bc + __builtin_amdgcn_logf(fmaxf(lb + oml * s, 1e-30f)) * 0.6931471805599453f, -80.0f);
                    const float qt = silu_f(bf2f(hqr[t])) * fast_exp(bc), kt = oml * sn * fast_exp(-bc);
                    Qg[t * 64] = (bf16)f2bf(qt); Kg[t * 64] = (bf16)f2bf(kt); k2[e] = kt; }
                kp[jj] = pk2(k2[0], k2[1]); }
            *(LAS u32x4*)(KT + d * 32 + t8 * 8) = kp; }
        const float ebend = fast_exp(bc); BE[d] = ebend; ((float*)(ws + WS_HBE))[un * 64 + d] = ebend;
    } else {
        const int cv = tid - 256, h = cv >> 6, vi = cv & 63; const size_t un = (size_t)(b * 4 + h) * NCH + c;
        LAS bf16* VT = (LAS bf16*)(lds + h * HB + 4096); bf16* VTg = (bf16*)(ws + WS_HVT) + un * 2048 + vi * 32;
        unsigned short hvr[32];
#pragma unroll
        for (int t = 0; t < 32; ++t) hvr[t] = P[(size_t)t * PINP + PC_HI + cv];
#pragma unroll
        for (int t8 = 0; t8 < 4; ++t8) { u32x4 vp;
#pragma unroll
            for (int jj = 0; jj < 4; ++jj) vp[jj] = (unsigned)hvr[t8 * 8 + 2 * jj] | ((unsigned)hvr[t8 * 8 + 2 * jj + 1] << 16);
            *(LAS u32x4*)(VT + vi * 32 + t8 * 8) = vp; *(u32x4*)(VTg + t8 * 8) = vp; }
    }
    __syncthreads();
    { const int h = wave >> 1, vt = wave & 1; const size_t un = (size_t)(b * 4 + h) * NCH + c;
      const LAS bf16* KT = (const LAS bf16*)(lds + h * HB); const LAS bf16* VT = (const LAS bf16*)(lds + h * HB + 4096); const LAS float* BE = (const LAS float*)(lds + h * HB + 8192);
      float* DSg = (float*)(ws + WS_HDS) + un * 4096;
#pragma unroll
      for (int dt = 0; dt < 2; ++dt) { f32x16 acc;
#pragma unroll
          for (int i = 0; i < 16; ++i) acc[i] = 0.f;
#pragma unroll
          for (int s = 0; s < 2; ++s) { const bf16x8 A = *(const LAS bf16x8*)(VT + (32 * vt + r32) * 32 + 16 * s + 8 * hh), B = *(const LAS bf16x8*)(KT + (32 * dt + r32) * 32 + 16 * s + 8 * hh);
              acc = __builtin_amdgcn_mfma_f32_32x32x16_bf16(A, B, acc, 0, 0, 0); }
          const float ebd = BE[32 * dt + r32];
#pragma unroll
          for (int r = 0; r < 16; ++r) DSg[(32 * vt + rho16(r, hh)) * 64 + 32 * dt + r32] = acc[r] * ebd; } }
    __syncthreads();
}
__device__ __forceinline__ void gla_fused_unit(LAS unsigned char* lds, int l, int b, int c) {
    const int tid = opaque_tid(), lane = tid & 63, wave = __builtin_amdgcn_readfirstlane(tid >> 6), r32 = lane & 31, hh = lane >> 5;
    unsigned char* ws = KWS();
    const int t0 = c * 32;
    const bf16* P = (const bf16*)(ws + WS_P) + ((size_t)b * T + t0) * PINP;
    LAS float* GL = (LAS float*)lds;
    constexpr int HB = 6272, H0 = 2048;
    GL[tid] = bf2f(P[(size_t)(tid >> 4) * PINP + PC_GLR + (tid & 15)]);
    __syncthreads();
    if (tid < 128) {
        const int ch = tid, h = ch >> 5, d = ch & 31; const size_t un = (size_t)(b * 4 + h) * NCH + c;
        const float* cw = KIN(I_GLACONV) + (size_t)l * 4 * 512 + ch;
        const float q0 = cw[0], q1 = cw[512], q2 = cw[1024], q3 = cw[1536], k0 = cw[128], k1 = cw[640], k2w = cw[1152], k3 = cw[1664];
        const float* w2p = KIN(I_GLAW2) + (size_t)l * 16 * 128 + ch; float wc[16];
#pragma unroll
        for (int r = 0; r < 16; ++r) wc[r] = w2p[r * 128];
        const float gb = KIN(I_GLAB)[l * 128 + ch];
        float uq0 = 0.f, uq1 = 0.f, uq2 = 0.f, uk0 = 0.f, uk1 = 0.f, uk2 = 0.f;
        if (t0 > 0) { uq0 = bf2f(*(P - 3 * PINP + PC_GQ + ch)); uq1 = bf2f(*(P - 2 * PINP + PC_GQ + ch)); uq2 = bf2f(*(P - PINP + PC_GQ + ch));
                      uk0 = bf2f(*(P - 3 * PINP + PC_GK + ch)); uk1 = bf2f(*(P - 2 * PINP + PC_GK + ch)); uk2 = bf2f(*(P - PINP + PC_GK + ch)); }
        LAS bf16* KT = (LAS bf16*)(lds + H0 + h * HB); LAS float* BE = (LAS float*)(lds + H0 + h * HB + 6144);
        bf16* Qg = (bf16*)(ws + WS_GQ) + un * 1024 + d; bf16* Kg = (bf16*)(ws + WS_GK) + un * 1024 + d;
        float bc = 0.f;
        unsigned short xqr[32], xkr[32];
#pragma unroll
        for (int t = 0; t < 32; ++t) { const bf16* row = P + (size_t)t * PINP; xqr[t] = row[PC_GQ + ch]; xkr[t] = row[PC_GK + ch]; }
#pragma unroll
        for (int t8 = 0; t8 < 4; ++t8) { u32x4 kp;
#pragma unroll
            for (int jj = 0; jj < 4; ++jj) { float kk2[2];
#pragma unroll
                for (int e = 0; e < 2; ++e) { const int t = t8 * 8 + jj * 2 + e; const float uq3 = bf2f(xqr[t]), uk3 = bf2f(xkr[t]);
                    const float q = silu_f(q0 * uq0 + q1 * uq1 + q2 * uq2 + q3 * uq3) * 0.17677669529663687f, k = silu_f(k0 * uk0 + k1 * uk1 + k2w * uk2 + k3 * uk3);
                    uq0 = uq1; uq1 = uq2; uq2 = uq3; uk0 = uk1; uk1 = uk2; uk2 = uk3;
                    float z = gb;
#pragma unroll
                    for (int r = 0; r < 16; ++r) z += GL[t * 16 + r] * wc[r];
                    bc = fmaxf(bc + (fminf(z, 0.f) - log1pexp_neg_abs(z)) * 0.0625f, -80.0f);
                    const float qt = q * fast_exp(bc), kt = k * fast_exp(-bc);
                    Qg[t * 32] = (bf16)f2bf(qt); Kg[t * 32] = (bf16)f2bf(kt); kk2[e] = kt; }
                kp[jj] = pk2(kk2[0], kk2[1]); }
            *(LAS u32x4*)(KT + d * 32 + t8 * 8) = kp; }
        const float ebend = fast_exp(bc); BE[d] = ebend; ((float*)(ws + WS_GBE))[un * 32 + d] = ebend;
    } else if (tid < 384) {
        const int cv = tid - 128, h = cv >> 6, vi = cv & 63; const size_t un = (size_t)(b * 4 + h) * NCH + c;
        const float* cw = KIN(I_GLACONV) + (size_t)l * 4 * 512 + 256 + cv;
        const float w0 = cw[0], w1 = cw[512], w2 = cw[1024], w3 = cw[1536];
        float u0 = 0.f, u1 = 0.f, u2 = 0.f;
        if (t0 > 0) { u0 = bf2f(*(P - 3 * PINP + PC_GV + cv)); u1 = bf2f(*(P - 2 * PINP + PC_GV + cv)); u2 = bf2f(*(P - PINP + PC_GV + cv)); }
        LAS bf16* VT = (LAS bf16*)(lds + H0 + h * HB + 2048); bf16* VTg = (bf16*)(ws + WS_GVT) + un * 2048 + vi * 32;
        unsigned short xvr[32];
#pragma unroll
        for (int t = 0; t < 32; ++t) xvr[t] = P[(size_t)t * PINP + PC_GV + cv];
#pragma unroll
        for (int t8 = 0; t8 < 4; ++t8) { u32x4 vp; float yv[8];
#pragma unroll
            for (int e = 0; e < 8; ++e) { const float u3 = bf2f(xvr[t8 * 8 + e]); yv[e] = silu_f(w0 * u0 + w1 * u1 + w2 * u2 + w3 * u3); u0 = u1; u1 = u2; u2 = u3; }
#pragma unroll
            for (int jj = 0; jj < 4; ++jj) vp[jj] = pk2(yv[2 * jj], yv[2 * jj + 1]);
            *(LAS u32x4*)(VT + vi * 32 + t8 * 8) = vp; *(u32x4*)(VTg + t8 * 8) = vp; }
    }
    __syncthreads();
    { const int h = wave >> 1, vt = wave & 1; const size_t un = (size_t)(b * 4 + h) * NCH + c;
      const LAS bf16* KT = (const LAS bf16*)(lds + H0 + h * HB); const LAS bf16* VT = (const LAS bf16*)(lds + H0 + h * HB + 2048); const LAS float* BE = (const LAS float*)(lds + H0 + h * HB + 6144);
      float* DSg = (float*)(ws + WS_GDS) + un * 2048;
      f32x16 acc;
#pragma unroll
      for (int i = 0; i < 16; ++i) acc[i] = 0.f;
#pragma unroll
      for (int s = 0; s < 2; ++s) { const bf16x8 A = *(const LAS bf16x8*)(VT + (32 * vt + r32) * 32 + 16 * s + 8 * hh), B = *(const LAS bf16x8*)(KT + r32 * 32 + 16 * s + 8 * hh);
          acc = __builtin_amdgcn_mfma_f32_32x32x16_bf16(A, B, acc, 0, 0, 0); }
      const float ebd = BE[r32];
#pragma unroll
      for (int r = 0; r < 16; ++r) DSg[(32 * vt + rho16(r, hh)) * 32 + r32] = acc[r] * ebd; }
    __syncthreads();
}
template <int DK>
__device__ __forceinline__ void m2_gh_elem(int e, const float* __restrict__ DS, const float* __restrict__ BE, bf16* __restrict__ SG) {
    constexpr int EPB = 64 * DK; const int bh = e / EPB, idx = e % EPB, d = idx % DK; const size_t un0 = (size_t)bh * NCH;
    float S = 0.f;
#pragma unroll 1
    for (int c0 = 0; c0 < NCH; c0 += 8) { float ds[8], be[8];
#pragma unroll
        for (int u = 0; u < 8; ++u) { ds[u] = DS[(un0 + c0 + u) * EPB + idx]; be[u] = BE[(un0 + c0 + u) * DK + d]; }
#pragma unroll
        for (int u = 0; u < 8; ++u) { SG[(un0 + c0 + u) * EPB + idx] = (bf16)f2bf(S); S = S * be[u] + ds[u]; } }
}
template <int DK>
__device__ __forceinline__ void m3_gh_task(int lane, const bf16* __restrict__ Qg, const bf16* __restrict__ Kg, const bf16* __restrict__ VTg, const bf16* __restrict__ Sg,
                                           const bf16* __restrict__ gate  , const float* __restrict__ ng  , bf16* __restrict__ orow  ) {
    const int r32 = lane & 31, hh = lane >> 5;
    bf16x8 qf[DK / 16];
    f32x16 at;
#pragma unroll
    for (int i = 0; i < 16; ++i) at[i] = 0.f;
#pragma unroll
    for (int s = 0; s < DK / 16; ++s) { qf[s] = *(const bf16x8*)(Qg + r32 * DK + 16 * s + 8 * hh); const bf16x8 kf = *(const bf16x8*)(Kg + r32 * DK + 16 * s + 8 * hh);
        at = __builtin_amdgcn_mfma_f32_32x32x16_bf16(kf, qf[s], at, 0, 0, 0); }
#pragma unroll
    for (int r = 0; r < 16; ++r) if (rho16(r, hh) > r32) at[r] = 0.f;
    f32x16 o[2];
#pragma unroll
    for (int vt = 0; vt < 2; ++vt)
#pragma unroll
        for (int i = 0; i < 16; ++i) o[vt][i] = 0.f;
#pragma unroll
    for (int s = 0; s < 2; ++s) { union { bf16x8 v; unsigned w[4]; } pf;
#pragma unroll
        for (int j = 0; j < 4; ++j) pf.w[j] = cvt_pk_bf16(at[8 * s + 2 * j], at[8 * s + 2 * j + 1]);
#pragma unroll
        for (int vt = 0; vt < 2; ++vt) { const bf16* vp = VTg + (32 * vt + r32) * 32 + 16 * s + 4 * hh;
            union { bf16x8 v; s16x4 h2[2]; } vf; vf.h2[0] = *(const s16x4*)vp; vf.h2[1] = *(const s16x4*)(vp + 8);
            o[vt] = __builtin_amdgcn_mfma_f32_32x32x16_bf16(vf.v, pf.v, o[vt], 0, 0, 0); } }
#pragma unroll
    for (int vt = 0; vt < 2; ++vt)
#pragma unroll
        for (int s = 0; s < DK / 16; ++s) { const bf16x8 sf = *(const bf16x8*)(Sg + (32 * vt + r32) * DK + 16 * s + 8 * hh);
            o[vt] = __builtin_amdgcn_mfma_f32_32x32x16_bf16(sf, qf[s], o[vt], 0, 0, 0); }
    float ss = 0.f;
#pragma unroll
    for (int vt = 0; vt < 2; ++vt)
#pragma unroll
        for (int i = 0; i < 16; ++i) ss += o[vt][i] * o[vt][i];
    ss += __shfl_xor(ss, 32);
    const float rstd = 1.0f / sqrtf(ss * (1.0f / 64.0f) + RMS_EPS);
    const bf16* grow = gate + (size_t)r32 * PINP; bf16* od = orow + (size_t)r32 * D;
#pragma unroll
    for (int vt = 0; vt < 2; ++vt)
#pragma unroll
        for (int g = 0; g < 4; ++g) { const int v0 = 32 * vt + 8 * g + 4 * hh; const u32x2 gw = *(const u32x2*)(grow + v0); const f32x4 n4 = *(const f32x4*)(ng + v0);
            const float y0 = o[vt][4 * g] * rstd * n4[0] * silu_f(bflo(gw.x)), y1 = o[vt][4 * g + 1] * rstd * n4[1] * silu_f(bfhi(gw.x));
            const float y2 = o[vt][4 * g + 2] * rstd * n4[2] * silu_f(bflo(gw.y)), y3 = o[vt][4 * g + 3] * rstd * n4[3] * silu_f(bfhi(gw.y));
            *(u32x2*)(od + v0) = (u32x2){pk2(y0, y1), pk2(y2, y3)}; }
}

constexpr int RWC_HEADB = 28928;
constexpr int RWC_AL = 4 * RWC_HEADB, RWC_LWL = RWC_AL + 32 * 264 * 2;
static_assert(RWC_LWL + 32 * 264 * 2 <= LDSCTL_OFF, "rw_fused_unit LDS");
__device__ __forceinline__ void rw_fused_unit(LAS unsigned char* lds, int l, int b, int c) {
    const int tid = opaque_tid(), lane = tid & 63, wave = __builtin_amdgcn_readfirstlane(tid >> 6), h = wave >> 1, p = wave & 1, r32 = lane & 31, hh = lane >> 5;
    unsigned char* ws = KWS();
    const int bh = b * 4 + h; const size_t un = (size_t)bh * NCH + c;
    const int t0 = c * 32;
    const bf16* P = (const bf16*)(ws + WS_P) + ((size_t)b * T + t0) * PINP + PC_RW;
    const float* mu = KIN(I_RWMU) + (size_t)l * 1024;
    LAS bf16* XL = (LAS bf16*)lds;
    LAS bf16* AL = (LAS bf16*)(lds + RWC_AL);
    LAS bf16* LWL = (LAS bf16*)(lds + RWC_LWL);
    for (int i = tid; i < 32 * 256; i += NTHR) { const int tok = i >> 8, cc = i & 255;
        const bf16* row = P + (size_t)tok * PINP + 768 + cc;
        const float cur = bf2f(row[0]), prev = (t0 + tok > 0) ? bf2f(*(row - PINP)) : 0.f;
        float x = cur + (prev - cur) * mu[768 + cc];
        if (cc < 64) x = tanh_f(x); else if (cc >= 128) x = fast_sigmoid(x);
        XL[tok * 264 + cc] = (bf16)f2bf(x); }
    __syncthreads();
    {
        const int ch = wave * 32 + r32;
        const bf16* w2T = (const bf16*)(ws + WS_LORA) + (size_t)l * 256 * 64 + (size_t)ch * 64;
        const bf16* a2T = (const bf16*)(ws + WS_LORA) + (size_t)(NL * 256 * 64) + (size_t)l * 256 * 64 + (size_t)ch * 64;
        const bf16* g2T = (const bf16*)(ws + WS_LORA) + (size_t)2 * (NL * 256 * 64) + (size_t)l * 256 * 128 + (size_t)ch * 128;
        const LAS bf16* xa = XL + r32 * 264 + 8 * hh;
        {
            f32x16 acc;
#pragma unroll
            for (int i = 0; i < 16; ++i) acc[i] = 0.f;
#pragma unroll
            for (int s = 0; s < 4; ++s) { const bf16x8 A = *(const LAS bf16x8*)(xa + 16 * s); const bf16x8 Bw = *(const bf16x8*)(w2T + 16 * s + 8 * hh);
                acc = __builtin_amdgcn_mfma_f32_32x32x16_bf16(A, Bw, acc, 0, 0, 0); }
            const float w0c = KIN(I_RWW0)[l * 256 + ch];
#pragma unroll
            for (int r = 0; r < 16; ++r) { const int tok = rho16(r, hh);
                const float zw = w0c + acc[r]; const float wlog = -(fmaxf(-zw, 0.f) + log1pexp_neg_abs(zw)) - 0.5f;
                LWL[tok * 264 + ch] = (bf16)f2bf(-fast_exp(wlog)); }
        }
        __builtin_amdgcn_sched_barrier(0);
        {
            f32x16 acc;
#pragma unroll
            for (int i = 0; i < 16; ++i) acc[i] = 0.f;
#pragma unroll
            for (int s = 0; s < 4; ++s) { const bf16x8 A = *(const LAS bf16x8*)(xa + 64 + 16 * s); const bf16x8 Bw = *(const bf16x8*)(a2T + 16 * s + 8 * hh);
                acc = __builtin_amdgcn_mfma_f32_32x32x16_bf16(A, Bw, acc, 0, 0, 0); }
            const float a0c = KIN(I_RWA0)[l * 256 + ch];
#pragma unroll
            for (int r = 0; r < 16; ++r) AL[rho16(r, hh) * 264 + ch] = (bf16)f2bf(fast_sigmoid(a0c + acc[r]));
        }
        __builtin_amdgcn_sched_barrier(0);
        {
            f32x16 acc;
#pragma unroll
            for (int i = 0; i < 16; ++i) acc[i] = 0.f;
#pragma unroll
            for (int s = 0; s < 8; ++s) { const bf16x8 A = *(const LAS bf16x8*)(xa + 128 + 16 * s); const bf16x8 Bw = *(const bf16x8*)(g2T + 16 * s + 8 * hh);
                acc = __builtin_amdgcn_mfma_f32_32x32x16_bf16(A, Bw, acc, 0, 0, 0); }
            bf16* gb = (bf16*)(ws + WS_GBUF) + ((size_t)b * T + t0) * 256 + ch;
#pragma unroll
            for (int r = 0; r < 16; ++r) gb[(size_t)rho16(r, hh) * 256] = (bf16)f2bf(acc[r]);
        }
    }
    __syncthreads();
    LAS unsigned char* L = lds + h * RWC_HEADB;
    LAS bf16* AT = (LAS bf16*)L;
    LAS bf16* BT = (LAS bf16*)(L + 4096);
    LAS bf16* KT = (LAS bf16*)(L + 8192);
    LAS bf16* ATT = (LAS bf16*)(L + 12288);
    LAS bf16* BHT = (LAS bf16*)(L + 16384);
    LAS bf16* KHT = (LAS bf16*)(L + 20480);
    LAS bf16* VT = (LAS bf16*)(L + 24576);
    LAS float* GC = (LAS float*)(L + 28672);
    LAS float* MAB = (LAS float*)(L + 4096);
    LAS bf16* MAK = (LAS bf16*)(L + 8192);
    LAS bf16* TM = (LAS bf16*)L;
    if (wave < 4) {
        const int hs = wave, d = lane, ch = hs * 64 + d; const size_t uns = (size_t)(b * 4 + hs) * NCH + c;
        LAS unsigned char* Ls = lds + hs * RWC_HEADB;
        LAS bf16* sAT = (LAS bf16*)Ls; LAS bf16* sBT = (LAS bf16*)(Ls + 4096); LAS bf16* sKT = (LAS bf16*)(Ls + 8192);
        LAS bf16* sATT = (LAS bf16*)(Ls + 12288); LAS bf16* sBHT = (LAS bf16*)(Ls + 16384); LAS bf16* sKHT = (LAS bf16*)(Ls + 20480); LAS float* sGC = (LAS float*)(Ls + 28672);
        const float mr = mu[ch], mk = mu[256 + ch];
        const float kkc = KIN(I_RWKK)[l * 256 + ch], kac = KIN(I_RWKA)[l * 256 + ch], rkc = KIN(I_RWRK)[l * 256 + ch];
        float lgend = 0.f;
#pragma unroll 8
        for (int t = 0; t < 32; ++t) lgend += bf2f(LWL[t * 264 + ch]);
        bf16* RGp = (bf16*)(ws + WS_RR) + uns * 2048 + d; bf16* BGp = (bf16*)(ws + WS_RB) + uns * 2048 + d; bf16* KGp = (bf16*)(ws + WS_RK) + uns * 2048 + d;
        float* bonp = (float*)(ws + WS_BONUS) + ((size_t)b * T + t0) * 4 + hs;
        float lg = 0.f;
        float rprev = 0.f, kprev = 0.f;
        if (t0 > 0) { rprev = bf2f(*(P - PINP + ch)); kprev = bf2f(*(P - PINP + 256 + ch)); }
        unsigned short xrr[32], xkr[32];
#pragma unroll
        for (int t = 0; t < 32; ++t) { const bf16* row = P + (size_t)t * PINP; xrr[t] = row[ch]; xkr[t] = row[256 + ch]; }
#pragma unroll 1
        for (int t8 = 0; t8 < 4; ++t8) { u32x4 ap, bp, kp; float xr[8], xk[8];
#pragma unroll
            for (int e = 0; e < 8; ++e) { xr[e] = bf2f(t8 == 0 ? xrr[e] : t8 == 1 ? xrr[8 + e] : t8 == 2 ? xrr[16 + e] : xrr[24 + e]); xk[e] = bf2f(t8 == 0 ? xkr[e] : t8 == 1 ? xkr[8 + e] : t8 == 2 ? xkr[16 + e] : xkr[24 + e]); }
#pragma unroll
            for (int jj = 0; jj < 4; ++jj) { float at2[2], bh2[2], kh2[2];
#pragma unroll
                for (int e = 0; e < 2; ++e) { const int t = t8 * 8 + jj * 2 + e;
                    const float rc = xr[jj * 2 + e], kc = xk[jj * 2 + e];
                    const float r = rc + (rprev - rc) * mr, k = kc + (kprev - kc) * mk; rprev = rc; kprev = kc;
                    const float av = bf2f(AL[t * 264 + ch]), lw = bf2f(LWL[t * 264 + ch]);
                    const float kkr = k * kkc, hk = k * (1.0f + (av - 1.0f) * kac);
                    const float ss = wave_sum(kkr * kkr); const float kk = kkr / fmaxf(sqrtf(ss), 1e-12f);
                    const float bon = wave_sum(r * hk * rkc);
                    const float aa = -kk, bb = kk * av;
                    const float lgp = lg; lg += lw;
                    const float at = aa * fast_exp(lgp), rt = r * fast_exp(lg), ei = fast_exp(-lg), bt = bb * ei, kt = hk * ei, eh = fast_exp(lgend - lg);
                    sAT[t * 64 + d] = (bf16)f2bf(at); sBT[t * 64 + d] = (bf16)f2bf(bt); sKT[t * 64 + d] = (bf16)f2bf(kt);
                    RGp[t * 64] = (bf16)f2bf(rt); BGp[t * 64] = (bf16)f2bf(bt); KGp[t * 64] = (bf16)f2bf(kt);
                    if (d == 0) bonp[t * 4] = bon;
                    at2[e] = at; bh2[e] = bb * eh; kh2[e] = hk * eh; }
                ap[jj] = pk2(at2[0], at2[1]); bp[jj] = pk2(bh2[0], bh2[1]); kp[jj] = pk2(kh2[0], kh2[1]); }
            *(LAS u32x4*)(sATT + d * 32 + t8 * 8) = ap; *(LAS u32x4*)(sBHT + d * 32 + t8 * 8) = bp; *(LAS u32x4*)(sKHT + d * 32 + t8 * 8) = kp; }
        sGC[d] = fast_exp(lgend);
    } else {
        const int cv = tid - 256, hs = cv >> 6, vi = cv & 63; const size_t uns = (size_t)(b * 4 + hs) * NCH + c;
        LAS bf16* sVT = (LAS bf16*)(lds + hs * RWC_HEADB + 24576);
        bf16* VTg = (bf16*)(ws + WS_RVT) + uns * 2048 + vi * 32; bf16* VGp = (bf16*)(ws + WS_RVG) + uns * 2048 + vi;
        const float mv = mu[512 + cv];
        float vprev = 0.f; if (t0 > 0) vprev = bf2f(*(P - PINP + 512 + cv));
        unsigned short xvr[32];
#pragma unroll
        for (int t = 0; t < 32; ++t) xvr[t] = P[(size_t)t * PINP + 512 + cv];
#pragma unroll
        for (int t8 = 0; t8 < 4; ++t8) { u32x4 vp; float yv[8];
#pragma unroll
            for (int e = 0; e < 8; ++e) { const float xv = bf2f(xvr[t8 * 8 + e]); yv[e] = xv + (vprev - xv) * mv; vprev = xv; VGp[(t8 * 8 + e) * 64] = (bf16)f2bf(yv[e]); }
#pragma unroll
            for (int jj = 0; jj < 4; ++jj) vp[jj] = pk2(yv[2 * jj], yv[2 * jj + 1]);
            *(LAS u32x4*)(sVT + vi * 32 + t8 * 8) = vp; *(u32x4*)(VTg + t8 * 8) = vp; }
    }
    __syncthreads();
    f32x16 accR[2];
    {
        f32x16 acc;
#pragma unroll
        for (int i = 0; i < 16; ++i) acc[i] = 0.f;
        const LAS bf16* Bsrc = p == 0 ? BT : KT;
#pragma unroll
        for (int s = 0; s < 4; ++s) { const bf16x8 A = *(const LAS bf16x8*)(AT + r32 * 64 + 16 * s + 8 * hh), B = *(const LAS bf16x8*)(Bsrc + r32 * 64 + 16 * s + 8 * hh);
            acc = __builtin_amdgcn_mfma_f32_32x32x16_bf16(A, B, acc, 0, 0, 0); }
        if (p == 0) {
#pragma unroll
            for (int r = 0; r < 16; ++r) { const int t = rho16(r, hh); MAB[t * 32 + r32] = (r32 < t) ? acc[r] : 0.f; }
        } else {
#pragma unroll
            for (int r = 0; r < 16; ++r) { const int t = rho16(r, hh); MAK[t * 32 + r32] = (bf16)f2bf((r32 < t) ? acc[r] : 0.f); }
        }
    }
    __syncthreads();
    if (p == 0) {
        const int cidx = r32; float tc[32];
#pragma unroll
        for (int t = 0; t < 32; ++t) { float acc0 = (t == cidx) ? 1.0f : 0.f, acc1 = 0.f;
#pragma unroll
            for (int s4 = 0; s4 < (t + 3) / 4; ++s4) { const f32x4 m4 = *(const LAS f32x4*)(MAB + t * 32 + 4 * s4);
#pragma unroll
                for (int e = 0; e < 4; ++e) { const int s = 4 * s4 + e; if (s < t) { if (e & 1) acc1 = fmaf(m4[e], tc[s], acc1); else acc0 = fmaf(m4[e], tc[s], acc0); } } }
            tc[t] = acc0 + acc1; }
#pragma unroll
        for (int t = 0; t < 32; ++t) if (hh == 0) TM[t * 32 + cidx] = (bf16)f2bf(tc[t]);
    } else {
#pragma unroll
        for (int vt = 0; vt < 2; ++vt) {
#pragma unroll
            for (int i = 0; i < 16; ++i) accR[vt][i] = 0.f;
#pragma unroll
            for (int s = 0; s < 2; ++s) { const bf16x8 A = *(const LAS bf16x8*)(MAK + r32 * 32 + 16 * s + 8 * hh), B = *(const LAS bf16x8*)(VT + (32 * vt + r32) * 32 + 16 * s + 8 * hh);
                accR[vt] = __builtin_amdgcn_mfma_f32_32x32x16_bf16(A, B, accR[vt], 0, 0, 0); } }
    }
    __syncthreads();
    if (p == 0) {
        f32x16 accW[2];
#pragma unroll
        for (int dt = 0; dt < 2; ++dt) {
#pragma unroll
            for (int i = 0; i < 16; ++i) accW[dt][i] = 0.f;
#pragma unroll
            for (int s = 0; s < 2; ++s) { const bf16x8 A = *(const LAS bf16x8*)(TM + r32 * 32 + 16 * s + 8 * hh), B = *(const LAS bf16x8*)(ATT + (32 * dt + r32) * 32 + 16 * s + 8 * hh);
                accW[dt] = __builtin_amdgcn_mfma_f32_32x32x16_bf16(A, B, accW[dt], 0, 0, 0); } }
        { LAS bf16* WL = ATT;
#pragma unroll
          for (int dt = 0; dt < 2; ++dt)
#pragma unroll
              for (int r = 0; r < 16; ++r) WL[rho16(r, hh) * 64 + 32 * dt + r32] = (bf16)f2bf(accW[dt][r]);
          u32x4* WGp = (u32x4*)((bf16*)(ws + WS_RW) + un * 2048);
#pragma unroll
          for (int i = 0; i < 4; ++i) WGp[i * 64 + lane] = *(const LAS u32x4*)(WL + (i * 64 + lane) * 8); }
        LAS bf16* PL = (LAS bf16*)(L + 4096);
        const int xs = r32 >> 4, xx = r32 & 15, hhA = (xx >> 2) & 1, jA = 4 * (xx >> 3) + (xx & 3);
#pragma unroll
        for (int dt = 0; dt < 2; ++dt)
#pragma unroll
            for (int dt2 = 0; dt2 < 2; ++dt2) { f32x16 acc;
#pragma unroll
                for (int i = 0; i < 16; ++i) acc[i] = 0.f;
#pragma unroll
                for (int s = 0; s < 2; ++s) { const LAS bf16* bp = BHT + (32 * dt + r32) * 32 + 16 * s + 4 * hh;
                    union { bf16x8 v; s16x4 h2[2]; } af; af.h2[0] = *(const LAS s16x4*)bp; af.h2[1] = *(const LAS s16x4*)(bp + 8);
                    union { bf16x8 v; unsigned w[4]; } bf;
#pragma unroll
                    for (int j = 0; j < 4; ++j) bf.w[j] = cvt_pk_bf16(accW[dt2][8 * s + 2 * j], accW[dt2][8 * s + 2 * j + 1]);
                    acc = __builtin_amdgcn_mfma_f32_32x32x16_bf16(af.v, bf.v, acc, 0, 0, 0); }
                if (dt == dt2) { const float gc = GC[32 * dt + r32];
#pragma unroll
                    for (int r = 0; r < 16; ++r) if (rho16(r, hh) == r32) acc[r] += gc; }
                LAS bf16* pf = PL + (((dt * 2 + dt2) * 2 + xs) * 64 + 32 * hhA) * 8 + jA;
#pragma unroll
                for (int r = 0; r < 16; ++r) pf[rho16(r, hh) * 8] = (bf16)f2bf(acc[r]); }
        { u32x4* PFp = (u32x4*)((bf16*)(ws + WS_RP) + un * 4096);
#pragma unroll
          for (int f = 0; f < 8; ++f) PFp[f * 64 + lane] = *(const LAS u32x4*)(PL + (f * 64 + lane) * 8); }
    } else {
        f32x16 accU[2];
#pragma unroll
        for (int vt = 0; vt < 2; ++vt) {
#pragma unroll
            for (int i = 0; i < 16; ++i) accU[vt][i] = 0.f;
#pragma unroll
            for (int s = 0; s < 2; ++s) { const LAS bf16* tp = TM + r32 * 32 + 16 * s + 4 * hh;
                union { bf16x8 v; s16x4 h2[2]; } af; af.h2[0] = *(const LAS s16x4*)tp; af.h2[1] = *(const LAS s16x4*)(tp + 8);
                union { bf16x8 v; unsigned w[4]; } bf;
#pragma unroll
                for (int j = 0; j < 4; ++j) bf.w[j] = cvt_pk_bf16(accR[vt][8 * s + 2 * j], accR[vt][8 * s + 2 * j + 1]);
                accU[vt] = __builtin_amdgcn_mfma_f32_32x32x16_bf16(af.v, bf.v, accU[vt], 0, 0, 0); } }
        float* UGp = (float*)(ws + WS_RU) + un * 2048;
#pragma unroll
        for (int vt = 0; vt < 2; ++vt)
#pragma unroll
            for (int g = 0; g < 4; ++g) *(f32x4*)(UGp + ((vt * 4 + g) * 64 + lane) * 4) = (f32x4){accU[vt][4 * g], accU[vt][4 * g + 1], accU[vt][4 * g + 2], accU[vt][4 * g + 3]};
        float* QFp = (float*)(ws + WS_RQ) + un * 4096;
#pragma unroll
        for (int vt = 0; vt < 2; ++vt)
#pragma unroll
            for (int dt = 0; dt < 2; ++dt) { f32x16 acc;
#pragma unroll
                for (int i = 0; i < 16; ++i) acc[i] = 0.f;
#pragma unroll
                for (int s = 0; s < 2; ++s) { const LAS bf16* bp = BHT + (32 * dt + r32) * 32 + 16 * s + 4 * hh;
                    union { bf16x8 v; s16x4 h2[2]; } af; af.h2[0] = *(const LAS s16x4*)bp; af.h2[1] = *(const LAS s16x4*)(bp + 8);
                    union { bf16x8 v; unsigned w[4]; } bf;
#pragma unroll
                    for (int j = 0; j < 4; ++j) bf.w[j] = cvt_pk_bf16(accU[vt][8 * s + 2 * j], accU[vt][8 * s + 2 * j + 1]);
                    acc = __builtin_amdgcn_mfma_f32_32x32x16_bf16(af.v, bf.v, acc, 0, 0, 0);
                    const bf16x8 A2 = *(const LAS bf16x8*)(KHT + (32 * dt + r32) * 32 + 16 * s + 8 * hh), B2 = *(const LAS bf16x8*)(VT + (32 * vt + r32) * 32 + 16 * s + 8 * hh);
                    acc = __builtin_amdgcn_mfma_f32_32x32x16_bf16(A2, B2, acc, 0, 0, 0); }
#pragma unroll
                for (int g = 0; g < 4; ++g) *(f32x4*)(QFp + (((vt * 2 + dt) * 4 + g) * 64 + lane) * 4) = (f32x4){acc[4 * g], acc[4 * g + 1], acc[4 * g + 2], acc[4 * g + 3]}; }
    }
    __syncthreads();
}
__device__ __forceinline__ void rw_m2_wave(int lane, int bh, int vt) {
    unsigned char* ws = KWS();
    const bf16* PF = (const bf16*)(ws + WS_RP) + (size_t)bh * NCH * 4096 + lane * 8;
    const float* QF = (const float*)(ws + WS_RQ) + (size_t)bh * NCH * 4096 + (size_t)vt * 2048 + lane * 4;
    bf16* SG = (bf16*)(ws + WS_RS) + (size_t)bh * NCH * 4096 + (size_t)vt * 2048 + lane * 8;
    f32x16 S[2];
#pragma unroll
    for (int dt = 0; dt < 2; ++dt)
#pragma unroll
        for (int i = 0; i < 16; ++i) S[dt][i] = 0.f;
    bf16x8 pA[8], pB[8]; f32x4 qA[8], qB[8];
#define RWM2_LOAD(P_, Q_, c_) do { const int _c = (c_) < NCH ? (c_) : NCH - 1; _Pragma("unroll") for (int f = 0; f < 8; ++f) { P_[f] = *(const bf16x8*)(PF + (size_t)_c * 4096 + f * 512); Q_[f] = *(const f32x4*)(QF + (size_t)_c * 4096 + f * 256); } } while (0)
#define RWM2_STEP(P_, Q_, c_) do { \
        union { bf16x8 v; unsigned w[4]; } sb[2][2]; \
        _Pragma("unroll") for (int dt2 = 0; dt2 < 2; ++dt2) _Pragma("unroll") for (int s = 0; s < 2; ++s) { \
            _Pragma("unroll") for (int j = 0; j < 4; ++j) sb[dt2][s].w[j] = cvt_pk_bf16(S[dt2][8 * s + 2 * j], S[dt2][8 * s + 2 * j + 1]); \
            *(bf16x8*)(SG + (size_t)(c_) * 4096 + (dt2 * 2 + s) * 512) = sb[dt2][s].v; } \
        f32x16 N[2]; \
        _Pragma("unroll") for (int dt = 0; dt < 2; ++dt) { \
            _Pragma("unroll") for (int g = 0; g < 4; ++g) { N[dt][4 * g] = Q_[dt * 4 + g][0]; N[dt][4 * g + 1] = Q_[dt * 4 + g][1]; N[dt][4 * g + 2] = Q_[dt * 4 + g][2]; N[dt][4 * g + 3] = Q_[dt * 4 + g][3]; } \
            _Pragma("unroll") for (int dt2 = 0; dt2 < 2; ++dt2) _Pragma("unroll") for (int s = 0; s < 2; ++s) N[dt] = __builtin_amdgcn_mfma_f32_32x32x16_bf16(P_[(dt * 2 + dt2) * 2 + s], sb[dt2][s].v, N[dt], 0, 0, 0); } \
        S[0] = N[0]; S[1] = N[1]; } while (0)
    RWM2_LOAD(pA, qA, 0); RWM2_LOAD(pB, qB, 1);
#pragma unroll 1
    for (int c = 0; c < NCH; c += 2) {
        RWM2_STEP(pA, qA, c); RWM2_LOAD(pA, qA, c + 2);
        RWM2_STEP(pB, qB, c + 1); RWM2_LOAD(pB, qB, c + 3);
    }
#undef RWM2_LOAD
#undef RWM2_STEP
}
__device__ __forceinline__ bf16x8 ld_perm8(const bf16* p) { union { bf16x8 v; s16x4 h2[2]; } f; f.h2[0] = *(const s16x4*)p; f.h2[1] = *(const s16x4*)(p + 8); return f.v; }
__device__ __forceinline__ void rw_m3_task(int lane, int l, int bh, int c) {
    unsigned char* ws = KWS();
    const int r32 = lane & 31, hh = lane >> 5, b = bh >> 2, h = bh & 3; const size_t un = (size_t)bh * NCH + c; const size_t tok0 = (size_t)b * T + c * 32;
    const bf16* RGp = (const bf16*)(ws + WS_RR) + un * 2048 + r32 * 64 + 4 * hh; const bf16* BGp = (const bf16*)(ws + WS_RB) + un * 2048 + r32 * 64 + 4 * hh;
    const bf16* KGp = (const bf16*)(ws + WS_RK) + un * 2048 + r32 * 64 + 4 * hh; const bf16* WGp = (const bf16*)(ws + WS_RW) + un * 2048 + r32 * 64 + 4 * hh;
    const bf16* SGp = (const bf16*)(ws + WS_RS) + un * 4096 + lane * 8; const bf16* VTp = (const bf16*)(ws + WS_RVT) + un * 2048 + r32 * 32 + 4 * hh;
    const float* UGp = (const float*)(ws + WS_RU) + un * 2048 + lane * 4;
    f32x16 U[2], Y[2], mb, mk;
#pragma unroll
    for (int vt = 0; vt < 2; ++vt)
#pragma unroll
        for (int g = 0; g < 4; ++g) { const f32x4 u4 = *(const f32x4*)(UGp + (vt * 4 + g) * 256); U[vt][4 * g] = u4[0]; U[vt][4 * g + 1] = u4[1]; U[vt][4 * g + 2] = u4[2]; U[vt][4 * g + 3] = u4[3]; }
#pragma unroll
    for (int i = 0; i < 16; ++i) { mb[i] = 0.f; mk[i] = 0.f; Y[0][i] = 0.f; Y[1][i] = 0.f; }
#pragma unroll
    for (int ks = 0; ks < 4; ++ks) {
        const bf16x8 rf = ld_perm8(RGp + 16 * ks), wf = ld_perm8(WGp + 16 * ks), bfr = ld_perm8(BGp + 16 * ks), kfr = ld_perm8(KGp + 16 * ks);
        const bf16x8 s0 = *(const bf16x8*)(SGp + ks * 512), s1 = *(const bf16x8*)(SGp + 2048 + ks * 512);
        U[0] = __builtin_amdgcn_mfma_f32_32x32x16_bf16(wf, s0, U[0], 0, 0, 0); U[1] = __builtin_amdgcn_mfma_f32_32x32x16_bf16(wf, s1, U[1], 0, 0, 0);
        mb = __builtin_amdgcn_mfma_f32_32x32x16_bf16(bfr, rf, mb, 0, 0, 0); mk = __builtin_amdgcn_mfma_f32_32x32x16_bf16(kfr, rf, mk, 0, 0, 0);
        Y[0] = __builtin_amdgcn_mfma_f32_32x32x16_bf16(s0, rf, Y[0], 0, 0, 0); Y[1] = __builtin_amdgcn_mfma_f32_32x32x16_bf16(s1, rf, Y[1], 0, 0, 0); }
#pragma unroll
    for (int r = 0; r < 16; ++r) if (rho16(r, hh) > r32) { mb[r] = 0.f; mk[r] = 0.f; }
#pragma unroll
    for (int s = 0; s < 2; ++s) { union { bf16x8 v; unsigned w[4]; } fb, fk;
#pragma unroll
        for (int j = 0; j < 4; ++j) { fb.w[j] = cvt_pk_bf16(mb[8 * s + 2 * j], mb[8 * s + 2 * j + 1]); fk.w[j] = cvt_pk_bf16(mk[8 * s + 2 * j], mk[8 * s + 2 * j + 1]); }
#pragma unroll
        for (int vt = 0; vt < 2; ++vt) { union { bf16x8 v; unsigned w[4]; } fu;
#pragma unroll
            for (int j = 0; j < 4; ++j) fu.w[j] = cvt_pk_bf16(U[vt][8 * s + 2 * j], U[vt][8 * s + 2 * j + 1]);
            Y[vt] = __builtin_amdgcn_mfma_f32_32x32x16_bf16(fu.v, fb.v, Y[vt], 0, 0, 0);
            const bf16* vp = VTp + (size_t)vt * 32 * 32 + 16 * s;
            union { bf16x8 v; s16x4 h2[2]; } vf; vf.h2[0] = *(const s16x4*)vp; vf.h2[1] = *(const s16x4*)(vp + 8);
            Y[vt] = __builtin_amdgcn_mfma_f32_32x32x16_bf16(vf.v, fk.v, Y[vt], 0, 0, 0); } }
    float sm = 0.f;
#pragma unroll
    for (int vt = 0; vt < 2; ++vt)
#pragma unroll
        for (int i = 0; i < 16; ++i) sm += Y[vt][i];
    sm += __shfl_xor(sm, 32); const float mu = sm * (1.0f / 64.0f);
    float q = 0.f;
#pragma unroll
    for (int vt = 0; vt < 2; ++vt)
#pragma unroll
        for (int i = 0; i < 16; ++i) { const float dd = Y[vt][i] - mu; q += dd * dd; }
    q += __shfl_xor(q, 32); const float rstd = 1.0f / sqrtf(q * (1.0f / 64.0f) + RW_LN_EPS);
    const size_t tok = tok0 + r32;
    const float bon = ((const float*)(ws + WS_BONUS))[tok * 4 + h];
    const bf16* vrec = (const bf16*)(ws + WS_RVG) + un * 2048 + r32 * 64;
    const bf16* gp = (const bf16*)(ws + WS_GBUF) + tok * 256 + h * 64; bf16* od = (bf16*)(ws + WS_O) + tok * D + 512 + h * 64;
    const float* lnw = KIN(I_RWLNW) + l * 256 + h * 64; const float* lnb = KIN(I_RWLNB) + l * 256 + h * 64;
#pragma unroll
    for (int vt = 0; vt < 2; ++vt)
#pragma unroll
        for (int g = 0; g < 4; ++g) { const int v0 = 32 * vt + 8 * g + 4 * hh; const f32x4 w4 = *(const f32x4*)(lnw + v0), b4 = *(const f32x4*)(lnb + v0); const u32x2 vw = *(const u32x2*)(vrec + v0); const f32x4 vv = {bflo(vw.x), bfhi(vw.x), bflo(vw.y), bfhi(vw.y)}; const u32x2 gw = *(const u32x2*)(gp + v0);
            const float y0 = ((Y[vt][4 * g] - mu) * rstd * w4[0] + b4[0] + bon * vv[0]) * bflo(gw.x), y1 = ((Y[vt][4 * g + 1] - mu) * rstd * w4[1] + b4[1] + bon * vv[1]) * bfhi(gw.x);
            const float y2 = ((Y[vt][4 * g + 2] - mu) * rstd * w4[2] + b4[2] + bon * vv[2]) * bflo(gw.y), y3 = ((Y[vt][4 * g + 3] - mu) * rstd * w4[3] + b4[3] + bon * vv[3]) * bfhi(gw.y);
            *(u32x2*)(od + v0) = (u32x2){pk2(y0, y1), pk2(y2, y3)}; }
}

__device__ __forceinline__ void c1_phase(LAS unsigned char* lds, int l, int vcu, int G) {
    for (int u = vcu; u < NB * NCH; u += G) { const int b = u >> 8, c = u & 255;
        for (int q = 0; q <= PHREP(16); ++q) rw_fused_unit(lds, l, b, c);
        for (int q = 0; q <= PHREP(17); ++q) hg_fused_unit(lds, l, b, c);
        for (int q = 0; q <= PHREP(18); ++q) gla_fused_unit(lds, l, b, c); }
}
__device__ __forceinline__ void m3_gh_phase(int l, int vcu, int G) {
    const int tid = opaque_tid(), lane = tid & 63, wave = __builtin_amdgcn_readfirstlane(tid >> 6);
    unsigned char* ws = KWS();
    const int gw = vcu * NWAVES + wave, NGW = G * NWAVES;
    const bf16* P = (const bf16*)(ws + WS_P); bf16* O = (bf16*)(ws + WS_O);
    const float* gng = KIN(I_GLANG) + l * 256; const float* hng = KIN(I_HGNG) + l * 256;
    for (int task = gw; task < 24576; task += NGW) {
        const int un = task & 8191, bh = un >> 8, c = un & 255, b = bh >> 2, h = bh & 3; const size_t tok0 = (size_t)b * T + c * 32;
        if (task >= 16384) { rw_m3_task(lane, l, bh, c); continue; }
        if (task < 8192) m3_gh_task<64>(lane, (const bf16*)(ws + WS_HQ) + (size_t)un * 2048, (const bf16*)(ws + WS_HK) + (size_t)un * 2048, (const bf16*)(ws + WS_HVT) + (size_t)un * 2048, (const bf16*)(ws + WS_HS) + (size_t)un * 4096,
                                         P + tok0 * PINP + PC_HG + h * 64, hng + h * 64, O + tok0 * D + 256 + h * 64);
        else m3_gh_task<32>(lane, (const bf16*)(ws + WS_GQ) + (size_t)un * 1024, (const bf16*)(ws + WS_GK) + (size_t)un * 1024, (const bf16*)(ws + WS_GVT) + (size_t)un * 2048, (const bf16*)(ws + WS_GS) + (size_t)un * 2048,
                            P + tok0 * PINP + PC_GOUT + h * 64, gng + h * 64, O + tok0 * D + h * 64);
    }
}

__device__ __forceinline__ void xattn_units(LAS unsigned char* lds, int l, int first, int last, int stride) {
    const int tid = opaque_tid(), lane = tid & 63, wave = __builtin_amdgcn_readfirstlane(tid >> 6), r32 = lane & 31, hh = lane >> 5;
    const bf16* P = (const bf16*)(KWS() + WS_P); const bf16* MKV = (const bf16*)(KWS() + WS_MKV); bf16* O = (bf16*)(KWS() + WS_O);
    LAS bf16* KL = (LAS bf16*)lds;
    LAS bf16* VT = (LAS bf16*)(lds + 256 * 72 * 2);
    int cur_bh = -1;
    for (int u = first; u < last; u += stride) {
        const int bh = u >> 5, qb = u & 31, b = bh >> 2, h = bh & 3;
        if (bh != cur_bh) {
            __syncthreads();
            for (int i = tid; i < 256 * 8; i += NTHR) { const int key = i >> 3, c8 = i & 7;
                const bf16* src = MKV + (size_t)(b * 256 + key) * 2048 + l * 512 + h * 64 + c8 * 8;
                *(LAS u32x4*)(KL + key * 72 + c8 * 8) = *(const u32x4*)src;
                const u32x4 vv = *(const u32x4*)(src + 256);
                LAS bf16* vd = VT + (c8 * 8) * 264 + key;
                vd[0 * 264] = (bf16)(vv.x & 0xffff); vd[1 * 264] = (bf16)(vv.x >> 16); vd[2 * 264] = (bf16)(vv.y & 0xffff); vd[3 * 264] = (bf16)(vv.y >> 16);
                vd[4 * 264] = (bf16)(vv.z & 0xffff); vd[5 * 264] = (bf16)(vv.z >> 16); vd[6 * 264] = (bf16)(vv.w & 0xffff); vd[7 * 264] = (bf16)(vv.w >> 16); }
            __syncthreads();
            cur_bh = bh;
        }
        const int q = b * T + qb * 256 + wave * 32 + r32;
        bf16x8 qf[4];
#pragma unroll
        for (int s = 0; s < 4; ++s) qf[s] = *(const bf16x8*)(P + (size_t)q * PINP + PC_MQ + h * 64 + 16 * s + 8 * hh);
        f32x16 sc[8];
#pragma unroll
        for (int kt = 0; kt < 8; ++kt) {
#pragma unroll
            for (int i = 0; i < 16; ++i) sc[kt][i] = 0.f;
#pragma unroll
            for (int s = 0; s < 4; ++s) { const bf16x8 kf = *(const LAS bf16x8*)(KL + (kt * 32 + r32) * 72 + 16 * s + 8 * hh);
                sc[kt] = __builtin_amdgcn_mfma_f32_32x32x16_bf16(kf, qf[s], sc[kt], 0, 0, 0); }
        }
        float m = -3.0e38f;
#pragma unroll
        for (int kt = 0; kt < 8; ++kt)
#pragma unroll
            for (int i = 0; i < 16; ++i) m = fmaxf(m, sc[kt][i]);
        m = fmaxf(m, __shfl_xor(m, 32));
        float sum = 0.f;
        const float c2 = 0.125f * 1.4426950408889634f;
#pragma unroll
        for (int kt = 0; kt < 8; ++kt)
#pragma unroll
            for (int i = 0; i < 16; ++i) { const float e = __builtin_amdgcn_exp2f((sc[kt][i] - m) * c2); sc[kt][i] = e; sum += e; }
        sum += __shfl_xor(sum, 32);
        const float inv = 1.0f / sum;
        f32x16 oa[2];
#pragma unroll
        for (int vt = 0; vt < 2; ++vt)
#pragma unroll
            for (int i = 0; i < 16; ++i) oa[vt][i] = 0.f;
#pragma unroll
        for (int kt = 0; kt < 8; ++kt)
#pragma unroll
            for (int s = 0; s < 2; ++s) {
                union { bf16x8 v; unsigned w[4]; } pf;
#pragma unroll
                for (int j = 0; j < 4; ++j) pf.w[j] = cvt_pk_bf16(sc[kt][8 * s + 2 * j], sc[kt][8 * s + 2 * j + 1]);
#pragma unroll
                for (int vt = 0; vt < 2; ++vt) {
                    const LAS bf16* vp = VT + (vt * 32 + r32) * 264 + kt * 32 + 16 * s + 4 * hh;
                    union { bf16x8 v; s16x4 h2[2]; } vf; vf.h2[0] = *(const LAS s16x4*)vp; vf.h2[1] = *(const LAS s16x4*)(vp + 8);
                    oa[vt] = __builtin_amdgcn_mfma_f32_32x32x16_bf16(vf.v, pf.v, oa[vt], 0, 0, 0); }
            }
        bf16* orow = O + (size_t)q * D + 768 + h * 64;
#pragma unroll
        for (int vt = 0; vt < 2; ++vt)
#pragma unroll
            for (int g = 0; g < 4; ++g) { u32x2 w; w.x = cvt_pk_bf16(oa[vt][4 * g] * inv, oa[vt][4 * g + 1] * inv); w.y = cvt_pk_bf16(oa[vt][4 * g + 2] * inv, oa[vt][4 * g + 3] * inv);
                *(u32x2*)(orow + vt * 32 + 8 * g + 4 * hh) = w; }
    }
    __syncthreads();
}

__device__ __forceinline__ void m2_phase(LAS unsigned char* lds, int l, int bx, int G) {
    unsigned char* ws = KWS();
    const int tid = opaque_tid(), lane = tid & 63, wave = __builtin_amdgcn_readfirstlane(tid >> 6);
    const int nrw = (G >= 128) ? 64 : 0;
    if (nrw) { if (bx < nrw && wave == 0) rw_m2_wave(lane, bx >> 1, bx & 1); }
    else { for (int q = bx * NWAVES + wave; q < 64; q += G * NWAVES) rw_m2_wave(lane, q >> 1, q & 1); }
    if (!(nrw && bx < nrw && wave == 0)) {
        const int nth = nrw ? (nrw * 448 + (G - nrw) * NTHR) : G * NTHR;
        const int gt = nrw ? (bx < nrw ? bx * 448 + (tid - 64) : nrw * 448 + (bx - nrw) * NTHR + tid) : bx * NTHR + tid;
        for (int e = gt; e < 196608; e += nth) {
            if (e < 131072) m2_gh_elem<64>(e, (const float*)(ws + WS_HDS), (const float*)(ws + WS_HBE), (bf16*)(ws + WS_HS));
            else m2_gh_elem<32>(e - 131072, (const float*)(ws + WS_GDS), (const float*)(ws + WS_GBE), (bf16*)(ws + WS_GS)); }
    }
    if (nrw == 0 || bx >= nrw) {
        const int nb = G - nrw, r = bx - nrw;
        const int per = (1024 + nb - 1) / nb, lo = r * per, hi = (lo + per < 1024) ? lo + per : 1024;
        xattn_units(lds, l, lo, hi, 1);
    }
}

__device__ __forceinline__ void ln1_router_phase(LAS unsigned char* lds, int l, int bx, int G) {
    const int tid = opaque_tid(), lane = tid & 63, wave = __builtin_amdgcn_readfirstlane(tid >> 6);
    LAS float* X = (LAS float*)lds;
    LAS float* PART = (LAS float*)(lds + 16 * 1028 * 4);
    LAS int* HIST = (LAS int*)(lds + 16 * 1028 * 4 + 8 * 16 * 32 * 4);
    const float* xin = (l == 0) ? KIN(I_X) : (const float*)(KWS() + WS_XF);
    const bf16* HM = (const bf16*)(KWS() + WS_HMIX);
    float* X1F = (float*)(KWS() + WS_X1F); bf16* X1B = (bf16*)(KWS() + WS_X1B);
    const float* g1 = KIN(I_LN1G) + l * D; const float* b1 = KIN(I_LN1B) + l * D;
    const float* rw = KIN(I_RTW) + (size_t)l * D * NE; const float* rb = KIN(I_RTB) + l * NE;
    int* tok_e = (int*)(KWS() + WS_ROUTE); float* tok_g = (float*)(KWS() + WS_ROUTE + 1 * MiB);
    if (tid < 32) HIST[tid] = 0;
    float rwB[2][32];
    { const int q = lane >> 4, e = lane & 15;
#pragma unroll
      for (int s = 0; s < 32; ++s) { const float* p = rw + (size_t)(128 * wave + 32 * q + s) * NE + e; rwB[0][s] = p[0]; rwB[1][s] = p[16]; } }
    __syncthreads();
    for (int it = bx; it < NTOK / 16; it += G) {
#pragma unroll
        for (int tt = 0; tt < 2; ++tt) { const int ti = wave * 2 + tt; const size_t tok = (size_t)it * 16 + ti;
            const f32x4* xr = (const f32x4*)(xin + tok * D) + lane; const u32x2* hr = (const u32x2*)(HM + tok * D) + lane;
            f32x4 v[4]; float s = 0.f;
#pragma unroll
            for (int j = 0; j < 4; ++j) { const f32x4 xv = xr[64 * j]; const u32x2 hw = hr[64 * j];
                v[j][0] = DN_ALPHA * xv[0] + bflo(hw.x); v[j][1] = DN_ALPHA * xv[1] + bfhi(hw.x); v[j][2] = DN_ALPHA * xv[2] + bflo(hw.y); v[j][3] = DN_ALPHA * xv[3] + bfhi(hw.y);
                s += (v[j][0] + v[j][1]) + (v[j][2] + v[j][3]); }
            const float mean = wave_sum(s) * (1.0f / D); float s2 = 0.f;
#pragma unroll
            for (int j = 0; j < 4; ++j) { v[j] = v[j] - mean; s2 += (v[j][0] * v[j][0] + v[j][1] * v[j][1]) + (v[j][2] * v[j][2] + v[j][3] * v[j][3]); }
            const float rstd = 1.0f / sqrtf(wave_sum(s2) * (1.0f / D) + LN_EPS);
#pragma unroll
            for (int j = 0; j < 4; ++j) { const f32x4 gg = *((const f32x4*)g1 + lane + 64 * j), bb = *((const f32x4*)b1 + lane + 64 * j);
                const f32x4 y = v[j] * rstd * gg + bb;
                *((f32x4*)(X1F + tok * D) + lane + 64 * j) = y;
                *((u32x2*)(X1B + tok * D) + lane + 64 * j) = (u32x2){pk2(y[0], y[1]), pk2(y[2], y[3])};
                *(LAS f32x4*)(X + ti * 1028 + 4 * lane + 256 * j) = y; }
        }
        __syncthreads();
        {
            const int q = lane >> 4, r = lane & 15;
            f32x4 acc0 = (f32x4){0.f, 0.f, 0.f, 0.f}, acc1 = (f32x4){0.f, 0.f, 0.f, 0.f};
            const LAS float* xa = X + r * 1028 + 128 * wave + 32 * q;
#pragma unroll
            for (int s4 = 0; s4 < 8; ++s4) { const f32x4 av = *(const LAS f32x4*)(xa + 4 * s4);
#pragma unroll
                for (int j = 0; j < 4; ++j) { acc0 = __builtin_amdgcn_mfma_f32_16x16x4f32(av[j], rwB[0][4 * s4 + j], acc0, 0, 0, 0); acc1 = __builtin_amdgcn_mfma_f32_16x16x4f32(av[j], rwB[1][4 * s4 + j], acc1, 0, 0, 0); } }
#pragma unroll
            for (int i = 0; i < 4; ++i) { PART[(wave * 16 + 4 * q + i) * 32 + r] = acc0[i]; PART[(wave * 16 + 4 * q + i) * 32 + 16 + r] = acc1[i]; }
        }
        __syncthreads();
        {
            const int ti = tid >> 5, e = tid & 31;
            float lg = rb[e];
#pragma unroll
            for (int w = 0; w < 8; ++w) lg += PART[(w * 16 + ti) * 32 + e];
            float tv[4]; int te[4]; float cur = lg;
#pragma unroll
            for (int k = 0; k < 4; ++k) { float bv = cur; int bi = e;
#pragma unroll
                for (int o = 16; o >= 1; o >>= 1) { const float ov = __shfl_xor(bv, o); const int oi = __shfl_xor(bi, o); if (ov > bv || (ov == bv && oi < bi)) { bv = ov; bi = oi; } }
                tv[k] = bv; te[k] = bi; if (e == bi) cur = -3.0e38f; }
            const float e1 = __expf(tv[1] - tv[0]), e2 = __expf(tv[2] - tv[0]), e3 = __expf(tv[3] - tv[0]); const float inv = 1.0f / (1.0f + e1 + e2 + e3);
            const size_t tok = (size_t)it * 16 + ti;
            if (e < 4) { const int ek = e == 0 ? te[0] : e == 1 ? te[1] : e == 2 ? te[2] : te[3]; const float gk = (e == 0 ? 1.0f : e == 1 ? e1 : e == 2 ? e2 : e3) * inv;
                tok_e[tok * 4 + e] = ek; tok_g[tok * 4 + e] = gk; __hip_atomic_fetch_add(&HIST[ek], 1, __ATOMIC_RELAXED, __HIP_MEMORY_SCOPE_WORKGROUP); }
        }
        __syncthreads();
    }
    __syncthreads();
    if (tid < 32) ((int*)(KWS() + WS_CTL))[CW_HIST + bx * 32 + tid] = HIST[tid];
}

__device__ __forceinline__ void slots_phase(LAS unsigned char* lds, int bx, int G) {
    const int tid = opaque_tid();
    int* ctl = (int*)(KWS() + WS_CTL);
    LAS int* RED = (LAS int*)lds;
    LAS int* TOT = RED + 1024;
    const int* tok_e = (const int*)(KWS() + WS_ROUTE); const float* tok_g = (const float*)(KWS() + WS_ROUTE + 1 * MiB);
    int* tok_slot = (int*)(KWS() + WS_ROUTE + 2 * MiB); int* slot_tok = (int*)(KWS() + WS_ROUTE + 3 * MiB); float* slot_gate = (float*)(KWS() + WS_ROUTE + 3 * MiB + 1536 * 1024);
    { const int e = tid & 31, part = tid >> 5; int tot = 0, pre = 0;
      for (int b2 = part; b2 < G; b2 += 16) { const int h = ctl[CW_HIST + b2 * 32 + e]; tot += h; if (b2 < bx) pre += h; }
      RED[(part * 32 + e) * 2] = tot; RED[(part * 32 + e) * 2 + 1] = pre; }
    __syncthreads();
    if (tid < 32) { int tot = 0, pre = 0; for (int p = 0; p < 16; ++p) { tot += RED[(p * 32 + tid) * 2]; pre += RED[(p * 32 + tid) * 2 + 1]; } TOT[tid] = tot; TOT[32 + tid] = pre; TOT[96 + tid] = 0; }
    __syncthreads();
    if (tid == 0) { int ps = 0;
#pragma unroll 1
        for (int e = 0; e < 32; ++e) { TOT[64 + e] = ps; ps += (TOT[e] + 255) & ~255; }
        TOT[128] = ps >> 8; if (bx == 0) ctl[CW_NT] = ps >> 8; }
    __syncthreads();
    if (bx == 0) { const int nt = TOT[128];
        for (int t = tid; t < nt; t += NTHR) { int e = 0;
#pragma unroll 1
            for (int k = 1; k < 32; ++k) if (TOT[64 + k] <= t * 256) e = k;
            ctl[CW_TILEE + t] = e; } }
    for (int e = bx; e < 32; e += G) { const int s0 = TOT[64 + e] + TOT[e], s1 = TOT[64 + e] + ((TOT[e] + 255) & ~255); for (int s = s0 + tid; s < s1; s += NTHR) { slot_tok[s] = 0; slot_gate[s] = 0.f; } }
    for (int it = bx; it < NTOK / 16; it += G) {
        if (tid < 64) { const int asg = it * 64 + tid; const int e = tok_e[asg]; const int rank = __hip_atomic_fetch_add(&TOT[96 + e], 1, __ATOMIC_RELAXED, __HIP_MEMORY_SCOPE_WORKGROUP); const int slot = TOT[64 + e] + TOT[32 + e] + rank;
            tok_slot[asg] = slot; slot_tok[slot] = asg >> 2; slot_gate[slot] = tok_g[asg]; }
    }
}

__device__ __forceinline__ void combine_phase(int l, int vcu, int G) {
    const int tid = opaque_tid(), lane = tid & 63, wave = __builtin_amdgcn_readfirstlane(tid >> 6);
    const int gw = vcu * NWAVES + wave, NGW = G * NWAVES;
    const float* X1F = (const float*)(KWS() + WS_X1F); const bf16* YB = (const bf16*)(KWS() + WS_YB); const int* tok_slot = (const int*)(KWS() + WS_ROUTE + 2 * MiB);
    float* xo = (l == NL - 1) ? KOUT() : (float*)(KWS() + WS_XF); bf16* XB = (bf16*)(KWS() + WS_XB);
    const float* g2 = KIN(I_LN2G) + l * D; const float* b2 = KIN(I_LN2B) + l * D;
    for (int tok = gw; tok < NTOK; tok += NGW) {
        const int s0 = tok_slot[tok * 4], s1 = tok_slot[tok * 4 + 1], s2i = tok_slot[tok * 4 + 2], s3 = tok_slot[tok * 4 + 3];
        const f32x4* xr = (const f32x4*)(X1F + (size_t)tok * D) + lane;
        const u32x2* y0 = (const u32x2*)(YB + (size_t)s0 * D) + lane; const u32x2* y1 = (const u32x2*)(YB + (size_t)s1 * D) + lane;
        const u32x2* y2 = (const u32x2*)(YB + (size_t)s2i * D) + lane; const u32x2* y3 = (const u32x2*)(YB + (size_t)s3 * D) + lane;
        f32x4 v[4]; float s = 0.f;
#pragma unroll
        for (int j = 0; j < 4; ++j) { const f32x4 xv = xr[64 * j]; const u32x2 a0 = y0[64 * j], a1 = y1[64 * j], a2 = y2[64 * j], a3 = y3[64 * j];
            v[j][0] = DN_ALPHA * xv[0] + ((bflo(a0.x) + bflo(a1.x)) + (bflo(a2.x) + bflo(a3.x))); v[j][1] = DN_ALPHA * xv[1] + ((bfhi(a0.x) + bfhi(a1.x)) + (bfhi(a2.x) + bfhi(a3.x)));
            v[j][2] = DN_ALPHA * xv[2] + ((bflo(a0.y) + bflo(a1.y)) + (bflo(a2.y) + bflo(a3.y))); v[j][3] = DN_ALPHA * xv[3] + ((bfhi(a0.y) + bfhi(a1.y)) + (bfhi(a2.y) + bfhi(a3.y)));
            s += (v[j][0] + v[j][1]) + (v[j][2] + v[j][3]); }
        const float mean = wave_sum(s) * (1.0f / D); float q = 0.f;
#pragma unroll
        for (int j = 0; j < 4; ++j) { v[j] = v[j] - mean; q += (v[j][0] * v[j][0] + v[j][1] * v[j][1]) + (v[j][2] * v[j][2] + v[j][3] * v[j][3]); }
        const float rstd = 1.0f / sqrtf(wave_sum(q) * (1.0f / D) + LN_EPS);
#pragma unroll
        for (int j = 0; j < 4; ++j) { const f32x4 gg = *((const f32x4*)g2 + lane + 64 * j), bb = *((const f32x4*)b2 + lane + 64 * j);
            const f32x4 y = v[j] * rstd * gg + bb;
            *((f32x4*)(xo + (size_t)tok * D) + lane + 64 * j) = y;
            *((u32x2*)(XB + (size_t)tok * D) + lane + 64 * j) = (u32x2){pk2(y[0], y[1]), pk2(y[2], y[3])}; }
    }
}


constexpr int PH_PER_LAYER = 10, NPHASES = 2 + NL * PH_PER_LAYER;
__global__ void __launch_bounds__(NTHR, 2) trunk_fwd(Args args) {
    extern __shared__ __attribute__((aligned(16))) unsigned char lds_raw[];
    LAS unsigned char* lds = (LAS unsigned char*)lds_raw;
    volatile LAS unsigned* MISC = (volatile LAS unsigned*)(lds + MISC_OFF);
    const int tid = threadIdx.x;
    const int G = gridDim.x, bx = blockIdx.x;
    const int vcu = (G % 8 == 0) ? (bx % 8) * (G / 8) + bx / 8 : bx;
    unsigned char* ws = KWS();
    unsigned* ctl = (unsigned*)(ws + WS_CTL);
    for (int u = tid; u < (LDS_BYTES - LDSCTL_OFF) / 4; u += NTHR) ((LAS unsigned*)(lds + LDSCTL_OFF))[u] = 0u;
    __syncthreads();
    XcdBarrier bar; bar.bar = ctl + CW_BAR; bar.x = 0; bar.st = nullptr;
#if !MK_PER_PHASE
    bar = xcd_barrier_post(ctl + CW_BAR, MISC + 8);
#define GRID_BAR() xcd_barrier(bar)
#else
#define GRID_BAR() do { } while (0)
#endif
    const int lo = (int)(unsigned)ka_u64<280>(), hi = (int)(unsigned)(ka_u64<280>() >> 32);
#ifndef PH_MASK
#define PH_MASK 0x1FFF
#endif
#define PHEN(n) (((PH_MASK) >> (n)) & 1)
#define IN(k) (lo <= (k) && (k) < hi)
#define SEAM(k) do { if (rep > 0 || IN((k) + 1)) GRID_BAR(); } while (0)

#define OG opaque_s(G)
#define OBX opaque_s(bx)
#define OVCU opaque_s(vcu)
#define OL opaque_s(l)
    if (PHEN(0) && IN(0)) for (int rep = PHREP(0); rep >= 0; --rep) { prologue_phase(lds, OVCU, OG); SEAM(0); }
    if (PHEN(1) && IN(1)) for (int rep = PHREP(1); rep >= 0; --rep) {
        pg8::DenseOrder S; S.init(KWS() + WS_MEMB, KWS() + WS_WMEM, NB * NMEM, 2048, D, OG, OBX);
        pg8::EpiBf16 E{(bf16*)(KWS() + WS_MKV), 2048};
        pg8::gemm_phase<pg8::EpiBf16, pg8::DenseOrder>(lds, D, S, E);
        SEAM(1);
    }
    for (int l = 0; l < NL; ++l) {
        const int p0 = 2 + l * PH_PER_LAYER;
        if (PHEN(2) && IN(p0 + 0)) for (int rep = PHREP(2); rep >= 0; --rep) {
            pg8::DenseOrder S; S.init(KWS() + WS_XB, KWS() + WS_WIN + (size_t)OL * PINP * D * 2, NTOK, PINP, D, OG, OBX);
            pg8::EpiBf16 E{(bf16*)(KWS() + WS_P), PINP};
            pg8::gemm_phase<pg8::EpiBf16, pg8::DenseOrder>(lds, D, S, E);
            SEAM(p0 + 0);
        }
        if (PHEN(4) && IN(p0 + 1)) for (int rep = PHREP(4); rep >= 0; --rep) { c1_phase(lds, OL, OVCU, OG); SEAM(p0 + 1); }
        if (PHEN(5) && IN(p0 + 2)) for (int rep = PHREP(5); rep >= 0; --rep) { m2_phase(lds, OL, OBX, OG); SEAM(p0 + 2); }
        if (PHEN(6) && IN(p0 + 3)) for (int rep = PHREP(6); rep >= 0; --rep) { m3_gh_phase(OL, OVCU, OG); SEAM(p0 + 3); }
        if (PHEN(7) && IN(p0 + 4)) for (int rep = PHREP(7); rep >= 0; --rep) {
            pg8::DenseOrder S; S.init(KWS() + WS_O, KWS() + WS_WOUT + (size_t)OL * D * D * 2, NTOK, D, D, OG, OBX);
            pg8::EpiBf16 E{(bf16*)(KWS() + WS_HMIX), D};
            pg8::gemm_phase<pg8::EpiBf16, pg8::DenseOrder>(lds, D, S, E);
            SEAM(p0 + 4);
        }
        if (PHEN(8) && IN(p0 + 5)) for (int rep = PHREP(8); rep >= 0; --rep) { ln1_router_phase(lds, OL, OBX, OG); SEAM(p0 + 5); }
        if (PHEN(9) && IN(p0 + 6)) for (int rep = PHREP(9); rep >= 0; --rep) { slots_phase(lds, OBX, OG); SEAM(p0 + 6); }
        if (PHEN(10) && IN(p0 + 7)) for (int rep = PHREP(10); rep >= 0; --rep) {
            const int ntiles = __builtin_amdgcn_readfirstlane(((const int*)(KWS() + WS_CTL))[CW_NT]);
            pg8::MoeOrder<true> S; S.init(KWS() + WS_X1B, KWS() + WS_WGU + (size_t)OL * NE * 2048 * D * 2, (const int*)(KWS() + WS_CTL) + CW_TILEE, (const int*)(KWS() + WS_ROUTE + 3 * MiB), ntiles, 2048, D, OG, OBX);
            pg8::EpiSwiglu E{(bf16*)(KWS() + WS_HB), (const float*)(KWS() + WS_BGU) + (size_t)OL * NE * 2048};
            pg8::gemm_phase<pg8::EpiSwiglu, pg8::MoeOrder<true>>(lds, D, S, E);
            SEAM(p0 + 7);
        }
        if (PHEN(11) && IN(p0 + 8)) for (int rep = PHREP(11); rep >= 0; --rep) {
            const int ntiles = __builtin_amdgcn_readfirstlane(((const int*)(KWS() + WS_CTL))[CW_NT]);
            pg8::MoeOrder<false> S; S.init(KWS() + WS_HB, KWS() + WS_WD + (size_t)OL * NE * D * FF * 2, (const int*)(KWS() + WS_CTL) + CW_TILEE, (const int*)(KWS() + WS_ROUTE + 3 * MiB), ntiles, D, FF, OG, OBX);
            pg8::EpiDown E{(bf16*)(KWS() + WS_YB), KIN(I_BDN) + (size_t)OL * NE * D, (const float*)(KWS() + WS_ROUTE + 3 * MiB + 1536 * 1024)};
            pg8::gemm_phase<pg8::EpiDown, pg8::MoeOrder<false>>(lds, FF, S, E);
            SEAM(p0 + 8);
        }
        if (PHEN(12) && IN(p0 + 9)) for (int rep = PHREP(12); rep >= 0; --rep) { combine_phase(OL, OVCU, OG); if (rep > 0 || l + 1 < NL) SEAM(p0 + 9); }
    }
#undef IN
#undef SEAM
}

extern "C" void kernel_launch(void* const* d_in, const int* in_sizes, int n_in, void* d_out, int out_size, void* d_ws, size_t ws_size, hipStream_t stream) {
    static int grid = 0;
    if (grid == 0) {
        if (n_in != 33 || ws_size < WS_END) { fprintf(stderr, "kernel_launch: unexpected inputs (n_in %d, ws %zu need %zu)\n", n_in, ws_size, (size_t)WS_END); grid = -1; return; }
        int dev = 0, cus = 0;
        if (hipGetDevice(&dev) != hipSuccess || hipDeviceGetAttribute(&cus, hipDeviceAttributeMultiprocessorCount, dev) != hipSuccess) { grid = -1; return; }
        if (hipFuncSetAttribute((const void*)trunk_fwd, hipFuncAttributeMaxDynamicSharedMemorySize, LDS_BYTES) != hipSuccess) { grid = -1; return; }
        int per_cu = 0; (void)hipOccupancyMaxActiveBlocksPerMultiprocessor(&per_cu, (const void*)trunk_fwd, NTHR, LDS_BYTES); (void)hipGetLastError();
        grid = cus;
    }
    if (grid < 0) return;
    (void)hipMemsetAsync((char*)d_ws + WS_CTL, 0, CTL_ZERO_BYTES, stream);
    Args a{};
    for (int i = 0; i < 33; ++i) a.in[i] = (const float*)d_in[i];
    a.out = (float*)d_out; a.ws = (unsigned char*)d_ws;
#if MK_PER_PHASE
    for (int p = 0; p < NPHASES; ++p) { a.ph_lo = p; a.ph_hi = p + 1; hipLaunchKernelGGL(trunk_fwd, dim3(grid), dim3(NTHR), LDS_BYTES, stream, a); }
#else
    a.ph_lo = 0; a.ph_hi = NPHASES;
    hipLaunchKernelGGL(trunk_fwd, dim3(grid), dim3(NTHR), LDS_BYTES, stream, a);
#endif
}
```

```cpp
#include <hip/hip_runtime.h>
#include <cstdio>
#include <cstdint>

#ifndef MK_PER_PHASE
#define MK_PER_PHASE 0
#endif

#ifndef REP_MASK
#define REP_MASK 0
#endif
#define PHREP(n) (((REP_MASK) >> (n)) & 1)
#define LAS __attribute__((address_space(3)))
#define GAS __attribute__((address_space(1)))
typedef unsigned short bf16;
typedef short bf16x8 __attribute__((ext_vector_type(8)));
typedef short s16x4 __attribute__((ext_vector_type(4)));
typedef float f32x4 __attribute__((ext_vector_type(4)));
typedef float f32x2 __attribute__((ext_vector_type(2)));
typedef float f32x16 __attribute__((ext_vector_type(16)));
typedef unsigned u32x4 __attribute__((ext_vector_type(4)));
typedef unsigned u32x2 __attribute__((ext_vector_type(2)));

constexpr int NB = 8, T = 8192, D = 1024, NL = 4, NTOK = NB * T;
constexpr int PIN = 3088, PINP = 3328;
constexpr int NE = 32, FF = 1024, NMEM = 256;
constexpr int NASSIGN = NTOK * 4;
constexpr int MAXTILES = NASSIGN / 256 + NE;
constexpr int MAXSLOTS = MAXTILES * 256;
constexpr int PC_GQ = 0, PC_GK = 128, PC_GV = 256, PC_GOUT = 512, PC_HQ = 768, PC_HF = 1024, PC_HI = 1280, PC_HG = 1536;
constexpr int PC_RW = 1792, PC_MQ = 2816, PC_GLR = 3072;
constexpr float DN_ALPHA = 1.6817928305074292f;
constexpr float LN_EPS = 1e-5f, RMS_EPS = 1e-6f, RW_LN_EPS = 64e-5f;

constexpr size_t MiB = 1u << 20;
constexpr size_t WS_CTL = 0, CTL_ZERO_BYTES = 1 * MiB;
constexpr size_t WS_WIN = 1 * MiB;
constexpr size_t WS_WOUT = WS_WIN + 26 * MiB;
constexpr size_t WS_WMEM = WS_WOUT + 8 * MiB;
constexpr size_t WS_WGU = WS_WMEM + 4 * MiB;
constexpr size_t WS_WD = WS_WGU + 512 * MiB;
constexpr size_t WS_BGU = WS_WD + 256 * MiB;
constexpr size_t WS_LORA = WS_BGU + 1 * MiB;
constexpr size_t WS_MEMB = WS_LORA + 1 * MiB;
constexpr size_t WS_MKV = WS_MEMB + 4 * MiB;
constexpr size_t WS_XB = WS_MKV + 8 * MiB;
constexpr size_t WS_X1B = WS_XB + 128 * MiB;
constexpr size_t WS_XF = WS_X1B + 128 * MiB;
constexpr size_t WS_X1F = WS_XF + 256 * MiB;
constexpr size_t WS_O = WS_X1F + 256 * MiB;
constexpr size_t WS_HMIX = WS_O + 128 * MiB;
constexpr size_t WS_ROUTE = WS_HMIX + 128 * MiB;
constexpr size_t WS_GBUF = WS_ROUTE + 6 * MiB;
constexpr size_t WS_BONUS = WS_GBUF + 32 * MiB;
constexpr size_t WS_BIG = WS_BONUS + 1 * MiB;
constexpr size_t WS_P = WS_BIG;
constexpr size_t WS_ORAW = WS_P + 416 * MiB;
constexpr size_t WS_HB = WS_BIG;
constexpr size_t WS_YB = WS_HB + 528 * MiB;
constexpr size_t WS_CHK = WS_ORAW;
constexpr size_t WS_HQ = WS_CHK, WS_HK = WS_HQ + 32 * MiB, WS_HVT = WS_HK + 32 * MiB, WS_HDS = WS_HVT + 32 * MiB, WS_HS = WS_HDS + 128 * MiB, WS_HBE = WS_HS + 64 * MiB;
constexpr size_t WS_GQ = WS_HBE + 2 * MiB, WS_GK = WS_GQ + 16 * MiB, WS_GVT = WS_GK + 16 * MiB, WS_GDS = WS_GVT + 32 * MiB, WS_GS = WS_GDS + 64 * MiB, WS_GBE = WS_GS + 32 * MiB;
constexpr size_t WS_RR = WS_GBE + 1 * MiB, WS_RB = WS_RR + 32 * MiB, WS_RK = WS_RB + 32 * MiB, WS_RW = WS_RK + 32 * MiB, WS_RVT = WS_RW + 32 * MiB;
constexpr size_t WS_RVG = WS_RVT + 32 * MiB;
constexpr size_t WS_RU = WS_RVG + 32 * MiB, WS_RP = WS_RU + 64 * MiB, WS_RQ = WS_RP + 64 * MiB, WS_RS = WS_RQ + 128 * MiB;
constexpr size_t WS_END = WS_RS + 64 * MiB;
static_assert(WS_YB + 528 * MiB <= WS_END, "overlay");
static_assert(WS_END <= (size_t)4096 * MiB, "workspace");
constexpr int CW_TMO = 0;
constexpr int CW_BAR = 4096;
constexpr int CW_HIST = 16384;
constexpr int CW_NT = 32768;
constexpr int CW_TILEE = 32768 + 64;
constexpr int CW_PADSTART = 40960;

constexpr int RING_BYTES = 131072;
constexpr int LDSCTL_OFF = 162816, MISC_OFF = LDSCTL_OFF + 320;
constexpr int LDS_BYTES = 163840;
constexpr int NWAVES = 8, NTHR = 512;

#define RLX_AGENT __ATOMIC_RELAXED, __HIP_MEMORY_SCOPE_AGENT
#define LDS_WAIT() asm volatile("s_waitcnt lgkmcnt(0)" ::: "memory")
#define VM_WAIT() asm volatile("s_waitcnt vmcnt(0)" ::: "memory")

__device__ __forceinline__ unsigned f2bf(float f) { unsigned u = __builtin_bit_cast(unsigned, f); return (u + 0x7fffu + ((u >> 16) & 1u)) >> 16; }
__device__ __forceinline__ unsigned pk2(float lo, float hi) { return f2bf(lo) | (f2bf(hi) << 16); }
__device__ __forceinline__ float bf2f(unsigned short b) { return __builtin_bit_cast(float, (unsigned)b << 16); }
__device__ __forceinline__ float bflo(unsigned w) { return __builtin_bit_cast(float, w << 16); }
__device__ __forceinline__ float bfhi(unsigned w) { return __builtin_bit_cast(float, w & 0xffff0000u); }
typedef __bf16 bf16x2_t __attribute__((ext_vector_type(2)));
__device__ __forceinline__ unsigned cvt_pk_bf16(float lo, float hi) { const f32x2 v = {lo, hi}; const bf16x2_t b = __builtin_convertvector(v, bf16x2_t); return __builtin_bit_cast(unsigned, b); }
__device__ __forceinline__ float fast_exp(float x) { return __builtin_amdgcn_exp2f(x * 1.4426950408889634f); }
__device__ __forceinline__ float fast_sigmoid(float x) { return __builtin_amdgcn_rcpf(1.0f + fast_exp(-x)); }
__device__ __forceinline__ float silu_f(float x) { return x * fast_sigmoid(x); }
__device__ __forceinline__ int opaque_tid() { int t = threadIdx.x; asm volatile("" : "+v"(t)); return t; }
__device__ __forceinline__ int opaque_s(int v) { asm volatile("" : "+s"(v)); return v; }
__device__ __forceinline__ float wave_sum(float v) {
#pragma unroll
    for (int o = 1; o < 64; o <<= 1) v += __shfl_xor(v, o);
    return v;
}

namespace pg8 {
constexpr int BM = 256, BK = 64, HALF = 128, HTB = HALF * BK * 2, STAGE_BYTES = 8 * HTB, NXCD = 8, WGM = 8;
__host__ __device__ __forceinline__ int lds_byte(int r, int c) { const int st = (r >> 4) * 2 + (c >> 5), rr = r & 15, cc = c & 31, ob = rr * 64 + cc * 2; return st * 1024 + (ob ^ (((ob >> 9) & 1) << 5)); }
__host__ __device__ __forceinline__ void stage_rc(int b, int& R, int& C) { const int st = b / 1024, sb = b % 1024, swz = sb ^ (((sb >> 9) & 1) << 5); R = (st >> 1) * 16 + swz / 64; C = (st & 1) * 32 + (swz % 64) / 2; }
__host__ __device__ __forceinline__ int perm32(int rho) { const int n = rho >> 4, i = rho & 15; return 8 * (i >> 2) + 4 * n + (i & 3); }

struct Unit { int pm, pn, e; const char* A; const char* B; };

__device__ __forceinline__ bool static_tile(int i, int G, int c, int nM, int nN, int& pm, int& pn) {
    const int nwg = nM * nN; const long L = (long)i * G + c; if (L >= nwg) return false;
    int wgid = (int)L; { const int q = nwg / NXCD, r = nwg % NXCD, xcd = wgid % NXCD, off = wgid / NXCD; wgid = (xcd < r ? xcd * (q + 1) : r * (q + 1) + (xcd - r) * q) + off; }
    const int nig = WGM * nN, gid = wgid / nig, fm = gid * WGM, gsz = (nM - fm) < WGM ? (nM - fm) : WGM;
    pm = fm + ((wgid % nig) % gsz); pn = (wgid % nig) / gsz; return true;
}
struct DenseOrder {
    static constexpr bool GATHER = false;
    const char* A; const char* B; int nM, nN, G, c; size_t tstep;
    __device__ __forceinline__ void init(const void* A_, const void* B_, int M, int N, int K, int G_, int c_) { A = (const char*)A_; B = (const char*)B_; nM = M / BM; nN = N / BM; G = G_; c = c_; tstep = (size_t)BM * K * 2; }
    __device__ __forceinline__ bool next(int i, Unit& u) const { if (!static_tile(i, G, c, nM, nN, u.pm, u.pn)) return false; u.e = 0; u.A = A + (size_t)u.pm * tstep; u.B = B + (size_t)u.pn * tstep; return true; }
    __device__ __forceinline__ unsigned row_tok(const Unit&, int) const { return 0; }
};
template <bool GATHER_> struct MoeOrder {
    static constexpr bool GATHER = GATHER_;
    const char* A; const char* B; const int* tile_e; const int* slot_tok; int nM, nN, G, c; size_t tstep, estep;
    __device__ __forceinline__ void init(const void* A_, const void* B_, const int* tile_e_, const int* slot_tok_, int ntiles, int Nper, int K, int G_, int c_) {
        A = (const char*)A_; B = (const char*)B_; tile_e = tile_e_; slot_tok = slot_tok_; nM = ntiles; nN = Nper / BM; G = G_; c = c_; tstep = (size_t)BM * K * 2; estep = (size_t)Nper * K * 2; }
    __device__ __forceinline__ bool next(int i, Unit& u) const { if (!static_tile(i, G, c, nM, nN, u.pm, u.pn)) return false;
        u.e = __builtin_amdgcn_readfirstlane(tile_e[u.pm]); u.A = GATHER_ ? A : A + (size_t)u.pm * tstep; u.B = B + (size_t)u.e * estep + (size_t)u.pn * tstep; return true; }
    __device__ __forceinline__ unsigned row_tok(const Unit& u, int r) const { return (unsigned)slot_tok[u.pm * BM + r]; }
};

struct EpiBf16 {
    static constexpr bool PERM = true;
    bf16* O; int ldc;
    __device__ __forceinline__ void operator()(const f32x4 (&acc)[2][2][4][2], const Unit& u, int wr, int wc, int fr, int fq) const {
        const int row0 = u.pm * BM + wr * 64 + fr, col0 = u.pn * BM + wc * 32 + 8 * fq;
#pragma unroll
        for (int ai = 0; ai < 2; ++ai)
#pragma unroll
            for (int m = 0; m < 4; ++m) { bf16* rowp = O + (size_t)(row0 + ai * HALF + m * 16) * ldc + col0;
#pragma unroll
                for (int bj = 0; bj < 2; ++bj) { const f32x4 v0 = acc[ai][bj][m][0], v1 = acc[ai][bj][m][1];
                    u32x4 w; w.x = cvt_pk_bf16(v0[0], v0[1]); w.y = cvt_pk_bf16(v0[2], v0[3]); w.z = cvt_pk_bf16(v1[0], v1[1]); w.w = cvt_pk_bf16(v1[2], v1[3]);
                    *(u32x4*)(rowp + bj * HALF) = w; } }
    }
};
struct EpiSwiglu {
    static constexpr bool PERM = false;
    bf16* H; const float* bias;
    __device__ __forceinline__ void operator()(const f32x4 (&acc)[2][2][4][2], const Unit& u, int wr, int wc, int fr, int fq) const {
        const int row0 = u.pm * BM + wr * 64 + fr, colh = u.pn * 128 + wc * 32 + 8 * fq;
        const float* bp = bias + (size_t)u.e * 2048 + u.pn * 256 + wc * 32 + 4 * fq;
        f32x4 bv[2][2];
#pragma unroll
        for (int bj = 0; bj < 2; ++bj)
#pragma unroll
            for (int n = 0; n < 2; ++n) bv[bj][n] = *(const f32x4*)(bp + bj * HALF + n * 16);
#pragma unroll
        for (int ai = 0; ai < 2; ++ai)
#pragma unroll
            for (int m = 0; m < 4; ++m) { bf16* rowp = H + (size_t)(row0 + ai * HALF + m * 16) * FF + colh;
                float o[8];
#pragma unroll
                for (int n = 0; n < 2; ++n) { const f32x4 g4 = acc[ai][0][m][n] + bv[0][n], u4 = acc[ai][1][m][n] + bv[1][n];
#pragma unroll
                    for (int j = 0; j < 4; ++j) { const float g = fminf(g4[j], 7.0f), up = fminf(fmaxf(u4[j], -7.0f), 7.0f);
                        const float glu = g * __builtin_amdgcn_rcpf(1.0f + __builtin_amdgcn_exp2f(g * (-1.702f * 1.4426950408889634f)));
                        o[n * 4 + j] = (up + 1.0f) * glu; } }
                u32x4 w; w.x = cvt_pk_bf16(o[0], o[1]); w.y = cvt_pk_bf16(o[2], o[3]); w.z = cvt_pk_bf16(o[4], o[5]); w.w = cvt_pk_bf16(o[6], o[7]);
                *(u32x4*)rowp = w; }
    }
};
struct EpiDown {
    static constexpr bool PERM = true;
    bf16* Y; const float* bias; const float* slot_gate;
    __device__ __forceinline__ void operator()(const f32x4 (&acc)[2][2][4][2], const Unit& u, int wr, int wc, int fr, int fq) const {
        const int row0 = u.pm * BM + wr * 64 + fr, col0 = u.pn * BM + wc * 32 + 8 * fq;
        const float* bp = bias + (size_t)u.e * 1024 + col0;
        f32x4 bv[2][2];
#pragma unroll
        for (int bj = 0; bj < 2; ++bj)
#pragma unroll
            for (int n = 0; n < 2; ++n) bv[bj][n] = *(const f32x4*)(bp + bj * HALF + 4 * n);
#pragma unroll
        for (int ai = 0; ai < 2; ++ai)
#pragma unroll
            for (int m = 0; m < 4; ++m) { const int row = row0 + ai * HALF + m * 16; const float g = slot_gate[row]; bf16* rowp = Y + (size_t)row * D + col0;
#pragma unroll
                for (int bj = 0; bj < 2; ++bj) { const f32x4 v0 = (acc[ai][bj][m][0] + bv[bj][0]) * g, v1 = (acc[ai][bj][m][1] + bv[bj][1]) * g;
                    u32x4 w; w.x = cvt_pk_bf16(v0[0], v0[1]); w.y = cvt_pk_bf16(v0[2], v0[3]); w.z = cvt_pk_bf16(v1[0], v1[1]); w.w = cvt_pk_bf16(v1[2], v1[3]);
                    *(u32x4*)(rowp + bj * HALF) = w; } }
    }
};

template <class Epi, class Sched, bool ALIGN_EPI = true>
__device__ __forceinline__ void gemm_phase(LAS unsigned char* lds, const int K, const Sched& S, const Epi& E) {
    constexpr bool GA = Sched::GATHER;
    const int tid = opaque_tid(), wid = __builtin_amdgcn_readfirstlane(tid >> 6), lane = tid & 63, wr = wid >> 2, wc = wid & 3, fr = lane & 15, fq = lane >> 4;
    const int nt = K / BK;
    unsigned voffA[2], voffB[2]; int Rr[2]; unsigned Cb[2];
#pragma unroll
    for (int i = 0; i < 2; ++i) { int R, C; stage_rc(tid * 16 + i * 8192, R, C); const int Rb = Epi::PERM ? ((R & ~31) + perm32(R & 31)) : R;
        voffA[i] = (unsigned)(R * K + C) * 2u; voffB[i] = (unsigned)(Rb * K + C) * 2u; Rr[i] = R; Cb[i] = (unsigned)C * 2u; }
    const size_t kstep = (size_t)(BK * 2);
    const size_t hstep = (size_t)HALF * K * 2;
    const unsigned ldsw = (unsigned)wid * 1024u;
    const int aoff = lds_byte(wr * 64 + fr, fq * 8), boff = lds_byte(wc * 32 + fr, fq * 8);
    unsigned cOff[2][2], nOff[2][2], sOff[2][2];
#define PG8_SA(b, h) (((b) * 2 + (h)) * HTB)
#define PG8_SB(b, h) ((4 + (b) * 2 + (h)) * HTB)
#define PG8_STAGE(bufoff, gbase, voff) do { _Pragma("unroll") for (int _i = 0; _i < 2; ++_i) \
        __builtin_amdgcn_global_load_lds((const unsigned*)((const char*)(gbase) + (voff)[_i]), (LAS unsigned*)(lds + (bufoff) + ldsw + _i * 8192), 16, 0, 0); } while (0)
#define PG8_STAGE_A(bufoff, gbase, half, OFF) do { if constexpr (GA) { PG8_STAGE(bufoff, gbase, (OFF)[half]); } else { PG8_STAGE(bufoff, (gbase) + (half) * hstep, voffA); } } while (0)
#define PG8_LDA(dst, b, h) do { _Pragma("unroll") for (int m = 0; m < 4; ++m) _Pragma("unroll") for (int k = 0; k < 2; ++k) dst[m][k] = *(const LAS bf16x8*)(lds + PG8_SA(b, h) + aoff + m * 2048 + k * 1024); } while (0)
#define PG8_LDB(dst, b, h) do { _Pragma("unroll") for (int n = 0; n < 2; ++n) _Pragma("unroll") for (int k = 0; k < 2; ++k) dst[n][k] = *(const LAS bf16x8*)(lds + PG8_SB(b, h) + boff + n * 2048 + k * 1024); } while (0)
#define PG8_MMA(ai, bj, At, Bt) do { __builtin_amdgcn_s_setprio(1); _Pragma("unroll") for (int m = 0; m < 4; ++m) _Pragma("unroll") for (int n = 0; n < 2; ++n) _Pragma("unroll") for (int k = 0; k < 2; ++k) \
        acc[ai][bj][m][n] = __builtin_amdgcn_mfma_f32_16x16x32_bf16(Bt[n][k], At[m][k], acc[ai][bj][m][n], 0, 0, 0); __builtin_amdgcn_s_setprio(0); } while (0)
#define PG8_WAIT_V(n) asm volatile("s_waitcnt vmcnt(" #n ")" ::: "memory")
#define PG8_WAIT_L(n) asm volatile("s_waitcnt lgkmcnt(" #n ")" ::: "memory")
#define PG8_BAR __builtin_amdgcn_s_barrier()
#define PG8_SCHED __builtin_amdgcn_sched_barrier(0)
#define PG8_GOFF(dst, u) do { if constexpr (GA) { _Pragma("unroll") for (int _h = 0; _h < 2; ++_h) _Pragma("unroll") for (int _i = 0; _i < 2; ++_i) \
        dst[_h][_i] = S.row_tok(u, _h * HALF + Rr[_i]) * (unsigned)(K * 2) + Cb[_i]; } } while (0)
    Unit cur, nxt; int ui = 0;
    if (!S.next(0, cur)) return;
    f32x4 acc[2][2][4][2];
#pragma unroll
    for (int a = 0; a < 2; ++a)
#pragma unroll
        for (int b = 0; b < 2; ++b)
#pragma unroll
            for (int m = 0; m < 4; ++m)
#pragma unroll
                for (int n = 0; n < 2; ++n) acc[a][b][m][n] = (f32x4){0.f, 0.f, 0.f, 0.f};
    bf16x8 At[4][2], B0[2][2], B1[2][2];
    const char* cA = cur.A; const char* cB = cur.B;
    PG8_GOFF(cOff, cur);
#pragma unroll
    for (int h = 0; h < 2; ++h)
#pragma unroll
        for (int i = 0; i < 2; ++i) { nOff[h][i] = 0u; sOff[h][i] = 0u; }
    if constexpr (GA) { VM_WAIT(); }
    PG8_STAGE(PG8_SB(0, 0), cB, voffB); PG8_STAGE(PG8_SB(0, 1), cB + hstep, voffB); PG8_STAGE_A(PG8_SA(0, 0), cA, 0, cOff); PG8_STAGE_A(PG8_SA(0, 1), cA, 1, cOff);
    if (wr == 1) PG8_BAR;
    PG8_WAIT_V(2); PG8_BAR;
    PG8_STAGE(PG8_SB(1, 0), cB + kstep, voffB); PG8_STAGE_A(PG8_SA(1, 0), cA + kstep, 0, cOff); PG8_STAGE(PG8_SB(1, 1), cB + hstep + kstep, voffB);
    PG8_WAIT_V(6); PG8_BAR;
    for (;;) {
        const bool has_next = S.next(ui + 1, nxt);
        const char* nA = has_next ? nxt.A : cA; const char* nB = has_next ? nxt.B : cB;
        if constexpr (GA) { if (has_next) { PG8_GOFF(nOff, nxt); } else {
#pragma unroll
            for (int h = 0; h < 2; ++h)
#pragma unroll
                for (int i = 0; i < 2; ++i) nOff[h][i] = cOff[h][i]; } }
        for (int t = 0; t < nt; t += 2) {
            const bool last = (t == nt - 2);
            const char* a1 = cA + (size_t)(t + 1) * kstep;
            const char* a2 = last ? nA : cA + (size_t)(t + 2) * kstep; const char* b2 = last ? nB : cB + (size_t)(t + 2) * kstep;
            const char* a3 = a2 + kstep; const char* b3 = b2 + kstep;
            if constexpr (GA) {
#pragma unroll
                for (int h = 0; h < 2; ++h)
#pragma unroll
                    for (int i = 0; i < 2; ++i) sOff[h][i] = last ? nOff[h][i] : cOff[h][i]; }
            PG8_LDB(B0, 0, 0); PG8_LDB(B1, 0, 1); PG8_SCHED; PG8_LDA(At, 0, 0); PG8_STAGE_A(PG8_SA(1, 1), a1, 1, cOff);
            PG8_WAIT_V(8); PG8_WAIT_L(0); PG8_BAR; PG8_MMA(0, 0, At, B0); PG8_MMA(0, 1, At, B1); PG8_BAR; PG8_SCHED;
            PG8_LDA(At, 0, 1); PG8_STAGE(PG8_SB(0, 0), b2, voffB); PG8_STAGE(PG8_SB(0, 1), b2 + hstep, voffB); PG8_STAGE_A(PG8_SA(0, 0), a2, 0, sOff);
            PG8_WAIT_V(8); PG8_WAIT_L(0); PG8_BAR; PG8_MMA(1, 0, At, B0); PG8_MMA(1, 1, At, B1); PG8_BAR; PG8_SCHED;
            PG8_LDB(B0, 1, 0); PG8_LDB(B1, 1, 1); PG8_SCHED; PG8_LDA(At, 1, 0); PG8_STAGE_A(PG8_SA(0, 1), a2, 1, sOff);
            PG8_WAIT_V(8); PG8_WAIT_L(0); PG8_BAR; PG8_MMA(0, 0, At, B0); PG8_MMA(0, 1, At, B1); PG8_BAR; PG8_SCHED;
            PG8_LDA(At, 1, 1); PG8_STAGE(PG8_SB(1, 0), b3, voffB); PG8_STAGE(PG8_SB(1, 1), b3 + hstep, voffB); PG8_STAGE_A(PG8_SA(1, 0), a3, 0, sOff);
            PG8_WAIT_V(8); PG8_WAIT_L(0); PG8_BAR; PG8_MMA(1, 0, At, B0); PG8_MMA(1, 1, At, B1); PG8_BAR; PG8_SCHED;
        }
        if constexpr (ALIGN_EPI) { if (wr == 0) PG8_BAR; }
        E(acc, cur, wr, wc, fr, fq);
        if (!has_next) break;
#pragma unroll
        for (int a = 0; a < 2; ++a)
#pragma unroll
            for (int b = 0; b < 2; ++b)
#pragma unroll
                for (int m = 0; m < 4; ++m)
#pragma unroll
                    for (int n = 0; n < 2; ++n) acc[a][b][m][n] = (f32x4){0.f, 0.f, 0.f, 0.f};
        cur = nxt; cA = nA; cB = nB; ++ui;
        if constexpr (GA) {
#pragma unroll
            for (int h = 0; h < 2; ++h)
#pragma unroll
                for (int i = 0; i < 2; ++i) cOff[h][i] = nOff[h][i]; }
        if constexpr (ALIGN_EPI) { if (wr == 1) PG8_BAR; }
    }
    PG8_WAIT_V(0);
    if constexpr (!ALIGN_EPI) { if (wr == 0) PG8_BAR; }
    PG8_BAR;
#undef PG8_SA
#undef PG8_SB
#undef PG8_STAGE
#undef PG8_STAGE_A
#undef PG8_LDA
#undef PG8_LDB
#undef PG8_MMA
#undef PG8_WAIT_V
#undef PG8_WAIT_L
#undef PG8_BAR
#undef PG8_SCHED
#undef PG8_GOFF
}
}

#define XB_TMO      128
#define XB_XCNT(j)  (256  + 64 * (j))
#define XB_XSUB(j)  (1280 + 64 * (j))
#define XB_XGEN(j)  (2304 + 64 * (j))
#define XB_TOP      3328
#define XB_TOPGEN   3392
#define XCD_BAR_WORDS 3456
#define XB_SPIN_CAP (1u << 18)
__device__ __forceinline__ unsigned xb_ld(unsigned* p)              { return __hip_atomic_load(p, __ATOMIC_RELAXED, __HIP_MEMORY_SCOPE_AGENT); }
__device__ __forceinline__ unsigned xb_add(unsigned* p, unsigned v) { return __hip_atomic_fetch_add(p, v, __ATOMIC_RELAXED, __HIP_MEMORY_SCOPE_AGENT); }
__device__ __forceinline__ unsigned xb_xcc_id() { return (unsigned)__builtin_amdgcn_s_getreg((3 << 11) | 20) & 0xFu; }
#define XB_SPIN(cond, bar) do { unsigned _sp = 0; while (cond) { __builtin_amdgcn_s_sleep(1); \
    if ((++_sp & 255u) == 0u) { if (xb_ld(&(bar)[XB_TMO])) break; if (_sp > XB_SPIN_CAP) { atomicAdd(&(bar)[XB_TMO], 1u); break; } } } } while (0)
struct XcdBarrier { unsigned* bar; unsigned x; volatile LAS unsigned* st; };
__device__ __forceinline__ XcdBarrier xcd_barrier_post(unsigned* bar, volatile LAS unsigned* st) {
    XcdBarrier b; b.bar = bar; b.x = xb_xcc_id(); b.st = st;
    if (threadIdx.x == 0) (void)xb_add(&bar[XB_XCNT(b.x)], 1u);
    return b;
}
__device__ __forceinline__ void xcd_barrier_complete(unsigned* bar, unsigned x, unsigned& nloc, unsigned& nx) {
    const unsigned G = gridDim.x * gridDim.y * gridDim.z;
    unsigned sum, cnt, mine, sp = 0u;
    for (;;) {
        sum = 0u; cnt = 0u; mine = 0u;
#pragma unroll
        for (unsigned j = 0; j < 16; ++j) { const unsigned c = xb_ld(&bar[XB_XCNT(j)]); sum += c; cnt += (c > 0u) ? 1u : 0u; mine = (j == x) ? c : mine; }
        if (sum == G) break;
        __builtin_amdgcn_s_sleep(1);
        if ((++sp & 255u) == 0u) { if (xb_ld(&bar[XB_TMO])) break; if (sp > XB_SPIN_CAP) { atomicAdd(&bar[XB_TMO], 1u); break; } }
    }
    nloc = mine > 0u ? mine : 1u; nx = cnt > 0u ? cnt : 1u;
}
__device__ __forceinline__ void xcd_barrier(const XcdBarrier& b) {
    asm volatile("s_waitcnt vmcnt(0)" ::: "memory");
    __syncthreads();
    if (threadIdx.x == 0) {
        unsigned* bar = b.bar;
        __builtin_amdgcn_s_waitcnt(0);
        unsigned nloc = b.st[0], nx = b.st[1];
        if (nloc == 0u) { xcd_barrier_complete(bar, b.x, nloc, nx); b.st[0] = nloc; b.st[1] = nx; }
        const unsigned old = xb_add(&bar[XB_XSUB(b.x)], 1u);
        const unsigned gen = old / nloc;
        if (old + 1u == (gen + 1u) * nloc) {
            __builtin_amdgcn_fence(__ATOMIC_RELEASE, "agent");
            asm volatile("s_waitcnt vmcnt(0)" ::: "memory");
            const unsigned og = xb_add(&bar[XB_TOP], 1u);
            const unsigned tg = og / nx;
            if (og + 1u == (tg + 1u) * nx) xb_add(&bar[XB_TOPGEN], 1u);
            else XB_SPIN(xb_ld(&bar[XB_TOPGEN]) == tg, bar);
            __builtin_amdgcn_fence(__ATOMIC_ACQUIRE, "agent");
            xb_add(&bar[XB_XGEN(b.x)], 1u);
            asm volatile("s_waitcnt vmcnt(0)" ::: "memory");
        } else {
            XB_SPIN(xb_ld(&bar[XB_XGEN(b.x)]) == gen, bar);
            __builtin_amdgcn_fence(__ATOMIC_ACQUIRE, "agent");
            asm volatile("s_waitcnt vmcnt(0)" ::: "memory");
        }
    }
    __syncthreads();
}

struct Args {
    const float* in[33];
    float* out; unsigned char* ws;
    int ph_lo, ph_hi;
};
enum { I_X = 0, I_MEM, I_WIN, I_GLACONV, I_GLAW2, I_GLAB, I_GLANG, I_HGLB, I_HGNG, I_RWMU, I_RWW0, I_RWW2, I_RWA0, I_RWA2, I_RWG2, I_RWKK, I_RWKA, I_RWRK, I_RWLNW, I_RWLNB,
       I_WMK, I_WMV, I_WOUT, I_LN1G, I_LN1B, I_RTW, I_RTB, I_WGU, I_BGU, I_WDN, I_BDN, I_LN2G, I_LN2B };


template <int OFF> __device__ __forceinline__ unsigned long long ka_u64() { unsigned long long v; asm volatile("s_load_dwordx2 %0, %1, %2\n\ts_waitcnt lgkmcnt(0)" : "=s"(v) : "s"(__builtin_amdgcn_kernarg_segment_ptr()), "n"(OFF)); return v; }
#define KIN(i) ((const float*)(const GAS float*)ka_u64<8 * (i)>())
#define KOUT() ((float*)(GAS float*)ka_u64<264>())
#define KWS() ((unsigned char*)(GAS unsigned char*)ka_u64<272>())

template <class Map>
__device__ __forceinline__ void tr_item(const float* __restrict__ W, int K, int N, bf16* __restrict__ WT, LAS float* scr, int kb, int nb, int lane, Map map) {
    const int k0 = 64 * kb, n0 = 64 * nb, col = n0 + lane; const bool valid = col < N;
    const float* src = W + (size_t)k0 * N + (valid ? col : 0);
#pragma unroll 16
    for (int kk = 0; kk < 64; ++kk) { const float v = valid ? src[(size_t)kk * N] : 0.f; scr[kk * 65 + lane] = v; }
    LDS_WAIT(); asm volatile("" ::: "memory");
    const int c = lane & 7;
#pragma unroll
    for (int j = 0; j < 8; ++j) { const int n = (lane >> 3) + 8 * j;
        if (n0 + n < N) { const int orow = map(n0 + n); const LAS float* s = scr + (8 * c) * 65 + n;
            u32x4 o; o.x = pk2(s[0 * 65], s[1 * 65]); o.y = pk2(s[2 * 65], s[3 * 65]); o.z = pk2(s[4 * 65], s[5 * 65]); o.w = pk2(s[6 * 65], s[7 * 65]);
            *(u32x4*)(WT + (size_t)orow * K + k0 + 8 * c) = o; } }
    LDS_WAIT(); asm volatile("" ::: "memory");
}
struct MapIdent { int off; __device__ __forceinline__ int operator()(int c) const { return c + off; } };
struct MapWin { __device__ __forceinline__ int operator()(int c) const { return c < 512 ? c : (c < 528 ? c + 2560 : c - 16); } };
__device__ __forceinline__ int gu_row(int c) { const int f = c >> 1, bj = c & 1, pn = f >> 7, fl = f & 127, wc = fl >> 5, fq = (fl >> 3) & 3, n = (fl >> 2) & 1, j = fl & 3; return 256 * pn + 128 * bj + 32 * wc + 16 * n + 4 * fq + j; }
struct MapGu { __device__ __forceinline__ int operator()(int c) const { return gu_row(c); } };

__device__ __forceinline__ void prologue_phase(LAS unsigned char* lds, int vcu, int G) {
    const int tid = opaque_tid(), lane = tid & 63, wave = __builtin_amdgcn_readfirstlane(tid >> 6);
    LAS float* scr = (LAS float*)(lds + wave * 16640); static_assert(8 * 16640 <= LDSCTL_OFF, "prologue scratch below the LDS control words");
    const int gw = vcu * NWAVES + wave, NGW = G * NWAVES;
    unsigned char* ws = KWS();
    constexpr int IT_GU = NL * NE * 512, IT_DN = NL * NE * 256, IT_IN = NL * 16 * 49, IT_OUT = NL * 256, IT_MEM = NL * 2 * 64, IT_L64 = NL * 2 * 4, IT_L128 = NL * 2 * 4;
    constexpr int IT_TOTAL = IT_GU + IT_DN + IT_IN + IT_OUT + IT_MEM + IT_L64 + IT_L128;
    for (int it = gw; it < IT_TOTAL; it += NGW) {
        int r = it;
        if (r < IT_GU) { const int le = r >> 9, q = r & 511, kb = q >> 5, nb = q & 31;
            tr_item(KIN(I_WGU) + (size_t)le * 1024 * 2048, 1024, 2048, (bf16*)(ws + WS_WGU) + (size_t)le * 2048 * 1024, scr, kb, nb, lane, MapGu{}); continue; } r -= IT_GU;
        if (r < IT_DN) { const int le = r >> 8, q = r & 255, kb = q >> 4, nb = q & 15;
            tr_item(KIN(I_WDN) + (size_t)le * 1024 * 1024, 1024, 1024, (bf16*)(ws + WS_WD) + (size_t)le * 1024 * 1024, scr, kb, nb, lane, MapIdent{0}); continue; } r -= IT_DN;
        if (r < IT_IN) { const int l = r / (16 * 49), q = r % (16 * 49), kb = q / 49, nb = q % 49;
            tr_item(KIN(I_WIN) + (size_t)l * 1024 * PIN, 1024, PIN, (bf16*)(ws + WS_WIN) + (size_t)l * PINP * 1024, scr, kb, nb, lane, MapWin{}); continue; } r -= IT_IN;
        if (r < IT_OUT) { const int l = r >> 8, q = r & 255, kb = q >> 4, nb = q & 15;
            tr_item(KIN(I_WOUT) + (size_t)l * 1024 * 1024, 1024, 1024, (bf16*)(ws + WS_WOUT) + (size_t)l * 1024 * 1024, scr, kb, nb, lane, MapIdent{0}); continue; } r -= IT_OUT;
        if (r < IT_MEM) { const int l = r >> 7, q = r & 127, kv = q >> 6, kb = (q >> 2) & 15, nb = q & 3;
            tr_item((kv ? KIN(I_WMV) : KIN(I_WMK)) + (size_t)l * 1024 * 256, 1024, 256, (bf16*)(ws + WS_WMEM), scr, kb, nb, lane, MapIdent{l * 512 + kv * 256}); continue; } r -= IT_MEM;
        if (r < IT_L64) { const int l = r >> 3, q = r & 7, wa = q >> 2, nb = q & 3;
            tr_item((wa ? KIN(I_RWA2) : KIN(I_RWW2)) + (size_t)l * 64 * 256, 64, 256, (bf16*)(ws + WS_LORA) + (size_t)wa * (NL * 256 * 64) + (size_t)l * 256 * 64, scr, 0, nb, lane, MapIdent{0}); continue; } r -= IT_L64;
        { const int l = r >> 3, q = r & 7, kb = q >> 2, nb = q & 3;
            tr_item(KIN(I_RWG2) + (size_t)l * 128 * 256, 128, 256, (bf16*)(ws + WS_LORA) + (size_t)2 * (NL * 256 * 64) + (size_t)l * 256 * 128, scr, kb, nb, lane, MapIdent{0}); }
    }
    { const size_t gt = (size_t)vcu * NTHR + tid, GT = (size_t)G * NTHR; constexpr size_t per = (size_t)(PINP - PIN) * 1024 / 8;
        for (size_t i = gt; i < per * NL; i += GT) { const size_t l = i / per, j = i % per; *(u32x4*)((bf16*)(ws + WS_WIN) + l * PINP * 1024 + (size_t)PIN * 1024 + j * 8) = (u32x4){0u, 0u, 0u, 0u}; }
        for (size_t i = gt; i < (size_t)NL * NE * 2048; i += GT) { const size_t le = i >> 11; const int c = (int)(i & 2047); ((float*)(ws + WS_BGU))[le * 2048 + gu_row(c)] = KIN(I_BGU)[i]; }
        const f32x4* xs = (const f32x4*)KIN(I_X); u32x4* xd = (u32x4*)(ws + WS_XB);
        for (size_t i = gt; i < (size_t)NTOK * D / 8; i += GT) { const f32x4 v0 = xs[2 * i], v1 = xs[2 * i + 1]; xd[i] = (u32x4){pk2(v0[0], v0[1]), pk2(v0[2], v0[3]), pk2(v1[0], v1[1]), pk2(v1[2], v1[3])}; }
        const f32x4* ms = (const f32x4*)KIN(I_MEM); u32x4* md = (u32x4*)(ws + WS_MEMB);
        for (size_t i = gt; i < (size_t)NB * NMEM * D / 8; i += GT) { const f32x4 v0 = ms[2 * i], v1 = ms[2 * i + 1]; md[i] = (u32x4){pk2(v0[0], v0[1]), pk2(v0[2], v0[3]), pk2(v1[0], v1[1]), pk2(v1[2], v1[3])}; }
    }
}


__device__ __forceinline__ float log1pexp_neg_abs(float z) { return __builtin_amdgcn_logf(1.0f + fast_exp(-fabsf(z))) * 0.6931471805599453f; }
__device__ __forceinline__ float tanh_f(float x) { const float e = fast_exp(-2.0f * fabsf(x)); const float t = (1.0f - e) * __builtin_amdgcn_rcpf(1.0f + e); return x < 0.f ? -t : t; }

constexpr int NCH = T / 32;
__device__ __forceinline__ int rho16(int r, int hh) { return (r & 3) + 8 * (r >> 2) + 4 * hh; }
__device__ __forceinline__ void hg_fused_unit(LAS unsigned char* lds, int l, int b, int c) {
    const int tid = opaque_tid(), lane = tid & 63, wave = __builtin_amdgcn_readfirstlane(tid >> 6), r32 = lane & 31, hh = lane >> 5;
    unsigned char* ws = KWS();
    const bf16* P = (const bf16*)(ws + WS_P) + ((size_t)b * T + c * 32) * PINP;
    constexpr int HB = 8448;
    if (tid < 256) {
        const int ch = tid, h = ch >> 6, d = ch & 63; const size_t un = (size_t)(b * 4 + h) * NCH + c;
        float lb;
        { const float* hp = KIN(I_HGLB) + ch; const float v0 = hp[0], v1 = hp[256], v2 = hp[512], v3 = hp[768]; const float m = fmaxf(fmaxf(v0, v1), fmaxf(v2, v3));
          const float e0 = __expf(v0 - m), e1 = __expf(v1 - m), e2 = __expf(v2 - m), e3 = __expf(v3 - m); const float inv = 1.0f / (e0 + e1 + e2 + e3);
          lb = (l >= 1 ? e1 : 0.f) + (l >= 2 ? e2 : 0.f) + (l >= 3 ? e3 : 0.f); lb *= inv; }
        const float oml = 1.0f - lb;
        LAS bf16* KT = (LAS bf16*)(lds + h * HB); LAS float* BE = (LAS float*)(lds + h * HB + 8192);
        bf16* Qg = (bf16*)(ws + WS_HQ) + un * 2048 + d; bf16* Kg = (bf16*)(ws + WS_HK) + un * 2048 + d;
        float bc = 0.f;
        unsigned short hqr[32], hfr[32];
#pragma unroll
        for (int t = 0; t < 32; ++t) { const bf16* row = P + (size_t)t * PINP; hqr[t] = row[PC_HQ + ch]; hfr[t] = row[PC_HF + ch]; }
#pragma unroll
        for (int t8 = 0; t8 < 4; ++t8) { u32x4 kp;
#pragma unroll
            for (int jj = 0; jj < 4; ++jj) { float k2[2];
#pragma unroll
                for (int e = 0; e < 2; ++e) { const int t = t8 * 8 + jj * 2 + e; const float hf = bf2f(hfr[t]); const float s = fast_sigmoid(hf), sn = fast_sigmoid(-hf);
                    bc = fmaxf(bc + __builtin_amdgcn_logf(fmaxf(lb + oml * s, 1e-30f)) * 0.6931471805599453f, -80.0f);
                    const float qt = silu_f(bf2f(hqr[t])) * fast_exp(bc), kt = oml * sn * fast_exp(-bc);
                    Qg[t * 64] = (bf16)f2bf(qt); Kg[t * 64] = (bf16)f2bf(kt); k2[e] = kt; }
                kp[jj] = pk2(k2[0], k2[1]); }
            *(LAS u32x4*)(KT + d * 32 + t8 * 8) = kp; }
        const float ebend = fast_exp(bc); BE[d] = ebend; ((float*)(ws + WS_HBE))[un * 64 + d] = ebend;
    } else {
        const int cv = tid - 256, h = cv >> 6, vi = cv & 63; const size_t un = (size_t)(b * 4 + h) * NCH + c;
        LAS bf16* VT = (LAS bf16*)(lds + h * HB + 4096); bf16* VTg = (bf16*)(ws + WS_HVT) + un * 2048 + vi * 32;
        unsigned short hvr[32];
#pragma unroll
        for (int t = 0; t < 32; ++t) hvr[t] = P[(size_t)t * PINP + PC_HI + cv];
#pragma unroll
        for (int t8 = 0; t8 < 4; ++t8) { u32x4 vp;
#pragma unroll
            for (int jj = 0; jj < 4; ++jj) vp[jj] = (unsigned)hvr[t8 * 8 + 2 * jj] | ((unsigned)hvr[t8 * 8 + 2 * jj + 1] << 16);
            *(LAS u32x4*)(VT + vi * 32 + t8 * 8) = vp; *(u32x4*)(VTg + t8 * 8) = vp; }
    }
    __syncthreads();
    { const int h = wave >> 1, vt = wave & 1; const size_t un = (size_t)(b * 4 + h) * NCH + c;
      const LAS bf16* KT = (const LAS bf16*)(lds + h * HB); const LAS bf16* VT = (const LAS bf16*)(lds + h * HB + 4096); const LAS float* BE = (const LAS float*)(lds + h * HB + 8192);
      float* DSg = (float*)(ws + WS_HDS) + un * 4096;
#pragma unroll
      for (int dt = 0; dt < 2; ++dt) { f32x16 acc;
#pragma unroll
          for (int i = 0; i < 16; ++i) acc[i] = 0.f;
#pragma unroll
          for (int s = 0; s < 2; ++s) { const bf16x8 A = *(const LAS bf16x8*)(VT + (32 * vt + r32) * 32 + 16 * s + 8 * hh), B = *(const LAS bf16x8*)(KT + (32 * dt + r32) * 32 + 16 * s + 8 * hh);
              acc = __builtin_amdgcn_mfma_f32_32x32x16_bf16(A, B, acc, 0, 0, 0); }
          const float ebd = BE[32 * dt + r32];
#pragma unroll
          for (int r = 0; r < 16; ++r) DSg[(32 * vt + rho16(r, hh)) * 64 + 32 * dt + r32] = acc[r] * ebd; } }
    __syncthreads();
}
__device__ __forceinline__ void gla_fused_unit(LAS unsigned char* lds, int l, int b, int c) {
    const int tid = opaque_tid(), lane = tid & 63, wave = __builtin_amdgcn_readfirstlane(tid >> 6), r32 = lane & 31, hh = lane >> 5;
    unsigned char* ws = KWS();
    const int t0 = c * 32;
    const bf16* P = (const bf16*)(ws + WS_P) + ((size_t)b * T + t0) * PINP;
    LAS float* GL = (LAS float*)lds;
    constexpr int HB = 6272, H0 = 2048;
    GL[tid] = bf2f(P[(size_t)(tid >> 4) * PINP + PC_GLR + (tid & 15)]);
    __syncthreads();
    if (tid < 128) {
        const int ch = tid, h = ch >> 5, d = ch & 31; const size_t un = (size_t)(b * 4 + h) * NCH + c;
        const float* cw = KIN(I_GLACONV) + (size_t)l * 4 * 512 + ch;
        const float q0 = cw[0], q1 = cw[512], q2 = cw[1024], q3 = cw[1536], k0 = cw[128], k1 = cw[640], k2w = cw[1152], k3 = cw[1664];
        const float* w2p = KIN(I_GLAW2) + (size_t)l * 16 * 128 + ch; float wc[16];
#pragma unroll
        for (int r = 0; r < 16; ++r) wc[r] = w2p[r * 128];
        const float gb = KIN(I_GLAB)[l * 128 + ch];
        float uq0 = 0.f, uq1 = 0.f, uq2 = 0.f, uk0 = 0.f, uk1 = 0.f, uk2 = 0.f;
        if (t0 > 0) { uq0 = bf2f(*(P - 3 * PINP + PC_GQ + ch)); uq1 = bf2f(*(P - 2 * PINP + PC_GQ + ch)); uq2 = bf2f(*(P - PINP + PC_GQ + ch));
                      uk0 = bf2f(*(P - 3 * PINP + PC_GK + ch)); uk1 = bf2f(*(P - 2 * PINP + PC_GK + ch)); uk2 = bf2f(*(P - PINP + PC_GK + ch)); }
        LAS bf16* KT = (LAS bf16*)(lds + H0 + h * HB); LAS float* BE = (LAS float*)(lds + H0 + h * HB + 6144);
        bf16* Qg = (bf16*)(ws + WS_GQ) + un * 1024 + d; bf16* Kg = (bf16*)(ws + WS_GK) + un * 1024 + d;
        float bc = 0.f;
        unsigned short xqr[32], xkr[32];
#pragma unroll
        for (int t = 0; t < 32; ++t) { const bf16* row = P + (size_t)t * PINP; xqr[t] = row[PC_GQ + ch]; xkr[t] = row[PC_GK + ch]; }
#pragma unroll
        for (int t8 = 0; t8 < 4; ++t8) { u32x4 kp;
#pragma unroll
            for (int jj = 0; jj < 4; ++jj) { float kk2[2];
#pragma unroll
                for (int e = 0; e < 2; ++e) { const int t = t8 * 8 + jj * 2 + e; const float uq3 = bf2f(xqr[t]), uk3 = bf2f(xkr[t]);
                    const float q = silu_f(q0 * uq0 + q1 * uq1 + q2 * uq2 + q3 * uq3) * 0.17677669529663687f, k = silu_f(k0 * uk0 + k1 * uk1 + k2w * uk2 + k3 * uk3);
                    uq0 = uq1; uq1 = uq2; uq2 = uq3; uk0 = uk1; uk1 = uk2; uk2 = uk3;
                    float z = gb;
#pragma unroll
                    for (int r = 0; r < 16; ++r) z += GL[t * 16 + r] * wc[r];
                    bc = fmaxf(bc + (fminf(z, 0.f) - log1pexp_neg_abs(z)) * 0.0625f, -80.0f);
                    const float qt = q * fast_exp(bc), kt = k * fast_exp(-bc);
                    Qg[t * 32] = (bf16)f2bf(qt); Kg[t * 32] = (bf16)f2bf(kt); kk2[e] = kt; }
                kp[jj] = pk2(kk2[0], kk2[1]); }
            *(LAS u32x4*)(KT + d * 32 + t8 * 8) = kp; }
        const float ebend = fast_exp(bc); BE[d] = ebend; ((float*)(ws + WS_GBE))[un * 32 + d] = ebend;
    } else if (tid < 384) {
        const int cv = tid - 128, h = cv >> 6, vi = cv & 63; const size_t un = (size_t)(b * 4 + h) * NCH + c;
        const float* cw = KIN(I_GLACONV) + (size_t)l * 4 * 512 + 256 + cv;
        const float w0 = cw[0], w1 = cw[512], w2 = cw[1024], w3 = cw[1536];
        float u0 = 0.f, u1 = 0.f, u2 = 0.f;
        if (t0 > 0) { u0 = bf2f(*(P - 3 * PINP + PC_GV + cv)); u1 = bf2f(*(P - 2 * PINP + PC_GV + cv)); u2 = bf2f(*(P - PINP + PC_GV + cv)); }
        LAS bf16* VT = (LAS bf16*)(lds + H0 + h * HB + 2048); bf16* VTg = (bf16*)(ws + WS_GVT) + un * 2048 + vi * 32;
        unsigned short xvr[32];
#pragma unroll
        for (int t = 0; t < 32; ++t) xvr[t] = P[(size_t)t * PINP + PC_GV + cv];
#pragma unroll
        for (int t8 = 0; t8 < 4; ++t8) { u32x4 vp; float yv[8];
#pragma unroll
            for (int e = 0; e < 8; ++e) { const float u3 = bf2f(xvr[t8 * 8 + e]); yv[e] = silu_f(w0 * u0 + w1 * u1 + w2 * u2 + w3 * u3); u0 = u1; u1 = u2; u2 = u3; }
#pragma unroll
            for (int jj = 0; jj < 4; ++jj) vp[jj] = pk2(yv[2 * jj], yv[2 * jj + 1]);
            *(LAS u32x4*)(VT + vi * 32 + t8 * 8) = vp; *(u32x4*)(VTg + t8 * 8) = vp; }
    }
    __syncthreads();
    { const int h = wave >> 1, vt = wave & 1; const size_t un = (size_t)(b * 4 + h) * NCH + c;
      const LAS bf16* KT = (const LAS bf16*)(lds + H0 + h * HB); const LAS bf16* VT = (const LAS bf16*)(lds + H0 + h * HB + 2048); const LAS float* BE = (const LAS float*)(lds + H0 + h * HB + 6144);
      float* DSg = (float*)(ws + WS_GDS) + un * 2048;
      f32x16 acc;
#pragma unroll
      for (int i = 0; i < 16; ++i) acc[i] = 0.f;
#pragma unroll
      for (int s = 0; s < 2; ++s) { const bf16x8 A = *(const LAS bf16x8*)(VT + (32 * vt + r32) * 32 + 16 * s + 8 * hh), B = *(const LAS bf16x8*)(KT + r32 * 32 + 16 * s + 8 * hh);
          acc = __builtin_amdgcn_mfma_f32_32x32x16_bf16(A, B, acc, 0, 0, 0); }
      const float ebd = BE[r32];
#pragma unroll
      for (int r = 0; r < 16; ++r) DSg[(32 * vt + rho16(r, hh)) * 32 + r32] = acc[r] * ebd; }
    __syncthreads();
}
template <int DK>
__device__ __forceinline__ void m2_gh_elem(int e, const float* __restrict__ DS, const float* __restrict__ BE, bf16* __restrict__ SG) {
    constexpr int EPB = 64 * DK; const int bh = e / EPB, idx = e % EPB, d = idx % DK; const size_t un0 = (size_t)bh * NCH;
    float S = 0.f;
#pragma unroll 1
    for (int c0 = 0; c0 < NCH; c0 += 8) { float ds[8], be[8];
#pragma unroll
        for (int u = 0; u < 8; ++u) { ds[u] = DS[(un0 + c0 + u) * EPB + idx]; be[u] = BE[(un0 + c0 + u) * DK + d]; }
#pragma unroll
        for (int u = 0; u < 8; ++u) { SG[(un0 + c0 + u) * EPB + idx] = (bf16)f2bf(S); S = S * be[u] + ds[u]; } }
}
template <int DK>
__device__ __forceinline__ void m3_gh_task(int lane, const bf16* __restrict__ Qg, const bf16* __restrict__ Kg, const bf16* __restrict__ VTg, const bf16* __restrict__ Sg,
                                           const bf16* __restrict__ gate  , const float* __restrict__ ng  , bf16* __restrict__ orow  ) {
    const int r32 = lane & 31, hh = lane >> 5;
    bf16x8 qf[DK / 16];
    f32x16 at;
#pragma unroll
    for (int i = 0; i < 16; ++i) at[i] = 0.f;
#pragma unroll
    for (int s = 0; s < DK / 16; ++s) { qf[s] = *(const bf16x8*)(Qg + r32 * DK + 16 * s + 8 * hh); const bf16x8 kf = *(const bf16x8*)(Kg + r32 * DK + 16 * s + 8 * hh);
        at = __builtin_amdgcn_mfma_f32_32x32x16_bf16(kf, qf[s], at, 0, 0, 0); }
#pragma unroll
    for (int r = 0; r < 16; ++r) if (rho16(r, hh) > r32) at[r] = 0.f;
    f32x16 o[2];
#pragma unroll
    for (int vt = 0; vt < 2; ++vt)
#pragma unroll
        for (int i = 0; i < 16; ++i) o[vt][i] = 0.f;
#pragma unroll
    for (int s = 0; s < 2; ++s) { union { bf16x8 v; unsigned w[4]; } pf;
#pragma unroll
        for (int j = 0; j < 4; ++j) pf.w[j] = cvt_pk_bf16(at[8 * s + 2 * j], at[8 * s + 2 * j + 1]);
#pragma unroll
        for (int vt = 0; vt < 2; ++vt) { const bf16* vp = VTg + (32 * vt + r32) * 32 + 16 * s + 4 * hh;
            union { bf16x8 v; s16x4 h2[2]; } vf; vf.h2[0] = *(const s16x4*)vp; vf.h2[1] = *(const s16x4*)(vp + 8);
            o[vt] = __builtin_amdgcn_mfma_f32_32x32x16_bf16(vf.v, pf.v, o[vt], 0, 0, 0); } }
#pragma unroll
    for (int vt = 0; vt < 2; ++vt)
#pragma unroll
        for (int s = 0; s < DK / 16; ++s) { const bf16x8 sf = *(const bf16x8*)(Sg + (32 * vt + r32) * DK + 16 * s + 8 * hh);
            o[vt] = __builtin_amdgcn_mfma_f32_32x32x16_bf16(sf, qf[s], o[vt], 0, 0, 0); }
    float ss = 0.f;
#pragma unroll
    for (int vt = 0; vt < 2; ++vt)
#pragma unroll
        for (int i = 0; i < 16; ++i) ss += o[vt][i] * o[vt][i];
    ss += __shfl_xor(ss, 32);
    const float rstd = 1.0f / sqrtf(ss * (1.0f / 64.0f) + RMS_EPS);
    const bf16* grow = gate + (size_t)r32 * PINP; bf16* od = orow + (size_t)r32 * D;
#pragma unroll
    for (int vt = 0; vt < 2; ++vt)
#pragma unroll
        for (int g = 0; g < 4; ++g) { const int v0 = 32 * vt + 8 * g + 4 * hh; const u32x2 gw = *(const u32x2*)(grow + v0); const f32x4 n4 = *(const f32x4*)(ng + v0);
            const float y0 = o[vt][4 * g] * rstd * n4[0] * silu_f(bflo(gw.x)), y1 = o[vt][4 * g + 1] * rstd * n4[1] * silu_f(bfhi(gw.x));
            const float y2 = o[vt][4 * g + 2] * rstd * n4[2] * silu_f(bflo(gw.y)), y3 = o[vt][4 * g + 3] * rstd * n4[3] * silu_f(bfhi(gw.y));
            *(u32x2*)(od + v0) = (u32x2){pk2(y0, y1), pk2(y2, y3)}; }
}

constexpr int RWC_HEADB = 28928;
constexpr int RWC_AL = 4 * RWC_HEADB, RWC_LWL = RWC_AL + 32 * 264 * 2;
static_assert(RWC_LWL + 32 * 264 * 2 <= LDSCTL_OFF, "rw_fused_unit LDS");
__device__ __forceinline__ void rw_fused_unit(LAS unsigned char* lds, int l, int b, int c) {
    const int tid = opaque_tid(), lane = tid & 63, wave = __builtin_amdgcn_readfirstlane(tid >> 6), h = wave >> 1, p = wave & 1, r32 = lane & 31, hh = lane >> 5;
    unsigned char* ws = KWS();
    const int bh = b * 4 + h; const size_t un = (size_t)bh * NCH + c;
    const int t0 = c * 32;
    const bf16* P = (const bf16*)(ws + WS_P) + ((size_t)b * T + t0) * PINP + PC_RW;
    const float* mu = KIN(I_RWMU) + (size_t)l * 1024;
    LAS bf16* XL = (LAS bf16*)lds;
    LAS bf16* AL = (LAS bf16*)(lds + RWC_AL);
    LAS bf16* LWL = (LAS bf16*)(lds + RWC_LWL);
    for (int i = tid; i < 32 * 256; i += NTHR) { const int tok = i >> 8, cc = i & 255;
        const bf16* row = P + (size_t)tok * PINP + 768 + cc;
        const float cur = bf2f(row[0]), prev = (t0 + tok > 0) ? bf2f(*(row - PINP)) : 0.f;
        float x = cur + (prev - cur) * mu[768 + cc];
        if (cc < 64) x = tanh_f(x); else if (cc >= 128) x = fast_sigmoid(x);
        XL[tok * 264 + cc] = (bf16)f2bf(x); }
    __syncthreads();
    {
        const int ch = wave * 32 + r32;
        const bf16* w2T = (const bf16*)(ws + WS_LORA) + (size_t)l * 256 * 64 + (size_t)ch * 64;
        const bf16* a2T = (const bf16*)(ws + WS_LORA) + (size_t)(NL * 256 * 64) + (size_t)l * 256 * 64 + (size_t)ch * 64;
        const bf16* g2T = (const bf16*)(ws + WS_LORA) + (size_t)2 * (NL * 256 * 64) + (size_t)l * 256 * 128 + (size_t)ch * 128;
        const LAS bf16* xa = XL + r32 * 264 + 8 * hh;
        {
            f32x16 acc;
#pragma unroll
            for (int i = 0; i < 16; ++i) acc[i] = 0.f;
#pragma unroll
            for (int s = 0; s < 4; ++s) { const bf16x8 A = *(const LAS bf16x8*)(xa + 16 * s); const bf16x8 Bw = *(const bf16x8*)(w2T + 16 * s + 8 * hh);
                acc = __builtin_amdgcn_mfma_f32_32x32x16_bf16(A, Bw, acc, 0, 0, 0); }
            const float w0c = KIN(I_RWW0)[l * 256 + ch];
#pragma unroll
            for (int r = 0; r < 16; ++r) { const int tok = rho16(r, hh);
                const float zw = w0c + acc[r]; const float wlog = -(fmaxf(-zw, 0.f) + log1pexp_neg_abs(zw)) - 0.5f;
                LWL[tok * 264 + ch] = (bf16)f2bf(-fast_exp(wlog)); }
        }
        __builtin_amdgcn_sched_barrier(0);
        {
            f32x16 acc;
#pragma unroll
            for (int i = 0; i < 16; ++i) acc[i] = 0.f;
#pragma unroll
            for (int s = 0; s < 4; ++s) { const bf16x8 A = *(const LAS bf16x8*)(xa + 64 + 16 * s); const bf16x8 Bw = *(const bf16x8*)(a2T + 16 * s + 8 * hh);
                acc = __builtin_amdgcn_mfma_f32_32x32x16_bf16(A, Bw, acc, 0, 0, 0); }
            const float a0c = KIN(I_RWA0)[l * 256 + ch];
#pragma unroll
            for (int r = 0; r < 16; ++r) AL[rho16(r, hh) * 264 + ch] = (bf16)f2bf(fast_sigmoid(a0c + acc[r]));
        }
        __builtin_amdgcn_sched_barrier(0);
        {
            f32x16 acc;
#pragma unroll
            for (int i = 0; i < 16; ++i) acc[i] = 0.f;
#pragma unroll
            for (int s = 0; s < 8; ++s) { const bf16x8 A = *(const LAS bf16x8*)(xa + 128 + 16 * s); const bf16x8 Bw = *(const bf16x8*)(g2T + 16 * s + 8 * hh);
                acc = __builtin_amdgcn_mfma_f32_32x32x16_bf16(A, Bw, acc, 0, 0, 0); }
            bf16* gb = (bf16*)(ws + WS_GBUF) + ((size_t)b * T + t0) * 256 + ch;
#pragma unroll
            for (int r = 0; r < 16; ++r) gb[(size_t)rho16(r, hh) * 256] = (bf16)f2bf(acc[r]);
        }
    }
    __syncthreads();
    LAS unsigned char* L = lds + h * RWC_HEADB;
    LAS bf16* AT = (LAS bf16*)L;
    LAS bf16* BT = (LAS bf16*)(L + 4096);
    LAS bf16* KT = (LAS bf16*)(L + 8192);
    LAS bf16* ATT = (LAS bf16*)(L + 12288);
    LAS bf16* BHT = (LAS bf16*)(L + 16384);
    LAS bf16* KHT = (LAS bf16*)(L + 20480);
    LAS bf16* VT = (LAS bf16*)(L + 24576);
    LAS float* GC = (LAS float*)(L + 28672);
    LAS float* MAB = (LAS float*)(L + 4096);
    LAS bf16* MAK = (LAS bf16*)(L + 8192);
    LAS bf16* TM = (LAS bf16*)L;
    if (wave < 4) {
        const int hs = wave, d = lane, ch = hs * 64 + d; const size_t uns = (size_t)(b * 4 + hs) * NCH + c;
        LAS unsigned char* Ls = lds + hs * RWC_HEADB;
        LAS bf16* sAT = (LAS bf16*)Ls; LAS bf16* sBT = (LAS bf16*)(Ls + 4096); LAS bf16* sKT = (LAS bf16*)(Ls + 8192);
        LAS bf16* sATT = (LAS bf16*)(Ls + 12288); LAS bf16* sBHT = (LAS bf16*)(Ls + 16384); LAS bf16* sKHT = (LAS bf16*)(Ls + 20480); LAS float* sGC = (LAS float*)(Ls + 28672);
        const float mr = mu[ch], mk = mu[256 + ch];
        const float kkc = KIN(I_RWKK)[l * 256 + ch], kac = KIN(I_RWKA)[l * 256 + ch], rkc = KIN(I_RWRK)[l * 256 + ch];
        float lgend = 0.f;
#pragma unroll 8
        for (int t = 0; t < 32; ++t) lgend += bf2f(LWL[t * 264 + ch]);
        bf16* RGp = (bf16*)(ws + WS_RR) + uns * 2048 + d; bf16* BGp = (bf16*)(ws + WS_RB) + uns * 2048 + d; bf16* KGp = (bf16*)(ws + WS_RK) + uns * 2048 + d;
        float* bonp = (float*)(ws + WS_BONUS) + ((size_t)b * T + t0) * 4 + hs;
        float lg = 0.f;
        float rprev = 0.f, kprev = 0.f;
        if (t0 > 0) { rprev = bf2f(*(P - PINP + ch)); kprev = bf2f(*(P - PINP + 256 + ch)); }
        unsigned short xrr[32], xkr[32];
#pragma unroll
        for (int t = 0; t < 32; ++t) { const bf16* row = P + (size_t)t * PINP; xrr[t] = row[ch]; xkr[t] = row[256 + ch]; }
#pragma unroll 1
        for (int t8 = 0; t8 < 4; ++t8) { u32x4 ap, bp, kp; float xr[8], xk[8];
#pragma unroll
            for (int e = 0; e < 8; ++e) { xr[e] = bf2f(t8 == 0 ? xrr[e] : t8 == 1 ? xrr[8 + e] : t8 == 2 ? xrr[16 + e] : xrr[24 + e]); xk[e] = bf2f(t8 == 0 ? xkr[e] : t8 == 1 ? xkr[8 + e] : t8 == 2 ? xkr[16 + e] : xkr[24 + e]); }
#pragma unroll
            for (int jj = 0; jj < 4; ++jj) { float at2[2], bh2[2], kh2[2];
#pragma unroll
                for (int e = 0; e < 2; ++e) { const int t = t8 * 8 + jj * 2 + e;
                    const float rc = xr[jj * 2 + e], kc = xk[jj * 2 + e];
                    const float r = rc + (rprev - rc) * mr, k = kc + (kprev - kc) * mk; rprev = rc; kprev = kc;
                    const float av = bf2f(AL[t * 264 + ch]), lw = bf2f(LWL[t * 264 + ch]);
                    const float kkr = k * kkc, hk = k * (1.0f + (av - 1.0f) * kac);
                    const float ss = wave_sum(kkr * kkr); const float kk = kkr / fmaxf(sqrtf(ss), 1e-12f);
                    const float bon = wave_sum(r * hk * rkc);
                    const float aa = -kk, bb = kk * av;
                    const float lgp = lg; lg += lw;
                    const float at = aa * fast_exp(lgp), rt = r * fast_exp(lg), ei = fast_exp(-lg), bt = bb * ei, kt = hk * ei, eh = fast_exp(lgend - lg);
                    sAT[t * 64 + d] = (bf16)f2bf(at); sBT[t * 64 + d] = (bf16)f2bf(bt); sKT[t * 64 + d] = (bf16)f2bf(kt);
                    RGp[t * 64] = (bf16)f2bf(rt); BGp[t * 64] = (bf16)f2bf(bt); KGp[t * 64] = (bf16)f2bf(kt);
                    if (d == 0) bonp[t * 4] = bon;
                    at2[e] = at; bh2[e] = bb * eh; kh2[e] = hk * eh; }
                ap[jj] = pk2(at2[0], at2[1]); bp[jj] = pk2(bh2[0], bh2[1]); kp[jj] = pk2(kh2[0], kh2[1]); }
            *(LAS u32x4*)(sATT + d * 32 + t8 * 8) = ap; *(LAS u32x4*)(sBHT + d * 32 + t8 * 8) = bp; *(LAS u32x4*)(sKHT + d * 32 + t8 * 8) = kp; }
        sGC[d] = fast_exp(lgend);
    } else {
        const int cv = tid - 256, hs = cv >> 6, vi = cv & 63; const size_t uns = (size_t)(b * 4 + hs) * NCH + c;
        LAS bf16* sVT = (LAS bf16*)(lds + hs * RWC_HEADB + 24576);
        bf16* VTg = (bf16*)(ws + WS_RVT) + uns * 2048 + vi * 32; bf16* VGp = (bf16*)(ws + WS_RVG) + uns * 2048 + vi;
        const float mv = mu[512 + cv];
        float vprev = 0.f; if (t0 > 0) vprev = bf2f(*(P - PINP + 512 + cv));
        unsigned short xvr[32];
#pragma unroll
        for (int t = 0; t < 32; ++t) xvr[t] = P[(size_t)t * PINP + 512 + cv];
#pragma unroll
        for (int t8 = 0; t8 < 4; ++t8) { u32x4 vp; float yv[8];
#pragma unroll
            for (int e = 0; e < 8; ++e) { const float xv = bf2f(xvr[t8 * 8 + e]); yv[e] = xv + (vprev - xv) * mv; vprev = xv; VGp[(t8 * 8 + e) * 64] = (bf16)f2bf(yv[e]); }
#pragma unroll
            for (int jj = 0; jj < 4; ++jj) vp[jj] = pk2(yv[2 * jj], yv[2 * jj + 1]);
            *(LAS u32x4*)(sVT + vi * 32 + t8 * 8) = vp; *(u32x4*)(VTg + t8 * 8) = vp; }
    }
    __syncthreads();
    f32x16 accR[2];
    {
        f32x16 acc;
#pragma unroll
        for (int i = 0; i < 16; ++i) acc[i] = 0.f;
        const LAS bf16* Bsrc = p == 0 ? BT : KT;
#pragma unroll
        for (int s = 0; s < 4; ++s) { const bf16x8 A = *(const LAS bf16x8*)(AT + r32 * 64 + 16 * s + 8 * hh), B = *(const LAS bf16x8*)(Bsrc + r32 * 64 + 16 * s + 8 * hh);
            acc = __builtin_amdgcn_mfma_f32_32x32x16_bf16(A, B, acc, 0, 0, 0); }
        if (p == 0) {
#pragma unroll
            for (int r = 0; r < 16; ++r) { const int t = rho16(r, hh); MAB[t * 32 + r32] = (r32 < t) ? acc[r] : 0.f; }
        } else {
#pragma unroll
            for (int r = 0; r < 16; ++r) { const int t = rho16(r, hh); MAK[t * 32 + r32] = (bf16)f2bf((r32 < t) ? acc[r] : 0.f); }
        }
    }
    __syncthreads();
    if (p == 0) {
        const int cidx = r32; float tc[32];
#pragma unroll
        for (int t = 0; t < 32; ++t) { float acc0 = (t == cidx) ? 1.0f : 0.f, acc1 = 0.f;
#pragma unroll
            for (int s4 = 0; s4 < (t + 3) / 4; ++s4) { const f32x4 m4 = *(const LAS f32x4*)(MAB + t * 32 + 4 * s4);
#pragma unroll
                for (int e = 0; e < 4; ++e) { const int s = 4 * s4 + e; if (s < t) { if (e & 1) acc1 = fmaf(m4[e], tc[s], acc1); else acc0 = fmaf(m4[e], tc[s], acc0); } } }
            tc[t] = acc0 + acc1; }
#pragma unroll
        for (int t = 0; t < 32; ++t) if (hh == 0) TM[t * 32 + cidx] = (bf16)f2bf(tc[t]);
    } else {
#pragma unroll
        for (int vt = 0; vt < 2; ++vt) {
#pragma unroll
            for (int i = 0; i < 16; ++i) accR[vt][i] = 0.f;
#pragma unroll
            for (int s = 0; s < 2; ++s) { const bf16x8 A = *(const LAS bf16x8*)(MAK + r32 * 32 + 16 * s + 8 * hh), B = *(const LAS bf16x8*)(VT + (32 * vt + r32) * 32 + 16 * s + 8 * hh);
                accR[vt] = __builtin_amdgcn_mfma_f32_32x32x16_bf16(A, B, accR[vt], 0, 0, 0); } }
    }
    __syncthreads();
    if (p == 0) {
        f32x16 accW[2];
#pragma unroll
        for (int dt = 0; dt < 2; ++dt) {
#pragma unroll
            for (int i = 0; i < 16; ++i) accW[dt][i] = 0.f;
#pragma unroll
            for (int s = 0; s < 2; ++s) { const bf16x8 A = *(const LAS bf16x8*)(TM + r32 * 32 + 16 * s + 8 * hh), B = *(const LAS bf16x8*)(ATT + (32 * dt + r32) * 32 + 16 * s + 8 * hh);
                accW[dt] = __builtin_amdgcn_mfma_f32_32x32x16_bf16(A, B, accW[dt], 0, 0, 0); } }
        { LAS bf16* WL = ATT;
#pragma unroll
          for (int dt = 0; dt < 2; ++dt)
#pragma unroll
              for (int r = 0; r < 16; ++r) WL[rho16(r, hh) * 64 + 32 * dt + r32] = (bf16)f2bf(accW[dt][r]);
          u32x4* WGp = (u32x4*)((bf16*)(ws + WS_RW) + un * 2048);
#pragma unroll
          for (int i = 0; i < 4; ++i) WGp[i * 64 + lane] = *(const LAS u32x4*)(WL + (i * 64 + lane) * 8); }
        LAS bf16* PL = (LAS bf16*)(L + 4096);
        const int xs = r32 >> 4, xx = r32 & 15, hhA = (xx >> 2) & 1, jA = 4 * (xx >> 3) + (xx & 3);
#pragma unroll
        for (int dt = 0; dt < 2; ++dt)
#pragma unroll
            for (int dt2 = 0; dt2 < 2; ++dt2) { f32x16 acc;
#pragma unroll
                for (int i = 0; i < 16; ++i) acc[i] = 0.f;
#pragma unroll
                for (int s = 0; s < 2; ++s) { const LAS bf16* bp = BHT + (32 * dt + r32) * 32 + 16 * s + 4 * hh;
                    union { bf16x8 v; s16x4 h2[2]; } af; af.h2[0] = *(const LAS s16x4*)bp; af.h2[1] = *(const LAS s16x4*)(bp + 8);
                    union { bf16x8 v; unsigned w[4]; } bf;
#pragma unroll
                    for (int j = 0; j < 4; ++j) bf.w[j] = cvt_pk_bf16(accW[dt2][8 * s + 2 * j], accW[dt2][8 * s + 2 * j + 1]);
                    acc = __builtin_amdgcn_mfma_f32_32x32x16_bf16(af.v, bf.v, acc, 0, 0, 0); }
                if (dt == dt2) { const float gc = GC[32 * dt + r32];
#pragma unroll
                    for (int r = 0; r < 16; ++r) if (rho16(r, hh) == r32) acc[r] += gc; }
                LAS bf16* pf = PL + (((dt * 2 + dt2) * 2 + xs) * 64 + 32 * hhA) * 8 + jA;
#pragma unroll
                for (int r = 0; r < 16; ++r) pf[rho16(r, hh) * 8] = (bf16)f2bf(acc[r]); }
        { u32x4* PFp = (u32x4*)((bf16*)(ws + WS_RP) + un * 4096);
#pragma unroll
          for (int f = 0; f < 8; ++f) PFp[f * 64 + lane] = *(const LAS u32x4*)(PL + (f * 64 + lane) * 8); }
    } else {
        f32x16 accU[2];
#pragma unroll
        for (int vt = 0; vt < 2; ++vt) {
#pragma unroll
            for (int i = 0; i < 16; ++i) accU[vt][i] = 0.f;
#pragma unroll
            for (int s = 0; s < 2; ++s) { const LAS bf16* tp = TM + r32 * 32 + 16 * s + 4 * hh;
                union { bf16x8 v; s16x4 h2[2]; } af; af.h2[0] = *(const LAS s16x4*)tp; af.h2[1] = *(const LAS s16x4*)(tp + 8);
                union { bf16x8 v; unsigned w[4]; } bf;
#pragma unroll
                for (int j = 0; j < 4; ++j) bf.w[j] = cvt_pk_bf16(accR[vt][8 * s + 2 * j], accR[vt][8 * s + 2 * j + 1]);
                accU[vt] = __builtin_amdgcn_mfma_f32_32x32x16_bf16(af.v, bf.v, accU[vt], 0, 0, 0); } }
        float* UGp = (float*)(ws + WS_RU) + un * 2048;
#pragma unroll
        for (int vt = 0; vt < 2; ++vt)
#pragma unroll
            for (int g = 0; g < 4; ++g) *(f32x4*)(UGp + ((vt * 4 + g) * 64 + lane) * 4) = (f32x4){accU[vt][4 * g], accU[vt][4 * g + 1], accU[vt][4 * g + 2], accU[vt][4 * g + 3]};
        float* QFp = (float*)(ws + WS_RQ) + un * 4096;
#pragma unroll
        for (int vt = 0; vt < 2; ++vt)
#pragma unroll
            for (int dt = 0; dt < 2; ++dt) { f32x16 acc;
#pragma unroll
                for (int i = 0; i < 16; ++i) acc[i] = 0.f;
#pragma unroll
                for (int s = 0; s < 2; ++s) { const LAS bf16* bp = BHT + (32 * dt + r32) * 32 + 16 * s + 4 * hh;
                    union { bf16x8 v; s16x4 h2[2]; } af; af.h2[0] = *(const LAS s16x4*)bp; af.h2[1] = *(const LAS s16x4*)(bp + 8);
                    union { bf16x8 v; unsigned w[4]; } bf;
#pragma unroll
                    for (int j = 0; j < 4; ++j) bf.w[j] = cvt_pk_bf16(accU[vt][8 * s + 2 * j], accU[vt][8 * s + 2 * j + 1]);
                    acc = __builtin_amdgcn_mfma_f32_32x32x16_bf16(af.v, bf.v, acc, 0, 0, 0);
                    const bf16x8 A2 = *(const LAS bf16x8*)(KHT + (32 * dt + r32) * 32 + 16 * s + 8 * hh), B2 = *(const LAS bf16x8*)(VT + (32 * vt + r32) * 32 + 16 * s + 8 * hh);
                    acc = __builtin_amdgcn_mfma_f32_32x32x16_bf16(A2, B2, acc, 0, 0, 0); }
#pragma unroll
                for (int g = 0; g < 4; ++g) *(f32x4*)(QFp + (((vt * 2 + dt) * 4 + g) * 64 + lane) * 4) = (f32x4){acc[4 * g], acc[4 * g + 1], acc[4 * g + 2], acc[4 * g + 3]}; }
    }
    __syncthreads();
}
__device__ __forceinline__ void rw_m2_wave(int lane, int bh, int vt) {
    unsigned char* ws = KWS();
    const bf16* PF = (const bf16*)(ws + WS_RP) + (size_t)bh * NCH * 4096 + lane * 8;
    const float* QF = (const float*)(ws + WS_RQ) + (size_t)bh * NCH * 4096 + (size_t)vt * 2048 + lane * 4;
    bf16* SG = (bf16*)(ws + WS_RS) + (size_t)bh * NCH * 4096 + (size_t)vt * 2048 + lane * 8;
    f32x16 S[2];
#pragma unroll
    for (int dt = 0; dt < 2; ++dt)
#pragma unroll
        for (int i = 0; i < 16; ++i) S[dt][i] = 0.f;
    bf16x8 pA[8], pB[8]; f32x4 qA[8], qB[8];
#define RWM2_LOAD(P_, Q_, c_) do { const int _c = (c_) < NCH ? (c_) : NCH - 1; _Pragma("unroll") for (int f = 0; f < 8; ++f) { P_[f] = *(const bf16x8*)(PF + (size_t)_c * 4096 + f * 512); Q_[f] = *(const f32x4*)(QF + (size_t)_c * 4096 + f * 256); } } while (0)
#define RWM2_STEP(P_, Q_, c_) do { \
        union { bf16x8 v; unsigned w[4]; } sb[2][2]; \
        _Pragma("unroll") for (int dt2 = 0; dt2 < 2; ++dt2) _Pragma("unroll") for (int s = 0; s < 2; ++s) { \
            _Pragma("unroll") for (int j = 0; j < 4; ++j) sb[dt2][s].w[j] = cvt_pk_bf16(S[dt2][8 * s + 2 * j], S[dt2][8 * s + 2 * j + 1]); \
            *(bf16x8*)(SG + (size_t)(c_) * 4096 + (dt2 * 2 + s) * 512) = sb[dt2][s].v; } \
        f32x16 N[2]; \
        _Pragma("unroll") for (int dt = 0; dt < 2; ++dt) { \
            _Pragma("unroll") for (int g = 0; g < 4; ++g) { N[dt][4 * g] = Q_[dt * 4 + g][0]; N[dt][4 * g + 1] = Q_[dt * 4 + g][1]; N[dt][4 * g + 2] = Q_[dt * 4 + g][2]; N[dt][4 * g + 3] = Q_[dt * 4 + g][3]; } \
            _Pragma("unroll") for (int dt2 = 0; dt2 < 2; ++dt2) _Pragma("unroll") for (int s = 0; s < 2; ++s) N[dt] = __builtin_amdgcn_mfma_f32_32x32x16_bf16(P_[(dt * 2 + dt2) * 2 + s], sb[dt2][s].v, N[dt], 0, 0, 0); } \
        S[0] = N[0]; S[1] = N[1]; } while (0)
    RWM2_LOAD(pA, qA, 0); RWM2_LOAD(pB, qB, 1);
#pragma unroll 1
    for (int c = 0; c < NCH; c += 2) {
        RWM2_STEP(pA, qA, c); RWM2_LOAD(pA, qA, c + 2);
        RWM2_STEP(pB, qB, c + 1); RWM2_LOAD(pB, qB, c + 3);
    }
#undef RWM2_LOAD
#undef RWM2_STEP
}
__device__ __forceinline__ bf16x8 ld_perm8(const bf16* p) { union { bf16x8 v; s16x4 h2[2]; } f; f.h2[0] = *(const s16x4*)p; f.h2[1] = *(const s16x4*)(p + 8); return f.v; }
__device__ __forceinline__ void rw_m3_task(int lane, int l, int bh, int c) {
    unsigned char* ws = KWS();
    const int r32 = lane & 31, hh = lane >> 5, b = bh >> 2, h = bh & 3; const size_t un = (size_t)bh * NCH + c; const size_t tok0 = (size_t)b * T + c * 32;
    const bf16* RGp = (const bf16*)(ws + WS_RR) + un * 2048 + r32 * 64 + 4 * hh; const bf16* BGp = (const bf16*)(ws + WS_RB) + un * 2048 + r32 * 64 + 4 * hh;
    const bf16* KGp = (const bf16*)(ws + WS_RK) + un * 2048 + r32 * 64 + 4 * hh; const bf16* WGp = (const bf16*)(ws + WS_RW) + un * 2048 + r32 * 64 + 4 * hh;
    const bf16* SGp = (const bf16*)(ws + WS_RS) + un * 4096 + lane * 8; const bf16* VTp = (const bf16*)(ws + WS_RVT) + un * 2048 + r32 * 32 + 4 * hh;
    const float* UGp = (const float*)(ws + WS_RU) + un * 2048 + lane * 4;
    f32x16 U[2], Y[2], mb, mk;
#pragma unroll
    for (int vt = 0; vt < 2; ++vt)
#pragma unroll
        for (int g = 0; g < 4; ++g) { const f32x4 u4 = *(const f32x4*)(UGp + (vt * 4 + g) * 256); U[vt][4 * g] = u4[0]; U[vt][4 * g + 1] = u4[1]; U[vt][4 * g + 2] = u4[2]; U[vt][4 * g + 3] = u4[3]; }
#pragma unroll
    for (int i = 0; i < 16; ++i) { mb[i] = 0.f; mk[i] = 0.f; Y[0][i] = 0.f; Y[1][i] = 0.f; }
#pragma unroll
    for (int ks = 0; ks < 4; ++ks) {
        const bf16x8 rf = ld_perm8(RGp + 16 * ks), wf = ld_perm8(WGp + 16 * ks), bfr = ld_perm8(BGp + 16 * ks), kfr = ld_perm8(KGp + 16 * ks);
        const bf16x8 s0 = *(const bf16x8*)(SGp + ks * 512), s1 = *(const bf16x8*)(SGp + 2048 + ks * 512);
        U[0] = __builtin_amdgcn_mfma_f32_32x32x16_bf16(wf, s0, U[0], 0, 0, 0); U[1] = __builtin_amdgcn_mfma_f32_32x32x16_bf16(wf, s1, U[1], 0, 0, 0);
        mb = __builtin_amdgcn_mfma_f32_32x32x16_bf16(bfr, rf, mb, 0, 0, 0); mk = __builtin_amdgcn_mfma_f32_32x32x16_bf16(kfr, rf, mk, 0, 0, 0);
        Y[0] = __builtin_amdgcn_mfma_f32_32x32x16_bf16(s0, rf, Y[0], 0, 0, 0); Y[1] = __builtin_amdgcn_mfma_f32_32x32x16_bf16(s1, rf, Y[1], 0, 0, 0); }
#pragma unroll
    for (int r = 0; r < 16; ++r) if (rho16(r, hh) > r32) { mb[r] = 0.f; mk[r] = 0.f; }
#pragma unroll
    for (int s = 0; s < 2; ++s) { union { bf16x8 v; unsigned w[4]; } fb, fk;
#pragma unroll
        for (int j = 0; j < 4; ++j) { fb.w[j] = cvt_pk_bf16(mb[8 * s + 2 * j], mb[8 * s + 2 * j + 1]); fk.w[j] = cvt_pk_bf16(mk[8 * s + 2 * j], mk[8 * s + 2 * j + 1]); }
#pragma unroll
        for (int vt = 0; vt < 2; ++vt) { union { bf16x8 v; unsigned w[4]; } fu;
#pragma unroll
            for (int j = 0; j < 4; ++j) fu.w[j] = cvt_pk_bf16(U[vt][8 * s + 2 * j], U[vt][8 * s + 2 * j + 1]);
            Y[vt] = __builtin_amdgcn_mfma_f32_32x32x16_bf16(fu.v, fb.v, Y[vt], 0, 0, 0);
            const bf16* vp = VTp + (size_t)vt * 32 * 32 + 16 * s;
            union { bf16x8 v; s16x4 h2[2]; } vf; vf.h2[0] = *(const s16x4*)vp; vf.h2[1] = *(const s16x4*)(vp + 8);
            Y[vt] = __builtin_amdgcn_mfma_f32_32x32x16_bf16(vf.v, fk.v, Y[vt], 0, 0, 0); } }
    float sm = 0.f;
#pragma unroll
    for (int vt = 0; vt < 2; ++vt)
#pragma unroll
        for (int i = 0; i < 16; ++i) sm += Y[vt][i];
    sm += __shfl_xor(sm, 32); const float mu = sm * (1.0f / 64.0f);
    float q = 0.f;
#pragma unroll
    for (int vt = 0; vt < 2; ++vt)
#pragma unroll
        for (int i = 0; i < 16; ++i) { const float dd = Y[vt][i] - mu; q += dd * dd; }
    q += __shfl_xor(q, 32); const float rstd = 1.0f / sqrtf(q * (1.0f / 64.0f) + RW_LN_EPS);
    const size_t tok = tok0 + r32;
    const float bon = ((const float*)(ws + WS_BONUS))[tok * 4 + h];
    const bf16* vrec = (const bf16*)(ws + WS_RVG) + un * 2048 + r32 * 64;
    const bf16* gp = (const bf16*)(ws + WS_GBUF) + tok * 256 + h * 64; bf16* od = (bf16*)(ws + WS_O) + tok * D + 512 + h * 64;
    const float* lnw = KIN(I_RWLNW) + l * 256 + h * 64; const float* lnb = KIN(I_RWLNB) + l * 256 + h * 64;
#pragma unroll
    for (int vt = 0; vt < 2; ++vt)
#pragma unroll
        for (int g = 0; g < 4; ++g) { const int v0 = 32 * vt + 8 * g + 4 * hh; const f32x4 w4 = *(const f32x4*)(lnw + v0), b4 = *(const f32x4*)(lnb + v0); const u32x2 vw = *(const u32x2*)(vrec + v0); const f32x4 vv = {bflo(vw.x), bfhi(vw.x), bflo(vw.y), bfhi(vw.y)}; const u32x2 gw = *(const u32x2*)(gp + v0);
            const float y0 = ((Y[vt][4 * g] - mu) * rstd * w4[0] + b4[0] + bon * vv[0]) * bflo(gw.x), y1 = ((Y[vt][4 * g + 1] - mu) * rstd * w4[1] + b4[1] + bon * vv[1]) * bfhi(gw.x);
            const float y2 = ((Y[vt][4 * g + 2] - mu) * rstd * w4[2] + b4[2] + bon * vv[2]) * bflo(gw.y), y3 = ((Y[vt][4 * g + 3] - mu) * rstd * w4[3] + b4[3] + bon * vv[3]) * bfhi(gw.y);
            *(u32x2*)(od + v0) = (u32x2){pk2(y0, y1), pk2(y2, y3)}; }
}

__device__ __forceinline__ void c1_phase(LAS unsigned char* lds, int l, int vcu, int G) {
    for (int u = vcu; u < NB * NCH; u += G) { const int b = u >> 8, c = u & 255;
        for (int q = 0; q <= PHREP(16); ++q) rw_fused_unit(lds, l, b, c);
        for (int q = 0; q <= PHREP(17); ++q) hg_fused_unit(lds, l, b, c);
        for (int q = 0; q <= PHREP(18); ++q) gla_fused_unit(lds, l, b, c); }
}
__device__ __forceinline__ void m3_gh_phase(int l, int vcu, int G) {
    const int tid = opaque_tid(), lane = tid & 63, wave = __builtin_amdgcn_readfirstlane(tid >> 6);
    unsigned char* ws = KWS();
    const int gw = vcu * NWAVES + wave, NGW = G * NWAVES;
    const bf16* P = (const bf16*)(ws + WS_P); bf16* O = (bf16*)(ws + WS_O);
    const float* gng = KIN(I_GLANG) + l * 256; const float* hng = KIN(I_HGNG) + l * 256;
    for (int task = gw; task < 24576; task += NGW) {
        const int un = task & 8191, bh = un >> 8, c = un & 255, b = bh >> 2, h = bh & 3; const size_t tok0 = (size_t)b * T + c * 32;
        if (task >= 16384) { rw_m3_task(lane, l, bh, c); continue; }
        if (task < 8192) m3_gh_task<64>(lane, (const bf16*)(ws + WS_HQ) + (size_t)un * 2048, (const bf16*)(ws + WS_HK) + (size_t)un * 2048, (const bf16*)(ws + WS_HVT) + (size_t)un * 2048, (const bf16*)(ws + WS_HS) + (size_t)un * 4096,
                                         P + tok0 * PINP + PC_HG + h * 64, hng + h * 64, O + tok0 * D + 256 + h * 64);
        else m3_gh_task<32>(lane, (const bf16*)(ws + WS_GQ) + (size_t)un * 1024, (const bf16*)(ws + WS_GK) + (size_t)un * 1024, (const bf16*)(ws + WS_GVT) + (size_t)un * 2048, (const bf16*)(ws + WS_GS) + (size_t)un * 2048,
                            P + tok0 * PINP + PC_GOUT + h * 64, gng + h * 64, O + tok0 * D + h * 64);
    }
}

__device__ __forceinline__ void xattn_units(LAS unsigned char* lds, int l, int first, int last, int stride) {
    const int tid = opaque_tid(), lane = tid & 63, wave = __builtin_amdgcn_readfirstlane(tid >> 6), r32 = lane & 31, hh = lane >> 5;
    const bf16* P = (const bf16*)(KWS() + WS_P); const bf16* MKV = (const bf16*)(KWS() + WS_MKV); bf16* O = (bf16*)(KWS() + WS_O);
    LAS bf16* KL = (LAS bf16*)lds;
    LAS bf16* VT = (LAS bf16*)(lds + 256 * 72 * 2);
    int cur_bh = -1;
    for (int u = first; u < last; u += stride) {
        const int bh = u >> 5, qb = u & 31, b = bh >> 2, h = bh & 3;
        if (bh != cur_bh) {
            __syncthreads();
            for (int i = tid; i < 256 * 8; i += NTHR) { const int key = i >> 3, c8 = i & 7;
                const bf16* src = MKV + (size_t)(b * 256 + key) * 2048 + l * 512 + h * 64 + c8 * 8;
                *(LAS u32x4*)(KL + key * 72 + c8 * 8) = *(const u32x4*)src;
                const u32x4 vv = *(const u32x4*)(src + 256);
                LAS bf16* vd = VT + (c8 * 8) * 264 + key;
                vd[0 * 264] = (bf16)(vv.x & 0xffff); vd[1 * 264] = (bf16)(vv.x >> 16); vd[2 * 264] = (bf16)(vv.y & 0xffff); vd[3 * 264] = (bf16)(vv.y >> 16);
                vd[4 * 264] = (bf16)(vv.z & 0xffff); vd[5 * 264] = (bf16)(vv.z >> 16); vd[6 * 264] = (bf16)(vv.w & 0xffff); vd[7 * 264] = (bf16)(vv.w >> 16); }
            __syncthreads();
            cur_bh = bh;
        }
        const int q = b * T + qb * 256 + wave * 32 + r32;
        bf16x8 qf[4];
#pragma unroll
        for (int s = 0; s < 4; ++s) qf[s] = *(const bf16x8*)(P + (size_t)q * PINP + PC_MQ + h * 64 + 16 * s + 8 * hh);
        f32x16 sc[8];
#pragma unroll
        for (int kt = 0; kt < 8; ++kt) {
#pragma unroll
            for (int i = 0; i < 16; ++i) sc[kt][i] = 0.f;
#pragma unroll
            for (int s = 0; s < 4; ++s) { const bf16x8 kf = *(const LAS bf16x8*)(KL + (kt * 32 + r32) * 72 + 16 * s + 8 * hh);
                sc[kt] = __builtin_amdgcn_mfma_f32_32x32x16_bf16(kf, qf[s], sc[kt], 0, 0, 0); }
        }
        float m = -3.0e38f;
#pragma unroll
        for (int kt = 0; kt < 8; ++kt)
#pragma unroll
            for (int i = 0; i < 16; ++i) m = fmaxf(m, sc[kt][i]);
        m = fmaxf(m, __shfl_xor(m, 32));
        float sum = 0.f;
        const float c2 = 0.125f * 1.4426950408889634f;
#pragma unroll
        for (int kt = 0; kt < 8; ++kt)
#pragma unroll
            for (int i = 0; i < 16; ++i) { const float e = __builtin_amdgcn_exp2f((sc[kt][i] - m) * c2); sc[kt][i] = e; sum += e; }
        sum += __shfl_xor(sum, 32);
        const float inv = 1.0f / sum;
        f32x16 oa[2];
#pragma unroll
        for (int vt = 0; vt < 2; ++vt)
#pragma unroll
            for (int i = 0; i < 16; ++i) oa[vt][i] = 0.f;
#pragma unroll
        for (int kt = 0; kt < 8; ++kt)
#pragma unroll
            for (int s = 0; s < 2; ++s) {
                union { bf16x8 v; unsigned w[4]; } pf;
#pragma unroll
                for (int j = 0; j < 4; ++j) pf.w[j] = cvt_pk_bf16(sc[kt][8 * s + 2 * j], sc[kt][8 * s + 2 * j + 1]);
#pragma unroll
                for (int vt = 0; vt < 2; ++vt) {
                    const LAS bf16* vp = VT + (vt * 32 + r32) * 264 + kt * 32 + 16 * s + 4 * hh;
                    union { bf16x8 v; s16x4 h2[2]; } vf; vf.h2[0] = *(const LAS s16x4*)vp; vf.h2[1] = *(const LAS s16x4*)(vp + 8);
                    oa[vt] = __builtin_amdgcn_mfma_f32_32x32x16_bf16(vf.v, pf.v, oa[vt], 0, 0, 0); }
            }
        bf16* orow = O + (size_t)q * D + 768 + h * 64;
#pragma unroll
        for (int vt = 0; vt < 2; ++vt)
#pragma unroll
            for (int g = 0; g < 4; ++g) { u32x2 w; w.x = cvt_pk_bf16(oa[vt][4 * g] * inv, oa[vt][4 * g + 1] * inv); w.y = cvt_pk_bf16(oa[vt][4 * g + 2] * inv, oa[vt][4 * g + 3] * inv);
                *(u32x2*)(orow + vt * 32 + 8 * g + 4 * hh) = w; }
    }
    __syncthreads();
}

__device__ __forceinline__ void m2_phase(LAS unsigned char* lds, int l, int bx, int G) {
    unsigned char* ws = KWS();
    const int tid = opaque_tid(), lane = tid & 63, wave = __builtin_amdgcn_readfirstlane(tid >> 6);
    const int nrw = (G >= 128) ? 64 : 0;
    if (nrw) { if (bx < nrw && wave == 0) rw_m2_wave(lane, bx >> 1, bx & 1); }
    else { for (int q = bx * NWAVES + wave; q < 64; q += G * NWAVES) rw_m2_wave(lane, q >> 1, q & 1); }
    if (!(nrw && bx < nrw && wave == 0)) {
        const int nth = nrw ? (nrw * 448 + (G - nrw) * NTHR) : G * NTHR;
        const int gt = nrw ? (bx < nrw ? bx * 448 + (tid - 64) : nrw * 448 + (bx - nrw) * NTHR + tid) : bx * NTHR + tid;
        for (int e = gt; e < 196608; e += nth) {
            if (e < 131072) m2_gh_elem<64>(e, (const float*)(ws + WS_HDS), (const float*)(ws + WS_HBE), (bf16*)(ws + WS_HS));
            else m2_gh_elem<32>(e - 131072, (const float*)(ws + WS_GDS), (const float*)(ws + WS_GBE), (bf16*)(ws + WS_GS)); }
    }
    if (nrw == 0 || bx >= nrw) {
        const int nb = G - nrw, r = bx - nrw;
        const int per = (1024 + nb - 1) / nb, lo = r * per, hi = (lo + per < 1024) ? lo + per : 1024;
        xattn_units(lds, l, lo, hi, 1);
    }
}

__device__ __forceinline__ void ln1_router_phase(LAS unsigned char* lds, int l, int bx, int G) {
    const int tid = opaque_tid(), lane = tid & 63, wave = __builtin_amdgcn_readfirstlane(tid >> 6);
    LAS float* X = (LAS float*)lds;
    LAS float* PART = (LAS float*)(lds + 16 * 1028 * 4);
    LAS int* HIST = (LAS int*)(lds + 16 * 1028 * 4 + 8 * 16 * 32 * 4);
    const float* xin = KIN(I_X); const bf16* xinb = (const bf16*)(KWS() + WS_XB);
    const bf16* HM = (const bf16*)(KWS() + WS_HMIX);
    bf16* X1B = (bf16*)(KWS() + WS_X1B);
    const float* g1 = KIN(I_LN1G) + l * D; const float* b1 = KIN(I_LN1B) + l * D;
    const float* rw = KIN(I_RTW) + (size_t)l * D * NE; const float* rb = KIN(I_RTB) + l * NE;
    int* tok_e = (int*)(KWS() + WS_ROUTE); float* tok_g = (float*)(KWS() + WS_ROUTE + 1 * MiB);
    if (tid < 32) HIST[tid] = 0;
    float rwB[2][32];
    { const int q = lane >> 4, e = lane & 15;
#pragma unroll
      for (int s = 0; s < 32; ++s) { const float* p = rw + (size_t)(128 * wave + 32 * q + s) * NE + e; rwB[0][s] = p[0]; rwB[1][s] = p[16]; } }
    __syncthreads();
    for (int it = bx; it < NTOK / 16; it += G) {
#pragma unroll
        for (int tt = 0; tt < 2; ++tt) { const int ti = wave * 2 + tt; const size_t tok = (size_t)it * 16 + ti;
            const f32x4* xr = (const f32x4*)(xin + tok * D) + lane; const u32x2* xbr = (const u32x2*)(xinb + tok * D) + lane; const u32x2* hr = (const u32x2*)(HM + tok * D) + lane;
            f32x4 v[4]; float s = 0.f;
#pragma unroll
            for (int j = 0; j < 4; ++j) { f32x4 xv; if (l == 0) xv = xr[64 * j]; else { const u32x2 xw = xbr[64 * j]; xv = (f32x4){bflo(xw.x), bfhi(xw.x), bflo(xw.y), bfhi(xw.y)}; } const u32x2 hw = hr[64 * j];
                v[j][0] = DN_ALPHA * xv[0] + bflo(hw.x); v[j][1] = DN_ALPHA * xv[1] + bfhi(hw.x); v[j][2] = DN_ALPHA * xv[2] + bflo(hw.y); v[j][3] = DN_ALPHA * xv[3] + bfhi(hw.y);
                s += (v[j][0] + v[j][1]) + (v[j][2] + v[j][3]); }
            const float mean = wave_sum(s) * (1.0f / D); float s2 = 0.f;
#pragma unroll
            for (int j = 0; j < 4; ++j) { v[j] = v[j] - mean; s2 += (v[j][0] * v[j][0] + v[j][1] * v[j][1]) + (v[j][2] * v[j][2] + v[j][3] * v[j][3]); }
            const float rstd = 1.0f / sqrtf(wave_sum(s2) * (1.0f / D) + LN_EPS);
#pragma unroll
            for (int j = 0; j < 4; ++j) { const f32x4 gg = *((const f32x4*)g1 + lane + 64 * j), bb = *((const f32x4*)b1 + lane + 64 * j);
                const f32x4 y = v[j] * rstd * gg + bb;
                *((u32x2*)(X1B + tok * D) + lane + 64 * j) = (u32x2){pk2(y[0], y[1]), pk2(y[2], y[3])};
                *(LAS f32x4*)(X + ti * 1028 + 4 * lane + 256 * j) = y; }
        }
        __syncthreads();
        {
            const int q = lane >> 4, r = lane & 15;
            f32x4 acc0 = (f32x4){0.f, 0.f, 0.f, 0.f}, acc1 = (f32x4){0.f, 0.f, 0.f, 0.f};
            const LAS float* xa = X + r * 1028 + 128 * wave + 32 * q;
#pragma unroll
            for (int s4 = 0; s4 < 8; ++s4) { const f32x4 av = *(const LAS f32x4*)(xa + 4 * s4);
#pragma unroll
                for (int j = 0; j < 4; ++j) { acc0 = __builtin_amdgcn_mfma_f32_16x16x4f32(av[j], rwB[0][4 * s4 + j], acc0, 0, 0, 0); acc1 = __builtin_amdgcn_mfma_f32_16x16x4f32(av[j], rwB[1][4 * s4 + j], acc1, 0, 0, 0); } }
#pragma unroll
            for (int i = 0; i < 4; ++i) { PART[(wave * 16 + 4 * q + i) * 32 + r] = acc0[i]; PART[(wave * 16 + 4 * q + i) * 32 + 16 + r] = acc1[i]; }
        }
        __syncthreads();
        {
            const int ti = tid >> 5, e = tid & 31;
            float lg = rb[e];
#pragma unroll
            for (int w = 0; w < 8; ++w) lg += PART[(w * 16 + ti) * 32 + e];
            float tv[4]; int te[4]; float cur = lg;
#pragma unroll
            for (int k = 0; k < 4; ++k) { float bv = cur; int bi = e;
#pragma unroll
                for (int o = 16; o >= 1; o >>= 1) { const float ov = __shfl_xor(bv, o); const int oi = __shfl_xor(bi, o); if (ov > bv || (ov == bv && oi < bi)) { bv = ov; bi = oi; } }
                tv[k] = bv; te[k] = bi; if (e == bi) cur = -3.0e38f; }
            const float e1 = __expf(tv[1] - tv[0]), e2 = __expf(tv[2] - tv[0]), e3 = __expf(tv[3] - tv[0]); const float inv = 1.0f / (1.0f + e1 + e2 + e3);
            const size_t tok = (size_t)it * 16 + ti;
            if (e < 4) { const int ek = e == 0 ? te[0] : e == 1 ? te[1] : e == 2 ? te[2] : te[3]; const float gk = (e == 0 ? 1.0f : e == 1 ? e1 : e == 2 ? e2 : e3) * inv;
                tok_e[tok * 4 + e] = ek; tok_g[tok * 4 + e] = gk; __hip_atomic_fetch_add(&HIST[ek], 1, __ATOMIC_RELAXED, __HIP_MEMORY_SCOPE_WORKGROUP); }
        }
        __syncthreads();
    }
    __syncthreads();
    if (tid < 32) ((int*)(KWS() + WS_CTL))[CW_HIST + bx * 32 + tid] = HIST[tid];
}

__device__ __forceinline__ void slots_phase(LAS unsigned char* lds, int bx, int G) {
    const int tid = opaque_tid();
    int* ctl = (int*)(KWS() + WS_CTL);
    LAS int* RED = (LAS int*)lds;
    LAS int* TOT = RED + 1024;
    const int* tok_e = (const int*)(KWS() + WS_ROUTE); const float* tok_g = (const float*)(KWS() + WS_ROUTE + 1 * MiB);
    int* tok_slot = (int*)(KWS() + WS_ROUTE + 2 * MiB); int* slot_tok = (int*)(KWS() + WS_ROUTE + 3 * MiB); float* slot_gate = (float*)(KWS() + WS_ROUTE + 3 * MiB + 1536 * 1024);
    { const int e = tid & 31, part = tid >> 5; int tot = 0, pre = 0;
      for (int b2 = part; b2 < G; b2 += 16) { const int h = ctl[CW_HIST + b2 * 32 + e]; tot += h; if (b2 < bx) pre += h; }
      RED[(part * 32 + e) * 2] = tot; RED[(part * 32 + e) * 2 + 1] = pre; }
    __syncthreads();
    if (tid < 32) { int tot = 0, pre = 0; for (int p = 0; p < 16; ++p) { tot += RED[(p * 32 + tid) * 2]; pre += RED[(p * 32 + tid) * 2 + 1]; } TOT[tid] = tot; TOT[32 + tid] = pre; TOT[96 + tid] = 0; }
    __syncthreads();
    if (tid == 0) { int ps = 0;
#pragma unroll 1
        for (int e = 0; e < 32; ++e) { TOT[64 + e] = ps; ps += (TOT[e] + 255) & ~255; }
        TOT[128] = ps >> 8; if (bx == 0) ctl[CW_NT] = ps >> 8; }
    __syncthreads();
    if (bx == 0) { const int nt = TOT[128];
        for (int t = tid; t < nt; t += NTHR) { int e = 0;
#pragma unroll 1
            for (int k = 1; k < 32; ++k) if (TOT[64 + k] <= t * 256) e = k;
            ctl[CW_TILEE + t] = e; } }
    for (int e = bx; e < 32; e += G) { const int s0 = TOT[64 + e] + TOT[e], s1 = TOT[64 + e] + ((TOT[e] + 255) & ~255); for (int s = s0 + tid; s < s1; s += NTHR) { slot_tok[s] = 0; slot_gate[s] = 0.f; } }
    for (int it = bx; it < NTOK / 16; it += G) {
        if (tid < 64) { const int asg = it * 64 + tid; const int e = tok_e[asg]; const int rank = __hip_atomic_fetch_add(&TOT[96 + e], 1, __ATOMIC_RELAXED, __HIP_MEMORY_SCOPE_WORKGROUP); const int slot = TOT[64 + e] + TOT[32 + e] + rank;
            tok_slot[asg] = slot; slot_tok[slot] = asg >> 2; slot_gate[slot] = tok_g[asg]; }
    }
}

__device__ __forceinline__ void combine_phase(int l, int vcu, int G) {
    const int tid = opaque_tid(), lane = tid & 63, wave = __builtin_amdgcn_readfirstlane(tid >> 6);
    const int gw = vcu * NWAVES + wave, NGW = G * NWAVES;
    const bf16* X1B = (const bf16*)(KWS() + WS_X1B); const bf16* YB = (const bf16*)(KWS() + WS_YB); const int* tok_slot = (const int*)(KWS() + WS_ROUTE + 2 * MiB);
    float* xo = KOUT(); bf16* XB = (bf16*)(KWS() + WS_XB);
    const float* g2 = KIN(I_LN2G) + l * D; const float* b2 = KIN(I_LN2B) + l * D;
    for (int tok = gw; tok < NTOK; tok += NGW) {
        const int s0 = tok_slot[tok * 4], s1 = tok_slot[tok * 4 + 1], s2i = tok_slot[tok * 4 + 2], s3 = tok_slot[tok * 4 + 3];
        const u32x2* xr = (const u32x2*)(X1B + (size_t)tok * D) + lane;
        const u32x2* y0 = (const u32x2*)(YB + (size_t)s0 * D) + lane; const u32x2* y1 = (const u32x2*)(YB + (size_t)s1 * D) + lane;
        const u32x2* y2 = (const u32x2*)(YB + (size_t)s2i * D) + lane; const u32x2* y3 = (const u32x2*)(YB + (size_t)s3 * D) + lane;
        f32x4 v[4]; float s = 0.f;
#pragma unroll
        for (int j = 0; j < 4; ++j) { const u32x2 xw = xr[64 * j]; const f32x4 xv = {bflo(xw.x), bfhi(xw.x), bflo(xw.y), bfhi(xw.y)}; const u32x2 a0 = y0[64 * j], a1 = y1[64 * j], a2 = y2[64 * j], a3 = y3[64 * j];
            v[j][0] = DN_ALPHA * xv[0] + ((bflo(a0.x) + bflo(a1.x)) + (bflo(a2.x) + bflo(a3.x))); v[j][1] = DN_ALPHA * xv[1] + ((bfhi(a0.x) + bfhi(a1.x)) + (bfhi(a2.x) + bfhi(a3.x)));
            v[j][2] = DN_ALPHA * xv[2] + ((bflo(a0.y) + bflo(a1.y)) + (bflo(a2.y) + bflo(a3.y))); v[j][3] = DN_ALPHA * xv[3] + ((bfhi(a0.y) + bfhi(a1.y)) + (bfhi(a2.y) + bfhi(a3.y)));
            s += (v[j][0] + v[j][1]) + (v[j][2] + v[j][3]); }
        const float mean = wave_sum(s) * (1.0f / D); float q = 0.f;
#pragma unroll
        for (int j = 0; j < 4; ++j) { v[j] = v[j] - mean; q += (v[j][0] * v[j][0] + v[j][1] * v[j][1]) + (v[j][2] * v[j][2] + v[j][3] * v[j][3]); }
        const float rstd = 1.0f / sqrtf(wave_sum(q) * (1.0f / D) + LN_EPS);
#pragma unroll
        for (int j = 0; j < 4; ++j) { const f32x4 gg = *((const f32x4*)g2 + lane + 64 * j), bb = *((const f32x4*)b2 + lane + 64 * j);
            const f32x4 y = v[j] * rstd * gg + bb;
            if (l == NL - 1) *((f32x4*)(xo + (size_t)tok * D) + lane + 64 * j) = y;
            else *((u32x2*)(XB + (size_t)tok * D) + lane + 64 * j) = (u32x2){pk2(y[0], y[1]), pk2(y[2], y[3])}; }
    }
}


constexpr int PH_PER_LAYER = 10, NPHASES = 2 + NL * PH_PER_LAYER;
__global__ void __launch_bounds__(NTHR, 2) trunk_fwd(Args args) {
    extern __shared__ __attribute__((aligned(16))) unsigned char lds_raw[];
    LAS unsigned char* lds = (LAS unsigned char*)lds_raw;
    volatile LAS unsigned* MISC = (volatile LAS unsigned*)(lds + MISC_OFF);
    const int tid = threadIdx.x;
    const int G = gridDim.x, bx = blockIdx.x;
    const int vcu = (G % 8 == 0) ? (bx % 8) * (G / 8) + bx / 8 : bx;
    unsigned char* ws = KWS();
    unsigned* ctl = (unsigned*)(ws + WS_CTL);
    for (int u = tid; u < (LDS_BYTES - LDSCTL_OFF) / 4; u += NTHR) ((LAS unsigned*)(lds + LDSCTL_OFF))[u] = 0u;
    __syncthreads();
    XcdBarrier bar; bar.bar = ctl + CW_BAR; bar.x = 0; bar.st = nullptr;
#if !MK_PER_PHASE
    bar = xcd_barrier_post(ctl + CW_BAR, MISC + 8);
#define GRID_BAR() xcd_barrier(bar)
#else
#define GRID_BAR() do { } while (0)
#endif
    const int lo = (int)(unsigned)ka_u64<280>(), hi = (int)(unsigned)(ka_u64<280>() >> 32);
#ifndef PH_MASK
#define PH_MASK 0x1FFF
#endif
#define PHEN(n) (((PH_MASK) >> (n)) & 1)
#define IN(k) (lo <= (k) && (k) < hi)
#define SEAM(k) do { if (rep > 0 || IN((k) + 1)) GRID_BAR(); } while (0)

#define OG opaque_s(G)
#define OBX opaque_s(bx)
#define OVCU opaque_s(vcu)
#define OL opaque_s(l)
    if (PHEN(0) && IN(0)) for (int rep = PHREP(0); rep >= 0; --rep) { prologue_phase(lds, OVCU, OG); SEAM(0); }
    if (PHEN(1) && IN(1)) for (int rep = PHREP(1); rep >= 0; --rep) {
        pg8::DenseOrder S; S.init(KWS() + WS_MEMB, KWS() + WS_WMEM, NB * NMEM, 2048, D, OG, OBX);
        pg8::EpiBf16 E{(bf16*)(KWS() + WS_MKV), 2048};
        pg8::gemm_phase<pg8::EpiBf16, pg8::DenseOrder>(lds, D, S, E);
        SEAM(1);
    }
    for (int l = 0; l < NL; ++l) {
        const int p0 = 2 + l * PH_PER_LAYER;
        if (PHEN(2) && IN(p0 + 0)) for (int rep = PHREP(2); rep >= 0; --rep) {
            pg8::DenseOrder S; S.init(KWS() + WS_XB, KWS() + WS_WIN + (size_t)OL * PINP * D * 2, NTOK, PINP, D, OG, OBX);
            pg8::EpiBf16 E{(bf16*)(KWS() + WS_P), PINP};
            pg8::gemm_phase<pg8::EpiBf16, pg8::DenseOrder>(lds, D, S, E);
            SEAM(p0 + 0);
        }
        if (PHEN(4) && IN(p0 + 1)) for (int rep = PHREP(4); rep >= 0; --rep) { c1_phase(lds, OL, OVCU, OG); SEAM(p0 + 1); }
        if (PHEN(5) && IN(p0 + 2)) for (int rep = PHREP(5); rep >= 0; --rep) { m2_phase(lds, OL, OBX, OG); SEAM(p0 + 2); }
        if (PHEN(6) && IN(p0 + 3)) for (int rep = PHREP(6); rep >= 0; --rep) { m3_gh_phase(OL, OVCU, OG); SEAM(p0 + 3); }
        if (PHEN(7) && IN(p0 + 4)) for (int rep = PHREP(7); rep >= 0; --rep) {
            pg8::DenseOrder S; S.init(KWS() + WS_O, KWS() + WS_WOUT + (size_t)OL * D * D * 2, NTOK, D, D, OG, OBX);
            pg8::EpiBf16 E{(bf16*)(KWS() + WS_HMIX), D};
            pg8::gemm_phase<pg8::EpiBf16, pg8::DenseOrder>(lds, D, S, E);
            SEAM(p0 + 4);
        }
        if (PHEN(8) && IN(p0 + 5)) for (int rep = PHREP(8); rep >= 0; --rep) { ln1_router_phase(lds, OL, OBX, OG); SEAM(p0 + 5); }
        if (PHEN(9) && IN(p0 + 6)) for (int rep = PHREP(9); rep >= 0; --rep) { slots_phase(lds, OBX, OG); SEAM(p0 + 6); }
        if (PHEN(10) && IN(p0 + 7)) for (int rep = PHREP(10); rep >= 0; --rep) {
            const int ntiles = __builtin_amdgcn_readfirstlane(((const int*)(KWS() + WS_CTL))[CW_NT]);
            pg8::MoeOrder<true> S; S.init(KWS() + WS_X1B, KWS() + WS_WGU + (size_t)OL * NE * 2048 * D * 2, (const int*)(KWS() + WS_CTL) + CW_TILEE, (const int*)(KWS() + WS_ROUTE + 3 * MiB), ntiles, 2048, D, OG, OBX);
            pg8::EpiSwiglu E{(bf16*)(KWS() + WS_HB), (const float*)(KWS() + WS_BGU) + (size_t)OL * NE * 2048};
            pg8::gemm_phase<pg8::EpiSwiglu, pg8::MoeOrder<true>>(lds, D, S, E);
            SEAM(p0 + 7);
        }
        if (PHEN(11) && IN(p0 + 8)) for (int rep = PHREP(11); rep >= 0; --rep) {
            const int ntiles = __builtin_amdgcn_readfirstlane(((const int*)(KWS() + WS_CTL))[CW_NT]);
            pg8::MoeOrder<false> S; S.init(KWS() + WS_HB, KWS() + WS_WD + (size_t)OL * NE * D * FF * 2, (const int*)(KWS() + WS_CTL) + CW_TILEE, (const int*)(KWS() + WS_ROUTE + 3 * MiB), ntiles, D, FF, OG, OBX);
            pg8::EpiDown E{(bf16*)(KWS() + WS_YB), KIN(I_BDN) + (size_t)OL * NE * D, (const float*)(KWS() + WS_ROUTE + 3 * MiB + 1536 * 1024)};
            pg8::gemm_phase<pg8::EpiDown, pg8::MoeOrder<false>>(lds, FF, S, E);
            SEAM(p0 + 8);
        }
        if (PHEN(12) && IN(p0 + 9)) for (int rep = PHREP(12); rep >= 0; --rep) { combine_phase(OL, OVCU, OG); if (rep > 0 || l + 1 < NL) SEAM(p0 + 9); }
    }
#undef IN
#undef SEAM
}

extern "C" void kernel_launch(void* const* d_in, const int* in_sizes, int n_in, void* d_out, int out_size, void* d_ws, size_t ws_size, hipStream_t stream) {
    static int grid = 0;
    if (grid == 0) {
        if (n_in != 33 || ws_size < WS_END) { fprintf(stderr, "kernel_launch: unexpected inputs (n_in %d, ws %zu need %zu)\n", n_in, ws_size, (size_t)WS_END); grid = -1; return; }
        int dev = 0, cus = 0;
        if (hipGetDevice(&dev) != hipSuccess || hipDeviceGetAttribute(&cus, hipDeviceAttributeMultiprocessorCount, dev) != hipSuccess) { grid = -1; return; }
        if (hipFuncSetAttribute((const void*)trunk_fwd, hipFuncAttributeMaxDynamicSharedMemorySize, LDS_BYTES) != hipSuccess) { grid = -1; return; }
        int per_cu = 0; (void)hipOccupancyMaxActiveBlocksPerMultiprocessor(&per_cu, (const void*)trunk_fwd, NTHR, LDS_BYTES); (void)hipGetLastError();
        grid = cus;
    }
    if (grid < 0) return;
    (void)hipMemsetAsync((char*)d_ws + WS_CTL, 0, CTL_ZERO_BYTES, stream);
    Args a{};
    for (int i = 0; i < 33; ++i) a.in[i] = (const float*)d_in[i];
    a.out = (float*)d_out; a.ws = (unsigned char*)d_ws;
#if MK_PER_PHASE
    for (int p = 0; p < NPHASES; ++p) { a.ph_lo = p; a.ph_hi = p + 1; hipLaunchKernelGGL(trunk_fwd, dim3(grid), dim3(NTHR), LDS_BYTES, stream, a); }
#else
    a.ph_lo = 0; a.ph_hi = NPHASES;
    hipLaunchKernelGGL(trunk_fwd, dim3(grid), dim3(NTHR), LDS_BYTES, stream, a);
#endif
}
```

```cpp
#include <hip/hip_runtime.h>
#include <cstdio>
#include <cstdint>

#ifndef MK_PER_PHASE
#define MK_PER_PHASE 0
#endif

#ifndef REP_MASK
#define REP_MASK 0
#endif
#define PHREP(n) (((REP_MASK) >> (n)) & 1)
#define LAS __attribute__((address_space(3)))
#define GAS __attribute__((address_space(1)))
typedef unsigned short bf16;
typedef short bf16x8 __attribute__((ext_vector_type(8)));
typedef short s16x4 __attribute__((ext_vector_type(4)));
typedef float f32x4 __attribute__((ext_vector_type(4)));
typedef float f32x2 __attribute__((ext_vector_type(2)));
typedef float f32x16 __attribute__((ext_vector_type(16)));
typedef unsigned u32x4 __attribute__((ext_vector_type(4)));
typedef unsigned u32x2 __attribute__((ext_vector_type(2)));

constexpr int NB = 8, T = 8192, D = 1024, NL = 4, NTOK = NB * T;
constexpr int PIN = 3088, PINP = 3328;
constexpr int NE = 32, FF = 1024, NMEM = 256;
constexpr int NASSIGN = NTOK * 4;
constexpr int MAXTILES = NASSIGN / 256 + NE;
constexpr int MAXSLOTS = MAXTILES * 256;
constexpr int PC_GQ = 0, PC_GK = 128, PC_GV = 256, PC_GOUT = 512, PC_HQ = 768, PC_HF = 1024, PC_HI = 1280, PC_HG = 1536;
constexpr int PC_RW = 1792, PC_MQ = 2816, PC_GLR = 3072;
constexpr float DN_ALPHA = 1.6817928305074292f;
constexpr float LN_EPS = 1e-5f, RMS_EPS = 1e-6f, RW_LN_EPS = 64e-5f;

constexpr size_t MiB = 1u << 20;
constexpr size_t WS_CTL = 0, CTL_ZERO_BYTES = 1 * MiB;
constexpr size_t WS_WIN = 1 * MiB;
constexpr size_t WS_WOUT = WS_WIN + 26 * MiB;
constexpr size_t WS_WMEM = WS_WOUT + 8 * MiB;
constexpr size_t WS_WGU = WS_WMEM + 4 * MiB;
constexpr size_t WS_WD = WS_WGU + 512 * MiB;
constexpr size_t WS_BGU = WS_WD + 256 * MiB;
constexpr size_t WS_LORA = WS_BGU + 1 * MiB;
constexpr size_t WS_MEMB = WS_LORA + 1 * MiB;
constexpr size_t WS_MKV = WS_MEMB + 4 * MiB;
constexpr size_t WS_XB = WS_MKV + 8 * MiB;
constexpr size_t WS_X1B = WS_XB + 128 * MiB;
constexpr size_t WS_XF = WS_X1B + 128 * MiB;
constexpr size_t WS_X1F = WS_XF + 256 * MiB;
constexpr size_t WS_O = WS_X1F + 256 * MiB;
constexpr size_t WS_HMIX = WS_O + 128 * MiB;
constexpr size_t WS_ROUTE = WS_HMIX + 128 * MiB;
constexpr size_t WS_GBUF = WS_ROUTE + 6 * MiB;
constexpr size_t WS_BONUS = WS_GBUF + 32 * MiB;
constexpr size_t WS_BIG = WS_BONUS + 1 * MiB;
constexpr size_t WS_P = WS_BIG;
constexpr size_t WS_ORAW = WS_P + 416 * MiB;
constexpr size_t WS_HB = WS_BIG;
constexpr size_t WS_YB = WS_HB + 528 * MiB;
constexpr size_t WS_CHK = WS_ORAW;
constexpr size_t WS_HQ = WS_CHK, WS_HK = WS_HQ + 32 * MiB, WS_HVT = WS_HK + 32 * MiB, WS_HDS = WS_HVT + 32 * MiB, WS_HS = WS_HDS + 128 * MiB, WS_HBE = WS_HS + 64 * MiB;
constexpr size_t WS_GQ = WS_HBE + 2 * MiB, WS_GK = WS_GQ + 16 * MiB, WS_GVT = WS_GK + 16 * MiB, WS_GDS = WS_GVT + 32 * MiB, WS_GS = WS_GDS + 64 * MiB, WS_GBE = WS_GS + 32 * MiB;
constexpr size_t WS_RR = WS_GBE + 1 * MiB, WS_RB = WS_RR + 32 * MiB, WS_RK = WS_RB + 32 * MiB, WS_RW = WS_RK + 32 * MiB, WS_RVT = WS_RW + 32 * MiB;
constexpr size_t WS_RVG = WS_RVT + 32 * MiB;
constexpr size_t WS_RU = WS_RVG + 32 * MiB, WS_RP = WS_RU + 64 * MiB, WS_RQ = WS_RP + 64 * MiB, WS_RS = WS_RQ + 128 * MiB;
constexpr size_t WS_END = WS_RS + 64 * MiB;
static_assert(WS_YB + 528 * MiB <= WS_END, "overlay");
static_assert(WS_END <= (size_t)4096 * MiB, "workspace");
constexpr int CW_TMO = 0;
constexpr int CW_BAR = 4096;
constexpr int CW_HIST = 16384;
constexpr int CW_NT = 32768;
constexpr int CW_TILEE = 32768 + 64;
constexpr int CW_PADSTART = 40960;

constexpr int RING_BYTES = 131072;
constexpr int LDSCTL_OFF = 162816, MISC_OFF = LDSCTL_OFF + 320;
constexpr int LDS_BYTES = 163840;
constexpr int NWAVES = 8, NTHR = 512;

#define RLX_AGENT __ATOMIC_RELAXED, __HIP_MEMORY_SCOPE_AGENT
#define LDS_WAIT() asm volatile("s_waitcnt lgkmcnt(0)" ::: "memory")
#define VM_WAIT() asm volatile("s_waitcnt vmcnt(0)" ::: "memory")

__device__ __forceinline__ unsigned f2bf(float f) { unsigned u = __builtin_bit_cast(unsigned, f); return (u + 0x7fffu + ((u >> 16) & 1u)) >> 16; }
__device__ __forceinline__ unsigned pk2(float lo, float hi) { return f2bf(lo) | (f2bf(hi) << 16); }
__device__ __forceinline__ float bf2f(unsigned short b) { return __builtin_bit_cast(float, (unsigned)b << 16); }
__device__ __forceinline__ float bflo(unsigned w) { return __builtin_bit_cast(float, w << 16); }
__device__ __forceinline__ float bfhi(unsigned w) { return __builtin_bit_cast(float, w & 0xffff0000u); }
typedef __bf16 bf16x2_t __attribute__((ext_vector_type(2)));
__device__ __forceinline__ unsigned cvt_pk_bf16(float lo, float hi) { const f32x2 v = {lo, hi}; const bf16x2_t b = __builtin_convertvector(v, bf16x2_t); return __builtin_bit_cast(unsigned, b); }
__device__ __forceinline__ float fast_exp(float x) { return __builtin_amdgcn_exp2f(x * 1.4426950408889634f); }
__device__ __forceinline__ float fast_sigmoid(float x) { return __builtin_amdgcn_rcpf(1.0f + fast_exp(-x)); }
__device__ __forceinline__ float silu_f(float x) { return x * fast_sigmoid(x); }
__device__ __forceinline__ int opaque_tid() { int t = threadIdx.x; asm volatile("" : "+v"(t)); return t; }
__device__ __forceinline__ int opaque_s(int v) { asm volatile("" : "+s"(v)); return v; }
__device__ __forceinline__ float wave_sum(float v) {
#pragma unroll
    for (int o = 1; o < 64; o <<= 1) v += __shfl_xor(v, o);
    return v;
}

namespace pg8 {
constexpr int BM = 256, BK = 64, HALF = 128, HTB = HALF * BK * 2, STAGE_BYTES = 8 * HTB, NXCD = 8, WGM = 8;
__host__ __device__ __forceinline__ int lds_byte(int r, int c) { const int st = (r >> 4) * 2 + (c >> 5), rr = r & 15, cc = c & 31, ob = rr * 64 + cc * 2; return st * 1024 + (ob ^ (((ob >> 9) & 1) << 5)); }
__host__ __device__ __forceinline__ void stage_rc(int b, int& R, int& C) { const int st = b / 1024, sb = b % 1024, swz = sb ^ (((sb >> 9) & 1) << 5); R = (st >> 1) * 16 + swz / 64; C = (st & 1) * 32 + (swz % 64) / 2; }
__host__ __device__ __forceinline__ int perm32(int rho) { const int n = rho >> 4, i = rho & 15; return 8 * (i >> 2) + 4 * n + (i & 3); }

struct Unit { int pm, pn, e; const char* A; const char* B; };

__device__ __forceinline__ bool static_tile(int i, int G, int c, int nM, int nN, int& pm, int& pn) {
    const int nwg = nM * nN; const long L = (long)i * G + c; if (L >= nwg) return false;
    int wgid = (int)L; { const int q = nwg / NXCD, r = nwg % NXCD, xcd = wgid % NXCD, off = wgid / NXCD; wgid = (xcd < r ? xcd * (q + 1) : r * (q + 1) + (xcd - r) * q) + off; }
    const int nig = WGM * nN, gid = wgid / nig, fm = gid * WGM, gsz = (nM - fm) < WGM ? (nM - fm) : WGM;
    pm = fm + ((wgid % nig) % gsz); pn = (wgid % nig) / gsz; return true;
}
struct DenseOrder {
    static constexpr bool GATHER = false;
    const char* A; const char* B; int nM, nN, G, c; size_t tstep;
    __device__ __forceinline__ void init(const void* A_, const void* B_, int M, int N, int K, int G_, int c_) { A = (const char*)A_; B = (const char*)B_; nM = M / BM; nN = N / BM; G = G_; c = c_; tstep = (size_t)BM * K * 2; }
    __device__ __forceinline__ bool next(int i, Unit& u) const { if (!static_tile(i, G, c, nM, nN, u.pm, u.pn)) return false; u.e = 0; u.A = A + (size_t)u.pm * tstep; u.B = B + (size_t)u.pn * tstep; return true; }
    __device__ __forceinline__ unsigned row_tok(const Unit&, int) const { return 0; }
};
template <bool GATHER_> struct MoeOrder {
    static constexpr bool GATHER = GATHER_;
    const char* A; const char* B; const int* tile_e; const int* slot_tok; int nM, nN, G, c; size_t tstep, estep;
    __device__ __forceinline__ void init(const void* A_, const void* B_, const int* tile_e_, const int* slot_tok_, int ntiles, int Nper, int K, int G_, int c_) {
        A = (const char*)A_; B = (const char*)B_; tile_e = tile_e_; slot_tok = slot_tok_; nM = ntiles; nN = Nper / BM; G = G_; c = c_; tstep = (size_t)BM * K * 2; estep = (size_t)Nper * K * 2; }
    __device__ __forceinline__ bool next(int i, Unit& u) const { if (!static_tile(i, G, c, nM, nN, u.pm, u.pn)) return false;
        u.e = __builtin_amdgcn_readfirstlane(tile_e[u.pm]); u.A = GATHER_ ? A : A + (size_t)u.pm * tstep; u.B = B + (size_t)u.e * estep + (size_t)u.pn * tstep; return true; }
    __device__ __forceinline__ unsigned row_tok(const Unit& u, int r) const { return (unsigned)slot_tok[u.pm * BM + r]; }
};

struct EpiBf16 {
    static constexpr bool PERM = true;
    bf16* O; int ldc;
    __device__ __forceinline__ void operator()(const f32x4 (&acc)[2][2][4][2], const Unit& u, int wr, int wc, int fr, int fq) const {
        const int row0 = u.pm * BM + wr * 64 + fr, col0 = u.pn * BM + wc * 32 + 8 * fq;
#pragma unroll
        for (int ai = 0; ai < 2; ++ai)
#pragma unroll
            for (int m = 0; m < 4; ++m) { bf16* rowp = O + (size_t)(row0 + ai * HALF + m * 16) * ldc + col0;
#pragma unroll
                for (int bj = 0; bj < 2; ++bj) { const f32x4 v0 = acc[ai][bj][m][0], v1 = acc[ai][bj][m][1];
                    u32x4 w; w.x = cvt_pk_bf16(v0[0], v0[1]); w.y = cvt_pk_bf16(v0[2], v0[3]); w.z = cvt_pk_bf16(v1[0], v1[1]); w.w = cvt_pk_bf16(v1[2], v1[3]);
                    *(u32x4*)(rowp + bj * HALF) = w; } }
    }
};
struct EpiSwiglu {
    static constexpr bool PERM = false;
    bf16* H; const float* bias;
    __device__ __forceinline__ void operator()(const f32x4 (&acc)[2][2][4][2], const Unit& u, int wr, int wc, int fr, int fq) const {
        const int row0 = u.pm * BM + wr * 64 + fr, colh = u.pn * 128 + wc * 32 + 8 * fq;
        const float* bp = bias + (size_t)u.e * 2048 + u.pn * 256 + wc * 32 + 4 * fq;
        f32x4 bv[2][2];
#pragma unroll
        for (int bj = 0; bj < 2; ++bj)
#pragma unroll
            for (int n = 0; n < 2; ++n) bv[bj][n] = *(const f32x4*)(bp + bj * HALF + n * 16);
#pragma unroll
        for (int ai = 0; ai < 2; ++ai)
#pragma unroll
            for (int m = 0; m < 4; ++m) { bf16* rowp = H + (size_t)(row0 + ai * HALF + m * 16) * FF + colh;
                float o[8];
#pragma unroll
                for (int n = 0; n < 2; ++n) { const f32x4 g4 = acc[ai][0][m][n] + bv[0][n], u4 = acc[ai][1][m][n] + bv[1][n];
#pragma unroll
                    for (int j = 0; j < 4; ++j) { const float g = fminf(g4[j], 7.0f), up = fminf(fmaxf(u4[j], -7.0f), 7.0f);
                        const float glu = g * __builtin_amdgcn_rcpf(1.0f + __builtin_amdgcn_exp2f(g * (-1.702f * 1.4426950408889634f)));
                        o[n * 4 + j] = (up + 1.0f) * glu; } }
                u32x4 w; w.x = cvt_pk_bf16(o[0], o[1]); w.y = cvt_pk_bf16(o[2], o[3]); w.z = cvt_pk_bf16(o[4], o[5]); w.w = cvt_pk_bf16(o[6], o[7]);
                *(u32x4*)rowp = w; }
    }
};
struct EpiDown {
    static constexpr bool PERM = true;
    bf16* Y; const float* bias; const float* slot_gate;
    __device__ __forceinline__ void operator()(const f32x4 (&acc)[2][2][4][2], const Unit& u, int wr, int wc, int fr, int fq) const {
        const int row0 = u.pm * BM + wr * 64 + fr, col0 = u.pn * BM + wc * 32 + 8 * fq;
        const float* bp = bias + (size_t)u.e * 1024 + col0;
        f32x4 bv[2][2];
#pragma unroll
        for (int bj = 0; bj < 2; ++bj)
#pragma unroll
            for (int n = 0; n < 2; ++n) bv[bj][n] = *(const f32x4*)(bp + bj * HALF + 4 * n);
#pragma unroll
        for (int ai = 0; ai < 2; ++ai)
#pragma unroll
            for (int m = 0; m < 4; ++m) { const int row = row0 + ai * HALF + m * 16; const float g = slot_gate[row]; bf16* rowp = Y + (size_t)row * D + col0;
#pragma unroll
                for (int bj = 0; bj < 2; ++bj) { const f32x4 v0 = (acc[ai][bj][m][0] + bv[bj][0]) * g, v1 = (acc[ai][bj][m][1] + bv[bj][1]) * g;
                    u32x4 w; w.x = cvt_pk_bf16(v0[0], v0[1]); w.y = cvt_pk_bf16(v0[2], v0[3]); w.z = cvt_pk_bf16(v1[0], v1[1]); w.w = cvt_pk_bf16(v1[2], v1[3]);
                    *(u32x4*)(rowp + bj * HALF) = w; } }
    }
};

template <class Epi, class Sched, bool ALIGN_EPI = true>
__device__ __forceinline__ void gemm_phase(LAS unsigned char* lds, const int K, const Sched& S, const Epi& E) {
    constexpr bool GA = Sched::GATHER;
    const int tid = opaque_tid(), wid = __builtin_amdgcn_readfirstlane(tid >> 6), lane = tid & 63, wr = wid >> 2, wc = wid & 3, fr = lane & 15, fq = lane >> 4;
    const int nt = K / BK;
    unsigned voffA[2], voffB[2]; int Rr[2]; unsigned Cb[2];
#pragma unroll
    for (int i = 0; i < 2; ++i) { int R, C; stage_rc(tid * 16 + i * 8192, R, C); const int Rb = Epi::PERM ? ((R & ~31) + perm32(R & 31)) : R;
        voffA[i] = (unsigned)(R * K + C) * 2u; voffB[i] = (unsigned)(Rb * K + C) * 2u; Rr[i] = R; Cb[i] = (unsigned)C * 2u; }
    const size_t kstep = (size_t)(BK * 2);
    const size_t hstep = (size_t)HALF * K * 2;
    const unsigned ldsw = (unsigned)wid * 1024u;
    const int aoff = lds_byte(wr * 64 + fr, fq * 8), boff = lds_byte(wc * 32 + fr, fq * 8);
    unsigned cOff[2][2], nOff[2][2], sOff[2][2];
#define PG8_SA(b, h) (((b) * 2 + (h)) * HTB)
#define PG8_SB(b, h) ((4 + (b) * 2 + (h)) * HTB)
#define PG8_STAGE(bufoff, gbase, voff) do { _Pragma("unroll") for (int _i = 0; _i < 2; ++_i) \
        __builtin_amdgcn_global_load_lds((const unsigned*)((const char*)(gbase) + (voff)[_i]), (LAS unsigned*)(lds + (bufoff) + ldsw + _i * 8192), 16, 0, 0); } while (0)
#define PG8_STAGE_A(bufoff, gbase, half, OFF) do { if constexpr (GA) { PG8_STAGE(bufoff, gbase, (OFF)[half]); } else { PG8_STAGE(bufoff, (gbase) + (half) * hstep, voffA); } } while (0)
#define PG8_LDA(dst, b, h) do { _Pragma("unroll") for (int m = 0; m < 4; ++m) _Pragma("unroll") for (int k = 0; k < 2; ++k) dst[m][k] = *(const LAS bf16x8*)(lds + PG8_SA(b, h) + aoff + m * 2048 + k * 1024); } while (0)
#define PG8_LDB(dst, b, h) do { _Pragma("unroll") for (int n = 0; n < 2; ++n) _Pragma("unroll") for (int k = 0; k < 2; ++k) dst[n][k] = *(const LAS bf16x8*)(lds + PG8_SB(b, h) + boff + n * 2048 + k * 1024); } while (0)
#define PG8_MMA(ai, bj, At, Bt) do { __builtin_amdgcn_s_setprio(1); _Pragma("unroll") for (int m = 0; m < 4; ++m) _Pragma("unroll") for (int n = 0; n < 2; ++n) _Pragma("unroll") for (int k = 0; k < 2; ++k) \
        acc[ai][bj][m][n] = __builtin_amdgcn_mfma_f32_16x16x32_bf16(Bt[n][k], At[m][k], acc[ai][bj][m][n], 0, 0, 0); __builtin_amdgcn_s_setprio(0); } while (0)
#define PG8_WAIT_V(n) asm volatile("s_waitcnt vmcnt(" #n ")" ::: "memory")
#define PG8_WAIT_L(n) asm volatile("s_waitcnt lgkmcnt(" #n ")" ::: "memory")
#define PG8_BAR __builtin_amdgcn_s_barrier()
#define PG8_SCHED __builtin_amdgcn_sched_barrier(0)
#define PG8_GOFF(dst, u) do { if constexpr (GA) { _Pragma("unroll") for (int _h = 0; _h < 2; ++_h) _Pragma("unroll") for (int _i = 0; _i < 2; ++_i) \
        dst[_h][_i] = S.row_tok(u, _h * HALF + Rr[_i]) * (unsigned)(K * 2) + Cb[_i]; } } while (0)
    Unit cur, nxt; int ui = 0;
    if (!S.next(0, cur)) return;
    f32x4 acc[2][2][4][2];
#pragma unroll
    for (int a = 0; a < 2; ++a)
#pragma unroll
        for (int b = 0; b < 2; ++b)
#pragma unroll
            for (int m = 0; m < 4; ++m)
#pragma unroll
                for (int n = 0; n < 2; ++n) acc[a][b][m][n] = (f32x4){0.f, 0.f, 0.f, 0.f};
    bf16x8 At[4][2], B0[2][2], B1[2][2];
    const char* cA = cur.A; const char* cB = cur.B;
    PG8_GOFF(cOff, cur);
#pragma unroll
    for (int h = 0; h < 2; ++h)
#pragma unroll
        for (int i = 0; i < 2; ++i) { nOff[h][i] = 0u; sOff[h][i] = 0u; }
    if constexpr (GA) { VM_WAIT(); }
    PG8_STAGE(PG8_SB(0, 0), cB, voffB); PG8_STAGE(PG8_SB(0, 1), cB + hstep, voffB); PG8_STAGE_A(PG8_SA(0, 0), cA, 0, cOff); PG8_STAGE_A(PG8_SA(0, 1), cA, 1, cOff);
    if (wr == 1) PG8_BAR;
    PG8_WAIT_V(2); PG8_BAR;
    PG8_STAGE(PG8_SB(1, 0), cB + kstep, voffB); PG8_STAGE_A(PG8_SA(1, 0), cA + kstep, 0, cOff); PG8_STAGE(PG8_SB(1, 1), cB + hstep + kstep, voffB);
    PG8_WAIT_V(6); PG8_BAR;
    for (;;) {
        const bool has_next = S.next(ui + 1, nxt);
        const char* nA = has_next ? nxt.A : cA; const char* nB = has_next ? nxt.B : cB;
        if constexpr (GA) { if (has_next) { PG8_GOFF(nOff, nxt); } else {
#pragma unroll
            for (int h = 0; h < 2; ++h)
#pragma unroll
                for (int i = 0; i < 2; ++i) nOff[h][i] = cOff[h][i]; } }
        for (int t = 0; t < nt; t += 2) {
            const bool last = (t == nt - 2);
            const char* a1 = cA + (size_t)(t + 1) * kstep;
            const char* a2 = last ? nA : cA + (size_t)(t + 2) * kstep; const char* b2 = last ? nB : cB + (size_t)(t + 2) * kstep;
            const char* a3 = a2 + kstep; const char* b3 = b2 + kstep;
            if constexpr (GA) {
#pragma unroll
                for (int h = 0; h < 2; ++h)
#pragma unroll
                    for (int i = 0; i < 2; ++i) sOff[h][i] = last ? nOff[h][i] : cOff[h][i]; }
            PG8_LDB(B0, 0, 0); PG8_LDB(B1, 0, 1); PG8_SCHED; PG8_LDA(At, 0, 0); PG8_STAGE_A(PG8_SA(1, 1), a1, 1, cOff);
            PG8_WAIT_V(8); PG8_WAIT_L(0); PG8_BAR; PG8_MMA(0, 0, At, B0); PG8_MMA(0, 1, At, B1); PG8_BAR; PG8_SCHED;
            PG8_LDA(At, 0, 1); PG8_STAGE(PG8_SB(0, 0), b2, voffB); PG8_STAGE(PG8_SB(0, 1), b2 + hstep, voffB); PG8_STAGE_A(PG8_SA(0, 0), a2, 0, sOff);
            PG8_WAIT_V(8); PG8_WAIT_L(0); PG8_BAR; PG8_MMA(1, 0, At, B0); PG8_MMA(1, 1, At, B1); PG8_BAR; PG8_SCHED;
            PG8_LDB(B0, 1, 0); PG8_LDB(B1, 1, 1); PG8_SCHED; PG8_LDA(At, 1, 0); PG8_STAGE_A(PG8_SA(0, 1), a2, 1, sOff);
            PG8_WAIT_V(8); PG8_WAIT_L(0); PG8_BAR; PG8_MMA(0, 0, At, B0); PG8_MMA(0, 1, At, B1); PG8_BAR; PG8_SCHED;
            PG8_LDA(At, 1, 1); PG8_STAGE(PG8_SB(1, 0), b3, voffB); PG8_STAGE(PG8_SB(1, 1), b3 + hstep, voffB); PG8_STAGE_A(PG8_SA(1, 0), a3, 0, sOff);
            PG8_WAIT_V(8); PG8_WAIT_L(0); PG8_BAR; PG8_MMA(1, 0, At, B0); PG8_MMA(1, 1, At, B1); PG8_BAR; PG8_SCHED;
        }
        if constexpr (ALIGN_EPI) { if (wr == 0) PG8_BAR; }
        E(acc, cur, wr, wc, fr, fq);
        if (!has_next) break;
#pragma unroll
        for (int a = 0; a < 2; ++a)
#pragma unroll
            for (int b = 0; b < 2; ++b)
#pragma unroll
                for (int m = 0; m < 4; ++m)
#pragma unroll
                    for (int n = 0; n < 2; ++n) acc[a][b][m][n] = (f32x4){0.f, 0.f, 0.f, 0.f};
        cur = nxt; cA = nA; cB = nB; ++ui;
        if constexpr (GA) {
#pragma unroll
            for (int h = 0; h < 2; ++h)
#pragma unroll
                for (int i = 0; i < 2; ++i) cOff[h][i] = nOff[h][i]; }
        if constexpr (ALIGN_EPI) { if (wr == 1) PG8_BAR; }
    }
    PG8_WAIT_V(0);
    if constexpr (!ALIGN_EPI) { if (wr == 0) PG8_BAR; }
    PG8_BAR;
#undef PG8_SA
#undef PG8_SB
#undef PG8_STAGE
#undef PG8_STAGE_A
#undef PG8_LDA
#undef PG8_LDB
#undef PG8_MMA
#undef PG8_WAIT_V
#undef PG8_WAIT_L
#undef PG8_BAR
#undef PG8_SCHED
#undef PG8_GOFF
}
}

#define XB_TMO      128
#define XB_XCNT(j)  (256  + 64 * (j))
#define XB_XSUB(j)  (1280 + 64 * (j))
#define XB_XGEN(j)  (2304 + 64 * (j))
#define XB_TOP      3328
#define XB_TOPGEN   3392
#define XCD_BAR_WORDS 3456
#define XB_SPIN_CAP (1u << 18)
__device__ __forceinline__ unsigned xb_ld(unsigned* p)              { return __hip_atomic_load(p, __ATOMIC_RELAXED, __HIP_MEMORY_SCOPE_AGENT); }
__device__ __forceinline__ unsigned xb_add(unsigned* p, unsigned v) { return __hip_atomic_fetch_add(p, v, __ATOMIC_RELAXED, __HIP_MEMORY_SCOPE_AGENT); }
__device__ __forceinline__ unsigned xb_xcc_id() { return (unsigned)__builtin_amdgcn_s_getreg((3 << 11) | 20) & 0xFu; }
#define XB_SPIN(cond, bar) do { unsigned _sp = 0; while (cond) { __builtin_amdgcn_s_sleep(1); \
    if ((++_sp & 255u) == 0u) { if (xb_ld(&(bar)[XB_TMO])) break; if (_sp > XB_SPIN_CAP) { atomicAdd(&(bar)[XB_TMO], 1u); break; } } } } while (0)
struct XcdBarrier { unsigned* bar; unsigned x; volatile LAS unsigned* st; };
__device__ __forceinline__ XcdBarrier xcd_barrier_post(unsigned* bar, volatile LAS unsigned* st) {
    XcdBarrier b; b.bar = bar; b.x = xb_xcc_id(); b.st = st;
    if (threadIdx.x == 0) (void)xb_add(&bar[XB_XCNT(b.x)], 1u);
    return b;
}
__device__ __forceinline__ void xcd_barrier_complete(unsigned* bar, unsigned x, unsigned& nloc, unsigned& nx) {
    const unsigned G = gridDim.x * gridDim.y * gridDim.z;
    unsigned sum, cnt, mine, sp = 0u;
    for (;;) {
        sum = 0u; cnt = 0u; mine = 0u;
#pragma unroll
        for (unsigned j = 0; j < 16; ++j) { const unsigned c = xb_ld(&bar[XB_XCNT(j)]); sum += c; cnt += (c > 0u) ? 1u : 0u; mine = (j == x) ? c : mine; }
        if (sum == G) break;
        __builtin_amdgcn_s_sleep(1);
        if ((++sp & 255u) == 0u) { if (xb_ld(&bar[XB_TMO])) break; if (sp > XB_SPIN_CAP) { atomicAdd(&bar[XB_TMO], 1u); break; } }
    }
    nloc = mine > 0u ? mine : 1u; nx = cnt > 0u ? cnt : 1u;
}
__device__ __forceinline__ void xcd_barrier(const XcdBarrier& b) {
    asm volatile("s_waitcnt vmcnt(0)" ::: "memory");
    __syncthreads();
    if (threadIdx.x == 0) {
        unsigned* bar = b.bar;
        __builtin_amdgcn_s_waitcnt(0);
        unsigned nloc = b.st[0], nx = b.st[1];
        if (nloc == 0u) { xcd_barrier_complete(bar, b.x, nloc, nx); b.st[0] = nloc; b.st[1] = nx; }
        const unsigned old = xb_add(&bar[XB_XSUB(b.x)], 1u);
        const unsigned gen = old / nloc;
        if (old + 1u == (gen + 1u) * nloc) {
            __builtin_amdgcn_fence(__ATOMIC_RELEASE, "agent");
            asm volatile("s_waitcnt vmcnt(0)" ::: "memory");
            const unsigned og = xb_add(&bar[XB_TOP], 1u);
            const unsigned tg = og / nx;
            if (og + 1u == (tg + 1u) * nx) xb_add(&bar[XB_TOPGEN], 1u);
            else XB_SPIN(xb_ld(&bar[XB_TOPGEN]) == tg, bar);
            __builtin_amdgcn_fence(__ATOMIC_ACQUIRE, "agent");
            xb_add(&bar[XB_XGEN(b.x)], 1u);
            asm volatile("s_waitcnt vmcnt(0)" ::: "memory");
        } else {
            XB_SPIN(xb_ld(&bar[XB_XGEN(b.x)]) == gen, bar);
            __builtin_amdgcn_fence(__ATOMIC_ACQUIRE, "agent");
            asm volatile("s_waitcnt vmcnt(0)" ::: "memory");
        }
    }
    __syncthreads();
}

struct Args {
    const float* in[33];
    float* out; unsigned char* ws;
    int ph_lo, ph_hi;
};
enum { I_X = 0, I_MEM, I_WIN, I_GLACONV, I_GLAW2, I_GLAB, I_GLANG, I_HGLB, I_HGNG, I_RWMU, I_RWW0, I_RWW2, I_RWA0, I_RWA2, I_RWG2, I_RWKK, I_RWKA, I_RWRK, I_RWLNW, I_RWLNB,
       I_WMK, I_WMV, I_WOUT, I_LN1G, I_LN1B, I_RTW, I_RTB, I_WGU, I_BGU, I_WDN, I_BDN, I_LN2G, I_LN2B };


template <int OFF> __device__ __forceinline__ unsigned long long ka_u64() { unsigned long long v; asm volatile("s_load_dwordx2 %0, %1, %2\n\ts_waitcnt lgkmcnt(0)" : "=s"(v) : "s"(__builtin_amdgcn_kernarg_segment_ptr()), "n"(OFF)); return v; }
#define KIN(i) ((const float*)(const GAS float*)ka_u64<8 * (i)>())
#define KOUT() ((float*)(GAS float*)ka_u64<264>())
#define KWS() ((unsigned char*)(GAS unsigned char*)ka_u64<272>())

template <class Map>
__device__ __forceinline__ void tr_item(const float* __restrict__ W, int K, int N, bf16* __restrict__ WT, LAS float* scr, int kb, int nb, int lane, Map map) {
    const int k0 = 64 * kb, n0 = 64 * nb, col = n0 + lane; const bool valid = col < N;
    const float* src = W + (size_t)k0 * N + (valid ? col : 0);
#pragma unroll 16
    for (int kk = 0; kk < 64; ++kk) { const float v = valid ? src[(size_t)kk * N] : 0.f; scr[kk * 65 + lane] = v; }
    LDS_WAIT(); asm volatile("" ::: "memory");
    const int c = lane & 7;
#pragma unroll
    for (int j = 0; j < 8; ++j) { const int n = (lane >> 3) + 8 * j;
        if (n0 + n < N) { const int orow = map(n0 + n); const LAS float* s = scr + (8 * c) * 65 + n;
            u32x4 o; o.x = pk2(s[0 * 65], s[1 * 65]); o.y = pk2(s[2 * 65], s[3 * 65]); o.z = pk2(s[4 * 65], s[5 * 65]); o.w = pk2(s[6 * 65], s[7 * 65]);
            *(u32x4*)(WT + (size_t)orow * K + k0 + 8 * c) = o; } }
    LDS_WAIT(); asm volatile("" ::: "memory");
}
struct MapIdent { int off; __device__ __forceinline__ int operator()(int c) const { return c + off; } };
struct MapWin { __device__ __forceinline__ int operator()(int c) const { return c < 512 ? c : (c < 528 ? c + 2560 : c - 16); } };
__device__ __forceinline__ int gu_row(int c) { const int f = c >> 1, bj = c & 1, pn = f >> 7, fl = f & 127, wc = fl >> 5, fq = (fl >> 3) & 3, n = (fl >> 2) & 1, j = fl & 3; return 256 * pn + 128 * bj + 32 * wc + 16 * n + 4 * fq + j; }
struct MapGu { __device__ __forceinline__ int operator()(int c) const { return gu_row(c); } };

__device__ __forceinline__ void prologue_phase(LAS unsigned char* lds, int vcu, int G) {
    const int tid = opaque_tid(), lane = tid & 63, wave = __builtin_amdgcn_readfirstlane(tid >> 6);
    LAS float* scr = (LAS float*)(lds + wave * 16640); static_assert(8 * 16640 <= LDSCTL_OFF, "prologue scratch below the LDS control words");
    const int gw = vcu * NWAVES + wave, NGW = G * NWAVES;
    unsigned char* ws = KWS();
    constexpr int IT_GU = NL * NE * 512, IT_DN = NL * NE * 256, IT_IN = NL * 16 * 49, IT_OUT = NL * 256, IT_MEM = NL * 2 * 64, IT_L64 = NL * 2 * 4, IT_L128 = NL * 2 * 4;
    constexpr int IT_TOTAL = IT_GU + IT_DN + IT_IN + IT_OUT + IT_MEM + IT_L64 + IT_L128;
    for (int it = gw; it < IT_TOTAL; it += NGW) {
        int r = it;
        if (r < IT_GU) { const int le = r >> 9, q = r & 511, kb = q >> 5, nb = q & 31;
            tr_item(KIN(I_WGU) + (size_t)le * 1024 * 2048, 1024, 2048, (bf16*)(ws + WS_WGU) + (size_t)le * 2048 * 1024, scr, kb, nb, lane, MapGu{}); continue; } r -= IT_GU;
        if (r < IT_DN) { const int le = r >> 8, q = r & 255, kb = q >> 4, nb = q & 15;
            tr_item(KIN(I_WDN) + (size_t)le * 1024 * 1024, 1024, 1024, (bf16*)(ws + WS_WD) + (size_t)le * 1024 * 1024, scr, kb, nb, lane, MapIdent{0}); continue; } r -= IT_DN;
        if (r < IT_IN) { const int l = r / (16 * 49), q = r % (16 * 49), kb = q / 49, nb = q % 49;
            tr_item(KIN(I_WIN) + (size_t)l * 1024 * PIN, 1024, PIN, (bf16*)(ws + WS_WIN) + (size_t)l * PINP * 1024, scr, kb, nb, lane, MapWin{}); continue; } r -= IT_IN;
        if (r < IT_OUT) { const int l = r >> 8, q = r & 255, kb = q >> 4, nb = q & 15;
            tr_item(KIN(I_WOUT) + (size_t)l * 1024 * 1024, 1024, 1024, (bf16*)(ws + WS_WOUT) + (size_t)l * 1024 * 1024, scr, kb, nb, lane, MapIdent{0}); continue; } r -= IT_OUT;
        if (r < IT_MEM) { const int l = r >> 7, q = r & 127, kv = q >> 6, kb = (q >> 2) & 15, nb = q & 3;
            tr_item((kv ? KIN(I_WMV) : KIN(I_WMK)) + (size_t)l * 1024 * 256, 1024, 256, (bf16*)(ws + WS_WMEM), scr, kb, nb, lane, MapIdent{l * 512 + kv * 256}); continue; } r -= IT_MEM;
        if (r < IT_L64) { const int l = r >> 3, q = r & 7, wa = q >> 2, nb = q & 3;
            tr_item((wa ? KIN(I_RWA2) : KIN(I_RWW2)) + (size_t)l * 64 * 256, 64, 256, (bf16*)(ws + WS_LORA) + (size_t)wa * (NL * 256 * 64) + (size_t)l * 256 * 64, scr, 0, nb, lane, MapIdent{0}); continue; } r -= IT_L64;
        { const int l = r >> 3, q = r & 7, kb = q >> 2, nb = q & 3;
            tr_item(KIN(I_RWG2) + (size_t)l * 128 * 256, 128, 256, (bf16*)(ws + WS_LORA) + (size_t)2 * (NL * 256 * 64) + (size_t)l * 256 * 128, scr, kb, nb, lane, MapIdent{0}); }
    }
    { const size_t gt = (size_t)vcu * NTHR + tid, GT = (size_t)G * NTHR; constexpr size_t per = (size_t)(PINP - PIN) * 1024 / 8;
        for (size_t i = gt; i < per * NL; i += GT) { const size_t l = i / per, j = i % per; *(u32x4*)((bf16*)(ws + WS_WIN) + l * PINP * 1024 + (size_t)PIN * 1024 + j * 8) = (u32x4){0u, 0u, 0u, 0u}; }
        for (size_t i = gt; i < (size_t)NL * NE * 2048; i += GT) { const size_t le = i >> 11; const int c = (int)(i & 2047); ((float*)(ws + WS_BGU))[le * 2048 + gu_row(c)] = KIN(I_BGU)[i]; }
        const f32x4* xs = (const f32x4*)KIN(I_X); u32x4* xd = (u32x4*)(ws + WS_XB);
        for (size_t i = gt; i < (size_t)NTOK * D / 8; i += GT) { const f32x4 v0 = xs[2 * i], v1 = xs[2 * i + 1]; xd[i] = (u32x4){pk2(v0[0], v0[1]), pk2(v0[2], v0[3]), pk2(v1[0], v1[1]), pk2(v1[2], v1[3])}; }
        const f32x4* ms = (const f32x4*)KIN(I_MEM); u32x4* md = (u32x4*)(ws + WS_MEMB);
        for (size_t i = gt; i < (size_t)NB * NMEM * D / 8; i += GT) { const f32x4 v0 = ms[2 * i], v1 = ms[2 * i + 1]; md[i] = (u32x4){pk2(v0[0], v0[1]), pk2(v0[2], v0[3]), pk2(v1[0], v1[1]), pk2(v1[2], v1[3])}; }
    }
}


__device__ __forceinline__ float log1pexp_neg_abs(float z) { return __builtin_amdgcn_logf(1.0f + fast_exp(-fabsf(z))) * 0.6931471805599453f; }
__device__ __forceinline__ float tanh_f(float x) { const float e = fast_exp(-2.0f * fabsf(x)); const float t = (1.0f - e) * __builtin_amdgcn_rcpf(1.0f + e); return x < 0.f ? -t : t; }

constexpr int NCH = T / 32;
__device__ __forceinline__ int rho16(int r, int hh) { return (r & 3) + 8 * (r >> 2) + 4 * hh; }
__device__ __forceinline__ void hg_fused_unit(LAS unsigned char* lds, int l, int b, int c) {
    const int tid = opaque_tid(), lane = tid & 63, wave = __builtin_amdgcn_readfirstlane(tid >> 6), r32 = lane & 31, hh = lane >> 5;
    unsigned char* ws = KWS();
    const bf16* P = (const bf16*)(ws + WS_P) + ((size_t)b * T + c * 32) * PINP;
    constexpr int HB = 8448;
    if (tid < 256) {
        const int ch = tid, h = ch >> 6, d = ch & 63; const size_t un = (size_t)(b * 4 + h) * NCH + c;
        float lb;
        { const float* hp = KIN(I_HGLB) + ch; const float v0 = hp[0], v1 = hp[256], v2 = hp[512], v3 = hp[768]; const float m = fmaxf(fmaxf(v0, v1), fmaxf(v2, v3));
          const float e0 = __expf(v0 - m), e1 = __expf(v1 - m), e2 = __expf(v2 - m), e3 = __expf(v3 - m); const float inv = 1.0f / (e0 + e1 + e2 + e3);
          lb = (l >= 1 ? e1 : 0.f) + (l >= 2 ? e2 : 0.f) + (l >= 3 ? e3 : 0.f); lb *= inv; }
        const float oml = 1.0f - lb;
        LAS bf16* KT = (LAS bf16*)(lds + h * HB); LAS float* BE = (LAS float*)(lds + h * HB + 8192);
        bf16* Qg = (bf16*)(ws + WS_HQ) + un * 2048 + d; bf16* Kg = (bf16*)(ws + WS_HK) + un * 2048 + d;
        float bc = 0.f;
        unsigned short hqr[32], hfr[32];
#pragma unroll
        for (int t = 0; t < 32; ++t) { const bf16* row = P + (size_t)t * PINP; hqr[t] = row[PC_HQ + ch]; hfr[t] = row[PC_HF + ch]; }
#pragma unroll
        for (int t8 = 0; t8 < 4; ++t8) { u32x4 kp;
#pragma unroll
            for (int jj = 0; jj < 4; ++jj) { float k2[2];
#pragma unroll
                for (int e = 0; e < 2; ++e) { const int t = t8 * 8 + jj * 2 + e; const float hf = bf2f(hfr[t]); const float s = fast_sigmoid(hf), sn = fast_sigmoid(-hf);
                    bc = fmaxf(bc + __builtin_amdgcn_logf(fmaxf(lb + oml * s, 1e-30f)) * 0.6931471805599453f, -80.0f);
                    const float qt = silu_f(bf2f(hqr[t])) * fast_exp(bc), kt = oml * sn * fast_exp(-bc);
                    Qg[t * 64] = (bf16)f2bf(qt); Kg[t * 64] = (bf16)f2bf(kt); k2[e] = kt; }
                kp[jj] = pk2(k2[0], k2[1]); }
            *(LAS u32x4*)(KT + d * 32 + t8 * 8) = kp; }
        const float ebend = fast_exp(bc); BE[d] = ebend; ((float*)(ws + WS_HBE))[un * 64 + d] = ebend;
    } else {
        const int cv = tid - 256, h = cv >> 6, vi = cv & 63; const size_t un = (size_t)(b * 4 + h) * NCH + c;
        LAS bf16* VT = (LAS bf16*)(lds + h * HB + 4096); bf16* VTg = (bf16*)(ws + WS_HVT) + un * 2048 + vi * 32;
        unsigned short hvr[32];
#pragma unroll
        for (int t = 0; t < 32; ++t) hvr[t] = P[(size_t)t * PINP + PC_HI + cv];
#pragma unroll
        for (int t8 = 0; t8 < 4; ++t8) { u32x4 vp;
#pragma unroll
            for (int jj = 0; jj < 4; ++jj) vp[jj] = (unsigned)hvr[t8 * 8 + 2 * jj] | ((unsigned)hvr[t8 * 8 + 2 * jj + 1] << 16);
            *(LAS u32x4*)(VT + vi * 32 + t8 * 8) = vp; *(u32x4*)(VTg + t8 * 8) = vp; }
    }
    __syncthreads();
    { const int h = wave >> 1, vt = wave & 1; const size_t un = (size_t)(b * 4 + h) * NCH + c;
      const LAS bf16* KT = (const LAS bf16*)(lds + h * HB); const LAS bf16* VT = (const LAS bf16*)(lds + h * HB + 4096); const LAS float* BE = (const LAS float*)(lds + h * HB + 8192);
      float* DSg = (float*)(ws + WS_HDS) + un * 4096;
#pragma unroll
      for (int dt = 0; dt < 2; ++dt) { f32x16 acc;
#pragma unroll
          for (int i = 0; i < 16; ++i) acc[i] = 0.f;
#pragma unroll
          for (int s = 0; s < 2; ++s) { const bf16x8 A = *(const LAS bf16x8*)(VT + (32 * vt + r32) * 32 + 16 * s + 8 * hh), B = *(const LAS bf16x8*)(KT + (32 * dt + r32) * 32 + 16 * s + 8 * hh);
              acc = __builtin_amdgcn_mfma_f32_32x32x16_bf16(A, B, acc, 0, 0, 0); }
          const float ebd = BE[32 * dt + r32];
#pragma unroll
          for (int r = 0; r < 16; ++r) DSg[(32 * vt + rho16(r, hh)) * 64 + 32 * dt + r32] = acc[r] * ebd; } }
    __syncthreads();
}
__device__ __forceinline__ void gla_fused_unit(LAS unsigned char* lds, int l, int b, int c) {
    const int tid = opaque_tid(), lane = tid & 63, wave = __builtin_amdgcn_readfirstlane(tid >> 6), r32 = lane & 31, hh = lane >> 5;
    unsigned char* ws = KWS();
    const int t0 = c * 32;
    const bf16* P = (const bf16*)(ws + WS_P) + ((size_t)b * T + t0) * PINP;
    LAS float* GL = (LAS float*)lds;
    constexpr int HB = 6272, H0 = 2048;
    GL[tid] = bf2f(P[(size_t)(tid >> 4) * PINP + PC_GLR + (tid & 15)]);
    __syncthreads();
    if (tid < 128) {
        const int ch = tid, h = ch >> 5, d = ch & 31; const size_t un = (size_t)(b * 4 + h) * NCH + c;
        const float* cw = KIN(I_GLACONV) + (size_t)l * 4 * 512 + ch;
        const float q0 = cw[0], q1 = cw[512], q2 = cw[1024], q3 = cw[1536], k0 = cw[128], k1 = cw[640], k2w = cw[1152], k3 = cw[1664];
        const float* w2p = KIN(I_GLAW2) + (size_t)l * 16 * 128 + ch; float wc[16];
#pragma unroll
        for (int r = 0; r < 16; ++r) wc[r] = w2p[r * 128];
        const float gb = KIN(I_GLAB)[l * 128 + ch];
        float uq0 = 0.f, uq1 = 0.f, uq2 = 0.f, uk0 = 0.f, uk1 = 0.f, uk2 = 0.f;
        if (t0 > 0) { uq0 = bf2f(*(P - 3 * PINP + PC_GQ + ch)); uq1 = bf2f(*(P - 2 * PINP + PC_GQ + ch)); uq2 = bf2f(*(P - PINP + PC_GQ + ch));
                      uk0 = bf2f(*(P - 3 * PINP + PC_GK + ch)); uk1 = bf2f(*(P - 2 * PINP + PC_GK + ch)); uk2 = bf2f(*(P - PINP + PC_GK + ch)); }
        LAS bf16* KT = (LAS bf16*)(lds + H0 + h * HB); LAS float* BE = (LAS float*)(lds + H0 + h * HB + 6144);
        bf16* Qg = (bf16*)(ws + WS_GQ) + un * 1024 + d; bf16* Kg = (bf16*)(ws + WS_GK) + un * 1024 + d;
        float bc = 0.f;
        unsigned short xqr[32], xkr[32];
#pragma unroll
        for (int t = 0; t < 32; ++t) { const bf16* row = P + (size_t)t * PINP; xqr[t] = row[PC_GQ + ch]; xkr[t] = row[PC_GK + ch]; }
#pragma unroll
        for (int t8 = 0; t8 < 4; ++t8) { u32x4 kp;
#pragma unroll
            for (int jj = 0; jj < 4; ++jj) { float kk2[2];
#pragma unroll
                for (int e = 0; e < 2; ++e) { const int t = t8 * 8 + jj * 2 + e; const float uq3 = bf2f(xqr[t]), uk3 = bf2f(xkr[t]);
                    const float q = silu_f(q0 * uq0 + q1 * uq1 + q2 * uq2 + q3 * uq3) * 0.17677669529663687f, k = silu_f(k0 * uk0 + k1 * uk1 + k2w * uk2 + k3 * uk3);
                    uq0 = uq1; uq1 = uq2; uq2 = uq3; uk0 = uk1; uk1 = uk2; uk2 = uk3;
                    float z = gb;
#pragma unroll
                    for (int r = 0; r < 16; ++r) z += GL[t * 16 + r] * wc[r];
                    bc = fmaxf(bc + (fminf(z, 0.f) - log1pexp_neg_abs(z)) * 0.0625f, -80.0f);
                    const float qt = q * fast_exp(bc), kt = k * fast_exp(-bc);
                    Qg[t * 32] = (bf16)f2bf(qt); Kg[t * 32] = (bf16)f2bf(kt); kk2[e] = kt; }
                kp[jj] = pk2(kk2[0], kk2[1]); }
            *(LAS u32x4*)(KT + d * 32 + t8 * 8) = kp; }
        const float ebend = fast_exp(bc); BE[d] = ebend; ((float*)(ws + WS_GBE))[un * 32 + d] = ebend;
    } else if (tid < 384) {
        const int cv = tid - 128, h = cv >> 6, vi = cv & 63; const size_t un = (size_t)(b * 4 + h) * NCH + c;
        const float* cw = KIN(I_GLACONV) + (size_t)l * 4 * 512 + 256 + cv;
        const float w0 = cw[0], w1 = cw[512], w2 = cw[1024], w3 = cw[1536];
        float u0 = 0.f, u1 = 0.f, u2 = 0.f;
        if (t0 > 0) { u0 = bf2f(*(P - 3 * PINP + PC_GV + cv)); u1 = bf2f(*(P - 2 * PINP + PC_GV + cv)); u2 = bf2f(*(P - PINP + PC_GV + cv)); }
        LAS bf16* VT = (LAS bf16*)(lds + H0 + h * HB + 2048); bf16* VTg = (bf16*)(ws + WS_GVT) + un * 2048 + vi * 32;
        unsigned short xvr[32];
#pragma unroll
        for (int t = 0; t < 32; ++t) xvr[t] = P[(size_t)t * PINP + PC_GV + cv];
#pragma unroll
        for (int t8 = 0; t8 < 4; ++t8) { u32x4 vp; float yv[8];
#pragma unroll
            for (int e = 0; e < 8; ++e) { const float u3 = bf2f(xvr[t8 * 8 + e]); yv[e] = silu_f(w0 * u0 + w1 * u1 + w2 * u2 + w3 * u3); u0 = u1; u1 = u2; u2 = u3; }
#pragma unroll
            for (int jj = 0; jj < 4; ++jj) vp[jj] = pk2(yv[2 * jj], yv[2 * jj + 1]);
            *(LAS u32x4*)(VT + vi * 32 + t8 * 8) = vp; *(u32x4*)(VTg + t8 * 8) = vp; }
    }
    __syncthreads();
    { const int h = wave >> 1, vt = wave & 1; const size_t un = (size_t)(b * 4 + h) * NCH + c;
      const LAS bf16* KT = (const LAS bf16*)(lds + H0 + h * HB); const LAS bf16* VT = (const LAS bf16*)(lds + H0 + h * HB + 2048); const LAS float* BE = (const LAS float*)(lds + H0 + h * HB + 6144);
      float* DSg = (float*)(ws + WS_GDS) + un * 2048;
      f32x16 acc;
#pragma unroll
      for (int i = 0; i < 16; ++i) acc[i] = 0.f;
#pragma unroll
      for (int s = 0; s < 2; ++s) { const bf16x8 A = *(const LAS bf16x8*)(VT + (32 * vt + r32) * 32 + 16 * s + 8 * hh), B = *(const LAS bf16x8*)(KT + r32 * 32 + 16 * s + 8 * hh);
          acc = __builtin_amdgcn_mfma_f32_32x32x16_bf16(A, B, acc, 0, 0, 0); }
      const float ebd = BE[r32];
#pragma unroll
      for (int r = 0; r < 16; ++r) DSg[(32 * vt + rho16(r, hh)) * 32 + r32] = acc[r] * ebd; }
    __syncthreads();
}
template <int DK>
__device__ __forceinline__ void m2_gh_elem2(int e2, const float* __restrict__ DS, const float* __restrict__ BE, bf16* __restrict__ SG) {
    constexpr int EPB = 64 * DK; const int e = e2 * 2, bh = e / EPB, idx = e % EPB, d = idx % DK; const size_t un0 = (size_t)bh * NCH;
    float S0 = 0.f, S1 = 0.f;
#pragma unroll 1
    for (int c0 = 0; c0 < NCH; c0 += 16) { f32x2 ds[16], be[16];
#pragma unroll
        for (int u = 0; u < 16; ++u) { ds[u] = *(const f32x2*)(DS + (un0 + c0 + u) * EPB + idx); be[u] = *(const f32x2*)(BE + (un0 + c0 + u) * DK + d); }
#pragma unroll
        for (int u = 0; u < 16; ++u) { *(unsigned*)(SG + (un0 + c0 + u) * EPB + idx) = pk2(S0, S1); S0 = S0 * be[u][0] + ds[u][0]; S1 = S1 * be[u][1] + ds[u][1]; } }
}
template <int DK>
__device__ __forceinline__ void m3_gh_task(int lane, const bf16* __restrict__ Qg, const bf16* __restrict__ Kg, const bf16* __restrict__ VTg, const bf16* __restrict__ Sg,
                                           const bf16* __restrict__ gate  , const float* __restrict__ ng  , bf16* __restrict__ orow  ) {
    const int r32 = lane & 31, hh = lane >> 5;
    bf16x8 qf[DK / 16];
    f32x16 at;
#pragma unroll
    for (int i = 0; i < 16; ++i) at[i] = 0.f;
#pragma unroll
    for (int s = 0; s < DK / 16; ++s) { qf[s] = *(const bf16x8*)(Qg + r32 * DK + 16 * s + 8 * hh); const bf16x8 kf = *(const bf16x8*)(Kg + r32 * DK + 16 * s + 8 * hh);
        at = __builtin_amdgcn_mfma_f32_32x32x16_bf16(kf, qf[s], at, 0, 0, 0); }
#pragma unroll
    for (int r = 0; r < 16; ++r) if (rho16(r, hh) > r32) at[r] = 0.f;
    f32x16 o[2];
#pragma unroll
    for (int vt = 0; vt < 2; ++vt)
#pragma unroll
        for (int i = 0; i < 16; ++i) o[vt][i] = 0.f;
#pragma unroll
    for (int s = 0; s < 2; ++s) { union { bf16x8 v; unsigned w[4]; } pf;
#pragma unroll
        for (int j = 0; j < 4; ++j) pf.w[j] = cvt_pk_bf16(at[8 * s + 2 * j], at[8 * s + 2 * j + 1]);
#pragma unroll
        for (int vt = 0; vt < 2; ++vt) { const bf16* vp = VTg + (32 * vt + r32) * 32 + 16 * s + 4 * hh;
            union { bf16x8 v; s16x4 h2[2]; } vf; vf.h2[0] = *(const s16x4*)vp; vf.h2[1] = *(const s16x4*)(vp + 8);
            o[vt] = __builtin_amdgcn_mfma_f32_32x32x16_bf16(vf.v, pf.v, o[vt], 0, 0, 0); } }
#pragma unroll
    for (int vt = 0; vt < 2; ++vt)
#pragma unroll
        for (int s = 0; s < DK / 16; ++s) { const bf16x8 sf = *(const bf16x8*)(Sg + (32 * vt + r32) * DK + 16 * s + 8 * hh);
            o[vt] = __builtin_amdgcn_mfma_f32_32x32x16_bf16(sf, qf[s], o[vt], 0, 0, 0); }
    float ss = 0.f;
#pragma unroll
    for (int vt = 0; vt < 2; ++vt)
#pragma unroll
        for (int i = 0; i < 16; ++i) ss += o[vt][i] * o[vt][i];
    ss += __shfl_xor(ss, 32);
    const float rstd = 1.0f / sqrtf(ss * (1.0f / 64.0f) + RMS_EPS);
    const bf16* grow = gate + (size_t)r32 * PINP; bf16* od = orow + (size_t)r32 * D;
#pragma unroll
    for (int vt = 0; vt < 2; ++vt)
#pragma unroll
        for (int g = 0; g < 4; ++g) { const int v0 = 32 * vt + 8 * g + 4 * hh; const u32x2 gw = *(const u32x2*)(grow + v0); const f32x4 n4 = *(const f32x4*)(ng + v0);
            const float y0 = o[vt][4 * g] * rstd * n4[0] * silu_f(bflo(gw.x)), y1 = o[vt][4 * g + 1] * rstd * n4[1] * silu_f(bfhi(gw.x));
            const float y2 = o[vt][4 * g + 2] * rstd * n4[2] * silu_f(bflo(gw.y)), y3 = o[vt][4 * g + 3] * rstd * n4[3] * silu_f(bfhi(gw.y));
            *(u32x2*)(od + v0) = (u32x2){pk2(y0, y1), pk2(y2, y3)}; }
}

constexpr int RWC_HEADB = 28928;
constexpr int RWC_AL = 4 * RWC_HEADB, RWC_LWL = RWC_AL + 32 * 264 * 2;
static_assert(RWC_LWL + 32 * 264 * 2 <= LDSCTL_OFF, "rw_fused_unit LDS");
__device__ __forceinline__ void rw_fused_unit(LAS unsigned char* lds, int l, int b, int c) {
    const int tid = opaque_tid(), lane = tid & 63, wave = __builtin_amdgcn_readfirstlane(tid >> 6), h = wave >> 1, p = wave & 1, r32 = lane & 31, hh = lane >> 5;
    unsigned char* ws = KWS();
    const int bh = b * 4 + h; const size_t un = (size_t)bh * NCH + c;
    const int t0 = c * 32;
    const bf16* P = (const bf16*)(ws + WS_P) + ((size_t)b * T + t0) * PINP + PC_RW;
    const float* mu = KIN(I_RWMU) + (size_t)l * 1024;
    LAS bf16* XL = (LAS bf16*)lds;
    LAS bf16* AL = (LAS bf16*)(lds + RWC_AL);
    LAS bf16* LWL = (LAS bf16*)(lds + RWC_LWL);
    for (int i = tid; i < 32 * 256; i += NTHR) { const int tok = i >> 8, cc = i & 255;
        const bf16* row = P + (size_t)tok * PINP + 768 + cc;
        const float cur = bf2f(row[0]), prev = (t0 + tok > 0) ? bf2f(*(row - PINP)) : 0.f;
        float x = cur + (prev - cur) * mu[768 + cc];
        if (cc < 64) x = tanh_f(x); else if (cc >= 128) x = fast_sigmoid(x);
        XL[tok * 264 + cc] = (bf16)f2bf(x); }
    __syncthreads();
    {
        const int ch = wave * 32 + r32;
        const bf16* w2T = (const bf16*)(ws + WS_LORA) + (size_t)l * 256 * 64 + (size_t)ch * 64;
        const bf16* a2T = (const bf16*)(ws + WS_LORA) + (size_t)(NL * 256 * 64) + (size_t)l * 256 * 64 + (size_t)ch * 64;
        const bf16* g2T = (const bf16*)(ws + WS_LORA) + (size_t)2 * (NL * 256 * 64) + (size_t)l * 256 * 128 + (size_t)ch * 128;
        const LAS bf16* xa = XL + r32 * 264 + 8 * hh;
        {
            f32x16 acc;
#pragma unroll
            for (int i = 0; i < 16; ++i) acc[i] = 0.f;
#pragma unroll
            for (int s = 0; s < 4; ++s) { const bf16x8 A = *(const LAS bf16x8*)(xa + 16 * s); const bf16x8 Bw = *(const bf16x8*)(w2T + 16 * s + 8 * hh);
                acc = __builtin_amdgcn_mfma_f32_32x32x16_bf16(A, Bw, acc, 0, 0, 0); }
            const float w0c = KIN(I_RWW0)[l * 256 + ch];
#pragma unroll
            for (int r = 0; r < 16; ++r) { const int tok = rho16(r, hh);
                const float zw = w0c + acc[r]; const float wlog = -(fmaxf(-zw, 0.f) + log1pexp_neg_abs(zw)) - 0.5f;
                LWL[tok * 264 + ch] = (bf16)f2bf(-fast_exp(wlog)); }
        }
        __builtin_amdgcn_sched_barrier(0);
        {
            f32x16 acc;
#pragma unroll
            for (int i = 0; i < 16; ++i) acc[i] = 0.f;
#pragma unroll
            for (int s = 0; s < 4; ++s) { const bf16x8 A = *(const LAS bf16x8*)(xa + 64 + 16 * s); const bf16x8 Bw = *(const bf16x8*)(a2T + 16 * s + 8 * hh);
                acc = __builtin_amdgcn_mfma_f32_32x32x16_bf16(A, Bw, acc, 0, 0, 0); }
            const float a0c = KIN(I_RWA0)[l * 256 + ch];
#pragma unroll
            for (int r = 0; r < 16; ++r) AL[rho16(r, hh) * 264 + ch] = (bf16)f2bf(fast_sigmoid(a0c + acc[r]));
        }
        __builtin_amdgcn_sched_barrier(0);
        {
            f32x16 acc;
#pragma unroll
            for (int i = 0; i < 16; ++i) acc[i] = 0.f;
#pragma unroll
            for (int s = 0; s < 8; ++s) { const bf16x8 A = *(const LAS bf16x8*)(xa + 128 + 16 * s); const bf16x8 Bw = *(const bf16x8*)(g2T + 16 * s + 8 * hh);
                acc = __builtin_amdgcn_mfma_f32_32x32x16_bf16(A, Bw, acc, 0, 0, 0); }
            bf16* gb = (bf16*)(ws + WS_GBUF) + ((size_t)b * T + t0) * 256 + ch;
#pragma unroll
            for (int r = 0; r < 16; ++r) gb[(size_t)rho16(r, hh) * 256] = (bf16)f2bf(acc[r]);
        }
    }
    __syncthreads();
    LAS unsigned char* L = lds + h * RWC_HEADB;
    LAS bf16* AT = (LAS bf16*)L;
    LAS bf16* BT = (LAS bf16*)(L + 4096);
    LAS bf16* KT = (LAS bf16*)(L + 8192);
    LAS bf16* ATT = (LAS bf16*)(L + 12288);
    LAS bf16* BHT = (LAS bf16*)(L + 16384);
    LAS bf16* KHT = (LAS bf16*)(L + 20480);
    LAS bf16* VT = (LAS bf16*)(L + 24576);
    LAS float* GC = (LAS float*)(L + 28672);
    LAS float* MAB = (LAS float*)(L + 4096);
    LAS bf16* MAK = (LAS bf16*)(L + 8192);
    LAS bf16* TM = (LAS bf16*)L;
    if (wave < 4) {
        const int hs = wave, d = lane, ch = hs * 64 + d; const size_t uns = (size_t)(b * 4 + hs) * NCH + c;
        LAS unsigned char* Ls = lds + hs * RWC_HEADB;
        LAS bf16* sAT = (LAS bf16*)Ls; LAS bf16* sBT = (LAS bf16*)(Ls + 4096); LAS bf16* sKT = (LAS bf16*)(Ls + 8192);
        LAS bf16* sATT = (LAS bf16*)(Ls + 12288); LAS bf16* sBHT = (LAS bf16*)(Ls + 16384); LAS bf16* sKHT = (LAS bf16*)(Ls + 20480); LAS float* sGC = (LAS float*)(Ls + 28672);
        const float mr = mu[ch], mk = mu[256 + ch];
        const float kkc = KIN(I_RWKK)[l * 256 + ch], kac = KIN(I_RWKA)[l * 256 + ch], rkc = KIN(I_RWRK)[l * 256 + ch];
        float lgend = 0.f;
#pragma unroll 8
        for (int t = 0; t < 32; ++t) lgend += bf2f(LWL[t * 264 + ch]);
        bf16* RGp = (bf16*)(ws + WS_RR) + uns * 2048 + d; bf16* BGp = (bf16*)(ws + WS_RB) + uns * 2048 + d; bf16* KGp = (bf16*)(ws + WS_RK) + uns * 2048 + d;
        float* bonp = (float*)(ws + WS_BONUS) + ((size_t)b * T + t0) * 4 + hs;
        float lg = 0.f;
        float rprev = 0.f, kprev = 0.f;
        if (t0 > 0) { rprev = bf2f(*(P - PINP + ch)); kprev = bf2f(*(P - PINP + 256 + ch)); }
        unsigned short xrr[32], xkr[32];
#pragma unroll
        for (int t = 0; t < 32; ++t) { const bf16* row = P + (size_t)t * PINP; xrr[t] = row[ch]; xkr[t] = row[256 + ch]; }
#pragma unroll 1
        for (int t8 = 0; t8 < 4; ++t8) { u32x4 ap, bp, kp; float xr[8], xk[8];
#pragma unroll
            for (int e = 0; e < 8; ++e) { xr[e] = bf2f(t8 == 0 ? xrr[e] : t8 == 1 ? xrr[8 + e] : t8 == 2 ? xrr[16 + e] : xrr[24 + e]); xk[e] = bf2f(t8 == 0 ? xkr[e] : t8 == 1 ? xkr[8 + e] : t8 == 2 ? xkr[16 + e] : xkr[24 + e]); }
#pragma unroll
            for (int jj = 0; jj < 4; ++jj) { float at2[2], bh2[2], kh2[2];
#pragma unroll
                for (int e = 0; e < 2; ++e) { const int t = t8 * 8 + jj * 2 + e;
                    const float rc = xr[jj * 2 + e], kc = xk[jj * 2 + e];
                    const float r = rc + (rprev - rc) * mr, k = kc + (kprev - kc) * mk; rprev = rc; kprev = kc;
                    const float av = bf2f(AL[t * 264 + ch]), lw = bf2f(LWL[t * 264 + ch]);
                    const float kkr = k * kkc, hk = k * (1.0f + (av - 1.0f) * kac);
                    const float ss = wave_sum(kkr * kkr); const float kk = kkr / fmaxf(sqrtf(ss), 1e-12f);
                    const float bon = wave_sum(r * hk * rkc);
                    const float aa = -kk, bb = kk * av;
                    const float lgp = lg; lg += lw;
                    const float at = aa * fast_exp(lgp), rt = r * fast_exp(lg), ei = fast_exp(-lg), bt = bb * ei, kt = hk * ei, eh = fast_exp(lgend - lg);
                    sAT[t * 64 + d] = (bf16)f2bf(at); sBT[t * 64 + d] = (bf16)f2bf(bt); sKT[t * 64 + d] = (bf16)f2bf(kt);
                    RGp[t * 64] = (bf16)f2bf(rt); BGp[t * 64] = (bf16)f2bf(bt); KGp[t * 64] = (bf16)f2bf(kt);
                    if (d == 0) bonp[t * 4] = bon;
                    at2[e] = at; bh2[e] = bb * eh; kh2[e] = hk * eh; }
                ap[jj] = pk2(at2[0], at2[1]); bp[jj] = pk2(bh2[0], bh2[1]); kp[jj] = pk2(kh2[0], kh2[1]); }
            *(LAS u32x4*)(sATT + d * 32 + t8 * 8) = ap; *(LAS u32x4*)(sBHT + d * 32 + t8 * 8) = bp; *(LAS u32x4*)(sKHT + d * 32 + t8 * 8) = kp; }
        sGC[d] = fast_exp(lgend);
    } else {
        const int cv = tid - 256, hs = cv >> 6, vi = cv & 63; const size_t uns = (size_t)(b * 4 + hs) * NCH + c;
        LAS bf16* sVT = (LAS bf16*)(lds + hs * RWC_HEADB + 24576);
        bf16* VTg = (bf16*)(ws + WS_RVT) + uns * 2048 + vi * 32; bf16* VGp = (bf16*)(ws + WS_RVG) + uns * 2048 + vi;
        const float mv = mu[512 + cv];
        float vprev = 0.f; if (t0 > 0) vprev = bf2f(*(P - PINP + 512 + cv));
        unsigned short xvr[32];
#pragma unroll
        for (int t = 0; t < 32; ++t) xvr[t] = P[(size_t)t * PINP + 512 + cv];
#pragma unroll
        for (int t8 = 0; t8 < 4; ++t8) { u32x4 vp; float yv[8];
#pragma unroll
            for (int e = 0; e < 8; ++e) { const float xv = bf2f(xvr[t8 * 8 + e]); yv[e] = xv + (vprev - xv) * mv; vprev = xv; VGp[(t8 * 8 + e) * 64] = (bf16)f2bf(yv[e]); }
#pragma unroll
            for (int jj = 0; jj < 4; ++jj) vp[jj] = pk2(yv[2 * jj], yv[2 * jj + 1]);
            *(LAS u32x4*)(sVT + vi * 32 + t8 * 8) = vp; *(u32x4*)(VTg + t8 * 8) = vp; }
    }
    __syncthreads();
    f32x16 accR[2];
    {
        f32x16 acc;
#pragma unroll
        for (int i = 0; i < 16; ++i) acc[i] = 0.f;
        const LAS bf16* Bsrc = p == 0 ? BT : KT;
#pragma unroll
        for (int s = 0; s < 4; ++s) { const bf16x8 A = *(const LAS bf16x8*)(AT + r32 * 64 + 16 * s + 8 * hh), B = *(const LAS bf16x8*)(Bsrc + r32 * 64 + 16 * s + 8 * hh);
            acc = __builtin_amdgcn_mfma_f32_32x32x16_bf16(A, B, acc, 0, 0, 0); }
        if (p == 0) {
#pragma unroll
            for (int r = 0; r < 16; ++r) { const int t = rho16(r, hh); MAB[t * 32 + r32] = (r32 < t) ? acc[r] : 0.f; }
        } else {
#pragma unroll
            for (int r = 0; r < 16; ++r) { const int t = rho16(r, hh); MAK[t * 32 + r32] = (bf16)f2bf((r32 < t) ? acc[r] : 0.f); }
        }
    }
    __syncthreads();
    if (p == 0) {
        const int cidx = r32; float tc[32];
#pragma unroll
        for (int t = 0; t < 32; ++t) { float acc0 = (t == cidx) ? 1.0f : 0.f, acc1 = 0.f;
#pragma unroll
            for (int s4 = 0; s4 < (t + 3) / 4; ++s4) { const f32x4 m4 = *(const LAS f32x4*)(MAB + t * 32 + 4 * s4);
#pragma unroll
                for (int e = 0; e < 4; ++e) { const int s = 4 * s4 + e; if (s < t) { if (e & 1) acc1 = fmaf(m4[e], tc[s], acc1); else acc0 = fmaf(m4[e], tc[s], acc0); } } }
            tc[t] = acc0 + acc1; }
#pragma unroll
        for (int t = 0; t < 32; ++t) if (hh == 0) TM[t * 32 + cidx] = (bf16)f2bf(tc[t]);
    } else {
#pragma unroll
        for (int vt = 0; vt < 2; ++vt) {
#pragma unroll
            for (int i = 0; i < 16; ++i) accR[vt][i] = 0.f;
#pragma unroll
            for (int s = 0; s < 2; ++s) { const bf16x8 A = *(const LAS bf16x8*)(MAK + r32 * 32 + 16 * s + 8 * hh), B = *(const LAS bf16x8*)(VT + (32 * vt + r32) * 32 + 16 * s + 8 * hh);
                accR[vt] = __builtin_amdgcn_mfma_f32_32x32x16_bf16(A, B, accR[vt], 0, 0, 0); } }
    }
    __syncthreads();
    if (p == 0) {
        f32x16 accW[2];
#pragma unroll
        for (int dt = 0; dt < 2; ++dt) {
#pragma unroll
            for (int i = 0; i < 16; ++i) accW[dt][i] = 0.f;
#pragma unroll
            for (int s = 0; s < 2; ++s) { const bf16x8 A = *(const LAS bf16x8*)(TM + r32 * 32 + 16 * s + 8 * hh), B = *(const LAS bf16x8*)(ATT + (32 * dt + r32) * 32 + 16 * s + 8 * hh);
                accW[dt] = __builtin_amdgcn_mfma_f32_32x32x16_bf16(A, B, accW[dt], 0, 0, 0); } }
        { LAS bf16* WL = ATT;
#pragma unroll
          for (int dt = 0; dt < 2; ++dt)
#pragma unroll
              for (int r = 0; r < 16; ++r) WL[rho16(r, hh) * 64 + 32 * dt + r32] = (bf16)f2bf(accW[dt][r]);
          u32x4* WGp = (u32x4*)((bf16*)(ws + WS_RW) + un * 2048);
#pragma unroll
          for (int i = 0; i < 4; ++i) WGp[i * 64 + lane] = *(const LAS u32x4*)(WL + (i * 64 + lane) * 8); }
        LAS bf16* PL = (LAS bf16*)(L + 4096);
        const int xs = r32 >> 4, xx = r32 & 15, hhA = (xx >> 2) & 1, jA = 4 * (xx >> 3) + (xx & 3);
#pragma unroll
        for (int dt = 0; dt < 2; ++dt)
#pragma unroll
            for (int dt2 = 0; dt2 < 2; ++dt2) { f32x16 acc;
#pragma unroll
                for (int i = 0; i < 16; ++i) acc[i] = 0.f;
#pragma unroll
                for (int s = 0; s < 2; ++s) { const LAS bf16* bp = BHT + (32 * dt + r32) * 32 + 16 * s + 4 * hh;
                    union { bf16x8 v; s16x4 h2[2]; } af; af.h2[0] = *(const LAS s16x4*)bp; af.h2[1] = *(const LAS s16x4*)(bp + 8);
                    union { bf16x8 v; unsigned w[4]; } bf;
#pragma unroll
                    for (int j = 0; j < 4; ++j) bf.w[j] = cvt_pk_bf16(accW[dt2][8 * s + 2 * j], accW[dt2][8 * s + 2 * j + 1]);
                    acc = __builtin_amdgcn_mfma_f32_32x32x16_bf16(af.v, bf.v, acc, 0, 0, 0); }
                if (dt == dt2) { const float gc = GC[32 * dt + r32];
#pragma unroll
                    for (int r = 0; r < 16; ++r) if (rho16(r, hh) == r32) acc[r] += gc; }
                LAS bf16* pf = PL + (((dt * 2 + dt2) * 2 + xs) * 64 + 32 * hhA) * 8 + jA;
#pragma unroll
                for (int r = 0; r < 16; ++r) pf[rho16(r, hh) * 8] = (bf16)f2bf(acc[r]); }
        { u32x4* PFp = (u32x4*)((bf16*)(ws + WS_RP) + un * 4096);
#pragma unroll
          for (int f = 0; f < 8; ++f) PFp[f * 64 + lane] = *(const LAS u32x4*)(PL + (f * 64 + lane) * 8); }
    } else {
        f32x16 accU[2];
#pragma unroll
        for (int vt = 0; vt < 2; ++vt) {
#pragma unroll
            for (int i = 0; i < 16; ++i) accU[vt][i] = 0.f;
#pragma unroll
            for (int s = 0; s < 2; ++s) { const LAS bf16* tp = TM + r32 * 32 + 16 * s + 4 * hh;
                union { bf16x8 v; s16x4 h2[2]; } af; af.h2[0] = *(const LAS s16x4*)tp; af.h2[1] = *(const LAS s16x4*)(tp + 8);
                union { bf16x8 v; unsigned w[4]; } bf;
#pragma unroll
                for (int j = 0; j < 4; ++j) bf.w[j] = cvt_pk_bf16(accR[vt][8 * s + 2 * j], accR[vt][8 * s + 2 * j + 1]);
                accU[vt] = __builtin_amdgcn_mfma_f32_32x32x16_bf16(af.v, bf.v, accU[vt], 0, 0, 0); } }
        float* UGp = (float*)(ws + WS_RU) + un * 2048;
#pragma unroll
        for (int vt = 0; vt < 2; ++vt)
#pragma unroll
            for (int g = 0; g < 4; ++g) *(f32x4*)(UGp + ((vt * 4 + g) * 64 + lane) * 4) = (f32x4){accU[vt][4 * g], accU[vt][4 * g + 1], accU[vt][4 * g + 2], accU[vt][4 * g + 3]};
        float* QFp = (float*)(ws + WS_RQ) + un * 4096;
#pragma unroll
        for (int vt = 0; vt < 2; ++vt)
#pragma unroll
            for (int dt = 0; dt < 2; ++dt) { f32x16 acc;
#pragma unroll
                for (int i = 0; i < 16; ++i) acc[i] = 0.f;
#pragma unroll
                for (int s = 0; s < 2; ++s) { const LAS bf16* bp = BHT + (32 * dt + r32) * 32 + 16 * s + 4 * hh;
                    union { bf16x8 v; s16x4 h2[2]; } af; af.h2[0] = *(const LAS s16x4*)bp; af.h2[1] = *(const LAS s16x4*)(bp + 8);
                    union { bf16x8 v; unsigned w[4]; } bf;
#pragma unroll
                    for (int j = 0; j < 4; ++j) bf.w[j] = cvt_pk_bf16(accU[vt][8 * s + 2 * j], accU[vt][8 * s + 2 * j + 1]);
                    acc = __builtin_amdgcn_mfma_f32_32x32x16_bf16(af.v, bf.v, acc, 0, 0, 0);
                    const bf16x8 A2 = *(const LAS bf16x8*)(KHT + (32 * dt + r32) * 32 + 16 * s + 8 * hh), B2 = *(const LAS bf16x8*)(VT + (32 * vt + r32) * 32 + 16 * s + 8 * hh);
                    acc = __builtin_amdgcn_mfma_f32_32x32x16_bf16(A2, B2, acc, 0, 0, 0); }
#pragma unroll
                for (int g = 0; g < 4; ++g) *(f32x4*)(QFp + (((vt * 2 + dt) * 4 + g) * 64 + lane) * 4) = (f32x4){acc[4 * g], acc[4 * g + 1], acc[4 * g + 2], acc[4 * g + 3]}; }
    }
    __syncthreads();
}
__device__ __forceinline__ void rw_m2_wave(LAS unsigned char* ring, int lane, int bh, int vt) {
    unsigned char* ws = KWS();
    const char* PF = (const char*)((const bf16*)(ws + WS_RP) + (size_t)bh * NCH * 4096) + lane * 16;
    const char* QF = (const char*)((const float*)(ws + WS_RQ) + (size_t)bh * NCH * 4096 + (size_t)vt * 2048) + lane * 16;
    bf16* SG = (bf16*)(ws + WS_RS) + (size_t)bh * NCH * 4096 + (size_t)vt * 2048 + lane * 8;
    f32x16 S[2];
#pragma unroll
    for (int dt = 0; dt < 2; ++dt)
#pragma unroll
        for (int i = 0; i < 16; ++i) S[dt][i] = 0.f;
#define RWM2_DMA(c_) do { const int _c = (c_) < NCH ? (c_) : NCH - 1; LAS unsigned char* _sl = ring + ((c_) & 3) * 16384; \
        _Pragma("unroll") for (int f = 0; f < 8; ++f) { \
            __builtin_amdgcn_global_load_lds((const unsigned*)(PF + (size_t)_c * 8192 + f * 1024), (LAS unsigned*)(_sl + f * 1024), 16, 0, 0); \
            __builtin_amdgcn_global_load_lds((const unsigned*)(QF + (size_t)_c * 16384 + f * 1024), (LAS unsigned*)(_sl + 8192 + f * 1024), 16, 0, 0); } } while (0)
    RWM2_DMA(0); RWM2_DMA(1); RWM2_DMA(2);
#pragma unroll 1
    for (int c = 0; c < NCH; ++c) {
        asm volatile("s_waitcnt vmcnt(32)" ::: "memory");
        const LAS unsigned char* sl = ring + (c & 3) * 16384 + lane * 16;
        bf16x8 pf[8]; f32x4 qv[8];
#pragma unroll
        for (int f = 0; f < 8; ++f) { pf[f] = *(const LAS bf16x8*)(sl + f * 1024); qv[f] = *(const LAS f32x4*)(sl + 8192 + f * 1024); }
        union { bf16x8 v; unsigned w[4]; } sb[2][2];
#pragma unroll
        for (int dt2 = 0; dt2 < 2; ++dt2)
#pragma unroll
            for (int s = 0; s < 2; ++s) {
#pragma unroll
                for (int j = 0; j < 4; ++j) sb[dt2][s].w[j] = cvt_pk_bf16(S[dt2][8 * s + 2 * j], S[dt2][8 * s + 2 * j + 1]);
                *(bf16x8*)(SG + (size_t)c * 4096 + (dt2 * 2 + s) * 512) = sb[dt2][s].v; }
        f32x16 N[2];
#pragma unroll
        for (int dt = 0; dt < 2; ++dt) {
#pragma unroll
            for (int g = 0; g < 4; ++g) { N[dt][4 * g] = qv[dt * 4 + g][0]; N[dt][4 * g + 1] = qv[dt * 4 + g][1]; N[dt][4 * g + 2] = qv[dt * 4 + g][2]; N[dt][4 * g + 3] = qv[dt * 4 + g][3]; }
#pragma unroll
            for (int dt2 = 0; dt2 < 2; ++dt2)
#pragma unroll
                for (int s = 0; s < 2; ++s) N[dt] = __builtin_amdgcn_mfma_f32_32x32x16_bf16(pf[(dt * 2 + dt2) * 2 + s], sb[dt2][s].v, N[dt], 0, 0, 0); }
        S[0] = N[0]; S[1] = N[1];
        asm volatile("s_waitcnt lgkmcnt(0)" ::: "memory");
        RWM2_DMA(c + 3);
    }
    asm volatile("s_waitcnt vmcnt(0)" ::: "memory");
#undef RWM2_DMA
}
__device__ __forceinline__ bf16x8 ld_perm8(const bf16* p) { union { bf16x8 v; s16x4 h2[2]; } f; f.h2[0] = *(const s16x4*)p; f.h2[1] = *(const s16x4*)(p + 8); return f.v; }
__device__ __forceinline__ void rw_m3_task(int lane, int l, int bh, int c) {
    unsigned char* ws = KWS();
    const int r32 = lane & 31, hh = lane >> 5, b = bh >> 2, h = bh & 3; const size_t un = (size_t)bh * NCH + c; const size_t tok0 = (size_t)b * T + c * 32;
    const bf16* RGp = (const bf16*)(ws + WS_RR) + un * 2048 + r32 * 64 + 4 * hh; const bf16* BGp = (const bf16*)(ws + WS_RB) + un * 2048 + r32 * 64 + 4 * hh;
    const bf16* KGp = (const bf16*)(ws + WS_RK) + un * 2048 + r32 * 64 + 4 * hh; const bf16* WGp = (const bf16*)(ws + WS_RW) + un * 2048 + r32 * 64 + 4 * hh;
    const bf16* SGp = (const bf16*)(ws + WS_RS) + un * 4096 + lane * 8; const bf16* VTp = (const bf16*)(ws + WS_RVT) + un * 2048 + r32 * 32 + 4 * hh;
    const float* UGp = (const float*)(ws + WS_RU) + un * 2048 + lane * 4;
    f32x16 U[2], Y[2], mb, mk;
#pragma unroll
    for (int vt = 0; vt < 2; ++vt)
#pragma unroll
        for (int g = 0; g < 4; ++g) { const f32x4 u4 = *(const f32x4*)(UGp + (vt * 4 + g) * 256); U[vt][4 * g] = u4[0]; U[vt][4 * g + 1] = u4[1]; U[vt][4 * g + 2] = u4[2]; U[vt][4 * g + 3] = u4[3]; }
#pragma unroll
    for (int i = 0; i < 16; ++i) { mb[i] = 0.f; mk[i] = 0.f; Y[0][i] = 0.f; Y[1][i] = 0.f; }
#pragma unroll
    for (int ks = 0; ks < 4; ++ks) {
        const bf16x8 rf = ld_perm8(RGp + 16 * ks), wf = ld_perm8(WGp + 16 * ks), bfr = ld_perm8(BGp + 16 * ks), kfr = ld_perm8(KGp + 16 * ks);
        const bf16x8 s0 = *(const bf16x8*)(SGp + ks * 512), s1 = *(const bf16x8*)(SGp + 2048 + ks * 512);
        U[0] = __builtin_amdgcn_mfma_f32_32x32x16_bf16(wf, s0, U[0], 0, 0, 0); U[1] = __builtin_amdgcn_mfma_f32_32x32x16_bf16(wf, s1, U[1], 0, 0, 0);
        mb = __builtin_amdgcn_mfma_f32_32x32x16_bf16(bfr, rf, mb, 0, 0, 0); mk = __builtin_amdgcn_mfma_f32_32x32x16_bf16(kfr, rf, mk, 0, 0, 0);
        Y[0] = __builtin_amdgcn_mfma_f32_32x32x16_bf16(s0, rf, Y[0], 0, 0, 0); Y[1] = __builtin_amdgcn_mfma_f32_32x32x16_bf16(s1, rf, Y[1], 0, 0, 0); }
#pragma unroll
    for (int r = 0; r < 16; ++r) if (rho16(r, hh) > r32) { mb[r] = 0.f; mk[r] = 0.f; }
#pragma unroll
    for (int s = 0; s < 2; ++s) { union { bf16x8 v; unsigned w[4]; } fb, fk;
#pragma unroll
        for (int j = 0; j < 4; ++j) { fb.w[j] = cvt_pk_bf16(mb[8 * s + 2 * j], mb[8 * s + 2 * j + 1]); fk.w[j] = cvt_pk_bf16(mk[8 * s + 2 * j], mk[8 * s + 2 * j + 1]); }
#pragma unroll
        for (int vt = 0; vt < 2; ++vt) { union { bf16x8 v; unsigned w[4]; } fu;
#pragma unroll
            for (int j = 0; j < 4; ++j) fu.w[j] = cvt_pk_bf16(U[vt][8 * s + 2 * j], U[vt][8 * s + 2 * j + 1]);
            Y[vt] = __builtin_amdgcn_mfma_f32_32x32x16_bf16(fu.v, fb.v, Y[vt], 0, 0, 0);
            const bf16* vp = VTp + (size_t)vt * 32 * 32 + 16 * s;
            union { bf16x8 v; s16x4 h2[2]; } vf; vf.h2[0] = *(const s16x4*)vp; vf.h2[1] = *(const s16x4*)(vp + 8);
            Y[vt] = __builtin_amdgcn_mfma_f32_32x32x16_bf16(vf.v, fk.v, Y[vt], 0, 0, 0); } }
    float sm = 0.f;
#pragma unroll
    for (int vt = 0; vt < 2; ++vt)
#pragma unroll
        for (int i = 0; i < 16; ++i) sm += Y[vt][i];
    sm += __shfl_xor(sm, 32); const float mu = sm * (1.0f / 64.0f);
    float q = 0.f;
#pragma unroll
    for (int vt = 0; vt < 2; ++vt)
#pragma unroll
        for (int i = 0; i < 16; ++i) { const float dd = Y[vt][i] - mu; q += dd * dd; }
    q += __shfl_xor(q, 32); const float rstd = 1.0f / sqrtf(q * (1.0f / 64.0f) + RW_LN_EPS);
    const size_t tok = tok0 + r32;
    const float bon = ((const float*)(ws + WS_BONUS))[tok * 4 + h];
    const bf16* vrec = (const bf16*)(ws + WS_RVG) + un * 2048 + r32 * 64;
    const bf16* gp = (const bf16*)(ws + WS_GBUF) + tok * 256 + h * 64; bf16* od = (bf16*)(ws + WS_O) + tok * D + 512 + h * 64;
    const float* lnw = KIN(I_RWLNW) + l * 256 + h * 64; const float* lnb = KIN(I_RWLNB) + l * 256 + h * 64;
#pragma unroll
    for (int vt = 0; vt < 2; ++vt)
#pragma unroll
        for (int g = 0; g < 4; ++g) { const int v0 = 32 * vt + 8 * g + 4 * hh; const f32x4 w4 = *(const f32x4*)(lnw + v0), b4 = *(const f32x4*)(lnb + v0); const u32x2 vw = *(const u32x2*)(vrec + v0); const f32x4 vv = {bflo(vw.x), bfhi(vw.x), bflo(vw.y), bfhi(vw.y)}; const u32x2 gw = *(const u32x2*)(gp + v0);
            const float y0 = ((Y[vt][4 * g] - mu) * rstd * w4[0] + b4[0] + bon * vv[0]) * bflo(gw.x), y1 = ((Y[vt][4 * g + 1] - mu) * rstd * w4[1] + b4[1] + bon * vv[1]) * bfhi(gw.x);
            const float y2 = ((Y[vt][4 * g + 2] - mu) * rstd * w4[2] + b4[2] + bon * vv[2]) * bflo(gw.y), y3 = ((Y[vt][4 * g + 3] - mu) * rstd * w4[3] + b4[3] + bon * vv[3]) * bfhi(gw.y);
            *(u32x2*)(od + v0) = (u32x2){pk2(y0, y1), pk2(y2, y3)}; }
}

__device__ __forceinline__ void c1_phase(LAS unsigned char* lds, int l, int vcu, int G) {
    for (int u = vcu; u < NB * NCH; u += G) { const int b = u >> 8, c = u & 255;
        for (int q = 0; q <= PHREP(16); ++q) rw_fused_unit(lds, l, b, c);
        for (int q = 0; q <= PHREP(17); ++q) hg_fused_unit(lds, l, b, c);
        for (int q = 0; q <= PHREP(18); ++q) gla_fused_unit(lds, l, b, c); }
}
__device__ __forceinline__ void m3_gh_phase(int l, int vcu, int G) {
    const int tid = opaque_tid(), lane = tid & 63, wave = __builtin_amdgcn_readfirstlane(tid >> 6);
    unsigned char* ws = KWS();
    const int gw = vcu * NWAVES + wave, NGW = G * NWAVES;
    const bf16* P = (const bf16*)(ws + WS_P); bf16* O = (bf16*)(ws + WS_O);
    const float* gng = KIN(I_GLANG) + l * 256; const float* hng = KIN(I_HGNG) + l * 256;
    for (int task = gw; task < 24576; task += NGW) {
        const int un = task & 8191, bh = un >> 8, c = un & 255, b = bh >> 2, h = bh & 3; const size_t tok0 = (size_t)b * T + c * 32;
        if (task >= 16384) { rw_m3_task(lane, l, bh, c); continue; }
        if (task < 8192) m3_gh_task<64>(lane, (const bf16*)(ws + WS_HQ) + (size_t)un * 2048, (const bf16*)(ws + WS_HK) + (size_t)un * 2048, (const bf16*)(ws + WS_HVT) + (size_t)un * 2048, (const bf16*)(ws + WS_HS) + (size_t)un * 4096,
                                         P + tok0 * PINP + PC_HG + h * 64, hng + h * 64, O + tok0 * D + 256 + h * 64);
        else m3_gh_task<32>(lane, (const bf16*)(ws + WS_GQ) + (size_t)un * 1024, (const bf16*)(ws + WS_GK) + (size_t)un * 1024, (const bf16*)(ws + WS_GVT) + (size_t)un * 2048, (const bf16*)(ws + WS_GS) + (size_t)un * 2048,
                            P + tok0 * PINP + PC_GOUT + h * 64, gng + h * 64, O + tok0 * D + h * 64);
    }
}

__device__ __forceinline__ void xattn_units(LAS unsigned char* lds, int l, int first, int last, int stride) {
    const int tid = opaque_tid(), lane = tid & 63, wave = __builtin_amdgcn_readfirstlane(tid >> 6), r32 = lane & 31, hh = lane >> 5;
    const bf16* P = (const bf16*)(KWS() + WS_P); const bf16* MKV = (const bf16*)(KWS() + WS_MKV); bf16* O = (bf16*)(KWS() + WS_O);
    LAS bf16* KL = (LAS bf16*)lds;
    LAS bf16* VT = (LAS bf16*)(lds + 256 * 72 * 2);
    int cur_bh = -1;
    for (int u = first; u < last; u += stride) {
        const int bh = u >> 5, qb = u & 31, b = bh >> 2, h = bh & 3;
        if (bh != cur_bh) {
            __syncthreads();
            for (int i = tid; i < 256 * 8; i += NTHR) { const int key = i >> 3, c8 = i & 7;
                const bf16* src = MKV + (size_t)(b * 256 + key) * 2048 + l * 512 + h * 64 + c8 * 8;
                *(LAS u32x4*)(KL + key * 72 + c8 * 8) = *(const u32x4*)src;
                const u32x4 vv = *(const u32x4*)(src + 256);
                LAS bf16* vd = VT + (c8 * 8) * 264 + key;
                vd[0 * 264] = (bf16)(vv.x & 0xffff); vd[1 * 264] = (bf16)(vv.x >> 16); vd[2 * 264] = (bf16)(vv.y & 0xffff); vd[3 * 264] = (bf16)(vv.y >> 16);
                vd[4 * 264] = (bf16)(vv.z & 0xffff); vd[5 * 264] = (bf16)(vv.z >> 16); vd[6 * 264] = (bf16)(vv.w & 0xffff); vd[7 * 264] = (bf16)(vv.w >> 16); }
            __syncthreads();
            cur_bh = bh;
        }
        const int q = b * T + qb * 256 + wave * 32 + r32;
        bf16x8 qf[4];
#pragma unroll
        for (int s = 0; s < 4; ++s) qf[s] = *(const bf16x8*)(P + (size_t)q * PINP + PC_MQ + h * 64 + 16 * s + 8 * hh);
        f32x16 sc[8];
#pragma unroll
        for (int kt = 0; kt < 8; ++kt) {
#pragma unroll
            for (int i = 0; i < 16; ++i) sc[kt][i] = 0.f;
#pragma unroll
            for (int s = 0; s < 4; ++s) { const bf16x8 kf = *(const LAS bf16x8*)(KL + (kt * 32 + r32) * 72 + 16 * s + 8 * hh);
                sc[kt] = __builtin_amdgcn_mfma_f32_32x32x16_bf16(kf, qf[s], sc[kt], 0, 0, 0); }
        }
        float m = -3.0e38f;
#pragma unroll
        for (int kt = 0; kt < 8; ++kt)
#pragma unroll
            for (int i = 0; i < 16; ++i) m = fmaxf(m, sc[kt][i]);
        m = fmaxf(m, __shfl_xor(m, 32));
        float sum = 0.f;
        const float c2 = 0.125f * 1.4426950408889634f;
#pragma unroll
        for (int kt = 0; kt < 8; ++kt)
#pragma unroll
            for (int i = 0; i < 16; ++i) { const float e = __builtin_amdgcn_exp2f((sc[kt][i] - m) * c2); sc[kt][i] = e; sum += e; }
        sum += __shfl_xor(sum, 32);
        const float inv = 1.0f / sum;
        f32x16 oa[2];
#pragma unroll
        for (int vt = 0; vt < 2; ++vt)
#pragma unroll
            for (int i = 0; i < 16; ++i) oa[vt][i] = 0.f;
#pragma unroll
        for (int kt = 0; kt < 8; ++kt)
#pragma unroll
            for (int s = 0; s < 2; ++s) {
                union { bf16x8 v; unsigned w[4]; } pf;
#pragma unroll
                for (int j = 0; j < 4; ++j) pf.w[j] = cvt_pk_bf16(sc[kt][8 * s + 2 * j], sc[kt][8 * s + 2 * j + 1]);
#pragma unroll
                for (int vt = 0; vt < 2; ++vt) {
                    const LAS bf16* vp = VT + (vt * 32 + r32) * 264 + kt * 32 + 16 * s + 4 * hh;
                    union { bf16x8 v; s16x4 h2[2]; } vf; vf.h2[0] = *(const LAS s16x4*)vp; vf.h2[1] = *(const LAS s16x4*)(vp + 8);
                    oa[vt] = __builtin_amdgcn_mfma_f32_32x32x16_bf16(vf.v, pf.v, oa[vt], 0, 0, 0); }
            }
        bf16* orow = O + (size_t)q * D + 768 + h * 64;
#pragma unroll
        for (int vt = 0; vt < 2; ++vt)
#pragma unroll
            for (int g = 0; g < 4; ++g) { u32x2 w; w.x = cvt_pk_bf16(oa[vt][4 * g] * inv, oa[vt][4 * g + 1] * inv); w.y = cvt_pk_bf16(oa[vt][4 * g + 2] * inv, oa[vt][4 * g + 3] * inv);
                *(u32x2*)(orow + vt * 32 + 8 * g + 4 * hh) = w; }
    }
    __syncthreads();
}

__device__ __forceinline__ void m2_phase(LAS unsigned char* lds, int l, int bx, int G) {
    unsigned char* ws = KWS();
    const int tid = opaque_tid(), lane = tid & 63, wave = __builtin_amdgcn_readfirstlane(tid >> 6);
    const int nrw = (G >= 128) ? 64 : 0;
    if (nrw) { if (bx < nrw && wave == 0) rw_m2_wave(lds, lane, bx >> 1, bx & 1); }
    else { if (wave == 0) for (int q = bx; q < 64; q += G) rw_m2_wave(lds, lane, q >> 1, q & 1); }
    if (nrw && !(bx < nrw && wave == 0)) {
        const int nth = nrw ? (nrw * 448 + (G - nrw) * NTHR) : G * NTHR;
        const int gt = nrw ? (bx < nrw ? bx * 448 + (tid - 64) : nrw * 448 + (bx - nrw) * NTHR + tid) : bx * NTHR + tid;
        for (int e = gt; e < 98304; e += nth) {
            if (e < 65536) m2_gh_elem2<64>(e, (const float*)(ws + WS_HDS), (const float*)(ws + WS_HBE), (bf16*)(ws + WS_HS));
            else m2_gh_elem2<32>(e - 65536, (const float*)(ws + WS_GDS), (const float*)(ws + WS_GBE), (bf16*)(ws + WS_GS)); }
    }
    if (nrw == 0) { __syncthreads(); for (int e = bx * NTHR + tid; e < 98304; e += G * NTHR) {
            if (e < 65536) m2_gh_elem2<64>(e, (const float*)(ws + WS_HDS), (const float*)(ws + WS_HBE), (bf16*)(ws + WS_HS));
            else m2_gh_elem2<32>(e - 65536, (const float*)(ws + WS_GDS), (const float*)(ws + WS_GBE), (bf16*)(ws + WS_GS)); } }
    if (nrw == 0 || bx >= nrw) {
        const int nb = G - nrw, r = bx - nrw;
        const int per = (1024 + nb - 1) / nb, lo = r * per, hi = (lo + per < 1024) ? lo + per : 1024;
        xattn_units(lds, l, lo, hi, 1);
    }
}

__device__ __forceinline__ void ln1_router_phase(LAS unsigned char* lds, int l, int bx, int G) {
    const int tid = opaque_tid(), lane = tid & 63, wave = __builtin_amdgcn_readfirstlane(tid >> 6);
    LAS float* X = (LAS float*)lds;
    LAS float* PART = (LAS float*)(lds + 16 * 1028 * 4);
    LAS int* HIST = (LAS int*)(lds + 16 * 1028 * 4 + 8 * 16 * 32 * 4);
    const float* xin = KIN(I_X); const bf16* xinb = (const bf16*)(KWS() + WS_XB);
    const bf16* HM = (const bf16*)(KWS() + WS_HMIX);
    bf16* X1B = (bf16*)(KWS() + WS_X1B);
    const float* g1 = KIN(I_LN1G) + l * D; const float* b1 = KIN(I_LN1B) + l * D;
    const float* rw = KIN(I_RTW) + (size_t)l * D * NE; const float* rb = KIN(I_RTB) + l * NE;
    int* tok_e = (int*)(KWS() + WS_ROUTE); float* tok_g = (float*)(KWS() + WS_ROUTE + 1 * MiB);
    if (tid < 32) HIST[tid] = 0;
    float rwB[2][32];
    { const int q = lane >> 4, e = lane & 15;
#pragma unroll
      for (int s = 0; s < 32; ++s) { const float* p = rw + (size_t)(128 * wave + 32 * q + s) * NE + e; rwB[0][s] = p[0]; rwB[1][s] = p[16]; } }
    __syncthreads();
    for (int it = bx; it < NTOK / 16; it += G) {
#pragma unroll
        for (int tt = 0; tt < 2; ++tt) { const int ti = wave * 2 + tt; const size_t tok = (size_t)it * 16 + ti;
            const f32x4* xr = (const f32x4*)(xin + tok * D) + lane; const u32x2* xbr = (const u32x2*)(xinb + tok * D) + lane; const u32x2* hr = (const u32x2*)(HM + tok * D) + lane;
            f32x4 v[4]; float s = 0.f;
#pragma unroll
            for (int j = 0; j < 4; ++j) { f32x4 xv; if (l == 0) xv = xr[64 * j]; else { const u32x2 xw = xbr[64 * j]; xv = (f32x4){bflo(xw.x), bfhi(xw.x), bflo(xw.y), bfhi(xw.y)}; } const u32x2 hw = hr[64 * j];
                v[j][0] = DN_ALPHA * xv[0] + bflo(hw.x); v[j][1] = DN_ALPHA * xv[1] + bfhi(hw.x); v[j][2] = DN_ALPHA * xv[2] + bflo(hw.y); v[j][3] = DN_ALPHA * xv[3] + bfhi(hw.y);
                s += (v[j][0] + v[j][1]) + (v[j][2] + v[j][3]); }
            const float mean = wave_sum(s) * (1.0f / D); float s2 = 0.f;
#pragma unroll
            for (int j = 0; j < 4; ++j) { v[j] = v[j] - mean; s2 += (v[j][0] * v[j][0] + v[j][1] * v[j][1]) + (v[j][2] * v[j][2] + v[j][3] * v[j][3]); }
            const float rstd = 1.0f / sqrtf(wave_sum(s2) * (1.0f / D) + LN_EPS);
#pragma unroll
            for (int j = 0; j < 4; ++j) { const f32x4 gg = *((const f32x4*)g1 + lane + 64 * j), bb = *((const f32x4*)b1 + lane + 64 * j);
                const f32x4 y = v[j] * rstd * gg + bb;
                *((u32x2*)(X1B + tok * D) + lane + 64 * j) = (u32x2){pk2(y[0], y[1]), pk2(y[2], y[3])};
                *(LAS f32x4*)(X + ti * 1028 + 4 * lane + 256 * j) = y; }
        }
        __syncthreads();
        {
            const int q = lane >> 4, r = lane & 15;
            f32x4 acc0 = (f32x4){0.f, 0.f, 0.f, 0.f}, acc1 = (f32x4){0.f, 0.f, 0.f, 0.f};
            const LAS float* xa = X + r * 1028 + 128 * wave + 32 * q;
#pragma unroll
            for (int s4 = 0; s4 < 8; ++s4) { const f32x4 av = *(const LAS f32x4*)(xa + 4 * s4);
#pragma unroll
                for (int j = 0; j < 4; ++j) { acc0 = __builtin_amdgcn_mfma_f32_16x16x4f32(av[j], rwB[0][4 * s4 + j], acc0, 0, 0, 0); acc1 = __builtin_amdgcn_mfma_f32_16x16x4f32(av[j], rwB[1][4 * s4 + j], acc1, 0, 0, 0); } }
#pragma unroll
            for (int i = 0; i < 4; ++i) { PART[(wave * 16 + 4 * q + i) * 32 + r] = acc0[i]; PART[(wave * 16 + 4 * q + i) * 32 + 16 + r] = acc1[i]; }
        }
        __syncthreads();
        {
            const int ti = tid >> 5, e = tid & 31;
            float lg = rb[e];
#pragma unroll
            for (int w = 0; w < 8; ++w) lg += PART[(w * 16 + ti) * 32 + e];
            float tv[4]; int te[4]; float cur = lg;
#pragma unroll
            for (int k = 0; k < 4; ++k) { float bv = cur; int bi = e;
#pragma unroll
                for (int o = 16; o >= 1; o >>= 1) { const float ov = __shfl_xor(bv, o); const int oi = __shfl_xor(bi, o); if (ov > bv || (ov == bv && oi < bi)) { bv = ov; bi = oi; } }
                tv[k] = bv; te[k] = bi; if (e == bi) cur = -3.0e38f; }
            const float e1 = __expf(tv[1] - tv[0]), e2 = __expf(tv[2] - tv[0]), e3 = __expf(tv[3] - tv[0]); const float inv = 1.0f / (1.0f + e1 + e2 + e3);
            const size_t tok = (size_t)it * 16 + ti;
            if (e < 4) { const int ek = e == 0 ? te[0] : e == 1 ? te[1] : e == 2 ? te[2] : te[3]; const float gk = (e == 0 ? 1.0f : e == 1 ? e1 : e == 2 ? e2 : e3) * inv;
                tok_e[tok * 4 + e] = ek; tok_g[tok * 4 + e] = gk; __hip_atomic_fetch_add(&HIST[ek], 1, __ATOMIC_RELAXED, __HIP_MEMORY_SCOPE_WORKGROUP); }
        }
        __syncthreads();
    }
    __syncthreads();
    if (tid < 32) ((int*)(KWS() + WS_CTL))[CW_HIST + bx * 32 + tid] = HIST[tid];
}

__device__ __forceinline__ void slots_phase(LAS unsigned char* lds, int bx, int G) {
    const int tid = opaque_tid();
    int* ctl = (int*)(KWS() + WS_CTL);
    LAS int* RED = (LAS int*)lds;
    LAS int* TOT = RED + 1024;
    const int* tok_e = (const int*)(KWS() + WS_ROUTE); const float* tok_g = (const float*)(KWS() + WS_ROUTE + 1 * MiB);
    int* tok_slot = (int*)(KWS() + WS_ROUTE + 2 * MiB); int* slot_tok = (int*)(KWS() + WS_ROUTE + 3 * MiB); float* slot_gate = (float*)(KWS() + WS_ROUTE + 3 * MiB + 1536 * 1024);
    { const int e = tid & 31, part = tid >> 5; int tot = 0, pre = 0;
      for (int b2 = part; b2 < G; b2 += 16) { const int h = ctl[CW_HIST + b2 * 32 + e]; tot += h; if (b2 < bx) pre += h; }
      RED[(part * 32 + e) * 2] = tot; RED[(part * 32 + e) * 2 + 1] = pre; }
    __syncthreads();
    if (tid < 32) { int tot = 0, pre = 0; for (int p = 0; p < 16; ++p) { tot += RED[(p * 32 + tid) * 2]; pre += RED[(p * 32 + tid) * 2 + 1]; } TOT[tid] = tot; TOT[32 + tid] = pre; TOT[96 + tid] = 0; }
    __syncthreads();
    if (tid == 0) { int ps = 0;
#pragma unroll 1
        for (int e = 0; e < 32; ++e) { TOT[64 + e] = ps; ps += (TOT[e] + 255) & ~255; }
        TOT[128] = ps >> 8; if (bx == 0) ctl[CW_NT] = ps >> 8; }
    __syncthreads();
    if (bx == 0) { const int nt = TOT[128];
        for (int t = tid; t < nt; t += NTHR) { int e = 0;
#pragma unroll 1
            for (int k = 1; k < 32; ++k) if (TOT[64 + k] <= t * 256) e = k;
            ctl[CW_TILEE + t] = e; } }
    for (int e = bx; e < 32; e += G) { const int s0 = TOT[64 + e] + TOT[e], s1 = TOT[64 + e] + ((TOT[e] + 255) & ~255); for (int s = s0 + tid; s < s1; s += NTHR) { slot_tok[s] = 0; slot_gate[s] = 0.f; } }
    for (int it = bx; it < NTOK / 16; it += G) {
        if (tid < 64) { const int asg = it * 64 + tid; const int e = tok_e[asg]; const int rank = __hip_atomic_fetch_add(&TOT[96 + e], 1, __ATOMIC_RELAXED, __HIP_MEMORY_SCOPE_WORKGROUP); const int slot = TOT[64 + e] + TOT[32 + e] + rank;
            tok_slot[asg] = slot; slot_tok[slot] = asg >> 2; slot_gate[slot] = tok_g[asg]; }
    }
}

__device__ __forceinline__ void combine_phase(int l, int vcu, int G) {
    const int tid = opaque_tid(), lane = tid & 63, wave = __builtin_amdgcn_readfirstlane(tid >> 6);
    const int gw = vcu * NWAVES + wave, NGW = G * NWAVES;
    const bf16* X1B = (const bf16*)(KWS() + WS_X1B); const bf16* YB = (const bf16*)(KWS() + WS_YB); const int* tok_slot = (const int*)(KWS() + WS_ROUTE + 2 * MiB);
    float* xo = KOUT(); bf16* XB = (bf16*)(KWS() + WS_XB);
    const float* g2 = KIN(I_LN2G) + l * D; const float* b2 = KIN(I_LN2B) + l * D;
    for (int tok = gw; tok < NTOK; tok += NGW) {
        const int s0 = tok_slot[tok * 4], s1 = tok_slot[tok * 4 + 1], s2i = tok_slot[tok * 4 + 2], s3 = tok_slot[tok * 4 + 3];
        const u32x2* xr = (const u32x2*)(X1B + (size_t)tok * D) + lane;
        const u32x2* y0 = (const u32x2*)(YB + (size_t)s0 * D) + lane; const u32x2* y1 = (const u32x2*)(YB + (size_t)s1 * D) + lane;
        const u32x2* y2 = (const u32x2*)(YB + (size_t)s2i * D) + lane; const u32x2* y3 = (const u32x2*)(YB + (size_t)s3 * D) + lane;
        f32x4 v[4]; float s = 0.f;
#pragma unroll
        for (int j = 0; j < 4; ++j) { const u32x2 xw = xr[64 * j]; const f32x4 xv = {bflo(xw.x), bfhi(xw.x), bflo(xw.y), bfhi(xw.y)}; const u32x2 a0 = y0[64 * j], a1 = y1[64 * j], a2 = y2[64 * j], a3 = y3[64 * j];
            v[j][0] = DN_ALPHA * xv[0] + ((bflo(a0.x) + bflo(a1.x)) + (bflo(a2.x) + bflo(a3.x))); v[j][1] = DN_ALPHA * xv[1] + ((bfhi(a0.x) + bfhi(a1.x)) + (bfhi(a2.x) + bfhi(a3.x)));
            v[j][2] = DN_ALPHA * xv[2] + ((bflo(a0.y) + bflo(a1.y)) + (bflo(a2.y) + bflo(a3.y))); v[j][3] = DN_ALPHA * xv[3] + ((bfhi(a0.y) + bfhi(a1.y)) + (bfhi(a2.y) + bfhi(a3.y)));
            s += (v[j][0] + v[j][1]) + (v[j][2] + v[j][3]); }
        const float mean = wave_sum(s) * (1.0f / D); float q = 0.f;
#pragma unroll
        for (int j = 0; j < 4; ++j) { v[j] = v[j] - mean; q += (v[j][0] * v[j][0] + v[j][1] * v[j][1]) + (v[j][2] * v[j][2] + v[j][3] * v[j][3]); }
        const float rstd = 1.0f / sqrtf(wave_sum(q) * (1.0f / D) + LN_EPS);
#pragma unroll
        for (int j = 0; j < 4; ++j) { const f32x4 gg = *((const f32x4*)g2 + lane + 64 * j), bb = *((const f32x4*)b2 + lane + 64 * j);
            const f32x4 y = v[j] * rstd * gg + bb;
            if (l == NL - 1) *((f32x4*)(xo + (size_t)tok * D) + lane + 64 * j) = y;
            else *((u32x2*)(XB + (size_t)tok * D) + lane + 64 * j) = (u32x2){pk2(y[0], y[1]), pk2(y[2], y[3])}; }
    }
}


constexpr int PH_PER_LAYER = 10, NPHASES = 2 + NL * PH_PER_LAYER;
__global__ void __launch_bounds__(NTHR, 2) trunk_fwd(Args args) {
    extern __shared__ __attribute__((aligned(16))) unsigned char lds_raw[];
    LAS unsigned char* lds = (LAS unsigned char*)lds_raw;
    volatile LAS unsigned* MISC = (volatile LAS unsigned*)(lds + MISC_OFF);
    const int tid = threadIdx.x;
    const int G = gridDim.x, bx = blockIdx.x;
    const int vcu = (G % 8 == 0) ? (bx % 8) * (G / 8) + bx / 8 : bx;
    unsigned char* ws = KWS();
    unsigned* ctl = (unsigned*)(ws + WS_CTL);
    for (int u = tid; u < (LDS_BYTES - LDSCTL_OFF) / 4; u += NTHR) ((LAS unsigned*)(lds + LDSCTL_OFF))[u] = 0u;
    __syncthreads();
    XcdBarrier bar; bar.bar = ctl + CW_BAR; bar.x = 0; bar.st = nullptr;
#if !MK_PER_PHASE
    bar = xcd_barrier_post(ctl + CW_BAR, MISC + 8);
#define GRID_BAR() xcd_barrier(bar)
#else
#define GRID_BAR() do { } while (0)
#endif
    const int lo = (int)(unsigned)ka_u64<280>(), hi = (int)(unsigned)(ka_u64<280>() >> 32);
#ifndef PH_MASK
#define PH_MASK 0x1FFF
#endif
#define PHEN(n) (((PH_MASK) >> (n)) & 1)
#define IN(k) (lo <= (k) && (k) < hi)
#define SEAM(k) do { if (rep > 0 || IN((k) + 1)) GRID_BAR(); } while (0)

#define OG opaque_s(G)
#define OBX opaque_s(bx)
#define OVCU opaque_s(vcu)
#define OL opaque_s(l)
    if (PHEN(0) && IN(0)) for (int rep = PHREP(0); rep >= 0; --rep) { prologue_phase(lds, OVCU, OG); SEAM(0); }
    if (PHEN(1) && IN(1)) for (int rep = PHREP(1); rep >= 0; --rep) {
        pg8::DenseOrder S; S.init(KWS() + WS_MEMB, KWS() + WS_WMEM, NB * NMEM, 2048, D, OG, OBX);
        pg8::EpiBf16 E{(bf16*)(KWS() + WS_MKV), 2048};
        pg8::gemm_phase<pg8::EpiBf16, pg8::DenseOrder>(lds, D, S, E);
        SEAM(1);
    }
    for (int l = 0; l < NL; ++l) {
        const int p0 = 2 + l * PH_PER_LAYER;
        if (PHEN(2) && IN(p0 + 0)) for (int rep = PHREP(2); rep >= 0; --rep) {
            pg8::DenseOrder S; S.init(KWS() + WS_XB, KWS() + WS_WIN + (size_t)OL * PINP * D * 2, NTOK, PINP, D, OG, OBX);
            pg8::EpiBf16 E{(bf16*)(KWS() + WS_P), PINP};
            pg8::gemm_phase<pg8::EpiBf16, pg8::DenseOrder>(lds, D, S, E);
            SEAM(p0 + 0);
        }
        if (PHEN(4) && IN(p0 + 1)) for (int rep = PHREP(4); rep >= 0; --rep) { c1_phase(lds, OL, OVCU, OG); SEAM(p0 + 1); }
        if (PHEN(5) && IN(p0 + 2)) for (int rep = PHREP(5); rep >= 0; --rep) { m2_phase(lds, OL, OBX, OG); SEAM(p0 + 2); }
        if (PHEN(6) && IN(p0 + 3)) for (int rep = PHREP(6); rep >= 0; --rep) { m3_gh_phase(OL, OVCU, OG); SEAM(p0 + 3); }
        if (PHEN(7) && IN(p0 + 4)) for (int rep = PHREP(7); rep >= 0; --rep) {
            pg8::DenseOrder S; S.init(KWS() + WS_O, KWS() + WS_WOUT + (size_t)OL * D * D * 2, NTOK, D, D, OG, OBX);
            pg8::EpiBf16 E{(bf16*)(KWS() + WS_HMIX), D};
            pg8::gemm_phase<pg8::EpiBf16, pg8::DenseOrder>(lds, D, S, E);
            SEAM(p0 + 4);
        }
        if (PHEN(8) && IN(p0 + 5)) for (int rep = PHREP(8); rep >= 0; --rep) { ln1_router_phase(lds, OL, OBX, OG); SEAM(p0 + 5); }
        if (PHEN(9) && IN(p0 + 6)) for (int rep = PHREP(9); rep >= 0; --rep) { slots_phase(lds, OBX, OG); SEAM(p0 + 6); }
        if (PHEN(10) && IN(p0 + 7)) for (int rep = PHREP(10); rep >= 0; --rep) {
            const int ntiles = __builtin_amdgcn_readfirstlane(((const int*)(KWS() + WS_CTL))[CW_NT]);
            pg8::MoeOrder<true> S; S.init(KWS() + WS_X1B, KWS() + WS_WGU + (size_t)OL * NE * 2048 * D * 2, (const int*)(KWS() + WS_CTL) + CW_TILEE, (const int*)(KWS() + WS_ROUTE + 3 * MiB), ntiles, 2048, D, OG, OBX);
            pg8::EpiSwiglu E{(bf16*)(KWS() + WS_HB), (const float*)(KWS() + WS_BGU) + (size_t)OL * NE * 2048};
            pg8::gemm_phase<pg8::EpiSwiglu, pg8::MoeOrder<true>>(lds, D, S, E);
            SEAM(p0 + 7);
        }
        if (PHEN(11) && IN(p0 + 8)) for (int rep = PHREP(11); rep >= 0; --rep) {
            const int ntiles = __builtin_amdgcn_readfirstlane(((const int*)(KWS() + WS_CTL))[CW_NT]);
            pg8::MoeOrder<false> S; S.init(KWS() + WS_HB, KWS() + WS_WD + (size_t)OL * NE * D * FF * 2, (const int*)(KWS() + WS_CTL) + CW_TILEE, (const int*)(KWS() + WS_ROUTE + 3 * MiB), ntiles, D, FF, OG, OBX);
            pg8::EpiDown E{(bf16*)(KWS() + WS_YB), KIN(I_BDN) + (size_t)OL * NE * D, (const float*)(KWS() + WS_ROUTE + 3 * MiB + 1536 * 1024)};
            pg8::gemm_phase<pg8::EpiDown, pg8::MoeOrder<false>>(lds, FF, S, E);
            SEAM(p0 + 8);
        }
        if (PHEN(12) && IN(p0 + 9)) for (int rep = PHREP(12); rep >= 0; --rep) { combine_phase(OL, OVCU, OG); if (rep > 0 || l + 1 < NL) SEAM(p0 + 9); }
    }
#undef IN
#undef SEAM
}

extern "C" void kernel_launch(void* const* d_in, const int* in_sizes, int n_in, void* d_out, int out_size, void* d_ws, size_t ws_size, hipStream_t stream) {
    static int grid = 0;
    if (grid == 0) {
        if (n_in != 33 || ws_size < WS_END) { fprintf(stderr, "kernel_launch: unexpected inputs (n_in %d, ws %zu need %zu)\n", n_in, ws_size, (size_t)WS_END); grid = -1; return; }
        int dev = 0, cus = 0;
        if (hipGetDevice(&dev) != hipSuccess || hipDeviceGetAttribute(&cus, hipDeviceAttributeMultiprocessorCount, dev) != hipSuccess) { grid = -1; return; }
        if (hipFuncSetAttribute((const void*)trunk_fwd, hipFuncAttributeMaxDynamicSharedMemorySize, LDS_BYTES) != hipSuccess) { grid = -1; return; }
        int per_cu = 0; (void)hipOccupancyMaxActiveBlocksPerMultiprocessor(&per_cu, (const void*)trunk_fwd, NTHR, LDS_BYTES); (void)hipGetLastError();
        grid = cus;
    }
    if (grid < 0) return;
    (void)hipMemsetAsync((char*)d_ws + WS_CTL, 0, CTL_ZERO_BYTES, stream);
    Args a{};
    for (int i = 0; i < 33; ++i) a.in[i] = (const float*)d_in[i];
    a.out = (float*)d_out; a.ws = (unsigned char*)d_ws;
#if MK_PER_PHASE
    for (int p = 0; p < NPHASES; ++p) { a.ph_lo = p; a.ph_hi = p + 1; hipLaunchKernelGGL(trunk_fwd, dim3(grid), dim3(NTHR), LDS_BYTES, stream, a); }
#else
    a.ph_lo = 0; a.ph_hi = NPHASES;
    hipLaunchKernelGGL(trunk_fwd, dim3(grid), dim3(NTHR), LDS_BYTES, stream, a);
#endif
}
```

```cpp
#include <hip/hip_runtime.h>
#include <cstdio>
#include <cstdint>

#ifndef MK_PER_PHASE
#define MK_PER_PHASE 0
#endif

#ifndef REP_MASK
#define REP_MASK 0
#endif
#define PHREP(n) (((REP_MASK) >> (n)) & 1)
#define LAS __attribute__((address_space(3)))
#define GAS __attribute__((address_space(1)))
typedef unsigned short bf16;
typedef short bf16x8 __attribute__((ext_vector_type(8)));
typedef short s16x4 __attribute__((ext_vector_type(4)));
typedef float f32x4 __attribute__((ext_vector_type(4)));
typedef float f32x2 __attribute__((ext_vector_type(2)));
typedef float f32x16 __attribute__((ext_vector_type(16)));
typedef unsigned u32x4 __attribute__((ext_vector_type(4)));
typedef unsigned u32x2 __attribute__((ext_vector_type(2)));

constexpr int NB = 8, T = 8192, D = 1024, NL = 4, NTOK = NB * T;
constexpr int PIN = 3088, PINP = 3328;
constexpr int NE = 32, FF = 1024, NMEM = 256;
constexpr int NASSIGN = NTOK * 4;
constexpr int MAXTILES = NASSIGN / 256 + NE;
constexpr int MAXSLOTS = MAXTILES * 256;
constexpr int PC_GQ = 0, PC_GK = 128, PC_GV = 256, PC_GOUT = 512, PC_HQ = 768, PC_HF = 1024, PC_HI = 1280, PC_HG = 1536;
constexpr int PC_RW = 1792, PC_MQ = 2816, PC_GLR = 3072;
constexpr float DN_ALPHA = 1.6817928305074292f;
constexpr float LN_EPS = 1e-5f, RMS_EPS = 1e-6f, RW_LN_EPS = 64e-5f;

constexpr size_t MiB = 1u << 20;
constexpr size_t WS_CTL = 0, CTL_ZERO_BYTES = 1 * MiB;
constexpr size_t WS_WIN = 1 * MiB;
constexpr size_t WS_WOUT = WS_WIN + 26 * MiB;
constexpr size_t WS_WMEM = WS_WOUT + 8 * MiB;
constexpr size_t WS_WGU = WS_WMEM + 4 * MiB;
constexpr size_t WS_WD = WS_WGU + 512 * MiB;
constexpr size_t WS_BGU = WS_WD + 256 * MiB;
constexpr size_t WS_LORA = WS_BGU + 1 * MiB;
constexpr size_t WS_MEMB = WS_LORA + 1 * MiB;
constexpr size_t WS_MKV = WS_MEMB + 4 * MiB;
constexpr size_t WS_XB = WS_MKV + 8 * MiB;
constexpr size_t WS_X1B = WS_XB + 128 * MiB;
constexpr size_t WS_XF = WS_X1B + 128 * MiB;
constexpr size_t WS_X1F = WS_XF + 256 * MiB;
constexpr size_t WS_O = WS_X1F + 256 * MiB;
constexpr size_t WS_HMIX = WS_O + 128 * MiB;
constexpr size_t WS_ROUTE = WS_HMIX + 128 * MiB;
constexpr size_t WS_GBUF = WS_ROUTE + 6 * MiB;
constexpr size_t WS_BONUS = WS_GBUF + 32 * MiB;
constexpr size_t WS_BIG = WS_BONUS + 1 * MiB;
constexpr size_t WS_P = WS_BIG;
constexpr size_t WS_ORAW = WS_P + 416 * MiB;
constexpr size_t WS_HB = WS_BIG;
constexpr size_t WS_YB = WS_HB + 528 * MiB;
constexpr size_t WS_CHK = WS_ORAW;
constexpr size_t WS_HQ = WS_CHK, WS_HK = WS_HQ + 32 * MiB, WS_HVT = WS_HK + 32 * MiB, WS_HDS = WS_HVT + 32 * MiB, WS_HS = WS_HDS + 128 * MiB, WS_HBE = WS_HS + 64 * MiB;
constexpr size_t WS_GQ = WS_HBE + 2 * MiB, WS_GK = WS_GQ + 16 * MiB, WS_GVT = WS_GK + 16 * MiB, WS_GDS = WS_GVT + 32 * MiB, WS_GS = WS_GDS + 64 * MiB, WS_GBE = WS_GS + 32 * MiB;
constexpr size_t WS_RR = WS_GBE + 1 * MiB, WS_RB = WS_RR + 32 * MiB, WS_RK = WS_RB + 32 * MiB, WS_RW = WS_RK + 32 * MiB, WS_RVT = WS_RW + 32 * MiB;
constexpr size_t WS_RVG = WS_RVT + 32 * MiB;
constexpr size_t WS_RU = WS_RVG + 32 * MiB, WS_RP = WS_RU + 64 * MiB, WS_RQ = WS_RP + 64 * MiB, WS_RS = WS_RQ + 128 * MiB;
constexpr size_t WS_END = WS_RS + 64 * MiB;
static_assert(WS_YB + 528 * MiB <= WS_END, "overlay");
static_assert(WS_END <= (size_t)4096 * MiB, "workspace");
constexpr int CW_TMO = 0;
constexpr int CW_BAR = 4096;
constexpr int CW_HIST = 16384;
constexpr int CW_NT = 32768;
constexpr int CW_TILEE = 32768 + 64;
constexpr int CW_PADSTART = 40960;

constexpr int RING_BYTES = 131072;
constexpr int LDSCTL_OFF = 162816, MISC_OFF = LDSCTL_OFF + 320;
constexpr int LDS_BYTES = 163840;
constexpr int NWAVES = 8, NTHR = 512;

#define RLX_AGENT __ATOMIC_RELAXED, __HIP_MEMORY_SCOPE_AGENT
#define LDS_WAIT() asm volatile("s_waitcnt lgkmcnt(0)" ::: "memory")
#define VM_WAIT() asm volatile("s_waitcnt vmcnt(0)" ::: "memory")

__device__ __forceinline__ unsigned f2bf(float f) { unsigned u = __builtin_bit_cast(unsigned, f); return (u + 0x7fffu + ((u >> 16) & 1u)) >> 16; }
__device__ __forceinline__ unsigned pk2(float lo, float hi) { return f2bf(lo) | (f2bf(hi) << 16); }
__device__ __forceinline__ float bf2f(unsigned short b) { return __builtin_bit_cast(float, (unsigned)b << 16); }
__device__ __forceinline__ float bflo(unsigned w) { return __builtin_bit_cast(float, w << 16); }
__device__ __forceinline__ float bfhi(unsigned w) { return __builtin_bit_cast(float, w & 0xffff0000u); }
typedef __bf16 bf16x2_t __attribute__((ext_vector_type(2)));
__device__ __forceinline__ unsigned cvt_pk_bf16(float lo, float hi) { const f32x2 v = {lo, hi}; const bf16x2_t b = __builtin_convertvector(v, bf16x2_t); return __builtin_bit_cast(unsigned, b); }
__device__ __forceinline__ float fast_exp(float x) { return __builtin_amdgcn_exp2f(x * 1.4426950408889634f); }
__device__ __forceinline__ float fast_sigmoid(float x) { return __builtin_amdgcn_rcpf(1.0f + fast_exp(-x)); }
__device__ __forceinline__ float silu_f(float x) { return x * fast_sigmoid(x); }
__device__ __forceinline__ int opaque_tid() { int t = threadIdx.x; asm volatile("" : "+v"(t)); return t; }
__device__ __forceinline__ int opaque_s(int v) { asm volatile("" : "+s"(v)); return v; }
__device__ __forceinline__ float wave_sum(float v) {
#pragma unroll
    for (int o = 1; o < 64; o <<= 1) v += __shfl_xor(v, o);
    return v;
}

namespace pg8 {
constexpr int BM = 256, BK = 64, HALF = 128, HTB = HALF * BK * 2, STAGE_BYTES = 8 * HTB, NXCD = 8, WGM = 8;
__host__ __device__ __forceinline__ int lds_byte(int r, int c) { const int st = (r >> 4) * 2 + (c >> 5), rr = r & 15, cc = c & 31, ob = rr * 64 + cc * 2; return st * 1024 + (ob ^ (((ob >> 9) & 1) << 5)); }
__host__ __device__ __forceinline__ void stage_rc(int b, int& R, int& C) { const int st = b / 1024, sb = b % 1024, swz = sb ^ (((sb >> 9) & 1) << 5); R = (st >> 1) * 16 + swz / 64; C = (st & 1) * 32 + (swz % 64) / 2; }
__host__ __device__ __forceinline__ int perm32(int rho) { const int n = rho >> 4, i = rho & 15; return 8 * (i >> 2) + 4 * n + (i & 3); }

typedef int v4i_t __attribute__((ext_vector_type(4)));
typedef int v8i_t __attribute__((ext_vector_type(8)));
struct Unit { int pm, pn, e; const char* A; const char* B; };

__device__ __forceinline__ bool static_tile(int i, int G, int c, int nM, int nN, int& pm, int& pn) {
    const int nwg = nM * nN; const long L = (long)i * G + c; if (L >= nwg) return false;
    int wgid = (int)L; { const int q = nwg / NXCD, r = nwg % NXCD, xcd = wgid % NXCD, off = wgid / NXCD; wgid = (xcd < r ? xcd * (q + 1) : r * (q + 1) + (xcd - r) * q) + off; }
    const int nig = WGM * nN, gid = wgid / nig, fm = gid * WGM, gsz = (nM - fm) < WGM ? (nM - fm) : WGM;
    pm = fm + ((wgid % nig) % gsz); pn = (wgid % nig) / gsz; return true;
}
struct DenseOrder {
    static constexpr bool GATHER = false;
    const char* A; const char* B; int nM, nN, G, c; size_t tstep;
    __device__ __forceinline__ void init(const void* A_, const void* B_, int M, int N, int K, int G_, int c_) { A = (const char*)A_; B = (const char*)B_; nM = M / BM; nN = N / BM; G = G_; c = c_; tstep = (size_t)BM * K * 2; }
    __device__ __forceinline__ bool next(int i, Unit& u) const { if (!static_tile(i, G, c, nM, nN, u.pm, u.pn)) return false; u.e = 0; u.A = A + (size_t)u.pm * tstep; u.B = B + (size_t)u.pn * tstep; return true; }
    __device__ __forceinline__ unsigned row_tok(const Unit&, int) const { return 0; }
};
template <bool GATHER_> struct MoeOrder {
    static constexpr bool GATHER = GATHER_;
    const char* A; const char* B; const int* tile_e; const int* slot_tok; int nM, nN, G, c; size_t tstep, estep;
    __device__ __forceinline__ void init(const void* A_, const void* B_, const int* tile_e_, const int* slot_tok_, int ntiles, int Nper, int Kbytes, int G_, int c_) {
        A = (const char*)A_; B = (const char*)B_; tile_e = tile_e_; slot_tok = slot_tok_; nM = ntiles; nN = Nper / BM; G = G_; c = c_; tstep = (size_t)BM * Kbytes; estep = (size_t)Nper * Kbytes; }
    __device__ __forceinline__ bool next(int i, Unit& u) const { if (!static_tile(i, G, c, nM, nN, u.pm, u.pn)) return false;
        u.e = __builtin_amdgcn_readfirstlane(tile_e[u.pm]); u.A = GATHER_ ? A : A + (size_t)u.pm * tstep; u.B = B + (size_t)u.e * estep + (size_t)u.pn * tstep; return true; }
    __device__ __forceinline__ unsigned row_tok(const Unit& u, int r) const { return (unsigned)slot_tok[u.pm * BM + r]; }
};

struct EpiBf16 {
    static constexpr bool PERM = true; static constexpr int WSCALE = 127;
    bf16* O; int ldc;
    __device__ __forceinline__ void operator()(const f32x4 (&acc)[2][2][4][2], const Unit& u, int wr, int wc, int fr, int fq) const {
        const int row0 = u.pm * BM + wr * 64 + fr, col0 = u.pn * BM + wc * 32 + 8 * fq;
#pragma unroll
        for (int ai = 0; ai < 2; ++ai)
#pragma unroll
            for (int m = 0; m < 4; ++m) { bf16* rowp = O + (size_t)(row0 + ai * HALF + m * 16) * ldc + col0;
#pragma unroll
                for (int bj = 0; bj < 2; ++bj) { const f32x4 v0 = acc[ai][bj][m][0], v1 = acc[ai][bj][m][1];
                    u32x4 w; w.x = cvt_pk_bf16(v0[0], v0[1]); w.y = cvt_pk_bf16(v0[2], v0[3]); w.z = cvt_pk_bf16(v1[0], v1[1]); w.w = cvt_pk_bf16(v1[2], v1[3]);
                    *(u32x4*)(rowp + bj * HALF) = w; } }
    }
};
struct EpiSwiglu {
    static constexpr bool PERM = false; static constexpr int WSCALE = 123;
    unsigned char* H; const float* bias;
    __device__ __forceinline__ void operator()(const f32x4 (&acc)[2][2][4][2], const Unit& u, int wr, int wc, int fr, int fq) const {
        const int row0 = u.pm * BM + wr * 64 + fr, colh = u.pn * 128 + wc * 32 + 8 * fq;
        const float* bp = bias + (size_t)u.e * 2048 + u.pn * 256 + wc * 32 + 4 * fq;
        f32x4 bv[2][2];
#pragma unroll
        for (int bj = 0; bj < 2; ++bj)
#pragma unroll
            for (int n = 0; n < 2; ++n) bv[bj][n] = *(const f32x4*)(bp + bj * HALF + n * 16);
#pragma unroll
        for (int ai = 0; ai < 2; ++ai)
#pragma unroll
            for (int m = 0; m < 4; ++m) { unsigned char* rowp = H + (size_t)(row0 + ai * HALF + m * 16) * FF + colh;
                float o[8];
#pragma unroll
                for (int n = 0; n < 2; ++n) { const f32x4 g4 = acc[ai][0][m][n] + bv[0][n], u4 = acc[ai][1][m][n] + bv[1][n];
#pragma unroll
                    for (int j = 0; j < 4; ++j) { const float g = fminf(g4[j], 7.0f), up = fminf(fmaxf(u4[j], -7.0f), 7.0f);
                        const float glu = g * __builtin_amdgcn_rcpf(1.0f + __builtin_amdgcn_exp2f(g * (-1.702f * 1.4426950408889634f)));
                        o[n * 4 + j] = (up + 1.0f) * glu; } }
                int w0 = __builtin_amdgcn_cvt_pk_fp8_f32(o[0], o[1], 0, false); w0 = __builtin_amdgcn_cvt_pk_fp8_f32(o[2], o[3], w0, true);
                int w1 = __builtin_amdgcn_cvt_pk_fp8_f32(o[4], o[5], 0, false); w1 = __builtin_amdgcn_cvt_pk_fp8_f32(o[6], o[7], w1, true);
                *(u32x2*)rowp = (u32x2){(unsigned)w0, (unsigned)w1}; }
    }
};
struct EpiDown {
    static constexpr bool PERM = true; static constexpr int WSCALE = 122;
    bf16* Y; const float* bias; const float* slot_gate;
    __device__ __forceinline__ void operator()(const f32x4 (&acc)[2][2][4][2], const Unit& u, int wr, int wc, int fr, int fq) const {
        const int row0 = u.pm * BM + wr * 64 + fr, col0 = u.pn * BM + wc * 32 + 8 * fq;
        const float* bp = bias + (size_t)u.e * 1024 + col0;
        f32x4 bv[2][2];
#pragma unroll
        for (int bj = 0; bj < 2; ++bj)
#pragma unroll
            for (int n = 0; n < 2; ++n) bv[bj][n] = *(const f32x4*)(bp + bj * HALF + 4 * n);
#pragma unroll
        for (int ai = 0; ai < 2; ++ai)
#pragma unroll
            for (int m = 0; m < 4; ++m) { const int row = row0 + ai * HALF + m * 16; const float g = slot_gate[row]; bf16* rowp = Y + (size_t)row * D + col0;
#pragma unroll
                for (int bj = 0; bj < 2; ++bj) { const f32x4 v0 = (acc[ai][bj][m][0] + bv[bj][0]) * g, v1 = (acc[ai][bj][m][1] + bv[bj][1]) * g;
                    u32x4 w; w.x = cvt_pk_bf16(v0[0], v0[1]); w.y = cvt_pk_bf16(v0[2], v0[3]); w.z = cvt_pk_bf16(v1[0], v1[1]); w.w = cvt_pk_bf16(v1[2], v1[3]);
                    *(u32x4*)(rowp + bj * HALF) = w; } }
    }
};

template <class Epi, class Sched, int ES = 2, bool ALIGN_EPI = true>
__device__ __forceinline__ void gemm_phase(LAS unsigned char* lds, const int K, const Sched& S, const Epi& E) {
    constexpr bool GA = Sched::GATHER;
    const int tid = opaque_tid(), wid = __builtin_amdgcn_readfirstlane(tid >> 6), lane = tid & 63, wr = wid >> 2, wc = wid & 3, fr = lane & 15, fq = lane >> 4;
    const int nt = K * ES / (BK * 2);
    unsigned voffA[2], voffB[2]; int Rr[2]; unsigned Cb[2];
#pragma unroll
    for (int i = 0; i < 2; ++i) { int R, C; stage_rc(tid * 16 + i * 8192, R, C); const int Rb = Epi::PERM ? ((R & ~31) + perm32(R & 31)) : R;
        voffA[i] = (unsigned)(R * K * ES + C * 2); voffB[i] = (unsigned)(Rb * K * ES + C * 2); Rr[i] = R; Cb[i] = (unsigned)C * 2u; }
    const size_t kstep = (size_t)(BK * 2);
    const size_t hstep = (size_t)HALF * K * ES;
    const unsigned ldsw = (unsigned)wid * 1024u;
    const int aoff0 = lds_byte(wr * 64 + fr, ES == 2 ? fq * 8 : fq * 16), aoff1 = lds_byte(wr * 64 + fr, ES == 2 ? fq * 8 + 32 : fq * 16 + 8);
    const int boff0 = lds_byte(wc * 32 + fr, ES == 2 ? fq * 8 : fq * 16), boff1 = lds_byte(wc * 32 + fr, ES == 2 ? fq * 8 + 32 : fq * 16 + 8);
    unsigned cOff[2][2], nOff[2][2], sOff[2][2];
#define PG8_SA(b, h) (((b) * 2 + (h)) * HTB)
#define PG8_SB(b, h) ((4 + (b) * 2 + (h)) * HTB)
#define PG8_STAGE(bufoff, gbase, voff) do { _Pragma("unroll") for (int _i = 0; _i < 2; ++_i) \
        __builtin_amdgcn_global_load_lds((const unsigned*)((const char*)(gbase) + (voff)[_i]), (LAS unsigned*)(lds + (bufoff) + ldsw + _i * 8192), 16, 0, 0); } while (0)
#define PG8_STAGE_A(bufoff, gbase, half, OFF) do { if constexpr (GA) { PG8_STAGE(bufoff, gbase, (OFF)[half]); } else { PG8_STAGE(bufoff, (gbase) + (half) * hstep, voffA); } } while (0)
#define PG8_LDA(dst, b, h) do { if constexpr (ES == 2) { _Pragma("unroll") for (int m = 0; m < 4; ++m) _Pragma("unroll") for (int k = 0; k < 2; ++k) dst[m][k] = *(const LAS bf16x8*)(lds + PG8_SA(b, h) + (k ? aoff1 : aoff0) + m * 2048); } \
        else { _Pragma("unroll") for (int m = 0; m < 4; ++m) dst##8[m] = __builtin_shufflevector(*(const LAS v4i_t*)(lds + PG8_SA(b, h) + aoff0 + m * 2048), *(const LAS v4i_t*)(lds + PG8_SA(b, h) + aoff1 + m * 2048), 0, 1, 2, 3, 4, 5, 6, 7); } } while (0)
#define PG8_LDB(dst, b, h) do { if constexpr (ES == 2) { _Pragma("unroll") for (int n = 0; n < 2; ++n) _Pragma("unroll") for (int k = 0; k < 2; ++k) dst[n][k] = *(const LAS bf16x8*)(lds + PG8_SB(b, h) + (k ? boff1 : boff0) + n * 2048); } \
        else { _Pragma("unroll") for (int n = 0; n < 2; ++n) dst##8[n] = __builtin_shufflevector(*(const LAS v4i_t*)(lds + PG8_SB(b, h) + boff0 + n * 2048), *(const LAS v4i_t*)(lds + PG8_SB(b, h) + boff1 + n * 2048), 0, 1, 2, 3, 4, 5, 6, 7); } } while (0)
#define PG8_MMA(ai, bj, At, Bt) do { __builtin_amdgcn_s_setprio(1); _Pragma("unroll") for (int m = 0; m < 4; ++m) _Pragma("unroll") for (int n = 0; n < 2; ++n) { \
        if constexpr (ES == 2) { _Pragma("unroll") for (int k = 0; k < 2; ++k) acc[ai][bj][m][n] = __builtin_amdgcn_mfma_f32_16x16x32_bf16(Bt[n][k], At[m][k], acc[ai][bj][m][n], 0, 0, 0); } \
        else { asm volatile("v_mfma_scale_f32_16x16x128_f8f6f4 %0, %1, %2, %0, %3, %4 op_sel_hi:[0,0,0]" : "+v"(acc[ai][bj][m][n]) : "v"(Bt##8[n]), "v"(At##8[m]), "v"(wscale_v), "v"(ascale_v)); } } \
        __builtin_amdgcn_s_setprio(0); } while (0)
#define PG8_WAIT_V(n) asm volatile("s_waitcnt vmcnt(" #n ")" ::: "memory")
#define PG8_WAIT_L(n) asm volatile("s_waitcnt lgkmcnt(" #n ")" ::: "memory")
#define PG8_BAR __builtin_amdgcn_s_barrier()
#define PG8_SCHED __builtin_amdgcn_sched_barrier(0)
#define PG8_GOFF(dst, u) do { if constexpr (GA) { _Pragma("unroll") for (int _h = 0; _h < 2; ++_h) _Pragma("unroll") for (int _i = 0; _i < 2; ++_i) \
        dst[_h][_i] = S.row_tok(u, _h * HALF + Rr[_i]) * (unsigned)(K * ES) + Cb[_i]; } } while (0)
    Unit cur, nxt; int ui = 0;
    if (!S.next(0, cur)) return;
    f32x4 acc[2][2][4][2];
#pragma unroll
    for (int a = 0; a < 2; ++a)
#pragma unroll
        for (int b = 0; b < 2; ++b)
#pragma unroll
            for (int m = 0; m < 4; ++m)
#pragma unroll
                for (int n = 0; n < 2; ++n) acc[a][b][m][n] = (f32x4){0.f, 0.f, 0.f, 0.f};
    int wscale_v = Epi::WSCALE, ascale_v = 127; asm volatile("" : "+v"(wscale_v), "+v"(ascale_v));
    bf16x8 At[4][2], B0[2][2], B1[2][2];
    v8i_t At8[4], B08[2], B18[2];
    const char* cA = cur.A; const char* cB = cur.B;
    PG8_GOFF(cOff, cur);
#pragma unroll
    for (int h = 0; h < 2; ++h)
#pragma unroll
        for (int i = 0; i < 2; ++i) { nOff[h][i] = 0u; sOff[h][i] = 0u; }
    if constexpr (GA) { VM_WAIT(); }
    PG8_STAGE(PG8_SB(0, 0), cB, voffB); PG8_STAGE(PG8_SB(0, 1), cB + hstep, voffB); PG8_STAGE_A(PG8_SA(0, 0), cA, 0, cOff); PG8_STAGE_A(PG8_SA(0, 1), cA, 1, cOff);
    if (wr == 1) PG8_BAR;
    PG8_WAIT_V(2); PG8_BAR;
    PG8_STAGE(PG8_SB(1, 0), cB + kstep, voffB); PG8_STAGE_A(PG8_SA(1, 0), cA + kstep, 0, cOff); PG8_STAGE(PG8_SB(1, 1), cB + hstep + kstep, voffB);
    PG8_WAIT_V(6); PG8_BAR;
    for (;;) {
        const bool has_next = S.next(ui + 1, nxt);
        const char* nA = has_next ? nxt.A : cA; const char* nB = has_next ? nxt.B : cB;
        if constexpr (GA) { if (has_next) { PG8_GOFF(nOff, nxt); } else {
#pragma unroll
            for (int h = 0; h < 2; ++h)
#pragma unroll
                for (int i = 0; i < 2; ++i) nOff[h][i] = cOff[h][i]; } }
#pragma unroll 1
        for (int t = 0; t < nt; t += 2) {
            const bool last = (t == nt - 2);
            const char* a1 = cA + (size_t)(t + 1) * kstep;
            const char* a2 = last ? nA : cA + (size_t)(t + 2) * kstep; const char* b2 = last ? nB : cB + (size_t)(t + 2) * kstep;
            const char* a3 = a2 + kstep; const char* b3 = b2 + kstep;
            if constexpr (GA) {
#pragma unroll
                for (int h = 0; h < 2; ++h)
#pragma unroll
                    for (int i = 0; i < 2; ++i) sOff[h][i] = last ? nOff[h][i] : cOff[h][i]; }
            PG8_LDB(B0, 0, 0); PG8_LDB(B1, 0, 1); PG8_SCHED; PG8_LDA(At, 0, 0); PG8_STAGE_A(PG8_SA(1, 1), a1, 1, cOff);
            PG8_WAIT_V(8); PG8_WAIT_L(0); PG8_BAR; PG8_MMA(0, 0, At, B0); PG8_MMA(0, 1, At, B1); PG8_BAR; PG8_SCHED;
            PG8_LDA(At, 0, 1); PG8_STAGE(PG8_SB(0, 0), b2, voffB); PG8_STAGE(PG8_SB(0, 1), b2 + hstep, voffB); PG8_STAGE_A(PG8_SA(0, 0), a2, 0, sOff);
            PG8_WAIT_V(8); PG8_WAIT_L(0); PG8_BAR; PG8_MMA(1, 0, At, B0); PG8_MMA(1, 1, At, B1); PG8_BAR; PG8_SCHED;
            PG8_LDB(B0, 1, 0); PG8_LDB(B1, 1, 1); PG8_SCHED; PG8_LDA(At, 1, 0); PG8_STAGE_A(PG8_SA(0, 1), a2, 1, sOff);
            PG8_WAIT_V(8); PG8_WAIT_L(0); PG8_BAR; PG8_MMA(0, 0, At, B0); PG8_MMA(0, 1, At, B1); PG8_BAR; PG8_SCHED;
            PG8_LDA(At, 1, 1); PG8_STAGE(PG8_SB(1, 0), b3, voffB); PG8_STAGE(PG8_SB(1, 1), b3 + hstep, voffB); PG8_STAGE_A(PG8_SA(1, 0), a3, 0, sOff);
            PG8_WAIT_V(8); PG8_WAIT_L(0); PG8_BAR; PG8_MMA(1, 0, At, B0); PG8_MMA(1, 1, At, B1); PG8_BAR; PG8_SCHED;
        }
        if constexpr (ALIGN_EPI) { if (wr == 0) PG8_BAR; }
        if constexpr (ES == 1) { asm volatile("s_nop 15\n\ts_nop 15" ::: "memory"); }
        E(acc, cur, wr, wc, fr, fq);
        if (!has_next) break;
#pragma unroll
        for (int a = 0; a < 2; ++a)
#pragma unroll
            for (int b = 0; b < 2; ++b)
#pragma unroll
                for (int m = 0; m < 4; ++m)
#pragma unroll
                    for (int n = 0; n < 2; ++n) acc[a][b][m][n] = (f32x4){0.f, 0.f, 0.f, 0.f};
        cur = nxt; cA = nA; cB = nB; ++ui;
        if constexpr (GA) {
#pragma unroll
            for (int h = 0; h < 2; ++h)
#pragma unroll
                for (int i = 0; i < 2; ++i) cOff[h][i] = nOff[h][i]; }
        if constexpr (ALIGN_EPI) { if (wr == 1) PG8_BAR; }
    }
    PG8_WAIT_V(0);
    if constexpr (!ALIGN_EPI) { if (wr == 0) PG8_BAR; }
    PG8_BAR;
#undef PG8_SA
#undef PG8_SB
#undef PG8_STAGE
#undef PG8_STAGE_A
#undef PG8_LDA
#undef PG8_LDB
#undef PG8_MMA
#undef PG8_WAIT_V
#undef PG8_WAIT_L
#undef PG8_BAR
#undef PG8_SCHED
#undef PG8_GOFF
}
}

#define XB_TMO      128
#define XB_XCNT(j)  (256  + 64 * (j))
#define XB_XSUB(j)  (1280 + 64 * (j))
#define XB_XGEN(j)  (2304 + 64 * (j))
#define XB_TOP      3328
#define XB_TOPGEN   3392
#define XCD_BAR_WORDS 3456
#define XB_SPIN_CAP (1u << 18)
__device__ __forceinline__ unsigned xb_ld(unsigned* p)              { return __hip_atomic_load(p, __ATOMIC_RELAXED, __HIP_MEMORY_SCOPE_AGENT); }
__device__ __forceinline__ unsigned xb_add(unsigned* p, unsigned v) { return __hip_atomic_fetch_add(p, v, __ATOMIC_RELAXED, __HIP_MEMORY_SCOPE_AGENT); }
__device__ __forceinline__ unsigned xb_xcc_id() { return (unsigned)__builtin_amdgcn_s_getreg((3 << 11) | 20) & 0xFu; }
#define XB_SPIN(cond, bar) do { unsigned _sp = 0; while (cond) { __builtin_amdgcn_s_sleep(1); \
    if ((++_sp & 255u) == 0u) { if (xb_ld(&(bar)[XB_TMO])) break; if (_sp > XB_SPIN_CAP) { atomicAdd(&(bar)[XB_TMO], 1u); break; } } } } while (0)
struct XcdBarrier { unsigned* bar; unsigned x; volatile LAS unsigned* st; };
__device__ __forceinline__ XcdBarrier xcd_barrier_post(unsigned* bar, volatile LAS unsigned* st) {
    XcdBarrier b; b.bar = bar; b.x = xb_xcc_id(); b.st = st;
    if (threadIdx.x == 0) (void)xb_add(&bar[XB_XCNT(b.x)], 1u);
    return b;
}
__device__ __forceinline__ void xcd_barrier_complete(unsigned* bar, unsigned x, unsigned& nloc, unsigned& nx) {
    const unsigned G = gridDim.x * gridDim.y * gridDim.z;
    unsigned sum, cnt, mine, sp = 0u;
    for (;;) {
        sum = 0u; cnt = 0u; mine = 0u;
#pragma unroll
        for (unsigned j = 0; j < 16; ++j) { const unsigned c = xb_ld(&bar[XB_XCNT(j)]); sum += c; cnt += (c > 0u) ? 1u : 0u; mine = (j == x) ? c : mine; }
        if (sum == G) break;
        __builtin_amdgcn_s_sleep(1);
        if ((++sp & 255u) == 0u) { if (xb_ld(&bar[XB_TMO])) break; if (sp > XB_SPIN_CAP) { atomicAdd(&bar[XB_TMO], 1u); break; } }
    }
    nloc = mine > 0u ? mine : 1u; nx = cnt > 0u ? cnt : 1u;
}
__device__ __forceinline__ void xcd_barrier(const XcdBarrier& b) {
    asm volatile("s_waitcnt vmcnt(0)" ::: "memory");
    __syncthreads();
    if (threadIdx.x == 0) {
        unsigned* bar = b.bar;
        __builtin_amdgcn_s_waitcnt(0);
        unsigned nloc = b.st[0], nx = b.st[1];
        if (nloc == 0u) { xcd_barrier_complete(bar, b.x, nloc, nx); b.st[0] = nloc; b.st[1] = nx; }
        const unsigned old = xb_add(&bar[XB_XSUB(b.x)], 1u);
        const unsigned gen = old / nloc;
        if (old + 1u == (gen + 1u) * nloc) {
            __builtin_amdgcn_fence(__ATOMIC_RELEASE, "agent");
            asm volatile("s_waitcnt vmcnt(0)" ::: "memory");
            const unsigned og = xb_add(&bar[XB_TOP], 1u);
            const unsigned tg = og / nx;
            if (og + 1u == (tg + 1u) * nx) xb_add(&bar[XB_TOPGEN], 1u);
            else XB_SPIN(xb_ld(&bar[XB_TOPGEN]) == tg, bar);
            __builtin_amdgcn_fence(__ATOMIC_ACQUIRE, "agent");
            xb_add(&bar[XB_XGEN(b.x)], 1u);
            asm volatile("s_waitcnt vmcnt(0)" ::: "memory");
        } else {
            XB_SPIN(xb_ld(&bar[XB_XGEN(b.x)]) == gen, bar);
            __builtin_amdgcn_fence(__ATOMIC_ACQUIRE, "agent");
            asm volatile("s_waitcnt vmcnt(0)" ::: "memory");
        }
    }
    __syncthreads();
}

struct Args {
    const float* in[33];
    float* out; unsigned char* ws;
    int ph_lo, ph_hi;
};
enum { I_X = 0, I_MEM, I_WIN, I_GLACONV, I_GLAW2, I_GLAB, I_GLANG, I_HGLB, I_HGNG, I_RWMU, I_RWW0, I_RWW2, I_RWA0, I_RWA2, I_RWG2, I_RWKK, I_RWKA, I_RWRK, I_RWLNW, I_RWLNB,
       I_WMK, I_WMV, I_WOUT, I_LN1G, I_LN1B, I_RTW, I_RTB, I_WGU, I_BGU, I_WDN, I_BDN, I_LN2G, I_LN2B };


template <int OFF> __device__ __forceinline__ unsigned long long ka_u64() { unsigned long long v; asm volatile("s_load_dwordx2 %0, %1, %2\n\ts_waitcnt lgkmcnt(0)" : "=s"(v) : "s"(__builtin_amdgcn_kernarg_segment_ptr()), "n"(OFF)); return v; }
#define KIN(i) ((const float*)(const GAS float*)ka_u64<8 * (i)>())
#define KOUT() ((float*)(GAS float*)ka_u64<264>())
#define KWS() ((unsigned char*)(GAS unsigned char*)ka_u64<272>())

template <class Map>
__device__ __forceinline__ void tr_item(const float* __restrict__ W, int K, int N, bf16* __restrict__ WT, LAS float* scr, int kb, int nb, int lane, Map map) {
    const int k0 = 64 * kb, n0 = 64 * nb, col = n0 + lane; const bool valid = col < N;
    const float* src = W + (size_t)k0 * N + (valid ? col : 0);
#pragma unroll 16
    for (int kk = 0; kk < 64; ++kk) { const float v = valid ? src[(size_t)kk * N] : 0.f; scr[kk * 65 + lane] = v; }
    LDS_WAIT(); asm volatile("" ::: "memory");
    const int c = lane & 7;
#pragma unroll
    for (int j = 0; j < 8; ++j) { const int n = (lane >> 3) + 8 * j;
        if (n0 + n < N) { const int orow = map(n0 + n); const LAS float* s = scr + (8 * c) * 65 + n;
            u32x4 o; o.x = pk2(s[0 * 65], s[1 * 65]); o.y = pk2(s[2 * 65], s[3 * 65]); o.z = pk2(s[4 * 65], s[5 * 65]); o.w = pk2(s[6 * 65], s[7 * 65]);
            *(u32x4*)(WT + (size_t)orow * K + k0 + 8 * c) = o; } }
    LDS_WAIT(); asm volatile("" ::: "memory");
}
template <class Map>
__device__ __forceinline__ void tr_item_f8(const float* __restrict__ W, int K, int N, unsigned char* __restrict__ WT8, LAS float* scr, int kb, int nb, int lane, float scale, Map map) {
    const int k0 = 64 * kb, n0 = 64 * nb, col = n0 + lane;
    const float* src = W + (size_t)k0 * N + col;
#pragma unroll 16
    for (int kk = 0; kk < 64; ++kk) scr[kk * 65 + lane] = src[(size_t)kk * N] * scale;
    LDS_WAIT(); asm volatile("" ::: "memory");
    const int c = lane & 3;
#pragma unroll
    for (int j = 0; j < 4; ++j) { const int n = (lane >> 2) + 16 * j; const int orow = map(n0 + n); const LAS float* s = scr + (16 * c) * 65 + n;
        u32x4 o;
#pragma unroll
        for (int q = 0; q < 4; ++q) { int w = __builtin_amdgcn_cvt_pk_fp8_f32(s[(4 * q) * 65], s[(4 * q + 1) * 65], 0, false); w = __builtin_amdgcn_cvt_pk_fp8_f32(s[(4 * q + 2) * 65], s[(4 * q + 3) * 65], w, true); o[q] = (unsigned)w; }
        *(u32x4*)(WT8 + (size_t)orow * K + k0 + 16 * c) = o; }
    LDS_WAIT(); asm volatile("" ::: "memory");
}
struct MapIdent { int off; __device__ __forceinline__ int operator()(int c) const { return c + off; } };
struct MapWin { __device__ __forceinline__ int operator()(int c) const { return c < 512 ? c : (c < 528 ? c + 2560 : c - 16); } };
__device__ __forceinline__ int gu_row(int c) { const int f = c >> 1, bj = c & 1, pn = f >> 7, fl = f & 127, wc = fl >> 5, fq = (fl >> 3) & 3, n = (fl >> 2) & 1, j = fl & 3; return 256 * pn + 128 * bj + 32 * wc + 16 * n + 4 * fq + j; }
struct MapGu { __device__ __forceinline__ int operator()(int c) const { return gu_row(c); } };

__device__ __forceinline__ void prologue_phase(LAS unsigned char* lds, int vcu, int G) {
    const int tid = opaque_tid(), lane = tid & 63, wave = __builtin_amdgcn_readfirstlane(tid >> 6);
    LAS float* scr = (LAS float*)(lds + wave * 16640); static_assert(8 * 16640 <= LDSCTL_OFF, "prologue scratch below the LDS control words");
    const int gw = vcu * NWAVES + wave, NGW = G * NWAVES;
    unsigned char* ws = KWS();
    constexpr int IT_GU = NL * NE * 512, IT_DN = NL * NE * 256, IT_IN = NL * 16 * 49, IT_OUT = NL * 256, IT_MEM = NL * 2 * 64, IT_L64 = NL * 2 * 4, IT_L128 = NL * 2 * 4;
    constexpr int IT_TOTAL = IT_GU + IT_DN + IT_IN + IT_OUT + IT_MEM + IT_L64 + IT_L128;
    for (int it = gw; it < IT_TOTAL; it += NGW) {
        int r = it;
        if (r < IT_GU) { const int le = r >> 9, q = r & 511, kb = q >> 5, nb = q & 31;
            tr_item_f8(KIN(I_WGU) + (size_t)le * 1024 * 2048, 1024, 2048, (unsigned char*)(ws + WS_WGU) + (size_t)le * 2048 * 1024, scr, kb, nb, lane, 16.0f, MapGu{}); continue; } r -= IT_GU;
        if (r < IT_DN) { const int le = r >> 8, q = r & 255, kb = q >> 4, nb = q & 15;
            tr_item_f8(KIN(I_WDN) + (size_t)le * 1024 * 1024, 1024, 1024, (unsigned char*)(ws + WS_WD) + (size_t)le * 1024 * 1024, scr, kb, nb, lane, 32.0f, MapIdent{0}); continue; } r -= IT_DN;
        if (r < IT_IN) { const int l = r / (16 * 49), q = r % (16 * 49), kb = q / 49, nb = q % 49;
            tr_item(KIN(I_WIN) + (size_t)l * 1024 * PIN, 1024, PIN, (bf16*)(ws + WS_WIN) + (size_t)l * PINP * 1024, scr, kb, nb, lane, MapWin{}); continue; } r -= IT_IN;
        if (r < IT_OUT) { const int l = r >> 8, q = r & 255, kb = q >> 4, nb = q & 15;
            tr_item(KIN(I_WOUT) + (size_t)l * 1024 * 1024, 1024, 1024, (bf16*)(ws + WS_WOUT) + (size_t)l * 1024 * 1024, scr, kb, nb, lane, MapIdent{0}); continue; } r -= IT_OUT;
        if (r < IT_MEM) { const int l = r >> 7, q = r & 127, kv = q >> 6, kb = (q >> 2) & 15, nb = q & 3;
            tr_item((kv ? KIN(I_WMV) : KIN(I_WMK)) + (size_t)l * 1024 * 256, 1024, 256, (bf16*)(ws + WS_WMEM), scr, kb, nb, lane, MapIdent{l * 512 + kv * 256}); continue; } r -= IT_MEM;
        if (r < IT_L64) { const int l = r >> 3, q = r & 7, wa = q >> 2, nb = q & 3;
            tr_item((wa ? KIN(I_RWA2) : KIN(I_RWW2)) + (size_t)l * 64 * 256, 64, 256, (bf16*)(ws + WS_LORA) + (size_t)wa * (NL * 256 * 64) + (size_t)l * 256 * 64, scr, 0, nb, lane, MapIdent{0}); continue; } r -= IT_L64;
        { const int l = r >> 3, q = r & 7, kb = q >> 2, nb = q & 3;
            tr_item(KIN(I_RWG2) + (size_t)l * 128 * 256, 128, 256, (bf16*)(ws + WS_LORA) + (size_t)2 * (NL * 256 * 64) + (size_t)l * 256 * 128, scr, kb, nb, lane, MapIdent{0}); }
    }
    { const size_t gt = (size_t)vcu * NTHR + tid, GT = (size_t)G * NTHR; constexpr size_t per = (size_t)(PINP - PIN) * 1024 / 8;
        for (size_t i = gt; i < per * NL; i += GT) { const size_t l = i / per, j = i % per; *(u32x4*)((bf16*)(ws + WS_WIN) + l * PINP * 1024 + (size_t)PIN * 1024 + j * 8) = (u32x4){0u, 0u, 0u, 0u}; }
        for (size_t i = gt; i < (size_t)NL * NE * 2048; i += GT) { const size_t le = i >> 11; const int c = (int)(i & 2047); ((float*)(ws + WS_BGU))[le * 2048 + gu_row(c)] = KIN(I_BGU)[i]; }
        const f32x4* xs = (const f32x4*)KIN(I_X); u32x4* xd = (u32x4*)(ws + WS_XB);
        for (size_t i = gt; i < (size_t)NTOK * D / 8; i += GT) { const f32x4 v0 = xs[2 * i], v1 = xs[2 * i + 1]; xd[i] = (u32x4){pk2(v0[0], v0[1]), pk2(v0[2], v0[3]), pk2(v1[0], v1[1]), pk2(v1[2], v1[3])}; }
        const f32x4* ms = (const f32x4*)KIN(I_MEM); u32x4* md = (u32x4*)(ws + WS_MEMB);
        for (size_t i = gt; i < (size_t)NB * NMEM * D / 8; i += GT) { const f32x4 v0 = ms[2 * i], v1 = ms[2 * i + 1]; md[i] = (u32x4){pk2(v0[0], v0[1]), pk2(v0[2], v0[3]), pk2(v1[0], v1[1]), pk2(v1[2], v1[3])}; }
    }
}


__device__ __forceinline__ float log1pexp_neg_abs(float z) { return __builtin_amdgcn_logf(1.0f + fast_exp(-fabsf(z))) * 0.6931471805599453f; }
__device__ __forceinline__ float tanh_f(float x) { const float e = fast_exp(-2.0f * fabsf(x)); const float t = (1.0f - e) * __builtin_amdgcn_rcpf(1.0f + e); return x < 0.f ? -t : t; }

constexpr int NCH = T / 32;
__device__ __forceinline__ int rho16(int r, int hh) { return (r & 3) + 8 * (r >> 2) + 4 * hh; }
__device__ __forceinline__ void hg_fused_unit(LAS unsigned char* lds, int l, int b, int c) {
    const int tid = opaque_tid(), lane = tid & 63, wave = __builtin_amdgcn_readfirstlane(tid >> 6), r32 = lane & 31, hh = lane >> 5;
    unsigned char* ws = KWS();
    const bf16* P = (const bf16*)(ws + WS_P) + ((size_t)b * T + c * 32) * PINP;
    constexpr int HB = 8448;
    if (tid < 256) {
        const int ch = tid, h = ch >> 6, d = ch & 63; const size_t un = (size_t)(b * 4 + h) * NCH + c;
        float lb;
        { const float* hp = KIN(I_HGLB) + ch; const float v0 = hp[0], v1 = hp[256], v2 = hp[512], v3 = hp[768]; const float m = fmaxf(fmaxf(v0, v1), fmaxf(v2, v3));
          const float e0 = __expf(v0 - m), e1 = __expf(v1 - m), e2 = __expf(v2 - m), e3 = __expf(v3 - m); const float inv = 1.0f / (e0 + e1 + e2 + e3);
          lb = (l >= 1 ? e1 : 0.f) + (l >= 2 ? e2 : 0.f) + (l >= 3 ? e3 : 0.f); lb *= inv; }
        const float oml = 1.0f - lb;
        LAS bf16* KT = (LAS bf16*)(lds + h * HB); LAS float* BE = (LAS float*)(lds + h * HB + 8192);
        bf16* Qg = (bf16*)(ws + WS_HQ) + un * 2048 + d; bf16* Kg = (bf16*)(ws + WS_HK) + un * 2048 + d;
        float bc = 0.f;
        unsigned short hqr[32], hfr[32];
#pragma unroll
        for (int t = 0; t < 32; ++t) { const bf16* row = P + (size_t)t * PINP; hqr[t] = row[PC_HQ + ch]; hfr[t] = row[PC_HF + ch]; }
#pragma unroll
        for (int t8 = 0; t8 < 4; ++t8) { u32x4 kp;
#pragma unroll
            for (int jj = 0; jj < 4; ++jj) { float k2[2];
#pragma unroll
                for (int e = 0; e < 2; ++e) { const int t = t8 * 8 + jj * 2 + e; const float hf = bf2f(hfr[t]); const float s = fast_sigmoid(hf), sn = fast_sigmoid(-hf);
                    bc = fmaxf(bc + __builtin_amdgcn_logf(fmaxf(lb + oml * s, 1e-30f)) * 0.6931471805599453f, -80.0f);
                    const float qt = silu_f(bf2f(hqr[t])) * fast_exp(bc), kt = oml * sn * fast_exp(-bc);
                    Qg[t * 64] = (bf16)f2bf(qt); Kg[t * 64] = (bf16)f2bf(kt); k2[e] = kt; }
                kp[jj] = pk2(k2[0], k2[1]); }
            *(LAS u32x4*)(KT + d * 32 + t8 * 8) = kp; }
        const float ebend = fast_exp(bc); BE[d] = ebend; ((float*)(ws + WS_HBE))[un * 64 + d] = ebend;
    } else {
        const int cv = tid - 256, h = cv >> 6, vi = cv & 63; const size_t un = (size_t)(b * 4 + h) * NCH + c;
        LAS bf16* VT = (LAS bf16*)(lds + h * HB + 4096); bf16* VTg = (bf16*)(ws + WS_HVT) + un * 2048 + vi * 32;
        unsigned short hvr[32];
#pragma unroll
        for (int t = 0; t < 32; ++t) hvr[t] = P[(size_t)t * PINP + PC_HI + cv];
#pragma unroll
        for (int t8 = 0; t8 < 4; ++t8) { u32x4 vp;
#pragma unroll
            for (int jj = 0; jj < 4; ++jj) vp[jj] = (unsigned)hvr[t8 * 8 + 2 * jj] | ((unsigned)hvr[t8 * 8 + 2 * jj + 1] << 16);
            *(LAS u32x4*)(VT + vi * 32 + t8 * 8) = vp; *(u32x4*)(VTg + t8 * 8) = vp; }
    }
    __syncthreads();
    { const int h = wave >> 1, vt = wave & 1; const size_t un = (size_t)(b * 4 + h) * NCH + c;
      const LAS bf16* KT = (const LAS bf16*)(lds + h * HB); const LAS bf16* VT = (const LAS bf16*)(lds + h * HB + 4096); const LAS float* BE = (const LAS float*)(lds + h * HB + 8192);
      float* DSg = (float*)(ws + WS_HDS) + un * 4096;
#pragma unroll
      for (int dt = 0; dt < 2; ++dt) { f32x16 acc;
#pragma unroll
          for (int i = 0; i < 16; ++i) acc[i] = 0.f;
#pragma unroll
          for (int s = 0; s < 2; ++s) { const bf16x8 A = *(const LAS bf16x8*)(VT + (32 * vt + r32) * 32 + 16 * s + 8 * hh), B = *(const LAS bf16x8*)(KT + (32 * dt + r32) * 32 + 16 * s + 8 * hh);
              acc = __builtin_amdgcn_mfma_f32_32x32x16_bf16(A, B, acc, 0, 0, 0); }
          const float ebd = BE[32 * dt + r32];
#pragma unroll
          for (int r = 0; r < 16; ++r) DSg[(32 * vt + rho16(r, hh)) * 64 + 32 * dt + r32] = acc[r] * ebd; } }
    __syncthreads();
}
__device__ __forceinline__ void gla_fused_unit(LAS unsigned char* lds, int l, int b, int c) {
    const int tid = opaque_tid(), lane = tid & 63, wave = __builtin_amdgcn_readfirstlane(tid >> 6), r32 = lane & 31, hh = lane >> 5;
    unsigned char* ws = KWS();
    const int t0 = c * 32;
    const bf16* P = (const bf16*)(ws + WS_P) + ((size_t)b * T + t0) * PINP;
    LAS float* GL = (LAS float*)lds;
    constexpr int HB = 6272, H0 = 2048;
    GL[tid] = bf2f(P[(size_t)(tid >> 4) * PINP + PC_GLR + (tid & 15)]);
    __syncthreads();
    if (tid < 128) {
        const int ch = tid, h = ch >> 5, d = ch & 31; const size_t un = (size_t)(b * 4 + h) * NCH + c;
        const float* cw = KIN(I_GLACONV) + (size_t)l * 4 * 512 + ch;
        const float q0 = cw[0], q1 = cw[512], q2 = cw[1024], q3 = cw[1536], k0 = cw[128], k1 = cw[640], k2w = cw[1152], k3 = cw[1664];
        const float* w2p = KIN(I_GLAW2) + (size_t)l * 16 * 128 + ch; float wc[16];
#pragma unroll
        for (int r = 0; r < 16; ++r) wc[r] = w2p[r * 128];
        const float gb = KIN(I_GLAB)[l * 128 + ch];
        float uq0 = 0.f, uq1 = 0.f, uq2 = 0.f, uk0 = 0.f, uk1 = 0.f, uk2 = 0.f;
        if (t0 > 0) { uq0 = bf2f(*(P - 3 * PINP + PC_GQ + ch)); uq1 = bf2f(*(P - 2 * PINP + PC_GQ + ch)); uq2 = bf2f(*(P - PINP + PC_GQ + ch));
                      uk0 = bf2f(*(P - 3 * PINP + PC_GK + ch)); uk1 = bf2f(*(P - 2 * PINP + PC_GK + ch)); uk2 = bf2f(*(P - PINP + PC_GK + ch)); }
        LAS bf16* KT = (LAS bf16*)(lds + H0 + h * HB); LAS float* BE = (LAS float*)(lds + H0 + h * HB + 6144);
        bf16* Qg = (bf16*)(ws + WS_GQ) + un * 1024 + d; bf16* Kg = (bf16*)(ws + WS_GK) + un * 1024 + d;
        float bc = 0.f;
        unsigned short xqr[32], xkr[32];
#pragma unroll
        for (int t = 0; t < 32; ++t) { const bf16* row = P + (size_t)t * PINP; xqr[t] = row[PC_GQ + ch]; xkr[t] = row[PC_GK + ch]; }
#pragma unroll
        for (int t8 = 0; t8 < 4; ++t8) { u32x4 kp;
#pragma unroll
            for (int jj = 0; jj < 4; ++jj) { float kk2[2];
#pragma unroll
                for (int e = 0; e < 2; ++e) { const int t = t8 * 8 + jj * 2 + e; const float uq3 = bf2f(xqr[t]), uk3 = bf2f(xkr[t]);
                    const float q = silu_f(q0 * uq0 + q1 * uq1 + q2 * uq2 + q3 * uq3) * 0.17677669529663687f, k = silu_f(k0 * uk0 + k1 * uk1 + k2w * uk2 + k3 * uk3);
                    uq0 = uq1; uq1 = uq2; uq2 = uq3; uk0 = uk1; uk1 = uk2; uk2 = uk3;
                    float z = gb;
#pragma unroll
                    for (int r = 0; r < 16; ++r) z += GL[t * 16 + r] * wc[r];
                    bc = fmaxf(bc + (fminf(z, 0.f) - log1pexp_neg_abs(z)) * 0.0625f, -80.0f);
                    const float qt = q * fast_exp(bc), kt = k * fast_exp(-bc);
                    Qg[t * 32] = (bf16)f2bf(qt); Kg[t * 32] = (bf16)f2bf(kt); kk2[e] = kt; }
                kp[jj] = pk2(kk2[0], kk2[1]); }
            *(LAS u32x4*)(KT + d * 32 + t8 * 8) = kp; }
        const float ebend = fast_exp(bc); BE[d] = ebend; ((float*)(ws + WS_GBE))[un * 32 + d] = ebend;
    } else if (tid < 384) {
        const int cv = tid - 128, h = cv >> 6, vi = cv & 63; const size_t un = (size_t)(b * 4 + h) * NCH + c;
        const float* cw = KIN(I_GLACONV) + (size_t)l * 4 * 512 + 256 + cv;
        const float w0 = cw[0], w1 = cw[512], w2 = cw[1024], w3 = cw[1536];
        float u0 = 0.f, u1 = 0.f, u2 = 0.f;
        if (t0 > 0) { u0 = bf2f(*(P - 3 * PINP + PC_GV + cv)); u1 = bf2f(*(P - 2 * PINP + PC_GV + cv)); u2 = bf2f(*(P - PINP + PC_GV + cv)); }
        LAS bf16* VT = (LAS bf16*)(lds + H0 + h * HB + 2048); bf16* VTg = (bf16*)(ws + WS_GVT) + un * 2048 + vi * 32;
        unsigned short xvr[32];
#pragma unroll
        for (int t = 0; t < 32; ++t) xvr[t] = P[(size_t)t * PINP + PC_GV + cv];
#pragma unroll
        for (int t8 = 0; t8 < 4; ++t8) { u32x4 vp; float yv[8];
#pragma unroll
            for (int e = 0; e < 8; ++e) { const float u3 = bf2f(xvr[t8 * 8 + e]); yv[e] = silu_f(w0 * u0 + w1 * u1 + w2 * u2 + w3 * u3); u0 = u1; u1 = u2; u2 = u3; }
#pragma unroll
            for (int jj = 0; jj < 4; ++jj) vp[jj] = pk2(yv[2 * jj], yv[2 * jj + 1]);
            *(LAS u32x4*)(VT + vi * 32 + t8 * 8) = vp; *(u32x4*)(VTg + t8 * 8) = vp; }
    }
    __syncthreads();
    { const int h = wave >> 1, vt = wave & 1; const size_t un = (size_t)(b * 4 + h) * NCH + c;
      const LAS bf16* KT = (const LAS bf16*)(lds + H0 + h * HB); const LAS bf16* VT = (const LAS bf16*)(lds + H0 + h * HB + 2048); const LAS float* BE = (const LAS float*)(lds + H0 + h * HB + 6144);
      float* DSg = (float*)(ws + WS_GDS) + un * 2048;
      f32x16 acc;
#pragma unroll
      for (int i = 0; i < 16; ++i) acc[i] = 0.f;
#pragma unroll
      for (int s = 0; s < 2; ++s) { const bf16x8 A = *(const LAS bf16x8*)(VT + (32 * vt + r32) * 32 + 16 * s + 8 * hh), B = *(const LAS bf16x8*)(KT + r32 * 32 + 16 * s + 8 * hh);
          acc = __builtin_amdgcn_mfma_f32_32x32x16_bf16(A, B, acc, 0, 0, 0); }
      const float ebd = BE[r32];
#pragma unroll
      for (int r = 0; r < 16; ++r) DSg[(32 * vt + rho16(r, hh)) * 32 + r32] = acc[r] * ebd; }
    __syncthreads();
}
template <int DK>
__device__ __forceinline__ void m2_gh_elem2(int e2, const float* __restrict__ DS, const float* __restrict__ BE, bf16* __restrict__ SG) {
    constexpr int EPB = 64 * DK; const int e = e2 * 2, bh = e / EPB, idx = e % EPB, d = idx % DK; const size_t un0 = (size_t)bh * NCH;
    float S0 = 0.f, S1 = 0.f;
#pragma unroll 1
    for (int c0 = 0; c0 < NCH; c0 += 16) { f32x2 ds[16], be[16];
#pragma unroll
        for (int u = 0; u < 16; ++u) { ds[u] = *(const f32x2*)(DS + (un0 + c0 + u) * EPB + idx); be[u] = *(const f32x2*)(BE + (un0 + c0 + u) * DK + d); }
#pragma unroll
        for (int u = 0; u < 16; ++u) { *(unsigned*)(SG + (un0 + c0 + u) * EPB + idx) = pk2(S0, S1); S0 = S0 * be[u][0] + ds[u][0]; S1 = S1 * be[u][1] + ds[u][1]; } }
}
template <int DK>
__device__ __forceinline__ void m3_gh_task(int lane, const bf16* __restrict__ Qg, const bf16* __restrict__ Kg, const bf16* __restrict__ VTg, const bf16* __restrict__ Sg,
                                           const bf16* __restrict__ gate  , const float* __restrict__ ng  , bf16* __restrict__ orow  ) {
    const int r32 = lane & 31, hh = lane >> 5;
    bf16x8 qf[DK / 16];
    f32x16 at;
#pragma unroll
    for (int i = 0; i < 16; ++i) at[i] = 0.f;
#pragma unroll
    for (int s = 0; s < DK / 16; ++s) { qf[s] = *(const bf16x8*)(Qg + r32 * DK + 16 * s + 8 * hh); const bf16x8 kf = *(const bf16x8*)(Kg + r32 * DK + 16 * s + 8 * hh);
        at = __builtin_amdgcn_mfma_f32_32x32x16_bf16(kf, qf[s], at, 0, 0, 0); }
#pragma unroll
    for (int r = 0; r < 16; ++r) if (rho16(r, hh) > r32) at[r] = 0.f;
    f32x16 o[2];
#pragma unroll
    for (int vt = 0; vt < 2; ++vt)
#pragma unroll
        for (int i = 0; i < 16; ++i) o[vt][i] = 0.f;
#pragma unroll
    for (int s = 0; s < 2; ++s) { union { bf16x8 v; unsigned w[4]; } pf;
#pragma unroll
        for (int j = 0; j < 4; ++j) pf.w[j] = cvt_pk_bf16(at[8 * s + 2 * j], at[8 * s + 2 * j + 1]);
#pragma unroll
        for (int vt = 0; vt < 2; ++vt) { const bf16* vp = VTg + (32 * vt + r32) * 32 + 16 * s + 4 * hh;
            union { bf16x8 v; s16x4 h2[2]; } vf; vf.h2[0] = *(const s16x4*)vp; vf.h2[1] = *(const s16x4*)(vp + 8);
            o[vt] = __builtin_amdgcn_mfma_f32_32x32x16_bf16(vf.v, pf.v, o[vt], 0, 0, 0); } }
#pragma unroll
    for (int vt = 0; vt < 2; ++vt)
#pragma unroll
        for (int s = 0; s < DK / 16; ++s) { const bf16x8 sf = *(const bf16x8*)(Sg + (32 * vt + r32) * DK + 16 * s + 8 * hh);
            o[vt] = __builtin_amdgcn_mfma_f32_32x32x16_bf16(sf, qf[s], o[vt], 0, 0, 0); }
    float ss = 0.f;
#pragma unroll
    for (int vt = 0; vt < 2; ++vt)
#pragma unroll
        for (int i = 0; i < 16; ++i) ss += o[vt][i] * o[vt][i];
    ss += __shfl_xor(ss, 32);
    const float rstd = 1.0f / sqrtf(ss * (1.0f / 64.0f) + RMS_EPS);
    const bf16* grow = gate + (size_t)r32 * PINP; bf16* od = orow + (size_t)r32 * D;
#pragma unroll
    for (int vt = 0; vt < 2; ++vt)
#pragma unroll
        for (int g = 0; g < 4; ++g) { const int v0 = 32 * vt + 8 * g + 4 * hh; const u32x2 gw = *(const u32x2*)(grow + v0); const f32x4 n4 = *(const f32x4*)(ng + v0);
            const float y0 = o[vt][4 * g] * rstd * n4[0] * silu_f(bflo(gw.x)), y1 = o[vt][4 * g + 1] * rstd * n4[1] * silu_f(bfhi(gw.x));
            const float y2 = o[vt][4 * g + 2] * rstd * n4[2] * silu_f(bflo(gw.y)), y3 = o[vt][4 * g + 3] * rstd * n4[3] * silu_f(bfhi(gw.y));
            *(u32x2*)(od + v0) = (u32x2){pk2(y0, y1), pk2(y2, y3)}; }
}

constexpr int RWC_HEADB = 28928;
constexpr int RWC_AL = 4 * RWC_HEADB, RWC_LWL = RWC_AL + 32 * 264 * 2;
static_assert(RWC_LWL + 32 * 264 * 2 <= LDSCTL_OFF, "rw_fused_unit LDS");
__device__ __forceinline__ void rw_fused_unit(LAS unsigned char* lds, int l, int b, int c) {
    const int tid = opaque_tid(), lane = tid & 63, wave = __builtin_amdgcn_readfirstlane(tid >> 6), h = wave >> 1, p = wave & 1, r32 = lane & 31, hh = lane >> 5;
    unsigned char* ws = KWS();
    const int bh = b * 4 + h; const size_t un = (size_t)bh * NCH + c;
    const int t0 = c * 32;
    const bf16* P = (const bf16*)(ws + WS_P) + ((size_t)b * T + t0) * PINP + PC_RW;
    const float* mu = KIN(I_RWMU) + (size_t)l * 1024;
    LAS bf16* XL = (LAS bf16*)lds;
    LAS bf16* AL = (LAS bf16*)(lds + RWC_AL);
    LAS bf16* LWL = (LAS bf16*)(lds + RWC_LWL);
    for (int i = tid; i < 32 * 256; i += NTHR) { const int tok = i >> 8, cc = i & 255;
        const bf16* row = P + (size_t)tok * PINP + 768 + cc;
        const float cur = bf2f(row[0]), prev = (t0 + tok > 0) ? bf2f(*(row - PINP)) : 0.f;
        float x = cur + (prev - cur) * mu[768 + cc];
        if (cc < 64) x = tanh_f(x); else if (cc >= 128) x = fast_sigmoid(x);
        XL[tok * 264 + cc] = (bf16)f2bf(x); }
    __syncthreads();
    {
        const int ch = wave * 32 + r32;
        const bf16* w2T = (const bf16*)(ws + WS_LORA) + (size_t)l * 256 * 64 + (size_t)ch * 64;
        const bf16* a2T = (const bf16*)(ws + WS_LORA) + (size_t)(NL * 256 * 64) + (size_t)l * 256 * 64 + (size_t)ch * 64;
        const bf16* g2T = (const bf16*)(ws + WS_LORA) + (size_t)2 * (NL * 256 * 64) + (size_t)l * 256 * 128 + (size_t)ch * 128;
        const LAS bf16* xa = XL + r32 * 264 + 8 * hh;
        {
            f32x16 acc;
#pragma unroll
            for (int i = 0; i < 16; ++i) acc[i] = 0.f;
#pragma unroll
            for (int s = 0; s < 4; ++s) { const bf16x8 A = *(const LAS bf16x8*)(xa + 16 * s); const bf16x8 Bw = *(const bf16x8*)(w2T + 16 * s + 8 * hh);
                acc = __builtin_amdgcn_mfma_f32_32x32x16_bf16(A, Bw, acc, 0, 0, 0); }
            const float w0c = KIN(I_RWW0)[l * 256 + ch];
#pragma unroll
            for (int r = 0; r < 16; ++r) { const int tok = rho16(r, hh);
                const float zw = w0c + acc[r]; const float wlog = -(fmaxf(-zw, 0.f) + log1pexp_neg_abs(zw)) - 0.5f;
                LWL[tok * 264 + ch] = (bf16)f2bf(-fast_exp(wlog)); }
        }
        __builtin_amdgcn_sched_barrier(0);
        {
            f32x16 acc;
#pragma unroll
            for (int i = 0; i < 16; ++i) acc[i] = 0.f;
#pragma unroll
            for (int s = 0; s < 4; ++s) { const bf16x8 A = *(const LAS bf16x8*)(xa + 64 + 16 * s); const bf16x8 Bw = *(const bf16x8*)(a2T + 16 * s + 8 * hh);
                acc = __builtin_amdgcn_mfma_f32_32x32x16_bf16(A, Bw, acc, 0, 0, 0); }
            const float a0c = KIN(I_RWA0)[l * 256 + ch];
#pragma unroll
            for (int r = 0; r < 16; ++r) AL[rho16(r, hh) * 264 + ch] = (bf16)f2bf(fast_sigmoid(a0c + acc[r]));
        }
        __builtin_amdgcn_sched_barrier(0);
        {
            f32x16 acc;
#pragma unroll
            for (int i = 0; i < 16; ++i) acc[i] = 0.f;
#pragma unroll
            for (int s = 0; s < 8; ++s) { const bf16x8 A = *(const LAS bf16x8*)(xa + 128 + 16 * s); const bf16x8 Bw = *(const bf16x8*)(g2T + 16 * s + 8 * hh);
                acc = __builtin_amdgcn_mfma_f32_32x32x16_bf16(A, Bw, acc, 0, 0, 0); }
            bf16* gb = (bf16*)(ws + WS_GBUF) + ((size_t)b * T + t0) * 256 + ch;
#pragma unroll
            for (int r = 0; r < 16; ++r) gb[(size_t)rho16(r, hh) * 256] = (bf16)f2bf(acc[r]);
        }
    }
    __syncthreads();
    LAS unsigned char* L = lds + h * RWC_HEADB;
    LAS bf16* AT = (LAS bf16*)L;
    LAS bf16* BT = (LAS bf16*)(L + 4096);
    LAS bf16* KT = (LAS bf16*)(L + 8192);
    LAS bf16* ATT = (LAS bf16*)(L + 12288);
    LAS bf16* BHT = (LAS bf16*)(L + 16384);
    LAS bf16* KHT = (LAS bf16*)(L + 20480);
    LAS bf16* VT = (LAS bf16*)(L + 24576);
    LAS float* GC = (LAS float*)(L + 28672);
    LAS float* MAB = (LAS float*)(L + 4096);
    LAS bf16* MAK = (LAS bf16*)(L + 8192);
    LAS bf16* TM = (LAS bf16*)L;
    if (wave < 4) {
        const int hs = wave, d = lane, ch = hs * 64 + d; const size_t uns = (size_t)(b * 4 + hs) * NCH + c;
        LAS unsigned char* Ls = lds + hs * RWC_HEADB;
        LAS bf16* sAT = (LAS bf16*)Ls; LAS bf16* sBT = (LAS bf16*)(Ls + 4096); LAS bf16* sKT = (LAS bf16*)(Ls + 8192);
        LAS bf16* sATT = (LAS bf16*)(Ls + 12288); LAS bf16* sBHT = (LAS bf16*)(Ls + 16384); LAS bf16* sKHT = (LAS bf16*)(Ls + 20480); LAS float* sGC = (LAS float*)(Ls + 28672);
        const float mr = mu[ch], mk = mu[256 + ch];
        const float kkc = KIN(I_RWKK)[l * 256 + ch], kac = KIN(I_RWKA)[l * 256 + ch], rkc = KIN(I_RWRK)[l * 256 + ch];
        float lgend = 0.f;
#pragma unroll 8
        for (int t = 0; t < 32; ++t) lgend += bf2f(LWL[t * 264 + ch]);
        bf16* RGp = (bf16*)(ws + WS_RR) + uns * 2048 + d; bf16* BGp = (bf16*)(ws + WS_RB) + uns * 2048 + d; bf16* KGp = (bf16*)(ws + WS_RK) + uns * 2048 + d;
        float* bonp = (float*)(ws + WS_BONUS) + ((size_t)b * T + t0) * 4 + hs;
        float lg = 0.f;
        float rprev = 0.f, kprev = 0.f;
        if (t0 > 0) { rprev = bf2f(*(P - PINP + ch)); kprev = bf2f(*(P - PINP + 256 + ch)); }
        unsigned short xrr[32], xkr[32];
#pragma unroll
        for (int t = 0; t < 32; ++t) { const bf16* row = P + (size_t)t * PINP; xrr[t] = row[ch]; xkr[t] = row[256 + ch]; }
#pragma unroll 1
        for (int t8 = 0; t8 < 4; ++t8) { u32x4 ap, bp, kp; float xr[8], xk[8];
#pragma unroll
            for (int e = 0; e < 8; ++e) { xr[e] = bf2f(t8 == 0 ? xrr[e] : t8 == 1 ? xrr[8 + e] : t8 == 2 ? xrr[16 + e] : xrr[24 + e]); xk[e] = bf2f(t8 == 0 ? xkr[e] : t8 == 1 ? xkr[8 + e] : t8 == 2 ? xkr[16 + e] : xkr[24 + e]); }
#pragma unroll
            for (int jj = 0; jj < 4; ++jj) { float at2[2], bh2[2], kh2[2];
#pragma unroll
                for (int e = 0; e < 2; ++e) { const int t = t8 * 8 + jj * 2 + e;
                    const float rc = xr[jj * 2 + e], kc = xk[jj * 2 + e];
                    const float r = rc + (rprev - rc) * mr, k = kc + (kprev - kc) * mk; rprev = rc; kprev = kc;
                    const float av = bf2f(AL[t * 264 + ch]), lw = bf2f(LWL[t * 264 + ch]);
                    const float kkr = k * kkc, hk = k * (1.0f + (av - 1.0f) * kac);
                    const float ss = wave_sum(kkr * kkr); const float kk = kkr / fmaxf(sqrtf(ss), 1e-12f);
                    const float bon = wave_sum(r * hk * rkc);
                    const float aa = -kk, bb = kk * av;
                    const float lgp = lg; lg += lw;
                    const float at = aa * fast_exp(lgp), rt = r * fast_exp(lg), ei = fast_exp(-lg), bt = bb * ei, kt = hk * ei, eh = fast_exp(lgend - lg);
                    sAT[t * 64 + d] = (bf16)f2bf(at); sBT[t * 64 + d] = (bf16)f2bf(bt); sKT[t * 64 + d] = (bf16)f2bf(kt);
                    RGp[t * 64] = (bf16)f2bf(rt); BGp[t * 64] = (bf16)f2bf(bt); KGp[t * 64] = (bf16)f2bf(kt);
                    if (d == 0) bonp[t * 4] = bon;
                    at2[e] = at; bh2[e] = bb * eh; kh2[e] = hk * eh; }
                ap[jj] = pk2(at2[0], at2[1]); bp[jj] = pk2(bh2[0], bh2[1]); kp[jj] = pk2(kh2[0], kh2[1]); }
            *(LAS u32x4*)(sATT + d * 32 + t8 * 8) = ap; *(LAS u32x4*)(sBHT + d * 32 + t8 * 8) = bp; *(LAS u32x4*)(sKHT + d * 32 + t8 * 8) = kp; }
        sGC[d] = fast_exp(lgend);
    } else {
        const int cv = tid - 256, hs = cv >> 6, vi = cv & 63; const size_t uns = (size_t)(b * 4 + hs) * NCH + c;
        LAS bf16* sVT = (LAS bf16*)(lds + hs * RWC_HEADB + 24576);
        bf16* VTg = (bf16*)(ws + WS_RVT) + uns * 2048 + vi * 32; bf16* VGp = (bf16*)(ws + WS_RVG) + uns * 2048 + vi;
        const float mv = mu[512 + cv];
        float vprev = 0.f; if (t0 > 0) vprev = bf2f(*(P - PINP + 512 + cv));
        unsigned short xvr[32];
#pragma unroll
        for (int t = 0; t < 32; ++t) xvr[t] = P[(size_t)t * PINP + 512 + cv];
#pragma unroll
        for (int t8 = 0; t8 < 4; ++t8) { u32x4 vp; float yv[8];
#pragma unroll
            for (int e = 0; e < 8; ++e) { const float xv = bf2f(xvr[t8 * 8 + e]); yv[e] = xv + (vprev - xv) * mv; vprev = xv; VGp[(t8 * 8 + e) * 64] = (bf16)f2bf(yv[e]); }
#pragma unroll
            for (int jj = 0; jj < 4; ++jj) vp[jj] = pk2(yv[2 * jj], yv[2 * jj + 1]);
            *(LAS u32x4*)(sVT + vi * 32 + t8 * 8) = vp; *(u32x4*)(VTg + t8 * 8) = vp; }
    }
    __syncthreads();
    f32x16 accR[2];
    {
        f32x16 acc;
#pragma unroll
        for (int i = 0; i < 16; ++i) acc[i] = 0.f;
        const LAS bf16* Bsrc = p == 0 ? BT : KT;
#pragma unroll
        for (int s = 0; s < 4; ++s) { const bf16x8 A = *(const LAS bf16x8*)(AT + r32 * 64 + 16 * s + 8 * hh), B = *(const LAS bf16x8*)(Bsrc + r32 * 64 + 16 * s + 8 * hh);
            acc = __builtin_amdgcn_mfma_f32_32x32x16_bf16(A, B, acc, 0, 0, 0); }
        if (p == 0) {
#pragma unroll
            for (int r = 0; r < 16; ++r) { const int t = rho16(r, hh); MAB[t * 32 + r32] = (r32 < t) ? acc[r] : 0.f; }
        } else {
#pragma unroll
            for (int r = 0; r < 16; ++r) { const int t = rho16(r, hh); MAK[t * 32 + r32] = (bf16)f2bf((r32 < t) ? acc[r] : 0.f); }
        }
    }
    __syncthreads();
    if (p == 0) {
        const int cidx = r32; float tc[32];
#pragma unroll
        for (int t = 0; t < 32; ++t) { float acc0 = (t == cidx) ? 1.0f : 0.f, acc1 = 0.f;
#pragma unroll
            for (int s4 = 0; s4 < (t + 3) / 4; ++s4) { const f32x4 m4 = *(const LAS f32x4*)(MAB + t * 32 + 4 * s4);
#pragma unroll
                for (int e = 0; e < 4; ++e) { const int s = 4 * s4 + e; if (s < t) { if (e & 1) acc1 = fmaf(m4[e], tc[s], acc1); else acc0 = fmaf(m4[e], tc[s], acc0); } } }
            tc[t] = acc0 + acc1; }
#pragma unroll
        for (int t = 0; t < 32; ++t) if (hh == 0) TM[t * 32 + cidx] = (bf16)f2bf(tc[t]);
    } else {
#pragma unroll
        for (int vt = 0; vt < 2; ++vt) {
#pragma unroll
            for (int i = 0; i < 16; ++i) accR[vt][i] = 0.f;
#pragma unroll
            for (int s = 0; s < 2; ++s) { const bf16x8 A = *(const LAS bf16x8*)(MAK + r32 * 32 + 16 * s + 8 * hh), B = *(const LAS bf16x8*)(VT + (32 * vt + r32) * 32 + 16 * s + 8 * hh);
                accR[vt] = __builtin_amdgcn_mfma_f32_32x32x16_bf16(A, B, accR[vt], 0, 0, 0); } }
    }
    __syncthreads();
    if (p == 0) {
        f32x16 accW[2];
#pragma unroll
        for (int dt = 0; dt < 2; ++dt) {
#pragma unroll
            for (int i = 0; i < 16; ++i) accW[dt][i] = 0.f;
#pragma unroll
            for (int s = 0; s < 2; ++s) { const bf16x8 A = *(const LAS bf16x8*)(TM + r32 * 32 + 16 * s + 8 * hh), B = *(const LAS bf16x8*)(ATT + (32 * dt + r32) * 32 + 16 * s + 8 * hh);
                accW[dt] = __builtin_amdgcn_mfma_f32_32x32x16_bf16(A, B, accW[dt], 0, 0, 0); } }
        { LAS bf16* WL = ATT;
#pragma unroll
          for (int dt = 0; dt < 2; ++dt)
#pragma unroll
              for (int r = 0; r < 16; ++r) WL[rho16(r, hh) * 64 + 32 * dt + r32] = (bf16)f2bf(accW[dt][r]);
          u32x4* WGp = (u32x4*)((bf16*)(ws + WS_RW) + un * 2048);
#pragma unroll
          for (int i = 0; i < 4; ++i) WGp[i * 64 + lane] = *(const LAS u32x4*)(WL + (i * 64 + lane) * 8); }
        LAS bf16* PL = (LAS bf16*)(L + 4096);
        const int xs = r32 >> 4, xx = r32 & 15, hhA = (xx >> 2) & 1, jA = 4 * (xx >> 3) + (xx & 3);
#pragma unroll
        for (int dt = 0; dt < 2; ++dt)
#pragma unroll
            for (int dt2 = 0; dt2 < 2; ++dt2) { f32x16 acc;
#pragma unroll
                for (int i = 0; i < 16; ++i) acc[i] = 0.f;
#pragma unroll
                for (int s = 0; s < 2; ++s) { const LAS bf16* bp = BHT + (32 * dt + r32) * 32 + 16 * s + 4 * hh;
                    union { bf16x8 v; s16x4 h2[2]; } af; af.h2[0] = *(const LAS s16x4*)bp; af.h2[1] = *(const LAS s16x4*)(bp + 8);
                    union { bf16x8 v; unsigned w[4]; } bf;
#pragma unroll
                    for (int j = 0; j < 4; ++j) bf.w[j] = cvt_pk_bf16(accW[dt2][8 * s + 2 * j], accW[dt2][8 * s + 2 * j + 1]);
                    acc = __builtin_amdgcn_mfma_f32_32x32x16_bf16(af.v, bf.v, acc, 0, 0, 0); }
                if (dt == dt2) { const float gc = GC[32 * dt + r32];
#pragma unroll
                    for (int r = 0; r < 16; ++r) if (rho16(r, hh) == r32) acc[r] += gc; }
                LAS bf16* pf = PL + (((dt * 2 + dt2) * 2 + xs) * 64 + 32 * hhA) * 8 + jA;
#pragma unroll
                for (int r = 0; r < 16; ++r) pf[rho16(r, hh) * 8] = (bf16)f2bf(acc[r]); }
        { u32x4* PFp = (u32x4*)((bf16*)(ws + WS_RP) + un * 4096);
#pragma unroll
          for (int f = 0; f < 8; ++f) PFp[f * 64 + lane] = *(const LAS u32x4*)(PL + (f * 64 + lane) * 8); }
    } else {
        f32x16 accU[2];
#pragma unroll
        for (int vt = 0; vt < 2; ++vt) {
#pragma unroll
            for (int i = 0; i < 16; ++i) accU[vt][i] = 0.f;
#pragma unroll
            for (int s = 0; s < 2; ++s) { const LAS bf16* tp = TM + r32 * 32 + 16 * s + 4 * hh;
                union { bf16x8 v; s16x4 h2[2]; } af; af.h2[0] = *(const LAS s16x4*)tp; af.h2[1] = *(const LAS s16x4*)(tp + 8);
                union { bf16x8 v; unsigned w[4]; } bf;
#pragma unroll
                for (int j = 0; j < 4; ++j) bf.w[j] = cvt_pk_bf16(accR[vt][8 * s + 2 * j], accR[vt][8 * s + 2 * j + 1]);
                accU[vt] = __builtin_amdgcn_mfma_f32_32x32x16_bf16(af.v, bf.v, accU[vt], 0, 0, 0); } }
        float* UGp = (float*)(ws + WS_RU) + un * 2048;
#pragma unroll
        for (int vt = 0; vt < 2; ++vt)
#pragma unroll
            for (int g = 0; g < 4; ++g) *(f32x4*)(UGp + ((vt * 4 + g) * 64 + lane) * 4) = (f32x4){accU[vt][4 * g], accU[vt][4 * g + 1], accU[vt][4 * g + 2], accU[vt][4 * g + 3]};
        float* QFp = (float*)(ws + WS_RQ) + un * 4096;
#pragma unroll
        for (int vt = 0; vt < 2; ++vt)
#pragma unroll
            for (int dt = 0; dt < 2; ++dt) { f32x16 acc;
#pragma unroll
                for (int i = 0; i < 16; ++i) acc[i] = 0.f;
#pragma unroll
                for (int s = 0; s < 2; ++s) { const LAS bf16* bp = BHT + (32 * dt + r32) * 32 + 16 * s + 4 * hh;
                    union { bf16x8 v; s16x4 h2[2]; } af; af.h2[0] = *(const LAS s16x4*)bp; af.h2[1] = *(const LAS s16x4*)(bp + 8);
                    union { bf16x8 v; unsigned w[4]; } bf;
#pragma unroll
                    for (int j = 0; j < 4; ++j) bf.w[j] = cvt_pk_bf16(accU[vt][8 * s + 2 * j], accU[vt][8 * s + 2 * j + 1]);
                    acc = __builtin_amdgcn_mfma_f32_32x32x16_bf16(af.v, bf.v, acc, 0, 0, 0);
                    const bf16x8 A2 = *(const LAS bf16x8*)(KHT + (32 * dt + r32) * 32 + 16 * s + 8 * hh), B2 = *(const LAS bf16x8*)(VT + (32 * vt + r32) * 32 + 16 * s + 8 * hh);
                    acc = __builtin_amdgcn_mfma_f32_32x32x16_bf16(A2, B2, acc, 0, 0, 0); }
#pragma unroll
                for (int g = 0; g < 4; ++g) *(f32x4*)(QFp + (((vt * 2 + dt) * 4 + g) * 64 + lane) * 4) = (f32x4){acc[4 * g], acc[4 * g + 1], acc[4 * g + 2], acc[4 * g + 3]}; }
    }
    __syncthreads();
}
__device__ __forceinline__ void rw_m2_wave(LAS unsigned char* ring, int lane, int bh, int vt) {
    unsigned char* ws = KWS();
    const char* PF = (const char*)((const bf16*)(ws + WS_RP) + (size_t)bh * NCH * 4096) + lane * 16;
    const char* QF = (const char*)((const float*)(ws + WS_RQ) + (size_t)bh * NCH * 4096 + (size_t)vt * 2048) + lane * 16;
    bf16* SG = (bf16*)(ws + WS_RS) + (size_t)bh * NCH * 4096 + (size_t)vt * 2048 + lane * 8;
    f32x16 S[2];
#pragma unroll
    for (int dt = 0; dt < 2; ++dt)
#pragma unroll
        for (int i = 0; i < 16; ++i) S[dt][i] = 0.f;
#define RWM2_DMA(c_) do { const int _c = (c_) < NCH ? (c_) : NCH - 1; LAS unsigned char* _sl = ring + ((c_) & 3) * 16384; \
        _Pragma("unroll") for (int f = 0; f < 8; ++f) { \
            __builtin_amdgcn_global_load_lds((const unsigned*)(PF + (size_t)_c * 8192 + f * 1024), (LAS unsigned*)(_sl + f * 1024), 16, 0, 0); \
            __builtin_amdgcn_global_load_lds((const unsigned*)(QF + (size_t)_c * 16384 + f * 1024), (LAS unsigned*)(_sl + 8192 + f * 1024), 16, 0, 0); } } while (0)
    RWM2_DMA(0); RWM2_DMA(1); RWM2_DMA(2);
#pragma unroll 1
    for (int c = 0; c < NCH; ++c) {
        asm volatile("s_waitcnt vmcnt(32)" ::: "memory");
        const LAS unsigned char* sl = ring + (c & 3) * 16384 + lane * 16;
        bf16x8 pf[8]; f32x4 qv[8];
#pragma unroll
        for (int f = 0; f < 8; ++f) { pf[f] = *(const LAS bf16x8*)(sl + f * 1024); qv[f] = *(const LAS f32x4*)(sl + 8192 + f * 1024); }
        union { bf16x8 v; unsigned w[4]; } sb[2][2];
#pragma unroll
        for (int dt2 = 0; dt2 < 2; ++dt2)
#pragma unroll
            for (int s = 0; s < 2; ++s) {
#pragma unroll
                for (int j = 0; j < 4; ++j) sb[dt2][s].w[j] = cvt_pk_bf16(S[dt2][8 * s + 2 * j], S[dt2][8 * s + 2 * j + 1]);
                *(bf16x8*)(SG + (size_t)c * 4096 + (dt2 * 2 + s) * 512) = sb[dt2][s].v; }
        f32x16 N[2];
#pragma unroll
        for (int dt = 0; dt < 2; ++dt) {
#pragma unroll
            for (int g = 0; g < 4; ++g) { N[dt][4 * g] = qv[dt * 4 + g][0]; N[dt][4 * g + 1] = qv[dt * 4 + g][1]; N[dt][4 * g + 2] = qv[dt * 4 + g][2]; N[dt][4 * g + 3] = qv[dt * 4 + g][3]; }
#pragma unroll
            for (int dt2 = 0; dt2 < 2; ++dt2)
#pragma unroll
                for (int s = 0; s < 2; ++s) N[dt] = __builtin_amdgcn_mfma_f32_32x32x16_bf16(pf[(dt * 2 + dt2) * 2 + s], sb[dt2][s].v, N[dt], 0, 0, 0); }
        S[0] = N[0]; S[1] = N[1];
        asm volatile("s_waitcnt lgkmcnt(0)" ::: "memory");
        RWM2_DMA(c + 3);
    }
    asm volatile("s_waitcnt vmcnt(0)" ::: "memory");
#undef RWM2_DMA
}
__device__ __forceinline__ bf16x8 ld_perm8(const bf16* p) { union { bf16x8 v; s16x4 h2[2]; } f; f.h2[0] = *(const s16x4*)p; f.h2[1] = *(const s16x4*)(p + 8); return f.v; }
__device__ __forceinline__ void rw_m3_task(int lane, int l, int bh, int c) {
    unsigned char* ws = KWS();
    const int r32 = lane & 31, hh = lane >> 5, b = bh >> 2, h = bh & 3; const size_t un = (size_t)bh * NCH + c; const size_t tok0 = (size_t)b * T + c * 32;
    const bf16* RGp = (const bf16*)(ws + WS_RR) + un * 2048 + r32 * 64 + 4 * hh; const bf16* BGp = (const bf16*)(ws + WS_RB) + un * 2048 + r32 * 64 + 4 * hh;
    const bf16* KGp = (const bf16*)(ws + WS_RK) + un * 2048 + r32 * 64 + 4 * hh; const bf16* WGp = (const bf16*)(ws + WS_RW) + un * 2048 + r32 * 64 + 4 * hh;
    const bf16* SGp = (const bf16*)(ws + WS_RS) + un * 4096 + lane * 8; const bf16* VTp = (const bf16*)(ws + WS_RVT) + un * 2048 + r32 * 32 + 4 * hh;
    const float* UGp = (const float*)(ws + WS_RU) + un * 2048 + lane * 4;
    f32x16 U[2], Y[2], mb, mk;
#pragma unroll
    for (int vt = 0; vt < 2; ++vt)
#pragma unroll
        for (int g = 0; g < 4; ++g) { const f32x4 u4 = *(const f32x4*)(UGp + (vt * 4 + g) * 256); U[vt][4 * g] = u4[0]; U[vt][4 * g + 1] = u4[1]; U[vt][4 * g + 2] = u4[2]; U[vt][4 * g + 3] = u4[3]; }
#pragma unroll
    for (int i = 0; i < 16; ++i) { mb[i] = 0.f; mk[i] = 0.f; Y[0][i] = 0.f; Y[1][i] = 0.f; }
#pragma unroll
    for (int ks = 0; ks < 4; ++ks) {
        const bf16x8 rf = ld_perm8(RGp + 16 * ks), wf = ld_perm8(WGp + 16 * ks), bfr = ld_perm8(BGp + 16 * ks), kfr = ld_perm8(KGp + 16 * ks);
        const bf16x8 s0 = *(const bf16x8*)(SGp + ks * 512), s1 = *(const bf16x8*)(SGp + 2048 + ks * 512);
        U[0] = __builtin_amdgcn_mfma_f32_32x32x16_bf16(wf, s0, U[0], 0, 0, 0); U[1] = __builtin_amdgcn_mfma_f32_32x32x16_bf16(wf, s1, U[1], 0, 0, 0);
        mb = __builtin_amdgcn_mfma_f32_32x32x16_bf16(bfr, rf, mb, 0, 0, 0); mk = __builtin_amdgcn_mfma_f32_32x32x16_bf16(kfr, rf, mk, 0, 0, 0);
        Y[0] = __builtin_amdgcn_mfma_f32_32x32x16_bf16(s0, rf, Y[0], 0, 0, 0); Y[1] = __builtin_amdgcn_mfma_f32_32x32x16_bf16(s1, rf, Y[1], 0, 0, 0); }
#pragma unroll
    for (int r = 0; r < 16; ++r) if (rho16(r, hh) > r32) { mb[r] = 0.f; mk[r] = 0.f; }
#pragma unroll
    for (int s = 0; s < 2; ++s) { union { bf16x8 v; unsigned w[4]; } fb, fk;
#pragma unroll
        for (int j = 0; j < 4; ++j) { fb.w[j] = cvt_pk_bf16(mb[8 * s + 2 * j], mb[8 * s + 2 * j + 1]); fk.w[j] = cvt_pk_bf16(mk[8 * s + 2 * j], mk[8 * s + 2 * j + 1]); }
#pragma unroll
        for (int vt = 0; vt < 2; ++vt) { union { bf16x8 v; unsigned w[4]; } fu;
#pragma unroll
            for (int j = 0; j < 4; ++j) fu.w[j] = cvt_pk_bf16(U[vt][8 * s + 2 * j], U[vt][8 * s + 2 * j + 1]);
            Y[vt] = __builtin_amdgcn_mfma_f32_32x32x16_bf16(fu.v, fb.v, Y[vt], 0, 0, 0);
            const bf16* vp = VTp + (size_t)vt * 32 * 32 + 16 * s;
            union { bf16x8 v; s16x4 h2[2]; } vf; vf.h2[0] = *(const s16x4*)vp; vf.h2[1] = *(const s16x4*)(vp + 8);
            Y[vt] = __builtin_amdgcn_mfma_f32_32x32x16_bf16(vf.v, fk.v, Y[vt], 0, 0, 0); } }
    float sm = 0.f;
#pragma unroll
    for (int vt = 0; vt < 2; ++vt)
#pragma unroll
        for (int i = 0; i < 16; ++i) sm += Y[vt][i];
    sm += __shfl_xor(sm, 32); const float mu = sm * (1.0f / 64.0f);
    float q = 0.f;
#pragma unroll
    for (int vt = 0; vt < 2; ++vt)
#pragma unroll
        for (int i = 0; i < 16; ++i) { const float dd = Y[vt][i] - mu; q += dd * dd; }
    q += __shfl_xor(q, 32); const float rstd = 1.0f / sqrtf(q * (1.0f / 64.0f) + RW_LN_EPS);
    const size_t tok = tok0 + r32;
    const float bon = ((const float*)(ws + WS_BONUS))[tok * 4 + h];
    const bf16* vrec = (const bf16*)(ws + WS_RVG) + un * 2048 + r32 * 64;
    const bf16* gp = (const bf16*)(ws + WS_GBUF) + tok * 256 + h * 64; bf16* od = (bf16*)(ws + WS_O) + tok * D + 512 + h * 64;
    const float* lnw = KIN(I_RWLNW) + l * 256 + h * 64; const float* lnb = KIN(I_RWLNB) + l * 256 + h * 64;
#pragma unroll
    for (int vt = 0; vt < 2; ++vt)
#pragma unroll
        for (int g = 0; g < 4; ++g) { const int v0 = 32 * vt + 8 * g + 4 * hh; const f32x4 w4 = *(const f32x4*)(lnw + v0), b4 = *(const f32x4*)(lnb + v0); const u32x2 vw = *(const u32x2*)(vrec + v0); const f32x4 vv = {bflo(vw.x), bfhi(vw.x), bflo(vw.y), bfhi(vw.y)}; const u32x2 gw = *(const u32x2*)(gp + v0);
            const float y0 = ((Y[vt][4 * g] - mu) * rstd * w4[0] + b4[0] + bon * vv[0]) * bflo(gw.x), y1 = ((Y[vt][4 * g + 1] - mu) * rstd * w4[1] + b4[1] + bon * vv[1]) * bfhi(gw.x);
            const float y2 = ((Y[vt][4 * g + 2] - mu) * rstd * w4[2] + b4[2] + bon * vv[2]) * bflo(gw.y), y3 = ((Y[vt][4 * g + 3] - mu) * rstd * w4[3] + b4[3] + bon * vv[3]) * bfhi(gw.y);
            *(u32x2*)(od + v0) = (u32x2){pk2(y0, y1), pk2(y2, y3)}; }
}

__device__ __forceinline__ void c1_phase(LAS unsigned char* lds, int l, int vcu, int G) {
    for (int u = vcu; u < NB * NCH; u += G) { const int b = u >> 8, c = u & 255;
        for (int q = 0; q <= PHREP(16); ++q) rw_fused_unit(lds, l, b, c);
        for (int q = 0; q <= PHREP(17); ++q) hg_fused_unit(lds, l, b, c);
        for (int q = 0; q <= PHREP(18); ++q) gla_fused_unit(lds, l, b, c); }
}
__device__ __forceinline__ void m3_gh_phase(int l, int vcu, int G) {
    const int tid = opaque_tid(), lane = tid & 63, wave = __builtin_amdgcn_readfirstlane(tid >> 6);
    unsigned char* ws = KWS();
    const int gw = vcu * NWAVES + wave, NGW = G * NWAVES;
    const bf16* P = (const bf16*)(ws + WS_P); bf16* O = (bf16*)(ws + WS_O);
    const float* gng = KIN(I_GLANG) + l * 256; const float* hng = KIN(I_HGNG) + l * 256;
    for (int task = gw; task < 24576; task += NGW) {
        const int un = task & 8191, bh = un >> 8, c = un & 255, b = bh >> 2, h = bh & 3; const size_t tok0 = (size_t)b * T + c * 32;
        if (task >= 16384) { rw_m3_task(lane, l, bh, c); continue; }
        if (task < 8192) m3_gh_task<64>(lane, (const bf16*)(ws + WS_HQ) + (size_t)un * 2048, (const bf16*)(ws + WS_HK) + (size_t)un * 2048, (const bf16*)(ws + WS_HVT) + (size_t)un * 2048, (const bf16*)(ws + WS_HS) + (size_t)un * 4096,
                                         P + tok0 * PINP + PC_HG + h * 64, hng + h * 64, O + tok0 * D + 256 + h * 64);
        else m3_gh_task<32>(lane, (const bf16*)(ws + WS_GQ) + (size_t)un * 1024, (const bf16*)(ws + WS_GK) + (size_t)un * 1024, (const bf16*)(ws + WS_GVT) + (size_t)un * 2048, (const bf16*)(ws + WS_GS) + (size_t)un * 2048,
                            P + tok0 * PINP + PC_GOUT + h * 64, gng + h * 64, O + tok0 * D + h * 64);
    }
}

__device__ __forceinline__ void xattn_units(LAS unsigned char* lds, int l, int first, int last, int stride) {
    const int tid = opaque_tid(), lane = tid & 63, wave = __builtin_amdgcn_readfirstlane(tid >> 6), r32 = lane & 31, hh = lane >> 5;
    const bf16* P = (const bf16*)(KWS() + WS_P); const bf16* MKV = (const bf16*)(KWS() + WS_MKV); bf16* O = (bf16*)(KWS() + WS_O);
    LAS bf16* KL = (LAS bf16*)lds;
    LAS bf16* VT = (LAS bf16*)(lds + 256 * 72 * 2);
    int cur_bh = -1;
    for (int u = first; u < last; u += stride) {
        const int bh = u >> 5, qb = u & 31, b = bh >> 2, h = bh & 3;
        if (bh != cur_bh) {
            __syncthreads();
            for (int i = tid; i < 256 * 8; i += NTHR) { const int key = i >> 3, c8 = i & 7;
                const bf16* src = MKV + (size_t)(b * 256 + key) * 2048 + l * 512 + h * 64 + c8 * 8;
                *(LAS u32x4*)(KL + key * 72 + c8 * 8) = *(const u32x4*)src;
                const u32x4 vv = *(const u32x4*)(src + 256);
                LAS bf16* vd = VT + (c8 * 8) * 264 + key;
                vd[0 * 264] = (bf16)(vv.x & 0xffff); vd[1 * 264] = (bf16)(vv.x >> 16); vd[2 * 264] = (bf16)(vv.y & 0xffff); vd[3 * 264] = (bf16)(vv.y >> 16);
                vd[4 * 264] = (bf16)(vv.z & 0xffff); vd[5 * 264] = (bf16)(vv.z >> 16); vd[6 * 264] = (bf16)(vv.w & 0xffff); vd[7 * 264] = (bf16)(vv.w >> 16); }
            __syncthreads();
            cur_bh = bh;
        }
        const int q = b * T + qb * 256 + wave * 32 + r32;
        bf16x8 qf[4];
#pragma unroll
        for (int s = 0; s < 4; ++s) qf[s] = *(const bf16x8*)(P + (size_t)q * PINP + PC_MQ + h * 64 + 16 * s + 8 * hh);
        f32x16 sc[8];
#pragma unroll
        for (int kt = 0; kt < 8; ++kt) {
#pragma unroll
            for (int i = 0; i < 16; ++i) sc[kt][i] = 0.f;
#pragma unroll
            for (int s = 0; s < 4; ++s) { const bf16x8 kf = *(const LAS bf16x8*)(KL + (kt * 32 + r32) * 72 + 16 * s + 8 * hh);
                sc[kt] = __builtin_amdgcn_mfma_f32_32x32x16_bf16(kf, qf[s], sc[kt], 0, 0, 0); }
        }
        float m = -3.0e38f;
#pragma unroll
        for (int kt = 0; kt < 8; ++kt)
#pragma unroll
            for (int i = 0; i < 16; ++i) m = fmaxf(m, sc[kt][i]);
        m = fmaxf(m, __shfl_xor(m, 32));
        float sum = 0.f;
        const float c2 = 0.125f * 1.4426950408889634f;
#pragma unroll
        for (int kt = 0; kt < 8; ++kt)
#pragma unroll
            for (int i = 0; i < 16; ++i) { const float e = __builtin_amdgcn_exp2f((sc[kt][i] - m) * c2); sc[kt][i] = e; sum += e; }
        sum += __shfl_xor(sum, 32);
        const float inv = 1.0f / sum;
        f32x16 oa[2];
#pragma unroll
        for (int vt = 0; vt < 2; ++vt)
#pragma unroll
            for (int i = 0; i < 16; ++i) oa[vt][i] = 0.f;
#pragma unroll
        for (int kt = 0; kt < 8; ++kt)
#pragma unroll
            for (int s = 0; s < 2; ++s) {
                union { bf16x8 v; unsigned w[4]; } pf;
#pragma unroll
                for (int j = 0; j < 4; ++j) pf.w[j] = cvt_pk_bf16(sc[kt][8 * s + 2 * j], sc[kt][8 * s + 2 * j + 1]);
#pragma unroll
                for (int vt = 0; vt < 2; ++vt) {
                    const LAS bf16* vp = VT + (vt * 32 + r32) * 264 + kt * 32 + 16 * s + 4 * hh;
                    union { bf16x8 v; s16x4 h2[2]; } vf; vf.h2[0] = *(const LAS s16x4*)vp; vf.h2[1] = *(const LAS s16x4*)(vp + 8);
                    oa[vt] = __builtin_amdgcn_mfma_f32_32x32x16_bf16(vf.v, pf.v, oa[vt], 0, 0, 0); }
            }
        bf16* orow = O + (size_t)q * D + 768 + h * 64;
#pragma unroll
        for (int vt = 0; vt < 2; ++vt)
#pragma unroll
            for (int g = 0; g < 4; ++g) { u32x2 w; w.x = cvt_pk_bf16(oa[vt][4 * g] * inv, oa[vt][4 * g + 1] * inv); w.y = cvt_pk_bf16(oa[vt][4 * g + 2] * inv, oa[vt][4 * g + 3] * inv);
                *(u32x2*)(orow + vt * 32 + 8 * g + 4 * hh) = w; }
    }
    __syncthreads();
}

__device__ __forceinline__ void m2_phase(LAS unsigned char* lds, int l, int bx, int G) {
    unsigned char* ws = KWS();
    const int tid = opaque_tid(), lane = tid & 63, wave = __builtin_amdgcn_readfirstlane(tid >> 6);
    const int nrw = (G >= 128) ? 64 : 0;
    if (nrw) { if (bx < nrw && wave == 0) rw_m2_wave(lds, lane, bx >> 1, bx & 1); }
    else { if (wave == 0) for (int q = bx; q < 64; q += G) rw_m2_wave(lds, lane, q >> 1, q & 1); }
    if (nrw && !(bx < nrw && wave == 0)) {
        const int nth = nrw ? (nrw * 448 + (G - nrw) * NTHR) : G * NTHR;
        const int gt = nrw ? (bx < nrw ? bx * 448 + (tid - 64) : nrw * 448 + (bx - nrw) * NTHR + tid) : bx * NTHR + tid;
        for (int e = gt; e < 98304; e += nth) {
            if (e < 65536) m2_gh_elem2<64>(e, (const float*)(ws + WS_HDS), (const float*)(ws + WS_HBE), (bf16*)(ws + WS_HS));
            else m2_gh_elem2<32>(e - 65536, (const float*)(ws + WS_GDS), (const float*)(ws + WS_GBE), (bf16*)(ws + WS_GS)); }
    }
    if (nrw == 0) { __syncthreads(); for (int e = bx * NTHR + tid; e < 98304; e += G * NTHR) {
            if (e < 65536) m2_gh_elem2<64>(e, (const float*)(ws + WS_HDS), (const float*)(ws + WS_HBE), (bf16*)(ws + WS_HS));
            else m2_gh_elem2<32>(e - 65536, (const float*)(ws + WS_GDS), (const float*)(ws + WS_GBE), (bf16*)(ws + WS_GS)); } }
    if (nrw == 0 || bx >= nrw) {
        const int nb = G - nrw, r = bx - nrw;
        const int per = (1024 + nb - 1) / nb, lo = r * per, hi = (lo + per < 1024) ? lo + per : 1024;
        xattn_units(lds, l, lo, hi, 1);
    }
}

__device__ __forceinline__ void ln1_router_phase(LAS unsigned char* lds, int l, int bx, int G) {
    const int tid = opaque_tid(), lane = tid & 63, wave = __builtin_amdgcn_readfirstlane(tid >> 6);
    LAS float* X = (LAS float*)lds;
    LAS float* PART = (LAS float*)(lds + 16 * 1028 * 4);
    LAS int* HIST = (LAS int*)(lds + 16 * 1028 * 4 + 8 * 16 * 32 * 4);
    const float* xin = KIN(I_X); const bf16* xinb = (const bf16*)(KWS() + WS_XB);
    const bf16* HM = (const bf16*)(KWS() + WS_HMIX);
    bf16* X1B = (bf16*)(KWS() + WS_X1B); unsigned char* X1Q = (unsigned char*)(KWS() + WS_XF);
    const float* g1 = KIN(I_LN1G) + l * D; const float* b1 = KIN(I_LN1B) + l * D;
    const float* rw = KIN(I_RTW) + (size_t)l * D * NE; const float* rb = KIN(I_RTB) + l * NE;
    int* tok_e = (int*)(KWS() + WS_ROUTE); float* tok_g = (float*)(KWS() + WS_ROUTE + 1 * MiB);
    if (tid < 32) HIST[tid] = 0;
    float rwB[2][32];
    { const int q = lane >> 4, e = lane & 15;
#pragma unroll
      for (int s = 0; s < 32; ++s) { const float* p = rw + (size_t)(128 * wave + 32 * q + s) * NE + e; rwB[0][s] = p[0]; rwB[1][s] = p[16]; } }
    __syncthreads();
    for (int it = bx; it < NTOK / 16; it += G) {
#pragma unroll
        for (int tt = 0; tt < 2; ++tt) { const int ti = wave * 2 + tt; const size_t tok = (size_t)it * 16 + ti;
            const f32x4* xr = (const f32x4*)(xin + tok * D) + lane; const u32x2* xbr = (const u32x2*)(xinb + tok * D) + lane; const u32x2* hr = (const u32x2*)(HM + tok * D) + lane;
            f32x4 v[4]; float s = 0.f;
#pragma unroll
            for (int j = 0; j < 4; ++j) { f32x4 xv; if (l == 0) xv = xr[64 * j]; else { const u32x2 xw = xbr[64 * j]; xv = (f32x4){bflo(xw.x), bfhi(xw.x), bflo(xw.y), bfhi(xw.y)}; } const u32x2 hw = hr[64 * j];
                v[j][0] = DN_ALPHA * xv[0] + bflo(hw.x); v[j][1] = DN_ALPHA * xv[1] + bfhi(hw.x); v[j][2] = DN_ALPHA * xv[2] + bflo(hw.y); v[j][3] = DN_ALPHA * xv[3] + bfhi(hw.y);
                s += (v[j][0] + v[j][1]) + (v[j][2] + v[j][3]); }
            const float mean = wave_sum(s) * (1.0f / D); float s2 = 0.f;
#pragma unroll
            for (int j = 0; j < 4; ++j) { v[j] = v[j] - mean; s2 += (v[j][0] * v[j][0] + v[j][1] * v[j][1]) + (v[j][2] * v[j][2] + v[j][3] * v[j][3]); }
            const float rstd = 1.0f / sqrtf(wave_sum(s2) * (1.0f / D) + LN_EPS);
#pragma unroll
            for (int j = 0; j < 4; ++j) { const f32x4 gg = *((const f32x4*)g1 + lane + 64 * j), bb = *((const f32x4*)b1 + lane + 64 * j);
                const f32x4 y = v[j] * rstd * gg + bb;
                *((u32x2*)(X1B + tok * D) + lane + 64 * j) = (u32x2){pk2(y[0], y[1]), pk2(y[2], y[3])};
                { int w = __builtin_amdgcn_cvt_pk_fp8_f32(y[0], y[1], 0, false); w = __builtin_amdgcn_cvt_pk_fp8_f32(y[2], y[3], w, true); *((unsigned*)(X1Q + tok * D) + lane + 64 * j) = (unsigned)w; }
                *(LAS f32x4*)(X + ti * 1028 + 4 * lane + 256 * j) = y; }
        }
        __syncthreads();
        {
            const int q = lane >> 4, r = lane & 15;
            f32x4 acc0 = (f32x4){0.f, 0.f, 0.f, 0.f}, acc1 = (f32x4){0.f, 0.f, 0.f, 0.f};
            const LAS float* xa = X + r * 1028 + 128 * wave + 32 * q;
#pragma unroll
            for (int s4 = 0; s4 < 8; ++s4) { const f32x4 av = *(const LAS f32x4*)(xa + 4 * s4);
#pragma unroll
                for (int j = 0; j < 4; ++j) { acc0 = __builtin_amdgcn_mfma_f32_16x16x4f32(av[j], rwB[0][4 * s4 + j], acc0, 0, 0, 0); acc1 = __builtin_amdgcn_mfma_f32_16x16x4f32(av[j], rwB[1][4 * s4 + j], acc1, 0, 0, 0); } }
#pragma unroll
            for (int i = 0; i < 4; ++i) { PART[(wave * 16 + 4 * q + i) * 32 + r] = acc0[i]; PART[(wave * 16 + 4 * q + i) * 32 + 16 + r] = acc1[i]; }
        }
        __syncthreads();
        {
            const int ti = tid >> 5, e = tid & 31;
            float lg = rb[e];
#pragma unroll
            for (int w = 0; w < 8; ++w) lg += PART[(w * 16 + ti) * 32 + e];
            float tv[4]; int te[4]; float cur = lg;
#pragma unroll
            for (int k = 0; k < 4; ++k) { float bv = cur; int bi = e;
#pragma unroll
                for (int o = 16; o >= 1; o >>= 1) { const float ov = __shfl_xor(bv, o); const int oi = __shfl_xor(bi, o); if (ov > bv || (ov == bv && oi < bi)) { bv = ov; bi = oi; } }
                tv[k] = bv; te[k] = bi; if (e == bi) cur = -3.0e38f; }
            const float e1 = __expf(tv[1] - tv[0]), e2 = __expf(tv[2] - tv[0]), e3 = __expf(tv[3] - tv[0]); const float inv = 1.0f / (1.0f + e1 + e2 + e3);
            const size_t tok = (size_t)it * 16 + ti;
            if (e < 4) { const int ek = e == 0 ? te[0] : e == 1 ? te[1] : e == 2 ? te[2] : te[3]; const float gk = (e == 0 ? 1.0f : e == 1 ? e1 : e == 2 ? e2 : e3) * inv;
                tok_e[tok * 4 + e] = ek; tok_g[tok * 4 + e] = gk; __hip_atomic_fetch_add(&HIST[ek], 1, __ATOMIC_RELAXED, __HIP_MEMORY_SCOPE_WORKGROUP); }
        }
        __syncthreads();
    }
    __syncthreads();
    if (tid < 32) ((int*)(KWS() + WS_CTL))[CW_HIST + bx * 32 + tid] = HIST[tid];
}

__device__ __forceinline__ void slots_phase(LAS unsigned char* lds, int bx, int G) {
    const int tid = opaque_tid();
    int* ctl = (int*)(KWS() + WS_CTL);
    LAS int* RED = (LAS int*)lds;
    LAS int* TOT = RED + 1024;
    const int* tok_e = (const int*)(KWS() + WS_ROUTE); const float* tok_g = (const float*)(KWS() + WS_ROUTE + 1 * MiB);
    int* tok_slot = (int*)(KWS() + WS_ROUTE + 2 * MiB); int* slot_tok = (int*)(KWS() + WS_ROUTE + 3 * MiB); float* slot_gate = (float*)(KWS() + WS_ROUTE + 3 * MiB + 1536 * 1024);
    { const int e = tid & 31, part = tid >> 5; int tot = 0, pre = 0;
      for (int b2 = part; b2 < G; b2 += 16) { const int h = ctl[CW_HIST + b2 * 32 + e]; tot += h; if (b2 < bx) pre += h; }
      RED[(part * 32 + e) * 2] = tot; RED[(part * 32 + e) * 2 + 1] = pre; }
    __syncthreads();
    if (tid < 32) { int tot = 0, pre = 0; for (int p = 0; p < 16; ++p) { tot += RED[(p * 32 + tid) * 2]; pre += RED[(p * 32 + tid) * 2 + 1]; } TOT[tid] = tot; TOT[32 + tid] = pre; TOT[96 + tid] = 0; }
    __syncthreads();
    if (tid == 0) { int ps = 0;
#pragma unroll 1
        for (int e = 0; e < 32; ++e) { TOT[64 + e] = ps; ps += (TOT[e] + 255) & ~255; }
        TOT[128] = ps >> 8; if (bx == 0) ctl[CW_NT] = ps >> 8; }
    __syncthreads();
    if (bx == 0) { const int nt = TOT[128];
        for (int t = tid; t < nt; t += NTHR) { int e = 0;
#pragma unroll 1
            for (int k = 1; k < 32; ++k) if (TOT[64 + k] <= t * 256) e = k;
            ctl[CW_TILEE + t] = e; } }
    for (int e = bx; e < 32; e += G) { const int s0 = TOT[64 + e] + TOT[e], s1 = TOT[64 + e] + ((TOT[e] + 255) & ~255); for (int s = s0 + tid; s < s1; s += NTHR) { slot_tok[s] = 0; slot_gate[s] = 0.f; } }
    for (int it = bx; it < NTOK / 16; it += G) {
        if (tid < 64) { const int asg = it * 64 + tid; const int e = tok_e[asg]; const int rank = __hip_atomic_fetch_add(&TOT[96 + e], 1, __ATOMIC_RELAXED, __HIP_MEMORY_SCOPE_WORKGROUP); const int slot = TOT[64 + e] + TOT[32 + e] + rank;
            tok_slot[asg] = slot; slot_tok[slot] = asg >> 2; slot_gate[slot] = tok_g[asg]; }
    }
}

__device__ __forceinline__ void combine_phase(int l, int vcu, int G) {
    const int tid = opaque_tid(), lane = tid & 63, wave = __builtin_amdgcn_readfirstlane(tid >> 6);
    const int gw = vcu * NWAVES + wave, NGW = G * NWAVES;
    const bf16* X1B = (const bf16*)(KWS() + WS_X1B); const bf16* YB = (const bf16*)(KWS() + WS_YB); const int* tok_slot = (const int*)(KWS() + WS_ROUTE + 2 * MiB);
    float* xo = KOUT(); bf16* XB = (bf16*)(KWS() + WS_XB);
    const float* g2 = KIN(I_LN2G) + l * D; const float* b2 = KIN(I_LN2B) + l * D;
    for (int tok = gw; tok < NTOK; tok += NGW) {
        const int s0 = tok_slot[tok * 4], s1 = tok_slot[tok * 4 + 1], s2i = tok_slot[tok * 4 + 2], s3 = tok_slot[tok * 4 + 3];
        const u32x2* xr = (const u32x2*)(X1B + (size_t)tok * D) + lane;
        const u32x2* y0 = (const u32x2*)(YB + (size_t)s0 * D) + lane; const u32x2* y1 = (const u32x2*)(YB + (size_t)s1 * D) + lane;
        const u32x2* y2 = (const u32x2*)(YB + (size_t)s2i * D) + lane; const u32x2* y3 = (const u32x2*)(YB + (size_t)s3 * D) + lane;
        f32x4 v[4]; float s = 0.f;
#pragma unroll
        for (int j = 0; j < 4; ++j) { const u32x2 xw = xr[64 * j]; const f32x4 xv = {bflo(xw.x), bfhi(xw.x), bflo(xw.y), bfhi(xw.y)}; const u32x2 a0 = y0[64 * j], a1 = y1[64 * j], a2 = y2[64 * j], a3 = y3[64 * j];
            v[j][0] = DN_ALPHA * xv[0] + ((bflo(a0.x) + bflo(a1.x)) + (bflo(a2.x) + bflo(a3.x))); v[j][1] = DN_ALPHA * xv[1] + ((bfhi(a0.x) + bfhi(a1.x)) + (bfhi(a2.x) + bfhi(a3.x)));
            v[j][2] = DN_ALPHA * xv[2] + ((bflo(a0.y) + bflo(a1.y)) + (bflo(a2.y) + bflo(a3.y))); v[j][3] = DN_ALPHA * xv[3] + ((bfhi(a0.y) + bfhi(a1.y)) + (bfhi(a2.y) + bfhi(a3.y)));
            s += (v[j][0] + v[j][1]) + (v[j][2] + v[j][3]); }
        const float mean = wave_sum(s) * (1.0f / D); float q = 0.f;
#pragma unroll
        for (int j = 0; j < 4; ++j) { v[j] = v[j] - mean; q += (v[j][0] * v[j][0] + v[j][1] * v[j][1]) + (v[j][2] * v[j][2] + v[j][3] * v[j][3]); }
        const float rstd = 1.0f / sqrtf(wave_sum(q) * (1.0f / D) + LN_EPS);
#pragma unroll
        for (int j = 0; j < 4; ++j) { const f32x4 gg = *((const f32x4*)g2 + lane + 64 * j), bb = *((const f32x4*)b2 + lane + 64 * j);
            const f32x4 y = v[j] * rstd * gg + bb;
            if (l == NL - 1) *((f32x4*)(xo + (size_t)tok * D) + lane + 64 * j) = y;
            else *((u32x2*)(XB + (size_t)tok * D) + lane + 64 * j) = (u32x2){pk2(y[0], y[1]), pk2(y[2], y[3])}; }
    }
}


constexpr int PH_PER_LAYER = 10, NPHASES = 2 + NL * PH_PER_LAYER;
__global__ void __launch_bounds__(NTHR, 2) trunk_fwd(Args args) {
    extern __shared__ __attribute__((aligned(16))) unsigned char lds_raw[];
    LAS unsigned char* lds = (LAS unsigned char*)lds_raw;
    volatile LAS unsigned* MISC = (volatile LAS unsigned*)(lds + MISC_OFF);
    const int tid = threadIdx.x;
    const int G = gridDim.x, bx = blockIdx.x;
    const int vcu = (G % 8 == 0) ? (bx % 8) * (G / 8) + bx / 8 : bx;
    unsigned char* ws = KWS();
    unsigned* ctl = (unsigned*)(ws + WS_CTL);
    for (int u = tid; u < (LDS_BYTES - LDSCTL_OFF) / 4; u += NTHR) ((LAS unsigned*)(lds + LDSCTL_OFF))[u] = 0u;
    __syncthreads();
    XcdBarrier bar; bar.bar = ctl + CW_BAR; bar.x = 0; bar.st = nullptr;
#if !MK_PER_PHASE
    bar = xcd_barrier_post(ctl + CW_BAR, MISC + 8);
#define GRID_BAR() xcd_barrier(bar)
#else
#define GRID_BAR() do { } while (0)
#endif
    const int lo = (int)(unsigned)ka_u64<280>(), hi = (int)(unsigned)(ka_u64<280>() >> 32);
#ifndef PH_MASK
#define PH_MASK 0x1FFF
#endif
#define PHEN(n) (((PH_MASK) >> (n)) & 1)
#define IN(k) (lo <= (k) && (k) < hi)
#define SEAM(k) do { if (rep > 0 || IN((k) + 1)) GRID_BAR(); } while (0)

#define OG opaque_s(G)
#define OBX opaque_s(bx)
#define OVCU opaque_s(vcu)
#define OL opaque_s(l)
    if (PHEN(0) && IN(0)) for (int rep = PHREP(0); rep >= 0; --rep) { prologue_phase(lds, OVCU, OG); SEAM(0); }
    if (PHEN(1) && IN(1)) for (int rep = PHREP(1); rep >= 0; --rep) {
        pg8::DenseOrder S; S.init(KWS() + WS_MEMB, KWS() + WS_WMEM, NB * NMEM, 2048, D, OG, OBX);
        pg8::EpiBf16 E{(bf16*)(KWS() + WS_MKV), 2048};
        pg8::gemm_phase<pg8::EpiBf16, pg8::DenseOrder>(lds, D, S, E);
        SEAM(1);
    }
    for (int l = 0; l < NL; ++l) {
        const int p0 = 2 + l * PH_PER_LAYER;
        if (PHEN(2) && IN(p0 + 0)) for (int rep = PHREP(2); rep >= 0; --rep) {
            pg8::DenseOrder S; S.init(KWS() + WS_XB, KWS() + WS_WIN + (size_t)OL * PINP * D * 2, NTOK, PINP, D, OG, OBX);
            pg8::EpiBf16 E{(bf16*)(KWS() + WS_P), PINP};
            pg8::gemm_phase<pg8::EpiBf16, pg8::DenseOrder>(lds, D, S, E);
            SEAM(p0 + 0);
        }
        if (PHEN(4) && IN(p0 + 1)) for (int rep = PHREP(4); rep >= 0; --rep) { c1_phase(lds, OL, OVCU, OG); SEAM(p0 + 1); }
        if (PHEN(5) && IN(p0 + 2)) for (int rep = PHREP(5); rep >= 0; --rep) { m2_phase(lds, OL, OBX, OG); SEAM(p0 + 2); }
        if (PHEN(6) && IN(p0 + 3)) for (int rep = PHREP(6); rep >= 0; --rep) { m3_gh_phase(OL, OVCU, OG); SEAM(p0 + 3); }
        if (PHEN(7) && IN(p0 + 4)) for (int rep = PHREP(7); rep >= 0; --rep) {
            pg8::DenseOrder S; S.init(KWS() + WS_O, KWS() + WS_WOUT + (size_t)OL * D * D * 2, NTOK, D, D, OG, OBX);
            pg8::EpiBf16 E{(bf16*)(KWS() + WS_HMIX), D};
            pg8::gemm_phase<pg8::EpiBf16, pg8::DenseOrder>(lds, D, S, E);
            SEAM(p0 + 4);
        }
        if (PHEN(8) && IN(p0 + 5)) for (int rep = PHREP(8); rep >= 0; --rep) { ln1_router_phase(lds, OL, OBX, OG); SEAM(p0 + 5); }
        if (PHEN(9) && IN(p0 + 6)) for (int rep = PHREP(9); rep >= 0; --rep) { slots_phase(lds, OBX, OG); SEAM(p0 + 6); }
        if (PHEN(10) && IN(p0 + 7)) for (int rep = PHREP(10); rep >= 0; --rep) {
            const int ntiles = __builtin_amdgcn_readfirstlane(((const int*)(KWS() + WS_CTL))[CW_NT]);
            pg8::MoeOrder<true> S; S.init(KWS() + WS_XF, KWS() + WS_WGU + (size_t)OL * NE * 2048 * D, (const int*)(KWS() + WS_CTL) + CW_TILEE, (const int*)(KWS() + WS_ROUTE + 3 * MiB), ntiles, 2048, D, OG, OBX);
            pg8::EpiSwiglu E{(unsigned char*)(KWS() + WS_HB), (const float*)(KWS() + WS_BGU) + (size_t)OL * NE * 2048};
            pg8::gemm_phase<pg8::EpiSwiglu, pg8::MoeOrder<true>, 1>(lds, D, S, E);
            SEAM(p0 + 7);
        }
        if (PHEN(11) && IN(p0 + 8)) for (int rep = PHREP(11); rep >= 0; --rep) {
            const int ntiles = __builtin_amdgcn_readfirstlane(((const int*)(KWS() + WS_CTL))[CW_NT]);
            pg8::MoeOrder<false> S; S.init(KWS() + WS_HB, KWS() + WS_WD + (size_t)OL * NE * D * FF, (const int*)(KWS() + WS_CTL) + CW_TILEE, (const int*)(KWS() + WS_ROUTE + 3 * MiB), ntiles, D, FF, OG, OBX);
            pg8::EpiDown E{(bf16*)(KWS() + WS_YB), KIN(I_BDN) + (size_t)OL * NE * D, (const float*)(KWS() + WS_ROUTE + 3 * MiB + 1536 * 1024)};
            pg8::gemm_phase<pg8::EpiDown, pg8::MoeOrder<false>, 1>(lds, FF, S, E);
            SEAM(p0 + 8);
        }
        if (PHEN(12) && IN(p0 + 9)) for (int rep = PHREP(12); rep >= 0; --rep) { combine_phase(OL, OVCU, OG); if (rep > 0 || l + 1 < NL) SEAM(p0 + 9); }
    }
#undef IN
#undef SEAM
}

extern "C" void kernel_launch(void* const* d_in, const int* in_sizes, int n_in, void* d_out, int out_size, void* d_ws, size_t ws_size, hipStream_t stream) {
    static int grid = 0;
    if (grid == 0) {
        if (n_in != 33 || ws_size < WS_END) { fprintf(stderr, "kernel_launch: unexpected inputs (n_in %d, ws %zu need %zu)\n", n_in, ws_size, (size_t)WS_END); grid = -1; return; }
        int dev = 0, cus = 0;
        if (hipGetDevice(&dev) != hipSuccess || hipDeviceGetAttribute(&cus, hipDeviceAttributeMultiprocessorCount, dev) != hipSuccess) { grid = -1; return; }
        if (hipFuncSetAttribute((const void*)trunk_fwd, hipFuncAttributeMaxDynamicSharedMemorySize, LDS_BYTES) != hipSuccess) { grid = -1; return; }
        int per_cu = 0; (void)hipOccupancyMaxActiveBlocksPerMultiprocessor(&per_cu, (const void*)trunk_fwd, NTHR, LDS_BYTES); (void)hipGetLastError();
        grid = cus;
    }
    if (grid < 0) return;
    (void)hipMemsetAsync((char*)d_ws + WS_CTL, 0, CTL_ZERO_BYTES, stream);
    Args a{};
    for (int i = 0; i < 33; ++i) a.in[i] = (const float*)d_in[i];
    a.out = (float*)d_out; a.ws = (unsigned char*)d_ws;
#if MK_PER_PHASE
    for (int p = 0; p < NPHASES; ++p) { a.ph_lo = p; a.ph_hi = p + 1; hipLaunchKernelGGL(trunk_fwd, dim3(grid), dim3(NTHR), LDS_BYTES, stream, a); }
#else
    a.ph_lo = 0; a.ph_hi = NPHASES;
    hipLaunchKernelGGL(trunk_fwd, dim3(grid), dim3(NTHR), LDS_BYTES, stream, a);
#endif
}
```

```cpp
#include <hip/hip_runtime.h>
#include <cstdio>
#include <cstdint>

#ifndef MK_PER_PHASE
#define MK_PER_PHASE 0
#endif

#ifndef REP_MASK
#define REP_MASK 0
#endif
#define PHREP(n) (((REP_MASK) >> (n)) & 1)
#define LAS __attribute__((address_space(3)))
#define GAS __attribute__((address_space(1)))
typedef unsigned short bf16;
typedef short bf16x8 __attribute__((ext_vector_type(8)));
typedef short s16x4 __attribute__((ext_vector_type(4)));
typedef float f32x4 __attribute__((ext_vector_type(4)));
typedef float f32x2 __attribute__((ext_vector_type(2)));
typedef float f32x16 __attribute__((ext_vector_type(16)));
typedef unsigned u32x4 __attribute__((ext_vector_type(4)));
typedef unsigned u32x2 __attribute__((ext_vector_type(2)));

constexpr int NB = 8, T = 8192, D = 1024, NL = 4, NTOK = NB * T;
constexpr int PIN = 3088, PINP = 3328;
constexpr int NE = 32, FF = 1024, NMEM = 256;
constexpr int NASSIGN = NTOK * 4;
constexpr int MAXTILES = NASSIGN / 256 + NE;
constexpr int MAXSLOTS = MAXTILES * 256;
constexpr int PC_GQ = 0, PC_GK = 128, PC_GV = 256, PC_GOUT = 512, PC_HQ = 768, PC_HF = 1024, PC_HI = 1280, PC_HG = 1536;
constexpr int PC_RW = 1792, PC_MQ = 2816, PC_GLR = 3072;
constexpr float DN_ALPHA = 1.6817928305074292f;
constexpr float LN_EPS = 1e-5f, RMS_EPS = 1e-6f, RW_LN_EPS = 64e-5f;

constexpr size_t MiB = 1u << 20;
constexpr size_t WS_CTL = 0, CTL_ZERO_BYTES = 1 * MiB;
constexpr size_t WS_WIN = 1 * MiB;
constexpr size_t WS_WOUT = WS_WIN + 26 * MiB;
constexpr size_t WS_WMEM = WS_WOUT + 8 * MiB;
constexpr size_t WS_WGU = WS_WMEM + 4 * MiB;
constexpr size_t WS_WD = WS_WGU + 512 * MiB;
constexpr size_t WS_BGU = WS_WD + 256 * MiB;
constexpr size_t WS_LORA = WS_BGU + 1 * MiB;
constexpr size_t WS_MEMB = WS_LORA + 1 * MiB;
constexpr size_t WS_MKV = WS_MEMB + 4 * MiB;
constexpr size_t WS_XB = WS_MKV + 8 * MiB;
constexpr size_t WS_X1B = WS_XB + 128 * MiB;
constexpr size_t WS_XF = WS_X1B + 128 * MiB;
constexpr size_t WS_X1F = WS_XF + 256 * MiB;
constexpr size_t WS_O = WS_X1F + 256 * MiB;
constexpr size_t WS_HMIX = WS_O + 128 * MiB;
constexpr size_t WS_ROUTE = WS_HMIX + 128 * MiB;
constexpr size_t WS_GBUF = WS_ROUTE + 6 * MiB;
constexpr size_t WS_BONUS = WS_GBUF + 32 * MiB;
constexpr size_t WS_BIG = WS_BONUS + 1 * MiB;
constexpr size_t WS_P = WS_BIG;
constexpr size_t WS_ORAW = WS_P + 416 * MiB;
constexpr size_t WS_HB = WS_BIG;
constexpr size_t WS_YB = WS_HB + 528 * MiB;
constexpr size_t WS_CHK = WS_ORAW;
constexpr size_t WS_HQ = WS_CHK, WS_HK = WS_HQ + 32 * MiB, WS_HVT = WS_HK + 32 * MiB, WS_HDS = WS_HVT + 32 * MiB, WS_HS = WS_HDS + 128 * MiB, WS_HBE = WS_HS + 64 * MiB;
constexpr size_t WS_GQ = WS_HBE + 2 * MiB, WS_GK = WS_GQ + 16 * MiB, WS_GVT = WS_GK + 16 * MiB, WS_GDS = WS_GVT + 32 * MiB, WS_GS = WS_GDS + 64 * MiB, WS_GBE = WS_GS + 32 * MiB;
constexpr size_t WS_RR = WS_GBE + 1 * MiB, WS_RB = WS_RR + 32 * MiB, WS_RK = WS_RB + 32 * MiB, WS_RW = WS_RK + 32 * MiB, WS_RVT = WS_RW + 32 * MiB;
constexpr size_t WS_RVG = WS_RVT + 32 * MiB;
constexpr size_t WS_RU = WS_RVG + 32 * MiB, WS_RP = WS_RU + 64 * MiB, WS_RQ = WS_RP + 64 * MiB, WS_RS = WS_RQ + 128 * MiB;
constexpr size_t WS_END = WS_RS + 64 * MiB;
static_assert(WS_YB + 528 * MiB <= WS_END, "overlay");
static_assert(WS_END <= (size_t)4096 * MiB, "workspace");
constexpr int CW_TMO = 0;
constexpr int CW_BAR = 4096;
constexpr int CW_HIST = 16384;
constexpr int CW_NT = 32768;
constexpr int CW_TILEE = 32768 + 64;
constexpr int CW_PADSTART = 40960;

constexpr int RING_BYTES = 131072;
constexpr int LDSCTL_OFF = 162816, MISC_OFF = LDSCTL_OFF + 320;
constexpr int LDS_BYTES = 163840;
constexpr int NWAVES = 8, NTHR = 512;

#define RLX_AGENT __ATOMIC_RELAXED, __HIP_MEMORY_SCOPE_AGENT
#define LDS_WAIT() asm volatile("s_waitcnt lgkmcnt(0)" ::: "memory")
#define VM_WAIT() asm volatile("s_waitcnt vmcnt(0)" ::: "memory")

__device__ __forceinline__ float bf2f(unsigned short b) { return __builtin_bit_cast(float, (unsigned)b << 16); }
__device__ __forceinline__ float bflo(unsigned w) { return __builtin_bit_cast(float, w << 16); }
__device__ __forceinline__ float bfhi(unsigned w) { return __builtin_bit_cast(float, w & 0xffff0000u); }
typedef __bf16 bf16x2_t __attribute__((ext_vector_type(2)));
__device__ __forceinline__ unsigned cvt_pk_bf16(float lo, float hi) { const f32x2 v = {lo, hi}; const bf16x2_t b = __builtin_convertvector(v, bf16x2_t); return __builtin_bit_cast(unsigned, b); }
__device__ __forceinline__ unsigned pk2(float lo, float hi) { return cvt_pk_bf16(lo, hi); }
__device__ __forceinline__ unsigned f2bf(float f) { return cvt_pk_bf16(f, 0.f) & 0xffffu; }
__device__ __forceinline__ float fast_exp(float x) { return __builtin_amdgcn_exp2f(x * 1.4426950408889634f); }
__device__ __forceinline__ float fast_sigmoid(float x) { return __builtin_amdgcn_rcpf(1.0f + fast_exp(-x)); }
__device__ __forceinline__ float silu_f(float x) { return x * fast_sigmoid(x); }
__device__ __forceinline__ int opaque_tid() { int t = threadIdx.x; asm volatile("" : "+v"(t)); return t; }
__device__ __forceinline__ int opaque_s(int v) { asm volatile("" : "+s"(v)); return v; }
__device__ __forceinline__ void lds_barrier() { asm volatile("s_waitcnt lgkmcnt(0)" ::: "memory"); __builtin_amdgcn_s_barrier(); asm volatile("" ::: "memory"); }
__device__ __forceinline__ float dpp_add(float x, const int sel) {
    const int xi = __builtin_bit_cast(int, x); int r;
    switch (sel) { case 0: r = __builtin_amdgcn_update_dpp(xi, xi, 0xB1, 0xf, 0xf, false); break;
                   case 1: r = __builtin_amdgcn_update_dpp(xi, xi, 0x4E, 0xf, 0xf, false); break;
                   case 2: r = __builtin_amdgcn_update_dpp(xi, xi, 0x141, 0xf, 0xf, false); break;
                   default: r = __builtin_amdgcn_update_dpp(xi, xi, 0x140, 0xf, 0xf, false); break; }
    return x + __builtin_bit_cast(float, r);
}
__device__ __forceinline__ float wave_sum(float v) {
    v = dpp_add(v, 0); v = dpp_add(v, 1); v = dpp_add(v, 2); v = dpp_add(v, 3);
    v += __shfl_xor(v, 16); v += __shfl_xor(v, 32);
    return v;
}

namespace pg8 {
constexpr int BM = 256, BK = 64, HALF = 128, HTB = HALF * BK * 2, STAGE_BYTES = 8 * HTB, NXCD = 8, WGM = 8;
__host__ __device__ __forceinline__ int lds_byte(int r, int c) { const int st = (r >> 4) * 2 + (c >> 5), rr = r & 15, cc = c & 31, ob = rr * 64 + cc * 2; return st * 1024 + (ob ^ (((ob >> 9) & 1) << 5)); }
__host__ __device__ __forceinline__ void stage_rc(int b, int& R, int& C) { const int st = b / 1024, sb = b % 1024, swz = sb ^ (((sb >> 9) & 1) << 5); R = (st >> 1) * 16 + swz / 64; C = (st & 1) * 32 + (swz % 64) / 2; }
__host__ __device__ __forceinline__ int perm32(int rho) { const int n = rho >> 4, i = rho & 15; return 8 * (i >> 2) + 4 * n + (i & 3); }

typedef int v4i_t __attribute__((ext_vector_type(4)));
typedef int v8i_t __attribute__((ext_vector_type(8)));
struct Unit { int pm, pn, e; const char* A; const char* B; };

__device__ __forceinline__ bool static_tile(int i, int G, int c, int nM, int nN, int& pm, int& pn) {
    const int nwg = nM * nN; const long L = (long)i * G + c; if (L >= nwg) return false;
    int wgid = (int)L; { const int q = nwg / NXCD, r = nwg % NXCD, xcd = wgid % NXCD, off = wgid / NXCD; wgid = (xcd < r ? xcd * (q + 1) : r * (q + 1) + (xcd - r) * q) + off; }
    const int nig = WGM * nN, gid = wgid / nig, fm = gid * WGM, gsz = (nM - fm) < WGM ? (nM - fm) : WGM;
    pm = fm + ((wgid % nig) % gsz); pn = (wgid % nig) / gsz; return true;
}
struct DenseOrder {
    static constexpr bool GATHER = false;
    const char* A; const char* B; int nM, nN, G, c; size_t tstep;
    __device__ __forceinline__ void init(const void* A_, const void* B_, int M, int N, int K, int G_, int c_) { A = (const char*)A_; B = (const char*)B_; nM = M / BM; nN = N / BM; G = G_; c = c_; tstep = (size_t)BM * K * 2; }
    __device__ __forceinline__ bool next(int i, Unit& u) const { if (!static_tile(i, G, c, nM, nN, u.pm, u.pn)) return false; u.e = 0; u.A = A + (size_t)u.pm * tstep; u.B = B + (size_t)u.pn * tstep; return true; }
    __device__ __forceinline__ unsigned row_tok(const Unit&, int) const { return 0; }
};
template <bool GATHER_> struct MoeOrder {
    static constexpr bool GATHER = GATHER_;
    const char* A; const char* B; const int* tile_e; const int* slot_tok; int nM, nN, G, c; size_t tstep, estep;
    __device__ __forceinline__ void init(const void* A_, const void* B_, const int* tile_e_, const int* slot_tok_, int ntiles, int Nper, int Kbytes, int G_, int c_) {
        A = (const char*)A_; B = (const char*)B_; tile_e = tile_e_; slot_tok = slot_tok_; nM = ntiles; nN = Nper / BM; G = G_; c = c_; tstep = (size_t)BM * Kbytes; estep = (size_t)Nper * Kbytes; }
    __device__ __forceinline__ bool next(int i, Unit& u) const { if (!static_tile(i, G, c, nM, nN, u.pm, u.pn)) return false;
        u.e = __builtin_amdgcn_readfirstlane(tile_e[u.pm]); u.A = GATHER_ ? A : A + (size_t)u.pm * tstep; u.B = B + (size_t)u.e * estep + (size_t)u.pn * tstep; return true; }
    __device__ __forceinline__ unsigned row_tok(const Unit& u, int r) const { return (unsigned)slot_tok[u.pm * BM + r]; }
};

struct EpiBf16 {
    static constexpr bool PERM = true; static constexpr int WSCALE = 127;
    bf16* O; int ldc;
    __device__ __forceinline__ void operator()(const f32x4 (&acc)[2][2][4][2], const Unit& u, int wr, int wc, int fr, int fq) const {
        const int row0 = u.pm * BM + wr * 64 + fr, col0 = u.pn * BM + wc * 32 + 8 * fq;
#pragma unroll
        for (int ai = 0; ai < 2; ++ai)
#pragma unroll
            for (int m = 0; m < 4; ++m) { bf16* rowp = O + (size_t)(row0 + ai * HALF + m * 16) * ldc + col0;
#pragma unroll
                for (int bj = 0; bj < 2; ++bj) { const f32x4 v0 = acc[ai][bj][m][0], v1 = acc[ai][bj][m][1];
                    u32x4 w; w.x = cvt_pk_bf16(v0[0], v0[1]); w.y = cvt_pk_bf16(v0[2], v0[3]); w.z = cvt_pk_bf16(v1[0], v1[1]); w.w = cvt_pk_bf16(v1[2], v1[3]);
                    *(u32x4*)(rowp + bj * HALF) = w; } }
    }
};
struct EpiSwiglu {
    static constexpr bool PERM = false; static constexpr int WSCALE = 123;
    unsigned char* H; const float* bias;
    __device__ __forceinline__ void operator()(const f32x4 (&acc)[2][2][4][2], const Unit& u, int wr, int wc, int fr, int fq) const {
        const int row0 = u.pm * BM + wr * 64 + fr, colh = u.pn * 128 + wc * 32 + 8 * fq;
        const float* bp = bias + (size_t)u.e * 2048 + u.pn * 256 + wc * 32 + 4 * fq;
        f32x4 bv[2][2];
#pragma unroll
        for (int bj = 0; bj < 2; ++bj)
#pragma unroll
            for (int n = 0; n < 2; ++n) bv[bj][n] = *(const f32x4*)(bp + bj * HALF + n * 16);
#pragma unroll
        for (int ai = 0; ai < 2; ++ai)
#pragma unroll
            for (int m = 0; m < 4; ++m) { unsigned char* rowp = H + (size_t)(row0 + ai * HALF + m * 16) * FF + colh;
                float o[8];
#pragma unroll
                for (int n = 0; n < 2; ++n) { const f32x4 g4 = acc[ai][0][m][n] + bv[0][n], u4 = acc[ai][1][m][n] + bv[1][n];
#pragma unroll
                    for (int j = 0; j < 4; ++j) { const float g = fminf(g4[j], 7.0f), up = fminf(fmaxf(u4[j], -7.0f), 7.0f);
                        const float glu = g * __builtin_amdgcn_rcpf(1.0f + __builtin_amdgcn_exp2f(g * (-1.702f * 1.4426950408889634f)));
                        o[n * 4 + j] = (up + 1.0f) * glu; } }
                int w0 = __builtin_amdgcn_cvt_pk_fp8_f32(o[0], o[1], 0, false); w0 = __builtin_amdgcn_cvt_pk_fp8_f32(o[2], o[3], w0, true);
                int w1 = __builtin_amdgcn_cvt_pk_fp8_f32(o[4], o[5], 0, false); w1 = __builtin_amdgcn_cvt_pk_fp8_f32(o[6], o[7], w1, true);
                *(u32x2*)rowp = (u32x2){(unsigned)w0, (unsigned)w1}; }
    }
};
struct EpiDown {
    static constexpr bool PERM = true; static constexpr int WSCALE = 122;
    bf16* Y; const float* bias; const float* slot_gate;
    __device__ __forceinline__ void operator()(const f32x4 (&acc)[2][2][4][2], const Unit& u, int wr, int wc, int fr, int fq) const {
        const int row0 = u.pm * BM + wr * 64 + fr, col0 = u.pn * BM + wc * 32 + 8 * fq;
        const float* bp = bias + (size_t)u.e * 1024 + col0;
        f32x4 bv[2][2];
#pragma unroll
        for (int bj = 0; bj < 2; ++bj)
#pragma unroll
            for (int n = 0; n < 2; ++n) bv[bj][n] = *(const f32x4*)(bp + bj * HALF + 4 * n);
#pragma unroll
        for (int ai = 0; ai < 2; ++ai)
#pragma unroll
            for (int m = 0; m < 4; ++m) { const int row = row0 + ai * HALF + m * 16; const float g = slot_gate[row]; bf16* rowp = Y + (size_t)row * D + col0;
#pragma unroll
                for (int bj = 0; bj < 2; ++bj) { const f32x4 v0 = (acc[ai][bj][m][0] + bv[bj][0]) * g, v1 = (acc[ai][bj][m][1] + bv[bj][1]) * g;
                    u32x4 w; w.x = cvt_pk_bf16(v0[0], v0[1]); w.y = cvt_pk_bf16(v0[2], v0[3]); w.z = cvt_pk_bf16(v1[0], v1[1]); w.w = cvt_pk_bf16(v1[2], v1[3]);
                    *(u32x4*)(rowp + bj * HALF) = w; } }
    }
};

template <class Epi, class Sched, int ES = 2, bool ALIGN_EPI = true>
__device__ __forceinline__ void gemm_phase(LAS unsigned char* lds, const int K, const Sched& S, const Epi& E) {
    constexpr bool GA = Sched::GATHER;
    const int tid = opaque_tid(), wid = __builtin_amdgcn_readfirstlane(tid >> 6), lane = tid & 63, wr = wid >> 2, wc = wid & 3, fr = lane & 15, fq = lane >> 4;
    const int nt = K * ES / (BK * 2);
    unsigned voffA[2], voffB[2]; int Rr[2]; unsigned Cb[2];
#pragma unroll
    for (int i = 0; i < 2; ++i) { int R, C; stage_rc(tid * 16 + i * 8192, R, C); const int Rb = Epi::PERM ? ((R & ~31) + perm32(R & 31)) : R;
        voffA[i] = (unsigned)(R * K * ES + C * 2); voffB[i] = (unsigned)(Rb * K * ES + C * 2); Rr[i] = R; Cb[i] = (unsigned)C * 2u; }
    const size_t kstep = (size_t)(BK * 2);
    const size_t hstep = (size_t)HALF * K * ES;
    const unsigned ldsw = (unsigned)wid * 1024u;
    const int aoff0 = lds_byte(wr * 64 + fr, ES == 2 ? fq * 8 : fq * 16), aoff1 = lds_byte(wr * 64 + fr, ES == 2 ? fq * 8 + 32 : fq * 16 + 8);
    const int boff0 = lds_byte(wc * 32 + fr, ES == 2 ? fq * 8 : fq * 16), boff1 = lds_byte(wc * 32 + fr, ES == 2 ? fq * 8 + 32 : fq * 16 + 8);
    unsigned cOff[2][2], nOff[2][2], sOff[2][2];
#define PG8_SA(b, h) (((b) * 2 + (h)) * HTB)
#define PG8_SB(b, h) ((4 + (b) * 2 + (h)) * HTB)
#define PG8_STAGE(bufoff, gbase, voff) do { _Pragma("unroll") for (int _i = 0; _i < 2; ++_i) \
        __builtin_amdgcn_global_load_lds((const unsigned*)((const char*)(gbase) + (voff)[_i]), (LAS unsigned*)(lds + (bufoff) + ldsw + _i * 8192), 16, 0, 0); } while (0)
#define PG8_STAGE_A(bufoff, gbase, half, OFF) do { if constexpr (GA) { PG8_STAGE(bufoff, gbase, (OFF)[half]); } else { PG8_STAGE(bufoff, (gbase) + (half) * hstep, voffA); } } while (0)
#define PG8_LDA(dst, b, h) do { if constexpr (ES == 2) { _Pragma("unroll") for (int m = 0; m < 4; ++m) _Pragma("unroll") for (int k = 0; k < 2; ++k) dst[m][k] = *(const LAS bf16x8*)(lds + PG8_SA(b, h) + (k ? aoff1 : aoff0) + m * 2048); } \
        else { _Pragma("unroll") for (int m = 0; m < 4; ++m) dst##8[m] = __builtin_shufflevector(*(const LAS v4i_t*)(lds + PG8_SA(b, h) + aoff0 + m * 2048), *(const LAS v4i_t*)(lds + PG8_SA(b, h) + aoff1 + m * 2048), 0, 1, 2, 3, 4, 5, 6, 7); } } while (0)
#define PG8_LDB(dst, b, h) do { if constexpr (ES == 2) { _Pragma("unroll") for (int n = 0; n < 2; ++n) _Pragma("unroll") for (int k = 0; k < 2; ++k) dst[n][k] = *(const LAS bf16x8*)(lds + PG8_SB(b, h) + (k ? boff1 : boff0) + n * 2048); } \
        else { _Pragma("unroll") for (int n = 0; n < 2; ++n) dst##8[n] = __builtin_shufflevector(*(const LAS v4i_t*)(lds + PG8_SB(b, h) + boff0 + n * 2048), *(const LAS v4i_t*)(lds + PG8_SB(b, h) + boff1 + n * 2048), 0, 1, 2, 3, 4, 5, 6, 7); } } while (0)
#define PG8_MMA(ai, bj, At, Bt) do { __builtin_amdgcn_s_setprio(1); _Pragma("unroll") for (int m = 0; m < 4; ++m) _Pragma("unroll") for (int n = 0; n < 2; ++n) { \
        if constexpr (ES == 2) { _Pragma("unroll") for (int k = 0; k < 2; ++k) acc[ai][bj][m][n] = __builtin_amdgcn_mfma_f32_16x16x32_bf16(Bt[n][k], At[m][k], acc[ai][bj][m][n], 0, 0, 0); } \
        else { asm volatile("v_mfma_scale_f32_16x16x128_f8f6f4 %0, %1, %2, %0, %3, %4 op_sel_hi:[0,0,0]" : "+v"(acc[ai][bj][m][n]) : "v"(Bt##8[n]), "v"(At##8[m]), "v"(wscale_v), "v"(ascale_v)); } } \
        __builtin_amdgcn_s_setprio(0); } while (0)
#define PG8_WAIT_V(n) asm volatile("s_waitcnt vmcnt(" #n ")" ::: "memory")
#define PG8_WAIT_L(n) asm volatile("s_waitcnt lgkmcnt(" #n ")" ::: "memory")
#define PG8_BAR __builtin_amdgcn_s_barrier()
#define PG8_SCHED __builtin_amdgcn_sched_barrier(0)
#define PG8_GOFF(dst, u) do { if constexpr (GA) { _Pragma("unroll") for (int _h = 0; _h < 2; ++_h) _Pragma("unroll") for (int _i = 0; _i < 2; ++_i) \
        dst[_h][_i] = S.row_tok(u, _h * HALF + Rr[_i]) * (unsigned)(K * ES) + Cb[_i]; } } while (0)
    Unit cur, nxt; int ui = 0;
    if (!S.next(0, cur)) return;
    f32x4 acc[2][2][4][2];
#pragma unroll
    for (int a = 0; a < 2; ++a)
#pragma unroll
        for (int b = 0; b < 2; ++b)
#pragma unroll
            for (int m = 0; m < 4; ++m)
#pragma unroll
                for (int n = 0; n < 2; ++n) acc[a][b][m][n] = (f32x4){0.f, 0.f, 0.f, 0.f};
    int wscale_v = Epi::WSCALE, ascale_v = 127; asm volatile("" : "+v"(wscale_v), "+v"(ascale_v));
    bf16x8 At[4][2], B0[2][2], B1[2][2];
    v8i_t At8[4], B08[2], B18[2];
    const char* cA = cur.A; const char* cB = cur.B;
    PG8_GOFF(cOff, cur);
#pragma unroll
    for (int h = 0; h < 2; ++h)
#pragma unroll
        for (int i = 0; i < 2; ++i) { nOff[h][i] = 0u; sOff[h][i] = 0u; }
    if constexpr (GA) { VM_WAIT(); }
    PG8_STAGE(PG8_SB(0, 0), cB, voffB); PG8_STAGE(PG8_SB(0, 1), cB + hstep, voffB); PG8_STAGE_A(PG8_SA(0, 0), cA, 0, cOff); PG8_STAGE_A(PG8_SA(0, 1), cA, 1, cOff);
    if (wr == 1) PG8_BAR;
    PG8_WAIT_V(2); PG8_BAR;
    PG8_STAGE(PG8_SB(1, 0), cB + kstep, voffB); PG8_STAGE_A(PG8_SA(1, 0), cA + kstep, 0, cOff); PG8_STAGE(PG8_SB(1, 1), cB + hstep + kstep, voffB);
    PG8_WAIT_V(6); PG8_BAR;
    for (;;) {
        const bool has_next = S.next(ui + 1, nxt);
        const char* nA = has_next ? nxt.A : cA; const char* nB = has_next ? nxt.B : cB;
        if constexpr (GA) { if (has_next) { PG8_GOFF(nOff, nxt); } else {
#pragma unroll
            for (int h = 0; h < 2; ++h)
#pragma unroll
                for (int i = 0; i < 2; ++i) nOff[h][i] = cOff[h][i]; } }
#pragma unroll 1
        for (int t = 0; t < nt; t += 2) {
            const bool last = (t == nt - 2);
            const char* a1 = cA + (size_t)(t + 1) * kstep;
            const char* a2 = last ? nA : cA + (size_t)(t + 2) * kstep; const char* b2 = last ? nB : cB + (size_t)(t + 2) * kstep;
            const char* a3 = a2 + kstep; const char* b3 = b2 + kstep;
            if constexpr (GA) {
#pragma unroll
                for (int h = 0; h < 2; ++h)
#pragma unroll
                    for (int i = 0; i < 2; ++i) sOff[h][i] = last ? nOff[h][i] : cOff[h][i]; }
            PG8_LDB(B0, 0, 0); PG8_LDB(B1, 0, 1); PG8_SCHED; PG8_LDA(At, 0, 0); PG8_STAGE_A(PG8_SA(1, 1), a1, 1, cOff);
            PG8_WAIT_V(8); PG8_WAIT_L(0); PG8_BAR; PG8_MMA(0, 0, At, B0); PG8_MMA(0, 1, At, B1); PG8_BAR; PG8_SCHED;
            PG8_LDA(At, 0, 1); PG8_STAGE(PG8_SB(0, 0), b2, voffB); PG8_STAGE(PG8_SB(0, 1), b2 + hstep, voffB); PG8_STAGE_A(PG8_SA(0, 0), a2, 0, sOff);
            PG8_WAIT_V(8); PG8_WAIT_L(0); PG8_BAR; PG8_MMA(1, 0, At, B0); PG8_MMA(1, 1, At, B1); PG8_BAR; PG8_SCHED;
            PG8_LDB(B0, 1, 0); PG8_LDB(B1, 1, 1); PG8_SCHED; PG8_LDA(At, 1, 0); PG8_STAGE_A(PG8_SA(0, 1), a2, 1, sOff);
            PG8_WAIT_V(8); PG8_WAIT_L(0); PG8_BAR; PG8_MMA(0, 0, At, B0); PG8_MMA(0, 1, At, B1); PG8_BAR; PG8_SCHED;
            PG8_LDA(At, 1, 1); PG8_STAGE(PG8_SB(1, 0), b3, voffB); PG8_STAGE(PG8_SB(1, 1), b3 + hstep, voffB); PG8_STAGE_A(PG8_SA(1, 0), a3, 0, sOff);
            PG8_WAIT_V(8); PG8_WAIT_L(0); PG8_BAR; PG8_MMA(1, 0, At, B0); PG8_MMA(1, 1, At, B1); PG8_BAR; PG8_SCHED;
        }
        if constexpr (ALIGN_EPI) { if (wr == 0) PG8_BAR; }
        if constexpr (ES == 1) { asm volatile("s_nop 15\n\ts_nop 15" ::: "memory"); }
        E(acc, cur, wr, wc, fr, fq);
        if (!has_next) break;
#pragma unroll
        for (int a = 0; a < 2; ++a)
#pragma unroll
            for (int b = 0; b < 2; ++b)
#pragma unroll
                for (int m = 0; m < 4; ++m)
#pragma unroll
                    for (int n = 0; n < 2; ++n) acc[a][b][m][n] = (f32x4){0.f, 0.f, 0.f, 0.f};
        cur = nxt; cA = nA; cB = nB; ++ui;
        if constexpr (GA) {
#pragma unroll
            for (int h = 0; h < 2; ++h)
#pragma unroll
                for (int i = 0; i < 2; ++i) cOff[h][i] = nOff[h][i]; }
        if constexpr (ALIGN_EPI) { if (wr == 1) PG8_BAR; }
    }
    PG8_WAIT_V(0);
    if constexpr (!ALIGN_EPI) { if (wr == 0) PG8_BAR; }
    PG8_BAR;
#undef PG8_SA
#undef PG8_SB
#undef PG8_STAGE
#undef PG8_STAGE_A
#undef PG8_LDA
#undef PG8_LDB
#undef PG8_MMA
#undef PG8_WAIT_V
#undef PG8_WAIT_L
#undef PG8_BAR
#undef PG8_SCHED
#undef PG8_GOFF
}
}

#define XB_TMO      128
#define XB_XCNT(j)  (256  + 64 * (j))
#define XB_XSUB(j)  (1280 + 64 * (j))
#define XB_XGEN(j)  (2304 + 64 * (j))
#define XB_TOP      3328
#define XB_TOPGEN   3392
#define XCD_BAR_WORDS 3456
#define XB_SPIN_CAP (1u << 18)
__device__ __forceinline__ unsigned xb_ld(unsigned* p)              { return __hip_atomic_load(p, __ATOMIC_RELAXED, __HIP_MEMORY_SCOPE_AGENT); }
__device__ __forceinline__ unsigned xb_add(unsigned* p, unsigned v) { return __hip_atomic_fetch_add(p, v, __ATOMIC_RELAXED, __HIP_MEMORY_SCOPE_AGENT); }
__device__ __forceinline__ unsigned xb_xcc_id() { return (unsigned)__builtin_amdgcn_s_getreg((3 << 11) | 20) & 0xFu; }
#define XB_SPIN(cond, bar) do { unsigned _sp = 0; while (cond) { __builtin_amdgcn_s_sleep(1); \
    if ((++_sp & 255u) == 0u) { if (xb_ld(&(bar)[XB_TMO])) break; if (_sp > XB_SPIN_CAP) { atomicAdd(&(bar)[XB_TMO], 1u); break; } } } } while (0)
struct XcdBarrier { unsigned* bar; unsigned x; volatile LAS unsigned* st; };
__device__ __forceinline__ XcdBarrier xcd_barrier_post(unsigned* bar, volatile LAS unsigned* st) {
    XcdBarrier b; b.bar = bar; b.x = xb_xcc_id(); b.st = st;
    if (threadIdx.x == 0) (void)xb_add(&bar[XB_XCNT(b.x)], 1u);
    return b;
}
__device__ __forceinline__ void xcd_barrier_complete(unsigned* bar, unsigned x, unsigned& nloc, unsigned& nx) {
    const unsigned G = gridDim.x * gridDim.y * gridDim.z;
    unsigned sum, cnt, mine, sp = 0u;
    for (;;) {
        sum = 0u; cnt = 0u; mine = 0u;
#pragma unroll
        for (unsigned j = 0; j < 16; ++j) { const unsigned c = xb_ld(&bar[XB_XCNT(j)]); sum += c; cnt += (c > 0u) ? 1u : 0u; mine = (j == x) ? c : mine; }
        if (sum == G) break;
        __builtin_amdgcn_s_sleep(1);
        if ((++sp & 255u) == 0u) { if (xb_ld(&bar[XB_TMO])) break; if (sp > XB_SPIN_CAP) { atomicAdd(&bar[XB_TMO], 1u); break; } }
    }
    nloc = mine > 0u ? mine : 1u; nx = cnt > 0u ? cnt : 1u;
}
__device__ __forceinline__ void xcd_barrier(const XcdBarrier& b) {
    asm volatile("s_waitcnt vmcnt(0)" ::: "memory");
    __syncthreads();
    if (threadIdx.x == 0) {
        unsigned* bar = b.bar;
        __builtin_amdgcn_s_waitcnt(0);
        unsigned nloc = b.st[0], nx = b.st[1];
        if (nloc == 0u) { xcd_barrier_complete(bar, b.x, nloc, nx); b.st[0] = nloc; b.st[1] = nx; }
        const unsigned old = xb_add(&bar[XB_XSUB(b.x)], 1u);
        const unsigned gen = old / nloc;
        if (old + 1u == (gen + 1u) * nloc) {
            __builtin_amdgcn_fence(__ATOMIC_RELEASE, "agent");
            asm volatile("s_waitcnt vmcnt(0)" ::: "memory");
            const unsigned og = xb_add(&bar[XB_TOP], 1u);
            const unsigned tg = og / nx;
            if (og + 1u == (tg + 1u) * nx) xb_add(&bar[XB_TOPGEN], 1u);
            else XB_SPIN(xb_ld(&bar[XB_TOPGEN]) == tg, bar);
            __builtin_amdgcn_fence(__ATOMIC_ACQUIRE, "agent");
            xb_add(&bar[XB_XGEN(b.x)], 1u);
            asm volatile("s_waitcnt vmcnt(0)" ::: "memory");
        } else {
            XB_SPIN(xb_ld(&bar[XB_XGEN(b.x)]) == gen, bar);
            __builtin_amdgcn_fence(__ATOMIC_ACQUIRE, "agent");
            asm volatile("s_waitcnt vmcnt(0)" ::: "memory");
        }
    }
    __syncthreads();
}

struct Args {
    const float* in[33];
    float* out; unsigned char* ws;
    int ph_lo, ph_hi;
};
enum { I_X = 0, I_MEM, I_WIN, I_GLACONV, I_GLAW2, I_GLAB, I_GLANG, I_HGLB, I_HGNG, I_RWMU, I_RWW0, I_RWW2, I_RWA0, I_RWA2, I_RWG2, I_RWKK, I_RWKA, I_RWRK, I_RWLNW, I_RWLNB,
       I_WMK, I_WMV, I_WOUT, I_LN1G, I_LN1B, I_RTW, I_RTB, I_WGU, I_BGU, I_WDN, I_BDN, I_LN2G, I_LN2B };


template <int OFF> __device__ __forceinline__ unsigned long long ka_u64() { unsigned long long v; asm volatile("s_load_dwordx2 %0, %1, %2\n\ts_waitcnt lgkmcnt(0)" : "=s"(v) : "s"(__builtin_amdgcn_kernarg_segment_ptr()), "n"(OFF)); return v; }
#define KIN(i) ((const float*)(const GAS float*)ka_u64<8 * (i)>())
#define KOUT() ((float*)(GAS float*)ka_u64<264>())
#define KWS() ((unsigned char*)(GAS unsigned char*)ka_u64<272>())

template <class Map>
__device__ __forceinline__ void tr_item(const float* __restrict__ W, int K, int N, bf16* __restrict__ WT, LAS float* scr, int kb, int nb, int lane, Map map) {
    const int k0 = 64 * kb, n0 = 64 * nb, col = n0 + lane; const bool valid = col < N;
    const float* src = W + (size_t)k0 * N + (valid ? col : 0);
#pragma unroll 16
    for (int kk = 0; kk < 64; ++kk) { const float v = valid ? src[(size_t)kk * N] : 0.f; scr[kk * 65 + lane] = v; }
    LDS_WAIT(); asm volatile("" ::: "memory");
    const int c = lane & 7;
#pragma unroll
    for (int j = 0; j < 8; ++j) { const int n = (lane >> 3) + 8 * j;
        if (n0 + n < N) { const int orow = map(n0 + n); const LAS float* s = scr + (8 * c) * 65 + n;
            u32x4 o; o.x = pk2(s[0 * 65], s[1 * 65]); o.y = pk2(s[2 * 65], s[3 * 65]); o.z = pk2(s[4 * 65], s[5 * 65]); o.w = pk2(s[6 * 65], s[7 * 65]);
            *(u32x4*)(WT + (size_t)orow * K + k0 + 8 * c) = o; } }
    LDS_WAIT(); asm volatile("" ::: "memory");
}
template <class Map>
__device__ __forceinline__ void tr_item_f8(const float* __restrict__ W, int K, int N, unsigned char* __restrict__ WT8, LAS float* scr, int kb, int nb, int lane, float scale, Map map) {
    const int k0 = 64 * kb, n0 = 64 * nb, col = n0 + lane;
    const float* src = W + (size_t)k0 * N + col;
#pragma unroll 16
    for (int kk = 0; kk < 64; ++kk) scr[kk * 65 + lane] = src[(size_t)kk * N] * scale;
    LDS_WAIT(); asm volatile("" ::: "memory");
    const int c = lane & 3;
#pragma unroll
    for (int j = 0; j < 4; ++j) { const int n = (lane >> 2) + 16 * j; const int orow = map(n0 + n); const LAS float* s = scr + (16 * c) * 65 + n;
        u32x4 o;
#pragma unroll
        for (int q = 0; q < 4; ++q) { int w = __builtin_amdgcn_cvt_pk_fp8_f32(s[(4 * q) * 65], s[(4 * q + 1) * 65], 0, false); w = __builtin_amdgcn_cvt_pk_fp8_f32(s[(4 * q + 2) * 65], s[(4 * q + 3) * 65], w, true); o[q] = (unsigned)w; }
        *(u32x4*)(WT8 + (size_t)orow * K + k0 + 16 * c) = o; }
    LDS_WAIT(); asm volatile("" ::: "memory");
}
struct MapIdent { int off; __device__ __forceinline__ int operator()(int c) const { return c + off; } };
struct MapWin { __device__ __forceinline__ int operator()(int c) const { return c < 512 ? c : (c < 528 ? c + 2560 : c - 16); } };
__device__ __forceinline__ int gu_row(int c) { const int f = c >> 1, bj = c & 1, pn = f >> 7, fl = f & 127, wc = fl >> 5, fq = (fl >> 3) & 3, n = (fl >> 2) & 1, j = fl & 3; return 256 * pn + 128 * bj + 32 * wc + 16 * n + 4 * fq + j; }
struct MapGu { __device__ __forceinline__ int operator()(int c) const { return gu_row(c); } };

__device__ __forceinline__ void prologue_phase(LAS unsigned char* lds, int vcu, int G) {
    const int tid = opaque_tid(), lane = tid & 63, wave = __builtin_amdgcn_readfirstlane(tid >> 6);
    LAS float* scr = (LAS float*)(lds + wave * 16640); static_assert(8 * 16640 <= LDSCTL_OFF, "prologue scratch below the LDS control words");
    const int gw = vcu * NWAVES + wave, NGW = G * NWAVES;
    unsigned char* ws = KWS();
    constexpr int IT_GU = NL * NE * 512, IT_DN = NL * NE * 256, IT_IN = NL * 16 * 49, IT_OUT = NL * 256, IT_MEM = NL * 2 * 64, IT_L64 = NL * 2 * 4, IT_L128 = NL * 2 * 4;
    constexpr int IT_TOTAL = IT_GU + IT_DN + IT_IN + IT_OUT + IT_MEM + IT_L64 + IT_L128;
    for (int it = gw; it < IT_TOTAL; it += NGW) {
        int r = it;
        if (r < IT_GU) { const int le = r >> 9, q = r & 511, kb = q >> 5, nb = q & 31;
            tr_item_f8(KIN(I_WGU) + (size_t)le * 1024 * 2048, 1024, 2048, (unsigned char*)(ws + WS_WGU) + (size_t)le * 2048 * 1024, scr, kb, nb, lane, 16.0f, MapGu{}); continue; } r -= IT_GU;
        if (r < IT_DN) { const int le = r >> 8, q = r & 255, kb = q >> 4, nb = q & 15;
            tr_item_f8(KIN(I_WDN) + (size_t)le * 1024 * 1024, 1024, 1024, (unsigned char*)(ws + WS_WD) + (size_t)le * 1024 * 1024, scr, kb, nb, lane, 32.0f, MapIdent{0}); continue; } r -= IT_DN;
        if (r < IT_IN) { const int l = r / (16 * 49), q = r % (16 * 49), kb = q / 49, nb = q % 49;
            tr_item(KIN(I_WIN) + (size_t)l * 1024 * PIN, 1024, PIN, (bf16*)(ws + WS_WIN) + (size_t)l * PINP * 1024, scr, kb, nb, lane, MapWin{}); continue; } r -= IT_IN;
        if (r < IT_OUT) { const int l = r >> 8, q = r & 255, kb = q >> 4, nb = q & 15;
            tr_item(KIN(I_WOUT) + (size_t)l * 1024 * 1024, 1024, 1024, (bf16*)(ws + WS_WOUT) + (size_t)l * 1024 * 1024, scr, kb, nb, lane, MapIdent{0}); continue; } r -= IT_OUT;
        if (r < IT_MEM) { const int l = r >> 7, q = r & 127, kv = q >> 6, kb = (q >> 2) & 15, nb = q & 3;
            tr_item((kv ? KIN(I_WMV) : KIN(I_WMK)) + (size_t)l * 1024 * 256, 1024, 256, (bf16*)(ws + WS_WMEM), scr, kb, nb, lane, MapIdent{l * 512 + kv * 256}); continue; } r -= IT_MEM;
        if (r < IT_L64) { const int l = r >> 3, q = r & 7, wa = q >> 2, nb = q & 3;
            tr_item((wa ? KIN(I_RWA2) : KIN(I_RWW2)) + (size_t)l * 64 * 256, 64, 256, (bf16*)(ws + WS_LORA) + (size_t)wa * (NL * 256 * 64) + (size_t)l * 256 * 64, scr, 0, nb, lane, MapIdent{0}); continue; } r -= IT_L64;
        { const int l = r >> 3, q = r & 7, kb = q >> 2, nb = q & 3;
            tr_item(KIN(I_RWG2) + (size_t)l * 128 * 256, 128, 256, (bf16*)(ws + WS_LORA) + (size_t)2 * (NL * 256 * 64) + (size_t)l * 256 * 128, scr, kb, nb, lane, MapIdent{0}); }
    }
    { const size_t gt = (size_t)vcu * NTHR + tid, GT = (size_t)G * NTHR; constexpr size_t per = (size_t)(PINP - PIN) * 1024 / 8;
        for (size_t i = gt; i < per * NL; i += GT) { const size_t l = i / per, j = i % per; *(u32x4*)((bf16*)(ws + WS_WIN) + l * PINP * 1024 + (size_t)PIN * 1024 + j * 8) = (u32x4){0u, 0u, 0u, 0u}; }
        for (size_t i = gt; i < (size_t)NL * NE * 2048; i += GT) { const size_t le = i >> 11; const int c = (int)(i & 2047); ((float*)(ws + WS_BGU))[le * 2048 + gu_row(c)] = KIN(I_BGU)[i]; }
        const f32x4* xs = (const f32x4*)KIN(I_X); u32x4* xd = (u32x4*)(ws + WS_XB);
        for (size_t i = gt; i < (size_t)NTOK * D / 8; i += GT) { const f32x4 v0 = xs[2 * i], v1 = xs[2 * i + 1]; xd[i] = (u32x4){pk2(v0[0], v0[1]), pk2(v0[2], v0[3]), pk2(v1[0], v1[1]), pk2(v1[2], v1[3])}; }
        const f32x4* ms = (const f32x4*)KIN(I_MEM); u32x4* md = (u32x4*)(ws + WS_MEMB);
        for (size_t i = gt; i < (size_t)NB * NMEM * D / 8; i += GT) { const f32x4 v0 = ms[2 * i], v1 = ms[2 * i + 1]; md[i] = (u32x4){pk2(v0[0], v0[1]), pk2(v0[2], v0[3]), pk2(v1[0], v1[1]), pk2(v1[2], v1[3])}; }
    }
}


__device__ __forceinline__ float log1pexp_neg_abs(float z) { return __builtin_amdgcn_logf(1.0f + fast_exp(-fabsf(z))) * 0.6931471805599453f; }
__device__ __forceinline__ float tanh_f(float x) { const float e = fast_exp(-2.0f * fabsf(x)); const float t = (1.0f - e) * __builtin_amdgcn_rcpf(1.0f + e); return x < 0.f ? -t : t; }

constexpr int NCH = T / 32;
__device__ __forceinline__ int rho16(int r, int hh) { return (r & 3) + 8 * (r >> 2) + 4 * hh; }
__device__ __forceinline__ void hg_fused_unit(LAS unsigned char* lds, int l, int b, int c) {
    const int tid = opaque_tid(), lane = tid & 63, wave = __builtin_amdgcn_readfirstlane(tid >> 6), r32 = lane & 31, hh = lane >> 5;
    unsigned char* ws = KWS();
    const bf16* P = (const bf16*)(ws + WS_P) + ((size_t)b * T + c * 32) * PINP;
    constexpr int HB = 16640;
    if (tid < 256) {
        const int ch = tid, h = ch >> 6, d = ch & 63; const size_t un = (size_t)(b * 4 + h) * NCH + c;
        float lb;
        { const float* hp = KIN(I_HGLB) + ch; const float v0 = hp[0], v1 = hp[256], v2 = hp[512], v3 = hp[768]; const float m = fmaxf(fmaxf(v0, v1), fmaxf(v2, v3));
          const float e0 = __expf(v0 - m), e1 = __expf(v1 - m), e2 = __expf(v2 - m), e3 = __expf(v3 - m); const float inv = 1.0f / (e0 + e1 + e2 + e3);
          lb = (l >= 1 ? e1 : 0.f) + (l >= 2 ? e2 : 0.f) + (l >= 3 ? e3 : 0.f); lb *= inv; }
        const float oml = 1.0f - lb;
        LAS bf16* KT = (LAS bf16*)(lds + h * HB); LAS float* BE = (LAS float*)(lds + h * HB + 8192);
        LAS bf16* QL = (LAS bf16*)(lds + h * HB + 8448) + d; LAS bf16* KL = (LAS bf16*)(lds + h * HB + 12544) + d;
        float bc = 0.f;
        unsigned short hqr[32], hfr[32];
#pragma unroll
        for (int t = 0; t < 32; ++t) { const bf16* row = P + (size_t)t * PINP; hqr[t] = row[PC_HQ + ch]; hfr[t] = row[PC_HF + ch]; }
#pragma unroll
        for (int t8 = 0; t8 < 4; ++t8) { u32x4 kp;
#pragma unroll
            for (int jj = 0; jj < 4; ++jj) { float k2[2];
#pragma unroll
                for (int e = 0; e < 2; ++e) { const int t = t8 * 8 + jj * 2 + e; const float hf = bf2f(hfr[t]); const float s = fast_sigmoid(hf), sn = fast_sigmoid(-hf);
                    bc = fmaxf(bc + __builtin_amdgcn_logf(fmaxf(lb + oml * s, 1e-30f)) * 0.6931471805599453f, -80.0f);
                    const float qt = silu_f(bf2f(hqr[t])) * fast_exp(bc), kt = oml * sn * fast_exp(-bc);
                    QL[t * 64] = (bf16)f2bf(qt); KL[t * 64] = (bf16)f2bf(kt); k2[e] = kt; }
                kp[jj] = pk2(k2[0], k2[1]); }
            *(LAS u32x4*)(KT + d * 32 + t8 * 8) = kp; }
        const float ebend = fast_exp(bc); BE[d] = ebend; ((float*)(ws + WS_HBE))[un * 64 + d] = ebend;
    } else {
        const int cv = tid - 256, h = cv >> 6, vi = cv & 63; const size_t un = (size_t)(b * 4 + h) * NCH + c;
        LAS bf16* VT = (LAS bf16*)(lds + h * HB + 4096); bf16* VTg = (bf16*)(ws + WS_HVT) + un * 2048 + vi * 32;
        unsigned short hvr[32];
#pragma unroll
        for (int t = 0; t < 32; ++t) hvr[t] = P[(size_t)t * PINP + PC_HI + cv];
#pragma unroll
        for (int t8 = 0; t8 < 4; ++t8) { u32x4 vp;
#pragma unroll
            for (int jj = 0; jj < 4; ++jj) vp[jj] = (unsigned)hvr[t8 * 8 + 2 * jj] | ((unsigned)hvr[t8 * 8 + 2 * jj + 1] << 16);
            *(LAS u32x4*)(VT + vi * 32 + t8 * 8) = vp; *(u32x4*)(VTg + t8 * 8) = vp; }
    }
    lds_barrier();
    { const int h = wave >> 1, vt = wave & 1; const size_t un = (size_t)(b * 4 + h) * NCH + c;
      const LAS bf16* KT = (const LAS bf16*)(lds + h * HB); const LAS bf16* VT = (const LAS bf16*)(lds + h * HB + 4096); const LAS float* BE = (const LAS float*)(lds + h * HB + 8192);
      float* DSg = (float*)(ws + WS_HDS) + un * 4096;
      { const LAS bf16* srcL = (const LAS bf16*)(lds + h * HB + (vt == 0 ? 8448 : 12544)); u32x4* dstG = (u32x4*)((bf16*)(ws + (vt == 0 ? WS_HQ : WS_HK)) + un * 2048);
#pragma unroll
        for (int i = 0; i < 4; ++i) dstG[i * 64 + lane] = *(const LAS u32x4*)(srcL + (i * 64 + lane) * 8); }
#pragma unroll
      for (int dt = 0; dt < 2; ++dt) { f32x16 acc;
#pragma unroll
          for (int i = 0; i < 16; ++i) acc[i] = 0.f;
#pragma unroll
          for (int s = 0; s < 2; ++s) { const bf16x8 A = *(const LAS bf16x8*)(VT + (32 * vt + r32) * 32 + 16 * s + 8 * hh), B = *(const LAS bf16x8*)(KT + (32 * dt + r32) * 32 + 16 * s + 8 * hh);
              acc = __builtin_amdgcn_mfma_f32_32x32x16_bf16(A, B, acc, 0, 0, 0); }
          const float ebd = BE[32 * dt + r32];
#pragma unroll
          for (int r = 0; r < 16; ++r) DSg[(32 * vt + rho16(r, hh)) * 64 + 32 * dt + r32] = acc[r] * ebd; } }
    lds_barrier();
}
__device__ __forceinline__ void gla_fused_unit(LAS unsigned char* lds, int l, int b, int c) {
    const int tid = opaque_tid(), lane = tid & 63, wave = __builtin_amdgcn_readfirstlane(tid >> 6), r32 = lane & 31, hh = lane >> 5;
    unsigned char* ws = KWS();
    const int t0 = c * 32;
    const bf16* P = (const bf16*)(ws + WS_P) + ((size_t)b * T + t0) * PINP;
    LAS float* GL = (LAS float*)lds;
    constexpr int HB = 10368, H0 = 2048;
    GL[tid] = bf2f(P[(size_t)(tid >> 4) * PINP + PC_GLR + (tid & 15)]);
    lds_barrier();
    if (tid < 128) {
        const int ch = tid, h = ch >> 5, d = ch & 31; const size_t un = (size_t)(b * 4 + h) * NCH + c;
        const float* cw = KIN(I_GLACONV) + (size_t)l * 4 * 512 + ch;
        const float q0 = cw[0], q1 = cw[512], q2 = cw[1024], q3 = cw[1536], k0 = cw[128], k1 = cw[640], k2w = cw[1152], k3 = cw[1664];
        const float* w2p = KIN(I_GLAW2) + (size_t)l * 16 * 128 + ch; float wc[16];
#pragma unroll
        for (int r = 0; r < 16; ++r) wc[r] = w2p[r * 128];
        const float gb = KIN(I_GLAB)[l * 128 + ch];
        float uq0 = 0.f, uq1 = 0.f, uq2 = 0.f, uk0 = 0.f, uk1 = 0.f, uk2 = 0.f;
        if (t0 > 0) { uq0 = bf2f(*(P - 3 * PINP + PC_GQ + ch)); uq1 = bf2f(*(P - 2 * PINP + PC_GQ + ch)); uq2 = bf2f(*(P - PINP + PC_GQ + ch));
                      uk0 = bf2f(*(P - 3 * PINP + PC_GK + ch)); uk1 = bf2f(*(P - 2 * PINP + PC_GK + ch)); uk2 = bf2f(*(P - PINP + PC_GK + ch)); }
        LAS bf16* KT = (LAS bf16*)(lds + H0 + h * HB); LAS float* BE = (LAS float*)(lds + H0 + h * HB + 6144);
        LAS bf16* QL = (LAS bf16*)(lds + H0 + h * HB + 6272) + d; LAS bf16* KL = (LAS bf16*)(lds + H0 + h * HB + 8320) + d;
        float bc = 0.f;
        unsigned short xqr[32], xkr[32];
#pragma unroll
        for (int t = 0; t < 32; ++t) { const bf16* row = P + (size_t)t * PINP; xqr[t] = row[PC_GQ + ch]; xkr[t] = row[PC_GK + ch]; }
#pragma unroll
        for (int t8 = 0; t8 < 4; ++t8) { u32x4 kp;
#pragma unroll
            for (int jj = 0; jj < 4; ++jj) { float kk2[2];
#pragma unroll
                for (int e = 0; e < 2; ++e) { const int t = t8 * 8 + jj * 2 + e; const float uq3 = bf2f(xqr[t]), uk3 = bf2f(xkr[t]);
                    const float q = silu_f(q0 * uq0 + q1 * uq1 + q2 * uq2 + q3 * uq3) * 0.17677669529663687f, k = silu_f(k0 * uk0 + k1 * uk1 + k2w * uk2 + k3 * uk3);
                    uq0 = uq1; uq1 = uq2; uq2 = uq3; uk0 = uk1; uk1 = uk2; uk2 = uk3;
                    float z = gb;
#pragma unroll
                    for (int r = 0; r < 16; ++r) z += GL[t * 16 + r] * wc[r];
                    bc = fmaxf(bc + (fminf(z, 0.f) - log1pexp_neg_abs(z)) * 0.0625f, -80.0f);
                    const float qt = q * fast_exp(bc), kt = k * fast_exp(-bc);
                    QL[t * 32] = (bf16)f2bf(qt); KL[t * 32] = (bf16)f2bf(kt); kk2[e] = kt; }
                kp[jj] = pk2(kk2[0], kk2[1]); }
            *(LAS u32x4*)(KT + d * 32 + t8 * 8) = kp; }
        const float ebend = fast_exp(bc); BE[d] = ebend; ((float*)(ws + WS_GBE))[un * 32 + d] = ebend;
    } else if (tid < 384) {
        const int cv = tid - 128, h = cv >> 6, vi = cv & 63; const size_t un = (size_t)(b * 4 + h) * NCH + c;
        const float* cw = KIN(I_GLACONV) + (size_t)l * 4 * 512 + 256 + cv;
        const float w0 = cw[0], w1 = cw[512], w2 = cw[1024], w3 = cw[1536];
        float u0 = 0.f, u1 = 0.f, u2 = 0.f;
        if (t0 > 0) { u0 = bf2f(*(P - 3 * PINP + PC_GV + cv)); u1 = bf2f(*(P - 2 * PINP + PC_GV + cv)); u2 = bf2f(*(P - PINP + PC_GV + cv)); }
        LAS bf16* VT = (LAS bf16*)(lds + H0 + h * HB + 2048); bf16* VTg = (bf16*)(ws + WS_GVT) + un * 2048 + vi * 32;
        unsigned short xvr[32];
#pragma unroll
        for (int t = 0; t < 32; ++t) xvr[t] = P[(size_t)t * PINP + PC_GV + cv];
#pragma unroll
        for (int t8 = 0; t8 < 4; ++t8) { u32x4 vp; float yv[8];
#pragma unroll
            for (int e = 0; e < 8; ++e) { const float u3 = bf2f(xvr[t8 * 8 + e]); yv[e] = silu_f(w0 * u0 + w1 * u1 + w2 * u2 + w3 * u3); u0 = u1; u1 = u2; u2 = u3; }
#pragma unroll
            for (int jj = 0; jj < 4; ++jj) vp[jj] = pk2(yv[2 * jj], yv[2 * jj + 1]);
            *(LAS u32x4*)(VT + vi * 32 + t8 * 8) = vp; *(u32x4*)(VTg + t8 * 8) = vp; }
    }
    lds_barrier();
    { const int h = wave >> 1, vt = wave & 1; const size_t un = (size_t)(b * 4 + h) * NCH + c;
      const LAS bf16* KT = (const LAS bf16*)(lds + H0 + h * HB); const LAS bf16* VT = (const LAS bf16*)(lds + H0 + h * HB + 2048); const LAS float* BE = (const LAS float*)(lds + H0 + h * HB + 6144);
      float* DSg = (float*)(ws + WS_GDS) + un * 2048;
      { const LAS bf16* srcL = (const LAS bf16*)(lds + H0 + h * HB + (vt == 0 ? 6272 : 8320)); u32x4* dstG = (u32x4*)((bf16*)(ws + (vt == 0 ? WS_GQ : WS_GK)) + un * 1024);
#pragma unroll
        for (int i = 0; i < 2; ++i) dstG[i * 64 + lane] = *(const LAS u32x4*)(srcL + (i * 64 + lane) * 8); }
      f32x16 acc;
#pragma unroll
      for (int i = 0; i < 16; ++i) acc[i] = 0.f;
#pragma unroll
      for (int s = 0; s < 2; ++s) { const bf16x8 A = *(const LAS bf16x8*)(VT + (32 * vt + r32) * 32 + 16 * s + 8 * hh), B = *(const LAS bf16x8*)(KT + r32 * 32 + 16 * s + 8 * hh);
          acc = __builtin_amdgcn_mfma_f32_32x32x16_bf16(A, B, acc, 0, 0, 0); }
      const float ebd = BE[r32];
#pragma unroll
      for (int r = 0; r < 16; ++r) DSg[(32 * vt + rho16(r, hh)) * 32 + r32] = acc[r] * ebd; }
    lds_barrier();
}
template <int DK>
__device__ __forceinline__ void m2_gh_elem2(int e2, const float* __restrict__ DS, const float* __restrict__ BE, bf16* __restrict__ SG) {
    constexpr int EPB = 64 * DK; const int e = e2 * 2, bh = e / EPB, idx = e % EPB, d = idx % DK; const size_t un0 = (size_t)bh * NCH;
    float S0 = 0.f, S1 = 0.f;
#pragma unroll 1
    for (int c0 = 0; c0 < NCH; c0 += 16) { f32x2 ds[16], be[16];
#pragma unroll
        for (int u = 0; u < 16; ++u) { ds[u] = *(const f32x2*)(DS + (un0 + c0 + u) * EPB + idx); be[u] = *(const f32x2*)(BE + (un0 + c0 + u) * DK + d); }
#pragma unroll
        for (int u = 0; u < 16; ++u) { *(unsigned*)(SG + (un0 + c0 + u) * EPB + idx) = pk2(S0, S1); S0 = S0 * be[u][0] + ds[u][0]; S1 = S1 * be[u][1] + ds[u][1]; } }
}
template <int DK>
__device__ __forceinline__ void m3_gh_task(int lane, const bf16* __restrict__ Qg, const bf16* __restrict__ Kg, const bf16* __restrict__ VTg, const bf16* __restrict__ Sg,
                                           const bf16* __restrict__ gate  , const float* __restrict__ ng  , bf16* __restrict__ orow  ) {
    const int r32 = lane & 31, hh = lane >> 5;
    bf16x8 qf[DK / 16];
    f32x16 at;
#pragma unroll
    for (int i = 0; i < 16; ++i) at[i] = 0.f;
#pragma unroll
    for (int s = 0; s < DK / 16; ++s) { qf[s] = *(const bf16x8*)(Qg + r32 * DK + 16 * s + 8 * hh); const bf16x8 kf = *(const bf16x8*)(Kg + r32 * DK + 16 * s + 8 * hh);
        at = __builtin_amdgcn_mfma_f32_32x32x16_bf16(kf, qf[s], at, 0, 0, 0); }
#pragma unroll
    for (int r = 0; r < 16; ++r) if (rho16(r, hh) > r32) at[r] = 0.f;
    f32x16 o[2];
#pragma unroll
    for (int vt = 0; vt < 2; ++vt)
#pragma unroll
        for (int i = 0; i < 16; ++i) o[vt][i] = 0.f;
#pragma unroll
    for (int s = 0; s < 2; ++s) { union { bf16x8 v; unsigned w[4]; } pf;
#pragma unroll
        for (int j = 0; j < 4; ++j) pf.w[j] = cvt_pk_bf16(at[8 * s + 2 * j], at[8 * s + 2 * j + 1]);
#pragma unroll
        for (int vt = 0; vt < 2; ++vt) { const bf16* vp = VTg + (32 * vt + r32) * 32 + 16 * s + 4 * hh;
            union { bf16x8 v; s16x4 h2[2]; } vf; vf.h2[0] = *(const s16x4*)vp; vf.h2[1] = *(const s16x4*)(vp + 8);
            o[vt] = __builtin_amdgcn_mfma_f32_32x32x16_bf16(vf.v, pf.v, o[vt], 0, 0, 0); } }
#pragma unroll
    for (int vt = 0; vt < 2; ++vt)
#pragma unroll
        for (int s = 0; s < DK / 16; ++s) { const bf16x8 sf = *(const bf16x8*)(Sg + (32 * vt + r32) * DK + 16 * s + 8 * hh);
            o[vt] = __builtin_amdgcn_mfma_f32_32x32x16_bf16(sf, qf[s], o[vt], 0, 0, 0); }
    float ss = 0.f;
#pragma unroll
    for (int vt = 0; vt < 2; ++vt)
#pragma unroll
        for (int i = 0; i < 16; ++i) ss += o[vt][i] * o[vt][i];
    ss += __shfl_xor(ss, 32);
    const float rstd = 1.0f / sqrtf(ss * (1.0f / 64.0f) + RMS_EPS);
    const bf16* grow = gate + (size_t)r32 * PINP; bf16* od = orow + (size_t)r32 * D;
#pragma unroll
    for (int vt = 0; vt < 2; ++vt)
#pragma unroll
        for (int g = 0; g < 4; ++g) { const int v0 = 32 * vt + 8 * g + 4 * hh; const u32x2 gw = *(const u32x2*)(grow + v0); const f32x4 n4 = *(const f32x4*)(ng + v0);
            const float y0 = o[vt][4 * g] * rstd * n4[0] * silu_f(bflo(gw.x)), y1 = o[vt][4 * g + 1] * rstd * n4[1] * silu_f(bfhi(gw.x));
            const float y2 = o[vt][4 * g + 2] * rstd * n4[2] * silu_f(bflo(gw.y)), y3 = o[vt][4 * g + 3] * rstd * n4[3] * silu_f(bfhi(gw.y));
            *(u32x2*)(od + v0) = (u32x2){pk2(y0, y1), pk2(y2, y3)}; }
}

constexpr int RWC_HEADB = 28928;
constexpr int RWC_AL = 4 * RWC_HEADB, RWC_LWL = RWC_AL + 32 * 264 * 2;
static_assert(RWC_LWL + 32 * 264 * 2 <= LDSCTL_OFF, "rw_fused_unit LDS");
__device__ __forceinline__ void rw_fused_unit(LAS unsigned char* lds, int l, int b, int c) {
    const int tid = opaque_tid(), lane = tid & 63, wave = __builtin_amdgcn_readfirstlane(tid >> 6), h = wave >> 1, p = wave & 1, r32 = lane & 31, hh = lane >> 5;
    unsigned char* ws = KWS();
    const int bh = b * 4 + h; const size_t un = (size_t)bh * NCH + c;
    const int t0 = c * 32;
    const bf16* P = (const bf16*)(ws + WS_P) + ((size_t)b * T + t0) * PINP + PC_RW;
    const float* mu = KIN(I_RWMU) + (size_t)l * 1024;
    LAS bf16* XL = (LAS bf16*)lds;
    LAS bf16* AL = (LAS bf16*)(lds + RWC_AL);
    LAS bf16* LWL = (LAS bf16*)(lds + RWC_LWL);
    { const int cc = tid & 255, tp = tid >> 8; const float mc = mu[768 + cc];
      unsigned short xr[17];
#pragma unroll
      for (int j = 0; j < 17; ++j) { const int tk = tp * 16 + j - 1; xr[j] = (t0 + tk >= 0) ? P[(long)tk * PINP + 768 + cc] : (unsigned short)0; }
#pragma unroll
      for (int j = 0; j < 16; ++j) { const float cur = bf2f(xr[j + 1]), prev = bf2f(xr[j]);
          float x = cur + (prev - cur) * mc;
          if (cc < 64) x = tanh_f(x); else if (cc >= 128) x = fast_sigmoid(x);
          XL[(tp * 16 + j) * 264 + cc] = (bf16)f2bf(x); } }
    lds_barrier();
    {
        const int ch = wave * 32 + r32;
        const bf16* w2T = (const bf16*)(ws + WS_LORA) + (size_t)l * 256 * 64 + (size_t)ch * 64;
        const bf16* a2T = (const bf16*)(ws + WS_LORA) + (size_t)(NL * 256 * 64) + (size_t)l * 256 * 64 + (size_t)ch * 64;
        const bf16* g2T = (const bf16*)(ws + WS_LORA) + (size_t)2 * (NL * 256 * 64) + (size_t)l * 256 * 128 + (size_t)ch * 128;
        const LAS bf16* xa = XL + r32 * 264 + 8 * hh;
        {
            f32x16 acc;
#pragma unroll
            for (int i = 0; i < 16; ++i) acc[i] = 0.f;
#pragma unroll
            for (int s = 0; s < 4; ++s) { const bf16x8 A = *(const LAS bf16x8*)(xa + 16 * s); const bf16x8 Bw = *(const bf16x8*)(w2T + 16 * s + 8 * hh);
                acc = __builtin_amdgcn_mfma_f32_32x32x16_bf16(A, Bw, acc, 0, 0, 0); }
            const float w0c = KIN(I_RWW0)[l * 256 + ch];
#pragma unroll
            for (int r = 0; r < 16; ++r) { const int tok = rho16(r, hh);
                const float zw = w0c + acc[r]; const float wlog = -(fmaxf(-zw, 0.f) + log1pexp_neg_abs(zw)) - 0.5f;
                LWL[tok * 264 + ch] = (bf16)f2bf(-fast_exp(wlog)); }
        }
        __builtin_amdgcn_sched_barrier(0);
        {
            f32x16 acc;
#pragma unroll
            for (int i = 0; i < 16; ++i) acc[i] = 0.f;
#pragma unroll
            for (int s = 0; s < 4; ++s) { const bf16x8 A = *(const LAS bf16x8*)(xa + 64 + 16 * s); const bf16x8 Bw = *(const bf16x8*)(a2T + 16 * s + 8 * hh);
                acc = __builtin_amdgcn_mfma_f32_32x32x16_bf16(A, Bw, acc, 0, 0, 0); }
            const float a0c = KIN(I_RWA0)[l * 256 + ch];
#pragma unroll
            for (int r = 0; r < 16; ++r) AL[rho16(r, hh) * 264 + ch] = (bf16)f2bf(fast_sigmoid(a0c + acc[r]));
        }
        __builtin_amdgcn_sched_barrier(0);
        {
            f32x16 acc;
#pragma unroll
            for (int i = 0; i < 16; ++i) acc[i] = 0.f;
#pragma unroll
            for (int s = 0; s < 8; ++s) { const bf16x8 A = *(const LAS bf16x8*)(xa + 128 + 16 * s); const bf16x8 Bw = *(const bf16x8*)(g2T + 16 * s + 8 * hh);
                acc = __builtin_amdgcn_mfma_f32_32x32x16_bf16(A, Bw, acc, 0, 0, 0); }
            bf16* gb = (bf16*)(ws + WS_GBUF) + ((size_t)b * T + t0) * 256 + ch;
#pragma unroll
            for (int r = 0; r < 16; ++r) gb[(size_t)rho16(r, hh) * 256] = (bf16)f2bf(acc[r]);
        }
    }
    lds_barrier();
    LAS unsigned char* L = lds + h * RWC_HEADB;
    LAS bf16* AT = (LAS bf16*)L;
    LAS bf16* BT = (LAS bf16*)(L + 4096);
    LAS bf16* KT = (LAS bf16*)(L + 8192);
    LAS bf16* ATT = (LAS bf16*)(L + 12288);
    LAS bf16* BHT = (LAS bf16*)(L + 16384);
    LAS bf16* KHT = (LAS bf16*)(L + 20480);
    LAS bf16* VT = (LAS bf16*)(L + 24576);
    LAS float* GC = (LAS float*)(L + 28672);
    LAS float* MAB = (LAS float*)(L + 4096);
    LAS bf16* MAK = (LAS bf16*)(L + 8192);
    LAS bf16* TM = (LAS bf16*)L;
    if (wave < 4) {
        const int hs = wave, d = lane, ch = hs * 64 + d; const size_t uns = (size_t)(b * 4 + hs) * NCH + c;
        LAS unsigned char* Ls = lds + hs * RWC_HEADB;
        LAS bf16* sAT = (LAS bf16*)Ls; LAS bf16* sBT = (LAS bf16*)(Ls + 4096); LAS bf16* sKT = (LAS bf16*)(Ls + 8192);
        LAS bf16* sATT = (LAS bf16*)(Ls + 12288); LAS bf16* sBHT = (LAS bf16*)(Ls + 16384); LAS bf16* sKHT = (LAS bf16*)(Ls + 20480); LAS float* sGC = (LAS float*)(Ls + 28672);
        const float mr = mu[ch], mk = mu[256 + ch];
        const float kkc = KIN(I_RWKK)[l * 256 + ch], kac = KIN(I_RWKA)[l * 256 + ch], rkc = KIN(I_RWRK)[l * 256 + ch];
        float lgend = 0.f;
#pragma unroll 8
        for (int t = 0; t < 32; ++t) lgend += bf2f(LWL[t * 264 + ch]);
        float* bonp = (float*)(ws + WS_BONUS) + ((size_t)b * T + t0) * 4 + hs;
        float lg = 0.f;
        float rprev = 0.f, kprev = 0.f;
        if (t0 > 0) { rprev = bf2f(*(P - PINP + ch)); kprev = bf2f(*(P - PINP + 256 + ch)); }
        unsigned short xrr[32], xkr[32];
#pragma unroll
        for (int t = 0; t < 32; ++t) { const bf16* row = P + (size_t)t * PINP; xrr[t] = row[ch]; xkr[t] = row[256 + ch]; }
#pragma unroll 1
        for (int t8 = 0; t8 < 4; ++t8) { u32x4 ap, bp, kp; float xr[8], xk[8];
#pragma unroll
            for (int e = 0; e < 8; ++e) { xr[e] = bf2f(t8 == 0 ? xrr[e] : t8 == 1 ? xrr[8 + e] : t8 == 2 ? xrr[16 + e] : xrr[24 + e]); xk[e] = bf2f(t8 == 0 ? xkr[e] : t8 == 1 ? xkr[8 + e] : t8 == 2 ? xkr[16 + e] : xkr[24 + e]); }
#pragma unroll
            for (int jj = 0; jj < 4; ++jj) { float at2[2], bh2[2], kh2[2];
#pragma unroll
                for (int e = 0; e < 2; ++e) { const int t = t8 * 8 + jj * 2 + e;
                    const float rc = xr[jj * 2 + e], kc = xk[jj * 2 + e];
                    const float r = rc + (rprev - rc) * mr, k = kc + (kprev - kc) * mk; rprev = rc; kprev = kc;
                    const float av = bf2f(AL[t * 264 + ch]), lw = bf2f(LWL[t * 264 + ch]);
                    const float kkr = k * kkc, hk = k * (1.0f + (av - 1.0f) * kac);
                    const float ss = wave_sum(kkr * kkr); const float kk = kkr / fmaxf(sqrtf(ss), 1e-12f);
                    const float bon = wave_sum(r * hk * rkc);
                    const float aa = -kk, bb = kk * av;
                    const float lgp = lg; lg += lw;
                    const float at = aa * fast_exp(lgp), rt = r * fast_exp(lg), ei = fast_exp(-lg), bt = bb * ei, kt = hk * ei, eh = fast_exp(lgend - lg);
                    sAT[t * 64 + d] = (bf16)f2bf(at); sBT[t * 64 + d] = (bf16)f2bf(bt); sKT[t * 64 + d] = (bf16)f2bf(kt);
                    LWL[t * 264 + ch] = (bf16)f2bf(rt);
                    if (d == 0) bonp[t * 4] = bon;
                    at2[e] = at; bh2[e] = bb * eh; kh2[e] = hk * eh; }
                ap[jj] = pk2(at2[0], at2[1]); bp[jj] = pk2(bh2[0], bh2[1]); kp[jj] = pk2(kh2[0], kh2[1]); }
            *(LAS u32x4*)(sATT + d * 32 + t8 * 8) = ap; *(LAS u32x4*)(sBHT + d * 32 + t8 * 8) = bp; *(LAS u32x4*)(sKHT + d * 32 + t8 * 8) = kp; }
        sGC[d] = fast_exp(lgend);
    } else {
        const int cv = tid - 256, hs = cv >> 6, vi = cv & 63; const size_t uns = (size_t)(b * 4 + hs) * NCH + c;
        LAS bf16* sVT = (LAS bf16*)(lds + hs * RWC_HEADB + 24576);
        bf16* VTg = (bf16*)(ws + WS_RVT) + uns * 2048 + vi * 32; bf16* VGp = (bf16*)(ws + WS_RVG) + uns * 2048 + vi;
        const float mv = mu[512 + cv];
        float vprev = 0.f; if (t0 > 0) vprev = bf2f(*(P - PINP + 512 + cv));
        unsigned short xvr[32];
#pragma unroll
        for (int t = 0; t < 32; ++t) xvr[t] = P[(size_t)t * PINP + 512 + cv];
#pragma unroll
        for (int t8 = 0; t8 < 4; ++t8) { u32x4 vp; float yv[8];
#pragma unroll
            for (int e = 0; e < 8; ++e) { const float xv = bf2f(xvr[t8 * 8 + e]); yv[e] = xv + (vprev - xv) * mv; vprev = xv; VGp[(t8 * 8 + e) * 64] = (bf16)f2bf(yv[e]); }
#pragma unroll
            for (int jj = 0; jj < 4; ++jj) vp[jj] = pk2(yv[2 * jj], yv[2 * jj + 1]);
            *(LAS u32x4*)(sVT + vi * 32 + t8 * 8) = vp; *(u32x4*)(VTg + t8 * 8) = vp; }
    }
    lds_barrier();
    {
        const LAS bf16* srcL = p == 0 ? BT : KT; u32x4* dstG = (u32x4*)((bf16*)(ws + (p == 0 ? WS_RB : WS_RK)) + un * 2048);
#pragma unroll
        for (int i = 0; i < 4; ++i) dstG[i * 64 + lane] = *(const LAS u32x4*)(srcL + (i * 64 + lane) * 8);
        u32x4* dstR = (u32x4*)((bf16*)(ws + WS_RR) + un * 2048);
#pragma unroll
        for (int i = 0; i < 2; ++i) { const int q = (p * 2 + i) * 64 + lane, t = q >> 3, c8 = q & 7;
            dstR[q] = *(const LAS u32x4*)(LWL + t * 264 + h * 64 + c8 * 8); }
    }
    f32x16 accR[2];
    {
        f32x16 acc;
#pragma unroll
        for (int i = 0; i < 16; ++i) acc[i] = 0.f;
        const LAS bf16* Bsrc = p == 0 ? BT : KT;
#pragma unroll
        for (int s = 0; s < 4; ++s) { const bf16x8 A = *(const LAS bf16x8*)(AT + r32 * 64 + 16 * s + 8 * hh), B = *(const LAS bf16x8*)(Bsrc + r32 * 64 + 16 * s + 8 * hh);
            acc = __builtin_amdgcn_mfma_f32_32x32x16_bf16(A, B, acc, 0, 0, 0); }
        if (p == 0) {
#pragma unroll
            for (int r = 0; r < 16; ++r) { const int t = rho16(r, hh); MAB[t * 32 + r32] = (r32 < t) ? acc[r] : 0.f; }
        } else {
#pragma unroll
            for (int r = 0; r < 16; ++r) { const int t = rho16(r, hh); MAK[t * 32 + r32] = (bf16)f2bf((r32 < t) ? acc[r] : 0.f); }
        }
    }
    lds_barrier();
    if (p == 0) {
        const int cidx = r32; float tc[32];
#pragma unroll
        for (int t = 0; t < 32; ++t) { float acc0 = (t == cidx) ? 1.0f : 0.f, acc1 = 0.f;
#pragma unroll
            for (int s4 = 0; s4 < (t + 3) / 4; ++s4) { const f32x4 m4 = *(const LAS f32x4*)(MAB + t * 32 + 4 * s4);
#pragma unroll
                for (int e = 0; e < 4; ++e) { const int s = 4 * s4 + e; if (s < t) { if (e & 1) acc1 = fmaf(m4[e], tc[s], acc1); else acc0 = fmaf(m4[e], tc[s], acc0); } } }
            tc[t] = acc0 + acc1; }
#pragma unroll
        for (int t = 0; t < 32; ++t) if (hh == 0) TM[t * 32 + cidx] = (bf16)f2bf(tc[t]);
    } else {
#pragma unroll
        for (int vt = 0; vt < 2; ++vt) {
#pragma unroll
            for (int i = 0; i < 16; ++i) accR[vt][i] = 0.f;
#pragma unroll
            for (int s = 0; s < 2; ++s) { const bf16x8 A = *(const LAS bf16x8*)(MAK + r32 * 32 + 16 * s + 8 * hh), B = *(const LAS bf16x8*)(VT + (32 * vt + r32) * 32 + 16 * s + 8 * hh);
                accR[vt] = __builtin_amdgcn_mfma_f32_32x32x16_bf16(A, B, accR[vt], 0, 0, 0); } }
    }
    lds_barrier();
    if (p == 0) {
        f32x16 accW[2];
#pragma unroll
        for (int dt = 0; dt < 2; ++dt) {
#pragma unroll
            for (int i = 0; i < 16; ++i) accW[dt][i] = 0.f;
#pragma unroll
            for (int s = 0; s < 2; ++s) { const bf16x8 A = *(const LAS bf16x8*)(TM + r32 * 32 + 16 * s + 8 * hh), B = *(const LAS bf16x8*)(ATT + (32 * dt + r32) * 32 + 16 * s + 8 * hh);
                accW[dt] = __builtin_amdgcn_mfma_f32_32x32x16_bf16(A, B, accW[dt], 0, 0, 0); } }
        { LAS bf16* WL = ATT;
#pragma unroll
          for (int dt = 0; dt < 2; ++dt)
#pragma unroll
              for (int r = 0; r < 16; ++r) WL[rho16(r, hh) * 64 + 32 * dt + r32] = (bf16)f2bf(accW[dt][r]);
          u32x4* WGp = (u32x4*)((bf16*)(ws + WS_RW) + un * 2048);
#pragma unroll
          for (int i = 0; i < 4; ++i) WGp[i * 64 + lane] = *(const LAS u32x4*)(WL + (i * 64 + lane) * 8); }
        LAS bf16* PL = (LAS bf16*)(L + 4096);
        const int xs = r32 >> 4, xx = r32 & 15, hhA = (xx >> 2) & 1, jA = 4 * (xx >> 3) + (xx & 3);
#pragma unroll
        for (int dt = 0; dt < 2; ++dt)
#pragma unroll
            for (int dt2 = 0; dt2 < 2; ++dt2) { f32x16 acc;
#pragma unroll
                for (int i = 0; i < 16; ++i) acc[i] = 0.f;
#pragma unroll
                for (int s = 0; s < 2; ++s) { const LAS bf16* bp = BHT + (32 * dt + r32) * 32 + 16 * s + 4 * hh;
                    union { bf16x8 v; s16x4 h2[2]; } af; af.h2[0] = *(const LAS s16x4*)bp; af.h2[1] = *(const LAS s16x4*)(bp + 8);
                    union { bf16x8 v; unsigned w[4]; } bf;
#pragma unroll
                    for (int j = 0; j < 4; ++j) bf.w[j] = cvt_pk_bf16(accW[dt2][8 * s + 2 * j], accW[dt2][8 * s + 2 * j + 1]);
                    acc = __builtin_amdgcn_mfma_f32_32x32x16_bf16(af.v, bf.v, acc, 0, 0, 0); }
                if (dt == dt2) { const float gc = GC[32 * dt + r32];
#pragma unroll
                    for (int r = 0; r < 16; ++r) if (rho16(r, hh) == r32) acc[r] += gc; }
                LAS bf16* pf = PL + (((dt * 2 + dt2) * 2 + xs) * 64 + 32 * hhA) * 8 + jA;
#pragma unroll
                for (int r = 0; r < 16; ++r) pf[rho16(r, hh) * 8] = (bf16)f2bf(acc[r]); }
        { u32x4* PFp = (u32x4*)((bf16*)(ws + WS_RP) + un * 4096);
#pragma unroll
          for (int f = 0; f < 8; ++f) PFp[f * 64 + lane] = *(const LAS u32x4*)(PL + (f * 64 + lane) * 8); }
    } else {
        f32x16 accU[2];
#pragma unroll
        for (int vt = 0; vt < 2; ++vt) {
#pragma unroll
            for (int i = 0; i < 16; ++i) accU[vt][i] = 0.f;
#pragma unroll
            for (int s = 0; s < 2; ++s) { const LAS bf16* tp = TM + r32 * 32 + 16 * s + 4 * hh;
                union { bf16x8 v; s16x4 h2[2]; } af; af.h2[0] = *(const LAS s16x4*)tp; af.h2[1] = *(const LAS s16x4*)(tp + 8);
                union { bf16x8 v; unsigned w[4]; } bf;
#pragma unroll
                for (int j = 0; j < 4; ++j) bf.w[j] = cvt_pk_bf16(accR[vt][8 * s + 2 * j], accR[vt][8 * s + 2 * j + 1]);
                accU[vt] = __builtin_amdgcn_mfma_f32_32x32x16_bf16(af.v, bf.v, accU[vt], 0, 0, 0); } }
        float* UGp = (float*)(ws + WS_RU) + un * 2048;
#pragma unroll
        for (int vt = 0; vt < 2; ++vt)
#pragma unroll
            for (int g = 0; g < 4; ++g) *(f32x4*)(UGp + ((vt * 4 + g) * 64 + lane) * 4) = (f32x4){accU[vt][4 * g], accU[vt][4 * g + 1], accU[vt][4 * g + 2], accU[vt][4 * g + 3]};
        float* QFp = (float*)(ws + WS_RQ) + un * 4096;
#pragma unroll
        for (int vt = 0; vt < 2; ++vt)
#pragma unroll
            for (int dt = 0; dt < 2; ++dt) { f32x16 acc;
#pragma unroll
                for (int i = 0; i < 16; ++i) acc[i] = 0.f;
#pragma unroll
                for (int s = 0; s < 2; ++s) { const LAS bf16* bp = BHT + (32 * dt + r32) * 32 + 16 * s + 4 * hh;
                    union { bf16x8 v; s16x4 h2[2]; } af; af.h2[0] = *(const LAS s16x4*)bp; af.h2[1] = *(const LAS s16x4*)(bp + 8);
                    union { bf16x8 v; unsigned w[4]; } bf;
#pragma unroll
                    for (int j = 0; j < 4; ++j) bf.w[j] = cvt_pk_bf16(accU[vt][8 * s + 2 * j], accU[vt][8 * s + 2 * j + 1]);
                    acc = __builtin_amdgcn_mfma_f32_32x32x16_bf16(af.v, bf.v, acc, 0, 0, 0);
                    const bf16x8 A2 = *(const LAS bf16x8*)(KHT + (32 * dt + r32) * 32 + 16 * s + 8 * hh), B2 = *(const LAS bf16x8*)(VT + (32 * vt + r32) * 32 + 16 * s + 8 * hh);
                    acc = __builtin_amdgcn_mfma_f32_32x32x16_bf16(A2, B2, acc, 0, 0, 0); }
#pragma unroll
                for (int g = 0; g < 4; ++g) *(f32x4*)(QFp + (((vt * 2 + dt) * 4 + g) * 64 + lane) * 4) = (f32x4){acc[4 * g], acc[4 * g + 1], acc[4 * g + 2], acc[4 * g + 3]}; }
    }
    lds_barrier();
}
__device__ __forceinline__ void rw_m2_wave(LAS unsigned char* ring, int lane, int bh, int vt) {
    unsigned char* ws = KWS();
    const char* PF = (const char*)((const bf16*)(ws + WS_RP) + (size_t)bh * NCH * 4096) + lane * 16;
    const char* QF = (const char*)((const float*)(ws + WS_RQ) + (size_t)bh * NCH * 4096 + (size_t)vt * 2048) + lane * 16;
    bf16* SG = (bf16*)(ws + WS_RS) + (size_t)bh * NCH * 4096 + (size_t)vt * 2048 + lane * 8;
    f32x16 S[2];
#pragma unroll
    for (int dt = 0; dt < 2; ++dt)
#pragma unroll
        for (int i = 0; i < 16; ++i) S[dt][i] = 0.f;
#define RWM2_DMA(c_) do { const int _c = (c_) < NCH ? (c_) : NCH - 1; LAS unsigned char* _sl = ring + ((c_) & 3) * 16384; \
        _Pragma("unroll") for (int f = 0; f < 8; ++f) { \
            __builtin_amdgcn_global_load_lds((const unsigned*)(PF + (size_t)_c * 8192 + f * 1024), (LAS unsigned*)(_sl + f * 1024), 16, 0, 0); \
            __builtin_amdgcn_global_load_lds((const unsigned*)(QF + (size_t)_c * 16384 + f * 1024), (LAS unsigned*)(_sl + 8192 + f * 1024), 16, 0, 0); } } while (0)
    RWM2_DMA(0); RWM2_DMA(1); RWM2_DMA(2);
#pragma unroll 1
    for (int c = 0; c < NCH; ++c) {
        asm volatile("s_waitcnt vmcnt(32)" ::: "memory");
        const LAS unsigned char* sl = ring + (c & 3) * 16384 + lane * 16;
        bf16x8 pf[8]; f32x4 qv[8];
#pragma unroll
        for (int f = 0; f < 8; ++f) { pf[f] = *(const LAS bf16x8*)(sl + f * 1024); qv[f] = *(const LAS f32x4*)(sl + 8192 + f * 1024); }
        union { bf16x8 v; unsigned w[4]; } sb[2][2];
#pragma unroll
        for (int dt2 = 0; dt2 < 2; ++dt2)
#pragma unroll
            for (int s = 0; s < 2; ++s) {
#pragma unroll
                for (int j = 0; j < 4; ++j) sb[dt2][s].w[j] = cvt_pk_bf16(S[dt2][8 * s + 2 * j], S[dt2][8 * s + 2 * j + 1]);
                *(bf16x8*)(SG + (size_t)c * 4096 + (dt2 * 2 + s) * 512) = sb[dt2][s].v; }
        f32x16 N[2];
#pragma unroll
        for (int dt = 0; dt < 2; ++dt) {
#pragma unroll
            for (int g = 0; g < 4; ++g) { N[dt][4 * g] = qv[dt * 4 + g][0]; N[dt][4 * g + 1] = qv[dt * 4 + g][1]; N[dt][4 * g + 2] = qv[dt * 4 + g][2]; N[dt][4 * g + 3] = qv[dt * 4 + g][3]; }
#pragma unroll
            for (int dt2 = 0; dt2 < 2; ++dt2)
#pragma unroll
                for (int s = 0; s < 2; ++s) N[dt] = __builtin_amdgcn_mfma_f32_32x32x16_bf16(pf[(dt * 2 + dt2) * 2 + s], sb[dt2][s].v, N[dt], 0, 0, 0); }
        S[0] = N[0]; S[1] = N[1];
        asm volatile("s_waitcnt lgkmcnt(0)" ::: "memory");
        RWM2_DMA(c + 3);
    }
    asm volatile("s_waitcnt vmcnt(0)" ::: "memory");
#undef RWM2_DMA
}
__device__ __forceinline__ bf16x8 ld_perm8(const bf16* p) { union { bf16x8 v; s16x4 h2[2]; } f; f.h2[0] = *(const s16x4*)p; f.h2[1] = *(const s16x4*)(p + 8); return f.v; }
__device__ __forceinline__ void rw_m3_task(int lane, int l, int bh, int c) {
    unsigned char* ws = KWS();
    const int r32 = lane & 31, hh = lane >> 5, b = bh >> 2, h = bh & 3; const size_t un = (size_t)bh * NCH + c; const size_t tok0 = (size_t)b * T + c * 32;
    const bf16* RGp = (const bf16*)(ws + WS_RR) + un * 2048 + r32 * 64 + 4 * hh; const bf16* BGp = (const bf16*)(ws + WS_RB) + un * 2048 + r32 * 64 + 4 * hh;
    const bf16* KGp = (const bf16*)(ws + WS_RK) + un * 2048 + r32 * 64 + 4 * hh; const bf16* WGp = (const bf16*)(ws + WS_RW) + un * 2048 + r32 * 64 + 4 * hh;
    const bf16* SGp = (const bf16*)(ws + WS_RS) + un * 4096 + lane * 8; const bf16* VTp = (const bf16*)(ws + WS_RVT) + un * 2048 + r32 * 32 + 4 * hh;
    const float* UGp = (const float*)(ws + WS_RU) + un * 2048 + lane * 4;
    f32x16 U[2], Y[2], mb, mk;
#pragma unroll
    for (int vt = 0; vt < 2; ++vt)
#pragma unroll
        for (int g = 0; g < 4; ++g) { const f32x4 u4 = *(const f32x4*)(UGp + (vt * 4 + g) * 256); U[vt][4 * g] = u4[0]; U[vt][4 * g + 1] = u4[1]; U[vt][4 * g + 2] = u4[2]; U[vt][4 * g + 3] = u4[3]; }
#pragma unroll
    for (int i = 0; i < 16; ++i) { mb[i] = 0.f; mk[i] = 0.f; Y[0][i] = 0.f; Y[1][i] = 0.f; }
#pragma unroll
    for (int ks = 0; ks < 4; ++ks) {
        const bf16x8 rf = ld_perm8(RGp + 16 * ks), wf = ld_perm8(WGp + 16 * ks), bfr = ld_perm8(BGp + 16 * ks), kfr = ld_perm8(KGp + 16 * ks);
        const bf16x8 s0 = *(const bf16x8*)(SGp + ks * 512), s1 = *(const bf16x8*)(SGp + 2048 + ks * 512);
        U[0] = __builtin_amdgcn_mfma_f32_32x32x16_bf16(wf, s0, U[0], 0, 0, 0); U[1] = __builtin_amdgcn_mfma_f32_32x32x16_bf16(wf, s1, U[1], 0, 0, 0);
        mb = __builtin_amdgcn_mfma_f32_32x32x16_bf16(bfr, rf, mb, 0, 0, 0); mk = __builtin_amdgcn_mfma_f32_32x32x16_bf16(kfr, rf, mk, 0, 0, 0);
        Y[0] = __builtin_amdgcn_mfma_f32_32x32x16_bf16(s0, rf, Y[0], 0, 0, 0); Y[1] = __builtin_amdgcn_mfma_f32_32x32x16_bf16(s1, rf, Y[1], 0, 0, 0); }
#pragma unroll
    for (int r = 0; r < 16; ++r) if (rho16(r, hh) > r32) { mb[r] = 0.f; mk[r] = 0.f; }
#pragma unroll
    for (int s = 0; s < 2; ++s) { union { bf16x8 v; unsigned w[4]; } fb, fk;
#pragma unroll
        for (int j = 0; j < 4; ++j) { fb.w[j] = cvt_pk_bf16(mb[8 * s + 2 * j], mb[8 * s + 2 * j + 1]); fk.w[j] = cvt_pk_bf16(mk[8 * s + 2 * j], mk[8 * s + 2 * j + 1]); }
#pragma unroll
        for (int vt = 0; vt < 2; ++vt) { union { bf16x8 v; unsigned w[4]; } fu;
#pragma unroll
            for (int j = 0; j < 4; ++j) fu.w[j] = cvt_pk_bf16(U[vt][8 * s + 2 * j], U[vt][8 * s + 2 * j + 1]);
            Y[vt] = __builtin_amdgcn_mfma_f32_32x32x16_bf16(fu.v, fb.v, Y[vt], 0, 0, 0);
            const bf16* vp = VTp + (size_t)vt * 32 * 32 + 16 * s;
            union { bf16x8 v; s16x4 h2[2]; } vf; vf.h2[0] = *(const s16x4*)vp; vf.h2[1] = *(const s16x4*)(vp + 8);
            Y[vt] = __builtin_amdgcn_mfma_f32_32x32x16_bf16(vf.v, fk.v, Y[vt], 0, 0, 0); } }
    float sm = 0.f;
#pragma unroll
    for (int vt = 0; vt < 2; ++vt)
#pragma unroll
        for (int i = 0; i < 16; ++i) sm += Y[vt][i];
    sm += __shfl_xor(sm, 32); const float mu = sm * (1.0f / 64.0f);
    float q = 0.f;
#pragma unroll
    for (int vt = 0; vt < 2; ++vt)
#pragma unroll
        for (int i = 0; i < 16; ++i) { const float dd = Y[vt][i] - mu; q += dd * dd; }
    q += __shfl_xor(q, 32); const float rstd = 1.0f / sqrtf(q * (1.0f / 64.0f) + RW_LN_EPS);
    const size_t tok = tok0 + r32;
    const float bon = ((const float*)(ws + WS_BONUS))[tok * 4 + h];
    const bf16* vrec = (const bf16*)(ws + WS_RVG) + un * 2048 + r32 * 64;
    const bf16* gp = (const bf16*)(ws + WS_GBUF) + tok * 256 + h * 64; bf16* od = (bf16*)(ws + WS_O) + tok * D + 512 + h * 64;
    const float* lnw = KIN(I_RWLNW) + l * 256 + h * 64; const float* lnb = KIN(I_RWLNB) + l * 256 + h * 64;
#pragma unroll
    for (int vt = 0; vt < 2; ++vt)
#pragma unroll
        for (int g = 0; g < 4; ++g) { const int v0 = 32 * vt + 8 * g + 4 * hh; const f32x4 w4 = *(const f32x4*)(lnw + v0), b4 = *(const f32x4*)(lnb + v0); const u32x2 vw = *(const u32x2*)(vrec + v0); const f32x4 vv = {bflo(vw.x), bfhi(vw.x), bflo(vw.y), bfhi(vw.y)}; const u32x2 gw = *(const u32x2*)(gp + v0);
            const float y0 = ((Y[vt][4 * g] - mu) * rstd * w4[0] + b4[0] + bon * vv[0]) * bflo(gw.x), y1 = ((Y[vt][4 * g + 1] - mu) * rstd * w4[1] + b4[1] + bon * vv[1]) * bfhi(gw.x);
            const float y2 = ((Y[vt][4 * g + 2] - mu) * rstd * w4[2] + b4[2] + bon * vv[2]) * bflo(gw.y), y3 = ((Y[vt][4 * g + 3] - mu) * rstd * w4[3] + b4[3] + bon * vv[3]) * bfhi(gw.y);
            *(u32x2*)(od + v0) = (u32x2){pk2(y0, y1), pk2(y2, y3)}; }
}

__device__ __forceinline__ void c1_phase(LAS unsigned char* lds, int l, int vcu, int G) {
    for (int u = vcu; u < NB * NCH; u += G) { const int b = u >> 8, c = u & 255;
        for (int q = 0; q <= PHREP(16); ++q) rw_fused_unit(lds, l, b, c);
        for (int q = 0; q <= PHREP(17); ++q) hg_fused_unit(lds, l, b, c);
        for (int q = 0; q <= PHREP(18); ++q) gla_fused_unit(lds, l, b, c); }
}
__device__ __forceinline__ void m3_gh_phase(int l, int vcu, int G) {
    const int tid = opaque_tid(), lane = tid & 63, wave = __builtin_amdgcn_readfirstlane(tid >> 6);
    unsigned char* ws = KWS();
    const int gw = vcu * NWAVES + wave, NGW = G * NWAVES;
    const bf16* P = (const bf16*)(ws + WS_P); bf16* O = (bf16*)(ws + WS_O);
    const float* gng = KIN(I_GLANG) + l * 256; const float* hng = KIN(I_HGNG) + l * 256;
    for (int task = gw; task < 24576; task += NGW) {
        const int un = task & 8191, bh = un >> 8, c = un & 255, b = bh >> 2, h = bh & 3; const size_t tok0 = (size_t)b * T + c * 32;
        if (task >= 16384) { rw_m3_task(lane, l, bh, c); continue; }
        if (task < 8192) m3_gh_task<64>(lane, (const bf16*)(ws + WS_HQ) + (size_t)un * 2048, (const bf16*)(ws + WS_HK) + (size_t)un * 2048, (const bf16*)(ws + WS_HVT) + (size_t)un * 2048, (const bf16*)(ws + WS_HS) + (size_t)un * 4096,
                                         P + tok0 * PINP + PC_HG + h * 64, hng + h * 64, O + tok0 * D + 256 + h * 64);
        else m3_gh_task<32>(lane, (const bf16*)(ws + WS_GQ) + (size_t)un * 1024, (const bf16*)(ws + WS_GK) + (size_t)un * 1024, (const bf16*)(ws + WS_GVT) + (size_t)un * 2048, (const bf16*)(ws + WS_GS) + (size_t)un * 2048,
                            P + tok0 * PINP + PC_GOUT + h * 64, gng + h * 64, O + tok0 * D + h * 64);
    }
}

__device__ __forceinline__ void xattn_units(LAS unsigned char* lds, int l, int first, int last, int stride) {
    const int tid = opaque_tid(), lane = tid & 63, wave = __builtin_amdgcn_readfirstlane(tid >> 6), r32 = lane & 31, hh = lane >> 5;
    const bf16* P = (const bf16*)(KWS() + WS_P); const bf16* MKV = (const bf16*)(KWS() + WS_MKV); bf16* O = (bf16*)(KWS() + WS_O);
    LAS bf16* KL = (LAS bf16*)lds;
    LAS bf16* VT = (LAS bf16*)(lds + 256 * 72 * 2);
    int cur_bh = -1;
    for (int u = first; u < last; u += stride) {
        const int bh = u >> 5, qb = u & 31, b = bh >> 2, h = bh & 3;
        if (bh != cur_bh) {
            lds_barrier();
            for (int i = tid; i < 256 * 8; i += NTHR) { const int key = i >> 3, c8 = i & 7;
                const bf16* src = MKV + (size_t)(b * 256 + key) * 2048 + l * 512 + h * 64 + c8 * 8;
                *(LAS u32x4*)(KL + key * 72 + c8 * 8) = *(const u32x4*)src;
                const u32x4 vv = *(const u32x4*)(src + 256);
                LAS bf16* vd = VT + (c8 * 8) * 264 + key;
                vd[0 * 264] = (bf16)(vv.x & 0xffff); vd[1 * 264] = (bf16)(vv.x >> 16); vd[2 * 264] = (bf16)(vv.y & 0xffff); vd[3 * 264] = (bf16)(vv.y >> 16);
                vd[4 * 264] = (bf16)(vv.z & 0xffff); vd[5 * 264] = (bf16)(vv.z >> 16); vd[6 * 264] = (bf16)(vv.w & 0xffff); vd[7 * 264] = (bf16)(vv.w >> 16); }
            lds_barrier();
            cur_bh = bh;
        }
        const int q = b * T + qb * 256 + wave * 32 + r32;
        bf16x8 qf[4];
#pragma unroll
        for (int s = 0; s < 4; ++s) qf[s] = *(const bf16x8*)(P + (size_t)q * PINP + PC_MQ + h * 64 + 16 * s + 8 * hh);
        f32x16 sc[8];
#pragma unroll
        for (int kt = 0; kt < 8; ++kt) {
#pragma unroll
            for (int i = 0; i < 16; ++i) sc[kt][i] = 0.f;
#pragma unroll
            for (int s = 0; s < 4; ++s) { const bf16x8 kf = *(const LAS bf16x8*)(KL + (kt * 32 + r32) * 72 + 16 * s + 8 * hh);
                sc[kt] = __builtin_amdgcn_mfma_f32_32x32x16_bf16(kf, qf[s], sc[kt], 0, 0, 0); }
        }
        float m = -3.0e38f;
#pragma unroll
        for (int kt = 0; kt < 8; ++kt)
#pragma unroll
            for (int i = 0; i < 16; ++i) m = fmaxf(m, sc[kt][i]);
        m = fmaxf(m, __shfl_xor(m, 32));
        float sum = 0.f;
        const float c2 = 0.125f * 1.4426950408889634f;
#pragma unroll
        for (int kt = 0; kt < 8; ++kt)
#pragma unroll
            for (int i = 0; i < 16; ++i) { const float e = __builtin_amdgcn_exp2f((sc[kt][i] - m) * c2); sc[kt][i] = e; sum += e; }
        sum += __shfl_xor(sum, 32);
        const float inv = 1.0f / sum;
        f32x16 oa[2];
#pragma unroll
        for (int vt = 0; vt < 2; ++vt)
#pragma unroll
            for (int i = 0; i < 16; ++i) oa[vt][i] = 0.f;
#pragma unroll
        for (int kt = 0; kt < 8; ++kt)
#pragma unroll
            for (int s = 0; s < 2; ++s) {
                union { bf16x8 v; unsigned w[4]; } pf;
#pragma unroll
                for (int j = 0; j < 4; ++j) pf.w[j] = cvt_pk_bf16(sc[kt][8 * s + 2 * j], sc[kt][8 * s + 2 * j + 1]);
#pragma unroll
                for (int vt = 0; vt < 2; ++vt) {
                    const LAS bf16* vp = VT + (vt * 32 + r32) * 264 + kt * 32 + 16 * s + 4 * hh;
                    union { bf16x8 v; s16x4 h2[2]; } vf; vf.h2[0] = *(const LAS s16x4*)vp; vf.h2[1] = *(const LAS s16x4*)(vp + 8);
                    oa[vt] = __builtin_amdgcn_mfma_f32_32x32x16_bf16(vf.v, pf.v, oa[vt], 0, 0, 0); }
            }
        bf16* orow = O + (size_t)q * D + 768 + h * 64;
#pragma unroll
        for (int vt = 0; vt < 2; ++vt)
#pragma unroll
            for (int g = 0; g < 4; ++g) { u32x2 w; w.x = cvt_pk_bf16(oa[vt][4 * g] * inv, oa[vt][4 * g + 1] * inv); w.y = cvt_pk_bf16(oa[vt][4 * g + 2] * inv, oa[vt][4 * g + 3] * inv);
                *(u32x2*)(orow + vt * 32 + 8 * g + 4 * hh) = w; }
    }
    lds_barrier();
}

__device__ __forceinline__ void m2_phase(LAS unsigned char* lds, int l, int bx, int G) {
    unsigned char* ws = KWS();
    const int tid = opaque_tid(), lane = tid & 63, wave = __builtin_amdgcn_readfirstlane(tid >> 6);
    const int nrw = (G >= 128) ? 64 : 0;
    if (nrw) { if (bx < nrw && wave == 0) rw_m2_wave(lds, lane, bx >> 1, bx & 1); }
    else { if (wave == 0) for (int q = bx; q < 64; q += G) rw_m2_wave(lds, lane, q >> 1, q & 1); }
    if (nrw && !(bx < nrw && wave == 0)) {
        const int nth = nrw ? (nrw * 448 + (G - nrw) * NTHR) : G * NTHR;
        const int gt = nrw ? (bx < nrw ? bx * 448 + (tid - 64) : nrw * 448 + (bx - nrw) * NTHR + tid) : bx * NTHR + tid;
        for (int e = gt; e < 98304; e += nth) {
            if (e < 65536) m2_gh_elem2<64>(e, (const float*)(ws + WS_HDS), (const float*)(ws + WS_HBE), (bf16*)(ws + WS_HS));
            else m2_gh_elem2<32>(e - 65536, (const float*)(ws + WS_GDS), (const float*)(ws + WS_GBE), (bf16*)(ws + WS_GS)); }
    }
    if (nrw == 0) { __syncthreads(); for (int e = bx * NTHR + tid; e < 98304; e += G * NTHR) {
            if (e < 65536) m2_gh_elem2<64>(e, (const float*)(ws + WS_HDS), (const float*)(ws + WS_HBE), (bf16*)(ws + WS_HS));
            else m2_gh_elem2<32>(e - 65536, (const float*)(ws + WS_GDS), (const float*)(ws + WS_GBE), (bf16*)(ws + WS_GS)); } }
    if (nrw == 0 || bx >= nrw) {
        const int nb = G - nrw, r = bx - nrw;
        const int per = (1024 + nb - 1) / nb, lo = r * per, hi = (lo + per < 1024) ? lo + per : 1024;
        xattn_units(lds, l, lo, hi, 1);
    }
}

__device__ __forceinline__ void ln1_router_phase(LAS unsigned char* lds, int l, int bx, int G) {
    const int tid = opaque_tid(), lane = tid & 63, wave = __builtin_amdgcn_readfirstlane(tid >> 6);
    LAS float* X = (LAS float*)lds;
    LAS float* PART = (LAS float*)(lds + 16 * 1028 * 4);
    LAS int* HIST = (LAS int*)(lds + 16 * 1028 * 4 + 8 * 16 * 32 * 4);
    const float* xin = KIN(I_X); const bf16* xinb = (const bf16*)(KWS() + WS_XB);
    const bf16* HM = (const bf16*)(KWS() + WS_HMIX);
    bf16* X1B = (bf16*)(KWS() + WS_X1B); unsigned char* X1Q = (unsigned char*)(KWS() + WS_XF);
    const float* g1 = KIN(I_LN1G) + l * D; const float* b1 = KIN(I_LN1B) + l * D;
    const float* rw = KIN(I_RTW) + (size_t)l * D * NE; const float* rb = KIN(I_RTB) + l * NE;
    int* tok_e = (int*)(KWS() + WS_ROUTE); float* tok_g = (float*)(KWS() + WS_ROUTE + 1 * MiB);
    if (tid < 32) HIST[tid] = 0;
    float rwB[2][32];
    { const int q = lane >> 4, e = lane & 15;
#pragma unroll
      for (int s = 0; s < 32; ++s) { const float* p = rw + (size_t)(128 * wave + 32 * q + s) * NE + e; rwB[0][s] = p[0]; rwB[1][s] = p[16]; } }
    lds_barrier();
    f32x4 xraw[2][4]; u32x2 xbraw[2][4], hraw[2][4];
#define LN1_LOAD(it_) do { _Pragma("unroll") for (int tt = 0; tt < 2; ++tt) { const size_t _tok = (size_t)(it_) * 16 + wave * 2 + tt; \
        const f32x4* _xr = (const f32x4*)(xin + _tok * D) + lane; const u32x2* _xbr = (const u32x2*)(xinb + _tok * D) + lane; const u32x2* _hr = (const u32x2*)(HM + _tok * D) + lane; \
        _Pragma("unroll") for (int j = 0; j < 4; ++j) { if (l == 0) xraw[tt][j] = _xr[64 * j]; else xbraw[tt][j] = _xbr[64 * j]; hraw[tt][j] = _hr[64 * j]; } } } while (0)
    if (bx < NTOK / 16) LN1_LOAD(bx);
    for (int it = bx; it < NTOK / 16; it += G) {
        f32x4 vv[2][4];
#pragma unroll
        for (int tt = 0; tt < 2; ++tt)
#pragma unroll
            for (int j = 0; j < 4; ++j) { f32x4 xv; if (l == 0) xv = xraw[tt][j]; else { const u32x2 xw = xbraw[tt][j]; xv = (f32x4){bflo(xw.x), bfhi(xw.x), bflo(xw.y), bfhi(xw.y)}; } const u32x2 hw = hraw[tt][j];
                vv[tt][j][0] = DN_ALPHA * xv[0] + bflo(hw.x); vv[tt][j][1] = DN_ALPHA * xv[1] + bfhi(hw.x); vv[tt][j][2] = DN_ALPHA * xv[2] + bflo(hw.y); vv[tt][j][3] = DN_ALPHA * xv[3] + bfhi(hw.y); }
        if (it + G < NTOK / 16) LN1_LOAD(it + G);
#pragma unroll
        for (int tt = 0; tt < 2; ++tt) { const int ti = wave * 2 + tt; const size_t tok = (size_t)it * 16 + ti;
            f32x4 v[4]; float s = 0.f;
#pragma unroll
            for (int j = 0; j < 4; ++j) { v[j] = vv[tt][j]; s += (v[j][0] + v[j][1]) + (v[j][2] + v[j][3]); }
            const float mean = wave_sum(s) * (1.0f / D); float s2 = 0.f;
#pragma unroll
            for (int j = 0; j < 4; ++j) { v[j] = v[j] - mean; s2 += (v[j][0] * v[j][0] + v[j][1] * v[j][1]) + (v[j][2] * v[j][2] + v[j][3] * v[j][3]); }
            const float rstd = 1.0f / sqrtf(wave_sum(s2) * (1.0f / D) + LN_EPS);
#pragma unroll
            for (int j = 0; j < 4; ++j) { const f32x4 gg = *((const f32x4*)g1 + lane + 64 * j), bb = *((const f32x4*)b1 + lane + 64 * j);
                const f32x4 y = v[j] * rstd * gg + bb;
                *((u32x2*)(X1B + tok * D) + lane + 64 * j) = (u32x2){pk2(y[0], y[1]), pk2(y[2], y[3])};
                { int w = __builtin_amdgcn_cvt_pk_fp8_f32(y[0], y[1], 0, false); w = __builtin_amdgcn_cvt_pk_fp8_f32(y[2], y[3], w, true); *((unsigned*)(X1Q + tok * D) + lane + 64 * j) = (unsigned)w; }
                *(LAS f32x4*)(X + ti * 1028 + 4 * lane + 256 * j) = y; }
        }
        lds_barrier();
        {
            const int q = lane >> 4, r = lane & 15;
            f32x4 acc0 = (f32x4){0.f, 0.f, 0.f, 0.f}, acc1 = (f32x4){0.f, 0.f, 0.f, 0.f};
            const LAS float* xa = X + r * 1028 + 128 * wave + 32 * q;
#pragma unroll
            for (int s4 = 0; s4 < 8; ++s4) { const f32x4 av = *(const LAS f32x4*)(xa + 4 * s4);
#pragma unroll
                for (int j = 0; j < 4; ++j) { acc0 = __builtin_amdgcn_mfma_f32_16x16x4f32(av[j], rwB[0][4 * s4 + j], acc0, 0, 0, 0); acc1 = __builtin_amdgcn_mfma_f32_16x16x4f32(av[j], rwB[1][4 * s4 + j], acc1, 0, 0, 0); } }
#pragma unroll
            for (int i = 0; i < 4; ++i) { PART[(wave * 16 + 4 * q + i) * 32 + r] = acc0[i]; PART[(wave * 16 + 4 * q + i) * 32 + 16 + r] = acc1[i]; }
        }
        lds_barrier();
        {
            const int ti = tid >> 5, e = tid & 31;
            float lg = rb[e];
#pragma unroll
            for (int w = 0; w < 8; ++w) lg += PART[(w * 16 + ti) * 32 + e];
            float tv[4]; int te[4]; float cur = lg;
#pragma unroll
            for (int k = 0; k < 4; ++k) { float bv = cur; int bi = e;
#pragma unroll
                for (int o = 16; o >= 1; o >>= 1) { const float ov = __shfl_xor(bv, o); const int oi = __shfl_xor(bi, o); if (ov > bv || (ov == bv && oi < bi)) { bv = ov; bi = oi; } }
                tv[k] = bv; te[k] = bi; if (e == bi) cur = -3.0e38f; }
            const float e1 = __expf(tv[1] - tv[0]), e2 = __expf(tv[2] - tv[0]), e3 = __expf(tv[3] - tv[0]); const float inv = 1.0f / (1.0f + e1 + e2 + e3);
            const size_t tok = (size_t)it * 16 + ti;
            if (e < 4) { const int ek = e == 0 ? te[0] : e == 1 ? te[1] : e == 2 ? te[2] : te[3]; const float gk = (e == 0 ? 1.0f : e == 1 ? e1 : e == 2 ? e2 : e3) * inv;
                tok_e[tok * 4 + e] = ek; tok_g[tok * 4 + e] = gk; __hip_atomic_fetch_add(&HIST[ek], 1, __ATOMIC_RELAXED, __HIP_MEMORY_SCOPE_WORKGROUP); }
        }
        lds_barrier();
    }
#undef LN1_LOAD
    lds_barrier();
    if (tid < 32) ((int*)(KWS() + WS_CTL))[CW_HIST + bx * 32 + tid] = HIST[tid];
}

__device__ __forceinline__ void slots_phase(LAS unsigned char* lds, int bx, int G) {
    const int tid = opaque_tid();
    int* ctl = (int*)(KWS() + WS_CTL);
    LAS int* RED = (LAS int*)lds;
    LAS int* TOT = RED + 1024;
    const int* tok_e = (const int*)(KWS() + WS_ROUTE); const float* tok_g = (const float*)(KWS() + WS_ROUTE + 1 * MiB);
    int* tok_slot = (int*)(KWS() + WS_ROUTE + 2 * MiB); int* slot_tok = (int*)(KWS() + WS_ROUTE + 3 * MiB); float* slot_gate = (float*)(KWS() + WS_ROUTE + 3 * MiB + 1536 * 1024);
    { const int e = tid & 31, part = tid >> 5; int tot = 0, pre = 0;
      for (int b2 = part; b2 < G; b2 += 16) { const int h = ctl[CW_HIST + b2 * 32 + e]; tot += h; if (b2 < bx) pre += h; }
      RED[(part * 32 + e) * 2] = tot; RED[(part * 32 + e) * 2 + 1] = pre; }
    __syncthreads();
    if (tid < 32) { int tot = 0, pre = 0; for (int p = 0; p < 16; ++p) { tot += RED[(p * 32 + tid) * 2]; pre += RED[(p * 32 + tid) * 2 + 1]; } TOT[tid] = tot; TOT[32 + tid] = pre; TOT[96 + tid] = 0; }
    __syncthreads();
    if (tid == 0) { int ps = 0;
#pragma unroll 1
        for (int e = 0; e < 32; ++e) { TOT[64 + e] = ps; ps += (TOT[e] + 255) & ~255; }
        TOT[128] = ps >> 8; if (bx == 0) ctl[CW_NT] = ps >> 8; }
    __syncthreads();
    if (bx == 0) { const int nt = TOT[128];
        for (int t = tid; t < nt; t += NTHR) { int e = 0;
#pragma unroll 1
            for (int k = 1; k < 32; ++k) if (TOT[64 + k] <= t * 256) e = k;
            ctl[CW_TILEE + t] = e; } }
    for (int e = bx; e < 32; e += G) { const int s0 = TOT[64 + e] + TOT[e], s1 = TOT[64 + e] + ((TOT[e] + 255) & ~255); for (int s = s0 + tid; s < s1; s += NTHR) { slot_tok[s] = 0; slot_gate[s] = 0.f; } }
    for (int it = bx + G * (tid >> 6); it < NTOK / 16; it += G * 8) {
        const int asg = it * 64 + (tid & 63); const int e = tok_e[asg]; const int rank = __hip_atomic_fetch_add(&TOT[96 + e], 1, __ATOMIC_RELAXED, __HIP_MEMORY_SCOPE_WORKGROUP); const int slot = TOT[64 + e] + TOT[32 + e] + rank;
        tok_slot[asg] = slot; slot_tok[slot] = asg >> 2; slot_gate[slot] = tok_g[asg];
    }
}

__device__ __forceinline__ void combine_phase(int l, int vcu, int G) {
    const int tid = opaque_tid(), lane = tid & 63, wave = __builtin_amdgcn_readfirstlane(tid >> 6);
    const int gw = vcu * NWAVES + wave, NGW = G * NWAVES;
    const bf16* X1B = (const bf16*)(KWS() + WS_X1B); const bf16* YB = (const bf16*)(KWS() + WS_YB); const int* tok_slot = (const int*)(KWS() + WS_ROUTE + 2 * MiB);
    float* xo = KOUT(); bf16* XB = (bf16*)(KWS() + WS_XB);
    const float* g2 = KIN(I_LN2G) + l * D; const float* b2 = KIN(I_LN2B) + l * D;
    for (int tok = gw; tok < NTOK; tok += NGW) {
        const int s0 = tok_slot[tok * 4], s1 = tok_slot[tok * 4 + 1], s2i = tok_slot[tok * 4 + 2], s3 = tok_slot[tok * 4 + 3];
        const u32x2* xr = (const u32x2*)(X1B + (size_t)tok * D) + lane;
        const u32x2* y0 = (const u32x2*)(YB + (size_t)s0 * D) + lane; const u32x2* y1 = (const u32x2*)(YB + (size_t)s1 * D) + lane;
        const u32x2* y2 = (const u32x2*)(YB + (size_t)s2i * D) + lane; const u32x2* y3 = (const u32x2*)(YB + (size_t)s3 * D) + lane;
        f32x4 v[4]; float s = 0.f;
#pragma unroll
        for (int j = 0; j < 4; ++j) { const u32x2 xw = xr[64 * j]; const f32x4 xv = {bflo(xw.x), bfhi(xw.x), bflo(xw.y), bfhi(xw.y)}; const u32x2 a0 = y0[64 * j], a1 = y1[64 * j], a2 = y2[64 * j], a3 = y3[64 * j];
            v[j][0] = DN_ALPHA * xv[0] + ((bflo(a0.x) + bflo(a1.x)) + (bflo(a2.x) + bflo(a3.x))); v[j][1] = DN_ALPHA * xv[1] + ((bfhi(a0.x) + bfhi(a1.x)) + (bfhi(a2.x) + bfhi(a3.x)));
            v[j][2] = DN_ALPHA * xv[2] + ((bflo(a0.y) + bflo(a1.y)) + (bflo(a2.y) + bflo(a3.y))); v[j][3] = DN_ALPHA * xv[3] + ((bfhi(a0.y) + bfhi(a1.y)) + (bfhi(a2.y) + bfhi(a3.y)));
            s += (v[j][0] + v[j][1]) + (v[j][2] + v[j][3]); }
        const float mean = wave_sum(s) * (1.0f / D); float q = 0.f;
#pragma unroll
        for (int j = 0; j < 4; ++j) { v[j] = v[j] - mean; q += (v[j][0] * v[j][0] + v[j][1] * v[j][1]) + (v[j][2] * v[j][2] + v[j][3] * v[j][3]); }
        const float rstd = 1.0f / sqrtf(wave_sum(q) * (1.0f / D) + LN_EPS);
#pragma unroll
        for (int j = 0; j < 4; ++j) { const f32x4 gg = *((const f32x4*)g2 + lane + 64 * j), bb = *((const f32x4*)b2 + lane + 64 * j);
            const f32x4 y = v[j] * rstd * gg + bb;
            if (l == NL - 1) *((f32x4*)(xo + (size_t)tok * D) + lane + 64 * j) = y;
            else *((u32x2*)(XB + (size_t)tok * D) + lane + 64 * j) = (u32x2){pk2(y[0], y[1]), pk2(y[2], y[3])}; }
    }
}


constexpr int PH_PER_LAYER = 10, NPHASES = 2 + NL * PH_PER_LAYER;
__global__ void __launch_bounds__(NTHR, 2) trunk_fwd(Args args) {
    extern __shared__ __attribute__((aligned(16))) unsigned char lds_raw[];
    LAS unsigned char* lds = (LAS unsigned char*)lds_raw;
    volatile LAS unsigned* MISC = (volatile LAS unsigned*)(lds + MISC_OFF);
    const int tid = threadIdx.x;
    const int G = gridDim.x, bx = blockIdx.x;
    const int vcu = (G % 8 == 0) ? (bx % 8) * (G / 8) + bx / 8 : bx;
    unsigned char* ws = KWS();
    unsigned* ctl = (unsigned*)(ws + WS_CTL);
    for (int u = tid; u < (LDS_BYTES - LDSCTL_OFF) / 4; u += NTHR) ((LAS unsigned*)(lds + LDSCTL_OFF))[u] = 0u;
    __syncthreads();
    XcdBarrier bar; bar.bar = ctl + CW_BAR; bar.x = 0; bar.st = nullptr;
#if !MK_PER_PHASE
    bar = xcd_barrier_post(ctl + CW_BAR, MISC + 8);
#define GRID_BAR() xcd_barrier(bar)
#else
#define GRID_BAR() do { } while (0)
#endif
    const int lo = (int)(unsigned)ka_u64<280>(), hi = (int)(unsigned)(ka_u64<280>() >> 32);
#ifndef PH_MASK
#define PH_MASK 0x1FFF
#endif
#define PHEN(n) (((PH_MASK) >> (n)) & 1)
#define IN(k) (lo <= (k) && (k) < hi)
#define SEAM(k) do { if (rep > 0 || IN((k) + 1)) GRID_BAR(); } while (0)

#define OG opaque_s(G)
#define OBX opaque_s(bx)
#define OVCU opaque_s(vcu)
#define OL opaque_s(l)
    if (PHEN(0) && IN(0)) for (int rep = PHREP(0); rep >= 0; --rep) { prologue_phase(lds, OVCU, OG); SEAM(0); }
    if (PHEN(1) && IN(1)) for (int rep = PHREP(1); rep >= 0; --rep) {
        pg8::DenseOrder S; S.init(KWS() + WS_MEMB, KWS() + WS_WMEM, NB * NMEM, 2048, D, OG, OBX);
        pg8::EpiBf16 E{(bf16*)(KWS() + WS_MKV), 2048};
        pg8::gemm_phase<pg8::EpiBf16, pg8::DenseOrder>(lds, D, S, E);
        SEAM(1);
    }
    for (int l = 0; l < NL; ++l) {
        const int p0 = 2 + l * PH_PER_LAYER;
        if (PHEN(2) && IN(p0 + 0)) for (int rep = PHREP(2); rep >= 0; --rep) {
            pg8::DenseOrder S; S.init(KWS() + WS_XB, KWS() + WS_WIN + (size_t)OL * PINP * D * 2, NTOK, PINP, D, OG, OBX);
            pg8::EpiBf16 E{(bf16*)(KWS() + WS_P), PINP};
            pg8::gemm_phase<pg8::EpiBf16, pg8::DenseOrder>(lds, D, S, E);
            SEAM(p0 + 0);
        }
        if (PHEN(4) && IN(p0 + 1)) for (int rep = PHREP(4); rep >= 0; --rep) { c1_phase(lds, OL, OVCU, OG); SEAM(p0 + 1); }
        if (PHEN(5) && IN(p0 + 2)) for (int rep = PHREP(5); rep >= 0; --rep) { m2_phase(lds, OL, OBX, OG); SEAM(p0 + 2); }
        if (PHEN(6) && IN(p0 + 3)) for (int rep = PHREP(6); rep >= 0; --rep) { m3_gh_phase(OL, OVCU, OG); SEAM(p0 + 3); }
        if (PHEN(7) && IN(p0 + 4)) for (int rep = PHREP(7); rep >= 0; --rep) {
            pg8::DenseOrder S; S.init(KWS() + WS_O, KWS() + WS_WOUT + (size_t)OL * D * D * 2, NTOK, D, D, OG, OBX);
            pg8::EpiBf16 E{(bf16*)(KWS() + WS_HMIX), D};
            pg8::gemm_phase<pg8::EpiBf16, pg8::DenseOrder>(lds, D, S, E);
            SEAM(p0 + 4);
        }
        if (PHEN(8) && IN(p0 + 5)) for (int rep = PHREP(8); rep >= 0; --rep) { ln1_router_phase(lds, OL, OBX, OG); SEAM(p0 + 5); }
        if (PHEN(9) && IN(p0 + 6)) for (int rep = PHREP(9); rep >= 0; --rep) { slots_phase(lds, OBX, OG); SEAM(p0 + 6); }
        if (PHEN(10) && IN(p0 + 7)) for (int rep = PHREP(10); rep >= 0; --rep) {
            const int ntiles = __builtin_amdgcn_readfirstlane(((const int*)(KWS() + WS_CTL))[CW_NT]);
            pg8::MoeOrder<true> S; S.init(KWS() + WS_XF, KWS() + WS_WGU + (size_t)OL * NE * 2048 * D, (const int*)(KWS() + WS_CTL) + CW_TILEE, (const int*)(KWS() + WS_ROUTE + 3 * MiB), ntiles, 2048, D, OG, OBX);
            pg8::EpiSwiglu E{(unsigned char*)(KWS() + WS_HB), (const float*)(KWS() + WS_BGU) + (size_t)OL * NE * 2048};
            pg8::gemm_phase<pg8::EpiSwiglu, pg8::MoeOrder<true>, 1>(lds, D, S, E);
            SEAM(p0 + 7);
        }
        if (PHEN(11) && IN(p0 + 8)) for (int rep = PHREP(11); rep >= 0; --rep) {
            const int ntiles = __builtin_amdgcn_readfirstlane(((const int*)(KWS() + WS_CTL))[CW_NT]);
            pg8::MoeOrder<false> S; S.init(KWS() + WS_HB, KWS() + WS_WD + (size_t)OL * NE * D * FF, (const int*)(KWS() + WS_CTL) + CW_TILEE, (const int*)(KWS() + WS_ROUTE + 3 * MiB), ntiles, D, FF, OG, OBX);
            pg8::EpiDown E{(bf16*)(KWS() + WS_YB), KIN(I_BDN) + (size_t)OL * NE * D, (const float*)(KWS() + WS_ROUTE + 3 * MiB + 1536 * 1024)};
            pg8::gemm_phase<pg8::EpiDown, pg8::MoeOrder<false>, 1>(lds, FF, S, E);
            SEAM(p0 + 8);
        }
        if (PHEN(12) && IN(p0 + 9)) for (int rep = PHREP(12); rep >= 0; --rep) { combine_phase(OL, OVCU, OG); if (rep > 0 || l + 1 < NL) SEAM(p0 + 9); }
    }
#undef IN
#undef SEAM
}

extern "C" void kernel_launch(void* const* d_in, const int* in_sizes, int n_in, void* d_out, int out_size, void* d_ws, size_t ws_size, hipStream_t stream) {
    static int grid = 0;
    if (grid == 0) {
        if (n_in != 33 || ws_size < WS_END) { fprintf(stderr, "kernel_launch: unexpected inputs (n_in %d, ws %zu need %zu)\n", n_in, ws_size, (size_t)WS_END); grid = -1; return; }
        int dev = 0, cus = 0;
        if (hipGetDevice(&dev) != hipSuccess || hipDeviceGetAttribute(&cus, hipDeviceAttributeMultiprocessorCount, dev) != hipSuccess) { grid = -1; return; }
        if (hipFuncSetAttribute((const void*)trunk_fwd, hipFuncAttributeMaxDynamicSharedMemorySize, LDS_BYTES) != hipSuccess) { grid = -1; return; }
        int per_cu = 0; (void)hipOccupancyMaxActiveBlocksPerMultiprocessor(&per_cu, (const void*)trunk_fwd, NTHR, LDS_BYTES); (void)hipGetLastError();
        grid = cus;
    }
    if (grid < 0) return;
    (void)hipMemsetAsync((char*)d_ws + WS_CTL, 0, CTL_ZERO_BYTES, stream);
    Args a{};
    for (int i = 0; i < 33; ++i) a.in[i] = (const float*)d_in[i];
    a.out = (float*)d_out; a.ws = (unsigned char*)d_ws;
#if MK_PER_PHASE
    for (int p = 0; p < NPHASES; ++p) { a.ph_lo = p; a.ph_hi = p + 1; hipLaunchKernelGGL(trunk_fwd, dim3(grid), dim3(NTHR), LDS_BYTES, stream, a); }
#else
    a.ph_lo = 0; a.ph_hi = NPHASES;
    hipLaunchKernelGGL(trunk_fwd, dim3(grid), dim3(NTHR), LDS_BYTES, stream, a);
#endif
}
```

```cpp
#include <hip/hip_runtime.h>
#include <cstdio>
#include <cstdint>

#ifndef MK_PER_PHASE
#define MK_PER_PHASE 0
#endif

#ifndef REP_MASK
#define REP_MASK 0
#endif
#define PHREP(n) (((REP_MASK) >> (n)) & 1)
#define LAS __attribute__((address_space(3)))
#define GAS __attribute__((address_space(1)))
typedef unsigned short bf16;
typedef short bf16x8 __attribute__((ext_vector_type(8)));
typedef short s16x4 __attribute__((ext_vector_type(4)));
typedef float f32x4 __attribute__((ext_vector_type(4)));
typedef float f32x2 __attribute__((ext_vector_type(2)));
typedef float f32x16 __attribute__((ext_vector_type(16)));
typedef unsigned u32x4 __attribute__((ext_vector_type(4)));
typedef unsigned u32x2 __attribute__((ext_vector_type(2)));

constexpr int NB = 8, T = 8192, D = 1024, NL = 4, NTOK = NB * T;
constexpr int PIN = 3088, PINP = 3328;
constexpr int NE = 32, FF = 1024, NMEM = 256;
constexpr int NASSIGN = NTOK * 4;
constexpr int MAXTILES = NASSIGN / 256 + NE;
constexpr int MAXSLOTS = MAXTILES * 256;
constexpr int PC_GQ = 0, PC_GK = 128, PC_GV = 256, PC_GOUT = 512, PC_HQ = 768, PC_HF = 1024, PC_HI = 1280, PC_HG = 1536;
constexpr int PC_RW = 1792, PC_MQ = 2816, PC_GLR = 3072;
constexpr float DN_ALPHA = 1.6817928305074292f;
constexpr float LN_EPS = 1e-5f, RMS_EPS = 1e-6f, RW_LN_EPS = 64e-5f;

constexpr size_t MiB = 1u << 20;
constexpr size_t WS_CTL = 0, CTL_ZERO_BYTES = 1 * MiB;
constexpr size_t WS_WIN = 1 * MiB;
constexpr size_t WS_WOUT = WS_WIN + 26 * MiB;
constexpr size_t WS_WMEM = WS_WOUT + 8 * MiB;
constexpr size_t WS_WGU = WS_WMEM + 4 * MiB;
constexpr size_t WS_WD = WS_WGU + 512 * MiB;
constexpr size_t WS_BGU = WS_WD + 256 * MiB;
constexpr size_t WS_LORA = WS_BGU + 1 * MiB;
constexpr size_t WS_MEMB = WS_LORA + 1 * MiB;
constexpr size_t WS_MKV = WS_MEMB + 4 * MiB;
constexpr size_t WS_XB = WS_MKV + 8 * MiB;
constexpr size_t WS_X1B = WS_XB + 128 * MiB;
constexpr size_t WS_XF = WS_X1B + 128 * MiB;
constexpr size_t WS_X1F = WS_XF + 256 * MiB;
constexpr size_t WS_O = WS_X1F + 256 * MiB;
constexpr size_t WS_HMIX = WS_O + 128 * MiB;
constexpr size_t WS_ROUTE = WS_HMIX + 128 * MiB;
constexpr size_t WS_GBUF = WS_ROUTE + 6 * MiB;
constexpr size_t WS_BONUS = WS_GBUF + 32 * MiB;
constexpr size_t WS_BIG = WS_BONUS + 1 * MiB;
constexpr size_t WS_P = WS_BIG;
constexpr size_t WS_ORAW = WS_P + 416 * MiB;
constexpr size_t WS_HB = WS_BIG;
constexpr size_t WS_YB = WS_HB + 528 * MiB;
constexpr size_t WS_CHK = WS_ORAW;
constexpr size_t WS_HQ = WS_CHK, WS_HK = WS_HQ + 32 * MiB, WS_HVT = WS_HK + 32 * MiB, WS_HDS = WS_HVT + 32 * MiB, WS_HS = WS_HDS + 128 * MiB, WS_HBE = WS_HS + 64 * MiB;
constexpr size_t WS_GQ = WS_HBE + 2 * MiB, WS_GK = WS_GQ + 16 * MiB, WS_GVT = WS_GK + 16 * MiB, WS_GDS = WS_GVT + 32 * MiB, WS_GS = WS_GDS + 64 * MiB, WS_GBE = WS_GS + 32 * MiB;
constexpr size_t WS_RR = WS_GBE + 1 * MiB, WS_RB = WS_RR + 32 * MiB, WS_RK = WS_RB + 32 * MiB, WS_RW = WS_RK + 32 * MiB, WS_RVT = WS_RW + 32 * MiB;
constexpr size_t WS_RVG = WS_RVT + 32 * MiB;
constexpr size_t WS_RU = WS_RVG + 32 * MiB, WS_RP = WS_RU + 64 * MiB, WS_RQ = WS_RP + 64 * MiB, WS_RS = WS_RQ + 128 * MiB;
constexpr size_t WS_END = WS_RS + 64 * MiB;
static_assert(WS_YB + 528 * MiB <= WS_END, "overlay");
static_assert(WS_END <= (size_t)4096 * MiB, "workspace");
constexpr int CW_TMO = 0;
constexpr int CW_BAR = 4096;
constexpr int CW_HIST = 16384;
constexpr int CW_NT = 32768;
constexpr int CW_TILEE = 32768 + 64;
constexpr int CW_PADSTART = 40960;

constexpr int RING_BYTES = 131072;
constexpr int LDSCTL_OFF = 162816, MISC_OFF = LDSCTL_OFF + 320;
constexpr int LDS_BYTES = 163840;
constexpr int NWAVES = 8, NTHR = 512;

#define RLX_AGENT __ATOMIC_RELAXED, __HIP_MEMORY_SCOPE_AGENT
#define LDS_WAIT() asm volatile("s_waitcnt lgkmcnt(0)" ::: "memory")
#define VM_WAIT() asm volatile("s_waitcnt vmcnt(0)" ::: "memory")

__device__ __forceinline__ float bf2f(unsigned short b) { return __builtin_bit_cast(float, (unsigned)b << 16); }
__device__ __forceinline__ float bflo(unsigned w) { return __builtin_bit_cast(float, w << 16); }
__device__ __forceinline__ float bfhi(unsigned w) { return __builtin_bit_cast(float, w & 0xffff0000u); }
typedef __bf16 bf16x2_t __attribute__((ext_vector_type(2)));
__device__ __forceinline__ unsigned cvt_pk_bf16(float lo, float hi) { const f32x2 v = {lo, hi}; const bf16x2_t b = __builtin_convertvector(v, bf16x2_t); return __builtin_bit_cast(unsigned, b); }
__device__ __forceinline__ unsigned pk2(float lo, float hi) { return cvt_pk_bf16(lo, hi); }
__device__ __forceinline__ unsigned f2bf(float f) { return cvt_pk_bf16(f, 0.f) & 0xffffu; }
__device__ __forceinline__ float fast_exp(float x) { return __builtin_amdgcn_exp2f(x * 1.4426950408889634f); }
__device__ __forceinline__ float fast_sigmoid(float x) { return __builtin_amdgcn_rcpf(1.0f + fast_exp(-x)); }
__device__ __forceinline__ float silu_f(float x) { return x * fast_sigmoid(x); }
__device__ __forceinline__ int opaque_tid() { int t = threadIdx.x; asm volatile("" : "+v"(t)); return t; }
__device__ __forceinline__ int opaque_s(int v) { asm volatile("" : "+s"(v)); return v; }
__device__ __forceinline__ void lds_barrier() { asm volatile("s_waitcnt lgkmcnt(0)" ::: "memory"); __builtin_amdgcn_s_barrier(); asm volatile("" ::: "memory"); }
__device__ __forceinline__ float dpp_add(float x, const int sel) {
    const int xi = __builtin_bit_cast(int, x); int r;
    switch (sel) { case 0: r = __builtin_amdgcn_update_dpp(xi, xi, 0xB1, 0xf, 0xf, false); break;
                   case 1: r = __builtin_amdgcn_update_dpp(xi, xi, 0x4E, 0xf, 0xf, false); break;
                   case 2: r = __builtin_amdgcn_update_dpp(xi, xi, 0x141, 0xf, 0xf, false); break;
                   default: r = __builtin_amdgcn_update_dpp(xi, xi, 0x140, 0xf, 0xf, false); break; }
    return x + __builtin_bit_cast(float, r);
}
__device__ __forceinline__ float wave_sum(float v) {
    v = dpp_add(v, 0); v = dpp_add(v, 1); v = dpp_add(v, 2); v = dpp_add(v, 3);
    v += __shfl_xor(v, 16); v += __shfl_xor(v, 32);
    return v;
}

namespace pg8 {
constexpr int BM = 256, BK = 64, HALF = 128, HTB = HALF * BK * 2, STAGE_BYTES = 8 * HTB, NXCD = 8, WGM = 8;
__host__ __device__ __forceinline__ int lds_byte(int r, int c) { const int st = (r >> 4) * 2 + (c >> 5), rr = r & 15, cc = c & 31, ob = rr * 64 + cc * 2; return st * 1024 + (ob ^ (((ob >> 9) & 1) << 5)); }
__host__ __device__ __forceinline__ void stage_rc(int b, int& R, int& C) { const int st = b / 1024, sb = b % 1024, swz = sb ^ (((sb >> 9) & 1) << 5); R = (st >> 1) * 16 + swz / 64; C = (st & 1) * 32 + (swz % 64) / 2; }
__host__ __device__ __forceinline__ int perm32(int rho) { const int n = rho >> 4, i = rho & 15; return 8 * (i >> 2) + 4 * n + (i & 3); }

typedef int v4i_t __attribute__((ext_vector_type(4)));
typedef int v8i_t __attribute__((ext_vector_type(8)));
struct Unit { int pm, pn, e; const char* A; const char* B; };

__device__ __forceinline__ bool static_tile(int i, int G, int c, int nM, int nN, int& pm, int& pn) {
    const int nwg = nM * nN; const long L = (long)i * G + c; if (L >= nwg) return false;
    int wgid = (int)L; { const int q = nwg / NXCD, r = nwg % NXCD, xcd = wgid % NXCD, off = wgid / NXCD; wgid = (xcd < r ? xcd * (q + 1) : r * (q + 1) + (xcd - r) * q) + off; }
    const int nig = WGM * nN, gid = wgid / nig, fm = gid * WGM, gsz = (nM - fm) < WGM ? (nM - fm) : WGM;
    pm = fm + ((wgid % nig) % gsz); pn = (wgid % nig) / gsz; return true;
}
struct DenseOrder {
    static constexpr bool GATHER = false;
    const char* A; const char* B; int nM, nN, G, c; size_t tstep;
    __device__ __forceinline__ void init(const void* A_, const void* B_, int M, int N, int K, int G_, int c_) { A = (const char*)A_; B = (const char*)B_; nM = M / BM; nN = N / BM; G = G_; c = c_; tstep = (size_t)BM * K * 2; }
    __device__ __forceinline__ bool next(int i, Unit& u) const { if (!static_tile(i, G, c, nM, nN, u.pm, u.pn)) return false; u.e = 0; u.A = A + (size_t)u.pm * tstep; u.B = B + (size_t)u.pn * tstep; return true; }
    __device__ __forceinline__ unsigned row_tok(const Unit&, int) const { return 0; }
};
template <bool GATHER_> struct MoeOrder {
    static constexpr bool GATHER = GATHER_;
    const char* A; const char* B; const int* tile_e; const int* slot_tok; int nM, nN, G, c; size_t tstep, estep;
    __device__ __forceinline__ void init(const void* A_, const void* B_, const int* tile_e_, const int* slot_tok_, int ntiles, int Nper, int Kbytes, int G_, int c_) {
        A = (const char*)A_; B = (const char*)B_; tile_e = tile_e_; slot_tok = slot_tok_; nM = ntiles; nN = Nper / BM; G = G_; c = c_; tstep = (size_t)BM * Kbytes; estep = (size_t)Nper * Kbytes; }
    __device__ __forceinline__ bool next(int i, Unit& u) const { if (!static_tile(i, G, c, nM, nN, u.pm, u.pn)) return false;
        u.e = __builtin_amdgcn_readfirstlane(tile_e[u.pm]); u.A = GATHER_ ? A : A + (size_t)u.pm * tstep; u.B = B + (size_t)u.e * estep + (size_t)u.pn * tstep; return true; }
    __device__ __forceinline__ unsigned row_tok(const Unit& u, int r) const { return (unsigned)slot_tok[u.pm * BM + r]; }
};

struct EpiBf16 {
    static constexpr bool PERM = true; static constexpr int WSCALE = 127;
    bf16* O; int ldc;
    __device__ __forceinline__ void operator()(const f32x4 (&acc)[2][2][4][2], const Unit& u, int wr, int wc, int fr, int fq) const {
        const int row0 = u.pm * BM + wr * 64 + fr, col0 = u.pn * BM + wc * 32 + 8 * fq;
#pragma unroll
        for (int ai = 0; ai < 2; ++ai)
#pragma unroll
            for (int m = 0; m < 4; ++m) { bf16* rowp = O + (size_t)(row0 + ai * HALF + m * 16) * ldc + col0;
#pragma unroll
                for (int bj = 0; bj < 2; ++bj) { const f32x4 v0 = acc[ai][bj][m][0], v1 = acc[ai][bj][m][1];
                    u32x4 w; w.x = cvt_pk_bf16(v0[0], v0[1]); w.y = cvt_pk_bf16(v0[2], v0[3]); w.z = cvt_pk_bf16(v1[0], v1[1]); w.w = cvt_pk_bf16(v1[2], v1[3]);
                    *(u32x4*)(rowp + bj * HALF) = w; } }
    }
};
struct EpiSwiglu {
    static constexpr bool PERM = false; static constexpr int WSCALE = 123;
    unsigned char* H; const float* bias;
    __device__ __forceinline__ void operator()(const f32x4 (&acc)[2][2][4][2], const Unit& u, int wr, int wc, int fr, int fq) const {
        const int row0 = u.pm * BM + wr * 64 + fr, colh = u.pn * 128 + wc * 32 + 8 * fq;
        const float* bp = bias + (size_t)u.e * 2048 + u.pn * 256 + wc * 32 + 4 * fq;
        f32x4 bv[2][2];
#pragma unroll
        for (int bj = 0; bj < 2; ++bj)
#pragma unroll
            for (int n = 0; n < 2; ++n) bv[bj][n] = *(const f32x4*)(bp + bj * HALF + n * 16);
#pragma unroll
        for (int ai = 0; ai < 2; ++ai)
#pragma unroll
            for (int m = 0; m < 4; ++m) { unsigned char* rowp = H + (size_t)(row0 + ai * HALF + m * 16) * FF + colh;
                float o[8];
#pragma unroll
                for (int n = 0; n < 2; ++n) { const f32x4 g4 = acc[ai][0][m][n] + bv[0][n], u4 = acc[ai][1][m][n] + bv[1][n];
#pragma unroll
                    for (int j = 0; j < 4; ++j) { const float g = fminf(g4[j], 7.0f), up = fminf(fmaxf(u4[j], -7.0f), 7.0f);
                        const float glu = g * __builtin_amdgcn_rcpf(1.0f + __builtin_amdgcn_exp2f(g * (-1.702f * 1.4426950408889634f)));
                        o[n * 4 + j] = (up + 1.0f) * glu; } }
                int w0 = __builtin_amdgcn_cvt_pk_fp8_f32(o[0], o[1], 0, false); w0 = __builtin_amdgcn_cvt_pk_fp8_f32(o[2], o[3], w0, true);
                int w1 = __builtin_amdgcn_cvt_pk_fp8_f32(o[4], o[5], 0, false); w1 = __builtin_amdgcn_cvt_pk_fp8_f32(o[6], o[7], w1, true);
                *(u32x2*)rowp = (u32x2){(unsigned)w0, (unsigned)w1}; }
    }
};
struct EpiDown {
    static constexpr bool PERM = true; static constexpr int WSCALE = 122;
    bf16* Y; const float* bias; const float* slot_gate;
    __device__ __forceinline__ void operator()(const f32x4 (&acc)[2][2][4][2], const Unit& u, int wr, int wc, int fr, int fq) const {
        const int row0 = u.pm * BM + wr * 64 + fr, col0 = u.pn * BM + wc * 32 + 8 * fq;
        const float* bp = bias + (size_t)u.e * 1024 + col0;
        f32x4 bv[2][2];
#pragma unroll
        for (int bj = 0; bj < 2; ++bj)
#pragma unroll
            for (int n = 0; n < 2; ++n) bv[bj][n] = *(const f32x4*)(bp + bj * HALF + 4 * n);
#pragma unroll
        for (int ai = 0; ai < 2; ++ai)
#pragma unroll
            for (int m = 0; m < 4; ++m) { const int row = row0 + ai * HALF + m * 16; const float g = slot_gate[row]; bf16* rowp = Y + (size_t)row * D + col0;
#pragma unroll
                for (int bj = 0; bj < 2; ++bj) { const f32x4 v0 = (acc[ai][bj][m][0] + bv[bj][0]) * g, v1 = (acc[ai][bj][m][1] + bv[bj][1]) * g;
                    u32x4 w; w.x = cvt_pk_bf16(v0[0], v0[1]); w.y = cvt_pk_bf16(v0[2], v0[3]); w.z = cvt_pk_bf16(v1[0], v1[1]); w.w = cvt_pk_bf16(v1[2], v1[3]);
                    *(u32x4*)(rowp + bj * HALF) = w; } }
    }
};

template <class Epi, class Sched, int ES = 2, bool ALIGN_EPI = true>
__device__ __forceinline__ void gemm_phase(LAS unsigned char* lds, const int K, const Sched& S, const Epi& E) {
    constexpr bool GA = Sched::GATHER;
    const int tid = opaque_tid(), wid = __builtin_amdgcn_readfirstlane(tid >> 6), lane = tid & 63, wr = wid >> 2, wc = wid & 3, fr = lane & 15, fq = lane >> 4;
    const int nt = K * ES / (BK * 2);
    unsigned voffA[2], voffB[2]; int Rr[2]; unsigned Cb[2];
#pragma unroll
    for (int i = 0; i < 2; ++i) { int R, C; stage_rc(tid * 16 + i * 8192, R, C); const int Rb = Epi::PERM ? ((R & ~31) + perm32(R & 31)) : R;
        voffA[i] = (unsigned)(R * K * ES + C * 2); voffB[i] = (unsigned)(Rb * K * ES + C * 2); Rr[i] = R; Cb[i] = (unsigned)C * 2u; }
    const size_t kstep = (size_t)(BK * 2);
    const size_t hstep = (size_t)HALF * K * ES;
    const unsigned ldsw = (unsigned)wid * 1024u;
    const int aoff0 = lds_byte(wr * 64 + fr, fq * 8), aoff1 = lds_byte(wr * 64 + fr, fq * 8 + 32);
    const int boff0 = lds_byte(wc * 32 + fr, fq * 8), boff1 = lds_byte(wc * 32 + fr, fq * 8 + 32);
    unsigned cOff[2][2], nOff[2][2], sOff[2][2];
#define PG8_SA(b, h) (((b) * 2 + (h)) * HTB)
#define PG8_SB(b, h) ((4 + (b) * 2 + (h)) * HTB)
#define PG8_STAGE(bufoff, gbase, voff) do { _Pragma("unroll") for (int _i = 0; _i < 2; ++_i) \
        __builtin_amdgcn_global_load_lds((const unsigned*)((const char*)(gbase) + (voff)[_i]), (LAS unsigned*)(lds + (bufoff) + ldsw + _i * 8192), 16, 0, 0); } while (0)
#define PG8_STAGE_A(bufoff, gbase, half, OFF) do { if constexpr (GA) { PG8_STAGE(bufoff, gbase, (OFF)[half]); } else { PG8_STAGE(bufoff, (gbase) + (half) * hstep, voffA); } } while (0)
#define PG8_LDA(dst, b, h) do { if constexpr (ES == 2) { _Pragma("unroll") for (int m = 0; m < 4; ++m) _Pragma("unroll") for (int k = 0; k < 2; ++k) dst[m][k] = *(const LAS bf16x8*)(lds + PG8_SA(b, h) + (k ? aoff1 : aoff0) + m * 2048); } \
        else { _Pragma("unroll") for (int m = 0; m < 4; ++m) dst##8[m] = __builtin_shufflevector(*(const LAS v4i_t*)(lds + PG8_SA(b, h) + aoff0 + m * 2048), *(const LAS v4i_t*)(lds + PG8_SA(b, h) + aoff1 + m * 2048), 0, 1, 2, 3, 4, 5, 6, 7); } } while (0)
#define PG8_LDB(dst, b, h) do { if constexpr (ES == 2) { _Pragma("unroll") for (int n = 0; n < 2; ++n) _Pragma("unroll") for (int k = 0; k < 2; ++k) dst[n][k] = *(const LAS bf16x8*)(lds + PG8_SB(b, h) + (k ? boff1 : boff0) + n * 2048); } \
        else { _Pragma("unroll") for (int n = 0; n < 2; ++n) dst##8[n] = __builtin_shufflevector(*(const LAS v4i_t*)(lds + PG8_SB(b, h) + boff0 + n * 2048), *(const LAS v4i_t*)(lds + PG8_SB(b, h) + boff1 + n * 2048), 0, 1, 2, 3, 4, 5, 6, 7); } } while (0)
#define PG8_MMA(ai, bj, At, Bt) do { __builtin_amdgcn_s_setprio(1); _Pragma("unroll") for (int m = 0; m < 4; ++m) _Pragma("unroll") for (int n = 0; n < 2; ++n) { \
        if constexpr (ES == 2) { _Pragma("unroll") for (int k = 0; k < 2; ++k) acc[ai][bj][m][n] = __builtin_amdgcn_mfma_f32_16x16x32_bf16(Bt[n][k], At[m][k], acc[ai][bj][m][n], 0, 0, 0); } \
        else { asm volatile("v_mfma_scale_f32_16x16x128_f8f6f4 %0, %1, %2, %0, %3, %4 op_sel_hi:[0,0,0]" : "+v"(acc[ai][bj][m][n]) : "v"(Bt##8[n]), "v"(At##8[m]), "v"(wscale_v), "v"(ascale_v)); } } \
        __builtin_amdgcn_s_setprio(0); } while (0)
#define PG8_WAIT_V(n) asm volatile("s_waitcnt vmcnt(" #n ")" ::: "memory")
#define PG8_WAIT_L(n) asm volatile("s_waitcnt lgkmcnt(" #n ")" ::: "memory")
#define PG8_BAR __builtin_amdgcn_s_barrier()
#define PG8_SCHED __builtin_amdgcn_sched_barrier(0)
#define PG8_GOFF(dst, u) do { if constexpr (GA) { _Pragma("unroll") for (int _h = 0; _h < 2; ++_h) _Pragma("unroll") for (int _i = 0; _i < 2; ++_i) \
        dst[_h][_i] = S.row_tok(u, _h * HALF + Rr[_i]) * (unsigned)(K * ES) + Cb[_i]; } } while (0)
    Unit cur, nxt; int ui = 0;
    if (!S.next(0, cur)) return;
    f32x4 acc[2][2][4][2];
#pragma unroll
    for (int a = 0; a < 2; ++a)
#pragma unroll
        for (int b = 0; b < 2; ++b)
#pragma unroll
            for (int m = 0; m < 4; ++m)
#pragma unroll
                for (int n = 0; n < 2; ++n) acc[a][b][m][n] = (f32x4){0.f, 0.f, 0.f, 0.f};
    int wscale_v = Epi::WSCALE, ascale_v = 127; asm volatile("" : "+v"(wscale_v), "+v"(ascale_v));
    bf16x8 At[4][2], B0[2][2], B1[2][2];
    v8i_t At8[4], B08[2], B18[2];
    const char* cA = cur.A; const char* cB = cur.B;
    PG8_GOFF(cOff, cur);
#pragma unroll
    for (int h = 0; h < 2; ++h)
#pragma unroll
        for (int i = 0; i < 2; ++i) { nOff[h][i] = 0u; sOff[h][i] = 0u; }
    if constexpr (GA) { VM_WAIT(); }
    PG8_STAGE(PG8_SB(0, 0), cB, voffB); PG8_STAGE(PG8_SB(0, 1), cB + hstep, voffB); PG8_STAGE_A(PG8_SA(0, 0), cA, 0, cOff); PG8_STAGE_A(PG8_SA(0, 1), cA, 1, cOff);
    if (wr == 1) PG8_BAR;
    PG8_WAIT_V(2); PG8_BAR;
    PG8_STAGE(PG8_SB(1, 0), cB + kstep, voffB); PG8_STAGE_A(PG8_SA(1, 0), cA + kstep, 0, cOff); PG8_STAGE(PG8_SB(1, 1), cB + hstep + kstep, voffB);
    PG8_WAIT_V(6); PG8_BAR;
    for (;;) {
        const bool has_next = S.next(ui + 1, nxt);
        const char* nA = has_next ? nxt.A : cA; const char* nB = has_next ? nxt.B : cB;
        if constexpr (GA) { if (has_next) { PG8_GOFF(nOff, nxt); } else {
#pragma unroll
            for (int h = 0; h < 2; ++h)
#pragma unroll
                for (int i = 0; i < 2; ++i) nOff[h][i] = cOff[h][i]; } }
#pragma unroll 1
        for (int t = 0; t < nt; t += 2) {
            const bool last = (t == nt - 2);
            const char* a1 = cA + (size_t)(t + 1) * kstep;
            const char* a2 = last ? nA : cA + (size_t)(t + 2) * kstep; const char* b2 = last ? nB : cB + (size_t)(t + 2) * kstep;
            const char* a3 = a2 + kstep; const char* b3 = b2 + kstep;
            if constexpr (GA) {
#pragma unroll
                for (int h = 0; h < 2; ++h)
#pragma unroll
                    for (int i = 0; i < 2; ++i) sOff[h][i] = last ? nOff[h][i] : cOff[h][i]; }
            PG8_LDB(B0, 0, 0); PG8_LDB(B1, 0, 1); PG8_SCHED; PG8_LDA(At, 0, 0); PG8_STAGE_A(PG8_SA(1, 1), a1, 1, cOff);
            PG8_WAIT_V(8); PG8_WAIT_L(0); PG8_BAR; PG8_MMA(0, 0, At, B0); PG8_MMA(0, 1, At, B1); PG8_BAR; PG8_SCHED;
            PG8_LDA(At, 0, 1); PG8_STAGE(PG8_SB(0, 0), b2, voffB); PG8_STAGE(PG8_SB(0, 1), b2 + hstep, voffB); PG8_STAGE_A(PG8_SA(0, 0), a2, 0, sOff);
            PG8_WAIT_V(8); PG8_WAIT_L(0); PG8_BAR; PG8_MMA(1, 0, At, B0); PG8_MMA(1, 1, At, B1); PG8_BAR; PG8_SCHED;
            PG8_LDB(B0, 1, 0); PG8_LDB(B1, 1, 1); PG8_SCHED; PG8_LDA(At, 1, 0); PG8_STAGE_A(PG8_SA(0, 1), a2, 1, sOff);
            PG8_WAIT_V(8); PG8_WAIT_L(0); PG8_BAR; PG8_MMA(0, 0, At, B0); PG8_MMA(0, 1, At, B1); PG8_BAR; PG8_SCHED;
            PG8_LDA(At, 1, 1); PG8_STAGE(PG8_SB(1, 0), b3, voffB); PG8_STAGE(PG8_SB(1, 1), b3 + hstep, voffB); PG8_STAGE_A(PG8_SA(1, 0), a3, 0, sOff);
            PG8_WAIT_V(8); PG8_WAIT_L(0); PG8_BAR; PG8_MMA(1, 0, At, B0); PG8_MMA(1, 1, At, B1); PG8_BAR; PG8_SCHED;
        }
        if constexpr (ALIGN_EPI) { if (wr == 0) PG8_BAR; }
        if constexpr (ES == 1) { asm volatile("s_nop 15\n\ts_nop 15" ::: "memory"); }
        E(acc, cur, wr, wc, fr, fq);
        if (!has_next) break;
#pragma unroll
        for (int a = 0; a < 2; ++a)
#pragma unroll
            for (int b = 0; b < 2; ++b)
#pragma unroll
                for (int m = 0; m < 4; ++m)
#pragma unroll
                    for (int n = 0; n < 2; ++n) acc[a][b][m][n] = (f32x4){0.f, 0.f, 0.f, 0.f};
        cur = nxt; cA = nA; cB = nB; ++ui;
        if constexpr (GA) {
#pragma unroll
            for (int h = 0; h < 2; ++h)
#pragma unroll
                for (int i = 0; i < 2; ++i) cOff[h][i] = nOff[h][i]; }
        if constexpr (ALIGN_EPI) { if (wr == 1) PG8_BAR; }
    }
    PG8_WAIT_V(0);
    if constexpr (!ALIGN_EPI) { if (wr == 0) PG8_BAR; }
    PG8_BAR;
#undef PG8_SA
#undef PG8_SB
#undef PG8_STAGE
#undef PG8_STAGE_A
#undef PG8_LDA
#undef PG8_LDB
#undef PG8_MMA
#undef PG8_WAIT_V
#undef PG8_WAIT_L
#undef PG8_BAR
#undef PG8_SCHED
#undef PG8_GOFF
}
}

#define XB_TMO      128
#define XB_XCNT(j)  (256  + 64 * (j))
#define XB_XSUB(j)  (1280 + 64 * (j))
#define XB_XGEN(j)  (2304 + 64 * (j))
#define XB_TOP      3328
#define XB_TOPGEN   3392
#define XCD_BAR_WORDS 3456
#define XB_SPIN_CAP (1u << 18)
__device__ __forceinline__ unsigned xb_ld(unsigned* p)              { return __hip_atomic_load(p, __ATOMIC_RELAXED, __HIP_MEMORY_SCOPE_AGENT); }
__device__ __forceinline__ unsigned xb_add(unsigned* p, unsigned v) { return __hip_atomic_fetch_add(p, v, __ATOMIC_RELAXED, __HIP_MEMORY_SCOPE_AGENT); }
__device__ __forceinline__ unsigned xb_xcc_id() { return (unsigned)__builtin_amdgcn_s_getreg((3 << 11) | 20) & 0xFu; }
#define XB_SPIN(cond, bar) do { unsigned _sp = 0; while (cond) { __builtin_amdgcn_s_sleep(1); \
    if ((++_sp & 255u) == 0u) { if (xb_ld(&(bar)[XB_TMO])) break; if (_sp > XB_SPIN_CAP) { atomicAdd(&(bar)[XB_TMO], 1u); break; } } } } while (0)
struct XcdBarrier { unsigned* bar; unsigned x; volatile LAS unsigned* st; };
__device__ __forceinline__ XcdBarrier xcd_barrier_post(unsigned* bar, volatile LAS unsigned* st) {
    XcdBarrier b; b.bar = bar; b.x = xb_xcc_id(); b.st = st;
    if (threadIdx.x == 0) (void)xb_add(&bar[XB_XCNT(b.x)], 1u);
    return b;
}
__device__ __forceinline__ void xcd_barrier_complete(unsigned* bar, unsigned x, unsigned& nloc, unsigned& nx) {
    const unsigned G = gridDim.x * gridDim.y * gridDim.z;
    unsigned sum, cnt, mine, sp = 0u;
    for (;;) {
        sum = 0u; cnt = 0u; mine = 0u;
#pragma unroll
        for (unsigned j = 0; j < 16; ++j) { const unsigned c = xb_ld(&bar[XB_XCNT(j)]); sum += c; cnt += (c > 0u) ? 1u : 0u; mine = (j == x) ? c : mine; }
        if (sum == G) break;
        __builtin_amdgcn_s_sleep(1);
        if ((++sp & 255u) == 0u) { if (xb_ld(&bar[XB_TMO])) break; if (sp > XB_SPIN_CAP) { atomicAdd(&bar[XB_TMO], 1u); break; } }
    }
    nloc = mine > 0u ? mine : 1u; nx = cnt > 0u ? cnt : 1u;
}
__device__ __forceinline__ void xcd_barrier(const XcdBarrier& b) {
    asm volatile("s_waitcnt vmcnt(0)" ::: "memory");
    __syncthreads();
    if (threadIdx.x == 0) {
        unsigned* bar = b.bar;
        __builtin_amdgcn_s_waitcnt(0);
        unsigned nloc = b.st[0], nx = b.st[1];
        if (nloc == 0u) { xcd_barrier_complete(bar, b.x, nloc, nx); b.st[0] = nloc; b.st[1] = nx; }
        const unsigned old = xb_add(&bar[XB_XSUB(b.x)], 1u);
        const unsigned gen = old / nloc;
        if (old + 1u == (gen + 1u) * nloc) {
            __builtin_amdgcn_fence(__ATOMIC_RELEASE, "agent");
            asm volatile("s_waitcnt vmcnt(0)" ::: "memory");
            const unsigned og = xb_add(&bar[XB_TOP], 1u);
            const unsigned tg = og / nx;
            if (og + 1u == (tg + 1u) * nx) xb_add(&bar[XB_TOPGEN], 1u);
            else XB_SPIN(xb_ld(&bar[XB_TOPGEN]) == tg, bar);
            __builtin_amdgcn_fence(__ATOMIC_ACQUIRE, "agent");
            xb_add(&bar[XB_XGEN(b.x)], 1u);
            asm volatile("s_waitcnt vmcnt(0)" ::: "memory");
        } else {
            XB_SPIN(xb_ld(&bar[XB_XGEN(b.x)]) == gen, bar);
            __builtin_amdgcn_fence(__ATOMIC_ACQUIRE, "agent");
            asm volatile("s_waitcnt vmcnt(0)" ::: "memory");
        }
    }
    __syncthreads();
}

struct Args {
    const float* in[33];
    float* out; unsigned char* ws;
    int ph_lo, ph_hi;
};
enum { I_X = 0, I_MEM, I_WIN, I_GLACONV, I_GLAW2, I_GLAB, I_GLANG, I_HGLB, I_HGNG, I_RWMU, I_RWW0, I_RWW2, I_RWA0, I_RWA2, I_RWG2, I_RWKK, I_RWKA, I_RWRK, I_RWLNW, I_RWLNB,
       I_WMK, I_WMV, I_WOUT, I_LN1G, I_LN1B, I_RTW, I_RTB, I_WGU, I_BGU, I_WDN, I_BDN, I_LN2G, I_LN2B };


template <int OFF> __device__ __forceinline__ unsigned long long ka_u64() { unsigned long long v; asm volatile("s_load_dwordx2 %0, %1, %2\n\ts_waitcnt lgkmcnt(0)" : "=s"(v) : "s"(__builtin_amdgcn_kernarg_segment_ptr()), "n"(OFF)); return v; }
#define KIN(i) ((const float*)(const GAS float*)ka_u64<8 * (i)>())
#define KOUT() ((float*)(GAS float*)ka_u64<264>())
#define KWS() ((unsigned char*)(GAS unsigned char*)ka_u64<272>())

template <class Map>
__device__ __forceinline__ void tr_item(const float* __restrict__ W, int K, int N, bf16* __restrict__ WT, LAS float* scr, int kb, int nb, int lane, Map map) {
    const int k0 = 64 * kb, n0 = 64 * nb, col = n0 + lane; const bool valid = col < N;
    const float* src = W + (size_t)k0 * N + (valid ? col : 0);
#pragma unroll 16
    for (int kk = 0; kk < 64; ++kk) { const float v = valid ? src[(size_t)kk * N] : 0.f; scr[kk * 65 + lane] = v; }
    LDS_WAIT(); asm volatile("" ::: "memory");
    const int c = lane & 7;
#pragma unroll
    for (int j = 0; j < 8; ++j) { const int n = (lane >> 3) + 8 * j;
        if (n0 + n < N) { const int orow = map(n0 + n); const LAS float* s = scr + (8 * c) * 65 + n;
            u32x4 o; o.x = pk2(s[0 * 65], s[1 * 65]); o.y = pk2(s[2 * 65], s[3 * 65]); o.z = pk2(s[4 * 65], s[5 * 65]); o.w = pk2(s[6 * 65], s[7 * 65]);
            *(u32x4*)(WT + (size_t)orow * K + k0 + 8 * c) = o; } }
    LDS_WAIT(); asm volatile("" ::: "memory");
}
template <class Map>
__device__ __forceinline__ void tr_item_f8(const float* __restrict__ W, int K, int N, unsigned char* __restrict__ WT8, LAS float* scr, int kb, int nb, int lane, float scale, Map map) {
    const int k0 = 64 * kb, n0 = 64 * nb, col = n0 + lane;
    const float* src = W + (size_t)k0 * N + col;
#pragma unroll 16
    for (int kk = 0; kk < 64; ++kk) scr[kk * 65 + lane] = src[(size_t)kk * N] * scale;
    LDS_WAIT(); asm volatile("" ::: "memory");
    const int c = lane & 3;
#pragma unroll
    for (int j = 0; j < 4; ++j) { const int n = (lane >> 2) + 16 * j; const int orow = map(n0 + n); const LAS float* s = scr + (16 * c) * 65 + n;
        u32x4 o;
#pragma unroll
        for (int q = 0; q < 4; ++q) { int w = __builtin_amdgcn_cvt_pk_fp8_f32(s[(4 * q) * 65], s[(4 * q + 1) * 65], 0, false); w = __builtin_amdgcn_cvt_pk_fp8_f32(s[(4 * q + 2) * 65], s[(4 * q + 3) * 65], w, true); o[q] = (unsigned)w; }
        *(u32x4*)(WT8 + (size_t)orow * K + k0 + 16 * c) = o; }
    LDS_WAIT(); asm volatile("" ::: "memory");
}
struct MapIdent { int off; __device__ __forceinline__ int operator()(int c) const { return c + off; } };
struct MapWin { __device__ __forceinline__ int operator()(int c) const { return c < 512 ? c : (c < 528 ? c + 2560 : c - 16); } };
__device__ __forceinline__ int gu_row(int c) { const int f = c >> 1, bj = c & 1, pn = f >> 7, fl = f & 127, wc = fl >> 5, fq = (fl >> 3) & 3, n = (fl >> 2) & 1, j = fl & 3; return 256 * pn + 128 * bj + 32 * wc + 16 * n + 4 * fq + j; }
struct MapGu { __device__ __forceinline__ int operator()(int c) const { return gu_row(c); } };

__device__ __forceinline__ void prologue_phase(LAS unsigned char* lds, int vcu, int G) {
    const int tid = opaque_tid(), lane = tid & 63, wave = __builtin_amdgcn_readfirstlane(tid >> 6);
    LAS float* scr = (LAS float*)(lds + wave * 16640); static_assert(8 * 16640 <= LDSCTL_OFF, "prologue scratch below the LDS control words");
    const int gw = vcu * NWAVES + wave, NGW = G * NWAVES;
    unsigned char* ws = KWS();
    constexpr int IT_GU = NL * NE * 512, IT_DN = NL * NE * 256, IT_IN = NL * 16 * 49, IT_OUT = NL * 256, IT_MEM = NL * 2 * 64, IT_L64 = NL * 2 * 4, IT_L128 = NL * 2 * 4;
    constexpr int IT_TOTAL = IT_GU + IT_DN + IT_IN + IT_OUT + IT_MEM + IT_L64 + IT_L128;
    for (int it = gw; it < IT_TOTAL; it += NGW) {
        int r = it;
        if (r < IT_GU) { const int le = r >> 9, q = r & 511, kb = q >> 5, nb = q & 31;
            tr_item_f8(KIN(I_WGU) + (size_t)le * 1024 * 2048, 1024, 2048, (unsigned char*)(ws + WS_WGU) + (size_t)le * 2048 * 1024, scr, kb, nb, lane, 16.0f, MapGu{}); continue; } r -= IT_GU;
        if (r < IT_DN) { const int le = r >> 8, q = r & 255, kb = q >> 4, nb = q & 15;
            tr_item_f8(KIN(I_WDN) + (size_t)le * 1024 * 1024, 1024, 1024, (unsigned char*)(ws + WS_WD) + (size_t)le * 1024 * 1024, scr, kb, nb, lane, 32.0f, MapIdent{0}); continue; } r -= IT_DN;
        if (r < IT_IN) { const int l = r / (16 * 49), q = r % (16 * 49), kb = q / 49, nb = q % 49;
            tr_item(KIN(I_WIN) + (size_t)l * 1024 * PIN, 1024, PIN, (bf16*)(ws + WS_WIN) + (size_t)l * PINP * 1024, scr, kb, nb, lane, MapWin{}); continue; } r -= IT_IN;
        if (r < IT_OUT) { const int l = r >> 8, q = r & 255, kb = q >> 4, nb = q & 15;
            tr_item(KIN(I_WOUT) + (size_t)l * 1024 * 1024, 1024, 1024, (bf16*)(ws + WS_WOUT) + (size_t)l * 1024 * 1024, scr, kb, nb, lane, MapIdent{0}); continue; } r -= IT_OUT;
        if (r < IT_MEM) { const int l = r >> 7, q = r & 127, kv = q >> 6, kb = (q >> 2) & 15, nb = q & 3;
            tr_item((kv ? KIN(I_WMV) : KIN(I_WMK)) + (size_t)l * 1024 * 256, 1024, 256, (bf16*)(ws + WS_WMEM), scr, kb, nb, lane, MapIdent{l * 512 + kv * 256}); continue; } r -= IT_MEM;
        if (r < IT_L64) { const int l = r >> 3, q = r & 7, wa = q >> 2, nb = q & 3;
            tr_item((wa ? KIN(I_RWA2) : KIN(I_RWW2)) + (size_t)l * 64 * 256, 64, 256, (bf16*)(ws + WS_LORA) + (size_t)wa * (NL * 256 * 64) + (size_t)l * 256 * 64, scr, 0, nb, lane, MapIdent{0}); continue; } r -= IT_L64;
        { const int l = r >> 3, q = r & 7, kb = q >> 2, nb = q & 3;
            tr_item(KIN(I_RWG2) + (size_t)l * 128 * 256, 128, 256, (bf16*)(ws + WS_LORA) + (size_t)2 * (NL * 256 * 64) + (size_t)l * 256 * 128, scr, kb, nb, lane, MapIdent{0}); }
    }
    { const size_t gt = (size_t)vcu * NTHR + tid, GT = (size_t)G * NTHR; constexpr size_t per = (size_t)(PINP - PIN) * 1024 / 8;
        for (size_t i = gt; i < per * NL; i += GT) { const size_t l = i / per, j = i % per; *(u32x4*)((bf16*)(ws + WS_WIN) + l * PINP * 1024 + (size_t)PIN * 1024 + j * 8) = (u32x4){0u, 0u, 0u, 0u}; }
        for (size_t i = gt; i < (size_t)NL * NE * 2048; i += GT) { const size_t le = i >> 11; const int c = (int)(i & 2047); ((float*)(ws + WS_BGU))[le * 2048 + gu_row(c)] = KIN(I_BGU)[i]; }
        const f32x4* xs = (const f32x4*)KIN(I_X); u32x4* xd = (u32x4*)(ws + WS_XB);
        for (size_t i = gt; i < (size_t)NTOK * D / 8; i += GT) { const f32x4 v0 = xs[2 * i], v1 = xs[2 * i + 1]; xd[i] = (u32x4){pk2(v0[0], v0[1]), pk2(v0[2], v0[3]), pk2(v1[0], v1[1]), pk2(v1[2], v1[3])}; }
        const f32x4* ms = (const f32x4*)KIN(I_MEM); u32x4* md = (u32x4*)(ws + WS_MEMB);
        for (size_t i = gt; i < (size_t)NB * NMEM * D / 8; i += GT) { const f32x4 v0 = ms[2 * i], v1 = ms[2 * i + 1]; md[i] = (u32x4){pk2(v0[0], v0[1]), pk2(v0[2], v0[3]), pk2(v1[0], v1[1]), pk2(v1[2], v1[3])}; }
    }
}


__device__ __forceinline__ float log1pexp_neg_abs(float z) { return __builtin_amdgcn_logf(1.0f + fast_exp(-fabsf(z))) * 0.6931471805599453f; }
__device__ __forceinline__ float tanh_f(float x) { const float e = fast_exp(-2.0f * fabsf(x)); const float t = (1.0f - e) * __builtin_amdgcn_rcpf(1.0f + e); return x < 0.f ? -t : t; }

constexpr int NCH = T / 32;
__device__ __forceinline__ int rho16(int r, int hh) { return (r & 3) + 8 * (r >> 2) + 4 * hh; }
__device__ __forceinline__ void hg_fused_unit(LAS unsigned char* lds, int l, int b, int c) {
    const int tid = opaque_tid(), lane = tid & 63, wave = __builtin_amdgcn_readfirstlane(tid >> 6), r32 = lane & 31, hh = lane >> 5;
    unsigned char* ws = KWS();
    const bf16* P = (const bf16*)(ws + WS_P) + ((size_t)b * T + c * 32) * PINP;
    constexpr int HB = 16640;
    if (tid < 256) {
        const int ch = tid, h = ch >> 6, d = ch & 63; const size_t un = (size_t)(b * 4 + h) * NCH + c;
        float lb;
        { const float* hp = KIN(I_HGLB) + ch; const float v0 = hp[0], v1 = hp[256], v2 = hp[512], v3 = hp[768]; const float m = fmaxf(fmaxf(v0, v1), fmaxf(v2, v3));
          const float e0 = __expf(v0 - m), e1 = __expf(v1 - m), e2 = __expf(v2 - m), e3 = __expf(v3 - m); const float inv = 1.0f / (e0 + e1 + e2 + e3);
          lb = (l >= 1 ? e1 : 0.f) + (l >= 2 ? e2 : 0.f) + (l >= 3 ? e3 : 0.f); lb *= inv; }
        const float oml = 1.0f - lb;
        LAS bf16* KT = (LAS bf16*)(lds + h * HB); LAS float* BE = (LAS float*)(lds + h * HB + 8192);
        LAS bf16* QL = (LAS bf16*)(lds + h * HB + 8448) + d; LAS bf16* KL = (LAS bf16*)(lds + h * HB + 12544) + d;
        float bc = 0.f;
        unsigned short hqr[32], hfr[32];
#pragma unroll
        for (int t = 0; t < 32; ++t) { const bf16* row = P + (size_t)t * PINP; hqr[t] = row[PC_HQ + ch]; hfr[t] = row[PC_HF + ch]; }
#pragma unroll
        for (int t8 = 0; t8 < 4; ++t8) { u32x4 kp;
#pragma unroll
            for (int jj = 0; jj < 4; ++jj) { float k2[2];
#pragma unroll
                for (int e = 0; e < 2; ++e) { const int t = t8 * 8 + jj * 2 + e; const float hf = bf2f(hfr[t]); const float s = fast_sigmoid(hf), sn = fast_sigmoid(-hf);
                    bc = fmaxf(bc + __builtin_amdgcn_logf(fmaxf(lb + oml * s, 1e-30f)) * 0.6931471805599453f, -80.0f);
                    const float qt = silu_f(bf2f(hqr[t])) * fast_exp(bc), kt = oml * sn * fast_exp(-bc);
                    QL[t * 64] = (bf16)f2bf(qt); KL[t * 64] = (bf16)f2bf(kt); k2[e] = kt; }
                kp[jj] = pk2(k2[0], k2[1]); }
            *(LAS u32x4*)(KT + d * 32 + t8 * 8) = kp; }
        const float ebend = fast_exp(bc); BE[d] = ebend; ((float*)(ws + WS_HBE))[un * 64 + d] = ebend;
    } else {
        const int cv = tid - 256, h = cv >> 6, vi = cv & 63; const size_t un = (size_t)(b * 4 + h) * NCH + c;
        LAS bf16* VT = (LAS bf16*)(lds + h * HB + 4096); bf16* VTg = (bf16*)(ws + WS_HVT) + un * 2048 + vi * 32;
        unsigned short hvr[32];
#pragma unroll
        for (int t = 0; t < 32; ++t) hvr[t] = P[(size_t)t * PINP + PC_HI + cv];
#pragma unroll
        for (int t8 = 0; t8 < 4; ++t8) { u32x4 vp;
#pragma unroll
            for (int jj = 0; jj < 4; ++jj) vp[jj] = (unsigned)hvr[t8 * 8 + 2 * jj] | ((unsigned)hvr[t8 * 8 + 2 * jj + 1] << 16);
            *(LAS u32x4*)(VT + vi * 32 + t8 * 8) = vp; *(u32x4*)(VTg + t8 * 8) = vp; }
    }
    lds_barrier();
    { const int h = wave >> 1, vt = wave & 1; const size_t un = (size_t)(b * 4 + h) * NCH + c;
      const LAS bf16* KT = (const LAS bf16*)(lds + h * HB); const LAS bf16* VT = (const LAS bf16*)(lds + h * HB + 4096); const LAS float* BE = (const LAS float*)(lds + h * HB + 8192);
      float* DSg = (float*)(ws + WS_HDS) + un * 4096;
      { const LAS bf16* srcL = (const LAS bf16*)(lds + h * HB + (vt == 0 ? 8448 : 12544)); u32x4* dstG = (u32x4*)((bf16*)(ws + (vt == 0 ? WS_HQ : WS_HK)) + un * 2048);
#pragma unroll
        for (int i = 0; i < 4; ++i) dstG[i * 64 + lane] = *(const LAS u32x4*)(srcL + (i * 64 + lane) * 8); }
#pragma unroll
      for (int dt = 0; dt < 2; ++dt) { f32x16 acc;
#pragma unroll
          for (int i = 0; i < 16; ++i) acc[i] = 0.f;
#pragma unroll
          for (int s = 0; s < 2; ++s) { const bf16x8 A = *(const LAS bf16x8*)(VT + (32 * vt + r32) * 32 + 16 * s + 8 * hh), B = *(const LAS bf16x8*)(KT + (32 * dt + r32) * 32 + 16 * s + 8 * hh);
              acc = __builtin_amdgcn_mfma_f32_32x32x16_bf16(A, B, acc, 0, 0, 0); }
          const float ebd = BE[32 * dt + r32];
#pragma unroll
          for (int r = 0; r < 16; ++r) DSg[(32 * vt + rho16(r, hh)) * 64 + 32 * dt + r32] = acc[r] * ebd; } }
    lds_barrier();
}
__device__ __forceinline__ void gla_fused_unit(LAS unsigned char* lds, int l, int b, int c) {
    const int tid = opaque_tid(), lane = tid & 63, wave = __builtin_amdgcn_readfirstlane(tid >> 6), r32 = lane & 31, hh = lane >> 5;
    unsigned char* ws = KWS();
    const int t0 = c * 32;
    const bf16* P = (const bf16*)(ws + WS_P) + ((size_t)b * T + t0) * PINP;
    LAS float* GL = (LAS float*)lds;
    constexpr int HB = 10368, H0 = 2048;
    GL[tid] = bf2f(P[(size_t)(tid >> 4) * PINP + PC_GLR + (tid & 15)]);
    lds_barrier();
    if (tid < 128) {
        const int ch = tid, h = ch >> 5, d = ch & 31; const size_t un = (size_t)(b * 4 + h) * NCH + c;
        const float* cw = KIN(I_GLACONV) + (size_t)l * 4 * 512 + ch;
        const float q0 = cw[0], q1 = cw[512], q2 = cw[1024], q3 = cw[1536], k0 = cw[128], k1 = cw[640], k2w = cw[1152], k3 = cw[1664];
        const float* w2p = KIN(I_GLAW2) + (size_t)l * 16 * 128 + ch; float wc[16];
#pragma unroll
        for (int r = 0; r < 16; ++r) wc[r] = w2p[r * 128];
        const float gb = KIN(I_GLAB)[l * 128 + ch];
        float uq0 = 0.f, uq1 = 0.f, uq2 = 0.f, uk0 = 0.f, uk1 = 0.f, uk2 = 0.f;
        if (t0 > 0) { uq0 = bf2f(*(P - 3 * PINP + PC_GQ + ch)); uq1 = bf2f(*(P - 2 * PINP + PC_GQ + ch)); uq2 = bf2f(*(P - PINP + PC_GQ + ch));
                      uk0 = bf2f(*(P - 3 * PINP + PC_GK + ch)); uk1 = bf2f(*(P - 2 * PINP + PC_GK + ch)); uk2 = bf2f(*(P - PINP + PC_GK + ch)); }
        LAS bf16* KT = (LAS bf16*)(lds + H0 + h * HB); LAS float* BE = (LAS float*)(lds + H0 + h * HB + 6144);
        LAS bf16* QL = (LAS bf16*)(lds + H0 + h * HB + 6272) + d; LAS bf16* KL = (LAS bf16*)(lds + H0 + h * HB + 8320) + d;
        float bc = 0.f;
        unsigned short xqr[32], xkr[32];
#pragma unroll
        for (int t = 0; t < 32; ++t) { const bf16* row = P + (size_t)t * PINP; xqr[t] = row[PC_GQ + ch]; xkr[t] = row[PC_GK + ch]; }
#pragma unroll
        for (int t8 = 0; t8 < 4; ++t8) { u32x4 kp;
#pragma unroll
            for (int jj = 0; jj < 4; ++jj) { float kk2[2];
#pragma unroll
                for (int e = 0; e < 2; ++e) { const int t = t8 * 8 + jj * 2 + e; const float uq3 = bf2f(xqr[t]), uk3 = bf2f(xkr[t]);
                    const float q = silu_f(q0 * uq0 + q1 * uq1 + q2 * uq2 + q3 * uq3) * 0.17677669529663687f, k = silu_f(k0 * uk0 + k1 * uk1 + k2w * uk2 + k3 * uk3);
                    uq0 = uq1; uq1 = uq2; uq2 = uq3; uk0 = uk1; uk1 = uk2; uk2 = uk3;
                    float z = gb;
#pragma unroll
                    for (int r = 0; r < 16; ++r) z += GL[t * 16 + r] * wc[r];
                    bc = fmaxf(bc + (fminf(z, 0.f) - log1pexp_neg_abs(z)) * 0.0625f, -80.0f);
                    const float qt = q * fast_exp(bc), kt = k * fast_exp(-bc);
                    QL[t * 32] = (bf16)f2bf(qt); KL[t * 32] = (bf16)f2bf(kt); kk2[e] = kt; }
                kp[jj] = pk2(kk2[0], kk2[1]); }
            *(LAS u32x4*)(KT + d * 32 + t8 * 8) = kp; }
        const float ebend = fast_exp(bc); BE[d] = ebend; ((float*)(ws + WS_GBE))[un * 32 + d] = ebend;
    } else if (tid < 384) {
        const int cv = tid - 128, h = cv >> 6, vi = cv & 63; const size_t un = (size_t)(b * 4 + h) * NCH + c;
        const float* cw = KIN(I_GLACONV) + (size_t)l * 4 * 512 + 256 + cv;
        const float w0 = cw[0], w1 = cw[512], w2 = cw[1024], w3 = cw[1536];
        float u0 = 0.f, u1 = 0.f, u2 = 0.f;
        if (t0 > 0) { u0 = bf2f(*(P - 3 * PINP + PC_GV + cv)); u1 = bf2f(*(P - 2 * PINP + PC_GV + cv)); u2 = bf2f(*(P - PINP + PC_GV + cv)); }
        LAS bf16* VT = (LAS bf16*)(lds + H0 + h * HB + 2048); bf16* VTg = (bf16*)(ws + WS_GVT) + un * 2048 + vi * 32;
        unsigned short xvr[32];
#pragma unroll
        for (int t = 0; t < 32; ++t) xvr[t] = P[(size_t)t * PINP + PC_GV + cv];
#pragma unroll
        for (int t8 = 0; t8 < 4; ++t8) { u32x4 vp; float yv[8];
#pragma unroll
            for (int e = 0; e < 8; ++e) { const float u3 = bf2f(xvr[t8 * 8 + e]); yv[e] = silu_f(w0 * u0 + w1 * u1 + w2 * u2 + w3 * u3); u0 = u1; u1 = u2; u2 = u3; }
#pragma unroll
            for (int jj = 0; jj < 4; ++jj) vp[jj] = pk2(yv[2 * jj], yv[2 * jj + 1]);
            *(LAS u32x4*)(VT + vi * 32 + t8 * 8) = vp; *(u32x4*)(VTg + t8 * 8) = vp; }
    }
    lds_barrier();
    { const int h = wave >> 1, vt = wave & 1; const size_t un = (size_t)(b * 4 + h) * NCH + c;
      const LAS bf16* KT = (const LAS bf16*)(lds + H0 + h * HB); const LAS bf16* VT = (const LAS bf16*)(lds + H0 + h * HB + 2048); const LAS float* BE = (const LAS float*)(lds + H0 + h * HB + 6144);
      float* DSg = (float*)(ws + WS_GDS) + un * 2048;
      { const LAS bf16* srcL = (const LAS bf16*)(lds + H0 + h * HB + (vt == 0 ? 6272 : 8320)); u32x4* dstG = (u32x4*)((bf16*)(ws + (vt == 0 ? WS_GQ : WS_GK)) + un * 1024);
#pragma unroll
        for (int i = 0; i < 2; ++i) dstG[i * 64 + lane] = *(const LAS u32x4*)(srcL + (i * 64 + lane) * 8); }
      f32x16 acc;
#pragma unroll
      for (int i = 0; i < 16; ++i) acc[i] = 0.f;
#pragma unroll
      for (int s = 0; s < 2; ++s) { const bf16x8 A = *(const LAS bf16x8*)(VT + (32 * vt + r32) * 32 + 16 * s + 8 * hh), B = *(const LAS bf16x8*)(KT + r32 * 32 + 16 * s + 8 * hh);
          acc = __builtin_amdgcn_mfma_f32_32x32x16_bf16(A, B, acc, 0, 0, 0); }
      const float ebd = BE[r32];
#pragma unroll
      for (int r = 0; r < 16; ++r) DSg[(32 * vt + rho16(r, hh)) * 32 + r32] = acc[r] * ebd; }
    lds_barrier();
}
template <int DK>
__device__ __forceinline__ void m2_gh_elem2(int e2, const float* __restrict__ DS, const float* __restrict__ BE, bf16* __restrict__ SG) {
    constexpr int EPB = 64 * DK; const int e = e2 * 2, bh = e / EPB, idx = e % EPB, d = idx % DK; const size_t un0 = (size_t)bh * NCH;
    float S0 = 0.f, S1 = 0.f;
#pragma unroll 1
    for (int c0 = 0; c0 < NCH; c0 += 16) { f32x2 ds[16], be[16];
#pragma unroll
        for (int u = 0; u < 16; ++u) { ds[u] = *(const f32x2*)(DS + (un0 + c0 + u) * EPB + idx); be[u] = *(const f32x2*)(BE + (un0 + c0 + u) * DK + d); }
#pragma unroll
        for (int u = 0; u < 16; ++u) { *(unsigned*)(SG + (un0 + c0 + u) * EPB + idx) = pk2(S0, S1); S0 = S0 * be[u][0] + ds[u][0]; S1 = S1 * be[u][1] + ds[u][1]; } }
}
template <int DK>
__device__ __forceinline__ void m3_gh_task(int lane, const bf16* __restrict__ Qg, const bf16* __restrict__ Kg, const bf16* __restrict__ VTg, const bf16* __restrict__ Sg,
                                           const bf16* __restrict__ gate  , const float* __restrict__ ng  , bf16* __restrict__ orow  ) {
    const int r32 = lane & 31, hh = lane >> 5;
    bf16x8 qf[DK / 16];
    f32x16 at;
#pragma unroll
    for (int i = 0; i < 16; ++i) at[i] = 0.f;
#pragma unroll
    for (int s = 0; s < DK / 16; ++s) { qf[s] = *(const bf16x8*)(Qg + r32 * DK + 16 * s + 8 * hh); const bf16x8 kf = *(const bf16x8*)(Kg + r32 * DK + 16 * s + 8 * hh);
        at = __builtin_amdgcn_mfma_f32_32x32x16_bf16(kf, qf[s], at, 0, 0, 0); }
#pragma unroll
    for (int r = 0; r < 16; ++r) if (rho16(r, hh) > r32) at[r] = 0.f;
    f32x16 o[2];
#pragma unroll
    for (int vt = 0; vt < 2; ++vt)
#pragma unroll
        for (int i = 0; i < 16; ++i) o[vt][i] = 0.f;
#pragma unroll
    for (int s = 0; s < 2; ++s) { union { bf16x8 v; unsigned w[4]; } pf;
#pragma unroll
        for (int j = 0; j < 4; ++j) pf.w[j] = cvt_pk_bf16(at[8 * s + 2 * j], at[8 * s + 2 * j + 1]);
#pragma unroll
        for (int vt = 0; vt < 2; ++vt) { const bf16* vp = VTg + (32 * vt + r32) * 32 + 16 * s + 4 * hh;
            union { bf16x8 v; s16x4 h2[2]; } vf; vf.h2[0] = *(const s16x4*)vp; vf.h2[1] = *(const s16x4*)(vp + 8);
            o[vt] = __builtin_amdgcn_mfma_f32_32x32x16_bf16(vf.v, pf.v, o[vt], 0, 0, 0); } }
#pragma unroll
    for (int vt = 0; vt < 2; ++vt)
#pragma unroll
        for (int s = 0; s < DK / 16; ++s) { const bf16x8 sf = *(const bf16x8*)(Sg + (32 * vt + r32) * DK + 16 * s + 8 * hh);
            o[vt] = __builtin_amdgcn_mfma_f32_32x32x16_bf16(sf, qf[s], o[vt], 0, 0, 0); }
    float ss = 0.f;
#pragma unroll
    for (int vt = 0; vt < 2; ++vt)
#pragma unroll
        for (int i = 0; i < 16; ++i) ss += o[vt][i] * o[vt][i];
    ss += __shfl_xor(ss, 32);
    const float rstd = 1.0f / sqrtf(ss * (1.0f / 64.0f) + RMS_EPS);
    const bf16* grow = gate + (size_t)r32 * PINP; bf16* od = orow + (size_t)r32 * D;
#pragma unroll
    for (int vt = 0; vt < 2; ++vt)
#pragma unroll
        for (int g = 0; g < 4; ++g) { const int v0 = 32 * vt + 8 * g + 4 * hh; const u32x2 gw = *(const u32x2*)(grow + v0); const f32x4 n4 = *(const f32x4*)(ng + v0);
            const float y0 = o[vt][4 * g] * rstd * n4[0] * silu_f(bflo(gw.x)), y1 = o[vt][4 * g + 1] * rstd * n4[1] * silu_f(bfhi(gw.x));
            const float y2 = o[vt][4 * g + 2] * rstd * n4[2] * silu_f(bflo(gw.y)), y3 = o[vt][4 * g + 3] * rstd * n4[3] * silu_f(bfhi(gw.y));
            *(u32x2*)(od + v0) = (u32x2){pk2(y0, y1), pk2(y2, y3)}; }
}

constexpr int RWC_HEADB = 28928;
constexpr int RWC_AL = 4 * RWC_HEADB, RWC_LWL = RWC_AL + 32 * 264 * 2;
static_assert(RWC_LWL + 32 * 264 * 2 <= LDSCTL_OFF, "rw_fused_unit LDS");
__device__ __forceinline__ void rw_fused_unit(LAS unsigned char* lds, int l, int b, int c) {
    const int tid = opaque_tid(), lane = tid & 63, wave = __builtin_amdgcn_readfirstlane(tid >> 6), h = wave >> 1, p = wave & 1, r32 = lane & 31, hh = lane >> 5;
    unsigned char* ws = KWS();
    const int bh = b * 4 + h; const size_t un = (size_t)bh * NCH + c;
    const int t0 = c * 32;
    const bf16* P = (const bf16*)(ws + WS_P) + ((size_t)b * T + t0) * PINP + PC_RW;
    const float* mu = KIN(I_RWMU) + (size_t)l * 1024;
    LAS bf16* XL = (LAS bf16*)lds;
    LAS bf16* AL = (LAS bf16*)(lds + RWC_AL);
    LAS bf16* LWL = (LAS bf16*)(lds + RWC_LWL);
    { const int cc = tid & 255, tp = tid >> 8; const float mc = mu[768 + cc];
      unsigned short xr[17];
#pragma unroll
      for (int j = 0; j < 17; ++j) { const int tk = tp * 16 + j - 1; xr[j] = (t0 + tk >= 0) ? P[(long)tk * PINP + 768 + cc] : (unsigned short)0; }
#pragma unroll
      for (int j = 0; j < 16; ++j) { const float cur = bf2f(xr[j + 1]), prev = bf2f(xr[j]);
          float x = cur + (prev - cur) * mc;
          if (cc < 64) x = tanh_f(x); else if (cc >= 128) x = fast_sigmoid(x);
          XL[(tp * 16 + j) * 264 + cc] = (bf16)f2bf(x); } }
    lds_barrier();
    {
        const int ch = wave * 32 + r32;
        const bf16* w2T = (const bf16*)(ws + WS_LORA) + (size_t)l * 256 * 64 + (size_t)ch * 64;
        const bf16* a2T = (const bf16*)(ws + WS_LORA) + (size_t)(NL * 256 * 64) + (size_t)l * 256 * 64 + (size_t)ch * 64;
        const bf16* g2T = (const bf16*)(ws + WS_LORA) + (size_t)2 * (NL * 256 * 64) + (size_t)l * 256 * 128 + (size_t)ch * 128;
        const LAS bf16* xa = XL + r32 * 264 + 8 * hh;
        {
            f32x16 acc;
#pragma unroll
            for (int i = 0; i < 16; ++i) acc[i] = 0.f;
#pragma unroll
            for (int s = 0; s < 4; ++s) { const bf16x8 A = *(const LAS bf16x8*)(xa + 16 * s); const bf16x8 Bw = *(const bf16x8*)(w2T + 16 * s + 8 * hh);
                acc = __builtin_amdgcn_mfma_f32_32x32x16_bf16(A, Bw, acc, 0, 0, 0); }
            const float w0c = KIN(I_RWW0)[l * 256 + ch];
#pragma unroll
            for (int r = 0; r < 16; ++r) { const int tok = rho16(r, hh);
                const float zw = w0c + acc[r]; const float wlog = -(fmaxf(-zw, 0.f) + log1pexp_neg_abs(zw)) - 0.5f;
                LWL[tok * 264 + ch] = (bf16)f2bf(-fast_exp(wlog)); }
        }
        __builtin_amdgcn_sched_barrier(0);
        {
            f32x16 acc;
#pragma unroll
            for (int i = 0; i < 16; ++i) acc[i] = 0.f;
#pragma unroll
            for (int s = 0; s < 4; ++s) { const bf16x8 A = *(const LAS bf16x8*)(xa + 64 + 16 * s); const bf16x8 Bw = *(const bf16x8*)(a2T + 16 * s + 8 * hh);
                acc = __builtin_amdgcn_mfma_f32_32x32x16_bf16(A, Bw, acc, 0, 0, 0); }
            const float a0c = KIN(I_RWA0)[l * 256 + ch];
#pragma unroll
            for (int r = 0; r < 16; ++r) AL[rho16(r, hh) * 264 + ch] = (bf16)f2bf(fast_sigmoid(a0c + acc[r]));
        }
        __builtin_amdgcn_sched_barrier(0);
        {
            f32x16 acc;
#pragma unroll
            for (int i = 0; i < 16; ++i) acc[i] = 0.f;
#pragma unroll
            for (int s = 0; s < 8; ++s) { const bf16x8 A = *(const LAS bf16x8*)(xa + 128 + 16 * s); const bf16x8 Bw = *(const bf16x8*)(g2T + 16 * s + 8 * hh);
                acc = __builtin_amdgcn_mfma_f32_32x32x16_bf16(A, Bw, acc, 0, 0, 0); }
            bf16* gb = (bf16*)(ws + WS_GBUF) + ((size_t)b * T + t0) * 256 + ch;
#pragma unroll
            for (int r = 0; r < 16; ++r) gb[(size_t)rho16(r, hh) * 256] = (bf16)f2bf(acc[r]);
        }
    }
    lds_barrier();
    LAS unsigned char* L = lds + h * RWC_HEADB;
    LAS bf16* AT = (LAS bf16*)L;
    LAS bf16* BT = (LAS bf16*)(L + 4096);
    LAS bf16* KT = (LAS bf16*)(L + 8192);
    LAS bf16* ATT = (LAS bf16*)(L + 12288);
    LAS bf16* BHT = (LAS bf16*)(L + 16384);
    LAS bf16* KHT = (LAS bf16*)(L + 20480);
    LAS bf16* VT = (LAS bf16*)(L + 24576);
    LAS float* GC = (LAS float*)(L + 28672);
    LAS float* MAB = (LAS float*)(L + 4096);
    LAS bf16* MAK = (LAS bf16*)(L + 8192);
    LAS bf16* TM = (LAS bf16*)L;
    if (wave < 4) {
        const int hs = wave, d = lane, ch = hs * 64 + d; const size_t uns = (size_t)(b * 4 + hs) * NCH + c;
        LAS unsigned char* Ls = lds + hs * RWC_HEADB;
        LAS bf16* sAT = (LAS bf16*)Ls; LAS bf16* sBT = (LAS bf16*)(Ls + 4096); LAS bf16* sKT = (LAS bf16*)(Ls + 8192);
        LAS bf16* sATT = (LAS bf16*)(Ls + 12288); LAS bf16* sBHT = (LAS bf16*)(Ls + 16384); LAS bf16* sKHT = (LAS bf16*)(Ls + 20480); LAS float* sGC = (LAS float*)(Ls + 28672);
        const float mr = mu[ch], mk = mu[256 + ch];
        const float kkc = KIN(I_RWKK)[l * 256 + ch], kac = KIN(I_RWKA)[l * 256 + ch], rkc = KIN(I_RWRK)[l * 256 + ch];
        float lgend = 0.f;
#pragma unroll 8
        for (int t = 0; t < 32; ++t) lgend += bf2f(LWL[t * 264 + ch]);
        float* bonp = (float*)(ws + WS_BONUS) + ((size_t)b * T + t0) * 4 + hs;
        float lg = 0.f;
        float rprev = 0.f, kprev = 0.f;
        if (t0 > 0) { rprev = bf2f(*(P - PINP + ch)); kprev = bf2f(*(P - PINP + 256 + ch)); }
        unsigned short xrr[32], xkr[32];
#pragma unroll
        for (int t = 0; t < 32; ++t) { const bf16* row = P + (size_t)t * PINP; xrr[t] = row[ch]; xkr[t] = row[256 + ch]; }
#pragma unroll 1
        for (int t8 = 0; t8 < 4; ++t8) { u32x4 ap, bp, kp; float xr[8], xk[8];
#pragma unroll
            for (int e = 0; e < 8; ++e) { xr[e] = bf2f(t8 == 0 ? xrr[e] : t8 == 1 ? xrr[8 + e] : t8 == 2 ? xrr[16 + e] : xrr[24 + e]); xk[e] = bf2f(t8 == 0 ? xkr[e] : t8 == 1 ? xkr[8 + e] : t8 == 2 ? xkr[16 + e] : xkr[24 + e]); }
#pragma unroll
            for (int jj = 0; jj < 4; ++jj) { float at2[2], bh2[2], kh2[2];
#pragma unroll
                for (int e = 0; e < 2; ++e) { const int t = t8 * 8 + jj * 2 + e;
                    const float rc = xr[jj * 2 + e], kc = xk[jj * 2 + e];
                    const float r = rc + (rprev - rc) * mr, k = kc + (kprev - kc) * mk; rprev = rc; kprev = kc;
                    const float av = bf2f(AL[t * 264 + ch]), lw = bf2f(LWL[t * 264 + ch]);
                    const float kkr = k * kkc, hk = k * (1.0f + (av - 1.0f) * kac);
                    const float ss = wave_sum(kkr * kkr); const float kk = kkr / fmaxf(sqrtf(ss), 1e-12f);
                    const float bon = wave_sum(r * hk * rkc);
                    const float aa = -kk, bb = kk * av;
                    const float lgp = lg; lg += lw;
                    const float at = aa * fast_exp(lgp), rt = r * fast_exp(lg), ei = fast_exp(-lg), bt = bb * ei, kt = hk * ei, eh = fast_exp(lgend - lg);
                    sAT[t * 64 + d] = (bf16)f2bf(at); sBT[t * 64 + d] = (bf16)f2bf(bt); sKT[t * 64 + d] = (bf16)f2bf(kt);
                    LWL[t * 264 + ch] = (bf16)f2bf(rt);
                    if (d == 0) bonp[t * 4] = bon;
                    at2[e] = at; bh2[e] = bb * eh; kh2[e] = hk * eh; }
                ap[jj] = pk2(at2[0], at2[1]); bp[jj] = pk2(bh2[0], bh2[1]); kp[jj] = pk2(kh2[0], kh2[1]); }
            *(LAS u32x4*)(sATT + d * 32 + t8 * 8) = ap; *(LAS u32x4*)(sBHT + d * 32 + t8 * 8) = bp; *(LAS u32x4*)(sKHT + d * 32 + t8 * 8) = kp; }
        sGC[d] = fast_exp(lgend);
    } else {
        const int cv = tid - 256, hs = cv >> 6, vi = cv & 63; const size_t uns = (size_t)(b * 4 + hs) * NCH + c;
        LAS bf16* sVT = (LAS bf16*)(lds + hs * RWC_HEADB + 24576);
        bf16* VTg = (bf16*)(ws + WS_RVT) + uns * 2048 + vi * 32; bf16* VGp = (bf16*)(ws + WS_RVG) + uns * 2048 + vi;
        const float mv = mu[512 + cv];
        float vprev = 0.f; if (t0 > 0) vprev = bf2f(*(P - PINP + 512 + cv));
        unsigned short xvr[32];
#pragma unroll
        for (int t = 0; t < 32; ++t) xvr[t] = P[(size_t)t * PINP + 512 + cv];
#pragma unroll
        for (int t8 = 0; t8 < 4; ++t8) { u32x4 vp; float yv[8];
#pragma unroll
            for (int e = 0; e < 8; ++e) { const float xv = bf2f(xvr[t8 * 8 + e]); yv[e] = xv + (vprev - xv) * mv; vprev = xv; VGp[(t8 * 8 + e) * 64] = (bf16)f2bf(yv[e]); }
#pragma unroll
            for (int jj = 0; jj < 4; ++jj) vp[jj] = pk2(yv[2 * jj], yv[2 * jj + 1]);
            *(LAS u32x4*)(sVT + vi * 32 + t8 * 8) = vp; *(u32x4*)(VTg + t8 * 8) = vp; }
    }
    lds_barrier();
    {
        const LAS bf16* srcL = p == 0 ? BT : KT; u32x4* dstG = (u32x4*)((bf16*)(ws + (p == 0 ? WS_RB : WS_RK)) + un * 2048);
#pragma unroll
        for (int i = 0; i < 4; ++i) dstG[i * 64 + lane] = *(const LAS u32x4*)(srcL + (i * 64 + lane) * 8);
        u32x4* dstR = (u32x4*)((bf16*)(ws + WS_RR) + un * 2048);
#pragma unroll
        for (int i = 0; i < 2; ++i) { const int q = (p * 2 + i) * 64 + lane, t = q >> 3, c8 = q & 7;
            dstR[q] = *(const LAS u32x4*)(LWL + t * 264 + h * 64 + c8 * 8); }
    }
    f32x16 accR[2];
    {
        f32x16 acc;
#pragma unroll
        for (int i = 0; i < 16; ++i) acc[i] = 0.f;
        const LAS bf16* Bsrc = p == 0 ? BT : KT;
#pragma unroll
        for (int s = 0; s < 4; ++s) { const bf16x8 A = *(const LAS bf16x8*)(AT + r32 * 64 + 16 * s + 8 * hh), B = *(const LAS bf16x8*)(Bsrc + r32 * 64 + 16 * s + 8 * hh);
            acc = __builtin_amdgcn_mfma_f32_32x32x16_bf16(A, B, acc, 0, 0, 0); }
        if (p == 0) {
#pragma unroll
            for (int r = 0; r < 16; ++r) { const int t = rho16(r, hh); MAB[t * 32 + r32] = (r32 < t) ? acc[r] : 0.f; }
        } else {
#pragma unroll
            for (int r = 0; r < 16; ++r) { const int t = rho16(r, hh); MAK[t * 32 + r32] = (bf16)f2bf((r32 < t) ? acc[r] : 0.f); }
        }
    }
    lds_barrier();
    if (p == 0) {
        const int cidx = r32; float tc[32];
#pragma unroll
        for (int t = 0; t < 32; ++t) { float acc0 = (t == cidx) ? 1.0f : 0.f, acc1 = 0.f;
#pragma unroll
            for (int s4 = 0; s4 < (t + 3) / 4; ++s4) { const f32x4 m4 = *(const LAS f32x4*)(MAB + t * 32 + 4 * s4);
#pragma unroll
                for (int e = 0; e < 4; ++e) { const int s = 4 * s4 + e; if (s < t) { if (e & 1) acc1 = fmaf(m4[e], tc[s], acc1); else acc0 = fmaf(m4[e], tc[s], acc0); } } }
            tc[t] = acc0 + acc1; }
#pragma unroll
        for (int t = 0; t < 32; ++t) if (hh == 0) TM[t * 32 + cidx] = (bf16)f2bf(tc[t]);
    } else {
#pragma unroll
        for (int vt = 0; vt < 2; ++vt) {
#pragma unroll
            for (int i = 0; i < 16; ++i) accR[vt][i] = 0.f;
#pragma unroll
            for (int s = 0; s < 2; ++s) { const bf16x8 A = *(const LAS bf16x8*)(MAK + r32 * 32 + 16 * s + 8 * hh), B = *(const LAS bf16x8*)(VT + (32 * vt + r32) * 32 + 16 * s + 8 * hh);
                accR[vt] = __builtin_amdgcn_mfma_f32_32x32x16_bf16(A, B, accR[vt], 0, 0, 0); } }
    }
    lds_barrier();
    if (p == 0) {
        f32x16 accW[2];
#pragma unroll
        for (int dt = 0; dt < 2; ++dt) {
#pragma unroll
            for (int i = 0; i < 16; ++i) accW[dt][i] = 0.f;
#pragma unroll
            for (int s = 0; s < 2; ++s) { const bf16x8 A = *(const LAS bf16x8*)(TM + r32 * 32 + 16 * s + 8 * hh), B = *(const LAS bf16x8*)(ATT + (32 * dt + r32) * 32 + 16 * s + 8 * hh);
                accW[dt] = __builtin_amdgcn_mfma_f32_32x32x16_bf16(A, B, accW[dt], 0, 0, 0); } }
        { LAS bf16* WL = ATT;
#pragma unroll
          for (int dt = 0; dt < 2; ++dt)
#pragma unroll
              for (int r = 0; r < 16; ++r) WL[rho16(r, hh) * 64 + 32 * dt + r32] = (bf16)f2bf(accW[dt][r]);
          u32x4* WGp = (u32x4*)((bf16*)(ws + WS_RW) + un * 2048);
#pragma unroll
          for (int i = 0; i < 4; ++i) WGp[i * 64 + lane] = *(const LAS u32x4*)(WL + (i * 64 + lane) * 8); }
        LAS bf16* PL = (LAS bf16*)(L + 4096);
        const int xs = r32 >> 4, xx = r32 & 15, hhA = (xx >> 2) & 1, jA = 4 * (xx >> 3) + (xx & 3);
#pragma unroll
        for (int dt = 0; dt < 2; ++dt)
#pragma unroll
            for (int dt2 = 0; dt2 < 2; ++dt2) { f32x16 acc;
#pragma unroll
                for (int i = 0; i < 16; ++i) acc[i] = 0.f;
#pragma unroll
                for (int s = 0; s < 2; ++s) { const LAS bf16* bp = BHT + (32 * dt + r32) * 32 + 16 * s + 4 * hh;
                    union { bf16x8 v; s16x4 h2[2]; } af; af.h2[0] = *(const LAS s16x4*)bp; af.h2[1] = *(const LAS s16x4*)(bp + 8);
                    union { bf16x8 v; unsigned w[4]; } bf;
#pragma unroll
                    for (int j = 0; j < 4; ++j) bf.w[j] = cvt_pk_bf16(accW[dt2][8 * s + 2 * j], accW[dt2][8 * s + 2 * j + 1]);
                    acc = __builtin_amdgcn_mfma_f32_32x32x16_bf16(af.v, bf.v, acc, 0, 0, 0); }
                if (dt == dt2) { const float gc = GC[32 * dt + r32];
#pragma unroll
                    for (int r = 0; r < 16; ++r) if (rho16(r, hh) == r32) acc[r] += gc; }
                LAS bf16* pf = PL + (((dt * 2 + dt2) * 2 + xs) * 64 + 32 * hhA) * 8 + jA;
#pragma unroll
                for (int r = 0; r < 16; ++r) pf[rho16(r, hh) * 8] = (bf16)f2bf(acc[r]); }
        { u32x4* PFp = (u32x4*)((bf16*)(ws + WS_RP) + un * 4096);
#pragma unroll
          for (int f = 0; f < 8; ++f) PFp[f * 64 + lane] = *(const LAS u32x4*)(PL + (f * 64 + lane) * 8); }
    } else {
        f32x16 accU[2];
#pragma unroll
        for (int vt = 0; vt < 2; ++vt) {
#pragma unroll
            for (int i = 0; i < 16; ++i) accU[vt][i] = 0.f;
#pragma unroll
            for (int s = 0; s < 2; ++s) { const LAS bf16* tp = TM + r32 * 32 + 16 * s + 4 * hh;
                union { bf16x8 v; s16x4 h2[2]; } af; af.h2[0] = *(const LAS s16x4*)tp; af.h2[1] = *(const LAS s16x4*)(tp + 8);
                union { bf16x8 v; unsigned w[4]; } bf;
#pragma unroll
                for (int j = 0; j < 4; ++j) bf.w[j] = cvt_pk_bf16(accR[vt][8 * s + 2 * j], accR[vt][8 * s + 2 * j + 1]);
                accU[vt] = __builtin_amdgcn_mfma_f32_32x32x16_bf16(af.v, bf.v, accU[vt], 0, 0, 0); } }
        float* UGp = (float*)(ws + WS_RU) + un * 2048;
#pragma unroll
        for (int vt = 0; vt < 2; ++vt)
#pragma unroll
            for (int g = 0; g < 4; ++g) *(f32x4*)(UGp + ((vt * 4 + g) * 64 + lane) * 4) = (f32x4){accU[vt][4 * g], accU[vt][4 * g + 1], accU[vt][4 * g + 2], accU[vt][4 * g + 3]};
        float* QFp = (float*)(ws + WS_RQ) + un * 4096;
#pragma unroll
        for (int vt = 0; vt < 2; ++vt)
#pragma unroll
            for (int dt = 0; dt < 2; ++dt) { f32x16 acc;
#pragma unroll
                for (int i = 0; i < 16; ++i) acc[i] = 0.f;
#pragma unroll
                for (int s = 0; s < 2; ++s) { const LAS bf16* bp = BHT + (32 * dt + r32) * 32 + 16 * s + 4 * hh;
                    union { bf16x8 v; s16x4 h2[2]; } af; af.h2[0] = *(const LAS s16x4*)bp; af.h2[1] = *(const LAS s16x4*)(bp + 8);
                    union { bf16x8 v; unsigned w[4]; } bf;
#pragma unroll
                    for (int j = 0; j < 4; ++j) bf.w[j] = cvt_pk_bf16(accU[vt][8 * s + 2 * j], accU[vt][8 * s + 2 * j + 1]);
                    acc = __builtin_amdgcn_mfma_f32_32x32x16_bf16(af.v, bf.v, acc, 0, 0, 0);
                    const bf16x8 A2 = *(const LAS bf16x8*)(KHT + (32 * dt + r32) * 32 + 16 * s + 8 * hh), B2 = *(const LAS bf16x8*)(VT + (32 * vt + r32) * 32 + 16 * s + 8 * hh);
                    acc = __builtin_amdgcn_mfma_f32_32x32x16_bf16(A2, B2, acc, 0, 0, 0); }
#pragma unroll
                for (int g = 0; g < 4; ++g) *(f32x4*)(QFp + (((vt * 2 + dt) * 4 + g) * 64 + lane) * 4) = (f32x4){acc[4 * g], acc[4 * g + 1], acc[4 * g + 2], acc[4 * g + 3]}; }
    }
    lds_barrier();
}
__device__ __forceinline__ void rw_m2_wave(LAS unsigned char* ring, int lane, int bh, int vt) {
    unsigned char* ws = KWS();
    const char* PF = (const char*)((const bf16*)(ws + WS_RP) + (size_t)bh * NCH * 4096) + lane * 16;
    const char* QF = (const char*)((const float*)(ws + WS_RQ) + (size_t)bh * NCH * 4096 + (size_t)vt * 2048) + lane * 16;
    bf16* SG = (bf16*)(ws + WS_RS) + (size_t)bh * NCH * 4096 + (size_t)vt * 2048 + lane * 8;
    f32x16 S[2];
#pragma unroll
    for (int dt = 0; dt < 2; ++dt)
#pragma unroll
        for (int i = 0; i < 16; ++i) S[dt][i] = 0.f;
#define RWM2_DMA(c_) do { const int _c = (c_) < NCH ? (c_) : NCH - 1; LAS unsigned char* _sl = ring + ((c_) & 3) * 16384; \
        _Pragma("unroll") for (int f = 0; f < 8; ++f) { \
            __builtin_amdgcn_global_load_lds((const unsigned*)(PF + (size_t)_c * 8192 + f * 1024), (LAS unsigned*)(_sl + f * 1024), 16, 0, 0); \
            __builtin_amdgcn_global_load_lds((const unsigned*)(QF + (size_t)_c * 16384 + f * 1024), (LAS unsigned*)(_sl + 8192 + f * 1024), 16, 0, 0); } } while (0)
    RWM2_DMA(0); RWM2_DMA(1); RWM2_DMA(2);
#pragma unroll 1
    for (int c = 0; c < NCH; ++c) {
        asm volatile("s_waitcnt vmcnt(32)" ::: "memory");
        const LAS unsigned char* sl = ring + (c & 3) * 16384 + lane * 16;
        bf16x8 pf[8]; f32x4 qv[8];
#pragma unroll
        for (int f = 0; f < 8; ++f) { pf[f] = *(const LAS bf16x8*)(sl + f * 1024); qv[f] = *(const LAS f32x4*)(sl + 8192 + f * 1024); }
        union { bf16x8 v; unsigned w[4]; } sb[2][2];
#pragma unroll
        for (int dt2 = 0; dt2 < 2; ++dt2)
#pragma unroll
            for (int s = 0; s < 2; ++s) {
#pragma unroll
                for (int j = 0; j < 4; ++j) sb[dt2][s].w[j] = cvt_pk_bf16(S[dt2][8 * s + 2 * j], S[dt2][8 * s + 2 * j + 1]);
                *(bf16x8*)(SG + (size_t)c * 4096 + (dt2 * 2 + s) * 512) = sb[dt2][s].v; }
        f32x16 N[2];
#pragma unroll
        for (int dt = 0; dt < 2; ++dt) {
#pragma unroll
            for (int g = 0; g < 4; ++g) { N[dt][4 * g] = qv[dt * 4 + g][0]; N[dt][4 * g + 1] = qv[dt * 4 + g][1]; N[dt][4 * g + 2] = qv[dt * 4 + g][2]; N[dt][4 * g + 3] = qv[dt * 4 + g][3]; }
#pragma unroll
            for (int dt2 = 0; dt2 < 2; ++dt2)
#pragma unroll
                for (int s = 0; s < 2; ++s) N[dt] = __builtin_amdgcn_mfma_f32_32x32x16_bf16(pf[(dt * 2 + dt2) * 2 + s], sb[dt2][s].v, N[dt], 0, 0, 0); }
        S[0] = N[0]; S[1] = N[1];
        asm volatile("s_waitcnt lgkmcnt(0)" ::: "memory");
        RWM2_DMA(c + 3);
    }
    asm volatile("s_waitcnt vmcnt(0)" ::: "memory");
#undef RWM2_DMA
}
__device__ __forceinline__ bf16x8 ld_perm8(const bf16* p) { union { bf16x8 v; s16x4 h2[2]; } f; f.h2[0] = *(const s16x4*)p; f.h2[1] = *(const s16x4*)(p + 8); return f.v; }
__device__ __forceinline__ void rw_m3_task(int lane, int l, int bh, int c) {
    unsigned char* ws = KWS();
    const int r32 = lane & 31, hh = lane >> 5, b = bh >> 2, h = bh & 3; const size_t un = (size_t)bh * NCH + c; const size_t tok0 = (size_t)b * T + c * 32;
    const bf16* RGp = (const bf16*)(ws + WS_RR) + un * 2048 + r32 * 64 + 4 * hh; const bf16* BGp = (const bf16*)(ws + WS_RB) + un * 2048 + r32 * 64 + 4 * hh;
    const bf16* KGp = (const bf16*)(ws + WS_RK) + un * 2048 + r32 * 64 + 4 * hh; const bf16* WGp = (const bf16*)(ws + WS_RW) + un * 2048 + r32 * 64 + 4 * hh;
    const bf16* SGp = (const bf16*)(ws + WS_RS) + un * 4096 + lane * 8; const bf16* VTp = (const bf16*)(ws + WS_RVT) + un * 2048 + r32 * 32 + 4 * hh;
    const float* UGp = (const float*)(ws + WS_RU) + un * 2048 + lane * 4;
    f32x16 U[2], Y[2], mb, mk;
#pragma unroll
    for (int vt = 0; vt < 2; ++vt)
#pragma unroll
        for (int g = 0; g < 4; ++g) { const f32x4 u4 = *(const f32x4*)(UGp + (vt * 4 + g) * 256); U[vt][4 * g] = u4[0]; U[vt][4 * g + 1] = u4[1]; U[vt][4 * g + 2] = u4[2]; U[vt][4 * g + 3] = u4[3]; }
#pragma unroll
    for (int i = 0; i < 16; ++i) { mb[i] = 0.f; mk[i] = 0.f; Y[0][i] = 0.f; Y[1][i] = 0.f; }
#pragma unroll
    for (int ks = 0; ks < 4; ++ks) {
        const bf16x8 rf = ld_perm8(RGp + 16 * ks), wf = ld_perm8(WGp + 16 * ks), bfr = ld_perm8(BGp + 16 * ks), kfr = ld_perm8(KGp + 16 * ks);
        const bf16x8 s0 = *(const bf16x8*)(SGp + ks * 512), s1 = *(const bf16x8*)(SGp + 2048 + ks * 512);
        U[0] = __builtin_amdgcn_mfma_f32_32x32x16_bf16(wf, s0, U[0], 0, 0, 0); U[1] = __builtin_amdgcn_mfma_f32_32x32x16_bf16(wf, s1, U[1], 0, 0, 0);
        mb = __builtin_amdgcn_mfma_f32_32x32x16_bf16(bfr, rf, mb, 0, 0, 0); mk = __builtin_amdgcn_mfma_f32_32x32x16_bf16(kfr, rf, mk, 0, 0, 0);
        Y[0] = __builtin_amdgcn_mfma_f32_32x32x16_bf16(s0, rf, Y[0], 0, 0, 0); Y[1] = __builtin_amdgcn_mfma_f32_32x32x16_bf16(s1, rf, Y[1], 0, 0, 0); }
#pragma unroll
    for (int r = 0; r < 16; ++r) if (rho16(r, hh) > r32) { mb[r] = 0.f; mk[r] = 0.f; }
#pragma unroll
    for (int s = 0; s < 2; ++s) { union { bf16x8 v; unsigned w[4]; } fb, fk;
#pragma unroll
        for (int j = 0; j < 4; ++j) { fb.w[j] = cvt_pk_bf16(mb[8 * s + 2 * j], mb[8 * s + 2 * j + 1]); fk.w[j] = cvt_pk_bf16(mk[8 * s + 2 * j], mk[8 * s + 2 * j + 1]); }
#pragma unroll
        for (int vt = 0; vt < 2; ++vt) { union { bf16x8 v; unsigned w[4]; } fu;
#pragma unroll
            for (int j = 0; j < 4; ++j) fu.w[j] = cvt_pk_bf16(U[vt][8 * s + 2 * j], U[vt][8 * s + 2 * j + 1]);
            Y[vt] = __builtin_amdgcn_mfma_f32_32x32x16_bf16(fu.v, fb.v, Y[vt], 0, 0, 0);
            const bf16* vp = VTp + (size_t)vt * 32 * 32 + 16 * s;
            union { bf16x8 v; s16x4 h2[2]; } vf; vf.h2[0] = *(const s16x4*)vp; vf.h2[1] = *(const s16x4*)(vp + 8);
            Y[vt] = __builtin_amdgcn_mfma_f32_32x32x16_bf16(vf.v, fk.v, Y[vt], 0, 0, 0); } }
    float sm = 0.f;
#pragma unroll
    for (int vt = 0; vt < 2; ++vt)
#pragma unroll
        for (int i = 0; i < 16; ++i) sm += Y[vt][i];
    sm += __shfl_xor(sm, 32); const float mu = sm * (1.0f / 64.0f);
    float q = 0.f;
#pragma unroll
    for (int vt = 0; vt < 2; ++vt)
#pragma unroll
        for (int i = 0; i < 16; ++i) { const float dd = Y[vt][i] - mu; q += dd * dd; }
    q += __shfl_xor(q, 32); const float rstd = 1.0f / sqrtf(q * (1.0f / 64.0f) + RW_LN_EPS);
    const size_t tok = tok0 + r32;
    const float bon = ((const float*)(ws + WS_BONUS))[tok * 4 + h];
    const bf16* vrec = (const bf16*)(ws + WS_RVG) + un * 2048 + r32 * 64;
    const bf16* gp = (const bf16*)(ws + WS_GBUF) + tok * 256 + h * 64; bf16* od = (bf16*)(ws + WS_O) + tok * D + 512 + h * 64;
    const float* lnw = KIN(I_RWLNW) + l * 256 + h * 64; const float* lnb = KIN(I_RWLNB) + l * 256 + h * 64;
#pragma unroll
    for (int vt = 0; vt < 2; ++vt)
#pragma unroll
        for (int g = 0; g < 4; ++g) { const int v0 = 32 * vt + 8 * g + 4 * hh; const f32x4 w4 = *(const f32x4*)(lnw + v0), b4 = *(const f32x4*)(lnb + v0); const u32x2 vw = *(const u32x2*)(vrec + v0); const f32x4 vv = {bflo(vw.x), bfhi(vw.x), bflo(vw.y), bfhi(vw.y)}; const u32x2 gw = *(const u32x2*)(gp + v0);
            const float y0 = ((Y[vt][4 * g] - mu) * rstd * w4[0] + b4[0] + bon * vv[0]) * bflo(gw.x), y1 = ((Y[vt][4 * g + 1] - mu) * rstd * w4[1] + b4[1] + bon * vv[1]) * bfhi(gw.x);
            const float y2 = ((Y[vt][4 * g + 2] - mu) * rstd * w4[2] + b4[2] + bon * vv[2]) * bflo(gw.y), y3 = ((Y[vt][4 * g + 3] - mu) * rstd * w4[3] + b4[3] + bon * vv[3]) * bfhi(gw.y);
            *(u32x2*)(od + v0) = (u32x2){pk2(y0, y1), pk2(y2, y3)}; }
}

__device__ __forceinline__ void c1_phase(LAS unsigned char* lds, int l, int vcu, int G) {
    for (int u = vcu; u < NB * NCH; u += G) { const int b = u >> 8, c = u & 255;
        for (int q = 0; q <= PHREP(16); ++q) rw_fused_unit(lds, l, b, c);
        for (int q = 0; q <= PHREP(17); ++q) hg_fused_unit(lds, l, b, c);
        for (int q = 0; q <= PHREP(18); ++q) gla_fused_unit(lds, l, b, c); }
}
__device__ __forceinline__ void m3_gh_phase(int l, int vcu, int G) {
    const int tid = opaque_tid(), lane = tid & 63, wave = __builtin_amdgcn_readfirstlane(tid >> 6);
    unsigned char* ws = KWS();
    const int gw = vcu * NWAVES + wave, NGW = G * NWAVES;
    const bf16* P = (const bf16*)(ws + WS_P); bf16* O = (bf16*)(ws + WS_O);
    const float* gng = KIN(I_GLANG) + l * 256; const float* hng = KIN(I_HGNG) + l * 256;
    for (int task = gw; task < 24576; task += NGW) {
        const int un = task & 8191, bh = un >> 8, c = un & 255, b = bh >> 2, h = bh & 3; const size_t tok0 = (size_t)b * T + c * 32;
        if (task >= 16384) { rw_m3_task(lane, l, bh, c); continue; }
        if (task < 8192) m3_gh_task<64>(lane, (const bf16*)(ws + WS_HQ) + (size_t)un * 2048, (const bf16*)(ws + WS_HK) + (size_t)un * 2048, (const bf16*)(ws + WS_HVT) + (size_t)un * 2048, (const bf16*)(ws + WS_HS) + (size_t)un * 4096,
                                         P + tok0 * PINP + PC_HG + h * 64, hng + h * 64, O + tok0 * D + 256 + h * 64);
        else m3_gh_task<32>(lane, (const bf16*)(ws + WS_GQ) + (size_t)un * 1024, (const bf16*)(ws + WS_GK) + (size_t)un * 1024, (const bf16*)(ws + WS_GVT) + (size_t)un * 2048, (const bf16*)(ws + WS_GS) + (size_t)un * 2048,
                            P + tok0 * PINP + PC_GOUT + h * 64, gng + h * 64, O + tok0 * D + h * 64);
    }
}

__device__ __forceinline__ void xattn_units(LAS unsigned char* lds, int l, int first, int last, int stride) {
    const int tid = opaque_tid(), lane = tid & 63, wave = __builtin_amdgcn_readfirstlane(tid >> 6), r32 = lane & 31, hh = lane >> 5;
    const bf16* P = (const bf16*)(KWS() + WS_P); const bf16* MKV = (const bf16*)(KWS() + WS_MKV); bf16* O = (bf16*)(KWS() + WS_O);
    LAS bf16* KL = (LAS bf16*)lds;
    LAS bf16* VT = (LAS bf16*)(lds + 256 * 72 * 2);
    int cur_bh = -1;
    for (int u = first; u < last; u += stride) {
        const int bh = u >> 5, qb = u & 31, b = bh >> 2, h = bh & 3;
        if (bh != cur_bh) {
            lds_barrier();
            for (int i = tid; i < 256 * 8; i += NTHR) { const int key = i >> 3, c8 = i & 7;
                const bf16* src = MKV + (size_t)(b * 256 + key) * 2048 + l * 512 + h * 64 + c8 * 8;
                *(LAS u32x4*)(KL + key * 72 + c8 * 8) = *(const u32x4*)src;
                const u32x4 vv = *(const u32x4*)(src + 256);
                LAS bf16* vd = VT + (c8 * 8) * 264 + key;
                vd[0 * 264] = (bf16)(vv.x & 0xffff); vd[1 * 264] = (bf16)(vv.x >> 16); vd[2 * 264] = (bf16)(vv.y & 0xffff); vd[3 * 264] = (bf16)(vv.y >> 16);
                vd[4 * 264] = (bf16)(vv.z & 0xffff); vd[5 * 264] = (bf16)(vv.z >> 16); vd[6 * 264] = (bf16)(vv.w & 0xffff); vd[7 * 264] = (bf16)(vv.w >> 16); }
            lds_barrier();
            cur_bh = bh;
        }
        const int q = b * T + qb * 256 + wave * 32 + r32;
        bf16x8 qf[4];
#pragma unroll
        for (int s = 0; s < 4; ++s) qf[s] = *(const bf16x8*)(P + (size_t)q * PINP + PC_MQ + h * 64 + 16 * s + 8 * hh);
        f32x16 sc[8];
#pragma unroll
        for (int kt = 0; kt < 8; ++kt) {
#pragma unroll
            for (int i = 0; i < 16; ++i) sc[kt][i] = 0.f;
#pragma unroll
            for (int s = 0; s < 4; ++s) { const bf16x8 kf = *(const LAS bf16x8*)(KL + (kt * 32 + r32) * 72 + 16 * s + 8 * hh);
                sc[kt] = __builtin_amdgcn_mfma_f32_32x32x16_bf16(kf, qf[s], sc[kt], 0, 0, 0); }
        }
        float m = -3.0e38f;
#pragma unroll
        for (int kt = 0; kt < 8; ++kt)
#pragma unroll
            for (int i = 0; i < 16; ++i) m = fmaxf(m, sc[kt][i]);
        m = fmaxf(m, __shfl_xor(m, 32));
        float sum = 0.f;
        const float c2 = 0.125f * 1.4426950408889634f;
#pragma unroll
        for (int kt = 0; kt < 8; ++kt)
#pragma unroll
            for (int i = 0; i < 16; ++i) { const float e = __builtin_amdgcn_exp2f((sc[kt][i] - m) * c2); sc[kt][i] = e; sum += e; }
        sum += __shfl_xor(sum, 32);
        const float inv = 1.0f / sum;
        f32x16 oa[2];
#pragma unroll
        for (int vt = 0; vt < 2; ++vt)
#pragma unroll
            for (int i = 0; i < 16; ++i) oa[vt][i] = 0.f;
#pragma unroll
        for (int kt = 0; kt < 8; ++kt)
#pragma unroll
            for (int s = 0; s < 2; ++s) {
                union { bf16x8 v; unsigned w[4]; } pf;
#pragma unroll
                for (int j = 0; j < 4; ++j) pf.w[j] = cvt_pk_bf16(sc[kt][8 * s + 2 * j], sc[kt][8 * s + 2 * j + 1]);
#pragma unroll
                for (int vt = 0; vt < 2; ++vt) {
                    const LAS bf16* vp = VT + (vt * 32 + r32) * 264 + kt * 32 + 16 * s + 4 * hh;
                    union { bf16x8 v; s16x4 h2[2]; } vf; vf.h2[0] = *(const LAS s16x4*)vp; vf.h2[1] = *(const LAS s16x4*)(vp + 8);
                    oa[vt] = __builtin_amdgcn_mfma_f32_32x32x16_bf16(vf.v, pf.v, oa[vt], 0, 0, 0); }
            }
        bf16* orow = O + (size_t)q * D + 768 + h * 64;
#pragma unroll
        for (int vt = 0; vt < 2; ++vt)
#pragma unroll
            for (int g = 0; g < 4; ++g) { u32x2 w; w.x = cvt_pk_bf16(oa[vt][4 * g] * inv, oa[vt][4 * g + 1] * inv); w.y = cvt_pk_bf16(oa[vt][4 * g + 2] * inv, oa[vt][4 * g + 3] * inv);
                *(u32x2*)(orow + vt * 32 + 8 * g + 4 * hh) = w; }
    }
    lds_barrier();
}

__device__ __forceinline__ void m2_phase(LAS unsigned char* lds, int l, int bx, int G) {
    unsigned char* ws = KWS();
    const int tid = opaque_tid(), lane = tid & 63, wave = __builtin_amdgcn_readfirstlane(tid >> 6);
    const int nrw = (G >= 128) ? 64 : 0;
    if (nrw) { if (bx < nrw && wave == 0) rw_m2_wave(lds, lane, bx >> 1, bx & 1); }
    else { if (wave == 0) for (int q = bx; q < 64; q += G) rw_m2_wave(lds, lane, q >> 1, q & 1); }
    if (nrw && !(bx < nrw && wave == 0)) {
        const int nth = nrw ? (nrw * 448 + (G - nrw) * NTHR) : G * NTHR;
        const int gt = nrw ? (bx < nrw ? bx * 448 + (tid - 64) : nrw * 448 + (bx - nrw) * NTHR + tid) : bx * NTHR + tid;
        for (int e = gt; e < 98304; e += nth) {
            if (e < 65536) m2_gh_elem2<64>(e, (const float*)(ws + WS_HDS), (const float*)(ws + WS_HBE), (bf16*)(ws + WS_HS));
            else m2_gh_elem2<32>(e - 65536, (const float*)(ws + WS_GDS), (const float*)(ws + WS_GBE), (bf16*)(ws + WS_GS)); }
    }
    if (nrw == 0) { __syncthreads(); for (int e = bx * NTHR + tid; e < 98304; e += G * NTHR) {
            if (e < 65536) m2_gh_elem2<64>(e, (const float*)(ws + WS_HDS), (const float*)(ws + WS_HBE), (bf16*)(ws + WS_HS));
            else m2_gh_elem2<32>(e - 65536, (const float*)(ws + WS_GDS), (const float*)(ws + WS_GBE), (bf16*)(ws + WS_GS)); } }
    if (nrw == 0 || bx >= nrw) {
        const int nb = G - nrw, r = bx - nrw;
        const int per = (1024 + nb - 1) / nb, lo = r * per, hi = (lo + per < 1024) ? lo + per : 1024;
        xattn_units(lds, l, lo, hi, 1);
    }
}

__device__ __forceinline__ void ln1_router_phase(LAS unsigned char* lds, int l, int bx, int G) {
    const int tid = opaque_tid(), lane = tid & 63, wave = __builtin_amdgcn_readfirstlane(tid >> 6);
    LAS float* X = (LAS float*)lds;
    LAS float* PART = (LAS float*)(lds + 16 * 1028 * 4);
    LAS int* HIST = (LAS int*)(lds + 16 * 1028 * 4 + 8 * 16 * 32 * 4);
    const float* xin = KIN(I_X); const bf16* xinb = (const bf16*)(KWS() + WS_XB);
    const bf16* HM = (const bf16*)(KWS() + WS_HMIX);
    bf16* X1B = (bf16*)(KWS() + WS_X1B); unsigned char* X1Q = (unsigned char*)(KWS() + WS_XF);
    const float* g1 = KIN(I_LN1G) + l * D; const float* b1 = KIN(I_LN1B) + l * D;
    const float* rw = KIN(I_RTW) + (size_t)l * D * NE; const float* rb = KIN(I_RTB) + l * NE;
    int* tok_e = (int*)(KWS() + WS_ROUTE); float* tok_g = (float*)(KWS() + WS_ROUTE + 1 * MiB);
    if (tid < 32) HIST[tid] = 0;
    float rwB[2][32];
    { const int q = lane >> 4, e = lane & 15;
#pragma unroll
      for (int s = 0; s < 32; ++s) { const float* p = rw + (size_t)(128 * wave + 32 * q + s) * NE + e; rwB[0][s] = p[0]; rwB[1][s] = p[16]; } }
    lds_barrier();
    f32x4 xraw[2][4]; u32x2 xbraw[2][4], hraw[2][4];
#define LN1_LOAD(it_) do { _Pragma("unroll") for (int tt = 0; tt < 2; ++tt) { const size_t _tok = (size_t)(it_) * 16 + wave * 2 + tt; \
        const f32x4* _xr = (const f32x4*)(xin + _tok * D) + lane; const u32x2* _xbr = (const u32x2*)(xinb + _tok * D) + lane; const u32x2* _hr = (const u32x2*)(HM + _tok * D) + lane; \
        _Pragma("unroll") for (int j = 0; j < 4; ++j) { if (l == 0) xraw[tt][j] = _xr[64 * j]; else xbraw[tt][j] = _xbr[64 * j]; hraw[tt][j] = _hr[64 * j]; } } } while (0)
    if (bx < NTOK / 16) LN1_LOAD(bx);
    for (int it = bx; it < NTOK / 16; it += G) {
        f32x4 vv[2][4];
#pragma unroll
        for (int tt = 0; tt < 2; ++tt)
#pragma unroll
            for (int j = 0; j < 4; ++j) { f32x4 xv; if (l == 0) xv = xraw[tt][j]; else { const u32x2 xw = xbraw[tt][j]; xv = (f32x4){bflo(xw.x), bfhi(xw.x), bflo(xw.y), bfhi(xw.y)}; } const u32x2 hw = hraw[tt][j];
                vv[tt][j][0] = DN_ALPHA * xv[0] + bflo(hw.x); vv[tt][j][1] = DN_ALPHA * xv[1] + bfhi(hw.x); vv[tt][j][2] = DN_ALPHA * xv[2] + bflo(hw.y); vv[tt][j][3] = DN_ALPHA * xv[3] + bfhi(hw.y); }
        if (it + G < NTOK / 16) LN1_LOAD(it + G);
#pragma unroll
        for (int tt = 0; tt < 2; ++tt) { const int ti = wave * 2 + tt; const size_t tok = (size_t)it * 16 + ti;
            f32x4 v[4]; float s = 0.f;
#pragma unroll
            for (int j = 0; j < 4; ++j) { v[j] = vv[tt][j]; s += (v[j][0] + v[j][1]) + (v[j][2] + v[j][3]); }
            const float mean = wave_sum(s) * (1.0f / D); float s2 = 0.f;
#pragma unroll
            for (int j = 0; j < 4; ++j) { v[j] = v[j] - mean; s2 += (v[j][0] * v[j][0] + v[j][1] * v[j][1]) + (v[j][2] * v[j][2] + v[j][3] * v[j][3]); }
            const float rstd = 1.0f / sqrtf(wave_sum(s2) * (1.0f / D) + LN_EPS);
#pragma unroll
            for (int j = 0; j < 4; ++j) { const f32x4 gg = *((const f32x4*)g1 + lane + 64 * j), bb = *((const f32x4*)b1 + lane + 64 * j);
                const f32x4 y = v[j] * rstd * gg + bb;
                *((u32x2*)(X1B + tok * D) + lane + 64 * j) = (u32x2){pk2(y[0], y[1]), pk2(y[2], y[3])};
                { int w = __builtin_amdgcn_cvt_pk_fp8_f32(y[0], y[1], 0, false); w = __builtin_amdgcn_cvt_pk_fp8_f32(y[2], y[3], w, true); *((unsigned*)(X1Q + tok * D) + lane + 64 * j) = (unsigned)w; }
                *(LAS f32x4*)(X + ti * 1028 + 4 * lane + 256 * j) = y; }
        }
        lds_barrier();
        {
            const int q = lane >> 4, r = lane & 15;
            f32x4 acc0 = (f32x4){0.f, 0.f, 0.f, 0.f}, acc1 = (f32x4){0.f, 0.f, 0.f, 0.f};
            const LAS float* xa = X + r * 1028 + 128 * wave + 32 * q;
#pragma unroll
            for (int s4 = 0; s4 < 8; ++s4) { const f32x4 av = *(const LAS f32x4*)(xa + 4 * s4);
#pragma unroll
                for (int j = 0; j < 4; ++j) { acc0 = __builtin_amdgcn_mfma_f32_16x16x4f32(av[j], rwB[0][4 * s4 + j], acc0, 0, 0, 0); acc1 = __builtin_amdgcn_mfma_f32_16x16x4f32(av[j], rwB[1][4 * s4 + j], acc1, 0, 0, 0); } }
#pragma unroll
            for (int i = 0; i < 4; ++i) { PART[(wave * 16 + 4 * q + i) * 32 + r] = acc0[i]; PART[(wave * 16 + 4 * q + i) * 32 + 16 + r] = acc1[i]; }
        }
        lds_barrier();
        {
            const int ti = tid >> 5, e = tid & 31;
            float lg = rb[e];
#pragma unroll
            for (int w = 0; w < 8; ++w) lg += PART[(w * 16 + ti) * 32 + e];
            float tv[4]; int te[4]; float cur = lg;
#pragma unroll
            for (int k = 0; k < 4; ++k) { float bv = cur; int bi = e;
#pragma unroll
                for (int o = 16; o >= 1; o >>= 1) { const float ov = __shfl_xor(bv, o); const int oi = __shfl_xor(bi, o); if (ov > bv || (ov == bv && oi < bi)) { bv = ov; bi = oi; } }
                tv[k] = bv; te[k] = bi; if (e == bi) cur = -3.0e38f; }
            const float e1 = __expf(tv[1] - tv[0]), e2 = __expf(tv[2] - tv[0]), e3 = __expf(tv[3] - tv[0]); const float inv = 1.0f / (1.0f + e1 + e2 + e3);
            const size_t tok = (size_t)it * 16 + ti;
            if (e < 4) { const int ek = e == 0 ? te[0] : e == 1 ? te[1] : e == 2 ? te[2] : te[3]; const float gk = (e == 0 ? 1.0f : e == 1 ? e1 : e == 2 ? e2 : e3) * inv;
                tok_e[tok * 4 + e] = ek; tok_g[tok * 4 + e] = gk; __hip_atomic_fetch_add(&HIST[ek], 1, __ATOMIC_RELAXED, __HIP_MEMORY_SCOPE_WORKGROUP); }
        }
        lds_barrier();
    }
#undef LN1_LOAD
    lds_barrier();
    if (tid < 32) ((int*)(KWS() + WS_CTL))[CW_HIST + bx * 32 + tid] = HIST[tid];
}

__device__ __forceinline__ void slots_phase(LAS unsigned char* lds, int bx, int G) {
    const int tid = opaque_tid();
    int* ctl = (int*)(KWS() + WS_CTL);
    LAS int* RED = (LAS int*)lds;
    LAS int* TOT = RED + 1024;
    const int* tok_e = (const int*)(KWS() + WS_ROUTE); const float* tok_g = (const float*)(KWS() + WS_ROUTE + 1 * MiB);
    int* tok_slot = (int*)(KWS() + WS_ROUTE + 2 * MiB); int* slot_tok = (int*)(KWS() + WS_ROUTE + 3 * MiB); float* slot_gate = (float*)(KWS() + WS_ROUTE + 3 * MiB + 1536 * 1024);
    { const int e = tid & 31, part = tid >> 5; int tot = 0, pre = 0;
      for (int b2 = part; b2 < G; b2 += 16) { const int h = ctl[CW_HIST + b2 * 32 + e]; tot += h; if (b2 < bx) pre += h; }
      RED[(part * 32 + e) * 2] = tot; RED[(part * 32 + e) * 2 + 1] = pre; }
    __syncthreads();
    if (tid < 32) { int tot = 0, pre = 0; for (int p = 0; p < 16; ++p) { tot += RED[(p * 32 + tid) * 2]; pre += RED[(p * 32 + tid) * 2 + 1]; } TOT[tid] = tot; TOT[32 + tid] = pre; TOT[96 + tid] = 0; }
    __syncthreads();
    if (tid == 0) { int ps = 0;
#pragma unroll 1
        for (int e = 0; e < 32; ++e) { TOT[64 + e] = ps; ps += (TOT[e] + 255) & ~255; }
        TOT[128] = ps >> 8; if (bx == 0) ctl[CW_NT] = ps >> 8; }
    __syncthreads();
    if (bx == 0) { const int nt = TOT[128];
        for (int t = tid; t < nt; t += NTHR) { int e = 0;
#pragma unroll 1
            for (int k = 1; k < 32; ++k) if (TOT[64 + k] <= t * 256) e = k;
            ctl[CW_TILEE + t] = e; } }
    for (int e = bx; e < 32; e += G) { const int s0 = TOT[64 + e] + TOT[e], s1 = TOT[64 + e] + ((TOT[e] + 255) & ~255); for (int s = s0 + tid; s < s1; s += NTHR) { slot_tok[s] = 0; slot_gate[s] = 0.f; } }
    for (int it = bx + G * (tid >> 6); it < NTOK / 16; it += G * 8) {
        const int asg = it * 64 + (tid & 63); const int e = tok_e[asg]; const int rank = __hip_atomic_fetch_add(&TOT[96 + e], 1, __ATOMIC_RELAXED, __HIP_MEMORY_SCOPE_WORKGROUP); const int slot = TOT[64 + e] + TOT[32 + e] + rank;
        tok_slot[asg] = slot; slot_tok[slot] = asg >> 2; slot_gate[slot] = tok_g[asg];
    }
}

__device__ __forceinline__ void combine_phase(int l, int vcu, int G) {
    const int tid = opaque_tid(), lane = tid & 63, wave = __builtin_amdgcn_readfirstlane(tid >> 6);
    const int gw = vcu * NWAVES + wave, NGW = G * NWAVES;
    const bf16* X1B = (const bf16*)(KWS() + WS_X1B); const bf16* YB = (const bf16*)(KWS() + WS_YB); const int* tok_slot = (const int*)(KWS() + WS_ROUTE + 2 * MiB);
    float* xo = KOUT(); bf16* XB = (bf16*)(KWS() + WS_XB);
    const float* g2 = KIN(I_LN2G) + l * D; const float* b2 = KIN(I_LN2B) + l * D;
    for (int tok = gw; tok < NTOK; tok += NGW) {
        const int s0 = tok_slot[tok * 4], s1 = tok_slot[tok * 4 + 1], s2i = tok_slot[tok * 4 + 2], s3 = tok_slot[tok * 4 + 3];
        const u32x2* xr = (const u32x2*)(X1B + (size_t)tok * D) + lane;
        const u32x2* y0 = (const u32x2*)(YB + (size_t)s0 * D) + lane; const u32x2* y1 = (const u32x2*)(YB + (size_t)s1 * D) + lane;
        const u32x2* y2 = (const u32x2*)(YB + (size_t)s2i * D) + lane; const u32x2* y3 = (const u32x2*)(YB + (size_t)s3 * D) + lane;
        f32x4 v[4]; float s = 0.f;
#pragma unroll
        for (int j = 0; j < 4; ++j) { const u32x2 xw = xr[64 * j]; const f32x4 xv = {bflo(xw.x), bfhi(xw.x), bflo(xw.y), bfhi(xw.y)}; const u32x2 a0 = y0[64 * j], a1 = y1[64 * j], a2 = y2[64 * j], a3 = y3[64 * j];
            v[j][0] = DN_ALPHA * xv[0] + ((bflo(a0.x) + bflo(a1.x)) + (bflo(a2.x) + bflo(a3.x))); v[j][1] = DN_ALPHA * xv[1] + ((bfhi(a0.x) + bfhi(a1.x)) + (bfhi(a2.x) + bfhi(a3.x)));
            v[j][2] = DN_ALPHA * xv[2] + ((bflo(a0.y) + bflo(a1.y)) + (bflo(a2.y) + bflo(a3.y))); v[j][3] = DN_ALPHA * xv[3] + ((bfhi(a0.y) + bfhi(a1.y)) + (bfhi(a2.y) + bfhi(a3.y)));
            s += (v[j][0] + v[j][1]) + (v[j][2] + v[j][3]); }
        const float mean = wave_sum(s) * (1.0f / D); float q = 0.f;
#pragma unroll
        for (int j = 0; j < 4; ++j) { v[j] = v[j] - mean; q += (v[j][0] * v[j][0] + v[j][1] * v[j][1]) + (v[j][2] * v[j][2] + v[j][3] * v[j][3]); }
        const float rstd = 1.0f / sqrtf(wave_sum(q) * (1.0f / D) + LN_EPS);
#pragma unroll
        for (int j = 0; j < 4; ++j) { const f32x4 gg = *((const f32x4*)g2 + lane + 64 * j), bb = *((const f32x4*)b2 + lane + 64 * j);
            const f32x4 y = v[j] * rstd * gg + bb;
            if (l == NL - 1) *((f32x4*)(xo + (size_t)tok * D) + lane + 64 * j) = y;
            else *((u32x2*)(XB + (size_t)tok * D) + lane + 64 * j) = (u32x2){pk2(y[0], y[1]), pk2(y[2], y[3])}; }
    }
}


constexpr int PH_PER_LAYER = 10, NPHASES = 2 + NL * PH_PER_LAYER;
__global__ void __launch_bounds__(NTHR, 2) trunk_fwd(Args args) {
    extern __shared__ __attribute__((aligned(16))) unsigned char lds_raw[];
    LAS unsigned char* lds = (LAS unsigned char*)lds_raw;
    volatile LAS unsigned* MISC = (volatile LAS unsigned*)(lds + MISC_OFF);
    const int tid = threadIdx.x;
    const int G = gridDim.x, bx = blockIdx.x;
    const int vcu = (G % 8 == 0) ? (bx % 8) * (G / 8) + bx / 8 : bx;
    unsigned char* ws = KWS();
    unsigned* ctl = (unsigned*)(ws + WS_CTL);
    for (int u = tid; u < (LDS_BYTES - LDSCTL_OFF) / 4; u += NTHR) ((LAS unsigned*)(lds + LDSCTL_OFF))[u] = 0u;
    __syncthreads();
    XcdBarrier bar; bar.bar = ctl + CW_BAR; bar.x = 0; bar.st = nullptr;
#if !MK_PER_PHASE
    bar = xcd_barrier_post(ctl + CW_BAR, MISC + 8);
#define GRID_BAR() xcd_barrier(bar)
#else
#define GRID_BAR() do { } while (0)
#endif
    const int lo = (int)(unsigned)ka_u64<280>(), hi = (int)(unsigned)(ka_u64<280>() >> 32);
#ifndef PH_MASK
#define PH_MASK 0x1FFF
#endif
#define PHEN(n) (((PH_MASK) >> (n)) & 1)
#define IN(k) (lo <= (k) && (k) < hi)
#define SEAM(k) do { if (rep > 0 || IN((k) + 1)) GRID_BAR(); } while (0)

#define OG opaque_s(G)
#define OBX opaque_s(bx)
#define OVCU opaque_s(vcu)
#define OL opaque_s(l)
    if (PHEN(0) && IN(0)) for (int rep = PHREP(0); rep >= 0; --rep) { prologue_phase(lds, OVCU, OG); SEAM(0); }
    if (PHEN(1) && IN(1)) for (int rep = PHREP(1); rep >= 0; --rep) {
        pg8::DenseOrder S; S.init(KWS() + WS_MEMB, KWS() + WS_WMEM, NB * NMEM, 2048, D, OG, OBX);
        pg8::EpiBf16 E{(bf16*)(KWS() + WS_MKV), 2048};
        pg8::gemm_phase<pg8::EpiBf16, pg8::DenseOrder>(lds, D, S, E);
        SEAM(1);
    }
    for (int l = 0; l < NL; ++l) {
        const int p0 = 2 + l * PH_PER_LAYER;
        if (PHEN(2) && IN(p0 + 0)) for (int rep = PHREP(2); rep >= 0; --rep) {
            pg8::DenseOrder S; S.init(KWS() + WS_XB, KWS() + WS_WIN + (size_t)OL * PINP * D * 2, NTOK, PINP, D, OG, OBX);
            pg8::EpiBf16 E{(bf16*)(KWS() + WS_P), PINP};
            pg8::gemm_phase<pg8::EpiBf16, pg8::DenseOrder>(lds, D, S, E);
            SEAM(p0 + 0);
        }
        if (PHEN(4) && IN(p0 + 1)) for (int rep = PHREP(4); rep >= 0; --rep) { c1_phase(lds, OL, OVCU, OG); SEAM(p0 + 1); }
        if (PHEN(5) && IN(p0 + 2)) for (int rep = PHREP(5); rep >= 0; --rep) { m2_phase(lds, OL, OBX, OG); SEAM(p0 + 2); }
        if (PHEN(6) && IN(p0 + 3)) for (int rep = PHREP(6); rep >= 0; --rep) { m3_gh_phase(OL, OVCU, OG); SEAM(p0 + 3); }
        if (PHEN(7) && IN(p0 + 4)) for (int rep = PHREP(7); rep >= 0; --rep) {
            pg8::DenseOrder S; S.init(KWS() + WS_O, KWS() + WS_WOUT + (size_t)OL * D * D * 2, NTOK, D, D, OG, OBX);
            pg8::EpiBf16 E{(bf16*)(KWS() + WS_HMIX), D};
            pg8::gemm_phase<pg8::EpiBf16, pg8::DenseOrder>(lds, D, S, E);
            SEAM(p0 + 4);
        }
        if (PHEN(8) && IN(p0 + 5)) for (int rep = PHREP(8); rep >= 0; --rep) { ln1_router_phase(lds, OL, OBX, OG); SEAM(p0 + 5); }
        if (PHEN(9) && IN(p0 + 6)) for (int rep = PHREP(9); rep >= 0; --rep) { slots_phase(lds, OBX, OG); SEAM(p0 + 6); }
        if (PHEN(10) && IN(p0 + 7)) for (int rep = PHREP(10); rep >= 0; --rep) {
            const int ntiles = __builtin_amdgcn_readfirstlane(((const int*)(KWS() + WS_CTL))[CW_NT]);
            pg8::MoeOrder<true> S; S.init(KWS() + WS_XF, KWS() + WS_WGU + (size_t)OL * NE * 2048 * D, (const int*)(KWS() + WS_CTL) + CW_TILEE, (const int*)(KWS() + WS_ROUTE + 3 * MiB), ntiles, 2048, D, OG, OBX);
            pg8::EpiSwiglu E{(unsigned char*)(KWS() + WS_HB), (const float*)(KWS() + WS_BGU) + (size_t)OL * NE * 2048};
            pg8::gemm_phase<pg8::EpiSwiglu, pg8::MoeOrder<true>, 1>(lds, D, S, E);
            SEAM(p0 + 7);
        }
        if (PHEN(11) && IN(p0 + 8)) for (int rep = PHREP(11); rep >= 0; --rep) {
            const int ntiles = __builtin_amdgcn_readfirstlane(((const int*)(KWS() + WS_CTL))[CW_NT]);
            pg8::MoeOrder<false> S; S.init(KWS() + WS_HB, KWS() + WS_WD + (size_t)OL * NE * D * FF, (const int*)(KWS() + WS_CTL) + CW_TILEE, (const int*)(KWS() + WS_ROUTE + 3 * MiB), ntiles, D, FF, OG, OBX);
            pg8::EpiDown E{(bf16*)(KWS() + WS_YB), KIN(I_BDN) + (size_t)OL * NE * D, (const float*)(KWS() + WS_ROUTE + 3 * MiB + 1536 * 1024)};
            pg8::gemm_phase<pg8::EpiDown, pg8::MoeOrder<false>, 1>(lds, FF, S, E);
            SEAM(p0 + 8);
        }
        if (PHEN(12) && IN(p0 + 9)) for (int rep = PHREP(12); rep >= 0; --rep) { combine_phase(OL, OVCU, OG); if (rep > 0 || l + 1 < NL) SEAM(p0 + 9); }
    }
#undef IN
#undef SEAM
}

extern "C" void kernel_launch(void* const* d_in, const int* in_sizes, int n_in, void* d_out, int out_size, void* d_ws, size_t ws_size, hipStream_t stream) {
    static int grid = 0;
    if (grid == 0) {
        if (n_in != 33 || ws_size < WS_END) { fprintf(stderr, "kernel_launch: unexpected inputs (n_in %d, ws %zu need %zu)\n", n_in, ws_size, (size_t)WS_END); grid = -1; return; }
        int dev = 0, cus = 0;
        if (hipGetDevice(&dev) != hipSuccess || hipDeviceGetAttribute(&cus, hipDeviceAttributeMultiprocessorCount, dev) != hipSuccess) { grid = -1; return; }
        if (hipFuncSetAttribute((const void*)trunk_fwd, hipFuncAttributeMaxDynamicSharedMemorySize, LDS_BYTES) != hipSuccess) { grid = -1; return; }
        int per_cu = 0; (void)hipOccupancyMaxActiveBlocksPerMultiprocessor(&per_cu, (const void*)trunk_fwd, NTHR, LDS_BYTES); (void)hipGetLastError();
        grid = cus;
    }
    if (grid < 0) return;
    (void)hipMemsetAsync((char*)d_ws + WS_CTL, 0, CTL_ZERO_BYTES, stream);
    Args a{};
    for (int i = 0; i < 33; ++i) a.in[i] = (const float*)d_in[i];
    a.out = (float*)d_out; a.ws = (unsigned char*)d_ws;
#if MK_PER_PHASE
    for (int p = 0; p < NPHASES; ++p) { a.ph_lo = p; a.ph_hi = p + 1; hipLaunchKernelGGL(trunk_fwd, dim3(grid), dim3(NTHR), LDS_BYTES, stream, a); }
#else
    a.ph_lo = 0; a.ph_hi = NPHASES;
    hipLaunchKernelGGL(trunk_fwd, dim3(grid), dim3(NTHR), LDS_BYTES, stream, a);
#endif
}
```

```cpp
#include <hip/hip_runtime.h>
#include <cstdio>
#include <cstdint>

#ifndef MK_PER_PHASE
#define MK_PER_PHASE 0
#endif

#ifndef REP_MASK
#define REP_MASK 0
#endif
#define PHREP(n) (((REP_MASK) >> (n)) & 1)
#define LAS __attribute__((address_space(3)))
#define GAS __attribute__((address_space(1)))
typedef unsigned short bf16;
typedef short bf16x8 __attribute__((ext_vector_type(8)));
typedef short s16x4 __attribute__((ext_vector_type(4)));
typedef float f32x4 __attribute__((ext_vector_type(4)));
typedef float f32x2 __attribute__((ext_vector_type(2)));
typedef float f32x16 __attribute__((ext_vector_type(16)));
typedef unsigned u32x4 __attribute__((ext_vector_type(4)));
typedef unsigned u32x2 __attribute__((ext_vector_type(2)));

constexpr int NB = 8, T = 8192, D = 1024, NL = 4, NTOK = NB * T;
constexpr int PIN = 3088, PINP = 3328;
constexpr int NE = 32, FF = 1024, NMEM = 256;
constexpr int NASSIGN = NTOK * 4;
constexpr int MAXTILES = NASSIGN / 256 + NE;
constexpr int MAXSLOTS = MAXTILES * 256;
constexpr int PC_GQ = 0, PC_GK = 128, PC_GV = 256, PC_GOUT = 512, PC_HQ = 768, PC_HF = 1024, PC_HI = 1280, PC_HG = 1536;
constexpr int PC_RW = 1792, PC_MQ = 2816, PC_GLR = 3072;
constexpr float DN_ALPHA = 1.6817928305074292f;
constexpr float LN_EPS = 1e-5f, RMS_EPS = 1e-6f, RW_LN_EPS = 64e-5f;

constexpr size_t MiB = 1u << 20;
constexpr size_t WS_CTL = 0, CTL_ZERO_BYTES = 1 * MiB;
constexpr size_t WS_WIN = 1 * MiB;
constexpr size_t WS_WOUT = WS_WIN + 26 * MiB;
constexpr size_t WS_WMEM = WS_WOUT + 8 * MiB;
constexpr size_t WS_WGU = WS_WMEM + 4 * MiB;
constexpr size_t WS_WD = WS_WGU + 512 * MiB;
constexpr size_t WS_BGU = WS_WD + 256 * MiB;
constexpr size_t WS_LORA = WS_BGU + 1 * MiB;
constexpr size_t WS_MEMB = WS_LORA + 1 * MiB;
constexpr size_t WS_MKV = WS_MEMB + 4 * MiB;
constexpr size_t WS_XB = WS_MKV + 8 * MiB;
constexpr size_t WS_X1B = WS_XB + 128 * MiB;
constexpr size_t WS_XF = WS_X1B + 128 * MiB;
constexpr size_t WS_X1F = WS_XF + 256 * MiB;
constexpr size_t WS_O = WS_X1F + 256 * MiB;
constexpr size_t WS_HMIX = WS_O + 128 * MiB;
constexpr size_t WS_ROUTE = WS_HMIX + 128 * MiB;
constexpr size_t WS_GBUF = WS_ROUTE + 6 * MiB;
constexpr size_t WS_BONUS = WS_GBUF + 32 * MiB;
constexpr size_t WS_BIG = WS_BONUS + 1 * MiB;
constexpr size_t WS_P = WS_BIG;
constexpr size_t WS_ORAW = WS_P + 416 * MiB;
constexpr size_t WS_HB = WS_BIG;
constexpr size_t WS_YB = WS_HB + 528 * MiB;
constexpr size_t WS_CHK = WS_ORAW;
constexpr size_t WS_HQ = WS_CHK, WS_HK = WS_HQ + 32 * MiB, WS_HVT = WS_HK + 32 * MiB, WS_HDS = WS_HVT + 32 * MiB, WS_HS = WS_HDS + 128 * MiB, WS_HBE = WS_HS + 64 * MiB;
constexpr size_t WS_GQ = WS_HBE + 2 * MiB, WS_GK = WS_GQ + 16 * MiB, WS_GVT = WS_GK + 16 * MiB, WS_GDS = WS_GVT + 32 * MiB, WS_GS = WS_GDS + 64 * MiB, WS_GBE = WS_GS + 32 * MiB;
constexpr size_t WS_RR = WS_GBE + 1 * MiB, WS_RB = WS_RR + 32 * MiB, WS_RK = WS_RB + 32 * MiB, WS_RW = WS_RK + 32 * MiB, WS_RVT = WS_RW + 32 * MiB;
constexpr size_t WS_RVG = WS_RVT + 32 * MiB;
constexpr size_t WS_RU = WS_RVG + 32 * MiB, WS_RP = WS_RU + 64 * MiB, WS_RQ = WS_RP + 64 * MiB, WS_RS = WS_RQ + 128 * MiB;
constexpr size_t WS_END = WS_RS + 64 * MiB;
static_assert(WS_YB + 528 * MiB <= WS_END, "overlay");
static_assert(WS_END <= (size_t)4096 * MiB, "workspace");
constexpr int CW_TMO = 0;
constexpr int CW_BAR = 4096;
constexpr int CW_HIST = 16384;
constexpr int CW_NT = 32768;
constexpr int CW_TILEE = 32768 + 64;
constexpr int CW_PADSTART = 40960;

constexpr int RING_BYTES = 131072;
constexpr int LDSCTL_OFF = 162816, MISC_OFF = LDSCTL_OFF + 320;
constexpr int LDS_BYTES = 163840;
constexpr int NWAVES = 8, NTHR = 512;

#define RLX_AGENT __ATOMIC_RELAXED, __HIP_MEMORY_SCOPE_AGENT
#define LDS_WAIT() asm volatile("s_waitcnt lgkmcnt(0)" ::: "memory")
#define VM_WAIT() asm volatile("s_waitcnt vmcnt(0)" ::: "memory")

__device__ __forceinline__ float bf2f(unsigned short b) { return __builtin_bit_cast(float, (unsigned)b << 16); }
__device__ __forceinline__ float bflo(unsigned w) { return __builtin_bit_cast(float, w << 16); }
__device__ __forceinline__ float bfhi(unsigned w) { return __builtin_bit_cast(float, w & 0xffff0000u); }
typedef __bf16 bf16x2_t __attribute__((ext_vector_type(2)));
__device__ __forceinline__ unsigned cvt_pk_bf16(float lo, float hi) { const f32x2 v = {lo, hi}; const bf16x2_t b = __builtin_convertvector(v, bf16x2_t); return __builtin_bit_cast(unsigned, b); }
__device__ __forceinline__ unsigned pk2(float lo, float hi) { return cvt_pk_bf16(lo, hi); }
__device__ __forceinline__ unsigned f2bf(float f) { return cvt_pk_bf16(f, 0.f) & 0xffffu; }
__device__ __forceinline__ float fast_exp(float x) { return __builtin_amdgcn_exp2f(x * 1.4426950408889634f); }
__device__ __forceinline__ float fast_sigmoid(float x) { return __builtin_amdgcn_rcpf(1.0f + fast_exp(-x)); }
__device__ __forceinline__ float silu_f(float x) { return x * fast_sigmoid(x); }
__device__ __forceinline__ int opaque_tid() { int t = threadIdx.x; asm volatile("" : "+v"(t)); return t; }
__device__ __forceinline__ int opaque_s(int v) { asm volatile("" : "+s"(v)); return v; }
__device__ __forceinline__ void lds_barrier() { asm volatile("s_waitcnt lgkmcnt(0)" ::: "memory"); __builtin_amdgcn_s_barrier(); asm volatile("" ::: "memory"); }
__device__ __forceinline__ float dpp_add(float x, const int sel) {
    const int xi = __builtin_bit_cast(int, x); int r;
    switch (sel) { case 0: r = __builtin_amdgcn_update_dpp(xi, xi, 0xB1, 0xf, 0xf, false); break;
                   case 1: r = __builtin_amdgcn_update_dpp(xi, xi, 0x4E, 0xf, 0xf, false); break;
                   case 2: r = __builtin_amdgcn_update_dpp(xi, xi, 0x141, 0xf, 0xf, false); break;
                   default: r = __builtin_amdgcn_update_dpp(xi, xi, 0x140, 0xf, 0xf, false); break; }
    return x + __builtin_bit_cast(float, r);
}
__device__ __forceinline__ float wave_sum(float v) {
    v = dpp_add(v, 0); v = dpp_add(v, 1); v = dpp_add(v, 2); v = dpp_add(v, 3);
    v += __shfl_xor(v, 16); v += __shfl_xor(v, 32);
    return v;
}

namespace pg8 {
constexpr int BM = 256, BK = 64, HALF = 128, HTB = HALF * BK * 2, STAGE_BYTES = 8 * HTB, NXCD = 8, WGM = 8;
__host__ __device__ __forceinline__ int lds_byte(int r, int c) { const int st = (r >> 4) * 2 + (c >> 5), rr = r & 15, cc = c & 31, ob = rr * 64 + cc * 2; return st * 1024 + (ob ^ (((ob >> 9) & 1) << 5)); }
__host__ __device__ __forceinline__ void stage_rc(int b, int& R, int& C) { const int st = b / 1024, sb = b % 1024, swz = sb ^ (((sb >> 9) & 1) << 5); R = (st >> 1) * 16 + swz / 64; C = (st & 1) * 32 + (swz % 64) / 2; }
__host__ __device__ __forceinline__ int perm32(int rho) { const int n = rho >> 4, i = rho & 15; return 8 * (i >> 2) + 4 * n + (i & 3); }

typedef int v4i_t __attribute__((ext_vector_type(4)));
typedef int v8i_t __attribute__((ext_vector_type(8)));
struct Unit { int pm, pn, e; const char* A; const char* B; };

__device__ __forceinline__ bool static_tile(int i, int G, int c, int nM, int nN, int& pm, int& pn) {
    const int nwg = nM * nN; const long L = (long)i * G + c; if (L >= nwg) return false;
    int wgid = (int)L; { const int q = nwg / NXCD, r = nwg % NXCD, xcd = wgid % NXCD, off = wgid / NXCD; wgid = (xcd < r ? xcd * (q + 1) : r * (q + 1) + (xcd - r) * q) + off; }
    const int nig = WGM * nN, gid = wgid / nig, fm = gid * WGM, gsz = (nM - fm) < WGM ? (nM - fm) : WGM;
    pm = fm + ((wgid % nig) % gsz); pn = (wgid % nig) / gsz; return true;
}
struct DenseOrder {
    static constexpr bool GATHER = false;
    const char* A; const char* B; int nM, nN, G, c; size_t tstep;
    __device__ __forceinline__ void init(const void* A_, const void* B_, int M, int N, int K, int G_, int c_) { A = (const char*)A_; B = (const char*)B_; nM = M / BM; nN = N / BM; G = G_; c = c_; tstep = (size_t)BM * K * 2; }
    __device__ __forceinline__ bool next(int i, Unit& u) const { if (!static_tile(i, G, c, nM, nN, u.pm, u.pn)) return false; u.e = 0; u.A = A + (size_t)u.pm * tstep; u.B = B + (size_t)u.pn * tstep; return true; }
    __device__ __forceinline__ unsigned row_tok(const Unit&, int) const { return 0; }
};
template <bool GATHER_> struct MoeOrder {
    static constexpr bool GATHER = GATHER_;
    const char* A; const char* B; const int* tile_e; const int* slot_tok; int nM, nN, G, c; size_t tstep, estep;
    __device__ __forceinline__ void init(const void* A_, const void* B_, const int* tile_e_, const int* slot_tok_, int ntiles, int Nper, int Kbytes, int G_, int c_) {
        A = (const char*)A_; B = (const char*)B_; tile_e = tile_e_; slot_tok = slot_tok_; nM = ntiles; nN = Nper / BM; G = G_; c = c_; tstep = (size_t)BM * Kbytes; estep = (size_t)Nper * Kbytes; }
    __device__ __forceinline__ bool next(int i, Unit& u) const { if (!static_tile(i, G, c, nM, nN, u.pm, u.pn)) return false;
        u.e = __builtin_amdgcn_readfirstlane(tile_e[u.pm]); u.A = GATHER_ ? A : A + (size_t)u.pm * tstep; u.B = B + (size_t)u.e * estep + (size_t)u.pn * tstep; return true; }
    __device__ __forceinline__ unsigned row_tok(const Unit& u, int r) const { return (unsigned)slot_tok[u.pm * BM + r]; }
};

struct EpiBf16 {
    static constexpr bool PERM = true; static constexpr int WSCALE = 127;
    bf16* O; int ldc;
    __device__ __forceinline__ void operator()(const f32x4 (&acc)[2][2][4][2], const Unit& u, int wr, int wc, int fr, int fq) const {
        const int row0 = u.pm * BM + wr * 64 + fr, col0 = u.pn * BM + wc * 32 + 8 * fq;
#pragma unroll
        for (int ai = 0; ai < 2; ++ai)
#pragma unroll
            for (int m = 0; m < 4; ++m) { bf16* rowp = O + (size_t)(row0 + ai * HALF + m * 16) * ldc + col0;
#pragma unroll
                for (int bj = 0; bj < 2; ++bj) { const f32x4 v0 = acc[ai][bj][m][0], v1 = acc[ai][bj][m][1];
                    u32x4 w; w.x = cvt_pk_bf16(v0[0], v0[1]); w.y = cvt_pk_bf16(v0[2], v0[3]); w.z = cvt_pk_bf16(v1[0], v1[1]); w.w = cvt_pk_bf16(v1[2], v1[3]);
                    *(u32x4*)(rowp + bj * HALF) = w; } }
    }
};
struct EpiSwiglu {
    static constexpr bool PERM = false; static constexpr int WSCALE = 123;
    unsigned char* H; const float* bias;
    __device__ __forceinline__ void operator()(const f32x4 (&acc)[2][2][4][2], const Unit& u, int wr, int wc, int fr, int fq) const {
        const int row0 = u.pm * BM + wr * 64 + fr, colh = u.pn * 128 + wc * 32 + 8 * fq;
        const float* bp = bias + (size_t)u.e * 2048 + u.pn * 256 + wc * 32 + 4 * fq;
        f32x4 bv[2][2];
#pragma unroll
        for (int bj = 0; bj < 2; ++bj)
#pragma unroll
            for (int n = 0; n < 2; ++n) bv[bj][n] = *(const f32x4*)(bp + bj * HALF + n * 16);
#pragma unroll
        for (int ai = 0; ai < 2; ++ai)
#pragma unroll
            for (int m = 0; m < 4; ++m) { unsigned char* rowp = H + (size_t)(row0 + ai * HALF + m * 16) * FF + colh;
                float o[8];
#pragma unroll
                for (int n = 0; n < 2; ++n) { const f32x4 g4 = acc[ai][0][m][n] + bv[0][n], u4 = acc[ai][1][m][n] + bv[1][n];
#pragma unroll
                    for (int j = 0; j < 4; ++j) { const float g = fminf(g4[j], 7.0f), up = fminf(fmaxf(u4[j], -7.0f), 7.0f);
                        const float glu = g * __builtin_amdgcn_rcpf(1.0f + __builtin_amdgcn_exp2f(g * (-1.702f * 1.4426950408889634f)));
                        o[n * 4 + j] = (up + 1.0f) * glu; } }
                int w0 = __builtin_amdgcn_cvt_pk_fp8_f32(o[0], o[1], 0, false); w0 = __builtin_amdgcn_cvt_pk_fp8_f32(o[2], o[3], w0, true);
                int w1 = __builtin_amdgcn_cvt_pk_fp8_f32(o[4], o[5], 0, false); w1 = __builtin_amdgcn_cvt_pk_fp8_f32(o[6], o[7], w1, true);
                *(u32x2*)rowp = (u32x2){(unsigned)w0, (unsigned)w1}; }
    }
};
struct EpiDown {
    static constexpr bool PERM = true; static constexpr int WSCALE = 122;
    bf16* Y; const float* bias; const float* slot_gate;
    __device__ __forceinline__ void operator()(const f32x4 (&acc)[2][2][4][2], const Unit& u, int wr, int wc, int fr, int fq) const {
        const int row0 = u.pm * BM + wr * 64 + fr, col0 = u.pn * BM + wc * 32 + 8 * fq;
        const float* bp = bias + (size_t)u.e * 1024 + col0;
        f32x4 bv[2][2];
#pragma unroll
        for (int bj = 0; bj < 2; ++bj)
#pragma unroll
            for (int n = 0; n < 2; ++n) bv[bj][n] = *(const f32x4*)(bp + bj * HALF + 4 * n);
#pragma unroll
        for (int ai = 0; ai < 2; ++ai)
#pragma unroll
            for (int m = 0; m < 4; ++m) { const int row = row0 + ai * HALF + m * 16; const float g = slot_gate[row]; bf16* rowp = Y + (size_t)row * D + col0;
#pragma unroll
                for (int bj = 0; bj < 2; ++bj) { const f32x4 v0 = (acc[ai][bj][m][0] + bv[bj][0]) * g, v1 = (acc[ai][bj][m][1] + bv[bj][1]) * g;
                    u32x4 w; w.x = cvt_pk_bf16(v0[0], v0[1]); w.y = cvt_pk_bf16(v0[2], v0[3]); w.z = cvt_pk_bf16(v1[0], v1[1]); w.w = cvt_pk_bf16(v1[2], v1[3]);
                    *(u32x4*)(rowp + bj * HALF) = w; } }
    }
};

template <class Epi, class Sched, int ES = 2, bool ALIGN_EPI = true>
__device__ __forceinline__ void gemm_phase(LAS unsigned char* lds, const int K, const Sched& S, const Epi& E) {
    constexpr bool GA = Sched::GATHER;
    const int tid = opaque_tid(), wid = __builtin_amdgcn_readfirstlane(tid >> 6), lane = tid & 63, wr = wid >> 2, wc = wid & 3, fr = lane & 15, fq = lane >> 4;
    const int nt = K * ES / (BK * 2);
    unsigned voffA[2], voffB[2]; int Rr[2]; unsigned Cb[2];
#pragma unroll
    for (int i = 0; i < 2; ++i) { int R, C; stage_rc(tid * 16 + i * 8192, R, C); const int Rb = Epi::PERM ? ((R & ~31) + perm32(R & 31)) : R;
        voffA[i] = (unsigned)(R * K * ES + C * 2); voffB[i] = (unsigned)(Rb * K * ES + C * 2); Rr[i] = R; Cb[i] = (unsigned)C * 2u; }
    const size_t kstep = (size_t)(BK * 2);
    const size_t hstep = (size_t)HALF * K * ES;
    const unsigned ldsw = (unsigned)wid * 1024u;
    const int aoff0 = lds_byte(wr * 64 + fr, fq * 8), aoff1 = lds_byte(wr * 64 + fr, fq * 8 + 32);
    const int boff0 = lds_byte(wc * 32 + fr, fq * 8), boff1 = lds_byte(wc * 32 + fr, fq * 8 + 32);
    unsigned cOff[2][2], nOff[2][2], sOff[2][2];
#define PG8_SA(b, h) (((b) * 2 + (h)) * HTB)
#define PG8_SB(b, h) ((4 + (b) * 2 + (h)) * HTB)
#define PG8_STAGE(bufoff, gbase, voff) do { _Pragma("unroll") for (int _i = 0; _i < 2; ++_i) \
        __builtin_amdgcn_global_load_lds((const unsigned*)((const char*)(gbase) + (voff)[_i]), (LAS unsigned*)(lds + (bufoff) + ldsw + _i * 8192), 16, 0, 0); } while (0)
#define PG8_STAGE_A(bufoff, gbase, half, OFF) do { if constexpr (GA) { PG8_STAGE(bufoff, gbase, (OFF)[half]); } else { PG8_STAGE(bufoff, (gbase) + (half) * hstep, voffA); } } while (0)
#define PG8_LDA(dst, b, h) do { if constexpr (ES == 2) { _Pragma("unroll") for (int m = 0; m < 4; ++m) _Pragma("unroll") for (int k = 0; k < 2; ++k) dst[m][k] = *(const LAS bf16x8*)(lds + PG8_SA(b, h) + (k ? aoff1 : aoff0) + m * 2048); } \
        else { _Pragma("unroll") for (int m = 0; m < 4; ++m) dst##8[m] = __builtin_shufflevector(*(const LAS v4i_t*)(lds + PG8_SA(b, h) + aoff0 + m * 2048), *(const LAS v4i_t*)(lds + PG8_SA(b, h) + aoff1 + m * 2048), 0, 1, 2, 3, 4, 5, 6, 7); } } while (0)
#define PG8_LDB(dst, b, h) do { if constexpr (ES == 2) { _Pragma("unroll") for (int n = 0; n < 2; ++n) _Pragma("unroll") for (int k = 0; k < 2; ++k) dst[n][k] = *(const LAS bf16x8*)(lds + PG8_SB(b, h) + (k ? boff1 : boff0) + n * 2048); } \
        else { _Pragma("unroll") for (int n = 0; n < 2; ++n) dst##8[n] = __builtin_shufflevector(*(const LAS v4i_t*)(lds + PG8_SB(b, h) + boff0 + n * 2048), *(const LAS v4i_t*)(lds + PG8_SB(b, h) + boff1 + n * 2048), 0, 1, 2, 3, 4, 5, 6, 7); } } while (0)
#define PG8_MMA(ai, bj, At, Bt) do { __builtin_amdgcn_s_setprio(1); _Pragma("unroll") for (int m = 0; m < 4; ++m) _Pragma("unroll") for (int n = 0; n < 2; ++n) { \
        if constexpr (ES == 2) { _Pragma("unroll") for (int k = 0; k < 2; ++k) acc[ai][bj][m][n] = __builtin_amdgcn_mfma_f32_16x16x32_bf16(Bt[n][k], At[m][k], acc[ai][bj][m][n], 0, 0, 0); } \
        else { asm volatile("v_mfma_scale_f32_16x16x128_f8f6f4 %0, %1, %2, %0, %3, %4 op_sel_hi:[0,0,0]" : "+v"(acc[ai][bj][m][n]) : "v"(Bt##8[n]), "v"(At##8[m]), "v"(wscale_v), "v"(ascale_v)); } } \
        __builtin_amdgcn_s_setprio(0); } while (0)
#define PG8_WAIT_V(n) asm volatile("s_waitcnt vmcnt(" #n ")" ::: "memory")
#define PG8_WAIT_L(n) asm volatile("s_waitcnt lgkmcnt(" #n ")" ::: "memory")
#define PG8_BAR __builtin_amdgcn_s_barrier()
#define PG8_SCHED __builtin_amdgcn_sched_barrier(0)
#define PG8_GOFF(dst, u) do { if constexpr (GA) { _Pragma("unroll") for (int _h = 0; _h < 2; ++_h) _Pragma("unroll") for (int _i = 0; _i < 2; ++_i) \
        dst[_h][_i] = S.row_tok(u, _h * HALF + Rr[_i]) * (unsigned)(K * ES) + Cb[_i]; } } while (0)
    Unit cur, nxt; int ui = 0;
    if (!S.next(0, cur)) return;
    f32x4 acc[2][2][4][2];
#pragma unroll
    for (int a = 0; a < 2; ++a)
#pragma unroll
        for (int b = 0; b < 2; ++b)
#pragma unroll
            for (int m = 0; m < 4; ++m)
#pragma unroll
                for (int n = 0; n < 2; ++n) acc[a][b][m][n] = (f32x4){0.f, 0.f, 0.f, 0.f};
    int wscale_v = Epi::WSCALE, ascale_v = 127; asm volatile("" : "+v"(wscale_v), "+v"(ascale_v));
    bf16x8 At[4][2], B0[2][2], B1[2][2];
    v8i_t At8[4], B08[2], B18[2];
    const char* cA = cur.A; const char* cB = cur.B;
    PG8_GOFF(cOff, cur);
#pragma unroll
    for (int h = 0; h < 2; ++h)
#pragma unroll
        for (int i = 0; i < 2; ++i) { nOff[h][i] = 0u; sOff[h][i] = 0u; }
    if constexpr (GA) { VM_WAIT(); }
    PG8_STAGE(PG8_SB(0, 0), cB, voffB); PG8_STAGE(PG8_SB(0, 1), cB + hstep, voffB); PG8_STAGE_A(PG8_SA(0, 0), cA, 0, cOff); PG8_STAGE_A(PG8_SA(0, 1), cA, 1, cOff);
    if (wr == 1) PG8_BAR;
    PG8_WAIT_V(2); PG8_BAR;
    PG8_STAGE(PG8_SB(1, 0), cB + kstep, voffB); PG8_STAGE_A(PG8_SA(1, 0), cA + kstep, 0, cOff); PG8_STAGE(PG8_SB(1, 1), cB + hstep + kstep, voffB);
    PG8_WAIT_V(6); PG8_BAR;
    for (;;) {
        const bool has_next = S.next(ui + 1, nxt);
        const char* nA = has_next ? nxt.A : cA; const char* nB = has_next ? nxt.B : cB;
        if constexpr (GA) { if (has_next) { PG8_GOFF(nOff, nxt); } else {
#pragma unroll
            for (int h = 0; h < 2; ++h)
#pragma unroll
                for (int i = 0; i < 2; ++i) nOff[h][i] = cOff[h][i]; } }
#pragma unroll 1
        for (int t = 0; t < nt; t += 2) {
            const bool last = (t == nt - 2);
            const char* a1 = cA + (size_t)(t + 1) * kstep;
            const char* a2 = last ? nA : cA + (size_t)(t + 2) * kstep; const char* b2 = last ? nB : cB + (size_t)(t + 2) * kstep;
            const char* a3 = a2 + kstep; const char* b3 = b2 + kstep;
            if constexpr (GA) {
#pragma unroll
                for (int h = 0; h < 2; ++h)
#pragma unroll
                    for (int i = 0; i < 2; ++i) sOff[h][i] = last ? nOff[h][i] : cOff[h][i]; }
            PG8_LDB(B0, 0, 0); PG8_LDB(B1, 0, 1); PG8_SCHED; PG8_LDA(At, 0, 0); PG8_STAGE_A(PG8_SA(1, 1), a1, 1, cOff);
            PG8_WAIT_V(8); PG8_WAIT_L(0); PG8_BAR; PG8_MMA(0, 0, At, B0); PG8_MMA(0, 1, At, B1); PG8_BAR; PG8_SCHED;
            PG8_LDA(At, 0, 1); PG8_STAGE(PG8_SB(0, 0), b2, voffB); PG8_STAGE(PG8_SB(0, 1), b2 + hstep, voffB); PG8_STAGE_A(PG8_SA(0, 0), a2, 0, sOff);
            PG8_WAIT_V(8); PG8_WAIT_L(0); PG8_BAR; PG8_MMA(1, 0, At, B0); PG8_MMA(1, 1, At, B1); PG8_BAR; PG8_SCHED;
            PG8_LDB(B0, 1, 0); PG8_LDB(B1, 1, 1); PG8_SCHED; PG8_LDA(At, 1, 0); PG8_STAGE_A(PG8_SA(0, 1), a2, 1, sOff);
            PG8_WAIT_V(8); PG8_WAIT_L(0); PG8_BAR; PG8_MMA(0, 0, At, B0); PG8_MMA(0, 1, At, B1); PG8_BAR; PG8_SCHED;
            PG8_LDA(At, 1, 1); PG8_STAGE(PG8_SB(1, 0), b3, voffB); PG8_STAGE(PG8_SB(1, 1), b3 + hstep, voffB); PG8_STAGE_A(PG8_SA(1, 0), a3, 0, sOff);
            PG8_WAIT_V(8); PG8_WAIT_L(0); PG8_BAR; PG8_MMA(1, 0, At, B0); PG8_MMA(1, 1, At, B1); PG8_BAR; PG8_SCHED;
        }
        if constexpr (ALIGN_EPI) { if (wr == 0) PG8_BAR; }
        if constexpr (ES == 1) { asm volatile("s_nop 15\n\ts_nop 15" ::: "memory"); }
        E(acc, cur, wr, wc, fr, fq);
        if (!has_next) break;
#pragma unroll
        for (int a = 0; a < 2; ++a)
#pragma unroll
            for (int b = 0; b < 2; ++b)
#pragma unroll
                for (int m = 0; m < 4; ++m)
#pragma unroll
                    for (int n = 0; n < 2; ++n) acc[a][b][m][n] = (f32x4){0.f, 0.f, 0.f, 0.f};
        cur = nxt; cA = nA; cB = nB; ++ui;
        if constexpr (GA) {
#pragma unroll
            for (int h = 0; h < 2; ++h)
#pragma unroll
                for (int i = 0; i < 2; ++i) cOff[h][i] = nOff[h][i]; }
        if constexpr (ALIGN_EPI) { if (wr == 1) PG8_BAR; }
    }
    PG8_WAIT_V(0);
    if constexpr (!ALIGN_EPI) { if (wr == 0) PG8_BAR; }
    PG8_BAR;
#undef PG8_SA
#undef PG8_SB
#undef PG8_STAGE
#undef PG8_STAGE_A
#undef PG8_LDA
#undef PG8_LDB
#undef PG8_MMA
#undef PG8_WAIT_V
#undef PG8_WAIT_L
#undef PG8_BAR
#undef PG8_SCHED
#undef PG8_GOFF
}
}

#define XB_TMO      128
#define XB_XCNT(j)  (256  + 64 * (j))
#define XB_XSUB(j)  (1280 + 64 * (j))
#define XB_XGEN(j)  (2304 + 64 * (j))
#define XB_TOP      3328
#define XB_TOPGEN   3392
#define XCD_BAR_WORDS 3456
#define XB_SPIN_CAP (1u << 18)
__device__ __forceinline__ unsigned xb_ld(unsigned* p)              { return __hip_atomic_load(p, __ATOMIC_RELAXED, __HIP_MEMORY_SCOPE_AGENT); }
__device__ __forceinline__ unsigned xb_add(unsigned* p, unsigned v) { return __hip_atomic_fetch_add(p, v, __ATOMIC_RELAXED, __HIP_MEMORY_SCOPE_AGENT); }
__device__ __forceinline__ unsigned xb_xcc_id() { return (unsigned)__builtin_amdgcn_s_getreg((3 << 11) | 20) & 0xFu; }
#define XB_SPIN(cond, bar) do { unsigned _sp = 0; while (cond) { __builtin_amdgcn_s_sleep(1); \
    if ((++_sp & 255u) == 0u) { if (xb_ld(&(bar)[XB_TMO])) break; if (_sp > XB_SPIN_CAP) { atomicAdd(&(bar)[XB_TMO], 1u); break; } } } } while (0)
struct XcdBarrier { unsigned* bar; unsigned x; volatile LAS unsigned* st; };
__device__ __forceinline__ XcdBarrier xcd_barrier_post(unsigned* bar, volatile LAS unsigned* st) {
    XcdBarrier b; b.bar = bar; b.x = xb_xcc_id(); b.st = st;
    if (threadIdx.x == 0) (void)xb_add(&bar[XB_XCNT(b.x)], 1u);
    return b;
}
__device__ __forceinline__ void xcd_barrier_complete(unsigned* bar, unsigned x, unsigned& nloc, unsigned& nx) {
    const unsigned G = gridDim.x * gridDim.y * gridDim.z;
    unsigned sum, cnt, mine, sp = 0u;
    for (;;) {
        sum = 0u; cnt = 0u; mine = 0u;
#pragma unroll
        for (unsigned j = 0; j < 16; ++j) { const unsigned c = xb_ld(&bar[XB_XCNT(j)]); sum += c; cnt += (c > 0u) ? 1u : 0u; mine = (j == x) ? c : mine; }
        if (sum == G) break;
        __builtin_amdgcn_s_sleep(1);
        if ((++sp & 255u) == 0u) { if (xb_ld(&bar[XB_TMO])) break; if (sp > XB_SPIN_CAP) { atomicAdd(&bar[XB_TMO], 1u); break; } }
    }
    nloc = mine > 0u ? mine : 1u; nx = cnt > 0u ? cnt : 1u;
}
__device__ __forceinline__ void xcd_barrier(const XcdBarrier& b) {
    asm volatile("s_waitcnt vmcnt(0)" ::: "memory");
    __syncthreads();
    if (threadIdx.x == 0) {
        unsigned* bar = b.bar;
        __builtin_amdgcn_s_waitcnt(0);
        unsigned nloc = b.st[0], nx = b.st[1];
        if (nloc == 0u) { xcd_barrier_complete(bar, b.x, nloc, nx); b.st[0] = nloc; b.st[1] = nx; }
        const unsigned old = xb_add(&bar[XB_XSUB(b.x)], 1u);
        const unsigned gen = old / nloc;
        if (old + 1u == (gen + 1u) * nloc) {
            __builtin_amdgcn_fence(__ATOMIC_RELEASE, "agent");
            asm volatile("s_waitcnt vmcnt(0)" ::: "memory");
            const unsigned og = xb_add(&bar[XB_TOP], 1u);
            const unsigned tg = og / nx;
            if (og + 1u == (tg + 1u) * nx) xb_add(&bar[XB_TOPGEN], 1u);
            else XB_SPIN(xb_ld(&bar[XB_TOPGEN]) == tg, bar);
            __builtin_amdgcn_fence(__ATOMIC_ACQUIRE, "agent");
            xb_add(&bar[XB_XGEN(b.x)], 1u);
            asm volatile("s_waitcnt vmcnt(0)" ::: "memory");
        } else {
            XB_SPIN(xb_ld(&bar[XB_XGEN(b.x)]) == gen, bar);
            __builtin_amdgcn_fence(__ATOMIC_ACQUIRE, "agent");
            asm volatile("s_waitcnt vmcnt(0)" ::: "memory");
        }
    }
    __syncthreads();
}

struct Args {
    const float* in[33];
    float* out; unsigned char* ws;
    int ph_lo, ph_hi;
};
enum { I_X = 0, I_MEM, I_WIN, I_GLACONV, I_GLAW2, I_GLAB, I_GLANG, I_HGLB, I_HGNG, I_RWMU, I_RWW0, I_RWW2, I_RWA0, I_RWA2, I_RWG2, I_RWKK, I_RWKA, I_RWRK, I_RWLNW, I_RWLNB,
       I_WMK, I_WMV, I_WOUT, I_LN1G, I_LN1B, I_RTW, I_RTB, I_WGU, I_BGU, I_WDN, I_BDN, I_LN2G, I_LN2B };


template <int OFF> __device__ __forceinline__ unsigned long long ka_u64() { unsigned long long v; asm volatile("s_load_dwordx2 %0, %1, %2\n\ts_waitcnt lgkmcnt(0)" : "=s"(v) : "s"(__builtin_amdgcn_kernarg_segment_ptr()), "n"(OFF)); return v; }
#define KIN(i) ((const float*)(const GAS float*)ka_u64<8 * (i)>())
#define KOUT() ((float*)(GAS float*)ka_u64<264>())
#define KWS() ((unsigned char*)(GAS unsigned char*)ka_u64<272>())

template <class Map>
__device__ __forceinline__ void tr_item(const float* __restrict__ W, int K, int N, bf16* __restrict__ WT, LAS float* scr, int kb, int nb, int lane, Map map) {
    const int k0 = 64 * kb, n0 = 64 * nb, col = n0 + lane; const bool valid = col < N;
    const float* src = W + (size_t)k0 * N + (valid ? col : 0);
#pragma unroll 16
    for (int kk = 0; kk < 64; ++kk) { const float v = valid ? src[(size_t)kk * N] : 0.f; scr[kk * 65 + lane] = v; }
    LDS_WAIT(); asm volatile("" ::: "memory");
    const int c = lane & 7;
#pragma unroll
    for (int j = 0; j < 8; ++j) { const int n = (lane >> 3) + 8 * j;
        if (n0 + n < N) { const int orow = map(n0 + n); const LAS float* s = scr + (8 * c) * 65 + n;
            u32x4 o; o.x = pk2(s[0 * 65], s[1 * 65]); o.y = pk2(s[2 * 65], s[3 * 65]); o.z = pk2(s[4 * 65], s[5 * 65]); o.w = pk2(s[6 * 65], s[7 * 65]);
            *(u32x4*)(WT + (size_t)orow * K + k0 + 8 * c) = o; } }
    LDS_WAIT(); asm volatile("" ::: "memory");
}
template <class Map>
__device__ __forceinline__ void tr_item_f8(const float* __restrict__ W, int K, int N, unsigned char* __restrict__ WT8, LAS float* scr, int kb, int nb, int lane, float scale, Map map) {
    const int k0 = 64 * kb, n0 = 64 * nb, col = n0 + lane;
    const float* src = W + (size_t)k0 * N + col;
#pragma unroll 16
    for (int kk = 0; kk < 64; ++kk) scr[kk * 65 + lane] = src[(size_t)kk * N] * scale;
    LDS_WAIT(); asm volatile("" ::: "memory");
    const int c = lane & 3;
#pragma unroll
    for (int j = 0; j < 4; ++j) { const int n = (lane >> 2) + 16 * j; const int orow = map(n0 + n); const LAS float* s = scr + (16 * c) * 65 + n;
        u32x4 o;
#pragma unroll
        for (int q = 0; q < 4; ++q) { int w = __builtin_amdgcn_cvt_pk_fp8_f32(s[(4 * q) * 65], s[(4 * q + 1) * 65], 0, false); w = __builtin_amdgcn_cvt_pk_fp8_f32(s[(4 * q + 2) * 65], s[(4 * q + 3) * 65], w, true); o[q] = (unsigned)w; }
        *(u32x4*)(WT8 + (size_t)orow * K + k0 + 16 * c) = o; }
    LDS_WAIT(); asm volatile("" ::: "memory");
}
struct MapIdent { int off; __device__ __forceinline__ int operator()(int c) const { return c + off; } };
struct MapWin { __device__ __forceinline__ int operator()(int c) const { return c < 512 ? c : (c < 528 ? c + 2560 : c - 16); } };
__device__ __forceinline__ int gu_row(int c) { const int f = c >> 1, bj = c & 1, pn = f >> 7, fl = f & 127, wc = fl >> 5, fq = (fl >> 3) & 3, n = (fl >> 2) & 1, j = fl & 3; return 256 * pn + 128 * bj + 32 * wc + 16 * n + 4 * fq + j; }
struct MapGu { __device__ __forceinline__ int operator()(int c) const { return gu_row(c); } };

__device__ __forceinline__ void prologue_phase(LAS unsigned char* lds, int vcu, int G) {
    const int tid = opaque_tid(), lane = tid & 63, wave = __builtin_amdgcn_readfirstlane(tid >> 6);
    LAS float* scr = (LAS float*)(lds + wave * 16640); static_assert(8 * 16640 <= LDSCTL_OFF, "prologue scratch below the LDS control words");
    const int gw = vcu * NWAVES + wave, NGW = G * NWAVES;
    unsigned char* ws = KWS();
    constexpr int IT_GU = NL * NE * 512, IT_DN = NL * NE * 256, IT_IN = NL * 16 * 49, IT_OUT = NL * 256, IT_MEM = NL * 2 * 64, IT_L64 = NL * 2 * 4, IT_L128 = NL * 2 * 4;
    constexpr int IT_TOTAL = IT_GU + IT_DN + IT_IN + IT_OUT + IT_MEM + IT_L64 + IT_L128;
    for (int it = gw; it < IT_TOTAL; it += NGW) {
        int r = it;
        if (r < IT_GU) { const int le = r >> 9, q = r & 511, kb = q >> 5, nb = q & 31;
            tr_item_f8(KIN(I_WGU) + (size_t)le * 1024 * 2048, 1024, 2048, (unsigned char*)(ws + WS_WGU) + (size_t)le * 2048 * 1024, scr, kb, nb, lane, 16.0f, MapGu{}); continue; } r -= IT_GU;
        if (r < IT_DN) { const int le = r >> 8, q = r & 255, kb = q >> 4, nb = q & 15;
            tr_item_f8(KIN(I_WDN) + (size_t)le * 1024 * 1024, 1024, 1024, (unsigned char*)(ws + WS_WD) + (size_t)le * 1024 * 1024, scr, kb, nb, lane, 32.0f, MapIdent{0}); continue; } r -= IT_DN;
        if (r < IT_IN) { const int l = r / (16 * 49), q = r % (16 * 49), kb = q / 49, nb = q % 49;
            tr_item(KIN(I_WIN) + (size_t)l * 1024 * PIN, 1024, PIN, (bf16*)(ws + WS_WIN) + (size_t)l * PINP * 1024, scr, kb, nb, lane, MapWin{}); continue; } r -= IT_IN;
        if (r < IT_OUT) { const int l = r >> 8, q = r & 255, kb = q >> 4, nb = q & 15;
            tr_item(KIN(I_WOUT) + (size_t)l * 1024 * 1024, 1024, 1024, (bf16*)(ws + WS_WOUT) + (size_t)l * 1024 * 1024, scr, kb, nb, lane, MapIdent{0}); continue; } r -= IT_OUT;
        if (r < IT_MEM) { const int l = r >> 7, q = r & 127, kv = q >> 6, kb = (q >> 2) & 15, nb = q & 3;
            tr_item((kv ? KIN(I_WMV) : KIN(I_WMK)) + (size_t)l * 1024 * 256, 1024, 256, (bf16*)(ws + WS_WMEM), scr, kb, nb, lane, MapIdent{l * 512 + kv * 256}); continue; } r -= IT_MEM;
        if (r < IT_L64) { const int l = r >> 3, q = r & 7, wa = q >> 2, nb = q & 3;
            tr_item((wa ? KIN(I_RWA2) : KIN(I_RWW2)) + (size_t)l * 64 * 256, 64, 256, (bf16*)(ws + WS_LORA) + (size_t)wa * (NL * 256 * 64) + (size_t)l * 256 * 64, scr, 0, nb, lane, MapIdent{0}); continue; } r -= IT_L64;
        { const int l = r >> 3, q = r & 7, kb = q >> 2, nb = q & 3;
            tr_item(KIN(I_RWG2) + (size_t)l * 128 * 256, 128, 256, (bf16*)(ws + WS_LORA) + (size_t)2 * (NL * 256 * 64) + (size_t)l * 256 * 128, scr, kb, nb, lane, MapIdent{0}); }
    }
    { const size_t gt = (size_t)vcu * NTHR + tid, GT = (size_t)G * NTHR; constexpr size_t per = (size_t)(PINP - PIN) * 1024 / 8;
        for (size_t i = gt; i < per * NL; i += GT) { const size_t l = i / per, j = i % per; *(u32x4*)((bf16*)(ws + WS_WIN) + l * PINP * 1024 + (size_t)PIN * 1024 + j * 8) = (u32x4){0u, 0u, 0u, 0u}; }
        for (size_t i = gt; i < (size_t)NL * NE * 2048; i += GT) { const size_t le = i >> 11; const int c = (int)(i & 2047); ((float*)(ws + WS_BGU))[le * 2048 + gu_row(c)] = KIN(I_BGU)[i]; }
        const f32x4* xs = (const f32x4*)KIN(I_X); u32x4* xd = (u32x4*)(ws + WS_XB);
        for (size_t i = gt; i < (size_t)NTOK * D / 8; i += GT) { const f32x4 v0 = xs[2 * i], v1 = xs[2 * i + 1]; xd[i] = (u32x4){pk2(v0[0], v0[1]), pk2(v0[2], v0[3]), pk2(v1[0], v1[1]), pk2(v1[2], v1[3])}; }
        const f32x4* ms = (const f32x4*)KIN(I_MEM); u32x4* md = (u32x4*)(ws + WS_MEMB);
        for (size_t i = gt; i < (size_t)NB * NMEM * D / 8; i += GT) { const f32x4 v0 = ms[2 * i], v1 = ms[2 * i + 1]; md[i] = (u32x4){pk2(v0[0], v0[1]), pk2(v0[2], v0[3]), pk2(v1[0], v1[1]), pk2(v1[2], v1[3])}; }
    }
}


__device__ __forceinline__ float log1pexp_neg_abs(float z) { return __builtin_amdgcn_logf(1.0f + fast_exp(-fabsf(z))) * 0.6931471805599453f; }
__device__ __forceinline__ float tanh_f(float x) { const float e = fast_exp(-2.0f * fabsf(x)); const float t = (1.0f - e) * __builtin_amdgcn_rcpf(1.0f + e); return x < 0.f ? -t : t; }

constexpr int NCH = T / 32;
__device__ __forceinline__ int rho16(int r, int hh) { return (r & 3) + 8 * (r >> 2) + 4 * hh; }
__device__ __forceinline__ void hg_fused_unit(LAS unsigned char* lds, int l, int b, int c) {
    const int tid = opaque_tid(), lane = tid & 63, wave = __builtin_amdgcn_readfirstlane(tid >> 6), r32 = lane & 31, hh = lane >> 5;
    unsigned char* ws = KWS();
    const bf16* P = (const bf16*)(ws + WS_P) + ((size_t)b * T + c * 32) * PINP;
    constexpr int HB = 16640;
    if (tid < 256) {
        const int ch = tid, h = ch >> 6, d = ch & 63; const size_t un = (size_t)(b * 4 + h) * NCH + c;
        float lb;
        { const float* hp = KIN(I_HGLB) + ch; const float v0 = hp[0], v1 = hp[256], v2 = hp[512], v3 = hp[768]; const float m = fmaxf(fmaxf(v0, v1), fmaxf(v2, v3));
          const float e0 = __expf(v0 - m), e1 = __expf(v1 - m), e2 = __expf(v2 - m), e3 = __expf(v3 - m); const float inv = 1.0f / (e0 + e1 + e2 + e3);
          lb = (l >= 1 ? e1 : 0.f) + (l >= 2 ? e2 : 0.f) + (l >= 3 ? e3 : 0.f); lb *= inv; }
        const float oml = 1.0f - lb;
        LAS bf16* KT = (LAS bf16*)(lds + h * HB); LAS float* BE = (LAS float*)(lds + h * HB + 8192);
        LAS bf16* QL = (LAS bf16*)(lds + h * HB + 8448) + d; LAS bf16* KL = (LAS bf16*)(lds + h * HB + 12544) + d;
        float bc = 0.f;
        unsigned short hqr[32], hfr[32];
#pragma unroll
        for (int t = 0; t < 32; ++t) { const bf16* row = P + (size_t)t * PINP; hqr[t] = row[PC_HQ + ch]; hfr[t] = row[PC_HF + ch]; }
#pragma unroll
        for (int t8 = 0; t8 < 4; ++t8) { u32x4 kp;
#pragma unroll
            for (int jj = 0; jj < 4; ++jj) { float k2[2];
#pragma unroll
                for (int e = 0; e < 2; ++e) { const int t = t8 * 8 + jj * 2 + e; const float hf = bf2f(hfr[t]); const float s = fast_sigmoid(hf), sn = fast_sigmoid(-hf);
                    bc = fmaxf(bc + __builtin_amdgcn_logf(fmaxf(lb + oml * s, 1e-30f)) * 0.6931471805599453f, -80.0f);
                    const float qt = silu_f(bf2f(hqr[t])) * fast_exp(bc), kt = oml * sn * fast_exp(-bc);
                    QL[t * 64] = (bf16)f2bf(qt); KL[t * 64] = (bf16)f2bf(kt); k2[e] = kt; }
                kp[jj] = pk2(k2[0], k2[1]); }
            *(LAS u32x4*)(KT + d * 32 + t8 * 8) = kp; }
        const float ebend = fast_exp(bc); BE[d] = ebend; ((float*)(ws + WS_HBE))[un * 64 + d] = ebend;
    } else {
        const int cv = tid - 256, h = cv >> 6, vi = cv & 63; const size_t un = (size_t)(b * 4 + h) * NCH + c;
        LAS bf16* VT = (LAS bf16*)(lds + h * HB + 4096); bf16* VTg = (bf16*)(ws + WS_HVT) + un * 2048 + vi * 32;
        unsigned short hvr[32];
#pragma unroll
        for (int t = 0; t < 32; ++t) hvr[t] = P[(size_t)t * PINP + PC_HI + cv];
#pragma unroll
        for (int t8 = 0; t8 < 4; ++t8) { u32x4 vp;
#pragma unroll
            for (int jj = 0; jj < 4; ++jj) vp[jj] = (unsigned)hvr[t8 * 8 + 2 * jj] | ((unsigned)hvr[t8 * 8 + 2 * jj + 1] << 16);
            *(LAS u32x4*)(VT + vi * 32 + t8 * 8) = vp; *(u32x4*)(VTg + t8 * 8) = vp; }
    }
    lds_barrier();
    { const int h = wave >> 1, vt = wave & 1; const size_t un = (size_t)(b * 4 + h) * NCH + c;
      const LAS bf16* KT = (const LAS bf16*)(lds + h * HB); const LAS bf16* VT = (const LAS bf16*)(lds + h * HB + 4096); const LAS float* BE = (const LAS float*)(lds + h * HB + 8192);
      bf16* DSg = (bf16*)(ws + WS_HDS) + un * 4096;
      { const LAS bf16* srcL = (const LAS bf16*)(lds + h * HB + (vt == 0 ? 8448 : 12544)); u32x4* dstG = (u32x4*)((bf16*)(ws + (vt == 0 ? WS_HQ : WS_HK)) + un * 2048);
#pragma unroll
        for (int i = 0; i < 4; ++i) dstG[i * 64 + lane] = *(const LAS u32x4*)(srcL + (i * 64 + lane) * 8); }
#pragma unroll
      for (int dt = 0; dt < 2; ++dt) { f32x16 acc;
#pragma unroll
          for (int i = 0; i < 16; ++i) acc[i] = 0.f;
#pragma unroll
          for (int s = 0; s < 2; ++s) { const bf16x8 A = *(const LAS bf16x8*)(VT + (32 * vt + r32) * 32 + 16 * s + 8 * hh), B = *(const LAS bf16x8*)(KT + (32 * dt + r32) * 32 + 16 * s + 8 * hh);
              acc = __builtin_amdgcn_mfma_f32_32x32x16_bf16(A, B, acc, 0, 0, 0); }
          const float ebd = BE[32 * dt + r32];
#pragma unroll
          for (int r = 0; r < 16; ++r) DSg[(32 * vt + rho16(r, hh)) * 64 + 32 * dt + r32] = (bf16)f2bf(acc[r] * ebd); } }
    lds_barrier();
}
__device__ __forceinline__ void gla_fused_unit(LAS unsigned char* lds, int l, int b, int c) {
    const int tid = opaque_tid(), lane = tid & 63, wave = __builtin_amdgcn_readfirstlane(tid >> 6), r32 = lane & 31, hh = lane >> 5;
    unsigned char* ws = KWS();
    const int t0 = c * 32;
    const bf16* P = (const bf16*)(ws + WS_P) + ((size_t)b * T + t0) * PINP;
    LAS float* GL = (LAS float*)lds;
    constexpr int HB = 10368, H0 = 2048;
    GL[tid] = bf2f(P[(size_t)(tid >> 4) * PINP + PC_GLR + (tid & 15)]);
    lds_barrier();
    if (tid < 128) {
        const int ch = tid, h = ch >> 5, d = ch & 31; const size_t un = (size_t)(b * 4 + h) * NCH + c;
        const float* cw = KIN(I_GLACONV) + (size_t)l * 4 * 512 + ch;
        const float q0 = cw[0], q1 = cw[512], q2 = cw[1024], q3 = cw[1536], k0 = cw[128], k1 = cw[640], k2w = cw[1152], k3 = cw[1664];
        const float* w2p = KIN(I_GLAW2) + (size_t)l * 16 * 128 + ch; float wc[16];
#pragma unroll
        for (int r = 0; r < 16; ++r) wc[r] = w2p[r * 128];
        const float gb = KIN(I_GLAB)[l * 128 + ch];
        float uq0 = 0.f, uq1 = 0.f, uq2 = 0.f, uk0 = 0.f, uk1 = 0.f, uk2 = 0.f;
        if (t0 > 0) { uq0 = bf2f(*(P - 3 * PINP + PC_GQ + ch)); uq1 = bf2f(*(P - 2 * PINP + PC_GQ + ch)); uq2 = bf2f(*(P - PINP + PC_GQ + ch));
                      uk0 = bf2f(*(P - 3 * PINP + PC_GK + ch)); uk1 = bf2f(*(P - 2 * PINP + PC_GK + ch)); uk2 = bf2f(*(P - PINP + PC_GK + ch)); }
        LAS bf16* KT = (LAS bf16*)(lds + H0 + h * HB); LAS float* BE = (LAS float*)(lds + H0 + h * HB + 6144);
        LAS bf16* QL = (LAS bf16*)(lds + H0 + h * HB + 6272) + d; LAS bf16* KL = (LAS bf16*)(lds + H0 + h * HB + 8320) + d;
        float bc = 0.f;
        unsigned short xqr[32], xkr[32];
#pragma unroll
        for (int t = 0; t < 32; ++t) { const bf16* row = P + (size_t)t * PINP; xqr[t] = row[PC_GQ + ch]; xkr[t] = row[PC_GK + ch]; }
#pragma unroll
        for (int t8 = 0; t8 < 4; ++t8) { u32x4 kp;
#pragma unroll
            for (int jj = 0; jj < 4; ++jj) { float kk2[2];
#pragma unroll
                for (int e = 0; e < 2; ++e) { const int t = t8 * 8 + jj * 2 + e; const float uq3 = bf2f(xqr[t]), uk3 = bf2f(xkr[t]);
                    const float q = silu_f(q0 * uq0 + q1 * uq1 + q2 * uq2 + q3 * uq3) * 0.17677669529663687f, k = silu_f(k0 * uk0 + k1 * uk1 + k2w * uk2 + k3 * uk3);
                    uq0 = uq1; uq1 = uq2; uq2 = uq3; uk0 = uk1; uk1 = uk2; uk2 = uk3;
                    float z = gb;
#pragma unroll
                    for (int r = 0; r < 16; ++r) z += GL[t * 16 + r] * wc[r];
                    bc = fmaxf(bc + (fminf(z, 0.f) - log1pexp_neg_abs(z)) * 0.0625f, -80.0f);
                    const float qt = q * fast_exp(bc), kt = k * fast_exp(-bc);
                    QL[t * 32] = (bf16)f2bf(qt); KL[t * 32] = (bf16)f2bf(kt); kk2[e] = kt; }
                kp[jj] = pk2(kk2[0], kk2[1]); }
            *(LAS u32x4*)(KT + d * 32 + t8 * 8) = kp; }
        const float ebend = fast_exp(bc); BE[d] = ebend; ((float*)(ws + WS_GBE))[un * 32 + d] = ebend;
    } else if (tid < 384) {
        const int cv = tid - 128, h = cv >> 6, vi = cv & 63; const size_t un = (size_t)(b * 4 + h) * NCH + c;
        const float* cw = KIN(I_GLACONV) + (size_t)l * 4 * 512 + 256 + cv;
        const float w0 = cw[0], w1 = cw[512], w2 = cw[1024], w3 = cw[1536];
        float u0 = 0.f, u1 = 0.f, u2 = 0.f;
        if (t0 > 0) { u0 = bf2f(*(P - 3 * PINP + PC_GV + cv)); u1 = bf2f(*(P - 2 * PINP + PC_GV + cv)); u2 = bf2f(*(P - PINP + PC_GV + cv)); }
        LAS bf16* VT = (LAS bf16*)(lds + H0 + h * HB + 2048); bf16* VTg = (bf16*)(ws + WS_GVT) + un * 2048 + vi * 32;
        unsigned short xvr[32];
#pragma unroll
        for (int t = 0; t < 32; ++t) xvr[t] = P[(size_t)t * PINP + PC_GV + cv];
#pragma unroll
        for (int t8 = 0; t8 < 4; ++t8) { u32x4 vp; float yv[8];
#pragma unroll
            for (int e = 0; e < 8; ++e) { const float u3 = bf2f(xvr[t8 * 8 + e]); yv[e] = silu_f(w0 * u0 + w1 * u1 + w2 * u2 + w3 * u3); u0 = u1; u1 = u2; u2 = u3; }
#pragma unroll
            for (int jj = 0; jj < 4; ++jj) vp[jj] = pk2(yv[2 * jj], yv[2 * jj + 1]);
            *(LAS u32x4*)(VT + vi * 32 + t8 * 8) = vp; *(u32x4*)(VTg + t8 * 8) = vp; }
    }
    lds_barrier();
    { const int h = wave >> 1, vt = wave & 1; const size_t un = (size_t)(b * 4 + h) * NCH + c;
      const LAS bf16* KT = (const LAS bf16*)(lds + H0 + h * HB); const LAS bf16* VT = (const LAS bf16*)(lds + H0 + h * HB + 2048); const LAS float* BE = (const LAS float*)(lds + H0 + h * HB + 6144);
      bf16* DSg = (bf16*)(ws + WS_GDS) + un * 2048;
      { const LAS bf16* srcL = (const LAS bf16*)(lds + H0 + h * HB + (vt == 0 ? 6272 : 8320)); u32x4* dstG = (u32x4*)((bf16*)(ws + (vt == 0 ? WS_GQ : WS_GK)) + un * 1024);
#pragma unroll
        for (int i = 0; i < 2; ++i) dstG[i * 64 + lane] = *(const LAS u32x4*)(srcL + (i * 64 + lane) * 8); }
      f32x16 acc;
#pragma unroll
      for (int i = 0; i < 16; ++i) acc[i] = 0.f;
#pragma unroll
      for (int s = 0; s < 2; ++s) { const bf16x8 A = *(const LAS bf16x8*)(VT + (32 * vt + r32) * 32 + 16 * s + 8 * hh), B = *(const LAS bf16x8*)(KT + r32 * 32 + 16 * s + 8 * hh);
          acc = __builtin_amdgcn_mfma_f32_32x32x16_bf16(A, B, acc, 0, 0, 0); }
      const float ebd = BE[r32];
#pragma unroll
      for (int r = 0; r < 16; ++r) DSg[(32 * vt + rho16(r, hh)) * 32 + r32] = (bf16)f2bf(acc[r] * ebd); }
    lds_barrier();
}
template <int DK>
__device__ __forceinline__ void m2_gh_elem2(int e2, const bf16* __restrict__ DS, const float* __restrict__ BE, bf16* __restrict__ SG) {
    constexpr int EPB = 64 * DK; const int e = e2 * 2, bh = e / EPB, idx = e % EPB, d = idx % DK; const size_t un0 = (size_t)bh * NCH;
    float S0 = 0.f, S1 = 0.f;
#pragma unroll 1
    for (int c0 = 0; c0 < NCH; c0 += 16) { unsigned ds[16]; f32x2 be[16];
#pragma unroll
        for (int u = 0; u < 16; ++u) { ds[u] = *(const unsigned*)(DS + (un0 + c0 + u) * EPB + idx); be[u] = *(const f32x2*)(BE + (un0 + c0 + u) * DK + d); }
#pragma unroll
        for (int u = 0; u < 16; ++u) { *(unsigned*)(SG + (un0 + c0 + u) * EPB + idx) = pk2(S0, S1); S0 = S0 * be[u][0] + bflo(ds[u]); S1 = S1 * be[u][1] + bfhi(ds[u]); } }
}
template <int DK>
__device__ __forceinline__ void m3_gh_task(int lane, const bf16* __restrict__ Qg, const bf16* __restrict__ Kg, const bf16* __restrict__ VTg, const bf16* __restrict__ Sg,
                                           const bf16* __restrict__ gate  , const float* __restrict__ ng  , bf16* __restrict__ orow  ) {
    const int r32 = lane & 31, hh = lane >> 5;
    bf16x8 qf[DK / 16];
    f32x16 at;
#pragma unroll
    for (int i = 0; i < 16; ++i) at[i] = 0.f;
#pragma unroll
    for (int s = 0; s < DK / 16; ++s) { qf[s] = *(const bf16x8*)(Qg + r32 * DK + 16 * s + 8 * hh); const bf16x8 kf = *(const bf16x8*)(Kg + r32 * DK + 16 * s + 8 * hh);
        at = __builtin_amdgcn_mfma_f32_32x32x16_bf16(kf, qf[s], at, 0, 0, 0); }
#pragma unroll
    for (int r = 0; r < 16; ++r) if (rho16(r, hh) > r32) at[r] = 0.f;
    f32x16 o[2];
#pragma unroll
    for (int vt = 0; vt < 2; ++vt)
#pragma unroll
        for (int i = 0; i < 16; ++i) o[vt][i] = 0.f;
#pragma unroll
    for (int s = 0; s < 2; ++s) { union { bf16x8 v; unsigned w[4]; } pf;
#pragma unroll
        for (int j = 0; j < 4; ++j) pf.w[j] = cvt_pk_bf16(at[8 * s + 2 * j], at[8 * s + 2 * j + 1]);
#pragma unroll
        for (int vt = 0; vt < 2; ++vt) { const bf16* vp = VTg + (32 * vt + r32) * 32 + 16 * s + 4 * hh;
            union { bf16x8 v; s16x4 h2[2]; } vf; vf.h2[0] = *(const s16x4*)vp; vf.h2[1] = *(const s16x4*)(vp + 8);
            o[vt] = __builtin_amdgcn_mfma_f32_32x32x16_bf16(vf.v, pf.v, o[vt], 0, 0, 0); } }
#pragma unroll
    for (int vt = 0; vt < 2; ++vt)
#pragma unroll
        for (int s = 0; s < DK / 16; ++s) { const bf16x8 sf = *(const bf16x8*)(Sg + (32 * vt + r32) * DK + 16 * s + 8 * hh);
            o[vt] = __builtin_amdgcn_mfma_f32_32x32x16_bf16(sf, qf[s], o[vt], 0, 0, 0); }
    float ss = 0.f;
#pragma unroll
    for (int vt = 0; vt < 2; ++vt)
#pragma unroll
        for (int i = 0; i < 16; ++i) ss += o[vt][i] * o[vt][i];
    ss += __shfl_xor(ss, 32);
    const float rstd = 1.0f / sqrtf(ss * (1.0f / 64.0f) + RMS_EPS);
    const bf16* grow = gate + (size_t)r32 * PINP; bf16* od = orow + (size_t)r32 * D;
#pragma unroll
    for (int vt = 0; vt < 2; ++vt)
#pragma unroll
        for (int g = 0; g < 4; ++g) { const int v0 = 32 * vt + 8 * g + 4 * hh; const u32x2 gw = *(const u32x2*)(grow + v0); const f32x4 n4 = *(const f32x4*)(ng + v0);
            const float y0 = o[vt][4 * g] * rstd * n4[0] * silu_f(bflo(gw.x)), y1 = o[vt][4 * g + 1] * rstd * n4[1] * silu_f(bfhi(gw.x));
            const float y2 = o[vt][4 * g + 2] * rstd * n4[2] * silu_f(bflo(gw.y)), y3 = o[vt][4 * g + 3] * rstd * n4[3] * silu_f(bfhi(gw.y));
            *(u32x2*)(od + v0) = (u32x2){pk2(y0, y1), pk2(y2, y3)}; }
}

constexpr int RWC_HEADB = 28928;
constexpr int RWC_AL = 4 * RWC_HEADB, RWC_LWL = RWC_AL + 32 * 264 * 2;
static_assert(RWC_LWL + 32 * 264 * 2 <= LDSCTL_OFF, "rw_fused_unit LDS");
__device__ __forceinline__ void rw_fused_unit(LAS unsigned char* lds, int l, int b, int c) {
    const int tid = opaque_tid(), lane = tid & 63, wave = __builtin_amdgcn_readfirstlane(tid >> 6), h = wave >> 1, p = wave & 1, r32 = lane & 31, hh = lane >> 5;
    unsigned char* ws = KWS();
    const int bh = b * 4 + h; const size_t un = (size_t)bh * NCH + c;
    const int t0 = c * 32;
    const bf16* P = (const bf16*)(ws + WS_P) + ((size_t)b * T + t0) * PINP + PC_RW;
    const float* mu = KIN(I_RWMU) + (size_t)l * 1024;
    LAS bf16* XL = (LAS bf16*)lds;
    LAS bf16* AL = (LAS bf16*)(lds + RWC_AL);
    LAS bf16* LWL = (LAS bf16*)(lds + RWC_LWL);
    { const int cc = tid & 255, tp = tid >> 8; const float mc = mu[768 + cc];
      unsigned short xr[17];
#pragma unroll
      for (int j = 0; j < 17; ++j) { const int tk = tp * 16 + j - 1; xr[j] = (t0 + tk >= 0) ? P[(long)tk * PINP + 768 + cc] : (unsigned short)0; }
#pragma unroll
      for (int j = 0; j < 16; ++j) { const float cur = bf2f(xr[j + 1]), prev = bf2f(xr[j]);
          float x = cur + (prev - cur) * mc;
          if (cc < 64) x = tanh_f(x); else if (cc >= 128) x = fast_sigmoid(x);
          XL[(tp * 16 + j) * 264 + cc] = (bf16)f2bf(x); } }
    lds_barrier();
    {
        const int ch = wave * 32 + r32;
        const bf16* w2T = (const bf16*)(ws + WS_LORA) + (size_t)l * 256 * 64 + (size_t)ch * 64;
        const bf16* a2T = (const bf16*)(ws + WS_LORA) + (size_t)(NL * 256 * 64) + (size_t)l * 256 * 64 + (size_t)ch * 64;
        const bf16* g2T = (const bf16*)(ws + WS_LORA) + (size_t)2 * (NL * 256 * 64) + (size_t)l * 256 * 128 + (size_t)ch * 128;
        const LAS bf16* xa = XL + r32 * 264 + 8 * hh;
        {
            f32x16 acc;
#pragma unroll
            for (int i = 0; i < 16; ++i) acc[i] = 0.f;
#pragma unroll
            for (int s = 0; s < 4; ++s) { const bf16x8 A = *(const LAS bf16x8*)(xa + 16 * s); const bf16x8 Bw = *(const bf16x8*)(w2T + 16 * s + 8 * hh);
                acc = __builtin_amdgcn_mfma_f32_32x32x16_bf16(A, Bw, acc, 0, 0, 0); }
            const float w0c = KIN(I_RWW0)[l * 256 + ch];
#pragma unroll
            for (int r = 0; r < 16; ++r) { const int tok = rho16(r, hh);
                const float zw = w0c + acc[r]; const float wlog = -(fmaxf(-zw, 0.f) + log1pexp_neg_abs(zw)) - 0.5f;
                LWL[tok * 264 + ch] = (bf16)f2bf(-fast_exp(wlog)); }
        }
        __builtin_amdgcn_sched_barrier(0);
        {
            f32x16 acc;
#pragma unroll
            for (int i = 0; i < 16; ++i) acc[i] = 0.f;
#pragma unroll
            for (int s = 0; s < 4; ++s) { const bf16x8 A = *(const LAS bf16x8*)(xa + 64 + 16 * s); const bf16x8 Bw = *(const bf16x8*)(a2T + 16 * s + 8 * hh);
                acc = __builtin_amdgcn_mfma_f32_32x32x16_bf16(A, Bw, acc, 0, 0, 0); }
            const float a0c = KIN(I_RWA0)[l * 256 + ch];
#pragma unroll
            for (int r = 0; r < 16; ++r) AL[rho16(r, hh) * 264 + ch] = (bf16)f2bf(fast_sigmoid(a0c + acc[r]));
        }
        __builtin_amdgcn_sched_barrier(0);
        {
            f32x16 acc;
#pragma unroll
            for (int i = 0; i < 16; ++i) acc[i] = 0.f;
#pragma unroll
            for (int s = 0; s < 8; ++s) { const bf16x8 A = *(const LAS bf16x8*)(xa + 128 + 16 * s); const bf16x8 Bw = *(const bf16x8*)(g2T + 16 * s + 8 * hh);
                acc = __builtin_amdgcn_mfma_f32_32x32x16_bf16(A, Bw, acc, 0, 0, 0); }
            bf16* gb = (bf16*)(ws + WS_GBUF) + ((size_t)b * T + t0) * 256 + ch;
#pragma unroll
            for (int r = 0; r < 16; ++r) gb[(size_t)rho16(r, hh) * 256] = (bf16)f2bf(acc[r]);
        }
    }
    lds_barrier();
    LAS unsigned char* L = lds + h * RWC_HEADB;
    LAS bf16* AT = (LAS bf16*)L;
    LAS bf16* BT = (LAS bf16*)(L + 4096);
    LAS bf16* KT = (LAS bf16*)(L + 8192);
    LAS bf16* ATT = (LAS bf16*)(L + 12288);
    LAS bf16* BHT = (LAS bf16*)(L + 16384);
    LAS bf16* KHT = (LAS bf16*)(L + 20480);
    LAS bf16* VT = (LAS bf16*)(L + 24576);
    LAS float* GC = (LAS float*)(L + 28672);
    LAS float* MAB = (LAS float*)(L + 4096);
    LAS bf16* MAK = (LAS bf16*)(L + 8192);
    LAS bf16* TM = (LAS bf16*)L;
    if (wave < 4) {
        const int hs = wave, d = lane, ch = hs * 64 + d; const size_t uns = (size_t)(b * 4 + hs) * NCH + c;
        LAS unsigned char* Ls = lds + hs * RWC_HEADB;
        LAS bf16* sAT = (LAS bf16*)Ls; LAS bf16* sBT = (LAS bf16*)(Ls + 4096); LAS bf16* sKT = (LAS bf16*)(Ls + 8192);
        LAS bf16* sATT = (LAS bf16*)(Ls + 12288); LAS bf16* sBHT = (LAS bf16*)(Ls + 16384); LAS bf16* sKHT = (LAS bf16*)(Ls + 20480); LAS float* sGC = (LAS float*)(Ls + 28672);
        const float mr = mu[ch], mk = mu[256 + ch];
        const float kkc = KIN(I_RWKK)[l * 256 + ch], kac = KIN(I_RWKA)[l * 256 + ch], rkc = KIN(I_RWRK)[l * 256 + ch];
        float lgend = 0.f;
#pragma unroll 8
        for (int t = 0; t < 32; ++t) lgend += bf2f(LWL[t * 264 + ch]);
        float* bonp = (float*)(ws + WS_BONUS) + ((size_t)b * T + t0) * 4 + hs;
        float lg = 0.f;
        float rprev = 0.f, kprev = 0.f;
        if (t0 > 0) { rprev = bf2f(*(P - PINP + ch)); kprev = bf2f(*(P - PINP + 256 + ch)); }
        unsigned short xrr[32], xkr[32];
#pragma unroll
        for (int t = 0; t < 32; ++t) { const bf16* row = P + (size_t)t * PINP; xrr[t] = row[ch]; xkr[t] = row[256 + ch]; }
#pragma unroll 1
        for (int t8 = 0; t8 < 4; ++t8) { u32x4 ap, bp, kp; float xr[8], xk[8];
#pragma unroll
            for (int e = 0; e < 8; ++e) { xr[e] = bf2f(t8 == 0 ? xrr[e] : t8 == 1 ? xrr[8 + e] : t8 == 2 ? xrr[16 + e] : xrr[24 + e]); xk[e] = bf2f(t8 == 0 ? xkr[e] : t8 == 1 ? xkr[8 + e] : t8 == 2 ? xkr[16 + e] : xkr[24 + e]); }
#pragma unroll
            for (int jj = 0; jj < 4; ++jj) { float at2[2], bh2[2], kh2[2];
#pragma unroll
                for (int e = 0; e < 2; ++e) { const int t = t8 * 8 + jj * 2 + e;
                    const float rc = xr[jj * 2 + e], kc = xk[jj * 2 + e];
                    const float r = rc + (rprev - rc) * mr, k = kc + (kprev - kc) * mk; rprev = rc; kprev = kc;
                    const float av = bf2f(AL[t * 264 + ch]), lw = bf2f(LWL[t * 264 + ch]);
                    const float kkr = k * kkc, hk = k * (1.0f + (av - 1.0f) * kac);
                    const float ss = wave_sum(kkr * kkr); const float kk = kkr * __builtin_amdgcn_rsqf(fmaxf(ss, 1e-24f));
                    const float bon = wave_sum(r * hk * rkc);
                    const float aa = -kk, bb = kk * av;
                    const float lgp = lg; lg += lw;
                    const float at = aa * fast_exp(lgp), rt = r * fast_exp(lg), ei = fast_exp(-lg), bt = bb * ei, kt = hk * ei, eh = fast_exp(lgend - lg);
                    sAT[t * 64 + d] = (bf16)f2bf(at); sBT[t * 64 + d] = (bf16)f2bf(bt); sKT[t * 64 + d] = (bf16)f2bf(kt);
                    LWL[t * 264 + ch] = (bf16)f2bf(rt);
                    if (d == 0) bonp[t * 4] = bon;
                    at2[e] = at; bh2[e] = bb * eh; kh2[e] = hk * eh; }
                ap[jj] = pk2(at2[0], at2[1]); bp[jj] = pk2(bh2[0], bh2[1]); kp[jj] = pk2(kh2[0], kh2[1]); }
            *(LAS u32x4*)(sATT + d * 32 + t8 * 8) = ap; *(LAS u32x4*)(sBHT + d * 32 + t8 * 8) = bp; *(LAS u32x4*)(sKHT + d * 32 + t8 * 8) = kp; }
        sGC[d] = fast_exp(lgend);
    } else {
        const int cv = tid - 256, hs = cv >> 6, vi = cv & 63; const size_t uns = (size_t)(b * 4 + hs) * NCH + c;
        LAS bf16* sVT = (LAS bf16*)(lds + hs * RWC_HEADB + 24576);
        bf16* VTg = (bf16*)(ws + WS_RVT) + uns * 2048 + vi * 32; bf16* VGp = (bf16*)(ws + WS_RVG) + uns * 2048 + vi;
        const float mv = mu[512 + cv];
        float vprev = 0.f; if (t0 > 0) vprev = bf2f(*(P - PINP + 512 + cv));
        unsigned short xvr[32];
#pragma unroll
        for (int t = 0; t < 32; ++t) xvr[t] = P[(size_t)t * PINP + 512 + cv];
#pragma unroll
        for (int t8 = 0; t8 < 4; ++t8) { u32x4 vp; float yv[8];
#pragma unroll
            for (int e = 0; e < 8; ++e) { const float xv = bf2f(xvr[t8 * 8 + e]); yv[e] = xv + (vprev - xv) * mv; vprev = xv; VGp[(t8 * 8 + e) * 64] = (bf16)f2bf(yv[e]); }
#pragma unroll
            for (int jj = 0; jj < 4; ++jj) vp[jj] = pk2(yv[2 * jj], yv[2 * jj + 1]);
            *(LAS u32x4*)(sVT + vi * 32 + t8 * 8) = vp; *(u32x4*)(VTg + t8 * 8) = vp; }
    }
    lds_barrier();
    {
        const LAS bf16* srcL = p == 0 ? BT : KT; u32x4* dstG = (u32x4*)((bf16*)(ws + (p == 0 ? WS_RB : WS_RK)) + un * 2048);
#pragma unroll
        for (int i = 0; i < 4; ++i) dstG[i * 64 + lane] = *(const LAS u32x4*)(srcL + (i * 64 + lane) * 8);
        u32x4* dstR = (u32x4*)((bf16*)(ws + WS_RR) + un * 2048);
#pragma unroll
        for (int i = 0; i < 2; ++i) { const int q = (p * 2 + i) * 64 + lane, t = q >> 3, c8 = q & 7;
            dstR[q] = *(const LAS u32x4*)(LWL + t * 264 + h * 64 + c8 * 8); }
    }
    f32x16 accR[2];
    {
        f32x16 acc;
#pragma unroll
        for (int i = 0; i < 16; ++i) acc[i] = 0.f;
        const LAS bf16* Bsrc = p == 0 ? BT : KT;
#pragma unroll
        for (int s = 0; s < 4; ++s) { const bf16x8 A = *(const LAS bf16x8*)(AT + r32 * 64 + 16 * s + 8 * hh), B = *(const LAS bf16x8*)(Bsrc + r32 * 64 + 16 * s + 8 * hh);
            acc = __builtin_amdgcn_mfma_f32_32x32x16_bf16(A, B, acc, 0, 0, 0); }
        if (p == 0) {
#pragma unroll
            for (int r = 0; r < 16; ++r) { const int t = rho16(r, hh); MAB[t * 32 + r32] = (r32 < t) ? acc[r] : 0.f; }
        } else {
#pragma unroll
            for (int r = 0; r < 16; ++r) { const int t = rho16(r, hh); MAK[t * 32 + r32] = (bf16)f2bf((r32 < t) ? acc[r] : 0.f); }
        }
    }
    lds_barrier();
    if (p == 0) {
        const int cidx = r32; float tc[32];
#pragma unroll
        for (int t = 0; t < 32; ++t) { float acc0 = (t == cidx) ? 1.0f : 0.f, acc1 = 0.f;
#pragma unroll
            for (int s4 = 0; s4 < (t + 3) / 4; ++s4) { const f32x4 m4 = *(const LAS f32x4*)(MAB + t * 32 + 4 * s4);
#pragma unroll
                for (int e = 0; e < 4; ++e) { const int s = 4 * s4 + e; if (s < t) { if (e & 1) acc1 = fmaf(m4[e], tc[s], acc1); else acc0 = fmaf(m4[e], tc[s], acc0); } } }
            tc[t] = acc0 + acc1; }
#pragma unroll
        for (int t = 0; t < 32; ++t) if (hh == 0) TM[t * 32 + cidx] = (bf16)f2bf(tc[t]);
    } else {
#pragma unroll
        for (int vt = 0; vt < 2; ++vt) {
#pragma unroll
            for (int i = 0; i < 16; ++i) accR[vt][i] = 0.f;
#pragma unroll
            for (int s = 0; s < 2; ++s) { const bf16x8 A = *(const LAS bf16x8*)(MAK + r32 * 32 + 16 * s + 8 * hh), B = *(const LAS bf16x8*)(VT + (32 * vt + r32) * 32 + 16 * s + 8 * hh);
                accR[vt] = __builtin_amdgcn_mfma_f32_32x32x16_bf16(A, B, accR[vt], 0, 0, 0); } }
    }
    lds_barrier();
    if (p == 0) {
        f32x16 accW[2];
#pragma unroll
        for (int dt = 0; dt < 2; ++dt) {
#pragma unroll
            for (int i = 0; i < 16; ++i) accW[dt][i] = 0.f;
#pragma unroll
            for (int s = 0; s < 2; ++s) { const bf16x8 A = *(const LAS bf16x8*)(TM + r32 * 32 + 16 * s + 8 * hh), B = *(const LAS bf16x8*)(ATT + (32 * dt + r32) * 32 + 16 * s + 8 * hh);
                accW[dt] = __builtin_amdgcn_mfma_f32_32x32x16_bf16(A, B, accW[dt], 0, 0, 0); } }
        { LAS bf16* WL = ATT;
#pragma unroll
          for (int dt = 0; dt < 2; ++dt)
#pragma unroll
              for (int r = 0; r < 16; ++r) WL[rho16(r, hh) * 64 + 32 * dt + r32] = (bf16)f2bf(accW[dt][r]);
          u32x4* WGp = (u32x4*)((bf16*)(ws + WS_RW) + un * 2048);
#pragma unroll
          for (int i = 0; i < 4; ++i) WGp[i * 64 + lane] = *(const LAS u32x4*)(WL + (i * 64 + lane) * 8); }
        LAS bf16* PL = (LAS bf16*)(L + 4096);
        const int xs = r32 >> 4, xx = r32 & 15, hhA = (xx >> 2) & 1, jA = 4 * (xx >> 3) + (xx & 3);
#pragma unroll
        for (int dt = 0; dt < 2; ++dt)
#pragma unroll
            for (int dt2 = 0; dt2 < 2; ++dt2) { f32x16 acc;
#pragma unroll
                for (int i = 0; i < 16; ++i) acc[i] = 0.f;
#pragma unroll
                for (int s = 0; s < 2; ++s) { const LAS bf16* bp = BHT + (32 * dt + r32) * 32 + 16 * s + 4 * hh;
                    union { bf16x8 v; s16x4 h2[2]; } af; af.h2[0] = *(const LAS s16x4*)bp; af.h2[1] = *(const LAS s16x4*)(bp + 8);
                    union { bf16x8 v; unsigned w[4]; } bf;
#pragma unroll
                    for (int j = 0; j < 4; ++j) bf.w[j] = cvt_pk_bf16(accW[dt2][8 * s + 2 * j], accW[dt2][8 * s + 2 * j + 1]);
                    acc = __builtin_amdgcn_mfma_f32_32x32x16_bf16(af.v, bf.v, acc, 0, 0, 0); }
                if (dt == dt2) { const float gc = GC[32 * dt + r32];
#pragma unroll
                    for (int r = 0; r < 16; ++r) if (rho16(r, hh) == r32) acc[r] += gc; }
                LAS bf16* pf = PL + (((dt * 2 + dt2) * 2 + xs) * 64 + 32 * hhA) * 8 + jA;
#pragma unroll
                for (int r = 0; r < 16; ++r) pf[rho16(r, hh) * 8] = (bf16)f2bf(acc[r]); }
        { u32x4* PFp = (u32x4*)((bf16*)(ws + WS_RP) + un * 4096);
#pragma unroll
          for (int f = 0; f < 8; ++f) PFp[f * 64 + lane] = *(const LAS u32x4*)(PL + (f * 64 + lane) * 8); }
    } else {
        f32x16 accU[2];
#pragma unroll
        for (int vt = 0; vt < 2; ++vt) {
#pragma unroll
            for (int i = 0; i < 16; ++i) accU[vt][i] = 0.f;
#pragma unroll
            for (int s = 0; s < 2; ++s) { const LAS bf16* tp = TM + r32 * 32 + 16 * s + 4 * hh;
                union { bf16x8 v; s16x4 h2[2]; } af; af.h2[0] = *(const LAS s16x4*)tp; af.h2[1] = *(const LAS s16x4*)(tp + 8);
                union { bf16x8 v; unsigned w[4]; } bf;
#pragma unroll
                for (int j = 0; j < 4; ++j) bf.w[j] = cvt_pk_bf16(accR[vt][8 * s + 2 * j], accR[vt][8 * s + 2 * j + 1]);
                accU[vt] = __builtin_amdgcn_mfma_f32_32x32x16_bf16(af.v, bf.v, accU[vt], 0, 0, 0); } }
        bf16* UGp = (bf16*)(ws + WS_RU) + un * 2048;
#pragma unroll
        for (int vt = 0; vt < 2; ++vt)
#pragma unroll
            for (int g2 = 0; g2 < 2; ++g2) *(u32x4*)(UGp + ((vt * 2 + g2) * 64 + lane) * 8) = (u32x4){cvt_pk_bf16(accU[vt][8 * g2], accU[vt][8 * g2 + 1]), cvt_pk_bf16(accU[vt][8 * g2 + 2], accU[vt][8 * g2 + 3]),
                                                                                                 cvt_pk_bf16(accU[vt][8 * g2 + 4], accU[vt][8 * g2 + 5]), cvt_pk_bf16(accU[vt][8 * g2 + 6], accU[vt][8 * g2 + 7])};
        bf16* QFp = (bf16*)(ws + WS_RQ) + un * 4096;
#pragma unroll
        for (int vt = 0; vt < 2; ++vt)
#pragma unroll
            for (int dt = 0; dt < 2; ++dt) { f32x16 acc;
#pragma unroll
                for (int i = 0; i < 16; ++i) acc[i] = 0.f;
#pragma unroll
                for (int s = 0; s < 2; ++s) { const LAS bf16* bp = BHT + (32 * dt + r32) * 32 + 16 * s + 4 * hh;
                    union { bf16x8 v; s16x4 h2[2]; } af; af.h2[0] = *(const LAS s16x4*)bp; af.h2[1] = *(const LAS s16x4*)(bp + 8);
                    union { bf16x8 v; unsigned w[4]; } bf;
#pragma unroll
                    for (int j = 0; j < 4; ++j) bf.w[j] = cvt_pk_bf16(accU[vt][8 * s + 2 * j], accU[vt][8 * s + 2 * j + 1]);
                    acc = __builtin_amdgcn_mfma_f32_32x32x16_bf16(af.v, bf.v, acc, 0, 0, 0);
                    const bf16x8 A2 = *(const LAS bf16x8*)(KHT + (32 * dt + r32) * 32 + 16 * s + 8 * hh), B2 = *(const LAS bf16x8*)(VT + (32 * vt + r32) * 32 + 16 * s + 8 * hh);
                    acc = __builtin_amdgcn_mfma_f32_32x32x16_bf16(A2, B2, acc, 0, 0, 0); }
#pragma unroll
                for (int g2 = 0; g2 < 2; ++g2) *(u32x4*)(QFp + (((vt * 2 + dt) * 2 + g2) * 64 + lane) * 8) = (u32x4){cvt_pk_bf16(acc[8 * g2], acc[8 * g2 + 1]), cvt_pk_bf16(acc[8 * g2 + 2], acc[8 * g2 + 3]),
                                                                                                                   cvt_pk_bf16(acc[8 * g2 + 4], acc[8 * g2 + 5]), cvt_pk_bf16(acc[8 * g2 + 6], acc[8 * g2 + 7])}; }
    }
    lds_barrier();
}
__device__ __forceinline__ void rw_m2_wave(LAS unsigned char* ring, int lane, int bh, int vt) {
    unsigned char* ws = KWS();
    const char* PF = (const char*)((const bf16*)(ws + WS_RP) + (size_t)bh * NCH * 4096) + lane * 16;
    const char* QF = (const char*)((const bf16*)(ws + WS_RQ) + (size_t)bh * NCH * 4096 + (size_t)vt * 2048) + lane * 16;
    bf16* SG = (bf16*)(ws + WS_RS) + (size_t)bh * NCH * 4096 + (size_t)vt * 2048 + lane * 8;
    f32x16 S[2];
#pragma unroll
    for (int dt = 0; dt < 2; ++dt)
#pragma unroll
        for (int i = 0; i < 16; ++i) S[dt][i] = 0.f;
#define RWM2_DMA(c_) do { const int _c = (c_) < NCH ? (c_) : NCH - 1; LAS unsigned char* _sl = ring + ((c_) & 3) * 16384; \
        _Pragma("unroll") for (int f = 0; f < 8; ++f) __builtin_amdgcn_global_load_lds((const unsigned*)(PF + (size_t)_c * 8192 + f * 1024), (LAS unsigned*)(_sl + f * 1024), 16, 0, 0); \
        _Pragma("unroll") for (int f = 0; f < 4; ++f) __builtin_amdgcn_global_load_lds((const unsigned*)(QF + (size_t)_c * 8192 + f * 1024), (LAS unsigned*)(_sl + 8192 + f * 1024), 16, 0, 0); } while (0)
    RWM2_DMA(0); RWM2_DMA(1); RWM2_DMA(2);
#pragma unroll 1
    for (int c = 0; c < NCH; ++c) {
        asm volatile("s_waitcnt vmcnt(24)" ::: "memory");
        const LAS unsigned char* sl = ring + (c & 3) * 16384 + lane * 16;
        bf16x8 pf[8]; u32x4 qv[4];
#pragma unroll
        for (int f = 0; f < 8; ++f) pf[f] = *(const LAS bf16x8*)(sl + f * 1024);
#pragma unroll
        for (int f = 0; f < 4; ++f) qv[f] = *(const LAS u32x4*)(sl + 8192 + f * 1024);
        union { bf16x8 v; unsigned w[4]; } sb[2][2];
#pragma unroll
        for (int dt2 = 0; dt2 < 2; ++dt2)
#pragma unroll
            for (int s = 0; s < 2; ++s) {
#pragma unroll
                for (int j = 0; j < 4; ++j) sb[dt2][s].w[j] = cvt_pk_bf16(S[dt2][8 * s + 2 * j], S[dt2][8 * s + 2 * j + 1]);
                *(bf16x8*)(SG + (size_t)c * 4096 + (dt2 * 2 + s) * 512) = sb[dt2][s].v; }
        f32x16 N[2];
#pragma unroll
        for (int dt = 0; dt < 2; ++dt) {
#pragma unroll
            for (int g2 = 0; g2 < 2; ++g2)
#pragma unroll
                for (int j = 0; j < 4; ++j) { N[dt][8 * g2 + 2 * j] = bflo(qv[dt * 2 + g2][j]); N[dt][8 * g2 + 2 * j + 1] = bfhi(qv[dt * 2 + g2][j]); }
#pragma unroll
            for (int dt2 = 0; dt2 < 2; ++dt2)
#pragma unroll
                for (int s = 0; s < 2; ++s) N[dt] = __builtin_amdgcn_mfma_f32_32x32x16_bf16(pf[(dt * 2 + dt2) * 2 + s], sb[dt2][s].v, N[dt], 0, 0, 0); }
        S[0] = N[0]; S[1] = N[1];
        asm volatile("s_waitcnt lgkmcnt(0)" ::: "memory");
        RWM2_DMA(c + 3);
    }
    asm volatile("s_waitcnt vmcnt(0)" ::: "memory");
#undef RWM2_DMA
}
__device__ __forceinline__ bf16x8 ld_perm8(const bf16* p) { union { bf16x8 v; s16x4 h2[2]; } f; f.h2[0] = *(const s16x4*)p; f.h2[1] = *(const s16x4*)(p + 8); return f.v; }
__device__ __forceinline__ void rw_m3_task(int lane, int l, int bh, int c) {
    unsigned char* ws = KWS();
    const int r32 = lane & 31, hh = lane >> 5, b = bh >> 2, h = bh & 3; const size_t un = (size_t)bh * NCH + c; const size_t tok0 = (size_t)b * T + c * 32;
    const bf16* RGp = (const bf16*)(ws + WS_RR) + un * 2048 + r32 * 64 + 4 * hh; const bf16* BGp = (const bf16*)(ws + WS_RB) + un * 2048 + r32 * 64 + 4 * hh;
    const bf16* KGp = (const bf16*)(ws + WS_RK) + un * 2048 + r32 * 64 + 4 * hh; const bf16* WGp = (const bf16*)(ws + WS_RW) + un * 2048 + r32 * 64 + 4 * hh;
    const bf16* SGp = (const bf16*)(ws + WS_RS) + un * 4096 + lane * 8; const bf16* VTp = (const bf16*)(ws + WS_RVT) + un * 2048 + r32 * 32 + 4 * hh;
    const bf16* UGp = (const bf16*)(ws + WS_RU) + un * 2048 + lane * 8;
    f32x16 U[2], Y[2], mb, mk;
#pragma unroll
    for (int vt = 0; vt < 2; ++vt)
#pragma unroll
        for (int g2 = 0; g2 < 2; ++g2) { const u32x4 u4 = *(const u32x4*)(UGp + (vt * 2 + g2) * 512);
#pragma unroll
            for (int j = 0; j < 4; ++j) { U[vt][8 * g2 + 2 * j] = bflo(u4[j]); U[vt][8 * g2 + 2 * j + 1] = bfhi(u4[j]); } }
#pragma unroll
    for (int i = 0; i < 16; ++i) { mb[i] = 0.f; mk[i] = 0.f; Y[0][i] = 0.f; Y[1][i] = 0.f; }
#pragma unroll
    for (int ks = 0; ks < 4; ++ks) {
        const bf16x8 rf = ld_perm8(RGp + 16 * ks), wf = ld_perm8(WGp + 16 * ks), bfr = ld_perm8(BGp + 16 * ks), kfr = ld_perm8(KGp + 16 * ks);
        const bf16x8 s0 = *(const bf16x8*)(SGp + ks * 512), s1 = *(const bf16x8*)(SGp + 2048 + ks * 512);
        U[0] = __builtin_amdgcn_mfma_f32_32x32x16_bf16(wf, s0, U[0], 0, 0, 0); U[1] = __builtin_amdgcn_mfma_f32_32x32x16_bf16(wf, s1, U[1], 0, 0, 0);
        mb = __builtin_amdgcn_mfma_f32_32x32x16_bf16(bfr, rf, mb, 0, 0, 0); mk = __builtin_amdgcn_mfma_f32_32x32x16_bf16(kfr, rf, mk, 0, 0, 0);
        Y[0] = __builtin_amdgcn_mfma_f32_32x32x16_bf16(s0, rf, Y[0], 0, 0, 0); Y[1] = __builtin_amdgcn_mfma_f32_32x32x16_bf16(s1, rf, Y[1], 0, 0, 0); }
#pragma unroll
    for (int r = 0; r < 16; ++r) if (rho16(r, hh) > r32) { mb[r] = 0.f; mk[r] = 0.f; }
#pragma unroll
    for (int s = 0; s < 2; ++s) { union { bf16x8 v; unsigned w[4]; } fb, fk;
#pragma unroll
        for (int j = 0; j < 4; ++j) { fb.w[j] = cvt_pk_bf16(mb[8 * s + 2 * j], mb[8 * s + 2 * j + 1]); fk.w[j] = cvt_pk_bf16(mk[8 * s + 2 * j], mk[8 * s + 2 * j + 1]); }
#pragma unroll
        for (int vt = 0; vt < 2; ++vt) { union { bf16x8 v; unsigned w[4]; } fu;
#pragma unroll
            for (int j = 0; j < 4; ++j) fu.w[j] = cvt_pk_bf16(U[vt][8 * s + 2 * j], U[vt][8 * s + 2 * j + 1]);
            Y[vt] = __builtin_amdgcn_mfma_f32_32x32x16_bf16(fu.v, fb.v, Y[vt], 0, 0, 0);
            const bf16* vp = VTp + (size_t)vt * 32 * 32 + 16 * s;
            union { bf16x8 v; s16x4 h2[2]; } vf; vf.h2[0] = *(const s16x4*)vp; vf.h2[1] = *(const s16x4*)(vp + 8);
            Y[vt] = __builtin_amdgcn_mfma_f32_32x32x16_bf16(vf.v, fk.v, Y[vt], 0, 0, 0); } }
    float sm = 0.f;
#pragma unroll
    for (int vt = 0; vt < 2; ++vt)
#pragma unroll
        for (int i = 0; i < 16; ++i) sm += Y[vt][i];
    sm += __shfl_xor(sm, 32); const float mu = sm * (1.0f / 64.0f);
    float q = 0.f;
#pragma unroll
    for (int vt = 0; vt < 2; ++vt)
#pragma unroll
        for (int i = 0; i < 16; ++i) { const float dd = Y[vt][i] - mu; q += dd * dd; }
    q += __shfl_xor(q, 32); const float rstd = 1.0f / sqrtf(q * (1.0f / 64.0f) + RW_LN_EPS);
    const size_t tok = tok0 + r32;
    const float bon = ((const float*)(ws + WS_BONUS))[tok * 4 + h];
    const bf16* vrec = (const bf16*)(ws + WS_RVG) + un * 2048 + r32 * 64;
    const bf16* gp = (const bf16*)(ws + WS_GBUF) + tok * 256 + h * 64; bf16* od = (bf16*)(ws + WS_O) + tok * D + 512 + h * 64;
    const float* lnw = KIN(I_RWLNW) + l * 256 + h * 64; const float* lnb = KIN(I_RWLNB) + l * 256 + h * 64;
#pragma unroll
    for (int vt = 0; vt < 2; ++vt)
#pragma unroll
        for (int g = 0; g < 4; ++g) { const int v0 = 32 * vt + 8 * g + 4 * hh; const f32x4 w4 = *(const f32x4*)(lnw + v0), b4 = *(const f32x4*)(lnb + v0); const u32x2 vw = *(const u32x2*)(vrec + v0); const f32x4 vv = {bflo(vw.x), bfhi(vw.x), bflo(vw.y), bfhi(vw.y)}; const u32x2 gw = *(const u32x2*)(gp + v0);
            const float y0 = ((Y[vt][4 * g] - mu) * rstd * w4[0] + b4[0] + bon * vv[0]) * bflo(gw.x), y1 = ((Y[vt][4 * g + 1] - mu) * rstd * w4[1] + b4[1] + bon * vv[1]) * bfhi(gw.x);
            const float y2 = ((Y[vt][4 * g + 2] - mu) * rstd * w4[2] + b4[2] + bon * vv[2]) * bflo(gw.y), y3 = ((Y[vt][4 * g + 3] - mu) * rstd * w4[3] + b4[3] + bon * vv[3]) * bfhi(gw.y);
            *(u32x2*)(od + v0) = (u32x2){pk2(y0, y1), pk2(y2, y3)}; }
}

__device__ __forceinline__ void c1_phase(LAS unsigned char* lds, int l, int vcu, int G) {
    for (int u = vcu; u < NB * NCH; u += G) { const int b = u >> 8, c = u & 255;
        for (int q = 0; q <= PHREP(16); ++q) rw_fused_unit(lds, l, b, c);
        for (int q = 0; q <= PHREP(17); ++q) hg_fused_unit(lds, l, b, c);
        for (int q = 0; q <= PHREP(18); ++q) gla_fused_unit(lds, l, b, c); }
}
__device__ __forceinline__ void m3_gh_phase(int l, int vcu, int G) {
    const int tid = opaque_tid(), lane = tid & 63, wave = __builtin_amdgcn_readfirstlane(tid >> 6);
    unsigned char* ws = KWS();
    const int gw = vcu * NWAVES + wave, NGW = G * NWAVES;
    const bf16* P = (const bf16*)(ws + WS_P); bf16* O = (bf16*)(ws + WS_O);
    const float* gng = KIN(I_GLANG) + l * 256; const float* hng = KIN(I_HGNG) + l * 256;
    for (int task = gw; task < 24576; task += NGW) {
        const int un = task & 8191, bh = un >> 8, c = un & 255, b = bh >> 2, h = bh & 3; const size_t tok0 = (size_t)b * T + c * 32;
        if (task >= 16384) { rw_m3_task(lane, l, bh, c); continue; }
        if (task < 8192) m3_gh_task<64>(lane, (const bf16*)(ws + WS_HQ) + (size_t)un * 2048, (const bf16*)(ws + WS_HK) + (size_t)un * 2048, (const bf16*)(ws + WS_HVT) + (size_t)un * 2048, (const bf16*)(ws + WS_HS) + (size_t)un * 4096,
                                         P + tok0 * PINP + PC_HG + h * 64, hng + h * 64, O + tok0 * D + 256 + h * 64);
        else m3_gh_task<32>(lane, (const bf16*)(ws + WS_GQ) + (size_t)un * 1024, (const bf16*)(ws + WS_GK) + (size_t)un * 1024, (const bf16*)(ws + WS_GVT) + (size_t)un * 2048, (const bf16*)(ws + WS_GS) + (size_t)un * 2048,
                            P + tok0 * PINP + PC_GOUT + h * 64, gng + h * 64, O + tok0 * D + h * 64);
    }
}

__device__ __forceinline__ void xattn_units(LAS unsigned char* lds, int l, int first, int last, int stride) {
    const int tid = opaque_tid(), lane = tid & 63, wave = __builtin_amdgcn_readfirstlane(tid >> 6), r32 = lane & 31, hh = lane >> 5;
    const bf16* P = (const bf16*)(KWS() + WS_P); const bf16* MKV = (const bf16*)(KWS() + WS_MKV); bf16* O = (bf16*)(KWS() + WS_O);
    LAS bf16* KL = (LAS bf16*)lds;
    LAS bf16* VT = (LAS bf16*)(lds + 256 * 72 * 2);
    int cur_bh = -1;
    for (int u = first; u < last; u += stride) {
        const int bh = u >> 5, qb = u & 31, b = bh >> 2, h = bh & 3;
        if (bh != cur_bh) {
            lds_barrier();
            for (int i = tid; i < 256 * 8; i += NTHR) { const int key = i >> 3, c8 = i & 7;
                const bf16* src = MKV + (size_t)(b * 256 + key) * 2048 + l * 512 + h * 64 + c8 * 8;
                *(LAS u32x4*)(KL + key * 72 + c8 * 8) = *(const u32x4*)src;
                const u32x4 vv = *(const u32x4*)(src + 256);
                LAS bf16* vd = VT + (c8 * 8) * 264 + key;
                vd[0 * 264] = (bf16)(vv.x & 0xffff); vd[1 * 264] = (bf16)(vv.x >> 16); vd[2 * 264] = (bf16)(vv.y & 0xffff); vd[3 * 264] = (bf16)(vv.y >> 16);
                vd[4 * 264] = (bf16)(vv.z & 0xffff); vd[5 * 264] = (bf16)(vv.z >> 16); vd[6 * 264] = (bf16)(vv.w & 0xffff); vd[7 * 264] = (bf16)(vv.w >> 16); }
            lds_barrier();
            cur_bh = bh;
        }
        const int q = b * T + qb * 256 + wave * 32 + r32;
        bf16x8 qf[4];
#pragma unroll
        for (int s = 0; s < 4; ++s) qf[s] = *(const bf16x8*)(P + (size_t)q * PINP + PC_MQ + h * 64 + 16 * s + 8 * hh);
        f32x16 sc[8];
#pragma unroll
        for (int kt = 0; kt < 8; ++kt) {
#pragma unroll
            for (int i = 0; i < 16; ++i) sc[kt][i] = 0.f;
#pragma unroll
            for (int s = 0; s < 4; ++s) { const bf16x8 kf = *(const LAS bf16x8*)(KL + (kt * 32 + r32) * 72 + 16 * s + 8 * hh);
                sc[kt] = __builtin_amdgcn_mfma_f32_32x32x16_bf16(kf, qf[s], sc[kt], 0, 0, 0); }
        }
        float m = -3.0e38f;
#pragma unroll
        for (int kt = 0; kt < 8; ++kt)
#pragma unroll
            for (int i = 0; i < 16; ++i) m = fmaxf(m, sc[kt][i]);
        m = fmaxf(m, __shfl_xor(m, 32));
        float sum = 0.f;
        const float c2 = 0.125f * 1.4426950408889634f;
#pragma unroll
        for (int kt = 0; kt < 8; ++kt)
#pragma unroll
            for (int i = 0; i < 16; ++i) { const float e = __builtin_amdgcn_exp2f((sc[kt][i] - m) * c2); sc[kt][i] = e; sum += e; }
        sum += __shfl_xor(sum, 32);
        const float inv = 1.0f / sum;
        f32x16 oa[2];
#pragma unroll
        for (int vt = 0; vt < 2; ++vt)
#pragma unroll
            for (int i = 0; i < 16; ++i) oa[vt][i] = 0.f;
#pragma unroll
        for (int kt = 0; kt < 8; ++kt)
#pragma unroll
            for (int s = 0; s < 2; ++s) {
                union { bf16x8 v; unsigned w[4]; } pf;
#pragma unroll
                for (int j = 0; j < 4; ++j) pf.w[j] = cvt_pk_bf16(sc[kt][8 * s + 2 * j], sc[kt][8 * s + 2 * j + 1]);
#pragma unroll
                for (int vt = 0; vt < 2; ++vt) {
                    const LAS bf16* vp = VT + (vt * 32 + r32) * 264 + kt * 32 + 16 * s + 4 * hh;
                    union { bf16x8 v; s16x4 h2[2]; } vf; vf.h2[0] = *(const LAS s16x4*)vp; vf.h2[1] = *(const LAS s16x4*)(vp + 8);
                    oa[vt] = __builtin_amdgcn_mfma_f32_32x32x16_bf16(vf.v, pf.v, oa[vt], 0, 0, 0); }
            }
        bf16* orow = O + (size_t)q * D + 768 + h * 64;
#pragma unroll
        for (int vt = 0; vt < 2; ++vt)
#pragma unroll
            for (int g = 0; g < 4; ++g) { u32x2 w; w.x = cvt_pk_bf16(oa[vt][4 * g] * inv, oa[vt][4 * g + 1] * inv); w.y = cvt_pk_bf16(oa[vt][4 * g + 2] * inv, oa[vt][4 * g + 3] * inv);
                *(u32x2*)(orow + vt * 32 + 8 * g + 4 * hh) = w; }
    }
    lds_barrier();
}

__device__ __forceinline__ void m2_phase(LAS unsigned char* lds, int l, int bx, int G) {
    unsigned char* ws = KWS();
    const int tid = opaque_tid(), lane = tid & 63, wave = __builtin_amdgcn_readfirstlane(tid >> 6);
    const int nrw = (G >= 128) ? 64 : 0;
    if (nrw) { if (bx < nrw && wave == 0) rw_m2_wave(lds, lane, bx >> 1, bx & 1); }
    else { if (wave == 0) for (int q = bx; q < 64; q += G) rw_m2_wave(lds, lane, q >> 1, q & 1); }
    if (nrw && !(bx < nrw && wave == 0)) {
        const int nth = nrw ? (nrw * 448 + (G - nrw) * NTHR) : G * NTHR;
        const int gt = nrw ? (bx < nrw ? bx * 448 + (tid - 64) : nrw * 448 + (bx - nrw) * NTHR + tid) : bx * NTHR + tid;
        for (int e = gt; e < 98304; e += nth) {
            if (e < 65536) m2_gh_elem2<64>(e, (const bf16*)(ws + WS_HDS), (const float*)(ws + WS_HBE), (bf16*)(ws + WS_HS));
            else m2_gh_elem2<32>(e - 65536, (const bf16*)(ws + WS_GDS), (const float*)(ws + WS_GBE), (bf16*)(ws + WS_GS)); }
    }
    if (nrw == 0) { __syncthreads(); for (int e = bx * NTHR + tid; e < 98304; e += G * NTHR) {
            if (e < 65536) m2_gh_elem2<64>(e, (const bf16*)(ws + WS_HDS), (const float*)(ws + WS_HBE), (bf16*)(ws + WS_HS));
            else m2_gh_elem2<32>(e - 65536, (const bf16*)(ws + WS_GDS), (const float*)(ws + WS_GBE), (bf16*)(ws + WS_GS)); } }
    if (nrw == 0 || bx >= nrw) {
        const int nb = G - nrw, r = bx - nrw;
        const int per = (1024 + nb - 1) / nb, lo = r * per, hi = (lo + per < 1024) ? lo + per : 1024;
        xattn_units(lds, l, lo, hi, 1);
    }
}

__device__ __forceinline__ void ln1_router_phase(LAS unsigned char* lds, int l, int bx, int G) {
    const int tid = opaque_tid(), lane = tid & 63, wave = __builtin_amdgcn_readfirstlane(tid >> 6);
    LAS float* X = (LAS float*)lds;
    LAS float* PART = (LAS float*)(lds + 16 * 1028 * 4);
    LAS int* HIST = (LAS int*)(lds + 16 * 1028 * 4 + 8 * 16 * 32 * 4);
    const float* xin = KIN(I_X); const bf16* xinb = (const bf16*)(KWS() + WS_XB);
    const bf16* HM = (const bf16*)(KWS() + WS_HMIX);
    bf16* X1B = (bf16*)(KWS() + WS_X1B); unsigned char* X1Q = (unsigned char*)(KWS() + WS_XF);
    const float* g1 = KIN(I_LN1G) + l * D; const float* b1 = KIN(I_LN1B) + l * D;
    const float* rw = KIN(I_RTW) + (size_t)l * D * NE; const float* rb = KIN(I_RTB) + l * NE;
    int* tok_e = (int*)(KWS() + WS_ROUTE); float* tok_g = (float*)(KWS() + WS_ROUTE + 1 * MiB);
    if (tid < 32) HIST[tid] = 0;
    float rwB[2][32];
    { const int q = lane >> 4, e = lane & 15;
#pragma unroll
      for (int s = 0; s < 32; ++s) { const float* p = rw + (size_t)(128 * wave + 32 * q + s) * NE + e; rwB[0][s] = p[0]; rwB[1][s] = p[16]; } }
    lds_barrier();
    f32x4 xraw[2][4]; u32x2 xbraw[2][4], hraw[2][4];
#define LN1_LOAD(it_) do { _Pragma("unroll") for (int tt = 0; tt < 2; ++tt) { const size_t _tok = (size_t)(it_) * 16 + wave * 2 + tt; \
        const f32x4* _xr = (const f32x4*)(xin + _tok * D) + lane; const u32x2* _xbr = (const u32x2*)(xinb + _tok * D) + lane; const u32x2* _hr = (const u32x2*)(HM + _tok * D) + lane; \
        _Pragma("unroll") for (int j = 0; j < 4; ++j) { if (l == 0) xraw[tt][j] = _xr[64 * j]; else xbraw[tt][j] = _xbr[64 * j]; hraw[tt][j] = _hr[64 * j]; } } } while (0)
    if (bx < NTOK / 16) LN1_LOAD(bx);
    for (int it = bx; it < NTOK / 16; it += G) {
        f32x4 vv[2][4];
#pragma unroll
        for (int tt = 0; tt < 2; ++tt)
#pragma unroll
            for (int j = 0; j < 4; ++j) { f32x4 xv; if (l == 0) xv = xraw[tt][j]; else { const u32x2 xw = xbraw[tt][j]; xv = (f32x4){bflo(xw.x), bfhi(xw.x), bflo(xw.y), bfhi(xw.y)}; } const u32x2 hw = hraw[tt][j];
                vv[tt][j][0] = DN_ALPHA * xv[0] + bflo(hw.x); vv[tt][j][1] = DN_ALPHA * xv[1] + bfhi(hw.x); vv[tt][j][2] = DN_ALPHA * xv[2] + bflo(hw.y); vv[tt][j][3] = DN_ALPHA * xv[3] + bfhi(hw.y); }
        if (it + G < NTOK / 16) LN1_LOAD(it + G);
#pragma unroll
        for (int tt = 0; tt < 2; ++tt) { const int ti = wave * 2 + tt; const size_t tok = (size_t)it * 16 + ti;
            f32x4 v[4]; float s = 0.f;
#pragma unroll
            for (int j = 0; j < 4; ++j) { v[j] = vv[tt][j]; s += (v[j][0] + v[j][1]) + (v[j][2] + v[j][3]); }
            const float mean = wave_sum(s) * (1.0f / D); float s2 = 0.f;
#pragma unroll
            for (int j = 0; j < 4; ++j) { v[j] = v[j] - mean; s2 += (v[j][0] * v[j][0] + v[j][1] * v[j][1]) + (v[j][2] * v[j][2] + v[j][3] * v[j][3]); }
            const float rstd = 1.0f / sqrtf(wave_sum(s2) * (1.0f / D) + LN_EPS);
#pragma unroll
            for (int j = 0; j < 4; ++j) { const f32x4 gg = *((const f32x4*)g1 + lane + 64 * j), bb = *((const f32x4*)b1 + lane + 64 * j);
                const f32x4 y = v[j] * rstd * gg + bb;
                *((u32x2*)(X1B + tok * D) + lane + 64 * j) = (u32x2){pk2(y[0], y[1]), pk2(y[2], y[3])};
                { int w = __builtin_amdgcn_cvt_pk_fp8_f32(y[0], y[1], 0, false); w = __builtin_amdgcn_cvt_pk_fp8_f32(y[2], y[3], w, true); *((unsigned*)(X1Q + tok * D) + lane + 64 * j) = (unsigned)w; }
                *(LAS f32x4*)(X + ti * 1028 + 4 * lane + 256 * j) = y; }
        }
        lds_barrier();
        {
            const int q = lane >> 4, r = lane & 15;
            f32x4 acc0 = (f32x4){0.f, 0.f, 0.f, 0.f}, acc1 = (f32x4){0.f, 0.f, 0.f, 0.f};
            const LAS float* xa = X + r * 1028 + 128 * wave + 32 * q;
#pragma unroll
            for (int s4 = 0; s4 < 8; ++s4) { const f32x4 av = *(const LAS f32x4*)(xa + 4 * s4);
#pragma unroll
                for (int j = 0; j < 4; ++j) { acc0 = __builtin_amdgcn_mfma_f32_16x16x4f32(av[j], rwB[0][4 * s4 + j], acc0, 0, 0, 0); acc1 = __builtin_amdgcn_mfma_f32_16x16x4f32(av[j], rwB[1][4 * s4 + j], acc1, 0, 0, 0); } }
#pragma unroll
            for (int i = 0; i < 4; ++i) { PART[(wave * 16 + 4 * q + i) * 32 + r] = acc0[i]; PART[(wave * 16 + 4 * q + i) * 32 + 16 + r] = acc1[i]; }
        }
        lds_barrier();
        {
            const int ti = tid >> 5, e = tid & 31;
            float lg = rb[e];
#pragma unroll
            for (int w = 0; w < 8; ++w) lg += PART[(w * 16 + ti) * 32 + e];
            float tv[4]; int te[4]; float cur = lg;
#pragma unroll
            for (int k = 0; k < 4; ++k) { float bv = cur; int bi = e;
#pragma unroll
                for (int o = 16; o >= 1; o >>= 1) { const float ov = __shfl_xor(bv, o); const int oi = __shfl_xor(bi, o); if (ov > bv || (ov == bv && oi < bi)) { bv = ov; bi = oi; } }
                tv[k] = bv; te[k] = bi; if (e == bi) cur = -3.0e38f; }
            const float e1 = __expf(tv[1] - tv[0]), e2 = __expf(tv[2] - tv[0]), e3 = __expf(tv[3] - tv[0]); const float inv = 1.0f / (1.0f + e1 + e2 + e3);
            const size_t tok = (size_t)it * 16 + ti;
            if (e < 4) { const int ek = e == 0 ? te[0] : e == 1 ? te[1] : e == 2 ? te[2] : te[3]; const float gk = (e == 0 ? 1.0f : e == 1 ? e1 : e == 2 ? e2 : e3) * inv;
                tok_e[tok * 4 + e] = ek; tok_g[tok * 4 + e] = gk; __hip_atomic_fetch_add(&HIST[ek], 1, __ATOMIC_RELAXED, __HIP_MEMORY_SCOPE_WORKGROUP); }
        }
        lds_barrier();
    }
#undef LN1_LOAD
    lds_barrier();
    if (tid < 32) ((int*)(KWS() + WS_CTL))[CW_HIST + bx * 32 + tid] = HIST[tid];
}

__device__ __forceinline__ void slots_phase(LAS unsigned char* lds, int bx, int G) {
    const int tid = opaque_tid();
    int* ctl = (int*)(KWS() + WS_CTL);
    LAS int* RED = (LAS int*)lds;
    LAS int* TOT = RED + 1024;
    const int* tok_e = (const int*)(KWS() + WS_ROUTE); const float* tok_g = (const float*)(KWS() + WS_ROUTE + 1 * MiB);
    int* tok_slot = (int*)(KWS() + WS_ROUTE + 2 * MiB); int* slot_tok = (int*)(KWS() + WS_ROUTE + 3 * MiB); float* slot_gate = (float*)(KWS() + WS_ROUTE + 3 * MiB + 1536 * 1024);
    { const int e = tid & 31, part = tid >> 5; int tot = 0, pre = 0;
      for (int b2 = part; b2 < G; b2 += 16) { const int h = ctl[CW_HIST + b2 * 32 + e]; tot += h; if (b2 < bx) pre += h; }
      RED[(part * 32 + e) * 2] = tot; RED[(part * 32 + e) * 2 + 1] = pre; }
    __syncthreads();
    if (tid < 32) { int tot = 0, pre = 0; for (int p = 0; p < 16; ++p) { tot += RED[(p * 32 + tid) * 2]; pre += RED[(p * 32 + tid) * 2 + 1]; } TOT[tid] = tot; TOT[32 + tid] = pre; TOT[96 + tid] = 0; }
    __syncthreads();
    if (tid == 0) { int ps = 0;
#pragma unroll 1
        for (int e = 0; e < 32; ++e) { TOT[64 + e] = ps; ps += (TOT[e] + 255) & ~255; }
        TOT[128] = ps >> 8; if (bx == 0) ctl[CW_NT] = ps >> 8; }
    __syncthreads();
    if (bx == 0) { const int nt = TOT[128];
        for (int t = tid; t < nt; t += NTHR) { int e = 0;
#pragma unroll 1
            for (int k = 1; k < 32; ++k) if (TOT[64 + k] <= t * 256) e = k;
            ctl[CW_TILEE + t] = e; } }
    for (int e = bx; e < 32; e += G) { const int s0 = TOT[64 + e] + TOT[e], s1 = TOT[64 + e] + ((TOT[e] + 255) & ~255); for (int s = s0 + tid; s < s1; s += NTHR) { slot_tok[s] = 0; slot_gate[s] = 0.f; } }
    for (int it = bx + G * (tid >> 6); it < NTOK / 16; it += G * 8) {
        const int asg = it * 64 + (tid & 63); const int e = tok_e[asg]; const int rank = __hip_atomic_fetch_add(&TOT[96 + e], 1, __ATOMIC_RELAXED, __HIP_MEMORY_SCOPE_WORKGROUP); const int slot = TOT[64 + e] + TOT[32 + e] + rank;
        tok_slot[asg] = slot; slot_tok[slot] = asg >> 2; slot_gate[slot] = tok_g[asg];
    }
}

__device__ __forceinline__ void combine_phase(int l, int vcu, int G) {
    const int tid = opaque_tid(), lane = tid & 63, wave = __builtin_amdgcn_readfirstlane(tid >> 6);
    const int gw = vcu * NWAVES + wave, NGW = G * NWAVES;
    const bf16* X1B = (const bf16*)(KWS() + WS_X1B); const bf16* YB = (const bf16*)(KWS() + WS_YB); const int* tok_slot = (const int*)(KWS() + WS_ROUTE + 2 * MiB);
    float* xo = KOUT(); bf16* XB = (bf16*)(KWS() + WS_XB);
    const float* g2 = KIN(I_LN2G) + l * D; const float* b2 = KIN(I_LN2B) + l * D;
    u32x2 xw[4], ya[4][4]; int ns0 = 0, ns1 = 0, ns2 = 0, ns3 = 0;
#define CMB_SLOTS(t_) do { const int4 _s = *(const int4*)(tok_slot + (size_t)(t_) * 4); ns0 = _s.x; ns1 = _s.y; ns2 = _s.z; ns3 = _s.w; } while (0)
#define CMB_ROWS(t_) do { const u32x2* _xr = (const u32x2*)(X1B + (size_t)(t_) * D) + lane; \
        const u32x2* _y0 = (const u32x2*)(YB + (size_t)ns0 * D) + lane; const u32x2* _y1 = (const u32x2*)(YB + (size_t)ns1 * D) + lane; \
        const u32x2* _y2 = (const u32x2*)(YB + (size_t)ns2 * D) + lane; const u32x2* _y3 = (const u32x2*)(YB + (size_t)ns3 * D) + lane; \
        _Pragma("unroll") for (int j = 0; j < 4; ++j) { xw[j] = _xr[64 * j]; ya[0][j] = _y0[64 * j]; ya[1][j] = _y1[64 * j]; ya[2][j] = _y2[64 * j]; ya[3][j] = _y3[64 * j]; } } while (0)
    if (gw < NTOK) { CMB_SLOTS(gw); CMB_ROWS(gw); if (gw + NGW < NTOK) CMB_SLOTS(gw + NGW); }
    for (int tok = gw; tok < NTOK; tok += NGW) {
        f32x4 v[4]; float s = 0.f;
#pragma unroll
        for (int j = 0; j < 4; ++j) { const f32x4 xv = {bflo(xw[j].x), bfhi(xw[j].x), bflo(xw[j].y), bfhi(xw[j].y)}; const u32x2 a0 = ya[0][j], a1 = ya[1][j], a2 = ya[2][j], a3 = ya[3][j];
            v[j][0] = DN_ALPHA * xv[0] + ((bflo(a0.x) + bflo(a1.x)) + (bflo(a2.x) + bflo(a3.x))); v[j][1] = DN_ALPHA * xv[1] + ((bfhi(a0.x) + bfhi(a1.x)) + (bfhi(a2.x) + bfhi(a3.x)));
            v[j][2] = DN_ALPHA * xv[2] + ((bflo(a0.y) + bflo(a1.y)) + (bflo(a2.y) + bflo(a3.y))); v[j][3] = DN_ALPHA * xv[3] + ((bfhi(a0.y) + bfhi(a1.y)) + (bfhi(a2.y) + bfhi(a3.y)));
            s += (v[j][0] + v[j][1]) + (v[j][2] + v[j][3]); }
        if (tok + NGW < NTOK) { CMB_ROWS(tok + NGW); if (tok + 2 * NGW < NTOK) CMB_SLOTS(tok + 2 * NGW); }
        const float mean = wave_sum(s) * (1.0f / D); float q = 0.f;
#pragma unroll
        for (int j = 0; j < 4; ++j) { v[j] = v[j] - mean; q += (v[j][0] * v[j][0] + v[j][1] * v[j][1]) + (v[j][2] * v[j][2] + v[j][3] * v[j][3]); }
        const float rstd = 1.0f / sqrtf(wave_sum(q) * (1.0f / D) + LN_EPS);
#pragma unroll
        for (int j = 0; j < 4; ++j) { const f32x4 gg = *((const f32x4*)g2 + lane + 64 * j), bb = *((const f32x4*)b2 + lane + 64 * j);
            const f32x4 y = v[j] * rstd * gg + bb;
            if (l == NL - 1) *((f32x4*)(xo + (size_t)tok * D) + lane + 64 * j) = y;
            else *((u32x2*)(XB + (size_t)tok * D) + lane + 64 * j) = (u32x2){pk2(y[0], y[1]), pk2(y[2], y[3])}; }
    }
#undef CMB_SLOTS
#undef CMB_ROWS
}


constexpr int PH_PER_LAYER = 10, NPHASES = 2 + NL * PH_PER_LAYER;
__global__ void __launch_bounds__(NTHR, 2) trunk_fwd(Args args) {
    extern __shared__ __attribute__((aligned(16))) unsigned char lds_raw[];
    LAS unsigned char* lds = (LAS unsigned char*)lds_raw;
    volatile LAS unsigned* MISC = (volatile LAS unsigned*)(lds + MISC_OFF);
    const int tid = threadIdx.x;
    const int G = gridDim.x, bx = blockIdx.x;
    const int vcu = (G % 8 == 0) ? (bx % 8) * (G / 8) + bx / 8 : bx;
    unsigned char* ws = KWS();
    unsigned* ctl = (unsigned*)(ws + WS_CTL);
    for (int u = tid; u < (LDS_BYTES - LDSCTL_OFF) / 4; u += NTHR) ((LAS unsigned*)(lds + LDSCTL_OFF))[u] = 0u;
    __syncthreads();
    XcdBarrier bar; bar.bar = ctl + CW_BAR; bar.x = 0; bar.st = nullptr;
#if !MK_PER_PHASE
    bar = xcd_barrier_post(ctl + CW_BAR, MISC + 8);
#define GRID_BAR() xcd_barrier(bar)
#else
#define GRID_BAR() do { } while (0)
#endif
    const int lo = (int)(unsigned)ka_u64<280>(), hi = (int)(unsigned)(ka_u64<280>() >> 32);
#ifndef PH_MASK
#define PH_MASK 0x1FFF
#endif
#define PHEN(n) (((PH_MASK) >> (n)) & 1)
#define IN(k) (lo <= (k) && (k) < hi)
#define SEAM(k) do { if (rep > 0 || IN((k) + 1)) GRID_BAR(); } while (0)

#define OG opaque_s(G)
#define OBX opaque_s(bx)
#define OVCU opaque_s(vcu)
#define OL opaque_s(l)
    if (PHEN(0) && IN(0)) for (int rep = PHREP(0); rep >= 0; --rep) { prologue_phase(lds, OVCU, OG); SEAM(0); }
    if (PHEN(1) && IN(1)) for (int rep = PHREP(1); rep >= 0; --rep) {
        pg8::DenseOrder S; S.init(KWS() + WS_MEMB, KWS() + WS_WMEM, NB * NMEM, 2048, D, OG, OBX);
        pg8::EpiBf16 E{(bf16*)(KWS() + WS_MKV), 2048};
        pg8::gemm_phase<pg8::EpiBf16, pg8::DenseOrder>(lds, D, S, E);
        SEAM(1);
    }
    for (int l = 0; l < NL; ++l) {
        const int p0 = 2 + l * PH_PER_LAYER;
        if (PHEN(2) && IN(p0 + 0)) for (int rep = PHREP(2); rep >= 0; --rep) {
            pg8::DenseOrder S; S.init(KWS() + WS_XB, KWS() + WS_WIN + (size_t)OL * PINP * D * 2, NTOK, PINP, D, OG, OBX);
            pg8::EpiBf16 E{(bf16*)(KWS() + WS_P), PINP};
            pg8::gemm_phase<pg8::EpiBf16, pg8::DenseOrder>(lds, D, S, E);
            SEAM(p0 + 0);
        }
        if (PHEN(4) && IN(p0 + 1)) for (int rep = PHREP(4); rep >= 0; --rep) { c1_phase(lds, OL, OVCU, OG); SEAM(p0 + 1); }
        if (PHEN(5) && IN(p0 + 2)) for (int rep = PHREP(5); rep >= 0; --rep) { m2_phase(lds, OL, OBX, OG); SEAM(p0 + 2); }
        if (PHEN(6) && IN(p0 + 3)) for (int rep = PHREP(6); rep >= 0; --rep) { m3_gh_phase(OL, OVCU, OG); SEAM(p0 + 3); }
        if (PHEN(7) && IN(p0 + 4)) for (int rep = PHREP(7); rep >= 0; --rep) {
            pg8::DenseOrder S; S.init(KWS() + WS_O, KWS() + WS_WOUT + (size_t)OL * D * D * 2, NTOK, D, D, OG, OBX);
            pg8::EpiBf16 E{(bf16*)(KWS() + WS_HMIX), D};
            pg8::gemm_phase<pg8::EpiBf16, pg8::DenseOrder>(lds, D, S, E);
            SEAM(p0 + 4);
        }
        if (PHEN(8) && IN(p0 + 5)) for (int rep = PHREP(8); rep >= 0; --rep) { ln1_router_phase(lds, OL, OBX, OG); SEAM(p0 + 5); }
        if (PHEN(9) && IN(p0 + 6)) for (int rep = PHREP(9); rep >= 0; --rep) { slots_phase(lds, OBX, OG); SEAM(p0 + 6); }
        if (PHEN(10) && IN(p0 + 7)) for (int rep = PHREP(10); rep >= 0; --rep) {
            const int ntiles = __builtin_amdgcn_readfirstlane(((const int*)(KWS() + WS_CTL))[CW_NT]);
            pg8::MoeOrder<true> S; S.init(KWS() + WS_XF, KWS() + WS_WGU + (size_t)OL * NE * 2048 * D, (const int*)(KWS() + WS_CTL) + CW_TILEE, (const int*)(KWS() + WS_ROUTE + 3 * MiB), ntiles, 2048, D, OG, OBX);
            pg8::EpiSwiglu E{(unsigned char*)(KWS() + WS_HB), (const float*)(KWS() + WS_BGU) + (size_t)OL * NE * 2048};
            pg8::gemm_phase<pg8::EpiSwiglu, pg8::MoeOrder<true>, 1>(lds, D, S, E);
            SEAM(p0 + 7);
        }
        if (PHEN(11) && IN(p0 + 8)) for (int rep = PHREP(11); rep >= 0; --rep) {
            const int ntiles = __builtin_amdgcn_readfirstlane(((const int*)(KWS() + WS_CTL))[CW_NT]);
            pg8::MoeOrder<false> S; S.init(KWS() + WS_HB, KWS() + WS_WD + (size_t)OL * NE * D * FF, (const int*)(KWS() + WS_CTL) + CW_TILEE, (const int*)(KWS() + WS_ROUTE + 3 * MiB), ntiles, D, FF, OG, OBX);
            pg8::EpiDown E{(bf16*)(KWS() + WS_YB), KIN(I_BDN) + (size_t)OL * NE * D, (const float*)(KWS() + WS_ROUTE + 3 * MiB + 1536 * 1024)};
            pg8::gemm_phase<pg8::EpiDown, pg8::MoeOrder<false>, 1>(lds, FF, S, E);
            SEAM(p0 + 8);
        }
        if (PHEN(12) && IN(p0 + 9)) for (int rep = PHREP(12); rep >= 0; --rep) { combine_phase(OL, OVCU, OG); if (rep > 0 || l + 1 < NL) SEAM(p0 + 9); }
    }
#undef IN
#undef SEAM
}

extern "C" void kernel_launch(void* const* d_in, const int* in_sizes, int n_in, void* d_out, int out_size, void* d_ws, size_t ws_size, hipStream_t stream) {
    static int grid = 0;
    if (grid == 0) {
        if (n_in != 33 || ws_size < WS_END) { fprintf(stderr, "kernel_launch: unexpected inputs (n_in %d, ws %zu need %zu)\n", n_in, ws_size, (size_t)WS_END); grid = -1; return; }
        int dev = 0, cus = 0;
        if (hipGetDevice(&dev) != hipSuccess || hipDeviceGetAttribute(&cus, hipDeviceAttributeMultiprocessorCount, dev) != hipSuccess) { grid = -1; return; }
        if (hipFuncSetAttribute((const void*)trunk_fwd, hipFuncAttributeMaxDynamicSharedMemorySize, LDS_BYTES) != hipSuccess) { grid = -1; return; }
        int per_cu = 0; (void)hipOccupancyMaxActiveBlocksPerMultiprocessor(&per_cu, (const void*)trunk_fwd, NTHR, LDS_BYTES); (void)hipGetLastError();
        grid = cus;
    }
    if (grid < 0) return;
    (void)hipMemsetAsync((char*)d_ws + WS_CTL, 0, CTL_ZERO_BYTES, stream);
    Args a{};
    for (int i = 0; i < 33; ++i) a.in[i] = (const float*)d_in[i];
    a.out = (float*)d_out; a.ws = (unsigned char*)d_ws;
#if MK_PER_PHASE
    for (int p = 0; p < NPHASES; ++p) { a.ph_lo = p; a.ph_hi = p + 1; hipLaunchKernelGGL(trunk_fwd, dim3(grid), dim3(NTHR), LDS_BYTES, stream, a); }
#else
    a.ph_lo = 0; a.ph_hi = NPHASES;
    hipLaunchKernelGGL(trunk_fwd, dim3(grid), dim3(NTHR), LDS_BYTES, stream, a);
#endif
}
```

```cpp
#include <hip/hip_runtime.h>
#include <cstdio>
#include <cstdint>

#ifndef MK_PER_PHASE
#define MK_PER_PHASE 0
#endif

#ifndef REP_MASK
#define REP_MASK 0
#endif
#define PHREP(n) (((REP_MASK) >> (n)) & 1)
#define LAS __attribute__((address_space(3)))
#define GAS __attribute__((address_space(1)))
typedef unsigned short bf16;
typedef short bf16x8 __attribute__((ext_vector_type(8)));
typedef short s16x4 __attribute__((ext_vector_type(4)));
typedef float f32x4 __attribute__((ext_vector_type(4)));
typedef float f32x2 __attribute__((ext_vector_type(2)));
typedef float f32x16 __attribute__((ext_vector_type(16)));
typedef unsigned u32x4 __attribute__((ext_vector_type(4)));
typedef unsigned u32x2 __attribute__((ext_vector_type(2)));

constexpr int NB = 8, T = 8192, D = 1024, NL = 4, NTOK = NB * T;
constexpr int PIN = 3088, PINP = 3328;
constexpr int NE = 32, FF = 1024, NMEM = 256;
constexpr int NASSIGN = NTOK * 4;
constexpr int MAXTILES = NASSIGN / 256 + NE;
constexpr int MAXSLOTS = MAXTILES * 256;
constexpr int PC_GQ = 0, PC_GK = 128, PC_GV = 256, PC_GOUT = 512, PC_HQ = 768, PC_HF = 1024, PC_HI = 1280, PC_HG = 1536;
constexpr int PC_RW = 1792, PC_MQ = 2816, PC_GLR = 3072;
constexpr float DN_ALPHA = 1.6817928305074292f;
constexpr float LN_EPS = 1e-5f, RMS_EPS = 1e-6f, RW_LN_EPS = 64e-5f;

constexpr size_t MiB = 1u << 20;
constexpr size_t WS_CTL = 0, CTL_ZERO_BYTES = 32768;
constexpr size_t WS_WIN = 1 * MiB;
constexpr size_t WS_WOUT = WS_WIN + 26 * MiB;
constexpr size_t WS_WMEM = WS_WOUT + 8 * MiB;
constexpr size_t WS_WGU = WS_WMEM + 4 * MiB;
constexpr size_t WS_WD = WS_WGU + 512 * MiB;
constexpr size_t WS_BGU = WS_WD + 256 * MiB;
constexpr size_t WS_LORA = WS_BGU + 1 * MiB;
constexpr size_t WS_GLRW = WS_LORA + 512 * 1024;
constexpr size_t WS_MEMB = WS_LORA + 1 * MiB;
constexpr size_t WS_MKV = WS_MEMB + 4 * MiB;
constexpr size_t WS_XB = WS_MKV + 8 * MiB;
constexpr size_t WS_X1B = WS_XB + 128 * MiB;
constexpr size_t WS_XF = WS_X1B + 128 * MiB;
constexpr size_t WS_X1F = WS_XF + 256 * MiB;
constexpr size_t WS_X8 = WS_X1F;
constexpr size_t WS_O = WS_X1F + 256 * MiB;
constexpr size_t WS_HMIX = WS_O + 128 * MiB;
constexpr size_t WS_ROUTE = WS_HMIX + 128 * MiB;
constexpr size_t WS_GBUF = WS_ROUTE + 6 * MiB;
constexpr size_t WS_BONUS = WS_GBUF + 32 * MiB;
constexpr size_t WS_BIG = WS_BONUS + 1 * MiB;
constexpr size_t WS_P = WS_BIG;
constexpr size_t WS_ORAW = WS_P + 416 * MiB;
constexpr size_t WS_HB = WS_BIG;
constexpr size_t WS_YB = WS_HB + 528 * MiB;
constexpr size_t WS_CHK = WS_ORAW;
constexpr size_t WS_HQ = WS_CHK, WS_HK = WS_HQ + 32 * MiB, WS_HVT = WS_HK + 32 * MiB, WS_HDS = WS_HVT + 32 * MiB, WS_HS = WS_HDS + 128 * MiB, WS_HBE = WS_HS + 64 * MiB;
constexpr size_t WS_GQ = WS_HBE + 2 * MiB, WS_GK = WS_GQ + 16 * MiB, WS_GVT = WS_GK + 16 * MiB, WS_GDS = WS_GVT + 32 * MiB, WS_GS = WS_GDS + 64 * MiB, WS_GBE = WS_GS + 32 * MiB;
constexpr size_t WS_RR = WS_GBE + 1 * MiB, WS_RB = WS_RR + 32 * MiB, WS_RK = WS_RB + 32 * MiB, WS_RW = WS_RK + 32 * MiB, WS_RVT = WS_RW + 32 * MiB;
constexpr size_t WS_RVG = WS_RVT + 32 * MiB;
constexpr size_t WS_RU = WS_RVG + 32 * MiB, WS_RP = WS_RU + 64 * MiB, WS_RQ = WS_RP + 64 * MiB, WS_RS = WS_RQ + 128 * MiB;
constexpr size_t WS_END = WS_RS + 64 * MiB;
static_assert(WS_YB + 528 * MiB <= WS_END, "overlay");
static_assert(WS_END <= (size_t)4096 * MiB, "workspace");
constexpr int CW_TMO = 0;
constexpr int CW_BAR = 4096;
constexpr int CW_HIST = 16384;
constexpr int CW_NT = 32768;
constexpr int CW_TILEE = 32768 + 64;
constexpr int CW_PADSTART = 40960;

constexpr int RING_BYTES = 131072;
constexpr int LDSCTL_OFF = 162816, MISC_OFF = LDSCTL_OFF + 320;
constexpr int LDS_BYTES = 163840;
constexpr int NWAVES = 8, NTHR = 512;

#define RLX_AGENT __ATOMIC_RELAXED, __HIP_MEMORY_SCOPE_AGENT
#define LDS_WAIT() asm volatile("s_waitcnt lgkmcnt(0)" ::: "memory")
#define VM_WAIT() asm volatile("s_waitcnt vmcnt(0)" ::: "memory")

__device__ __forceinline__ float bf2f(unsigned short b) { return __builtin_bit_cast(float, (unsigned)b << 16); }
__device__ __forceinline__ float bflo(unsigned w) { return __builtin_bit_cast(float, w << 16); }
__device__ __forceinline__ float bfhi(unsigned w) { return __builtin_bit_cast(float, w & 0xffff0000u); }
typedef __bf16 bf16x2_t __attribute__((ext_vector_type(2)));
__device__ __forceinline__ unsigned cvt_pk_bf16(float lo, float hi) { const f32x2 v = {lo, hi}; const bf16x2_t b = __builtin_convertvector(v, bf16x2_t); return __builtin_bit_cast(unsigned, b); }
__device__ __forceinline__ unsigned pk2(float lo, float hi) { return cvt_pk_bf16(lo, hi); }
__device__ __forceinline__ unsigned f2bf(float f) { return cvt_pk_bf16(f, 0.f) & 0xffffu; }
__device__ __forceinline__ float o_q(float y) { return __builtin_amdgcn_fmed3f(y * 4.0f, -448.0f, 448.0f); }
__device__ __forceinline__ void store_o4(unsigned char* p, float y0, float y1, float y2, float y3) { int w = __builtin_amdgcn_cvt_pk_fp8_f32(o_q(y0), o_q(y1), 0, false); w = __builtin_amdgcn_cvt_pk_fp8_f32(o_q(y2), o_q(y3), w, true); *(unsigned*)p = (unsigned)w; }
__device__ __forceinline__ float fast_exp(float x) { return __builtin_amdgcn_exp2f(x * 1.4426950408889634f); }
__device__ __forceinline__ float fast_sigmoid(float x) { return __builtin_amdgcn_rcpf(1.0f + fast_exp(-x)); }
__device__ __forceinline__ float silu_f(float x) { return x * fast_sigmoid(x); }
__device__ __forceinline__ int opaque_tid() { int t = threadIdx.x; asm volatile("" : "+v"(t)); return t; }
__device__ __forceinline__ int opaque_s(int v) { asm volatile("" : "+s"(v)); return v; }
__device__ __forceinline__ void lds_barrier() { asm volatile("s_waitcnt lgkmcnt(0)" ::: "memory"); __builtin_amdgcn_s_barrier(); asm volatile("" ::: "memory"); }
__device__ __forceinline__ float dpp_add(float x, const int sel) {
    const int xi = __builtin_bit_cast(int, x); int r;
    switch (sel) { case 0: r = __builtin_amdgcn_update_dpp(xi, xi, 0xB1, 0xf, 0xf, false); break;
                   case 1: r = __builtin_amdgcn_update_dpp(xi, xi, 0x4E, 0xf, 0xf, false); break;
                   case 2: r = __builtin_amdgcn_update_dpp(xi, xi, 0x141, 0xf, 0xf, false); break;
                   default: r = __builtin_amdgcn_update_dpp(xi, xi, 0x140, 0xf, 0xf, false); break; }
    return x + __builtin_bit_cast(float, r);
}
__device__ __forceinline__ float wave_sum(float v) {
    v = dpp_add(v, 0); v = dpp_add(v, 1); v = dpp_add(v, 2); v = dpp_add(v, 3);
    v += __builtin_bit_cast(float, __builtin_amdgcn_update_dpp(0, __builtin_bit_cast(int, v), 0x142, 0xa, 0xf, false));
    v += __builtin_bit_cast(float, __builtin_amdgcn_update_dpp(0, __builtin_bit_cast(int, v), 0x143, 0xc, 0xf, false));
    return __builtin_bit_cast(float, __builtin_amdgcn_readlane(__builtin_bit_cast(int, v), 63));
}

namespace pg8 {
constexpr int BM = 256, BK = 64, HALF = 128, HTB = HALF * BK * 2, STAGE_BYTES = 8 * HTB, NXCD = 8, WGM = 8;
__host__ __device__ __forceinline__ int lds_byte(int r, int c) { const int st = (r >> 4) * 2 + (c >> 5), rr = r & 15, cc = c & 31, ob = rr * 64 + cc * 2; return st * 1024 + (ob ^ (((ob >> 9) & 1) << 5)); }
__host__ __device__ __forceinline__ void stage_rc(int b, int& R, int& C) { const int st = b / 1024, sb = b % 1024, swz = sb ^ (((sb >> 9) & 1) << 5); R = (st >> 1) * 16 + swz / 64; C = (st & 1) * 32 + (swz % 64) / 2; }
__host__ __device__ __forceinline__ int perm32(int rho) { const int n = rho >> 4, i = rho & 15; return 8 * (i >> 2) + 4 * n + (i & 3); }

typedef int v4i_t __attribute__((ext_vector_type(4)));
typedef int v8i_t __attribute__((ext_vector_type(8)));
struct Unit { int pm, pn, e; const char* A; const char* B; };
__device__ __forceinline__ unsigned asm_gload_u32(const void* p) { unsigned v; asm volatile("global_load_dword %0, %1, off" : "=v"(v) : "v"(p) : "memory"); return v; }

__device__ __forceinline__ bool static_tile(int i, int G, int c, int nM, int nN, int& pm, int& pn) {
    const int nwg = nM * nN; const long L = (long)i * G + c; if (L >= nwg) return false;
    int wgid = (int)L; { const int q = nwg / NXCD, r = nwg % NXCD, xcd = wgid % NXCD, off = wgid / NXCD; wgid = (xcd < r ? xcd * (q + 1) : r * (q + 1) + (xcd - r) * q) + off; }
    const int nig = WGM * nN, gid = wgid / nig, fm = gid * WGM, gsz = (nM - fm) < WGM ? (nM - fm) : WGM;
    pm = fm + ((wgid % nig) % gsz); pn = (wgid % nig) / gsz; return true;
}
struct DenseOrder {
    static constexpr bool GATHER = false, HAS_E = false;
    const char* A; const char* B; int nM, nN, G, c; size_t tstep;
    __device__ __forceinline__ void init(const void* A_, const void* B_, int M, int N, int K, int G_, int c_) { A = (const char*)A_; B = (const char*)B_; nM = M / BM; nN = N / BM; G = G_; c = c_; tstep = (size_t)BM * K * 2; }
    __device__ __forceinline__ bool next(int i, Unit& u) const { if (!static_tile(i, G, c, nM, nN, u.pm, u.pn)) return false; u.e = 0; u.A = A + (size_t)u.pm * tstep; u.B = B + (size_t)u.pn * tstep; return true; }
    __device__ __forceinline__ unsigned row_tok(const Unit&, int) const { return 0; }
};
template <bool GATHER_> struct MoeOrder {
    static constexpr bool GATHER = GATHER_, HAS_E = true;
    const char* A; const char* B; const int* tile_e; const int* slot_tok; int nM, nN, G, c; size_t tstep, estep;
    __device__ __forceinline__ void init(const void* A_, const void* B_, const int* tile_e_, const int* slot_tok_, int ntiles, int Nper, int Kbytes, int G_, int c_) {
        A = (const char*)A_; B = (const char*)B_; tile_e = tile_e_; slot_tok = slot_tok_; nM = ntiles; nN = Nper / BM; G = G_; c = c_; tstep = (size_t)BM * Kbytes; estep = (size_t)Nper * Kbytes; }
    __device__ __forceinline__ bool next(int i, Unit& u) const { if (!static_tile(i, G, c, nM, nN, u.pm, u.pn)) return false;
        u.e = __builtin_amdgcn_readfirstlane(tile_e[u.pm]); u.A = GATHER_ ? A : A + (size_t)u.pm * tstep; u.B = B + (size_t)u.e * estep + (size_t)u.pn * tstep; return true; }
    __device__ __forceinline__ unsigned row_tok(const Unit& u, int r) const { return (unsigned)slot_tok[u.pm * BM + r]; }
    __device__ __forceinline__ bool next_static(int i, Unit& u) const { return static_tile(i, G, c, nM, nN, u.pm, u.pn); }
    __device__ __forceinline__ const int* e_ptr(const Unit& u) const { return tile_e + u.pm; }
    __device__ __forceinline__ const int* tok_ptr(const Unit& u, int r) const { return slot_tok + u.pm * BM + r; }
    __device__ __forceinline__ void finish(Unit& u, int e) const { u.e = e; u.A = GATHER_ ? A : A + (size_t)u.pm * tstep; u.B = B + (size_t)e * estep + (size_t)u.pn * tstep; }
};

template <int WSCALE_ = 127, int ASCALE_ = 127>
struct EpiBf16T {
    static constexpr bool PERM = true; static constexpr int WSCALE = WSCALE_, ASCALE = ASCALE_;
    bf16* O; int ldc;
    __device__ __forceinline__ void init(f32x4 (&acc)[2][2][4][2], const Unit&, int, int) const {
#pragma unroll
        for (int a = 0; a < 2; ++a)
#pragma unroll
            for (int b = 0; b < 2; ++b)
#pragma unroll
                for (int m = 0; m < 4; ++m)
#pragma unroll
                    for (int n = 0; n < 2; ++n) acc[a][b][m][n] = (f32x4){0.f, 0.f, 0.f, 0.f}; }
    __device__ __forceinline__ void operator()(const f32x4 (&acc)[2][2][4][2], const Unit& u, int wr, int wc, int fr, int fq) const {
        const int row0 = u.pm * BM + wr * 64 + fr, col0 = u.pn * BM + wc * 32 + 8 * fq;
#pragma unroll
        for (int ai = 0; ai < 2; ++ai)
#pragma unroll
            for (int m = 0; m < 4; ++m) { bf16* rowp = O + (size_t)(row0 + ai * HALF + m * 16) * ldc + col0;
#pragma unroll
                for (int bj = 0; bj < 2; ++bj) { const f32x4 v0 = acc[ai][bj][m][0], v1 = acc[ai][bj][m][1];
                    u32x4 w; w.x = cvt_pk_bf16(v0[0], v0[1]); w.y = cvt_pk_bf16(v0[2], v0[3]); w.z = cvt_pk_bf16(v1[0], v1[1]); w.w = cvt_pk_bf16(v1[2], v1[3]);
                    *(u32x4*)(rowp + bj * HALF) = w; } }
    }
};
typedef EpiBf16T<> EpiBf16;
struct EpiSwiglu {
    static constexpr bool PERM = false; static constexpr int WSCALE = 123, ASCALE = 127;
    unsigned char* H; const float* bias;
    __device__ __forceinline__ void init(f32x4 (&acc)[2][2][4][2], const Unit& u, int wc, int fq) const {
        const float* bp = bias + (size_t)u.e * 2048 + u.pn * 256 + wc * 32 + 4 * fq;
#pragma unroll
        for (int bj = 0; bj < 2; ++bj)
#pragma unroll
            for (int n = 0; n < 2; ++n) { const f32x4 bv = *(const f32x4*)(bp + bj * HALF + n * 16);
#pragma unroll
                for (int ai = 0; ai < 2; ++ai)
#pragma unroll
                    for (int m = 0; m < 4; ++m) acc[ai][bj][m][n] = bv; } }
    __device__ __forceinline__ void operator()(const f32x4 (&acc)[2][2][4][2], const Unit& u, int wr, int wc, int fr, int fq) const {
        const int row0 = u.pm * BM + wr * 64 + fr, colh = u.pn * 128 + wc * 32 + 8 * fq;
        f32x2 kc = {-1.702f * 1.4426950408889634f, -1.702f * 1.4426950408889634f}, k1 = {1.0f, 1.0f}; asm volatile("" : "+v"(kc), "+v"(k1));
#pragma unroll
        for (int ai = 0; ai < 2; ++ai)
#pragma unroll
            for (int m = 0; m < 4; ++m) { unsigned char* rowp = H + (size_t)(row0 + ai * HALF + m * 16) * FF + colh;
                float o[8];
#pragma unroll
                for (int n = 0; n < 2; ++n)
#pragma unroll
                    for (int hq = 0; hq < 2; ++hq) { const f32x4 g4 = acc[ai][0][m][n], u4 = acc[ai][1][m][n]; f32x2 g, up, e, r;
#pragma unroll
                        for (int j = 0; j < 2; ++j) { g[j] = __builtin_amdgcn_fmed3f(g4[2 * hq + j], -3.0e38f, 7.0f); up[j] = __builtin_amdgcn_fmed3f(u4[2 * hq + j], -7.0f, 7.0f); }
                        const f32x2 t = g * kc;
#pragma unroll
                        for (int j = 0; j < 2; ++j) e[j] = __builtin_amdgcn_exp2f(t[j]);
                        const f32x2 d = e + k1;
#pragma unroll
                        for (int j = 0; j < 2; ++j) r[j] = __builtin_amdgcn_rcpf(d[j]);
                        const f32x2 glu = g * r, ov = up * glu + glu;
                        o[n * 4 + 2 * hq] = ov[0]; o[n * 4 + 2 * hq + 1] = ov[1]; }
                int w0 = __builtin_amdgcn_cvt_pk_fp8_f32(o[0], o[1], 0, false); w0 = __builtin_amdgcn_cvt_pk_fp8_f32(o[2], o[3], w0, true);
                int w1 = __builtin_amdgcn_cvt_pk_fp8_f32(o[4], o[5], 0, false); w1 = __builtin_amdgcn_cvt_pk_fp8_f32(o[6], o[7], w1, true);
                *(u32x2*)rowp = (u32x2){(unsigned)w0, (unsigned)w1}; }
    }
};
struct EpiDown {
    static constexpr bool PERM = true; static constexpr int WSCALE = 122, ASCALE = 127;
    unsigned char* Y; const float* bias;
    __device__ __forceinline__ void init(f32x4 (&acc)[2][2][4][2], const Unit& u, int wc, int fq) const {
        const float* bp = bias + (size_t)u.e * 1024 + u.pn * BM + wc * 32 + 8 * fq;
#pragma unroll
        for (int bj = 0; bj < 2; ++bj)
#pragma unroll
            for (int n = 0; n < 2; ++n) { const f32x4 bv = *(const f32x4*)(bp + bj * HALF + 4 * n);
#pragma unroll
                for (int ai = 0; ai < 2; ++ai)
#pragma unroll
                    for (int m = 0; m < 4; ++m) acc[ai][bj][m][n] = bv; } }
    __device__ __forceinline__ void operator()(const f32x4 (&acc)[2][2][4][2], const Unit& u, int wr, int wc, int fr, int fq) const {
        const int row0 = u.pm * BM + wr * 64 + fr, col0 = u.pn * BM + wc * 32 + 8 * fq;
#pragma unroll
        for (int ai = 0; ai < 2; ++ai)
#pragma unroll
            for (int m = 0; m < 4; ++m) { const int row = row0 + ai * HALF + m * 16; const float g = 16.0f; unsigned char* rowp = Y + (size_t)row * D + col0;
#pragma unroll
                for (int bj = 0; bj < 2; ++bj) { const f32x4 v0 = acc[ai][bj][m][0] * g, v1 = acc[ai][bj][m][1] * g;
                    int w0 = __builtin_amdgcn_cvt_pk_fp8_f32(v0[0], v0[1], 0, false); w0 = __builtin_amdgcn_cvt_pk_fp8_f32(v0[2], v0[3], w0, true);
                    int w1 = __builtin_amdgcn_cvt_pk_fp8_f32(v1[0], v1[1], 0, false); w1 = __builtin_amdgcn_cvt_pk_fp8_f32(v1[2], v1[3], w1, true);
                    *(u32x2*)(rowp + bj * HALF) = (u32x2){(unsigned)w0, (unsigned)w1}; } }
    }
};

template <class Epi, class Sched, int ES = 2, bool ALIGN_EPI = true>
__device__ __forceinline__ void gemm_phase(LAS unsigned char* lds, const int K, const Sched& S, const Epi& E) {
    constexpr bool GA = Sched::GATHER;
    const int tid = opaque_tid(), wid = __builtin_amdgcn_readfirstlane(tid >> 6), lane = tid & 63, wr = wid >> 2, wc = wid & 3, fr = lane & 15, fq = lane >> 4;
    const int nt = K * ES / (BK * 2);
    unsigned voffA[2], voffB[2]; int Rr[2]; unsigned Cb[2];
#pragma unroll
    for (int i = 0; i < 2; ++i) { int R, C; stage_rc(tid * 16 + i * 8192, R, C); const int Rb = Epi::PERM ? ((R & ~31) + perm32(R & 31)) : R;
        voffA[i] = (unsigned)(R * K * ES + C * 2); voffB[i] = (unsigned)(Rb * K * ES + C * 2); Rr[i] = R; Cb[i] = (unsigned)C * 2u; }
    const size_t kstep = (size_t)(BK * 2);
    const size_t hstep = (size_t)HALF * K * ES;
    const unsigned ldsw = (unsigned)wid * 1024u;
    const int aoff0 = lds_byte(wr * 64 + fr, fq * 8), aoff1 = lds_byte(wr * 64 + fr, fq * 8 + 32);
    const int boff0 = lds_byte(wc * 32 + fr, fq * 8), boff1 = lds_byte(wc * 32 + fr, fq * 8 + 32);
    unsigned cOff[2][2], nOff[2][2], sOff[2][2];
#define PG8_SA(b, h) (((b) * 2 + (h)) * HTB)
#define PG8_SB(b, h) ((4 + (b) * 2 + (h)) * HTB)
#define PG8_STAGE(bufoff, gbase, voff) do { _Pragma("unroll") for (int _i = 0; _i < 2; ++_i) \
        __builtin_amdgcn_global_load_lds((const unsigned*)((const char*)(gbase) + (voff)[_i]), (LAS unsigned*)(lds + (bufoff) + ldsw + _i * 8192), 16, 0, 0); } while (0)
#define PG8_STAGE_A(bufoff, gbase, half, OFF) do { if constexpr (GA) { PG8_STAGE(bufoff, gbase, (OFF)[half]); } else { PG8_STAGE(bufoff, (gbase) + (half) * hstep, voffA); } } while (0)
#define PG8_LDA(dst, b, h) do { if constexpr (ES == 2) { _Pragma("unroll") for (int m = 0; m < 4; ++m) _Pragma("unroll") for (int k = 0; k < 2; ++k) dst[m][k] = *(const LAS bf16x8*)(lds + PG8_SA(b, h) + (k ? aoff1 : aoff0) + m * 2048); } \
        else { _Pragma("unroll") for (int m = 0; m < 4; ++m) dst##8[m] = __builtin_shufflevector(*(const LAS v4i_t*)(lds + PG8_SA(b, h) + aoff0 + m * 2048), *(const LAS v4i_t*)(lds + PG8_SA(b, h) + aoff1 + m * 2048), 0, 1, 2, 3, 4, 5, 6, 7); } } while (0)
#define PG8_LDB(dst, b, h) do { if constexpr (ES == 2) { _Pragma("unroll") for (int n = 0; n < 2; ++n) _Pragma("unroll") for (int k = 0; k < 2; ++k) dst[n][k] = *(const LAS bf16x8*)(lds + PG8_SB(b, h) + (k ? boff1 : boff0) + n * 2048); } \
        else { _Pragma("unroll") for (int n = 0; n < 2; ++n) dst##8[n] = __builtin_shufflevector(*(const LAS v4i_t*)(lds + PG8_SB(b, h) + boff0 + n * 2048), *(const LAS v4i_t*)(lds + PG8_SB(b, h) + boff1 + n * 2048), 0, 1, 2, 3, 4, 5, 6, 7); } } while (0)
#define PG8_MMA(ai, bj, At, Bt) do { __builtin_amdgcn_s_setprio(1); _Pragma("unroll") for (int m = 0; m < 4; ++m) _Pragma("unroll") for (int n = 0; n < 2; ++n) { \
        if constexpr (ES == 2) { _Pragma("unroll") for (int k = 0; k < 2; ++k) acc[ai][bj][m][n] = __builtin_amdgcn_mfma_f32_16x16x32_bf16(Bt[n][k], At[m][k], acc[ai][bj][m][n], 0, 0, 0); } \
        else { asm volatile("v_mfma_scale_f32_16x16x128_f8f6f4 %0, %1, %2, %0, %3, %4 op_sel_hi:[0,0,0]" : "+v"(acc[ai][bj][m][n]) : "v"(Bt##8[n]), "v"(At##8[m]), "v"(wscale_v), "v"(ascale_v)); } } \
        __builtin_amdgcn_s_setprio(0); } while (0)
#define PG8_WAIT_V(n) asm volatile("s_waitcnt vmcnt(" #n ")" ::: "memory")
#define PG8_WAIT_L(n) asm volatile("s_waitcnt lgkmcnt(" #n ")" ::: "memory")
#define PG8_WAIT_VR() do { if (relax) { if constexpr (GA) PG8_WAIT_V(13); else PG8_WAIT_V(9); } else PG8_WAIT_V(8); } while (0)
#define PG8_BAR __builtin_amdgcn_s_barrier()
#define PG8_SCHED __builtin_amdgcn_sched_barrier(0)
#define PG8_GOFF(dst, u) do { if constexpr (GA) { _Pragma("unroll") for (int _h = 0; _h < 2; ++_h) _Pragma("unroll") for (int _i = 0; _i < 2; ++_i) \
        dst[_h][_i] = S.row_tok(u, _h * HALF + Rr[_i]) * (unsigned)(K * ES) + Cb[_i]; } } while (0)
    Unit cur, nxt; int ui = 0;
    if (!S.next(0, cur)) return;
#ifndef GEMM_STAGGER_TICKS
#define GEMM_STAGGER_TICKS 0
#endif
    if (GEMM_STAGGER_TICKS > 0) {
        const unsigned long long t0 = __builtin_amdgcn_s_memrealtime(), dl = (unsigned long long)((S.c * 5) & 15) * GEMM_STAGGER_TICKS;
        while (__builtin_amdgcn_s_memrealtime() - t0 < dl) __builtin_amdgcn_s_sleep(8);
    }
    f32x4 acc[2][2][4][2];
    E.init(acc, cur, wc, fq);
    int wscale_v = Epi::WSCALE, ascale_v = Epi::ASCALE; asm volatile("" : "+v"(wscale_v), "+v"(ascale_v));
    bf16x8 At[4][2], B0[2][2], B1[2][2];
    v8i_t At8[4], B08[2], B18[2];
    const char* cA = cur.A; const char* cB = cur.B;
    PG8_GOFF(cOff, cur);
#pragma unroll
    for (int h = 0; h < 2; ++h)
#pragma unroll
        for (int i = 0; i < 2; ++i) { nOff[h][i] = 0u; sOff[h][i] = 0u; }
    if constexpr (GA) { VM_WAIT(); }
    PG8_STAGE(PG8_SB(0, 0), cB, voffB); PG8_STAGE(PG8_SB(0, 1), cB + hstep, voffB); PG8_STAGE_A(PG8_SA(0, 0), cA, 0, cOff); PG8_STAGE_A(PG8_SA(0, 1), cA, 1, cOff);
    if (wr == 1) PG8_BAR;
    PG8_WAIT_V(2); PG8_BAR;
    PG8_STAGE(PG8_SB(1, 0), cB + kstep, voffB); PG8_STAGE_A(PG8_SA(1, 0), cA + kstep, 0, cOff); PG8_STAGE(PG8_SB(1, 1), cB + hstep + kstep, voffB);
    PG8_WAIT_V(6); PG8_BAR;
    for (;;) {
        bool has_next; const char* nA = cA; const char* nB = cB;
        unsigned eraw = 0u, traw[2][2] = {{0u, 0u}, {0u, 0u}};
        if constexpr (Sched::HAS_E) {
            has_next = S.next_static(ui + 1, nxt);
            if (has_next) { eraw = asm_gload_u32(S.e_ptr(nxt));
                if constexpr (GA) {
#pragma unroll
                    for (int h = 0; h < 2; ++h)
#pragma unroll
                        for (int i = 0; i < 2; ++i) traw[h][i] = asm_gload_u32(S.tok_ptr(nxt, h * HALF + Rr[i])); } }
        } else { has_next = S.next(ui + 1, nxt); if (has_next) { nA = nxt.A; nB = nxt.B; } }
#pragma unroll 1
        for (int t = 0; t < nt; t += 2) {
            const bool last = (t == nt - 2);
            const bool relax = Sched::HAS_E && has_next && t == 0;
            if constexpr (Sched::HAS_E) { if (last) {
                if (has_next) {
                    if constexpr (GA) asm volatile("" : "+v"(eraw), "+v"(traw[0][0]), "+v"(traw[0][1]), "+v"(traw[1][0]), "+v"(traw[1][1]) :: "memory"); else asm volatile("" : "+v"(eraw) :: "memory");
                    S.finish(nxt, __builtin_amdgcn_readfirstlane((int)eraw)); nA = nxt.A; nB = nxt.B;
                    if constexpr (GA) {
#pragma unroll
                        for (int h = 0; h < 2; ++h)
#pragma unroll
                            for (int i = 0; i < 2; ++i) nOff[h][i] = traw[h][i] * (unsigned)(K * ES) + Cb[i]; }
                } else if constexpr (GA) {
#pragma unroll
                    for (int h = 0; h < 2; ++h)
#pragma unroll
                        for (int i = 0; i < 2; ++i) nOff[h][i] = cOff[h][i]; } } }
            const char* a1 = cA + (size_t)(t + 1) * kstep;
            const char* a2 = last ? nA : cA + (size_t)(t + 2) * kstep; const char* b2 = last ? nB : cB + (size_t)(t + 2) * kstep;
            const char* a3 = a2 + kstep; const char* b3 = b2 + kstep;
            if constexpr (GA) {
#pragma unroll
                for (int h = 0; h < 2; ++h)
#pragma unroll
                    for (int i = 0; i < 2; ++i) sOff[h][i] = last ? nOff[h][i] : cOff[h][i]; }
            PG8_LDB(B0, 0, 0); PG8_LDB(B1, 0, 1); PG8_SCHED; PG8_LDA(At, 0, 0); PG8_STAGE_A(PG8_SA(1, 1), a1, 1, cOff);
            PG8_WAIT_VR(); PG8_WAIT_L(0); PG8_BAR; PG8_MMA(0, 0, At, B0); PG8_MMA(0, 1, At, B1); PG8_BAR; PG8_SCHED;
            PG8_LDA(At, 0, 1); PG8_STAGE(PG8_SB(0, 0), b2, voffB); PG8_STAGE(PG8_SB(0, 1), b2 + hstep, voffB); PG8_STAGE_A(PG8_SA(0, 0), a2, 0, sOff);
            PG8_WAIT_VR(); PG8_WAIT_L(0); PG8_BAR; PG8_MMA(1, 0, At, B0); PG8_MMA(1, 1, At, B1); PG8_BAR; PG8_SCHED;
            PG8_LDB(B0, 1, 0); PG8_LDB(B1, 1, 1); PG8_SCHED; PG8_LDA(At, 1, 0); PG8_STAGE_A(PG8_SA(0, 1), a2, 1, sOff);
            PG8_WAIT_V(8); PG8_WAIT_L(0); PG8_BAR; PG8_MMA(0, 0, At, B0); PG8_MMA(0, 1, At, B1); PG8_BAR; PG8_SCHED;
            PG8_LDA(At, 1, 1); PG8_STAGE(PG8_SB(1, 0), b3, voffB); PG8_STAGE(PG8_SB(1, 1), b3 + hstep, voffB); PG8_STAGE_A(PG8_SA(1, 0), a3, 0, sOff);
            PG8_WAIT_V(8); PG8_WAIT_L(0); PG8_BAR; PG8_MMA(1, 0, At, B0); PG8_MMA(1, 1, At, B1); PG8_BAR; PG8_SCHED;
        }
        if constexpr (ALIGN_EPI) { if (wr == 0) PG8_BAR; }
        if constexpr (ES == 1) { asm volatile("s_nop 15\n\ts_nop 15" ::: "memory"); }
        E(acc, cur, wr, wc, fr, fq);
        if (PHREP(25)) E(acc, cur, wr, wc, fr, fq);
        if (!has_next) break;
        E.init(acc, nxt, wc, fq);
        cur = nxt; cA = nA; cB = nB; ++ui;
        if constexpr (GA) {
#pragma unroll
            for (int h = 0; h < 2; ++h)
#pragma unroll
                for (int i = 0; i < 2; ++i) cOff[h][i] = nOff[h][i]; }
        if constexpr (ALIGN_EPI) { if (wr == 1) PG8_BAR; }
    }
    PG8_WAIT_V(0);
    if constexpr (!ALIGN_EPI) { if (wr == 0) PG8_BAR; }
    PG8_BAR;
#undef PG8_SA
#undef PG8_SB
#undef PG8_STAGE
#undef PG8_STAGE_A
#undef PG8_LDA
#undef PG8_LDB
#undef PG8_MMA
#undef PG8_WAIT_V
#undef PG8_WAIT_L
#undef PG8_WAIT_VR
#undef PG8_BAR
#undef PG8_SCHED
#undef PG8_GOFF
}
}

#define XB_TMO      128
#define XB_XCNT(j)  (256  + 64 * (j))
#define XB_XSUB(j)  (1280 + 64 * (j))
#define XB_XGEN(j)  (2304 + 64 * (j))
#define XB_TOP      3328
#define XB_TOPGEN   3392
#define XCD_BAR_WORDS 3456
#define XB_SPIN_CAP (1u << 18)
__device__ __forceinline__ unsigned xb_ld(unsigned* p)              { return __hip_atomic_load(p, __ATOMIC_RELAXED, __HIP_MEMORY_SCOPE_AGENT); }
__device__ __forceinline__ unsigned xb_add(unsigned* p, unsigned v) { return __hip_atomic_fetch_add(p, v, __ATOMIC_RELAXED, __HIP_MEMORY_SCOPE_AGENT); }
__device__ __forceinline__ unsigned xb_xcc_id() { return (unsigned)__builtin_amdgcn_s_getreg((3 << 11) | 20) & 0xFu; }
#define XB_SPIN(cond, bar) do { unsigned _sp = 0; while (cond) { __builtin_amdgcn_s_sleep(1); \
    if ((++_sp & 255u) == 0u) { if (xb_ld(&(bar)[XB_TMO])) break; if (_sp > XB_SPIN_CAP) { atomicAdd(&(bar)[XB_TMO], 1u); break; } } } } while (0)
struct XcdBarrier { unsigned* bar; unsigned x; volatile LAS unsigned* st; };
__device__ __forceinline__ XcdBarrier xcd_barrier_post(unsigned* bar, volatile LAS unsigned* st) {
    XcdBarrier b; b.bar = bar; b.x = xb_xcc_id(); b.st = st;
    if (threadIdx.x == 0) (void)xb_add(&bar[XB_XCNT(b.x)], 1u);
    return b;
}
__device__ __forceinline__ void xcd_barrier_complete(unsigned* bar, unsigned x, unsigned& nloc, unsigned& nx) {
    const unsigned G = gridDim.x * gridDim.y * gridDim.z;
    unsigned sum, cnt, mine, sp = 0u;
    for (;;) {
        sum = 0u; cnt = 0u; mine = 0u;
#pragma unroll
        for (unsigned j = 0; j < 16; ++j) { const unsigned c = xb_ld(&bar[XB_XCNT(j)]); sum += c; cnt += (c > 0u) ? 1u : 0u; mine = (j == x) ? c : mine; }
        if (sum == G) break;
        __builtin_amdgcn_s_sleep(1);
        if ((++sp & 255u) == 0u) { if (xb_ld(&bar[XB_TMO])) break; if (sp > XB_SPIN_CAP) { atomicAdd(&bar[XB_TMO], 1u); break; } }
    }
    nloc = mine > 0u ? mine : 1u; nx = cnt > 0u ? cnt : 1u;
}
__device__ __forceinline__ void xcd_barrier(const XcdBarrier& b) {
    asm volatile("s_waitcnt vmcnt(0)" ::: "memory");
    __syncthreads();
    if (threadIdx.x == 0) {
        unsigned* bar = b.bar;
        __builtin_amdgcn_s_waitcnt(0);
        unsigned nloc = b.st[0], nx = b.st[1];
        if (nloc == 0u) { xcd_barrier_complete(bar, b.x, nloc, nx); b.st[0] = nloc; b.st[1] = nx; }
        const unsigned old = xb_add(&bar[XB_XSUB(b.x)], 1u);
        const unsigned gen = old / nloc;
        if (old + 1u == (gen + 1u) * nloc) {
            __builtin_amdgcn_fence(__ATOMIC_RELEASE, "agent");
            asm volatile("s_waitcnt vmcnt(0)" ::: "memory");
            const unsigned og = xb_add(&bar[XB_TOP], 1u);
            const unsigned tg = og / nx;
            if (og + 1u == (tg + 1u) * nx) xb_add(&bar[XB_TOPGEN], 1u);
            else XB_SPIN(xb_ld(&bar[XB_TOPGEN]) == tg, bar);
            __builtin_amdgcn_fence(__ATOMIC_ACQUIRE, "agent");
            xb_add(&bar[XB_XGEN(b.x)], 1u);
            asm volatile("s_waitcnt vmcnt(0)" ::: "memory");
        } else {
            XB_SPIN(xb_ld(&bar[XB_XGEN(b.x)]) == gen, bar);
            __builtin_amdgcn_fence(__ATOMIC_ACQUIRE, "agent");
            asm volatile("s_waitcnt vmcnt(0)" ::: "memory");
        }
    }
    __syncthreads();
}

struct Args {
    const float* in[33];
    float* out; unsigned char* ws;
    int ph_lo, ph_hi;
};
enum { I_X = 0, I_MEM, I_WIN, I_GLACONV, I_GLAW2, I_GLAB, I_GLANG, I_HGLB, I_HGNG, I_RWMU, I_RWW0, I_RWW2, I_RWA0, I_RWA2, I_RWG2, I_RWKK, I_RWKA, I_RWRK, I_RWLNW, I_RWLNB,
       I_WMK, I_WMV, I_WOUT, I_LN1G, I_LN1B, I_RTW, I_RTB, I_WGU, I_BGU, I_WDN, I_BDN, I_LN2G, I_LN2B };


template <int OFF> __device__ __forceinline__ unsigned long long ka_u64() { unsigned long long v; asm volatile("s_load_dwordx2 %0, %1, %2\n\ts_waitcnt lgkmcnt(0)" : "=s"(v) : "s"(__builtin_amdgcn_kernarg_segment_ptr()), "n"(OFF)); return v; }
#define KIN(i) ((const float*)(const GAS float*)ka_u64<8 * (i)>())
#define KOUT() ((float*)(GAS float*)ka_u64<264>())
#define KWS() ((unsigned char*)(GAS unsigned char*)ka_u64<272>())

template <class Map>
__device__ __forceinline__ void tr_item(const float* __restrict__ W, int K, int N, bf16* __restrict__ WT, LAS float* scr, int kb, int nb, int lane, Map map) {
    const int k0 = 64 * kb, n0 = 64 * nb, col = n0 + lane; const bool valid = col < N;
    const float* src = W + (size_t)k0 * N + (valid ? col : 0);
#pragma unroll 64
    for (int kk = 0; kk < 64; ++kk) { const float v = valid ? src[(size_t)kk * N] : 0.f; scr[kk * 65 + lane] = v; }
    LDS_WAIT(); asm volatile("" ::: "memory");
    const int c = lane & 7;
#pragma unroll
    for (int j = 0; j < 8; ++j) { const int n = (lane >> 3) + 8 * j;
        if (n0 + n < N) { const int orow = map(n0 + n); const LAS float* s = scr + (8 * c) * 65 + n;
            u32x4 o; o.x = pk2(s[0 * 65], s[1 * 65]); o.y = pk2(s[2 * 65], s[3 * 65]); o.z = pk2(s[4 * 65], s[5 * 65]); o.w = pk2(s[6 * 65], s[7 * 65]);
            *(u32x4*)(WT + (size_t)orow * K + k0 + 8 * c) = o; } }
    LDS_WAIT(); asm volatile("" ::: "memory");
}
template <bool GUARD = false, class Map>
__device__ __forceinline__ void tr_item_f8(const float* __restrict__ W, int K, int N, unsigned char* __restrict__ WT8, LAS float* scr, int kb, int nb, int lane, float scale, Map map) {
    const int k0 = 64 * kb, n0 = 64 * nb, col = (GUARD && n0 + lane >= N) ? N - 1 : n0 + lane;
    const float* src = W + (size_t)k0 * N + col;
#pragma unroll 64
    for (int kk = 0; kk < 64; ++kk) scr[kk * 65 + lane] = src[(size_t)kk * N] * scale;
    LDS_WAIT(); asm volatile("" ::: "memory");
    const int c = lane & 3;
#pragma unroll
    for (int j = 0; j < 4; ++j) { const int n = (lane >> 2) + 16 * j; const LAS float* s = scr + (16 * c) * 65 + n;
        u32x4 o;
#pragma unroll
        for (int q = 0; q < 4; ++q) { int w = __builtin_amdgcn_cvt_pk_fp8_f32(s[(4 * q) * 65], s[(4 * q + 1) * 65], 0, false); w = __builtin_amdgcn_cvt_pk_fp8_f32(s[(4 * q + 2) * 65], s[(4 * q + 3) * 65], w, true); o[q] = (unsigned)w; }
        if (!GUARD || n0 + n < N) { const int orow = map(n0 + n); *(u32x4*)(WT8 + (size_t)orow * K + k0 + 16 * c) = o; } }
    LDS_WAIT(); asm volatile("" ::: "memory");
}
struct MapIdent { int off; __device__ __forceinline__ int operator()(int c) const { return c + off; } };
struct MapWin { __device__ __forceinline__ int operator()(int c) const { return c < 512 ? c : (c < 528 ? c + 2560 : c - 16); } };
__device__ __forceinline__ int gu_row(int c) { const int f = c >> 1, bj = c & 1, pn = f >> 7, fl = f & 127, wc = fl >> 5, fq = (fl >> 3) & 3, n = (fl >> 2) & 1, j = fl & 3; return 256 * pn + 128 * bj + 32 * wc + 16 * n + 4 * fq + j; }
struct MapGu { __device__ __forceinline__ int operator()(int c) const { return gu_row(c); } };

__device__ __forceinline__ void prologue_phase(LAS unsigned char* lds, int vcu, int G) {
    const int tid = opaque_tid(), lane = tid & 63, wave = __builtin_amdgcn_readfirstlane(tid >> 6);
    LAS float* scr = (LAS float*)(lds + wave * 16640); static_assert(8 * 16640 <= LDSCTL_OFF, "prologue scratch below the LDS control words");
    const int gw = vcu * NWAVES + wave, NGW = G * NWAVES;
    unsigned char* ws = KWS();
    constexpr int IT_GU = NL * NE * 512, IT_DN = NL * NE * 256, IT_IN = NL * 16 * 49, IT_OUT = NL * 256, IT_MEM = NL * 2 * 64, IT_L64 = NL * 2 * 4, IT_L128 = NL * 2 * 4;
    constexpr int IT_TOTAL = IT_GU + IT_DN + IT_IN + IT_OUT + IT_MEM + IT_L64 + IT_L128;
    for (int it = gw; it < IT_TOTAL; it += NGW) {
        int r = it;
        if (r < IT_GU) { const int le = r >> 9, q = r & 511, kb = q >> 5, nb = q & 31;
            tr_item_f8(KIN(I_WGU) + (size_t)le * 1024 * 2048, 1024, 2048, (unsigned char*)(ws + WS_WGU) + (size_t)le * 2048 * 1024, scr, kb, nb, lane, 16.0f, MapGu{}); continue; } r -= IT_GU;
        if (r < IT_DN) { const int le = r >> 8, q = r & 255, kb = q >> 4, nb = q & 15;
            tr_item_f8(KIN(I_WDN) + (size_t)le * 1024 * 1024, 1024, 1024, (unsigned char*)(ws + WS_WD) + (size_t)le * 1024 * 1024, scr, kb, nb, lane, 32.0f, MapIdent{0}); continue; } r -= IT_DN;
        if (r < IT_IN) { const int l = r / (16 * 49), q = r % (16 * 49), kb = q / 49, nb = q % 49;
            tr_item_f8<true>(KIN(I_WIN) + (size_t)l * 1024 * PIN, 1024, PIN, (unsigned char*)(ws + WS_WIN) + (size_t)l * PINP * 1024, scr, kb, nb, lane, 16.0f, MapWin{}); continue; } r -= IT_IN;
        if (r < IT_OUT) { const int l = r >> 8, q = r & 255, kb = q >> 4, nb = q & 15;
            tr_item_f8(KIN(I_WOUT) + (size_t)l * 1024 * 1024, 1024, 1024, (unsigned char*)(ws + WS_WOUT) + (size_t)l * 1024 * 1024, scr, kb, nb, lane, 32.0f, MapIdent{0}); continue; } r -= IT_OUT;
        if (r < IT_MEM) { const int l = r >> 7, q = r & 127, kv = q >> 6, kb = (q >> 2) & 15, nb = q & 3;
            tr_item((kv ? KIN(I_WMV) : KIN(I_WMK)) + (size_t)l * 1024 * 256, 1024, 256, (bf16*)(ws + WS_WMEM), scr, kb, nb, lane, MapIdent{l * 512 + kv * 256}); continue; } r -= IT_MEM;
        if (r < IT_L64) { const int l = r >> 3, q = r & 7, wa = q >> 2, nb = q & 3;
            tr_item((wa ? KIN(I_RWA2) : KIN(I_RWW2)) + (size_t)l * 64 * 256, 64, 256, (bf16*)(ws + WS_LORA) + (size_t)wa * (NL * 256 * 64) + (size_t)l * 256 * 64, scr, 0, nb, lane, MapIdent{0}); continue; } r -= IT_L64;
        { const int l = r >> 3, q = r & 7, kb = q >> 2, nb = q & 3;
            tr_item(KIN(I_RWG2) + (size_t)l * 128 * 256, 128, 256, (bf16*)(ws + WS_LORA) + (size_t)2 * (NL * 256 * 64) + (size_t)l * 256 * 128, scr, kb, nb, lane, MapIdent{0}); }
    }
    { const size_t gt = (size_t)vcu * NTHR + tid, GT = (size_t)G * NTHR; constexpr size_t per = (size_t)(PINP - PIN) * 1024 / 16;
        for (size_t i = gt; i < per * NL; i += GT) { const size_t l = i / per, j = i % per; *(u32x4*)((unsigned char*)(ws + WS_WIN) + l * PINP * 1024 + (size_t)PIN * 1024 + j * 16) = (u32x4){0u, 0u, 0u, 0u}; }
        for (size_t i = gt; i < (size_t)NL * 8192; i += GT) { const int l = (int)(i >> 13), q = (int)(i >> 6) & 127, ln = (int)i & 63, jj = q >> 4, c = q & 15, k0 = 4 * (ln + 64 * (jj >> 1)) + 2 * (jj & 1);
            const float* s = KIN(I_WIN) + (size_t)l * 1024 * PIN + (size_t)k0 * PIN + 512 + c; ((unsigned*)(ws + WS_GLRW))[i] = pk2(s[0], s[PIN]); }
        for (size_t i = gt; i < (size_t)NL * NE * 2048; i += GT) { const size_t le = i >> 11; const int c = (int)(i & 2047); ((float*)(ws + WS_BGU))[le * 2048 + gu_row(c)] = KIN(I_BGU)[i]; }
        const f32x4* xs = (const f32x4*)KIN(I_X); unsigned char* xd8 = (unsigned char*)(ws + WS_X8);
        for (size_t i = gt; i < (size_t)NTOK * D / 8; i += GT) { const f32x4 v0 = xs[2 * i], v1 = xs[2 * i + 1]; store_o4(xd8 + 8 * i, v0[0], v0[1], v0[2], v0[3]); store_o4(xd8 + 8 * i + 4, v1[0], v1[1], v1[2], v1[3]); }
        const f32x4* ms = (const f32x4*)KIN(I_MEM); u32x4* md = (u32x4*)(ws + WS_MEMB);
        for (size_t i = gt; i < (size_t)NB * NMEM * D / 8; i += GT) { const f32x4 v0 = ms[2 * i], v1 = ms[2 * i + 1]; md[i] = (u32x4){pk2(v0[0], v0[1]), pk2(v0[2], v0[3]), pk2(v1[0], v1[1]), pk2(v1[2], v1[3])}; }
    }
}


__device__ __forceinline__ float log1pexp_neg_abs(float z) { return __builtin_amdgcn_logf(1.0f + fast_exp(-fabsf(z))) * 0.6931471805599453f; }
__device__ __forceinline__ float tanh_f(float x) { const float e = fast_exp(-2.0f * fabsf(x)); const float t = (1.0f - e) * __builtin_amdgcn_rcpf(1.0f + e); return x < 0.f ? -t : t; }

constexpr int NCH = T / 32;
__device__ __forceinline__ int rho16(int r, int hh) { return (r & 3) + 8 * (r >> 2) + 4 * hh; }
__device__ __forceinline__ void hg_fused_unit(LAS unsigned char* lds, int l, int b, int c) {
    const int tid = opaque_tid(), lane = tid & 63, wave = __builtin_amdgcn_readfirstlane(tid >> 6), r32 = lane & 31, hh = lane >> 5;
    unsigned char* ws = KWS();
    const bf16* P = (const bf16*)(ws + WS_P) + ((size_t)b * T + c * 32) * PINP;
    constexpr int HB = 16640;
    if (tid < 256) {
        const int ch = tid, h = ch >> 6, d = ch & 63; const size_t un = (size_t)(b * 4 + h) * NCH + c;
        const float* hp = KIN(I_HGLB) + ch; const float v0 = hp[0], v1 = hp[256], v2 = hp[512], v3 = hp[768];
        unsigned short hqr[32], hfr[32];
#pragma unroll
        for (int t = 0; t < 32; ++t) { const bf16* row = P + (size_t)t * PINP; hqr[t] = row[PC_HQ + ch]; hfr[t] = row[PC_HF + ch]; }
        __builtin_amdgcn_sched_barrier(0);
        float lb;
        { const float m = fmaxf(fmaxf(v0, v1), fmaxf(v2, v3));
          const float e0 = __expf(v0 - m), e1 = __expf(v1 - m), e2 = __expf(v2 - m), e3 = __expf(v3 - m); const float inv = 1.0f / (e0 + e1 + e2 + e3);
          lb = (l >= 1 ? e1 : 0.f) + (l >= 2 ? e2 : 0.f) + (l >= 3 ? e3 : 0.f); lb *= inv; }
        const float oml = 1.0f - lb;
        LAS bf16* KT = (LAS bf16*)(lds + h * HB); LAS float* BE = (LAS float*)(lds + h * HB + 8192);
        LAS bf16* QL = (LAS bf16*)(lds + h * HB + 8448) + d; LAS bf16* KL = (LAS bf16*)(lds + h * HB + 12544) + d;
        float bc = 0.f;
#pragma unroll
        for (int t8 = 0; t8 < 4; ++t8) { u32x4 kp;
#pragma unroll
            for (int jj = 0; jj < 4; ++jj) { float k2[2];
#pragma unroll
                for (int e = 0; e < 2; ++e) { const int t = t8 * 8 + jj * 2 + e; const float hf = bf2f(hfr[t]); const float s = fast_sigmoid(hf), sn = fast_sigmoid(-hf);
                    bc = fmaxf(bc + __builtin_amdgcn_logf(fmaxf(lb + oml * s, 1e-30f)) * 0.6931471805599453f, -80.0f);
                    const float qt = silu_f(bf2f(hqr[t])) * fast_exp(bc), kt = oml * sn * fast_exp(-bc);
                    QL[t * 64] = (bf16)f2bf(qt); KL[t * 64] = (bf16)f2bf(kt); k2[e] = kt; }
                kp[jj] = pk2(k2[0], k2[1]); }
            *(LAS u32x4*)(KT + d * 32 + t8 * 8) = kp; }
        const float ebend = fast_exp(bc); BE[d] = ebend; ((float*)(ws + WS_HBE))[un * 64 + d] = ebend;
    } else {
        const int cv = tid - 256, h = cv >> 6, vi = cv & 63; const size_t un = (size_t)(b * 4 + h) * NCH + c;
        LAS bf16* VT = (LAS bf16*)(lds + h * HB + 4096); bf16* VTg = (bf16*)(ws + WS_HVT) + un * 2048 + vi * 32;
        unsigned short hvr[32];
#pragma unroll
        for (int t = 0; t < 32; ++t) hvr[t] = P[(size_t)t * PINP + PC_HI + cv];
        __builtin_amdgcn_sched_barrier(0);
#pragma unroll
        for (int t8 = 0; t8 < 4; ++t8) { u32x4 vp;
#pragma unroll
            for (int jj = 0; jj < 4; ++jj) vp[jj] = (unsigned)hvr[t8 * 8 + 2 * jj] | ((unsigned)hvr[t8 * 8 + 2 * jj + 1] << 16);
            *(LAS u32x4*)(VT + vi * 32 + t8 * 8) = vp; *(u32x4*)(VTg + t8 * 8) = vp; }
    }
    lds_barrier();
    { const int h = wave >> 1, vt = wave & 1; const size_t un = (size_t)(b * 4 + h) * NCH + c;
      const LAS bf16* KT = (const LAS bf16*)(lds + h * HB); const LAS bf16* VT = (const LAS bf16*)(lds + h * HB + 4096); const LAS float* BE = (const LAS float*)(lds + h * HB + 8192);
      bf16* DSg = (bf16*)(ws + WS_HDS) + un * 4096;
      { const LAS bf16* srcL = (const LAS bf16*)(lds + h * HB + (vt == 0 ? 8448 : 12544)); u32x4* dstG = (u32x4*)((bf16*)(ws + (vt == 0 ? WS_HQ : WS_HK)) + un * 2048);
#pragma unroll
        for (int i = 0; i < 4; ++i) dstG[i * 64 + lane] = *(const LAS u32x4*)(srcL + (i * 64 + lane) * 8); }
#pragma unroll
      for (int dt = 0; dt < 2; ++dt) { f32x16 acc;
#pragma unroll
          for (int i = 0; i < 16; ++i) acc[i] = 0.f;
#pragma unroll
          for (int s = 0; s < 2; ++s) { const bf16x8 A = *(const LAS bf16x8*)(VT + (32 * vt + r32) * 32 + 16 * s + 8 * hh), B = *(const LAS bf16x8*)(KT + (32 * dt + r32) * 32 + 16 * s + 8 * hh);
              acc = __builtin_amdgcn_mfma_f32_32x32x16_bf16(A, B, acc, 0, 0, 0); }
          const float ebd = BE[32 * dt + r32];
#pragma unroll
          for (int r = 0; r < 16; ++r) DSg[(32 * vt + rho16(r, hh)) * 64 + 32 * dt + r32] = (bf16)f2bf(acc[r] * ebd); } }
    lds_barrier();
}
__device__ __forceinline__ void gla_fused_unit(LAS unsigned char* lds, int l, int b, int c) {
    const int tid = opaque_tid(), lane = tid & 63, wave = __builtin_amdgcn_readfirstlane(tid >> 6), r32 = lane & 31, hh = lane >> 5;
    unsigned char* ws = KWS();
    const int t0 = c * 32;
    const bf16* P = (const bf16*)(ws + WS_P) + ((size_t)b * T + t0) * PINP;
    LAS float* GL = (LAS float*)lds;
    constexpr int HB = 10368, H0 = 2048;
    const unsigned short glr = P[(size_t)(tid >> 4) * PINP + PC_GLR + (tid & 15)];
    unsigned short xra[32], xrb[32], hra[3], hrb[3]; float cwv[8], wc[16], gb = 0.f;
    const long hb = t0 > 0 ? 1 : 0;
    if (tid < 128) { const int ch = tid;
        const float* cw = KIN(I_GLACONV) + (size_t)l * 4 * 512 + ch;
        cwv[0] = cw[0]; cwv[1] = cw[512]; cwv[2] = cw[1024]; cwv[3] = cw[1536]; cwv[4] = cw[128]; cwv[5] = cw[640]; cwv[6] = cw[1152]; cwv[7] = cw[1664];
        const float* w2p = KIN(I_GLAW2) + (size_t)l * 16 * 128 + ch;
#pragma unroll
        for (int r = 0; r < 16; ++r) wc[r] = w2p[r * 128];
        gb = KIN(I_GLAB)[l * 128 + ch];
#pragma unroll
        for (int j = 0; j < 3; ++j) { const bf16* hrow = P - hb * (3 - j) * PINP; hra[j] = hrow[PC_GQ + ch]; hrb[j] = hrow[PC_GK + ch]; }
#pragma unroll
        for (int t = 0; t < 32; ++t) { const bf16* row = P + (size_t)t * PINP; xra[t] = row[PC_GQ + ch]; xrb[t] = row[PC_GK + ch]; }
    } else if (tid < 384) { const int cv = tid - 128;
        const float* cw = KIN(I_GLACONV) + (size_t)l * 4 * 512 + 256 + cv;
        cwv[0] = cw[0]; cwv[1] = cw[512]; cwv[2] = cw[1024]; cwv[3] = cw[1536];
#pragma unroll
        for (int j = 0; j < 3; ++j) hra[j] = (P - hb * (3 - j) * PINP)[PC_GV + cv];
#pragma unroll
        for (int t = 0; t < 32; ++t) xra[t] = P[(size_t)t * PINP + PC_GV + cv];
    }
    __builtin_amdgcn_sched_barrier(0);
    GL[tid] = bf2f(glr);
    lds_barrier();
    if (tid < 128) {
        const int ch = tid, h = ch >> 5, d = ch & 31; const size_t un = (size_t)(b * 4 + h) * NCH + c;
        const float q0 = cwv[0], q1 = cwv[1], q2 = cwv[2], q3 = cwv[3], k0 = cwv[4], k1 = cwv[5], k2w = cwv[6], k3 = cwv[7];
        float uq0 = hb ? bf2f(hra[0]) : 0.f, uq1 = hb ? bf2f(hra[1]) : 0.f, uq2 = hb ? bf2f(hra[2]) : 0.f, uk0 = hb ? bf2f(hrb[0]) : 0.f, uk1 = hb ? bf2f(hrb[1]) : 0.f, uk2 = hb ? bf2f(hrb[2]) : 0.f;
        LAS bf16* KT = (LAS bf16*)(lds + H0 + h * HB); LAS float* BE = (LAS float*)(lds + H0 + h * HB + 6144);
        LAS bf16* QL = (LAS bf16*)(lds + H0 + h * HB + 6272) + d; LAS bf16* KL = (LAS bf16*)(lds + H0 + h * HB + 8320) + d;
        float bc = 0.f;
#pragma unroll
        for (int t8 = 0; t8 < 4; ++t8) { u32x4 kp;
#pragma unroll
            for (int jj = 0; jj < 4; ++jj) { float kk2[2];
#pragma unroll
                for (int e = 0; e < 2; ++e) { const int t = t8 * 8 + jj * 2 + e; const float uq3 = bf2f(xra[t]), uk3 = bf2f(xrb[t]);
                    const float q = silu_f(q0 * uq0 + q1 * uq1 + q2 * uq2 + q3 * uq3) * 0.17677669529663687f, k = silu_f(k0 * uk0 + k1 * uk1 + k2w * uk2 + k3 * uk3);
                    uq0 = uq1; uq1 = uq2; uq2 = uq3; uk0 = uk1; uk1 = uk2; uk2 = uk3;
                    float z = gb;
#pragma unroll
                    for (int r = 0; r < 16; ++r) z += GL[t * 16 + r] * wc[r];
                    bc = fmaxf(bc + (fminf(z, 0.f) - log1pexp_neg_abs(z)) * 0.0625f, -80.0f);
                    const float qt = q * fast_exp(bc), kt = k * fast_exp(-bc);
                    QL[t * 32] = (bf16)f2bf(qt); KL[t * 32] = (bf16)f2bf(kt); kk2[e] = kt; }
                kp[jj] = pk2(kk2[0], kk2[1]); }
            *(LAS u32x4*)(KT + d * 32 + t8 * 8) = kp; }
        const float ebend = fast_exp(bc); BE[d] = ebend; ((float*)(ws + WS_GBE))[un * 32 + d] = ebend;
    } else if (tid < 384) {
        const int cv = tid - 128, h = cv >> 6, vi = cv & 63; const size_t un = (size_t)(b * 4 + h) * NCH + c;
        const float w0 = cwv[0], w1 = cwv[1], w2 = cwv[2], w3 = cwv[3];
        float u0 = hb ? bf2f(hra[0]) : 0.f, u1 = hb ? bf2f(hra[1]) : 0.f, u2 = hb ? bf2f(hra[2]) : 0.f;
        LAS bf16* VT = (LAS bf16*)(lds + H0 + h * HB + 2048); bf16* VTg = (bf16*)(ws + WS_GVT) + un * 2048 + vi * 32;
#pragma unroll
        for (int t8 = 0; t8 < 4; ++t8) { u32x4 vp; float yv[8];
#pragma unroll
            for (int e = 0; e < 8; ++e) { const float u3 = bf2f(xra[t8 * 8 + e]); yv[e] = silu_f(w0 * u0 + w1 * u1 + w2 * u2 + w3 * u3); u0 = u1; u1 = u2; u2 = u3; }
#pragma unroll
            for (int jj = 0; jj < 4; ++jj) vp[jj] = pk2(yv[2 * jj], yv[2 * jj + 1]);
            *(LAS u32x4*)(VT + vi * 32 + t8 * 8) = vp; *(u32x4*)(VTg + t8 * 8) = vp; }
    }
    lds_barrier();
    { const int h = wave >> 1, vt = wave & 1; const size_t un = (size_t)(b * 4 + h) * NCH + c;
      const LAS bf16* KT = (const LAS bf16*)(lds + H0 + h * HB); const LAS bf16* VT = (const LAS bf16*)(lds + H0 + h * HB + 2048); const LAS float* BE = (const LAS float*)(lds + H0 + h * HB + 6144);
      bf16* DSg = (bf16*)(ws + WS_GDS) + un * 2048;
      { const LAS bf16* srcL = (const LAS bf16*)(lds + H0 + h * HB + (vt == 0 ? 6272 : 8320)); u32x4* dstG = (u32x4*)((bf16*)(ws + (vt == 0 ? WS_GQ : WS_GK)) + un * 1024);
#pragma unroll
        for (int i = 0; i < 2; ++i) dstG[i * 64 + lane] = *(const LAS u32x4*)(srcL + (i * 64 + lane) * 8); }
      f32x16 acc;
#pragma unroll
      for (int i = 0; i < 16; ++i) acc[i] = 0.f;
#pragma unroll
      for (int s = 0; s < 2; ++s) { const bf16x8 A = *(const LAS bf16x8*)(VT + (32 * vt + r32) * 32 + 16 * s + 8 * hh), B = *(const LAS bf16x8*)(KT + r32 * 32 + 16 * s + 8 * hh);
          acc = __builtin_amdgcn_mfma_f32_32x32x16_bf16(A, B, acc, 0, 0, 0); }
      const float ebd = BE[r32];
#pragma unroll
      for (int r = 0; r < 16; ++r) DSg[(32 * vt + rho16(r, hh)) * 32 + r32] = (bf16)f2bf(acc[r] * ebd); }
    lds_barrier();
}
template <int DK>
__device__ __forceinline__ void m2_gh_elem2(int e2, const bf16* __restrict__ DS, const float* __restrict__ BE, bf16* __restrict__ SG) {
    constexpr int EPB = 64 * DK; const int e = e2 * 2, bh = e / EPB, idx = e % EPB, d = idx % DK; const size_t un0 = (size_t)bh * NCH;
    float S0 = 0.f, S1 = 0.f;
#pragma unroll 1
    for (int c0 = 0; c0 < NCH; c0 += 16) { unsigned ds[16]; f32x2 be[16];
#pragma unroll
        for (int u = 0; u < 16; ++u) { ds[u] = *(const unsigned*)(DS + (un0 + c0 + u) * EPB + idx); be[u] = *(const f32x2*)(BE + (un0 + c0 + u) * DK + d); }
#pragma unroll
        for (int u = 0; u < 16; ++u) { *(unsigned*)(SG + (un0 + c0 + u) * EPB + idx) = pk2(S0, S1); S0 = S0 * be[u][0] + bflo(ds[u]); S1 = S1 * be[u][1] + bfhi(ds[u]); } }
}
template <int DK>
__device__ __forceinline__ void m3_gh_task(int lane, const bf16* __restrict__ Qg, const bf16* __restrict__ Kg, const bf16* __restrict__ VTg, const bf16* __restrict__ Sg,
                                           const bf16* __restrict__ gate  , const float* __restrict__ ng  , unsigned char* __restrict__ orow  ) {
    const int r32 = lane & 31, hh = lane >> 5;
    bf16x8 qf[DK / 16];
    f32x16 at;
#pragma unroll
    for (int i = 0; i < 16; ++i) at[i] = 0.f;
#pragma unroll
    for (int s = 0; s < DK / 16; ++s) { qf[s] = *(const bf16x8*)(Qg + r32 * DK + 16 * s + 8 * hh); const bf16x8 kf = *(const bf16x8*)(Kg + r32 * DK + 16 * s + 8 * hh);
        at = __builtin_amdgcn_mfma_f32_32x32x16_bf16(kf, qf[s], at, 0, 0, 0); }
#pragma unroll
    for (int r = 0; r < 16; ++r) if (rho16(r, hh) > r32) at[r] = 0.f;
    f32x16 o[2];
#pragma unroll
    for (int vt = 0; vt < 2; ++vt)
#pragma unroll
        for (int i = 0; i < 16; ++i) o[vt][i] = 0.f;
#pragma unroll
    for (int s = 0; s < 2; ++s) { union { bf16x8 v; unsigned w[4]; } pf;
#pragma unroll
        for (int j = 0; j < 4; ++j) pf.w[j] = cvt_pk_bf16(at[8 * s + 2 * j], at[8 * s + 2 * j + 1]);
#pragma unroll
        for (int vt = 0; vt < 2; ++vt) { const bf16* vp = VTg + (32 * vt + r32) * 32 + 16 * s + 4 * hh;
            union { bf16x8 v; s16x4 h2[2]; } vf; vf.h2[0] = *(const s16x4*)vp; vf.h2[1] = *(const s16x4*)(vp + 8);
            o[vt] = __builtin_amdgcn_mfma_f32_32x32x16_bf16(vf.v, pf.v, o[vt], 0, 0, 0); } }
#pragma unroll
    for (int vt = 0; vt < 2; ++vt)
#pragma unroll
        for (int s = 0; s < DK / 16; ++s) { const bf16x8 sf = *(const bf16x8*)(Sg + (32 * vt + r32) * DK + 16 * s + 8 * hh);
            o[vt] = __builtin_amdgcn_mfma_f32_32x32x16_bf16(sf, qf[s], o[vt], 0, 0, 0); }
    float ss = 0.f;
#pragma unroll
    for (int vt = 0; vt < 2; ++vt)
#pragma unroll
        for (int i = 0; i < 16; ++i) ss += o[vt][i] * o[vt][i];
    ss += __shfl_xor(ss, 32);
    const float rstd = 1.0f / sqrtf(ss * (1.0f / 64.0f) + RMS_EPS);
    const bf16* grow = gate + (size_t)r32 * PINP; unsigned char* od = orow + (size_t)r32 * D;
#pragma unroll
    for (int vt = 0; vt < 2; ++vt)
#pragma unroll
        for (int g = 0; g < 4; ++g) { const int v0 = 32 * vt + 8 * g + 4 * hh; const u32x2 gw = *(const u32x2*)(grow + v0); const f32x4 n4 = *(const f32x4*)(ng + v0);
            const float y0 = o[vt][4 * g] * rstd * n4[0] * silu_f(bflo(gw.x)), y1 = o[vt][4 * g + 1] * rstd * n4[1] * silu_f(bfhi(gw.x));
            const float y2 = o[vt][4 * g + 2] * rstd * n4[2] * silu_f(bflo(gw.y)), y3 = o[vt][4 * g + 3] * rstd * n4[3] * silu_f(bfhi(gw.y));
            store_o4(od + v0, y0, y1, y2, y3); }
}

constexpr int RWC_HEADB = 28928;
constexpr int RWC_AL = 4 * RWC_HEADB, RWC_LWL = RWC_AL + 32 * 264 * 2;
static_assert(RWC_LWL + 32 * 264 * 2 <= LDSCTL_OFF, "rw_fused_unit LDS");
__device__ __forceinline__ void rw_fused_unit(LAS unsigned char* lds, int l, int b, int c) {
    const int tid = opaque_tid(), lane = tid & 63, wave = __builtin_amdgcn_readfirstlane(tid >> 6), h = wave >> 1, p = wave & 1, r32 = lane & 31, hh = lane >> 5;
    unsigned char* ws = KWS();
    const int bh = b * 4 + h; const size_t un = (size_t)bh * NCH + c;
    const int t0 = c * 32;
    const bf16* P = (const bf16*)(ws + WS_P) + ((size_t)b * T + t0) * PINP + PC_RW;
    const float* mu = KIN(I_RWMU) + (size_t)l * 1024;
    LAS bf16* XL = (LAS bf16*)lds;
    LAS bf16* AL = (LAS bf16*)(lds + RWC_AL);
    LAS bf16* LWL = (LAS bf16*)(lds + RWC_LWL);
    bf16x8 bwW[4], bwA[4], bwG[8]; float w0c, a0c;
    { const int ch = wave * 32 + r32;
      const bf16* w2T = (const bf16*)(ws + WS_LORA) + (size_t)l * 256 * 64 + (size_t)ch * 64 + 8 * hh;
      const bf16* a2T = (const bf16*)(ws + WS_LORA) + (size_t)(NL * 256 * 64) + (size_t)l * 256 * 64 + (size_t)ch * 64 + 8 * hh;
      const bf16* g2T = (const bf16*)(ws + WS_LORA) + (size_t)2 * (NL * 256 * 64) + (size_t)l * 256 * 128 + (size_t)ch * 128 + 8 * hh;
#pragma unroll
      for (int s = 0; s < 4; ++s) { bwW[s] = *(const bf16x8*)(w2T + 16 * s); bwA[s] = *(const bf16x8*)(a2T + 16 * s); }
#pragma unroll
      for (int s = 0; s < 8; ++s) bwG[s] = *(const bf16x8*)(g2T + 16 * s);
      w0c = KIN(I_RWW0)[l * 256 + ch]; a0c = KIN(I_RWA0)[l * 256 + ch]; }
    { const int cc = tid & 255, tp = tid >> 8; const float mc = mu[768 + cc];
      unsigned short xr[17];
#pragma unroll
      for (int j = 0; j < 17; ++j) { const int tk = tp * 16 + j - 1;
          if (j == 0) { const bool ok = (t0 + tk >= 0); const unsigned short v = P[(long)(ok ? tk : 0) * PINP + 768 + cc]; xr[0] = ok ? v : (unsigned short)0; }
          else xr[j] = P[(long)tk * PINP + 768 + cc]; }
#pragma unroll
      for (int j = 0; j < 16; ++j) { const float cur = bf2f(xr[j + 1]), prev = bf2f(xr[j]);
          float x = cur + (prev - cur) * mc;
          if (cc < 64) x = tanh_f(x); else if (cc >= 128) x = fast_sigmoid(x);
          XL[(tp * 16 + j) * 264 + cc] = (bf16)f2bf(x); } }
    lds_barrier();
    float mr, mk, mv, kkc, kac, rkc; unsigned short xrr[17], xkr[17], xvr[17];
    { const int ch = (wave & 3) * 64 + lane, tb = (wave >> 2) * 16;
      mr = mu[ch]; mk = mu[256 + ch]; mv = mu[512 + ch]; kkc = KIN(I_RWKK)[l * 256 + ch]; kac = KIN(I_RWKA)[l * 256 + ch]; rkc = KIN(I_RWRK)[l * 256 + ch];
#pragma unroll
      for (int j = 0; j < 17; ++j) { const int tk = tb + j - 1;
          if (j == 0) { const bool ok = (t0 + tk >= 0); const bf16* row = P + (long)(ok ? tk : 0) * PINP; const unsigned short v0 = row[ch], v1 = row[256 + ch], v2 = row[512 + ch];
              xrr[0] = ok ? v0 : (unsigned short)0; xkr[0] = ok ? v1 : (unsigned short)0; xvr[0] = ok ? v2 : (unsigned short)0; }
          else { const bf16* row = P + (long)tk * PINP; xrr[j] = row[ch]; xkr[j] = row[256 + ch]; xvr[j] = row[512 + ch]; } }
      __builtin_amdgcn_sched_barrier(0); }
    {
        const int ch = wave * 32 + r32;
        const LAS bf16* xa = XL + r32 * 264 + 8 * hh;
        {
            f32x16 acc;
#pragma unroll
            for (int i = 0; i < 16; ++i) acc[i] = 0.f;
#pragma unroll
            for (int s = 0; s < 4; ++s) { const bf16x8 A = *(const LAS bf16x8*)(xa + 16 * s);
                acc = __builtin_amdgcn_mfma_f32_32x32x16_bf16(A, bwW[s], acc, 0, 0, 0); }
#pragma unroll
            for (int r = 0; r < 16; ++r) { const int tok = rho16(r, hh);
                const float zw = w0c + acc[r]; const float wlog = -(fmaxf(-zw, 0.f) + log1pexp_neg_abs(zw)) - 0.5f;
                LWL[tok * 264 + ch] = (bf16)f2bf(-fast_exp(wlog)); }
        }
        __builtin_amdgcn_sched_barrier(0);
        {
            f32x16 acc;
#pragma unroll
            for (int i = 0; i < 16; ++i) acc[i] = 0.f;
#pragma unroll
            for (int s = 0; s < 4; ++s) { const bf16x8 A = *(const LAS bf16x8*)(xa + 64 + 16 * s);
                acc = __builtin_amdgcn_mfma_f32_32x32x16_bf16(A, bwA[s], acc, 0, 0, 0); }
#pragma unroll
            for (int r = 0; r < 16; ++r) AL[rho16(r, hh) * 264 + ch] = (bf16)f2bf(fast_sigmoid(a0c + acc[r]));
        }
        __builtin_amdgcn_sched_barrier(0);
        {
            f32x16 acc;
#pragma unroll
            for (int i = 0; i < 16; ++i) acc[i] = 0.f;
#pragma unroll
            for (int s = 0; s < 8; ++s) { const bf16x8 A = *(const LAS bf16x8*)(xa + 128 + 16 * s);
                acc = __builtin_amdgcn_mfma_f32_32x32x16_bf16(A, bwG[s], acc, 0, 0, 0); }
            bf16* gb = (bf16*)(ws + WS_GBUF) + ((size_t)b * T + t0) * 256 + ch;
#pragma unroll
            for (int r = 0; r < 16; ++r) gb[(size_t)rho16(r, hh) * 256] = (bf16)f2bf(acc[r]);
        }
    }
    lds_barrier();
    LAS unsigned char* L = lds + h * RWC_HEADB;
    LAS bf16* AT = (LAS bf16*)L;
    LAS bf16* BT = (LAS bf16*)(L + 4096);
    LAS bf16* KT = (LAS bf16*)(L + 8192);
    LAS bf16* ATT = (LAS bf16*)(L + 12288);
    LAS bf16* BHT = (LAS bf16*)(L + 16384);
    LAS bf16* KHT = (LAS bf16*)(L + 20480);
    LAS bf16* VT = (LAS bf16*)(L + 24576);
    LAS float* GC = (LAS float*)(L + 28672);
    LAS float* MAB = (LAS float*)(L + 4096);
    LAS bf16* MAK = (LAS bf16*)(L + 8192);
    LAS bf16* TM = (LAS bf16*)L;
    {
        const int hs = wave & 3, half = wave >> 2, d = lane, ch = hs * 64 + d, tb = half * 16; const size_t uns = (size_t)(b * 4 + hs) * NCH + c;
        LAS unsigned char* Ls = lds + hs * RWC_HEADB;
        LAS bf16* sAT = (LAS bf16*)Ls; LAS bf16* sBT = (LAS bf16*)(Ls + 4096); LAS bf16* sKT = (LAS bf16*)(Ls + 8192);
        LAS bf16* sATT = (LAS bf16*)(Ls + 12288); LAS bf16* sBHT = (LAS bf16*)(Ls + 16384); LAS bf16* sKHT = (LAS bf16*)(Ls + 20480); LAS bf16* sVT = (LAS bf16*)(Ls + 24576); LAS float* sGC = (LAS float*)(Ls + 28672);
        float lg0 = 0.f, lg1 = 0.f;
#pragma unroll
        for (int t = 0; t < 16; ++t) { lg0 += bf2f(LWL[t * 264 + ch]); lg1 += bf2f(LWL[(16 + t) * 264 + ch]); }
        const float lgend = lg0 + lg1;
        lds_barrier();
        float* bonp = (float*)(ws + WS_BONUS) + ((size_t)b * T + t0) * 4 + hs;
        float lg = half ? lg0 : 0.f;
#pragma unroll
        for (int t8 = 0; t8 < 2; ++t8) { u32x4 ap, bp, kp;
#pragma unroll
            for (int jj = 0; jj < 4; ++jj) { float at2[2], bh2[2], kh2[2];
#pragma unroll
                for (int e = 0; e < 2; ++e) { const int j = t8 * 8 + jj * 2 + e, t = tb + j;
                    const float rc = bf2f(xrr[j + 1]), kc = bf2f(xkr[j + 1]);
                    const float r = rc + (bf2f(xrr[j]) - rc) * mr, k = kc + (bf2f(xkr[j]) - kc) * mk;
                    const float av = bf2f(AL[t * 264 + ch]), lw = bf2f(LWL[t * 264 + ch]);
                    const float kkr = k * kkc, hk = k * (1.0f + (av - 1.0f) * kac);
                    const float ss = wave_sum(kkr * kkr); const float kk = kkr * __builtin_amdgcn_rsqf(fmaxf(ss, 1e-24f));
                    const float bon = wave_sum(r * hk * rkc);
                    const float aa = -kk, bb = kk * av;
                    const float lgp = lg; lg += lw;
                    const float at = aa * fast_exp(lgp), rt = r * fast_exp(lg), ei = fast_exp(-lg), bt = bb * ei, kt = hk * ei, eh = fast_exp(lgend - lg);
                    sAT[t * 64 + d] = (bf16)f2bf(at); sBT[t * 64 + d] = (bf16)f2bf(bt); sKT[t * 64 + d] = (bf16)f2bf(kt);
                    LWL[t * 264 + ch] = (bf16)f2bf(rt);
                    if (d == 0) bonp[t * 4] = bon;
                    at2[e] = at; bh2[e] = bb * eh; kh2[e] = hk * eh; }
                ap[jj] = pk2(at2[0], at2[1]); bp[jj] = pk2(bh2[0], bh2[1]); kp[jj] = pk2(kh2[0], kh2[1]); }
            *(LAS u32x4*)(sATT + d * 32 + tb + t8 * 8) = ap; *(LAS u32x4*)(sBHT + d * 32 + tb + t8 * 8) = bp; *(LAS u32x4*)(sKHT + d * 32 + tb + t8 * 8) = kp; }
        if (half == 0) sGC[d] = fast_exp(lgend);
        bf16* VTg = (bf16*)(ws + WS_RVT) + uns * 2048 + d * 32 + tb;
#pragma unroll
        for (int t8 = 0; t8 < 2; ++t8) { u32x4 vp; float yv[8];
#pragma unroll
            for (int e = 0; e < 8; ++e) { const int j = t8 * 8 + e; const float xv = bf2f(xvr[j + 1]); yv[e] = xv + (bf2f(xvr[j]) - xv) * mv; }
#pragma unroll
            for (int jj = 0; jj < 4; ++jj) vp[jj] = pk2(yv[2 * jj], yv[2 * jj + 1]);
            *(LAS u32x4*)(sVT + d * 32 + tb + t8 * 8) = vp; *(u32x4*)(VTg + t8 * 8) = vp; }
    }
    lds_barrier();
    f32x16 accR[2];
    union { bf16x8 v; unsigned w[4]; } mfr[2];
    LAS u32x4* EX = (LAS u32x4*)(lds + RWC_AL + h * 2048);
    {
        f32x16 acc, acc2;
#pragma unroll
        for (int i = 0; i < 16; ++i) { acc[i] = 0.f; acc2[i] = 0.f; }
        const LAS bf16* Bsrc = p == 0 ? BT : KT;
#pragma unroll
        for (int s = 0; s < 4; ++s) { const bf16x8 A = *(const LAS bf16x8*)(AT + r32 * 64 + 16 * s + 8 * hh), B = *(const LAS bf16x8*)(Bsrc + r32 * 64 + 16 * s + 8 * hh);
            const bf16x8 Rf = *(const LAS bf16x8*)(LWL + r32 * 264 + h * 64 + 16 * s + 8 * hh);
            acc = __builtin_amdgcn_mfma_f32_32x32x16_bf16(A, B, acc, 0, 0, 0);
            acc2 = __builtin_amdgcn_mfma_f32_32x32x16_bf16(B, Rf, acc2, 0, 0, 0); }
#pragma unroll
        for (int r = 0; r < 16; ++r) if (rho16(r, hh) > r32) acc2[r] = 0.f;
#pragma unroll
        for (int s2 = 0; s2 < 2; ++s2) {
#pragma unroll
            for (int j = 0; j < 4; ++j) mfr[s2].w[j] = cvt_pk_bf16(acc2[8 * s2 + 2 * j], acc2[8 * s2 + 2 * j + 1]);
            if (p == 0) EX[s2 * 64 + lane] = (u32x4){mfr[s2].w[0], mfr[s2].w[1], mfr[s2].w[2], mfr[s2].w[3]}; }
        if (p == 0) {
#pragma unroll
            for (int r = 0; r < 16; ++r) { const int t = rho16(r, hh); MAB[t * 32 + r32] = (r32 < t) ? acc[r] : 0.f; }
        } else {
#pragma unroll
            for (int r = 0; r < 16; ++r) { const int t = rho16(r, hh); MAK[t * 32 + r32] = (bf16)f2bf((r32 < t) ? acc[r] : 0.f); }
        }
    }
    lds_barrier();
    if (p == 0) {
        const int cidx = r32; float tc[32];
#pragma unroll
        for (int t = 0; t < 32; ++t) { float acc0 = (t == cidx) ? 1.0f : 0.f, acc1 = 0.f;
#pragma unroll
            for (int s4 = 0; s4 < (t + 3) / 4; ++s4) { const f32x4 m4 = *(const LAS f32x4*)(MAB + t * 32 + 4 * s4);
#pragma unroll
                for (int e = 0; e < 4; ++e) { const int s = 4 * s4 + e; if (s < t) { if (e & 1) acc1 = fmaf(m4[e], tc[s], acc1); else acc0 = fmaf(m4[e], tc[s], acc0); } } }
            tc[t] = acc0 + acc1; }
#pragma unroll
        for (int t = 0; t < 32; ++t) if (hh == 0) TM[t * 32 + cidx] = (bf16)f2bf(tc[t]);
    } else {
#pragma unroll
        for (int vt = 0; vt < 2; ++vt) {
#pragma unroll
            for (int i = 0; i < 16; ++i) accR[vt][i] = 0.f;
#pragma unroll
            for (int s = 0; s < 2; ++s) { const bf16x8 A = *(const LAS bf16x8*)(MAK + r32 * 32 + 16 * s + 8 * hh), B = *(const LAS bf16x8*)(VT + (32 * vt + r32) * 32 + 16 * s + 8 * hh);
                accR[vt] = __builtin_amdgcn_mfma_f32_32x32x16_bf16(A, B, accR[vt], 0, 0, 0); } }
    }
    lds_barrier();
    if (p == 0) {
        f32x16 accW[2];
#pragma unroll
        for (int dt = 0; dt < 2; ++dt) {
#pragma unroll
            for (int i = 0; i < 16; ++i) accW[dt][i] = 0.f;
#pragma unroll
            for (int s = 0; s < 2; ++s) { const bf16x8 A = *(const LAS bf16x8*)(TM + r32 * 32 + 16 * s + 8 * hh), B = *(const LAS bf16x8*)(ATT + (32 * dt + r32) * 32 + 16 * s + 8 * hh);
                accW[dt] = __builtin_amdgcn_mfma_f32_32x32x16_bf16(A, B, accW[dt], 0, 0, 0); } }
        { LAS bf16* WL = ATT;
#pragma unroll
          for (int dt = 0; dt < 2; ++dt) { f32x16 acc;
#pragma unroll
              for (int i = 0; i < 16; ++i) acc[i] = 0.f;
#pragma unroll
              for (int s = 0; s < 2; ++s) { union { bf16x8 v; unsigned w[4]; } bf;
#pragma unroll
                  for (int j = 0; j < 4; ++j) bf.w[j] = cvt_pk_bf16(accW[dt][8 * s + 2 * j], accW[dt][8 * s + 2 * j + 1]);
                  acc = __builtin_amdgcn_mfma_f32_32x32x16_bf16(mfr[s].v, bf.v, acc, 0, 0, 0); }
#pragma unroll
              for (int r = 0; r < 16; ++r) { const int t = rho16(r, hh); WL[t * 64 + 32 * dt + r32] = (bf16)f2bf(acc[r] + bf2f(LWL[t * 264 + h * 64 + 32 * dt + r32])); } }
          u32x4* RGw = (u32x4*)((bf16*)(ws + WS_RR) + un * 2048);
#pragma unroll
          for (int i = 0; i < 4; ++i) RGw[i * 64 + lane] = *(const LAS u32x4*)(WL + (i * 64 + lane) * 8); }
        LAS bf16* PL = (LAS bf16*)(L + 4096);
        const int xs = r32 >> 4, xx = r32 & 15, hhA = (xx >> 2) & 1, jA = 4 * (xx >> 3) + (xx & 3);
#pragma unroll
        for (int dt = 0; dt < 2; ++dt)
#pragma unroll
            for (int dt2 = 0; dt2 < 2; ++dt2) { f32x16 acc;
#pragma unroll
                for (int i = 0; i < 16; ++i) acc[i] = 0.f;
#pragma unroll
                for (int s = 0; s < 2; ++s) { const LAS bf16* bp = BHT + (32 * dt + r32) * 32 + 16 * s + 4 * hh;
                    union { bf16x8 v; s16x4 h2[2]; } af; af.h2[0] = *(const LAS s16x4*)bp; af.h2[1] = *(const LAS s16x4*)(bp + 8);
                    union { bf16x8 v; unsigned w[4]; } bf;
#pragma unroll
                    for (int j = 0; j < 4; ++j) bf.w[j] = cvt_pk_bf16(accW[dt2][8 * s + 2 * j], accW[dt2][8 * s + 2 * j + 1]);
                    acc = __builtin_amdgcn_mfma_f32_32x32x16_bf16(af.v, bf.v, acc, 0, 0, 0); }
                if (dt == dt2) { const float gc = GC[32 * dt + r32];
#pragma unroll
                    for (int r = 0; r < 16; ++r) if (rho16(r, hh) == r32) acc[r] += gc; }
                LAS bf16* pf = PL + (((dt * 2 + dt2) * 2 + xs) * 64 + 32 * hhA) * 8 + jA;
#pragma unroll
                for (int r = 0; r < 16; ++r) pf[rho16(r, hh) * 8] = (bf16)f2bf(acc[r]); }
        { u32x4* PFp = (u32x4*)((bf16*)(ws + WS_RP) + un * 4096);
#pragma unroll
          for (int f = 0; f < 8; ++f) PFp[f * 64 + lane] = *(const LAS u32x4*)(PL + (f * 64 + lane) * 8); }
    } else {
        f32x16 accU[2];
#pragma unroll
        for (int vt = 0; vt < 2; ++vt) {
#pragma unroll
            for (int i = 0; i < 16; ++i) accU[vt][i] = 0.f;
#pragma unroll
            for (int s = 0; s < 2; ++s) { const LAS bf16* tp = TM + r32 * 32 + 16 * s + 4 * hh;
                union { bf16x8 v; s16x4 h2[2]; } af; af.h2[0] = *(const LAS s16x4*)tp; af.h2[1] = *(const LAS s16x4*)(tp + 8);
                union { bf16x8 v; unsigned w[4]; } bf;
#pragma unroll
                for (int j = 0; j < 4; ++j) bf.w[j] = cvt_pk_bf16(accR[vt][8 * s + 2 * j], accR[vt][8 * s + 2 * j + 1]);
                accU[vt] = __builtin_amdgcn_mfma_f32_32x32x16_bf16(af.v, bf.v, accU[vt], 0, 0, 0); } }
        bf16* UGp = (bf16*)(ws + WS_RU) + un * 2048;
#pragma unroll
        for (int vt = 0; vt < 2; ++vt) { f32x16 acc;
#pragma unroll
            for (int i = 0; i < 16; ++i) acc[i] = 0.f;
#pragma unroll
            for (int s = 0; s < 2; ++s) { union { bf16x8 v; unsigned w[4]; } fu; union { bf16x8 v; u32x4 q; } fb;
#pragma unroll
                for (int j = 0; j < 4; ++j) fu.w[j] = cvt_pk_bf16(accU[vt][8 * s + 2 * j], accU[vt][8 * s + 2 * j + 1]);
                fb.q = EX[s * 64 + lane];
                acc = __builtin_amdgcn_mfma_f32_32x32x16_bf16(fu.v, fb.v, acc, 0, 0, 0);
                const LAS bf16* vp = VT + (32 * vt + r32) * 32 + 16 * s + 4 * hh;
                union { bf16x8 v; s16x4 h2[2]; } vf; vf.h2[0] = *(const LAS s16x4*)vp; vf.h2[1] = *(const LAS s16x4*)(vp + 8);
                acc = __builtin_amdgcn_mfma_f32_32x32x16_bf16(vf.v, mfr[s].v, acc, 0, 0, 0); }
#pragma unroll
            for (int g2 = 0; g2 < 2; ++g2) *(u32x4*)(UGp + ((vt * 2 + g2) * 64 + lane) * 8) = (u32x4){cvt_pk_bf16(acc[8 * g2], acc[8 * g2 + 1]), cvt_pk_bf16(acc[8 * g2 + 2], acc[8 * g2 + 3]),
                                                                                                 cvt_pk_bf16(acc[8 * g2 + 4], acc[8 * g2 + 5]), cvt_pk_bf16(acc[8 * g2 + 6], acc[8 * g2 + 7])}; }
        bf16* QFp = (bf16*)(ws + WS_RQ) + un * 4096;
#pragma unroll
        for (int vt = 0; vt < 2; ++vt)
#pragma unroll
            for (int dt = 0; dt < 2; ++dt) { f32x16 acc;
#pragma unroll
                for (int i = 0; i < 16; ++i) acc[i] = 0.f;
#pragma unroll
                for (int s = 0; s < 2; ++s) { const LAS bf16* bp = BHT + (32 * dt + r32) * 32 + 16 * s + 4 * hh;
                    union { bf16x8 v; s16x4 h2[2]; } af; af.h2[0] = *(const LAS s16x4*)bp; af.h2[1] = *(const LAS s16x4*)(bp + 8);
                    union { bf16x8 v; unsigned w[4]; } bf;
#pragma unroll
                    for (int j = 0; j < 4; ++j) bf.w[j] = cvt_pk_bf16(accU[vt][8 * s + 2 * j], accU[vt][8 * s + 2 * j + 1]);
                    acc = __builtin_amdgcn_mfma_f32_32x32x16_bf16(af.v, bf.v, acc, 0, 0, 0);
                    const bf16x8 A2 = *(const LAS bf16x8*)(KHT + (32 * dt + r32) * 32 + 16 * s + 8 * hh), B2 = *(const LAS bf16x8*)(VT + (32 * vt + r32) * 32 + 16 * s + 8 * hh);
                    acc = __builtin_amdgcn_mfma_f32_32x32x16_bf16(A2, B2, acc, 0, 0, 0); }
#pragma unroll
                for (int g2 = 0; g2 < 2; ++g2) *(u32x4*)(QFp + (((vt * 2 + dt) * 2 + g2) * 64 + lane) * 8) = (u32x4){cvt_pk_bf16(acc[8 * g2], acc[8 * g2 + 1]), cvt_pk_bf16(acc[8 * g2 + 2], acc[8 * g2 + 3]),
                                                                                                                   cvt_pk_bf16(acc[8 * g2 + 4], acc[8 * g2 + 5]), cvt_pk_bf16(acc[8 * g2 + 6], acc[8 * g2 + 7])}; }
    }
    lds_barrier();
}
__device__ __forceinline__ void rw_m2_wave(int lane, int bh, int vt) {
    unsigned char* ws = KWS();
    const bf16* PF = (const bf16*)(ws + WS_RP) + (size_t)bh * NCH * 4096 + lane * 8;
    const bf16* QF = (const bf16*)(ws + WS_RQ) + (size_t)bh * NCH * 4096 + (size_t)vt * 2048 + lane * 8;
    bf16* SG = (bf16*)(ws + WS_RS) + (size_t)bh * NCH * 4096 + (size_t)vt * 2048 + lane * 8;
    f32x16 S[2];
#pragma unroll
    for (int dt = 0; dt < 2; ++dt)
#pragma unroll
        for (int i = 0; i < 16; ++i) S[dt][i] = 0.f;
    bf16x8 pA[8], pB[8], pC[8]; u32x4 qA[4], qB[4], qC[4];
#pragma unroll
    for (int f = 0; f < 8; ++f) { pA[f] = (bf16x8){0, 0, 0, 0, 0, 0, 0, 0}; pB[f] = pA[f]; pC[f] = pA[f]; }
#pragma unroll
    for (int f = 0; f < 4; ++f) { qA[f] = (u32x4){0u, 0u, 0u, 0u}; qB[f] = qA[f]; qC[f] = qA[f]; }
#define RWM2_LD4(d0, d1, d2, d3, ptr) asm volatile("global_load_dwordx4 %0, %4, off\n\tglobal_load_dwordx4 %1, %4, off offset:1024\n\tglobal_load_dwordx4 %2, %4, off offset:2048\n\tglobal_load_dwordx4 %3, %4, off offset:3072" \
        : "+v"(d0), "+v"(d1), "+v"(d2), "+v"(d3) : "v"(ptr) : "memory")
#define RWM2_LOAD(P_, Q_, c_) do { const int _c = (c_) < NCH ? (c_) : NCH - 1; const bf16* _p0 = PF + (size_t)_c * 4096; const bf16* _p1 = _p0 + 2048; const bf16* _q = QF + (size_t)_c * 4096; \
        RWM2_LD4(P_[0], P_[1], P_[2], P_[3], _p0); RWM2_LD4(P_[4], P_[5], P_[6], P_[7], _p1); RWM2_LD4(Q_[0], Q_[1], Q_[2], Q_[3], _q); } while (0)
#define RWM2_WAIT(P_, Q_) asm volatile("s_waitcnt vmcnt(24)" : "+v"(P_[0]), "+v"(P_[1]), "+v"(P_[2]), "+v"(P_[3]), "+v"(P_[4]), "+v"(P_[5]), "+v"(P_[6]), "+v"(P_[7]), "+v"(Q_[0]), "+v"(Q_[1]), "+v"(Q_[2]), "+v"(Q_[3]) :: "memory")
#define RWM2_STEP(P_, Q_, c_) do { \
        RWM2_WAIT(P_, Q_); \
        union { bf16x8 v; unsigned w[4]; } sb[2][2]; \
        _Pragma("unroll") for (int dt2 = 0; dt2 < 2; ++dt2) _Pragma("unroll") for (int s = 0; s < 2; ++s) { \
            _Pragma("unroll") for (int j = 0; j < 4; ++j) sb[dt2][s].w[j] = cvt_pk_bf16(S[dt2][8 * s + 2 * j], S[dt2][8 * s + 2 * j + 1]); \
            *(bf16x8*)(SG + (size_t)(c_) * 4096 + (dt2 * 2 + s) * 512) = sb[dt2][s].v; } \
        f32x16 N[2]; \
        _Pragma("unroll") for (int dt = 0; dt < 2; ++dt) { \
            _Pragma("unroll") for (int g2 = 0; g2 < 2; ++g2) _Pragma("unroll") for (int j = 0; j < 4; ++j) { N[dt][8 * g2 + 2 * j] = bflo(Q_[dt * 2 + g2][j]); N[dt][8 * g2 + 2 * j + 1] = bfhi(Q_[dt * 2 + g2][j]); } \
            _Pragma("unroll") for (int dt2 = 0; dt2 < 2; ++dt2) _Pragma("unroll") for (int s = 0; s < 2; ++s) N[dt] = __builtin_amdgcn_mfma_f32_32x32x16_bf16(P_[(dt * 2 + dt2) * 2 + s], sb[dt2][s].v, N[dt], 0, 0, 0); } \
        S[0] = N[0]; S[1] = N[1]; } while (0)
    RWM2_LOAD(pA, qA, 0); RWM2_LOAD(pB, qB, 1); RWM2_LOAD(pC, qC, 2);
#pragma unroll 1
    for (int c = 0; c < NCH - 1; c += 3) {
        RWM2_STEP(pA, qA, c); RWM2_LOAD(pA, qA, c + 3);
        RWM2_STEP(pB, qB, c + 1); RWM2_LOAD(pB, qB, c + 4);
        RWM2_STEP(pC, qC, c + 2); RWM2_LOAD(pC, qC, c + 5);
    }
    static_assert((NCH - 1) % 3 == 0, "chunk loop: 85 rounds of three steps, then the last chunk");
    RWM2_STEP(pA, qA, NCH - 1);
    asm volatile("s_waitcnt vmcnt(0)" ::: "memory");
#undef RWM2_LD4
#undef RWM2_LOAD
#undef RWM2_WAIT
#undef RWM2_STEP
}
__device__ __forceinline__ bf16x8 ld_perm8(const bf16* p) { union { bf16x8 v; s16x4 h2[2]; } f; f.h2[0] = *(const s16x4*)p; f.h2[1] = *(const s16x4*)(p + 8); return f.v; }
__device__ __forceinline__ void rw_m3_task(int lane, int l, int bh, int c) {
    unsigned char* ws = KWS();
    const int r32 = lane & 31, hh = lane >> 5, b = bh >> 2, h = bh & 3; const size_t un = (size_t)bh * NCH + c; const size_t tok0 = (size_t)b * T + c * 32;
    const bf16* RGp = (const bf16*)(ws + WS_RR) + un * 2048 + r32 * 64 + 4 * hh;
    const bf16* SGp = (const bf16*)(ws + WS_RS) + un * 4096 + lane * 8; const bf16* VTp = (const bf16*)(ws + WS_RVT) + un * 2048 + r32 * 32 + 4 * hh;
    const bf16* UGp = (const bf16*)(ws + WS_RU) + un * 2048 + lane * 8;
    f32x16 Y[2], Z[2];
    const float bon = ((const float*)(ws + WS_BONUS))[(tok0 + r32) * 4 + h];
#pragma unroll
    for (int vt = 0; vt < 2; ++vt)
#pragma unroll
        for (int g2 = 0; g2 < 2; ++g2) { const u32x4 u4 = *(const u32x4*)(UGp + (vt * 2 + g2) * 512);
#pragma unroll
            for (int j = 0; j < 4; ++j) { Y[vt][8 * g2 + 2 * j] = bflo(u4[j]); Y[vt][8 * g2 + 2 * j + 1] = bfhi(u4[j]); } }
#pragma unroll
    for (int i = 0; i < 16; ++i) { Z[0][i] = 0.f; Z[1][i] = 0.f; }
#pragma unroll
    for (int ks = 0; ks < 4; ++ks) {
        const bf16x8 rf = ld_perm8(RGp + 16 * ks);
        const bf16x8 s0 = *(const bf16x8*)(SGp + ks * 512), s1 = *(const bf16x8*)(SGp + 2048 + ks * 512);
        Y[0] = __builtin_amdgcn_mfma_f32_32x32x16_bf16(s0, rf, Y[0], 0, 0, 0); Y[1] = __builtin_amdgcn_mfma_f32_32x32x16_bf16(s1, rf, Y[1], 0, 0, 0); }
#pragma unroll
    for (int s = 0; s < 2; ++s) {
        union { bf16x8 v; unsigned short e[8]; } db;
#pragma unroll
        for (int j = 0; j < 8; ++j) db.e[j] = (16 * s + 8 * (j >> 2) + 4 * hh + (j & 3) == r32) ? (unsigned short)f2bf(bon) : (unsigned short)0;
#pragma unroll
        for (int vt = 0; vt < 2; ++vt) {
            const bf16* vp = VTp + (size_t)vt * 32 * 32 + 16 * s;
            union { bf16x8 v; s16x4 h2[2]; } vf; vf.h2[0] = *(const s16x4*)vp; vf.h2[1] = *(const s16x4*)(vp + 8);
            Z[vt] = __builtin_amdgcn_mfma_f32_32x32x16_bf16(vf.v, db.v, Z[vt], 0, 0, 0); } }
    float sm = 0.f;
#pragma unroll
    for (int vt = 0; vt < 2; ++vt)
#pragma unroll
        for (int i = 0; i < 16; ++i) sm += Y[vt][i];
    sm += __shfl_xor(sm, 32); const float mu = sm * (1.0f / 64.0f);
    float q = 0.f;
#pragma unroll
    for (int vt = 0; vt < 2; ++vt)
#pragma unroll
        for (int i = 0; i < 16; ++i) { const float dd = Y[vt][i] - mu; q += dd * dd; }
    q += __shfl_xor(q, 32); const float rstd = 1.0f / sqrtf(q * (1.0f / 64.0f) + RW_LN_EPS);
    const size_t tok = tok0 + r32;
    const bf16* gp = (const bf16*)(ws + WS_GBUF) + tok * 256 + h * 64; unsigned char* od = (unsigned char*)(ws + WS_O) + tok * D + 512 + h * 64;
    const float* lnw = KIN(I_RWLNW) + l * 256 + h * 64; const float* lnb = KIN(I_RWLNB) + l * 256 + h * 64;
#pragma unroll
    for (int vt = 0; vt < 2; ++vt)
#pragma unroll
        for (int g = 0; g < 4; ++g) { const int v0 = 32 * vt + 8 * g + 4 * hh; const f32x4 w4 = *(const f32x4*)(lnw + v0), b4 = *(const f32x4*)(lnb + v0); const u32x2 gw = *(const u32x2*)(gp + v0);
            const float y0 = ((Y[vt][4 * g] - mu) * rstd * w4[0] + b4[0] + Z[vt][4 * g]) * bflo(gw.x), y1 = ((Y[vt][4 * g + 1] - mu) * rstd * w4[1] + b4[1] + Z[vt][4 * g + 1]) * bfhi(gw.x);
            const float y2 = ((Y[vt][4 * g + 2] - mu) * rstd * w4[2] + b4[2] + Z[vt][4 * g + 2]) * bflo(gw.y), y3 = ((Y[vt][4 * g + 3] - mu) * rstd * w4[3] + b4[3] + Z[vt][4 * g + 3]) * bfhi(gw.y);
            store_o4(od + v0, y0, y1, y2, y3); }
}

__device__ __forceinline__ void c1_phase(LAS unsigned char* lds, int l, int vcu, int G) {
    for (int u = vcu, k = 0; u < NB * NCH; u += G, ++k) {
        const int b = (G == 256) ? (vcu >> 5) : (u >> 8), c = (G == 256) ? 255 - ((vcu & 31) + 32 * k) : (u & 255);
        for (int q = 0; q <= PHREP(16); ++q) rw_fused_unit(lds, l, b, c);
        for (int q = 0; q <= PHREP(17); ++q) hg_fused_unit(lds, l, b, c);
        for (int q = 0; q <= PHREP(18); ++q) gla_fused_unit(lds, l, b, c); }
}
__device__ __forceinline__ void m3_gh_phase(int l, int vcu, int G) {
    const int tid = opaque_tid(), lane = tid & 63, wave = __builtin_amdgcn_readfirstlane(tid >> 6);
    unsigned char* ws = KWS();
    const int gw = vcu * NWAVES + wave, NGW = G * NWAVES;
    const bf16* P = (const bf16*)(ws + WS_P); unsigned char* O = (unsigned char*)(ws + WS_O);
    const float* gng = KIN(I_GLANG) + l * 256; const float* hng = KIN(I_HGNG) + l * 256;
    for (int task = gw; task < 24576; task += NGW) {
        const int un = task & 8191, bh = un >> 8, c = un & 255, b = bh >> 2, h = bh & 3; const size_t tok0 = (size_t)b * T + c * 32;
        if (task >= 16384) { for (int q = 0; q <= PHREP(19); ++q) rw_m3_task(lane, l, bh, c); continue; }
        for (int q = 0; q <= PHREP(20); ++q)
        if (task < 8192) m3_gh_task<64>(lane, (const bf16*)(ws + WS_HQ) + (size_t)un * 2048, (const bf16*)(ws + WS_HK) + (size_t)un * 2048, (const bf16*)(ws + WS_HVT) + (size_t)un * 2048, (const bf16*)(ws + WS_HS) + (size_t)un * 4096,
                                         P + tok0 * PINP + PC_HG + h * 64, hng + h * 64, O + tok0 * D + 256 + h * 64);
        else m3_gh_task<32>(lane, (const bf16*)(ws + WS_GQ) + (size_t)un * 1024, (const bf16*)(ws + WS_GK) + (size_t)un * 1024, (const bf16*)(ws + WS_GVT) + (size_t)un * 2048, (const bf16*)(ws + WS_GS) + (size_t)un * 2048,
                            P + tok0 * PINP + PC_GOUT + h * 64, gng + h * 64, O + tok0 * D + h * 64);
    }
}

__device__ __forceinline__ void xattn_units(LAS unsigned char* lds, int l, int first, int last, int stride) {
    const int tid = opaque_tid(), lane = tid & 63, wave = __builtin_amdgcn_readfirstlane(tid >> 6), r32 = lane & 31, hh = lane >> 5;
    const bf16* P = (const bf16*)(KWS() + WS_P); const bf16* MKV = (const bf16*)(KWS() + WS_MKV); unsigned char* O = (unsigned char*)(KWS() + WS_O);
    LAS bf16* KL = (LAS bf16*)lds;
    LAS bf16* VT = (LAS bf16*)(lds + 256 * 72 * 2);
    int cur_bh = -1;
    for (int u = first; u < last; u += stride) {
        const int bh = u >> 5, qb = u & 31, b = bh >> 2, h = bh & 3;
        if (bh != cur_bh) {
            lds_barrier();
            for (int i = tid; i < 256 * 8; i += NTHR) { const int key = i >> 3, c8 = i & 7;
                const bf16* src = MKV + (size_t)(b * 256 + key) * 2048 + l * 512 + h * 64 + c8 * 8;
                *(LAS u32x4*)(KL + key * 72 + c8 * 8) = *(const u32x4*)src;
                const u32x4 vv = *(const u32x4*)(src + 256);
                LAS bf16* vd = VT + (c8 * 8) * 264 + key;
                vd[0 * 264] = (bf16)(vv.x & 0xffff); vd[1 * 264] = (bf16)(vv.x >> 16); vd[2 * 264] = (bf16)(vv.y & 0xffff); vd[3 * 264] = (bf16)(vv.y >> 16);
                vd[4 * 264] = (bf16)(vv.z & 0xffff); vd[5 * 264] = (bf16)(vv.z >> 16); vd[6 * 264] = (bf16)(vv.w & 0xffff); vd[7 * 264] = (bf16)(vv.w >> 16); }
            lds_barrier();
            cur_bh = bh;
        }
        const int q = b * T + qb * 256 + wave * 32 + r32;
        bf16x8 qf[4];
#pragma unroll
        for (int s = 0; s < 4; ++s) qf[s] = *(const bf16x8*)(P + (size_t)q * PINP + PC_MQ + h * 64 + 16 * s + 8 * hh);
        f32x16 sc[8];
#pragma unroll
        for (int kt = 0; kt < 8; ++kt) {
#pragma unroll
            for (int i = 0; i < 16; ++i) sc[kt][i] = 0.f;
#pragma unroll
            for (int s = 0; s < 4; ++s) { const bf16x8 kf = *(const LAS bf16x8*)(KL + (kt * 32 + r32) * 72 + 16 * s + 8 * hh);
                sc[kt] = __builtin_amdgcn_mfma_f32_32x32x16_bf16(kf, qf[s], sc[kt], 0, 0, 0); }
        }
        float m = -3.0e38f;
#pragma unroll
        for (int kt = 0; kt < 8; ++kt)
#pragma unroll
            for (int i = 0; i < 16; ++i) m = fmaxf(m, sc[kt][i]);
        m = fmaxf(m, __shfl_xor(m, 32));
        float sum = 0.f;
        const float c2 = 0.125f * 1.4426950408889634f;
#pragma unroll
        for (int kt = 0; kt < 8; ++kt)
#pragma unroll
            for (int i = 0; i < 16; ++i) { const float e = __builtin_amdgcn_exp2f((sc[kt][i] - m) * c2); sc[kt][i] = e; sum += e; }
        sum += __shfl_xor(sum, 32);
        const float inv = 1.0f / sum;
        f32x16 oa[2];
#pragma unroll
        for (int vt = 0; vt < 2; ++vt)
#pragma unroll
            for (int i = 0; i < 16; ++i) oa[vt][i] = 0.f;
#pragma unroll
        for (int kt = 0; kt < 8; ++kt)
#pragma unroll
            for (int s = 0; s < 2; ++s) {
                union { bf16x8 v; unsigned w[4]; } pf;
#pragma unroll
                for (int j = 0; j < 4; ++j) pf.w[j] = cvt_pk_bf16(sc[kt][8 * s + 2 * j], sc[kt][8 * s + 2 * j + 1]);
#pragma unroll
                for (int vt = 0; vt < 2; ++vt) {
                    const LAS bf16* vp = VT + (vt * 32 + r32) * 264 + kt * 32 + 16 * s + 4 * hh;
                    union { bf16x8 v; s16x4 h2[2]; } vf; vf.h2[0] = *(const LAS s16x4*)vp; vf.h2[1] = *(const LAS s16x4*)(vp + 8);
                    oa[vt] = __builtin_amdgcn_mfma_f32_32x32x16_bf16(vf.v, pf.v, oa[vt], 0, 0, 0); }
            }
        unsigned char* orow = O + (size_t)q * D + 768 + h * 64;
#pragma unroll
        for (int vt = 0; vt < 2; ++vt)
#pragma unroll
            for (int g = 0; g < 4; ++g) store_o4(orow + vt * 32 + 8 * g + 4 * hh, oa[vt][4 * g] * inv, oa[vt][4 * g + 1] * inv, oa[vt][4 * g + 2] * inv, oa[vt][4 * g + 3] * inv);
    }
    lds_barrier();
}

__device__ __forceinline__ void m2_phase(LAS unsigned char* lds, int l, int bx, int G) {
    unsigned char* ws = KWS();
    const int tid = opaque_tid(), lane = tid & 63, wave = __builtin_amdgcn_readfirstlane(tid >> 6);
    const int nrw = (G >= 128) ? 64 : 0;
    if (nrw) { if (bx < nrw && wave == 0) for (int q = 0; q <= PHREP(22); ++q) rw_m2_wave(lane, bx >> 1, bx & 1); }
    else { if (wave == 0) for (int q = bx; q < 64; q += G) rw_m2_wave(lane, q >> 1, q & 1); }
    if (nrw && bx >= nrw) {
        const int nth = (G - nrw) * NTHR;
        const int gt = (bx - nrw) * NTHR + tid;
        for (int q = 0; q <= PHREP(23); ++q)
        for (int e = gt; e < 98304; e += nth) {
            if (e < 65536) m2_gh_elem2<64>(e, (const bf16*)(ws + WS_HDS), (const float*)(ws + WS_HBE), (bf16*)(ws + WS_HS));
            else m2_gh_elem2<32>(e - 65536, (const bf16*)(ws + WS_GDS), (const float*)(ws + WS_GBE), (bf16*)(ws + WS_GS)); }
    }
    if (nrw == 0) { __syncthreads(); for (int e = bx * NTHR + tid; e < 98304; e += G * NTHR) {
            if (e < 65536) m2_gh_elem2<64>(e, (const bf16*)(ws + WS_HDS), (const float*)(ws + WS_HBE), (bf16*)(ws + WS_HS));
            else m2_gh_elem2<32>(e - 65536, (const bf16*)(ws + WS_GDS), (const float*)(ws + WS_GBE), (bf16*)(ws + WS_GS)); } }
    if (nrw == 0 || bx >= nrw) {
        const int nb = G - nrw, r = bx - nrw;
        const int per = (1024 + nb - 1) / nb, lo = r * per, hi = (lo + per < 1024) ? lo + per : 1024;
        for (int q = 0; q <= PHREP(24); ++q) xattn_units(lds, l, lo, hi, 1);
    }
}

__device__ __forceinline__ void ln1_router_phase(LAS unsigned char* lds, int l, int bx, int G) {
    const int tid = opaque_tid(), lane = tid & 63, wave = __builtin_amdgcn_readfirstlane(tid >> 6);
    LAS float* X = (LAS float*)lds;
    LAS float* PART = (LAS float*)(lds + 16 * 1028 * 4);
    LAS int* HIST = (LAS int*)(lds + 16 * 1028 * 4 + 8 * 16 * 32 * 4);
    LAS f32x4* GB = (LAS f32x4*)(lds + 16 * 1028 * 4 + 8 * 16 * 32 * 4 + 256);
    const float* xin = KIN(I_X); const bf16* xinb = (const bf16*)(KWS() + WS_XB);
    const bf16* HM = (const bf16*)(KWS() + WS_HMIX);
    bf16* X1B = (bf16*)(KWS() + WS_X1B); unsigned char* X1Q = (unsigned char*)(KWS() + WS_XF);
    const float* g1 = KIN(I_LN1G) + l * D; const float* b1 = KIN(I_LN1B) + l * D;
    const float* rw = KIN(I_RTW) + (size_t)l * D * NE; const float* rb = KIN(I_RTB) + l * NE;
    int* tok_e = (int*)(KWS() + WS_ROUTE); float* tok_g = (float*)(KWS() + WS_ROUTE + 1 * MiB);
    if (tid < 32) HIST[tid] = 0;
    if (tid < 256) { GB[tid] = ((const f32x4*)g1)[tid]; GB[256 + tid] = ((const f32x4*)b1)[tid]; }
    const float rbe = rb[tid & 31];
    bf16x8 rwH[4][2], rwL[4][2];
    { const int q = lane >> 4, e = lane & 15;
#pragma unroll
      for (int s = 0; s < 4; ++s)
#pragma unroll
          for (int nt = 0; nt < 2; ++nt) { union { bf16x8 v; unsigned w[4]; } fh, fl;
#pragma unroll
              for (int j = 0; j < 4; ++j) { const float* p = rw + (size_t)(128 * wave + 32 * s + 8 * q + 2 * j) * NE + 16 * nt + e; const float v0 = p[0], v1 = p[NE];
                  const unsigned h = cvt_pk_bf16(v0, v1); fh.w[j] = h; fl.w[j] = cvt_pk_bf16(v0 - bflo(h), v1 - bfhi(h)); }
              rwH[s][nt] = fh.v; rwL[s][nt] = fl.v; } }
    lds_barrier();
    f32x4 xraw[2][4]; u32x2 xbraw[2][4], hraw[2][4];
#define LN1_LOAD(it_) do { const size_t _tok = (size_t)(it_) * 16 + wave * 2; const u32x2* _hr = (const u32x2*)(HM + _tok * D) + lane; \
        if (l == 0) { const f32x4* _xr = (const f32x4*)(xin + _tok * D) + lane;        \
            _Pragma("unroll") for (int tt = 0; tt < 2; ++tt) _Pragma("unroll") for (int j = 0; j < 4; ++j) xraw[tt][j] = _xr[tt * 256 + 64 * j]; } \
        else { const u32x2* _xbr = (const u32x2*)(xinb + _tok * D) + lane; \
            _Pragma("unroll") for (int tt = 0; tt < 2; ++tt) _Pragma("unroll") for (int j = 0; j < 4; ++j) xbraw[tt][j] = _xbr[tt * 256 + 64 * j]; } \
        _Pragma("unroll") for (int tt = 0; tt < 2; ++tt) _Pragma("unroll") for (int j = 0; j < 4; ++j) hraw[tt][j] = _hr[tt * 256 + 64 * j]; } while (0)
    if (bx < NTOK / 16) LN1_LOAD(bx);
    for (int it = bx; it < NTOK / 16; it += G) {
        f32x4 vv[2][4];
#pragma unroll
        for (int tt = 0; tt < 2; ++tt)
#pragma unroll
            for (int j = 0; j < 4; ++j) { f32x4 xv; if (l == 0) xv = xraw[tt][j]; else { const u32x2 xw = xbraw[tt][j]; xv = (f32x4){bflo(xw.x), bfhi(xw.x), bflo(xw.y), bfhi(xw.y)}; } const u32x2 hw = hraw[tt][j];
                vv[tt][j][0] = DN_ALPHA * xv[0] + bflo(hw.x); vv[tt][j][1] = DN_ALPHA * xv[1] + bfhi(hw.x); vv[tt][j][2] = DN_ALPHA * xv[2] + bflo(hw.y); vv[tt][j][3] = DN_ALPHA * xv[3] + bfhi(hw.y); }
        if (it + G < NTOK / 16) LN1_LOAD(it + G);
#pragma unroll
        for (int tt = 0; tt < 2; ++tt) { const int ti = wave * 2 + tt; const size_t tok = (size_t)it * 16 + ti;
            f32x4 v[4]; float s = 0.f;
#pragma unroll
            for (int j = 0; j < 4; ++j) { v[j] = vv[tt][j]; s += (v[j][0] + v[j][1]) + (v[j][2] + v[j][3]); }
            const float mean = wave_sum(s) * (1.0f / D); float s2 = 0.f;
#pragma unroll
            for (int j = 0; j < 4; ++j) { v[j] = v[j] - mean; s2 += (v[j][0] * v[j][0] + v[j][1] * v[j][1]) + (v[j][2] * v[j][2] + v[j][3] * v[j][3]); }
            const float rstd = 1.0f / sqrtf(wave_sum(s2) * (1.0f / D) + LN_EPS);
#pragma unroll
            for (int j = 0; j < 4; ++j) { const f32x4 gg = GB[lane + 64 * j], bb = GB[256 + lane + 64 * j];
                const f32x4 y = v[j] * rstd * gg + bb;
                *((u32x2*)(X1B + tok * D) + lane + 64 * j) = (u32x2){pk2(y[0], y[1]), pk2(y[2], y[3])};
                { int w = __builtin_amdgcn_cvt_pk_fp8_f32(y[0], y[1], 0, false); w = __builtin_amdgcn_cvt_pk_fp8_f32(y[2], y[3], w, true); *((unsigned*)(X1Q + tok * D) + lane + 64 * j) = (unsigned)w; }
                *(LAS f32x4*)(X + ti * 1028 + 4 * lane + 256 * j) = y; }
        }
        lds_barrier();
        {
            const int q = lane >> 4, r = lane & 15;
            f32x4 acc0 = (f32x4){0.f, 0.f, 0.f, 0.f}, acc1 = (f32x4){0.f, 0.f, 0.f, 0.f};
            const LAS float* xa = X + r * 1028 + 128 * wave + 8 * q;
#pragma unroll
            for (int s = 0; s < 4; ++s) { const f32x4 x0 = *(const LAS f32x4*)(xa + 32 * s), x1 = *(const LAS f32x4*)(xa + 32 * s + 4);
                union { bf16x8 v; unsigned w[4]; } ah, al;
                ah.w[0] = cvt_pk_bf16(x0[0], x0[1]); ah.w[1] = cvt_pk_bf16(x0[2], x0[3]); ah.w[2] = cvt_pk_bf16(x1[0], x1[1]); ah.w[3] = cvt_pk_bf16(x1[2], x1[3]);
                al.w[0] = cvt_pk_bf16(x0[0] - bflo(ah.w[0]), x0[1] - bfhi(ah.w[0])); al.w[1] = cvt_pk_bf16(x0[2] - bflo(ah.w[1]), x0[3] - bfhi(ah.w[1]));
                al.w[2] = cvt_pk_bf16(x1[0] - bflo(ah.w[2]), x1[1] - bfhi(ah.w[2])); al.w[3] = cvt_pk_bf16(x1[2] - bflo(ah.w[3]), x1[3] - bfhi(ah.w[3]));
                acc0 = __builtin_amdgcn_mfma_f32_16x16x32_bf16(ah.v, rwH[s][0], acc0, 0, 0, 0); acc1 = __builtin_amdgcn_mfma_f32_16x16x32_bf16(ah.v, rwH[s][1], acc1, 0, 0, 0);
                acc0 = __builtin_amdgcn_mfma_f32_16x16x32_bf16(ah.v, rwL[s][0], acc0, 0, 0, 0); acc1 = __builtin_amdgcn_mfma_f32_16x16x32_bf16(ah.v, rwL[s][1], acc1, 0, 0, 0);
                acc0 = __builtin_amdgcn_mfma_f32_16x16x32_bf16(al.v, rwH[s][0], acc0, 0, 0, 0); acc1 = __builtin_amdgcn_mfma_f32_16x16x32_bf16(al.v, rwH[s][1], acc1, 0, 0, 0); }
#pragma unroll
            for (int i = 0; i < 4; ++i) { PART[(wave * 16 + 4 * q + i) * 32 + r] = acc0[i]; PART[(wave * 16 + 4 * q + i) * 32 + 16 + r] = acc1[i]; }
        }
        lds_barrier();
        {
            const int ti = tid >> 5, e = tid & 31;
            float lg = rbe;
#pragma unroll
            for (int w = 0; w < 8; ++w) lg += PART[(w * 16 + ti) * 32 + e];
            float tv[4]; int te[4]; float cur = lg;
#pragma unroll
            for (int k = 0; k < 4; ++k) { float bv = cur; int bi = e;
#pragma unroll
                for (int st = 0; st < 5; ++st) { float ov; int oi;
                    const int bvi = __builtin_bit_cast(int, bv);
                    if (st == 0) { ov = __builtin_bit_cast(float, __builtin_amdgcn_update_dpp(bvi, bvi, 0xB1, 0xf, 0xf, false)); oi = __builtin_amdgcn_update_dpp(bi, bi, 0xB1, 0xf, 0xf, false); }
                    else if (st == 1) { ov = __builtin_bit_cast(float, __builtin_amdgcn_update_dpp(bvi, bvi, 0x4E, 0xf, 0xf, false)); oi = __builtin_amdgcn_update_dpp(bi, bi, 0x4E, 0xf, 0xf, false); }
                    else if (st == 2) { ov = __builtin_bit_cast(float, __builtin_amdgcn_update_dpp(bvi, bvi, 0x141, 0xf, 0xf, false)); oi = __builtin_amdgcn_update_dpp(bi, bi, 0x141, 0xf, 0xf, false); }
                    else if (st == 3) { ov = __builtin_bit_cast(float, __builtin_amdgcn_update_dpp(bvi, bvi, 0x140, 0xf, 0xf, false)); oi = __builtin_amdgcn_update_dpp(bi, bi, 0x140, 0xf, 0xf, false); }
                    else { ov = __shfl_xor(bv, 16); oi = __shfl_xor(bi, 16); }
                    if (ov > bv || (ov == bv && oi < bi)) { bv = ov; bi = oi; } }
                tv[k] = bv; te[k] = bi; if (e == bi) cur = -3.0e38f; }
            const float e1 = __expf(tv[1] - tv[0]), e2 = __expf(tv[2] - tv[0]), e3 = __expf(tv[3] - tv[0]); const float inv = 1.0f / (1.0f + e1 + e2 + e3);
            const size_t tok = (size_t)it * 16 + ti;
            if (e < 4) { const int ek = e == 0 ? te[0] : e == 1 ? te[1] : e == 2 ? te[2] : te[3]; const float gk = (e == 0 ? 1.0f : e == 1 ? e1 : e == 2 ? e2 : e3) * inv;
                tok_e[tok * 4 + e] = ek; tok_g[tok * 4 + e] = gk; __hip_atomic_fetch_add(&HIST[ek], 1, __ATOMIC_RELAXED, __HIP_MEMORY_SCOPE_WORKGROUP); }
        }
    }
#undef LN1_LOAD
    lds_barrier();
    if (tid < 32) ((int*)(KWS() + WS_CTL))[CW_HIST + bx * 32 + tid] = HIST[tid];
}

__device__ __forceinline__ void slots_phase(LAS unsigned char* lds, int bx, int G) {
    const int tid = opaque_tid();
    int* ctl = (int*)(KWS() + WS_CTL);
    LAS int* RED = (LAS int*)lds;
    LAS int* TOT = RED + 1024;
    const int* tok_e = (const int*)(KWS() + WS_ROUTE); const float* tok_g = (const float*)(KWS() + WS_ROUTE + 1 * MiB);
    int* tok_slot = (int*)(KWS() + WS_ROUTE + 2 * MiB); int* slot_tok = (int*)(KWS() + WS_ROUTE + 3 * MiB);
    { const int e = tid & 31, part = tid >> 5; int tot = 0, pre = 0;
      for (int b2 = part; b2 < G; b2 += 16) { const int h = ctl[CW_HIST + b2 * 32 + e]; tot += h; if (b2 < bx) pre += h; }
      RED[(part * 32 + e) * 2] = tot; RED[(part * 32 + e) * 2 + 1] = pre; }
    __syncthreads();
    if (tid < 32) { int tot = 0, pre = 0; for (int p = 0; p < 16; ++p) { tot += RED[(p * 32 + tid) * 2]; pre += RED[(p * 32 + tid) * 2 + 1]; } TOT[tid] = tot; TOT[32 + tid] = pre; TOT[96 + tid] = 0; }
    __syncthreads();
    if (tid == 0) { int ps = 0;
#pragma unroll 1
        for (int e = 0; e < 32; ++e) { TOT[64 + e] = ps; ps += (TOT[e] + 255) & ~255; }
        TOT[128] = ps >> 8; if (bx == 0) ctl[CW_NT] = ps >> 8; }
    __syncthreads();
    if (bx == 0) { const int nt = TOT[128];
        for (int t = tid; t < nt; t += NTHR) { int e = 0;
#pragma unroll 1
            for (int k = 1; k < 32; ++k) if (TOT[64 + k] <= t * 256) e = k;
            ctl[CW_TILEE + t] = e; } }
    for (int e = bx; e < 32; e += G) { const int s0 = TOT[64 + e] + TOT[e], s1 = TOT[64 + e] + ((TOT[e] + 255) & ~255); for (int s = s0 + tid; s < s1; s += NTHR) slot_tok[s] = 0; }
    for (int it = bx + G * (tid >> 6); it < NTOK / 16; it += G * 8) {
        const int asg = it * 64 + (tid & 63); const int e = tok_e[asg]; const int rank = __hip_atomic_fetch_add(&TOT[96 + e], 1, __ATOMIC_RELAXED, __HIP_MEMORY_SCOPE_WORKGROUP); const int slot = TOT[64 + e] + TOT[32 + e] + rank;
        tok_slot[asg] = slot; slot_tok[slot] = asg >> 2;
    }
}

__device__ __forceinline__ void combine_phase(int l, int vcu, int G) {
    const int tid = opaque_tid(), lane = tid & 63, wave = __builtin_amdgcn_readfirstlane(tid >> 6);
    const int gw = vcu * NWAVES + wave, NGW = G * NWAVES;
    const bf16* X1B = (const bf16*)(KWS() + WS_X1B); const unsigned char* YB = (const unsigned char*)(KWS() + WS_YB); const int* tok_slot = (const int*)(KWS() + WS_ROUTE + 2 * MiB); const float* tok_gate = (const float*)(KWS() + WS_ROUTE + 1 * MiB);
    float* xo = KOUT(); bf16* XB = (bf16*)(KWS() + WS_XB); unsigned char* X8 = (unsigned char*)(KWS() + WS_X8);
    const float* g2 = KIN(I_LN2G) + l * D; const float* b2 = KIN(I_LN2B) + l * D;
    unsigned wg[128];
    { const unsigned* Wg = (const unsigned*)(KWS() + WS_GLRW) + (size_t)(l + 1 < NL ? l + 1 : l) * 8192 + lane;
#pragma unroll
      for (int i = 0; i < 128; ++i) wg[i] = Wg[i * 64]; }
    bf16* PG = (bf16*)(KWS() + WS_P) + PC_GLR + ((lane >> 2) & 15);
    u32x2 xw[4]; unsigned ya[4][4]; int ns0 = 0, ns1 = 0, ns2 = 0, ns3 = 0; f32x4 gv = {0.f, 0.f, 0.f, 0.f};
#define CMB_SLOTS(t_) do { const int4 _s = *(const int4*)(tok_slot + (size_t)(t_) * 4); ns0 = _s.x; ns1 = _s.y; ns2 = _s.z; ns3 = _s.w; } while (0)
#define CMB_ROWS(t_) do { const u32x2* _xr = (const u32x2*)(X1B + (size_t)(t_) * D) + lane; gv = *(const f32x4*)(tok_gate + (size_t)(t_) * 4); \
        const unsigned* _y0 = (const unsigned*)(YB + (size_t)ns0 * D) + lane; const unsigned* _y1 = (const unsigned*)(YB + (size_t)ns1 * D) + lane; \
        const unsigned* _y2 = (const unsigned*)(YB + (size_t)ns2 * D) + lane; const unsigned* _y3 = (const unsigned*)(YB + (size_t)ns3 * D) + lane; \
        _Pragma("unroll") for (int j = 0; j < 4; ++j) { xw[j] = _xr[64 * j]; ya[0][j] = _y0[64 * j]; ya[1][j] = _y1[64 * j]; ya[2][j] = _y2[64 * j]; ya[3][j] = _y3[64 * j]; } } while (0)
    if (gw < NTOK) { CMB_SLOTS(gw); CMB_ROWS(gw); if (gw + NGW < NTOK) CMB_SLOTS(gw + NGW); }
    for (int tok = gw; tok < NTOK; tok += NGW) {
        f32x4 v[4]; float s = 0.f; const f32x4 gs = gv * 0.0625f;
#pragma unroll
        for (int j = 0; j < 4; ++j) { const f32x4 xv = {bflo(xw[j].x), bfhi(xw[j].x), bflo(xw[j].y), bfhi(xw[j].y)};
            f32x2 lo = __builtin_amdgcn_cvt_pk_f32_fp8(ya[0][j], false) * gs[0], hi = __builtin_amdgcn_cvt_pk_f32_fp8(ya[0][j], true) * gs[0];
#pragma unroll
            for (int k = 1; k < 4; ++k) { lo += __builtin_amdgcn_cvt_pk_f32_fp8(ya[k][j], false) * gs[k]; hi += __builtin_amdgcn_cvt_pk_f32_fp8(ya[k][j], true) * gs[k]; }
            v[j][0] = DN_ALPHA * xv[0] + lo[0]; v[j][1] = DN_ALPHA * xv[1] + lo[1]; v[j][2] = DN_ALPHA * xv[2] + hi[0]; v[j][3] = DN_ALPHA * xv[3] + hi[1];
            s += (v[j][0] + v[j][1]) + (v[j][2] + v[j][3]); }
        if (tok + NGW < NTOK) { CMB_ROWS(tok + NGW); if (tok + 2 * NGW < NTOK) CMB_SLOTS(tok + 2 * NGW); }
        const float mean = wave_sum(s) * (1.0f / D); float q = 0.f;
#pragma unroll
        for (int j = 0; j < 4; ++j) { v[j] = v[j] - mean; q += (v[j][0] * v[j][0] + v[j][1] * v[j][1]) + (v[j][2] * v[j][2] + v[j][3] * v[j][3]); }
        const float rstd = 1.0f / sqrtf(wave_sum(q) * (1.0f / D) + LN_EPS);
        float ga[16];
#pragma unroll
        for (int c = 0; c < 16; ++c) ga[c] = 0.f;
#pragma unroll
        for (int j = 0; j < 4; ++j) { const f32x4 gg = *((const f32x4*)g2 + lane + 64 * j), bb = *((const f32x4*)b2 + lane + 64 * j);
            const f32x4 y = v[j] * rstd * gg + bb;
            if (l == NL - 1) *((f32x4*)(xo + (size_t)tok * D) + lane + 64 * j) = y;
            else { const unsigned p0 = pk2(y[0], y[1]), p1 = pk2(y[2], y[3]); *((u32x2*)(XB + (size_t)tok * D) + lane + 64 * j) = (u32x2){p0, p1};
                store_o4(X8 + (size_t)tok * D + 4 * (lane + 64 * j), y[0], y[1], y[2], y[3]);
#pragma unroll
                for (int c = 0; c < 16; ++c) { ga[c] = __builtin_amdgcn_fdot2_f32_bf16(__builtin_bit_cast(bf16x2_t, p0), __builtin_bit_cast(bf16x2_t, wg[(2 * j) * 16 + c]), ga[c], false);
                                               ga[c] = __builtin_amdgcn_fdot2_f32_bf16(__builtin_bit_cast(bf16x2_t, p1), __builtin_bit_cast(bf16x2_t, wg[(2 * j + 1) * 16 + c]), ga[c], false); } } }
        if (l != NL - 1) {
            const bool h5 = (lane & 32) != 0, h4 = (lane & 16) != 0, h3 = (lane & 8) != 0, h2 = (lane & 4) != 0;
            float r8[8], r4[4], r2[2];
#pragma unroll
            for (int i = 0; i < 8; ++i) { const float keep = h5 ? ga[8 + i] : ga[i], send = h5 ? ga[i] : ga[8 + i]; r8[i] = keep + __shfl_xor(send, 32); }
#pragma unroll
            for (int i = 0; i < 4; ++i) { const float keep = h4 ? r8[4 + i] : r8[i], send = h4 ? r8[i] : r8[4 + i]; r4[i] = keep + __shfl_xor(send, 16); }
#pragma unroll
            for (int i = 0; i < 2; ++i) { const float keep = h3 ? r4[2 + i] : r4[i], send = h3 ? r4[i] : r4[2 + i]; r2[i] = keep + __shfl_xor(send, 8); }
            const float keep = h2 ? r2[1] : r2[0], send = h2 ? r2[0] : r2[1];
            float r1 = keep + __shfl_xor(send, 4);
            r1 = dpp_add(r1, 0); r1 = dpp_add(r1, 1);
            if ((lane & 3) == 0) PG[(size_t)tok * PINP] = (bf16)f2bf(r1);
        }
    }
#undef CMB_SLOTS
#undef CMB_ROWS
}


constexpr int PH_PER_LAYER = 10, NPHASES = 2 + NL * PH_PER_LAYER;
__global__ void __launch_bounds__(NTHR, 2) trunk_fwd(Args args) {
    extern __shared__ __attribute__((aligned(16))) unsigned char lds_raw[];
    LAS unsigned char* lds = (LAS unsigned char*)lds_raw;
    volatile LAS unsigned* MISC = (volatile LAS unsigned*)(lds + MISC_OFF);
    const int tid = threadIdx.x;
    const int G = gridDim.x, bx = blockIdx.x;
    const int vcu = (G % 8 == 0) ? (bx % 8) * (G / 8) + bx / 8 : bx;
    unsigned char* ws = KWS();
    unsigned* ctl = (unsigned*)(ws + WS_CTL);
    for (int u = tid; u < (LDS_BYTES - LDSCTL_OFF) / 4; u += NTHR) ((LAS unsigned*)(lds + LDSCTL_OFF))[u] = 0u;
    __syncthreads();
    XcdBarrier bar; bar.bar = ctl + CW_BAR; bar.x = 0; bar.st = nullptr;
#if !MK_PER_PHASE
    bar = xcd_barrier_post(ctl + CW_BAR, MISC + 8);
#define GRID_BAR() xcd_barrier(bar)
#else
#define GRID_BAR() do { } while (0)
#endif
    const int lo = (int)(unsigned)ka_u64<280>(), hi = (int)(unsigned)(ka_u64<280>() >> 32);
#ifndef PH_MASK
#define PH_MASK 0x1FFF
#endif
#define PHEN(n) (((PH_MASK) >> (n)) & 1)
#define IN(k) (lo <= (k) && (k) < hi)
#define SEAM(k) do { if (rep > 0 || IN((k) + 1)) { GRID_BAR(); if (PHREP(21)) GRID_BAR(); } } while (0)

#define OG opaque_s(G)
#define OBX opaque_s(bx)
#define OVCU opaque_s(vcu)
#define OL opaque_s(l)
    if (PHEN(0) && IN(0)) for (int rep = PHREP(0); rep >= 0; --rep) { prologue_phase(lds, OVCU, OG); SEAM(0); }
    if (PHEN(1) && IN(1)) for (int rep = PHREP(1); rep >= 0; --rep) {
        pg8::DenseOrder S; S.init(KWS() + WS_MEMB, KWS() + WS_WMEM, NB * NMEM, 2048, D, OG, OBX);
        pg8::EpiBf16 E{(bf16*)(KWS() + WS_MKV), 2048};
        pg8::gemm_phase<pg8::EpiBf16, pg8::DenseOrder>(lds, D, S, E);
        SEAM(1);
    }
    for (int l = 0; l < NL; ++l) {
        const int p0 = 2 + l * PH_PER_LAYER;
        if (PHEN(2) && IN(p0 + 0)) for (int rep = PHREP(2); rep >= 0; --rep) {
            pg8::DenseOrder S; S.init(KWS() + WS_X8, KWS() + WS_WIN + (size_t)OL * PINP * D, NTOK, l == 0 ? PINP : PINP - 256, D / 2, OG, OBX);
            pg8::EpiBf16T<123, 125> E{(bf16*)(KWS() + WS_P), PINP};
            pg8::gemm_phase<pg8::EpiBf16T<123, 125>, pg8::DenseOrder, 1>(lds, D, S, E);
            SEAM(p0 + 0);
        }
        if (PHEN(4) && IN(p0 + 1)) for (int rep = PHREP(4); rep >= 0; --rep) { c1_phase(lds, OL, OVCU, OG); SEAM(p0 + 1); }
        if (PHEN(5) && IN(p0 + 2)) for (int rep = PHREP(5); rep >= 0; --rep) { m2_phase(lds, OL, OBX, OG); SEAM(p0 + 2); }
        if (PHEN(6) && IN(p0 + 3)) for (int rep = PHREP(6); rep >= 0; --rep) { m3_gh_phase(OL, OVCU, OG); SEAM(p0 + 3); }
        if (PHEN(7) && IN(p0 + 4)) for (int rep = PHREP(7); rep >= 0; --rep) {
            pg8::DenseOrder S; S.init(KWS() + WS_O, KWS() + WS_WOUT + (size_t)OL * D * D, NTOK, D, D / 2, OG, OBX);
            pg8::EpiBf16T<122, 125> E{(bf16*)(KWS() + WS_HMIX), D};
            pg8::gemm_phase<pg8::EpiBf16T<122, 125>, pg8::DenseOrder, 1>(lds, D, S, E);
            SEAM(p0 + 4);
        }
        if (PHEN(8) && IN(p0 + 5)) for (int rep = PHREP(8); rep >= 0; --rep) { ln1_router_phase(lds, OL, OBX, OG); SEAM(p0 + 5); }
        if (PHEN(9) && IN(p0 + 6)) for (int rep = PHREP(9); rep >= 0; --rep) { slots_phase(lds, OBX, OG); SEAM(p0 + 6); }
        if (PHEN(10) && IN(p0 + 7)) for (int rep = PHREP(10); rep >= 0; --rep) {
            const int ntiles = __builtin_amdgcn_readfirstlane(((const int*)(KWS() + WS_CTL))[CW_NT]);
            pg8::MoeOrder<true> S; S.init(KWS() + WS_XF, KWS() + WS_WGU + (size_t)OL * NE * 2048 * D, (const int*)(KWS() + WS_CTL) + CW_TILEE, (const int*)(KWS() + WS_ROUTE + 3 * MiB), ntiles, 2048, D, OG, OBX);
            pg8::EpiSwiglu E{(unsigned char*)(KWS() + WS_HB), (const float*)(KWS() + WS_BGU) + (size_t)OL * NE * 2048};
            pg8::gemm_phase<pg8::EpiSwiglu, pg8::MoeOrder<true>, 1>(lds, D, S, E);
            SEAM(p0 + 7);
        }
        if (PHEN(11) && IN(p0 + 8)) for (int rep = PHREP(11); rep >= 0; --rep) {
            const int ntiles = __builtin_amdgcn_readfirstlane(((const int*)(KWS() + WS_CTL))[CW_NT]);
            pg8::MoeOrder<false> S; S.init(KWS() + WS_HB, KWS() + WS_WD + (size_t)OL * NE * D * FF, (const int*)(KWS() + WS_CTL) + CW_TILEE, (const int*)(KWS() + WS_ROUTE + 3 * MiB), ntiles, D, FF, OG, OBX);
            pg8::EpiDown E{(unsigned char*)(KWS() + WS_YB), KIN(I_BDN) + (size_t)OL * NE * D};
            pg8::gemm_phase<pg8::EpiDown, pg8::MoeOrder<false>, 1>(lds, FF, S, E);
            SEAM(p0 + 8);
        }
        if (PHEN(12) && IN(p0 + 9)) for (int rep = PHREP(12); rep >= 0; --rep) { combine_phase(OL, OVCU, OG); if (rep > 0 || l + 1 < NL) SEAM(p0 + 9); }
    }
#undef IN
#undef SEAM
}

extern "C" void kernel_launch(void* const* d_in, const int* in_sizes, int n_in, void* d_out, int out_size, void* d_ws, size_t ws_size, hipStream_t stream) {
    static int grid = 0;
    if (grid == 0) {
        if (n_in != 33 || ws_size < WS_END) { fprintf(stderr, "kernel_launch: unexpected inputs (n_in %d, ws %zu need %zu)\n", n_in, ws_size, (size_t)WS_END); grid = -1; return; }
        int dev = 0, cus = 0;
        if (hipGetDevice(&dev) != hipSuccess || hipDeviceGetAttribute(&cus, hipDeviceAttributeMultiprocessorCount, dev) != hipSuccess) { grid = -1; return; }
        if (hipFuncSetAttribute((const void*)trunk_fwd, hipFuncAttributeMaxDynamicSharedMemorySize, LDS_BYTES) != hipSuccess) { grid = -1; return; }
        int per_cu = 0; (void)hipOccupancyMaxActiveBlocksPerMultiprocessor(&per_cu, (const void*)trunk_fwd, NTHR, LDS_BYTES); (void)hipGetLastError();
        grid = cus;
    }
    if (grid < 0) return;
    (void)hipMemsetAsync((char*)d_ws + WS_CTL, 0, CTL_ZERO_BYTES, stream);
    Args a{};
    for (int i = 0; i < 33; ++i) a.in[i] = (const float*)d_in[i];
    a.out = (float*)d_out; a.ws = (unsigned char*)d_ws;
#if MK_PER_PHASE
    for (int p = 0; p < NPHASES; ++p) { a.ph_lo = p; a.ph_hi = p + 1; hipLaunchKernelGGL(trunk_fwd, dim3(grid), dim3(NTHR), LDS_BYTES, stream, a); }
#else
    a.ph_lo = 0; a.ph_hi = NPHASES;
    hipLaunchKernelGGL(trunk_fwd, dim3(grid), dim3(NTHR), LDS_BYTES, stream, a);
#endif
}
```

```cpp
#include <hip/hip_runtime.h>
#include <cstdio>
#include <cstdint>

#ifndef MK_PER_PHASE
#define MK_PER_PHASE 0
#endif

#ifndef REP_MASK
#define REP_MASK 0
#endif
#define PHREP(n) (((REP_MASK) >> (n)) & 1)
#define LAS __attribute__((address_space(3)))
#define GAS __attribute__((address_space(1)))
typedef unsigned short bf16;
typedef short bf16x8 __attribute__((ext_vector_type(8)));
typedef short s16x4 __attribute__((ext_vector_type(4)));
typedef float f32x4 __attribute__((ext_vector_type(4)));
typedef float f32x2 __attribute__((ext_vector_type(2)));
typedef float f32x16 __attribute__((ext_vector_type(16)));
typedef unsigned u32x4 __attribute__((ext_vector_type(4)));
typedef unsigned u32x2 __attribute__((ext_vector_type(2)));

constexpr int NB = 8, T = 8192, D = 1024, NL = 4, NTOK = NB * T;
constexpr int PIN = 3088, PINP = 3328;
constexpr int NE = 32, FF = 1024, NMEM = 256;
constexpr int NASSIGN = NTOK * 4;
constexpr int MAXTILES = NASSIGN / 256 + NE;
constexpr int MAXSLOTS = MAXTILES * 256;
constexpr int PC_GQ = 0, PC_GK = 128, PC_GV = 256, PC_GOUT = 512, PC_HQ = 768, PC_HF = 1024, PC_HI = 1280, PC_HG = 1536;
constexpr int PC_RW = 1792, PC_MQ = 2816, PC_GLR = 3072;
constexpr float DN_ALPHA = 1.6817928305074292f;
constexpr float LN_EPS = 1e-5f, RMS_EPS = 1e-6f, RW_LN_EPS = 64e-5f;

constexpr size_t MiB = 1u << 20;
constexpr size_t WS_CTL = 0, CTL_ZERO_BYTES = 32768;
constexpr size_t WS_WIN = 1 * MiB;
constexpr size_t WS_WOUT = WS_WIN + 26 * MiB;
constexpr size_t WS_WMEM = WS_WOUT + 8 * MiB;
constexpr size_t WS_WGU = WS_WMEM + 4 * MiB;
constexpr size_t WS_WD = WS_WGU + 512 * MiB;
constexpr size_t WS_BGU = WS_WD + 256 * MiB;
constexpr size_t WS_LORA = WS_BGU + 1 * MiB;
constexpr size_t WS_GLRW = WS_LORA + 512 * 1024;
constexpr size_t WS_MEMB = WS_LORA + 1 * MiB;
constexpr size_t WS_MKV = WS_MEMB + 4 * MiB;
constexpr size_t WS_XB = WS_MKV + 8 * MiB;
constexpr size_t WS_X1B = WS_XB + 128 * MiB;
constexpr size_t WS_XF = WS_X1B + 128 * MiB;
constexpr size_t WS_X1F = WS_XF + 256 * MiB;
constexpr size_t WS_X8 = WS_X1F;
constexpr size_t WS_O = WS_X1F + 256 * MiB;
constexpr size_t WS_HMIX = WS_O + 128 * MiB;
constexpr size_t WS_ROUTE = WS_HMIX + 128 * MiB;
constexpr size_t WS_GBUF = WS_ROUTE + 6 * MiB;
constexpr size_t WS_BONUS = WS_GBUF + 32 * MiB;
constexpr size_t WS_BIG = WS_BONUS + 1 * MiB;
constexpr size_t WS_P = WS_BIG;
constexpr size_t WS_ORAW = WS_P + 416 * MiB;
constexpr size_t WS_HB = WS_BIG;
constexpr size_t WS_YB = WS_HB + 528 * MiB;
constexpr size_t WS_CHK = WS_ORAW;
constexpr size_t WS_HQ = WS_CHK, WS_HK = WS_HQ + 32 * MiB, WS_HVT = WS_HK + 32 * MiB, WS_HDS = WS_HVT + 32 * MiB, WS_HS = WS_HDS + 128 * MiB, WS_HBE = WS_HS + 64 * MiB;
constexpr size_t WS_GQ = WS_HBE + 2 * MiB, WS_GK = WS_GQ + 16 * MiB, WS_GVT = WS_GK + 16 * MiB, WS_GDS = WS_GVT + 32 * MiB, WS_GS = WS_GDS + 64 * MiB, WS_GBE = WS_GS + 32 * MiB;
constexpr size_t WS_RR = WS_GBE + 1 * MiB, WS_RB = WS_RR + 32 * MiB, WS_RK = WS_RB + 32 * MiB, WS_RW = WS_RK + 32 * MiB, WS_RVT = WS_RW + 32 * MiB;
constexpr size_t WS_RVG = WS_RVT + 32 * MiB;
constexpr size_t WS_RU = WS_RVG + 32 * MiB, WS_RP = WS_RU + 64 * MiB, WS_RQ = WS_RP + 64 * MiB, WS_RS = WS_RQ + 128 * MiB;
constexpr size_t WS_END = WS_RS + 64 * MiB;
static_assert(WS_YB + 528 * MiB <= WS_END, "overlay");
static_assert(WS_END <= (size_t)4096 * MiB, "workspace");
constexpr int CW_TMO = 0;
constexpr int CW_BAR = 4096;
constexpr int CW_HIST = 16384;
constexpr int CW_NT = 32768;
constexpr int CW_TILEE = 32768 + 64;
constexpr int CW_PADSTART = 40960;

constexpr int RING_BYTES = 131072;
constexpr int LDSCTL_OFF = 162816, MISC_OFF = LDSCTL_OFF + 320;
constexpr int LDS_BYTES = 163840;
constexpr int NWAVES = 8, NTHR = 512;

#define RLX_AGENT __ATOMIC_RELAXED, __HIP_MEMORY_SCOPE_AGENT
#define LDS_WAIT() asm volatile("s_waitcnt lgkmcnt(0)" ::: "memory")
#define VM_WAIT() asm volatile("s_waitcnt vmcnt(0)" ::: "memory")

__device__ __forceinline__ float bf2f(unsigned short b) { return __builtin_bit_cast(float, (unsigned)b << 16); }
__device__ __forceinline__ float bflo(unsigned w) { return __builtin_bit_cast(float, w << 16); }
__device__ __forceinline__ float bfhi(unsigned w) { return __builtin_bit_cast(float, w & 0xffff0000u); }
typedef __bf16 bf16x2_t __attribute__((ext_vector_type(2)));
__device__ __forceinline__ unsigned cvt_pk_bf16(float lo, float hi) { const f32x2 v = {lo, hi}; const bf16x2_t b = __builtin_convertvector(v, bf16x2_t); return __builtin_bit_cast(unsigned, b); }
__device__ __forceinline__ unsigned pk2(float lo, float hi) { return cvt_pk_bf16(lo, hi); }
__device__ __forceinline__ unsigned f2bf(float f) { return cvt_pk_bf16(f, 0.f) & 0xffffu; }
__device__ __forceinline__ float o_q(float y) { return __builtin_amdgcn_fmed3f(y * 4.0f, -448.0f, 448.0f); }
__device__ __forceinline__ void store_o4(unsigned char* p, float y0, float y1, float y2, float y3) { int w = __builtin_amdgcn_cvt_pk_fp8_f32(o_q(y0), o_q(y1), 0, false); w = __builtin_amdgcn_cvt_pk_fp8_f32(o_q(y2), o_q(y3), w, true); *(unsigned*)p = (unsigned)w; }
__device__ __forceinline__ float fast_exp(float x) { return __builtin_amdgcn_exp2f(x * 1.4426950408889634f); }
__device__ __forceinline__ float fast_sigmoid(float x) { return __builtin_amdgcn_rcpf(1.0f + fast_exp(-x)); }
__device__ __forceinline__ float silu_f(float x) { return x * fast_sigmoid(x); }
__device__ __forceinline__ int opaque_tid() { int t = threadIdx.x; asm volatile("" : "+v"(t)); return t; }
__device__ __forceinline__ int opaque_s(int v) { asm volatile("" : "+s"(v)); return v; }
__device__ __forceinline__ void lds_barrier() { asm volatile("s_waitcnt lgkmcnt(0)" ::: "memory"); __builtin_amdgcn_s_barrier(); asm volatile("" ::: "memory"); }
__device__ __forceinline__ float dpp_add(float x, const int sel) {
    const int xi = __builtin_bit_cast(int, x); int r;
    switch (sel) { case 0: r = __builtin_amdgcn_update_dpp(xi, xi, 0xB1, 0xf, 0xf, false); break;
                   case 1: r = __builtin_amdgcn_update_dpp(xi, xi, 0x4E, 0xf, 0xf, false); break;
                   case 2: r = __builtin_amdgcn_update_dpp(xi, xi, 0x141, 0xf, 0xf, false); break;
                   default: r = __builtin_amdgcn_update_dpp(xi, xi, 0x140, 0xf, 0xf, false); break; }
    return x + __builtin_bit_cast(float, r);
}
__device__ __forceinline__ float wave_sum(float v) {
    v = dpp_add(v, 0); v = dpp_add(v, 1); v = dpp_add(v, 2); v = dpp_add(v, 3);
    v += __builtin_bit_cast(float, __builtin_amdgcn_update_dpp(0, __builtin_bit_cast(int, v), 0x142, 0xa, 0xf, false));
    v += __builtin_bit_cast(float, __builtin_amdgcn_update_dpp(0, __builtin_bit_cast(int, v), 0x143, 0xc, 0xf, false));
    return __builtin_bit_cast(float, __builtin_amdgcn_readlane(__builtin_bit_cast(int, v), 63));
}

namespace pg8 {
constexpr int BM = 256, BK = 64, HALF = 128, HTB = HALF * BK * 2, STAGE_BYTES = 8 * HTB, NXCD = 8, WGM = 8;
__host__ __device__ __forceinline__ int lds_byte(int r, int c) { const int st = (r >> 4) * 2 + (c >> 5), rr = r & 15, cc = c & 31, ob = rr * 64 + cc * 2; return st * 1024 + (ob ^ (((ob >> 9) & 1) << 5)); }
__host__ __device__ __forceinline__ void stage_rc(int b, int& R, int& C) { const int st = b / 1024, sb = b % 1024, swz = sb ^ (((sb >> 9) & 1) << 5); R = (st >> 1) * 16 + swz / 64; C = (st & 1) * 32 + (swz % 64) / 2; }
__host__ __device__ __forceinline__ int perm32(int rho) { const int n = rho >> 4, i = rho & 15; return 8 * (i >> 2) + 4 * n + (i & 3); }

typedef int v4i_t __attribute__((ext_vector_type(4)));
typedef int v8i_t __attribute__((ext_vector_type(8)));
struct Unit { int pm, pn, e; const char* A; const char* B; };
__device__ __forceinline__ unsigned asm_gload_u32(const void* p) { unsigned v; asm volatile("global_load_dword %0, %1, off" : "=v"(v) : "v"(p) : "memory"); return v; }

__device__ __forceinline__ bool static_tile(int i, int G, int c, int nM, int nN, int& pm, int& pn) {
    const int nwg = nM * nN; const long L = (long)i * G + c; if (L >= nwg) return false;
    int wgid = (int)L; { const int q = nwg / NXCD, r = nwg % NXCD, xcd = wgid % NXCD, off = wgid / NXCD; wgid = (xcd < r ? xcd * (q + 1) : r * (q + 1) + (xcd - r) * q) + off; }
    const int nig = WGM * nN, gid = wgid / nig, fm = gid * WGM, gsz = (nM - fm) < WGM ? (nM - fm) : WGM;
    pm = fm + ((wgid % nig) % gsz); pn = (wgid % nig) / gsz; return true;
}
struct DenseOrder {
    static constexpr bool GATHER = false, HAS_E = false;
    const char* A; const char* B; int nM, nN, G, c; size_t tstep;
    __device__ __forceinline__ void init(const void* A_, const void* B_, int M, int N, int K, int G_, int c_) { A = (const char*)A_; B = (const char*)B_; nM = M / BM; nN = N / BM; G = G_; c = c_; tstep = (size_t)BM * K * 2; }
    __device__ __forceinline__ bool next(int i, Unit& u) const { if (!static_tile(i, G, c, nM, nN, u.pm, u.pn)) return false; u.e = 0; u.A = A + (size_t)u.pm * tstep; u.B = B + (size_t)u.pn * tstep; return true; }
    __device__ __forceinline__ unsigned row_tok(const Unit&, int) const { return 0; }
};
template <bool GATHER_> struct MoeOrder {
    static constexpr bool GATHER = GATHER_, HAS_E = true;
    const char* A; const char* B; const int* tile_e; const int* slot_tok; int nM, nN, G, c; size_t tstep, estep;
    __device__ __forceinline__ void init(const void* A_, const void* B_, const int* tile_e_, const int* slot_tok_, int ntiles, int Nper, int Kbytes, int G_, int c_) {
        A = (const char*)A_; B = (const char*)B_; tile_e = tile_e_; slot_tok = slot_tok_; nM = ntiles; nN = Nper / BM; G = G_; c = c_; tstep = (size_t)BM * Kbytes; estep = (size_t)Nper * Kbytes; }
    __device__ __forceinline__ bool next(int i, Unit& u) const { if (!static_tile(i, G, c, nM, nN, u.pm, u.pn)) return false;
        u.e = __builtin_amdgcn_readfirstlane(tile_e[u.pm]); u.A = GATHER_ ? A : A + (size_t)u.pm * tstep; u.B = B + (size_t)u.e * estep + (size_t)u.pn * tstep; return true; }
    __device__ __forceinline__ unsigned row_tok(const Unit& u, int r) const { return (unsigned)slot_tok[u.pm * BM + r]; }
    __device__ __forceinline__ bool next_static(int i, Unit& u) const { return static_tile(i, G, c, nM, nN, u.pm, u.pn); }
    __device__ __forceinline__ const int* e_ptr(const Unit& u) const { return tile_e + u.pm; }
    __device__ __forceinline__ const int* tok_ptr(const Unit& u, int r) const { return slot_tok + u.pm * BM + r; }
    __device__ __forceinline__ void finish(Unit& u, int e) const { u.e = e; u.A = GATHER_ ? A : A + (size_t)u.pm * tstep; u.B = B + (size_t)e * estep + (size_t)u.pn * tstep; }
};

template <int WSCALE_ = 127, int ASCALE_ = 127>
struct EpiBf16T {
    static constexpr bool PERM = true; static constexpr int WSCALE = WSCALE_, ASCALE = ASCALE_;
    bf16* O; int ldc;
    __device__ __forceinline__ void init(f32x4 (&acc)[2][2][4][2], const Unit&, int, int) const {
#pragma unroll
        for (int a = 0; a < 2; ++a)
#pragma unroll
            for (int b = 0; b < 2; ++b)
#pragma unroll
                for (int m = 0; m < 4; ++m)
#pragma unroll
                    for (int n = 0; n < 2; ++n) acc[a][b][m][n] = (f32x4){0.f, 0.f, 0.f, 0.f}; }
    __device__ __forceinline__ void operator()(const f32x4 (&acc)[2][2][4][2], const Unit& u, int wr, int wc, int fr, int fq) const {
        const int row0 = u.pm * BM + wr * 64 + fr, col0 = u.pn * BM + wc * 32 + 8 * fq;
#pragma unroll
        for (int ai = 0; ai < 2; ++ai)
#pragma unroll
            for (int m = 0; m < 4; ++m) { bf16* rowp = O + (size_t)(row0 + ai * HALF + m * 16) * ldc + col0;
#pragma unroll
                for (int bj = 0; bj < 2; ++bj) { const f32x4 v0 = acc[ai][bj][m][0], v1 = acc[ai][bj][m][1];
                    u32x4 w; w.x = cvt_pk_bf16(v0[0], v0[1]); w.y = cvt_pk_bf16(v0[2], v0[3]); w.z = cvt_pk_bf16(v1[0], v1[1]); w.w = cvt_pk_bf16(v1[2], v1[3]);
                    *(u32x4*)(rowp + bj * HALF) = w; } }
    }
};
typedef EpiBf16T<> EpiBf16;
struct EpiSwiglu {
    static constexpr bool PERM = false; static constexpr int WSCALE = 123, ASCALE = 127;
    unsigned char* H; const float* bias;
    __device__ __forceinline__ void init(f32x4 (&acc)[2][2][4][2], const Unit& u, int wc, int fq) const {
        const float* bp = bias + (size_t)u.e * 2048 + u.pn * 256 + wc * 32 + 4 * fq;
#pragma unroll
        for (int bj = 0; bj < 2; ++bj)
#pragma unroll
            for (int n = 0; n < 2; ++n) { const f32x4 bv = *(const f32x4*)(bp + bj * HALF + n * 16);
#pragma unroll
                for (int ai = 0; ai < 2; ++ai)
#pragma unroll
                    for (int m = 0; m < 4; ++m) acc[ai][bj][m][n] = bv; } }
    __device__ __forceinline__ void operator()(const f32x4 (&acc)[2][2][4][2], const Unit& u, int wr, int wc, int fr, int fq) const {
        const int row0 = u.pm * BM + wr * 64 + fr, colh = u.pn * 128 + wc * 32 + 8 * fq;
        f32x2 kc = {-1.702f * 1.4426950408889634f, -1.702f * 1.4426950408889634f}, k1 = {1.0f, 1.0f}; asm volatile("" : "+v"(kc), "+v"(k1));
#pragma unroll
        for (int ai = 0; ai < 2; ++ai)
#pragma unroll
            for (int m = 0; m < 4; ++m) { unsigned char* rowp = H + (size_t)(row0 + ai * HALF + m * 16) * FF + colh;
                float o[8];
#pragma unroll
                for (int n = 0; n < 2; ++n)
#pragma unroll
                    for (int hq = 0; hq < 2; ++hq) { const f32x4 g4 = acc[ai][0][m][n], u4 = acc[ai][1][m][n]; f32x2 g, up, e, r;
#pragma unroll
                        for (int j = 0; j < 2; ++j) { g[j] = __builtin_amdgcn_fmed3f(g4[2 * hq + j], -3.0e38f, 7.0f); up[j] = __builtin_amdgcn_fmed3f(u4[2 * hq + j], -7.0f, 7.0f); }
                        const f32x2 t = g * kc;
#pragma unroll
                        for (int j = 0; j < 2; ++j) e[j] = __builtin_amdgcn_exp2f(t[j]);
                        const f32x2 d = e + k1;
#pragma unroll
                        for (int j = 0; j < 2; ++j) r[j] = __builtin_amdgcn_rcpf(d[j]);
                        const f32x2 glu = g * r, ov = up * glu + glu;
                        o[n * 4 + 2 * hq] = ov[0]; o[n * 4 + 2 * hq + 1] = ov[1]; }
                int w0 = __builtin_amdgcn_cvt_pk_fp8_f32(o[0], o[1], 0, false); w0 = __builtin_amdgcn_cvt_pk_fp8_f32(o[2], o[3], w0, true);
                int w1 = __builtin_amdgcn_cvt_pk_fp8_f32(o[4], o[5], 0, false); w1 = __builtin_amdgcn_cvt_pk_fp8_f32(o[6], o[7], w1, true);
                *(u32x2*)rowp = (u32x2){(unsigned)w0, (unsigned)w1}; }
    }
};
struct EpiDown {
    static constexpr bool PERM = true; static constexpr int WSCALE = 122, ASCALE = 127;
    unsigned char* Y; const float* bias;
    __device__ __forceinline__ void init(f32x4 (&acc)[2][2][4][2], const Unit& u, int wc, int fq) const {
        const float* bp = bias + (size_t)u.e * 1024 + u.pn * BM + wc * 32 + 8 * fq;
#pragma unroll
        for (int bj = 0; bj < 2; ++bj)
#pragma unroll
            for (int n = 0; n < 2; ++n) { const f32x4 bv = *(const f32x4*)(bp + bj * HALF + 4 * n);
#pragma unroll
                for (int ai = 0; ai < 2; ++ai)
#pragma unroll
                    for (int m = 0; m < 4; ++m) acc[ai][bj][m][n] = bv; } }
    __device__ __forceinline__ void operator()(const f32x4 (&acc)[2][2][4][2], const Unit& u, int wr, int wc, int fr, int fq) const {
        const int row0 = u.pm * BM + wr * 64 + fr, col0 = u.pn * BM + wc * 32 + 8 * fq;
#pragma unroll
        for (int ai = 0; ai < 2; ++ai)
#pragma unroll
            for (int m = 0; m < 4; ++m) { const int row = row0 + ai * HALF + m * 16; const float g = 16.0f; unsigned char* rowp = Y + (size_t)row * D + col0;
#pragma unroll
                for (int bj = 0; bj < 2; ++bj) { const f32x4 v0 = acc[ai][bj][m][0] * g, v1 = acc[ai][bj][m][1] * g;
                    int w0 = __builtin_amdgcn_cvt_pk_fp8_f32(v0[0], v0[1], 0, false); w0 = __builtin_amdgcn_cvt_pk_fp8_f32(v0[2], v0[3], w0, true);
                    int w1 = __builtin_amdgcn_cvt_pk_fp8_f32(v1[0], v1[1], 0, false); w1 = __builtin_amdgcn_cvt_pk_fp8_f32(v1[2], v1[3], w1, true);
                    *(u32x2*)(rowp + bj * HALF) = (u32x2){(unsigned)w0, (unsigned)w1}; } }
    }
};

template <class Epi, class Sched, int ES = 2, bool ALIGN_EPI = true>
__device__ __forceinline__ void gemm_phase(LAS unsigned char* lds, const int K, const Sched& S, const Epi& E) {
    constexpr bool GA = Sched::GATHER;
    const int tid = opaque_tid(), wid = __builtin_amdgcn_readfirstlane(tid >> 6), lane = tid & 63, wr = wid >> 2, wc = wid & 3, fr = lane & 15, fq = lane >> 4;
    const int nt = K * ES / (BK * 2);
    unsigned voffA[2], voffB[2]; int Rr[2]; unsigned Cb[2];
#pragma unroll
    for (int i = 0; i < 2; ++i) { int R, C; stage_rc(tid * 16 + i * 8192, R, C); const int Rb = Epi::PERM ? ((R & ~31) + perm32(R & 31)) : R;
        voffA[i] = (unsigned)(R * K * ES + C * 2); voffB[i] = (unsigned)(Rb * K * ES + C * 2); Rr[i] = R; Cb[i] = (unsigned)C * 2u; }
    const size_t kstep = (size_t)(BK * 2);
    const size_t hstep = (size_t)HALF * K * ES;
    const unsigned ldsw = (unsigned)wid * 1024u;
    const int aoff0 = lds_byte(wr * 64 + fr, fq * 8), aoff1 = lds_byte(wr * 64 + fr, fq * 8 + 32);
    const int boff0 = lds_byte(wc * 32 + fr, fq * 8), boff1 = lds_byte(wc * 32 + fr, fq * 8 + 32);
    unsigned cOff[2][2], nOff[2][2], sOff[2][2];
#define PG8_SA(b, h) (((b) * 2 + (h)) * HTB)
#define PG8_SB(b, h) ((4 + (b) * 2 + (h)) * HTB)
#define PG8_STAGE(bufoff, gbase, voff) do { _Pragma("unroll") for (int _i = 0; _i < 2; ++_i) \
        __builtin_amdgcn_global_load_lds((const unsigned*)((const char*)(gbase) + (voff)[_i]), (LAS unsigned*)(lds + (bufoff) + ldsw + _i * 8192), 16, 0, 0); } while (0)
#define PG8_STAGE_A(bufoff, gbase, half, OFF) do { if constexpr (GA) { PG8_STAGE(bufoff, gbase, (OFF)[half]); } else { PG8_STAGE(bufoff, (gbase) + (half) * hstep, voffA); } } while (0)
#define PG8_LDA(dst, b, h) do { if constexpr (ES == 2) { _Pragma("unroll") for (int m = 0; m < 4; ++m) _Pragma("unroll") for (int k = 0; k < 2; ++k) dst[m][k] = *(const LAS bf16x8*)(lds + PG8_SA(b, h) + (k ? aoff1 : aoff0) + m * 2048); } \
        else { _Pragma("unroll") for (int m = 0; m < 4; ++m) dst##8[m] = __builtin_shufflevector(*(const LAS v4i_t*)(lds + PG8_SA(b, h) + aoff0 + m * 2048), *(const LAS v4i_t*)(lds + PG8_SA(b, h) + aoff1 + m * 2048), 0, 1, 2, 3, 4, 5, 6, 7); } } while (0)
#define PG8_LDB(dst, b, h) do { if constexpr (ES == 2) { _Pragma("unroll") for (int n = 0; n < 2; ++n) _Pragma("unroll") for (int k = 0; k < 2; ++k) dst[n][k] = *(const LAS bf16x8*)(lds + PG8_SB(b, h) + (k ? boff1 : boff0) + n * 2048); } \
        else { _Pragma("unroll") for (int n = 0; n < 2; ++n) dst##8[n] = __builtin_shufflevector(*(const LAS v4i_t*)(lds + PG8_SB(b, h) + boff0 + n * 2048), *(const LAS v4i_t*)(lds + PG8_SB(b, h) + boff1 + n * 2048), 0, 1, 2, 3, 4, 5, 6, 7); } } while (0)
#define PG8_MMA(ai, bj, At, Bt) do { __builtin_amdgcn_s_setprio(1); _Pragma("unroll") for (int m = 0; m < 4; ++m) _Pragma("unroll") for (int n = 0; n < 2; ++n) { \
        if constexpr (ES == 2) { _Pragma("unroll") for (int k = 0; k < 2; ++k) acc[ai][bj][m][n] = __builtin_amdgcn_mfma_f32_16x16x32_bf16(Bt[n][k], At[m][k], acc[ai][bj][m][n], 0, 0, 0); } \
        else { asm volatile("v_mfma_scale_f32_16x16x128_f8f6f4 %0, %1, %2, %0, %3, %4 op_sel_hi:[0,0,0]" : "+v"(acc[ai][bj][m][n]) : "v"(Bt##8[n]), "v"(At##8[m]), "v"(wscale_v), "v"(ascale_v)); } } \
        __builtin_amdgcn_s_setprio(0); } while (0)
#define PG8_WAIT_V(n) asm volatile("s_waitcnt vmcnt(" #n ")" ::: "memory")
#define PG8_WAIT_L(n) asm volatile("s_waitcnt lgkmcnt(" #n ")" ::: "memory")
#define PG8_WAIT_VR() do { if (relax) { if constexpr (GA) PG8_WAIT_V(13); else PG8_WAIT_V(9); } else PG8_WAIT_V(8); } while (0)
#define PG8_BAR __builtin_amdgcn_s_barrier()
#define PG8_SCHED __builtin_amdgcn_sched_barrier(0)
#define PG8_GOFF(dst, u) do { if constexpr (GA) { _Pragma("unroll") for (int _h = 0; _h < 2; ++_h) _Pragma("unroll") for (int _i = 0; _i < 2; ++_i) \
        dst[_h][_i] = S.row_tok(u, _h * HALF + Rr[_i]) * (unsigned)(K * ES) + Cb[_i]; } } while (0)
    Unit cur, nxt; int ui = 0;
    if (!S.next(0, cur)) return;
#ifndef GEMM_STAGGER_TICKS
#define GEMM_STAGGER_TICKS 0
#endif
    if (GEMM_STAGGER_TICKS > 0) {
        const unsigned long long t0 = __builtin_amdgcn_s_memrealtime(), dl = (unsigned long long)((S.c * 5) & 15) * GEMM_STAGGER_TICKS;
        while (__builtin_amdgcn_s_memrealtime() - t0 < dl) __builtin_amdgcn_s_sleep(8);
    }
    f32x4 acc[2][2][4][2];
    E.init(acc, cur, wc, fq);
    int wscale_v = Epi::WSCALE, ascale_v = Epi::ASCALE; asm volatile("" : "+v"(wscale_v), "+v"(ascale_v));
    bf16x8 At[4][2], B0[2][2], B1[2][2];
    v8i_t At8[4], B08[2], B18[2];
    const char* cA = cur.A; const char* cB = cur.B;
    PG8_GOFF(cOff, cur);
#pragma unroll
    for (int h = 0; h < 2; ++h)
#pragma unroll
        for (int i = 0; i < 2; ++i) { nOff[h][i] = 0u; sOff[h][i] = 0u; }
    if constexpr (GA) { VM_WAIT(); }
    PG8_STAGE(PG8_SB(0, 0), cB, voffB); PG8_STAGE(PG8_SB(0, 1), cB + hstep, voffB); PG8_STAGE_A(PG8_SA(0, 0), cA, 0, cOff); PG8_STAGE_A(PG8_SA(0, 1), cA, 1, cOff);
    if (wr == 1) PG8_BAR;
    PG8_WAIT_V(2); PG8_BAR;
    PG8_STAGE(PG8_SB(1, 0), cB + kstep, voffB); PG8_STAGE_A(PG8_SA(1, 0), cA + kstep, 0, cOff); PG8_STAGE(PG8_SB(1, 1), cB + hstep + kstep, voffB);
    PG8_WAIT_V(6); PG8_BAR;
    for (;;) {
        bool has_next; const char* nA = cA; const char* nB = cB;
        unsigned eraw = 0u, traw[2][2] = {{0u, 0u}, {0u, 0u}};
        if constexpr (Sched::HAS_E) {
            has_next = S.next_static(ui + 1, nxt);
            if (has_next) { eraw = asm_gload_u32(S.e_ptr(nxt));
                if constexpr (GA) {
#pragma unroll
                    for (int h = 0; h < 2; ++h)
#pragma unroll
                        for (int i = 0; i < 2; ++i) traw[h][i] = asm_gload_u32(S.tok_ptr(nxt, h * HALF + Rr[i])); } }
        } else { has_next = S.next(ui + 1, nxt); if (has_next) { nA = nxt.A; nB = nxt.B; } }
#pragma unroll 1
        for (int t = 0; t < nt; t += 2) {
            const bool last = (t == nt - 2);
            const bool relax = Sched::HAS_E && has_next && t == 0;
            if constexpr (Sched::HAS_E) { if (last) {
                if (has_next) {
                    if constexpr (GA) asm volatile("" : "+v"(eraw), "+v"(traw[0][0]), "+v"(traw[0][1]), "+v"(traw[1][0]), "+v"(traw[1][1]) :: "memory"); else asm volatile("" : "+v"(eraw) :: "memory");
                    S.finish(nxt, __builtin_amdgcn_readfirstlane((int)eraw)); nA = nxt.A; nB = nxt.B;
                    if constexpr (GA) {
#pragma unroll
                        for (int h = 0; h < 2; ++h)
#pragma unroll
                            for (int i = 0; i < 2; ++i) nOff[h][i] = traw[h][i] * (unsigned)(K * ES) + Cb[i]; }
                } else if constexpr (GA) {
#pragma unroll
                    for (int h = 0; h < 2; ++h)
#pragma unroll
                        for (int i = 0; i < 2; ++i) nOff[h][i] = cOff[h][i]; } } }
            const char* a1 = cA + (size_t)(t + 1) * kstep;
            const char* a2 = last ? nA : cA + (size_t)(t + 2) * kstep; const char* b2 = last ? nB : cB + (size_t)(t + 2) * kstep;
            const char* a3 = a2 + kstep; const char* b3 = b2 + kstep;
            if constexpr (GA) {
#pragma unroll
                for (int h = 0; h < 2; ++h)
#pragma unroll
                    for (int i = 0; i < 2; ++i) sOff[h][i] = last ? nOff[h][i] : cOff[h][i]; }
            PG8_LDB(B0, 0, 0); PG8_LDB(B1, 0, 1); PG8_SCHED; PG8_LDA(At, 0, 0); PG8_STAGE_A(PG8_SA(1, 1), a1, 1, cOff);
            PG8_WAIT_VR(); PG8_WAIT_L(0); PG8_BAR; PG8_MMA(0, 0, At, B0); PG8_MMA(0, 1, At, B1); PG8_BAR; PG8_SCHED;
            PG8_LDA(At, 0, 1); PG8_STAGE(PG8_SB(0, 0), b2, voffB); PG8_STAGE(PG8_SB(0, 1), b2 + hstep, voffB); PG8_STAGE_A(PG8_SA(0, 0), a2, 0, sOff);
            PG8_WAIT_VR(); PG8_WAIT_L(0); PG8_BAR; PG8_MMA(1, 0, At, B0); PG8_MMA(1, 1, At, B1); PG8_BAR; PG8_SCHED;
            PG8_LDB(B0, 1, 0); PG8_LDB(B1, 1, 1); PG8_SCHED; PG8_LDA(At, 1, 0); PG8_STAGE_A(PG8_SA(0, 1), a2, 1, sOff);
            PG8_WAIT_V(8); PG8_WAIT_L(0); PG8_BAR; PG8_MMA(0, 0, At, B0); PG8_MMA(0, 1, At, B1); PG8_BAR; PG8_SCHED;
            PG8_LDA(At, 1, 1); PG8_STAGE(PG8_SB(1, 0), b3, voffB); PG8_STAGE(PG8_SB(1, 1), b3 + hstep, voffB); PG8_STAGE_A(PG8_SA(1, 0), a3, 0, sOff);
            PG8_WAIT_V(8); PG8_WAIT_L(0); PG8_BAR; PG8_MMA(1, 0, At, B0); PG8_MMA(1, 1, At, B1); PG8_BAR; PG8_SCHED;
        }
        if constexpr (ALIGN_EPI) { if (wr == 0) PG8_BAR; }
        if constexpr (ES == 1) { asm volatile("s_nop 15\n\ts_nop 15" ::: "memory"); }
        E(acc, cur, wr, wc, fr, fq);
        if (PHREP(25)) E(acc, cur, wr, wc, fr, fq);
        if (!has_next) break;
        E.init(acc, nxt, wc, fq);
        cur = nxt; cA = nA; cB = nB; ++ui;
        if constexpr (GA) {
#pragma unroll
            for (int h = 0; h < 2; ++h)
#pragma unroll
                for (int i = 0; i < 2; ++i) cOff[h][i] = nOff[h][i]; }
        if constexpr (ALIGN_EPI) { if (wr == 1) PG8_BAR; }
    }
    PG8_WAIT_V(0);
    if constexpr (!ALIGN_EPI) { if (wr == 0) PG8_BAR; }
    PG8_BAR;
#undef PG8_SA
#undef PG8_SB
#undef PG8_STAGE
#undef PG8_STAGE_A
#undef PG8_LDA
#undef PG8_LDB
#undef PG8_MMA
#undef PG8_WAIT_V
#undef PG8_WAIT_L
#undef PG8_WAIT_VR
#undef PG8_BAR
#undef PG8_SCHED
#undef PG8_GOFF
}
}

#define XB_TMO      128
#define XB_XCNT(j)  (256  + 64 * (j))
#define XB_XSUB(j)  (1280 + 64 * (j))
#define XB_XGEN(j)  (2304 + 64 * (j))
#define XB_TOP      3328
#define XB_TOPGEN   3392
#define XCD_BAR_WORDS 3456
#define XB_SPIN_CAP (1u << 18)
__device__ __forceinline__ unsigned xb_ld(unsigned* p)              { return __hip_atomic_load(p, __ATOMIC_RELAXED, __HIP_MEMORY_SCOPE_AGENT); }
__device__ __forceinline__ unsigned xb_add(unsigned* p, unsigned v) { return __hip_atomic_fetch_add(p, v, __ATOMIC_RELAXED, __HIP_MEMORY_SCOPE_AGENT); }
__device__ __forceinline__ unsigned xb_xcc_id() { return (unsigned)__builtin_amdgcn_s_getreg((3 << 11) | 20) & 0xFu; }
#define XB_SPIN(cond, bar) do { unsigned _sp = 0; while (cond) { __builtin_amdgcn_s_sleep(1); \
    if ((++_sp & 255u) == 0u) { if (xb_ld(&(bar)[XB_TMO])) break; if (_sp > XB_SPIN_CAP) { atomicAdd(&(bar)[XB_TMO], 1u); break; } } } } while (0)
struct XcdBarrier { unsigned* bar; unsigned x; volatile LAS unsigned* st; };
__device__ __forceinline__ XcdBarrier xcd_barrier_post(unsigned* bar, volatile LAS unsigned* st) {
    XcdBarrier b; b.bar = bar; b.x = xb_xcc_id(); b.st = st;
    if (threadIdx.x == 0) (void)xb_add(&bar[XB_XCNT(b.x)], 1u);
    return b;
}
__device__ __forceinline__ void xcd_barrier_complete(unsigned* bar, unsigned x, unsigned& nloc, unsigned& nx) {
    const unsigned G = gridDim.x * gridDim.y * gridDim.z;
    unsigned sum, cnt, mine, sp = 0u;
    for (;;) {
        sum = 0u; cnt = 0u; mine = 0u;
#pragma unroll
        for (unsigned j = 0; j < 16; ++j) { const unsigned c = xb_ld(&bar[XB_XCNT(j)]); sum += c; cnt += (c > 0u) ? 1u : 0u; mine = (j == x) ? c : mine; }
        if (sum == G) break;
        __builtin_amdgcn_s_sleep(1);
        if ((++sp & 255u) == 0u) { if (xb_ld(&bar[XB_TMO])) break; if (sp > XB_SPIN_CAP) { atomicAdd(&bar[XB_TMO], 1u); break; } }
    }
    nloc = mine > 0u ? mine : 1u; nx = cnt > 0u ? cnt : 1u;
}
__device__ __forceinline__ void xcd_barrier(const XcdBarrier& b) {
    asm volatile("s_waitcnt vmcnt(0)" ::: "memory");
    __syncthreads();
    if (threadIdx.x == 0) {
        unsigned* bar = b.bar;
        __builtin_amdgcn_s_waitcnt(0);
        unsigned nloc = b.st[0], nx = b.st[1];
        if (nloc == 0u) { xcd_barrier_complete(bar, b.x, nloc, nx); b.st[0] = nloc; b.st[1] = nx; }
        const unsigned old = xb_add(&bar[XB_XSUB(b.x)], 1u);
        const unsigned gen = old / nloc;
        if (old + 1u == (gen + 1u) * nloc) {
            __builtin_amdgcn_fence(__ATOMIC_RELEASE, "agent");
            asm volatile("s_waitcnt vmcnt(0)" ::: "memory");
            const unsigned og = xb_add(&bar[XB_TOP], 1u);
            const unsigned tg = og / nx;
            if (og + 1u == (tg + 1u) * nx) xb_add(&bar[XB_TOPGEN], 1u);
            else XB_SPIN(xb_ld(&bar[XB_TOPGEN]) == tg, bar);
            __builtin_amdgcn_fence(__ATOMIC_ACQUIRE, "agent");
            xb_add(&bar[XB_XGEN(b.x)], 1u);
            asm volatile("s_waitcnt vmcnt(0)" ::: "memory");
        } else {
            XB_SPIN(xb_ld(&bar[XB_XGEN(b.x)]) == gen, bar);
            __builtin_amdgcn_fence(__ATOMIC_ACQUIRE, "agent");
            asm volatile("s_waitcnt vmcnt(0)" ::: "memory");
        }
    }
    __syncthreads();
}

struct Args {
    const float* in[33];
    float* out; unsigned char* ws;
    int ph_lo, ph_hi;
};
enum { I_X = 0, I_MEM, I_WIN, I_GLACONV, I_GLAW2, I_GLAB, I_GLANG, I_HGLB, I_HGNG, I_RWMU, I_RWW0, I_RWW2, I_RWA0, I_RWA2, I_RWG2, I_RWKK, I_RWKA, I_RWRK, I_RWLNW, I_RWLNB,
       I_WMK, I_WMV, I_WOUT, I_LN1G, I_LN1B, I_RTW, I_RTB, I_WGU, I_BGU, I_WDN, I_BDN, I_LN2G, I_LN2B };


template <int OFF> __device__ __forceinline__ unsigned long long ka_u64() { unsigned long long v; asm volatile("s_load_dwordx2 %0, %1, %2\n\ts_waitcnt lgkmcnt(0)" : "=s"(v) : "s"(__builtin_amdgcn_kernarg_segment_ptr()), "n"(OFF)); return v; }
#define KIN(i) ((const float*)(const GAS float*)ka_u64<8 * (i)>())
#define KOUT() ((float*)(GAS float*)ka_u64<264>())
#define KWS() ((unsigned char*)(GAS unsigned char*)ka_u64<272>())

template <class Map>
__device__ __forceinline__ void tr_item(const float* __restrict__ W, int K, int N, bf16* __restrict__ WT, LAS float* scr, int kb, int nb, int lane, Map map) {
    const int k0 = 64 * kb, n0 = 64 * nb, col = n0 + lane; const bool valid = col < N;
    const float* src = W + (size_t)k0 * N + (valid ? col : 0);
#pragma unroll 64
    for (int kk = 0; kk < 64; ++kk) { const float v = valid ? src[(size_t)kk * N] : 0.f; scr[kk * 65 + lane] = v; }
    LDS_WAIT(); asm volatile("" ::: "memory");
    const int c = lane & 7;
#pragma unroll
    for (int j = 0; j < 8; ++j) { const int n = (lane >> 3) + 8 * j;
        if (n0 + n < N) { const int orow = map(n0 + n); const LAS float* s = scr + (8 * c) * 65 + n;
            u32x4 o; o.x = pk2(s[0 * 65], s[1 * 65]); o.y = pk2(s[2 * 65], s[3 * 65]); o.z = pk2(s[4 * 65], s[5 * 65]); o.w = pk2(s[6 * 65], s[7 * 65]);
            *(u32x4*)(WT + (size_t)orow * K + k0 + 8 * c) = o; } }
    LDS_WAIT(); asm volatile("" ::: "memory");
}
template <bool GUARD = false, class Map>
__device__ __forceinline__ void tr_item_f8(const float* __restrict__ W, int K, int N, unsigned char* __restrict__ WT8, LAS float* scr, int kb, int nb, int lane, float scale, Map map) {
    const int k0 = 64 * kb, n0 = 64 * nb, col = (GUARD && n0 + lane >= N) ? N - 1 : n0 + lane;
    const float* src = W + (size_t)k0 * N + col;
#pragma unroll 64
    for (int kk = 0; kk < 64; ++kk) scr[kk * 65 + lane] = src[(size_t)kk * N] * scale;
    LDS_WAIT(); asm volatile("" ::: "memory");
    const int c = lane & 3;
#pragma unroll
    for (int j = 0; j < 4; ++j) { const int n = (lane >> 2) + 16 * j; const LAS float* s = scr + (16 * c) * 65 + n;
        u32x4 o;
#pragma unroll
        for (int q = 0; q < 4; ++q) { int w = __builtin_amdgcn_cvt_pk_fp8_f32(s[(4 * q) * 65], s[(4 * q + 1) * 65], 0, false); w = __builtin_amdgcn_cvt_pk_fp8_f32(s[(4 * q + 2) * 65], s[(4 * q + 3) * 65], w, true); o[q] = (unsigned)w; }
        if (!GUARD || n0 + n < N) { const int orow = map(n0 + n); *(u32x4*)(WT8 + (size_t)orow * K + k0 + 16 * c) = o; } }
    LDS_WAIT(); asm volatile("" ::: "memory");
}
struct MapIdent { int off; __device__ __forceinline__ int operator()(int c) const { return c + off; } };
struct MapWin { __device__ __forceinline__ int operator()(int c) const { return c < 512 ? c : (c < 528 ? c + 2560 : c - 16); } };
__device__ __forceinline__ int gu_row(int c) { const int f = c >> 1, bj = c & 1, pn = f >> 7, fl = f & 127, wc = fl >> 5, fq = (fl >> 3) & 3, n = (fl >> 2) & 1, j = fl & 3; return 256 * pn + 128 * bj + 32 * wc + 16 * n + 4 * fq + j; }
struct MapGu { __device__ __forceinline__ int operator()(int c) const { return gu_row(c); } };

__device__ __forceinline__ void prologue_phase(LAS unsigned char* lds, int vcu, int G) {
    const int tid = opaque_tid(), lane = tid & 63, wave = __builtin_amdgcn_readfirstlane(tid >> 6);
    LAS float* scr = (LAS float*)(lds + wave * 16640); static_assert(8 * 16640 <= LDSCTL_OFF, "prologue scratch below the LDS control words");
    const int gw = vcu * NWAVES + wave, NGW = G * NWAVES;
    unsigned char* ws = KWS();
    constexpr int IT_GU = NL * NE * 512, IT_DN = NL * NE * 256, IT_IN = NL * 16 * 49, IT_OUT = NL * 256, IT_MEM = NL * 2 * 64, IT_L64 = NL * 2 * 4, IT_L128 = NL * 2 * 4;
    constexpr int IT_TOTAL = IT_GU + IT_DN + IT_IN + IT_OUT + IT_MEM + IT_L64 + IT_L128;
    for (int it = gw; it < IT_TOTAL; it += NGW) {
        int r = it;
        if (r < IT_GU) { const int le = r >> 9, q = r & 511, kb = q >> 5, nb = q & 31;
            tr_item_f8(KIN(I_WGU) + (size_t)le * 1024 * 2048, 1024, 2048, (unsigned char*)(ws + WS_WGU) + (size_t)le * 2048 * 1024, scr, kb, nb, lane, 16.0f, MapGu{}); continue; } r -= IT_GU;
        if (r < IT_DN) { const int le = r >> 8, q = r & 255, kb = q >> 4, nb = q & 15;
            tr_item_f8(KIN(I_WDN) + (size_t)le * 1024 * 1024, 1024, 1024, (unsigned char*)(ws + WS_WD) + (size_t)le * 1024 * 1024, scr, kb, nb, lane, 32.0f, MapIdent{0}); continue; } r -= IT_DN;
        if (r < IT_IN) { const int l = r / (16 * 49), q = r % (16 * 49), kb = q / 49, nb = q % 49;
            tr_item_f8<true>(KIN(I_WIN) + (size_t)l * 1024 * PIN, 1024, PIN, (unsigned char*)(ws + WS_WIN) + (size_t)l * PINP * 1024, scr, kb, nb, lane, 16.0f, MapWin{}); continue; } r -= IT_IN;
        if (r < IT_OUT) { const int l = r >> 8, q = r & 255, kb = q >> 4, nb = q & 15;
            tr_item_f8(KIN(I_WOUT) + (size_t)l * 1024 * 1024, 1024, 1024, (unsigned char*)(ws + WS_WOUT) + (size_t)l * 1024 * 1024, scr, kb, nb, lane, 32.0f, MapIdent{0}); continue; } r -= IT_OUT;
        if (r < IT_MEM) { const int l = r >> 7, q = r & 127, kv = q >> 6, kb = (q >> 2) & 15, nb = q & 3;
            tr_item((kv ? KIN(I_WMV) : KIN(I_WMK)) + (size_t)l * 1024 * 256, 1024, 256, (bf16*)(ws + WS_WMEM), scr, kb, nb, lane, MapIdent{l * 512 + kv * 256}); continue; } r -= IT_MEM;
        if (r < IT_L64) { const int l = r >> 3, q = r & 7, wa = q >> 2, nb = q & 3;
            tr_item((wa ? KIN(I_RWA2) : KIN(I_RWW2)) + (size_t)l * 64 * 256, 64, 256, (bf16*)(ws + WS_LORA) + (size_t)wa * (NL * 256 * 64) + (size_t)l * 256 * 64, scr, 0, nb, lane, MapIdent{0}); continue; } r -= IT_L64;
        { const int l = r >> 3, q = r & 7, kb = q >> 2, nb = q & 3;
            tr_item(KIN(I_RWG2) + (size_t)l * 128 * 256, 128, 256, (bf16*)(ws + WS_LORA) + (size_t)2 * (NL * 256 * 64) + (size_t)l * 256 * 128, scr, kb, nb, lane, MapIdent{0}); }
    }
    { const size_t gt = (size_t)vcu * NTHR + tid, GT = (size_t)G * NTHR; constexpr size_t per = (size_t)(PINP - PIN) * 1024 / 16;
        for (size_t i = gt; i < per * NL; i += GT) { const size_t l = i / per, j = i % per; *(u32x4*)((unsigned char*)(ws + WS_WIN) + l * PINP * 1024 + (size_t)PIN * 1024 + j * 16) = (u32x4){0u, 0u, 0u, 0u}; }
        for (size_t i = gt; i < (size_t)NL * 8192; i += GT) { const int l = (int)(i >> 13), q = (int)(i >> 6) & 127, ln = (int)i & 63, jj = q >> 4, c = q & 15, k0 = 4 * (ln + 64 * (jj >> 1)) + 2 * (jj & 1);
            const float* s = KIN(I_WIN) + (size_t)l * 1024 * PIN + (size_t)k0 * PIN + 512 + c; ((unsigned*)(ws + WS_GLRW))[i] = pk2(s[0], s[PIN]); }
        for (size_t i = gt; i < (size_t)NL * NE * 2048; i += GT) { const size_t le = i >> 11; const int c = (int)(i & 2047); ((float*)(ws + WS_BGU))[le * 2048 + gu_row(c)] = KIN(I_BGU)[i]; }
        const f32x4* xs = (const f32x4*)KIN(I_X); unsigned char* xd8 = (unsigned char*)(ws + WS_X8);
        for (size_t i = gt; i < (size_t)NTOK * D / 8; i += GT) { const f32x4 v0 = xs[2 * i], v1 = xs[2 * i + 1]; store_o4(xd8 + 8 * i, v0[0], v0[1], v0[2], v0[3]); store_o4(xd8 + 8 * i + 4, v1[0], v1[1], v1[2], v1[3]); }
        const f32x4* ms = (const f32x4*)KIN(I_MEM); u32x4* md = (u32x4*)(ws + WS_MEMB);
        for (size_t i = gt; i < (size_t)NB * NMEM * D / 8; i += GT) { const f32x4 v0 = ms[2 * i], v1 = ms[2 * i + 1]; md[i] = (u32x4){pk2(v0[0], v0[1]), pk2(v0[2], v0[3]), pk2(v1[0], v1[1]), pk2(v1[2], v1[3])}; }
    }
}


__device__ __forceinline__ float log1pexp_neg_abs(float z) { return __builtin_amdgcn_logf(1.0f + fast_exp(-fabsf(z))) * 0.6931471805599453f; }
__device__ __forceinline__ float tanh_f(float x) { const float e = fast_exp(-2.0f * fabsf(x)); const float t = (1.0f - e) * __builtin_amdgcn_rcpf(1.0f + e); return x < 0.f ? -t : t; }

constexpr int NCH = T / 32;
__device__ __forceinline__ int rho16(int r, int hh) { return (r & 3) + 8 * (r >> 2) + 4 * hh; }
__device__ __forceinline__ void hg_fused_unit(LAS unsigned char* lds, int l, int b, int c) {
    const int tid = opaque_tid(), lane = tid & 63, wave = __builtin_amdgcn_readfirstlane(tid >> 6), r32 = lane & 31, hh = lane >> 5;
    unsigned char* ws = KWS();
    const bf16* P = (const bf16*)(ws + WS_P) + ((size_t)b * T + c * 32) * PINP;
    constexpr int HB = 16640;
    if (tid < 256) {
        const int ch = tid, h = ch >> 6, d = ch & 63; const size_t un = (size_t)(b * 4 + h) * NCH + c;
        const float* hp = KIN(I_HGLB) + ch; const float v0 = hp[0], v1 = hp[256], v2 = hp[512], v3 = hp[768];
        unsigned short hqr[32], hfr[32];
#pragma unroll
        for (int t = 0; t < 32; ++t) { const bf16* row = P + (size_t)t * PINP; hqr[t] = row[PC_HQ + ch]; hfr[t] = row[PC_HF + ch]; }
        __builtin_amdgcn_sched_barrier(0);
        float lb;
        { const float m = fmaxf(fmaxf(v0, v1), fmaxf(v2, v3));
          const float e0 = __expf(v0 - m), e1 = __expf(v1 - m), e2 = __expf(v2 - m), e3 = __expf(v3 - m); const float inv = 1.0f / (e0 + e1 + e2 + e3);
          lb = (l >= 1 ? e1 : 0.f) + (l >= 2 ? e2 : 0.f) + (l >= 3 ? e3 : 0.f); lb *= inv; }
        const float oml = 1.0f - lb;
        LAS bf16* KT = (LAS bf16*)(lds + h * HB); LAS float* BE = (LAS float*)(lds + h * HB + 8192);
        LAS bf16* QL = (LAS bf16*)(lds + h * HB + 8448) + d; LAS bf16* KL = (LAS bf16*)(lds + h * HB + 12544) + d;
        float bc = 1.0f;
#pragma unroll
        for (int t8 = 0; t8 < 4; ++t8) { u32x4 kp;
#pragma unroll
            for (int jj = 0; jj < 4; ++jj) { float k2[2];
#pragma unroll
                for (int e = 0; e < 2; ++e) { const int t = t8 * 8 + jj * 2 + e; const float hf = bf2f(hfr[t]); const float eh_ = fast_exp(fminf(-hf, 80.0f)); const float s = __builtin_amdgcn_rcpf(1.0f + eh_), sn = eh_ * s;
                    bc = fmaxf(bc * fmaxf(lb + oml * s, 1e-30f), 1.8048513878454153e-35f);
                    const float qt = silu_f(bf2f(hqr[t])) * bc, kt = oml * sn * __builtin_amdgcn_rcpf(bc);
                    QL[t * 64] = (bf16)f2bf(qt); KL[t * 64] = (bf16)f2bf(kt); k2[e] = kt; }
                kp[jj] = pk2(k2[0], k2[1]); }
            *(LAS u32x4*)(KT + d * 32 + t8 * 8) = kp; }
        const float ebend = bc; BE[d] = ebend; ((float*)(ws + WS_HBE))[un * 64 + d] = ebend;
    } else {
        const int cv = tid - 256, h = cv >> 6, vi = cv & 63; const size_t un = (size_t)(b * 4 + h) * NCH + c;
        LAS bf16* VT = (LAS bf16*)(lds + h * HB + 4096); bf16* VTg = (bf16*)(ws + WS_HVT) + un * 2048 + vi * 32;
        unsigned short hvr[32];
#pragma unroll
        for (int t = 0; t < 32; ++t) hvr[t] = P[(size_t)t * PINP + PC_HI + cv];
        __builtin_amdgcn_sched_barrier(0);
#pragma unroll
        for (int t8 = 0; t8 < 4; ++t8) { u32x4 vp;
#pragma unroll
            for (int jj = 0; jj < 4; ++jj) vp[jj] = (unsigned)hvr[t8 * 8 + 2 * jj] | ((unsigned)hvr[t8 * 8 + 2 * jj + 1] << 16);
            *(LAS u32x4*)(VT + vi * 32 + t8 * 8) = vp; *(u32x4*)(VTg + t8 * 8) = vp; }
    }
    lds_barrier();
    { const int h = wave >> 1, vt = wave & 1; const size_t un = (size_t)(b * 4 + h) * NCH + c;
      const LAS bf16* KT = (const LAS bf16*)(lds + h * HB); const LAS bf16* VT = (const LAS bf16*)(lds + h * HB + 4096); const LAS float* BE = (const LAS float*)(lds + h * HB + 8192);
      bf16* DSg = (bf16*)(ws + WS_HDS) + un * 4096;
      { const LAS bf16* srcL = (const LAS bf16*)(lds + h * HB + (vt == 0 ? 8448 : 12544)); u32x4* dstG = (u32x4*)((bf16*)(ws + (vt == 0 ? WS_HQ : WS_HK)) + un * 2048);
#pragma unroll
        for (int i = 0; i < 4; ++i) dstG[i * 64 + lane] = *(const LAS u32x4*)(srcL + (i * 64 + lane) * 8); }
#pragma unroll
      for (int dt = 0; dt < 2; ++dt) { f32x16 acc;
#pragma unroll
          for (int i = 0; i < 16; ++i) acc[i] = 0.f;
#pragma unroll
          for (int s = 0; s < 2; ++s) { const bf16x8 A = *(const LAS bf16x8*)(VT + (32 * vt + r32) * 32 + 16 * s + 8 * hh), B = *(const LAS bf16x8*)(KT + (32 * dt + r32) * 32 + 16 * s + 8 * hh);
              acc = __builtin_amdgcn_mfma_f32_32x32x16_bf16(A, B, acc, 0, 0, 0); }
          const float ebd = BE[32 * dt + r32];
#pragma unroll
          for (int r = 0; r < 16; ++r) DSg[(32 * vt + rho16(r, hh)) * 64 + 32 * dt + r32] = (bf16)f2bf(acc[r] * ebd); } }
    lds_barrier();
}
__device__ __forceinline__ void gla_fused_unit(LAS unsigned char* lds, int l, int b, int c) {
    const int tid = opaque_tid(), lane = tid & 63, wave = __builtin_amdgcn_readfirstlane(tid >> 6), r32 = lane & 31, hh = lane >> 5;
    unsigned char* ws = KWS();
    const int t0 = c * 32;
    const bf16* P = (const bf16*)(ws + WS_P) + ((size_t)b * T + t0) * PINP;
    LAS float* GL = (LAS float*)lds;
    constexpr int HB = 10368, H0 = 2048;
    const unsigned short glr = P[(size_t)(tid >> 4) * PINP + PC_GLR + (tid & 15)];
    unsigned short xra[32], xrb[32], hra[3], hrb[3]; float cwv[8], wc[16], gb = 0.f;
    const long hb = t0 > 0 ? 1 : 0;
    if (tid < 128) { const int ch = tid;
        const float* cw = KIN(I_GLACONV) + (size_t)l * 4 * 512 + ch;
        cwv[0] = cw[0]; cwv[1] = cw[512]; cwv[2] = cw[1024]; cwv[3] = cw[1536]; cwv[4] = cw[128]; cwv[5] = cw[640]; cwv[6] = cw[1152]; cwv[7] = cw[1664];
        const float* w2p = KIN(I_GLAW2) + (size_t)l * 16 * 128 + ch;
#pragma unroll
        for (int r = 0; r < 16; ++r) wc[r] = w2p[r * 128];
        gb = KIN(I_GLAB)[l * 128 + ch];
#pragma unroll
        for (int j = 0; j < 3; ++j) { const bf16* hrow = P - hb * (3 - j) * PINP; hra[j] = hrow[PC_GQ + ch]; hrb[j] = hrow[PC_GK + ch]; }
#pragma unroll
        for (int t = 0; t < 32; ++t) { const bf16* row = P + (size_t)t * PINP; xra[t] = row[PC_GQ + ch]; xrb[t] = row[PC_GK + ch]; }
    } else if (tid < 384) { const int cv = tid - 128;
        const float* cw = KIN(I_GLACONV) + (size_t)l * 4 * 512 + 256 + cv;
        cwv[0] = cw[0]; cwv[1] = cw[512]; cwv[2] = cw[1024]; cwv[3] = cw[1536];
#pragma unroll
        for (int j = 0; j < 3; ++j) hra[j] = (P - hb * (3 - j) * PINP)[PC_GV + cv];
#pragma unroll
        for (int t = 0; t < 32; ++t) xra[t] = P[(size_t)t * PINP + PC_GV + cv];
    }
    __builtin_amdgcn_sched_barrier(0);
    GL[tid] = bf2f(glr);
    lds_barrier();
    if (tid < 128) {
        const int ch = tid, h = ch >> 5, d = ch & 31; const size_t un = (size_t)(b * 4 + h) * NCH + c;
        const float q0 = cwv[0], q1 = cwv[1], q2 = cwv[2], q3 = cwv[3], k0 = cwv[4], k1 = cwv[5], k2w = cwv[6], k3 = cwv[7];
        float uq0 = hb ? bf2f(hra[0]) : 0.f, uq1 = hb ? bf2f(hra[1]) : 0.f, uq2 = hb ? bf2f(hra[2]) : 0.f, uk0 = hb ? bf2f(hrb[0]) : 0.f, uk1 = hb ? bf2f(hrb[1]) : 0.f, uk2 = hb ? bf2f(hrb[2]) : 0.f;
        LAS bf16* KT = (LAS bf16*)(lds + H0 + h * HB); LAS float* BE = (LAS float*)(lds + H0 + h * HB + 6144);
        LAS bf16* QL = (LAS bf16*)(lds + H0 + h * HB + 6272) + d; LAS bf16* KL = (LAS bf16*)(lds + H0 + h * HB + 8320) + d;
        float bc = 0.f;
#pragma unroll
        for (int t8 = 0; t8 < 4; ++t8) { u32x4 kp;
#pragma unroll
            for (int jj = 0; jj < 4; ++jj) { float kk2[2];
#pragma unroll
                for (int e = 0; e < 2; ++e) { const int t = t8 * 8 + jj * 2 + e; const float uq3 = bf2f(xra[t]), uk3 = bf2f(xrb[t]);
                    const float q = silu_f(q0 * uq0 + q1 * uq1 + q2 * uq2 + q3 * uq3) * 0.17677669529663687f, k = silu_f(k0 * uk0 + k1 * uk1 + k2w * uk2 + k3 * uk3);
                    uq0 = uq1; uq1 = uq2; uq2 = uq3; uk0 = uk1; uk1 = uk2; uk2 = uk3;
                    float z = gb;
#pragma unroll
                    for (int r = 0; r < 16; ++r) z += GL[t * 16 + r] * wc[r];
                    bc = fmaxf(bc + (fminf(z, 0.f) - log1pexp_neg_abs(z)) * 0.0625f, -80.0f);
                    const float qt = q * fast_exp(bc), kt = k * fast_exp(-bc);
                    QL[t * 32] = (bf16)f2bf(qt); KL[t * 32] = (bf16)f2bf(kt); kk2[e] = kt; }
                kp[jj] = pk2(kk2[0], kk2[1]); }
            *(LAS u32x4*)(KT + d * 32 + t8 * 8) = kp; }
        const float ebend = fast_exp(bc); BE[d] = ebend; ((float*)(ws + WS_GBE))[un * 32 + d] = ebend;
    } else if (tid < 384) {
        const int cv = tid - 128, h = cv >> 6, vi = cv & 63; const size_t un = (size_t)(b * 4 + h) * NCH + c;
        const float w0 = cwv[0], w1 = cwv[1], w2 = cwv[2], w3 = cwv[3];
        float u0 = hb ? bf2f(hra[0]) : 0.f, u1 = hb ? bf2f(hra[1]) : 0.f, u2 = hb ? bf2f(hra[2]) : 0.f;
        LAS bf16* VT = (LAS bf16*)(lds + H0 + h * HB + 2048); bf16* VTg = (bf16*)(ws + WS_GVT) + un * 2048 + vi * 32;
#pragma unroll
        for (int t8 = 0; t8 < 4; ++t8) { u32x4 vp; float yv[8];
#pragma unroll
            for (int e = 0; e < 8; ++e) { const float u3 = bf2f(xra[t8 * 8 + e]); yv[e] = silu_f(w0 * u0 + w1 * u1 + w2 * u2 + w3 * u3); u0 = u1; u1 = u2; u2 = u3; }
#pragma unroll
            for (int jj = 0; jj < 4; ++jj) vp[jj] = pk2(yv[2 * jj], yv[2 * jj + 1]);
            *(LAS u32x4*)(VT + vi * 32 + t8 * 8) = vp; *(u32x4*)(VTg + t8 * 8) = vp; }
    }
    lds_barrier();
    { const int h = wave >> 1, vt = wave & 1; const size_t un = (size_t)(b * 4 + h) * NCH + c;
      const LAS bf16* KT = (const LAS bf16*)(lds + H0 + h * HB); const LAS bf16* VT = (const LAS bf16*)(lds + H0 + h * HB + 2048); const LAS float* BE = (const LAS float*)(lds + H0 + h * HB + 6144);
      bf16* DSg = (bf16*)(ws + WS_GDS) + un * 2048;
      { const LAS bf16* srcL = (const LAS bf16*)(lds + H0 + h * HB + (vt == 0 ? 6272 : 8320)); u32x4* dstG = (u32x4*)((bf16*)(ws + (vt == 0 ? WS_GQ : WS_GK)) + un * 1024);
#pragma unroll
        for (int i = 0; i < 2; ++i) dstG[i * 64 + lane] = *(const LAS u32x4*)(srcL + (i * 64 + lane) * 8); }
      f32x16 acc;
#pragma unroll
      for (int i = 0; i < 16; ++i) acc[i] = 0.f;
#pragma unroll
      for (int s = 0; s < 2; ++s) { const bf16x8 A = *(const LAS bf16x8*)(VT + (32 * vt + r32) * 32 + 16 * s + 8 * hh), B = *(const LAS bf16x8*)(KT + r32 * 32 + 16 * s + 8 * hh);
          acc = __builtin_amdgcn_mfma_f32_32x32x16_bf16(A, B, acc, 0, 0, 0); }
      const float ebd = BE[r32];
#pragma unroll
      for (int r = 0; r < 16; ++r) DSg[(32 * vt + rho16(r, hh)) * 32 + r32] = (bf16)f2bf(acc[r] * ebd); }
    lds_barrier();
}
template <int DK>
__device__ __forceinline__ void m2_gh_elem2(int e2, const bf16* __restrict__ DS, const float* __restrict__ BE, bf16* __restrict__ SG) {
    constexpr int EPB = 64 * DK; const int e = e2 * 2, bh = e / EPB, idx = e % EPB, d = idx % DK; const size_t un0 = (size_t)bh * NCH;
    float S0 = 0.f, S1 = 0.f;
#pragma unroll 1
    for (int c0 = 0; c0 < NCH; c0 += 16) { unsigned ds[16]; f32x2 be[16];
#pragma unroll
        for (int u = 0; u < 16; ++u) { ds[u] = *(const unsigned*)(DS + (un0 + c0 + u) * EPB + idx); be[u] = *(const f32x2*)(BE + (un0 + c0 + u) * DK + d); }
#pragma unroll
        for (int u = 0; u < 16; ++u) { *(unsigned*)(SG + (un0 + c0 + u) * EPB + idx) = pk2(S0, S1); S0 = S0 * be[u][0] + bflo(ds[u]); S1 = S1 * be[u][1] + bfhi(ds[u]); } }
}
template <int DK>
__device__ __forceinline__ void m3_gh_task(int lane, const bf16* __restrict__ Qg, const bf16* __restrict__ Kg, const bf16* __restrict__ VTg, const bf16* __restrict__ Sg,
                                           const bf16* __restrict__ gate  , const float* __restrict__ ng  , unsigned char* __restrict__ orow  ) {
    const int r32 = lane & 31, hh = lane >> 5;
    bf16x8 qf[DK / 16];
    f32x16 at;
#pragma unroll
    for (int i = 0; i < 16; ++i) at[i] = 0.f;
#pragma unroll
    for (int s = 0; s < DK / 16; ++s) { qf[s] = *(const bf16x8*)(Qg + r32 * DK + 16 * s + 8 * hh); const bf16x8 kf = *(const bf16x8*)(Kg + r32 * DK + 16 * s + 8 * hh);
        at = __builtin_amdgcn_mfma_f32_32x32x16_bf16(kf, qf[s], at, 0, 0, 0); }
#pragma unroll
    for (int r = 0; r < 16; ++r) if (rho16(r, hh) > r32) at[r] = 0.f;
    f32x16 o[2];
#pragma unroll
    for (int vt = 0; vt < 2; ++vt)
#pragma unroll
        for (int i = 0; i < 16; ++i) o[vt][i] = 0.f;
#pragma unroll
    for (int s = 0; s < 2; ++s) { union { bf16x8 v; unsigned w[4]; } pf;
#pragma unroll
        for (int j = 0; j < 4; ++j) pf.w[j] = cvt_pk_bf16(at[8 * s + 2 * j], at[8 * s + 2 * j + 1]);
#pragma unroll
        for (int vt = 0; vt < 2; ++vt) { const bf16* vp = VTg + (32 * vt + r32) * 32 + 16 * s + 4 * hh;
            union { bf16x8 v; s16x4 h2[2]; } vf; vf.h2[0] = *(const s16x4*)vp; vf.h2[1] = *(const s16x4*)(vp + 8);
            o[vt] = __builtin_amdgcn_mfma_f32_32x32x16_bf16(vf.v, pf.v, o[vt], 0, 0, 0); } }
#pragma unroll
    for (int vt = 0; vt < 2; ++vt)
#pragma unroll
        for (int s = 0; s < DK / 16; ++s) { const bf16x8 sf = *(const bf16x8*)(Sg + (32 * vt + r32) * DK + 16 * s + 8 * hh);
            o[vt] = __builtin_amdgcn_mfma_f32_32x32x16_bf16(sf, qf[s], o[vt], 0, 0, 0); }
    float ss = 0.f;
#pragma unroll
    for (int vt = 0; vt < 2; ++vt)
#pragma unroll
        for (int i = 0; i < 16; ++i) ss += o[vt][i] * o[vt][i];
    ss += __shfl_xor(ss, 32);
    const float rstd = 1.0f / sqrtf(ss * (1.0f / 64.0f) + RMS_EPS);
    const bf16* grow = gate + (size_t)r32 * PINP; unsigned char* od = orow + (size_t)r32 * D;
#pragma unroll
    for (int vt = 0; vt < 2; ++vt)
#pragma unroll
        for (int g = 0; g < 4; ++g) { const int v0 = 32 * vt + 8 * g + 4 * hh; const u32x2 gw = *(const u32x2*)(grow + v0); const f32x4 n4 = *(const f32x4*)(ng + v0);
            const float y0 = o[vt][4 * g] * rstd * n4[0] * silu_f(bflo(gw.x)), y1 = o[vt][4 * g + 1] * rstd * n4[1] * silu_f(bfhi(gw.x));
            const float y2 = o[vt][4 * g + 2] * rstd * n4[2] * silu_f(bflo(gw.y)), y3 = o[vt][4 * g + 3] * rstd * n4[3] * silu_f(bfhi(gw.y));
            store_o4(od + v0, y0, y1, y2, y3); }
}

constexpr int RWC_HEADB = 28928;
constexpr int RWC_AL = 4 * RWC_HEADB, RWC_LWL = RWC_AL + 32 * 264 * 2;
static_assert(RWC_LWL + 32 * 264 * 2 <= LDSCTL_OFF, "rw_fused_unit LDS");
__device__ __forceinline__ void rw_fused_unit(LAS unsigned char* lds, int l, int b, int c) {
    const int tid = opaque_tid(), lane = tid & 63, wave = __builtin_amdgcn_readfirstlane(tid >> 6), h = wave >> 1, p = wave & 1, r32 = lane & 31, hh = lane >> 5;
    unsigned char* ws = KWS();
    const int bh = b * 4 + h; const size_t un = (size_t)bh * NCH + c;
    const int t0 = c * 32;
    const bf16* P = (const bf16*)(ws + WS_P) + ((size_t)b * T + t0) * PINP + PC_RW;
    const float* mu = KIN(I_RWMU) + (size_t)l * 1024;
    LAS bf16* XL = (LAS bf16*)lds;
    LAS bf16* AL = (LAS bf16*)(lds + RWC_AL);
    LAS bf16* LWL = (LAS bf16*)(lds + RWC_LWL);
    bf16x8 bwW[4], bwA[4], bwG[8]; float w0c, a0c;
    { const int ch = wave * 32 + r32;
      const bf16* w2T = (const bf16*)(ws + WS_LORA) + (size_t)l * 256 * 64 + (size_t)ch * 64 + 8 * hh;
      const bf16* a2T = (const bf16*)(ws + WS_LORA) + (size_t)(NL * 256 * 64) + (size_t)l * 256 * 64 + (size_t)ch * 64 + 8 * hh;
      const bf16* g2T = (const bf16*)(ws + WS_LORA) + (size_t)2 * (NL * 256 * 64) + (size_t)l * 256 * 128 + (size_t)ch * 128 + 8 * hh;
#pragma unroll
      for (int s = 0; s < 4; ++s) { bwW[s] = *(const bf16x8*)(w2T + 16 * s); bwA[s] = *(const bf16x8*)(a2T + 16 * s); }
#pragma unroll
      for (int s = 0; s < 8; ++s) bwG[s] = *(const bf16x8*)(g2T + 16 * s);
      w0c = KIN(I_RWW0)[l * 256 + ch]; a0c = KIN(I_RWA0)[l * 256 + ch]; }
    { const int cc = tid & 255, tp = tid >> 8; const float mc = mu[768 + cc];
      unsigned short xr[17];
#pragma unroll
      for (int j = 0; j < 17; ++j) { const int tk = tp * 16 + j - 1;
          if (j == 0) { const bool ok = (t0 + tk >= 0); const unsigned short v = P[(long)(ok ? tk : 0) * PINP + 768 + cc]; xr[0] = ok ? v : (unsigned short)0; }
          else xr[j] = P[(long)tk * PINP + 768 + cc]; }
#pragma unroll
      for (int j = 0; j < 16; ++j) { const float cur = bf2f(xr[j + 1]), prev = bf2f(xr[j]);
          float x = cur + (prev - cur) * mc;
          if (cc < 64) x = tanh_f(x); else if (cc >= 128) x = fast_sigmoid(x);
          XL[(tp * 16 + j) * 264 + cc] = (bf16)f2bf(x); } }
    lds_barrier();
    float mr, mk, mv, kkc, kac, rkc; unsigned short xrr[17], xkr[17], xvr[17];
    { const int ch = (wave & 3) * 64 + lane, tb = (wave >> 2) * 16;
      mr = mu[ch]; mk = mu[256 + ch]; mv = mu[512 + ch]; kkc = KIN(I_RWKK)[l * 256 + ch]; kac = KIN(I_RWKA)[l * 256 + ch]; rkc = KIN(I_RWRK)[l * 256 + ch];
#pragma unroll
      for (int j = 0; j < 17; ++j) { const int tk = tb + j - 1;
          if (j == 0) { const bool ok = (t0 + tk >= 0); const bf16* row = P + (long)(ok ? tk : 0) * PINP; const unsigned short v0 = row[ch], v1 = row[256 + ch], v2 = row[512 + ch];
              xrr[0] = ok ? v0 : (unsigned short)0; xkr[0] = ok ? v1 : (unsigned short)0; xvr[0] = ok ? v2 : (unsigned short)0; }
          else { const bf16* row = P + (long)tk * PINP; xrr[j] = row[ch]; xkr[j] = row[256 + ch]; xvr[j] = row[512 + ch]; } }
      __builtin_amdgcn_sched_barrier(0); }
    {
        const int ch = wave * 32 + r32;
        const LAS bf16* xa = XL + r32 * 264 + 8 * hh;
        {
            f32x16 acc;
#pragma unroll
            for (int i = 0; i < 16; ++i) acc[i] = 0.f;
#pragma unroll
            for (int s = 0; s < 4; ++s) { const bf16x8 A = *(const LAS bf16x8*)(xa + 16 * s);
                acc = __builtin_amdgcn_mfma_f32_32x32x16_bf16(A, bwW[s], acc, 0, 0, 0); }
#pragma unroll
            for (int r = 0; r < 16; ++r) { const int tok = rho16(r, hh);
                const float zw = w0c + acc[r];
                LWL[tok * 264 + ch] = (bf16)f2bf(-0.6065306597126334f * fast_sigmoid(zw)); }
        }
        __builtin_amdgcn_sched_barrier(0);
        {
            f32x16 acc;
#pragma unroll
            for (int i = 0; i < 16; ++i) acc[i] = 0.f;
#pragma unroll
            for (int s = 0; s < 4; ++s) { const bf16x8 A = *(const LAS bf16x8*)(xa + 64 + 16 * s);
                acc = __builtin_amdgcn_mfma_f32_32x32x16_bf16(A, bwA[s], acc, 0, 0, 0); }
#pragma unroll
            for (int r = 0; r < 16; ++r) AL[rho16(r, hh) * 264 + ch] = (bf16)f2bf(fast_sigmoid(a0c + acc[r]));
        }
        __builtin_amdgcn_sched_barrier(0);
        {
            f32x16 acc;
#pragma unroll
            for (int i = 0; i < 16; ++i) acc[i] = 0.f;
#pragma unroll
            for (int s = 0; s < 8; ++s) { const bf16x8 A = *(const LAS bf16x8*)(xa + 128 + 16 * s);
                acc = __builtin_amdgcn_mfma_f32_32x32x16_bf16(A, bwG[s], acc, 0, 0, 0); }
            bf16* gb = (bf16*)(ws + WS_GBUF) + ((size_t)b * T + t0) * 256 + ch;
#pragma unroll
            for (int r = 0; r < 16; ++r) gb[(size_t)rho16(r, hh) * 256] = (bf16)f2bf(acc[r]);
        }
    }
    lds_barrier();
    LAS unsigned char* L = lds + h * RWC_HEADB;
    LAS bf16* AT = (LAS bf16*)L;
    LAS bf16* BT = (LAS bf16*)(L + 4096);
    LAS bf16* KT = (LAS bf16*)(L + 8192);
    LAS bf16* ATT = (LAS bf16*)(L + 12288);
    LAS bf16* BHT = (LAS bf16*)(L + 16384);
    LAS bf16* KHT = (LAS bf16*)(L + 20480);
    LAS bf16* VT = (LAS bf16*)(L + 24576);
    LAS float* GC = (LAS float*)(L + 28672);
    LAS float* MAB = (LAS float*)(L + 4096);
    LAS bf16* MAK = (LAS bf16*)(L + 8192);
    LAS bf16* TM = (LAS bf16*)L;
    {
        const int hs = wave & 3, half = wave >> 2, d = lane, ch = hs * 64 + d, tb = half * 16; const size_t uns = (size_t)(b * 4 + hs) * NCH + c;
        LAS unsigned char* Ls = lds + hs * RWC_HEADB;
        LAS bf16* sAT = (LAS bf16*)Ls; LAS bf16* sBT = (LAS bf16*)(Ls + 4096); LAS bf16* sKT = (LAS bf16*)(Ls + 8192);
        LAS bf16* sATT = (LAS bf16*)(Ls + 12288); LAS bf16* sBHT = (LAS bf16*)(Ls + 16384); LAS bf16* sKHT = (LAS bf16*)(Ls + 20480); LAS bf16* sVT = (LAS bf16*)(Ls + 24576); LAS float* sGC = (LAS float*)(Ls + 28672);
        float lg0 = 0.f, lg1 = 0.f;
#pragma unroll
        for (int t = 0; t < 16; ++t) { lg0 += bf2f(LWL[t * 264 + ch]); lg1 += bf2f(LWL[(16 + t) * 264 + ch]); }
        const float lgend = lg0 + lg1;
        lds_barrier();
        float* bonp = (float*)(ws + WS_BONUS) + ((size_t)b * T + t0) * 4 + hs;
        float lg = half ? lg0 : 0.f; float elg = fast_exp(lg); const float eend = fast_exp(lgend);
#pragma unroll
        for (int t8 = 0; t8 < 2; ++t8) { u32x4 ap, bp, kp;
#pragma unroll
            for (int jj = 0; jj < 4; ++jj) { float at2[2], bh2[2], kh2[2];
#pragma unroll
                for (int e = 0; e < 2; ++e) { const int j = t8 * 8 + jj * 2 + e, t = tb + j;
                    const float rc = bf2f(xrr[j + 1]), kc = bf2f(xkr[j + 1]);
                    const float r = rc + (bf2f(xrr[j]) - rc) * mr, k = kc + (bf2f(xkr[j]) - kc) * mk;
                    const float av = bf2f(AL[t * 264 + ch]), lw = bf2f(LWL[t * 264 + ch]);
                    const float kkr = k * kkc, hk = k * (1.0f + (av - 1.0f) * kac);
                    const float ss = wave_sum(kkr * kkr); const float kk = kkr * __builtin_amdgcn_rsqf(fmaxf(ss, 1e-24f));
                    const float bon = wave_sum(r * hk * rkc);
                    const float aa = -kk, bb = kk * av;
                    const float elgp = elg; lg += lw; elg = fast_exp(lg);
                    const float ei = __builtin_amdgcn_rcpf(elg), at = aa * elgp, rt = r * elg, bt = bb * ei, kt = hk * ei, eh = eend * ei;
                    sAT[t * 64 + d] = (bf16)f2bf(at); sBT[t * 64 + d] = (bf16)f2bf(bt); sKT[t * 64 + d] = (bf16)f2bf(kt);
                    LWL[t * 264 + ch] = (bf16)f2bf(rt);
                    if (d == 0) bonp[t * 4] = bon;
                    at2[e] = at; bh2[e] = bb * eh; kh2[e] = hk * eh; }
                ap[jj] = pk2(at2[0], at2[1]); bp[jj] = pk2(bh2[0], bh2[1]); kp[jj] = pk2(kh2[0], kh2[1]); }
            *(LAS u32x4*)(sATT + d * 32 + tb + t8 * 8) = ap; *(LAS u32x4*)(sBHT + d * 32 + tb + t8 * 8) = bp; *(LAS u32x4*)(sKHT + d * 32 + tb + t8 * 8) = kp; }
        if (half == 0) sGC[d] = eend;
        bf16* VTg = (bf16*)(ws + WS_RVT) + uns * 2048 + d * 32 + tb;
#pragma unroll
        for (int t8 = 0; t8 < 2; ++t8) { u32x4 vp; float yv[8];
#pragma unroll
            for (int e = 0; e < 8; ++e) { const int j = t8 * 8 + e; const float xv = bf2f(xvr[j + 1]); yv[e] = xv + (bf2f(xvr[j]) - xv) * mv; }
#pragma unroll
            for (int jj = 0; jj < 4; ++jj) vp[jj] = pk2(yv[2 * jj], yv[2 * jj + 1]);
            *(LAS u32x4*)(sVT + d * 32 + tb + t8 * 8) = vp; *(u32x4*)(VTg + t8 * 8) = vp; }
    }
    lds_barrier();
    f32x16 accR[2];
    union { bf16x8 v; unsigned w[4]; } mfr[2];
    LAS u32x4* EX = (LAS u32x4*)(lds + RWC_AL + h * 2048);
    {
        f32x16 acc, acc2;
#pragma unroll
        for (int i = 0; i < 16; ++i) { acc[i] = 0.f; acc2[i] = 0.f; }
        const LAS bf16* Bsrc = p == 0 ? BT : KT;
#pragma unroll
        for (int s = 0; s < 4; ++s) { const bf16x8 A = *(const LAS bf16x8*)(AT + r32 * 64 + 16 * s + 8 * hh), B = *(const LAS bf16x8*)(Bsrc + r32 * 64 + 16 * s + 8 * hh);
            const bf16x8 Rf = *(const LAS bf16x8*)(LWL + r32 * 264 + h * 64 + 16 * s + 8 * hh);
            acc = __builtin_amdgcn_mfma_f32_32x32x16_bf16(A, B, acc, 0, 0, 0);
            acc2 = __builtin_amdgcn_mfma_f32_32x32x16_bf16(B, Rf, acc2, 0, 0, 0); }
#pragma unroll
        for (int r = 0; r < 16; ++r) if (rho16(r, hh) > r32) acc2[r] = 0.f;
#pragma unroll
        for (int s2 = 0; s2 < 2; ++s2) {
#pragma unroll
            for (int j = 0; j < 4; ++j) mfr[s2].w[j] = cvt_pk_bf16(acc2[8 * s2 + 2 * j], acc2[8 * s2 + 2 * j + 1]);
            if (p == 0) EX[s2 * 64 + lane] = (u32x4){mfr[s2].w[0], mfr[s2].w[1], mfr[s2].w[2], mfr[s2].w[3]}; }
        if (p == 0) {
#pragma unroll
            for (int r = 0; r < 16; ++r) { const int t = rho16(r, hh); MAB[t * 32 + r32] = (r32 < t) ? acc[r] : 0.f; }
        } else {
#pragma unroll
            for (int r = 0; r < 16; ++r) { const int t = rho16(r, hh); MAK[t * 32 + r32] = (bf16)f2bf((r32 < t) ? acc[r] : 0.f); }
        }
    }
    lds_barrier();
    if (p == 0) {
        const int cidx = r32; float tc[32];
#pragma unroll
        for (int t = 0; t < 32; ++t) { float acc0 = (t == cidx) ? 1.0f : 0.f, acc1 = 0.f;
#pragma unroll
            for (int s4 = 0; s4 < (t + 3) / 4; ++s4) { const f32x4 m4 = *(const LAS f32x4*)(MAB + t * 32 + 4 * s4);
#pragma unroll
                for (int e = 0; e < 4; ++e) { const int s = 4 * s4 + e; if (s < t) { if (e & 1) acc1 = fmaf(m4[e], tc[s], acc1); else acc0 = fmaf(m4[e], tc[s], acc0); } } }
            tc[t] = acc0 + acc1; }
#pragma unroll
        for (int t = 0; t < 32; ++t) if (hh == 0) TM[t * 32 + cidx] = (bf16)f2bf(tc[t]);
    } else {
#pragma unroll
        for (int vt = 0; vt < 2; ++vt) {
#pragma unroll
            for (int i = 0; i < 16; ++i) accR[vt][i] = 0.f;
#pragma unroll
            for (int s = 0; s < 2; ++s) { const bf16x8 A = *(const LAS bf16x8*)(MAK + r32 * 32 + 16 * s + 8 * hh), B = *(const LAS bf16x8*)(VT + (32 * vt + r32) * 32 + 16 * s + 8 * hh);
                accR[vt] = __builtin_amdgcn_mfma_f32_32x32x16_bf16(A, B, accR[vt], 0, 0, 0); } }
    }
    lds_barrier();
    if (p == 0) {
        f32x16 accW[2];
#pragma unroll
        for (int dt = 0; dt < 2; ++dt) {
#pragma unroll
            for (int i = 0; i < 16; ++i) accW[dt][i] = 0.f;
#pragma unroll
            for (int s = 0; s < 2; ++s) { const bf16x8 A = *(const LAS bf16x8*)(TM + r32 * 32 + 16 * s + 8 * hh), B = *(const LAS bf16x8*)(ATT + (32 * dt + r32) * 32 + 16 * s + 8 * hh);
                accW[dt] = __builtin_amdgcn_mfma_f32_32x32x16_bf16(A, B, accW[dt], 0, 0, 0); } }
        { LAS bf16* WL = ATT;
#pragma unroll
          for (int dt = 0; dt < 2; ++dt) { f32x16 acc;
#pragma unroll
              for (int i = 0; i < 16; ++i) acc[i] = 0.f;
#pragma unroll
              for (int s = 0; s < 2; ++s) { union { bf16x8 v; unsigned w[4]; } bf;
#pragma unroll
                  for (int j = 0; j < 4; ++j) bf.w[j] = cvt_pk_bf16(accW[dt][8 * s + 2 * j], accW[dt][8 * s + 2 * j + 1]);
                  acc = __builtin_amdgcn_mfma_f32_32x32x16_bf16(mfr[s].v, bf.v, acc, 0, 0, 0); }
#pragma unroll
              for (int r = 0; r < 16; ++r) { const int t = rho16(r, hh); WL[t * 64 + 32 * dt + r32] = (bf16)f2bf(acc[r] + bf2f(LWL[t * 264 + h * 64 + 32 * dt + r32])); } }
          u32x4* RGw = (u32x4*)((bf16*)(ws + WS_RR) + un * 2048);
#pragma unroll
          for (int i = 0; i < 4; ++i) RGw[i * 64 + lane] = *(const LAS u32x4*)(WL + (i * 64 + lane) * 8); }
        LAS bf16* PL = (LAS bf16*)(L + 4096);
        const int xs = r32 >> 4, xx = r32 & 15, hhA = (xx >> 2) & 1, jA = 4 * (xx >> 3) + (xx & 3);
#pragma unroll
        for (int dt = 0; dt < 2; ++dt)
#pragma unroll
            for (int dt2 = 0; dt2 < 2; ++dt2) { f32x16 acc;
#pragma unroll
                for (int i = 0; i < 16; ++i) acc[i] = 0.f;
#pragma unroll
                for (int s = 0; s < 2; ++s) { const LAS bf16* bp = BHT + (32 * dt + r32) * 32 + 16 * s + 4 * hh;
                    union { bf16x8 v; s16x4 h2[2]; } af; af.h2[0] = *(const LAS s16x4*)bp; af.h2[1] = *(const LAS s16x4*)(bp + 8);
                    union { bf16x8 v; unsigned w[4]; } bf;
#pragma unroll
                    for (int j = 0; j < 4; ++j) bf.w[j] = cvt_pk_bf16(accW[dt2][8 * s + 2 * j], accW[dt2][8 * s + 2 * j + 1]);
                    acc = __builtin_amdgcn_mfma_f32_32x32x16_bf16(af.v, bf.v, acc, 0, 0, 0); }
                if (dt == dt2) { const float gc = GC[32 * dt + r32];
#pragma unroll
                    for (int r = 0; r < 16; ++r) if (rho16(r, hh) == r32) acc[r] += gc; }
                LAS bf16* pf = PL + (((dt * 2 + dt2) * 2 + xs) * 64 + 32 * hhA) * 8 + jA;
#pragma unroll
                for (int r = 0; r < 16; ++r) pf[rho16(r, hh) * 8] = (bf16)f2bf(acc[r]); }
        { u32x4* PFp = (u32x4*)((bf16*)(ws + WS_RP) + un * 4096);
#pragma unroll
          for (int f = 0; f < 8; ++f) PFp[f * 64 + lane] = *(const LAS u32x4*)(PL + (f * 64 + lane) * 8); }
    } else {
        f32x16 accU[2];
#pragma unroll
        for (int vt = 0; vt < 2; ++vt) {
#pragma unroll
            for (int i = 0; i < 16; ++i) accU[vt][i] = 0.f;
#pragma unroll
            for (int s = 0; s < 2; ++s) { const LAS bf16* tp = TM + r32 * 32 + 16 * s + 4 * hh;
                union { bf16x8 v; s16x4 h2[2]; } af; af.h2[0] = *(const LAS s16x4*)tp; af.h2[1] = *(const LAS s16x4*)(tp + 8);
                union { bf16x8 v; unsigned w[4]; } bf;
#pragma unroll
                for (int j = 0; j < 4; ++j) bf.w[j] = cvt_pk_bf16(accR[vt][8 * s + 2 * j], accR[vt][8 * s + 2 * j + 1]);
                accU[vt] = __builtin_amdgcn_mfma_f32_32x32x16_bf16(af.v, bf.v, accU[vt], 0, 0, 0); } }
        bf16* UGp = (bf16*)(ws + WS_RU) + un * 2048;
#pragma unroll
        for (int vt = 0; vt < 2; ++vt) { f32x16 acc;
#pragma unroll
            for (int i = 0; i < 16; ++i) acc[i] = 0.f;
#pragma unroll
            for (int s = 0; s < 2; ++s) { union { bf16x8 v; unsigned w[4]; } fu; union { bf16x8 v; u32x4 q; } fb;
#pragma unroll
                for (int j = 0; j < 4; ++j) fu.w[j] = cvt_pk_bf16(accU[vt][8 * s + 2 * j], accU[vt][8 * s + 2 * j + 1]);
                fb.q = EX[s * 64 + lane];
                acc = __builtin_amdgcn_mfma_f32_32x32x16_bf16(fu.v, fb.v, acc, 0, 0, 0);
                const LAS bf16* vp = VT + (32 * vt + r32) * 32 + 16 * s + 4 * hh;
                union { bf16x8 v; s16x4 h2[2]; } vf; vf.h2[0] = *(const LAS s16x4*)vp; vf.h2[1] = *(const LAS s16x4*)(vp + 8);
                acc = __builtin_amdgcn_mfma_f32_32x32x16_bf16(vf.v, mfr[s].v, acc, 0, 0, 0); }
#pragma unroll
            for (int g2 = 0; g2 < 2; ++g2) *(u32x4*)(UGp + ((vt * 2 + g2) * 64 + lane) * 8) = (u32x4){cvt_pk_bf16(acc[8 * g2], acc[8 * g2 + 1]), cvt_pk_bf16(acc[8 * g2 + 2], acc[8 * g2 + 3]),
                                                                                                 cvt_pk_bf16(acc[8 * g2 + 4], acc[8 * g2 + 5]), cvt_pk_bf16(acc[8 * g2 + 6], acc[8 * g2 + 7])}; }
        bf16* QFp = (bf16*)(ws + WS_RQ) + un * 4096;
#pragma unroll
        for (int vt = 0; vt < 2; ++vt)
#pragma unroll
            for (int dt = 0; dt < 2; ++dt) { f32x16 acc;
#pragma unroll
                for (int i = 0; i < 16; ++i) acc[i] = 0.f;
#pragma unroll
                for (int s = 0; s < 2; ++s) { const LAS bf16* bp = BHT + (32 * dt + r32) * 32 + 16 * s + 4 * hh;
                    union { bf16x8 v; s16x4 h2[2]; } af; af.h2[0] = *(const LAS s16x4*)bp; af.h2[1] = *(const LAS s16x4*)(bp + 8);
                    union { bf16x8 v; unsigned w[4]; } bf;
#pragma unroll
                    for (int j = 0; j < 4; ++j) bf.w[j] = cvt_pk_bf16(accU[vt][8 * s + 2 * j], accU[vt][8 * s + 2 * j + 1]);
                    acc = __builtin_amdgcn_mfma_f32_32x32x16_bf16(af.v, bf.v, acc, 0, 0, 0);
                    const bf16x8 A2 = *(const LAS bf16x8*)(KHT + (32 * dt + r32) * 32 + 16 * s + 8 * hh), B2 = *(const LAS bf16x8*)(VT + (32 * vt + r32) * 32 + 16 * s + 8 * hh);
                    acc = __builtin_amdgcn_mfma_f32_32x32x16_bf16(A2, B2, acc, 0, 0, 0); }
#pragma unroll
                for (int g2 = 0; g2 < 2; ++g2) *(u32x4*)(QFp + (((vt * 2 + dt) * 2 + g2) * 64 + lane) * 8) = (u32x4){cvt_pk_bf16(acc[8 * g2], acc[8 * g2 + 1]), cvt_pk_bf16(acc[8 * g2 + 2], acc[8 * g2 + 3]),
                                                                                                                   cvt_pk_bf16(acc[8 * g2 + 4], acc[8 * g2 + 5]), cvt_pk_bf16(acc[8 * g2 + 6], acc[8 * g2 + 7])}; }
    }
    lds_barrier();
}
__device__ __forceinline__ void rw_m2_wave(int lane, int bh, int vt) {
    unsigned char* ws = KWS();
    const bf16* PF = (const bf16*)(ws + WS_RP) + (size_t)bh * NCH * 4096 + lane * 8;
    const bf16* QF = (const bf16*)(ws + WS_RQ) + (size_t)bh * NCH * 4096 + (size_t)vt * 2048 + lane * 8;
    bf16* SG = (bf16*)(ws + WS_RS) + (size_t)bh * NCH * 4096 + (size_t)vt * 2048 + lane * 8;
    f32x16 S[2];
#pragma unroll
    for (int dt = 0; dt < 2; ++dt)
#pragma unroll
        for (int i = 0; i < 16; ++i) S[dt][i] = 0.f;
    bf16x8 pA[8], pB[8], pC[8]; u32x4 qA[4], qB[4], qC[4];
#pragma unroll
    for (int f = 0; f < 8; ++f) { pA[f] = (bf16x8){0, 0, 0, 0, 0, 0, 0, 0}; pB[f] = pA[f]; pC[f] = pA[f]; }
#pragma unroll
    for (int f = 0; f < 4; ++f) { qA[f] = (u32x4){0u, 0u, 0u, 0u}; qB[f] = qA[f]; qC[f] = qA[f]; }
#define RWM2_LD4(d0, d1, d2, d3, ptr) asm volatile("global_load_dwordx4 %0, %4, off\n\tglobal_load_dwordx4 %1, %4, off offset:1024\n\tglobal_load_dwordx4 %2, %4, off offset:2048\n\tglobal_load_dwordx4 %3, %4, off offset:3072" \
        : "+v"(d0), "+v"(d1), "+v"(d2), "+v"(d3) : "v"(ptr) : "memory")
#define RWM2_LOAD(P_, Q_, c_) do { const int _c = (c_) < NCH ? (c_) : NCH - 1; const bf16* _p0 = PF + (size_t)_c * 4096; const bf16* _p1 = _p0 + 2048; const bf16* _q = QF + (size_t)_c * 4096; \
        RWM2_LD4(P_[0], P_[1], P_[2], P_[3], _p0); RWM2_LD4(P_[4], P_[5], P_[6], P_[7], _p1); RWM2_LD4(Q_[0], Q_[1], Q_[2], Q_[3], _q); } while (0)
#define RWM2_WAIT(P_, Q_) asm volatile("s_waitcnt vmcnt(24)" : "+v"(P_[0]), "+v"(P_[1]), "+v"(P_[2]), "+v"(P_[3]), "+v"(P_[4]), "+v"(P_[5]), "+v"(P_[6]), "+v"(P_[7]), "+v"(Q_[0]), "+v"(Q_[1]), "+v"(Q_[2]), "+v"(Q_[3]) :: "memory")
#define RWM2_STEP(P_, Q_, c_) do { \
        RWM2_WAIT(P_, Q_); \
        union { bf16x8 v; unsigned w[4]; } sb[2][2]; \
        _Pragma("unroll") for (int dt2 = 0; dt2 < 2; ++dt2) _Pragma("unroll") for (int s = 0; s < 2; ++s) { \
            _Pragma("unroll") for (int j = 0; j < 4; ++j) sb[dt2][s].w[j] = cvt_pk_bf16(S[dt2][8 * s + 2 * j], S[dt2][8 * s + 2 * j + 1]); \
            *(bf16x8*)(SG + (size_t)(c_) * 4096 + (dt2 * 2 + s) * 512) = sb[dt2][s].v; } \
        f32x16 N[2]; \
        _Pragma("unroll") for (int dt = 0; dt < 2; ++dt) { \
            _Pragma("unroll") for (int g2 = 0; g2 < 2; ++g2) _Pragma("unroll") for (int j = 0; j < 4; ++j) { N[dt][8 * g2 + 2 * j] = bflo(Q_[dt * 2 + g2][j]); N[dt][8 * g2 + 2 * j + 1] = bfhi(Q_[dt * 2 + g2][j]); } \
            _Pragma("unroll") for (int dt2 = 0; dt2 < 2; ++dt2) _Pragma("unroll") for (int s = 0; s < 2; ++s) N[dt] = __builtin_amdgcn_mfma_f32_32x32x16_bf16(P_[(dt * 2 + dt2) * 2 + s], sb[dt2][s].v, N[dt], 0, 0, 0); } \
        S[0] = N[0]; S[1] = N[1]; } while (0)
    RWM2_LOAD(pA, qA, 0); RWM2_LOAD(pB, qB, 1); RWM2_LOAD(pC, qC, 2);
#pragma unroll 1
    for (int c = 0; c < NCH - 1; c += 3) {
        RWM2_STEP(pA, qA, c); RWM2_LOAD(pA, qA, c + 3);
        RWM2_STEP(pB, qB, c + 1); RWM2_LOAD(pB, qB, c + 4);
        RWM2_STEP(pC, qC, c + 2); RWM2_LOAD(pC, qC, c + 5);
    }
    static_assert((NCH - 1) % 3 == 0, "chunk loop: 85 rounds of three steps, then the last chunk");
    RWM2_STEP(pA, qA, NCH - 1);
    asm volatile("s_waitcnt vmcnt(0)" : "+v"(pB[0]), "+v"(pB[1]), "+v"(pB[2]), "+v"(pB[3]), "+v"(pB[4]), "+v"(pB[5]), "+v"(pB[6]), "+v"(pB[7]), "+v"(qB[0]), "+v"(qB[1]), "+v"(qB[2]), "+v"(qB[3]) :: "memory");
    asm volatile("" : "+v"(pC[0]), "+v"(pC[1]), "+v"(pC[2]), "+v"(pC[3]), "+v"(pC[4]), "+v"(pC[5]), "+v"(pC[6]), "+v"(pC[7]), "+v"(qC[0]), "+v"(qC[1]), "+v"(qC[2]), "+v"(qC[3]) :: "memory");
#undef RWM2_LD4
#undef RWM2_LOAD
#undef RWM2_WAIT
#undef RWM2_STEP
}
__device__ __forceinline__ bf16x8 ld_perm8(const bf16* p) { union { bf16x8 v; s16x4 h2[2]; } f; f.h2[0] = *(const s16x4*)p; f.h2[1] = *(const s16x4*)(p + 8); return f.v; }
__device__ __forceinline__ void rw_m3_task(int lane, int l, int bh, int c) {
    unsigned char* ws = KWS();
    const int r32 = lane & 31, hh = lane >> 5, b = bh >> 2, h = bh & 3; const size_t un = (size_t)bh * NCH + c; const size_t tok0 = (size_t)b * T + c * 32;
    const bf16* RGp = (const bf16*)(ws + WS_RR) + un * 2048 + r32 * 64 + 4 * hh;
    const bf16* SGp = (const bf16*)(ws + WS_RS) + un * 4096 + lane * 8; const bf16* VTp = (const bf16*)(ws + WS_RVT) + un * 2048 + r32 * 32 + 4 * hh;
    const bf16* UGp = (const bf16*)(ws + WS_RU) + un * 2048 + lane * 8;
    f32x16 Y[2], Z[2];
    const float bon = ((const float*)(ws + WS_BONUS))[(tok0 + r32) * 4 + h];
#pragma unroll
    for (int vt = 0; vt < 2; ++vt)
#pragma unroll
        for (int g2 = 0; g2 < 2; ++g2) { const u32x4 u4 = *(const u32x4*)(UGp + (vt * 2 + g2) * 512);
#pragma unroll
            for (int j = 0; j < 4; ++j) { Y[vt][8 * g2 + 2 * j] = bflo(u4[j]); Y[vt][8 * g2 + 2 * j + 1] = bfhi(u4[j]); } }
#pragma unroll
    for (int i = 0; i < 16; ++i) { Z[0][i] = 0.f; Z[1][i] = 0.f; }
#pragma unroll
    for (int ks = 0; ks < 4; ++ks) {
        const bf16x8 rf = ld_perm8(RGp + 16 * ks);
        const bf16x8 s0 = *(const bf16x8*)(SGp + ks * 512), s1 = *(const bf16x8*)(SGp + 2048 + ks * 512);
        Y[0] = __builtin_amdgcn_mfma_f32_32x32x16_bf16(s0, rf, Y[0], 0, 0, 0); Y[1] = __builtin_amdgcn_mfma_f32_32x32x16_bf16(s1, rf, Y[1], 0, 0, 0); }
#pragma unroll
    for (int s = 0; s < 2; ++s) {
        union { bf16x8 v; unsigned short e[8]; } db;
#pragma unroll
        for (int j = 0; j < 8; ++j) db.e[j] = (16 * s + 8 * (j >> 2) + 4 * hh + (j & 3) == r32) ? (unsigned short)f2bf(bon) : (unsigned short)0;
#pragma unroll
        for (int vt = 0; vt < 2; ++vt) {
            const bf16* vp = VTp + (size_t)vt * 32 * 32 + 16 * s;
            union { bf16x8 v; s16x4 h2[2]; } vf; vf.h2[0] = *(const s16x4*)vp; vf.h2[1] = *(const s16x4*)(vp + 8);
            Z[vt] = __builtin_amdgcn_mfma_f32_32x32x16_bf16(vf.v, db.v, Z[vt], 0, 0, 0); } }
    float sm = 0.f;
#pragma unroll
    for (int vt = 0; vt < 2; ++vt)
#pragma unroll
        for (int i = 0; i < 16; ++i) sm += Y[vt][i];
    sm += __shfl_xor(sm, 32); const float mu = sm * (1.0f / 64.0f);
    float q = 0.f;
#pragma unroll
    for (int vt = 0; vt < 2; ++vt)
#pragma unroll
        for (int i = 0; i < 16; ++i) { const float dd = Y[vt][i] - mu; q += dd * dd; }
    q += __shfl_xor(q, 32); const float rstd = 1.0f / sqrtf(q * (1.0f / 64.0f) + RW_LN_EPS);
    const size_t tok = tok0 + r32;
    const bf16* gp = (const bf16*)(ws + WS_GBUF) + tok * 256 + h * 64; unsigned char* od = (unsigned char*)(ws + WS_O) + tok * D + 512 + h * 64;
    const float* lnw = KIN(I_RWLNW) + l * 256 + h * 64; const float* lnb = KIN(I_RWLNB) + l * 256 + h * 64;
#pragma unroll
    for (int vt = 0; vt < 2; ++vt)
#pragma unroll
        for (int g = 0; g < 4; ++g) { const int v0 = 32 * vt + 8 * g + 4 * hh; const f32x4 w4 = *(const f32x4*)(lnw + v0), b4 = *(const f32x4*)(lnb + v0); const u32x2 gw = *(const u32x2*)(gp + v0);
            const float y0 = ((Y[vt][4 * g] - mu) * rstd * w4[0] + b4[0] + Z[vt][4 * g]) * bflo(gw.x), y1 = ((Y[vt][4 * g + 1] - mu) * rstd * w4[1] + b4[1] + Z[vt][4 * g + 1]) * bfhi(gw.x);
            const float y2 = ((Y[vt][4 * g + 2] - mu) * rstd * w4[2] + b4[2] + Z[vt][4 * g + 2]) * bflo(gw.y), y3 = ((Y[vt][4 * g + 3] - mu) * rstd * w4[3] + b4[3] + Z[vt][4 * g + 3]) * bfhi(gw.y);
            store_o4(od + v0, y0, y1, y2, y3); }
}

__device__ __forceinline__ void c1_phase(LAS unsigned char* lds, int l, int vcu, int G) {
    for (int u = vcu, k = 0; u < NB * NCH; u += G, ++k) {
        const int b = (G == 256) ? (vcu >> 5) : (u >> 8), c = (G == 256) ? 255 - ((vcu & 31) + 32 * k) : (u & 255);
        for (int q = 0; q <= PHREP(16); ++q) rw_fused_unit(lds, l, b, c);
        for (int q = 0; q <= PHREP(17); ++q) hg_fused_unit(lds, l, b, c);
        for (int q = 0; q <= PHREP(18); ++q) gla_fused_unit(lds, l, b, c); }
}
__device__ __forceinline__ void m3_gh_phase(int l, int vcu, int G) {
    const int tid = opaque_tid(), lane = tid & 63, wave = __builtin_amdgcn_readfirstlane(tid >> 6);
    unsigned char* ws = KWS();
    const int gw = vcu * NWAVES + wave, NGW = G * NWAVES;
    const bf16* P = (const bf16*)(ws + WS_P); unsigned char* O = (unsigned char*)(ws + WS_O);
    const float* gng = KIN(I_GLANG) + l * 256; const float* hng = KIN(I_HGNG) + l * 256;
    for (int task = gw; task < 24576; task += NGW) {
        const int un = task & 8191, bh = un >> 8, c = un & 255, b = bh >> 2, h = bh & 3; const size_t tok0 = (size_t)b * T + c * 32;
        if (task >= 16384) { for (int q = 0; q <= PHREP(19); ++q) rw_m3_task(lane, l, bh, c); continue; }
        for (int q = 0; q <= PHREP(20); ++q)
        if (task < 8192) m3_gh_task<64>(lane, (const bf16*)(ws + WS_HQ) + (size_t)un * 2048, (const bf16*)(ws + WS_HK) + (size_t)un * 2048, (const bf16*)(ws + WS_HVT) + (size_t)un * 2048, (const bf16*)(ws + WS_HS) + (size_t)un * 4096,
                                         P + tok0 * PINP + PC_HG + h * 64, hng + h * 64, O + tok0 * D + 256 + h * 64);
        else m3_gh_task<32>(lane, (const bf16*)(ws + WS_GQ) + (size_t)un * 1024, (const bf16*)(ws + WS_GK) + (size_t)un * 1024, (const bf16*)(ws + WS_GVT) + (size_t)un * 2048, (const bf16*)(ws + WS_GS) + (size_t)un * 2048,
                            P + tok0 * PINP + PC_GOUT + h * 64, gng + h * 64, O + tok0 * D + h * 64);
    }
}

__device__ __forceinline__ void xattn_units(LAS unsigned char* lds, int l, int first, int last, int stride) {
    const int tid = opaque_tid(), lane = tid & 63, wave = __builtin_amdgcn_readfirstlane(tid >> 6), r32 = lane & 31, hh = lane >> 5;
    const bf16* P = (const bf16*)(KWS() + WS_P); const bf16* MKV = (const bf16*)(KWS() + WS_MKV); unsigned char* O = (unsigned char*)(KWS() + WS_O);
    LAS bf16* KL = (LAS bf16*)lds;
    LAS bf16* VT = (LAS bf16*)(lds + 256 * 72 * 2);
    int cur_bh = -1;
    for (int u = first; u < last; u += stride) {
        const int bh = u >> 5, qb = u & 31, b = bh >> 2, h = bh & 3;
        if (bh != cur_bh) {
            lds_barrier();
            for (int i = tid; i < 256 * 8; i += NTHR) { const int key = i >> 3, c8 = i & 7;
                const bf16* src = MKV + (size_t)(b * 256 + key) * 2048 + l * 512 + h * 64 + c8 * 8;
                *(LAS u32x4*)(KL + key * 72 + c8 * 8) = *(const u32x4*)src;
                const u32x4 vv = *(const u32x4*)(src + 256);
                LAS bf16* vd = VT + (c8 * 8) * 264 + key;
                vd[0 * 264] = (bf16)(vv.x & 0xffff); vd[1 * 264] = (bf16)(vv.x >> 16); vd[2 * 264] = (bf16)(vv.y & 0xffff); vd[3 * 264] = (bf16)(vv.y >> 16);
                vd[4 * 264] = (bf16)(vv.z & 0xffff); vd[5 * 264] = (bf16)(vv.z >> 16); vd[6 * 264] = (bf16)(vv.w & 0xffff); vd[7 * 264] = (bf16)(vv.w >> 16); }
            lds_barrier();
            cur_bh = bh;
        }
        const int q = b * T + qb * 256 + wave * 32 + r32;
        bf16x8 qf[4];
#pragma unroll
        for (int s = 0; s < 4; ++s) qf[s] = *(const bf16x8*)(P + (size_t)q * PINP + PC_MQ + h * 64 + 16 * s + 8 * hh);
        f32x16 sc[8];
#pragma unroll
        for (int kt = 0; kt < 8; ++kt) {
#pragma unroll
            for (int i = 0; i < 16; ++i) sc[kt][i] = 0.f;
#pragma unroll
            for (int s = 0; s < 4; ++s) { const bf16x8 kf = *(const LAS bf16x8*)(KL + (kt * 32 + r32) * 72 + 16 * s + 8 * hh);
                sc[kt] = __builtin_amdgcn_mfma_f32_32x32x16_bf16(kf, qf[s], sc[kt], 0, 0, 0); }
        }
        float m = -3.0e38f;
#pragma unroll
        for (int kt = 0; kt < 8; ++kt)
#pragma unroll
            for (int i = 0; i < 16; ++i) m = fmaxf(m, sc[kt][i]);
        m = fmaxf(m, __shfl_xor(m, 32));
        float sum = 0.f;
        const float c2 = 0.125f * 1.4426950408889634f;
#pragma unroll
        for (int kt = 0; kt < 8; ++kt)
#pragma unroll
            for (int i = 0; i < 16; ++i) { const float e = __builtin_amdgcn_exp2f((sc[kt][i] - m) * c2); sc[kt][i] = e; sum += e; }
        sum += __shfl_xor(sum, 32);
        const float inv = 1.0f / sum;
        f32x16 oa[2];
#pragma unroll
        for (int vt = 0; vt < 2; ++vt)
#pragma unroll
            for (int i = 0; i < 16; ++i) oa[vt][i] = 0.f;
#pragma unroll
        for (int kt = 0; kt < 8; ++kt)
#pragma unroll
            for (int s = 0; s < 2; ++s) {
                union { bf16x8 v; unsigned w[4]; } pf;
#pragma unroll
                for (int j = 0; j < 4; ++j) pf.w[j] = cvt_pk_bf16(sc[kt][8 * s + 2 * j], sc[kt][8 * s + 2 * j + 1]);
#pragma unroll
                for (int vt = 0; vt < 2; ++vt) {
                    const LAS bf16* vp = VT + (vt * 32 + r32) * 264 + kt * 32 + 16 * s + 4 * hh;
                    union { bf16x8 v; s16x4 h2[2]; } vf; vf.h2[0] = *(const LAS s16x4*)vp; vf.h2[1] = *(const LAS s16x4*)(vp + 8);
                    oa[vt] = __builtin_amdgcn_mfma_f32_32x32x16_bf16(vf.v, pf.v, oa[vt], 0, 0, 0); }
            }
        unsigned char* orow = O + (size_t)q * D + 768 + h * 64;
#pragma unroll
        for (int vt = 0; vt < 2; ++vt)
#pragma unroll
            for (int g = 0; g < 4; ++g) store_o4(orow + vt * 32 + 8 * g + 4 * hh, oa[vt][4 * g] * inv, oa[vt][4 * g + 1] * inv, oa[vt][4 * g + 2] * inv, oa[vt][4 * g + 3] * inv);
    }
    lds_barrier();
}

__device__ __forceinline__ void m2_phase(LAS unsigned char* lds, int l, int bx, int G) {
    unsigned char* ws = KWS();
    const int tid = opaque_tid(), lane = tid & 63, wave = __builtin_amdgcn_readfirstlane(tid >> 6);
    const int nrw = (G >= 128) ? 64 : 0;
    if (nrw) { if (bx < nrw && wave == 0) for (int q = 0; q <= PHREP(22); ++q) rw_m2_wave(lane, bx >> 1, bx & 1); }
    else { if (wave == 0) for (int q = bx; q < 64; q += G) rw_m2_wave(lane, q >> 1, q & 1); }
    if (nrw && bx >= nrw) {
        const int nth = (G - nrw) * NTHR;
        const int gt = (bx - nrw) * NTHR + tid;
        for (int q = 0; q <= PHREP(23); ++q)
        for (int e = gt; e < 98304; e += nth) {
            if (e < 65536) m2_gh_elem2<64>(e, (const bf16*)(ws + WS_HDS), (const float*)(ws + WS_HBE), (bf16*)(ws + WS_HS));
            else m2_gh_elem2<32>(e - 65536, (const bf16*)(ws + WS_GDS), (const float*)(ws + WS_GBE), (bf16*)(ws + WS_GS)); }
    }
    if (nrw == 0) { __syncthreads(); for (int e = bx * NTHR + tid; e < 98304; e += G * NTHR) {
            if (e < 65536) m2_gh_elem2<64>(e, (const bf16*)(ws + WS_HDS), (const float*)(ws + WS_HBE), (bf16*)(ws + WS_HS));
            else m2_gh_elem2<32>(e - 65536, (const bf16*)(ws + WS_GDS), (const float*)(ws + WS_GBE), (bf16*)(ws + WS_GS)); } }
    if (nrw == 0 || bx >= nrw) {
        const int nb = G - nrw, r = bx - nrw;
        const int per = (1024 + nb - 1) / nb, lo = r * per, hi = (lo + per < 1024) ? lo + per : 1024;
        for (int q = 0; q <= PHREP(24); ++q) xattn_units(lds, l, lo, hi, 1);
    }
}

__device__ __forceinline__ void ln1_router_phase(LAS unsigned char* lds, int l, int bx, int G) {
    const int tid = opaque_tid(), lane = tid & 63, wave = __builtin_amdgcn_readfirstlane(tid >> 6);
    LAS float* X = (LAS float*)lds;
    LAS float* PART = (LAS float*)(lds + 16 * 1028 * 4);
    LAS int* HIST = (LAS int*)(lds + 16 * 1028 * 4 + 8 * 16 * 32 * 4);
    LAS f32x4* GB = (LAS f32x4*)(lds + 16 * 1028 * 4 + 8 * 16 * 32 * 4 + 256);
    const float* xin = KIN(I_X); const bf16* xinb = (const bf16*)(KWS() + WS_XB);
    const bf16* HM = (const bf16*)(KWS() + WS_HMIX);
    bf16* X1B = (bf16*)(KWS() + WS_X1B); unsigned char* X1Q = (unsigned char*)(KWS() + WS_XF);
    const float* g1 = KIN(I_LN1G) + l * D; const float* b1 = KIN(I_LN1B) + l * D;
    const float* rw = KIN(I_RTW) + (size_t)l * D * NE; const float* rb = KIN(I_RTB) + l * NE;
    int* tok_e = (int*)(KWS() + WS_ROUTE); float* tok_g = (float*)(KWS() + WS_ROUTE + 1 * MiB);
    if (tid < 32) HIST[tid] = 0;
    if (tid < 256) { GB[tid] = ((const f32x4*)g1)[tid]; GB[256 + tid] = ((const f32x4*)b1)[tid]; }
    const float rbe = rb[tid & 31];
    bf16x8 rwH[4][2], rwL[4][2];
    { const int q = lane >> 4, e = lane & 15;
#pragma unroll
      for (int s = 0; s < 4; ++s)
#pragma unroll
          for (int nt = 0; nt < 2; ++nt) { union { bf16x8 v; unsigned w[4]; } fh, fl;
#pragma unroll
              for (int j = 0; j < 4; ++j) { const float* p = rw + (size_t)(128 * wave + 32 * s + 8 * q + 2 * j) * NE + 16 * nt + e; const float v0 = p[0], v1 = p[NE];
                  const unsigned h = cvt_pk_bf16(v0, v1); fh.w[j] = h; fl.w[j] = cvt_pk_bf16(v0 - bflo(h), v1 - bfhi(h)); }
              rwH[s][nt] = fh.v; rwL[s][nt] = fl.v; } }
    lds_barrier();
    f32x4 xraw[2][4]; u32x2 xbraw[2][4], hraw[2][4];
#define LN1_LOAD(it_) do { const size_t _tok = (size_t)(it_) * 16 + wave * 2; const u32x2* _hr = (const u32x2*)(HM + _tok * D) + lane; \
        if (l == 0) { const f32x4* _xr = (const f32x4*)(xin + _tok * D) + lane;        \
            _Pragma("unroll") for (int tt = 0; tt < 2; ++tt) _Pragma("unroll") for (int j = 0; j < 4; ++j) xraw[tt][j] = _xr[tt * 256 + 64 * j]; } \
        else { const u32x2* _xbr = (const u32x2*)(xinb + _tok * D) + lane; \
            _Pragma("unroll") for (int tt = 0; tt < 2; ++tt) _Pragma("unroll") for (int j = 0; j < 4; ++j) xbraw[tt][j] = _xbr[tt * 256 + 64 * j]; } \
        _Pragma("unroll") for (int tt = 0; tt < 2; ++tt) _Pragma("unroll") for (int j = 0; j < 4; ++j) hraw[tt][j] = _hr[tt * 256 + 64 * j]; } while (0)
    if (bx < NTOK / 16) LN1_LOAD(bx);
    for (int it = bx; it < NTOK / 16; it += G) {
        f32x4 vv[2][4];
#pragma unroll
        for (int tt = 0; tt < 2; ++tt)
#pragma unroll
            for (int j = 0; j < 4; ++j) { f32x4 xv; if (l == 0) xv = xraw[tt][j]; else { const u32x2 xw = xbraw[tt][j]; xv = (f32x4){bflo(xw.x), bfhi(xw.x), bflo(xw.y), bfhi(xw.y)}; } const u32x2 hw = hraw[tt][j];
                vv[tt][j][0] = DN_ALPHA * xv[0] + bflo(hw.x); vv[tt][j][1] = DN_ALPHA * xv[1] + bfhi(hw.x); vv[tt][j][2] = DN_ALPHA * xv[2] + bflo(hw.y); vv[tt][j][3] = DN_ALPHA * xv[3] + bfhi(hw.y); }
        if (it + G < NTOK / 16) LN1_LOAD(it + G);
#pragma unroll
        for (int tt = 0; tt < 2; ++tt) { const int ti = wave * 2 + tt; const size_t tok = (size_t)it * 16 + ti;
            f32x4 v[4]; float s = 0.f;
#pragma unroll
            for (int j = 0; j < 4; ++j) { v[j] = vv[tt][j]; s += (v[j][0] + v[j][1]) + (v[j][2] + v[j][3]); }
            const float mean = wave_sum(s) * (1.0f / D); float s2 = 0.f;
#pragma unroll
            for (int j = 0; j < 4; ++j) { v[j] = v[j] - mean; s2 += (v[j][0] * v[j][0] + v[j][1] * v[j][1]) + (v[j][2] * v[j][2] + v[j][3] * v[j][3]); }
            const float rstd = 1.0f / sqrtf(wave_sum(s2) * (1.0f / D) + LN_EPS);
#pragma unroll
            for (int j = 0; j < 4; ++j) { const f32x4 gg = GB[lane + 64 * j], bb = GB[256 + lane + 64 * j];
                const f32x4 y = v[j] * rstd * gg + bb;
                *((u32x2*)(X1B + tok * D) + lane + 64 * j) = (u32x2){pk2(y[0], y[1]), pk2(y[2], y[3])};
                { int w = __builtin_amdgcn_cvt_pk_fp8_f32(y[0], y[1], 0, false); w = __builtin_amdgcn_cvt_pk_fp8_f32(y[2], y[3], w, true); *((unsigned*)(X1Q + tok * D) + lane + 64 * j) = (unsigned)w; }
                *(LAS f32x4*)(X + ti * 1028 + 4 * lane + 256 * j) = y; }
        }
        lds_barrier();
        {
            const int q = lane >> 4, r = lane & 15;
            f32x4 acc0 = (f32x4){0.f, 0.f, 0.f, 0.f}, acc1 = (f32x4){0.f, 0.f, 0.f, 0.f};
            const LAS float* xa = X + r * 1028 + 128 * wave + 8 * q;
#pragma unroll
            for (int s = 0; s < 4; ++s) { const f32x4 x0 = *(const LAS f32x4*)(xa + 32 * s), x1 = *(const LAS f32x4*)(xa + 32 * s + 4);
                union { bf16x8 v; unsigned w[4]; } ah, al;
                ah.w[0] = cvt_pk_bf16(x0[0], x0[1]); ah.w[1] = cvt_pk_bf16(x0[2], x0[3]); ah.w[2] = cvt_pk_bf16(x1[0], x1[1]); ah.w[3] = cvt_pk_bf16(x1[2], x1[3]);
                al.w[0] = cvt_pk_bf16(x0[0] - bflo(ah.w[0]), x0[1] - bfhi(ah.w[0])); al.w[1] = cvt_pk_bf16(x0[2] - bflo(ah.w[1]), x0[3] - bfhi(ah.w[1]));
                al.w[2] = cvt_pk_bf16(x1[0] - bflo(ah.w[2]), x1[1] - bfhi(ah.w[2])); al.w[3] = cvt_pk_bf16(x1[2] - bflo(ah.w[3]), x1[3] - bfhi(ah.w[3]));
                acc0 = __builtin_amdgcn_mfma_f32_16x16x32_bf16(ah.v, rwH[s][0], acc0, 0, 0, 0); acc1 = __builtin_amdgcn_mfma_f32_16x16x32_bf16(ah.v, rwH[s][1], acc1, 0, 0, 0);
                acc0 = __builtin_amdgcn_mfma_f32_16x16x32_bf16(ah.v, rwL[s][0], acc0, 0, 0, 0); acc1 = __builtin_amdgcn_mfma_f32_16x16x32_bf16(ah.v, rwL[s][1], acc1, 0, 0, 0);
                acc0 = __builtin_amdgcn_mfma_f32_16x16x32_bf16(al.v, rwH[s][0], acc0, 0, 0, 0); acc1 = __builtin_amdgcn_mfma_f32_16x16x32_bf16(al.v, rwH[s][1], acc1, 0, 0, 0); }
#pragma unroll
            for (int i = 0; i < 4; ++i) { PART[(wave * 16 + 4 * q + i) * 32 + r] = acc0[i]; PART[(wave * 16 + 4 * q + i) * 32 + 16 + r] = acc1[i]; }
        }
        lds_barrier();
        {
            const int ti = tid >> 5, e = tid & 31;
            float lg = rbe;
#pragma unroll
            for (int w = 0; w < 8; ++w) lg += PART[(w * 16 + ti) * 32 + e];
            float tv[4]; int te[4]; float cur = lg;
#pragma unroll
            for (int k = 0; k < 4; ++k) { float bv = cur; int bi = e;
#pragma unroll
                for (int st = 0; st < 5; ++st) { float ov; int oi;
                    const int bvi = __builtin_bit_cast(int, bv);
                    if (st == 0) { ov = __builtin_bit_cast(float, __builtin_amdgcn_update_dpp(bvi, bvi, 0xB1, 0xf, 0xf, false)); oi = __builtin_amdgcn_update_dpp(bi, bi, 0xB1, 0xf, 0xf, false); }
                    else if (st == 1) { ov = __builtin_bit_cast(float, __builtin_amdgcn_update_dpp(bvi, bvi, 0x4E, 0xf, 0xf, false)); oi = __builtin_amdgcn_update_dpp(bi, bi, 0x4E, 0xf, 0xf, false); }
                    else if (st == 2) { ov = __builtin_bit_cast(float, __builtin_amdgcn_update_dpp(bvi, bvi, 0x141, 0xf, 0xf, false)); oi = __builtin_amdgcn_update_dpp(bi, bi, 0x141, 0xf, 0xf, false); }
                    else if (st == 3) { ov = __builtin_bit_cast(float, __builtin_amdgcn_update_dpp(bvi, bvi, 0x140, 0xf, 0xf, false)); oi = __builtin_amdgcn_update_dpp(bi, bi, 0x140, 0xf, 0xf, false); }
                    else { ov = __shfl_xor(bv, 16); oi = __shfl_xor(bi, 16); }
                    if (ov > bv || (ov == bv && oi < bi)) { bv = ov; bi = oi; } }
                tv[k] = bv; te[k] = bi; if (e == bi) cur = -3.0e38f; }
            const float e1 = __expf(tv[1] - tv[0]), e2 = __expf(tv[2] - tv[0]), e3 = __expf(tv[3] - tv[0]); const float inv = 1.0f / (1.0f + e1 + e2 + e3);
            const size_t tok = (size_t)it * 16 + ti;
            if (e < 4) { const int ek = e == 0 ? te[0] : e == 1 ? te[1] : e == 2 ? te[2] : te[3]; const float gk = (e == 0 ? 1.0f : e == 1 ? e1 : e == 2 ? e2 : e3) * inv;
                tok_e[tok * 4 + e] = ek; tok_g[tok * 4 + e] = gk; __hip_atomic_fetch_add(&HIST[ek], 1, __ATOMIC_RELAXED, __HIP_MEMORY_SCOPE_WORKGROUP); }
        }
    }
#undef LN1_LOAD
    lds_barrier();
    if (tid < 32) ((int*)(KWS() + WS_CTL))[CW_HIST + bx * 32 + tid] = HIST[tid];
}

__device__ __forceinline__ void slots_phase(LAS unsigned char* lds, int bx, int G) {
    const int tid = opaque_tid();
    int* ctl = (int*)(KWS() + WS_CTL);
    LAS int* RED = (LAS int*)lds;
    LAS int* TOT = RED + 1024;
    const int* tok_e = (const int*)(KWS() + WS_ROUTE); const float* tok_g = (const float*)(KWS() + WS_ROUTE + 1 * MiB);
    int* tok_slot = (int*)(KWS() + WS_ROUTE + 2 * MiB); int* slot_tok = (int*)(KWS() + WS_ROUTE + 3 * MiB);
    { const int e = tid & 31, part = tid >> 5; int tot = 0, pre = 0;
      for (int b2 = part; b2 < G; b2 += 16) { const int h = ctl[CW_HIST + b2 * 32 + e]; tot += h; if (b2 < bx) pre += h; }
      RED[(part * 32 + e) * 2] = tot; RED[(part * 32 + e) * 2 + 1] = pre; }
    __syncthreads();
    if (tid < 32) { int tot = 0, pre = 0; for (int p = 0; p < 16; ++p) { tot += RED[(p * 32 + tid) * 2]; pre += RED[(p * 32 + tid) * 2 + 1]; } TOT[tid] = tot; TOT[32 + tid] = pre; TOT[96 + tid] = 0; }
    __syncthreads();
    if (tid == 0) { int ps = 0;
#pragma unroll 1
        for (int e = 0; e < 32; ++e) { TOT[64 + e] = ps; ps += (TOT[e] + 255) & ~255; }
        TOT[128] = ps >> 8; if (bx == 0) ctl[CW_NT] = ps >> 8; }
    __syncthreads();
    if (bx == 0) { const int nt = TOT[128];
        for (int t = tid; t < nt; t += NTHR) { int e = 0;
#pragma unroll 1
            for (int k = 1; k < 32; ++k) if (TOT[64 + k] <= t * 256) e = k;
            ctl[CW_TILEE + t] = e; } }
    for (int e = bx; e < 32; e += G) { const int s0 = TOT[64 + e] + TOT[e], s1 = TOT[64 + e] + ((TOT[e] + 255) & ~255); for (int s = s0 + tid; s < s1; s += NTHR) slot_tok[s] = 0; }
    for (int it = bx + G * (tid >> 6); it < NTOK / 16; it += G * 8) {
        const int asg = it * 64 + (tid & 63); const int e = tok_e[asg]; const int rank = __hip_atomic_fetch_add(&TOT[96 + e], 1, __ATOMIC_RELAXED, __HIP_MEMORY_SCOPE_WORKGROUP); const int slot = TOT[64 + e] + TOT[32 + e] + rank;
        tok_slot[asg] = slot; slot_tok[slot] = asg >> 2;
    }
}

__device__ __forceinline__ void combine_phase(int l, int vcu, int G) {
    const int tid = opaque_tid(), lane = tid & 63, wave = __builtin_amdgcn_readfirstlane(tid >> 6);
    const int gw = vcu * NWAVES + wave, NGW = G * NWAVES;
    const bf16* X1B = (const bf16*)(KWS() + WS_X1B); const unsigned char* YB = (const unsigned char*)(KWS() + WS_YB); const int* tok_slot = (const int*)(KWS() + WS_ROUTE + 2 * MiB); const float* tok_gate = (const float*)(KWS() + WS_ROUTE + 1 * MiB);
    float* xo = KOUT(); bf16* XB = (bf16*)(KWS() + WS_XB); unsigned char* X8 = (unsigned char*)(KWS() + WS_X8);
    const float* g2 = KIN(I_LN2G) + l * D; const float* b2 = KIN(I_LN2B) + l * D;
    unsigned wg[128];
    { const unsigned* Wg = (const unsigned*)(KWS() + WS_GLRW) + (size_t)(l + 1 < NL ? l + 1 : l) * 8192 + lane;
#pragma unroll
      for (int i = 0; i < 128; ++i) wg[i] = Wg[i * 64]; }
    bf16* PG = (bf16*)(KWS() + WS_P) + PC_GLR + ((lane >> 2) & 15);
    u32x2 xw[4]; unsigned ya[4][4]; int ns0 = 0, ns1 = 0, ns2 = 0, ns3 = 0; f32x4 gv = {0.f, 0.f, 0.f, 0.f};
#define CMB_SLOTS(t_) do { const int4 _s = *(const int4*)(tok_slot + (size_t)(t_) * 4); ns0 = _s.x; ns1 = _s.y; ns2 = _s.z; ns3 = _s.w; } while (0)
#define CMB_ROWS(t_) do { const u32x2* _xr = (const u32x2*)(X1B + (size_t)(t_) * D) + lane; gv = *(const f32x4*)(tok_gate + (size_t)(t_) * 4); \
        const unsigned* _y0 = (const unsigned*)(YB + (size_t)ns0 * D) + lane; const unsigned* _y1 = (const unsigned*)(YB + (size_t)ns1 * D) + lane; \
        const unsigned* _y2 = (const unsigned*)(YB + (size_t)ns2 * D) + lane; const unsigned* _y3 = (const unsigned*)(YB + (size_t)ns3 * D) + lane; \
        _Pragma("unroll") for (int j = 0; j < 4; ++j) { xw[j] = _xr[64 * j]; ya[0][j] = _y0[64 * j]; ya[1][j] = _y1[64 * j]; ya[2][j] = _y2[64 * j]; ya[3][j] = _y3[64 * j]; } } while (0)
    if (gw < NTOK) { CMB_SLOTS(gw); CMB_ROWS(gw); if (gw + NGW < NTOK) CMB_SLOTS(gw + NGW); }
    for (int tok = gw; tok < NTOK; tok += NGW) {
        f32x4 v[4]; float s = 0.f; const f32x4 gs = gv * 0.0625f;
#pragma unroll
        for (int j = 0; j < 4; ++j) { const f32x4 xv = {bflo(xw[j].x), bfhi(xw[j].x), bflo(xw[j].y), bfhi(xw[j].y)};
            f32x2 lo = __builtin_amdgcn_cvt_pk_f32_fp8(ya[0][j], false) * gs[0], hi = __builtin_amdgcn_cvt_pk_f32_fp8(ya[0][j], true) * gs[0];
#pragma unroll
            for (int k = 1; k < 4; ++k) { lo += __builtin_amdgcn_cvt_pk_f32_fp8(ya[k][j], false) * gs[k]; hi += __builtin_amdgcn_cvt_pk_f32_fp8(ya[k][j], true) * gs[k]; }
            v[j][0] = DN_ALPHA * xv[0] + lo[0]; v[j][1] = DN_ALPHA * xv[1] + lo[1]; v[j][2] = DN_ALPHA * xv[2] + hi[0]; v[j][3] = DN_ALPHA * xv[3] + hi[1];
            s += (v[j][0] + v[j][1]) + (v[j][2] + v[j][3]); }
        if (tok + NGW < NTOK) { CMB_ROWS(tok + NGW); if (tok + 2 * NGW < NTOK) CMB_SLOTS(tok + 2 * NGW); }
        const float mean = wave_sum(s) * (1.0f / D); float q = 0.f;
#pragma unroll
        for (int j = 0; j < 4; ++j) { v[j] = v[j] - mean; q += (v[j][0] * v[j][0] + v[j][1] * v[j][1]) + (v[j][2] * v[j][2] + v[j][3] * v[j][3]); }
        const float rstd = 1.0f / sqrtf(wave_sum(q) * (1.0f / D) + LN_EPS);
        float ga[16];
#pragma unroll
        for (int c = 0; c < 16; ++c) ga[c] = 0.f;
#pragma unroll
        for (int j = 0; j < 4; ++j) { const f32x4 gg = *((const f32x4*)g2 + lane + 64 * j), bb = *((const f32x4*)b2 + lane + 64 * j);
            const f32x4 y = v[j] * rstd * gg + bb;
            if (l == NL - 1) *((f32x4*)(xo + (size_t)tok * D) + lane + 64 * j) = y;
            else { const unsigned p0 = pk2(y[0], y[1]), p1 = pk2(y[2], y[3]); *((u32x2*)(XB + (size_t)tok * D) + lane + 64 * j) = (u32x2){p0, p1};
                store_o4(X8 + (size_t)tok * D + 4 * (lane + 64 * j), y[0], y[1], y[2], y[3]);
#pragma unroll
                for (int c = 0; c < 16; ++c) { ga[c] = __builtin_amdgcn_fdot2_f32_bf16(__builtin_bit_cast(bf16x2_t, p0), __builtin_bit_cast(bf16x2_t, wg[(2 * j) * 16 + c]), ga[c], false);
                                               ga[c] = __builtin_amdgcn_fdot2_f32_bf16(__builtin_bit_cast(bf16x2_t, p1), __builtin_bit_cast(bf16x2_t, wg[(2 * j + 1) * 16 + c]), ga[c], false); } } }
        if (l != NL - 1) {
            const bool h5 = (lane & 32) != 0, h4 = (lane & 16) != 0, h3 = (lane & 8) != 0, h2 = (lane & 4) != 0;
            float r8[8], r4[4], r2[2];
#pragma unroll
            for (int i = 0; i < 8; ++i) { const float keep = h5 ? ga[8 + i] : ga[i], send = h5 ? ga[i] : ga[8 + i]; r8[i] = keep + __shfl_xor(send, 32); }
#pragma unroll
            for (int i = 0; i < 4; ++i) { const float keep = h4 ? r8[4 + i] : r8[i], send = h4 ? r8[i] : r8[4 + i]; r4[i] = keep + __shfl_xor(send, 16); }
#pragma unroll
            for (int i = 0; i < 2; ++i) { const float keep = h3 ? r4[2 + i] : r4[i], send = h3 ? r4[i] : r4[2 + i]; r2[i] = keep + __shfl_xor(send, 8); }
            const float keep = h2 ? r2[1] : r2[0], send = h2 ? r2[0] : r2[1];
            float r1 = keep + __shfl_xor(send, 4);
            r1 = dpp_add(r1, 0); r1 = dpp_add(r1, 1);
            if ((lane & 3) == 0) PG[(size_t)tok * PINP] = (bf16)f2bf(r1);
        }
    }
#undef CMB_SLOTS
#undef CMB_ROWS
}


constexpr int PH_PER_LAYER = 10, NPHASES = 2 + NL * PH_PER_LAYER;
__global__ void __launch_bounds__(NTHR, 2) trunk_fwd(Args args) {
    extern __shared__ __attribute__((aligned(16))) unsigned char lds_raw[];
    LAS unsigned char* lds = (LAS unsigned char*)lds_raw;
    volatile LAS unsigned* MISC = (volatile LAS unsigned*)(lds + MISC_OFF);
    const int tid = threadIdx.x;
    const int G = gridDim.x, bx = blockIdx.x;
    const int vcu = (G % 8 == 0) ? (bx % 8) * (G / 8) + bx / 8 : bx;
    unsigned char* ws = KWS();
    unsigned* ctl = (unsigned*)(ws + WS_CTL);
    for (int u = tid; u < (LDS_BYTES - LDSCTL_OFF) / 4; u += NTHR) ((LAS unsigned*)(lds + LDSCTL_OFF))[u] = 0u;
    __syncthreads();
    XcdBarrier bar; bar.bar = ctl + CW_BAR; bar.x = 0; bar.st = nullptr;
#if !MK_PER_PHASE
    bar = xcd_barrier_post(ctl + CW_BAR, MISC + 8);
#define GRID_BAR() xcd_barrier(bar)
#else
#define GRID_BAR() do { } while (0)
#endif
    const int lo = (int)(unsigned)ka_u64<280>(), hi = (int)(unsigned)(ka_u64<280>() >> 32);
#ifndef PH_MASK
#define PH_MASK 0x1FFF
#endif
#define PHEN(n) (((PH_MASK) >> (n)) & 1)
#define IN(k) (lo <= (k) && (k) < hi)
#define SEAM(k) do { if (rep > 0 || IN((k) + 1)) { GRID_BAR(); if (PHREP(21)) GRID_BAR(); } } while (0)

#define OG opaque_s(G)
#define OBX opaque_s(bx)
#define OVCU opaque_s(vcu)
#define OL opaque_s(l)
    if (PHEN(0) && IN(0)) for (int rep = PHREP(0); rep >= 0; --rep) { prologue_phase(lds, OVCU, OG); SEAM(0); }
    if (PHEN(1) && IN(1)) for (int rep = PHREP(1); rep >= 0; --rep) {
        pg8::DenseOrder S; S.init(KWS() + WS_MEMB, KWS() + WS_WMEM, NB * NMEM, 2048, D, OG, OBX);
        pg8::EpiBf16 E{(bf16*)(KWS() + WS_MKV), 2048};
        pg8::gemm_phase<pg8::EpiBf16, pg8::DenseOrder>(lds, D, S, E);
        SEAM(1);
    }
    for (int l = 0; l < NL; ++l) {
        const int p0 = 2 + l * PH_PER_LAYER;
        if (PHEN(2) && IN(p0 + 0)) for (int rep = PHREP(2); rep >= 0; --rep) {
            pg8::DenseOrder S; S.init(KWS() + WS_X8, KWS() + WS_WIN + (size_t)OL * PINP * D, NTOK, l == 0 ? PINP : PINP - 256, D / 2, OG, OBX);
            pg8::EpiBf16T<123, 125> E{(bf16*)(KWS() + WS_P), PINP};
            pg8::gemm_phase<pg8::EpiBf16T<123, 125>, pg8::DenseOrder, 1>(lds, D, S, E);
            SEAM(p0 + 0);
        }
        if (PHEN(4) && IN(p0 + 1)) for (int rep = PHREP(4); rep >= 0; --rep) { c1_phase(lds, OL, OVCU, OG); SEAM(p0 + 1); }
        if (PHEN(5) && IN(p0 + 2)) for (int rep = PHREP(5); rep >= 0; --rep) { m2_phase(lds, OL, OBX, OG); SEAM(p0 + 2); }
        if (PHEN(6) && IN(p0 + 3)) for (int rep = PHREP(6); rep >= 0; --rep) { m3_gh_phase(OL, OVCU, OG); SEAM(p0 + 3); }
        if (PHEN(7) && IN(p0 + 4)) for (int rep = PHREP(7); rep >= 0; --rep) {
            pg8::DenseOrder S; S.init(KWS() + WS_O, KWS() + WS_WOUT + (size_t)OL * D * D, NTOK, D, D / 2, OG, OBX);
            pg8::EpiBf16T<122, 125> E{(bf16*)(KWS() + WS_HMIX), D};
            pg8::gemm_phase<pg8::EpiBf16T<122, 125>, pg8::DenseOrder, 1>(lds, D, S, E);
            SEAM(p0 + 4);
        }
        if (PHEN(8) && IN(p0 + 5)) for (int rep = PHREP(8); rep >= 0; --rep) { ln1_router_phase(lds, OL, OBX, OG); SEAM(p0 + 5); }
        if (PHEN(9) && IN(p0 + 6)) for (int rep = PHREP(9); rep >= 0; --rep) { slots_phase(lds, OBX, OG); SEAM(p0 + 6); }
        if (PHEN(10) && IN(p0 + 7)) for (int rep = PHREP(10); rep >= 0; --rep) {
            const int ntiles = __builtin_amdgcn_readfirstlane(((const int*)(KWS() + WS_CTL))[CW_NT]);
            pg8::MoeOrder<true> S; S.init(KWS() + WS_XF, KWS() + WS_WGU + (size_t)OL * NE * 2048 * D, (const int*)(KWS() + WS_CTL) + CW_TILEE, (const int*)(KWS() + WS_ROUTE + 3 * MiB), ntiles, 2048, D, OG, OBX);
            pg8::EpiSwiglu E{(unsigned char*)(KWS() + WS_HB), (const float*)(KWS() + WS_BGU) + (size_t)OL * NE * 2048};
            pg8::gemm_phase<pg8::EpiSwiglu, pg8::MoeOrder<true>, 1>(lds, D, S, E);
            SEAM(p0 + 7);
        }
        if (PHEN(11) && IN(p0 + 8)) for (int rep = PHREP(11); rep >= 0; --rep) {
            const int ntiles = __builtin_amdgcn_readfirstlane(((const int*)(KWS() + WS_CTL))[CW_NT]);
            pg8::MoeOrder<false> S; S.init(KWS() + WS_HB, KWS() + WS_WD + (size_t)OL * NE * D * FF, (const int*)(KWS() + WS_CTL) + CW_TILEE, (const int*)(KWS() + WS_ROUTE + 3 * MiB), ntiles, D, FF, OG, OBX);
            pg8::EpiDown E{(unsigned char*)(KWS() + WS_YB), KIN(I_BDN) + (size_t)OL * NE * D};
            pg8::gemm_phase<pg8::EpiDown, pg8::MoeOrder<false>, 1>(lds, FF, S, E);
            SEAM(p0 + 8);
        }
        if (PHEN(12) && IN(p0 + 9)) for (int rep = PHREP(12); rep >= 0; --rep) { combine_phase(OL, OVCU, OG); if (rep > 0 || l + 1 < NL) SEAM(p0 + 9); }
    }
#undef IN
#undef SEAM
}

extern "C" void kernel_launch(void* const* d_in, const int* in_sizes, int n_in, void* d_out, int out_size, void* d_ws, size_t ws_size, hipStream_t stream) {
    static int grid = 0;
    if (grid == 0) {
        if (n_in != 33 || ws_size < WS_END) { fprintf(stderr, "kernel_launch: unexpected inputs (n_in %d, ws %zu need %zu)\n", n_in, ws_size, (size_t)WS_END); grid = -1; return; }
        int dev = 0, cus = 0;
        if (hipGetDevice(&dev) != hipSuccess || hipDeviceGetAttribute(&cus, hipDeviceAttributeMultiprocessorCount, dev) != hipSuccess) { grid = -1; return; }
        if (hipFuncSetAttribute((const void*)trunk_fwd, hipFuncAttributeMaxDynamicSharedMemorySize, LDS_BYTES) != hipSuccess) { grid = -1; return; }
        int per_cu = 0; (void)hipOccupancyMaxActiveBlocksPerMultiprocessor(&per_cu, (const void*)trunk_fwd, NTHR, LDS_BYTES); (void)hipGetLastError();
        grid = cus;
    }
    if (grid < 0) return;
    (void)hipMemsetAsync((char*)d_ws + WS_CTL, 0, CTL_ZERO_BYTES, stream);
    Args a{};
    for (int i = 0; i < 33; ++i) a.in[i] = (const float*)d_in[i];
    a.out = (float*)d_out; a.ws = (unsigned char*)d_ws;
#if MK_PER_PHASE
    for (int p = 0; p < NPHASES; ++p) { a.ph_lo = p; a.ph_hi = p + 1; hipLaunchKernelGGL(trunk_fwd, dim3(grid), dim3(NTHR), LDS_BYTES, stream, a); }
#else
    a.ph_lo = 0; a.ph_hi = NPHASES;
    hipLaunchKernelGGL(trunk_fwd, dim3(grid), dim3(NTHR), LDS_BYTES, stream, a);
#endif
}
```

```cpp
#include <hip/hip_runtime.h>
#include <cstdio>
#include <cstdint>

#ifndef MK_PER_PHASE
#define MK_PER_PHASE 0
#endif

#ifndef REP_MASK
#define REP_MASK 0
#endif
#define PHREP(n) (((REP_MASK) >> (n)) & 1)
#define LAS __attribute__((address_space(3)))
#define GAS __attribute__((address_space(1)))
typedef unsigned short bf16;
typedef short bf16x8 __attribute__((ext_vector_type(8)));
typedef short s16x4 __attribute__((ext_vector_type(4)));
typedef float f32x4 __attribute__((ext_vector_type(4)));
typedef float f32x2 __attribute__((ext_vector_type(2)));
typedef float f32x16 __attribute__((ext_vector_type(16)));
typedef unsigned u32x4 __attribute__((ext_vector_type(4)));
typedef unsigned u32x2 __attribute__((ext_vector_type(2)));

constexpr int NB = 8, T = 8192, D = 1024, NL = 4, NTOK = NB * T;
constexpr int PIN = 3088, PINP = 3328;
constexpr int NE = 32, FF = 1024, NMEM = 256;
constexpr int NASSIGN = NTOK * 4;
constexpr int MAXTILES = NASSIGN / 256 + NE;
constexpr int MAXSLOTS = MAXTILES * 256;
constexpr int PC_GQ = 0, PC_GK = 128, PC_GV = 256, PC_GOUT = 512, PC_HQ = 768, PC_HF = 1024, PC_HI = 1280, PC_HG = 1536;
constexpr int PC_RW = 1792, PC_MQ = 2816, PC_GLR = 3072;
constexpr float DN_ALPHA = 1.6817928305074292f;
constexpr float LN_EPS = 1e-5f, RMS_EPS = 1e-6f, RW_LN_EPS = 64e-5f;

constexpr size_t MiB = 1u << 20;
constexpr size_t WS_CTL = 0, CTL_ZERO_BYTES = 32768;
constexpr size_t WS_WIN = 1 * MiB;
constexpr size_t WS_WOUT = WS_WIN + 26 * MiB;
constexpr size_t WS_WMEM = WS_WOUT + 8 * MiB;
constexpr size_t WS_WGU = WS_WMEM + 4 * MiB;
constexpr size_t WS_WD = WS_WGU + 512 * MiB;
constexpr size_t WS_BGU = WS_WD + 256 * MiB;
constexpr size_t WS_LORA = WS_BGU + 1 * MiB;
constexpr size_t WS_GLRW = WS_LORA + 512 * 1024;
constexpr size_t WS_MEMB = WS_LORA + 1 * MiB;
constexpr size_t WS_MKV = WS_MEMB + 4 * MiB;
constexpr size_t WS_XB = WS_MKV + 8 * MiB;
constexpr size_t WS_X1B = WS_XB + 128 * MiB;
constexpr size_t WS_XF = WS_X1B + 128 * MiB;
constexpr size_t WS_X1F = WS_XF + 256 * MiB;
constexpr size_t WS_X8 = WS_X1F;
constexpr size_t WS_O = WS_X1F + 256 * MiB;
constexpr size_t WS_HMIX = WS_O + 128 * MiB;
constexpr size_t WS_ROUTE = WS_HMIX + 128 * MiB;
constexpr size_t WS_GBUF = WS_ROUTE + 6 * MiB;
constexpr size_t WS_BONUS = WS_GBUF + 32 * MiB;
constexpr size_t WS_BIG = WS_BONUS + 1 * MiB;
constexpr size_t WS_P = WS_BIG;
constexpr size_t WS_ORAW = WS_P + 416 * MiB;
constexpr size_t WS_HB = WS_BIG;
constexpr size_t WS_YB = WS_HB + 528 * MiB;
constexpr size_t WS_CHK = WS_ORAW;
constexpr size_t WS_HQ = WS_CHK, WS_HK = WS_HQ + 32 * MiB, WS_HVT = WS_HK + 32 * MiB, WS_HDS = WS_HVT + 32 * MiB, WS_HS = WS_HDS + 128 * MiB, WS_HBE = WS_HS + 64 * MiB;
constexpr size_t WS_GQ = WS_HBE + 2 * MiB, WS_GK = WS_GQ + 16 * MiB, WS_GVT = WS_GK + 16 * MiB, WS_GDS = WS_GVT + 32 * MiB, WS_GS = WS_GDS + 64 * MiB, WS_GBE = WS_GS + 32 * MiB;
constexpr size_t WS_RR = WS_GBE + 1 * MiB, WS_RB = WS_RR + 32 * MiB, WS_RK = WS_RB + 32 * MiB, WS_RW = WS_RK + 32 * MiB, WS_RVT = WS_RW + 32 * MiB;
constexpr size_t WS_RVG = WS_RVT + 32 * MiB;
constexpr size_t WS_RU = WS_RVG + 32 * MiB, WS_RP = WS_RU + 64 * MiB, WS_RQ = WS_RP + 64 * MiB, WS_RS = WS_RQ + 128 * MiB;
constexpr size_t WS_END = WS_RS + 64 * MiB;
static_assert(WS_YB + 528 * MiB <= WS_END, "overlay");
static_assert(WS_END <= (size_t)4096 * MiB, "workspace");
constexpr int CW_TMO = 0;
constexpr int CW_BAR = 4096;
constexpr int CW_HIST = 16384;
constexpr int CW_NT = 32768;
constexpr int CW_TILEE = 32768 + 64;
constexpr int CW_PADSTART = 40960;

constexpr int RING_BYTES = 131072;
constexpr int LDSCTL_OFF = 162816, MISC_OFF = LDSCTL_OFF + 320;
constexpr int LDS_BYTES = 163840;
constexpr int NWAVES = 8, NTHR = 512;

#define RLX_AGENT __ATOMIC_RELAXED, __HIP_MEMORY_SCOPE_AGENT
#define LDS_WAIT() asm volatile("s_waitcnt lgkmcnt(0)" ::: "memory")
#define VM_WAIT() asm volatile("s_waitcnt vmcnt(0)" ::: "memory")

__device__ __forceinline__ float bf2f(unsigned short b) { return __builtin_bit_cast(float, (unsigned)b << 16); }
__device__ __forceinline__ float bflo(unsigned w) { return __builtin_bit_cast(float, w << 16); }
__device__ __forceinline__ float bfhi(unsigned w) { return __builtin_bit_cast(float, w & 0xffff0000u); }
typedef __bf16 bf16x2_t __attribute__((ext_vector_type(2)));
__device__ __forceinline__ unsigned cvt_pk_bf16(float lo, float hi) { const f32x2 v = {lo, hi}; const bf16x2_t b = __builtin_convertvector(v, bf16x2_t); return __builtin_bit_cast(unsigned, b); }
__device__ __forceinline__ unsigned pk2(float lo, float hi) { return cvt_pk_bf16(lo, hi); }
__device__ __forceinline__ unsigned f2bf(float f) { return cvt_pk_bf16(f, 0.f) & 0xffffu; }
__device__ __forceinline__ float o_q(float y) { return __builtin_amdgcn_fmed3f(y * 4.0f, -448.0f, 448.0f); }
__device__ __forceinline__ void store_o4(unsigned char* p, float y0, float y1, float y2, float y3) { int w = __builtin_amdgcn_cvt_pk_fp8_f32(o_q(y0), o_q(y1), 0, false); w = __builtin_amdgcn_cvt_pk_fp8_f32(o_q(y2), o_q(y3), w, true); *(unsigned*)p = (unsigned)w; }
__device__ __forceinline__ float fast_exp(float x) { return __builtin_amdgcn_exp2f(x * 1.4426950408889634f); }
__device__ __forceinline__ float fast_sigmoid(float x) { return __builtin_amdgcn_rcpf(1.0f + fast_exp(-x)); }
__device__ __forceinline__ float silu_f(float x) { return x * fast_sigmoid(x); }
__device__ __forceinline__ int opaque_tid() { int t = threadIdx.x; asm volatile("" : "+v"(t)); return t; }
__device__ __forceinline__ int opaque_s(int v) { asm volatile("" : "+s"(v)); return v; }
__device__ __forceinline__ void lds_barrier() { asm volatile("s_waitcnt lgkmcnt(0)" ::: "memory"); __builtin_amdgcn_s_barrier(); asm volatile("" ::: "memory"); }
__device__ __forceinline__ float dpp_add(float x, const int sel) {
    const int xi = __builtin_bit_cast(int, x); int r;
    switch (sel) { case 0: r = __builtin_amdgcn_update_dpp(xi, xi, 0xB1, 0xf, 0xf, false); break;
                   case 1: r = __builtin_amdgcn_update_dpp(xi, xi, 0x4E, 0xf, 0xf, false); break;
                   case 2: r = __builtin_amdgcn_update_dpp(xi, xi, 0x141, 0xf, 0xf, false); break;
                   default: r = __builtin_amdgcn_update_dpp(xi, xi, 0x140, 0xf, 0xf, false); break; }
    return x + __builtin_bit_cast(float, r);
}
__device__ __forceinline__ float wave_sum(float v) {
    v = dpp_add(v, 0); v = dpp_add(v, 1); v = dpp_add(v, 2); v = dpp_add(v, 3);
    v += __builtin_bit_cast(float, __builtin_amdgcn_update_dpp(0, __builtin_bit_cast(int, v), 0x142, 0xa, 0xf, false));
    v += __builtin_bit_cast(float, __builtin_amdgcn_update_dpp(0, __builtin_bit_cast(int, v), 0x143, 0xc, 0xf, false));
    return __builtin_bit_cast(float, __builtin_amdgcn_readlane(__builtin_bit_cast(int, v), 63));
}

namespace pg8 {
constexpr int BM = 256, BK = 64, HALF = 128, HTB = HALF * BK * 2, STAGE_BYTES = 8 * HTB, NXCD = 8, WGM = 8;
__host__ __device__ __forceinline__ int lds_byte(int r, int c) { const int st = (r >> 4) * 2 + (c >> 5), rr = r & 15, cc = c & 31, ob = rr * 64 + cc * 2; return st * 1024 + (ob ^ (((ob >> 9) & 1) << 5)); }
__host__ __device__ __forceinline__ void stage_rc(int b, int& R, int& C) { const int st = b / 1024, sb = b % 1024, swz = sb ^ (((sb >> 9) & 1) << 5); R = (st >> 1) * 16 + swz / 64; C = (st & 1) * 32 + (swz % 64) / 2; }
__host__ __device__ __forceinline__ int perm32(int rho) { const int n = rho >> 4, i = rho & 15; return 8 * (i >> 2) + 4 * n + (i & 3); }

typedef int v4i_t __attribute__((ext_vector_type(4)));
typedef int v8i_t __attribute__((ext_vector_type(8)));
struct Unit { int pm, pn, e; const char* A; const char* B; };
__device__ __forceinline__ unsigned asm_gload_u32(const void* p) { unsigned v; asm volatile("global_load_dword %0, %1, off" : "=v"(v) : "v"(p) : "memory"); return v; }

__device__ __forceinline__ bool static_tile(int i, int G, int c, int nM, int nN, int& pm, int& pn) {
    const int nwg = nM * nN; const long L = (long)i * G + c; if (L >= nwg) return false;
    int wgid = (int)L; { const int q = nwg / NXCD, r = nwg % NXCD, xcd = wgid % NXCD, off = wgid / NXCD; wgid = (xcd < r ? xcd * (q + 1) : r * (q + 1) + (xcd - r) * q) + off; }
    const int nig = WGM * nN, gid = wgid / nig, fm = gid * WGM, gsz = (nM - fm) < WGM ? (nM - fm) : WGM;
    pm = fm + ((wgid % nig) % gsz); pn = (wgid % nig) / gsz; return true;
}
struct DenseOrder {
    static constexpr bool GATHER = false, HAS_E = false;
    const char* A; const char* B; int nM, nN, G, c; size_t tstep;
    __device__ __forceinline__ void init(const void* A_, const void* B_, int M, int N, int K, int G_, int c_) { A = (const char*)A_; B = (const char*)B_; nM = M / BM; nN = N / BM; G = G_; c = c_; tstep = (size_t)BM * K * 2; }
    __device__ __forceinline__ bool next(int i, Unit& u) const { if (!static_tile(i, G, c, nM, nN, u.pm, u.pn)) return false; u.e = 0; u.A = A + (size_t)u.pm * tstep; u.B = B + (size_t)u.pn * tstep; return true; }
    __device__ __forceinline__ unsigned row_tok(const Unit&, int) const { return 0; }
};
template <bool GATHER_> struct MoeOrder {
    static constexpr bool GATHER = GATHER_, HAS_E = true;
    const char* A; const char* B; const int* tile_e; const int* slot_tok; int nM, nN, G, c; size_t tstep, estep;
    __device__ __forceinline__ void init(const void* A_, const void* B_, const int* tile_e_, const int* slot_tok_, int ntiles, int Nper, int Kbytes, int G_, int c_) {
        A = (const char*)A_; B = (const char*)B_; tile_e = tile_e_; slot_tok = slot_tok_; nM = ntiles; nN = Nper / BM; G = G_; c = c_; tstep = (size_t)BM * Kbytes; estep = (size_t)Nper * Kbytes; }
    __device__ __forceinline__ bool next(int i, Unit& u) const { if (!static_tile(i, G, c, nM, nN, u.pm, u.pn)) return false;
        u.e = __builtin_amdgcn_readfirstlane(tile_e[u.pm]); u.A = GATHER_ ? A : A + (size_t)u.pm * tstep; u.B = B + (size_t)u.e * estep + (size_t)u.pn * tstep; return true; }
    __device__ __forceinline__ unsigned row_tok(const Unit& u, int r) const { return (unsigned)slot_tok[u.pm * BM + r]; }
    __device__ __forceinline__ bool next_static(int i, Unit& u) const { return static_tile(i, G, c, nM, nN, u.pm, u.pn); }
    __device__ __forceinline__ const int* e_ptr(const Unit& u) const { return tile_e + u.pm; }
    __device__ __forceinline__ const int* tok_ptr(const Unit& u, int r) const { return slot_tok + u.pm * BM + r; }
    __device__ __forceinline__ void finish(Unit& u, int e) const { u.e = e; u.A = GATHER_ ? A : A + (size_t)u.pm * tstep; u.B = B + (size_t)e * estep + (size_t)u.pn * tstep; }
};

template <int WSCALE_ = 127, int ASCALE_ = 127>
struct EpiBf16T {
    static constexpr bool PERM = true; static constexpr int WSCALE = WSCALE_, ASCALE = ASCALE_;
    bf16* O; int ldc;
    __device__ __forceinline__ void init(f32x4 (&acc)[2][2][4][2], const Unit&, int, int) const {
#pragma unroll
        for (int a = 0; a < 2; ++a)
#pragma unroll
            for (int b = 0; b < 2; ++b)
#pragma unroll
                for (int m = 0; m < 4; ++m)
#pragma unroll
                    for (int n = 0; n < 2; ++n) acc[a][b][m][n] = (f32x4){0.f, 0.f, 0.f, 0.f}; }
    __device__ __forceinline__ void operator()(const f32x4 (&acc)[2][2][4][2], const Unit& u, int wr, int wc, int fr, int fq) const {
        const int row0 = u.pm * BM + wr * 64 + fr, col0 = u.pn * BM + wc * 32 + 8 * fq;
#pragma unroll
        for (int ai = 0; ai < 2; ++ai)
#pragma unroll
            for (int m = 0; m < 4; ++m) { bf16* rowp = O + (size_t)(row0 + ai * HALF + m * 16) * ldc + col0;
#pragma unroll
                for (int bj = 0; bj < 2; ++bj) { const f32x4 v0 = acc[ai][bj][m][0], v1 = acc[ai][bj][m][1];
                    u32x4 w; w.x = cvt_pk_bf16(v0[0], v0[1]); w.y = cvt_pk_bf16(v0[2], v0[3]); w.z = cvt_pk_bf16(v1[0], v1[1]); w.w = cvt_pk_bf16(v1[2], v1[3]);
                    *(u32x4*)(rowp + bj * HALF) = w; } }
    }
};
typedef EpiBf16T<> EpiBf16;
struct EpiSwiglu {
    static constexpr bool PERM = false; static constexpr int WSCALE = 123, ASCALE = 127;
    unsigned char* H; const float* bias;
    __device__ __forceinline__ void init(f32x4 (&acc)[2][2][4][2], const Unit& u, int wc, int fq) const {
        const float* bp = bias + (size_t)u.e * 2048 + u.pn * 256 + wc * 32 + 4 * fq;
#pragma unroll
        for (int bj = 0; bj < 2; ++bj)
#pragma unroll
            for (int n = 0; n < 2; ++n) { const f32x4 bv = *(const f32x4*)(bp + bj * HALF + n * 16);
#pragma unroll
                for (int ai = 0; ai < 2; ++ai)
#pragma unroll
                    for (int m = 0; m < 4; ++m) acc[ai][bj][m][n] = bv; } }
    __device__ __forceinline__ void operator()(const f32x4 (&acc)[2][2][4][2], const Unit& u, int wr, int wc, int fr, int fq) const {
        const int row0 = u.pm * BM + wr * 64 + fr, colh = u.pn * 128 + wc * 32 + 8 * fq;
        f32x2 kc = {-1.702f * 1.4426950408889634f, -1.702f * 1.4426950408889634f}, k1 = {1.0f, 1.0f}; asm volatile("" : "+v"(kc), "+v"(k1));
#pragma unroll
        for (int ai = 0; ai < 2; ++ai)
#pragma unroll
            for (int m = 0; m < 4; ++m) { unsigned char* rowp = H + (size_t)(row0 + ai * HALF + m * 16) * FF + colh;
                float o[8];
#pragma unroll
                for (int n = 0; n < 2; ++n)
#pragma unroll
                    for (int hq = 0; hq < 2; ++hq) { const f32x4 g4 = acc[ai][0][m][n], u4 = acc[ai][1][m][n]; f32x2 g, up, e, r;
#pragma unroll
                        for (int j = 0; j < 2; ++j) { g[j] = __builtin_amdgcn_fmed3f(g4[2 * hq + j], -3.0e38f, 7.0f); up[j] = __builtin_amdgcn_fmed3f(u4[2 * hq + j], -7.0f, 7.0f); }
                        const f32x2 t = g * kc;
#pragma unroll
                        for (int j = 0; j < 2; ++j) e[j] = __builtin_amdgcn_exp2f(t[j]);
                        const f32x2 d = e + k1;
#pragma unroll
                        for (int j = 0; j < 2; ++j) r[j] = __builtin_amdgcn_rcpf(d[j]);
                        const f32x2 glu = g * r, ov = up * glu + glu;
                        o[n * 4 + 2 * hq] = ov[0]; o[n * 4 + 2 * hq + 1] = ov[1]; }
                int w0 = __builtin_amdgcn_cvt_pk_fp8_f32(o[0], o[1], 0, false); w0 = __builtin_amdgcn_cvt_pk_fp8_f32(o[2], o[3], w0, true);
                int w1 = __builtin_amdgcn_cvt_pk_fp8_f32(o[4], o[5], 0, false); w1 = __builtin_amdgcn_cvt_pk_fp8_f32(o[6], o[7], w1, true);
                *(u32x2*)rowp = (u32x2){(unsigned)w0, (unsigned)w1}; }
    }
};
struct EpiDown {
    static constexpr bool PERM = true; static constexpr int WSCALE = 122, ASCALE = 127;
    unsigned char* Y; const float* bias;
    __device__ __forceinline__ void init(f32x4 (&acc)[2][2][4][2], const Unit& u, int wc, int fq) const {
        const float* bp = bias + (size_t)u.e * 1024 + u.pn * BM + wc * 32 + 8 * fq;
#pragma unroll
        for (int bj = 0; bj < 2; ++bj)
#pragma unroll
            for (int n = 0; n < 2; ++n) { const f32x4 bv = *(const f32x4*)(bp + bj * HALF + 4 * n);
#pragma unroll
                for (int ai = 0; ai < 2; ++ai)
#pragma unroll
                    for (int m = 0; m < 4; ++m) acc[ai][bj][m][n] = bv; } }
    __device__ __forceinline__ void operator()(const f32x4 (&acc)[2][2][4][2], const Unit& u, int wr, int wc, int fr, int fq) const {
        const int row0 = u.pm * BM + wr * 64 + fr, col0 = u.pn * BM + wc * 32 + 8 * fq;
#pragma unroll
        for (int ai = 0; ai < 2; ++ai)
#pragma unroll
            for (int m = 0; m < 4; ++m) { const int row = row0 + ai * HALF + m * 16; const float g = 16.0f; unsigned char* rowp = Y + (size_t)row * D + col0;
#pragma unroll
                for (int bj = 0; bj < 2; ++bj) { const f32x4 v0 = acc[ai][bj][m][0] * g, v1 = acc[ai][bj][m][1] * g;
                    int w0 = __builtin_amdgcn_cvt_pk_fp8_f32(v0[0], v0[1], 0, false); w0 = __builtin_amdgcn_cvt_pk_fp8_f32(v0[2], v0[3], w0, true);
                    int w1 = __builtin_amdgcn_cvt_pk_fp8_f32(v1[0], v1[1], 0, false); w1 = __builtin_amdgcn_cvt_pk_fp8_f32(v1[2], v1[3], w1, true);
                    *(u32x2*)(rowp + bj * HALF) = (u32x2){(unsigned)w0, (unsigned)w1}; } }
    }
};

template <class Epi, class Sched, int ES = 2, bool ALIGN_EPI = true>
__device__ __forceinline__ void gemm_phase(LAS unsigned char* lds, const int K, const Sched& S, const Epi& E) {
    constexpr bool GA = Sched::GATHER;
    const int tid = opaque_tid(), wid = __builtin_amdgcn_readfirstlane(tid >> 6), lane = tid & 63, wr = wid >> 2, wc = wid & 3, fr = lane & 15, fq = lane >> 4;
    const int nt = K * ES / (BK * 2);
    unsigned voffA[2], voffB[2]; int Rr[2]; unsigned Cb[2];
#pragma unroll
    for (int i = 0; i < 2; ++i) { int R, C; stage_rc(tid * 16 + i * 8192, R, C); const int Rb = Epi::PERM ? ((R & ~31) + perm32(R & 31)) : R;
        voffA[i] = (unsigned)(R * K * ES + C * 2); voffB[i] = (unsigned)(Rb * K * ES + C * 2); Rr[i] = R; Cb[i] = (unsigned)C * 2u; }
    const size_t kstep = (size_t)(BK * 2);
    const size_t hstep = (size_t)HALF * K * ES;
    const unsigned ldsw = (unsigned)wid * 1024u;
    const int aoff0 = lds_byte(wr * 64 + fr, fq * 8), aoff1 = lds_byte(wr * 64 + fr, fq * 8 + 32);
    const int boff0 = lds_byte(wc * 32 + fr, fq * 8), boff1 = lds_byte(wc * 32 + fr, fq * 8 + 32);
    unsigned cOff[2][2], nOff[2][2], sOff[2][2];
#define PG8_SA(b, h) (((b) * 2 + (h)) * HTB)
#define PG8_SB(b, h) ((4 + (b) * 2 + (h)) * HTB)
#define PG8_STAGE(bufoff, gbase, voff) do { _Pragma("unroll") for (int _i = 0; _i < 2; ++_i) \
        __builtin_amdgcn_global_load_lds((const unsigned*)((const char*)(gbase) + (voff)[_i]), (LAS unsigned*)(lds + (bufoff) + ldsw + _i * 8192), 16, 0, 0); } while (0)
#define PG8_STAGE_A(bufoff, gbase, half, OFF) do { if constexpr (GA) { PG8_STAGE(bufoff, gbase, (OFF)[half]); } else { PG8_STAGE(bufoff, (gbase) + (half) * hstep, voffA); } } while (0)
#define PG8_LDA(dst, b, h) do { if constexpr (ES == 2) { _Pragma("unroll") for (int m = 0; m < 4; ++m) _Pragma("unroll") for (int k = 0; k < 2; ++k) dst[m][k] = *(const LAS bf16x8*)(lds + PG8_SA(b, h) + (k ? aoff1 : aoff0) + m * 2048); } \
        else { _Pragma("unroll") for (int m = 0; m < 4; ++m) dst##8[m] = __builtin_shufflevector(*(const LAS v4i_t*)(lds + PG8_SA(b, h) + aoff0 + m * 2048), *(const LAS v4i_t*)(lds + PG8_SA(b, h) + aoff1 + m * 2048), 0, 1, 2, 3, 4, 5, 6, 7); } } while (0)
#define PG8_LDB(dst, b, h) do { if constexpr (ES == 2) { _Pragma("unroll") for (int n = 0; n < 2; ++n) _Pragma("unroll") for (int k = 0; k < 2; ++k) dst[n][k] = *(const LAS bf16x8*)(lds + PG8_SB(b, h) + (k ? boff1 : boff0) + n * 2048); } \
        else { _Pragma("unroll") for (int n = 0; n < 2; ++n) dst##8[n] = __builtin_shufflevector(*(const LAS v4i_t*)(lds + PG8_SB(b, h) + boff0 + n * 2048), *(const LAS v4i_t*)(lds + PG8_SB(b, h) + boff1 + n * 2048), 0, 1, 2, 3, 4, 5, 6, 7); } } while (0)
#define PG8_MMA(ai, bj, At, Bt) do { __builtin_amdgcn_s_setprio(1); _Pragma("unroll") for (int m = 0; m < 4; ++m) _Pragma("unroll") for (int n = 0; n < 2; ++n) { \
        if constexpr (ES == 2) { _Pragma("unroll") for (int k = 0; k < 2; ++k) acc[ai][bj][m][n] = __builtin_amdgcn_mfma_f32_16x16x32_bf16(Bt[n][k], At[m][k], acc[ai][bj][m][n], 0, 0, 0); } \
        else { asm volatile("v_mfma_scale_f32_16x16x128_f8f6f4 %0, %1, %2, %0, %3, %4 op_sel_hi:[0,0,0]" : "+v"(acc[ai][bj][m][n]) : "v"(Bt##8[n]), "v"(At##8[m]), "v"(wscale_v), "v"(ascale_v)); } } \
        __builtin_amdgcn_s_setprio(0); } while (0)
#define PG8_WAIT_V(n) asm volatile("s_waitcnt vmcnt(" #n ")" ::: "memory")
#define PG8_WAIT_L(n) asm volatile("s_waitcnt lgkmcnt(" #n ")" ::: "memory")
#define PG8_WAIT_VR() do { if (relax) { if constexpr (GA) PG8_WAIT_V(13); else PG8_WAIT_V(9); } else PG8_WAIT_V(8); } while (0)
#define PG8_BAR __builtin_amdgcn_s_barrier()
#define PG8_SCHED __builtin_amdgcn_sched_barrier(0)
#define PG8_GOFF(dst, u) do { if constexpr (GA) { _Pragma("unroll") for (int _h = 0; _h < 2; ++_h) _Pragma("unroll") for (int _i = 0; _i < 2; ++_i) \
        dst[_h][_i] = S.row_tok(u, _h * HALF + Rr[_i]) * (unsigned)(K * ES) + Cb[_i]; } } while (0)
    Unit cur, nxt; int ui = 0;
    if (!S.next(0, cur)) return;
#ifndef GEMM_STAGGER_TICKS
#define GEMM_STAGGER_TICKS 0
#endif
    if (GEMM_STAGGER_TICKS > 0) {
        const unsigned long long t0 = __builtin_amdgcn_s_memrealtime(), dl = (unsigned long long)((S.c * 5) & 15) * GEMM_STAGGER_TICKS;
        while (__builtin_amdgcn_s_memrealtime() - t0 < dl) __builtin_amdgcn_s_sleep(8);
    }
    f32x4 acc[2][2][4][2];
    E.init(acc, cur, wc, fq);
    int wscale_v = Epi::WSCALE, ascale_v = Epi::ASCALE; asm volatile("" : "+v"(wscale_v), "+v"(ascale_v));
    bf16x8 At[4][2], B0[2][2], B1[2][2];
    v8i_t At8[4], B08[2], B18[2];
    const char* cA = cur.A; const char* cB = cur.B;
    PG8_GOFF(cOff, cur);
#pragma unroll
    for (int h = 0; h < 2; ++h)
#pragma unroll
        for (int i = 0; i < 2; ++i) { nOff[h][i] = 0u; sOff[h][i] = 0u; }
    if constexpr (GA) { VM_WAIT(); }
    PG8_STAGE(PG8_SB(0, 0), cB, voffB); PG8_STAGE(PG8_SB(0, 1), cB + hstep, voffB); PG8_STAGE_A(PG8_SA(0, 0), cA, 0, cOff); PG8_STAGE_A(PG8_SA(0, 1), cA, 1, cOff);
    if (wr == 1) PG8_BAR;
    PG8_WAIT_V(2); PG8_BAR;
    PG8_STAGE(PG8_SB(1, 0), cB + kstep, voffB); PG8_STAGE_A(PG8_SA(1, 0), cA + kstep, 0, cOff); PG8_STAGE(PG8_SB(1, 1), cB + hstep + kstep, voffB);
    PG8_WAIT_V(6); PG8_BAR;
    for (;;) {
        bool has_next; const char* nA = cA; const char* nB = cB;
        unsigned eraw = 0u, traw[2][2] = {{0u, 0u}, {0u, 0u}};
        if constexpr (Sched::HAS_E) {
            has_next = S.next_static(ui + 1, nxt);
            if (has_next) { eraw = asm_gload_u32(S.e_ptr(nxt));
                if constexpr (GA) {
#pragma unroll
                    for (int h = 0; h < 2; ++h)
#pragma unroll
                        for (int i = 0; i < 2; ++i) traw[h][i] = asm_gload_u32(S.tok_ptr(nxt, h * HALF + Rr[i])); } }
        } else { has_next = S.next(ui + 1, nxt); if (has_next) { nA = nxt.A; nB = nxt.B; } }
#pragma unroll 1
        for (int t = 0; t < nt; t += 2) {
            const bool last = (t == nt - 2);
            const bool relax = Sched::HAS_E && has_next && t == 0;
            if constexpr (Sched::HAS_E) { if (last) {
                if (has_next) {
                    if constexpr (GA) asm volatile("" : "+v"(eraw), "+v"(traw[0][0]), "+v"(traw[0][1]), "+v"(traw[1][0]), "+v"(traw[1][1]) :: "memory"); else asm volatile("" : "+v"(eraw) :: "memory");
                    S.finish(nxt, __builtin_amdgcn_readfirstlane((int)eraw)); nA = nxt.A; nB = nxt.B;
                    if constexpr (GA) {
#pragma unroll
                        for (int h = 0; h < 2; ++h)
#pragma unroll
                            for (int i = 0; i < 2; ++i) nOff[h][i] = traw[h][i] * (unsigned)(K * ES) + Cb[i]; }
                } else if constexpr (GA) {
#pragma unroll
                    for (int h = 0; h < 2; ++h)
#pragma unroll
                        for (int i = 0; i < 2; ++i) nOff[h][i] = cOff[h][i]; } } }
            const char* a1 = cA + (size_t)(t + 1) * kstep;
            const char* a2 = last ? nA : cA + (size_t)(t + 2) * kstep; const char* b2 = last ? nB : cB + (size_t)(t + 2) * kstep;
            const char* a3 = a2 + kstep; const char* b3 = b2 + kstep;
            if constexpr (GA) {
#pragma unroll
                for (int h = 0; h < 2; ++h)
#pragma unroll
                    for (int i = 0; i < 2; ++i) sOff[h][i] = last ? nOff[h][i] : cOff[h][i]; }
            PG8_LDB(B0, 0, 0); PG8_LDB(B1, 0, 1); PG8_SCHED; PG8_LDA(At, 0, 0); PG8_STAGE_A(PG8_SA(1, 1), a1, 1, cOff);
            PG8_WAIT_VR(); PG8_WAIT_L(0); PG8_BAR; PG8_MMA(0, 0, At, B0); PG8_MMA(0, 1, At, B1); PG8_BAR; PG8_SCHED;
            PG8_LDA(At, 0, 1); PG8_STAGE(PG8_SB(0, 0), b2, voffB); PG8_STAGE(PG8_SB(0, 1), b2 + hstep, voffB); PG8_STAGE_A(PG8_SA(0, 0), a2, 0, sOff);
            PG8_WAIT_VR(); PG8_WAIT_L(0); PG8_BAR; PG8_MMA(1, 0, At, B0); PG8_MMA(1, 1, At, B1); PG8_BAR; PG8_SCHED;
            PG8_LDB(B0, 1, 0); PG8_LDB(B1, 1, 1); PG8_SCHED; PG8_LDA(At, 1, 0); PG8_STAGE_A(PG8_SA(0, 1), a2, 1, sOff);
            PG8_WAIT_V(8); PG8_WAIT_L(0); PG8_BAR; PG8_MMA(0, 0, At, B0); PG8_MMA(0, 1, At, B1); PG8_BAR; PG8_SCHED;
            PG8_LDA(At, 1, 1); PG8_STAGE(PG8_SB(1, 0), b3, voffB); PG8_STAGE(PG8_SB(1, 1), b3 + hstep, voffB); PG8_STAGE_A(PG8_SA(1, 0), a3, 0, sOff);
            PG8_WAIT_V(8); PG8_WAIT_L(0); PG8_BAR; PG8_MMA(1, 0, At, B0); PG8_MMA(1, 1, At, B1); PG8_BAR; PG8_SCHED;
        }
        if constexpr (ALIGN_EPI) { if (wr == 0) PG8_BAR; }
        if constexpr (ES == 1) { asm volatile("s_nop 15\n\ts_nop 15" ::: "memory"); }
        E(acc, cur, wr, wc, fr, fq);
        if (PHREP(25)) E(acc, cur, wr, wc, fr, fq);
        if (!has_next) break;
        E.init(acc, nxt, wc, fq);
        cur = nxt; cA = nA; cB = nB; ++ui;
        if constexpr (GA) {
#pragma unroll
            for (int h = 0; h < 2; ++h)
#pragma unroll
                for (int i = 0; i < 2; ++i) cOff[h][i] = nOff[h][i]; }
        if constexpr (ALIGN_EPI) { if (wr == 1) PG8_BAR; }
    }
    PG8_WAIT_V(0);
    if constexpr (!ALIGN_EPI) { if (wr == 0) PG8_BAR; }
    PG8_BAR;
#undef PG8_SA
#undef PG8_SB
#undef PG8_STAGE
#undef PG8_STAGE_A
#undef PG8_LDA
#undef PG8_LDB
#undef PG8_MMA
#undef PG8_WAIT_V
#undef PG8_WAIT_L
#undef PG8_WAIT_VR
#undef PG8_BAR
#undef PG8_SCHED
#undef PG8_GOFF
}
}

#define XB_TMO      128
#define XB_XCNT(j)  (256  + 64 * (j))
#define XB_XSUB(j)  (1280 + 64 * (j))
#define XB_XGEN(j)  (2304 + 64 * (j))
#define XB_TOP      3328
#define XB_TOPGEN   3392
#define XCD_BAR_WORDS 3456
#define XB_SPIN_CAP (1u << 18)
__device__ __forceinline__ unsigned xb_ld(unsigned* p)              { return __hip_atomic_load(p, __ATOMIC_RELAXED, __HIP_MEMORY_SCOPE_AGENT); }
__device__ __forceinline__ unsigned xb_add(unsigned* p, unsigned v) { return __hip_atomic_fetch_add(p, v, __ATOMIC_RELAXED, __HIP_MEMORY_SCOPE_AGENT); }
__device__ __forceinline__ unsigned xb_xcc_id() { return (unsigned)__builtin_amdgcn_s_getreg((3 << 11) | 20) & 0xFu; }
#define XB_SPIN(cond, bar) do { unsigned _sp = 0; while (cond) { __builtin_amdgcn_s_sleep(1); \
    if ((++_sp & 255u) == 0u) { if (xb_ld(&(bar)[XB_TMO])) break; if (_sp > XB_SPIN_CAP) { atomicAdd(&(bar)[XB_TMO], 1u); break; } } } } while (0)
struct XcdBarrier { unsigned* bar; unsigned x; volatile LAS unsigned* st; };
__device__ __forceinline__ XcdBarrier xcd_barrier_post(unsigned* bar, volatile LAS unsigned* st) {
    XcdBarrier b; b.bar = bar; b.x = xb_xcc_id(); b.st = st;
    if (threadIdx.x == 0) (void)xb_add(&bar[XB_XCNT(b.x)], 1u);
    return b;
}
__device__ __forceinline__ void xcd_barrier_complete(unsigned* bar, unsigned x, unsigned& nloc, unsigned& nx) {
    const unsigned G = gridDim.x * gridDim.y * gridDim.z;
    unsigned sum, cnt, mine, sp = 0u;
    for (;;) {
        sum = 0u; cnt = 0u; mine = 0u;
#pragma unroll
        for (unsigned j = 0; j < 16; ++j) { const unsigned c = xb_ld(&bar[XB_XCNT(j)]); sum += c; cnt += (c > 0u) ? 1u : 0u; mine = (j == x) ? c : mine; }
        if (sum == G) break;
        __builtin_amdgcn_s_sleep(1);
        if ((++sp & 255u) == 0u) { if (xb_ld(&bar[XB_TMO])) break; if (sp > XB_SPIN_CAP) { atomicAdd(&bar[XB_TMO], 1u); break; } }
    }
    nloc = mine > 0u ? mine : 1u; nx = cnt > 0u ? cnt : 1u;
}
__device__ __forceinline__ void xcd_barrier(const XcdBarrier& b) {
    asm volatile("s_waitcnt vmcnt(0)" ::: "memory");
    __syncthreads();
    if (threadIdx.x == 0) {
        unsigned* bar = b.bar;
        __builtin_amdgcn_s_waitcnt(0);
        unsigned nloc = b.st[0], nx = b.st[1];
        if (nloc == 0u) { xcd_barrier_complete(bar, b.x, nloc, nx); b.st[0] = nloc; b.st[1] = nx; }
        const unsigned old = xb_add(&bar[XB_XSUB(b.x)], 1u);
        const unsigned gen = old / nloc;
        if (old + 1u == (gen + 1u) * nloc) {
            __builtin_amdgcn_fence(__ATOMIC_RELEASE, "agent");
            asm volatile("s_waitcnt vmcnt(0)" ::: "memory");
            const unsigned og = xb_add(&bar[XB_TOP], 1u);
            const unsigned tg = og / nx;
            if (og + 1u == (tg + 1u) * nx) xb_add(&bar[XB_TOPGEN], 1u);
            else XB_SPIN(xb_ld(&bar[XB_TOPGEN]) == tg, bar);
            __builtin_amdgcn_fence(__ATOMIC_ACQUIRE, "agent");
            xb_add(&bar[XB_XGEN(b.x)], 1u);
            asm volatile("s_waitcnt vmcnt(0)" ::: "memory");
        } else {
            XB_SPIN(xb_ld(&bar[XB_XGEN(b.x)]) == gen, bar);
            __builtin_amdgcn_fence(__ATOMIC_ACQUIRE, "agent");
            asm volatile("s_waitcnt vmcnt(0)" ::: "memory");
        }
    }
    __syncthreads();
}

struct Args {
    const float* in[33];
    float* out; unsigned char* ws;
    int ph_lo, ph_hi;
};
enum { I_X = 0, I_MEM, I_WIN, I_GLACONV, I_GLAW2, I_GLAB, I_GLANG, I_HGLB, I_HGNG, I_RWMU, I_RWW0, I_RWW2, I_RWA0, I_RWA2, I_RWG2, I_RWKK, I_RWKA, I_RWRK, I_RWLNW, I_RWLNB,
       I_WMK, I_WMV, I_WOUT, I_LN1G, I_LN1B, I_RTW, I_RTB, I_WGU, I_BGU, I_WDN, I_BDN, I_LN2G, I_LN2B };


template <int OFF> __device__ __forceinline__ unsigned long long ka_u64() { unsigned long long v; asm volatile("s_load_dwordx2 %0, %1, %2\n\ts_waitcnt lgkmcnt(0)" : "=s"(v) : "s"(__builtin_amdgcn_kernarg_segment_ptr()), "n"(OFF)); return v; }
#define KIN(i) ((const float*)(const GAS float*)ka_u64<8 * (i)>())
#define KOUT() ((float*)(GAS float*)ka_u64<264>())
#define KWS() ((unsigned char*)(GAS unsigned char*)ka_u64<272>())

template <class Map>
__device__ __forceinline__ void tr_item(const float* __restrict__ W, int K, int N, bf16* __restrict__ WT, LAS float* scr, int kb, int nb, int lane, Map map) {
    const int k0 = 64 * kb, n0 = 64 * nb, col = n0 + lane; const bool valid = col < N;
    const float* src = W + (size_t)k0 * N + (valid ? col : 0);
#pragma unroll 64
    for (int kk = 0; kk < 64; ++kk) { const float v = valid ? src[(size_t)kk * N] : 0.f; scr[kk * 65 + lane] = v; }
    LDS_WAIT(); asm volatile("" ::: "memory");
    const int c = lane & 7;
#pragma unroll
    for (int j = 0; j < 8; ++j) { const int n = (lane >> 3) + 8 * j;
        if (n0 + n < N) { const int orow = map(n0 + n); const LAS float* s = scr + (8 * c) * 65 + n;
            u32x4 o; o.x = pk2(s[0 * 65], s[1 * 65]); o.y = pk2(s[2 * 65], s[3 * 65]); o.z = pk2(s[4 * 65], s[5 * 65]); o.w = pk2(s[6 * 65], s[7 * 65]);
            *(u32x4*)(WT + (size_t)orow * K + k0 + 8 * c) = o; } }
    LDS_WAIT(); asm volatile("" ::: "memory");
}
template <bool GUARD = false, class Map>
__device__ __forceinline__ void tr_item_f8(const float* __restrict__ W, int K, int N, unsigned char* __restrict__ WT8, LAS float* scr, int kb, int nb, int lane, float scale, Map map) {
    const int k0 = 64 * kb, n0 = 64 * nb, col = (GUARD && n0 + lane >= N) ? N - 1 : n0 + lane;
    const float* src = W + (size_t)k0 * N + col;
#pragma unroll 64
    for (int kk = 0; kk < 64; ++kk) scr[kk * 65 + lane] = src[(size_t)kk * N] * scale;
    LDS_WAIT(); asm volatile("" ::: "memory");
    const int c = lane & 3;
#pragma unroll
    for (int j = 0; j < 4; ++j) { const int n = (lane >> 2) + 16 * j; const LAS float* s = scr + (16 * c) * 65 + n;
        u32x4 o;
#pragma unroll
        for (int q = 0; q < 4; ++q) { int w = __builtin_amdgcn_cvt_pk_fp8_f32(s[(4 * q) * 65], s[(4 * q + 1) * 65], 0, false); w = __builtin_amdgcn_cvt_pk_fp8_f32(s[(4 * q + 2) * 65], s[(4 * q + 3) * 65], w, true); o[q] = (unsigned)w; }
        if (!GUARD || n0 + n < N) { const int orow = map(n0 + n); *(u32x4*)(WT8 + (size_t)orow * K + k0 + 16 * c) = o; } }
    LDS_WAIT(); asm volatile("" ::: "memory");
}
struct MapIdent { int off; __device__ __forceinline__ int operator()(int c) const { return c + off; } };
struct MapWin { __device__ __forceinline__ int operator()(int c) const { return c < 512 ? c : (c < 528 ? c + 2560 : c - 16); } };
__device__ __forceinline__ int gu_row(int c) { const int f = c >> 1, bj = c & 1, pn = f >> 7, fl = f & 127, wc = fl >> 5, fq = (fl >> 3) & 3, n = (fl >> 2) & 1, j = fl & 3; return 256 * pn + 128 * bj + 32 * wc + 16 * n + 4 * fq + j; }
struct MapGu { __device__ __forceinline__ int operator()(int c) const { return gu_row(c); } };

__device__ __forceinline__ void prologue_phase(LAS unsigned char* lds, int vcu, int G) {
    const int tid = opaque_tid(), lane = tid & 63, wave = __builtin_amdgcn_readfirstlane(tid >> 6);
    LAS float* scr = (LAS float*)(lds + wave * 16640); static_assert(8 * 16640 <= LDSCTL_OFF, "prologue scratch below the LDS control words");
    const int gw = vcu * NWAVES + wave, NGW = G * NWAVES;
    unsigned char* ws = KWS();
    constexpr int IT_GU = NL * NE * 512, IT_DN = NL * NE * 256, IT_IN = NL * 16 * 49, IT_OUT = NL * 256, IT_MEM = NL * 2 * 64, IT_L64 = NL * 2 * 4, IT_L128 = NL * 2 * 4;
    constexpr int IT_TOTAL = IT_GU + IT_DN + IT_IN + IT_OUT + IT_MEM + IT_L64 + IT_L128;
    for (int it = gw; it < IT_TOTAL; it += NGW) {
        int r = it;
        if (r < IT_GU) { const int le = r >> 9, q = r & 511, kb = q >> 5, nb = q & 31;
            tr_item_f8(KIN(I_WGU) + (size_t)le * 1024 * 2048, 1024, 2048, (unsigned char*)(ws + WS_WGU) + (size_t)le * 2048 * 1024, scr, kb, nb, lane, 16.0f, MapGu{}); continue; } r -= IT_GU;
        if (r < IT_DN) { const int le = r >> 8, q = r & 255, kb = q >> 4, nb = q & 15;
            tr_item_f8(KIN(I_WDN) + (size_t)le * 1024 * 1024, 1024, 1024, (unsigned char*)(ws + WS_WD) + (size_t)le * 1024 * 1024, scr, kb, nb, lane, 32.0f, MapIdent{0}); continue; } r -= IT_DN;
        if (r < IT_IN) { const int l = r / (16 * 49), q = r % (16 * 49), kb = q / 49, nb = q % 49;
            tr_item_f8<true>(KIN(I_WIN) + (size_t)l * 1024 * PIN, 1024, PIN, (unsigned char*)(ws + WS_WIN) + (size_t)l * PINP * 1024, scr, kb, nb, lane, 16.0f, MapWin{}); continue; } r -= IT_IN;
        if (r < IT_OUT) { const int l = r >> 8, q = r & 255, kb = q >> 4, nb = q & 15;
            tr_item_f8(KIN(I_WOUT) + (size_t)l * 1024 * 1024, 1024, 1024, (unsigned char*)(ws + WS_WOUT) + (size_t)l * 1024 * 1024, scr, kb, nb, lane, 32.0f, MapIdent{0}); continue; } r -= IT_OUT;
        if (r < IT_MEM) { const int l = r >> 7, q = r & 127, kv = q >> 6, kb = (q >> 2) & 15, nb = q & 3;
            tr_item((kv ? KIN(I_WMV) : KIN(I_WMK)) + (size_t)l * 1024 * 256, 1024, 256, (bf16*)(ws + WS_WMEM), scr, kb, nb, lane, MapIdent{l * 512 + kv * 256}); continue; } r -= IT_MEM;
        if (r < IT_L64) { const int l = r >> 3, q = r & 7, wa = q >> 2, nb = q & 3;
            tr_item((wa ? KIN(I_RWA2) : KIN(I_RWW2)) + (size_t)l * 64 * 256, 64, 256, (bf16*)(ws + WS_LORA) + (size_t)wa * (NL * 256 * 64) + (size_t)l * 256 * 64, scr, 0, nb, lane, MapIdent{0}); continue; } r -= IT_L64;
        { const int l = r >> 3, q = r & 7, kb = q >> 2, nb = q & 3;
            tr_item(KIN(I_RWG2) + (size_t)l * 128 * 256, 128, 256, (bf16*)(ws + WS_LORA) + (size_t)2 * (NL * 256 * 64) + (size_t)l * 256 * 128, scr, kb, nb, lane, MapIdent{0}); }
    }
    { const size_t gt = (size_t)vcu * NTHR + tid, GT = (size_t)G * NTHR; constexpr size_t per = (size_t)(PINP - PIN) * 1024 / 16;
        for (size_t i = gt; i < per * NL; i += GT) { const size_t l = i / per, j = i % per; *(u32x4*)((unsigned char*)(ws + WS_WIN) + l * PINP * 1024 + (size_t)PIN * 1024 + j * 16) = (u32x4){0u, 0u, 0u, 0u}; }
        for (size_t i = gt; i < (size_t)NL * 8192; i += GT) { const int l = (int)(i >> 13), q = (int)(i >> 6) & 127, ln = (int)i & 63, jj = q >> 4, c = q & 15, k0 = 4 * (ln + 64 * (jj >> 1)) + 2 * (jj & 1);
            const float* s = KIN(I_WIN) + (size_t)l * 1024 * PIN + (size_t)k0 * PIN + 512 + c; ((unsigned*)(ws + WS_GLRW))[i] = pk2(s[0], s[PIN]); }
        for (size_t i = gt; i < (size_t)NL * NE * 2048; i += GT) { const size_t le = i >> 11; const int c = (int)(i & 2047); ((float*)(ws + WS_BGU))[le * 2048 + gu_row(c)] = KIN(I_BGU)[i]; }
        const f32x4* xs = (const f32x4*)KIN(I_X); unsigned char* xd8 = (unsigned char*)(ws + WS_X8);
        for (size_t i = gt; i < (size_t)NTOK * D / 8; i += GT) { const f32x4 v0 = xs[2 * i], v1 = xs[2 * i + 1]; store_o4(xd8 + 8 * i, v0[0], v0[1], v0[2], v0[3]); store_o4(xd8 + 8 * i + 4, v1[0], v1[1], v1[2], v1[3]); }
        const f32x4* ms = (const f32x4*)KIN(I_MEM); u32x4* md = (u32x4*)(ws + WS_MEMB);
        for (size_t i = gt; i < (size_t)NB * NMEM * D / 8; i += GT) { const f32x4 v0 = ms[2 * i], v1 = ms[2 * i + 1]; md[i] = (u32x4){pk2(v0[0], v0[1]), pk2(v0[2], v0[3]), pk2(v1[0], v1[1]), pk2(v1[2], v1[3])}; }
    }
}


__device__ __forceinline__ float log1pexp_neg_abs(float z) { return __builtin_amdgcn_logf(1.0f + fast_exp(-fabsf(z))) * 0.6931471805599453f; }
__device__ __forceinline__ float tanh_f(float x) { const float e = fast_exp(-2.0f * fabsf(x)); const float t = (1.0f - e) * __builtin_amdgcn_rcpf(1.0f + e); return x < 0.f ? -t : t; }

constexpr int NCH = T / 32;
__device__ __forceinline__ int rho16(int r, int hh) { return (r & 3) + 8 * (r >> 2) + 4 * hh; }
__device__ __forceinline__ void hg_fused_unit(LAS unsigned char* lds, int l, int b, int c) {
    const int tid = opaque_tid(), lane = tid & 63, wave = __builtin_amdgcn_readfirstlane(tid >> 6), r32 = lane & 31, hh = lane >> 5;
    unsigned char* ws = KWS();
    const bf16* P = (const bf16*)(ws + WS_P) + ((size_t)b * T + c * 32) * PINP;
    constexpr int HB = 16640;
    if (tid < 256) {
        const int ch = tid, h = ch >> 6, d = ch & 63; const size_t un = (size_t)(b * 4 + h) * NCH + c;
        const float* hp = KIN(I_HGLB) + ch; const float v0 = hp[0], v1 = hp[256], v2 = hp[512], v3 = hp[768];
        unsigned short hqr[32], hfr[32];
#pragma unroll
        for (int t = 0; t < 32; ++t) { const bf16* row = P + (size_t)t * PINP; hqr[t] = row[PC_HQ + ch]; hfr[t] = row[PC_HF + ch]; }
        __builtin_amdgcn_sched_barrier(0);
        float lb;
        { const float m = fmaxf(fmaxf(v0, v1), fmaxf(v2, v3));
          const float e0 = __expf(v0 - m), e1 = __expf(v1 - m), e2 = __expf(v2 - m), e3 = __expf(v3 - m); const float inv = 1.0f / (e0 + e1 + e2 + e3);
          lb = (l >= 1 ? e1 : 0.f) + (l >= 2 ? e2 : 0.f) + (l >= 3 ? e3 : 0.f); lb *= inv; }
        const float oml = 1.0f - lb;
        LAS bf16* KT = (LAS bf16*)(lds + h * HB); LAS float* BE = (LAS float*)(lds + h * HB + 8192);
        LAS bf16* QL = (LAS bf16*)(lds + h * HB + 8448) + d; LAS bf16* KL = (LAS bf16*)(lds + h * HB + 12544) + d;
        float bc = 1.0f;
#pragma unroll
        for (int t8 = 0; t8 < 4; ++t8) { u32x4 kp;
#pragma unroll
            for (int jj = 0; jj < 4; ++jj) { float k2[2];
#pragma unroll
                for (int e = 0; e < 2; ++e) { const int t = t8 * 8 + jj * 2 + e; const float hf = bf2f(hfr[t]); const float eh_ = fast_exp(fminf(-hf, 80.0f)); const float s = __builtin_amdgcn_rcpf(1.0f + eh_), sn = eh_ * s;
                    bc = fmaxf(bc * fmaxf(lb + oml * s, 1e-30f), 1.8048513878454153e-35f);
                    const float qt = silu_f(bf2f(hqr[t])) * bc, kt = oml * sn * __builtin_amdgcn_rcpf(bc);
                    QL[t * 64] = (bf16)f2bf(qt); KL[t * 64] = (bf16)f2bf(kt); k2[e] = kt; }
                kp[jj] = pk2(k2[0], k2[1]); }
            *(LAS u32x4*)(KT + d * 32 + t8 * 8) = kp; }
        const float ebend = bc; BE[d] = ebend; ((float*)(ws + WS_HBE))[un * 64 + d] = ebend;
    } else {
        const int cv = tid - 256, h = cv >> 6, vi = cv & 63; const size_t un = (size_t)(b * 4 + h) * NCH + c;
        LAS bf16* VT = (LAS bf16*)(lds + h * HB + 4096); bf16* VTg = (bf16*)(ws + WS_HVT) + un * 2048 + vi * 32;
        unsigned short hvr[32];
#pragma unroll
        for (int t = 0; t < 32; ++t) hvr[t] = P[(size_t)t * PINP + PC_HI + cv];
        __builtin_amdgcn_sched_barrier(0);
#pragma unroll
        for (int t8 = 0; t8 < 4; ++t8) { u32x4 vp;
#pragma unroll
            for (int jj = 0; jj < 4; ++jj) vp[jj] = (unsigned)hvr[t8 * 8 + 2 * jj] | ((unsigned)hvr[t8 * 8 + 2 * jj + 1] << 16);
            *(LAS u32x4*)(VT + vi * 32 + t8 * 8) = vp; *(u32x4*)(VTg + t8 * 8) = vp; }
    }
    lds_barrier();
    { const int h = wave >> 1, vt = wave & 1; const size_t un = (size_t)(b * 4 + h) * NCH + c;
      const LAS bf16* KT = (const LAS bf16*)(lds + h * HB); const LAS bf16* VT = (const LAS bf16*)(lds + h * HB + 4096); const LAS float* BE = (const LAS float*)(lds + h * HB + 8192);
      bf16* DSg = (bf16*)(ws + WS_HDS) + un * 4096;
      { const LAS bf16* srcL = (const LAS bf16*)(lds + h * HB + (vt == 0 ? 8448 : 12544)); u32x4* dstG = (u32x4*)((bf16*)(ws + (vt == 0 ? WS_HQ : WS_HK)) + un * 2048);
#pragma unroll
        for (int i = 0; i < 4; ++i) dstG[i * 64 + lane] = *(const LAS u32x4*)(srcL + (i * 64 + lane) * 8); }
#pragma unroll
      for (int dt = 0; dt < 2; ++dt) { f32x16 acc;
#pragma unroll
          for (int i = 0; i < 16; ++i) acc[i] = 0.f;
#pragma unroll
          for (int s = 0; s < 2; ++s) { const bf16x8 A = *(const LAS bf16x8*)(VT + (32 * vt + r32) * 32 + 16 * s + 8 * hh), B = *(const LAS bf16x8*)(KT + (32 * dt + r32) * 32 + 16 * s + 8 * hh);
              acc = __builtin_amdgcn_mfma_f32_32x32x16_bf16(A, B, acc, 0, 0, 0); }
          const float ebd = BE[32 * dt + r32];
#pragma unroll
          for (int r = 0; r < 16; ++r) DSg[(32 * vt + rho16(r, hh)) * 64 + 32 * dt + r32] = (bf16)f2bf(acc[r] * ebd); } }
    lds_barrier();
}
__device__ __forceinline__ void gla_fused_unit(LAS unsigned char* lds, int l, int b, int c) {
    const int tid = opaque_tid(), lane = tid & 63, wave = __builtin_amdgcn_readfirstlane(tid >> 6), r32 = lane & 31, hh = lane >> 5;
    unsigned char* ws = KWS();
    const int t0 = c * 32;
    const bf16* P = (const bf16*)(ws + WS_P) + ((size_t)b * T + t0) * PINP;
    LAS float* GL = (LAS float*)lds;
    constexpr int HB = 10368, H0 = 2048;
    const unsigned short glr = P[(size_t)(tid >> 4) * PINP + PC_GLR + (tid & 15)];
    unsigned short xra[32], xrb[32], hra[3], hrb[3]; float cwv[8], wc[16], gb = 0.f;
    const long hb = t0 > 0 ? 1 : 0;
    if (tid < 128) { const int ch = tid;
        const float* cw = KIN(I_GLACONV) + (size_t)l * 4 * 512 + ch;
        cwv[0] = cw[0]; cwv[1] = cw[512]; cwv[2] = cw[1024]; cwv[3] = cw[1536]; cwv[4] = cw[128]; cwv[5] = cw[640]; cwv[6] = cw[1152]; cwv[7] = cw[1664];
        const float* w2p = KIN(I_GLAW2) + (size_t)l * 16 * 128 + ch;
#pragma unroll
        for (int r = 0; r < 16; ++r) wc[r] = w2p[r * 128];
        gb = KIN(I_GLAB)[l * 128 + ch];
#pragma unroll
        for (int j = 0; j < 3; ++j) { const bf16* hrow = P - hb * (3 - j) * PINP; hra[j] = hrow[PC_GQ + ch]; hrb[j] = hrow[PC_GK + ch]; }
#pragma unroll
        for (int t = 0; t < 32; ++t) { const bf16* row = P + (size_t)t * PINP; xra[t] = row[PC_GQ + ch]; xrb[t] = row[PC_GK + ch]; }
    } else if (tid < 384) { const int cv = tid - 128;
        const float* cw = KIN(I_GLACONV) + (size_t)l * 4 * 512 + 256 + cv;
        cwv[0] = cw[0]; cwv[1] = cw[512]; cwv[2] = cw[1024]; cwv[3] = cw[1536];
#pragma unroll
        for (int j = 0; j < 3; ++j) hra[j] = (P - hb * (3 - j) * PINP)[PC_GV + cv];
#pragma unroll
        for (int t = 0; t < 32; ++t) xra[t] = P[(size_t)t * PINP + PC_GV + cv];
    }
    __builtin_amdgcn_sched_barrier(0);
    GL[tid] = bf2f(glr);
    lds_barrier();
    if (tid < 128) {
        const int ch = tid, h = ch >> 5, d = ch & 31; const size_t un = (size_t)(b * 4 + h) * NCH + c;
        const float q0 = cwv[0], q1 = cwv[1], q2 = cwv[2], q3 = cwv[3], k0 = cwv[4], k1 = cwv[5], k2w = cwv[6], k3 = cwv[7];
        float uq0 = hb ? bf2f(hra[0]) : 0.f, uq1 = hb ? bf2f(hra[1]) : 0.f, uq2 = hb ? bf2f(hra[2]) : 0.f, uk0 = hb ? bf2f(hrb[0]) : 0.f, uk1 = hb ? bf2f(hrb[1]) : 0.f, uk2 = hb ? bf2f(hrb[2]) : 0.f;
        LAS bf16* KT = (LAS bf16*)(lds + H0 + h * HB); LAS float* BE = (LAS float*)(lds + H0 + h * HB + 6144);
        LAS bf16* QL = (LAS bf16*)(lds + H0 + h * HB + 6272) + d; LAS bf16* KL = (LAS bf16*)(lds + H0 + h * HB + 8320) + d;
        float bc = 0.f;
#pragma unroll
        for (int t8 = 0; t8 < 4; ++t8) { u32x4 kp;
#pragma unroll
            for (int jj = 0; jj < 4; ++jj) { float kk2[2];
#pragma unroll
                for (int e = 0; e < 2; ++e) { const int t = t8 * 8 + jj * 2 + e; const float uq3 = bf2f(xra[t]), uk3 = bf2f(xrb[t]);
                    const float q = silu_f(q0 * uq0 + q1 * uq1 + q2 * uq2 + q3 * uq3) * 0.17677669529663687f, k = silu_f(k0 * uk0 + k1 * uk1 + k2w * uk2 + k3 * uk3);
                    uq0 = uq1; uq1 = uq2; uq2 = uq3; uk0 = uk1; uk1 = uk2; uk2 = uk3;
                    float z = gb;
#pragma unroll
                    for (int r = 0; r < 16; ++r) z += GL[t * 16 + r] * wc[r];
                    bc = fmaxf(bc + (fminf(z, 0.f) - log1pexp_neg_abs(z)) * 0.0625f, -80.0f);
                    const float qt = q * fast_exp(bc), kt = k * fast_exp(-bc);
                    QL[t * 32] = (bf16)f2bf(qt); KL[t * 32] = (bf16)f2bf(kt); kk2[e] = kt; }
                kp[jj] = pk2(kk2[0], kk2[1]); }
            *(LAS u32x4*)(KT + d * 32 + t8 * 8) = kp; }
        const float ebend = fast_exp(bc); BE[d] = ebend; ((float*)(ws + WS_GBE))[un * 32 + d] = ebend;
    } else if (tid < 384) {
        const int cv = tid - 128, h = cv >> 6, vi = cv & 63; const size_t un = (size_t)(b * 4 + h) * NCH + c;
        const float w0 = cwv[0], w1 = cwv[1], w2 = cwv[2], w3 = cwv[3];
        float u0 = hb ? bf2f(hra[0]) : 0.f, u1 = hb ? bf2f(hra[1]) : 0.f, u2 = hb ? bf2f(hra[2]) : 0.f;
        LAS bf16* VT = (LAS bf16*)(lds + H0 + h * HB + 2048); bf16* VTg = (bf16*)(ws + WS_GVT) + un * 2048 + vi * 32;
#pragma unroll
        for (int t8 = 0; t8 < 4; ++t8) { u32x4 vp; float yv[8];
#pragma unroll
            for (int e = 0; e < 8; ++e) { const float u3 = bf2f(xra[t8 * 8 + e]); yv[e] = silu_f(w0 * u0 + w1 * u1 + w2 * u2 + w3 * u3); u0 = u1; u1 = u2; u2 = u3; }
#pragma unroll
            for (int jj = 0; jj < 4; ++jj) vp[jj] = pk2(yv[2 * jj], yv[2 * jj + 1]);
            *(LAS u32x4*)(VT + vi * 32 + t8 * 8) = vp; *(u32x4*)(VTg + t8 * 8) = vp; }
    }
    lds_barrier();
    { const int h = wave >> 1, vt = wave & 1; const size_t un = (size_t)(b * 4 + h) * NCH + c;
      const LAS bf16* KT = (const LAS bf16*)(lds + H0 + h * HB); const LAS bf16* VT = (const LAS bf16*)(lds + H0 + h * HB + 2048); const LAS float* BE = (const LAS float*)(lds + H0 + h * HB + 6144);
      bf16* DSg = (bf16*)(ws + WS_GDS) + un * 2048;
      { const LAS bf16* srcL = (const LAS bf16*)(lds + H0 + h * HB + (vt == 0 ? 6272 : 8320)); u32x4* dstG = (u32x4*)((bf16*)(ws + (vt == 0 ? WS_GQ : WS_GK)) + un * 1024);
#pragma unroll
        for (int i = 0; i < 2; ++i) dstG[i * 64 + lane] = *(const LAS u32x4*)(srcL + (i * 64 + lane) * 8); }
      f32x16 acc;
#pragma unroll
      for (int i = 0; i < 16; ++i) acc[i] = 0.f;
#pragma unroll
      for (int s = 0; s < 2; ++s) { const bf16x8 A = *(const LAS bf16x8*)(VT + (32 * vt + r32) * 32 + 16 * s + 8 * hh), B = *(const LAS bf16x8*)(KT + r32 * 32 + 16 * s + 8 * hh);
          acc = __builtin_amdgcn_mfma_f32_32x32x16_bf16(A, B, acc, 0, 0, 0); }
      const float ebd = BE[r32];
#pragma unroll
      for (int r = 0; r < 16; ++r) DSg[(32 * vt + rho16(r, hh)) * 32 + r32] = (bf16)f2bf(acc[r] * ebd); }
    lds_barrier();
}
template <int DK>
__device__ __forceinline__ void m2_gh_elem2(int e2, const bf16* __restrict__ DS, const float* __restrict__ BE, bf16* __restrict__ SG) {
    constexpr int EPB = 64 * DK; const int e = e2 * 2, bh = e / EPB, idx = e % EPB, d = idx % DK; const size_t un0 = (size_t)bh * NCH;
    float S0 = 0.f, S1 = 0.f;
#pragma unroll 1
    for (int c0 = 0; c0 < NCH; c0 += 16) { unsigned ds[16]; f32x2 be[16];
#pragma unroll
        for (int u = 0; u < 16; ++u) { ds[u] = *(const unsigned*)(DS + (un0 + c0 + u) * EPB + idx); be[u] = *(const f32x2*)(BE + (un0 + c0 + u) * DK + d); }
#pragma unroll
        for (int u = 0; u < 16; ++u) { *(unsigned*)(SG + (un0 + c0 + u) * EPB + idx) = pk2(S0, S1); S0 = S0 * be[u][0] + bflo(ds[u]); S1 = S1 * be[u][1] + bfhi(ds[u]); } }
}
template <int DK>
__device__ __forceinline__ void m3_gh_task(int lane, const bf16* __restrict__ Qg, const bf16* __restrict__ Kg, const bf16* __restrict__ VTg, const bf16* __restrict__ Sg,
                                           const bf16* __restrict__ gate  , const float* __restrict__ ng  , unsigned char* __restrict__ orow  ) {
    const int r32 = lane & 31, hh = lane >> 5;
    bf16x8 qf[DK / 16], kfa[DK / 16], sfa[2][DK / 16]; s16x4 vfa[2][2][2]; u32x2 gwa[2][4]; f32x4 n4a[2][4];
    const bf16* grow = gate + (size_t)r32 * PINP;
#pragma unroll
    for (int s = 0; s < DK / 16; ++s) { qf[s] = *(const bf16x8*)(Qg + r32 * DK + 16 * s + 8 * hh); kfa[s] = *(const bf16x8*)(Kg + r32 * DK + 16 * s + 8 * hh); }
#pragma unroll
    for (int s = 0; s < 2; ++s)
#pragma unroll
        for (int vt = 0; vt < 2; ++vt) { const bf16* vp = VTg + (32 * vt + r32) * 32 + 16 * s + 4 * hh; vfa[s][vt][0] = *(const s16x4*)vp; vfa[s][vt][1] = *(const s16x4*)(vp + 8); }
#pragma unroll
    for (int vt = 0; vt < 2; ++vt)
#pragma unroll
        for (int s = 0; s < DK / 16; ++s) sfa[vt][s] = *(const bf16x8*)(Sg + (32 * vt + r32) * DK + 16 * s + 8 * hh);
#pragma unroll
    for (int vt = 0; vt < 2; ++vt)
#pragma unroll
        for (int g = 0; g < 4; ++g) { gwa[vt][g] = *(const u32x2*)(grow + 32 * vt + 8 * g + 4 * hh); n4a[vt][g] = *(const f32x4*)(ng + 32 * vt + 8 * g + 4 * hh); }
    __builtin_amdgcn_sched_barrier(0);
    f32x16 at;
#pragma unroll
    for (int i = 0; i < 16; ++i) at[i] = 0.f;
#pragma unroll
    for (int s = 0; s < DK / 16; ++s) at = __builtin_amdgcn_mfma_f32_32x32x16_bf16(kfa[s], qf[s], at, 0, 0, 0);
#pragma unroll
    for (int r = 0; r < 16; ++r) if (rho16(r, hh) > r32) at[r] = 0.f;
    f32x16 o[2];
#pragma unroll
    for (int vt = 0; vt < 2; ++vt)
#pragma unroll
        for (int i = 0; i < 16; ++i) o[vt][i] = 0.f;
#pragma unroll
    for (int s = 0; s < 2; ++s) { union { bf16x8 v; unsigned w[4]; } pf;
#pragma unroll
        for (int j = 0; j < 4; ++j) pf.w[j] = cvt_pk_bf16(at[8 * s + 2 * j], at[8 * s + 2 * j + 1]);
#pragma unroll
        for (int vt = 0; vt < 2; ++vt) {
            union { bf16x8 v; s16x4 h2[2]; } vf; vf.h2[0] = vfa[s][vt][0]; vf.h2[1] = vfa[s][vt][1];
            o[vt] = __builtin_amdgcn_mfma_f32_32x32x16_bf16(vf.v, pf.v, o[vt], 0, 0, 0); } }
#pragma unroll
    for (int vt = 0; vt < 2; ++vt)
#pragma unroll
        for (int s = 0; s < DK / 16; ++s) o[vt] = __builtin_amdgcn_mfma_f32_32x32x16_bf16(sfa[vt][s], qf[s], o[vt], 0, 0, 0);
    float ss = 0.f;
#pragma unroll
    for (int vt = 0; vt < 2; ++vt)
#pragma unroll
        for (int i = 0; i < 16; ++i) ss += o[vt][i] * o[vt][i];
    ss += __shfl_xor(ss, 32);
    const float rstd = 1.0f / sqrtf(ss * (1.0f / 64.0f) + RMS_EPS);
    unsigned char* od = orow + (size_t)r32 * D;
#pragma unroll
    for (int vt = 0; vt < 2; ++vt)
#pragma unroll
        for (int g = 0; g < 4; ++g) { const int v0 = 32 * vt + 8 * g + 4 * hh; const u32x2 gw = gwa[vt][g]; const f32x4 n4 = n4a[vt][g];
            const float y0 = o[vt][4 * g] * rstd * n4[0] * silu_f(bflo(gw.x)), y1 = o[vt][4 * g + 1] * rstd * n4[1] * silu_f(bfhi(gw.x));
            const float y2 = o[vt][4 * g + 2] * rstd * n4[2] * silu_f(bflo(gw.y)), y3 = o[vt][4 * g + 3] * rstd * n4[3] * silu_f(bfhi(gw.y));
            store_o4(od + v0, y0, y1, y2, y3); }
}

constexpr int RWC_HEADB = 28928;
constexpr int RWC_AL = 4 * RWC_HEADB, RWC_LWL = RWC_AL + 32 * 264 * 2;
static_assert(RWC_LWL + 32 * 264 * 2 <= LDSCTL_OFF, "rw_fused_unit LDS");
__device__ __forceinline__ void rw_fused_unit(LAS unsigned char* lds, int l, int b, int c) {
    const int tid = opaque_tid(), lane = tid & 63, wave = __builtin_amdgcn_readfirstlane(tid >> 6), h = wave >> 1, p = wave & 1, r32 = lane & 31, hh = lane >> 5;
    unsigned char* ws = KWS();
    const int bh = b * 4 + h; const size_t un = (size_t)bh * NCH + c;
    const int t0 = c * 32;
    const bf16* P = (const bf16*)(ws + WS_P) + ((size_t)b * T + t0) * PINP + PC_RW;
    const float* mu = KIN(I_RWMU) + (size_t)l * 1024;
    LAS bf16* XL = (LAS bf16*)lds;
    LAS bf16* AL = (LAS bf16*)(lds + RWC_AL);
    LAS bf16* LWL = (LAS bf16*)(lds + RWC_LWL);
    bf16x8 bwW[4], bwA[4], bwG[8]; float w0c, a0c;
    { const int ch = wave * 32 + r32;
      const bf16* w2T = (const bf16*)(ws + WS_LORA) + (size_t)l * 256 * 64 + (size_t)ch * 64 + 8 * hh;
      const bf16* a2T = (const bf16*)(ws + WS_LORA) + (size_t)(NL * 256 * 64) + (size_t)l * 256 * 64 + (size_t)ch * 64 + 8 * hh;
      const bf16* g2T = (const bf16*)(ws + WS_LORA) + (size_t)2 * (NL * 256 * 64) + (size_t)l * 256 * 128 + (size_t)ch * 128 + 8 * hh;
#pragma unroll
      for (int s = 0; s < 4; ++s) { bwW[s] = *(const bf16x8*)(w2T + 16 * s); bwA[s] = *(const bf16x8*)(a2T + 16 * s); }
#pragma unroll
      for (int s = 0; s < 8; ++s) bwG[s] = *(const bf16x8*)(g2T + 16 * s);
      w0c = KIN(I_RWW0)[l * 256 + ch]; a0c = KIN(I_RWA0)[l * 256 + ch]; }
    { const int cc = tid & 255, tp = tid >> 8; const float mc = mu[768 + cc];
      unsigned short xr[17];
#pragma unroll
      for (int j = 0; j < 17; ++j) { const int tk = tp * 16 + j - 1;
          if (j == 0) { const bool ok = (t0 + tk >= 0); const unsigned short v = P[(long)(ok ? tk : 0) * PINP + 768 + cc]; xr[0] = ok ? v : (unsigned short)0; }
          else xr[j] = P[(long)tk * PINP + 768 + cc]; }
#pragma unroll
      for (int j = 0; j < 16; ++j) { const float cur = bf2f(xr[j + 1]), prev = bf2f(xr[j]);
          float x = cur + (prev - cur) * mc;
          if (cc < 64) x = tanh_f(x); else if (cc >= 128) x = fast_sigmoid(x);
          XL[(tp * 16 + j) * 264 + cc] = (bf16)f2bf(x); } }
    lds_barrier();
    float mr, mk, mv, kkc, kac, rkc; unsigned short xrr[17], xkr[17], xvr[17];
    { const int ch = (wave & 3) * 64 + lane, tb = (wave >> 2) * 16;
      mr = mu[ch]; mk = mu[256 + ch]; mv = mu[512 + ch]; kkc = KIN(I_RWKK)[l * 256 + ch]; kac = KIN(I_RWKA)[l * 256 + ch]; rkc = KIN(I_RWRK)[l * 256 + ch];
#pragma unroll
      for (int j = 0; j < 17; ++j) { const int tk = tb + j - 1;
          if (j == 0) { const bool ok = (t0 + tk >= 0); const bf16* row = P + (long)(ok ? tk : 0) * PINP; const unsigned short v0 = row[ch], v1 = row[256 + ch], v2 = row[512 + ch];
              xrr[0] = ok ? v0 : (unsigned short)0; xkr[0] = ok ? v1 : (unsigned short)0; xvr[0] = ok ? v2 : (unsigned short)0; }
          else { const bf16* row = P + (long)tk * PINP; xrr[j] = row[ch]; xkr[j] = row[256 + ch]; xvr[j] = row[512 + ch]; } }
      __builtin_amdgcn_sched_barrier(0); }
    {
        const int ch = wave * 32 + r32;
        const LAS bf16* xa = XL + r32 * 264 + 8 * hh;
        {
            f32x16 acc;
#pragma unroll
            for (int i = 0; i < 16; ++i) acc[i] = 0.f;
#pragma unroll
            for (int s = 0; s < 4; ++s) { const bf16x8 A = *(const LAS bf16x8*)(xa + 16 * s);
                acc = __builtin_amdgcn_mfma_f32_32x32x16_bf16(A, bwW[s], acc, 0, 0, 0); }
#pragma unroll
            for (int r = 0; r < 16; ++r) { const int tok = rho16(r, hh);
                const float zw = w0c + acc[r];
                LWL[tok * 264 + ch] = (bf16)f2bf(-0.6065306597126334f * fast_sigmoid(zw)); }
        }
        __builtin_amdgcn_sched_barrier(0);
        {
            f32x16 acc;
#pragma unroll
            for (int i = 0; i < 16; ++i) acc[i] = 0.f;
#pragma unroll
            for (int s = 0; s < 4; ++s) { const bf16x8 A = *(const LAS bf16x8*)(xa + 64 + 16 * s);
                acc = __builtin_amdgcn_mfma_f32_32x32x16_bf16(A, bwA[s], acc, 0, 0, 0); }
#pragma unroll
            for (int r = 0; r < 16; ++r) AL[rho16(r, hh) * 264 + ch] = (bf16)f2bf(fast_sigmoid(a0c + acc[r]));
        }
        __builtin_amdgcn_sched_barrier(0);
        {
            f32x16 acc;
#pragma unroll
            for (int i = 0; i < 16; ++i) acc[i] = 0.f;
#pragma unroll
            for (int s = 0; s < 8; ++s) { const bf16x8 A = *(const LAS bf16x8*)(xa + 128 + 16 * s);
                acc = __builtin_amdgcn_mfma_f32_32x32x16_bf16(A, bwG[s], acc, 0, 0, 0); }
            bf16* gb = (bf16*)(ws + WS_GBUF) + ((size_t)b * T + t0) * 256 + ch;
#pragma unroll
            for (int r = 0; r < 16; ++r) gb[(size_t)rho16(r, hh) * 256] = (bf16)f2bf(acc[r]);
        }
    }
    lds_barrier();
    LAS unsigned char* L = lds + h * RWC_HEADB;
    LAS bf16* AT = (LAS bf16*)L;
    LAS bf16* BT = (LAS bf16*)(L + 4096);
    LAS bf16* KT = (LAS bf16*)(L + 8192);
    LAS bf16* ATT = (LAS bf16*)(L + 12288);
    LAS bf16* BHT = (LAS bf16*)(L + 16384);
    LAS bf16* KHT = (LAS bf16*)(L + 20480);
    LAS bf16* VT = (LAS bf16*)(L + 24576);
    LAS float* GC = (LAS float*)(L + 28672);
    LAS float* MAB = (LAS float*)(L + 4096);
    LAS bf16* MAK = (LAS bf16*)(L + 8192);
    LAS bf16* TM = (LAS bf16*)L;
    {
        const int hs = wave & 3, half = wave >> 2, d = lane, ch = hs * 64 + d, tb = half * 16; const size_t uns = (size_t)(b * 4 + hs) * NCH + c;
        LAS unsigned char* Ls = lds + hs * RWC_HEADB;
        LAS bf16* sAT = (LAS bf16*)Ls; LAS bf16* sBT = (LAS bf16*)(Ls + 4096); LAS bf16* sKT = (LAS bf16*)(Ls + 8192);
        LAS bf16* sATT = (LAS bf16*)(Ls + 12288); LAS bf16* sBHT = (LAS bf16*)(Ls + 16384); LAS bf16* sKHT = (LAS bf16*)(Ls + 20480); LAS bf16* sVT = (LAS bf16*)(Ls + 24576); LAS float* sGC = (LAS float*)(Ls + 28672);
        float lg0 = 0.f, lg1 = 0.f;
#pragma unroll
        for (int t = 0; t < 16; ++t) { lg0 += bf2f(LWL[t * 264 + ch]); lg1 += bf2f(LWL[(16 + t) * 264 + ch]); }
        const float lgend = lg0 + lg1;
        lds_barrier();
        float* bonp = (float*)(ws + WS_BONUS) + ((size_t)b * T + t0) * 4 + hs;
        float lg = half ? lg0 : 0.f; float elg = fast_exp(lg); const float eend = fast_exp(lgend);
#pragma unroll
        for (int t8 = 0; t8 < 2; ++t8) { u32x4 ap, bp, kp;
#pragma unroll
            for (int jj = 0; jj < 4; ++jj) { float at2[2], bh2[2], kh2[2];
#pragma unroll
                for (int e = 0; e < 2; ++e) { const int j = t8 * 8 + jj * 2 + e, t = tb + j;
                    const float rc = bf2f(xrr[j + 1]), kc = bf2f(xkr[j + 1]);
                    const float r = rc + (bf2f(xrr[j]) - rc) * mr, k = kc + (bf2f(xkr[j]) - kc) * mk;
                    const float av = bf2f(AL[t * 264 + ch]), lw = bf2f(LWL[t * 264 + ch]);
                    const float kkr = k * kkc, hk = k * (1.0f + (av - 1.0f) * kac);
                    const float ss = wave_sum(kkr * kkr); const float kk = kkr * __builtin_amdgcn_rsqf(fmaxf(ss, 1e-24f));
                    const float bon = wave_sum(r * hk * rkc);
                    const float aa = -kk, bb = kk * av;
                    const float elgp = elg; lg += lw; elg = fast_exp(lg);
                    const float ei = __builtin_amdgcn_rcpf(elg), at = aa * elgp, rt = r * elg, bt = bb * ei, kt = hk * ei, eh = eend * ei;
                    sAT[t * 64 + d] = (bf16)f2bf(at); sBT[t * 64 + d] = (bf16)f2bf(bt); sKT[t * 64 + d] = (bf16)f2bf(kt);
                    LWL[t * 264 + ch] = (bf16)f2bf(rt);
                    if (d == 0) bonp[t * 4] = bon;
                    at2[e] = at; bh2[e] = bb * eh; kh2[e] = hk * eh; }
                ap[jj] = pk2(at2[0], at2[1]); bp[jj] = pk2(bh2[0], bh2[1]); kp[jj] = pk2(kh2[0], kh2[1]); }
            *(LAS u32x4*)(sATT + d * 32 + tb + t8 * 8) = ap; *(LAS u32x4*)(sBHT + d * 32 + tb + t8 * 8) = bp; *(LAS u32x4*)(sKHT + d * 32 + tb + t8 * 8) = kp; }
        if (half == 0) sGC[d] = eend;
        bf16* VTg = (bf16*)(ws + WS_RVT) + uns * 2048 + d * 32 + tb;
#pragma unroll
        for (int t8 = 0; t8 < 2; ++t8) { u32x4 vp; float yv[8];
#pragma unroll
            for (int e = 0; e < 8; ++e) { const int j = t8 * 8 + e; const float xv = bf2f(xvr[j + 1]); yv[e] = xv + (bf2f(xvr[j]) - xv) * mv; }
#pragma unroll
            for (int jj = 0; jj < 4; ++jj) vp[jj] = pk2(yv[2 * jj], yv[2 * jj + 1]);
            *(LAS u32x4*)(sVT + d * 32 + tb + t8 * 8) = vp; *(u32x4*)(VTg + t8 * 8) = vp; }
    }
    lds_barrier();
    f32x16 accR[2];
    union { bf16x8 v; unsigned w[4]; } mfr[2];
    LAS u32x4* EX = (LAS u32x4*)(lds + RWC_AL + h * 2048);
    {
        f32x16 acc, acc2;
#pragma unroll
        for (int i = 0; i < 16; ++i) { acc[i] = 0.f; acc2[i] = 0.f; }
        const LAS bf16* Bsrc = p == 0 ? BT : KT;
#pragma unroll
        for (int s = 0; s < 4; ++s) { const bf16x8 A = *(const LAS bf16x8*)(AT + r32 * 64 + 16 * s + 8 * hh), B = *(const LAS bf16x8*)(Bsrc + r32 * 64 + 16 * s + 8 * hh);
            const bf16x8 Rf = *(const LAS bf16x8*)(LWL + r32 * 264 + h * 64 + 16 * s + 8 * hh);
            acc = __builtin_amdgcn_mfma_f32_32x32x16_bf16(A, B, acc, 0, 0, 0);
            acc2 = __builtin_amdgcn_mfma_f32_32x32x16_bf16(B, Rf, acc2, 0, 0, 0); }
#pragma unroll
        for (int r = 0; r < 16; ++r) if (rho16(r, hh) > r32) acc2[r] = 0.f;
#pragma unroll
        for (int s2 = 0; s2 < 2; ++s2) {
#pragma unroll
            for (int j = 0; j < 4; ++j) mfr[s2].w[j] = cvt_pk_bf16(acc2[8 * s2 + 2 * j], acc2[8 * s2 + 2 * j + 1]);
            if (p == 0) EX[s2 * 64 + lane] = (u32x4){mfr[s2].w[0], mfr[s2].w[1], mfr[s2].w[2], mfr[s2].w[3]}; }
        if (p == 0) {
#pragma unroll
            for (int r = 0; r < 16; ++r) { const int t = rho16(r, hh); MAB[t * 32 + r32] = (r32 < t) ? acc[r] : 0.f; }
        } else {
#pragma unroll
            for (int r = 0; r < 16; ++r) { const int t = rho16(r, hh); MAK[t * 32 + r32] = (bf16)f2bf((r32 < t) ? acc[r] : 0.f); }
        }
    }
    lds_barrier();
    if (p == 0) {
        const int cidx = r32; float tc[32];
#pragma unroll
        for (int t = 0; t < 32; ++t) { float acc0 = (t == cidx) ? 1.0f : 0.f, acc1 = 0.f;
#pragma unroll
            for (int s4 = 0; s4 < (t + 3) / 4; ++s4) { const f32x4 m4 = *(const LAS f32x4*)(MAB + t * 32 + 4 * s4);
#pragma unroll
                for (int e = 0; e < 4; ++e) { const int s = 4 * s4 + e; if (s < t) { if (e & 1) acc1 = fmaf(m4[e], tc[s], acc1); else acc0 = fmaf(m4[e], tc[s], acc0); } } }
            tc[t] = acc0 + acc1; }
#pragma unroll
        for (int t = 0; t < 32; ++t) if (hh == 0) TM[t * 32 + cidx] = (bf16)f2bf(tc[t]);
    } else {
#pragma unroll
        for (int vt = 0; vt < 2; ++vt) {
#pragma unroll
            for (int i = 0; i < 16; ++i) accR[vt][i] = 0.f;
#pragma unroll
            for (int s = 0; s < 2; ++s) { const bf16x8 A = *(const LAS bf16x8*)(MAK + r32 * 32 + 16 * s + 8 * hh), B = *(const LAS bf16x8*)(VT + (32 * vt + r32) * 32 + 16 * s + 8 * hh);
                accR[vt] = __builtin_amdgcn_mfma_f32_32x32x16_bf16(A, B, accR[vt], 0, 0, 0); } }
    }
    lds_barrier();
    if (p == 0) {
        f32x16 accW[2];
#pragma unroll
        for (int dt = 0; dt < 2; ++dt) {
#pragma unroll
            for (int i = 0; i < 16; ++i) accW[dt][i] = 0.f;
#pragma unroll
            for (int s = 0; s < 2; ++s) { const bf16x8 A = *(const LAS bf16x8*)(TM + r32 * 32 + 16 * s + 8 * hh), B = *(const LAS bf16x8*)(ATT + (32 * dt + r32) * 32 + 16 * s + 8 * hh);
                accW[dt] = __builtin_amdgcn_mfma_f32_32x32x16_bf16(A, B, accW[dt], 0, 0, 0); } }
        { LAS bf16* WL = ATT;
#pragma unroll
          for (int dt = 0; dt < 2; ++dt) { f32x16 acc;
#pragma unroll
              for (int i = 0; i < 16; ++i) acc[i] = 0.f;
#pragma unroll
              for (int s = 0; s < 2; ++s) { union { bf16x8 v; unsigned w[4]; } bf;
#pragma unroll
                  for (int j = 0; j < 4; ++j) bf.w[j] = cvt_pk_bf16(accW[dt][8 * s + 2 * j], accW[dt][8 * s + 2 * j + 1]);
                  acc = __builtin_amdgcn_mfma_f32_32x32x16_bf16(mfr[s].v, bf.v, acc, 0, 0, 0); }
#pragma unroll
              for (int r = 0; r < 16; ++r) { const int t = rho16(r, hh); WL[t * 64 + 32 * dt + r32] = (bf16)f2bf(acc[r] + bf2f(LWL[t * 264 + h * 64 + 32 * dt + r32])); } }
          u32x4* RGw = (u32x4*)((bf16*)(ws + WS_RR) + un * 2048);
#pragma unroll
          for (int i = 0; i < 4; ++i) RGw[i * 64 + lane] = *(const LAS u32x4*)(WL + (i * 64 + lane) * 8); }
        LAS bf16* PL = (LAS bf16*)(L + 4096);
        const int xs = r32 >> 4, xx = r32 & 15, hhA = (xx >> 2) & 1, jA = 4 * (xx >> 3) + (xx & 3);
#pragma unroll
        for (int dt = 0; dt < 2; ++dt)
#pragma unroll
            for (int dt2 = 0; dt2 < 2; ++dt2) { f32x16 acc;
#pragma unroll
                for (int i = 0; i < 16; ++i) acc[i] = 0.f;
#pragma unroll
                for (int s = 0; s < 2; ++s) { const LAS bf16* bp = BHT + (32 * dt + r32) * 32 + 16 * s + 4 * hh;
                    union { bf16x8 v; s16x4 h2[2]; } af; af.h2[0] = *(const LAS s16x4*)bp; af.h2[1] = *(const LAS s16x4*)(bp + 8);
                    union { bf16x8 v; unsigned w[4]; } bf;
#pragma unroll
                    for (int j = 0; j < 4; ++j) bf.w[j] = cvt_pk_bf16(accW[dt2][8 * s + 2 * j], accW[dt2][8 * s + 2 * j + 1]);
                    acc = __builtin_amdgcn_mfma_f32_32x32x16_bf16(af.v, bf.v, acc, 0, 0, 0); }
                if (dt == dt2) { const float gc = GC[32 * dt + r32];
#pragma unroll
                    for (int r = 0; r < 16; ++r) if (rho16(r, hh) == r32) acc[r] += gc; }
                LAS bf16* pf = PL + (((dt * 2 + dt2) * 2 + xs) * 64 + 32 * hhA) * 8 + jA;
#pragma unroll
                for (int r = 0; r < 16; ++r) pf[rho16(r, hh) * 8] = (bf16)f2bf(acc[r]); }
        { u32x4* PFp = (u32x4*)((bf16*)(ws + WS_RP) + un * 4096);
#pragma unroll
          for (int f = 0; f < 8; ++f) PFp[f * 64 + lane] = *(const LAS u32x4*)(PL + (f * 64 + lane) * 8); }
    } else {
        f32x16 accU[2];
#pragma unroll
        for (int vt = 0; vt < 2; ++vt) {
#pragma unroll
            for (int i = 0; i < 16; ++i) accU[vt][i] = 0.f;
#pragma unroll
            for (int s = 0; s < 2; ++s) { const LAS bf16* tp = TM + r32 * 32 + 16 * s + 4 * hh;
                union { bf16x8 v; s16x4 h2[2]; } af; af.h2[0] = *(const LAS s16x4*)tp; af.h2[1] = *(const LAS s16x4*)(tp + 8);
                union { bf16x8 v; unsigned w[4]; } bf;
#pragma unroll
                for (int j = 0; j < 4; ++j) bf.w[j] = cvt_pk_bf16(accR[vt][8 * s + 2 * j], accR[vt][8 * s + 2 * j + 1]);
                accU[vt] = __builtin_amdgcn_mfma_f32_32x32x16_bf16(af.v, bf.v, accU[vt], 0, 0, 0); } }
        bf16* UGp = (bf16*)(ws + WS_RU) + un * 2048;
#pragma unroll
        for (int vt = 0; vt < 2; ++vt) { f32x16 acc;
#pragma unroll
            for (int i = 0; i < 16; ++i) acc[i] = 0.f;
#pragma unroll
            for (int s = 0; s < 2; ++s) { union { bf16x8 v; unsigned w[4]; } fu; union { bf16x8 v; u32x4 q; } fb;
#pragma unroll
                for (int j = 0; j < 4; ++j) fu.w[j] = cvt_pk_bf16(accU[vt][8 * s + 2 * j], accU[vt][8 * s + 2 * j + 1]);
                fb.q = EX[s * 64 + lane];
                acc = __builtin_amdgcn_mfma_f32_32x32x16_bf16(fu.v, fb.v, acc, 0, 0, 0);
                const LAS bf16* vp = VT + (32 * vt + r32) * 32 + 16 * s + 4 * hh;
                union { bf16x8 v; s16x4 h2[2]; } vf; vf.h2[0] = *(const LAS s16x4*)vp; vf.h2[1] = *(const LAS s16x4*)(vp + 8);
                acc = __builtin_amdgcn_mfma_f32_32x32x16_bf16(vf.v, mfr[s].v, acc, 0, 0, 0); }
#pragma unroll
            for (int g2 = 0; g2 < 2; ++g2) *(u32x4*)(UGp + ((vt * 2 + g2) * 64 + lane) * 8) = (u32x4){cvt_pk_bf16(acc[8 * g2], acc[8 * g2 + 1]), cvt_pk_bf16(acc[8 * g2 + 2], acc[8 * g2 + 3]),
                                                                                                 cvt_pk_bf16(acc[8 * g2 + 4], acc[8 * g2 + 5]), cvt_pk_bf16(acc[8 * g2 + 6], acc[8 * g2 + 7])}; }
        bf16* QFp = (bf16*)(ws + WS_RQ) + un * 4096;
#pragma unroll
        for (int vt = 0; vt < 2; ++vt)
#pragma unroll
            for (int dt = 0; dt < 2; ++dt) { f32x16 acc;
#pragma unroll
                for (int i = 0; i < 16; ++i) acc[i] = 0.f;
#pragma unroll
                for (int s = 0; s < 2; ++s) { const LAS bf16* bp = BHT + (32 * dt + r32) * 32 + 16 * s + 4 * hh;
                    union { bf16x8 v; s16x4 h2[2]; } af; af.h2[0] = *(const LAS s16x4*)bp; af.h2[1] = *(const LAS s16x4*)(bp + 8);
                    union { bf16x8 v; unsigned w[4]; } bf;
#pragma unroll
                    for (int j = 0; j < 4; ++j) bf.w[j] = cvt_pk_bf16(accU[vt][8 * s + 2 * j], accU[vt][8 * s + 2 * j + 1]);
                    acc = __builtin_amdgcn_mfma_f32_32x32x16_bf16(af.v, bf.v, acc, 0, 0, 0);
                    const bf16x8 A2 = *(const LAS bf16x8*)(KHT + (32 * dt + r32) * 32 + 16 * s + 8 * hh), B2 = *(const LAS bf16x8*)(VT + (32 * vt + r32) * 32 + 16 * s + 8 * hh);
                    acc = __builtin_amdgcn_mfma_f32_32x32x16_bf16(A2, B2, acc, 0, 0, 0); }
#pragma unroll
                for (int g2 = 0; g2 < 2; ++g2) *(u32x4*)(QFp + (((vt * 2 + dt) * 2 + g2) * 64 + lane) * 8) = (u32x4){cvt_pk_bf16(acc[8 * g2], acc[8 * g2 + 1]), cvt_pk_bf16(acc[8 * g2 + 2], acc[8 * g2 + 3]),
                                                                                                                   cvt_pk_bf16(acc[8 * g2 + 4], acc[8 * g2 + 5]), cvt_pk_bf16(acc[8 * g2 + 6], acc[8 * g2 + 7])}; }
    }
    lds_barrier();
}
__device__ __forceinline__ void rw_m2_wave(int lane, int bh, int vt) {
    unsigned char* ws = KWS();
    const bf16* PF = (const bf16*)(ws + WS_RP) + (size_t)bh * NCH * 4096 + lane * 8;
    const bf16* QF = (const bf16*)(ws + WS_RQ) + (size_t)bh * NCH * 4096 + (size_t)vt * 2048 + lane * 8;
    bf16* SG = (bf16*)(ws + WS_RS) + (size_t)bh * NCH * 4096 + (size_t)vt * 2048 + lane * 8;
    f32x16 S[2];
#pragma unroll
    for (int dt = 0; dt < 2; ++dt)
#pragma unroll
        for (int i = 0; i < 16; ++i) S[dt][i] = 0.f;
    bf16x8 pA[8], pB[8], pC[8]; u32x4 qA[4], qB[4], qC[4];
#pragma unroll
    for (int f = 0; f < 8; ++f) { pA[f] = (bf16x8){0, 0, 0, 0, 0, 0, 0, 0}; pB[f] = pA[f]; pC[f] = pA[f]; }
#pragma unroll
    for (int f = 0; f < 4; ++f) { qA[f] = (u32x4){0u, 0u, 0u, 0u}; qB[f] = qA[f]; qC[f] = qA[f]; }
#define RWM2_LD4(d0, d1, d2, d3, ptr) asm volatile("global_load_dwordx4 %0, %4, off\n\tglobal_load_dwordx4 %1, %4, off offset:1024\n\tglobal_load_dwordx4 %2, %4, off offset:2048\n\tglobal_load_dwordx4 %3, %4, off offset:3072" \
        : "+v"(d0), "+v"(d1), "+v"(d2), "+v"(d3) : "v"(ptr) : "memory")
#define RWM2_LOAD(P_, Q_, c_) do { const int _c = (c_) < NCH ? (c_) : NCH - 1; const bf16* _p0 = PF + (size_t)_c * 4096; const bf16* _p1 = _p0 + 2048; const bf16* _q = QF + (size_t)_c * 4096; \
        RWM2_LD4(P_[0], P_[1], P_[2], P_[3], _p0); RWM2_LD4(P_[4], P_[5], P_[6], P_[7], _p1); RWM2_LD4(Q_[0], Q_[1], Q_[2], Q_[3], _q); } while (0)
#define RWM2_WAIT(P_, Q_) asm volatile("s_waitcnt vmcnt(24)" : "+v"(P_[0]), "+v"(P_[1]), "+v"(P_[2]), "+v"(P_[3]), "+v"(P_[4]), "+v"(P_[5]), "+v"(P_[6]), "+v"(P_[7]), "+v"(Q_[0]), "+v"(Q_[1]), "+v"(Q_[2]), "+v"(Q_[3]) :: "memory")
#define RWM2_STEP(P_, Q_, c_) do { \
        RWM2_WAIT(P_, Q_); \
        union { bf16x8 v; unsigned w[4]; } sb[2][2]; \
        _Pragma("unroll") for (int dt2 = 0; dt2 < 2; ++dt2) _Pragma("unroll") for (int s = 0; s < 2; ++s) { \
            _Pragma("unroll") for (int j = 0; j < 4; ++j) sb[dt2][s].w[j] = cvt_pk_bf16(S[dt2][8 * s + 2 * j], S[dt2][8 * s + 2 * j + 1]); \
            *(bf16x8*)(SG + (size_t)(c_) * 4096 + (dt2 * 2 + s) * 512) = sb[dt2][s].v; } \
        f32x16 N[2]; \
        _Pragma("unroll") for (int dt = 0; dt < 2; ++dt) { \
            _Pragma("unroll") for (int g2 = 0; g2 < 2; ++g2) _Pragma("unroll") for (int j = 0; j < 4; ++j) { N[dt][8 * g2 + 2 * j] = bflo(Q_[dt * 2 + g2][j]); N[dt][8 * g2 + 2 * j + 1] = bfhi(Q_[dt * 2 + g2][j]); } \
            _Pragma("unroll") for (int dt2 = 0; dt2 < 2; ++dt2) _Pragma("unroll") for (int s = 0; s < 2; ++s) N[dt] = __builtin_amdgcn_mfma_f32_32x32x16_bf16(P_[(dt * 2 + dt2) * 2 + s], sb[dt2][s].v, N[dt], 0, 0, 0); } \
        S[0] = N[0]; S[1] = N[1]; } while (0)
    RWM2_LOAD(pA, qA, 0); RWM2_LOAD(pB, qB, 1); RWM2_LOAD(pC, qC, 2);
#pragma unroll 1
    for (int c = 0; c < NCH - 1; c += 3) {
        RWM2_STEP(pA, qA, c); RWM2_LOAD(pA, qA, c + 3);
        RWM2_STEP(pB, qB, c + 1); RWM2_LOAD(pB, qB, c + 4);
        RWM2_STEP(pC, qC, c + 2); RWM2_LOAD(pC, qC, c + 5);
    }
    static_assert((NCH - 1) % 3 == 0, "chunk loop: 85 rounds of three steps, then the last chunk");
    RWM2_STEP(pA, qA, NCH - 1);
    asm volatile("s_waitcnt vmcnt(0)" : "+v"(pB[0]), "+v"(pB[1]), "+v"(pB[2]), "+v"(pB[3]), "+v"(pB[4]), "+v"(pB[5]), "+v"(pB[6]), "+v"(pB[7]), "+v"(qB[0]), "+v"(qB[1]), "+v"(qB[2]), "+v"(qB[3]) :: "memory");
    asm volatile("" : "+v"(pC[0]), "+v"(pC[1]), "+v"(pC[2]), "+v"(pC[3]), "+v"(pC[4]), "+v"(pC[5]), "+v"(pC[6]), "+v"(pC[7]), "+v"(qC[0]), "+v"(qC[1]), "+v"(qC[2]), "+v"(qC[3]) :: "memory");
#undef RWM2_LD4
#undef RWM2_LOAD
#undef RWM2_WAIT
#undef RWM2_STEP
}
__device__ __forceinline__ bf16x8 ld_perm8(const bf16* p) { union { bf16x8 v; s16x4 h2[2]; } f; f.h2[0] = *(const s16x4*)p; f.h2[1] = *(const s16x4*)(p + 8); return f.v; }
__device__ __forceinline__ void rw_m3_task(int lane, int l, int bh, int c) {
    unsigned char* ws = KWS();
    const int r32 = lane & 31, hh = lane >> 5, b = bh >> 2, h = bh & 3; const size_t un = (size_t)bh * NCH + c; const size_t tok0 = (size_t)b * T + c * 32;
    const bf16* RGp = (const bf16*)(ws + WS_RR) + un * 2048 + r32 * 64 + 4 * hh;
    const bf16* SGp = (const bf16*)(ws + WS_RS) + un * 4096 + lane * 8; const bf16* VTp = (const bf16*)(ws + WS_RVT) + un * 2048 + r32 * 32 + 4 * hh;
    const bf16* UGp = (const bf16*)(ws + WS_RU) + un * 2048 + lane * 8;
    f32x16 Y[2], Z[2];
    const float bon = ((const float*)(ws + WS_BONUS))[(tok0 + r32) * 4 + h];
#pragma unroll
    for (int vt = 0; vt < 2; ++vt)
#pragma unroll
        for (int g2 = 0; g2 < 2; ++g2) { const u32x4 u4 = *(const u32x4*)(UGp + (vt * 2 + g2) * 512);
#pragma unroll
            for (int j = 0; j < 4; ++j) { Y[vt][8 * g2 + 2 * j] = bflo(u4[j]); Y[vt][8 * g2 + 2 * j + 1] = bfhi(u4[j]); } }
#pragma unroll
    for (int i = 0; i < 16; ++i) { Z[0][i] = 0.f; Z[1][i] = 0.f; }
#pragma unroll
    for (int ks = 0; ks < 4; ++ks) {
        const bf16x8 rf = ld_perm8(RGp + 16 * ks);
        const bf16x8 s0 = *(const bf16x8*)(SGp + ks * 512), s1 = *(const bf16x8*)(SGp + 2048 + ks * 512);
        Y[0] = __builtin_amdgcn_mfma_f32_32x32x16_bf16(s0, rf, Y[0], 0, 0, 0); Y[1] = __builtin_amdgcn_mfma_f32_32x32x16_bf16(s1, rf, Y[1], 0, 0, 0); }
#pragma unroll
    for (int s = 0; s < 2; ++s) {
        union { bf16x8 v; unsigned short e[8]; } db;
#pragma unroll
        for (int j = 0; j < 8; ++j) db.e[j] = (16 * s + 8 * (j >> 2) + 4 * hh + (j & 3) == r32) ? (unsigned short)f2bf(bon) : (unsigned short)0;
#pragma unroll
        for (int vt = 0; vt < 2; ++vt) {
            const bf16* vp = VTp + (size_t)vt * 32 * 32 + 16 * s;
            union { bf16x8 v; s16x4 h2[2]; } vf; vf.h2[0] = *(const s16x4*)vp; vf.h2[1] = *(const s16x4*)(vp + 8);
            Z[vt] = __builtin_amdgcn_mfma_f32_32x32x16_bf16(vf.v, db.v, Z[vt], 0, 0, 0); } }
    float sm = 0.f;
#pragma unroll
    for (int vt = 0; vt < 2; ++vt)
#pragma unroll
        for (int i = 0; i < 16; ++i) sm += Y[vt][i];
    sm += __shfl_xor(sm, 32); const float mu = sm * (1.0f / 64.0f);
    float q = 0.f;
#pragma unroll
    for (int vt = 0; vt < 2; ++vt)
#pragma unroll
        for (int i = 0; i < 16; ++i) { const float dd = Y[vt][i] - mu; q += dd * dd; }
    q += __shfl_xor(q, 32); const float rstd = 1.0f / sqrtf(q * (1.0f / 64.0f) + RW_LN_EPS);
    const size_t tok = tok0 + r32;
    const bf16* gp = (const bf16*)(ws + WS_GBUF) + tok * 256 + h * 64; unsigned char* od = (unsigned char*)(ws + WS_O) + tok * D + 512 + h * 64;
    const float* lnw = KIN(I_RWLNW) + l * 256 + h * 64; const float* lnb = KIN(I_RWLNB) + l * 256 + h * 64;
    f32x4 w4a[2][4], b4a[2][4]; u32x2 gwa[2][4];
#pragma unroll
    for (int vt = 0; vt < 2; ++vt)
#pragma unroll
        for (int g = 0; g < 4; ++g) { const int v0 = 32 * vt + 8 * g + 4 * hh; w4a[vt][g] = *(const f32x4*)(lnw + v0); b4a[vt][g] = *(const f32x4*)(lnb + v0); gwa[vt][g] = *(const u32x2*)(gp + v0); }
    __builtin_amdgcn_sched_barrier(0);
#pragma unroll
    for (int vt = 0; vt < 2; ++vt)
#pragma unroll
        for (int g = 0; g < 4; ++g) { const int v0 = 32 * vt + 8 * g + 4 * hh; const f32x4 w4 = w4a[vt][g], b4 = b4a[vt][g]; const u32x2 gw = gwa[vt][g];
            const float y0 = ((Y[vt][4 * g] - mu) * rstd * w4[0] + b4[0] + Z[vt][4 * g]) * bflo(gw.x), y1 = ((Y[vt][4 * g + 1] - mu) * rstd * w4[1] + b4[1] + Z[vt][4 * g + 1]) * bfhi(gw.x);
            const float y2 = ((Y[vt][4 * g + 2] - mu) * rstd * w4[2] + b4[2] + Z[vt][4 * g + 2]) * bflo(gw.y), y3 = ((Y[vt][4 * g + 3] - mu) * rstd * w4[3] + b4[3] + Z[vt][4 * g + 3]) * bfhi(gw.y);
            store_o4(od + v0, y0, y1, y2, y3); }
}

__device__ __forceinline__ void c1_phase(LAS unsigned char* lds, int l, int vcu, int G) {
    for (int u = vcu, k = 0; u < NB * NCH; u += G, ++k) {
        const int b = (G == 256) ? (vcu >> 5) : (u >> 8), c = (G == 256) ? 255 - ((vcu & 31) + 32 * k) : (u & 255);
        for (int q = 0; q <= PHREP(16); ++q) rw_fused_unit(lds, l, b, c);
        for (int q = 0; q <= PHREP(17); ++q) hg_fused_unit(lds, l, b, c);
        for (int q = 0; q <= PHREP(18); ++q) gla_fused_unit(lds, l, b, c); }
}
__device__ __forceinline__ void m3_gh_phase(int l, int vcu, int G) {
    const int tid = opaque_tid(), lane = tid & 63, wave = __builtin_amdgcn_readfirstlane(tid >> 6);
    unsigned char* ws = KWS();
    const int gw = vcu * NWAVES + wave, NGW = G * NWAVES;
    const bf16* P = (const bf16*)(ws + WS_P); unsigned char* O = (unsigned char*)(ws + WS_O);
    const float* gng = KIN(I_GLANG) + l * 256; const float* hng = KIN(I_HGNG) + l * 256;
    for (int task = gw; task < 24576; task += NGW) {
        const int un = task & 8191, bh = un >> 8, c = un & 255, b = bh >> 2, h = bh & 3; const size_t tok0 = (size_t)b * T + c * 32;
        if (task >= 16384) { for (int q = 0; q <= PHREP(19); ++q) rw_m3_task(lane, l, bh, c); continue; }
        for (int q = 0; q <= PHREP(20); ++q)
        if (task < 8192) m3_gh_task<64>(lane, (const bf16*)(ws + WS_HQ) + (size_t)un * 2048, (const bf16*)(ws + WS_HK) + (size_t)un * 2048, (const bf16*)(ws + WS_HVT) + (size_t)un * 2048, (const bf16*)(ws + WS_HS) + (size_t)un * 4096,
                                         P + tok0 * PINP + PC_HG + h * 64, hng + h * 64, O + tok0 * D + 256 + h * 64);
        else m3_gh_task<32>(lane, (const bf16*)(ws + WS_GQ) + (size_t)un * 1024, (const bf16*)(ws + WS_GK) + (size_t)un * 1024, (const bf16*)(ws + WS_GVT) + (size_t)un * 2048, (const bf16*)(ws + WS_GS) + (size_t)un * 2048,
                            P + tok0 * PINP + PC_GOUT + h * 64, gng + h * 64, O + tok0 * D + h * 64);
    }
}

__device__ __forceinline__ void xattn_units(LAS unsigned char* lds, int l, int first, int last, int stride) {
    const int tid = opaque_tid(), lane = tid & 63, wave = __builtin_amdgcn_readfirstlane(tid >> 6), r32 = lane & 31, hh = lane >> 5;
    const bf16* P = (const bf16*)(KWS() + WS_P); const bf16* MKV = (const bf16*)(KWS() + WS_MKV); unsigned char* O = (unsigned char*)(KWS() + WS_O);
    LAS bf16* KL = (LAS bf16*)lds;
    LAS bf16* VT = (LAS bf16*)(lds + 256 * 72 * 2);
    int cur_bh = -1;
    for (int u = first; u < last; u += stride) {
        const int bh = u >> 5, qb = u & 31, b = bh >> 2, h = bh & 3;
        if (bh != cur_bh) {
            lds_barrier();
            for (int i = tid; i < 256 * 8; i += NTHR) { const int key = i >> 3, c8 = i & 7;
                const bf16* src = MKV + (size_t)(b * 256 + key) * 2048 + l * 512 + h * 64 + c8 * 8;
                *(LAS u32x4*)(KL + key * 72 + c8 * 8) = *(const u32x4*)src;
                const u32x4 vv = *(const u32x4*)(src + 256);
                LAS bf16* vd = VT + (c8 * 8) * 264 + key;
                vd[0 * 264] = (bf16)(vv.x & 0xffff); vd[1 * 264] = (bf16)(vv.x >> 16); vd[2 * 264] = (bf16)(vv.y & 0xffff); vd[3 * 264] = (bf16)(vv.y >> 16);
                vd[4 * 264] = (bf16)(vv.z & 0xffff); vd[5 * 264] = (bf16)(vv.z >> 16); vd[6 * 264] = (bf16)(vv.w & 0xffff); vd[7 * 264] = (bf16)(vv.w >> 16); }
            lds_barrier();
            cur_bh = bh;
        }
        const int q = b * T + qb * 256 + wave * 32 + r32;
        bf16x8 qf[4];
#pragma unroll
        for (int s = 0; s < 4; ++s) qf[s] = *(const bf16x8*)(P + (size_t)q * PINP + PC_MQ + h * 64 + 16 * s + 8 * hh);
        f32x16 sc[8];
#pragma unroll
        for (int kt = 0; kt < 8; ++kt) {
#pragma unroll
            for (int i = 0; i < 16; ++i) sc[kt][i] = 0.f;
#pragma unroll
            for (int s = 0; s < 4; ++s) { const bf16x8 kf = *(const LAS bf16x8*)(KL + (kt * 32 + r32) * 72 + 16 * s + 8 * hh);
                sc[kt] = __builtin_amdgcn_mfma_f32_32x32x16_bf16(kf, qf[s], sc[kt], 0, 0, 0); }
        }
        float m = -3.0e38f;
#pragma unroll
        for (int kt = 0; kt < 8; ++kt)
#pragma unroll
            for (int i = 0; i < 16; ++i) m = fmaxf(m, sc[kt][i]);
        m = fmaxf(m, __shfl_xor(m, 32));
        float sum = 0.f;
        const float c2 = 0.125f * 1.4426950408889634f;
#pragma unroll
        for (int kt = 0; kt < 8; ++kt)
#pragma unroll
            for (int i = 0; i < 16; ++i) { const float e = __builtin_amdgcn_exp2f((sc[kt][i] - m) * c2); sc[kt][i] = e; sum += e; }
        sum += __shfl_xor(sum, 32);
        const float inv = 1.0f / sum;
        f32x16 oa[2];
#pragma unroll
        for (int vt = 0; vt < 2; ++vt)
#pragma unroll
            for (int i = 0; i < 16; ++i) oa[vt][i] = 0.f;
#pragma unroll
        for (int kt = 0; kt < 8; ++kt)
#pragma unroll
            for (int s = 0; s < 2; ++s) {
                union { bf16x8 v; unsigned w[4]; } pf;
#pragma unroll
                for (int j = 0; j < 4; ++j) pf.w[j] = cvt_pk_bf16(sc[kt][8 * s + 2 * j], sc[kt][8 * s + 2 * j + 1]);
#pragma unroll
                for (int vt = 0; vt < 2; ++vt) {
                    const LAS bf16* vp = VT + (vt * 32 + r32) * 264 + kt * 32 + 16 * s + 4 * hh;
                    union { bf16x8 v; s16x4 h2[2]; } vf; vf.h2[0] = *(const LAS s16x4*)vp; vf.h2[1] = *(const LAS s16x4*)(vp + 8);
                    oa[vt] = __builtin_amdgcn_mfma_f32_32x32x16_bf16(vf.v, pf.v, oa[vt], 0, 0, 0); }
            }
        unsigned char* orow = O + (size_t)q * D + 768 + h * 64;
#pragma unroll
        for (int vt = 0; vt < 2; ++vt)
#pragma unroll
            for (int g = 0; g < 4; ++g) store_o4(orow + vt * 32 + 8 * g + 4 * hh, oa[vt][4 * g] * inv, oa[vt][4 * g + 1] * inv, oa[vt][4 * g + 2] * inv, oa[vt][4 * g + 3] * inv);
    }
    lds_barrier();
}

__device__ __forceinline__ void m2_phase(LAS unsigned char* lds, int l, int bx, int G) {
    unsigned char* ws = KWS();
    const int tid = opaque_tid(), lane = tid & 63, wave = __builtin_amdgcn_readfirstlane(tid >> 6);
    const int nrw = (G >= 128) ? 64 : 0;
    if (nrw) { if (bx < nrw && wave == 0) for (int q = 0; q <= PHREP(22); ++q) rw_m2_wave(lane, bx >> 1, bx & 1); }
    else { if (wave == 0) for (int q = bx; q < 64; q += G) rw_m2_wave(lane, q >> 1, q & 1); }
    if (nrw && bx >= nrw) {
        const int nth = (G - nrw) * NTHR;
        const int gt = (bx - nrw) * NTHR + tid;
        for (int q = 0; q <= PHREP(23); ++q)
        for (int e = gt; e < 98304; e += nth) {
            if (e < 65536) m2_gh_elem2<64>(e, (const bf16*)(ws + WS_HDS), (const float*)(ws + WS_HBE), (bf16*)(ws + WS_HS));
            else m2_gh_elem2<32>(e - 65536, (const bf16*)(ws + WS_GDS), (const float*)(ws + WS_GBE), (bf16*)(ws + WS_GS)); }
    }
    if (nrw == 0) { __syncthreads(); for (int e = bx * NTHR + tid; e < 98304; e += G * NTHR) {
            if (e < 65536) m2_gh_elem2<64>(e, (const bf16*)(ws + WS_HDS), (const float*)(ws + WS_HBE), (bf16*)(ws + WS_HS));
            else m2_gh_elem2<32>(e - 65536, (const bf16*)(ws + WS_GDS), (const float*)(ws + WS_GBE), (bf16*)(ws + WS_GS)); } }
    if (nrw == 0 || bx >= nrw) {
        const int nb = G - nrw, r = bx - nrw;
        const int per = (1024 + nb - 1) / nb, lo = r * per, hi = (lo + per < 1024) ? lo + per : 1024;
        for (int q = 0; q <= PHREP(24); ++q) xattn_units(lds, l, lo, hi, 1);
    }
}

__device__ __forceinline__ void ln1_router_phase(LAS unsigned char* lds, int l, int bx, int G) {
    const int tid = opaque_tid(), lane = tid & 63, wave = __builtin_amdgcn_readfirstlane(tid >> 6);
    LAS float* X = (LAS float*)lds;
    LAS float* PART = (LAS float*)(lds + 16 * 1028 * 4);
    LAS int* HIST = (LAS int*)(lds + 16 * 1028 * 4 + 8 * 16 * 32 * 4);
    LAS f32x4* GB = (LAS f32x4*)(lds + 16 * 1028 * 4 + 8 * 16 * 32 * 4 + 256);
    const float* xin = KIN(I_X); const bf16* xinb = (const bf16*)(KWS() + WS_XB);
    const bf16* HM = (const bf16*)(KWS() + WS_HMIX);
    bf16* X1B = (bf16*)(KWS() + WS_X1B); unsigned char* X1Q = (unsigned char*)(KWS() + WS_XF);
    const float* g1 = KIN(I_LN1G) + l * D; const float* b1 = KIN(I_LN1B) + l * D;
    const float* rw = KIN(I_RTW) + (size_t)l * D * NE; const float* rb = KIN(I_RTB) + l * NE;
    int* tok_e = (int*)(KWS() + WS_ROUTE); float* tok_g = (float*)(KWS() + WS_ROUTE + 1 * MiB);
    if (tid < 32) HIST[tid] = 0;
    if (tid < 256) { GB[tid] = ((const f32x4*)g1)[tid]; GB[256 + tid] = ((const f32x4*)b1)[tid]; }
    const float rbe = rb[tid & 31];
    bf16x8 rwH[4][2], rwL[4][2];
    { const int q = lane >> 4, e = lane & 15;
#pragma unroll
      for (int s = 0; s < 4; ++s)
#pragma unroll
          for (int nt = 0; nt < 2; ++nt) { union { bf16x8 v; unsigned w[4]; } fh, fl;
#pragma unroll
              for (int j = 0; j < 4; ++j) { const float* p = rw + (size_t)(128 * wave + 32 * s + 8 * q + 2 * j) * NE + 16 * nt + e; const float v0 = p[0], v1 = p[NE];
                  const unsigned h = cvt_pk_bf16(v0, v1); fh.w[j] = h; fl.w[j] = cvt_pk_bf16(v0 - bflo(h), v1 - bfhi(h)); }
              rwH[s][nt] = fh.v; rwL[s][nt] = fl.v; } }
    lds_barrier();
    f32x4 xraw[2][4]; u32x2 xbraw[2][4], hraw[2][4];
#define LN1_LOAD(it_) do { const size_t _tok = (size_t)(it_) * 16 + wave * 2; const u32x2* _hr = (const u32x2*)(HM + _tok * D) + lane; \
        if (l == 0) { const f32x4* _xr = (const f32x4*)(xin + _tok * D) + lane;        \
            _Pragma("unroll") for (int tt = 0; tt < 2; ++tt) _Pragma("unroll") for (int j = 0; j < 4; ++j) xraw[tt][j] = _xr[tt * 256 + 64 * j]; } \
        else { const u32x2* _xbr = (const u32x2*)(xinb + _tok * D) + lane; \
            _Pragma("unroll") for (int tt = 0; tt < 2; ++tt) _Pragma("unroll") for (int j = 0; j < 4; ++j) xbraw[tt][j] = _xbr[tt * 256 + 64 * j]; } \
        _Pragma("unroll") for (int tt = 0; tt < 2; ++tt) _Pragma("unroll") for (int j = 0; j < 4; ++j) hraw[tt][j] = _hr[tt * 256 + 64 * j]; } while (0)
    if (bx < NTOK / 16) LN1_LOAD(bx);
    for (int it = bx; it < NTOK / 16; it += G) {
        f32x4 vv[2][4];
#pragma unroll
        for (int tt = 0; tt < 2; ++tt)
#pragma unroll
            for (int j = 0; j < 4; ++j) { f32x4 xv; if (l == 0) xv = xraw[tt][j]; else { const u32x2 xw = xbraw[tt][j]; xv = (f32x4){bflo(xw.x), bfhi(xw.x), bflo(xw.y), bfhi(xw.y)}; } const u32x2 hw = hraw[tt][j];
                vv[tt][j][0] = DN_ALPHA * xv[0] + bflo(hw.x); vv[tt][j][1] = DN_ALPHA * xv[1] + bfhi(hw.x); vv[tt][j][2] = DN_ALPHA * xv[2] + bflo(hw.y); vv[tt][j][3] = DN_ALPHA * xv[3] + bfhi(hw.y); }
        if (it + G < NTOK / 16) LN1_LOAD(it + G);
#pragma unroll
        for (int tt = 0; tt < 2; ++tt) { const int ti = wave * 2 + tt; const size_t tok = (size_t)it * 16 + ti;
            f32x4 v[4]; float s = 0.f;
#pragma unroll
            for (int j = 0; j < 4; ++j) { v[j] = vv[tt][j]; s += (v[j][0] + v[j][1]) + (v[j][2] + v[j][3]); }
            const float mean = wave_sum(s) * (1.0f / D); float s2 = 0.f;
#pragma unroll
            for (int j = 0; j < 4; ++j) { v[j] = v[j] - mean; s2 += (v[j][0] * v[j][0] + v[j][1] * v[j][1]) + (v[j][2] * v[j][2] + v[j][3] * v[j][3]); }
            const float rstd = 1.0f / sqrtf(wave_sum(s2) * (1.0f / D) + LN_EPS);
#pragma unroll
            for (int j = 0; j < 4; ++j) { const f32x4 gg = GB[lane + 64 * j], bb = GB[256 + lane + 64 * j];
                const f32x4 y = v[j] * rstd * gg + bb;
                *((u32x2*)(X1B + tok * D) + lane + 64 * j) = (u32x2){pk2(y[0], y[1]), pk2(y[2], y[3])};
                { int w = __builtin_amdgcn_cvt_pk_fp8_f32(y[0], y[1], 0, false); w = __builtin_amdgcn_cvt_pk_fp8_f32(y[2], y[3], w, true); *((unsigned*)(X1Q + tok * D) + lane + 64 * j) = (unsigned)w; }
                *(LAS f32x4*)(X + ti * 1028 + 4 * lane + 256 * j) = y; }
        }
        lds_barrier();
        {
            const int q = lane >> 4, r = lane & 15;
            f32x4 acc0 = (f32x4){0.f, 0.f, 0.f, 0.f}, acc1 = (f32x4){0.f, 0.f, 0.f, 0.f};
            const LAS float* xa = X + r * 1028 + 128 * wave + 8 * q;
#pragma unroll
            for (int s = 0; s < 4; ++s) { const f32x4 x0 = *(const LAS f32x4*)(xa + 32 * s), x1 = *(const LAS f32x4*)(xa + 32 * s + 4);
                union { bf16x8 v; unsigned w[4]; } ah, al;
                ah.w[0] = cvt_pk_bf16(x0[0], x0[1]); ah.w[1] = cvt_pk_bf16(x0[2], x0[3]); ah.w[2] = cvt_pk_bf16(x1[0], x1[1]); ah.w[3] = cvt_pk_bf16(x1[2], x1[3]);
                al.w[0] = cvt_pk_bf16(x0[0] - bflo(ah.w[0]), x0[1] - bfhi(ah.w[0])); al.w[1] = cvt_pk_bf16(x0[2] - bflo(ah.w[1]), x0[3] - bfhi(ah.w[1]));
                al.w[2] = cvt_pk_bf16(x1[0] - bflo(ah.w[2]), x1[1] - bfhi(ah.w[2])); al.w[3] = cvt_pk_bf16(x1[2] - bflo(ah.w[3]), x1[3] - bfhi(ah.w[3]));
                acc0 = __builtin_amdgcn_mfma_f32_16x16x32_bf16(ah.v, rwH[s][0], acc0, 0, 0, 0); acc1 = __builtin_amdgcn_mfma_f32_16x16x32_bf16(ah.v, rwH[s][1], acc1, 0, 0, 0);
                acc0 = __builtin_amdgcn_mfma_f32_16x16x32_bf16(ah.v, rwL[s][0], acc0, 0, 0, 0); acc1 = __builtin_amdgcn_mfma_f32_16x16x32_bf16(ah.v, rwL[s][1], acc1, 0, 0, 0);
                acc0 = __builtin_amdgcn_mfma_f32_16x16x32_bf16(al.v, rwH[s][0], acc0, 0, 0, 0); acc1 = __builtin_amdgcn_mfma_f32_16x16x32_bf16(al.v, rwH[s][1], acc1, 0, 0, 0); }
#pragma unroll
            for (int i = 0; i < 4; ++i) { PART[(wave * 16 + 4 * q + i) * 32 + r] = acc0[i]; PART[(wave * 16 + 4 * q + i) * 32 + 16 + r] = acc1[i]; }
        }
        lds_barrier();
        {
            const int ti = tid >> 5, e = tid & 31;
            float lg = rbe;
#pragma unroll
            for (int w = 0; w < 8; ++w) lg += PART[(w * 16 + ti) * 32 + e];
            float tv[4]; int te[4]; float cur = lg;
#pragma unroll
            for (int k = 0; k < 4; ++k) { float bv = cur; int bi = e;
#pragma unroll
                for (int st = 0; st < 5; ++st) { float ov; int oi;
                    const int bvi = __builtin_bit_cast(int, bv);
                    if (st == 0) { ov = __builtin_bit_cast(float, __builtin_amdgcn_update_dpp(bvi, bvi, 0xB1, 0xf, 0xf, false)); oi = __builtin_amdgcn_update_dpp(bi, bi, 0xB1, 0xf, 0xf, false); }
                    else if (st == 1) { ov = __builtin_bit_cast(float, __builtin_amdgcn_update_dpp(bvi, bvi, 0x4E, 0xf, 0xf, false)); oi = __builtin_amdgcn_update_dpp(bi, bi, 0x4E, 0xf, 0xf, false); }
                    else if (st == 2) { ov = __builtin_bit_cast(float, __builtin_amdgcn_update_dpp(bvi, bvi, 0x141, 0xf, 0xf, false)); oi = __builtin_amdgcn_update_dpp(bi, bi, 0x141, 0xf, 0xf, false); }
                    else if (st == 3) { ov = __builtin_bit_cast(float, __builtin_amdgcn_update_dpp(bvi, bvi, 0x140, 0xf, 0xf, false)); oi = __builtin_amdgcn_update_dpp(bi, bi, 0x140, 0xf, 0xf, false); }
                    else { ov = __shfl_xor(bv, 16); oi = __shfl_xor(bi, 16); }
                    if (ov > bv || (ov == bv && oi < bi)) { bv = ov; bi = oi; } }
                tv[k] = bv; te[k] = bi; if (e == bi) cur = -3.0e38f; }
            const float e1 = __expf(tv[1] - tv[0]), e2 = __expf(tv[2] - tv[0]), e3 = __expf(tv[3] - tv[0]); const float inv = 1.0f / (1.0f + e1 + e2 + e3);
            const size_t tok = (size_t)it * 16 + ti;
            if (e < 4) { const int ek = e == 0 ? te[0] : e == 1 ? te[1] : e == 2 ? te[2] : te[3]; const float gk = (e == 0 ? 1.0f : e == 1 ? e1 : e == 2 ? e2 : e3) * inv;
                tok_e[tok * 4 + e] = ek; tok_g[tok * 4 + e] = gk; __hip_atomic_fetch_add(&HIST[ek], 1, __ATOMIC_RELAXED, __HIP_MEMORY_SCOPE_WORKGROUP); }
        }
    }
#undef LN1_LOAD
    lds_barrier();
    if (tid < 32) ((int*)(KWS() + WS_CTL))[CW_HIST + bx * 32 + tid] = HIST[tid];
}

__device__ __forceinline__ void slots_phase(LAS unsigned char* lds, int bx, int G) {
    const int tid = opaque_tid();
    int* ctl = (int*)(KWS() + WS_CTL);
    LAS int* RED = (LAS int*)lds;
    LAS int* TOT = RED + 1024;
    const int* tok_e = (const int*)(KWS() + WS_ROUTE); const float* tok_g = (const float*)(KWS() + WS_ROUTE + 1 * MiB);
    int* tok_slot = (int*)(KWS() + WS_ROUTE + 2 * MiB); int* slot_tok = (int*)(KWS() + WS_ROUTE + 3 * MiB);
    { const int e = tid & 31, part = tid >> 5; int tot = 0, pre = 0;
      for (int b2 = part; b2 < G; b2 += 16) { const int h = ctl[CW_HIST + b2 * 32 + e]; tot += h; if (b2 < bx) pre += h; }
      RED[(part * 32 + e) * 2] = tot; RED[(part * 32 + e) * 2 + 1] = pre; }
    __syncthreads();
    if (tid < 32) { int tot = 0, pre = 0; for (int p = 0; p < 16; ++p) { tot += RED[(p * 32 + tid) * 2]; pre += RED[(p * 32 + tid) * 2 + 1]; } TOT[tid] = tot; TOT[32 + tid] = pre; TOT[96 + tid] = 0; }
    __syncthreads();
    if (tid == 0) { int ps = 0;
#pragma unroll 1
        for (int e = 0; e < 32; ++e) { TOT[64 + e] = ps; ps += (TOT[e] + 255) & ~255; }
        TOT[128] = ps >> 8; if (bx == 0) ctl[CW_NT] = ps >> 8; }
    __syncthreads();
    if (bx == 0) { const int nt = TOT[128];
        for (int t = tid; t < nt; t += NTHR) { int e = 0;
#pragma unroll 1
            for (int k = 1; k < 32; ++k) if (TOT[64 + k] <= t * 256) e = k;
            ctl[CW_TILEE + t] = e; } }
    for (int e = bx; e < 32; e += G) { const int s0 = TOT[64 + e] + TOT[e], s1 = TOT[64 + e] + ((TOT[e] + 255) & ~255); for (int s = s0 + tid; s < s1; s += NTHR) slot_tok[s] = 0; }
    for (int it = bx + G * (tid >> 6); it < NTOK / 16; it += G * 8) {
        const int asg = it * 64 + (tid & 63); const int e = tok_e[asg]; const int rank = __hip_atomic_fetch_add(&TOT[96 + e], 1, __ATOMIC_RELAXED, __HIP_MEMORY_SCOPE_WORKGROUP); const int slot = TOT[64 + e] + TOT[32 + e] + rank;
        tok_slot[asg] = slot; slot_tok[slot] = asg >> 2;
    }
}

__device__ __forceinline__ void combine_phase(int l, int vcu, int G) {
    const int tid = opaque_tid(), lane = tid & 63, wave = __builtin_amdgcn_readfirstlane(tid >> 6);
    const int gw = vcu * NWAVES + wave, NGW = G * NWAVES;
    const bf16* X1B = (const bf16*)(KWS() + WS_X1B); const unsigned char* YB = (const unsigned char*)(KWS() + WS_YB); const int* tok_slot = (const int*)(KWS() + WS_ROUTE + 2 * MiB); const float* tok_gate = (const float*)(KWS() + WS_ROUTE + 1 * MiB);
    float* xo = KOUT(); bf16* XB = (bf16*)(KWS() + WS_XB); unsigned char* X8 = (unsigned char*)(KWS() + WS_X8);
    const float* g2 = KIN(I_LN2G) + l * D; const float* b2 = KIN(I_LN2B) + l * D;
    unsigned wg[128];
    { const unsigned* Wg = (const unsigned*)(KWS() + WS_GLRW) + (size_t)(l + 1 < NL ? l + 1 : l) * 8192 + lane;
#pragma unroll
      for (int i = 0; i < 128; ++i) wg[i] = Wg[i * 64]; }
    bf16* PG = (bf16*)(KWS() + WS_P) + PC_GLR + ((lane >> 2) & 15);
    u32x2 xw[4]; unsigned ya[4][4]; int ns0 = 0, ns1 = 0, ns2 = 0, ns3 = 0; f32x4 gv = {0.f, 0.f, 0.f, 0.f};
#define CMB_SLOTS(t_) do { const int4 _s = *(const int4*)(tok_slot + (size_t)(t_) * 4); ns0 = _s.x; ns1 = _s.y; ns2 = _s.z; ns3 = _s.w; } while (0)
#define CMB_ROWS(t_) do { const u32x2* _xr = (const u32x2*)(X1B + (size_t)(t_) * D) + lane; gv = *(const f32x4*)(tok_gate + (size_t)(t_) * 4); \
        const unsigned* _y0 = (const unsigned*)(YB + (size_t)ns0 * D) + lane; const unsigned* _y1 = (const unsigned*)(YB + (size_t)ns1 * D) + lane; \
        const unsigned* _y2 = (const unsigned*)(YB + (size_t)ns2 * D) + lane; const unsigned* _y3 = (const unsigned*)(YB + (size_t)ns3 * D) + lane; \
        _Pragma("unroll") for (int j = 0; j < 4; ++j) { xw[j] = _xr[64 * j]; ya[0][j] = _y0[64 * j]; ya[1][j] = _y1[64 * j]; ya[2][j] = _y2[64 * j]; ya[3][j] = _y3[64 * j]; } } while (0)
    if (gw < NTOK) { CMB_SLOTS(gw); CMB_ROWS(gw); if (gw + NGW < NTOK) CMB_SLOTS(gw + NGW); }
    for (int tok = gw; tok < NTOK; tok += NGW) {
        f32x4 v[4]; float s = 0.f; const f32x4 gs = gv * 0.0625f;
#pragma unroll
        for (int j = 0; j < 4; ++j) { const f32x4 xv = {bflo(xw[j].x), bfhi(xw[j].x), bflo(xw[j].y), bfhi(xw[j].y)};
            f32x2 lo = __builtin_amdgcn_cvt_pk_f32_fp8(ya[0][j], false) * gs[0], hi = __builtin_amdgcn_cvt_pk_f32_fp8(ya[0][j], true) * gs[0];
#pragma unroll
            for (int k = 1; k < 4; ++k) { lo += __builtin_amdgcn_cvt_pk_f32_fp8(ya[k][j], false) * gs[k]; hi += __builtin_amdgcn_cvt_pk_f32_fp8(ya[k][j], true) * gs[k]; }
            v[j][0] = DN_ALPHA * xv[0] + lo[0]; v[j][1] = DN_ALPHA * xv[1] + lo[1]; v[j][2] = DN_ALPHA * xv[2] + hi[0]; v[j][3] = DN_ALPHA * xv[3] + hi[1];
            s += (v[j][0] + v[j][1]) + (v[j][2] + v[j][3]); }
        if (tok + NGW < NTOK) { CMB_ROWS(tok + NGW); if (tok + 2 * NGW < NTOK) CMB_SLOTS(tok + 2 * NGW); }
        const float mean = wave_sum(s) * (1.0f / D); float q = 0.f;
#pragma unroll
        for (int j = 0; j < 4; ++j) { v[j] = v[j] - mean; q += (v[j][0] * v[j][0] + v[j][1] * v[j][1]) + (v[j][2] * v[j][2] + v[j][3] * v[j][3]); }
        const float rstd = 1.0f / sqrtf(wave_sum(q) * (1.0f / D) + LN_EPS);
        float ga[16];
#pragma unroll
        for (int c = 0; c < 16; ++c) ga[c] = 0.f;
#pragma unroll
        for (int j = 0; j < 4; ++j) { const f32x4 gg = *((const f32x4*)g2 + lane + 64 * j), bb = *((const f32x4*)b2 + lane + 64 * j);
            const f32x4 y = v[j] * rstd * gg + bb;
            if (l == NL - 1) *((f32x4*)(xo + (size_t)tok * D) + lane + 64 * j) = y;
            else { const unsigned p0 = pk2(y[0], y[1]), p1 = pk2(y[2], y[3]); *((u32x2*)(XB + (size_t)tok * D) + lane + 64 * j) = (u32x2){p0, p1};
                store_o4(X8 + (size_t)tok * D + 4 * (lane + 64 * j), y[0], y[1], y[2], y[3]);
#pragma unroll
                for (int c = 0; c < 16; ++c) { ga[c] = __builtin_amdgcn_fdot2_f32_bf16(__builtin_bit_cast(bf16x2_t, p0), __builtin_bit_cast(bf16x2_t, wg[(2 * j) * 16 + c]), ga[c], false);
                                               ga[c] = __builtin_amdgcn_fdot2_f32_bf16(__builtin_bit_cast(bf16x2_t, p1), __builtin_bit_cast(bf16x2_t, wg[(2 * j + 1) * 16 + c]), ga[c], false); } } }
        if (l != NL - 1) {
            const bool h5 = (lane & 32) != 0, h4 = (lane & 16) != 0, h3 = (lane & 8) != 0, h2 = (lane & 4) != 0;
            float r8[8], r4[4], r2[2];
#pragma unroll
            for (int i = 0; i < 8; ++i) { const float keep = h5 ? ga[8 + i] : ga[i], send = h5 ? ga[i] : ga[8 + i]; r8[i] = keep + __shfl_xor(send, 32); }
#pragma unroll
            for (int i = 0; i < 4; ++i) { const float keep = h4 ? r8[4 + i] : r8[i], send = h4 ? r8[i] : r8[4 + i]; r4[i] = keep + __shfl_xor(send, 16); }
#pragma unroll
            for (int i = 0; i < 2; ++i) { const float keep = h3 ? r4[2 + i] : r4[i], send = h3 ? r4[i] : r4[2 + i]; r2[i] = keep + __shfl_xor(send, 8); }
            const float keep = h2 ? r2[1] : r2[0], send = h2 ? r2[0] : r2[1];
            float r1 = keep + __shfl_xor(send, 4);
            r1 = dpp_add(r1, 0); r1 = dpp_add(r1, 1);
            if ((lane & 3) == 0) PG[(size_t)tok * PINP] = (bf16)f2bf(r1);
        }
    }
#undef CMB_SLOTS
#undef CMB_ROWS
}


constexpr int PH_PER_LAYER = 10, NPHASES = 2 + NL * PH_PER_LAYER;
__global__ void __launch_bounds__(NTHR, 2) trunk_fwd(Args args) {
    extern __shared__ __attribute__((aligned(16))) unsigned char lds_raw[];
    LAS unsigned char* lds = (LAS unsigned char*)lds_raw;
    volatile LAS unsigned* MISC = (volatile LAS unsigned*)(lds + MISC_OFF);
    const int tid = threadIdx.x;
    const int G = gridDim.x, bx = blockIdx.x;
    const int vcu = (G % 8 == 0) ? (bx % 8) * (G / 8) + bx / 8 : bx;
    unsigned char* ws = KWS();
    unsigned* ctl = (unsigned*)(ws + WS_CTL);
    for (int u = tid; u < (LDS_BYTES - LDSCTL_OFF) / 4; u += NTHR) ((LAS unsigned*)(lds + LDSCTL_OFF))[u] = 0u;
    __syncthreads();
    XcdBarrier bar; bar.bar = ctl + CW_BAR; bar.x = 0; bar.st = nullptr;
#if !MK_PER_PHASE
    bar = xcd_barrier_post(ctl + CW_BAR, MISC + 8);
#define GRID_BAR() xcd_barrier(bar)
#else
#define GRID_BAR() do { } while (0)
#endif
    const int lo = (int)(unsigned)ka_u64<280>(), hi = (int)(unsigned)(ka_u64<280>() >> 32);
#ifndef PH_MASK
#define PH_MASK 0x1FFF
#endif
#define PHEN(n) (((PH_MASK) >> (n)) & 1)
#define IN(k) (lo <= (k) && (k) < hi)
#define SEAM(k) do { if (rep > 0 || IN((k) + 1)) { GRID_BAR(); if (PHREP(21)) GRID_BAR(); } } while (0)

#define OG opaque_s(G)
#define OBX opaque_s(bx)
#define OVCU opaque_s(vcu)
#define OL opaque_s(l)
    if (PHEN(0) && IN(0)) for (int rep = PHREP(0); rep >= 0; --rep) { prologue_phase(lds, OVCU, OG); SEAM(0); }
    if (PHEN(1) && IN(1)) for (int rep = PHREP(1); rep >= 0; --rep) {
        pg8::DenseOrder S; S.init(KWS() + WS_MEMB, KWS() + WS_WMEM, NB * NMEM, 2048, D, OG, OBX);
        pg8::EpiBf16 E{(bf16*)(KWS() + WS_MKV), 2048};
        pg8::gemm_phase<pg8::EpiBf16, pg8::DenseOrder>(lds, D, S, E);
        SEAM(1);
    }
    for (int l = 0; l < NL; ++l) {
        const int p0 = 2 + l * PH_PER_LAYER;
        if (PHEN(2) && IN(p0 + 0)) for (int rep = PHREP(2); rep >= 0; --rep) {
            pg8::DenseOrder S; S.init(KWS() + WS_X8, KWS() + WS_WIN + (size_t)OL * PINP * D, NTOK, l == 0 ? PINP : PINP - 256, D / 2, OG, OBX);
            pg8::EpiBf16T<123, 125> E{(bf16*)(KWS() + WS_P), PINP};
            pg8::gemm_phase<pg8::EpiBf16T<123, 125>, pg8::DenseOrder, 1>(lds, D, S, E);
            SEAM(p0 + 0);
        }
        if (PHEN(4) && IN(p0 + 1)) for (int rep = PHREP(4); rep >= 0; --rep) { c1_phase(lds, OL, OVCU, OG); SEAM(p0 + 1); }
        if (PHEN(5) && IN(p0 + 2)) for (int rep = PHREP(5); rep >= 0; --rep) { m2_phase(lds, OL, OBX, OG); SEAM(p0 + 2); }
        if (PHEN(6) && IN(p0 + 3)) for (int rep = PHREP(6); rep >= 0; --rep) { m3_gh_phase(OL, OVCU, OG); SEAM(p0 + 3); }
        if (PHEN(7) && IN(p0 + 4)) for (int rep = PHREP(7); rep >= 0; --rep) {
            pg8::DenseOrder S; S.init(KWS() + WS_O, KWS() + WS_WOUT + (size_t)OL * D * D, NTOK, D, D / 2, OG, OBX);
            pg8::EpiBf16T<122, 125> E{(bf16*)(KWS() + WS_HMIX), D};
            pg8::gemm_phase<pg8::EpiBf16T<122, 125>, pg8::DenseOrder, 1>(lds, D, S, E);
            SEAM(p0 + 4);
        }
        if (PHEN(8) && IN(p0 + 5)) for (int rep = PHREP(8); rep >= 0; --rep) { ln1_router_phase(lds, OL, OBX, OG); SEAM(p0 + 5); }
        if (PHEN(9) && IN(p0 + 6)) for (int rep = PHREP(9); rep >= 0; --rep) { slots_phase(lds, OBX, OG); SEAM(p0 + 6); }
        if (PHEN(10) && IN(p0 + 7)) for (int rep = PHREP(10); rep >= 0; --rep) {
            const int ntiles = __builtin_amdgcn_readfirstlane(((const int*)(KWS() + WS_CTL))[CW_NT]);
            pg8::MoeOrder<true> S; S.init(KWS() + WS_XF, KWS() + WS_WGU + (size_t)OL * NE * 2048 * D, (const int*)(KWS() + WS_CTL) + CW_TILEE, (const int*)(KWS() + WS_ROUTE + 3 * MiB), ntiles, 2048, D, OG, OBX);
            pg8::EpiSwiglu E{(unsigned char*)(KWS() + WS_HB), (const float*)(KWS() + WS_BGU) + (size_t)OL * NE * 2048};
            pg8::gemm_phase<pg8::EpiSwiglu, pg8::MoeOrder<true>, 1>(lds, D, S, E);
            SEAM(p0 + 7);
        }
        if (PHEN(11) && IN(p0 + 8)) for (int rep = PHREP(11); rep >= 0; --rep) {
            const int ntiles = __builtin_amdgcn_readfirstlane(((const int*)(KWS() + WS_CTL))[CW_NT]);
            pg8::MoeOrder<false> S; S.init(KWS() + WS_HB, KWS() + WS_WD + (size_t)OL * NE * D * FF, (const int*)(KWS() + WS_CTL) + CW_TILEE, (const int*)(KWS() + WS_ROUTE + 3 * MiB), ntiles, D, FF, OG, OBX);
            pg8::EpiDown E{(unsigned char*)(KWS() + WS_YB), KIN(I_BDN) + (size_t)OL * NE * D};
            pg8::gemm_phase<pg8::EpiDown, pg8::MoeOrder<false>, 1>(lds, FF, S, E);
            SEAM(p0 + 8);
        }
        if (PHEN(12) && IN(p0 + 9)) for (int rep = PHREP(12); rep >= 0; --rep) { combine_phase(OL, OVCU, OG); if (rep > 0 || l + 1 < NL) SEAM(p0 + 9); }
    }
#undef IN
#undef SEAM
}

extern "C" void kernel_launch(void* const* d_in, const int* in_sizes, int n_in, void* d_out, int out_size, void* d_ws, size_t ws_size, hipStream_t stream) {
    static int grid = 0;
    if (grid == 0) {
        if (n_in != 33 || ws_size < WS_END) { fprintf(stderr, "kernel_launch: unexpected inputs (n_in %d, ws %zu need %zu)\n", n_in, ws_size, (size_t)WS_END); grid = -1; return; }
        int dev = 0, cus = 0;
        if (hipGetDevice(&dev) != hipSuccess || hipDeviceGetAttribute(&cus, hipDeviceAttributeMultiprocessorCount, dev) != hipSuccess) { grid = -1; return; }
        if (hipFuncSetAttribute((const void*)trunk_fwd, hipFuncAttributeMaxDynamicSharedMemorySize, LDS_BYTES) != hipSuccess) { grid = -1; return; }
        int per_cu = 0; (void)hipOccupancyMaxActiveBlocksPerMultiprocessor(&per_cu, (const void*)trunk_fwd, NTHR, LDS_BYTES); (void)hipGetLastError();
        grid = cus;
    }
    if (grid < 0) return;
    (void)hipMemsetAsync((char*)d_ws + WS_CTL, 0, CTL_ZERO_BYTES, stream);
    Args a{};
    for (int i = 0; i < 33; ++i) a.in[i] = (const float*)d_in[i];
    a.out = (float*)d_out; a.ws = (unsigned char*)d_ws;
#if MK_PER_PHASE
    for (int p = 0; p < NPHASES; ++p) { a.ph_lo = p; a.ph_hi = p + 1; hipLaunchKernelGGL(trunk_fwd, dim3(grid), dim3(NTHR), LDS_BYTES, stream, a); }
#else
    a.ph_lo = 0; a.ph_hi = NPHASES;
    hipLaunchKernelGGL(trunk_fwd, dim3(grid), dim3(NTHR), LDS_BYTES, stream, a);
#endif
}
```

```cpp
#include <hip/hip_runtime.h>
#include <cstdio>
#include <cstdint>

#ifndef MK_PER_PHASE
#define MK_PER_PHASE 0
#endif

#ifndef REP_MASK
#define REP_MASK 0
#endif
#define PHREP(n) (((REP_MASK) >> (n)) & 1)
#define LAS __attribute__((address_space(3)))
#define GAS __attribute__((address_space(1)))
typedef unsigned short bf16;
typedef short bf16x8 __attribute__((ext_vector_type(8)));
typedef short s16x4 __attribute__((ext_vector_type(4)));
typedef float f32x4 __attribute__((ext_vector_type(4)));
typedef float f32x2 __attribute__((ext_vector_type(2)));
typedef float f32x16 __attribute__((ext_vector_type(16)));
typedef unsigned u32x4 __attribute__((ext_vector_type(4)));
typedef unsigned u32x2 __attribute__((ext_vector_type(2)));

constexpr int NB = 8, T = 8192, D = 1024, NL = 4, NTOK = NB * T;
constexpr int PIN = 3088, PINP = 3328;
constexpr int NE = 32, FF = 1024, NMEM = 256;
constexpr int NASSIGN = NTOK * 4;
constexpr int MAXTILES = NASSIGN / 256 + NE;
constexpr int MAXSLOTS = MAXTILES * 256;
constexpr int PC_GQ = 0, PC_GK = 128, PC_GV = 256, PC_GOUT = 512, PC_HQ = 768, PC_HF = 1024, PC_HI = 1280, PC_HG = 1536;
constexpr int PC_RW = 1792, PC_MQ = 2816, PC_GLR = 3072;
constexpr float DN_ALPHA = 1.6817928305074292f;
constexpr float LN_EPS = 1e-5f, RMS_EPS = 1e-6f, RW_LN_EPS = 64e-5f;

constexpr size_t MiB = 1u << 20;
constexpr size_t WS_CTL = 0, CTL_ZERO_BYTES = 32768;
constexpr size_t WS_WIN = 1 * MiB;
constexpr size_t WS_WOUT = WS_WIN + 26 * MiB;
constexpr size_t WS_WMEM = WS_WOUT + 8 * MiB;
constexpr size_t WS_WGU = WS_WMEM + 4 * MiB;
constexpr size_t WS_WD = WS_WGU + 512 * MiB;
constexpr size_t WS_BGU = WS_WD + 256 * MiB;
constexpr size_t WS_LORA = WS_BGU + 1 * MiB;
constexpr size_t WS_GLRW = WS_LORA + 512 * 1024;
constexpr size_t WS_MEMB = WS_LORA + 1 * MiB;
constexpr size_t WS_MKV = WS_MEMB + 4 * MiB;
constexpr size_t WS_XB = WS_MKV + 8 * MiB;
constexpr size_t WS_X1B = WS_XB + 128 * MiB;
constexpr size_t WS_XF = WS_X1B + 128 * MiB;
constexpr size_t WS_X1F = WS_XF + 256 * MiB;
constexpr size_t WS_X8 = WS_X1F;
constexpr size_t WS_O = WS_X1F + 256 * MiB;
constexpr size_t WS_HMIX = WS_O + 128 * MiB;
constexpr size_t WS_ROUTE = WS_HMIX + 128 * MiB;
constexpr size_t WS_GBUF = WS_ROUTE + 6 * MiB;
constexpr size_t WS_BONUS = WS_GBUF + 32 * MiB;
constexpr size_t WS_BIG = WS_BONUS + 1 * MiB;
constexpr size_t WS_P = WS_BIG;
constexpr size_t WS_ORAW = WS_P + 416 * MiB;
constexpr size_t WS_HB = WS_BIG;
constexpr size_t WS_YB = WS_HB + 528 * MiB;
constexpr size_t WS_CHK = WS_ORAW;
constexpr size_t WS_HQ = WS_CHK, WS_HK = WS_HQ + 32 * MiB, WS_HVT = WS_HK + 32 * MiB, WS_HDS = WS_HVT + 32 * MiB, WS_HS = WS_HDS + 128 * MiB, WS_HBE = WS_HS + 64 * MiB;
constexpr size_t WS_GQ = WS_HBE + 2 * MiB, WS_GK = WS_GQ + 16 * MiB, WS_GVT = WS_GK + 16 * MiB, WS_GDS = WS_GVT + 32 * MiB, WS_GS = WS_GDS + 64 * MiB, WS_GBE = WS_GS + 32 * MiB;
constexpr size_t WS_RR = WS_GBE + 1 * MiB, WS_RB = WS_RR + 32 * MiB, WS_RK = WS_RB + 32 * MiB, WS_RW = WS_RK + 32 * MiB, WS_RVT = WS_RW + 32 * MiB;
constexpr size_t WS_RVG = WS_RVT + 32 * MiB;
constexpr size_t WS_RU = WS_RVG + 32 * MiB, WS_RP = WS_RU + 64 * MiB, WS_RQ = WS_RP + 64 * MiB, WS_RS = WS_RQ + 128 * MiB;
constexpr size_t WS_END = WS_RS + 64 * MiB;
static_assert(WS_YB + 528 * MiB <= WS_END, "overlay");
static_assert(WS_END <= (size_t)4096 * MiB, "workspace");
constexpr int CW_TMO = 0;
constexpr int CW_BAR = 4096;
constexpr int CW_HIST = 16384;
constexpr int CW_NT = 32768;
constexpr int CW_TILEE = 32768 + 64;
constexpr int CW_PADSTART = 40960;

constexpr int RING_BYTES = 131072;
constexpr int LDSCTL_OFF = 162816, MISC_OFF = LDSCTL_OFF + 320;
constexpr int LDS_BYTES = 163840;
constexpr int NWAVES = 8, NTHR = 512;

#define RLX_AGENT __ATOMIC_RELAXED, __HIP_MEMORY_SCOPE_AGENT
#define LDS_WAIT() asm volatile("s_waitcnt lgkmcnt(0)" ::: "memory")
#define VM_WAIT() asm volatile("s_waitcnt vmcnt(0)" ::: "memory")

__device__ __forceinline__ float bf2f(unsigned short b) { return __builtin_bit_cast(float, (unsigned)b << 16); }
__device__ __forceinline__ float bflo(unsigned w) { return __builtin_bit_cast(float, w << 16); }
__device__ __forceinline__ float bfhi(unsigned w) { return __builtin_bit_cast(float, w & 0xffff0000u); }
typedef __bf16 bf16x2_t __attribute__((ext_vector_type(2)));
__device__ __forceinline__ unsigned cvt_pk_bf16(float lo, float hi) { const f32x2 v = {lo, hi}; const bf16x2_t b = __builtin_convertvector(v, bf16x2_t); return __builtin_bit_cast(unsigned, b); }
__device__ __forceinline__ unsigned pk2(float lo, float hi) { return cvt_pk_bf16(lo, hi); }
__device__ __forceinline__ unsigned f2bf(float f) { return cvt_pk_bf16(f, 0.f) & 0xffffu; }
__device__ __forceinline__ float o_q(float y) { return __builtin_amdgcn_fmed3f(y * 4.0f, -448.0f, 448.0f); }
__device__ __forceinline__ unsigned pack_o4(float y0, float y1, float y2, float y3) { int w = __builtin_amdgcn_cvt_pk_fp8_f32(o_q(y0), o_q(y1), 0, false); w = __builtin_amdgcn_cvt_pk_fp8_f32(o_q(y2), o_q(y3), w, true); return (unsigned)w; }
__device__ __forceinline__ void flush_o_tile(const LAS unsigned char* os, unsigned char* obase  , int lane) {
#pragma unroll
    for (int i = 0; i < 2; ++i) { const int q = i * 64 + lane, t = q >> 2, c4 = q & 3; *(u32x4*)(obase + (size_t)t * D + c4 * 16) = *(const LAS u32x4*)(os + t * 64 + c4 * 16); }
}
__device__ __forceinline__ void store_o4(unsigned char* p, float y0, float y1, float y2, float y3) { int w = __builtin_amdgcn_cvt_pk_fp8_f32(o_q(y0), o_q(y1), 0, false); w = __builtin_amdgcn_cvt_pk_fp8_f32(o_q(y2), o_q(y3), w, true); *(unsigned*)p = (unsigned)w; }
__device__ __forceinline__ float fast_exp(float x) { return __builtin_amdgcn_exp2f(x * 1.4426950408889634f); }
__device__ __forceinline__ float fast_sigmoid(float x) { return __builtin_amdgcn_rcpf(1.0f + fast_exp(-x)); }
__device__ __forceinline__ float silu_f(float x) { return x * fast_sigmoid(x); }
__device__ __forceinline__ int opaque_tid() { int t = threadIdx.x; asm volatile("" : "+v"(t)); return t; }
__device__ __forceinline__ int opaque_s(int v) { asm volatile("" : "+s"(v)); return v; }
__device__ __forceinline__ void lds_barrier() { asm volatile("s_waitcnt lgkmcnt(0)" ::: "memory"); __builtin_amdgcn_s_barrier(); asm volatile("" ::: "memory"); }
__device__ __forceinline__ float dpp_add(float x, const int sel) {
    const int xi = __builtin_bit_cast(int, x); int r;
    switch (sel) { case 0: r = __builtin_amdgcn_update_dpp(xi, xi, 0xB1, 0xf, 0xf, false); break;
                   case 1: r = __builtin_amdgcn_update_dpp(xi, xi, 0x4E, 0xf, 0xf, false); break;
                   case 2: r = __builtin_amdgcn_update_dpp(xi, xi, 0x141, 0xf, 0xf, false); break;
                   default: r = __builtin_amdgcn_update_dpp(xi, xi, 0x140, 0xf, 0xf, false); break; }
    return x + __builtin_bit_cast(float, r);
}
__device__ __forceinline__ float wave_sum(float v) {
    v = dpp_add(v, 0); v = dpp_add(v, 1); v = dpp_add(v, 2); v = dpp_add(v, 3);
    v += __builtin_bit_cast(float, __builtin_amdgcn_update_dpp(0, __builtin_bit_cast(int, v), 0x142, 0xa, 0xf, false));
    v += __builtin_bit_cast(float, __builtin_amdgcn_update_dpp(0, __builtin_bit_cast(int, v), 0x143, 0xc, 0xf, false));
    return __builtin_bit_cast(float, __builtin_amdgcn_readlane(__builtin_bit_cast(int, v), 63));
}

namespace pg8 {
constexpr int BM = 256, BK = 64, HALF = 128, HTB = HALF * BK * 2, STAGE_BYTES = 8 * HTB, NXCD = 8, WGM = 8;
__host__ __device__ __forceinline__ int lds_byte(int r, int c) { const int st = (r >> 4) * 2 + (c >> 5), rr = r & 15, cc = c & 31, ob = rr * 64 + cc * 2; return st * 1024 + (ob ^ (((ob >> 9) & 1) << 5)); }
__host__ __device__ __forceinline__ void stage_rc(int b, int& R, int& C) { const int st = b / 1024, sb = b % 1024, swz = sb ^ (((sb >> 9) & 1) << 5); R = (st >> 1) * 16 + swz / 64; C = (st & 1) * 32 + (swz % 64) / 2; }
__host__ __device__ __forceinline__ int perm32(int rho) { const int n = rho >> 4, i = rho & 15; return 8 * (i >> 2) + 4 * n + (i & 3); }

typedef int v4i_t __attribute__((ext_vector_type(4)));
typedef int v8i_t __attribute__((ext_vector_type(8)));
struct Unit { int pm, pn, e; const char* A; const char* B; };
__device__ __forceinline__ unsigned asm_gload_u32(const void* p) { unsigned v; asm volatile("global_load_dword %0, %1, off" : "=v"(v) : "v"(p) : "memory"); return v; }

__device__ __forceinline__ bool static_tile(int i, int G, int c, int nM, int nN, int& pm, int& pn) {
    const int nwg = nM * nN; const long L = (long)i * G + c; if (L >= nwg) return false;
    int wgid = (int)L; { const int q = nwg / NXCD, r = nwg % NXCD, xcd = wgid % NXCD, off = wgid / NXCD; wgid = (xcd < r ? xcd * (q + 1) : r * (q + 1) + (xcd - r) * q) + off; }
    const int nig = WGM * nN, gid = wgid / nig, fm = gid * WGM, gsz = (nM - fm) < WGM ? (nM - fm) : WGM;
    pm = fm + ((wgid % nig) % gsz); pn = (wgid % nig) / gsz; return true;
}
struct DenseOrder {
    static constexpr bool GATHER = false, HAS_E = false;
    const char* A; const char* B; int nM, nN, G, c; size_t tstep;
    __device__ __forceinline__ void init(const void* A_, const void* B_, int M, int N, int K, int G_, int c_) { A = (const char*)A_; B = (const char*)B_; nM = M / BM; nN = N / BM; G = G_; c = c_; tstep = (size_t)BM * K * 2; }
    __device__ __forceinline__ bool next(int i, Unit& u) const { if (!static_tile(i, G, c, nM, nN, u.pm, u.pn)) return false; u.e = 0; u.A = A + (size_t)u.pm * tstep; u.B = B + (size_t)u.pn * tstep; return true; }
    __device__ __forceinline__ unsigned row_tok(const Unit&, int) const { return 0; }
};
template <bool GATHER_> struct MoeOrder {
    static constexpr bool GATHER = GATHER_, HAS_E = true;
    const char* A; const char* B; const int* tile_e; const int* slot_tok; int nM, nN, G, c; size_t tstep, estep;
    __device__ __forceinline__ void init(const void* A_, const void* B_, const int* tile_e_, const int* slot_tok_, int ntiles, int Nper, int Kbytes, int G_, int c_) {
        A = (const char*)A_; B = (const char*)B_; tile_e = tile_e_; slot_tok = slot_tok_; nM = ntiles; nN = Nper / BM; G = G_; c = c_; tstep = (size_t)BM * Kbytes; estep = (size_t)Nper * Kbytes; }
    __device__ __forceinline__ bool next(int i, Unit& u) const { if (!static_tile(i, G, c, nM, nN, u.pm, u.pn)) return false;
        u.e = __builtin_amdgcn_readfirstlane(tile_e[u.pm]); u.A = GATHER_ ? A : A + (size_t)u.pm * tstep; u.B = B + (size_t)u.e * estep + (size_t)u.pn * tstep; return true; }
    __device__ __forceinline__ unsigned row_tok(const Unit& u, int r) const { return (unsigned)slot_tok[u.pm * BM + r]; }
    __device__ __forceinline__ bool next_static(int i, Unit& u) const { return static_tile(i, G, c, nM, nN, u.pm, u.pn); }
    __device__ __forceinline__ const int* e_ptr(const Unit& u) const { return tile_e + u.pm; }
    __device__ __forceinline__ const int* tok_ptr(const Unit& u, int r) const { return slot_tok + u.pm * BM + r; }
    __device__ __forceinline__ void finish(Unit& u, int e) const { u.e = e; u.A = GATHER_ ? A : A + (size_t)u.pm * tstep; u.B = B + (size_t)e * estep + (size_t)u.pn * tstep; }
};

template <int WSCALE_ = 127, int ASCALE_ = 127>
struct EpiBf16T {
    static constexpr bool PERM = true; static constexpr int WSCALE = WSCALE_, ASCALE = ASCALE_;
    bf16* O; int ldc;
    __device__ __forceinline__ void init(f32x4 (&acc)[2][2][4][2], const Unit&, int, int) const {
#pragma unroll
        for (int a = 0; a < 2; ++a)
#pragma unroll
            for (int b = 0; b < 2; ++b)
#pragma unroll
                for (int m = 0; m < 4; ++m)
#pragma unroll
                    for (int n = 0; n < 2; ++n) acc[a][b][m][n] = (f32x4){0.f, 0.f, 0.f, 0.f}; }
    __device__ __forceinline__ void operator()(const f32x4 (&acc)[2][2][4][2], const Unit& u, int wr, int wc, int fr, int fq) const {
        const int row0 = u.pm * BM + wr * 64 + fr, col0 = u.pn * BM + wc * 32 + 8 * fq;
#pragma unroll
        for (int ai = 0; ai < 2; ++ai)
#pragma unroll
            for (int m = 0; m < 4; ++m) { bf16* rowp = O + (size_t)(row0 + ai * HALF + m * 16) * ldc + col0;
#pragma unroll
                for (int bj = 0; bj < 2; ++bj) { const f32x4 v0 = acc[ai][bj][m][0], v1 = acc[ai][bj][m][1];
                    u32x4 w; w.x = cvt_pk_bf16(v0[0], v0[1]); w.y = cvt_pk_bf16(v0[2], v0[3]); w.z = cvt_pk_bf16(v1[0], v1[1]); w.w = cvt_pk_bf16(v1[2], v1[3]);
                    *(u32x4*)(rowp + bj * HALF) = w; } }
    }
};
typedef EpiBf16T<> EpiBf16;
struct EpiSwiglu {
    static constexpr bool PERM = false; static constexpr int WSCALE = 123, ASCALE = 127;
    unsigned char* H; const float* bias;
    __device__ __forceinline__ void init(f32x4 (&acc)[2][2][4][2], const Unit& u, int wc, int fq) const {
        const float* bp = bias + (size_t)u.e * 2048 + u.pn * 256 + wc * 32 + 4 * fq;
#pragma unroll
        for (int bj = 0; bj < 2; ++bj)
#pragma unroll
            for (int n = 0; n < 2; ++n) { const f32x4 bv = *(const f32x4*)(bp + bj * HALF + n * 16);
#pragma unroll
                for (int ai = 0; ai < 2; ++ai)
#pragma unroll
                    for (int m = 0; m < 4; ++m) acc[ai][bj][m][n] = bv; } }
    __device__ __forceinline__ void operator()(const f32x4 (&acc)[2][2][4][2], const Unit& u, int wr, int wc, int fr, int fq) const {
        const int row0 = u.pm * BM + wr * 64 + fr, colh = u.pn * 128 + wc * 32 + 8 * fq;
        f32x2 kc = {-1.702f * 1.4426950408889634f, -1.702f * 1.4426950408889634f}, k1 = {1.0f, 1.0f}; asm volatile("" : "+v"(kc), "+v"(k1));
#pragma unroll
        for (int ai = 0; ai < 2; ++ai)
#pragma unroll
            for (int m = 0; m < 4; ++m) { unsigned char* rowp = H + (size_t)(row0 + ai * HALF + m * 16) * FF + colh;
                float o[8];
#pragma unroll
                for (int n = 0; n < 2; ++n)
#pragma unroll
                    for (int hq = 0; hq < 2; ++hq) { const f32x4 g4 = acc[ai][0][m][n], u4 = acc[ai][1][m][n]; f32x2 g, up, e, r;
#pragma unroll
                        for (int j = 0; j < 2; ++j) { g[j] = __builtin_amdgcn_fmed3f(g4[2 * hq + j], -3.0e38f, 7.0f); up[j] = __builtin_amdgcn_fmed3f(u4[2 * hq + j], -7.0f, 7.0f); }
                        const f32x2 t = g * kc;
#pragma unroll
                        for (int j = 0; j < 2; ++j) e[j] = __builtin_amdgcn_exp2f(t[j]);
                        const f32x2 d = e + k1;
#pragma unroll
                        for (int j = 0; j < 2; ++j) r[j] = __builtin_amdgcn_rcpf(d[j]);
                        const f32x2 glu = g * r, ov = up * glu + glu;
                        o[n * 4 + 2 * hq] = ov[0]; o[n * 4 + 2 * hq + 1] = ov[1]; }
                int w0 = __builtin_amdgcn_cvt_pk_fp8_f32(o[0], o[1], 0, false); w0 = __builtin_amdgcn_cvt_pk_fp8_f32(o[2], o[3], w0, true);
                int w1 = __builtin_amdgcn_cvt_pk_fp8_f32(o[4], o[5], 0, false); w1 = __builtin_amdgcn_cvt_pk_fp8_f32(o[6], o[7], w1, true);
                *(u32x2*)rowp = (u32x2){(unsigned)w0, (unsigned)w1}; }
    }
};
struct EpiDown {
    static constexpr bool PERM = true; static constexpr int WSCALE = 122, ASCALE = 127;
    unsigned char* Y; const float* bias;
    __device__ __forceinline__ void init(f32x4 (&acc)[2][2][4][2], const Unit& u, int wc, int fq) const {
        const float* bp = bias + (size_t)u.e * 1024 + u.pn * BM + wc * 32 + 8 * fq;
#pragma unroll
        for (int bj = 0; bj < 2; ++bj)
#pragma unroll
            for (int n = 0; n < 2; ++n) { const f32x4 bv = *(const f32x4*)(bp + bj * HALF + 4 * n);
#pragma unroll
                for (int ai = 0; ai < 2; ++ai)
#pragma unroll
                    for (int m = 0; m < 4; ++m) acc[ai][bj][m][n] = bv; } }
    __device__ __forceinline__ void operator()(const f32x4 (&acc)[2][2][4][2], const Unit& u, int wr, int wc, int fr, int fq) const {
        const int row0 = u.pm * BM + wr * 64 + fr, col0 = u.pn * BM + wc * 32 + 8 * fq;
#pragma unroll
        for (int ai = 0; ai < 2; ++ai)
#pragma unroll
            for (int m = 0; m < 4; ++m) { const int row = row0 + ai * HALF + m * 16; const float g = 16.0f; unsigned char* rowp = Y + (size_t)row * D + col0;
#pragma unroll
                for (int bj = 0; bj < 2; ++bj) { const f32x4 v0 = acc[ai][bj][m][0] * g, v1 = acc[ai][bj][m][1] * g;
                    int w0 = __builtin_amdgcn_cvt_pk_fp8_f32(v0[0], v0[1], 0, false); w0 = __builtin_amdgcn_cvt_pk_fp8_f32(v0[2], v0[3], w0, true);
                    int w1 = __builtin_amdgcn_cvt_pk_fp8_f32(v1[0], v1[1], 0, false); w1 = __builtin_amdgcn_cvt_pk_fp8_f32(v1[2], v1[3], w1, true);
                    *(u32x2*)(rowp + bj * HALF) = (u32x2){(unsigned)w0, (unsigned)w1}; } }
    }
};

template <class Epi, class Sched, int ES = 2, bool ALIGN_EPI = true>
__device__ __forceinline__ void gemm_phase(LAS unsigned char* lds, const int K, const Sched& S, const Epi& E) {
    constexpr bool GA = Sched::GATHER;
    const int tid = opaque_tid(), wid = __builtin_amdgcn_readfirstlane(tid >> 6), lane = tid & 63, wr = wid >> 2, wc = wid & 3, fr = lane & 15, fq = lane >> 4;
    const int nt = K * ES / (BK * 2);
    unsigned voffA[2], voffB[2]; int Rr[2]; unsigned Cb[2];
#pragma unroll
    for (int i = 0; i < 2; ++i) { int R, C; stage_rc(tid * 16 + i * 8192, R, C); const int Rb = Epi::PERM ? ((R & ~31) + perm32(R & 31)) : R;
        voffA[i] = (unsigned)(R * K * ES + C * 2); voffB[i] = (unsigned)(Rb * K * ES + C * 2); Rr[i] = R; Cb[i] = (unsigned)C * 2u; }
    const size_t kstep = (size_t)(BK * 2);
    const size_t hstep = (size_t)HALF * K * ES;
    const unsigned ldsw = (unsigned)wid * 1024u;
    const int aoff0 = lds_byte(wr * 64 + fr, fq * 8), aoff1 = lds_byte(wr * 64 + fr, fq * 8 + 32);
    const int boff0 = lds_byte(wc * 32 + fr, fq * 8), boff1 = lds_byte(wc * 32 + fr, fq * 8 + 32);
    unsigned cOff[2][2], nOff[2][2], sOff[2][2];
#define PG8_SA(b, h) (((b) * 2 + (h)) * HTB)
#define PG8_SB(b, h) ((4 + (b) * 2 + (h)) * HTB)
#define PG8_STAGE(bufoff, gbase, voff) do { _Pragma("unroll") for (int _i = 0; _i < 2; ++_i) \
        __builtin_amdgcn_global_load_lds((const unsigned*)((const char*)(gbase) + (voff)[_i]), (LAS unsigned*)(lds + (bufoff) + ldsw + _i * 8192), 16, 0, 0); } while (0)
#define PG8_STAGE_A(bufoff, gbase, half, OFF) do { if constexpr (GA) { PG8_STAGE(bufoff, gbase, (OFF)[half]); } else { PG8_STAGE(bufoff, (gbase) + (half) * hstep, voffA); } } while (0)
#define PG8_LDA(dst, b, h) do { if constexpr (ES == 2) { _Pragma("unroll") for (int m = 0; m < 4; ++m) _Pragma("unroll") for (int k = 0; k < 2; ++k) dst[m][k] = *(const LAS bf16x8*)(lds + PG8_SA(b, h) + (k ? aoff1 : aoff0) + m * 2048); } \
        else { _Pragma("unroll") for (int m = 0; m < 4; ++m) dst##8[m] = __builtin_shufflevector(*(const LAS v4i_t*)(lds + PG8_SA(b, h) + aoff0 + m * 2048), *(const LAS v4i_t*)(lds + PG8_SA(b, h) + aoff1 + m * 2048), 0, 1, 2, 3, 4, 5, 6, 7); } } while (0)
#define PG8_LDB(dst, b, h) do { if constexpr (ES == 2) { _Pragma("unroll") for (int n = 0; n < 2; ++n) _Pragma("unroll") for (int k = 0; k < 2; ++k) dst[n][k] = *(const LAS bf16x8*)(lds + PG8_SB(b, h) + (k ? boff1 : boff0) + n * 2048); } \
        else { _Pragma("unroll") for (int n = 0; n < 2; ++n) dst##8[n] = __builtin_shufflevector(*(const LAS v4i_t*)(lds + PG8_SB(b, h) + boff0 + n * 2048), *(const LAS v4i_t*)(lds + PG8_SB(b, h) + boff1 + n * 2048), 0, 1, 2, 3, 4, 5, 6, 7); } } while (0)
#define PG8_MMA(ai, bj, At, Bt) do { __builtin_amdgcn_s_setprio(1); _Pragma("unroll") for (int m = 0; m < 4; ++m) _Pragma("unroll") for (int n = 0; n < 2; ++n) { \
        if constexpr (ES == 2) { _Pragma("unroll") for (int k = 0; k < 2; ++k) acc[ai][bj][m][n] = __builtin_amdgcn_mfma_f32_16x16x32_bf16(Bt[n][k], At[m][k], acc[ai][bj][m][n], 0, 0, 0); } \
        else { asm volatile("v_mfma_scale_f32_16x16x128_f8f6f4 %0, %1, %2, %0, %3, %4 op_sel_hi:[0,0,0]" : "+v"(acc[ai][bj][m][n]) : "v"(Bt##8[n]), "v"(At##8[m]), "v"(wscale_v), "v"(ascale_v)); } } \
        __builtin_amdgcn_s_setprio(0); } while (0)
#define PG8_WAIT_V(n) asm volatile("s_waitcnt vmcnt(" #n ")" ::: "memory")
#define PG8_WAIT_L(n) asm volatile("s_waitcnt lgkmcnt(" #n ")" ::: "memory")
#define PG8_WAIT_VR() do { if (relax) { if constexpr (GA) PG8_WAIT_V(13); else PG8_WAIT_V(9); } else PG8_WAIT_V(8); } while (0)
#define PG8_BAR __builtin_amdgcn_s_barrier()
#define PG8_SCHED __builtin_amdgcn_sched_barrier(0)
#define PG8_GOFF(dst, u) do { if constexpr (GA) { _Pragma("unroll") for (int _h = 0; _h < 2; ++_h) _Pragma("unroll") for (int _i = 0; _i < 2; ++_i) \
        dst[_h][_i] = S.row_tok(u, _h * HALF + Rr[_i]) * (unsigned)(K * ES) + Cb[_i]; } } while (0)
    Unit cur, nxt; int ui = 0;
    if (!S.next(0, cur)) return;
#ifndef GEMM_STAGGER_TICKS
#define GEMM_STAGGER_TICKS 0
#endif
    if (GEMM_STAGGER_TICKS > 0) {
        const unsigned long long t0 = __builtin_amdgcn_s_memrealtime(), dl = (unsigned long long)((S.c * 5) & 15) * GEMM_STAGGER_TICKS;
        while (__builtin_amdgcn_s_memrealtime() - t0 < dl) __builtin_amdgcn_s_sleep(8);
    }
    f32x4 acc[2][2][4][2];
    E.init(acc, cur, wc, fq);
    int wscale_v = Epi::WSCALE, ascale_v = Epi::ASCALE; asm volatile("" : "+v"(wscale_v), "+v"(ascale_v));
    bf16x8 At[4][2], B0[2][2], B1[2][2];
    v8i_t At8[4], B08[2], B18[2];
    const char* cA = cur.A; const char* cB = cur.B;
    PG8_GOFF(cOff, cur);
#pragma unroll
    for (int h = 0; h < 2; ++h)
#pragma unroll
        for (int i = 0; i < 2; ++i) { nOff[h][i] = 0u; sOff[h][i] = 0u; }
    if constexpr (GA) { VM_WAIT(); }
    PG8_STAGE(PG8_SB(0, 0), cB, voffB); PG8_STAGE(PG8_SB(0, 1), cB + hstep, voffB); PG8_STAGE_A(PG8_SA(0, 0), cA, 0, cOff); PG8_STAGE_A(PG8_SA(0, 1), cA, 1, cOff);
    if (wr == 1) PG8_BAR;
    PG8_WAIT_V(2); PG8_BAR;
    PG8_STAGE(PG8_SB(1, 0), cB + kstep, voffB); PG8_STAGE_A(PG8_SA(1, 0), cA + kstep, 0, cOff); PG8_STAGE(PG8_SB(1, 1), cB + hstep + kstep, voffB);
    PG8_WAIT_V(6); PG8_BAR;
    for (;;) {
        bool has_next; const char* nA = cA; const char* nB = cB;
        unsigned eraw = 0u, traw[2][2] = {{0u, 0u}, {0u, 0u}};
        if constexpr (Sched::HAS_E) {
            has_next = S.next_static(ui + 1, nxt);
            if (has_next) { eraw = asm_gload_u32(S.e_ptr(nxt));
                if constexpr (GA) {
#pragma unroll
                    for (int h = 0; h < 2; ++h)
#pragma unroll
                        for (int i = 0; i < 2; ++i) traw[h][i] = asm_gload_u32(S.tok_ptr(nxt, h * HALF + Rr[i])); } }
        } else { has_next = S.next(ui + 1, nxt); if (has_next) { nA = nxt.A; nB = nxt.B; } }
#pragma unroll 1
        for (int t = 0; t < nt; t += 2) {
            const bool last = (t == nt - 2);
            const bool relax = Sched::HAS_E && has_next && t == 0;
            if constexpr (Sched::HAS_E) { if (last) {
                if (has_next) {
                    if constexpr (GA) asm volatile("" : "+v"(eraw), "+v"(traw[0][0]), "+v"(traw[0][1]), "+v"(traw[1][0]), "+v"(traw[1][1]) :: "memory"); else asm volatile("" : "+v"(eraw) :: "memory");
                    S.finish(nxt, __builtin_amdgcn_readfirstlane((int)eraw)); nA = nxt.A; nB = nxt.B;
                    if constexpr (GA) {
#pragma unroll
                        for (int h = 0; h < 2; ++h)
#pragma unroll
                            for (int i = 0; i < 2; ++i) nOff[h][i] = traw[h][i] * (unsigned)(K * ES) + Cb[i]; }
                } else if constexpr (GA) {
#pragma unroll
                    for (int h = 0; h < 2; ++h)
#pragma unroll
                        for (int i = 0; i < 2; ++i) nOff[h][i] = cOff[h][i]; } } }
            const char* a1 = cA + (size_t)(t + 1) * kstep;
            const char* a2 = last ? nA : cA + (size_t)(t + 2) * kstep; const char* b2 = last ? nB : cB + (size_t)(t + 2) * kstep;
            const char* a3 = a2 + kstep; const char* b3 = b2 + kstep;
            if constexpr (GA) {
#pragma unroll
                for (int h = 0; h < 2; ++h)
#pragma unroll
                    for (int i = 0; i < 2; ++i) sOff[h][i] = last ? nOff[h][i] : cOff[h][i]; }
            PG8_LDB(B0, 0, 0); PG8_LDB(B1, 0, 1); PG8_SCHED; PG8_LDA(At, 0, 0); PG8_STAGE_A(PG8_SA(1, 1), a1, 1, cOff);
            PG8_WAIT_VR(); PG8_WAIT_L(0); PG8_BAR; PG8_MMA(0, 0, At, B0); PG8_MMA(0, 1, At, B1); PG8_BAR; PG8_SCHED;
            PG8_LDA(At, 0, 1); PG8_STAGE(PG8_SB(0, 0), b2, voffB); PG8_STAGE(PG8_SB(0, 1), b2 + hstep, voffB); PG8_STAGE_A(PG8_SA(0, 0), a2, 0, sOff);
            PG8_WAIT_VR(); PG8_WAIT_L(0); PG8_BAR; PG8_MMA(1, 0, At, B0); PG8_MMA(1, 1, At, B1); PG8_BAR; PG8_SCHED;
            PG8_LDB(B0, 1, 0); PG8_LDB(B1, 1, 1); PG8_SCHED; PG8_LDA(At, 1, 0); PG8_STAGE_A(PG8_SA(0, 1), a2, 1, sOff);
            PG8_WAIT_V(8); PG8_WAIT_L(0); PG8_BAR; PG8_MMA(0, 0, At, B0); PG8_MMA(0, 1, At, B1); PG8_BAR; PG8_SCHED;
            PG8_LDA(At, 1, 1); PG8_STAGE(PG8_SB(1, 0), b3, voffB); PG8_STAGE(PG8_SB(1, 1), b3 + hstep, voffB); PG8_STAGE_A(PG8_SA(1, 0), a3, 0, sOff);
            PG8_WAIT_V(8); PG8_WAIT_L(0); PG8_BAR; PG8_MMA(1, 0, At, B0); PG8_MMA(1, 1, At, B1); PG8_BAR; PG8_SCHED;
        }
        if constexpr (ALIGN_EPI) { if (wr == 0) PG8_BAR; }
        if constexpr (ES == 1) { asm volatile("s_nop 15\n\ts_nop 15" ::: "memory"); }
        E(acc, cur, wr, wc, fr, fq);
        if (PHREP(25)) E(acc, cur, wr, wc, fr, fq);
        if (!has_next) break;
        E.init(acc, nxt, wc, fq);
        cur = nxt; cA = nA; cB = nB; ++ui;
        if constexpr (GA) {
#pragma unroll
            for (int h = 0; h < 2; ++h)
#pragma unroll
                for (int i = 0; i < 2; ++i) cOff[h][i] = nOff[h][i]; }
        if constexpr (ALIGN_EPI) { if (wr == 1) PG8_BAR; }
    }
    PG8_WAIT_V(0);
    if constexpr (!ALIGN_EPI) { if (wr == 0) PG8_BAR; }
    PG8_BAR;
#undef PG8_SA
#undef PG8_SB
#undef PG8_STAGE
#undef PG8_STAGE_A
#undef PG8_LDA
#undef PG8_LDB
#undef PG8_MMA
#undef PG8_WAIT_V
#undef PG8_WAIT_L
#undef PG8_WAIT_VR
#undef PG8_BAR
#undef PG8_SCHED
#undef PG8_GOFF
}
}

#define XB_TMO      128
#define XB_XCNT(j)  (256  + 64 * (j))
#define XB_XSUB(j)  (1280 + 64 * (j))
#define XB_XGEN(j)  (2304 + 64 * (j))
#define XB_TOP      3328
#define XB_TOPGEN   3392
#define XCD_BAR_WORDS 3456
#define XB_SPIN_CAP (1u << 18)
__device__ __forceinline__ unsigned xb_ld(unsigned* p)              { return __hip_atomic_load(p, __ATOMIC_RELAXED, __HIP_MEMORY_SCOPE_AGENT); }
__device__ __forceinline__ unsigned xb_add(unsigned* p, unsigned v) { return __hip_atomic_fetch_add(p, v, __ATOMIC_RELAXED, __HIP_MEMORY_SCOPE_AGENT); }
__device__ __forceinline__ unsigned xb_xcc_id() { return (unsigned)__builtin_amdgcn_s_getreg((3 << 11) | 20) & 0xFu; }
#define XB_SPIN(cond, bar) do { unsigned _sp = 0; while (cond) { __builtin_amdgcn_s_sleep(1); \
    if ((++_sp & 255u) == 0u) { if (xb_ld(&(bar)[XB_TMO])) break; if (_sp > XB_SPIN_CAP) { atomicAdd(&(bar)[XB_TMO], 1u); break; } } } } while (0)
struct XcdBarrier { unsigned* bar; unsigned x; volatile LAS unsigned* st; };
__device__ __forceinline__ XcdBarrier xcd_barrier_post(unsigned* bar, volatile LAS unsigned* st) {
    XcdBarrier b; b.bar = bar; b.x = xb_xcc_id(); b.st = st;
    if (threadIdx.x == 0) (void)xb_add(&bar[XB_XCNT(b.x)], 1u);
    return b;
}
__device__ __forceinline__ void xcd_barrier_complete(unsigned* bar, unsigned x, unsigned& nloc, unsigned& nx) {
    const unsigned G = gridDim.x * gridDim.y * gridDim.z;
    unsigned sum, cnt, mine, sp = 0u;
    for (;;) {
        sum = 0u; cnt = 0u; mine = 0u;
#pragma unroll
        for (unsigned j = 0; j < 16; ++j) { const unsigned c = xb_ld(&bar[XB_XCNT(j)]); sum += c; cnt += (c > 0u) ? 1u : 0u; mine = (j == x) ? c : mine; }
        if (sum == G) break;
        __builtin_amdgcn_s_sleep(1);
        if ((++sp & 255u) == 0u) { if (xb_ld(&bar[XB_TMO])) break; if (sp > XB_SPIN_CAP) { atomicAdd(&bar[XB_TMO], 1u); break; } }
    }
    nloc = mine > 0u ? mine : 1u; nx = cnt > 0u ? cnt : 1u;
}
__device__ __forceinline__ void xcd_barrier(const XcdBarrier& b) {
    asm volatile("s_waitcnt vmcnt(0)" ::: "memory");
    __syncthreads();
    if (threadIdx.x == 0) {
        unsigned* bar = b.bar;
        __builtin_amdgcn_s_waitcnt(0);
        unsigned nloc = b.st[0], nx = b.st[1];
        if (nloc == 0u) { xcd_barrier_complete(bar, b.x, nloc, nx); b.st[0] = nloc; b.st[1] = nx; }
        const unsigned old = xb_add(&bar[XB_XSUB(b.x)], 1u);
        const unsigned gen = old / nloc;
        if (old + 1u == (gen + 1u) * nloc) {
            __builtin_amdgcn_fence(__ATOMIC_RELEASE, "agent");
            asm volatile("s_waitcnt vmcnt(0)" ::: "memory");
            const unsigned og = xb_add(&bar[XB_TOP], 1u);
            const unsigned tg = og / nx;
            if (og + 1u == (tg + 1u) * nx) xb_add(&bar[XB_TOPGEN], 1u);
            else XB_SPIN(xb_ld(&bar[XB_TOPGEN]) == tg, bar);
            __builtin_amdgcn_fence(__ATOMIC_ACQUIRE, "agent");
            xb_add(&bar[XB_XGEN(b.x)], 1u);
            asm volatile("s_waitcnt vmcnt(0)" ::: "memory");
        } else {
            XB_SPIN(xb_ld(&bar[XB_XGEN(b.x)]) == gen, bar);
            __builtin_amdgcn_fence(__ATOMIC_ACQUIRE, "agent");
            asm volatile("s_waitcnt vmcnt(0)" ::: "memory");
        }
    }
    __syncthreads();
}

struct Args {
    const float* in[33];
    float* out; unsigned char* ws;
    int ph_lo, ph_hi;
};
enum { I_X = 0, I_MEM, I_WIN, I_GLACONV, I_GLAW2, I_GLAB, I_GLANG, I_HGLB, I_HGNG, I_RWMU, I_RWW0, I_RWW2, I_RWA0, I_RWA2, I_RWG2, I_RWKK, I_RWKA, I_RWRK, I_RWLNW, I_RWLNB,
       I_WMK, I_WMV, I_WOUT, I_LN1G, I_LN1B, I_RTW, I_RTB, I_WGU, I_BGU, I_WDN, I_BDN, I_LN2G, I_LN2B };


template <int OFF> __device__ __forceinline__ unsigned long long ka_u64() { unsigned long long v; asm volatile("s_load_dwordx2 %0, %1, %2\n\ts_waitcnt lgkmcnt(0)" : "=s"(v) : "s"(__builtin_amdgcn_kernarg_segment_ptr()), "n"(OFF)); return v; }
#define KIN(i) ((const float*)(const GAS float*)ka_u64<8 * (i)>())
#define KOUT() ((float*)(GAS float*)ka_u64<264>())
#define KWS() ((unsigned char*)(GAS unsigned char*)ka_u64<272>())

template <class Map>
__device__ __forceinline__ void tr_item(const float* __restrict__ W, int K, int N, bf16* __restrict__ WT, LAS float* scr, int kb, int nb, int lane, Map map) {
    const int k0 = 64 * kb, n0 = 64 * nb, col = n0 + lane; const bool valid = col < N;
    const float* src = W + (size_t)k0 * N + (valid ? col : 0);
#pragma unroll 64
    for (int kk = 0; kk < 64; ++kk) { const float v = valid ? src[(size_t)kk * N] : 0.f; scr[kk * 65 + lane] = v; }
    LDS_WAIT(); asm volatile("" ::: "memory");
    const int c = lane & 7;
#pragma unroll
    for (int j = 0; j < 8; ++j) { const int n = (lane >> 3) + 8 * j;
        if (n0 + n < N) { const int orow = map(n0 + n); const LAS float* s = scr + (8 * c) * 65 + n;
            u32x4 o; o.x = pk2(s[0 * 65], s[1 * 65]); o.y = pk2(s[2 * 65], s[3 * 65]); o.z = pk2(s[4 * 65], s[5 * 65]); o.w = pk2(s[6 * 65], s[7 * 65]);
            *(u32x4*)(WT + (size_t)orow * K + k0 + 8 * c) = o; } }
    LDS_WAIT(); asm volatile("" ::: "memory");
}
template <bool GUARD = false, class Map>
__device__ __forceinline__ void tr_item_f8(const float* __restrict__ W, int K, int N, unsigned char* __restrict__ WT8, LAS float* scr, int kb, int nb, int lane, float scale, Map map) {
    const int k0 = 64 * kb, n0 = 64 * nb, col = (GUARD && n0 + lane >= N) ? N - 1 : n0 + lane;
    const float* src = W + (size_t)k0 * N + col;
#pragma unroll 64
    for (int kk = 0; kk < 64; ++kk) scr[kk * 65 + lane] = src[(size_t)kk * N] * scale;
    LDS_WAIT(); asm volatile("" ::: "memory");
    const int c = lane & 3;
#pragma unroll
    for (int j = 0; j < 4; ++j) { const int n = (lane >> 2) + 16 * j; const LAS float* s = scr + (16 * c) * 65 + n;
        u32x4 o;
#pragma unroll
        for (int q = 0; q < 4; ++q) { int w = __builtin_amdgcn_cvt_pk_fp8_f32(s[(4 * q) * 65], s[(4 * q + 1) * 65], 0, false); w = __builtin_amdgcn_cvt_pk_fp8_f32(s[(4 * q + 2) * 65], s[(4 * q + 3) * 65], w, true); o[q] = (unsigned)w; }
        if (!GUARD || n0 + n < N) { const int orow = map(n0 + n); *(u32x4*)(WT8 + (size_t)orow * K + k0 + 16 * c) = o; } }
    LDS_WAIT(); asm volatile("" ::: "memory");
}
struct MapIdent { int off; __device__ __forceinline__ int operator()(int c) const { return c + off; } };
struct MapWin { __device__ __forceinline__ int operator()(int c) const { return c < 512 ? c : (c < 528 ? c + 2560 : c - 16); } };
__device__ __forceinline__ int gu_row(int c) { const int f = c >> 1, bj = c & 1, pn = f >> 7, fl = f & 127, wc = fl >> 5, fq = (fl >> 3) & 3, n = (fl >> 2) & 1, j = fl & 3; return 256 * pn + 128 * bj + 32 * wc + 16 * n + 4 * fq + j; }
struct MapGu { __device__ __forceinline__ int operator()(int c) const { return gu_row(c); } };

__device__ __forceinline__ void prologue_phase(LAS unsigned char* lds, int vcu, int G) {
    const int tid = opaque_tid(), lane = tid & 63, wave = __builtin_amdgcn_readfirstlane(tid >> 6);
    LAS float* scr = (LAS float*)(lds + wave * 16640); static_assert(8 * 16640 <= LDSCTL_OFF, "prologue scratch below the LDS control words");
    const int gw = vcu * NWAVES + wave, NGW = G * NWAVES;
    unsigned char* ws = KWS();
    constexpr int IT_GU = NL * NE * 512, IT_DN = NL * NE * 256, IT_IN = NL * 16 * 49, IT_OUT = NL * 256, IT_MEM = NL * 2 * 64, IT_L64 = NL * 2 * 4, IT_L128 = NL * 2 * 4;
    constexpr int IT_TOTAL = IT_GU + IT_DN + IT_IN + IT_OUT + IT_MEM + IT_L64 + IT_L128;
    for (int it = gw; it < IT_TOTAL; it += NGW) {
        int r = it;
        if (r < IT_GU) { const int le = r >> 9, q = r & 511, kb = q >> 5, nb = q & 31;
            tr_item_f8(KIN(I_WGU) + (size_t)le * 1024 * 2048, 1024, 2048, (unsigned char*)(ws + WS_WGU) + (size_t)le * 2048 * 1024, scr, kb, nb, lane, 16.0f, MapGu{}); continue; } r -= IT_GU;
        if (r < IT_DN) { const int le = r >> 8, q = r & 255, kb = q >> 4, nb = q & 15;
            tr_item_f8(KIN(I_WDN) + (size_t)le * 1024 * 1024, 1024, 1024, (unsigned char*)(ws + WS_WD) + (size_t)le * 1024 * 1024, scr, kb, nb, lane, 32.0f, MapIdent{0}); continue; } r -= IT_DN;
        if (r < IT_IN) { const int l = r / (16 * 49), q = r % (16 * 49), kb = q / 49, nb = q % 49;
            tr_item_f8<true>(KIN(I_WIN) + (size_t)l * 1024 * PIN, 1024, PIN, (unsigned char*)(ws + WS_WIN) + (size_t)l * PINP * 1024, scr, kb, nb, lane, 16.0f, MapWin{}); continue; } r -= IT_IN;
        if (r < IT_OUT) { const int l = r >> 8, q = r & 255, kb = q >> 4, nb = q & 15;
            tr_item_f8(KIN(I_WOUT) + (size_t)l * 1024 * 1024, 1024, 1024, (unsigned char*)(ws + WS_WOUT) + (size_t)l * 1024 * 1024, scr, kb, nb, lane, 32.0f, MapIdent{0}); continue; } r -= IT_OUT;
        if (r < IT_MEM) { const int l = r >> 7, q = r & 127, kv = q >> 6, kb = (q >> 2) & 15, nb = q & 3;
            tr_item((kv ? KIN(I_WMV) : KIN(I_WMK)) + (size_t)l * 1024 * 256, 1024, 256, (bf16*)(ws + WS_WMEM), scr, kb, nb, lane, MapIdent{l * 512 + kv * 256}); continue; } r -= IT_MEM;
        if (r < IT_L64) { const int l = r >> 3, q = r & 7, wa = q >> 2, nb = q & 3;
            tr_item((wa ? KIN(I_RWA2) : KIN(I_RWW2)) + (size_t)l * 64 * 256, 64, 256, (bf16*)(ws + WS_LORA) + (size_t)wa * (NL * 256 * 64) + (size_t)l * 256 * 64, scr, 0, nb, lane, MapIdent{0}); continue; } r -= IT_L64;
        { const int l = r >> 3, q = r & 7, kb = q >> 2, nb = q & 3;
            tr_item(KIN(I_RWG2) + (size_t)l * 128 * 256, 128, 256, (bf16*)(ws + WS_LORA) + (size_t)2 * (NL * 256 * 64) + (size_t)l * 256 * 128, scr, kb, nb, lane, MapIdent{0}); }
    }
    { const size_t gt = (size_t)vcu * NTHR + tid, GT = (size_t)G * NTHR; constexpr size_t per = (size_t)(PINP - PIN) * 1024 / 16;
        for (size_t i = gt; i < per * NL; i += GT) { const size_t l = i / per, j = i % per; *(u32x4*)((unsigned char*)(ws + WS_WIN) + l * PINP * 1024 + (size_t)PIN * 1024 + j * 16) = (u32x4){0u, 0u, 0u, 0u}; }
        for (size_t i = gt; i < (size_t)NL * 8192; i += GT) { const int l = (int)(i >> 13), q = (int)(i >> 6) & 127, ln = (int)i & 63, jj = q >> 4, c = q & 15, k0 = 4 * (ln + 64 * (jj >> 1)) + 2 * (jj & 1);
            const float* s = KIN(I_WIN) + (size_t)l * 1024 * PIN + (size_t)k0 * PIN + 512 + c; ((unsigned*)(ws + WS_GLRW))[i] = pk2(s[0], s[PIN]); }
        for (size_t i = gt; i < (size_t)NL * NE * 2048; i += GT) { const size_t le = i >> 11; const int c = (int)(i & 2047); ((float*)(ws + WS_BGU))[le * 2048 + gu_row(c)] = KIN(I_BGU)[i]; }
        const f32x4* xs = (const f32x4*)KIN(I_X); unsigned char* xd8 = (unsigned char*)(ws + WS_X8);
        for (size_t i = gt; i < (size_t)NTOK * D / 8; i += GT) { const f32x4 v0 = xs[2 * i], v1 = xs[2 * i + 1]; store_o4(xd8 + 8 * i, v0[0], v0[1], v0[2], v0[3]); store_o4(xd8 + 8 * i + 4, v1[0], v1[1], v1[2], v1[3]); }
        const f32x4* ms = (const f32x4*)KIN(I_MEM); u32x4* md = (u32x4*)(ws + WS_MEMB);
        for (size_t i = gt; i < (size_t)NB * NMEM * D / 8; i += GT) { const f32x4 v0 = ms[2 * i], v1 = ms[2 * i + 1]; md[i] = (u32x4){pk2(v0[0], v0[1]), pk2(v0[2], v0[3]), pk2(v1[0], v1[1]), pk2(v1[2], v1[3])}; }
    }
}


__device__ __forceinline__ float log1pexp_neg_abs(float z) { return __builtin_amdgcn_logf(1.0f + fast_exp(-fabsf(z))) * 0.6931471805599453f; }
__device__ __forceinline__ float tanh_f(float x) { const float e = fast_exp(-2.0f * fabsf(x)); const float t = (1.0f - e) * __builtin_amdgcn_rcpf(1.0f + e); return x < 0.f ? -t : t; }

constexpr int NCH = T / 32;
__device__ __forceinline__ int rho16(int r, int hh) { return (r & 3) + 8 * (r >> 2) + 4 * hh; }
__device__ __forceinline__ void hg_fused_unit(LAS unsigned char* lds, int l, int b, int c) {
    const int tid = opaque_tid(), lane = tid & 63, wave = __builtin_amdgcn_readfirstlane(tid >> 6), r32 = lane & 31, hh = lane >> 5;
    unsigned char* ws = KWS();
    const bf16* P = (const bf16*)(ws + WS_P) + ((size_t)b * T + c * 32) * PINP;
    constexpr int HB = 16640;
    if (tid < 256) {
        const int ch = tid, h = ch >> 6, d = ch & 63; const size_t un = (size_t)(b * 4 + h) * NCH + c;
        const float* hp = KIN(I_HGLB) + ch; const float v0 = hp[0], v1 = hp[256], v2 = hp[512], v3 = hp[768];
        unsigned short hqr[32], hfr[32];
#pragma unroll
        for (int t = 0; t < 32; ++t) { const bf16* row = P + (size_t)t * PINP; hqr[t] = row[PC_HQ + ch]; hfr[t] = row[PC_HF + ch]; }
        __builtin_amdgcn_sched_barrier(0);
        float lb;
        { const float m = fmaxf(fmaxf(v0, v1), fmaxf(v2, v3));
          const float e0 = __expf(v0 - m), e1 = __expf(v1 - m), e2 = __expf(v2 - m), e3 = __expf(v3 - m); const float inv = 1.0f / (e0 + e1 + e2 + e3);
          lb = (l >= 1 ? e1 : 0.f) + (l >= 2 ? e2 : 0.f) + (l >= 3 ? e3 : 0.f); lb *= inv; }
        const float oml = 1.0f - lb;
        LAS bf16* KT = (LAS bf16*)(lds + h * HB); LAS float* BE = (LAS float*)(lds + h * HB + 8192);
        LAS bf16* QL = (LAS bf16*)(lds + h * HB + 8448) + d; LAS bf16* KL = (LAS bf16*)(lds + h * HB + 12544) + d;
        float bc = 1.0f;
#pragma unroll
        for (int t8 = 0; t8 < 4; ++t8) { u32x4 kp;
#pragma unroll
            for (int jj = 0; jj < 4; ++jj) { float k2[2];
#pragma unroll
                for (int e = 0; e < 2; ++e) { const int t = t8 * 8 + jj * 2 + e; const float hf = bf2f(hfr[t]); const float eh_ = fast_exp(fminf(-hf, 80.0f)); const float s = __builtin_amdgcn_rcpf(1.0f + eh_), sn = eh_ * s;
                    bc = fmaxf(bc * fmaxf(lb + oml * s, 1e-30f), 1.8048513878454153e-35f);
                    const float qt = silu_f(bf2f(hqr[t])) * bc, kt = oml * sn * __builtin_amdgcn_rcpf(bc);
                    QL[t * 64] = (bf16)f2bf(qt); KL[t * 64] = (bf16)f2bf(kt); k2[e] = kt; }
                kp[jj] = pk2(k2[0], k2[1]); }
            *(LAS u32x4*)(KT + d * 32 + t8 * 8) = kp; }
        const float ebend = bc; BE[d] = ebend; ((float*)(ws + WS_HBE))[un * 64 + d] = ebend;
    } else {
        const int cv = tid - 256, h = cv >> 6, vi = cv & 63; const size_t un = (size_t)(b * 4 + h) * NCH + c;
        LAS bf16* VT = (LAS bf16*)(lds + h * HB + 4096); bf16* VTg = (bf16*)(ws + WS_HVT) + un * 2048 + vi * 32;
        unsigned short hvr[32];
#pragma unroll
        for (int t = 0; t < 32; ++t) hvr[t] = P[(size_t)t * PINP + PC_HI + cv];
        __builtin_amdgcn_sched_barrier(0);
#pragma unroll
        for (int t8 = 0; t8 < 4; ++t8) { u32x4 vp;
#pragma unroll
            for (int jj = 0; jj < 4; ++jj) vp[jj] = (unsigned)hvr[t8 * 8 + 2 * jj] | ((unsigned)hvr[t8 * 8 + 2 * jj + 1] << 16);
            *(LAS u32x4*)(VT + vi * 32 + t8 * 8) = vp; *(u32x4*)(VTg + t8 * 8) = vp; }
    }
    lds_barrier();
    { const int h = wave >> 1, vt = wave & 1; const size_t un = (size_t)(b * 4 + h) * NCH + c;
      const LAS bf16* KT = (const LAS bf16*)(lds + h * HB); const LAS bf16* VT = (const LAS bf16*)(lds + h * HB + 4096); const LAS float* BE = (const LAS float*)(lds + h * HB + 8192);
      bf16* DSg = (bf16*)(ws + WS_HDS) + un * 4096;
      { const LAS bf16* srcL = (const LAS bf16*)(lds + h * HB + (vt == 0 ? 8448 : 12544)); u32x4* dstG = (u32x4*)((bf16*)(ws + (vt == 0 ? WS_HQ : WS_HK)) + un * 2048);
#pragma unroll
        for (int i = 0; i < 4; ++i) dstG[i * 64 + lane] = *(const LAS u32x4*)(srcL + (i * 64 + lane) * 8); }
#pragma unroll
      for (int dt = 0; dt < 2; ++dt) { f32x16 acc;
#pragma unroll
          for (int i = 0; i < 16; ++i) acc[i] = 0.f;
#pragma unroll
          for (int s = 0; s < 2; ++s) { const bf16x8 A = *(const LAS bf16x8*)(VT + (32 * vt + r32) * 32 + 16 * s + 8 * hh), B = *(const LAS bf16x8*)(KT + (32 * dt + r32) * 32 + 16 * s + 8 * hh);
              acc = __builtin_amdgcn_mfma_f32_32x32x16_bf16(A, B, acc, 0, 0, 0); }
          const float ebd = BE[32 * dt + r32];
#pragma unroll
          for (int r = 0; r < 16; ++r) DSg[(32 * vt + rho16(r, hh)) * 64 + 32 * dt + r32] = (bf16)f2bf(acc[r] * ebd); } }
    lds_barrier();
}
__device__ __forceinline__ void gla_fused_unit(LAS unsigned char* lds, int l, int b, int c) {
    const int tid = opaque_tid(), lane = tid & 63, wave = __builtin_amdgcn_readfirstlane(tid >> 6), r32 = lane & 31, hh = lane >> 5;
    unsigned char* ws = KWS();
    const int t0 = c * 32;
    const bf16* P = (const bf16*)(ws + WS_P) + ((size_t)b * T + t0) * PINP;
    LAS float* GL = (LAS float*)lds;
    constexpr int HB = 10368, H0 = 2048;
    const unsigned short glr = P[(size_t)(tid >> 4) * PINP + PC_GLR + (tid & 15)];
    unsigned short xra[32], xrb[32], hra[3], hrb[3]; float cwv[8], wc[16], gb = 0.f;
    const long hb = t0 > 0 ? 1 : 0;
    if (tid < 128) { const int ch = tid;
        const float* cw = KIN(I_GLACONV) + (size_t)l * 4 * 512 + ch;
        cwv[0] = cw[0]; cwv[1] = cw[512]; cwv[2] = cw[1024]; cwv[3] = cw[1536]; cwv[4] = cw[128]; cwv[5] = cw[640]; cwv[6] = cw[1152]; cwv[7] = cw[1664];
        const float* w2p = KIN(I_GLAW2) + (size_t)l * 16 * 128 + ch;
#pragma unroll
        for (int r = 0; r < 16; ++r) wc[r] = w2p[r * 128];
        gb = KIN(I_GLAB)[l * 128 + ch];
#pragma unroll
        for (int j = 0; j < 3; ++j) { const bf16* hrow = P - hb * (3 - j) * PINP; hra[j] = hrow[PC_GQ + ch]; hrb[j] = hrow[PC_GK + ch]; }
#pragma unroll
        for (int t = 0; t < 32; ++t) { const bf16* row = P + (size_t)t * PINP; xra[t] = row[PC_GQ + ch]; xrb[t] = row[PC_GK + ch]; }
    } else if (tid < 384) { const int cv = tid - 128;
        const float* cw = KIN(I_GLACONV) + (size_t)l * 4 * 512 + 256 + cv;
        cwv[0] = cw[0]; cwv[1] = cw[512]; cwv[2] = cw[1024]; cwv[3] = cw[1536];
#pragma unroll
        for (int j = 0; j < 3; ++j) hra[j] = (P - hb * (3 - j) * PINP)[PC_GV + cv];
#pragma unroll
        for (int t = 0; t < 32; ++t) xra[t] = P[(size_t)t * PINP + PC_GV + cv];
    }
    __builtin_amdgcn_sched_barrier(0);
    GL[tid] = bf2f(glr);
    lds_barrier();
    if (tid < 128) {
        const int ch = tid, h = ch >> 5, d = ch & 31; const size_t un = (size_t)(b * 4 + h) * NCH + c;
        const float q0 = cwv[0], q1 = cwv[1], q2 = cwv[2], q3 = cwv[3], k0 = cwv[4], k1 = cwv[5], k2w = cwv[6], k3 = cwv[7];
        float uq0 = hb ? bf2f(hra[0]) : 0.f, uq1 = hb ? bf2f(hra[1]) : 0.f, uq2 = hb ? bf2f(hra[2]) : 0.f, uk0 = hb ? bf2f(hrb[0]) : 0.f, uk1 = hb ? bf2f(hrb[1]) : 0.f, uk2 = hb ? bf2f(hrb[2]) : 0.f;
        LAS bf16* KT = (LAS bf16*)(lds + H0 + h * HB); LAS float* BE = (LAS float*)(lds + H0 + h * HB + 6144);
        LAS bf16* QL = (LAS bf16*)(lds + H0 + h * HB + 6272) + d; LAS bf16* KL = (LAS bf16*)(lds + H0 + h * HB + 8320) + d;
        float bc = 0.f;
#pragma unroll
        for (int t8 = 0; t8 < 4; ++t8) { u32x4 kp;
#pragma unroll
            for (int jj = 0; jj < 4; ++jj) { float kk2[2];
#pragma unroll
                for (int e = 0; e < 2; ++e) { const int t = t8 * 8 + jj * 2 + e; const float uq3 = bf2f(xra[t]), uk3 = bf2f(xrb[t]);
                    const float q = silu_f(q0 * uq0 + q1 * uq1 + q2 * uq2 + q3 * uq3) * 0.17677669529663687f, k = silu_f(k0 * uk0 + k1 * uk1 + k2w * uk2 + k3 * uk3);
                    uq0 = uq1; uq1 = uq2; uq2 = uq3; uk0 = uk1; uk1 = uk2; uk2 = uk3;
                    float z = gb;
#pragma unroll
                    for (int r = 0; r < 16; ++r) z += GL[t * 16 + r] * wc[r];
                    bc = fmaxf(bc + (fminf(z, 0.f) - log1pexp_neg_abs(z)) * 0.0625f, -80.0f);
                    const float qt = q * fast_exp(bc), kt = k * fast_exp(-bc);
                    QL[t * 32] = (bf16)f2bf(qt); KL[t * 32] = (bf16)f2bf(kt); kk2[e] = kt; }
                kp[jj] = pk2(kk2[0], kk2[1]); }
            *(LAS u32x4*)(KT + d * 32 + t8 * 8) = kp; }
        const float ebend = fast_exp(bc); BE[d] = ebend; ((float*)(ws + WS_GBE))[un * 32 + d] = ebend;
    } else if (tid < 384) {
        const int cv = tid - 128, h = cv >> 6, vi = cv & 63; const size_t un = (size_t)(b * 4 + h) * NCH + c;
        const float w0 = cwv[0], w1 = cwv[1], w2 = cwv[2], w3 = cwv[3];
        float u0 = hb ? bf2f(hra[0]) : 0.f, u1 = hb ? bf2f(hra[1]) : 0.f, u2 = hb ? bf2f(hra[2]) : 0.f;
        LAS bf16* VT = (LAS bf16*)(lds + H0 + h * HB + 2048); bf16* VTg = (bf16*)(ws + WS_GVT) + un * 2048 + vi * 32;
#pragma unroll
        for (int t8 = 0; t8 < 4; ++t8) { u32x4 vp; float yv[8];
#pragma unroll
            for (int e = 0; e < 8; ++e) { const float u3 = bf2f(xra[t8 * 8 + e]); yv[e] = silu_f(w0 * u0 + w1 * u1 + w2 * u2 + w3 * u3); u0 = u1; u1 = u2; u2 = u3; }
#pragma unroll
            for (int jj = 0; jj < 4; ++jj) vp[jj] = pk2(yv[2 * jj], yv[2 * jj + 1]);
            *(LAS u32x4*)(VT + vi * 32 + t8 * 8) = vp; *(u32x4*)(VTg + t8 * 8) = vp; }
    }
    lds_barrier();
    { const int h = wave >> 1, vt = wave & 1; const size_t un = (size_t)(b * 4 + h) * NCH + c;
      const LAS bf16* KT = (const LAS bf16*)(lds + H0 + h * HB); const LAS bf16* VT = (const LAS bf16*)(lds + H0 + h * HB + 2048); const LAS float* BE = (const LAS float*)(lds + H0 + h * HB + 6144);
      bf16* DSg = (bf16*)(ws + WS_GDS) + un * 2048;
      { const LAS bf16* srcL = (const LAS bf16*)(lds + H0 + h * HB + (vt == 0 ? 6272 : 8320)); u32x4* dstG = (u32x4*)((bf16*)(ws + (vt == 0 ? WS_GQ : WS_GK)) + un * 1024);
#pragma unroll
        for (int i = 0; i < 2; ++i) dstG[i * 64 + lane] = *(const LAS u32x4*)(srcL + (i * 64 + lane) * 8); }
      f32x16 acc;
#pragma unroll
      for (int i = 0; i < 16; ++i) acc[i] = 0.f;
#pragma unroll
      for (int s = 0; s < 2; ++s) { const bf16x8 A = *(const LAS bf16x8*)(VT + (32 * vt + r32) * 32 + 16 * s + 8 * hh), B = *(const LAS bf16x8*)(KT + r32 * 32 + 16 * s + 8 * hh);
          acc = __builtin_amdgcn_mfma_f32_32x32x16_bf16(A, B, acc, 0, 0, 0); }
      const float ebd = BE[r32];
#pragma unroll
      for (int r = 0; r < 16; ++r) DSg[(32 * vt + rho16(r, hh)) * 32 + r32] = (bf16)f2bf(acc[r] * ebd); }
    lds_barrier();
}
template <int DK>
__device__ __forceinline__ void m2_gh_elem2(int e2, const bf16* __restrict__ DS, const float* __restrict__ BE, bf16* __restrict__ SG) {
    constexpr int EPB = 64 * DK; const int e = e2 * 2, bh = e / EPB, idx = e % EPB, d = idx % DK; const size_t un0 = (size_t)bh * NCH;
    float S0 = 0.f, S1 = 0.f;
#pragma unroll 1
    for (int c0 = 0; c0 < NCH; c0 += 16) { unsigned ds[16]; f32x2 be[16];
#pragma unroll
        for (int u = 0; u < 16; ++u) { ds[u] = *(const unsigned*)(DS + (un0 + c0 + u) * EPB + idx); be[u] = *(const f32x2*)(BE + (un0 + c0 + u) * DK + d); }
#pragma unroll
        for (int u = 0; u < 16; ++u) { *(unsigned*)(SG + (un0 + c0 + u) * EPB + idx) = pk2(S0, S1); S0 = S0 * be[u][0] + bflo(ds[u]); S1 = S1 * be[u][1] + bfhi(ds[u]); } }
}
template <int DK>
__device__ __forceinline__ void m3_gh_task(int lane, const bf16* __restrict__ Qg, const bf16* __restrict__ Kg, const bf16* __restrict__ VTg, const bf16* __restrict__ Sg,
                                           const bf16* __restrict__ gate  , const float* __restrict__ ng  , unsigned char* __restrict__ orow  , LAS unsigned char* os  ) {
    const int r32 = lane & 31, hh = lane >> 5;
    bf16x8 qf[DK / 16], kfa[DK / 16], sfa[2][DK / 16]; s16x4 vfa[2][2][2]; u32x2 gwa[2][4]; f32x4 n4a[2][4];
    const bf16* grow = gate + (size_t)r32 * PINP;
#pragma unroll
    for (int s = 0; s < DK / 16; ++s) { qf[s] = *(const bf16x8*)(Qg + r32 * DK + 16 * s + 8 * hh); kfa[s] = *(const bf16x8*)(Kg + r32 * DK + 16 * s + 8 * hh); }
#pragma unroll
    for (int s = 0; s < 2; ++s)
#pragma unroll
        for (int vt = 0; vt < 2; ++vt) { const bf16* vp = VTg + (32 * vt + r32) * 32 + 16 * s + 4 * hh; vfa[s][vt][0] = *(const s16x4*)vp; vfa[s][vt][1] = *(const s16x4*)(vp + 8); }
#pragma unroll
    for (int vt = 0; vt < 2; ++vt)
#pragma unroll
        for (int s = 0; s < DK / 16; ++s) sfa[vt][s] = *(const bf16x8*)(Sg + (32 * vt + r32) * DK + 16 * s + 8 * hh);
#pragma unroll
    for (int vt = 0; vt < 2; ++vt)
#pragma unroll
        for (int g = 0; g < 4; ++g) { gwa[vt][g] = *(const u32x2*)(grow + 32 * vt + 8 * g + 4 * hh); n4a[vt][g] = *(const f32x4*)(ng + 32 * vt + 8 * g + 4 * hh); }
    __builtin_amdgcn_sched_barrier(0);
    f32x16 at;
#pragma unroll
    for (int i = 0; i < 16; ++i) at[i] = 0.f;
#pragma unroll
    for (int s = 0; s < DK / 16; ++s) at = __builtin_amdgcn_mfma_f32_32x32x16_bf16(kfa[s], qf[s], at, 0, 0, 0);
#pragma unroll
    for (int r = 0; r < 16; ++r) if (rho16(r, hh) > r32) at[r] = 0.f;
    f32x16 o[2];
#pragma unroll
    for (int vt = 0; vt < 2; ++vt)
#pragma unroll
        for (int i = 0; i < 16; ++i) o[vt][i] = 0.f;
#pragma unroll
    for (int s = 0; s < 2; ++s) { union { bf16x8 v; unsigned w[4]; } pf;
#pragma unroll
        for (int j = 0; j < 4; ++j) pf.w[j] = cvt_pk_bf16(at[8 * s + 2 * j], at[8 * s + 2 * j + 1]);
#pragma unroll
        for (int vt = 0; vt < 2; ++vt) {
            union { bf16x8 v; s16x4 h2[2]; } vf; vf.h2[0] = vfa[s][vt][0]; vf.h2[1] = vfa[s][vt][1];
            o[vt] = __builtin_amdgcn_mfma_f32_32x32x16_bf16(vf.v, pf.v, o[vt], 0, 0, 0); } }
#pragma unroll
    for (int vt = 0; vt < 2; ++vt)
#pragma unroll
        for (int s = 0; s < DK / 16; ++s) o[vt] = __builtin_amdgcn_mfma_f32_32x32x16_bf16(sfa[vt][s], qf[s], o[vt], 0, 0, 0);
    float ss = 0.f;
#pragma unroll
    for (int vt = 0; vt < 2; ++vt)
#pragma unroll
        for (int i = 0; i < 16; ++i) ss += o[vt][i] * o[vt][i];
    ss += __shfl_xor(ss, 32);
    const float rstd = 1.0f / sqrtf(ss * (1.0f / 64.0f) + RMS_EPS);
#pragma unroll
    for (int vt = 0; vt < 2; ++vt)
#pragma unroll
        for (int g = 0; g < 4; ++g) { const int v0 = 32 * vt + 8 * g + 4 * hh; const u32x2 gw = gwa[vt][g]; const f32x4 n4 = n4a[vt][g];
            const float y0 = o[vt][4 * g] * rstd * n4[0] * silu_f(bflo(gw.x)), y1 = o[vt][4 * g + 1] * rstd * n4[1] * silu_f(bfhi(gw.x));
            const float y2 = o[vt][4 * g + 2] * rstd * n4[2] * silu_f(bflo(gw.y)), y3 = o[vt][4 * g + 3] * rstd * n4[3] * silu_f(bfhi(gw.y));
            *(LAS unsigned*)(os + r32 * 64 + v0) = pack_o4(y0, y1, y2, y3); }
    flush_o_tile(os, orow, lane);
}

constexpr int RWC_HEADB = 28928;
constexpr int RWC_AL = 4 * RWC_HEADB, RWC_LWL = RWC_AL + 32 * 264 * 2;
static_assert(RWC_LWL + 32 * 264 * 2 <= LDSCTL_OFF, "rw_fused_unit LDS");
__device__ __forceinline__ void rw_fused_unit(LAS unsigned char* lds, int l, int b, int c) {
    const int tid = opaque_tid(), lane = tid & 63, wave = __builtin_amdgcn_readfirstlane(tid >> 6), h = wave >> 1, p = wave & 1, r32 = lane & 31, hh = lane >> 5;
    unsigned char* ws = KWS();
    const int bh = b * 4 + h; const size_t un = (size_t)bh * NCH + c;
    const int t0 = c * 32;
    const bf16* P = (const bf16*)(ws + WS_P) + ((size_t)b * T + t0) * PINP + PC_RW;
    const float* mu = KIN(I_RWMU) + (size_t)l * 1024;
    LAS bf16* XL = (LAS bf16*)lds;
    LAS bf16* AL = (LAS bf16*)(lds + RWC_AL);
    LAS bf16* LWL = (LAS bf16*)(lds + RWC_LWL);
    bf16x8 bwW[4], bwA[4], bwG[8]; float w0c, a0c;
    { const int ch = wave * 32 + r32;
      const bf16* w2T = (const bf16*)(ws + WS_LORA) + (size_t)l * 256 * 64 + (size_t)ch * 64 + 8 * hh;
      const bf16* a2T = (const bf16*)(ws + WS_LORA) + (size_t)(NL * 256 * 64) + (size_t)l * 256 * 64 + (size_t)ch * 64 + 8 * hh;
      const bf16* g2T = (const bf16*)(ws + WS_LORA) + (size_t)2 * (NL * 256 * 64) + (size_t)l * 256 * 128 + (size_t)ch * 128 + 8 * hh;
#pragma unroll
      for (int s = 0; s < 4; ++s) { bwW[s] = *(const bf16x8*)(w2T + 16 * s); bwA[s] = *(const bf16x8*)(a2T + 16 * s); }
#pragma unroll
      for (int s = 0; s < 8; ++s) bwG[s] = *(const bf16x8*)(g2T + 16 * s);
      w0c = KIN(I_RWW0)[l * 256 + ch]; a0c = KIN(I_RWA0)[l * 256 + ch]; }
    { const int cc = tid & 255, tp = tid >> 8; const float mc = mu[768 + cc];
      unsigned short xr[17];
#pragma unroll
      for (int j = 0; j < 17; ++j) { const int tk = tp * 16 + j - 1;
          if (j == 0) { const bool ok = (t0 + tk >= 0); const unsigned short v = P[(long)(ok ? tk : 0) * PINP + 768 + cc]; xr[0] = ok ? v : (unsigned short)0; }
          else xr[j] = P[(long)tk * PINP + 768 + cc]; }
#pragma unroll
      for (int j = 0; j < 16; ++j) { const float cur = bf2f(xr[j + 1]), prev = bf2f(xr[j]);
          float x = cur + (prev - cur) * mc;
          if (cc < 64) x = tanh_f(x); else if (cc >= 128) x = fast_sigmoid(x);
          XL[(tp * 16 + j) * 264 + cc] = (bf16)f2bf(x); } }
    lds_barrier();
    float mr, mk, mv, kkc, kac, rkc; unsigned short xrr[17], xkr[17], xvr[17];
    { const int ch = (wave & 3) * 64 + lane, tb = (wave >> 2) * 16;
      mr = mu[ch]; mk = mu[256 + ch]; mv = mu[512 + ch]; kkc = KIN(I_RWKK)[l * 256 + ch]; kac = KIN(I_RWKA)[l * 256 + ch]; rkc = KIN(I_RWRK)[l * 256 + ch];
#pragma unroll
      for (int j = 0; j < 17; ++j) { const int tk = tb + j - 1;
          if (j == 0) { const bool ok = (t0 + tk >= 0); const bf16* row = P + (long)(ok ? tk : 0) * PINP; const unsigned short v0 = row[ch], v1 = row[256 + ch], v2 = row[512 + ch];
              xrr[0] = ok ? v0 : (unsigned short)0; xkr[0] = ok ? v1 : (unsigned short)0; xvr[0] = ok ? v2 : (unsigned short)0; }
          else { const bf16* row = P + (long)tk * PINP; xrr[j] = row[ch]; xkr[j] = row[256 + ch]; xvr[j] = row[512 + ch]; } }
      __builtin_amdgcn_sched_barrier(0); }
    {
        const int ch = wave * 32 + r32;
        const LAS bf16* xa = XL + r32 * 264 + 8 * hh;
        {
            f32x16 acc;
#pragma unroll
            for (int i = 0; i < 16; ++i) acc[i] = 0.f;
#pragma unroll
            for (int s = 0; s < 4; ++s) { const bf16x8 A = *(const LAS bf16x8*)(xa + 16 * s);
                acc = __builtin_amdgcn_mfma_f32_32x32x16_bf16(A, bwW[s], acc, 0, 0, 0); }
#pragma unroll
            for (int r = 0; r < 16; ++r) { const int tok = rho16(r, hh);
                const float zw = w0c + acc[r];
                LWL[tok * 264 + ch] = (bf16)f2bf(-0.6065306597126334f * fast_sigmoid(zw)); }
        }
        __builtin_amdgcn_sched_barrier(0);
        {
            f32x16 acc;
#pragma unroll
            for (int i = 0; i < 16; ++i) acc[i] = 0.f;
#pragma unroll
            for (int s = 0; s < 4; ++s) { const bf16x8 A = *(const LAS bf16x8*)(xa + 64 + 16 * s);
                acc = __builtin_amdgcn_mfma_f32_32x32x16_bf16(A, bwA[s], acc, 0, 0, 0); }
#pragma unroll
            for (int r = 0; r < 16; ++r) AL[rho16(r, hh) * 264 + ch] = (bf16)f2bf(fast_sigmoid(a0c + acc[r]));
        }
        __builtin_amdgcn_sched_barrier(0);
        {
            f32x16 acc;
#pragma unroll
            for (int i = 0; i < 16; ++i) acc[i] = 0.f;
#pragma unroll
            for (int s = 0; s < 8; ++s) { const bf16x8 A = *(const LAS bf16x8*)(xa + 128 + 16 * s);
                acc = __builtin_amdgcn_mfma_f32_32x32x16_bf16(A, bwG[s], acc, 0, 0, 0); }
            bf16* gb = (bf16*)(ws + WS_GBUF) + ((size_t)b * T + t0) * 256 + ch;
#pragma unroll
            for (int r = 0; r < 16; ++r) gb[(size_t)rho16(r, hh) * 256] = (bf16)f2bf(acc[r]);
        }
    }
    lds_barrier();
    LAS unsigned char* L = lds + h * RWC_HEADB;
    LAS bf16* AT = (LAS bf16*)L;
    LAS bf16* BT = (LAS bf16*)(L + 4096);
    LAS bf16* KT = (LAS bf16*)(L + 8192);
    LAS bf16* ATT = (LAS bf16*)(L + 12288);
    LAS bf16* BHT = (LAS bf16*)(L + 16384);
    LAS bf16* KHT = (LAS bf16*)(L + 20480);
    LAS bf16* VT = (LAS bf16*)(L + 24576);
    LAS float* GC = (LAS float*)(L + 28672);
    LAS float* MAB = (LAS float*)(L + 4096);
    LAS bf16* MAK = (LAS bf16*)(L + 8192);
    LAS bf16* TM = (LAS bf16*)L;
    {
        const int hs = wave & 3, half = wave >> 2, d = lane, ch = hs * 64 + d, tb = half * 16; const size_t uns = (size_t)(b * 4 + hs) * NCH + c;
        LAS unsigned char* Ls = lds + hs * RWC_HEADB;
        LAS bf16* sAT = (LAS bf16*)Ls; LAS bf16* sBT = (LAS bf16*)(Ls + 4096); LAS bf16* sKT = (LAS bf16*)(Ls + 8192);
        LAS bf16* sATT = (LAS bf16*)(Ls + 12288); LAS bf16* sBHT = (LAS bf16*)(Ls + 16384); LAS bf16* sKHT = (LAS bf16*)(Ls + 20480); LAS bf16* sVT = (LAS bf16*)(Ls + 24576); LAS float* sGC = (LAS float*)(Ls + 28672);
        float lg0 = 0.f, lg1 = 0.f;
#pragma unroll
        for (int t = 0; t < 16; ++t) { lg0 += bf2f(LWL[t * 264 + ch]); lg1 += bf2f(LWL[(16 + t) * 264 + ch]); }
        const float lgend = lg0 + lg1;
        lds_barrier();
        float* bonp = (float*)(ws + WS_BONUS) + ((size_t)b * T + t0) * 4 + hs;
        float lg = half ? lg0 : 0.f; float elg = fast_exp(lg); const float eend = fast_exp(lgend);
#pragma unroll
        for (int t8 = 0; t8 < 2; ++t8) { u32x4 ap, bp, kp;
#pragma unroll
            for (int jj = 0; jj < 4; ++jj) { float at2[2], bh2[2], kh2[2];
#pragma unroll
                for (int e = 0; e < 2; ++e) { const int j = t8 * 8 + jj * 2 + e, t = tb + j;
                    const float rc = bf2f(xrr[j + 1]), kc = bf2f(xkr[j + 1]);
                    const float r = rc + (bf2f(xrr[j]) - rc) * mr, k = kc + (bf2f(xkr[j]) - kc) * mk;
                    const float av = bf2f(AL[t * 264 + ch]), lw = bf2f(LWL[t * 264 + ch]);
                    const float kkr = k * kkc, hk = k * (1.0f + (av - 1.0f) * kac);
                    const float ss = wave_sum(kkr * kkr); const float kk = kkr * __builtin_amdgcn_rsqf(fmaxf(ss, 1e-24f));
                    const float bon = wave_sum(r * hk * rkc);
                    const float aa = -kk, bb = kk * av;
                    const float elgp = elg; lg += lw; elg = fast_exp(lg);
                    const float ei = __builtin_amdgcn_rcpf(elg), at = aa * elgp, rt = r * elg, bt = bb * ei, kt = hk * ei, eh = eend * ei;
                    sAT[t * 64 + d] = (bf16)f2bf(at); sBT[t * 64 + d] = (bf16)f2bf(bt); sKT[t * 64 + d] = (bf16)f2bf(kt);
                    LWL[t * 264 + ch] = (bf16)f2bf(rt);
                    if (d == 0) bonp[t * 4] = bon;
                    at2[e] = at; bh2[e] = bb * eh; kh2[e] = hk * eh; }
                ap[jj] = pk2(at2[0], at2[1]); bp[jj] = pk2(bh2[0], bh2[1]); kp[jj] = pk2(kh2[0], kh2[1]); }
            *(LAS u32x4*)(sATT + d * 32 + tb + t8 * 8) = ap; *(LAS u32x4*)(sBHT + d * 32 + tb + t8 * 8) = bp; *(LAS u32x4*)(sKHT + d * 32 + tb + t8 * 8) = kp; }
        if (half == 0) sGC[d] = eend;
        bf16* VTg = (bf16*)(ws + WS_RVT) + uns * 2048 + d * 32 + tb;
#pragma unroll
        for (int t8 = 0; t8 < 2; ++t8) { u32x4 vp; float yv[8];
#pragma unroll
            for (int e = 0; e < 8; ++e) { const int j = t8 * 8 + e; const float xv = bf2f(xvr[j + 1]); yv[e] = xv + (bf2f(xvr[j]) - xv) * mv; }
#pragma unroll
            for (int jj = 0; jj < 4; ++jj) vp[jj] = pk2(yv[2 * jj], yv[2 * jj + 1]);
            *(LAS u32x4*)(sVT + d * 32 + tb + t8 * 8) = vp; *(u32x4*)(VTg + t8 * 8) = vp; }
    }
    lds_barrier();
    f32x16 accR[2];
    union { bf16x8 v; unsigned w[4]; } mfr[2];
    LAS u32x4* EX = (LAS u32x4*)(lds + RWC_AL + h * 2048);
    {
        f32x16 acc, acc2;
#pragma unroll
        for (int i = 0; i < 16; ++i) { acc[i] = 0.f; acc2[i] = 0.f; }
        const LAS bf16* Bsrc = p == 0 ? BT : KT;
#pragma unroll
        for (int s = 0; s < 4; ++s) { const bf16x8 A = *(const LAS bf16x8*)(AT + r32 * 64 + 16 * s + 8 * hh), B = *(const LAS bf16x8*)(Bsrc + r32 * 64 + 16 * s + 8 * hh);
            const bf16x8 Rf = *(const LAS bf16x8*)(LWL + r32 * 264 + h * 64 + 16 * s + 8 * hh);
            acc = __builtin_amdgcn_mfma_f32_32x32x16_bf16(A, B, acc, 0, 0, 0);
            acc2 = __builtin_amdgcn_mfma_f32_32x32x16_bf16(B, Rf, acc2, 0, 0, 0); }
#pragma unroll
        for (int r = 0; r < 16; ++r) if (rho16(r, hh) > r32) acc2[r] = 0.f;
#pragma unroll
        for (int s2 = 0; s2 < 2; ++s2) {
#pragma unroll
            for (int j = 0; j < 4; ++j) mfr[s2].w[j] = cvt_pk_bf16(acc2[8 * s2 + 2 * j], acc2[8 * s2 + 2 * j + 1]);
            if (p == 0) EX[s2 * 64 + lane] = (u32x4){mfr[s2].w[0], mfr[s2].w[1], mfr[s2].w[2], mfr[s2].w[3]}; }
        if (p == 0) {
#pragma unroll
            for (int r = 0; r < 16; ++r) { const int t = rho16(r, hh); MAB[t * 32 + r32] = (r32 < t) ? acc[r] : 0.f; }
        } else {
#pragma unroll
            for (int r = 0; r < 16; ++r) { const int t = rho16(r, hh); MAK[t * 32 + r32] = (bf16)f2bf((r32 < t) ? acc[r] : 0.f); }
        }
    }
    lds_barrier();
    if (p == 0) {
        const int cidx = r32; float tc[32];
#pragma unroll
        for (int t = 0; t < 32; ++t) { float acc0 = (t == cidx) ? 1.0f : 0.f, acc1 = 0.f;
#pragma unroll
            for (int s4 = 0; s4 < (t + 3) / 4; ++s4) { const f32x4 m4 = *(const LAS f32x4*)(MAB + t * 32 + 4 * s4);
#pragma unroll
                for (int e = 0; e < 4; ++e) { const int s = 4 * s4 + e; if (s < t) { if (e & 1) acc1 = fmaf(m4[e], tc[s], acc1); else acc0 = fmaf(m4[e], tc[s], acc0); } } }
            tc[t] = acc0 + acc1; }
#pragma unroll
        for (int t = 0; t < 32; ++t) if (hh == 0) TM[t * 32 + cidx] = (bf16)f2bf(tc[t]);
    } else {
#pragma unroll
        for (int vt = 0; vt < 2; ++vt) {
#pragma unroll
            for (int i = 0; i < 16; ++i) accR[vt][i] = 0.f;
#pragma unroll
            for (int s = 0; s < 2; ++s) { const bf16x8 A = *(const LAS bf16x8*)(MAK + r32 * 32 + 16 * s + 8 * hh), B = *(const LAS bf16x8*)(VT + (32 * vt + r32) * 32 + 16 * s + 8 * hh);
                accR[vt] = __builtin_amdgcn_mfma_f32_32x32x16_bf16(A, B, accR[vt], 0, 0, 0); } }
    }
    lds_barrier();
    if (p == 0) {
        f32x16 accW[2];
#pragma unroll
        for (int dt = 0; dt < 2; ++dt) {
#pragma unroll
            for (int i = 0; i < 16; ++i) accW[dt][i] = 0.f;
#pragma unroll
            for (int s = 0; s < 2; ++s) { const bf16x8 A = *(const LAS bf16x8*)(TM + r32 * 32 + 16 * s + 8 * hh), B = *(const LAS bf16x8*)(ATT + (32 * dt + r32) * 32 + 16 * s + 8 * hh);
                accW[dt] = __builtin_amdgcn_mfma_f32_32x32x16_bf16(A, B, accW[dt], 0, 0, 0); } }
        { LAS bf16* WL = ATT;
#pragma unroll
          for (int dt = 0; dt < 2; ++dt) { f32x16 acc;
#pragma unroll
              for (int i = 0; i < 16; ++i) acc[i] = 0.f;
#pragma unroll
              for (int s = 0; s < 2; ++s) { union { bf16x8 v; unsigned w[4]; } bf;
#pragma unroll
                  for (int j = 0; j < 4; ++j) bf.w[j] = cvt_pk_bf16(accW[dt][8 * s + 2 * j], accW[dt][8 * s + 2 * j + 1]);
                  acc = __builtin_amdgcn_mfma_f32_32x32x16_bf16(mfr[s].v, bf.v, acc, 0, 0, 0); }
#pragma unroll
              for (int r = 0; r < 16; ++r) { const int t = rho16(r, hh); WL[t * 64 + 32 * dt + r32] = (bf16)f2bf(acc[r] + bf2f(LWL[t * 264 + h * 64 + 32 * dt + r32])); } }
          u32x4* RGw = (u32x4*)((bf16*)(ws + WS_RR) + un * 2048);
#pragma unroll
          for (int i = 0; i < 4; ++i) RGw[i * 64 + lane] = *(const LAS u32x4*)(WL + (i * 64 + lane) * 8); }
        LAS bf16* PL = (LAS bf16*)(L + 4096);
        const int xs = r32 >> 4, xx = r32 & 15, hhA = (xx >> 2) & 1, jA = 4 * (xx >> 3) + (xx & 3);
#pragma unroll
        for (int dt = 0; dt < 2; ++dt)
#pragma unroll
            for (int dt2 = 0; dt2 < 2; ++dt2) { f32x16 acc;
#pragma unroll
                for (int i = 0; i < 16; ++i) acc[i] = 0.f;
#pragma unroll
                for (int s = 0; s < 2; ++s) { const LAS bf16* bp = BHT + (32 * dt + r32) * 32 + 16 * s + 4 * hh;
                    union { bf16x8 v; s16x4 h2[2]; } af; af.h2[0] = *(const LAS s16x4*)bp; af.h2[1] = *(const LAS s16x4*)(bp + 8);
                    union { bf16x8 v; unsigned w[4]; } bf;
#pragma unroll
                    for (int j = 0; j < 4; ++j) bf.w[j] = cvt_pk_bf16(accW[dt2][8 * s + 2 * j], accW[dt2][8 * s + 2 * j + 1]);
                    acc = __builtin_amdgcn_mfma_f32_32x32x16_bf16(af.v, bf.v, acc, 0, 0, 0); }
                if (dt == dt2) { const float gc = GC[32 * dt + r32];
#pragma unroll
                    for (int r = 0; r < 16; ++r) if (rho16(r, hh) == r32) acc[r] += gc; }
                LAS bf16* pf = PL + (((dt * 2 + dt2) * 2 + xs) * 64 + 32 * hhA) * 8 + jA;
#pragma unroll
                for (int r = 0; r < 16; ++r) pf[rho16(r, hh) * 8] = (bf16)f2bf(acc[r]); }
        { u32x4* PFp = (u32x4*)((bf16*)(ws + WS_RP) + un * 4096);
#pragma unroll
          for (int f = 0; f < 8; ++f) PFp[f * 64 + lane] = *(const LAS u32x4*)(PL + (f * 64 + lane) * 8); }
    } else {
        f32x16 accU[2];
#pragma unroll
        for (int vt = 0; vt < 2; ++vt) {
#pragma unroll
            for (int i = 0; i < 16; ++i) accU[vt][i] = 0.f;
#pragma unroll
            for (int s = 0; s < 2; ++s) { const LAS bf16* tp = TM + r32 * 32 + 16 * s + 4 * hh;
                union { bf16x8 v; s16x4 h2[2]; } af; af.h2[0] = *(const LAS s16x4*)tp; af.h2[1] = *(const LAS s16x4*)(tp + 8);
                union { bf16x8 v; unsigned w[4]; } bf;
#pragma unroll
                for (int j = 0; j < 4; ++j) bf.w[j] = cvt_pk_bf16(accR[vt][8 * s + 2 * j], accR[vt][8 * s + 2 * j + 1]);
                accU[vt] = __builtin_amdgcn_mfma_f32_32x32x16_bf16(af.v, bf.v, accU[vt], 0, 0, 0); } }
        bf16* UGp = (bf16*)(ws + WS_RU) + un * 2048;
#pragma unroll
        for (int vt = 0; vt < 2; ++vt) { f32x16 acc;
#pragma unroll
            for (int i = 0; i < 16; ++i) acc[i] = 0.f;
#pragma unroll
            for (int s = 0; s < 2; ++s) { union { bf16x8 v; unsigned w[4]; } fu; union { bf16x8 v; u32x4 q; } fb;
#pragma unroll
                for (int j = 0; j < 4; ++j) fu.w[j] = cvt_pk_bf16(accU[vt][8 * s + 2 * j], accU[vt][8 * s + 2 * j + 1]);
                fb.q = EX[s * 64 + lane];
                acc = __builtin_amdgcn_mfma_f32_32x32x16_bf16(fu.v, fb.v, acc, 0, 0, 0);
                const LAS bf16* vp = VT + (32 * vt + r32) * 32 + 16 * s + 4 * hh;
                union { bf16x8 v; s16x4 h2[2]; } vf; vf.h2[0] = *(const LAS s16x4*)vp; vf.h2[1] = *(const LAS s16x4*)(vp + 8);
                acc = __builtin_amdgcn_mfma_f32_32x32x16_bf16(vf.v, mfr[s].v, acc, 0, 0, 0); }
#pragma unroll
            for (int g2 = 0; g2 < 2; ++g2) *(u32x4*)(UGp + ((vt * 2 + g2) * 64 + lane) * 8) = (u32x4){cvt_pk_bf16(acc[8 * g2], acc[8 * g2 + 1]), cvt_pk_bf16(acc[8 * g2 + 2], acc[8 * g2 + 3]),
                                                                                                 cvt_pk_bf16(acc[8 * g2 + 4], acc[8 * g2 + 5]), cvt_pk_bf16(acc[8 * g2 + 6], acc[8 * g2 + 7])}; }
        bf16* QFp = (bf16*)(ws + WS_RQ) + un * 4096;
#pragma unroll
        for (int vt = 0; vt < 2; ++vt)
#pragma unroll
            for (int dt = 0; dt < 2; ++dt) { f32x16 acc;
#pragma unroll
                for (int i = 0; i < 16; ++i) acc[i] = 0.f;
#pragma unroll
                for (int s = 0; s < 2; ++s) { const LAS bf16* bp = BHT + (32 * dt + r32) * 32 + 16 * s + 4 * hh;
                    union { bf16x8 v; s16x4 h2[2]; } af; af.h2[0] = *(const LAS s16x4*)bp; af.h2[1] = *(const LAS s16x4*)(bp + 8);
                    union { bf16x8 v; unsigned w[4]; } bf;
#pragma unroll
                    for (int j = 0; j < 4; ++j) bf.w[j] = cvt_pk_bf16(accU[vt][8 * s + 2 * j], accU[vt][8 * s + 2 * j + 1]);
                    acc = __builtin_amdgcn_mfma_f32_32x32x16_bf16(af.v, bf.v, acc, 0, 0, 0);
                    const bf16x8 A2 = *(const LAS bf16x8*)(KHT + (32 * dt + r32) * 32 + 16 * s + 8 * hh), B2 = *(const LAS bf16x8*)(VT + (32 * vt + r32) * 32 + 16 * s + 8 * hh);
                    acc = __builtin_amdgcn_mfma_f32_32x32x16_bf16(A2, B2, acc, 0, 0, 0); }
#pragma unroll
                for (int g2 = 0; g2 < 2; ++g2) *(u32x4*)(QFp + (((vt * 2 + dt) * 2 + g2) * 64 + lane) * 8) = (u32x4){cvt_pk_bf16(acc[8 * g2], acc[8 * g2 + 1]), cvt_pk_bf16(acc[8 * g2 + 2], acc[8 * g2 + 3]),
                                                                                                                   cvt_pk_bf16(acc[8 * g2 + 4], acc[8 * g2 + 5]), cvt_pk_bf16(acc[8 * g2 + 6], acc[8 * g2 + 7])}; }
    }
    lds_barrier();
}
__device__ __forceinline__ void rw_m2_wave(int lane, int bh, int vt) {
    unsigned char* ws = KWS();
    const bf16* PF = (const bf16*)(ws + WS_RP) + (size_t)bh * NCH * 4096 + lane * 8;
    const bf16* QF = (const bf16*)(ws + WS_RQ) + (size_t)bh * NCH * 4096 + (size_t)vt * 2048 + lane * 8;
    bf16* SG = (bf16*)(ws + WS_RS) + (size_t)bh * NCH * 4096 + (size_t)vt * 2048 + lane * 8;
    f32x16 S[2];
#pragma unroll
    for (int dt = 0; dt < 2; ++dt)
#pragma unroll
        for (int i = 0; i < 16; ++i) S[dt][i] = 0.f;
    bf16x8 pA[8], pB[8], pC[8]; u32x4 qA[4], qB[4], qC[4];
#pragma unroll
    for (int f = 0; f < 8; ++f) { pA[f] = (bf16x8){0, 0, 0, 0, 0, 0, 0, 0}; pB[f] = pA[f]; pC[f] = pA[f]; }
#pragma unroll
    for (int f = 0; f < 4; ++f) { qA[f] = (u32x4){0u, 0u, 0u, 0u}; qB[f] = qA[f]; qC[f] = qA[f]; }
#define RWM2_LD4(d0, d1, d2, d3, ptr) asm volatile("global_load_dwordx4 %0, %4, off\n\tglobal_load_dwordx4 %1, %4, off offset:1024\n\tglobal_load_dwordx4 %2, %4, off offset:2048\n\tglobal_load_dwordx4 %3, %4, off offset:3072" \
        : "+v"(d0), "+v"(d1), "+v"(d2), "+v"(d3) : "v"(ptr) : "memory")
#define RWM2_LOAD(P_, Q_, c_) do { const int _c = (c_) < NCH ? (c_) : NCH - 1; const bf16* _p0 = PF + (size_t)_c * 4096; const bf16* _p1 = _p0 + 2048; const bf16* _q = QF + (size_t)_c * 4096; \
        RWM2_LD4(P_[0], P_[1], P_[2], P_[3], _p0); RWM2_LD4(P_[4], P_[5], P_[6], P_[7], _p1); RWM2_LD4(Q_[0], Q_[1], Q_[2], Q_[3], _q); } while (0)
#define RWM2_WAIT(P_, Q_) asm volatile("s_waitcnt vmcnt(24)" : "+v"(P_[0]), "+v"(P_[1]), "+v"(P_[2]), "+v"(P_[3]), "+v"(P_[4]), "+v"(P_[5]), "+v"(P_[6]), "+v"(P_[7]), "+v"(Q_[0]), "+v"(Q_[1]), "+v"(Q_[2]), "+v"(Q_[3]) :: "memory")
#define RWM2_STEP(P_, Q_, c_) do { \
        RWM2_WAIT(P_, Q_); \
        union { bf16x8 v; unsigned w[4]; } sb[2][2]; \
        _Pragma("unroll") for (int dt2 = 0; dt2 < 2; ++dt2) _Pragma("unroll") for (int s = 0; s < 2; ++s) { \
            _Pragma("unroll") for (int j = 0; j < 4; ++j) sb[dt2][s].w[j] = cvt_pk_bf16(S[dt2][8 * s + 2 * j], S[dt2][8 * s + 2 * j + 1]); \
            *(bf16x8*)(SG + (size_t)(c_) * 4096 + (dt2 * 2 + s) * 512) = sb[dt2][s].v; } \
        f32x16 N[2]; \
        _Pragma("unroll") for (int dt = 0; dt < 2; ++dt) { \
            _Pragma("unroll") for (int g2 = 0; g2 < 2; ++g2) _Pragma("unroll") for (int j = 0; j < 4; ++j) { N[dt][8 * g2 + 2 * j] = bflo(Q_[dt * 2 + g2][j]); N[dt][8 * g2 + 2 * j + 1] = bfhi(Q_[dt * 2 + g2][j]); } \
            _Pragma("unroll") for (int dt2 = 0; dt2 < 2; ++dt2) _Pragma("unroll") for (int s = 0; s < 2; ++s) N[dt] = __builtin_amdgcn_mfma_f32_32x32x16_bf16(P_[(dt * 2 + dt2) * 2 + s], sb[dt2][s].v, N[dt], 0, 0, 0); } \
        S[0] = N[0]; S[1] = N[1]; } while (0)
    RWM2_LOAD(pA, qA, 0); RWM2_LOAD(pB, qB, 1); RWM2_LOAD(pC, qC, 2);
#pragma unroll 1
    for (int c = 0; c < NCH - 1; c += 3) {
        RWM2_STEP(pA, qA, c); RWM2_LOAD(pA, qA, c + 3);
        RWM2_STEP(pB, qB, c + 1); RWM2_LOAD(pB, qB, c + 4);
        RWM2_STEP(pC, qC, c + 2); RWM2_LOAD(pC, qC, c + 5);
    }
    static_assert((NCH - 1) % 3 == 0, "chunk loop: 85 rounds of three steps, then the last chunk");
    RWM2_STEP(pA, qA, NCH - 1);
    asm volatile("s_waitcnt vmcnt(0)" : "+v"(pB[0]), "+v"(pB[1]), "+v"(pB[2]), "+v"(pB[3]), "+v"(pB[4]), "+v"(pB[5]), "+v"(pB[6]), "+v"(pB[7]), "+v"(qB[0]), "+v"(qB[1]), "+v"(qB[2]), "+v"(qB[3]) :: "memory");
    asm volatile("" : "+v"(pC[0]), "+v"(pC[1]), "+v"(pC[2]), "+v"(pC[3]), "+v"(pC[4]), "+v"(pC[5]), "+v"(pC[6]), "+v"(pC[7]), "+v"(qC[0]), "+v"(qC[1]), "+v"(qC[2]), "+v"(qC[3]) :: "memory");
#undef RWM2_LD4
#undef RWM2_LOAD
#undef RWM2_WAIT
#undef RWM2_STEP
}
__device__ __forceinline__ bf16x8 ld_perm8(const bf16* p) { union { bf16x8 v; s16x4 h2[2]; } f; f.h2[0] = *(const s16x4*)p; f.h2[1] = *(const s16x4*)(p + 8); return f.v; }
__device__ __forceinline__ void rw_m3_task(int lane, int l, int bh, int c, LAS unsigned char* os) {
    unsigned char* ws = KWS();
    const int r32 = lane & 31, hh = lane >> 5, b = bh >> 2, h = bh & 3; const size_t un = (size_t)bh * NCH + c; const size_t tok0 = (size_t)b * T + c * 32;
    const bf16* RGp = (const bf16*)(ws + WS_RR) + un * 2048 + r32 * 64 + 4 * hh;
    const bf16* SGp = (const bf16*)(ws + WS_RS) + un * 4096 + lane * 8; const bf16* VTp = (const bf16*)(ws + WS_RVT) + un * 2048 + r32 * 32 + 4 * hh;
    const bf16* UGp = (const bf16*)(ws + WS_RU) + un * 2048 + lane * 8;
    f32x16 Y[2], Z[2];
    const float bon = ((const float*)(ws + WS_BONUS))[(tok0 + r32) * 4 + h];
#pragma unroll
    for (int vt = 0; vt < 2; ++vt)
#pragma unroll
        for (int g2 = 0; g2 < 2; ++g2) { const u32x4 u4 = *(const u32x4*)(UGp + (vt * 2 + g2) * 512);
#pragma unroll
            for (int j = 0; j < 4; ++j) { Y[vt][8 * g2 + 2 * j] = bflo(u4[j]); Y[vt][8 * g2 + 2 * j + 1] = bfhi(u4[j]); } }
#pragma unroll
    for (int i = 0; i < 16; ++i) { Z[0][i] = 0.f; Z[1][i] = 0.f; }
#pragma unroll
    for (int ks = 0; ks < 4; ++ks) {
        const bf16x8 rf = ld_perm8(RGp + 16 * ks);
        const bf16x8 s0 = *(const bf16x8*)(SGp + ks * 512), s1 = *(const bf16x8*)(SGp + 2048 + ks * 512);
        Y[0] = __builtin_amdgcn_mfma_f32_32x32x16_bf16(s0, rf, Y[0], 0, 0, 0); Y[1] = __builtin_amdgcn_mfma_f32_32x32x16_bf16(s1, rf, Y[1], 0, 0, 0); }
#pragma unroll
    for (int s = 0; s < 2; ++s) {
        union { bf16x8 v; unsigned short e[8]; } db;
#pragma unroll
        for (int j = 0; j < 8; ++j) db.e[j] = (16 * s + 8 * (j >> 2) + 4 * hh + (j & 3) == r32) ? (unsigned short)f2bf(bon) : (unsigned short)0;
#pragma unroll
        for (int vt = 0; vt < 2; ++vt) {
            const bf16* vp = VTp + (size_t)vt * 32 * 32 + 16 * s;
            union { bf16x8 v; s16x4 h2[2]; } vf; vf.h2[0] = *(const s16x4*)vp; vf.h2[1] = *(const s16x4*)(vp + 8);
            Z[vt] = __builtin_amdgcn_mfma_f32_32x32x16_bf16(vf.v, db.v, Z[vt], 0, 0, 0); } }
    float sm = 0.f;
#pragma unroll
    for (int vt = 0; vt < 2; ++vt)
#pragma unroll
        for (int i = 0; i < 16; ++i) sm += Y[vt][i];
    sm += __shfl_xor(sm, 32); const float mu = sm * (1.0f / 64.0f);
    float q = 0.f;
#pragma unroll
    for (int vt = 0; vt < 2; ++vt)
#pragma unroll
        for (int i = 0; i < 16; ++i) { const float dd = Y[vt][i] - mu; q += dd * dd; }
    q += __shfl_xor(q, 32); const float rstd = 1.0f / sqrtf(q * (1.0f / 64.0f) + RW_LN_EPS);
    const size_t tok = tok0 + r32;
    const bf16* gp = (const bf16*)(ws + WS_GBUF) + tok * 256 + h * 64; unsigned char* od = (unsigned char*)(ws + WS_O) + tok * D + 512 + h * 64;
    const float* lnw = KIN(I_RWLNW) + l * 256 + h * 64; const float* lnb = KIN(I_RWLNB) + l * 256 + h * 64;
    f32x4 w4a[2][4], b4a[2][4]; u32x2 gwa[2][4];
#pragma unroll
    for (int vt = 0; vt < 2; ++vt)
#pragma unroll
        for (int g = 0; g < 4; ++g) { const int v0 = 32 * vt + 8 * g + 4 * hh; w4a[vt][g] = *(const f32x4*)(lnw + v0); b4a[vt][g] = *(const f32x4*)(lnb + v0); gwa[vt][g] = *(const u32x2*)(gp + v0); }
    __builtin_amdgcn_sched_barrier(0);
#pragma unroll
    for (int vt = 0; vt < 2; ++vt)
#pragma unroll
        for (int g = 0; g < 4; ++g) { const int v0 = 32 * vt + 8 * g + 4 * hh; const f32x4 w4 = w4a[vt][g], b4 = b4a[vt][g]; const u32x2 gw = gwa[vt][g];
            const float y0 = ((Y[vt][4 * g] - mu) * rstd * w4[0] + b4[0] + Z[vt][4 * g]) * bflo(gw.x), y1 = ((Y[vt][4 * g + 1] - mu) * rstd * w4[1] + b4[1] + Z[vt][4 * g + 1]) * bfhi(gw.x);
            const float y2 = ((Y[vt][4 * g + 2] - mu) * rstd * w4[2] + b4[2] + Z[vt][4 * g + 2]) * bflo(gw.y), y3 = ((Y[vt][4 * g + 3] - mu) * rstd * w4[3] + b4[3] + Z[vt][4 * g + 3]) * bfhi(gw.y);
            *(LAS unsigned*)(os + r32 * 64 + v0) = pack_o4(y0, y1, y2, y3); }
    flush_o_tile(os, (unsigned char*)(ws + WS_O) + tok0 * D + 512 + h * 64, lane);
}

__device__ __forceinline__ void c1_phase(LAS unsigned char* lds, int l, int vcu, int G) {
    for (int u = vcu, k = 0; u < NB * NCH; u += G, ++k) {
        const int b = (G == 256) ? (vcu >> 5) : (u >> 8), c = (G == 256) ? 255 - ((vcu & 31) + 32 * k) : (u & 255);
        for (int q = 0; q <= PHREP(16); ++q) rw_fused_unit(lds, l, b, c);
        for (int q = 0; q <= PHREP(17); ++q) hg_fused_unit(lds, l, b, c);
        for (int q = 0; q <= PHREP(18); ++q) gla_fused_unit(lds, l, b, c); }
}
__device__ __forceinline__ void m3_gh_phase(LAS unsigned char* lds, int l, int vcu, int G) {
    const int tid = opaque_tid(), lane = tid & 63, wave = __builtin_amdgcn_readfirstlane(tid >> 6);
    unsigned char* ws = KWS();
    const int gw = vcu * NWAVES + wave, NGW = G * NWAVES;
    const bf16* P = (const bf16*)(ws + WS_P); unsigned char* O = (unsigned char*)(ws + WS_O);
    const float* gng = KIN(I_GLANG) + l * 256; const float* hng = KIN(I_HGNG) + l * 256;
    for (int task = gw; task < 24576; task += NGW) {
        const int un = task & 8191, bh = un >> 8, c = un & 255, b = bh >> 2, h = bh & 3; const size_t tok0 = (size_t)b * T + c * 32;
        if (task >= 16384) { for (int q = 0; q <= PHREP(19); ++q) rw_m3_task(lane, l, bh, c, lds + wave * 2048); continue; }
        for (int q = 0; q <= PHREP(20); ++q)
        if (task < 8192) m3_gh_task<64>(lane, (const bf16*)(ws + WS_HQ) + (size_t)un * 2048, (const bf16*)(ws + WS_HK) + (size_t)un * 2048, (const bf16*)(ws + WS_HVT) + (size_t)un * 2048, (const bf16*)(ws + WS_HS) + (size_t)un * 4096,
                                         P + tok0 * PINP + PC_HG + h * 64, hng + h * 64, O + tok0 * D + 256 + h * 64, lds + wave * 2048);
        else m3_gh_task<32>(lane, (const bf16*)(ws + WS_GQ) + (size_t)un * 1024, (const bf16*)(ws + WS_GK) + (size_t)un * 1024, (const bf16*)(ws + WS_GVT) + (size_t)un * 2048, (const bf16*)(ws + WS_GS) + (size_t)un * 2048,
                            P + tok0 * PINP + PC_GOUT + h * 64, gng + h * 64, O + tok0 * D + h * 64, lds + wave * 2048);
    }
}

__device__ __forceinline__ void xattn_units(LAS unsigned char* lds, int l, int first, int last, int stride) {
    const int tid = opaque_tid(), lane = tid & 63, wave = __builtin_amdgcn_readfirstlane(tid >> 6), r32 = lane & 31, hh = lane >> 5;
    const bf16* P = (const bf16*)(KWS() + WS_P); const bf16* MKV = (const bf16*)(KWS() + WS_MKV); unsigned char* O = (unsigned char*)(KWS() + WS_O);
    LAS bf16* KL = (LAS bf16*)lds;
    LAS bf16* VT = (LAS bf16*)(lds + 256 * 72 * 2);
    int cur_bh = -1;
    for (int u = first; u < last; u += stride) {
        const int bh = u >> 5, qb = u & 31, b = bh >> 2, h = bh & 3;
        if (bh != cur_bh) {
            lds_barrier();
            for (int i = tid; i < 256 * 8; i += NTHR) { const int key = i >> 3, c8 = i & 7;
                const bf16* src = MKV + (size_t)(b * 256 + key) * 2048 + l * 512 + h * 64 + c8 * 8;
                *(LAS u32x4*)(KL + key * 72 + c8 * 8) = *(const u32x4*)src;
                const u32x4 vv = *(const u32x4*)(src + 256);
                LAS bf16* vd = VT + (c8 * 8) * 264 + key;
                vd[0 * 264] = (bf16)(vv.x & 0xffff); vd[1 * 264] = (bf16)(vv.x >> 16); vd[2 * 264] = (bf16)(vv.y & 0xffff); vd[3 * 264] = (bf16)(vv.y >> 16);
                vd[4 * 264] = (bf16)(vv.z & 0xffff); vd[5 * 264] = (bf16)(vv.z >> 16); vd[6 * 264] = (bf16)(vv.w & 0xffff); vd[7 * 264] = (bf16)(vv.w >> 16); }
            lds_barrier();
            cur_bh = bh;
        }
        const int q = b * T + qb * 256 + wave * 32 + r32;
        bf16x8 qf[4];
#pragma unroll
        for (int s = 0; s < 4; ++s) qf[s] = *(const bf16x8*)(P + (size_t)q * PINP + PC_MQ + h * 64 + 16 * s + 8 * hh);
        f32x16 sc[8];
#pragma unroll
        for (int kt = 0; kt < 8; ++kt) {
#pragma unroll
            for (int i = 0; i < 16; ++i) sc[kt][i] = 0.f;
#pragma unroll
            for (int s = 0; s < 4; ++s) { const bf16x8 kf = *(const LAS bf16x8*)(KL + (kt * 32 + r32) * 72 + 16 * s + 8 * hh);
                sc[kt] = __builtin_amdgcn_mfma_f32_32x32x16_bf16(kf, qf[s], sc[kt], 0, 0, 0); }
        }
        float m = -3.0e38f;
#pragma unroll
        for (int kt = 0; kt < 8; ++kt)
#pragma unroll
            for (int i = 0; i < 16; ++i) m = fmaxf(m, sc[kt][i]);
        m = fmaxf(m, __shfl_xor(m, 32));
        float sum = 0.f;
        const float c2 = 0.125f * 1.4426950408889634f;
#pragma unroll
        for (int kt = 0; kt < 8; ++kt)
#pragma unroll
            for (int i = 0; i < 16; ++i) { const float e = __builtin_amdgcn_exp2f((sc[kt][i] - m) * c2); sc[kt][i] = e; sum += e; }
        sum += __shfl_xor(sum, 32);
        const float inv = 1.0f / sum;
        f32x16 oa[2];
#pragma unroll
        for (int vt = 0; vt < 2; ++vt)
#pragma unroll
            for (int i = 0; i < 16; ++i) oa[vt][i] = 0.f;
#pragma unroll
        for (int kt = 0; kt < 8; ++kt)
#pragma unroll
            for (int s = 0; s < 2; ++s) {
                union { bf16x8 v; unsigned w[4]; } pf;
#pragma unroll
                for (int j = 0; j < 4; ++j) pf.w[j] = cvt_pk_bf16(sc[kt][8 * s + 2 * j], sc[kt][8 * s + 2 * j + 1]);
#pragma unroll
                for (int vt = 0; vt < 2; ++vt) {
                    const LAS bf16* vp = VT + (vt * 32 + r32) * 264 + kt * 32 + 16 * s + 4 * hh;
                    union { bf16x8 v; s16x4 h2[2]; } vf; vf.h2[0] = *(const LAS s16x4*)vp; vf.h2[1] = *(const LAS s16x4*)(vp + 8);
                    oa[vt] = __builtin_amdgcn_mfma_f32_32x32x16_bf16(vf.v, pf.v, oa[vt], 0, 0, 0); }
            }
        unsigned char* orow = O + (size_t)q * D + 768 + h * 64;
#pragma unroll
        for (int vt = 0; vt < 2; ++vt)
#pragma unroll
            for (int g = 0; g < 4; ++g) store_o4(orow + vt * 32 + 8 * g + 4 * hh, oa[vt][4 * g] * inv, oa[vt][4 * g + 1] * inv, oa[vt][4 * g + 2] * inv, oa[vt][4 * g + 3] * inv);
    }
    lds_barrier();
}

__device__ __forceinline__ void m2_phase(LAS unsigned char* lds, int l, int bx, int G) {
    unsigned char* ws = KWS();
    const int tid = opaque_tid(), lane = tid & 63, wave = __builtin_amdgcn_readfirstlane(tid >> 6);
    const int nrw = (G >= 128) ? 64 : 0;
    if (nrw) { if (bx < nrw && wave == 0) for (int q = 0; q <= PHREP(22); ++q) rw_m2_wave(lane, bx >> 1, bx & 1); }
    else { if (wave == 0) for (int q = bx; q < 64; q += G) rw_m2_wave(lane, q >> 1, q & 1); }
    if (nrw && bx >= nrw) {
        const int nth = (G - nrw) * NTHR;
        const int gt = (bx - nrw) * NTHR + tid;
        for (int q = 0; q <= PHREP(23); ++q)
        for (int e = gt; e < 98304; e += nth) {
            if (e < 65536) m2_gh_elem2<64>(e, (const bf16*)(ws + WS_HDS), (const float*)(ws + WS_HBE), (bf16*)(ws + WS_HS));
            else m2_gh_elem2<32>(e - 65536, (const bf16*)(ws + WS_GDS), (const float*)(ws + WS_GBE), (bf16*)(ws + WS_GS)); }
    }
    if (nrw == 0) { __syncthreads(); for (int e = bx * NTHR + tid; e < 98304; e += G * NTHR) {
            if (e < 65536) m2_gh_elem2<64>(e, (const bf16*)(ws + WS_HDS), (const float*)(ws + WS_HBE), (bf16*)(ws + WS_HS));
            else m2_gh_elem2<32>(e - 65536, (const bf16*)(ws + WS_GDS), (const float*)(ws + WS_GBE), (bf16*)(ws + WS_GS)); } }
    if (nrw == 0 || bx >= nrw) {
        const int nb = G - nrw, r = bx - nrw;
        const int per = (1024 + nb - 1) / nb, lo = r * per, hi = (lo + per < 1024) ? lo + per : 1024;
        for (int q = 0; q <= PHREP(24); ++q) xattn_units(lds, l, lo, hi, 1);
    }
}

__device__ __forceinline__ void ln1_router_phase(LAS unsigned char* lds, int l, int bx, int G) {
    const int tid = opaque_tid(), lane = tid & 63, wave = __builtin_amdgcn_readfirstlane(tid >> 6);
    LAS float* X = (LAS float*)lds;
    LAS float* PART = (LAS float*)(lds + 16 * 1028 * 4);
    LAS int* HIST = (LAS int*)(lds + 16 * 1028 * 4 + 8 * 16 * 32 * 4);
    LAS f32x4* GB = (LAS f32x4*)(lds + 16 * 1028 * 4 + 8 * 16 * 32 * 4 + 256);
    const float* xin = KIN(I_X); const bf16* xinb = (const bf16*)(KWS() + WS_XB);
    const bf16* HM = (const bf16*)(KWS() + WS_HMIX);
    bf16* X1B = (bf16*)(KWS() + WS_X1B); unsigned char* X1Q = (unsigned char*)(KWS() + WS_XF);
    const float* g1 = KIN(I_LN1G) + l * D; const float* b1 = KIN(I_LN1B) + l * D;
    const float* rw = KIN(I_RTW) + (size_t)l * D * NE; const float* rb = KIN(I_RTB) + l * NE;
    int* tok_e = (int*)(KWS() + WS_ROUTE); float* tok_g = (float*)(KWS() + WS_ROUTE + 1 * MiB);
    if (tid < 32) HIST[tid] = 0;
    if (tid < 256) { GB[tid] = ((const f32x4*)g1)[tid]; GB[256 + tid] = ((const f32x4*)b1)[tid]; }
    const float rbe = rb[tid & 31];
    bf16x8 rwH[4][2], rwL[4][2];
    { const int q = lane >> 4, e = lane & 15;
#pragma unroll
      for (int s = 0; s < 4; ++s)
#pragma unroll
          for (int nt = 0; nt < 2; ++nt) { union { bf16x8 v; unsigned w[4]; } fh, fl;
#pragma unroll
              for (int j = 0; j < 4; ++j) { const float* p = rw + (size_t)(128 * wave + 32 * s + 8 * q + 2 * j) * NE + 16 * nt + e; const float v0 = p[0], v1 = p[NE];
                  const unsigned h = cvt_pk_bf16(v0, v1); fh.w[j] = h; fl.w[j] = cvt_pk_bf16(v0 - bflo(h), v1 - bfhi(h)); }
              rwH[s][nt] = fh.v; rwL[s][nt] = fl.v; } }
    lds_barrier();
    f32x4 xraw[2][4]; u32x2 xbraw[2][4], hraw[2][4];
#define LN1_LOAD(it_) do { const size_t _tok = (size_t)(it_) * 16 + wave * 2; const u32x2* _hr = (const u32x2*)(HM + _tok * D) + lane; \
        if (l == 0) { const f32x4* _xr = (const f32x4*)(xin + _tok * D) + lane;        \
            _Pragma("unroll") for (int tt = 0; tt < 2; ++tt) _Pragma("unroll") for (int j = 0; j < 4; ++j) xraw[tt][j] = _xr[tt * 256 + 64 * j]; } \
        else { const u32x2* _xbr = (const u32x2*)(xinb + _tok * D) + lane; \
            _Pragma("unroll") for (int tt = 0; tt < 2; ++tt) _Pragma("unroll") for (int j = 0; j < 4; ++j) xbraw[tt][j] = _xbr[tt * 256 + 64 * j]; } \
        _Pragma("unroll") for (int tt = 0; tt < 2; ++tt) _Pragma("unroll") for (int j = 0; j < 4; ++j) hraw[tt][j] = _hr[tt * 256 + 64 * j]; } while (0)
    if (bx < NTOK / 16) LN1_LOAD(bx);
    for (int it = bx; it < NTOK / 16; it += G) {
        f32x4 vv[2][4];
#pragma unroll
        for (int tt = 0; tt < 2; ++tt)
#pragma unroll
            for (int j = 0; j < 4; ++j) { f32x4 xv; if (l == 0) xv = xraw[tt][j]; else { const u32x2 xw = xbraw[tt][j]; xv = (f32x4){bflo(xw.x), bfhi(xw.x), bflo(xw.y), bfhi(xw.y)}; } const u32x2 hw = hraw[tt][j];
                vv[tt][j][0] = DN_ALPHA * xv[0] + bflo(hw.x); vv[tt][j][1] = DN_ALPHA * xv[1] + bfhi(hw.x); vv[tt][j][2] = DN_ALPHA * xv[2] + bflo(hw.y); vv[tt][j][3] = DN_ALPHA * xv[3] + bfhi(hw.y); }
        if (it + G < NTOK / 16) LN1_LOAD(it + G);
#pragma unroll
        for (int tt = 0; tt < 2; ++tt) { const int ti = wave * 2 + tt; const size_t tok = (size_t)it * 16 + ti;
            f32x4 v[4]; float s = 0.f;
#pragma unroll
            for (int j = 0; j < 4; ++j) { v[j] = vv[tt][j]; s += (v[j][0] + v[j][1]) + (v[j][2] + v[j][3]); }
            const float mean = wave_sum(s) * (1.0f / D); float s2 = 0.f;
#pragma unroll
            for (int j = 0; j < 4; ++j) { v[j] = v[j] - mean; s2 += (v[j][0] * v[j][0] + v[j][1] * v[j][1]) + (v[j][2] * v[j][2] + v[j][3] * v[j][3]); }
            const float rstd = 1.0f / sqrtf(wave_sum(s2) * (1.0f / D) + LN_EPS);
#pragma unroll
            for (int j = 0; j < 4; ++j) { const f32x4 gg = GB[lane + 64 * j], bb = GB[256 + lane + 64 * j];
                const f32x4 y = v[j] * rstd * gg + bb;
                *((u32x2*)(X1B + tok * D) + lane + 64 * j) = (u32x2){pk2(y[0], y[1]), pk2(y[2], y[3])};
                { int w = __builtin_amdgcn_cvt_pk_fp8_f32(y[0], y[1], 0, false); w = __builtin_amdgcn_cvt_pk_fp8_f32(y[2], y[3], w, true); *((unsigned*)(X1Q + tok * D) + lane + 64 * j) = (unsigned)w; }
                *(LAS f32x4*)(X + ti * 1028 + 4 * lane + 256 * j) = y; }
        }
        lds_barrier();
        {
            const int q = lane >> 4, r = lane & 15;
            f32x4 acc0 = (f32x4){0.f, 0.f, 0.f, 0.f}, acc1 = (f32x4){0.f, 0.f, 0.f, 0.f};
            const LAS float* xa = X + r * 1028 + 128 * wave + 8 * q;
#pragma unroll
            for (int s = 0; s < 4; ++s) { const f32x4 x0 = *(const LAS f32x4*)(xa + 32 * s), x1 = *(const LAS f32x4*)(xa + 32 * s + 4);
                union { bf16x8 v; unsigned w[4]; } ah, al;
                ah.w[0] = cvt_pk_bf16(x0[0], x0[1]); ah.w[1] = cvt_pk_bf16(x0[2], x0[3]); ah.w[2] = cvt_pk_bf16(x1[0], x1[1]); ah.w[3] = cvt_pk_bf16(x1[2], x1[3]);
                al.w[0] = cvt_pk_bf16(x0[0] - bflo(ah.w[0]), x0[1] - bfhi(ah.w[0])); al.w[1] = cvt_pk_bf16(x0[2] - bflo(ah.w[1]), x0[3] - bfhi(ah.w[1]));
                al.w[2] = cvt_pk_bf16(x1[0] - bflo(ah.w[2]), x1[1] - bfhi(ah.w[2])); al.w[3] = cvt_pk_bf16(x1[2] - bflo(ah.w[3]), x1[3] - bfhi(ah.w[3]));
                acc0 = __builtin_amdgcn_mfma_f32_16x16x32_bf16(ah.v, rwH[s][0], acc0, 0, 0, 0); acc1 = __builtin_amdgcn_mfma_f32_16x16x32_bf16(ah.v, rwH[s][1], acc1, 0, 0, 0);
                acc0 = __builtin_amdgcn_mfma_f32_16x16x32_bf16(ah.v, rwL[s][0], acc0, 0, 0, 0); acc1 = __builtin_amdgcn_mfma_f32_16x16x32_bf16(ah.v, rwL[s][1], acc1, 0, 0, 0);
                acc0 = __builtin_amdgcn_mfma_f32_16x16x32_bf16(al.v, rwH[s][0], acc0, 0, 0, 0); acc1 = __builtin_amdgcn_mfma_f32_16x16x32_bf16(al.v, rwH[s][1], acc1, 0, 0, 0); }
#pragma unroll
            for (int i = 0; i < 4; ++i) { PART[(wave * 16 + 4 * q + i) * 32 + r] = acc0[i]; PART[(wave * 16 + 4 * q + i) * 32 + 16 + r] = acc1[i]; }
        }
        lds_barrier();
        {
            const int ti = tid >> 5, e = tid & 31;
            float lg = rbe;
#pragma unroll
            for (int w = 0; w < 8; ++w) lg += PART[(w * 16 + ti) * 32 + e];
            float tv[4]; int te[4]; float cur = lg;
#pragma unroll
            for (int k = 0; k < 4; ++k) { float bv = cur; int bi = e;
#pragma unroll
                for (int st = 0; st < 5; ++st) { float ov; int oi;
                    const int bvi = __builtin_bit_cast(int, bv);
                    if (st == 0) { ov = __builtin_bit_cast(float, __builtin_amdgcn_update_dpp(bvi, bvi, 0xB1, 0xf, 0xf, false)); oi = __builtin_amdgcn_update_dpp(bi, bi, 0xB1, 0xf, 0xf, false); }
                    else if (st == 1) { ov = __builtin_bit_cast(float, __builtin_amdgcn_update_dpp(bvi, bvi, 0x4E, 0xf, 0xf, false)); oi = __builtin_amdgcn_update_dpp(bi, bi, 0x4E, 0xf, 0xf, false); }
                    else if (st == 2) { ov = __builtin_bit_cast(float, __builtin_amdgcn_update_dpp(bvi, bvi, 0x141, 0xf, 0xf, false)); oi = __builtin_amdgcn_update_dpp(bi, bi, 0x141, 0xf, 0xf, false); }
                    else if (st == 3) { ov = __builtin_bit_cast(float, __builtin_amdgcn_update_dpp(bvi, bvi, 0x140, 0xf, 0xf, false)); oi = __builtin_amdgcn_update_dpp(bi, bi, 0x140, 0xf, 0xf, false); }
                    else { ov = __shfl_xor(bv, 16); oi = __shfl_xor(bi, 16); }
                    if (ov > bv || (ov == bv && oi < bi)) { bv = ov; bi = oi; } }
                tv[k] = bv; te[k] = bi; if (e == bi) cur = -3.0e38f; }
            const float e1 = __expf(tv[1] - tv[0]), e2 = __expf(tv[2] - tv[0]), e3 = __expf(tv[3] - tv[0]); const float inv = 1.0f / (1.0f + e1 + e2 + e3);
            const size_t tok = (size_t)it * 16 + ti;
            if (e < 4) { const int ek = e == 0 ? te[0] : e == 1 ? te[1] : e == 2 ? te[2] : te[3]; const float gk = (e == 0 ? 1.0f : e == 1 ? e1 : e == 2 ? e2 : e3) * inv;
                tok_e[tok * 4 + e] = ek; tok_g[tok * 4 + e] = gk; __hip_atomic_fetch_add(&HIST[ek], 1, __ATOMIC_RELAXED, __HIP_MEMORY_SCOPE_WORKGROUP); }
        }
    }
#undef LN1_LOAD
    lds_barrier();
    if (tid < 32) ((int*)(KWS() + WS_CTL))[CW_HIST + bx * 32 + tid] = HIST[tid];
}

__device__ __forceinline__ void slots_phase(LAS unsigned char* lds, int bx, int G) {
    const int tid = opaque_tid();
    int* ctl = (int*)(KWS() + WS_CTL);
    LAS int* RED = (LAS int*)lds;
    LAS int* TOT = RED + 1024;
    const int* tok_e = (const int*)(KWS() + WS_ROUTE); const float* tok_g = (const float*)(KWS() + WS_ROUTE + 1 * MiB);
    int* tok_slot = (int*)(KWS() + WS_ROUTE + 2 * MiB); int* slot_tok = (int*)(KWS() + WS_ROUTE + 3 * MiB);
    { const int e = tid & 31, part = tid >> 5; int tot = 0, pre = 0;
      for (int b2 = part; b2 < G; b2 += 16) { const int h = ctl[CW_HIST + b2 * 32 + e]; tot += h; if (b2 < bx) pre += h; }
      RED[(part * 32 + e) * 2] = tot; RED[(part * 32 + e) * 2 + 1] = pre; }
    __syncthreads();
    if (tid < 32) { int tot = 0, pre = 0; for (int p = 0; p < 16; ++p) { tot += RED[(p * 32 + tid) * 2]; pre += RED[(p * 32 + tid) * 2 + 1]; } TOT[tid] = tot; TOT[32 + tid] = pre; TOT[96 + tid] = 0; }
    __syncthreads();
    if (tid == 0) { int ps = 0;
#pragma unroll 1
        for (int e = 0; e < 32; ++e) { TOT[64 + e] = ps; ps += (TOT[e] + 255) & ~255; }
        TOT[128] = ps >> 8; if (bx == 0) ctl[CW_NT] = ps >> 8; }
    __syncthreads();
    if (bx == 0) { const int nt = TOT[128];
        for (int t = tid; t < nt; t += NTHR) { int e = 0;
#pragma unroll 1
            for (int k = 1; k < 32; ++k) if (TOT[64 + k] <= t * 256) e = k;
            ctl[CW_TILEE + t] = e; } }
    for (int e = bx; e < 32; e += G) { const int s0 = TOT[64 + e] + TOT[e], s1 = TOT[64 + e] + ((TOT[e] + 255) & ~255); for (int s = s0 + tid; s < s1; s += NTHR) slot_tok[s] = 0; }
    for (int it = bx + G * (tid >> 6); it < NTOK / 16; it += G * 8) {
        const int asg = it * 64 + (tid & 63); const int e = tok_e[asg]; const int rank = __hip_atomic_fetch_add(&TOT[96 + e], 1, __ATOMIC_RELAXED, __HIP_MEMORY_SCOPE_WORKGROUP); const int slot = TOT[64 + e] + TOT[32 + e] + rank;
        tok_slot[asg] = slot; slot_tok[slot] = asg >> 2;
    }
}

__device__ __forceinline__ void combine_phase(int l, int vcu, int G) {
    const int tid = opaque_tid(), lane = tid & 63, wave = __builtin_amdgcn_readfirstlane(tid >> 6);
    const int gw = vcu * NWAVES + wave, NGW = G * NWAVES;
    const bf16* X1B = (const bf16*)(KWS() + WS_X1B); const unsigned char* YB = (const unsigned char*)(KWS() + WS_YB); const int* tok_slot = (const int*)(KWS() + WS_ROUTE + 2 * MiB); const float* tok_gate = (const float*)(KWS() + WS_ROUTE + 1 * MiB);
    float* xo = KOUT(); bf16* XB = (bf16*)(KWS() + WS_XB); unsigned char* X8 = (unsigned char*)(KWS() + WS_X8);
    const float* g2 = KIN(I_LN2G) + l * D; const float* b2 = KIN(I_LN2B) + l * D;
    unsigned wg[128];
    { const unsigned* Wg = (const unsigned*)(KWS() + WS_GLRW) + (size_t)(l + 1 < NL ? l + 1 : l) * 8192 + lane;
#pragma unroll
      for (int i = 0; i < 128; ++i) wg[i] = Wg[i * 64]; }
    bf16* PG = (bf16*)(KWS() + WS_P) + PC_GLR + ((lane >> 2) & 15);
    u32x2 xw[4]; unsigned ya[4][4]; int ns0 = 0, ns1 = 0, ns2 = 0, ns3 = 0; f32x4 gv = {0.f, 0.f, 0.f, 0.f};
#define CMB_SLOTS(t_) do { const int4 _s = *(const int4*)(tok_slot + (size_t)(t_) * 4); ns0 = _s.x; ns1 = _s.y; ns2 = _s.z; ns3 = _s.w; } while (0)
#define CMB_ROWS(t_) do { const u32x2* _xr = (const u32x2*)(X1B + (size_t)(t_) * D) + lane; gv = *(const f32x4*)(tok_gate + (size_t)(t_) * 4); \
        const unsigned* _y0 = (const unsigned*)(YB + (size_t)ns0 * D) + lane; const unsigned* _y1 = (const unsigned*)(YB + (size_t)ns1 * D) + lane; \
        const unsigned* _y2 = (const unsigned*)(YB + (size_t)ns2 * D) + lane; const unsigned* _y3 = (const unsigned*)(YB + (size_t)ns3 * D) + lane; \
        _Pragma("unroll") for (int j = 0; j < 4; ++j) { xw[j] = _xr[64 * j]; ya[0][j] = _y0[64 * j]; ya[1][j] = _y1[64 * j]; ya[2][j] = _y2[64 * j]; ya[3][j] = _y3[64 * j]; } } while (0)
    if (gw < NTOK) { CMB_SLOTS(gw); CMB_ROWS(gw); if (gw + NGW < NTOK) CMB_SLOTS(gw + NGW); }
    for (int tok = gw; tok < NTOK; tok += NGW) {
        f32x4 v[4]; float s = 0.f; const f32x4 gs = gv * 0.0625f;
#pragma unroll
        for (int j = 0; j < 4; ++j) { const f32x4 xv = {bflo(xw[j].x), bfhi(xw[j].x), bflo(xw[j].y), bfhi(xw[j].y)};
            f32x2 lo = __builtin_amdgcn_cvt_pk_f32_fp8(ya[0][j], false) * gs[0], hi = __builtin_amdgcn_cvt_pk_f32_fp8(ya[0][j], true) * gs[0];
#pragma unroll
            for (int k = 1; k < 4; ++k) { lo += __builtin_amdgcn_cvt_pk_f32_fp8(ya[k][j], false) * gs[k]; hi += __builtin_amdgcn_cvt_pk_f32_fp8(ya[k][j], true) * gs[k]; }
            v[j][0] = DN_ALPHA * xv[0] + lo[0]; v[j][1] = DN_ALPHA * xv[1] + lo[1]; v[j][2] = DN_ALPHA * xv[2] + hi[0]; v[j][3] = DN_ALPHA * xv[3] + hi[1];
            s += (v[j][0] + v[j][1]) + (v[j][2] + v[j][3]); }
        if (tok + NGW < NTOK) { CMB_ROWS(tok + NGW); if (tok + 2 * NGW < NTOK) CMB_SLOTS(tok + 2 * NGW); }
        const float mean = wave_sum(s) * (1.0f / D); float q = 0.f;
#pragma unroll
        for (int j = 0; j < 4; ++j) { v[j] = v[j] - mean; q += (v[j][0] * v[j][0] + v[j][1] * v[j][1]) + (v[j][2] * v[j][2] + v[j][3] * v[j][3]); }
        const float rstd = 1.0f / sqrtf(wave_sum(q) * (1.0f / D) + LN_EPS);
        float ga[16];
#pragma unroll
        for (int c = 0; c < 16; ++c) ga[c] = 0.f;
#pragma unroll
        for (int j = 0; j < 4; ++j) { const f32x4 gg = *((const f32x4*)g2 + lane + 64 * j), bb = *((const f32x4*)b2 + lane + 64 * j);
            const f32x4 y = v[j] * rstd * gg + bb;
            if (l == NL - 1) *((f32x4*)(xo + (size_t)tok * D) + lane + 64 * j) = y;
            else { const unsigned p0 = pk2(y[0], y[1]), p1 = pk2(y[2], y[3]); *((u32x2*)(XB + (size_t)tok * D) + lane + 64 * j) = (u32x2){p0, p1};
                store_o4(X8 + (size_t)tok * D + 4 * (lane + 64 * j), y[0], y[1], y[2], y[3]);
#pragma unroll
                for (int c = 0; c < 16; ++c) { ga[c] = __builtin_amdgcn_fdot2_f32_bf16(__builtin_bit_cast(bf16x2_t, p0), __builtin_bit_cast(bf16x2_t, wg[(2 * j) * 16 + c]), ga[c], false);
                                               ga[c] = __builtin_amdgcn_fdot2_f32_bf16(__builtin_bit_cast(bf16x2_t, p1), __builtin_bit_cast(bf16x2_t, wg[(2 * j + 1) * 16 + c]), ga[c], false); } } }
        if (l != NL - 1) {
            const bool h5 = (lane & 32) != 0, h4 = (lane & 16) != 0, h3 = (lane & 8) != 0, h2 = (lane & 4) != 0;
            float r8[8], r4[4], r2[2];
#pragma unroll
            for (int i = 0; i < 8; ++i) { const float keep = h5 ? ga[8 + i] : ga[i], send = h5 ? ga[i] : ga[8 + i]; r8[i] = keep + __shfl_xor(send, 32); }
#pragma unroll
            for (int i = 0; i < 4; ++i) { const float keep = h4 ? r8[4 + i] : r8[i], send = h4 ? r8[i] : r8[4 + i]; r4[i] = keep + __shfl_xor(send, 16); }
#pragma unroll
            for (int i = 0; i < 2; ++i) { const float keep = h3 ? r4[2 + i] : r4[i], send = h3 ? r4[i] : r4[2 + i]; r2[i] = keep + __shfl_xor(send, 8); }
            const float keep = h2 ? r2[1] : r2[0], send = h2 ? r2[0] : r2[1];
            float r1 = keep + __shfl_xor(send, 4);
            r1 = dpp_add(r1, 0); r1 = dpp_add(r1, 1);
            if ((lane & 3) == 0) PG[(size_t)tok * PINP] = (bf16)f2bf(r1);
        }
    }
#undef CMB_SLOTS
#undef CMB_ROWS
}


constexpr int PH_PER_LAYER = 10, NPHASES = 2 + NL * PH_PER_LAYER;
__global__ void __launch_bounds__(NTHR, 2) trunk_fwd(Args args) {
    extern __shared__ __attribute__((aligned(16))) unsigned char lds_raw[];
    LAS unsigned char* lds = (LAS unsigned char*)lds_raw;
    volatile LAS unsigned* MISC = (volatile LAS unsigned*)(lds + MISC_OFF);
    const int tid = threadIdx.x;
    const int G = gridDim.x, bx = blockIdx.x;
    const int vcu = (G % 8 == 0) ? (bx % 8) * (G / 8) + bx / 8 : bx;
    unsigned char* ws = KWS();
    unsigned* ctl = (unsigned*)(ws + WS_CTL);
    for (int u = tid; u < (LDS_BYTES - LDSCTL_OFF) / 4; u += NTHR) ((LAS unsigned*)(lds + LDSCTL_OFF))[u] = 0u;
    __syncthreads();
    XcdBarrier bar; bar.bar = ctl + CW_BAR; bar.x = 0; bar.st = nullptr;
#if !MK_PER_PHASE
    bar = xcd_barrier_post(ctl + CW_BAR, MISC + 8);
#define GRID_BAR() xcd_barrier(bar)
#else
#define GRID_BAR() do { } while (0)
#endif
    const int lo = (int)(unsigned)ka_u64<280>(), hi = (int)(unsigned)(ka_u64<280>() >> 32);
#ifndef PH_MASK
#define PH_MASK 0x1FFF
#endif
#define PHEN(n) (((PH_MASK) >> (n)) & 1)
#define IN(k) (lo <= (k) && (k) < hi)
#define SEAM(k) do { if (rep > 0 || IN((k) + 1)) { GRID_BAR(); if (PHREP(21)) GRID_BAR(); } } while (0)

#define OG opaque_s(G)
#define OBX opaque_s(bx)
#define OVCU opaque_s(vcu)
#define OL opaque_s(l)
    if (PHEN(0) && IN(0)) for (int rep = PHREP(0); rep >= 0; --rep) { prologue_phase(lds, OVCU, OG); SEAM(0); }
    if (PHEN(1) && IN(1)) for (int rep = PHREP(1); rep >= 0; --rep) {
        pg8::DenseOrder S; S.init(KWS() + WS_MEMB, KWS() + WS_WMEM, NB * NMEM, 2048, D, OG, OBX);
        pg8::EpiBf16 E{(bf16*)(KWS() + WS_MKV), 2048};
        pg8::gemm_phase<pg8::EpiBf16, pg8::DenseOrder>(lds, D, S, E);
        SEAM(1);
    }
    for (int l = 0; l < NL; ++l) {
        const int p0 = 2 + l * PH_PER_LAYER;
        if (PHEN(2) && IN(p0 + 0)) for (int rep = PHREP(2); rep >= 0; --rep) {
            pg8::DenseOrder S; S.init(KWS() + WS_X8, KWS() + WS_WIN + (size_t)OL * PINP * D, NTOK, l == 0 ? PINP : PINP - 256, D / 2, OG, OBX);
            pg8::EpiBf16T<123, 125> E{(bf16*)(KWS() + WS_P), PINP};
            pg8::gemm_phase<pg8::EpiBf16T<123, 125>, pg8::DenseOrder, 1>(lds, D, S, E);
            SEAM(p0 + 0);
        }
        if (PHEN(4) && IN(p0 + 1)) for (int rep = PHREP(4); rep >= 0; --rep) { c1_phase(lds, OL, OVCU, OG); SEAM(p0 + 1); }
        if (PHEN(5) && IN(p0 + 2)) for (int rep = PHREP(5); rep >= 0; --rep) { m2_phase(lds, OL, OBX, OG); SEAM(p0 + 2); }
        if (PHEN(6) && IN(p0 + 3)) for (int rep = PHREP(6); rep >= 0; --rep) { m3_gh_phase(lds, OL, OVCU, OG); SEAM(p0 + 3); }
        if (PHEN(7) && IN(p0 + 4)) for (int rep = PHREP(7); rep >= 0; --rep) {
            pg8::DenseOrder S; S.init(KWS() + WS_O, KWS() + WS_WOUT + (size_t)OL * D * D, NTOK, D, D / 2, OG, OBX);
            pg8::EpiBf16T<122, 125> E{(bf16*)(KWS() + WS_HMIX), D};
            pg8::gemm_phase<pg8::EpiBf16T<122, 125>, pg8::DenseOrder, 1>(lds, D, S, E);
            SEAM(p0 + 4);
        }
        if (PHEN(8) && IN(p0 + 5)) for (int rep = PHREP(8); rep >= 0; --rep) { ln1_router_phase(lds, OL, OBX, OG); SEAM(p0 + 5); }
        if (PHEN(9) && IN(p0 + 6)) for (int rep = PHREP(9); rep >= 0; --rep) { slots_phase(lds, OBX, OG); SEAM(p0 + 6); }
        if (PHEN(10) && IN(p0 + 7)) for (int rep = PHREP(10); rep >= 0; --rep) {
            const int ntiles = __builtin_amdgcn_readfirstlane(((const int*)(KWS() + WS_CTL))[CW_NT]);
            pg8::MoeOrder<true> S; S.init(KWS() + WS_XF, KWS() + WS_WGU + (size_t)OL * NE * 2048 * D, (const int*)(KWS() + WS_CTL) + CW_TILEE, (const int*)(KWS() + WS_ROUTE + 3 * MiB), ntiles, 2048, D, OG, OBX);
            pg8::EpiSwiglu E{(unsigned char*)(KWS() + WS_HB), (const float*)(KWS() + WS_BGU) + (size_t)OL * NE * 2048};
            pg8::gemm_phase<pg8::EpiSwiglu, pg8::MoeOrder<true>, 1>(lds, D, S, E);
            SEAM(p0 + 7);
        }
        if (PHEN(11) && IN(p0 + 8)) for (int rep = PHREP(11); rep >= 0; --rep) {
            const int ntiles = __builtin_amdgcn_readfirstlane(((const int*)(KWS() + WS_CTL))[CW_NT]);
            pg8::MoeOrder<false> S; S.init(KWS() + WS_HB, KWS() + WS_WD + (size_t)OL * NE * D * FF, (const int*)(KWS() + WS_CTL) + CW_TILEE, (const int*)(KWS() + WS_ROUTE + 3 * MiB), ntiles, D, FF, OG, OBX);
            pg8::EpiDown E{(unsigned char*)(KWS() + WS_YB), KIN(I_BDN) + (size_t)OL * NE * D};
            pg8::gemm_phase<pg8::EpiDown, pg8::MoeOrder<false>, 1>(lds, FF, S, E);
            SEAM(p0 + 8);
        }
        if (PHEN(12) && IN(p0 + 9)) for (int rep = PHREP(12); rep >= 0; --rep) { combine_phase(OL, OVCU, OG); if (rep > 0 || l + 1 < NL) SEAM(p0 + 9); }
    }
#undef IN
#undef SEAM
}

extern "C" void kernel_launch(void* const* d_in, const int* in_sizes, int n_in, void* d_out, int out_size, void* d_ws, size_t ws_size, hipStream_t stream) {
    static int grid = 0;
    if (grid == 0) {
        if (n_in != 33 || ws_size < WS_END) { fprintf(stderr, "kernel_launch: unexpected inputs (n_in %d, ws %zu need %zu)\n", n_in, ws_size, (size_t)WS_END); grid = -1; return; }
        int dev = 0, cus = 0;
        if (hipGetDevice(&dev) != hipSuccess || hipDeviceGetAttribute(&cus, hipDeviceAttributeMultiprocessorCount, dev) != hipSuccess) { grid = -1; return; }
        if (hipFuncSetAttribute((const void*)trunk_fwd, hipFuncAttributeMaxDynamicSharedMemorySize, LDS_BYTES) != hipSuccess) { grid = -1; return; }
        int per_cu = 0; (void)hipOccupancyMaxActiveBlocksPerMultiprocessor(&per_cu, (const void*)trunk_fwd, NTHR, LDS_BYTES); (void)hipGetLastError();
        grid = cus;
    }
    if (grid < 0) return;
    (void)hipMemsetAsync((char*)d_ws + WS_CTL, 0, CTL_ZERO_BYTES, stream);
    Args a{};
    for (int i = 0; i < 33; ++i) a.in[i] = (const float*)d_in[i];
    a.out = (float*)d_out; a.ws = (unsigned char*)d_ws;
#if MK_PER_PHASE
    for (int p = 0; p < NPHASES; ++p) { a.ph_lo = p; a.ph_hi = p + 1; hipLaunchKernelGGL(trunk_fwd, dim3(grid), dim3(NTHR), LDS_BYTES, stream, a); }
#else
    a.ph_lo = 0; a.ph_hi = NPHASES;
    hipLaunchKernelGGL(trunk_fwd, dim3(grid), dim3(NTHR), LDS_BYTES, stream, a);
#endif
}
```

```cpp
#include <hip/hip_runtime.h>
#include <cstdio>
#include <cstdint>

#ifndef MK_PER_PHASE
#define MK_PER_PHASE 0
#endif

#ifndef REP_MASK
#define REP_MASK 0
#endif
#define PHREP(n) (((REP_MASK) >> (n)) & 1)
#define LAS __attribute__((address_space(3)))
#define GAS __attribute__((address_space(1)))
typedef unsigned short bf16;
typedef short bf16x8 __attribute__((ext_vector_type(8)));
typedef short s16x4 __attribute__((ext_vector_type(4)));
typedef float f32x4 __attribute__((ext_vector_type(4)));
typedef float f32x2 __attribute__((ext_vector_type(2)));
typedef float f32x16 __attribute__((ext_vector_type(16)));
typedef unsigned u32x4 __attribute__((ext_vector_type(4)));
typedef unsigned u32x2 __attribute__((ext_vector_type(2)));

constexpr int NB = 8, T = 8192, D = 1024, NL = 4, NTOK = NB * T;
constexpr int PIN = 3088, PINP = 3328;
constexpr int NE = 32, FF = 1024, NMEM = 256;
constexpr int NASSIGN = NTOK * 4;
constexpr int MAXTILES = NASSIGN / 256 + NE;
constexpr int MAXSLOTS = MAXTILES * 256;
constexpr int PC_GQ = 0, PC_GK = 128, PC_GV = 256, PC_GOUT = 512, PC_HQ = 768, PC_HF = 1024, PC_HI = 1280, PC_HG = 1536;
constexpr int PC_RW = 1792, PC_MQ = 2816, PC_GLR = 3072;
constexpr float DN_ALPHA = 1.6817928305074292f;
constexpr float LN_EPS = 1e-5f, RMS_EPS = 1e-6f, RW_LN_EPS = 64e-5f;

constexpr size_t MiB = 1u << 20;
constexpr size_t WS_CTL = 0, CTL_ZERO_BYTES = 32768;
constexpr size_t WS_WIN = 1 * MiB;
constexpr size_t WS_WOUT = WS_WIN + 26 * MiB;
constexpr size_t WS_WMEM = WS_WOUT + 8 * MiB;
constexpr size_t WS_WGU = WS_WMEM + 4 * MiB;
constexpr size_t WS_WD = WS_WGU + 512 * MiB;
constexpr size_t WS_BGU = WS_WD + 256 * MiB;
constexpr size_t WS_LORA = WS_BGU + 1 * MiB;
constexpr size_t WS_GLRW = WS_LORA + 512 * 1024;
constexpr size_t WS_MEMB = WS_LORA + 1 * MiB;
constexpr size_t WS_MKV = WS_MEMB + 4 * MiB;
constexpr size_t WS_XB = WS_MKV + 8 * MiB;
constexpr size_t WS_X1B = WS_XB + 128 * MiB;
constexpr size_t WS_XF = WS_X1B + 128 * MiB;
constexpr size_t WS_X1F = WS_XF + 256 * MiB;
constexpr size_t WS_X8 = WS_X1F;
constexpr size_t WS_O = WS_X1F + 256 * MiB;
constexpr size_t WS_HMIX = WS_O + 128 * MiB;
constexpr size_t WS_ROUTE = WS_HMIX + 128 * MiB;
constexpr size_t WS_GBUF = WS_ROUTE + 6 * MiB;
constexpr size_t WS_BONUS = WS_GBUF + 32 * MiB;
constexpr size_t WS_BIG = WS_BONUS + 1 * MiB;
constexpr size_t WS_P = WS_BIG;
constexpr size_t WS_ORAW = WS_P + 416 * MiB;
constexpr size_t WS_HB = WS_BIG;
constexpr size_t WS_YB = WS_HB + 528 * MiB;
constexpr size_t WS_CHK = WS_ORAW;
constexpr size_t WS_HQ = WS_CHK, WS_HK = WS_HQ + 32 * MiB, WS_HVT = WS_HK + 32 * MiB, WS_HDS = WS_HVT + 32 * MiB, WS_HS = WS_HDS + 128 * MiB, WS_HBE = WS_HS + 64 * MiB;
constexpr size_t WS_GQ = WS_HBE + 2 * MiB, WS_GK = WS_GQ + 16 * MiB, WS_GVT = WS_GK + 16 * MiB, WS_GDS = WS_GVT + 32 * MiB, WS_GS = WS_GDS + 64 * MiB, WS_GBE = WS_GS + 32 * MiB;
constexpr size_t WS_RR = WS_GBE + 1 * MiB, WS_RB = WS_RR + 32 * MiB, WS_RK = WS_RB + 32 * MiB, WS_RW = WS_RK + 32 * MiB, WS_RVT = WS_RW + 32 * MiB;
constexpr size_t WS_RVG = WS_RVT + 32 * MiB;
constexpr size_t WS_RU = WS_RVG + 32 * MiB, WS_RP = WS_RU + 64 * MiB, WS_RQ = WS_RP + 64 * MiB, WS_RS = WS_RQ + 128 * MiB;
constexpr size_t WS_END = WS_RS + 64 * MiB;
static_assert(WS_YB + 528 * MiB <= WS_END, "overlay");
static_assert(WS_END <= (size_t)4096 * MiB, "workspace");
constexpr int CW_TMO = 0;
constexpr int CW_BAR = 4096;
constexpr int CW_HIST = 16384;
constexpr int CW_NT = 32768;
constexpr int CW_TILEE = 32768 + 64;
constexpr int CW_PADSTART = 40960;

constexpr int RING_BYTES = 131072;
constexpr int LDSCTL_OFF = 162816, MISC_OFF = LDSCTL_OFF + 320;
constexpr int LDS_BYTES = 163840;
constexpr int NWAVES = 8, NTHR = 512;

#define RLX_AGENT __ATOMIC_RELAXED, __HIP_MEMORY_SCOPE_AGENT
#define LDS_WAIT() asm volatile("s_waitcnt lgkmcnt(0)" ::: "memory")
#define VM_WAIT() asm volatile("s_waitcnt vmcnt(0)" ::: "memory")

__device__ __forceinline__ float bf2f(unsigned short b) { return __builtin_bit_cast(float, (unsigned)b << 16); }
__device__ __forceinline__ float bflo(unsigned w) { return __builtin_bit_cast(float, w << 16); }
__device__ __forceinline__ float bfhi(unsigned w) { return __builtin_bit_cast(float, w & 0xffff0000u); }
typedef __bf16 bf16x2_t __attribute__((ext_vector_type(2)));
__device__ __forceinline__ unsigned cvt_pk_bf16(float lo, float hi) { const f32x2 v = {lo, hi}; const bf16x2_t b = __builtin_convertvector(v, bf16x2_t); return __builtin_bit_cast(unsigned, b); }
__device__ __forceinline__ unsigned pk2(float lo, float hi) { return cvt_pk_bf16(lo, hi); }
__device__ __forceinline__ unsigned f2bf(float f) { return cvt_pk_bf16(f, 0.f) & 0xffffu; }
__device__ __forceinline__ float o_q(float y) { return __builtin_amdgcn_fmed3f(y * 4.0f, -448.0f, 448.0f); }
__device__ __forceinline__ unsigned pack_o4(float y0, float y1, float y2, float y3) { int w = __builtin_amdgcn_cvt_pk_fp8_f32(o_q(y0), o_q(y1), 0, false); w = __builtin_amdgcn_cvt_pk_fp8_f32(o_q(y2), o_q(y3), w, true); return (unsigned)w; }
__device__ __forceinline__ void flush_o_tile(const LAS unsigned char* os, unsigned char* obase  , int lane) {
#pragma unroll
    for (int i = 0; i < 2; ++i) { const int q = i * 64 + lane, t = q >> 2, c4 = q & 3; *(u32x4*)(obase + (size_t)t * D + c4 * 16) = *(const LAS u32x4*)(os + t * 64 + c4 * 16); }
}
__device__ __forceinline__ void store_o4(unsigned char* p, float y0, float y1, float y2, float y3) { int w = __builtin_amdgcn_cvt_pk_fp8_f32(o_q(y0), o_q(y1), 0, false); w = __builtin_amdgcn_cvt_pk_fp8_f32(o_q(y2), o_q(y3), w, true); *(unsigned*)p = (unsigned)w; }
__device__ __forceinline__ float fast_exp(float x) { return __builtin_amdgcn_exp2f(x * 1.4426950408889634f); }
__device__ __forceinline__ float fast_sigmoid(float x) { return __builtin_amdgcn_rcpf(1.0f + fast_exp(-x)); }
__device__ __forceinline__ float silu_f(float x) { return x * fast_sigmoid(x); }
__device__ __forceinline__ int opaque_tid() { int t = threadIdx.x; asm volatile("" : "+v"(t)); return t; }
__device__ __forceinline__ int opaque_s(int v) { asm volatile("" : "+s"(v)); return v; }
__device__ __forceinline__ void lds_barrier() { asm volatile("s_waitcnt lgkmcnt(0)" ::: "memory"); __builtin_amdgcn_s_barrier(); asm volatile("" ::: "memory"); }
__device__ __forceinline__ float dpp_add(float x, const int sel) {
    const int xi = __builtin_bit_cast(int, x); int r;
    switch (sel) { case 0: r = __builtin_amdgcn_update_dpp(xi, xi, 0xB1, 0xf, 0xf, false); break;
                   case 1: r = __builtin_amdgcn_update_dpp(xi, xi, 0x4E, 0xf, 0xf, false); break;
                   case 2: r = __builtin_amdgcn_update_dpp(xi, xi, 0x141, 0xf, 0xf, false); break;
                   default: r = __builtin_amdgcn_update_dpp(xi, xi, 0x140, 0xf, 0xf, false); break; }
    return x + __builtin_bit_cast(float, r);
}
__device__ __forceinline__ float wave_sum(float v) {
    v = dpp_add(v, 0); v = dpp_add(v, 1); v = dpp_add(v, 2); v = dpp_add(v, 3);
    v += __builtin_bit_cast(float, __builtin_amdgcn_update_dpp(0, __builtin_bit_cast(int, v), 0x142, 0xa, 0xf, false));
    v += __builtin_bit_cast(float, __builtin_amdgcn_update_dpp(0, __builtin_bit_cast(int, v), 0x143, 0xc, 0xf, false));
    return __builtin_bit_cast(float, __builtin_amdgcn_readlane(__builtin_bit_cast(int, v), 63));
}

namespace pg8 {
constexpr int BM = 256, BK = 64, HALF = 128, HTB = HALF * BK * 2, STAGE_BYTES = 8 * HTB, NXCD = 8, WGM = 8;
__host__ __device__ __forceinline__ int lds_byte(int r, int c) { const int st = (r >> 4) * 2 + (c >> 5), rr = r & 15, cc = c & 31, ob = rr * 64 + cc * 2; return st * 1024 + (ob ^ (((ob >> 9) & 1) << 5)); }
__host__ __device__ __forceinline__ void stage_rc(int b, int& R, int& C) { const int st = b / 1024, sb = b % 1024, swz = sb ^ (((sb >> 9) & 1) << 5); R = (st >> 1) * 16 + swz / 64; C = (st & 1) * 32 + (swz % 64) / 2; }
__host__ __device__ __forceinline__ int perm32(int rho) { const int n = rho >> 4, i = rho & 15; return 8 * (i >> 2) + 4 * n + (i & 3); }

typedef int v4i_t __attribute__((ext_vector_type(4)));
typedef int v8i_t __attribute__((ext_vector_type(8)));
struct Unit { int pm, pn, e; const char* A; const char* B; };
__device__ __forceinline__ unsigned asm_gload_u32(const void* p) { unsigned v; asm volatile("global_load_dword %0, %1, off" : "=v"(v) : "v"(p) : "memory"); return v; }

__device__ __forceinline__ bool static_tile(int i, int G, int c, int nM, int nN, int& pm, int& pn) {
    const int nwg = nM * nN; const long L = (long)i * G + c; if (L >= nwg) return false;
    int wgid = (int)L; { const int q = nwg / NXCD, r = nwg % NXCD, xcd = wgid % NXCD, off = wgid / NXCD; wgid = (xcd < r ? xcd * (q + 1) : r * (q + 1) + (xcd - r) * q) + off; }
    const int nig = WGM * nN, gid = wgid / nig, fm = gid * WGM, gsz = (nM - fm) < WGM ? (nM - fm) : WGM;
    pm = fm + ((wgid % nig) % gsz); pn = (wgid % nig) / gsz; return true;
}
struct DenseOrder {
    static constexpr bool GATHER = false, HAS_E = false;
    const char* A; const char* B; int nM, nN, G, c; size_t tstep;
    __device__ __forceinline__ void init(const void* A_, const void* B_, int M, int N, int K, int G_, int c_) { A = (const char*)A_; B = (const char*)B_; nM = M / BM; nN = N / BM; G = G_; c = c_; tstep = (size_t)BM * K * 2; }
    __device__ __forceinline__ bool next(int i, Unit& u) const { if (!static_tile(i, G, c, nM, nN, u.pm, u.pn)) return false; u.e = 0; u.A = A + (size_t)u.pm * tstep; u.B = B + (size_t)u.pn * tstep; return true; }
    __device__ __forceinline__ unsigned row_tok(const Unit&, int) const { return 0; }
};
template <bool GATHER_> struct MoeOrder {
    static constexpr bool GATHER = GATHER_, HAS_E = true;
    const char* A; const char* B; const int* tile_e; const int* slot_tok; int nM, nN, G, c; size_t tstep, estep;
    __device__ __forceinline__ void init(const void* A_, const void* B_, const int* tile_e_, const int* slot_tok_, int ntiles, int Nper, int Kbytes, int G_, int c_) {
        A = (const char*)A_; B = (const char*)B_; tile_e = tile_e_; slot_tok = slot_tok_; nM = ntiles; nN = Nper / BM; G = G_; c = c_; tstep = (size_t)BM * Kbytes; estep = (size_t)Nper * Kbytes; }
    __device__ __forceinline__ bool next(int i, Unit& u) const { if (!static_tile(i, G, c, nM, nN, u.pm, u.pn)) return false;
        u.e = __builtin_amdgcn_readfirstlane(tile_e[u.pm]); u.A = GATHER_ ? A : A + (size_t)u.pm * tstep; u.B = B + (size_t)u.e * estep + (size_t)u.pn * tstep; return true; }
    __device__ __forceinline__ unsigned row_tok(const Unit& u, int r) const { return (unsigned)slot_tok[u.pm * BM + r]; }
    __device__ __forceinline__ bool next_static(int i, Unit& u) const { return static_tile(i, G, c, nM, nN, u.pm, u.pn); }
    __device__ __forceinline__ const int* e_ptr(const Unit& u) const { return tile_e + u.pm; }
    __device__ __forceinline__ const int* tok_ptr(const Unit& u, int r) const { return slot_tok + u.pm * BM + r; }
    __device__ __forceinline__ void finish(Unit& u, int e) const { u.e = e; u.A = GATHER_ ? A : A + (size_t)u.pm * tstep; u.B = B + (size_t)e * estep + (size_t)u.pn * tstep; }
};

template <int WSCALE_ = 127, int ASCALE_ = 127>
struct EpiBf16T {
    static constexpr bool PERM = true; static constexpr int WSCALE = WSCALE_, ASCALE = ASCALE_;
    bf16* O; int ldc;
    __device__ __forceinline__ void init(f32x4 (&acc)[2][2][4][2], const Unit&, int, int) const {
#pragma unroll
        for (int a = 0; a < 2; ++a)
#pragma unroll
            for (int b = 0; b < 2; ++b)
#pragma unroll
                for (int m = 0; m < 4; ++m)
#pragma unroll
                    for (int n = 0; n < 2; ++n) acc[a][b][m][n] = (f32x4){0.f, 0.f, 0.f, 0.f}; }
    __device__ __forceinline__ void operator()(const f32x4 (&acc)[2][2][4][2], const Unit& u, int wr, int wc, int fr, int fq) const {
        const int row0 = u.pm * BM + wr * 64 + fr, col0 = u.pn * BM + wc * 64 + 16 * fq;
#pragma unroll
        for (int ai = 0; ai < 2; ++ai)
#pragma unroll
            for (int m = 0; m < 4; ++m) { bf16* rowp = O + (size_t)(row0 + ai * HALF + m * 16) * ldc + col0;
#pragma unroll
                for (int bj = 0; bj < 2; ++bj) { const f32x4 v0 = acc[ai][bj][m][0], v1 = acc[ai][bj][m][1];
                    u32x4 w; w.x = cvt_pk_bf16(v0[0], v0[1]); w.y = cvt_pk_bf16(v0[2], v0[3]); w.z = cvt_pk_bf16(v1[0], v1[1]); w.w = cvt_pk_bf16(v1[2], v1[3]);
                    *(u32x4*)(rowp + bj * 8) = w; } }
    }
};
typedef EpiBf16T<> EpiBf16;
struct EpiSwiglu {
    static constexpr bool PERM = false; static constexpr int WSCALE = 123, ASCALE = 127;
    unsigned char* H; const float* bias;
    __device__ __forceinline__ void init(f32x4 (&acc)[2][2][4][2], const Unit& u, int wc, int fq) const {
        const float* bp = bias + (size_t)u.e * 2048 + u.pn * 256 + wc * 32 + 4 * fq;
#pragma unroll
        for (int bj = 0; bj < 2; ++bj)
#pragma unroll
            for (int n = 0; n < 2; ++n) { const f32x4 bv = *(const f32x4*)(bp + bj * HALF + n * 16);
#pragma unroll
                for (int ai = 0; ai < 2; ++ai)
#pragma unroll
                    for (int m = 0; m < 4; ++m) acc[ai][bj][m][n] = bv; } }
    __device__ __forceinline__ void operator()(const f32x4 (&acc)[2][2][4][2], const Unit& u, int wr, int wc, int fr, int fq) const {
        const int row0 = u.pm * BM + wr * 64 + fr, colh = u.pn * 128 + wc * 32 + 8 * fq;
        f32x2 kc = {-1.702f * 1.4426950408889634f, -1.702f * 1.4426950408889634f}, k1 = {1.0f, 1.0f}; asm volatile("" : "+v"(kc), "+v"(k1));
#pragma unroll
        for (int ai = 0; ai < 2; ++ai)
#pragma unroll
            for (int m = 0; m < 4; ++m) { unsigned char* rowp = H + (size_t)(row0 + ai * HALF + m * 16) * FF + colh;
                float o[8];
#pragma unroll
                for (int n = 0; n < 2; ++n)
#pragma unroll
                    for (int hq = 0; hq < 2; ++hq) { const f32x4 g4 = acc[ai][0][m][n], u4 = acc[ai][1][m][n]; f32x2 g, up, e, r;
#pragma unroll
                        for (int j = 0; j < 2; ++j) { g[j] = __builtin_amdgcn_fmed3f(g4[2 * hq + j], -3.0e38f, 7.0f); up[j] = __builtin_amdgcn_fmed3f(u4[2 * hq + j], -7.0f, 7.0f); }
                        const f32x2 t = g * kc;
#pragma unroll
                        for (int j = 0; j < 2; ++j) e[j] = __builtin_amdgcn_exp2f(t[j]);
                        const f32x2 d = e + k1;
#pragma unroll
                        for (int j = 0; j < 2; ++j) r[j] = __builtin_amdgcn_rcpf(d[j]);
                        const f32x2 glu = g * r, ov = up * glu + glu;
                        o[n * 4 + 2 * hq] = ov[0]; o[n * 4 + 2 * hq + 1] = ov[1]; }
                int w0 = __builtin_amdgcn_cvt_pk_fp8_f32(o[0], o[1], 0, false); w0 = __builtin_amdgcn_cvt_pk_fp8_f32(o[2], o[3], w0, true);
                int w1 = __builtin_amdgcn_cvt_pk_fp8_f32(o[4], o[5], 0, false); w1 = __builtin_amdgcn_cvt_pk_fp8_f32(o[6], o[7], w1, true);
                *(u32x2*)rowp = (u32x2){(unsigned)w0, (unsigned)w1}; }
    }
};
struct EpiDown {
    static constexpr bool PERM = true; static constexpr int WSCALE = 122, ASCALE = 127;
    unsigned char* Y; const float* bias;
    __device__ __forceinline__ void init(f32x4 (&acc)[2][2][4][2], const Unit& u, int wc, int fq) const {
        const float* bp = bias + (size_t)u.e * 1024 + u.pn * BM + wc * 64 + 16 * fq;
#pragma unroll
        for (int bj = 0; bj < 2; ++bj)
#pragma unroll
            for (int n = 0; n < 2; ++n) { const f32x4 bv = *(const f32x4*)(bp + bj * 8 + 4 * n);
#pragma unroll
                for (int ai = 0; ai < 2; ++ai)
#pragma unroll
                    for (int m = 0; m < 4; ++m) acc[ai][bj][m][n] = bv; } }
    __device__ __forceinline__ void operator()(const f32x4 (&acc)[2][2][4][2], const Unit& u, int wr, int wc, int fr, int fq) const {
        const int row0 = u.pm * BM + wr * 64 + fr, col0 = u.pn * BM + wc * 64 + 16 * fq;
#pragma unroll
        for (int ai = 0; ai < 2; ++ai)
#pragma unroll
            for (int m = 0; m < 4; ++m) { const int row = row0 + ai * HALF + m * 16; const float g = 16.0f; unsigned char* rowp = Y + (size_t)row * D + col0; u32x4 wq;
#pragma unroll
                for (int bj = 0; bj < 2; ++bj) { const f32x4 v0 = acc[ai][bj][m][0] * g, v1 = acc[ai][bj][m][1] * g;
                    int w0 = __builtin_amdgcn_cvt_pk_fp8_f32(v0[0], v0[1], 0, false); w0 = __builtin_amdgcn_cvt_pk_fp8_f32(v0[2], v0[3], w0, true);
                    int w1 = __builtin_amdgcn_cvt_pk_fp8_f32(v1[0], v1[1], 0, false); w1 = __builtin_amdgcn_cvt_pk_fp8_f32(v1[2], v1[3], w1, true);
                    wq[2 * bj] = (unsigned)w0; wq[2 * bj + 1] = (unsigned)w1; }
                *(u32x4*)rowp = wq; }
    }
};

template <class Epi, class Sched, int ES = 2, bool ALIGN_EPI = true>
__device__ __forceinline__ void gemm_phase(LAS unsigned char* lds, const int K, const Sched& S, const Epi& E) {
    constexpr bool GA = Sched::GATHER;
    const int tid = opaque_tid(), wid = __builtin_amdgcn_readfirstlane(tid >> 6), lane = tid & 63, wr = wid >> 2, wc = wid & 3, fr = lane & 15, fq = lane >> 4;
    const int nt = K * ES / (BK * 2);
    unsigned voffA[2], voffB[2]; int Rr[2]; unsigned Cb[2];
#pragma unroll
    for (int i = 0; i < 2; ++i) { int R, C; stage_rc(tid * 16 + i * 8192, R, C); const int Rb = Epi::PERM ? (64 * (R >> 5) + 16 * ((R >> 2) & 3) + 4 * ((R >> 4) & 1) + (R & 3)) : R;
        voffA[i] = (unsigned)(R * K * ES + C * 2); voffB[i] = (unsigned)(Rb * K * ES + C * 2); Rr[i] = R; Cb[i] = (unsigned)C * 2u; }
    const size_t kstep = (size_t)(BK * 2);
    const size_t hstep = (size_t)HALF * K * ES;
    const size_t hstepB = Epi::PERM ? (size_t)8 * K * ES : hstep;
    const unsigned ldsw = (unsigned)wid * 1024u;
    const int aoff0 = lds_byte(wr * 64 + fr, fq * 8), aoff1 = lds_byte(wr * 64 + fr, fq * 8 + 32);
    const int boff0 = lds_byte(wc * 32 + fr, fq * 8), boff1 = lds_byte(wc * 32 + fr, fq * 8 + 32);
    unsigned cOff[2][2], nOff[2][2], sOff[2][2];
#define PG8_SA(b, h) (((b) * 2 + (h)) * HTB)
#define PG8_SB(b, h) ((4 + (b) * 2 + (h)) * HTB)
#define PG8_STAGE(bufoff, gbase, voff) do { _Pragma("unroll") for (int _i = 0; _i < 2; ++_i) \
        __builtin_amdgcn_global_load_lds((const unsigned*)((const char*)(gbase) + (voff)[_i]), (LAS unsigned*)(lds + (bufoff) + ldsw + _i * 8192), 16, 0, 0); } while (0)
#define PG8_STAGE_A(bufoff, gbase, half, OFF) do { if constexpr (GA) { PG8_STAGE(bufoff, gbase, (OFF)[half]); } else { PG8_STAGE(bufoff, (gbase) + (half) * hstep, voffA); } } while (0)
#define PG8_LDA(dst, b, h) do { if constexpr (ES == 2) { _Pragma("unroll") for (int m = 0; m < 4; ++m) _Pragma("unroll") for (int k = 0; k < 2; ++k) dst[m][k] = *(const LAS bf16x8*)(lds + PG8_SA(b, h) + (k ? aoff1 : aoff0) + m * 2048); } \
        else { _Pragma("unroll") for (int m = 0; m < 4; ++m) dst##8[m] = __builtin_shufflevector(*(const LAS v4i_t*)(lds + PG8_SA(b, h) + aoff0 + m * 2048), *(const LAS v4i_t*)(lds + PG8_SA(b, h) + aoff1 + m * 2048), 0, 1, 2, 3, 4, 5, 6, 7); } } while (0)
#define PG8_LDB(dst, b, h) do { if constexpr (ES == 2) { _Pragma("unroll") for (int n = 0; n < 2; ++n) _Pragma("unroll") for (int k = 0; k < 2; ++k) dst[n][k] = *(const LAS bf16x8*)(lds + PG8_SB(b, h) + (k ? boff1 : boff0) + n * 2048); } \
        else { _Pragma("unroll") for (int n = 0; n < 2; ++n) dst##8[n] = __builtin_shufflevector(*(const LAS v4i_t*)(lds + PG8_SB(b, h) + boff0 + n * 2048), *(const LAS v4i_t*)(lds + PG8_SB(b, h) + boff1 + n * 2048), 0, 1, 2, 3, 4, 5, 6, 7); } } while (0)
#define PG8_MMA(ai, bj, At, Bt) do { __builtin_amdgcn_s_setprio(1); _Pragma("unroll") for (int m = 0; m < 4; ++m) _Pragma("unroll") for (int n = 0; n < 2; ++n) { \
        if constexpr (ES == 2) { _Pragma("unroll") for (int k = 0; k < 2; ++k) acc[ai][bj][m][n] = __builtin_amdgcn_mfma_f32_16x16x32_bf16(Bt[n][k], At[m][k], acc[ai][bj][m][n], 0, 0, 0); } \
        else { asm volatile("v_mfma_scale_f32_16x16x128_f8f6f4 %0, %1, %2, %0, %3, %4 op_sel_hi:[0,0,0]" : "+v"(acc[ai][bj][m][n]) : "v"(Bt##8[n]), "v"(At##8[m]), "v"(wscale_v), "v"(ascale_v)); } } \
        __builtin_amdgcn_s_setprio(0); } while (0)
#define PG8_WAIT_V(n) asm volatile("s_waitcnt vmcnt(" #n ")" ::: "memory")
#define PG8_WAIT_L(n) asm volatile("s_waitcnt lgkmcnt(" #n ")" ::: "memory")
#define PG8_WAIT_VR() do { if (relax) { if constexpr (GA) PG8_WAIT_V(13); else PG8_WAIT_V(9); } else PG8_WAIT_V(8); } while (0)
#define PG8_BAR __builtin_amdgcn_s_barrier()
#define PG8_SCHED __builtin_amdgcn_sched_barrier(0)
#define PG8_GOFF(dst, u) do { if constexpr (GA) { _Pragma("unroll") for (int _h = 0; _h < 2; ++_h) _Pragma("unroll") for (int _i = 0; _i < 2; ++_i) \
        dst[_h][_i] = S.row_tok(u, _h * HALF + Rr[_i]) * (unsigned)(K * ES) + Cb[_i]; } } while (0)
    Unit cur, nxt; int ui = 0;
    if (!S.next(0, cur)) return;
#ifndef GEMM_STAGGER_TICKS
#define GEMM_STAGGER_TICKS 0
#endif
    if (GEMM_STAGGER_TICKS > 0) {
        const unsigned long long t0 = __builtin_amdgcn_s_memrealtime(), dl = (unsigned long long)((S.c * 5) & 15) * GEMM_STAGGER_TICKS;
        while (__builtin_amdgcn_s_memrealtime() - t0 < dl) __builtin_amdgcn_s_sleep(8);
    }
    f32x4 acc[2][2][4][2];
    E.init(acc, cur, wc, fq);
    int wscale_v = Epi::WSCALE, ascale_v = Epi::ASCALE; asm volatile("" : "+v"(wscale_v), "+v"(ascale_v));
    bf16x8 At[4][2], B0[2][2], B1[2][2];
    v8i_t At8[4], B08[2], B18[2];
    const char* cA = cur.A; const char* cB = cur.B;
    PG8_GOFF(cOff, cur);
#pragma unroll
    for (int h = 0; h < 2; ++h)
#pragma unroll
        for (int i = 0; i < 2; ++i) { nOff[h][i] = 0u; sOff[h][i] = 0u; }
    if constexpr (GA) { VM_WAIT(); }
    PG8_STAGE(PG8_SB(0, 0), cB, voffB); PG8_STAGE(PG8_SB(0, 1), cB + hstepB, voffB); PG8_STAGE_A(PG8_SA(0, 0), cA, 0, cOff); PG8_STAGE_A(PG8_SA(0, 1), cA, 1, cOff);
    if (wr == 1) PG8_BAR;
    PG8_WAIT_V(2); PG8_BAR;
    PG8_STAGE(PG8_SB(1, 0), cB + kstep, voffB); PG8_STAGE_A(PG8_SA(1, 0), cA + kstep, 0, cOff); PG8_STAGE(PG8_SB(1, 1), cB + hstepB + kstep, voffB);
    PG8_WAIT_V(6); PG8_BAR;
    for (;;) {
        bool has_next; const char* nA = cA; const char* nB = cB;
        unsigned eraw = 0u, traw[2][2] = {{0u, 0u}, {0u, 0u}};
        if constexpr (Sched::HAS_E) {
            has_next = S.next_static(ui + 1, nxt);
            if (has_next) { eraw = asm_gload_u32(S.e_ptr(nxt));
                if constexpr (GA) {
#pragma unroll
                    for (int h = 0; h < 2; ++h)
#pragma unroll
                        for (int i = 0; i < 2; ++i) traw[h][i] = asm_gload_u32(S.tok_ptr(nxt, h * HALF + Rr[i])); } }
        } else { has_next = S.next(ui + 1, nxt); if (has_next) { nA = nxt.A; nB = nxt.B; } }
#pragma unroll 1
        for (int t = 0; t < nt; t += 2) {
            const bool last = (t == nt - 2);
            const bool relax = Sched::HAS_E && has_next && t == 0;
            if constexpr (Sched::HAS_E) { if (last) {
                if (has_next) {
                    if constexpr (GA) asm volatile("" : "+v"(eraw), "+v"(traw[0][0]), "+v"(traw[0][1]), "+v"(traw[1][0]), "+v"(traw[1][1]) :: "memory"); else asm volatile("" : "+v"(eraw) :: "memory");
                    S.finish(nxt, __builtin_amdgcn_readfirstlane((int)eraw)); nA = nxt.A; nB = nxt.B;
                    if constexpr (GA) {
#pragma unroll
                        for (int h = 0; h < 2; ++h)
#pragma unroll
                            for (int i = 0; i < 2; ++i) nOff[h][i] = traw[h][i] * (unsigned)(K * ES) + Cb[i]; }
                } else if constexpr (GA) {
#pragma unroll
                    for (int h = 0; h < 2; ++h)
#pragma unroll
                        for (int i = 0; i < 2; ++i) nOff[h][i] = cOff[h][i]; } } }
            const char* a1 = cA + (size_t)(t + 1) * kstep;
            const char* a2 = last ? nA : cA + (size_t)(t + 2) * kstep; const char* b2 = last ? nB : cB + (size_t)(t + 2) * kstep;
            const char* a3 = a2 + kstep; const char* b3 = b2 + kstep;
            if constexpr (GA) {
#pragma unroll
                for (int h = 0; h < 2; ++h)
#pragma unroll
                    for (int i = 0; i < 2; ++i) sOff[h][i] = last ? nOff[h][i] : cOff[h][i]; }
            PG8_LDB(B0, 0, 0); PG8_LDB(B1, 0, 1); PG8_SCHED; PG8_LDA(At, 0, 0); PG8_STAGE_A(PG8_SA(1, 1), a1, 1, cOff);
            PG8_WAIT_VR(); PG8_WAIT_L(0); PG8_BAR; PG8_MMA(0, 0, At, B0); PG8_MMA(0, 1, At, B1); PG8_BAR; PG8_SCHED;
            PG8_LDA(At, 0, 1); PG8_STAGE(PG8_SB(0, 0), b2, voffB); PG8_STAGE(PG8_SB(0, 1), b2 + hstepB, voffB); PG8_STAGE_A(PG8_SA(0, 0), a2, 0, sOff);
            PG8_WAIT_VR(); PG8_WAIT_L(0); PG8_BAR; PG8_MMA(1, 0, At, B0); PG8_MMA(1, 1, At, B1); PG8_BAR; PG8_SCHED;
            PG8_LDB(B0, 1, 0); PG8_LDB(B1, 1, 1); PG8_SCHED; PG8_LDA(At, 1, 0); PG8_STAGE_A(PG8_SA(0, 1), a2, 1, sOff);
            PG8_WAIT_V(8); PG8_WAIT_L(0); PG8_BAR; PG8_MMA(0, 0, At, B0); PG8_MMA(0, 1, At, B1); PG8_BAR; PG8_SCHED;
            PG8_LDA(At, 1, 1); PG8_STAGE(PG8_SB(1, 0), b3, voffB); PG8_STAGE(PG8_SB(1, 1), b3 + hstepB, voffB); PG8_STAGE_A(PG8_SA(1, 0), a3, 0, sOff);
            PG8_WAIT_V(8); PG8_WAIT_L(0); PG8_BAR; PG8_MMA(1, 0, At, B0); PG8_MMA(1, 1, At, B1); PG8_BAR; PG8_SCHED;
        }
        if constexpr (ALIGN_EPI) { if (wr == 0) PG8_BAR; }
        if constexpr (ES == 1) { asm volatile("s_nop 15\n\ts_nop 15" ::: "memory"); }
        E(acc, cur, wr, wc, fr, fq);
        if (PHREP(25)) E(acc, cur, wr, wc, fr, fq);
        if (!has_next) break;
        E.init(acc, nxt, wc, fq);
        cur = nxt; cA = nA; cB = nB; ++ui;
        if constexpr (GA) {
#pragma unroll
            for (int h = 0; h < 2; ++h)
#pragma unroll
                for (int i = 0; i < 2; ++i) cOff[h][i] = nOff[h][i]; }
        if constexpr (ALIGN_EPI) { if (wr == 1) PG8_BAR; }
    }
    PG8_WAIT_V(0);
    if constexpr (!ALIGN_EPI) { if (wr == 0) PG8_BAR; }
    PG8_BAR;
#undef PG8_SA
#undef PG8_SB
#undef PG8_STAGE
#undef PG8_STAGE_A
#undef PG8_LDA
#undef PG8_LDB
#undef PG8_MMA
#undef PG8_WAIT_V
#undef PG8_WAIT_L
#undef PG8_WAIT_VR
#undef PG8_BAR
#undef PG8_SCHED
#undef PG8_GOFF
}
}

#define XB_TMO      128
#define XB_XCNT(j)  (256  + 64 * (j))
#define XB_XSUB(j)  (1280 + 64 * (j))
#define XB_XGEN(j)  (2304 + 64 * (j))
#define XB_TOP      3328
#define XB_TOPGEN   3392
#define XCD_BAR_WORDS 3456
#define XB_SPIN_CAP (1u << 18)
__device__ __forceinline__ unsigned xb_ld(unsigned* p)              { return __hip_atomic_load(p, __ATOMIC_RELAXED, __HIP_MEMORY_SCOPE_AGENT); }
__device__ __forceinline__ unsigned xb_add(unsigned* p, unsigned v) { return __hip_atomic_fetch_add(p, v, __ATOMIC_RELAXED, __HIP_MEMORY_SCOPE_AGENT); }
__device__ __forceinline__ unsigned xb_xcc_id() { return (unsigned)__builtin_amdgcn_s_getreg((3 << 11) | 20) & 0xFu; }
#define XB_SPIN(cond, bar) do { unsigned _sp = 0; while (cond) { __builtin_amdgcn_s_sleep(1); \
    if ((++_sp & 255u) == 0u) { if (xb_ld(&(bar)[XB_TMO])) break; if (_sp > XB_SPIN_CAP) { atomicAdd(&(bar)[XB_TMO], 1u); break; } } } } while (0)
struct XcdBarrier { unsigned* bar; unsigned x; volatile LAS unsigned* st; };
__device__ __forceinline__ XcdBarrier xcd_barrier_post(unsigned* bar, volatile LAS unsigned* st) {
    XcdBarrier b; b.bar = bar; b.x = xb_xcc_id(); b.st = st;
    if (threadIdx.x == 0) (void)xb_add(&bar[XB_XCNT(b.x)], 1u);
    return b;
}
__device__ __forceinline__ void xcd_barrier_complete(unsigned* bar, unsigned x, unsigned& nloc, unsigned& nx) {
    const unsigned G = gridDim.x * gridDim.y * gridDim.z;
    unsigned sum, cnt, mine, sp = 0u;
    for (;;) {
        sum = 0u; cnt = 0u; mine = 0u;
#pragma unroll
        for (unsigned j = 0; j < 16; ++j) { const unsigned c = xb_ld(&bar[XB_XCNT(j)]); sum += c; cnt += (c > 0u) ? 1u : 0u; mine = (j == x) ? c : mine; }
        if (sum == G) break;
        __builtin_amdgcn_s_sleep(1);
        if ((++sp & 255u) == 0u) { if (xb_ld(&bar[XB_TMO])) break; if (sp > XB_SPIN_CAP) { atomicAdd(&bar[XB_TMO], 1u); break; } }
    }
    nloc = mine > 0u ? mine : 1u; nx = cnt > 0u ? cnt : 1u;
}
__device__ __forceinline__ void xcd_barrier(const XcdBarrier& b) {
    asm volatile("s_waitcnt vmcnt(0)" ::: "memory");
    __syncthreads();
    if (threadIdx.x == 0) {
        unsigned* bar = b.bar;
        __builtin_amdgcn_s_waitcnt(0);
        unsigned nloc = b.st[0], nx = b.st[1];
        if (nloc == 0u) { xcd_barrier_complete(bar, b.x, nloc, nx); b.st[0] = nloc; b.st[1] = nx; }
        const unsigned old = xb_add(&bar[XB_XSUB(b.x)], 1u);
        const unsigned gen = old / nloc;
        if (old + 1u == (gen + 1u) * nloc) {
            __builtin_amdgcn_fence(__ATOMIC_RELEASE, "agent");
            asm volatile("s_waitcnt vmcnt(0)" ::: "memory");
            const unsigned og = xb_add(&bar[XB_TOP], 1u);
            const unsigned tg = og / nx;
            if (og + 1u == (tg + 1u) * nx) xb_add(&bar[XB_TOPGEN], 1u);
            else XB_SPIN(xb_ld(&bar[XB_TOPGEN]) == tg, bar);
            __builtin_amdgcn_fence(__ATOMIC_ACQUIRE, "agent");
            xb_add(&bar[XB_XGEN(b.x)], 1u);
            asm volatile("s_waitcnt vmcnt(0)" ::: "memory");
        } else {
            XB_SPIN(xb_ld(&bar[XB_XGEN(b.x)]) == gen, bar);
            __builtin_amdgcn_fence(__ATOMIC_ACQUIRE, "agent");
            asm volatile("s_waitcnt vmcnt(0)" ::: "memory");
        }
    }
    __syncthreads();
}

struct Args {
    const float* in[33];
    float* out; unsigned char* ws;
    int ph_lo, ph_hi;
};
enum { I_X = 0, I_MEM, I_WIN, I_GLACONV, I_GLAW2, I_GLAB, I_GLANG, I_HGLB, I_HGNG, I_RWMU, I_RWW0, I_RWW2, I_RWA0, I_RWA2, I_RWG2, I_RWKK, I_RWKA, I_RWRK, I_RWLNW, I_RWLNB,
       I_WMK, I_WMV, I_WOUT, I_LN1G, I_LN1B, I_RTW, I_RTB, I_WGU, I_BGU, I_WDN, I_BDN, I_LN2G, I_LN2B };


template <int OFF> __device__ __forceinline__ unsigned long long ka_u64() { unsigned long long v; asm volatile("s_load_dwordx2 %0, %1, %2\n\ts_waitcnt lgkmcnt(0)" : "=s"(v) : "s"(__builtin_amdgcn_kernarg_segment_ptr()), "n"(OFF)); return v; }
#define KIN(i) ((const float*)(const GAS float*)ka_u64<8 * (i)>())
#define KOUT() ((float*)(GAS float*)ka_u64<264>())
#define KWS() ((unsigned char*)(GAS unsigned char*)ka_u64<272>())

template <class Map>
__device__ __forceinline__ void tr_item(const float* __restrict__ W, int K, int N, bf16* __restrict__ WT, LAS float* scr, int kb, int nb, int lane, Map map) {
    const int k0 = 64 * kb, n0 = 64 * nb, col = n0 + lane; const bool valid = col < N;
    const float* src = W + (size_t)k0 * N + (valid ? col : 0);
#pragma unroll 64
    for (int kk = 0; kk < 64; ++kk) { const float v = valid ? src[(size_t)kk * N] : 0.f; scr[kk * 65 + lane] = v; }
    LDS_WAIT(); asm volatile("" ::: "memory");
    const int c = lane & 7;
#pragma unroll
    for (int j = 0; j < 8; ++j) { const int n = (lane >> 3) + 8 * j;
        if (n0 + n < N) { const int orow = map(n0 + n); const LAS float* s = scr + (8 * c) * 65 + n;
            u32x4 o; o.x = pk2(s[0 * 65], s[1 * 65]); o.y = pk2(s[2 * 65], s[3 * 65]); o.z = pk2(s[4 * 65], s[5 * 65]); o.w = pk2(s[6 * 65], s[7 * 65]);
            *(u32x4*)(WT + (size_t)orow * K + k0 + 8 * c) = o; } }
    LDS_WAIT(); asm volatile("" ::: "memory");
}
template <bool GUARD = false, class Map>
__device__ __forceinline__ void tr_item_f8(const float* __restrict__ W, int K, int N, unsigned char* __restrict__ WT8, LAS float* scr, int kb, int nb, int lane, float scale, Map map) {
    const int k0 = 64 * kb, n0 = 64 * nb, col = (GUARD && n0 + lane >= N) ? N - 1 : n0 + lane;
    const float* src = W + (size_t)k0 * N + col;
#pragma unroll 64
    for (int kk = 0; kk < 64; ++kk) scr[kk * 65 + lane] = src[(size_t)kk * N] * scale;
    LDS_WAIT(); asm volatile("" ::: "memory");
    const int c = lane & 3;
#pragma unroll
    for (int j = 0; j < 4; ++j) { const int n = (lane >> 2) + 16 * j; const LAS float* s = scr + (16 * c) * 65 + n;
        u32x4 o;
#pragma unroll
        for (int q = 0; q < 4; ++q) { int w = __builtin_amdgcn_cvt_pk_fp8_f32(s[(4 * q) * 65], s[(4 * q + 1) * 65], 0, false); w = __builtin_amdgcn_cvt_pk_fp8_f32(s[(4 * q + 2) * 65], s[(4 * q + 3) * 65], w, true); o[q] = (unsigned)w; }
        if (!GUARD || n0 + n < N) { const int orow = map(n0 + n); *(u32x4*)(WT8 + (size_t)orow * K + k0 + 16 * c) = o; } }
    LDS_WAIT(); asm volatile("" ::: "memory");
}
struct MapIdent { int off; __device__ __forceinline__ int operator()(int c) const { return c + off; } };
struct MapWin { __device__ __forceinline__ int operator()(int c) const { return c < 512 ? c : (c < 528 ? c + 2560 : c - 16); } };
__device__ __forceinline__ int gu_row(int c) { const int f = c >> 1, bj = c & 1, pn = f >> 7, fl = f & 127, wc = fl >> 5, fq = (fl >> 3) & 3, n = (fl >> 2) & 1, j = fl & 3; return 256 * pn + 128 * bj + 32 * wc + 16 * n + 4 * fq + j; }
struct MapGu { __device__ __forceinline__ int operator()(int c) const { return gu_row(c); } };

__device__ __forceinline__ void prologue_phase(LAS unsigned char* lds, int vcu, int G) {
    const int tid = opaque_tid(), lane = tid & 63, wave = __builtin_amdgcn_readfirstlane(tid >> 6);
    LAS float* scr = (LAS float*)(lds + wave * 16640); static_assert(8 * 16640 <= LDSCTL_OFF, "prologue scratch below the LDS control words");
    const int gw = vcu * NWAVES + wave, NGW = G * NWAVES;
    unsigned char* ws = KWS();
    constexpr int IT_GU = NL * NE * 512, IT_DN = NL * NE * 256, IT_IN = NL * 16 * 49, IT_OUT = NL * 256, IT_MEM = NL * 2 * 64, IT_L64 = NL * 2 * 4, IT_L128 = NL * 2 * 4;
    constexpr int IT_TOTAL = IT_GU + IT_DN + IT_IN + IT_OUT + IT_MEM + IT_L64 + IT_L128;
    for (int it = gw; it < IT_TOTAL; it += NGW) {
        int r = it;
        if (r < IT_GU) { const int le = r >> 9, q = r & 511, kb = q >> 5, nb = q & 31;
            tr_item_f8(KIN(I_WGU) + (size_t)le * 1024 * 2048, 1024, 2048, (unsigned char*)(ws + WS_WGU) + (size_t)le * 2048 * 1024, scr, kb, nb, lane, 16.0f, MapGu{}); continue; } r -= IT_GU;
        if (r < IT_DN) { const int le = r >> 8, q = r & 255, kb = q >> 4, nb = q & 15;
            tr_item_f8(KIN(I_WDN) + (size_t)le * 1024 * 1024, 1024, 1024, (unsigned char*)(ws + WS_WD) + (size_t)le * 1024 * 1024, scr, kb, nb, lane, 32.0f, MapIdent{0}); continue; } r -= IT_DN;
        if (r < IT_IN) { const int l = r / (16 * 49), q = r % (16 * 49), kb = q / 49, nb = q % 49;
            tr_item_f8<true>(KIN(I_WIN) + (size_t)l * 1024 * PIN, 1024, PIN, (unsigned char*)(ws + WS_WIN) + (size_t)l * PINP * 1024, scr, kb, nb, lane, 16.0f, MapWin{}); continue; } r -= IT_IN;
        if (r < IT_OUT) { const int l = r >> 8, q = r & 255, kb = q >> 4, nb = q & 15;
            tr_item_f8(KIN(I_WOUT) + (size_t)l * 1024 * 1024, 1024, 1024, (unsigned char*)(ws + WS_WOUT) + (size_t)l * 1024 * 1024, scr, kb, nb, lane, 32.0f, MapIdent{0}); continue; } r -= IT_OUT;
        if (r < IT_MEM) { const int l = r >> 7, q = r & 127, kv = q >> 6, kb = (q >> 2) & 15, nb = q & 3;
            tr_item((kv ? KIN(I_WMV) : KIN(I_WMK)) + (size_t)l * 1024 * 256, 1024, 256, (bf16*)(ws + WS_WMEM), scr, kb, nb, lane, MapIdent{l * 512 + kv * 256}); continue; } r -= IT_MEM;
        if (r < IT_L64) { const int l = r >> 3, q = r & 7, wa = q >> 2, nb = q & 3;
            tr_item((wa ? KIN(I_RWA2) : KIN(I_RWW2)) + (size_t)l * 64 * 256, 64, 256, (bf16*)(ws + WS_LORA) + (size_t)wa * (NL * 256 * 64) + (size_t)l * 256 * 64, scr, 0, nb, lane, MapIdent{0}); continue; } r -= IT_L64;
        { const int l = r >> 3, q = r & 7, kb = q >> 2, nb = q & 3;
            tr_item(KIN(I_RWG2) + (size_t)l * 128 * 256, 128, 256, (bf16*)(ws + WS_LORA) + (size_t)2 * (NL * 256 * 64) + (size_t)l * 256 * 128, scr, kb, nb, lane, MapIdent{0}); }
    }
    { const size_t gt = (size_t)vcu * NTHR + tid, GT = (size_t)G * NTHR; constexpr size_t per = (size_t)(PINP - PIN) * 1024 / 16;
        for (size_t i = gt; i < per * NL; i += GT) { const size_t l = i / per, j = i % per; *(u32x4*)((unsigned char*)(ws + WS_WIN) + l * PINP * 1024 + (size_t)PIN * 1024 + j * 16) = (u32x4){0u, 0u, 0u, 0u}; }
        for (size_t i = gt; i < (size_t)NL * 8192; i += GT) { const int l = (int)(i >> 13), q = (int)(i >> 6) & 127, ln = (int)i & 63, jj = q >> 4, c = q & 15, k0 = 4 * (ln + 64 * (jj >> 1)) + 2 * (jj & 1);
            const float* s = KIN(I_WIN) + (size_t)l * 1024 * PIN + (size_t)k0 * PIN + 512 + c; ((unsigned*)(ws + WS_GLRW))[i] = pk2(s[0], s[PIN]); }
        for (size_t i = gt; i < (size_t)NL * NE * 2048; i += GT) { const size_t le = i >> 11; const int c = (int)(i & 2047); ((float*)(ws + WS_BGU))[le * 2048 + gu_row(c)] = KIN(I_BGU)[i]; }
        const f32x4* xs = (const f32x4*)KIN(I_X); unsigned char* xd8 = (unsigned char*)(ws + WS_X8);
        for (size_t i = gt; i < (size_t)NTOK * D / 8; i += GT) { const f32x4 v0 = xs[2 * i], v1 = xs[2 * i + 1]; store_o4(xd8 + 8 * i, v0[0], v0[1], v0[2], v0[3]); store_o4(xd8 + 8 * i + 4, v1[0], v1[1], v1[2], v1[3]); }
        const f32x4* ms = (const f32x4*)KIN(I_MEM); u32x4* md = (u32x4*)(ws + WS_MEMB);
        for (size_t i = gt; i < (size_t)NB * NMEM * D / 8; i += GT) { const f32x4 v0 = ms[2 * i], v1 = ms[2 * i + 1]; md[i] = (u32x4){pk2(v0[0], v0[1]), pk2(v0[2], v0[3]), pk2(v1[0], v1[1]), pk2(v1[2], v1[3])}; }
    }
}


__device__ __forceinline__ float log1pexp_neg_abs(float z) { return __builtin_amdgcn_logf(1.0f + fast_exp(-fabsf(z))) * 0.6931471805599453f; }
__device__ __forceinline__ float tanh_f(float x) { const float e = fast_exp(-2.0f * fabsf(x)); const float t = (1.0f - e) * __builtin_amdgcn_rcpf(1.0f + e); return x < 0.f ? -t : t; }

constexpr int NCH = T / 32;
__device__ __forceinline__ int rho16(int r, int hh) { return (r & 3) + 8 * (r >> 2) + 4 * hh; }
__device__ __forceinline__ void hg_fused_unit(LAS unsigned char* lds, int l, int b, int c) {
    const int tid = opaque_tid(), lane = tid & 63, wave = __builtin_amdgcn_readfirstlane(tid >> 6), r32 = lane & 31, hh = lane >> 5;
    unsigned char* ws = KWS();
    const bf16* P = (const bf16*)(ws + WS_P) + ((size_t)b * T + c * 32) * PINP;
    constexpr int HB = 16640;
    if (tid < 256) {
        const int ch = tid, h = ch >> 6, d = ch & 63; const size_t un = (size_t)(b * 4 + h) * NCH + c;
        const float* hp = KIN(I_HGLB) + ch; const float v0 = hp[0], v1 = hp[256], v2 = hp[512], v3 = hp[768];
        unsigned short hqr[32], hfr[32];
#pragma unroll
        for (int t = 0; t < 32; ++t) { const bf16* row = P + (size_t)t * PINP; hqr[t] = row[PC_HQ + ch]; hfr[t] = row[PC_HF + ch]; }
        __builtin_amdgcn_sched_barrier(0);
        float lb;
        { const float m = fmaxf(fmaxf(v0, v1), fmaxf(v2, v3));
          const float e0 = __expf(v0 - m), e1 = __expf(v1 - m), e2 = __expf(v2 - m), e3 = __expf(v3 - m); const float inv = 1.0f / (e0 + e1 + e2 + e3);
          lb = (l >= 1 ? e1 : 0.f) + (l >= 2 ? e2 : 0.f) + (l >= 3 ? e3 : 0.f); lb *= inv; }
        const float oml = 1.0f - lb;
        LAS bf16* KT = (LAS bf16*)(lds + h * HB); LAS float* BE = (LAS float*)(lds + h * HB + 8192);
        LAS bf16* QL = (LAS bf16*)(lds + h * HB + 8448) + d; LAS bf16* KL = (LAS bf16*)(lds + h * HB + 12544) + d;
        float bc = 1.0f;
#pragma unroll
        for (int t8 = 0; t8 < 4; ++t8) { u32x4 kp;
#pragma unroll
            for (int jj = 0; jj < 4; ++jj) { float k2[2];
#pragma unroll
                for (int e = 0; e < 2; ++e) { const int t = t8 * 8 + jj * 2 + e; const float hf = bf2f(hfr[t]); const float eh_ = fast_exp(fminf(-hf, 80.0f)); const float s = __builtin_amdgcn_rcpf(1.0f + eh_), sn = eh_ * s;
                    bc = fmaxf(bc * fmaxf(lb + oml * s, 1e-30f), 1.8048513878454153e-35f);
                    const float qt = silu_f(bf2f(hqr[t])) * bc, kt = oml * sn * __builtin_amdgcn_rcpf(bc);
                    QL[t * 64] = (bf16)f2bf(qt); KL[t * 64] = (bf16)f2bf(kt); k2[e] = kt; }
                kp[jj] = pk2(k2[0], k2[1]); }
            *(LAS u32x4*)(KT + d * 32 + t8 * 8) = kp; }
        const float ebend = bc; BE[d] = ebend; ((float*)(ws + WS_HBE))[un * 64 + d] = ebend;
    } else {
        const int cv = tid - 256, h = cv >> 6, vi = cv & 63; const size_t un = (size_t)(b * 4 + h) * NCH + c;
        LAS bf16* VT = (LAS bf16*)(lds + h * HB + 4096); bf16* VTg = (bf16*)(ws + WS_HVT) + un * 2048 + vi * 32;
        unsigned short hvr[32];
#pragma unroll
        for (int t = 0; t < 32; ++t) hvr[t] = P[(size_t)t * PINP + PC_HI + cv];
        __builtin_amdgcn_sched_barrier(0);
#pragma unroll
        for (int t8 = 0; t8 < 4; ++t8) { u32x4 vp;
#pragma unroll
            for (int jj = 0; jj < 4; ++jj) vp[jj] = (unsigned)hvr[t8 * 8 + 2 * jj] | ((unsigned)hvr[t8 * 8 + 2 * jj + 1] << 16);
            *(LAS u32x4*)(VT + vi * 32 + t8 * 8) = vp; *(u32x4*)(VTg + t8 * 8) = vp; }
    }
    lds_barrier();
    { const int h = wave >> 1, vt = wave & 1; const size_t un = (size_t)(b * 4 + h) * NCH + c;
      const LAS bf16* KT = (const LAS bf16*)(lds + h * HB); const LAS bf16* VT = (const LAS bf16*)(lds + h * HB + 4096); const LAS float* BE = (const LAS float*)(lds + h * HB + 8192);
      bf16* DSg = (bf16*)(ws + WS_HDS) + un * 4096;
      { const LAS bf16* srcL = (const LAS bf16*)(lds + h * HB + (vt == 0 ? 8448 : 12544)); u32x4* dstG = (u32x4*)((bf16*)(ws + (vt == 0 ? WS_HQ : WS_HK)) + un * 2048);
#pragma unroll
        for (int i = 0; i < 4; ++i) dstG[i * 64 + lane] = *(const LAS u32x4*)(srcL + (i * 64 + lane) * 8); }
#pragma unroll
      for (int dt = 0; dt < 2; ++dt) { f32x16 acc;
#pragma unroll
          for (int i = 0; i < 16; ++i) acc[i] = 0.f;
#pragma unroll
          for (int s = 0; s < 2; ++s) { const bf16x8 A = *(const LAS bf16x8*)(VT + (32 * vt + r32) * 32 + 16 * s + 8 * hh), B = *(const LAS bf16x8*)(KT + (32 * dt + r32) * 32 + 16 * s + 8 * hh);
              acc = __builtin_amdgcn_mfma_f32_32x32x16_bf16(A, B, acc, 0, 0, 0); }
          const float ebd = BE[32 * dt + r32];
#pragma unroll
          for (int r = 0; r < 16; ++r) DSg[(32 * vt + rho16(r, hh)) * 64 + 32 * dt + r32] = (bf16)f2bf(acc[r] * ebd); } }
    lds_barrier();
}
__device__ __forceinline__ void gla_fused_unit(LAS unsigned char* lds, int l, int b, int c) {
    const int tid = opaque_tid(), lane = tid & 63, wave = __builtin_amdgcn_readfirstlane(tid >> 6), r32 = lane & 31, hh = lane >> 5;
    unsigned char* ws = KWS();
    const int t0 = c * 32;
    const bf16* P = (const bf16*)(ws + WS_P) + ((size_t)b * T + t0) * PINP;
    LAS float* GL = (LAS float*)lds;
    constexpr int HB = 10368, H0 = 2048;
    const unsigned short glr = P[(size_t)(tid >> 4) * PINP + PC_GLR + (tid & 15)];
    unsigned short xra[32], xrb[32], hra[3], hrb[3]; float cwv[8], wc[16], gb = 0.f;
    const long hb = t0 > 0 ? 1 : 0;
    if (tid < 128) { const int ch = tid;
        const float* cw = KIN(I_GLACONV) + (size_t)l * 4 * 512 + ch;
        cwv[0] = cw[0]; cwv[1] = cw[512]; cwv[2] = cw[1024]; cwv[3] = cw[1536]; cwv[4] = cw[128]; cwv[5] = cw[640]; cwv[6] = cw[1152]; cwv[7] = cw[1664];
        const float* w2p = KIN(I_GLAW2) + (size_t)l * 16 * 128 + ch;
#pragma unroll
        for (int r = 0; r < 16; ++r) wc[r] = w2p[r * 128];
        gb = KIN(I_GLAB)[l * 128 + ch];
#pragma unroll
        for (int j = 0; j < 3; ++j) { const bf16* hrow = P - hb * (3 - j) * PINP; hra[j] = hrow[PC_GQ + ch]; hrb[j] = hrow[PC_GK + ch]; }
#pragma unroll
        for (int t = 0; t < 32; ++t) { const bf16* row = P + (size_t)t * PINP; xra[t] = row[PC_GQ + ch]; xrb[t] = row[PC_GK + ch]; }
    } else if (tid < 384) { const int cv = tid - 128;
        const float* cw = KIN(I_GLACONV) + (size_t)l * 4 * 512 + 256 + cv;
        cwv[0] = cw[0]; cwv[1] = cw[512]; cwv[2] = cw[1024]; cwv[3] = cw[1536];
#pragma unroll
        for (int j = 0; j < 3; ++j) hra[j] = (P - hb * (3 - j) * PINP)[PC_GV + cv];
#pragma unroll
        for (int t = 0; t < 32; ++t) xra[t] = P[(size_t)t * PINP + PC_GV + cv];
    }
    __builtin_amdgcn_sched_barrier(0);
    GL[tid] = bf2f(glr);
    lds_barrier();
    if (tid < 128) {
        const int ch = tid, h = ch >> 5, d = ch & 31; const size_t un = (size_t)(b * 4 + h) * NCH + c;
        const float q0 = cwv[0], q1 = cwv[1], q2 = cwv[2], q3 = cwv[3], k0 = cwv[4], k1 = cwv[5], k2w = cwv[6], k3 = cwv[7];
        float uq0 = hb ? bf2f(hra[0]) : 0.f, uq1 = hb ? bf2f(hra[1]) : 0.f, uq2 = hb ? bf2f(hra[2]) : 0.f, uk0 = hb ? bf2f(hrb[0]) : 0.f, uk1 = hb ? bf2f(hrb[1]) : 0.f, uk2 = hb ? bf2f(hrb[2]) : 0.f;
        LAS bf16* KT = (LAS bf16*)(lds + H0 + h * HB); LAS float* BE = (LAS float*)(lds + H0 + h * HB + 6144);
        LAS bf16* QL = (LAS bf16*)(lds + H0 + h * HB + 6272) + d; LAS bf16* KL = (LAS bf16*)(lds + H0 + h * HB + 8320) + d;
        float bc = 0.f;
#pragma unroll
        for (int t8 = 0; t8 < 4; ++t8) { u32x4 kp;
#pragma unroll
            for (int jj = 0; jj < 4; ++jj) { float kk2[2];
#pragma unroll
                for (int e = 0; e < 2; ++e) { const int t = t8 * 8 + jj * 2 + e; const float uq3 = bf2f(xra[t]), uk3 = bf2f(xrb[t]);
                    const float q = silu_f(q0 * uq0 + q1 * uq1 + q2 * uq2 + q3 * uq3) * 0.17677669529663687f, k = silu_f(k0 * uk0 + k1 * uk1 + k2w * uk2 + k3 * uk3);
                    uq0 = uq1; uq1 = uq2; uq2 = uq3; uk0 = uk1; uk1 = uk2; uk2 = uk3;
                    float z = gb;
#pragma unroll
                    for (int r = 0; r < 16; ++r) z += GL[t * 16 + r] * wc[r];
                    bc = fmaxf(bc + (fminf(z, 0.f) - log1pexp_neg_abs(z)) * 0.0625f, -80.0f);
                    const float qt = q * fast_exp(bc), kt = k * fast_exp(-bc);
                    QL[t * 32] = (bf16)f2bf(qt); KL[t * 32] = (bf16)f2bf(kt); kk2[e] = kt; }
                kp[jj] = pk2(kk2[0], kk2[1]); }
            *(LAS u32x4*)(KT + d * 32 + t8 * 8) = kp; }
        const float ebend = fast_exp(bc); BE[d] = ebend; ((float*)(ws + WS_GBE))[un * 32 + d] = ebend;
    } else if (tid < 384) {
        const int cv = tid - 128, h = cv >> 6, vi = cv & 63; const size_t un = (size_t)(b * 4 + h) * NCH + c;
        const float w0 = cwv[0], w1 = cwv[1], w2 = cwv[2], w3 = cwv[3];
        float u0 = hb ? bf2f(hra[0]) : 0.f, u1 = hb ? bf2f(hra[1]) : 0.f, u2 = hb ? bf2f(hra[2]) : 0.f;
        LAS bf16* VT = (LAS bf16*)(lds + H0 + h * HB + 2048); bf16* VTg = (bf16*)(ws + WS_GVT) + un * 2048 + vi * 32;
#pragma unroll
        for (int t8 = 0; t8 < 4; ++t8) { u32x4 vp; float yv[8];
#pragma unroll
            for (int e = 0; e < 8; ++e) { const float u3 = bf2f(xra[t8 * 8 + e]); yv[e] = silu_f(w0 * u0 + w1 * u1 + w2 * u2 + w3 * u3); u0 = u1; u1 = u2; u2 = u3; }
#pragma unroll
            for (int jj = 0; jj < 4; ++jj) vp[jj] = pk2(yv[2 * jj], yv[2 * jj + 1]);
            *(LAS u32x4*)(VT + vi * 32 + t8 * 8) = vp; *(u32x4*)(VTg + t8 * 8) = vp; }
    }
    lds_barrier();
    { const int h = wave >> 1, vt = wave & 1; const size_t un = (size_t)(b * 4 + h) * NCH + c;
      const LAS bf16* KT = (const LAS bf16*)(lds + H0 + h * HB); const LAS bf16* VT = (const LAS bf16*)(lds + H0 + h * HB + 2048); const LAS float* BE = (const LAS float*)(lds + H0 + h * HB + 6144);
      bf16* DSg = (bf16*)(ws + WS_GDS) + un * 2048;
      { const LAS bf16* srcL = (const LAS bf16*)(lds + H0 + h * HB + (vt == 0 ? 6272 : 8320)); u32x4* dstG = (u32x4*)((bf16*)(ws + (vt == 0 ? WS_GQ : WS_GK)) + un * 1024);
#pragma unroll
        for (int i = 0; i < 2; ++i) dstG[i * 64 + lane] = *(const LAS u32x4*)(srcL + (i * 64 + lane) * 8); }
      f32x16 acc;
#pragma unroll
      for (int i = 0; i < 16; ++i) acc[i] = 0.f;
#pragma unroll
      for (int s = 0; s < 2; ++s) { const bf16x8 A = *(const LAS bf16x8*)(VT + (32 * vt + r32) * 32 + 16 * s + 8 * hh), B = *(const LAS bf16x8*)(KT + r32 * 32 + 16 * s + 8 * hh);
          acc = __builtin_amdgcn_mfma_f32_32x32x16_bf16(A, B, acc, 0, 0, 0); }
      const float ebd = BE[r32];
#pragma unroll
      for (int r = 0; r < 16; ++r) DSg[(32 * vt + rho16(r, hh)) * 32 + r32] = (bf16)f2bf(acc[r] * ebd); }
    lds_barrier();
}
template <int DK>
__device__ __forceinline__ void m2_gh_elem2(int e2, const bf16* __restrict__ DS, const float* __restrict__ BE, bf16* __restrict__ SG) {
    constexpr int EPB = 64 * DK; const int e = e2 * 2, bh = e / EPB, idx = e % EPB, d = idx % DK; const size_t un0 = (size_t)bh * NCH;
    float S0 = 0.f, S1 = 0.f;
#pragma unroll 1
    for (int c0 = 0; c0 < NCH; c0 += 16) { unsigned ds[16]; f32x2 be[16];
#pragma unroll
        for (int u = 0; u < 16; ++u) { ds[u] = *(const unsigned*)(DS + (un0 + c0 + u) * EPB + idx); be[u] = *(const f32x2*)(BE + (un0 + c0 + u) * DK + d); }
#pragma unroll
        for (int u = 0; u < 16; ++u) { *(unsigned*)(SG + (un0 + c0 + u) * EPB + idx) = pk2(S0, S1); S0 = S0 * be[u][0] + bflo(ds[u]); S1 = S1 * be[u][1] + bfhi(ds[u]); } }
}
template <int DK>
__device__ __forceinline__ void m3_gh_task(int lane, const bf16* __restrict__ Qg, const bf16* __restrict__ Kg, const bf16* __restrict__ VTg, const bf16* __restrict__ Sg,
                                           const bf16* __restrict__ gate  , const float* __restrict__ ng  , unsigned char* __restrict__ orow  , LAS unsigned char* os  ) {
    const int r32 = lane & 31, hh = lane >> 5;
    bf16x8 qf[DK / 16], kfa[DK / 16], sfa[2][DK / 16]; s16x4 vfa[2][2][2]; u32x2 gwa[2][4]; f32x4 n4a[2][4];
    const bf16* grow = gate + (size_t)r32 * PINP;
#pragma unroll
    for (int s = 0; s < DK / 16; ++s) { qf[s] = *(const bf16x8*)(Qg + r32 * DK + 16 * s + 8 * hh); kfa[s] = *(const bf16x8*)(Kg + r32 * DK + 16 * s + 8 * hh); }
#pragma unroll
    for (int s = 0; s < 2; ++s)
#pragma unroll
        for (int vt = 0; vt < 2; ++vt) { const bf16* vp = VTg + (32 * vt + r32) * 32 + 16 * s + 4 * hh; vfa[s][vt][0] = *(const s16x4*)vp; vfa[s][vt][1] = *(const s16x4*)(vp + 8); }
#pragma unroll
    for (int vt = 0; vt < 2; ++vt)
#pragma unroll
        for (int s = 0; s < DK / 16; ++s) sfa[vt][s] = *(const bf16x8*)(Sg + (32 * vt + r32) * DK + 16 * s + 8 * hh);
#pragma unroll
    for (int vt = 0; vt < 2; ++vt)
#pragma unroll
        for (int g = 0; g < 4; ++g) { gwa[vt][g] = *(const u32x2*)(grow + 32 * vt + 8 * g + 4 * hh); n4a[vt][g] = *(const f32x4*)(ng + 32 * vt + 8 * g + 4 * hh); }
    __builtin_amdgcn_sched_barrier(0);
    f32x16 at;
#pragma unroll
    for (int i = 0; i < 16; ++i) at[i] = 0.f;
#pragma unroll
    for (int s = 0; s < DK / 16; ++s) at = __builtin_amdgcn_mfma_f32_32x32x16_bf16(kfa[s], qf[s], at, 0, 0, 0);
#pragma unroll
    for (int r = 0; r < 16; ++r) if (rho16(r, hh) > r32) at[r] = 0.f;
    f32x16 o[2];
#pragma unroll
    for (int vt = 0; vt < 2; ++vt)
#pragma unroll
        for (int i = 0; i < 16; ++i) o[vt][i] = 0.f;
#pragma unroll
    for (int s = 0; s < 2; ++s) { union { bf16x8 v; unsigned w[4]; } pf;
#pragma unroll
        for (int j = 0; j < 4; ++j) pf.w[j] = cvt_pk_bf16(at[8 * s + 2 * j], at[8 * s + 2 * j + 1]);
#pragma unroll
        for (int vt = 0; vt < 2; ++vt) {
            union { bf16x8 v; s16x4 h2[2]; } vf; vf.h2[0] = vfa[s][vt][0]; vf.h2[1] = vfa[s][vt][1];
            o[vt] = __builtin_amdgcn_mfma_f32_32x32x16_bf16(vf.v, pf.v, o[vt], 0, 0, 0); } }
#pragma unroll
    for (int vt = 0; vt < 2; ++vt)
#pragma unroll
        for (int s = 0; s < DK / 16; ++s) o[vt] = __builtin_amdgcn_mfma_f32_32x32x16_bf16(sfa[vt][s], qf[s], o[vt], 0, 0, 0);
    float ss = 0.f;
#pragma unroll
    for (int vt = 0; vt < 2; ++vt)
#pragma unroll
        for (int i = 0; i < 16; ++i) ss += o[vt][i] * o[vt][i];
    ss += __shfl_xor(ss, 32);
    const float rstd = 1.0f / sqrtf(ss * (1.0f / 64.0f) + RMS_EPS);
#pragma unroll
    for (int vt = 0; vt < 2; ++vt)
#pragma unroll
        for (int g = 0; g < 4; ++g) { const int v0 = 32 * vt + 8 * g + 4 * hh; const u32x2 gw = gwa[vt][g]; const f32x4 n4 = n4a[vt][g];
            const float y0 = o[vt][4 * g] * rstd * n4[0] * silu_f(bflo(gw.x)), y1 = o[vt][4 * g + 1] * rstd * n4[1] * silu_f(bfhi(gw.x));
            const float y2 = o[vt][4 * g + 2] * rstd * n4[2] * silu_f(bflo(gw.y)), y3 = o[vt][4 * g + 3] * rstd * n4[3] * silu_f(bfhi(gw.y));
            *(LAS unsigned*)(os + r32 * 64 + v0) = pack_o4(y0, y1, y2, y3); }
    flush_o_tile(os, orow, lane);
}

constexpr int RWC_HEADB = 28928;
constexpr int RWC_AL = 4 * RWC_HEADB, RWC_LWL = RWC_AL + 32 * 264 * 2;
static_assert(RWC_LWL + 32 * 264 * 2 <= LDSCTL_OFF, "rw_fused_unit LDS");
__device__ __forceinline__ void rw_fused_unit(LAS unsigned char* lds, int l, int b, int c) {
    const int tid = opaque_tid(), lane = tid & 63, wave = __builtin_amdgcn_readfirstlane(tid >> 6), h = wave >> 1, p = wave & 1, r32 = lane & 31, hh = lane >> 5;
    unsigned char* ws = KWS();
    const int bh = b * 4 + h; const size_t un = (size_t)bh * NCH + c;
    const int t0 = c * 32;
    const bf16* P = (const bf16*)(ws + WS_P) + ((size_t)b * T + t0) * PINP + PC_RW;
    const float* mu = KIN(I_RWMU) + (size_t)l * 1024;
    LAS bf16* XL = (LAS bf16*)lds;
    LAS bf16* AL = (LAS bf16*)(lds + RWC_AL);
    LAS bf16* LWL = (LAS bf16*)(lds + RWC_LWL);
    bf16x8 bwW[4], bwA[4], bwG[8]; float w0c, a0c;
    { const int ch = wave * 32 + r32;
      const bf16* w2T = (const bf16*)(ws + WS_LORA) + (size_t)l * 256 * 64 + (size_t)ch * 64 + 8 * hh;
      const bf16* a2T = (const bf16*)(ws + WS_LORA) + (size_t)(NL * 256 * 64) + (size_t)l * 256 * 64 + (size_t)ch * 64 + 8 * hh;
      const bf16* g2T = (const bf16*)(ws + WS_LORA) + (size_t)2 * (NL * 256 * 64) + (size_t)l * 256 * 128 + (size_t)ch * 128 + 8 * hh;
#pragma unroll
      for (int s = 0; s < 4; ++s) { bwW[s] = *(const bf16x8*)(w2T + 16 * s); bwA[s] = *(const bf16x8*)(a2T + 16 * s); }
#pragma unroll
      for (int s = 0; s < 8; ++s) bwG[s] = *(const bf16x8*)(g2T + 16 * s);
      w0c = KIN(I_RWW0)[l * 256 + ch]; a0c = KIN(I_RWA0)[l * 256 + ch]; }
    { const int cc = tid & 255, tp = tid >> 8; const float mc = mu[768 + cc];
      unsigned short xr[17];
#pragma unroll
      for (int j = 0; j < 17; ++j) { const int tk = tp * 16 + j - 1;
          if (j == 0) { const bool ok = (t0 + tk >= 0); const unsigned short v = P[(long)(ok ? tk : 0) * PINP + 768 + cc]; xr[0] = ok ? v : (unsigned short)0; }
          else xr[j] = P[(long)tk * PINP + 768 + cc]; }
#pragma unroll
      for (int j = 0; j < 16; ++j) { const float cur = bf2f(xr[j + 1]), prev = bf2f(xr[j]);
          float x = cur + (prev - cur) * mc;
          if (cc < 64) x = tanh_f(x); else if (cc >= 128) x = fast_sigmoid(x);
          XL[(tp * 16 + j) * 264 + cc] = (bf16)f2bf(x); } }
    lds_barrier();
    float mr, mk, mv, kkc, kac, rkc; unsigned short xrr[17], xkr[17], xvr[17];
    { const int ch = (wave & 3) * 64 + lane, tb = (wave >> 2) * 16;
      mr = mu[ch]; mk = mu[256 + ch]; mv = mu[512 + ch]; kkc = KIN(I_RWKK)[l * 256 + ch]; kac = KIN(I_RWKA)[l * 256 + ch]; rkc = KIN(I_RWRK)[l * 256 + ch];
#pragma unroll
      for (int j = 0; j < 17; ++j) { const int tk = tb + j - 1;
          if (j == 0) { const bool ok = (t0 + tk >= 0); const bf16* row = P + (long)(ok ? tk : 0) * PINP; const unsigned short v0 = row[ch], v1 = row[256 + ch], v2 = row[512 + ch];
              xrr[0] = ok ? v0 : (unsigned short)0; xkr[0] = ok ? v1 : (unsigned short)0; xvr[0] = ok ? v2 : (unsigned short)0; }
          else { const bf16* row = P + (long)tk * PINP; xrr[j] = row[ch]; xkr[j] = row[256 + ch]; xvr[j] = row[512 + ch]; } }
      __builtin_amdgcn_sched_barrier(0); }
    {
        const int ch = wave * 32 + r32;
        const LAS bf16* xa = XL + r32 * 264 + 8 * hh;
        {
            f32x16 acc;
#pragma unroll
            for (int i = 0; i < 16; ++i) acc[i] = 0.f;
#pragma unroll
            for (int s = 0; s < 4; ++s) { const bf16x8 A = *(const LAS bf16x8*)(xa + 16 * s);
                acc = __builtin_amdgcn_mfma_f32_32x32x16_bf16(A, bwW[s], acc, 0, 0, 0); }
#pragma unroll
            for (int r = 0; r < 16; ++r) { const int tok = rho16(r, hh);
                const float zw = w0c + acc[r];
                LWL[tok * 264 + ch] = (bf16)f2bf(-0.6065306597126334f * fast_sigmoid(zw)); }
        }
        __builtin_amdgcn_sched_barrier(0);
        {
            f32x16 acc;
#pragma unroll
            for (int i = 0; i < 16; ++i) acc[i] = 0.f;
#pragma unroll
            for (int s = 0; s < 4; ++s) { const bf16x8 A = *(const LAS bf16x8*)(xa + 64 + 16 * s);
                acc = __builtin_amdgcn_mfma_f32_32x32x16_bf16(A, bwA[s], acc, 0, 0, 0); }
#pragma unroll
            for (int r = 0; r < 16; ++r) AL[rho16(r, hh) * 264 + ch] = (bf16)f2bf(fast_sigmoid(a0c + acc[r]));
        }
        __builtin_amdgcn_sched_barrier(0);
        {
            f32x16 acc;
#pragma unroll
            for (int i = 0; i < 16; ++i) acc[i] = 0.f;
#pragma unroll
            for (int s = 0; s < 8; ++s) { const bf16x8 A = *(const LAS bf16x8*)(xa + 128 + 16 * s);
                acc = __builtin_amdgcn_mfma_f32_32x32x16_bf16(A, bwG[s], acc, 0, 0, 0); }
            bf16* gb = (bf16*)(ws + WS_GBUF) + ((size_t)b * T + t0) * 256 + ch;
#pragma unroll
            for (int r = 0; r < 16; ++r) gb[(size_t)rho16(r, hh) * 256] = (bf16)f2bf(acc[r]);
        }
    }
    lds_barrier();
    LAS unsigned char* L = lds + h * RWC_HEADB;
    LAS bf16* AT = (LAS bf16*)L;
    LAS bf16* BT = (LAS bf16*)(L + 4096);
    LAS bf16* KT = (LAS bf16*)(L + 8192);
    LAS bf16* ATT = (LAS bf16*)(L + 12288);
    LAS bf16* BHT = (LAS bf16*)(L + 16384);
    LAS bf16* KHT = (LAS bf16*)(L + 20480);
    LAS bf16* VT = (LAS bf16*)(L + 24576);
    LAS float* GC = (LAS float*)(L + 28672);
    LAS float* MAB = (LAS float*)(L + 4096);
    LAS bf16* MAK = (LAS bf16*)(L + 8192);
    LAS bf16* TM = (LAS bf16*)L;
    {
        const int hs = wave & 3, half = wave >> 2, d = lane, ch = hs * 64 + d, tb = half * 16; const size_t uns = (size_t)(b * 4 + hs) * NCH + c;
        LAS unsigned char* Ls = lds + hs * RWC_HEADB;
        LAS bf16* sAT = (LAS bf16*)Ls; LAS bf16* sBT = (LAS bf16*)(Ls + 4096); LAS bf16* sKT = (LAS bf16*)(Ls + 8192);
        LAS bf16* sATT = (LAS bf16*)(Ls + 12288); LAS bf16* sBHT = (LAS bf16*)(Ls + 16384); LAS bf16* sKHT = (LAS bf16*)(Ls + 20480); LAS bf16* sVT = (LAS bf16*)(Ls + 24576); LAS float* sGC = (LAS float*)(Ls + 28672);
        float lg0 = 0.f, lg1 = 0.f;
#pragma unroll
        for (int t = 0; t < 16; ++t) { lg0 += bf2f(LWL[t * 264 + ch]); lg1 += bf2f(LWL[(16 + t) * 264 + ch]); }
        const float lgend = lg0 + lg1;
        lds_barrier();
        float* bonp = (float*)(ws + WS_BONUS) + ((size_t)b * T + t0) * 4 + hs;
        float lg = half ? lg0 : 0.f; float elg = fast_exp(lg); const float eend = fast_exp(lgend);
#pragma unroll
        for (int t8 = 0; t8 < 2; ++t8) { u32x4 ap, bp, kp;
#pragma unroll
            for (int jj = 0; jj < 4; ++jj) { float at2[2], bh2[2], kh2[2];
#pragma unroll
                for (int e = 0; e < 2; ++e) { const int j = t8 * 8 + jj * 2 + e, t = tb + j;
                    const float rc = bf2f(xrr[j + 1]), kc = bf2f(xkr[j + 1]);
                    const float r = rc + (bf2f(xrr[j]) - rc) * mr, k = kc + (bf2f(xkr[j]) - kc) * mk;
                    const float av = bf2f(AL[t * 264 + ch]), lw = bf2f(LWL[t * 264 + ch]);
                    const float kkr = k * kkc, hk = k * (1.0f + (av - 1.0f) * kac);
                    const float ss = wave_sum(kkr * kkr); const float kk = kkr * __builtin_amdgcn_rsqf(fmaxf(ss, 1e-24f));
                    const float bon = wave_sum(r * hk * rkc);
                    const float aa = -kk, bb = kk * av;
                    const float elgp = elg; lg += lw; elg = fast_exp(lg);
                    const float ei = __builtin_amdgcn_rcpf(elg), at = aa * elgp, rt = r * elg, bt = bb * ei, kt = hk * ei, eh = eend * ei;
                    sAT[t * 64 + d] = (bf16)f2bf(at); sBT[t * 64 + d] = (bf16)f2bf(bt); sKT[t * 64 + d] = (bf16)f2bf(kt);
                    LWL[t * 264 + ch] = (bf16)f2bf(rt);
                    if (d == 0) bonp[t * 4] = bon;
                    at2[e] = at; bh2[e] = bb * eh; kh2[e] = hk * eh; }
                ap[jj] = pk2(at2[0], at2[1]); bp[jj] = pk2(bh2[0], bh2[1]); kp[jj] = pk2(kh2[0], kh2[1]); }
            *(LAS u32x4*)(sATT + d * 32 + tb + t8 * 8) = ap; *(LAS u32x4*)(sBHT + d * 32 + tb + t8 * 8) = bp; *(LAS u32x4*)(sKHT + d * 32 + tb + t8 * 8) = kp; }
        if (half == 0) sGC[d] = eend;
        bf16* VTg = (bf16*)(ws + WS_RVT) + uns * 2048 + d * 32 + tb;
#pragma unroll
        for (int t8 = 0; t8 < 2; ++t8) { u32x4 vp; float yv[8];
#pragma unroll
            for (int e = 0; e < 8; ++e) { const int j = t8 * 8 + e; const float xv = bf2f(xvr[j + 1]); yv[e] = xv + (bf2f(xvr[j]) - xv) * mv; }
#pragma unroll
            for (int jj = 0; jj < 4; ++jj) vp[jj] = pk2(yv[2 * jj], yv[2 * jj + 1]);
            *(LAS u32x4*)(sVT + d * 32 + tb + t8 * 8) = vp; *(u32x4*)(VTg + t8 * 8) = vp; }
    }
    lds_barrier();
    f32x16 accR[2];
    union { bf16x8 v; unsigned w[4]; } mfr[2];
    LAS u32x4* EX = (LAS u32x4*)(lds + RWC_AL + h * 2048);
    {
        f32x16 acc, acc2;
#pragma unroll
        for (int i = 0; i < 16; ++i) { acc[i] = 0.f; acc2[i] = 0.f; }
        const LAS bf16* Bsrc = p == 0 ? BT : KT;
#pragma unroll
        for (int s = 0; s < 4; ++s) { const bf16x8 A = *(const LAS bf16x8*)(AT + r32 * 64 + 16 * s + 8 * hh), B = *(const LAS bf16x8*)(Bsrc + r32 * 64 + 16 * s + 8 * hh);
            const bf16x8 Rf = *(const LAS bf16x8*)(LWL + r32 * 264 + h * 64 + 16 * s + 8 * hh);
            acc = __builtin_amdgcn_mfma_f32_32x32x16_bf16(A, B, acc, 0, 0, 0);
            acc2 = __builtin_amdgcn_mfma_f32_32x32x16_bf16(B, Rf, acc2, 0, 0, 0); }
#pragma unroll
        for (int r = 0; r < 16; ++r) if (rho16(r, hh) > r32) acc2[r] = 0.f;
#pragma unroll
        for (int s2 = 0; s2 < 2; ++s2) {
#pragma unroll
            for (int j = 0; j < 4; ++j) mfr[s2].w[j] = cvt_pk_bf16(acc2[8 * s2 + 2 * j], acc2[8 * s2 + 2 * j + 1]);
            if (p == 0) EX[s2 * 64 + lane] = (u32x4){mfr[s2].w[0], mfr[s2].w[1], mfr[s2].w[2], mfr[s2].w[3]}; }
        if (p == 0) {
#pragma unroll
            for (int r = 0; r < 16; ++r) { const int t = rho16(r, hh); MAB[t * 32 + r32] = (r32 < t) ? acc[r] : 0.f; }
        } else {
#pragma unroll
            for (int r = 0; r < 16; ++r) { const int t = rho16(r, hh); MAK[t * 32 + r32] = (bf16)f2bf((r32 < t) ? acc[r] : 0.f); }
        }
    }
    lds_barrier();
    if (p == 0) {
        const int cidx = r32; float tc[32];
#pragma unroll
        for (int t = 0; t < 32; ++t) { float acc0 = (t == cidx) ? 1.0f : 0.f, acc1 = 0.f;
#pragma unroll
            for (int s4 = 0; s4 < (t + 3) / 4; ++s4) { const f32x4 m4 = *(const LAS f32x4*)(MAB + t * 32 + 4 * s4);
#pragma unroll
                for (int e = 0; e < 4; ++e) { const int s = 4 * s4 + e; if (s < t) { if (e & 1) acc1 = fmaf(m4[e], tc[s], acc1); else acc0 = fmaf(m4[e], tc[s], acc0); } } }
            tc[t] = acc0 + acc1; }
#pragma unroll
        for (int t = 0; t < 32; ++t) if (hh == 0) TM[t * 32 + cidx] = (bf16)f2bf(tc[t]);
    } else {
#pragma unroll
        for (int vt = 0; vt < 2; ++vt) {
#pragma unroll
            for (int i = 0; i < 16; ++i) accR[vt][i] = 0.f;
#pragma unroll
            for (int s = 0; s < 2; ++s) { const bf16x8 A = *(const LAS bf16x8*)(MAK + r32 * 32 + 16 * s + 8 * hh), B = *(const LAS bf16x8*)(VT + (32 * vt + r32) * 32 + 16 * s + 8 * hh);
                accR[vt] = __builtin_amdgcn_mfma_f32_32x32x16_bf16(A, B, accR[vt], 0, 0, 0); } }
    }
    lds_barrier();
    if (p == 0) {
        f32x16 accW[2];
#pragma unroll
        for (int dt = 0; dt < 2; ++dt) {
#pragma unroll
            for (int i = 0; i < 16; ++i) accW[dt][i] = 0.f;
#pragma unroll
            for (int s = 0; s < 2; ++s) { const bf16x8 A = *(const LAS bf16x8*)(TM + r32 * 32 + 16 * s + 8 * hh), B = *(const LAS bf16x8*)(ATT + (32 * dt + r32) * 32 + 16 * s + 8 * hh);
                accW[dt] = __builtin_amdgcn_mfma_f32_32x32x16_bf16(A, B, accW[dt], 0, 0, 0); } }
        { LAS bf16* WL = ATT;
#pragma unroll
          for (int dt = 0; dt < 2; ++dt) { f32x16 acc;
#pragma unroll
              for (int i = 0; i < 16; ++i) acc[i] = 0.f;
#pragma unroll
              for (int s = 0; s < 2; ++s) { union { bf16x8 v; unsigned w[4]; } bf;
#pragma unroll
                  for (int j = 0; j < 4; ++j) bf.w[j] = cvt_pk_bf16(accW[dt][8 * s + 2 * j], accW[dt][8 * s + 2 * j + 1]);
                  acc = __builtin_amdgcn_mfma_f32_32x32x16_bf16(mfr[s].v, bf.v, acc, 0, 0, 0); }
#pragma unroll
              for (int r = 0; r < 16; ++r) { const int t = rho16(r, hh); WL[t * 64 + 32 * dt + r32] = (bf16)f2bf(acc[r] + bf2f(LWL[t * 264 + h * 64 + 32 * dt + r32])); } }
          u32x4* RGw = (u32x4*)((bf16*)(ws + WS_RR) + un * 2048);
#pragma unroll
          for (int i = 0; i < 4; ++i) RGw[i * 64 + lane] = *(const LAS u32x4*)(WL + (i * 64 + lane) * 8); }
        LAS bf16* PL = (LAS bf16*)(L + 4096);
        const int xs = r32 >> 4, xx = r32 & 15, hhA = (xx >> 2) & 1, jA = 4 * (xx >> 3) + (xx & 3);
#pragma unroll
        for (int dt = 0; dt < 2; ++dt)
#pragma unroll
            for (int dt2 = 0; dt2 < 2; ++dt2) { f32x16 acc;
#pragma unroll
                for (int i = 0; i < 16; ++i) acc[i] = 0.f;
#pragma unroll
                for (int s = 0; s < 2; ++s) { const LAS bf16* bp = BHT + (32 * dt + r32) * 32 + 16 * s + 4 * hh;
                    union { bf16x8 v; s16x4 h2[2]; } af; af.h2[0] = *(const LAS s16x4*)bp; af.h2[1] = *(const LAS s16x4*)(bp + 8);
                    union { bf16x8 v; unsigned w[4]; } bf;
#pragma unroll
                    for (int j = 0; j < 4; ++j) bf.w[j] = cvt_pk_bf16(accW[dt2][8 * s + 2 * j], accW[dt2][8 * s + 2 * j + 1]);
                    acc = __builtin_amdgcn_mfma_f32_32x32x16_bf16(af.v, bf.v, acc, 0, 0, 0); }
                if (dt == dt2) { const float gc = GC[32 * dt + r32];
#pragma unroll
                    for (int r = 0; r < 16; ++r) if (rho16(r, hh) == r32) acc[r] += gc; }
                LAS bf16* pf = PL + (((dt * 2 + dt2) * 2 + xs) * 64 + 32 * hhA) * 8 + jA;
#pragma unroll
                for (int r = 0; r < 16; ++r) pf[rho16(r, hh) * 8] = (bf16)f2bf(acc[r]); }
        { u32x4* PFp = (u32x4*)((bf16*)(ws + WS_RP) + un * 4096);
#pragma unroll
          for (int f = 0; f < 8; ++f) PFp[f * 64 + lane] = *(const LAS u32x4*)(PL + (f * 64 + lane) * 8); }
    } else {
        f32x16 accU[2];
#pragma unroll
        for (int vt = 0; vt < 2; ++vt) {
#pragma unroll
            for (int i = 0; i < 16; ++i) accU[vt][i] = 0.f;
#pragma unroll
            for (int s = 0; s < 2; ++s) { const LAS bf16* tp = TM + r32 * 32 + 16 * s + 4 * hh;
                union { bf16x8 v; s16x4 h2[2]; } af; af.h2[0] = *(const LAS s16x4*)tp; af.h2[1] = *(const LAS s16x4*)(tp + 8);
                union { bf16x8 v; unsigned w[4]; } bf;
#pragma unroll
                for (int j = 0; j < 4; ++j) bf.w[j] = cvt_pk_bf16(accR[vt][8 * s + 2 * j], accR[vt][8 * s + 2 * j + 1]);
                accU[vt] = __builtin_amdgcn_mfma_f32_32x32x16_bf16(af.v, bf.v, accU[vt], 0, 0, 0); } }
        bf16* UGp = (bf16*)(ws + WS_RU) + un * 2048;
#pragma unroll
        for (int vt = 0; vt < 2; ++vt) { f32x16 acc;
#pragma unroll
            for (int i = 0; i < 16; ++i) acc[i] = 0.f;
#pragma unroll
            for (int s = 0; s < 2; ++s) { union { bf16x8 v; unsigned w[4]; } fu; union { bf16x8 v; u32x4 q; } fb;
#pragma unroll
                for (int j = 0; j < 4; ++j) fu.w[j] = cvt_pk_bf16(accU[vt][8 * s + 2 * j], accU[vt][8 * s + 2 * j + 1]);
                fb.q = EX[s * 64 + lane];
                acc = __builtin_amdgcn_mfma_f32_32x32x16_bf16(fu.v, fb.v, acc, 0, 0, 0);
                const LAS bf16* vp = VT + (32 * vt + r32) * 32 + 16 * s + 4 * hh;
                union { bf16x8 v; s16x4 h2[2]; } vf; vf.h2[0] = *(const LAS s16x4*)vp; vf.h2[1] = *(const LAS s16x4*)(vp + 8);
                acc = __builtin_amdgcn_mfma_f32_32x32x16_bf16(vf.v, mfr[s].v, acc, 0, 0, 0); }
#pragma unroll
            for (int g2 = 0; g2 < 2; ++g2) *(u32x4*)(UGp + ((vt * 2 + g2) * 64 + lane) * 8) = (u32x4){cvt_pk_bf16(acc[8 * g2], acc[8 * g2 + 1]), cvt_pk_bf16(acc[8 * g2 + 2], acc[8 * g2 + 3]),
                                                                                                 cvt_pk_bf16(acc[8 * g2 + 4], acc[8 * g2 + 5]), cvt_pk_bf16(acc[8 * g2 + 6], acc[8 * g2 + 7])}; }
        bf16* QFp = (bf16*)(ws + WS_RQ) + un * 4096;
#pragma unroll
        for (int vt = 0; vt < 2; ++vt)
#pragma unroll
            for (int dt = 0; dt < 2; ++dt) { f32x16 acc;
#pragma unroll
                for (int i = 0; i < 16; ++i) acc[i] = 0.f;
#pragma unroll
                for (int s = 0; s < 2; ++s) { const LAS bf16* bp = BHT + (32 * dt + r32) * 32 + 16 * s + 4 * hh;
                    union { bf16x8 v; s16x4 h2[2]; } af; af.h2[0] = *(const LAS s16x4*)bp; af.h2[1] = *(const LAS s16x4*)(bp + 8);
                    union { bf16x8 v; unsigned w[4]; } bf;
#pragma unroll
                    for (int j = 0; j < 4; ++j) bf.w[j] = cvt_pk_bf16(accU[vt][8 * s + 2 * j], accU[vt][8 * s + 2 * j + 1]);
                    acc = __builtin_amdgcn_mfma_f32_32x32x16_bf16(af.v, bf.v, acc, 0, 0, 0);
                    const bf16x8 A2 = *(const LAS bf16x8*)(KHT + (32 * dt + r32) * 32 + 16 * s + 8 * hh), B2 = *(const LAS bf16x8*)(VT + (32 * vt + r32) * 32 + 16 * s + 8 * hh);
                    acc = __builtin_amdgcn_mfma_f32_32x32x16_bf16(A2, B2, acc, 0, 0, 0); }
#pragma unroll
                for (int g2 = 0; g2 < 2; ++g2) *(u32x4*)(QFp + (((vt * 2 + dt) * 2 + g2) * 64 + lane) * 8) = (u32x4){cvt_pk_bf16(acc[8 * g2], acc[8 * g2 + 1]), cvt_pk_bf16(acc[8 * g2 + 2], acc[8 * g2 + 3]),
                                                                                                                   cvt_pk_bf16(acc[8 * g2 + 4], acc[8 * g2 + 5]), cvt_pk_bf16(acc[8 * g2 + 6], acc[8 * g2 + 7])}; }
    }
    lds_barrier();
}
__device__ __forceinline__ void rw_m2_wave(int lane, int bh, int vt) {
    unsigned char* ws = KWS();
    const bf16* PF = (const bf16*)(ws + WS_RP) + (size_t)bh * NCH * 4096 + lane * 8;
    const bf16* QF = (const bf16*)(ws + WS_RQ) + (size_t)bh * NCH * 4096 + (size_t)vt * 2048 + lane * 8;
    bf16* SG = (bf16*)(ws + WS_RS) + (size_t)bh * NCH * 4096 + (size_t)vt * 2048 + lane * 8;
    f32x16 S[2];
#pragma unroll
    for (int dt = 0; dt < 2; ++dt)
#pragma unroll
        for (int i = 0; i < 16; ++i) S[dt][i] = 0.f;
    bf16x8 pA[8], pB[8], pC[8]; u32x4 qA[4], qB[4], qC[4];
#pragma unroll
    for (int f = 0; f < 8; ++f) { pA[f] = (bf16x8){0, 0, 0, 0, 0, 0, 0, 0}; pB[f] = pA[f]; pC[f] = pA[f]; }
#pragma unroll
    for (int f = 0; f < 4; ++f) { qA[f] = (u32x4){0u, 0u, 0u, 0u}; qB[f] = qA[f]; qC[f] = qA[f]; }
#define RWM2_LD4(d0, d1, d2, d3, ptr) asm volatile("global_load_dwordx4 %0, %4, off\n\tglobal_load_dwordx4 %1, %4, off offset:1024\n\tglobal_load_dwordx4 %2, %4, off offset:2048\n\tglobal_load_dwordx4 %3, %4, off offset:3072" \
        : "+v"(d0), "+v"(d1), "+v"(d2), "+v"(d3) : "v"(ptr) : "memory")
#define RWM2_LOAD(P_, Q_, c_) do { const int _c = (c_) < NCH ? (c_) : NCH - 1; const bf16* _p0 = PF + (size_t)_c * 4096; const bf16* _p1 = _p0 + 2048; const bf16* _q = QF + (size_t)_c * 4096; \
        RWM2_LD4(P_[0], P_[1], P_[2], P_[3], _p0); RWM2_LD4(P_[4], P_[5], P_[6], P_[7], _p1); RWM2_LD4(Q_[0], Q_[1], Q_[2], Q_[3], _q); } while (0)
#define RWM2_WAIT(P_, Q_) asm volatile("s_waitcnt vmcnt(24)" : "+v"(P_[0]), "+v"(P_[1]), "+v"(P_[2]), "+v"(P_[3]), "+v"(P_[4]), "+v"(P_[5]), "+v"(P_[6]), "+v"(P_[7]), "+v"(Q_[0]), "+v"(Q_[1]), "+v"(Q_[2]), "+v"(Q_[3]) :: "memory")
#define RWM2_STEP(P_, Q_, c_) do { \
        RWM2_WAIT(P_, Q_); \
        union { bf16x8 v; unsigned w[4]; } sb[2][2]; \
        _Pragma("unroll") for (int dt2 = 0; dt2 < 2; ++dt2) _Pragma("unroll") for (int s = 0; s < 2; ++s) { \
            _Pragma("unroll") for (int j = 0; j < 4; ++j) sb[dt2][s].w[j] = cvt_pk_bf16(S[dt2][8 * s + 2 * j], S[dt2][8 * s + 2 * j + 1]); \
            *(bf16x8*)(SG + (size_t)(c_) * 4096 + (dt2 * 2 + s) * 512) = sb[dt2][s].v; } \
        f32x16 N[2]; \
        _Pragma("unroll") for (int dt = 0; dt < 2; ++dt) { \
            _Pragma("unroll") for (int g2 = 0; g2 < 2; ++g2) _Pragma("unroll") for (int j = 0; j < 4; ++j) { N[dt][8 * g2 + 2 * j] = bflo(Q_[dt * 2 + g2][j]); N[dt][8 * g2 + 2 * j + 1] = bfhi(Q_[dt * 2 + g2][j]); } \
            _Pragma("unroll") for (int dt2 = 0; dt2 < 2; ++dt2) _Pragma("unroll") for (int s = 0; s < 2; ++s) N[dt] = __builtin_amdgcn_mfma_f32_32x32x16_bf16(P_[(dt * 2 + dt2) * 2 + s], sb[dt2][s].v, N[dt], 0, 0, 0); } \
        S[0] = N[0]; S[1] = N[1]; } while (0)
    RWM2_LOAD(pA, qA, 0); RWM2_LOAD(pB, qB, 1); RWM2_LOAD(pC, qC, 2);
#pragma unroll 1
    for (int c = 0; c < NCH - 1; c += 3) {
        RWM2_STEP(pA, qA, c); RWM2_LOAD(pA, qA, c + 3);
        RWM2_STEP(pB, qB, c + 1); RWM2_LOAD(pB, qB, c + 4);
        RWM2_STEP(pC, qC, c + 2); RWM2_LOAD(pC, qC, c + 5);
    }
    static_assert((NCH - 1) % 3 == 0, "chunk loop: 85 rounds of three steps, then the last chunk");
    RWM2_STEP(pA, qA, NCH - 1);
    asm volatile("s_waitcnt vmcnt(0)" : "+v"(pB[0]), "+v"(pB[1]), "+v"(pB[2]), "+v"(pB[3]), "+v"(pB[4]), "+v"(pB[5]), "+v"(pB[6]), "+v"(pB[7]), "+v"(qB[0]), "+v"(qB[1]), "+v"(qB[2]), "+v"(qB[3]) :: "memory");
    asm volatile("" : "+v"(pC[0]), "+v"(pC[1]), "+v"(pC[2]), "+v"(pC[3]), "+v"(pC[4]), "+v"(pC[5]), "+v"(pC[6]), "+v"(pC[7]), "+v"(qC[0]), "+v"(qC[1]), "+v"(qC[2]), "+v"(qC[3]) :: "memory");
#undef RWM2_LD4
#undef RWM2_LOAD
#undef RWM2_WAIT
#undef RWM2_STEP
}
__device__ __forceinline__ bf16x8 ld_perm8(const bf16* p) { union { bf16x8 v; s16x4 h2[2]; } f; f.h2[0] = *(const s16x4*)p; f.h2[1] = *(const s16x4*)(p + 8); return f.v; }
__device__ __forceinline__ void rw_m3_task(int lane, int l, int bh, int c, LAS unsigned char* os) {
    unsigned char* ws = KWS();
    const int r32 = lane & 31, hh = lane >> 5, b = bh >> 2, h = bh & 3; const size_t un = (size_t)bh * NCH + c; const size_t tok0 = (size_t)b * T + c * 32;
    const bf16* RGp = (const bf16*)(ws + WS_RR) + un * 2048 + r32 * 64 + 4 * hh;
    const bf16* SGp = (const bf16*)(ws + WS_RS) + un * 4096 + lane * 8; const bf16* VTp = (const bf16*)(ws + WS_RVT) + un * 2048 + r32 * 32 + 4 * hh;
    const bf16* UGp = (const bf16*)(ws + WS_RU) + un * 2048 + lane * 8;
    f32x16 Y[2], Z[2];
    const float bon = ((const float*)(ws + WS_BONUS))[(tok0 + r32) * 4 + h];
#pragma unroll
    for (int vt = 0; vt < 2; ++vt)
#pragma unroll
        for (int g2 = 0; g2 < 2; ++g2) { const u32x4 u4 = *(const u32x4*)(UGp + (vt * 2 + g2) * 512);
#pragma unroll
            for (int j = 0; j < 4; ++j) { Y[vt][8 * g2 + 2 * j] = bflo(u4[j]); Y[vt][8 * g2 + 2 * j + 1] = bfhi(u4[j]); } }
#pragma unroll
    for (int i = 0; i < 16; ++i) { Z[0][i] = 0.f; Z[1][i] = 0.f; }
#pragma unroll
    for (int ks = 0; ks < 4; ++ks) {
        const bf16x8 rf = ld_perm8(RGp + 16 * ks);
        const bf16x8 s0 = *(const bf16x8*)(SGp + ks * 512), s1 = *(const bf16x8*)(SGp + 2048 + ks * 512);
        Y[0] = __builtin_amdgcn_mfma_f32_32x32x16_bf16(s0, rf, Y[0], 0, 0, 0); Y[1] = __builtin_amdgcn_mfma_f32_32x32x16_bf16(s1, rf, Y[1], 0, 0, 0); }
#pragma unroll
    for (int s = 0; s < 2; ++s) {
        union { bf16x8 v; unsigned short e[8]; } db;
#pragma unroll
        for (int j = 0; j < 8; ++j) db.e[j] = (16 * s + 8 * (j >> 2) + 4 * hh + (j & 3) == r32) ? (unsigned short)f2bf(bon) : (unsigned short)0;
#pragma unroll
        for (int vt = 0; vt < 2; ++vt) {
            const bf16* vp = VTp + (size_t)vt * 32 * 32 + 16 * s;
            union { bf16x8 v; s16x4 h2[2]; } vf; vf.h2[0] = *(const s16x4*)vp; vf.h2[1] = *(const s16x4*)(vp + 8);
            Z[vt] = __builtin_amdgcn_mfma_f32_32x32x16_bf16(vf.v, db.v, Z[vt], 0, 0, 0); } }
    float sm = 0.f;
#pragma unroll
    for (int vt = 0; vt < 2; ++vt)
#pragma unroll
        for (int i = 0; i < 16; ++i) sm += Y[vt][i];
    sm += __shfl_xor(sm, 32); const float mu = sm * (1.0f / 64.0f);
    float q = 0.f;
#pragma unroll
    for (int vt = 0; vt < 2; ++vt)
#pragma unroll
        for (int i = 0; i < 16; ++i) { const float dd = Y[vt][i] - mu; q += dd * dd; }
    q += __shfl_xor(q, 32); const float rstd = 1.0f / sqrtf(q * (1.0f / 64.0f) + RW_LN_EPS);
    const size_t tok = tok0 + r32;
    const bf16* gp = (const bf16*)(ws + WS_GBUF) + tok * 256 + h * 64; unsigned char* od = (unsigned char*)(ws + WS_O) + tok * D + 512 + h * 64;
    const float* lnw = KIN(I_RWLNW) + l * 256 + h * 64; const float* lnb = KIN(I_RWLNB) + l * 256 + h * 64;
    f32x4 w4a[2][4], b4a[2][4]; u32x2 gwa[2][4];
#pragma unroll
    for (int vt = 0; vt < 2; ++vt)
#pragma unroll
        for (int g = 0; g < 4; ++g) { const int v0 = 32 * vt + 8 * g + 4 * hh; w4a[vt][g] = *(const f32x4*)(lnw + v0); b4a[vt][g] = *(const f32x4*)(lnb + v0); gwa[vt][g] = *(const u32x2*)(gp + v0); }
    __builtin_amdgcn_sched_barrier(0);
#pragma unroll
    for (int vt = 0; vt < 2; ++vt)
#pragma unroll
        for (int g = 0; g < 4; ++g) { const int v0 = 32 * vt + 8 * g + 4 * hh; const f32x4 w4 = w4a[vt][g], b4 = b4a[vt][g]; const u32x2 gw = gwa[vt][g];
            const float y0 = ((Y[vt][4 * g] - mu) * rstd * w4[0] + b4[0] + Z[vt][4 * g]) * bflo(gw.x), y1 = ((Y[vt][4 * g + 1] - mu) * rstd * w4[1] + b4[1] + Z[vt][4 * g + 1]) * bfhi(gw.x);
            const float y2 = ((Y[vt][4 * g + 2] - mu) * rstd * w4[2] + b4[2] + Z[vt][4 * g + 2]) * bflo(gw.y), y3 = ((Y[vt][4 * g + 3] - mu) * rstd * w4[3] + b4[3] + Z[vt][4 * g + 3]) * bfhi(gw.y);
            *(LAS unsigned*)(os + r32 * 64 + v0) = pack_o4(y0, y1, y2, y3); }
    flush_o_tile(os, (unsigned char*)(ws + WS_O) + tok0 * D + 512 + h * 64, lane);
}

__device__ __forceinline__ void c1_phase(LAS unsigned char* lds, int l, int vcu, int G) {
    for (int u = vcu, k = 0; u < NB * NCH; u += G, ++k) {
        const int b = (G == 256) ? (vcu >> 5) : (u >> 8), c = (G == 256) ? 255 - ((vcu & 31) + 32 * k) : (u & 255);
        for (int q = 0; q <= PHREP(16); ++q) rw_fused_unit(lds, l, b, c);
        for (int q = 0; q <= PHREP(17); ++q) hg_fused_unit(lds, l, b, c);
        for (int q = 0; q <= PHREP(18); ++q) gla_fused_unit(lds, l, b, c); }
}
__device__ __forceinline__ void m3_gh_phase(LAS unsigned char* lds, int l, int vcu, int G) {
    const int tid = opaque_tid(), lane = tid & 63, wave = __builtin_amdgcn_readfirstlane(tid >> 6);
    unsigned char* ws = KWS();
    const int gw = vcu * NWAVES + wave, NGW = G * NWAVES;
    const bf16* P = (const bf16*)(ws + WS_P); unsigned char* O = (unsigned char*)(ws + WS_O);
    const float* gng = KIN(I_GLANG) + l * 256; const float* hng = KIN(I_HGNG) + l * 256;
    for (int task = gw; task < 24576; task += NGW) {
        const int un = task & 8191, bh = un >> 8, c = un & 255, b = bh >> 2, h = bh & 3; const size_t tok0 = (size_t)b * T + c * 32;
        if (task >= 16384) { for (int q = 0; q <= PHREP(19); ++q) rw_m3_task(lane, l, bh, c, lds + wave * 2048); continue; }
        for (int q = 0; q <= PHREP(20); ++q)
        if (task < 8192) m3_gh_task<64>(lane, (const bf16*)(ws + WS_HQ) + (size_t)un * 2048, (const bf16*)(ws + WS_HK) + (size_t)un * 2048, (const bf16*)(ws + WS_HVT) + (size_t)un * 2048, (const bf16*)(ws + WS_HS) + (size_t)un * 4096,
                                         P + tok0 * PINP + PC_HG + h * 64, hng + h * 64, O + tok0 * D + 256 + h * 64, lds + wave * 2048);
        else m3_gh_task<32>(lane, (const bf16*)(ws + WS_GQ) + (size_t)un * 1024, (const bf16*)(ws + WS_GK) + (size_t)un * 1024, (const bf16*)(ws + WS_GVT) + (size_t)un * 2048, (const bf16*)(ws + WS_GS) + (size_t)un * 2048,
                            P + tok0 * PINP + PC_GOUT + h * 64, gng + h * 64, O + tok0 * D + h * 64, lds + wave * 2048);
    }
}

__device__ __forceinline__ void xattn_units(LAS unsigned char* lds, int l, int first, int last, int stride) {
    const int tid = opaque_tid(), lane = tid & 63, wave = __builtin_amdgcn_readfirstlane(tid >> 6), r32 = lane & 31, hh = lane >> 5;
    const bf16* P = (const bf16*)(KWS() + WS_P); const bf16* MKV = (const bf16*)(KWS() + WS_MKV); unsigned char* O = (unsigned char*)(KWS() + WS_O);
    LAS bf16* KL = (LAS bf16*)lds;
    LAS bf16* VT = (LAS bf16*)(lds + 256 * 72 * 2);
    int cur_bh = -1;
    for (int u = first; u < last; u += stride) {
        const int bh = u >> 5, qb = u & 31, b = bh >> 2, h = bh & 3;
        if (bh != cur_bh) {
            lds_barrier();
            for (int i = tid; i < 256 * 8; i += NTHR) { const int key = i >> 3, c8 = i & 7;
                const bf16* src = MKV + (size_t)(b * 256 + key) * 2048 + l * 512 + h * 64 + c8 * 8;
                *(LAS u32x4*)(KL + key * 72 + c8 * 8) = *(const u32x4*)src;
                const u32x4 vv = *(const u32x4*)(src + 256);
                LAS bf16* vd = VT + (c8 * 8) * 264 + key;
                vd[0 * 264] = (bf16)(vv.x & 0xffff); vd[1 * 264] = (bf16)(vv.x >> 16); vd[2 * 264] = (bf16)(vv.y & 0xffff); vd[3 * 264] = (bf16)(vv.y >> 16);
                vd[4 * 264] = (bf16)(vv.z & 0xffff); vd[5 * 264] = (bf16)(vv.z >> 16); vd[6 * 264] = (bf16)(vv.w & 0xffff); vd[7 * 264] = (bf16)(vv.w >> 16); }
            lds_barrier();
            cur_bh = bh;
        }
        const int q = b * T + qb * 256 + wave * 32 + r32;
        bf16x8 qf[4];
#pragma unroll
        for (int s = 0; s < 4; ++s) qf[s] = *(const bf16x8*)(P + (size_t)q * PINP + PC_MQ + h * 64 + 16 * s + 8 * hh);
        f32x16 sc[8];
#pragma unroll
        for (int kt = 0; kt < 8; ++kt) {
#pragma unroll
            for (int i = 0; i < 16; ++i) sc[kt][i] = 0.f;
#pragma unroll
            for (int s = 0; s < 4; ++s) { const bf16x8 kf = *(const LAS bf16x8*)(KL + (kt * 32 + r32) * 72 + 16 * s + 8 * hh);
                sc[kt] = __builtin_amdgcn_mfma_f32_32x32x16_bf16(kf, qf[s], sc[kt], 0, 0, 0); }
        }
        float m = -3.0e38f;
#pragma unroll
        for (int kt = 0; kt < 8; ++kt)
#pragma unroll
            for (int i = 0; i < 16; ++i) m = fmaxf(m, sc[kt][i]);
        m = fmaxf(m, __shfl_xor(m, 32));
        float sum = 0.f;
        const float c2 = 0.125f * 1.4426950408889634f;
#pragma unroll
        for (int kt = 0; kt < 8; ++kt)
#pragma unroll
            for (int i = 0; i < 16; ++i) { const float e = __builtin_amdgcn_exp2f((sc[kt][i] - m) * c2); sc[kt][i] = e; sum += e; }
        sum += __shfl_xor(sum, 32);
        const float inv = 1.0f / sum;
        f32x16 oa[2];
#pragma unroll
        for (int vt = 0; vt < 2; ++vt)
#pragma unroll
            for (int i = 0; i < 16; ++i) oa[vt][i] = 0.f;
#pragma unroll
        for (int kt = 0; kt < 8; ++kt)
#pragma unroll
            for (int s = 0; s < 2; ++s) {
                union { bf16x8 v; unsigned w[4]; } pf;
#pragma unroll
                for (int j = 0; j < 4; ++j) pf.w[j] = cvt_pk_bf16(sc[kt][8 * s + 2 * j], sc[kt][8 * s + 2 * j + 1]);
#pragma unroll
                for (int vt = 0; vt < 2; ++vt) {
                    const LAS bf16* vp = VT + (vt * 32 + r32) * 264 + kt * 32 + 16 * s + 4 * hh;
                    union { bf16x8 v; s16x4 h2[2]; } vf; vf.h2[0] = *(const LAS s16x4*)vp; vf.h2[1] = *(const LAS s16x4*)(vp + 8);
                    oa[vt] = __builtin_amdgcn_mfma_f32_32x32x16_bf16(vf.v, pf.v, oa[vt], 0, 0, 0); }
            }
        unsigned char* orow = O + (size_t)q * D + 768 + h * 64;
#pragma unroll
        for (int vt = 0; vt < 2; ++vt)
#pragma unroll
            for (int g = 0; g < 4; ++g) store_o4(orow + vt * 32 + 8 * g + 4 * hh, oa[vt][4 * g] * inv, oa[vt][4 * g + 1] * inv, oa[vt][4 * g + 2] * inv, oa[vt][4 * g + 3] * inv);
    }
    lds_barrier();
}

__device__ __forceinline__ void m2_phase(LAS unsigned char* lds, int l, int bx, int G) {
    unsigned char* ws = KWS();
    const int tid = opaque_tid(), lane = tid & 63, wave = __builtin_amdgcn_readfirstlane(tid >> 6);
    const int nrw = (G >= 128) ? 64 : 0;
    if (nrw) { if (bx < nrw && wave == 0) for (int q = 0; q <= PHREP(22); ++q) rw_m2_wave(lane, bx >> 1, bx & 1); }
    else { if (wave == 0) for (int q = bx; q < 64; q += G) rw_m2_wave(lane, q >> 1, q & 1); }
    if (nrw && bx >= nrw) {
        const int nth = (G - nrw) * NTHR;
        const int gt = (bx - nrw) * NTHR + tid;
        for (int q = 0; q <= PHREP(23); ++q)
        for (int e = gt; e < 98304; e += nth) {
            if (e < 65536) m2_gh_elem2<64>(e, (const bf16*)(ws + WS_HDS), (const float*)(ws + WS_HBE), (bf16*)(ws + WS_HS));
            else m2_gh_elem2<32>(e - 65536, (const bf16*)(ws + WS_GDS), (const float*)(ws + WS_GBE), (bf16*)(ws + WS_GS)); }
    }
    if (nrw == 0) { __syncthreads(); for (int e = bx * NTHR + tid; e < 98304; e += G * NTHR) {
            if (e < 65536) m2_gh_elem2<64>(e, (const bf16*)(ws + WS_HDS), (const float*)(ws + WS_HBE), (bf16*)(ws + WS_HS));
            else m2_gh_elem2<32>(e - 65536, (const bf16*)(ws + WS_GDS), (const float*)(ws + WS_GBE), (bf16*)(ws + WS_GS)); } }
    if (nrw == 0 || bx >= nrw) {
        const int nb = G - nrw, r = bx - nrw;
        const int per = (1024 + nb - 1) / nb, lo = r * per, hi = (lo + per < 1024) ? lo + per : 1024;
        for (int q = 0; q <= PHREP(24); ++q) xattn_units(lds, l, lo, hi, 1);
    }
}

__device__ __forceinline__ void ln1_router_phase(LAS unsigned char* lds, int l, int bx, int G) {
    const int tid = opaque_tid(), lane = tid & 63, wave = __builtin_amdgcn_readfirstlane(tid >> 6);
    LAS float* X = (LAS float*)lds;
    LAS float* PART = (LAS float*)(lds + 16 * 1028 * 4);
    LAS int* HIST = (LAS int*)(lds + 16 * 1028 * 4 + 8 * 16 * 32 * 4);
    LAS f32x4* GB = (LAS f32x4*)(lds + 16 * 1028 * 4 + 8 * 16 * 32 * 4 + 256);
    const float* xin = KIN(I_X); const bf16* xinb = (const bf16*)(KWS() + WS_XB);
    const bf16* HM = (const bf16*)(KWS() + WS_HMIX);
    bf16* X1B = (bf16*)(KWS() + WS_X1B); unsigned char* X1Q = (unsigned char*)(KWS() + WS_XF);
    const float* g1 = KIN(I_LN1G) + l * D; const float* b1 = KIN(I_LN1B) + l * D;
    const float* rw = KIN(I_RTW) + (size_t)l * D * NE; const float* rb = KIN(I_RTB) + l * NE;
    int* tok_e = (int*)(KWS() + WS_ROUTE); float* tok_g = (float*)(KWS() + WS_ROUTE + 1 * MiB);
    if (tid < 32) HIST[tid] = 0;
    if (tid < 256) { GB[tid] = ((const f32x4*)g1)[tid]; GB[256 + tid] = ((const f32x4*)b1)[tid]; }
    const float rbe = rb[tid & 31];
    bf16x8 rwH[4][2], rwL[4][2];
    { const int q = lane >> 4, e = lane & 15;
#pragma unroll
      for (int s = 0; s < 4; ++s)
#pragma unroll
          for (int nt = 0; nt < 2; ++nt) { union { bf16x8 v; unsigned w[4]; } fh, fl;
#pragma unroll
              for (int j = 0; j < 4; ++j) { const float* p = rw + (size_t)(128 * wave + 32 * s + 8 * q + 2 * j) * NE + 16 * nt + e; const float v0 = p[0], v1 = p[NE];
                  const unsigned h = cvt_pk_bf16(v0, v1); fh.w[j] = h; fl.w[j] = cvt_pk_bf16(v0 - bflo(h), v1 - bfhi(h)); }
              rwH[s][nt] = fh.v; rwL[s][nt] = fl.v; } }
    lds_barrier();
    f32x4 xraw[2][4]; u32x2 xbraw[2][4], hraw[2][4];
#define LN1_LOAD(it_) do { const size_t _tok = (size_t)(it_) * 16 + wave * 2; const u32x2* _hr = (const u32x2*)(HM + _tok * D) + lane; \
        if (l == 0) { const f32x4* _xr = (const f32x4*)(xin + _tok * D) + lane;        \
            _Pragma("unroll") for (int tt = 0; tt < 2; ++tt) _Pragma("unroll") for (int j = 0; j < 4; ++j) xraw[tt][j] = _xr[tt * 256 + 64 * j]; } \
        else { const u32x2* _xbr = (const u32x2*)(xinb + _tok * D) + lane; \
            _Pragma("unroll") for (int tt = 0; tt < 2; ++tt) _Pragma("unroll") for (int j = 0; j < 4; ++j) xbraw[tt][j] = _xbr[tt * 256 + 64 * j]; } \
        _Pragma("unroll") for (int tt = 0; tt < 2; ++tt) _Pragma("unroll") for (int j = 0; j < 4; ++j) hraw[tt][j] = _hr[tt * 256 + 64 * j]; } while (0)
    if (bx < NTOK / 16) LN1_LOAD(bx);
    for (int it = bx; it < NTOK / 16; it += G) {
        f32x4 vv[2][4];
#pragma unroll
        for (int tt = 0; tt < 2; ++tt)
#pragma unroll
            for (int j = 0; j < 4; ++j) { f32x4 xv; if (l == 0) xv = xraw[tt][j]; else { const u32x2 xw = xbraw[tt][j]; xv = (f32x4){bflo(xw.x), bfhi(xw.x), bflo(xw.y), bfhi(xw.y)}; } const u32x2 hw = hraw[tt][j];
                vv[tt][j][0] = DN_ALPHA * xv[0] + bflo(hw.x); vv[tt][j][1] = DN_ALPHA * xv[1] + bfhi(hw.x); vv[tt][j][2] = DN_ALPHA * xv[2] + bflo(hw.y); vv[tt][j][3] = DN_ALPHA * xv[3] + bfhi(hw.y); }
        if (it + G < NTOK / 16) LN1_LOAD(it + G);
#pragma unroll
        for (int tt = 0; tt < 2; ++tt) { const int ti = wave * 2 + tt; const size_t tok = (size_t)it * 16 + ti;
            f32x4 v[4]; float s = 0.f;
#pragma unroll
            for (int j = 0; j < 4; ++j) { v[j] = vv[tt][j]; s += (v[j][0] + v[j][1]) + (v[j][2] + v[j][3]); }
            const float mean = wave_sum(s) * (1.0f / D); float s2 = 0.f;
#pragma unroll
            for (int j = 0; j < 4; ++j) { v[j] = v[j] - mean; s2 += (v[j][0] * v[j][0] + v[j][1] * v[j][1]) + (v[j][2] * v[j][2] + v[j][3] * v[j][3]); }
            const float rstd = 1.0f / sqrtf(wave_sum(s2) * (1.0f / D) + LN_EPS);
#pragma unroll
            for (int j = 0; j < 4; ++j) { const f32x4 gg = GB[lane + 64 * j], bb = GB[256 + lane + 64 * j];
                const f32x4 y = v[j] * rstd * gg + bb;
                *((u32x2*)(X1B + tok * D) + lane + 64 * j) = (u32x2){pk2(y[0], y[1]), pk2(y[2], y[3])};
                { int w = __builtin_amdgcn_cvt_pk_fp8_f32(y[0], y[1], 0, false); w = __builtin_amdgcn_cvt_pk_fp8_f32(y[2], y[3], w, true); *((unsigned*)(X1Q + tok * D) + lane + 64 * j) = (unsigned)w; }
                *(LAS f32x4*)(X + ti * 1028 + 4 * lane + 256 * j) = y; }
        }
        lds_barrier();
        {
            const int q = lane >> 4, r = lane & 15;
            f32x4 acc0 = (f32x4){0.f, 0.f, 0.f, 0.f}, acc1 = (f32x4){0.f, 0.f, 0.f, 0.f};
            const LAS float* xa = X + r * 1028 + 128 * wave + 8 * q;
#pragma unroll
            for (int s = 0; s < 4; ++s) { const f32x4 x0 = *(const LAS f32x4*)(xa + 32 * s), x1 = *(const LAS f32x4*)(xa + 32 * s + 4);
                union { bf16x8 v; unsigned w[4]; } ah, al;
                ah.w[0] = cvt_pk_bf16(x0[0], x0[1]); ah.w[1] = cvt_pk_bf16(x0[2], x0[3]); ah.w[2] = cvt_pk_bf16(x1[0], x1[1]); ah.w[3] = cvt_pk_bf16(x1[2], x1[3]);
                al.w[0] = cvt_pk_bf16(x0[0] - bflo(ah.w[0]), x0[1] - bfhi(ah.w[0])); al.w[1] = cvt_pk_bf16(x0[2] - bflo(ah.w[1]), x0[3] - bfhi(ah.w[1]));
                al.w[2] = cvt_pk_bf16(x1[0] - bflo(ah.w[2]), x1[1] - bfhi(ah.w[2])); al.w[3] = cvt_pk_bf16(x1[2] - bflo(ah.w[3]), x1[3] - bfhi(ah.w[3]));
                acc0 = __builtin_amdgcn_mfma_f32_16x16x32_bf16(ah.v, rwH[s][0], acc0, 0, 0, 0); acc1 = __builtin_amdgcn_mfma_f32_16x16x32_bf16(ah.v, rwH[s][1], acc1, 0, 0, 0);
                acc0 = __builtin_amdgcn_mfma_f32_16x16x32_bf16(ah.v, rwL[s][0], acc0, 0, 0, 0); acc1 = __builtin_amdgcn_mfma_f32_16x16x32_bf16(ah.v, rwL[s][1], acc1, 0, 0, 0);
                acc0 = __builtin_amdgcn_mfma_f32_16x16x32_bf16(al.v, rwH[s][0], acc0, 0, 0, 0); acc1 = __builtin_amdgcn_mfma_f32_16x16x32_bf16(al.v, rwH[s][1], acc1, 0, 0, 0); }
#pragma unroll
            for (int i = 0; i < 4; ++i) { PART[(wave * 16 + 4 * q + i) * 32 + r] = acc0[i]; PART[(wave * 16 + 4 * q + i) * 32 + 16 + r] = acc1[i]; }
        }
        lds_barrier();
        {
            const int ti = tid >> 5, e = tid & 31;
            float lg = rbe;
#pragma unroll
            for (int w = 0; w < 8; ++w) lg += PART[(w * 16 + ti) * 32 + e];
            float tv[4]; int te[4]; float cur = lg;
#pragma unroll
            for (int k = 0; k < 4; ++k) { float bv = cur; int bi = e;
#pragma unroll
                for (int st = 0; st < 5; ++st) { float ov; int oi;
                    const int bvi = __builtin_bit_cast(int, bv);
                    if (st == 0) { ov = __builtin_bit_cast(float, __builtin_amdgcn_update_dpp(bvi, bvi, 0xB1, 0xf, 0xf, false)); oi = __builtin_amdgcn_update_dpp(bi, bi, 0xB1, 0xf, 0xf, false); }
                    else if (st == 1) { ov = __builtin_bit_cast(float, __builtin_amdgcn_update_dpp(bvi, bvi, 0x4E, 0xf, 0xf, false)); oi = __builtin_amdgcn_update_dpp(bi, bi, 0x4E, 0xf, 0xf, false); }
                    else if (st == 2) { ov = __builtin_bit_cast(float, __builtin_amdgcn_update_dpp(bvi, bvi, 0x141, 0xf, 0xf, false)); oi = __builtin_amdgcn_update_dpp(bi, bi, 0x141, 0xf, 0xf, false); }
                    else if (st == 3) { ov = __builtin_bit_cast(float, __builtin_amdgcn_update_dpp(bvi, bvi, 0x140, 0xf, 0xf, false)); oi = __builtin_amdgcn_update_dpp(bi, bi, 0x140, 0xf, 0xf, false); }
                    else { ov = __shfl_xor(bv, 16); oi = __shfl_xor(bi, 16); }
                    if (ov > bv || (ov == bv && oi < bi)) { bv = ov; bi = oi; } }
                tv[k] = bv; te[k] = bi; if (e == bi) cur = -3.0e38f; }
            const float e1 = __expf(tv[1] - tv[0]), e2 = __expf(tv[2] - tv[0]), e3 = __expf(tv[3] - tv[0]); const float inv = 1.0f / (1.0f + e1 + e2 + e3);
            const size_t tok = (size_t)it * 16 + ti;
            if (e < 4) { const int ek = e == 0 ? te[0] : e == 1 ? te[1] : e == 2 ? te[2] : te[3]; const float gk = (e == 0 ? 1.0f : e == 1 ? e1 : e == 2 ? e2 : e3) * inv;
                tok_e[tok * 4 + e] = ek; tok_g[tok * 4 + e] = gk; __hip_atomic_fetch_add(&HIST[ek], 1, __ATOMIC_RELAXED, __HIP_MEMORY_SCOPE_WORKGROUP); }
        }
    }
#undef LN1_LOAD
    lds_barrier();
    if (tid < 32) ((int*)(KWS() + WS_CTL))[CW_HIST + bx * 32 + tid] = HIST[tid];
}

__device__ __forceinline__ void slots_phase(LAS unsigned char* lds, int bx, int G) {
    const int tid = opaque_tid();
    int* ctl = (int*)(KWS() + WS_CTL);
    LAS int* RED = (LAS int*)lds;
    LAS int* TOT = RED + 1024;
    const int* tok_e = (const int*)(KWS() + WS_ROUTE); const float* tok_g = (const float*)(KWS() + WS_ROUTE + 1 * MiB);
    int* tok_slot = (int*)(KWS() + WS_ROUTE + 2 * MiB); int* slot_tok = (int*)(KWS() + WS_ROUTE + 3 * MiB);
    { const int e = tid & 31, part = tid >> 5; int tot = 0, pre = 0;
      for (int b2 = part; b2 < G; b2 += 16) { const int h = ctl[CW_HIST + b2 * 32 + e]; tot += h; if (b2 < bx) pre += h; }
      RED[(part * 32 + e) * 2] = tot; RED[(part * 32 + e) * 2 + 1] = pre; }
    __syncthreads();
    if (tid < 32) { int tot = 0, pre = 0; for (int p = 0; p < 16; ++p) { tot += RED[(p * 32 + tid) * 2]; pre += RED[(p * 32 + tid) * 2 + 1]; } TOT[tid] = tot; TOT[32 + tid] = pre; TOT[96 + tid] = 0; }
    __syncthreads();
    if (tid == 0) { int ps = 0;
#pragma unroll 1
        for (int e = 0; e < 32; ++e) { TOT[64 + e] = ps; ps += (TOT[e] + 255) & ~255; }
        TOT[128] = ps >> 8; if (bx == 0) ctl[CW_NT] = ps >> 8; }
    __syncthreads();
    if (bx == 0) { const int nt = TOT[128];
        for (int t = tid; t < nt; t += NTHR) { int e = 0;
#pragma unroll 1
            for (int k = 1; k < 32; ++k) if (TOT[64 + k] <= t * 256) e = k;
            ctl[CW_TILEE + t] = e; } }
    for (int e = bx; e < 32; e += G) { const int s0 = TOT[64 + e] + TOT[e], s1 = TOT[64 + e] + ((TOT[e] + 255) & ~255); for (int s = s0 + tid; s < s1; s += NTHR) slot_tok[s] = 0; }
    for (int it = bx + G * (tid >> 6); it < NTOK / 16; it += G * 8) {
        const int asg = it * 64 + (tid & 63); const int e = tok_e[asg]; const int rank = __hip_atomic_fetch_add(&TOT[96 + e], 1, __ATOMIC_RELAXED, __HIP_MEMORY_SCOPE_WORKGROUP); const int slot = TOT[64 + e] + TOT[32 + e] + rank;
        tok_slot[asg] = slot; slot_tok[slot] = asg >> 2;
    }
}

__device__ __forceinline__ void combine_phase(int l, int vcu, int G) {
    const int tid = opaque_tid(), lane = tid & 63, wave = __builtin_amdgcn_readfirstlane(tid >> 6);
    const int gw = vcu * NWAVES + wave, NGW = G * NWAVES;
    const bf16* X1B = (const bf16*)(KWS() + WS_X1B); const unsigned char* YB = (const unsigned char*)(KWS() + WS_YB); const int* tok_slot = (const int*)(KWS() + WS_ROUTE + 2 * MiB); const float* tok_gate = (const float*)(KWS() + WS_ROUTE + 1 * MiB);
    float* xo = KOUT(); bf16* XB = (bf16*)(KWS() + WS_XB); unsigned char* X8 = (unsigned char*)(KWS() + WS_X8);
    const float* g2 = KIN(I_LN2G) + l * D; const float* b2 = KIN(I_LN2B) + l * D;
    unsigned wg[128];
    { const unsigned* Wg = (const unsigned*)(KWS() + WS_GLRW) + (size_t)(l + 1 < NL ? l + 1 : l) * 8192 + lane;
#pragma unroll
      for (int i = 0; i < 128; ++i) wg[i] = Wg[i * 64]; }
    bf16* PG = (bf16*)(KWS() + WS_P) + PC_GLR + ((lane >> 2) & 15);
    u32x2 xw[4]; unsigned ya[4][4]; int ns0 = 0, ns1 = 0, ns2 = 0, ns3 = 0; f32x4 gv = {0.f, 0.f, 0.f, 0.f};
#define CMB_SLOTS(t_) do { const int4 _s = *(const int4*)(tok_slot + (size_t)(t_) * 4); ns0 = _s.x; ns1 = _s.y; ns2 = _s.z; ns3 = _s.w; } while (0)
#define CMB_ROWS(t_) do { const u32x2* _xr = (const u32x2*)(X1B + (size_t)(t_) * D) + lane; gv = *(const f32x4*)(tok_gate + (size_t)(t_) * 4); \
        const unsigned* _y0 = (const unsigned*)(YB + (size_t)ns0 * D) + lane; const unsigned* _y1 = (const unsigned*)(YB + (size_t)ns1 * D) + lane; \
        const unsigned* _y2 = (const unsigned*)(YB + (size_t)ns2 * D) + lane; const unsigned* _y3 = (const unsigned*)(YB + (size_t)ns3 * D) + lane; \
        _Pragma("unroll") for (int j = 0; j < 4; ++j) { xw[j] = _xr[64 * j]; ya[0][j] = _y0[64 * j]; ya[1][j] = _y1[64 * j]; ya[2][j] = _y2[64 * j]; ya[3][j] = _y3[64 * j]; } } while (0)
    if (gw < NTOK) { CMB_SLOTS(gw); CMB_ROWS(gw); if (gw + NGW < NTOK) CMB_SLOTS(gw + NGW); }
    for (int tok = gw; tok < NTOK; tok += NGW) {
        f32x4 v[4]; float s = 0.f; const f32x4 gs = gv * 0.0625f;
#pragma unroll
        for (int j = 0; j < 4; ++j) { const f32x4 xv = {bflo(xw[j].x), bfhi(xw[j].x), bflo(xw[j].y), bfhi(xw[j].y)};
            f32x2 lo = __builtin_amdgcn_cvt_pk_f32_fp8(ya[0][j], false) * gs[0], hi = __builtin_amdgcn_cvt_pk_f32_fp8(ya[0][j], true) * gs[0];
#pragma unroll
            for (int k = 1; k < 4; ++k) { lo += __builtin_amdgcn_cvt_pk_f32_fp8(ya[k][j], false) * gs[k]; hi += __builtin_amdgcn_cvt_pk_f32_fp8(ya[k][j], true) * gs[k]; }
            v[j][0] = DN_ALPHA * xv[0] + lo[0]; v[j][1] = DN_ALPHA * xv[1] + lo[1]; v[j][2] = DN_ALPHA * xv[2] + hi[0]; v[j][3] = DN_ALPHA * xv[3] + hi[1];
            s += (v[j][0] + v[j][1]) + (v[j][2] + v[j][3]); }
        if (tok + NGW < NTOK) { CMB_ROWS(tok + NGW); if (tok + 2 * NGW < NTOK) CMB_SLOTS(tok + 2 * NGW); }
        const float mean = wave_sum(s) * (1.0f / D); float q = 0.f;
#pragma unroll
        for (int j = 0; j < 4; ++j) { v[j] = v[j] - mean; q += (v[j][0] * v[j][0] + v[j][1] * v[j][1]) + (v[j][2] * v[j][2] + v[j][3] * v[j][3]); }
        const float rstd = 1.0f / sqrtf(wave_sum(q) * (1.0f / D) + LN_EPS);
        float ga[16];
#pragma unroll
        for (int c = 0; c < 16; ++c) ga[c] = 0.f;
#pragma unroll
        for (int j = 0; j < 4; ++j) { const f32x4 gg = *((const f32x4*)g2 + lane + 64 * j), bb = *((const f32x4*)b2 + lane + 64 * j);
            const f32x4 y = v[j] * rstd * gg + bb;
            if (l == NL - 1) *((f32x4*)(xo + (size_t)tok * D) + lane + 64 * j) = y;
            else { const unsigned p0 = pk2(y[0], y[1]), p1 = pk2(y[2], y[3]); *((u32x2*)(XB + (size_t)tok * D) + lane + 64 * j) = (u32x2){p0, p1};
                store_o4(X8 + (size_t)tok * D + 4 * (lane + 64 * j), y[0], y[1], y[2], y[3]);
#pragma unroll
                for (int c = 0; c < 16; ++c) { ga[c] = __builtin_amdgcn_fdot2_f32_bf16(__builtin_bit_cast(bf16x2_t, p0), __builtin_bit_cast(bf16x2_t, wg[(2 * j) * 16 + c]), ga[c], false);
                                               ga[c] = __builtin_amdgcn_fdot2_f32_bf16(__builtin_bit_cast(bf16x2_t, p1), __builtin_bit_cast(bf16x2_t, wg[(2 * j + 1) * 16 + c]), ga[c], false); } } }
        if (l != NL - 1) {
            const bool h5 = (lane & 32) != 0, h4 = (lane & 16) != 0, h3 = (lane & 8) != 0, h2 = (lane & 4) != 0;
            float r8[8], r4[4], r2[2];
#pragma unroll
            for (int i = 0; i < 8; ++i) { const float keep = h5 ? ga[8 + i] : ga[i], send = h5 ? ga[i] : ga[8 + i]; r8[i] = keep + __shfl_xor(send, 32); }
#pragma unroll
            for (int i = 0; i < 4; ++i) { const float keep = h4 ? r8[4 + i] : r8[i], send = h4 ? r8[i] : r8[4 + i]; r4[i] = keep + __shfl_xor(send, 16); }
#pragma unroll
            for (int i = 0; i < 2; ++i) { const float keep = h3 ? r4[2 + i] : r4[i], send = h3 ? r4[i] : r4[2 + i]; r2[i] = keep + __shfl_xor(send, 8); }
            const float keep = h2 ? r2[1] : r2[0], send = h2 ? r2[0] : r2[1];
            float r1 = keep + __shfl_xor(send, 4);
            r1 = dpp_add(r1, 0); r1 = dpp_add(r1, 1);
            if ((lane & 3) == 0) PG[(size_t)tok * PINP] = (bf16)f2bf(r1);
        }
    }
#undef CMB_SLOTS
#undef CMB_ROWS
}


constexpr int PH_PER_LAYER = 10, NPHASES = 2 + NL * PH_PER_LAYER;
__global__ void __launch_bounds__(NTHR, 2) trunk_fwd(Args args) {
    extern __shared__ __attribute__((aligned(16))) unsigned char lds_raw[];
    LAS unsigned char* lds = (LAS unsigned char*)lds_raw;
    volatile LAS unsigned* MISC = (volatile LAS unsigned*)(lds + MISC_OFF);
    const int tid = threadIdx.x;
    const int G = gridDim.x, bx = blockIdx.x;
    const int vcu = (G % 8 == 0) ? (bx % 8) * (G / 8) + bx / 8 : bx;
    unsigned char* ws = KWS();
    unsigned* ctl = (unsigned*)(ws + WS_CTL);
    for (int u = tid; u < (LDS_BYTES - LDSCTL_OFF) / 4; u += NTHR) ((LAS unsigned*)(lds + LDSCTL_OFF))[u] = 0u;
    __syncthreads();
    XcdBarrier bar; bar.bar = ctl + CW_BAR; bar.x = 0; bar.st = nullptr;
#if !MK_PER_PHASE
    bar = xcd_barrier_post(ctl + CW_BAR, MISC + 8);
#define GRID_BAR() xcd_barrier(bar)
#else
#define GRID_BAR() do { } while (0)
#endif
    const int lo = (int)(unsigned)ka_u64<280>(), hi = (int)(unsigned)(ka_u64<280>() >> 32);
#ifndef PH_MASK
#define PH_MASK 0x1FFF
#endif
#define PHEN(n) (((PH_MASK) >> (n)) & 1)
#define IN(k) (lo <= (k) && (k) < hi)
#define SEAM(k) do { if (rep > 0 || IN((k) + 1)) { GRID_BAR(); if (PHREP(21)) GRID_BAR(); } } while (0)

#define OG opaque_s(G)
#define OBX opaque_s(bx)
#define OVCU opaque_s(vcu)
#define OL opaque_s(l)
    if (PHEN(0) && IN(0)) for (int rep = PHREP(0); rep >= 0; --rep) { prologue_phase(lds, OVCU, OG); SEAM(0); }
    if (PHEN(1) && IN(1)) for (int rep = PHREP(1); rep >= 0; --rep) {
        pg8::DenseOrder S; S.init(KWS() + WS_MEMB, KWS() + WS_WMEM, NB * NMEM, 2048, D, OG, OBX);
        pg8::EpiBf16 E{(bf16*)(KWS() + WS_MKV), 2048};
        pg8::gemm_phase<pg8::EpiBf16, pg8::DenseOrder>(lds, D, S, E);
        SEAM(1);
    }
    for (int l = 0; l < NL; ++l) {
        const int p0 = 2 + l * PH_PER_LAYER;
        if (PHEN(2) && IN(p0 + 0)) for (int rep = PHREP(2); rep >= 0; --rep) {
            pg8::DenseOrder S; S.init(KWS() + WS_X8, KWS() + WS_WIN + (size_t)OL * PINP * D, NTOK, l == 0 ? PINP : PINP - 256, D / 2, OG, OBX);
            pg8::EpiBf16T<123, 125> E{(bf16*)(KWS() + WS_P), PINP};
            pg8::gemm_phase<pg8::EpiBf16T<123, 125>, pg8::DenseOrder, 1>(lds, D, S, E);
            SEAM(p0 + 0);
        }
        if (PHEN(4) && IN(p0 + 1)) for (int rep = PHREP(4); rep >= 0; --rep) { c1_phase(lds, OL, OVCU, OG); SEAM(p0 + 1); }
        if (PHEN(5) && IN(p0 + 2)) for (int rep = PHREP(5); rep >= 0; --rep) { m2_phase(lds, OL, OBX, OG); SEAM(p0 + 2); }
        if (PHEN(6) && IN(p0 + 3)) for (int rep = PHREP(6); rep >= 0; --rep) { m3_gh_phase(lds, OL, OVCU, OG); SEAM(p0 + 3); }
        if (PHEN(7) && IN(p0 + 4)) for (int rep = PHREP(7); rep >= 0; --rep) {
            pg8::DenseOrder S; S.init(KWS() + WS_O, KWS() + WS_WOUT + (size_t)OL * D * D, NTOK, D, D / 2, OG, OBX);
            pg8::EpiBf16T<122, 125> E{(bf16*)(KWS() + WS_HMIX), D};
            pg8::gemm_phase<pg8::EpiBf16T<122, 125>, pg8::DenseOrder, 1>(lds, D, S, E);
            SEAM(p0 + 4);
        }
        if (PHEN(8) && IN(p0 + 5)) for (int rep = PHREP(8); rep >= 0; --rep) { ln1_router_phase(lds, OL, OBX, OG); SEAM(p0 + 5); }
        if (PHEN(9) && IN(p0 + 6)) for (int rep = PHREP(9); rep >= 0; --rep) { slots_phase(lds, OBX, OG); SEAM(p0 + 6); }
        if (PHEN(10) && IN(p0 + 7)) for (int rep = PHREP(10); rep >= 0; --rep) {
            const int ntiles = __builtin_amdgcn_readfirstlane(((const int*)(KWS() + WS_CTL))[CW_NT]);
            pg8::MoeOrder<true> S; S.init(KWS() + WS_XF, KWS() + WS_WGU + (size_t)OL * NE * 2048 * D, (const int*)(KWS() + WS_CTL) + CW_TILEE, (const int*)(KWS() + WS_ROUTE + 3 * MiB), ntiles, 2048, D, OG, OBX);
            pg8::EpiSwiglu E{(unsigned char*)(KWS() + WS_HB), (const float*)(KWS() + WS_BGU) + (size_t)OL * NE * 2048};
            pg8::gemm_phase<pg8::EpiSwiglu, pg8::MoeOrder<true>, 1>(lds, D, S, E);
            SEAM(p0 + 7);
        }
        if (PHEN(11) && IN(p0 + 8)) for (int rep = PHREP(11); rep >= 0; --rep) {
            const int ntiles = __builtin_amdgcn_readfirstlane(((const int*)(KWS() + WS_CTL))[CW_NT]);
            pg8::MoeOrder<false> S; S.init(KWS() + WS_HB, KWS() + WS_WD + (size_t)OL * NE * D * FF, (const int*)(KWS() + WS_CTL) + CW_TILEE, (const int*)(KWS() + WS_ROUTE + 3 * MiB), ntiles, D, FF, OG, OBX);
            pg8::EpiDown E{(unsigned char*)(KWS() + WS_YB), KIN(I_BDN) + (size_t)OL * NE * D};
            pg8::gemm_phase<pg8::EpiDown, pg8::MoeOrder<false>, 1>(lds, FF, S, E);
            SEAM(p0 + 8);
        }
        if (PHEN(12) && IN(p0 + 9)) for (int rep = PHREP(12); rep >= 0; --rep) { combine_phase(OL, OVCU, OG); if (rep > 0 || l + 1 < NL) SEAM(p0 + 9); }
    }
#undef IN
#undef SEAM
}

extern "C" void kernel_launch(void* const* d_in, const int* in_sizes, int n_in, void* d_out, int out_size, void* d_ws, size_t ws_size, hipStream_t stream) {
    static int grid = 0;
    if (grid == 0) {
        if (n_in != 33 || ws_size < WS_END) { fprintf(stderr, "kernel_launch: unexpected inputs (n_in %d, ws %zu need %zu)\n", n_in, ws_size, (size_t)WS_END); grid = -1; return; }
        int dev = 0, cus = 0;
        if (hipGetDevice(&dev) != hipSuccess || hipDeviceGetAttribute(&cus, hipDeviceAttributeMultiprocessorCount, dev) != hipSuccess) { grid = -1; return; }
        if (hipFuncSetAttribute((const void*)trunk_fwd, hipFuncAttributeMaxDynamicSharedMemorySize, LDS_BYTES) != hipSuccess) { grid = -1; return; }
        int per_cu = 0; (void)hipOccupancyMaxActiveBlocksPerMultiprocessor(&per_cu, (const void*)trunk_fwd, NTHR, LDS_BYTES); (void)hipGetLastError();
        grid = cus;
    }
    if (grid < 0) return;
    (void)hipMemsetAsync((char*)d_ws + WS_CTL, 0, CTL_ZERO_BYTES, stream);
    Args a{};
    for (int i = 0; i < 33; ++i) a.in[i] = (const float*)d_in[i];
    a.out = (float*)d_out; a.ws = (unsigned char*)d_ws;
#if MK_PER_PHASE
    for (int p = 0; p < NPHASES; ++p) { a.ph_lo = p; a.ph_hi = p + 1; hipLaunchKernelGGL(trunk_fwd, dim3(grid), dim3(NTHR), LDS_BYTES, stream, a); }
#else
    a.ph_lo = 0; a.ph_hi = NPHASES;
    hipLaunchKernelGGL(trunk_fwd, dim3(grid), dim3(NTHR), LDS_BYTES, stream, a);
#endif
}
```

```cpp
#include <hip/hip_runtime.h>
#include <cstdio>
#include <cstdint>

#ifndef MK_PER_PHASE
#define MK_PER_PHASE 0
#endif

#ifndef REP_MASK
#define REP_MASK 0
#endif
#define PHREP(n) (((REP_MASK) >> (n)) & 1)
#define LAS __attribute__((address_space(3)))
#define GAS __attribute__((address_space(1)))
typedef unsigned short bf16;
typedef short bf16x8 __attribute__((ext_vector_type(8)));
typedef short s16x4 __attribute__((ext_vector_type(4)));
typedef float f32x4 __attribute__((ext_vector_type(4)));
typedef float f32x2 __attribute__((ext_vector_type(2)));
typedef float f32x16 __attribute__((ext_vector_type(16)));
typedef unsigned u32x4 __attribute__((ext_vector_type(4)));
typedef unsigned u32x2 __attribute__((ext_vector_type(2)));

constexpr int NB = 8, T = 8192, D = 1024, NL = 4, NTOK = NB * T;
constexpr int PIN = 3088, PINP = 3328;
constexpr int NE = 32, FF = 1024, NMEM = 256;
constexpr int NASSIGN = NTOK * 4;
constexpr int MAXTILES = NASSIGN / 256 + NE;
constexpr int MAXSLOTS = MAXTILES * 256;
constexpr int PC_GQ = 0, PC_GK = 128, PC_GV = 256, PC_GOUT = 512, PC_HQ = 768, PC_HF = 1024, PC_HI = 1280, PC_HG = 1536;
constexpr int PC_RW = 1792, PC_MQ = 2816, PC_GLR = 3072;
constexpr float DN_ALPHA = 1.6817928305074292f;
constexpr float LN_EPS = 1e-5f, RMS_EPS = 1e-6f, RW_LN_EPS = 64e-5f;

constexpr size_t MiB = 1u << 20;
constexpr size_t WS_CTL = 0, CTL_ZERO_BYTES = 32768;
constexpr size_t WS_WIN = 1 * MiB;
constexpr size_t WS_WOUT = WS_WIN + 26 * MiB;
constexpr size_t WS_WMEM = WS_WOUT + 8 * MiB;
constexpr size_t WS_WGU = WS_WMEM + 4 * MiB;
constexpr size_t WS_WD = WS_WGU + 512 * MiB;
constexpr size_t WS_BGU = WS_WD + 256 * MiB;
constexpr size_t WS_LORA = WS_BGU + 1 * MiB;
constexpr size_t WS_GLRW = WS_LORA + 512 * 1024;
constexpr size_t WS_MEMB = WS_LORA + 1 * MiB;
constexpr size_t WS_MKV = WS_MEMB + 4 * MiB;
constexpr size_t WS_XB = WS_MKV + 8 * MiB;
constexpr size_t WS_X1B = WS_XB + 128 * MiB;
constexpr size_t WS_XF = WS_X1B + 128 * MiB;
constexpr size_t WS_X1F = WS_XF + 256 * MiB;
constexpr size_t WS_X8 = WS_X1F;
constexpr size_t WS_O = WS_X1F + 256 * MiB;
constexpr size_t WS_HMIX = WS_O + 128 * MiB;
constexpr size_t WS_ROUTE = WS_HMIX + 128 * MiB;
constexpr size_t WS_GBUF = WS_ROUTE + 6 * MiB;
constexpr size_t WS_BONUS = WS_GBUF + 32 * MiB;
constexpr size_t WS_BIG = WS_BONUS + 1 * MiB;
constexpr size_t WS_P = WS_BIG;
constexpr size_t WS_ORAW = WS_P + 416 * MiB;
constexpr size_t WS_HB = WS_BIG;
constexpr size_t WS_YB = WS_HB + 528 * MiB;
constexpr size_t WS_CHK = WS_ORAW;
constexpr size_t WS_HQ = WS_CHK, WS_HK = WS_HQ + 32 * MiB, WS_HVT = WS_HK + 32 * MiB, WS_HDS = WS_HVT + 32 * MiB, WS_HS = WS_HDS + 128 * MiB, WS_HBE = WS_HS + 64 * MiB;
constexpr size_t WS_GQ = WS_HBE + 2 * MiB, WS_GK = WS_GQ + 16 * MiB, WS_GVT = WS_GK + 16 * MiB, WS_GDS = WS_GVT + 32 * MiB, WS_GS = WS_GDS + 64 * MiB, WS_GBE = WS_GS + 32 * MiB;
constexpr size_t WS_RR = WS_GBE + 1 * MiB, WS_RB = WS_RR + 32 * MiB, WS_RK = WS_RB + 32 * MiB, WS_RW = WS_RK + 32 * MiB, WS_RVT = WS_RW + 32 * MiB;
constexpr size_t WS_RVG = WS_RVT + 32 * MiB;
constexpr size_t WS_RU = WS_RVG + 32 * MiB, WS_RP = WS_RU + 64 * MiB, WS_RQ = WS_RP + 64 * MiB, WS_RS = WS_RQ + 128 * MiB;
constexpr size_t WS_END = WS_RS + 64 * MiB;
static_assert(WS_YB + 528 * MiB <= WS_END, "overlay");
static_assert(WS_END <= (size_t)4096 * MiB, "workspace");
constexpr int CW_TMO = 0;
constexpr int CW_BAR = 4096;
constexpr int CW_HIST = 16384;
constexpr int CW_NT = 32768;
constexpr int CW_TILEE = 32768 + 64;
constexpr int CW_PADSTART = 40960;

constexpr int RING_BYTES = 131072;
constexpr int LDSCTL_OFF = 162816, MISC_OFF = LDSCTL_OFF + 320;
constexpr int LDS_BYTES = 163840;
constexpr int NWAVES = 8, NTHR = 512;

#define RLX_AGENT __ATOMIC_RELAXED, __HIP_MEMORY_SCOPE_AGENT
#define LDS_WAIT() asm volatile("s_waitcnt lgkmcnt(0)" ::: "memory")
#define VM_WAIT() asm volatile("s_waitcnt vmcnt(0)" ::: "memory")

__device__ __forceinline__ float bf2f(unsigned short b) { return __builtin_bit_cast(float, (unsigned)b << 16); }
__device__ __forceinline__ float bflo(unsigned w) { return __builtin_bit_cast(float, w << 16); }
__device__ __forceinline__ float bfhi(unsigned w) { return __builtin_bit_cast(float, w & 0xffff0000u); }
typedef __bf16 bf16x2_t __attribute__((ext_vector_type(2)));
__device__ __forceinline__ unsigned cvt_pk_bf16(float lo, float hi) { const f32x2 v = {lo, hi}; const bf16x2_t b = __builtin_convertvector(v, bf16x2_t); return __builtin_bit_cast(unsigned, b); }
__device__ __forceinline__ unsigned pk2(float lo, float hi) { return cvt_pk_bf16(lo, hi); }
__device__ __forceinline__ unsigned f2bf(float f) { return cvt_pk_bf16(f, 0.f) & 0xffffu; }
__device__ __forceinline__ float o_q(float y) { return __builtin_amdgcn_fmed3f(y * 4.0f, -448.0f, 448.0f); }
__device__ __forceinline__ unsigned pack_o4(float y0, float y1, float y2, float y3) { int w = __builtin_amdgcn_cvt_pk_fp8_f32(o_q(y0), o_q(y1), 0, false); w = __builtin_amdgcn_cvt_pk_fp8_f32(o_q(y2), o_q(y3), w, true); return (unsigned)w; }
__device__ __forceinline__ void flush_o_tile(const LAS unsigned char* os, unsigned char* obase  , int lane) {
#pragma unroll
    for (int i = 0; i < 2; ++i) { const int q = i * 64 + lane, t = q >> 2, c4 = q & 3; *(u32x4*)(obase + (size_t)t * D + c4 * 16) = *(const LAS u32x4*)(os + t * 64 + c4 * 16); }
}
__device__ __forceinline__ void store_o4(unsigned char* p, float y0, float y1, float y2, float y3) { int w = __builtin_amdgcn_cvt_pk_fp8_f32(o_q(y0), o_q(y1), 0, false); w = __builtin_amdgcn_cvt_pk_fp8_f32(o_q(y2), o_q(y3), w, true); *(unsigned*)p = (unsigned)w; }
__device__ __forceinline__ float fast_exp(float x) { return __builtin_amdgcn_exp2f(x * 1.4426950408889634f); }
__device__ __forceinline__ float fast_sigmoid(float x) { return __builtin_amdgcn_rcpf(1.0f + fast_exp(-x)); }
__device__ __forceinline__ float silu_f(float x) { return x * fast_sigmoid(x); }
__device__ __forceinline__ int opaque_tid() { int t = threadIdx.x; asm volatile("" : "+v"(t)); return t; }
__device__ __forceinline__ int opaque_s(int v) { asm volatile("" : "+s"(v)); return v; }
__device__ __forceinline__ void lds_barrier() { asm volatile("s_waitcnt lgkmcnt(0)" ::: "memory"); __builtin_amdgcn_s_barrier(); asm volatile("" ::: "memory"); }
__device__ __forceinline__ float dpp_add(float x, const int sel) {
    const int xi = __builtin_bit_cast(int, x); int r;
    switch (sel) { case 0: r = __builtin_amdgcn_update_dpp(xi, xi, 0xB1, 0xf, 0xf, false); break;
                   case 1: r = __builtin_amdgcn_update_dpp(xi, xi, 0x4E, 0xf, 0xf, false); break;
                   case 2: r = __builtin_amdgcn_update_dpp(xi, xi, 0x141, 0xf, 0xf, false); break;
                   default: r = __builtin_amdgcn_update_dpp(xi, xi, 0x140, 0xf, 0xf, false); break; }
    return x + __builtin_bit_cast(float, r);
}
__device__ __forceinline__ float wave_sum(float v) {
    v = dpp_add(v, 0); v = dpp_add(v, 1); v = dpp_add(v, 2); v = dpp_add(v, 3);
    v += __builtin_bit_cast(float, __builtin_amdgcn_update_dpp(0, __builtin_bit_cast(int, v), 0x142, 0xa, 0xf, false));
    v += __builtin_bit_cast(float, __builtin_amdgcn_update_dpp(0, __builtin_bit_cast(int, v), 0x143, 0xc, 0xf, false));
    return __builtin_bit_cast(float, __builtin_amdgcn_readlane(__builtin_bit_cast(int, v), 63));
}

namespace pg8 {
constexpr int BM = 256, BK = 64, HALF = 128, HTB = HALF * BK * 2, STAGE_BYTES = 8 * HTB, NXCD = 8, WGM = 8;
__host__ __device__ __forceinline__ int lds_byte(int r, int c) { const int st = (r >> 4) * 2 + (c >> 5), rr = r & 15, cc = c & 31, ob = rr * 64 + cc * 2; return st * 1024 + (ob ^ (((ob >> 9) & 1) << 5)); }
__host__ __device__ __forceinline__ void stage_rc(int b, int& R, int& C) { const int st = b / 1024, sb = b % 1024, swz = sb ^ (((sb >> 9) & 1) << 5); R = (st >> 1) * 16 + swz / 64; C = (st & 1) * 32 + (swz % 64) / 2; }
__host__ __device__ __forceinline__ int perm32(int rho) { const int n = rho >> 4, i = rho & 15; return 8 * (i >> 2) + 4 * n + (i & 3); }

typedef int v4i_t __attribute__((ext_vector_type(4)));
typedef int v8i_t __attribute__((ext_vector_type(8)));
struct Unit { int pm, pn, e; const char* A; const char* B; };
__device__ __forceinline__ unsigned asm_gload_u32(const void* p) { unsigned v; asm volatile("global_load_dword %0, %1, off" : "=v"(v) : "v"(p) : "memory"); return v; }

__device__ __forceinline__ bool static_tile(int i, int G, int c, int nM, int nN, int& pm, int& pn) {
    const int nwg = nM * nN; const long L = (long)i * G + c; if (L >= nwg) return false;
    int wgid = (int)L; { const int q = nwg / NXCD, r = nwg % NXCD, xcd = wgid % NXCD, off = wgid / NXCD; wgid = (xcd < r ? xcd * (q + 1) : r * (q + 1) + (xcd - r) * q) + off; }
    const int nig = WGM * nN, gid = wgid / nig, fm = gid * WGM, gsz = (nM - fm) < WGM ? (nM - fm) : WGM;
    pm = fm + ((wgid % nig) % gsz); pn = (wgid % nig) / gsz; return true;
}
struct DenseOrder {
    static constexpr bool GATHER = false, HAS_E = false;
    const char* A; const char* B; int nM, nN, G, c; size_t tstep;
    __device__ __forceinline__ void init(const void* A_, const void* B_, int M, int N, int K, int G_, int c_) { A = (const char*)A_; B = (const char*)B_; nM = M / BM; nN = N / BM; G = G_; c = c_; tstep = (size_t)BM * K * 2; }
    __device__ __forceinline__ bool next(int i, Unit& u) const { if (!static_tile(i, G, c, nM, nN, u.pm, u.pn)) return false; u.e = 0; u.A = A + (size_t)u.pm * tstep; u.B = B + (size_t)u.pn * tstep; return true; }
    __device__ __forceinline__ unsigned row_tok(const Unit&, int) const { return 0; }
};
template <bool GATHER_> struct MoeOrder {
    static constexpr bool GATHER = GATHER_, HAS_E = true;
    const char* A; const char* B; const int* tile_e; const int* slot_tok; int nM, nN, G, c; size_t tstep, estep;
    __device__ __forceinline__ void init(const void* A_, const void* B_, const int* tile_e_, const int* slot_tok_, int ntiles, int Nper, int Kbytes, int G_, int c_) {
        A = (const char*)A_; B = (const char*)B_; tile_e = tile_e_; slot_tok = slot_tok_; nM = ntiles; nN = Nper / BM; G = G_; c = c_; tstep = (size_t)BM * Kbytes; estep = (size_t)Nper * Kbytes; }
    __device__ __forceinline__ bool next(int i, Unit& u) const { if (!static_tile(i, G, c, nM, nN, u.pm, u.pn)) return false;
        u.e = __builtin_amdgcn_readfirstlane(tile_e[u.pm]); u.A = GATHER_ ? A : A + (size_t)u.pm * tstep; u.B = B + (size_t)u.e * estep + (size_t)u.pn * tstep; return true; }
    __device__ __forceinline__ unsigned row_tok(const Unit& u, int r) const { return (unsigned)slot_tok[u.pm * BM + r]; }
    __device__ __forceinline__ bool next_static(int i, Unit& u) const { return static_tile(i, G, c, nM, nN, u.pm, u.pn); }
    __device__ __forceinline__ const int* e_ptr(const Unit& u) const { return tile_e + u.pm; }
    __device__ __forceinline__ const int* tok_ptr(const Unit& u, int r) const { return slot_tok + u.pm * BM + r; }
    __device__ __forceinline__ void finish(Unit& u, int e) const { u.e = e; u.A = GATHER_ ? A : A + (size_t)u.pm * tstep; u.B = B + (size_t)e * estep + (size_t)u.pn * tstep; }
};

template <int WSCALE_ = 127, int ASCALE_ = 127>
struct EpiBf16T {
    static constexpr bool PERM = true; static constexpr int WSCALE = WSCALE_, ASCALE = ASCALE_;
    bf16* O; int ldc;
    __device__ __forceinline__ void init(f32x4 (&acc)[2][2][4][2], const Unit&, int, int) const {
#pragma unroll
        for (int a = 0; a < 2; ++a)
#pragma unroll
            for (int b = 0; b < 2; ++b)
#pragma unroll
                for (int m = 0; m < 4; ++m)
#pragma unroll
                    for (int n = 0; n < 2; ++n) acc[a][b][m][n] = (f32x4){0.f, 0.f, 0.f, 0.f}; }
    __device__ __forceinline__ void operator()(const f32x4 (&acc)[2][2][4][2], const Unit& u, int wr, int wc, int fr, int fq) const {
        const int row0 = u.pm * BM + wr * 64 + fr, col0 = u.pn * BM + wc * 64 + 16 * fq;
#pragma unroll
        for (int ai = 0; ai < 2; ++ai)
#pragma unroll
            for (int m = 0; m < 4; ++m) { bf16* rowp = O + (size_t)(row0 + ai * HALF + m * 16) * ldc + col0;
#pragma unroll
                for (int bj = 0; bj < 2; ++bj) { const f32x4 v0 = acc[ai][bj][m][0], v1 = acc[ai][bj][m][1];
                    u32x4 w; w.x = cvt_pk_bf16(v0[0], v0[1]); w.y = cvt_pk_bf16(v0[2], v0[3]); w.z = cvt_pk_bf16(v1[0], v1[1]); w.w = cvt_pk_bf16(v1[2], v1[3]);
                    *(u32x4*)(rowp + bj * 8) = w; } }
    }
};
typedef EpiBf16T<> EpiBf16;
struct EpiSwiglu {
    static constexpr bool PERM = false; static constexpr int WSCALE = 123, ASCALE = 127;
    unsigned char* H; const float* bias;
    __device__ __forceinline__ void init(f32x4 (&acc)[2][2][4][2], const Unit& u, int wc, int fq) const {
        const float* bp = bias + (size_t)u.e * 2048 + u.pn * 256 + wc * 32 + 4 * fq;
#pragma unroll
        for (int bj = 0; bj < 2; ++bj)
#pragma unroll
            for (int n = 0; n < 2; ++n) { const f32x4 bv = *(const f32x4*)(bp + bj * HALF + n * 16);
#pragma unroll
                for (int ai = 0; ai < 2; ++ai)
#pragma unroll
                    for (int m = 0; m < 4; ++m) acc[ai][bj][m][n] = bv; } }
    __device__ __forceinline__ void operator()(const f32x4 (&acc)[2][2][4][2], const Unit& u, int wr, int wc, int fr, int fq) const {
        const int row0 = u.pm * BM + wr * 64 + fr, colh = u.pn * 128 + wc * 32 + 8 * fq;
        f32x2 kc = {-1.702f * 1.4426950408889634f, -1.702f * 1.4426950408889634f}, k1 = {1.0f, 1.0f}; asm volatile("" : "+v"(kc), "+v"(k1));
#pragma unroll
        for (int ai = 0; ai < 2; ++ai)
#pragma unroll
            for (int m = 0; m < 4; ++m) { unsigned char* rowp = H + (size_t)(row0 + ai * HALF + m * 16) * FF + colh;
                float o[8];
#pragma unroll
                for (int n = 0; n < 2; ++n)
#pragma unroll
                    for (int hq = 0; hq < 2; ++hq) { const f32x4 g4 = acc[ai][0][m][n], u4 = acc[ai][1][m][n]; f32x2 g, up, e, r;
#pragma unroll
                        for (int j = 0; j < 2; ++j) { g[j] = __builtin_amdgcn_fmed3f(g4[2 * hq + j], -3.0e38f, 7.0f); up[j] = __builtin_amdgcn_fmed3f(u4[2 * hq + j], -7.0f, 7.0f); }
                        const f32x2 t = g * kc;
#pragma unroll
                        for (int j = 0; j < 2; ++j) e[j] = __builtin_amdgcn_exp2f(t[j]);
                        const f32x2 d = e + k1;
#pragma unroll
                        for (int j = 0; j < 2; ++j) r[j] = __builtin_amdgcn_rcpf(d[j]);
                        const f32x2 glu = g * r, ov = up * glu + glu;
                        o[n * 4 + 2 * hq] = ov[0]; o[n * 4 + 2 * hq + 1] = ov[1]; }
                int w0 = __builtin_amdgcn_cvt_pk_fp8_f32(o[0], o[1], 0, false); w0 = __builtin_amdgcn_cvt_pk_fp8_f32(o[2], o[3], w0, true);
                int w1 = __builtin_amdgcn_cvt_pk_fp8_f32(o[4], o[5], 0, false); w1 = __builtin_amdgcn_cvt_pk_fp8_f32(o[6], o[7], w1, true);
                *(u32x2*)rowp = (u32x2){(unsigned)w0, (unsigned)w1}; }
    }
};
struct EpiDown {
    static constexpr bool PERM = true; static constexpr int WSCALE = 122, ASCALE = 127;
    unsigned char* Y; const float* bias;
    __device__ __forceinline__ void init(f32x4 (&acc)[2][2][4][2], const Unit& u, int wc, int fq) const {
        const float* bp = bias + (size_t)u.e * 1024 + u.pn * BM + wc * 64 + 16 * fq;
#pragma unroll
        for (int bj = 0; bj < 2; ++bj)
#pragma unroll
            for (int n = 0; n < 2; ++n) { const f32x4 bv = *(const f32x4*)(bp + bj * 8 + 4 * n);
#pragma unroll
                for (int ai = 0; ai < 2; ++ai)
#pragma unroll
                    for (int m = 0; m < 4; ++m) acc[ai][bj][m][n] = bv; } }
    __device__ __forceinline__ void operator()(const f32x4 (&acc)[2][2][4][2], const Unit& u, int wr, int wc, int fr, int fq) const {
        const int row0 = u.pm * BM + wr * 64 + fr, col0 = u.pn * BM + wc * 64 + 16 * fq;
#pragma unroll
        for (int ai = 0; ai < 2; ++ai)
#pragma unroll
            for (int m = 0; m < 4; ++m) { const int row = row0 + ai * HALF + m * 16; const float g = 16.0f; unsigned char* rowp = Y + (size_t)row * D + col0; u32x4 wq;
#pragma unroll
                for (int bj = 0; bj < 2; ++bj) { const f32x4 v0 = acc[ai][bj][m][0] * g, v1 = acc[ai][bj][m][1] * g;
                    int w0 = __builtin_amdgcn_cvt_pk_fp8_f32(v0[0], v0[1], 0, false); w0 = __builtin_amdgcn_cvt_pk_fp8_f32(v0[2], v0[3], w0, true);
                    int w1 = __builtin_amdgcn_cvt_pk_fp8_f32(v1[0], v1[1], 0, false); w1 = __builtin_amdgcn_cvt_pk_fp8_f32(v1[2], v1[3], w1, true);
                    wq[2 * bj] = (unsigned)w0; wq[2 * bj + 1] = (unsigned)w1; }
                *(u32x4*)rowp = wq; }
    }
};

template <class Epi, class Sched, int ES = 2, bool ALIGN_EPI = true>
__device__ __forceinline__ void gemm_phase(LAS unsigned char* lds, const int K, const Sched& S, const Epi& E) {
    constexpr bool GA = Sched::GATHER;
    const int tid = opaque_tid(), wid = __builtin_amdgcn_readfirstlane(tid >> 6), lane = tid & 63, wr = wid >> 2, wc = wid & 3, fr = lane & 15, fq = lane >> 4;
    const int nt = K * ES / (BK * 2);
    unsigned voffA[2], voffB[2]; int Rr[2]; unsigned Cb[2];
#pragma unroll
    for (int i = 0; i < 2; ++i) { int R, C; stage_rc(tid * 16 + i * 8192, R, C); const int Rb = Epi::PERM ? (64 * (R >> 5) + 16 * ((R >> 2) & 3) + 4 * ((R >> 4) & 1) + (R & 3)) : R;
        voffA[i] = (unsigned)(R * K * ES + C * 2); voffB[i] = (unsigned)(Rb * K * ES + C * 2); Rr[i] = R; Cb[i] = (unsigned)C * 2u; }
    const size_t kstep = (size_t)(BK * 2);
    const size_t hstep = (size_t)HALF * K * ES;
    const size_t hstepB = Epi::PERM ? (size_t)8 * K * ES : hstep;
    const unsigned ldsw = (unsigned)wid * 1024u;
    const int aoff0 = lds_byte(wr * 64 + fr, fq * 8), aoff1 = lds_byte(wr * 64 + fr, fq * 8 + 32);
    const int boff0 = lds_byte(wc * 32 + fr, fq * 8), boff1 = lds_byte(wc * 32 + fr, fq * 8 + 32);
    unsigned cOff[2][2], nOff[2][2], sOff[2][2];
#define PG8_SA(b, h) (((b) * 2 + (h)) * HTB)
#define PG8_SB(b, h) ((4 + (b) * 2 + (h)) * HTB)
#define PG8_STAGE(bufoff, gbase, voff) do { _Pragma("unroll") for (int _i = 0; _i < 2; ++_i) \
        __builtin_amdgcn_global_load_lds((const unsigned*)((const char*)(gbase) + (voff)[_i]), (LAS unsigned*)(lds + (bufoff) + ldsw + _i * 8192), 16, 0, 0); } while (0)
#define PG8_STAGE_A(bufoff, gbase, half, OFF) do { if constexpr (GA) { PG8_STAGE(bufoff, gbase, (OFF)[half]); } else { PG8_STAGE(bufoff, (gbase) + (half) * hstep, voffA); } } while (0)
#define PG8_LDA(dst, b, h) do { if constexpr (ES == 2) { _Pragma("unroll") for (int m = 0; m < 4; ++m) _Pragma("unroll") for (int k = 0; k < 2; ++k) dst[m][k] = *(const LAS bf16x8*)(lds + PG8_SA(b, h) + (k ? aoff1 : aoff0) + m * 2048); } \
        else { _Pragma("unroll") for (int m = 0; m < 4; ++m) dst##8[m] = __builtin_shufflevector(*(const LAS v4i_t*)(lds + PG8_SA(b, h) + aoff0 + m * 2048), *(const LAS v4i_t*)(lds + PG8_SA(b, h) + aoff1 + m * 2048), 0, 1, 2, 3, 4, 5, 6, 7); } } while (0)
#define PG8_LDB(dst, b, h) do { if constexpr (ES == 2) { _Pragma("unroll") for (int n = 0; n < 2; ++n) _Pragma("unroll") for (int k = 0; k < 2; ++k) dst[n][k] = *(const LAS bf16x8*)(lds + PG8_SB(b, h) + (k ? boff1 : boff0) + n * 2048); } \
        else { _Pragma("unroll") for (int n = 0; n < 2; ++n) dst##8[n] = __builtin_shufflevector(*(const LAS v4i_t*)(lds + PG8_SB(b, h) + boff0 + n * 2048), *(const LAS v4i_t*)(lds + PG8_SB(b, h) + boff1 + n * 2048), 0, 1, 2, 3, 4, 5, 6, 7); } } while (0)
#define PG8_MMA(ai, bj, At, Bt) do { __builtin_amdgcn_s_setprio(1); _Pragma("unroll") for (int m = 0; m < 4; ++m) _Pragma("unroll") for (int n = 0; n < 2; ++n) { \
        if constexpr (ES == 2) { _Pragma("unroll") for (int k = 0; k < 2; ++k) acc[ai][bj][m][n] = __builtin_amdgcn_mfma_f32_16x16x32_bf16(Bt[n][k], At[m][k], acc[ai][bj][m][n], 0, 0, 0); } \
        else { asm volatile("v_mfma_scale_f32_16x16x128_f8f6f4 %0, %1, %2, %0, %3, %4 op_sel_hi:[0,0,0]" : "+v"(acc[ai][bj][m][n]) : "v"(Bt##8[n]), "v"(At##8[m]), "v"(wscale_v), "v"(ascale_v)); } } \
        __builtin_amdgcn_s_setprio(0); } while (0)
#define PG8_WAIT_V(n) asm volatile("s_waitcnt vmcnt(" #n ")" ::: "memory")
#define PG8_WAIT_L(n) asm volatile("s_waitcnt lgkmcnt(" #n ")" ::: "memory")
#define PG8_WAIT_VR() do { if (relax) { if constexpr (GA) PG8_WAIT_V(13); else PG8_WAIT_V(9); } else PG8_WAIT_V(8); } while (0)
#define PG8_BAR __builtin_amdgcn_s_barrier()
#define PG8_SCHED __builtin_amdgcn_sched_barrier(0)
#define PG8_GOFF(dst, u) do { if constexpr (GA) { _Pragma("unroll") for (int _h = 0; _h < 2; ++_h) _Pragma("unroll") for (int _i = 0; _i < 2; ++_i) \
        dst[_h][_i] = S.row_tok(u, _h * HALF + Rr[_i]) * (unsigned)(K * ES) + Cb[_i]; } } while (0)
    Unit cur, nxt; int ui = 0;
    if (!S.next(0, cur)) return;
#ifndef GEMM_STAGGER_TICKS
#define GEMM_STAGGER_TICKS 0
#endif
    if (GEMM_STAGGER_TICKS > 0) {
        const unsigned long long t0 = __builtin_amdgcn_s_memrealtime(), dl = (unsigned long long)((S.c * 5) & 15) * GEMM_STAGGER_TICKS;
        while (__builtin_amdgcn_s_memrealtime() - t0 < dl) __builtin_amdgcn_s_sleep(8);
    }
    f32x4 acc[2][2][4][2];
    E.init(acc, cur, wc, fq);
    int wscale_v = Epi::WSCALE, ascale_v = Epi::ASCALE; asm volatile("" : "+v"(wscale_v), "+v"(ascale_v));
    bf16x8 At[4][2], B0[2][2], B1[2][2];
    v8i_t At8[4], B08[2], B18[2];
    const char* cA = cur.A; const char* cB = cur.B;
    PG8_GOFF(cOff, cur);
#pragma unroll
    for (int h = 0; h < 2; ++h)
#pragma unroll
        for (int i = 0; i < 2; ++i) { nOff[h][i] = 0u; sOff[h][i] = 0u; }
    if constexpr (GA) { VM_WAIT(); }
    PG8_STAGE(PG8_SB(0, 0), cB, voffB); PG8_STAGE(PG8_SB(0, 1), cB + hstepB, voffB); PG8_STAGE_A(PG8_SA(0, 0), cA, 0, cOff); PG8_STAGE_A(PG8_SA(0, 1), cA, 1, cOff);
    if (wr == 1) PG8_BAR;
    PG8_WAIT_V(2); PG8_BAR;
    PG8_STAGE(PG8_SB(1, 0), cB + kstep, voffB); PG8_STAGE_A(PG8_SA(1, 0), cA + kstep, 0, cOff); PG8_STAGE(PG8_SB(1, 1), cB + hstepB + kstep, voffB);
    PG8_WAIT_V(6); PG8_BAR;
    for (;;) {
        bool has_next; const char* nA = cA; const char* nB = cB;
        unsigned eraw = 0u, traw[2][2] = {{0u, 0u}, {0u, 0u}};
        if constexpr (Sched::HAS_E) {
            has_next = S.next_static(ui + 1, nxt);
            if (has_next) { eraw = asm_gload_u32(S.e_ptr(nxt));
                if constexpr (GA) {
#pragma unroll
                    for (int h = 0; h < 2; ++h)
#pragma unroll
                        for (int i = 0; i < 2; ++i) traw[h][i] = asm_gload_u32(S.tok_ptr(nxt, h * HALF + Rr[i])); } }
        } else { has_next = S.next(ui + 1, nxt); if (has_next) { nA = nxt.A; nB = nxt.B; } }
#pragma unroll 1
        for (int t = 0; t < nt; t += 2) {
            const bool last = (t == nt - 2);
            const bool relax = Sched::HAS_E && has_next && t == 0;
            if constexpr (Sched::HAS_E) { if (last) {
                if (has_next) {
                    if constexpr (GA) asm volatile("" : "+v"(eraw), "+v"(traw[0][0]), "+v"(traw[0][1]), "+v"(traw[1][0]), "+v"(traw[1][1]) :: "memory"); else asm volatile("" : "+v"(eraw) :: "memory");
                    S.finish(nxt, __builtin_amdgcn_readfirstlane((int)eraw)); nA = nxt.A; nB = nxt.B;
                    if constexpr (GA) {
#pragma unroll
                        for (int h = 0; h < 2; ++h)
#pragma unroll
                            for (int i = 0; i < 2; ++i) nOff[h][i] = traw[h][i] * (unsigned)(K * ES) + Cb[i]; }
                } else if constexpr (GA) {
#pragma unroll
                    for (int h = 0; h < 2; ++h)
#pragma unroll
                        for (int i = 0; i < 2; ++i) nOff[h][i] = cOff[h][i]; } } }
            const char* a1 = cA + (size_t)(t + 1) * kstep;
            const char* a2 = last ? nA : cA + (size_t)(t + 2) * kstep; const char* b2 = last ? nB : cB + (size_t)(t + 2) * kstep;
            const char* a3 = a2 + kstep; const char* b3 = b2 + kstep;
            if constexpr (GA) {
#pragma unroll
                for (int h = 0; h < 2; ++h)
#pragma unroll
                    for (int i = 0; i < 2; ++i) sOff[h][i] = last ? nOff[h][i] : cOff[h][i]; }
            PG8_LDB(B0, 0, 0); PG8_LDB(B1, 0, 1); PG8_SCHED; PG8_LDA(At, 0, 0); PG8_STAGE_A(PG8_SA(1, 1), a1, 1, cOff);
            PG8_WAIT_VR(); PG8_WAIT_L(0); PG8_BAR; PG8_MMA(0, 0, At, B0); PG8_MMA(0, 1, At, B1); PG8_BAR; PG8_SCHED;
            PG8_LDA(At, 0, 1); PG8_STAGE(PG8_SB(0, 0), b2, voffB); PG8_STAGE(PG8_SB(0, 1), b2 + hstepB, voffB); PG8_STAGE_A(PG8_SA(0, 0), a2, 0, sOff);
            PG8_WAIT_VR(); PG8_WAIT_L(0); PG8_BAR; PG8_MMA(1, 0, At, B0); PG8_MMA(1, 1, At, B1); PG8_BAR; PG8_SCHED;
            PG8_LDB(B0, 1, 0); PG8_LDB(B1, 1, 1); PG8_SCHED; PG8_LDA(At, 1, 0); PG8_STAGE_A(PG8_SA(0, 1), a2, 1, sOff);
            PG8_WAIT_V(8); PG8_WAIT_L(0); PG8_BAR; PG8_MMA(0, 0, At, B0); PG8_MMA(0, 1, At, B1); PG8_BAR; PG8_SCHED;
            PG8_LDA(At, 1, 1); PG8_STAGE(PG8_SB(1, 0), b3, voffB); PG8_STAGE(PG8_SB(1, 1), b3 + hstepB, voffB); PG8_STAGE_A(PG8_SA(1, 0), a3, 0, sOff);
            PG8_WAIT_V(8); PG8_WAIT_L(0); PG8_BAR; PG8_MMA(1, 0, At, B0); PG8_MMA(1, 1, At, B1); PG8_BAR; PG8_SCHED;
        }
        if constexpr (ALIGN_EPI) { if (wr == 0) PG8_BAR; }
        if constexpr (ES == 1) { asm volatile("s_nop 15\n\ts_nop 15" ::: "memory"); }
        E(acc, cur, wr, wc, fr, fq);
        if (PHREP(25)) E(acc, cur, wr, wc, fr, fq);
        if (!has_next) break;
        E.init(acc, nxt, wc, fq);
        cur = nxt; cA = nA; cB = nB; ++ui;
        if constexpr (GA) {
#pragma unroll
            for (int h = 0; h < 2; ++h)
#pragma unroll
                for (int i = 0; i < 2; ++i) cOff[h][i] = nOff[h][i]; }
        if constexpr (ALIGN_EPI) { if (wr == 1) PG8_BAR; }
    }
    PG8_WAIT_V(0);
    if constexpr (!ALIGN_EPI) { if (wr == 0) PG8_BAR; }
    PG8_BAR;
#undef PG8_SA
#undef PG8_SB
#undef PG8_STAGE
#undef PG8_STAGE_A
#undef PG8_LDA
#undef PG8_LDB
#undef PG8_MMA
#undef PG8_WAIT_V
#undef PG8_WAIT_L
#undef PG8_WAIT_VR
#undef PG8_BAR
#undef PG8_SCHED
#undef PG8_GOFF
}
}

#define XB_TMO      128
#define XB_XCNT(j)  (256  + 64 * (j))
#define XB_XSUB(j)  (1280 + 64 * (j))
#define XB_XGEN(j)  (2304 + 64 * (j))
#define XB_TOP      3328
#define XB_TOPGEN   3392
#define XCD_BAR_WORDS 3456
#define XB_SPIN_CAP (1u << 18)
__device__ __forceinline__ unsigned xb_ld(unsigned* p)              { return __hip_atomic_load(p, __ATOMIC_RELAXED, __HIP_MEMORY_SCOPE_AGENT); }
__device__ __forceinline__ unsigned xb_add(unsigned* p, unsigned v) { return __hip_atomic_fetch_add(p, v, __ATOMIC_RELAXED, __HIP_MEMORY_SCOPE_AGENT); }
__device__ __forceinline__ unsigned xb_xcc_id() { return (unsigned)__builtin_amdgcn_s_getreg((3 << 11) | 20) & 0xFu; }
#define XB_SPIN(cond, bar) do { unsigned _sp = 0; while (cond) { __builtin_amdgcn_s_sleep(1); \
    if ((++_sp & 255u) == 0u) { if (xb_ld(&(bar)[XB_TMO])) break; if (_sp > XB_SPIN_CAP) { atomicAdd(&(bar)[XB_TMO], 1u); break; } } } } while (0)
struct XcdBarrier { unsigned* bar; unsigned x; volatile LAS unsigned* st; };
__device__ __forceinline__ XcdBarrier xcd_barrier_post(unsigned* bar, volatile LAS unsigned* st) {
    XcdBarrier b; b.bar = bar; b.x = xb_xcc_id(); b.st = st;
    if (threadIdx.x == 0) (void)xb_add(&bar[XB_XCNT(b.x)], 1u);
    return b;
}
__device__ __forceinline__ void xcd_barrier_complete(unsigned* bar, unsigned x, unsigned& nloc, unsigned& nx) {
    const unsigned G = gridDim.x * gridDim.y * gridDim.z;
    unsigned sum, cnt, mine, sp = 0u;
    for (;;) {
        sum = 0u; cnt = 0u; mine = 0u;
#pragma unroll
        for (unsigned j = 0; j < 16; ++j) { const unsigned c = xb_ld(&bar[XB_XCNT(j)]); sum += c; cnt += (c > 0u) ? 1u : 0u; mine = (j == x) ? c : mine; }
        if (sum == G) break;
        __builtin_amdgcn_s_sleep(1);
        if ((++sp & 255u) == 0u) { if (xb_ld(&bar[XB_TMO])) break; if (sp > XB_SPIN_CAP) { atomicAdd(&bar[XB_TMO], 1u); break; } }
    }
    nloc = mine > 0u ? mine : 1u; nx = cnt > 0u ? cnt : 1u;
}
__device__ __forceinline__ void xcd_barrier(const XcdBarrier& b) {
    asm volatile("s_waitcnt vmcnt(0)" ::: "memory");
    __syncthreads();
    if (threadIdx.x == 0) {
        unsigned* bar = b.bar;
        __builtin_amdgcn_s_waitcnt(0);
        unsigned nloc = b.st[0], nx = b.st[1];
        if (nloc == 0u) { xcd_barrier_complete(bar, b.x, nloc, nx); b.st[0] = nloc; b.st[1] = nx; }
        const unsigned old = xb_add(&bar[XB_XSUB(b.x)], 1u);
        const unsigned gen = old / nloc;
        if (old + 1u == (gen + 1u) * nloc) {
            __builtin_amdgcn_fence(__ATOMIC_RELEASE, "agent");
            asm volatile("s_waitcnt vmcnt(0)" ::: "memory");
            const unsigned og = xb_add(&bar[XB_TOP], 1u);
            const unsigned tg = og / nx;
            if (og + 1u == (tg + 1u) * nx) xb_add(&bar[XB_TOPGEN], 1u);
            else XB_SPIN(xb_ld(&bar[XB_TOPGEN]) == tg, bar);
            __builtin_amdgcn_fence(__ATOMIC_ACQUIRE, "agent");
            xb_add(&bar[XB_XGEN(b.x)], 1u);
            asm volatile("s_waitcnt vmcnt(0)" ::: "memory");
        } else {
            XB_SPIN(xb_ld(&bar[XB_XGEN(b.x)]) == gen, bar);
            __builtin_amdgcn_fence(__ATOMIC_ACQUIRE, "agent");
            asm volatile("s_waitcnt vmcnt(0)" ::: "memory");
        }
    }
    __syncthreads();
}

struct Args {
    const float* in[33];
    float* out; unsigned char* ws;
    int ph_lo, ph_hi;
};
enum { I_X = 0, I_MEM, I_WIN, I_GLACONV, I_GLAW2, I_GLAB, I_GLANG, I_HGLB, I_HGNG, I_RWMU, I_RWW0, I_RWW2, I_RWA0, I_RWA2, I_RWG2, I_RWKK, I_RWKA, I_RWRK, I_RWLNW, I_RWLNB,
       I_WMK, I_WMV, I_WOUT, I_LN1G, I_LN1B, I_RTW, I_RTB, I_WGU, I_BGU, I_WDN, I_BDN, I_LN2G, I_LN2B };


template <int OFF> __device__ __forceinline__ unsigned long long ka_u64() { unsigned long long v; asm volatile("s_load_dwordx2 %0, %1, %2\n\ts_waitcnt lgkmcnt(0)" : "=s"(v) : "s"(__builtin_amdgcn_kernarg_segment_ptr()), "n"(OFF)); return v; }
#define KIN(i) ((const float*)(const GAS float*)ka_u64<8 * (i)>())
#define KOUT() ((float*)(GAS float*)ka_u64<264>())
#define KWS() ((unsigned char*)(GAS unsigned char*)ka_u64<272>())

template <class Map>
__device__ __forceinline__ void tr_item(const float* __restrict__ W, int K, int N, bf16* __restrict__ WT, LAS float* scr, int kb, int nb, int lane, Map map) {
    const int k0 = 64 * kb, n0 = 64 * nb, col = n0 + lane; const bool valid = col < N;
    const float* src = W + (size_t)k0 * N + (valid ? col : 0);
#pragma unroll 64
    for (int kk = 0; kk < 64; ++kk) { const float v = valid ? src[(size_t)kk * N] : 0.f; scr[kk * 65 + lane] = v; }
    LDS_WAIT(); asm volatile("" ::: "memory");
    const int c = lane & 7;
#pragma unroll
    for (int j = 0; j < 8; ++j) { const int n = (lane >> 3) + 8 * j;
        if (n0 + n < N) { const int orow = map(n0 + n); const LAS float* s = scr + (8 * c) * 65 + n;
            u32x4 o; o.x = pk2(s[0 * 65], s[1 * 65]); o.y = pk2(s[2 * 65], s[3 * 65]); o.z = pk2(s[4 * 65], s[5 * 65]); o.w = pk2(s[6 * 65], s[7 * 65]);
            *(u32x4*)(WT + (size_t)orow * K + k0 + 8 * c) = o; } }
    LDS_WAIT(); asm volatile("" ::: "memory");
}
template <bool GUARD = false, class Map>
__device__ __forceinline__ void tr_item_f8(const float* __restrict__ W, int K, int N, unsigned char* __restrict__ WT8, LAS float* scr, int kb, int nb, int lane, float scale, Map map) {
    const int k0 = 64 * kb, n0 = 64 * nb, col = (GUARD && n0 + lane >= N) ? N - 1 : n0 + lane;
    const float* src = W + (size_t)k0 * N + col;
#pragma unroll 64
    for (int kk = 0; kk < 64; ++kk) scr[kk * 65 + lane] = src[(size_t)kk * N] * scale;
    LDS_WAIT(); asm volatile("" ::: "memory");
    const int c = lane & 3;
#pragma unroll
    for (int j = 0; j < 4; ++j) { const int n = (lane >> 2) + 16 * j; const LAS float* s = scr + (16 * c) * 65 + n;
        u32x4 o;
#pragma unroll
        for (int q = 0; q < 4; ++q) { int w = __builtin_amdgcn_cvt_pk_fp8_f32(s[(4 * q) * 65], s[(4 * q + 1) * 65], 0, false); w = __builtin_amdgcn_cvt_pk_fp8_f32(s[(4 * q + 2) * 65], s[(4 * q + 3) * 65], w, true); o[q] = (unsigned)w; }
        if (!GUARD || n0 + n < N) { const int orow = map(n0 + n); *(u32x4*)(WT8 + (size_t)orow * K + k0 + 16 * c) = o; } }
    LDS_WAIT(); asm volatile("" ::: "memory");
}
struct MapIdent { int off; __device__ __forceinline__ int operator()(int c) const { return c + off; } };
struct MapWin { __device__ __forceinline__ int operator()(int c) const { return c < 512 ? c : (c < 528 ? c + 2560 : c - 16); } };
__device__ __forceinline__ int gu_row(int c) { const int f = c >> 1, bj = c & 1, pn = f >> 7, fl = f & 127, wc = fl >> 5, fq = (fl >> 3) & 3, n = (fl >> 2) & 1, j = fl & 3; return 256 * pn + 128 * bj + 32 * wc + 16 * n + 4 * fq + j; }
struct MapGu { __device__ __forceinline__ int operator()(int c) const { return gu_row(c); } };

__device__ __forceinline__ void prologue_phase(LAS unsigned char* lds, int vcu, int G) {
    const int tid = opaque_tid(), lane = tid & 63, wave = __builtin_amdgcn_readfirstlane(tid >> 6);
    LAS float* scr = (LAS float*)(lds + wave * 16640); static_assert(8 * 16640 <= LDSCTL_OFF, "prologue scratch below the LDS control words");
    const int gw = vcu * NWAVES + wave, NGW = G * NWAVES;
    unsigned char* ws = KWS();
    constexpr int IT_GU = NL * NE * 512, IT_DN = NL * NE * 256, IT_IN = NL * 16 * 49, IT_OUT = NL * 256, IT_MEM = NL * 2 * 64, IT_L64 = NL * 2 * 4, IT_L128 = NL * 2 * 4;
    constexpr int IT_TOTAL = IT_GU + IT_DN + IT_IN + IT_OUT + IT_MEM + IT_L64 + IT_L128;
    for (int it = gw; it < IT_TOTAL; it += NGW) {
        int r = it;
        if (r < IT_GU) { const int le = r >> 9, q = r & 511, kb = q >> 5, nb = q & 31;
            tr_item_f8(KIN(I_WGU) + (size_t)le * 1024 * 2048, 1024, 2048, (unsigned char*)(ws + WS_WGU) + (size_t)le * 2048 * 1024, scr, kb, nb, lane, 16.0f, MapGu{}); continue; } r -= IT_GU;
        if (r < IT_DN) { const int le = r >> 8, q = r & 255, kb = q >> 4, nb = q & 15;
            tr_item_f8(KIN(I_WDN) + (size_t)le * 1024 * 1024, 1024, 1024, (unsigned char*)(ws + WS_WD) + (size_t)le * 1024 * 1024, scr, kb, nb, lane, 32.0f, MapIdent{0}); continue; } r -= IT_DN;
        if (r < IT_IN) { const int l = r / (16 * 49), q = r % (16 * 49), kb = q / 49, nb = q % 49;
            tr_item_f8<true>(KIN(I_WIN) + (size_t)l * 1024 * PIN, 1024, PIN, (unsigned char*)(ws + WS_WIN) + (size_t)l * PINP * 1024, scr, kb, nb, lane, 16.0f, MapWin{}); continue; } r -= IT_IN;
        if (r < IT_OUT) { const int l = r >> 8, q = r & 255, kb = q >> 4, nb = q & 15;
            tr_item_f8(KIN(I_WOUT) + (size_t)l * 1024 * 1024, 1024, 1024, (unsigned char*)(ws + WS_WOUT) + (size_t)l * 1024 * 1024, scr, kb, nb, lane, 32.0f, MapIdent{0}); continue; } r -= IT_OUT;
        if (r < IT_MEM) { const int l = r >> 7, q = r & 127, kv = q >> 6, kb = (q >> 2) & 15, nb = q & 3;
            tr_item((kv ? KIN(I_WMV) : KIN(I_WMK)) + (size_t)l * 1024 * 256, 1024, 256, (bf16*)(ws + WS_WMEM), scr, kb, nb, lane, MapIdent{l * 512 + kv * 256}); continue; } r -= IT_MEM;
        if (r < IT_L64) { const int l = r >> 3, q = r & 7, wa = q >> 2, nb = q & 3;
            tr_item((wa ? KIN(I_RWA2) : KIN(I_RWW2)) + (size_t)l * 64 * 256, 64, 256, (bf16*)(ws + WS_LORA) + (size_t)wa * (NL * 256 * 64) + (size_t)l * 256 * 64, scr, 0, nb, lane, MapIdent{0}); continue; } r -= IT_L64;
        { const int l = r >> 3, q = r & 7, kb = q >> 2, nb = q & 3;
            tr_item(KIN(I_RWG2) + (size_t)l * 128 * 256, 128, 256, (bf16*)(ws + WS_LORA) + (size_t)2 * (NL * 256 * 64) + (size_t)l * 256 * 128, scr, kb, nb, lane, MapIdent{0}); }
    }
    { const size_t gt = (size_t)vcu * NTHR + tid, GT = (size_t)G * NTHR; constexpr size_t per = (size_t)(PINP - PIN) * 1024 / 16;
        for (size_t i = gt; i < per * NL; i += GT) { const size_t l = i / per, j = i % per; *(u32x4*)((unsigned char*)(ws + WS_WIN) + l * PINP * 1024 + (size_t)PIN * 1024 + j * 16) = (u32x4){0u, 0u, 0u, 0u}; }
        for (size_t i = gt; i < (size_t)NL * 8192; i += GT) { const int l = (int)(i >> 13), q = (int)(i >> 6) & 127, ln = (int)i & 63, jj = q >> 4, c = q & 15, k0 = 4 * (ln + 64 * (jj >> 1)) + 2 * (jj & 1);
            const float* s = KIN(I_WIN) + (size_t)l * 1024 * PIN + (size_t)k0 * PIN + 512 + c; ((unsigned*)(ws + WS_GLRW))[i] = pk2(s[0], s[PIN]); }
        for (size_t i = gt; i < (size_t)NL * NE * 2048; i += GT) { const size_t le = i >> 11; const int c = (int)(i & 2047); ((float*)(ws + WS_BGU))[le * 2048 + gu_row(c)] = KIN(I_BGU)[i]; }
        const f32x4* xs = (const f32x4*)KIN(I_X); unsigned char* xd8 = (unsigned char*)(ws + WS_X8);
        for (size_t i = gt; i < (size_t)NTOK * D / 8; i += GT) { const f32x4 v0 = xs[2 * i], v1 = xs[2 * i + 1]; store_o4(xd8 + 8 * i, v0[0], v0[1], v0[2], v0[3]); store_o4(xd8 + 8 * i + 4, v1[0], v1[1], v1[2], v1[3]); }
        const f32x4* ms = (const f32x4*)KIN(I_MEM); u32x4* md = (u32x4*)(ws + WS_MEMB);
        for (size_t i = gt; i < (size_t)NB * NMEM * D / 8; i += GT) { const f32x4 v0 = ms[2 * i], v1 = ms[2 * i + 1]; md[i] = (u32x4){pk2(v0[0], v0[1]), pk2(v0[2], v0[3]), pk2(v1[0], v1[1]), pk2(v1[2], v1[3])}; }
    }
}


__device__ __forceinline__ float log1pexp_neg_abs(float z) { return __builtin_amdgcn_logf(1.0f + fast_exp(-fabsf(z))) * 0.6931471805599453f; }
__device__ __forceinline__ float tanh_f(float x) { const float e = fast_exp(-2.0f * fabsf(x)); const float t = (1.0f - e) * __builtin_amdgcn_rcpf(1.0f + e); return x < 0.f ? -t : t; }

constexpr int NCH = T / 32;
__device__ __forceinline__ int rho16(int r, int hh) { return (r & 3) + 8 * (r >> 2) + 4 * hh; }
template <int DK>
__device__ __forceinline__ void gh_intra_store(const LAS bf16* QLb, const LAS bf16* KLb, const LAS bf16* VT, int vt, int lane, bf16* OIg  ) {
    const int r32 = lane & 31, hh = lane >> 5;
    f32x16 at;
#pragma unroll
    for (int i = 0; i < 16; ++i) at[i] = 0.f;
#pragma unroll
    for (int s = 0; s < DK / 16; ++s) { const bf16x8 qf = *(const LAS bf16x8*)(QLb + r32 * DK + 16 * s + 8 * hh), kf = *(const LAS bf16x8*)(KLb + r32 * DK + 16 * s + 8 * hh);
        at = __builtin_amdgcn_mfma_f32_32x32x16_bf16(kf, qf, at, 0, 0, 0); }
#pragma unroll
    for (int r = 0; r < 16; ++r) if (rho16(r, hh) > r32) at[r] = 0.f;
    f32x16 oi;
#pragma unroll
    for (int i = 0; i < 16; ++i) oi[i] = 0.f;
#pragma unroll
    for (int s = 0; s < 2; ++s) { union { bf16x8 v; unsigned w[4]; } pf;
#pragma unroll
        for (int j = 0; j < 4; ++j) pf.w[j] = cvt_pk_bf16(at[8 * s + 2 * j], at[8 * s + 2 * j + 1]);
        const LAS bf16* vp = VT + (32 * vt + r32) * 32 + 16 * s + 4 * hh;
        union { bf16x8 v; s16x4 h2[2]; } vf; vf.h2[0] = *(const LAS s16x4*)vp; vf.h2[1] = *(const LAS s16x4*)(vp + 8);
        oi = __builtin_amdgcn_mfma_f32_32x32x16_bf16(vf.v, pf.v, oi, 0, 0, 0); }
#pragma unroll
    for (int g2 = 0; g2 < 2; ++g2) *(u32x4*)(OIg + ((vt * 2 + g2) * 64 + lane) * 8) = (u32x4){cvt_pk_bf16(oi[8 * g2], oi[8 * g2 + 1]), cvt_pk_bf16(oi[8 * g2 + 2], oi[8 * g2 + 3]),
                                                                                         cvt_pk_bf16(oi[8 * g2 + 4], oi[8 * g2 + 5]), cvt_pk_bf16(oi[8 * g2 + 6], oi[8 * g2 + 7])};
}
__device__ __forceinline__ void hg_fused_unit(LAS unsigned char* lds, int l, int b, int c) {
    const int tid = opaque_tid(), lane = tid & 63, wave = __builtin_amdgcn_readfirstlane(tid >> 6), r32 = lane & 31, hh = lane >> 5;
    unsigned char* ws = KWS();
    const bf16* P = (const bf16*)(ws + WS_P) + ((size_t)b * T + c * 32) * PINP;
    constexpr int HB = 16640;
    if (tid < 256) {
        const int ch = tid, h = ch >> 6, d = ch & 63; const size_t un = (size_t)(b * 4 + h) * NCH + c;
        const float* hp = KIN(I_HGLB) + ch; const float v0 = hp[0], v1 = hp[256], v2 = hp[512], v3 = hp[768];
        unsigned short hqr[32], hfr[32];
#pragma unroll
        for (int t = 0; t < 32; ++t) { const bf16* row = P + (size_t)t * PINP; hqr[t] = row[PC_HQ + ch]; hfr[t] = row[PC_HF + ch]; }
        __builtin_amdgcn_sched_barrier(0);
        float lb;
        { const float m = fmaxf(fmaxf(v0, v1), fmaxf(v2, v3));
          const float e0 = __expf(v0 - m), e1 = __expf(v1 - m), e2 = __expf(v2 - m), e3 = __expf(v3 - m); const float inv = 1.0f / (e0 + e1 + e2 + e3);
          lb = (l >= 1 ? e1 : 0.f) + (l >= 2 ? e2 : 0.f) + (l >= 3 ? e3 : 0.f); lb *= inv; }
        const float oml = 1.0f - lb;
        LAS bf16* KT = (LAS bf16*)(lds + h * HB); LAS float* BE = (LAS float*)(lds + h * HB + 8192);
        LAS bf16* QL = (LAS bf16*)(lds + h * HB + 8448) + d; LAS bf16* KL = (LAS bf16*)(lds + h * HB + 12544) + d;
        float bc = 1.0f;
#pragma unroll
        for (int t8 = 0; t8 < 4; ++t8) { u32x4 kp;
#pragma unroll
            for (int jj = 0; jj < 4; ++jj) { float k2[2];
#pragma unroll
                for (int e = 0; e < 2; ++e) { const int t = t8 * 8 + jj * 2 + e; const float hf = bf2f(hfr[t]); const float eh_ = fast_exp(fminf(-hf, 80.0f)); const float s = __builtin_amdgcn_rcpf(1.0f + eh_), sn = eh_ * s;
                    bc = fmaxf(bc * fmaxf(lb + oml * s, 1e-30f), 1.8048513878454153e-35f);
                    const float qt = silu_f(bf2f(hqr[t])) * bc, kt = oml * sn * __builtin_amdgcn_rcpf(bc);
                    QL[t * 64] = (bf16)f2bf(qt); KL[t * 64] = (bf16)f2bf(kt); k2[e] = kt; }
                kp[jj] = pk2(k2[0], k2[1]); }
            *(LAS u32x4*)(KT + d * 32 + t8 * 8) = kp; }
        const float ebend = bc; BE[d] = ebend; ((float*)(ws + WS_HBE))[un * 64 + d] = ebend;
    } else {
        const int cv = tid - 256, h = cv >> 6, vi = cv & 63; const size_t un = (size_t)(b * 4 + h) * NCH + c;
        LAS bf16* VT = (LAS bf16*)(lds + h * HB + 4096);
        unsigned short hvr[32];
#pragma unroll
        for (int t = 0; t < 32; ++t) hvr[t] = P[(size_t)t * PINP + PC_HI + cv];
        __builtin_amdgcn_sched_barrier(0);
#pragma unroll
        for (int t8 = 0; t8 < 4; ++t8) { u32x4 vp;
#pragma unroll
            for (int jj = 0; jj < 4; ++jj) vp[jj] = (unsigned)hvr[t8 * 8 + 2 * jj] | ((unsigned)hvr[t8 * 8 + 2 * jj + 1] << 16);
            *(LAS u32x4*)(VT + vi * 32 + t8 * 8) = vp; }
    }
    lds_barrier();
    { const int h = wave >> 1, vt = wave & 1; const size_t un = (size_t)(b * 4 + h) * NCH + c;
      const LAS bf16* KT = (const LAS bf16*)(lds + h * HB); const LAS bf16* VT = (const LAS bf16*)(lds + h * HB + 4096); const LAS float* BE = (const LAS float*)(lds + h * HB + 8192);
      bf16* DSg = (bf16*)(ws + WS_HDS) + un * 4096;
      { const LAS bf16* srcL = (const LAS bf16*)(lds + h * HB + 8448); u32x4* dstG = (u32x4*)((bf16*)(ws + WS_HQ) + un * 2048);
#pragma unroll
        for (int i = 0; i < 2; ++i) dstG[(vt * 2 + i) * 64 + lane] = *(const LAS u32x4*)(srcL + ((vt * 2 + i) * 64 + lane) * 8); }
      gh_intra_store<64>((const LAS bf16*)(lds + h * HB + 8448), (const LAS bf16*)(lds + h * HB + 12544), VT, vt, lane, (bf16*)(ws + WS_HVT) + un * 2048);
#pragma unroll
      for (int dt = 0; dt < 2; ++dt) { f32x16 acc;
#pragma unroll
          for (int i = 0; i < 16; ++i) acc[i] = 0.f;
#pragma unroll
          for (int s = 0; s < 2; ++s) { const bf16x8 A = *(const LAS bf16x8*)(VT + (32 * vt + r32) * 32 + 16 * s + 8 * hh), B = *(const LAS bf16x8*)(KT + (32 * dt + r32) * 32 + 16 * s + 8 * hh);
              acc = __builtin_amdgcn_mfma_f32_32x32x16_bf16(A, B, acc, 0, 0, 0); }
          const float ebd = BE[32 * dt + r32];
#pragma unroll
          for (int r = 0; r < 16; ++r) DSg[(32 * vt + rho16(r, hh)) * 64 + 32 * dt + r32] = (bf16)f2bf(acc[r] * ebd); } }
    lds_barrier();
}
__device__ __forceinline__ void gla_fused_unit(LAS unsigned char* lds, int l, int b, int c) {
    const int tid = opaque_tid(), lane = tid & 63, wave = __builtin_amdgcn_readfirstlane(tid >> 6), r32 = lane & 31, hh = lane >> 5;
    unsigned char* ws = KWS();
    const int t0 = c * 32;
    const bf16* P = (const bf16*)(ws + WS_P) + ((size_t)b * T + t0) * PINP;
    LAS float* GL = (LAS float*)lds;
    constexpr int HB = 10368, H0 = 2048;
    const unsigned short glr = P[(size_t)(tid >> 4) * PINP + PC_GLR + (tid & 15)];
    unsigned short xra[32], xrb[32], hra[3], hrb[3]; float cwv[8], wc[16], gb = 0.f;
    const long hb = t0 > 0 ? 1 : 0;
    if (tid < 128) { const int ch = tid;
        const float* cw = KIN(I_GLACONV) + (size_t)l * 4 * 512 + ch;
        cwv[0] = cw[0]; cwv[1] = cw[512]; cwv[2] = cw[1024]; cwv[3] = cw[1536]; cwv[4] = cw[128]; cwv[5] = cw[640]; cwv[6] = cw[1152]; cwv[7] = cw[1664];
        const float* w2p = KIN(I_GLAW2) + (size_t)l * 16 * 128 + ch;
#pragma unroll
        for (int r = 0; r < 16; ++r) wc[r] = w2p[r * 128];
        gb = KIN(I_GLAB)[l * 128 + ch];
#pragma unroll
        for (int j = 0; j < 3; ++j) { const bf16* hrow = P - hb * (3 - j) * PINP; hra[j] = hrow[PC_GQ + ch]; hrb[j] = hrow[PC_GK + ch]; }
#pragma unroll
        for (int t = 0; t < 32; ++t) { const bf16* row = P + (size_t)t * PINP; xra[t] = row[PC_GQ + ch]; xrb[t] = row[PC_GK + ch]; }
    } else if (tid < 384) { const int cv = tid - 128;
        const float* cw = KIN(I_GLACONV) + (size_t)l * 4 * 512 + 256 + cv;
        cwv[0] = cw[0]; cwv[1] = cw[512]; cwv[2] = cw[1024]; cwv[3] = cw[1536];
#pragma unroll
        for (int j = 0; j < 3; ++j) hra[j] = (P - hb * (3 - j) * PINP)[PC_GV + cv];
#pragma unroll
        for (int t = 0; t < 32; ++t) xra[t] = P[(size_t)t * PINP + PC_GV + cv];
    }
    __builtin_amdgcn_sched_barrier(0);
    GL[tid] = bf2f(glr);
    lds_barrier();
    if (tid < 128) {
        const int ch = tid, h = ch >> 5, d = ch & 31; const size_t un = (size_t)(b * 4 + h) * NCH + c;
        const float q0 = cwv[0], q1 = cwv[1], q2 = cwv[2], q3 = cwv[3], k0 = cwv[4], k1 = cwv[5], k2w = cwv[6], k3 = cwv[7];
        float uq0 = hb ? bf2f(hra[0]) : 0.f, uq1 = hb ? bf2f(hra[1]) : 0.f, uq2 = hb ? bf2f(hra[2]) : 0.f, uk0 = hb ? bf2f(hrb[0]) : 0.f, uk1 = hb ? bf2f(hrb[1]) : 0.f, uk2 = hb ? bf2f(hrb[2]) : 0.f;
        LAS bf16* KT = (LAS bf16*)(lds + H0 + h * HB); LAS float* BE = (LAS float*)(lds + H0 + h * HB + 6144);
        LAS bf16* QL = (LAS bf16*)(lds + H0 + h * HB + 6272) + d; LAS bf16* KL = (LAS bf16*)(lds + H0 + h * HB + 8320) + d;
        float bc = 0.f;
#pragma unroll
        for (int t8 = 0; t8 < 4; ++t8) { u32x4 kp;
#pragma unroll
            for (int jj = 0; jj < 4; ++jj) { float kk2[2];
#pragma unroll
                for (int e = 0; e < 2; ++e) { const int t = t8 * 8 + jj * 2 + e; const float uq3 = bf2f(xra[t]), uk3 = bf2f(xrb[t]);
                    const float q = silu_f(q0 * uq0 + q1 * uq1 + q2 * uq2 + q3 * uq3) * 0.17677669529663687f, k = silu_f(k0 * uk0 + k1 * uk1 + k2w * uk2 + k3 * uk3);
                    uq0 = uq1; uq1 = uq2; uq2 = uq3; uk0 = uk1; uk1 = uk2; uk2 = uk3;
                    float z = gb;
#pragma unroll
                    for (int r = 0; r < 16; ++r) z += GL[t * 16 + r] * wc[r];
                    bc = fmaxf(bc + (fminf(z, 0.f) - log1pexp_neg_abs(z)) * 0.0625f, -80.0f);
                    const float qt = q * fast_exp(bc), kt = k * fast_exp(-bc);
                    QL[t * 32] = (bf16)f2bf(qt); KL[t * 32] = (bf16)f2bf(kt); kk2[e] = kt; }
                kp[jj] = pk2(kk2[0], kk2[1]); }
            *(LAS u32x4*)(KT + d * 32 + t8 * 8) = kp; }
        const float ebend = fast_exp(bc); BE[d] = ebend; ((float*)(ws + WS_GBE))[un * 32 + d] = ebend;
    } else if (tid < 384) {
        const int cv = tid - 128, h = cv >> 6, vi = cv & 63; const size_t un = (size_t)(b * 4 + h) * NCH + c;
        const float w0 = cwv[0], w1 = cwv[1], w2 = cwv[2], w3 = cwv[3];
        float u0 = hb ? bf2f(hra[0]) : 0.f, u1 = hb ? bf2f(hra[1]) : 0.f, u2 = hb ? bf2f(hra[2]) : 0.f;
        LAS bf16* VT = (LAS bf16*)(lds + H0 + h * HB + 2048);
#pragma unroll
        for (int t8 = 0; t8 < 4; ++t8) { u32x4 vp; float yv[8];
#pragma unroll
            for (int e = 0; e < 8; ++e) { const float u3 = bf2f(xra[t8 * 8 + e]); yv[e] = silu_f(w0 * u0 + w1 * u1 + w2 * u2 + w3 * u3); u0 = u1; u1 = u2; u2 = u3; }
#pragma unroll
            for (int jj = 0; jj < 4; ++jj) vp[jj] = pk2(yv[2 * jj], yv[2 * jj + 1]);
            *(LAS u32x4*)(VT + vi * 32 + t8 * 8) = vp; }
    }
    lds_barrier();
    { const int h = wave >> 1, vt = wave & 1; const size_t un = (size_t)(b * 4 + h) * NCH + c;
      const LAS bf16* KT = (const LAS bf16*)(lds + H0 + h * HB); const LAS bf16* VT = (const LAS bf16*)(lds + H0 + h * HB + 2048); const LAS float* BE = (const LAS float*)(lds + H0 + h * HB + 6144);
      bf16* DSg = (bf16*)(ws + WS_GDS) + un * 2048;
      { const LAS bf16* srcL = (const LAS bf16*)(lds + H0 + h * HB + 6272); u32x4* dstG = (u32x4*)((bf16*)(ws + WS_GQ) + un * 1024);
        dstG[vt * 64 + lane] = *(const LAS u32x4*)(srcL + (vt * 64 + lane) * 8); }
      gh_intra_store<32>((const LAS bf16*)(lds + H0 + h * HB + 6272), (const LAS bf16*)(lds + H0 + h * HB + 8320), VT, vt, lane, (bf16*)(ws + WS_GVT) + un * 2048);
      f32x16 acc;
#pragma unroll
      for (int i = 0; i < 16; ++i) acc[i] = 0.f;
#pragma unroll
      for (int s = 0; s < 2; ++s) { const bf16x8 A = *(const LAS bf16x8*)(VT + (32 * vt + r32) * 32 + 16 * s + 8 * hh), B = *(const LAS bf16x8*)(KT + r32 * 32 + 16 * s + 8 * hh);
          acc = __builtin_amdgcn_mfma_f32_32x32x16_bf16(A, B, acc, 0, 0, 0); }
      const float ebd = BE[r32];
#pragma unroll
      for (int r = 0; r < 16; ++r) DSg[(32 * vt + rho16(r, hh)) * 32 + r32] = (bf16)f2bf(acc[r] * ebd); }
    lds_barrier();
}
template <int DK>
__device__ __forceinline__ void m2_gh_elem2(int e2, const bf16* __restrict__ DS, const float* __restrict__ BE, bf16* __restrict__ SG) {
    constexpr int EPB = 64 * DK; const int e = e2 * 2, bh = e / EPB, idx = e % EPB, d = idx % DK; const size_t un0 = (size_t)bh * NCH;
    float S0 = 0.f, S1 = 0.f;
#pragma unroll 1
    for (int c0 = 0; c0 < NCH; c0 += 16) { unsigned ds[16]; f32x2 be[16];
#pragma unroll
        for (int u = 0; u < 16; ++u) { ds[u] = *(const unsigned*)(DS + (un0 + c0 + u) * EPB + idx); be[u] = *(const f32x2*)(BE + (un0 + c0 + u) * DK + d); }
#pragma unroll
        for (int u = 0; u < 16; ++u) { *(unsigned*)(SG + (un0 + c0 + u) * EPB + idx) = pk2(S0, S1); S0 = S0 * be[u][0] + bflo(ds[u]); S1 = S1 * be[u][1] + bfhi(ds[u]); } }
}
template <int DK>
__device__ __forceinline__ void m3_gh_task(int lane, const bf16* __restrict__ Qg, const bf16* __restrict__ Kg, const bf16* __restrict__ VTg, const bf16* __restrict__ Sg,
                                           const bf16* __restrict__ gate  , const float* __restrict__ ng  , unsigned char* __restrict__ orow  , LAS unsigned char* os  ) {
    const int r32 = lane & 31, hh = lane >> 5;
    bf16x8 qf[DK / 16], sfa[2][DK / 16]; u32x4 oia[2][2]; u32x2 gwa[2][4]; f32x4 n4a[2][4];
    const bf16* grow = gate + (size_t)r32 * PINP;
#pragma unroll
    for (int s = 0; s < DK / 16; ++s) qf[s] = *(const bf16x8*)(Qg + r32 * DK + 16 * s + 8 * hh);
#pragma unroll
    for (int vt = 0; vt < 2; ++vt)
#pragma unroll
        for (int g2 = 0; g2 < 2; ++g2) oia[vt][g2] = *(const u32x4*)(VTg + ((vt * 2 + g2) * 64 + lane) * 8);
#pragma unroll
    for (int vt = 0; vt < 2; ++vt)
#pragma unroll
        for (int s = 0; s < DK / 16; ++s) sfa[vt][s] = *(const bf16x8*)(Sg + (32 * vt + r32) * DK + 16 * s + 8 * hh);
#pragma unroll
    for (int vt = 0; vt < 2; ++vt)
#pragma unroll
        for (int g = 0; g < 4; ++g) { gwa[vt][g] = *(const u32x2*)(grow + 32 * vt + 8 * g + 4 * hh); n4a[vt][g] = *(const f32x4*)(ng + 32 * vt + 8 * g + 4 * hh); }
    __builtin_amdgcn_sched_barrier(0);
    f32x16 o[2];
#pragma unroll
    for (int vt = 0; vt < 2; ++vt)
#pragma unroll
        for (int g2 = 0; g2 < 2; ++g2)
#pragma unroll
            for (int j = 0; j < 4; ++j) { o[vt][8 * g2 + 2 * j] = bflo(oia[vt][g2][j]); o[vt][8 * g2 + 2 * j + 1] = bfhi(oia[vt][g2][j]); }
#pragma unroll
    for (int vt = 0; vt < 2; ++vt)
#pragma unroll
        for (int s = 0; s < DK / 16; ++s) o[vt] = __builtin_amdgcn_mfma_f32_32x32x16_bf16(sfa[vt][s], qf[s], o[vt], 0, 0, 0);
    float ss = 0.f;
#pragma unroll
    for (int vt = 0; vt < 2; ++vt)
#pragma unroll
        for (int i = 0; i < 16; ++i) ss += o[vt][i] * o[vt][i];
    ss += __shfl_xor(ss, 32);
    const float rstd = 1.0f / sqrtf(ss * (1.0f / 64.0f) + RMS_EPS);
#pragma unroll
    for (int vt = 0; vt < 2; ++vt)
#pragma unroll
        for (int g = 0; g < 4; ++g) { const int v0 = 32 * vt + 8 * g + 4 * hh; const u32x2 gw = gwa[vt][g]; const f32x4 n4 = n4a[vt][g];
            const float y0 = o[vt][4 * g] * rstd * n4[0] * silu_f(bflo(gw.x)), y1 = o[vt][4 * g + 1] * rstd * n4[1] * silu_f(bfhi(gw.x));
            const float y2 = o[vt][4 * g + 2] * rstd * n4[2] * silu_f(bflo(gw.y)), y3 = o[vt][4 * g + 3] * rstd * n4[3] * silu_f(bfhi(gw.y));
            *(LAS unsigned*)(os + r32 * 64 + v0) = pack_o4(y0, y1, y2, y3); }
    flush_o_tile(os, orow, lane);
}

constexpr int RWC_HEADB = 28928;
constexpr int RWC_AL = 4 * RWC_HEADB, RWC_LWL = RWC_AL + 32 * 264 * 2;
static_assert(RWC_LWL + 32 * 264 * 2 <= LDSCTL_OFF, "rw_fused_unit LDS");
__device__ __forceinline__ void rw_fused_unit(LAS unsigned char* lds, int l, int b, int c) {
    const int tid = opaque_tid(), lane = tid & 63, wave = __builtin_amdgcn_readfirstlane(tid >> 6), h = wave >> 1, p = wave & 1, r32 = lane & 31, hh = lane >> 5;
    unsigned char* ws = KWS();
    const int bh = b * 4 + h; const size_t un = (size_t)bh * NCH + c;
    const int t0 = c * 32;
    const bf16* P = (const bf16*)(ws + WS_P) + ((size_t)b * T + t0) * PINP + PC_RW;
    const float* mu = KIN(I_RWMU) + (size_t)l * 1024;
    LAS bf16* XL = (LAS bf16*)lds;
    LAS bf16* AL = (LAS bf16*)(lds + RWC_AL);
    LAS bf16* LWL = (LAS bf16*)(lds + RWC_LWL);
    bf16x8 bwW[4], bwA[4], bwG[8]; float w0c, a0c;
    { const int ch = wave * 32 + r32;
      const bf16* w2T = (const bf16*)(ws + WS_LORA) + (size_t)l * 256 * 64 + (size_t)ch * 64 + 8 * hh;
      const bf16* a2T = (const bf16*)(ws + WS_LORA) + (size_t)(NL * 256 * 64) + (size_t)l * 256 * 64 + (size_t)ch * 64 + 8 * hh;
      const bf16* g2T = (const bf16*)(ws + WS_LORA) + (size_t)2 * (NL * 256 * 64) + (size_t)l * 256 * 128 + (size_t)ch * 128 + 8 * hh;
#pragma unroll
      for (int s = 0; s < 4; ++s) { bwW[s] = *(const bf16x8*)(w2T + 16 * s); bwA[s] = *(const bf16x8*)(a2T + 16 * s); }
#pragma unroll
      for (int s = 0; s < 8; ++s) bwG[s] = *(const bf16x8*)(g2T + 16 * s);
      w0c = KIN(I_RWW0)[l * 256 + ch]; a0c = KIN(I_RWA0)[l * 256 + ch]; }
    { const int cc = tid & 255, tp = tid >> 8; const float mc = mu[768 + cc];
      unsigned short xr[17];
#pragma unroll
      for (int j = 0; j < 17; ++j) { const int tk = tp * 16 + j - 1;
          if (j == 0) { const bool ok = (t0 + tk >= 0); const unsigned short v = P[(long)(ok ? tk : 0) * PINP + 768 + cc]; xr[0] = ok ? v : (unsigned short)0; }
          else xr[j] = P[(long)tk * PINP + 768 + cc]; }
#pragma unroll
      for (int j = 0; j < 16; ++j) { const float cur = bf2f(xr[j + 1]), prev = bf2f(xr[j]);
          float x = cur + (prev - cur) * mc;
          if (cc < 64) x = tanh_f(x); else if (cc >= 128) x = fast_sigmoid(x);
          XL[(tp * 16 + j) * 264 + cc] = (bf16)f2bf(x); } }
    lds_barrier();
    float mr, mk, mv, kkc, kac, rkc; unsigned short xrr[17], xkr[17], xvr[17];
    { const int ch = (wave & 3) * 64 + lane, tb = (wave >> 2) * 16;
      mr = mu[ch]; mk = mu[256 + ch]; mv = mu[512 + ch]; kkc = KIN(I_RWKK)[l * 256 + ch]; kac = KIN(I_RWKA)[l * 256 + ch]; rkc = KIN(I_RWRK)[l * 256 + ch];
#pragma unroll
      for (int j = 0; j < 17; ++j) { const int tk = tb + j - 1;
          if (j == 0) { const bool ok = (t0 + tk >= 0); const bf16* row = P + (long)(ok ? tk : 0) * PINP; const unsigned short v0 = row[ch], v1 = row[256 + ch], v2 = row[512 + ch];
              xrr[0] = ok ? v0 : (unsigned short)0; xkr[0] = ok ? v1 : (unsigned short)0; xvr[0] = ok ? v2 : (unsigned short)0; }
          else { const bf16* row = P + (long)tk * PINP; xrr[j] = row[ch]; xkr[j] = row[256 + ch]; xvr[j] = row[512 + ch]; } }
      __builtin_amdgcn_sched_barrier(0); }
    {
        const int ch = wave * 32 + r32;
        const LAS bf16* xa = XL + r32 * 264 + 8 * hh;
        {
            f32x16 acc;
#pragma unroll
            for (int i = 0; i < 16; ++i) acc[i] = 0.f;
#pragma unroll
            for (int s = 0; s < 4; ++s) { const bf16x8 A = *(const LAS bf16x8*)(xa + 16 * s);
                acc = __builtin_amdgcn_mfma_f32_32x32x16_bf16(A, bwW[s], acc, 0, 0, 0); }
#pragma unroll
            for (int r = 0; r < 16; ++r) { const int tok = rho16(r, hh);
                const float zw = w0c + acc[r];
                LWL[tok * 264 + ch] = (bf16)f2bf(-0.6065306597126334f * fast_sigmoid(zw)); }
        }
        __builtin_amdgcn_sched_barrier(0);
        {
            f32x16 acc;
#pragma unroll
            for (int i = 0; i < 16; ++i) acc[i] = 0.f;
#pragma unroll
            for (int s = 0; s < 4; ++s) { const bf16x8 A = *(const LAS bf16x8*)(xa + 64 + 16 * s);
                acc = __builtin_amdgcn_mfma_f32_32x32x16_bf16(A, bwA[s], acc, 0, 0, 0); }
#pragma unroll
            for (int r = 0; r < 16; ++r) AL[rho16(r, hh) * 264 + ch] = (bf16)f2bf(fast_sigmoid(a0c + acc[r]));
        }
        __builtin_amdgcn_sched_barrier(0);
        {
            f32x16 acc;
#pragma unroll
            for (int i = 0; i < 16; ++i) acc[i] = 0.f;
#pragma unroll
            for (int s = 0; s < 8; ++s) { const bf16x8 A = *(const LAS bf16x8*)(xa + 128 + 16 * s);
                acc = __builtin_amdgcn_mfma_f32_32x32x16_bf16(A, bwG[s], acc, 0, 0, 0); }
            bf16* gb = (bf16*)(ws + WS_GBUF) + ((size_t)b * T + t0) * 256 + ch;
#pragma unroll
            for (int r = 0; r < 16; ++r) gb[(size_t)rho16(r, hh) * 256] = (bf16)f2bf(acc[r]);
        }
    }
    lds_barrier();
    LAS unsigned char* L = lds + h * RWC_HEADB;
    LAS bf16* AT = (LAS bf16*)L;
    LAS bf16* BT = (LAS bf16*)(L + 4096);
    LAS bf16* KT = (LAS bf16*)(L + 8192);
    LAS bf16* ATT = (LAS bf16*)(L + 12288);
    LAS bf16* BHT = (LAS bf16*)(L + 16384);
    LAS bf16* KHT = (LAS bf16*)(L + 20480);
    LAS bf16* VT = (LAS bf16*)(L + 24576);
    LAS float* GC = (LAS float*)(L + 28672);
    LAS float* MAB = (LAS float*)(L + 4096);
    LAS bf16* MAK = (LAS bf16*)(L + 8192);
    LAS bf16* TM = (LAS bf16*)L;
    {
        const int hs = wave & 3, half = wave >> 2, d = lane, ch = hs * 64 + d, tb = half * 16; const size_t uns = (size_t)(b * 4 + hs) * NCH + c;
        LAS unsigned char* Ls = lds + hs * RWC_HEADB;
        LAS bf16* sAT = (LAS bf16*)Ls; LAS bf16* sBT = (LAS bf16*)(Ls + 4096); LAS bf16* sKT = (LAS bf16*)(Ls + 8192);
        LAS bf16* sATT = (LAS bf16*)(Ls + 12288); LAS bf16* sBHT = (LAS bf16*)(Ls + 16384); LAS bf16* sKHT = (LAS bf16*)(Ls + 20480); LAS bf16* sVT = (LAS bf16*)(Ls + 24576); LAS float* sGC = (LAS float*)(Ls + 28672);
        float lg0 = 0.f, lg1 = 0.f;
#pragma unroll
        for (int t = 0; t < 16; ++t) { lg0 += bf2f(LWL[t * 264 + ch]); lg1 += bf2f(LWL[(16 + t) * 264 + ch]); }
        const float lgend = lg0 + lg1;
        lds_barrier();
        float* bonp = (float*)(ws + WS_BONUS) + ((size_t)b * T + t0) * 4 + hs;
        float lg = half ? lg0 : 0.f; float elg = fast_exp(lg); const float eend = fast_exp(lgend);
#pragma unroll
        for (int t8 = 0; t8 < 2; ++t8) { u32x4 ap, bp, kp;
#pragma unroll
            for (int jj = 0; jj < 4; ++jj) { float at2[2], bh2[2], kh2[2];
#pragma unroll
                for (int e = 0; e < 2; ++e) { const int j = t8 * 8 + jj * 2 + e, t = tb + j;
                    const float rc = bf2f(xrr[j + 1]), kc = bf2f(xkr[j + 1]);
                    const float r = rc + (bf2f(xrr[j]) - rc) * mr, k = kc + (bf2f(xkr[j]) - kc) * mk;
                    const float av = bf2f(AL[t * 264 + ch]), lw = bf2f(LWL[t * 264 + ch]);
                    const float kkr = k * kkc, hk = k * (1.0f + (av - 1.0f) * kac);
                    const float ss = wave_sum(kkr * kkr); const float kk = kkr * __builtin_amdgcn_rsqf(fmaxf(ss, 1e-24f));
                    const float bon = wave_sum(r * hk * rkc);
                    const float aa = -kk, bb = kk * av;
                    const float elgp = elg; lg += lw; elg = fast_exp(lg);
                    const float ei = __builtin_amdgcn_rcpf(elg), at = aa * elgp, rt = r * elg, bt = bb * ei, kt = hk * ei, eh = eend * ei;
                    sAT[t * 64 + d] = (bf16)f2bf(at); sBT[t * 64 + d] = (bf16)f2bf(bt); sKT[t * 64 + d] = (bf16)f2bf(kt);
                    LWL[t * 264 + ch] = (bf16)f2bf(rt);
                    if (d == 0) bonp[t * 4] = bon;
                    at2[e] = at; bh2[e] = bb * eh; kh2[e] = hk * eh; }
                ap[jj] = pk2(at2[0], at2[1]); bp[jj] = pk2(bh2[0], bh2[1]); kp[jj] = pk2(kh2[0], kh2[1]); }
            *(LAS u32x4*)(sATT + d * 32 + tb + t8 * 8) = ap; *(LAS u32x4*)(sBHT + d * 32 + tb + t8 * 8) = bp; *(LAS u32x4*)(sKHT + d * 32 + tb + t8 * 8) = kp; }
        if (half == 0) sGC[d] = eend;
        bf16* VTg = (bf16*)(ws + WS_RVT) + uns * 2048 + d * 32 + tb;
#pragma unroll
        for (int t8 = 0; t8 < 2; ++t8) { u32x4 vp; float yv[8];
#pragma unroll
            for (int e = 0; e < 8; ++e) { const int j = t8 * 8 + e; const float xv = bf2f(xvr[j + 1]); yv[e] = xv + (bf2f(xvr[j]) - xv) * mv; }
#pragma unroll
            for (int jj = 0; jj < 4; ++jj) vp[jj] = pk2(yv[2 * jj], yv[2 * jj + 1]);
            *(LAS u32x4*)(sVT + d * 32 + tb + t8 * 8) = vp; *(u32x4*)(VTg + t8 * 8) = vp; }
    }
    lds_barrier();
    f32x16 accR[2];
    union { bf16x8 v; unsigned w[4]; } mfr[2];
    LAS u32x4* EX = (LAS u32x4*)(lds + RWC_AL + h * 2048);
    {
        f32x16 acc, acc2;
#pragma unroll
        for (int i = 0; i < 16; ++i) { acc[i] = 0.f; acc2[i] = 0.f; }
        const LAS bf16* Bsrc = p == 0 ? BT : KT;
#pragma unroll
        for (int s = 0; s < 4; ++s) { const bf16x8 A = *(const LAS bf16x8*)(AT + r32 * 64 + 16 * s + 8 * hh), B = *(const LAS bf16x8*)(Bsrc + r32 * 64 + 16 * s + 8 * hh);
            const bf16x8 Rf = *(const LAS bf16x8*)(LWL + r32 * 264 + h * 64 + 16 * s + 8 * hh);
            acc = __builtin_amdgcn_mfma_f32_32x32x16_bf16(A, B, acc, 0, 0, 0);
            acc2 = __builtin_amdgcn_mfma_f32_32x32x16_bf16(B, Rf, acc2, 0, 0, 0); }
#pragma unroll
        for (int r = 0; r < 16; ++r) if (rho16(r, hh) > r32) acc2[r] = 0.f;
#pragma unroll
        for (int s2 = 0; s2 < 2; ++s2) {
#pragma unroll
            for (int j = 0; j < 4; ++j) mfr[s2].w[j] = cvt_pk_bf16(acc2[8 * s2 + 2 * j], acc2[8 * s2 + 2 * j + 1]);
            if (p == 0) EX[s2 * 64 + lane] = (u32x4){mfr[s2].w[0], mfr[s2].w[1], mfr[s2].w[2], mfr[s2].w[3]}; }
        if (p == 0) {
#pragma unroll
            for (int r = 0; r < 16; ++r) { const int t = rho16(r, hh); MAB[t * 32 + r32] = (r32 < t) ? acc[r] : 0.f; }
        } else {
#pragma unroll
            for (int r = 0; r < 16; ++r) { const int t = rho16(r, hh); MAK[t * 32 + r32] = (bf16)f2bf((r32 < t) ? acc[r] : 0.f); }
        }
    }
    lds_barrier();
    if (p == 0) {
        const int cidx = r32; float tc[32];
#pragma unroll
        for (int t = 0; t < 32; ++t) { float acc0 = (t == cidx) ? 1.0f : 0.f, acc1 = 0.f;
#pragma unroll
            for (int s4 = 0; s4 < (t + 3) / 4; ++s4) { const f32x4 m4 = *(const LAS f32x4*)(MAB + t * 32 + 4 * s4);
#pragma unroll
                for (int e = 0; e < 4; ++e) { const int s = 4 * s4 + e; if (s < t) { if (e & 1) acc1 = fmaf(m4[e], tc[s], acc1); else acc0 = fmaf(m4[e], tc[s], acc0); } } }
            tc[t] = acc0 + acc1; }
#pragma unroll
        for (int t = 0; t < 32; ++t) if (hh == 0) TM[t * 32 + cidx] = (bf16)f2bf(tc[t]);
    } else {
#pragma unroll
        for (int vt = 0; vt < 2; ++vt) {
#pragma unroll
            for (int i = 0; i < 16; ++i) accR[vt][i] = 0.f;
#pragma unroll
            for (int s = 0; s < 2; ++s) { const bf16x8 A = *(const LAS bf16x8*)(MAK + r32 * 32 + 16 * s + 8 * hh), B = *(const LAS bf16x8*)(VT + (32 * vt + r32) * 32 + 16 * s + 8 * hh);
                accR[vt] = __builtin_amdgcn_mfma_f32_32x32x16_bf16(A, B, accR[vt], 0, 0, 0); } }
    }
    lds_barrier();
    if (p == 0) {
        f32x16 accW[2];
#pragma unroll
        for (int dt = 0; dt < 2; ++dt) {
#pragma unroll
            for (int i = 0; i < 16; ++i) accW[dt][i] = 0.f;
#pragma unroll
            for (int s = 0; s < 2; ++s) { const bf16x8 A = *(const LAS bf16x8*)(TM + r32 * 32 + 16 * s + 8 * hh), B = *(const LAS bf16x8*)(ATT + (32 * dt + r32) * 32 + 16 * s + 8 * hh);
                accW[dt] = __builtin_amdgcn_mfma_f32_32x32x16_bf16(A, B, accW[dt], 0, 0, 0); } }
        { LAS bf16* WL = ATT;
#pragma unroll
          for (int dt = 0; dt < 2; ++dt) { f32x16 acc;
#pragma unroll
              for (int i = 0; i < 16; ++i) acc[i] = 0.f;
#pragma unroll
              for (int s = 0; s < 2; ++s) { union { bf16x8 v; unsigned w[4]; } bf;
#pragma unroll
                  for (int j = 0; j < 4; ++j) bf.w[j] = cvt_pk_bf16(accW[dt][8 * s + 2 * j], accW[dt][8 * s + 2 * j + 1]);
                  acc = __builtin_amdgcn_mfma_f32_32x32x16_bf16(mfr[s].v, bf.v, acc, 0, 0, 0); }
#pragma unroll
              for (int r = 0; r < 16; ++r) { const int t = rho16(r, hh); WL[t * 64 + 32 * dt + r32] = (bf16)f2bf(acc[r] + bf2f(LWL[t * 264 + h * 64 + 32 * dt + r32])); } }
          u32x4* RGw = (u32x4*)((bf16*)(ws + WS_RR) + un * 2048);
#pragma unroll
          for (int i = 0; i < 4; ++i) RGw[i * 64 + lane] = *(const LAS u32x4*)(WL + (i * 64 + lane) * 8); }
        LAS bf16* PL = (LAS bf16*)(L + 4096);
        const int xs = r32 >> 4, xx = r32 & 15, hhA = (xx >> 2) & 1, jA = 4 * (xx >> 3) + (xx & 3);
#pragma unroll
        for (int dt = 0; dt < 2; ++dt)
#pragma unroll
            for (int dt2 = 0; dt2 < 2; ++dt2) { f32x16 acc;
#pragma unroll
                for (int i = 0; i < 16; ++i) acc[i] = 0.f;
#pragma unroll
                for (int s = 0; s < 2; ++s) { const LAS bf16* bp = BHT + (32 * dt + r32) * 32 + 16 * s + 4 * hh;
                    union { bf16x8 v; s16x4 h2[2]; } af; af.h2[0] = *(const LAS s16x4*)bp; af.h2[1] = *(const LAS s16x4*)(bp + 8);
                    union { bf16x8 v; unsigned w[4]; } bf;
#pragma unroll
                    for (int j = 0; j < 4; ++j) bf.w[j] = cvt_pk_bf16(accW[dt2][8 * s + 2 * j], accW[dt2][8 * s + 2 * j + 1]);
                    acc = __builtin_amdgcn_mfma_f32_32x32x16_bf16(af.v, bf.v, acc, 0, 0, 0); }
                if (dt == dt2) { const float gc = GC[32 * dt + r32];
#pragma unroll
                    for (int r = 0; r < 16; ++r) if (rho16(r, hh) == r32) acc[r] += gc; }
                LAS bf16* pf = PL + (((dt * 2 + dt2) * 2 + xs) * 64 + 32 * hhA) * 8 + jA;
#pragma unroll
                for (int r = 0; r < 16; ++r) pf[rho16(r, hh) * 8] = (bf16)f2bf(acc[r]); }
        { u32x4* PFp = (u32x4*)((bf16*)(ws + WS_RP) + un * 4096);
#pragma unroll
          for (int f = 0; f < 8; ++f) PFp[f * 64 + lane] = *(const LAS u32x4*)(PL + (f * 64 + lane) * 8); }
    } else {
        f32x16 accU[2];
#pragma unroll
        for (int vt = 0; vt < 2; ++vt) {
#pragma unroll
            for (int i = 0; i < 16; ++i) accU[vt][i] = 0.f;
#pragma unroll
            for (int s = 0; s < 2; ++s) { const LAS bf16* tp = TM + r32 * 32 + 16 * s + 4 * hh;
                union { bf16x8 v; s16x4 h2[2]; } af; af.h2[0] = *(const LAS s16x4*)tp; af.h2[1] = *(const LAS s16x4*)(tp + 8);
                union { bf16x8 v; unsigned w[4]; } bf;
#pragma unroll
                for (int j = 0; j < 4; ++j) bf.w[j] = cvt_pk_bf16(accR[vt][8 * s + 2 * j], accR[vt][8 * s + 2 * j + 1]);
                accU[vt] = __builtin_amdgcn_mfma_f32_32x32x16_bf16(af.v, bf.v, accU[vt], 0, 0, 0); } }
        bf16* UGp = (bf16*)(ws + WS_RU) + un * 2048;
#pragma unroll
        for (int vt = 0; vt < 2; ++vt) { f32x16 acc;
#pragma unroll
            for (int i = 0; i < 16; ++i) acc[i] = 0.f;
#pragma unroll
            for (int s = 0; s < 2; ++s) { union { bf16x8 v; unsigned w[4]; } fu; union { bf16x8 v; u32x4 q; } fb;
#pragma unroll
                for (int j = 0; j < 4; ++j) fu.w[j] = cvt_pk_bf16(accU[vt][8 * s + 2 * j], accU[vt][8 * s + 2 * j + 1]);
                fb.q = EX[s * 64 + lane];
                acc = __builtin_amdgcn_mfma_f32_32x32x16_bf16(fu.v, fb.v, acc, 0, 0, 0);
                const LAS bf16* vp = VT + (32 * vt + r32) * 32 + 16 * s + 4 * hh;
                union { bf16x8 v; s16x4 h2[2]; } vf; vf.h2[0] = *(const LAS s16x4*)vp; vf.h2[1] = *(const LAS s16x4*)(vp + 8);
                acc = __builtin_amdgcn_mfma_f32_32x32x16_bf16(vf.v, mfr[s].v, acc, 0, 0, 0); }
#pragma unroll
            for (int g2 = 0; g2 < 2; ++g2) *(u32x4*)(UGp + ((vt * 2 + g2) * 64 + lane) * 8) = (u32x4){cvt_pk_bf16(acc[8 * g2], acc[8 * g2 + 1]), cvt_pk_bf16(acc[8 * g2 + 2], acc[8 * g2 + 3]),
                                                                                                 cvt_pk_bf16(acc[8 * g2 + 4], acc[8 * g2 + 5]), cvt_pk_bf16(acc[8 * g2 + 6], acc[8 * g2 + 7])}; }
        bf16* QFp = (bf16*)(ws + WS_RQ) + un * 4096;
#pragma unroll
        for (int vt = 0; vt < 2; ++vt)
#pragma unroll
            for (int dt = 0; dt < 2; ++dt) { f32x16 acc;
#pragma unroll
                for (int i = 0; i < 16; ++i) acc[i] = 0.f;
#pragma unroll
                for (int s = 0; s < 2; ++s) { const LAS bf16* bp = BHT + (32 * dt + r32) * 32 + 16 * s + 4 * hh;
                    union { bf16x8 v; s16x4 h2[2]; } af; af.h2[0] = *(const LAS s16x4*)bp; af.h2[1] = *(const LAS s16x4*)(bp + 8);
                    union { bf16x8 v; unsigned w[4]; } bf;
#pragma unroll
                    for (int j = 0; j < 4; ++j) bf.w[j] = cvt_pk_bf16(accU[vt][8 * s + 2 * j], accU[vt][8 * s + 2 * j + 1]);
                    acc = __builtin_amdgcn_mfma_f32_32x32x16_bf16(af.v, bf.v, acc, 0, 0, 0);
                    const bf16x8 A2 = *(const LAS bf16x8*)(KHT + (32 * dt + r32) * 32 + 16 * s + 8 * hh), B2 = *(const LAS bf16x8*)(VT + (32 * vt + r32) * 32 + 16 * s + 8 * hh);
                    acc = __builtin_amdgcn_mfma_f32_32x32x16_bf16(A2, B2, acc, 0, 0, 0); }
#pragma unroll
                for (int g2 = 0; g2 < 2; ++g2) *(u32x4*)(QFp + (((vt * 2 + dt) * 2 + g2) * 64 + lane) * 8) = (u32x4){cvt_pk_bf16(acc[8 * g2], acc[8 * g2 + 1]), cvt_pk_bf16(acc[8 * g2 + 2], acc[8 * g2 + 3]),
                                                                                                                   cvt_pk_bf16(acc[8 * g2 + 4], acc[8 * g2 + 5]), cvt_pk_bf16(acc[8 * g2 + 6], acc[8 * g2 + 7])}; }
    }
    lds_barrier();
}
__device__ __forceinline__ void rw_m2_wave(int lane, int bh, int vt) {
    unsigned char* ws = KWS();
    const bf16* PF = (const bf16*)(ws + WS_RP) + (size_t)bh * NCH * 4096 + lane * 8;
    const bf16* QF = (const bf16*)(ws + WS_RQ) + (size_t)bh * NCH * 4096 + (size_t)vt * 2048 + lane * 8;
    bf16* SG = (bf16*)(ws + WS_RS) + (size_t)bh * NCH * 4096 + (size_t)vt * 2048 + lane * 8;
    f32x16 S[2];
#pragma unroll
    for (int dt = 0; dt < 2; ++dt)
#pragma unroll
        for (int i = 0; i < 16; ++i) S[dt][i] = 0.f;
    bf16x8 pA[8], pB[8], pC[8]; u32x4 qA[4], qB[4], qC[4];
#pragma unroll
    for (int f = 0; f < 8; ++f) { pA[f] = (bf16x8){0, 0, 0, 0, 0, 0, 0, 0}; pB[f] = pA[f]; pC[f] = pA[f]; }
#pragma unroll
    for (int f = 0; f < 4; ++f) { qA[f] = (u32x4){0u, 0u, 0u, 0u}; qB[f] = qA[f]; qC[f] = qA[f]; }
#define RWM2_LD4(d0, d1, d2, d3, ptr) asm volatile("global_load_dwordx4 %0, %4, off\n\tglobal_load_dwordx4 %1, %4, off offset:1024\n\tglobal_load_dwordx4 %2, %4, off offset:2048\n\tglobal_load_dwordx4 %3, %4, off offset:3072" \
        : "+v"(d0), "+v"(d1), "+v"(d2), "+v"(d3) : "v"(ptr) : "memory")
#define RWM2_LOAD(P_, Q_, c_) do { const int _c = (c_) < NCH ? (c_) : NCH - 1; const bf16* _p0 = PF + (size_t)_c * 4096; const bf16* _p1 = _p0 + 2048; const bf16* _q = QF + (size_t)_c * 4096; \
        RWM2_LD4(P_[0], P_[1], P_[2], P_[3], _p0); RWM2_LD4(P_[4], P_[5], P_[6], P_[7], _p1); RWM2_LD4(Q_[0], Q_[1], Q_[2], Q_[3], _q); } while (0)
#define RWM2_WAIT(P_, Q_) asm volatile("s_waitcnt vmcnt(24)" : "+v"(P_[0]), "+v"(P_[1]), "+v"(P_[2]), "+v"(P_[3]), "+v"(P_[4]), "+v"(P_[5]), "+v"(P_[6]), "+v"(P_[7]), "+v"(Q_[0]), "+v"(Q_[1]), "+v"(Q_[2]), "+v"(Q_[3]) :: "memory")
#define RWM2_STEP(P_, Q_, c_) do { \
        RWM2_WAIT(P_, Q_); \
        union { bf16x8 v; unsigned w[4]; } sb[2][2]; \
        _Pragma("unroll") for (int dt2 = 0; dt2 < 2; ++dt2) _Pragma("unroll") for (int s = 0; s < 2; ++s) { \
            _Pragma("unroll") for (int j = 0; j < 4; ++j) sb[dt2][s].w[j] = cvt_pk_bf16(S[dt2][8 * s + 2 * j], S[dt2][8 * s + 2 * j + 1]); \
            *(bf16x8*)(SG + (size_t)(c_) * 4096 + (dt2 * 2 + s) * 512) = sb[dt2][s].v; } \
        f32x16 N[2]; \
        _Pragma("unroll") for (int dt = 0; dt < 2; ++dt) { \
            _Pragma("unroll") for (int g2 = 0; g2 < 2; ++g2) _Pragma("unroll") for (int j = 0; j < 4; ++j) { N[dt][8 * g2 + 2 * j] = bflo(Q_[dt * 2 + g2][j]); N[dt][8 * g2 + 2 * j + 1] = bfhi(Q_[dt * 2 + g2][j]); } \
            _Pragma("unroll") for (int dt2 = 0; dt2 < 2; ++dt2) _Pragma("unroll") for (int s = 0; s < 2; ++s) N[dt] = __builtin_amdgcn_mfma_f32_32x32x16_bf16(P_[(dt * 2 + dt2) * 2 + s], sb[dt2][s].v, N[dt], 0, 0, 0); } \
        S[0] = N[0]; S[1] = N[1]; } while (0)
    RWM2_LOAD(pA, qA, 0); RWM2_LOAD(pB, qB, 1); RWM2_LOAD(pC, qC, 2);
#pragma unroll 1
    for (int c = 0; c < NCH - 1; c += 3) {
        RWM2_STEP(pA, qA, c); RWM2_LOAD(pA, qA, c + 3);
        RWM2_STEP(pB, qB, c + 1); RWM2_LOAD(pB, qB, c + 4);
        RWM2_STEP(pC, qC, c + 2); RWM2_LOAD(pC, qC, c + 5);
    }
    static_assert((NCH - 1) % 3 == 0, "chunk loop: 85 rounds of three steps, then the last chunk");
    RWM2_STEP(pA, qA, NCH - 1);
    asm volatile("s_waitcnt vmcnt(0)" : "+v"(pB[0]), "+v"(pB[1]), "+v"(pB[2]), "+v"(pB[3]), "+v"(pB[4]), "+v"(pB[5]), "+v"(pB[6]), "+v"(pB[7]), "+v"(qB[0]), "+v"(qB[1]), "+v"(qB[2]), "+v"(qB[3]) :: "memory");
    asm volatile("" : "+v"(pC[0]), "+v"(pC[1]), "+v"(pC[2]), "+v"(pC[3]), "+v"(pC[4]), "+v"(pC[5]), "+v"(pC[6]), "+v"(pC[7]), "+v"(qC[0]), "+v"(qC[1]), "+v"(qC[2]), "+v"(qC[3]) :: "memory");
#undef RWM2_LD4
#undef RWM2_LOAD
#undef RWM2_WAIT
#undef RWM2_STEP
}
__device__ __forceinline__ bf16x8 ld_perm8(const bf16* p) { union { bf16x8 v; s16x4 h2[2]; } f; f.h2[0] = *(const s16x4*)p; f.h2[1] = *(const s16x4*)(p + 8); return f.v; }
__device__ __forceinline__ void rw_m3_task(int lane, int l, int bh, int c, LAS unsigned char* os) {
    unsigned char* ws = KWS();
    const int r32 = lane & 31, hh = lane >> 5, b = bh >> 2, h = bh & 3; const size_t un = (size_t)bh * NCH + c; const size_t tok0 = (size_t)b * T + c * 32;
    const bf16* RGp = (const bf16*)(ws + WS_RR) + un * 2048 + r32 * 64 + 4 * hh;
    const bf16* SGp = (const bf16*)(ws + WS_RS) + un * 4096 + lane * 8; const bf16* VTp = (const bf16*)(ws + WS_RVT) + un * 2048 + r32 * 32 + 4 * hh;
    const bf16* UGp = (const bf16*)(ws + WS_RU) + un * 2048 + lane * 8;
    f32x16 Y[2], Z[2];
    const float bon = ((const float*)(ws + WS_BONUS))[(tok0 + r32) * 4 + h];
#pragma unroll
    for (int vt = 0; vt < 2; ++vt)
#pragma unroll
        for (int g2 = 0; g2 < 2; ++g2) { const u32x4 u4 = *(const u32x4*)(UGp + (vt * 2 + g2) * 512);
#pragma unroll
            for (int j = 0; j < 4; ++j) { Y[vt][8 * g2 + 2 * j] = bflo(u4[j]); Y[vt][8 * g2 + 2 * j + 1] = bfhi(u4[j]); } }
#pragma unroll
    for (int i = 0; i < 16; ++i) { Z[0][i] = 0.f; Z[1][i] = 0.f; }
#pragma unroll
    for (int ks = 0; ks < 4; ++ks) {
        const bf16x8 rf = ld_perm8(RGp + 16 * ks);
        const bf16x8 s0 = *(const bf16x8*)(SGp + ks * 512), s1 = *(const bf16x8*)(SGp + 2048 + ks * 512);
        Y[0] = __builtin_amdgcn_mfma_f32_32x32x16_bf16(s0, rf, Y[0], 0, 0, 0); Y[1] = __builtin_amdgcn_mfma_f32_32x32x16_bf16(s1, rf, Y[1], 0, 0, 0); }
#pragma unroll
    for (int s = 0; s < 2; ++s) {
        union { bf16x8 v; unsigned short e[8]; } db;
#pragma unroll
        for (int j = 0; j < 8; ++j) db.e[j] = (16 * s + 8 * (j >> 2) + 4 * hh + (j & 3) == r32) ? (unsigned short)f2bf(bon) : (unsigned short)0;
#pragma unroll
        for (int vt = 0; vt < 2; ++vt) {
            const bf16* vp = VTp + (size_t)vt * 32 * 32 + 16 * s;
            union { bf16x8 v; s16x4 h2[2]; } vf; vf.h2[0] = *(const s16x4*)vp; vf.h2[1] = *(const s16x4*)(vp + 8);
            Z[vt] = __builtin_amdgcn_mfma_f32_32x32x16_bf16(vf.v, db.v, Z[vt], 0, 0, 0); } }
    float sm = 0.f;
#pragma unroll
    for (int vt = 0; vt < 2; ++vt)
#pragma unroll
        for (int i = 0; i < 16; ++i) sm += Y[vt][i];
    sm += __shfl_xor(sm, 32); const float mu = sm * (1.0f / 64.0f);
    float q = 0.f;
#pragma unroll
    for (int vt = 0; vt < 2; ++vt)
#pragma unroll
        for (int i = 0; i < 16; ++i) { const float dd = Y[vt][i] - mu; q += dd * dd; }
    q += __shfl_xor(q, 32); const float rstd = 1.0f / sqrtf(q * (1.0f / 64.0f) + RW_LN_EPS);
    const size_t tok = tok0 + r32;
    const bf16* gp = (const bf16*)(ws + WS_GBUF) + tok * 256 + h * 64; unsigned char* od = (unsigned char*)(ws + WS_O) + tok * D + 512 + h * 64;
    const float* lnw = KIN(I_RWLNW) + l * 256 + h * 64; const float* lnb = KIN(I_RWLNB) + l * 256 + h * 64;
    f32x4 w4a[2][4], b4a[2][4]; u32x2 gwa[2][4];
#pragma unroll
    for (int vt = 0; vt < 2; ++vt)
#pragma unroll
        for (int g = 0; g < 4; ++g) { const int v0 = 32 * vt + 8 * g + 4 * hh; w4a[vt][g] = *(const f32x4*)(lnw + v0); b4a[vt][g] = *(const f32x4*)(lnb + v0); gwa[vt][g] = *(const u32x2*)(gp + v0); }
    __builtin_amdgcn_sched_barrier(0);
#pragma unroll
    for (int vt = 0; vt < 2; ++vt)
#pragma unroll
        for (int g = 0; g < 4; ++g) { const int v0 = 32 * vt + 8 * g + 4 * hh; const f32x4 w4 = w4a[vt][g], b4 = b4a[vt][g]; const u32x2 gw = gwa[vt][g];
            const float y0 = ((Y[vt][4 * g] - mu) * rstd * w4[0] + b4[0] + Z[vt][4 * g]) * bflo(gw.x), y1 = ((Y[vt][4 * g + 1] - mu) * rstd * w4[1] + b4[1] + Z[vt][4 * g + 1]) * bfhi(gw.x);
            const float y2 = ((Y[vt][4 * g + 2] - mu) * rstd * w4[2] + b4[2] + Z[vt][4 * g + 2]) * bflo(gw.y), y3 = ((Y[vt][4 * g + 3] - mu) * rstd * w4[3] + b4[3] + Z[vt][4 * g + 3]) * bfhi(gw.y);
            *(LAS unsigned*)(os + r32 * 64 + v0) = pack_o4(y0, y1, y2, y3); }
    flush_o_tile(os, (unsigned char*)(ws + WS_O) + tok0 * D + 512 + h * 64, lane);
}

__device__ __forceinline__ void c1_phase(LAS unsigned char* lds, int l, int vcu, int G) {
    for (int u = vcu, k = 0; u < NB * NCH; u += G, ++k) {
        const int b = (G == 256) ? (vcu >> 5) : (u >> 8), c = (G == 256) ? 255 - ((vcu & 31) + 32 * k) : (u & 255);
        for (int q = 0; q <= PHREP(16); ++q) rw_fused_unit(lds, l, b, c);
        for (int q = 0; q <= PHREP(17); ++q) hg_fused_unit(lds, l, b, c);
        for (int q = 0; q <= PHREP(18); ++q) gla_fused_unit(lds, l, b, c); }
}
__device__ __forceinline__ void m3_gh_phase(LAS unsigned char* lds, int l, int vcu, int G) {
    const int tid = opaque_tid(), lane = tid & 63, wave = __builtin_amdgcn_readfirstlane(tid >> 6);
    unsigned char* ws = KWS();
    const int gw = vcu * NWAVES + wave, NGW = G * NWAVES;
    const bf16* P = (const bf16*)(ws + WS_P); unsigned char* O = (unsigned char*)(ws + WS_O);
    const float* gng = KIN(I_GLANG) + l * 256; const float* hng = KIN(I_HGNG) + l * 256;
    for (int task = gw; task < 24576; task += NGW) {
        const int un = task & 8191, bh = un >> 8, c = un & 255, b = bh >> 2, h = bh & 3; const size_t tok0 = (size_t)b * T + c * 32;
        if (task >= 16384) { for (int q = 0; q <= PHREP(19); ++q) rw_m3_task(lane, l, bh, c, lds + wave * 2048); continue; }
        for (int q = 0; q <= PHREP(20); ++q)
        if (task < 8192) m3_gh_task<64>(lane, (const bf16*)(ws + WS_HQ) + (size_t)un * 2048, (const bf16*)(ws + WS_HK) + (size_t)un * 2048, (const bf16*)(ws + WS_HVT) + (size_t)un * 2048, (const bf16*)(ws + WS_HS) + (size_t)un * 4096,
                                         P + tok0 * PINP + PC_HG + h * 64, hng + h * 64, O + tok0 * D + 256 + h * 64, lds + wave * 2048);
        else m3_gh_task<32>(lane, (const bf16*)(ws + WS_GQ) + (size_t)un * 1024, (const bf16*)(ws + WS_GK) + (size_t)un * 1024, (const bf16*)(ws + WS_GVT) + (size_t)un * 2048, (const bf16*)(ws + WS_GS) + (size_t)un * 2048,
                            P + tok0 * PINP + PC_GOUT + h * 64, gng + h * 64, O + tok0 * D + h * 64, lds + wave * 2048);
    }
}

__device__ __forceinline__ void xattn_units(LAS unsigned char* lds, int l, int first, int last, int stride) {
    const int tid = opaque_tid(), lane = tid & 63, wave = __builtin_amdgcn_readfirstlane(tid >> 6), r32 = lane & 31, hh = lane >> 5;
    const bf16* P = (const bf16*)(KWS() + WS_P); const bf16* MKV = (const bf16*)(KWS() + WS_MKV); unsigned char* O = (unsigned char*)(KWS() + WS_O);
    LAS bf16* KL = (LAS bf16*)lds;
    LAS bf16* VT = (LAS bf16*)(lds + 256 * 72 * 2);
    int cur_bh = -1;
    for (int u = first; u < last; u += stride) {
        const int bh = u >> 5, qb = u & 31, b = bh >> 2, h = bh & 3;
        if (bh != cur_bh) {
            lds_barrier();
            for (int i = tid; i < 256 * 8; i += NTHR) { const int key = i >> 3, c8 = i & 7;
                const bf16* src = MKV + (size_t)(b * 256 + key) * 2048 + l * 512 + h * 64 + c8 * 8;
                *(LAS u32x4*)(KL + key * 72 + c8 * 8) = *(const u32x4*)src;
                const u32x4 vv = *(const u32x4*)(src + 256);
                LAS bf16* vd = VT + (c8 * 8) * 264 + key;
                vd[0 * 264] = (bf16)(vv.x & 0xffff); vd[1 * 264] = (bf16)(vv.x >> 16); vd[2 * 264] = (bf16)(vv.y & 0xffff); vd[3 * 264] = (bf16)(vv.y >> 16);
                vd[4 * 264] = (bf16)(vv.z & 0xffff); vd[5 * 264] = (bf16)(vv.z >> 16); vd[6 * 264] = (bf16)(vv.w & 0xffff); vd[7 * 264] = (bf16)(vv.w >> 16); }
            lds_barrier();
            cur_bh = bh;
        }
        const int q = b * T + qb * 256 + wave * 32 + r32;
        bf16x8 qf[4];
#pragma unroll
        for (int s = 0; s < 4; ++s) qf[s] = *(const bf16x8*)(P + (size_t)q * PINP + PC_MQ + h * 64 + 16 * s + 8 * hh);
        f32x16 sc[8];
#pragma unroll
        for (int kt = 0; kt < 8; ++kt) {
#pragma unroll
            for (int i = 0; i < 16; ++i) sc[kt][i] = 0.f;
#pragma unroll
            for (int s = 0; s < 4; ++s) { const bf16x8 kf = *(const LAS bf16x8*)(KL + (kt * 32 + r32) * 72 + 16 * s + 8 * hh);
                sc[kt] = __builtin_amdgcn_mfma_f32_32x32x16_bf16(kf, qf[s], sc[kt], 0, 0, 0); }
        }
        float m = -3.0e38f;
#pragma unroll
        for (int kt = 0; kt < 8; ++kt)
#pragma unroll
            for (int i = 0; i < 16; ++i) m = fmaxf(m, sc[kt][i]);
        m = fmaxf(m, __shfl_xor(m, 32));
        float sum = 0.f;
        const float c2 = 0.125f * 1.4426950408889634f;
#pragma unroll
        for (int kt = 0; kt < 8; ++kt)
#pragma unroll
            for (int i = 0; i < 16; ++i) { const float e = __builtin_amdgcn_exp2f((sc[kt][i] - m) * c2); sc[kt][i] = e; sum += e; }
        sum += __shfl_xor(sum, 32);
        const float inv = 1.0f / sum;
        f32x16 oa[2];
#pragma unroll
        for (int vt = 0; vt < 2; ++vt)
#pragma unroll
            for (int i = 0; i < 16; ++i) oa[vt][i] = 0.f;
#pragma unroll
        for (int kt = 0; kt < 8; ++kt)
#pragma unroll
            for (int s = 0; s < 2; ++s) {
                union { bf16x8 v; unsigned w[4]; } pf;
#pragma unroll
                for (int j = 0; j < 4; ++j) pf.w[j] = cvt_pk_bf16(sc[kt][8 * s + 2 * j], sc[kt][8 * s + 2 * j + 1]);
#pragma unroll
                for (int vt = 0; vt < 2; ++vt) {
                    const LAS bf16* vp = VT + (vt * 32 + r32) * 264 + kt * 32 + 16 * s + 4 * hh;
                    union { bf16x8 v; s16x4 h2[2]; } vf; vf.h2[0] = *(const LAS s16x4*)vp; vf.h2[1] = *(const LAS s16x4*)(vp + 8);
                    oa[vt] = __builtin_amdgcn_mfma_f32_32x32x16_bf16(vf.v, pf.v, oa[vt], 0, 0, 0); }
            }
        unsigned char* orow = O + (size_t)q * D + 768 + h * 64;
#pragma unroll
        for (int vt = 0; vt < 2; ++vt)
#pragma unroll
            for (int g = 0; g < 4; ++g) store_o4(orow + vt * 32 + 8 * g + 4 * hh, oa[vt][4 * g] * inv, oa[vt][4 * g + 1] * inv, oa[vt][4 * g + 2] * inv, oa[vt][4 * g + 3] * inv);
    }
    lds_barrier();
}

__device__ __forceinline__ void m2_phase(LAS unsigned char* lds, int l, int bx, int G) {
    unsigned char* ws = KWS();
    const int tid = opaque_tid(), lane = tid & 63, wave = __builtin_amdgcn_readfirstlane(tid >> 6);
    const int nrw = (G >= 128) ? 64 : 0;
    if (nrw) { if (bx < nrw && wave == 0) for (int q = 0; q <= PHREP(22); ++q) rw_m2_wave(lane, bx >> 1, bx & 1); }
    else { if (wave == 0) for (int q = bx; q < 64; q += G) rw_m2_wave(lane, q >> 1, q & 1); }
    if (nrw && bx >= nrw) {
        const int nth = (G - nrw) * NTHR;
        const int gt = (bx - nrw) * NTHR + tid;
        for (int q = 0; q <= PHREP(23); ++q)
        for (int e = gt; e < 98304; e += nth) {
            if (e < 65536) m2_gh_elem2<64>(e, (const bf16*)(ws + WS_HDS), (const float*)(ws + WS_HBE), (bf16*)(ws + WS_HS));
            else m2_gh_elem2<32>(e - 65536, (const bf16*)(ws + WS_GDS), (const float*)(ws + WS_GBE), (bf16*)(ws + WS_GS)); }
    }
    if (nrw == 0) { __syncthreads(); for (int e = bx * NTHR + tid; e < 98304; e += G * NTHR) {
            if (e < 65536) m2_gh_elem2<64>(e, (const bf16*)(ws + WS_HDS), (const float*)(ws + WS_HBE), (bf16*)(ws + WS_HS));
            else m2_gh_elem2<32>(e - 65536, (const bf16*)(ws + WS_GDS), (const float*)(ws + WS_GBE), (bf16*)(ws + WS_GS)); } }
    if (nrw == 0 || bx >= nrw) {
        const int nb = G - nrw, r = bx - nrw;
        const int per = (1024 + nb - 1) / nb, lo = r * per, hi = (lo + per < 1024) ? lo + per : 1024;
        for (int q = 0; q <= PHREP(24); ++q) xattn_units(lds, l, lo, hi, 1);
    }
}

__device__ __forceinline__ void ln1_router_phase(LAS unsigned char* lds, int l, int bx, int G) {
    const int tid = opaque_tid(), lane = tid & 63, wave = __builtin_amdgcn_readfirstlane(tid >> 6);
    LAS float* X = (LAS float*)lds;
    LAS float* PART = (LAS float*)(lds + 16 * 1028 * 4);
    LAS int* HIST = (LAS int*)(lds + 16 * 1028 * 4 + 8 * 16 * 32 * 4);
    LAS f32x4* GB = (LAS f32x4*)(lds + 16 * 1028 * 4 + 8 * 16 * 32 * 4 + 256);
    const float* xin = KIN(I_X); const bf16* xinb = (const bf16*)(KWS() + WS_XB);
    const bf16* HM = (const bf16*)(KWS() + WS_HMIX);
    bf16* X1B = (bf16*)(KWS() + WS_X1B); unsigned char* X1Q = (unsigned char*)(KWS() + WS_XF);
    const float* g1 = KIN(I_LN1G) + l * D; const float* b1 = KIN(I_LN1B) + l * D;
    const float* rw = KIN(I_RTW) + (size_t)l * D * NE; const float* rb = KIN(I_RTB) + l * NE;
    int* tok_e = (int*)(KWS() + WS_ROUTE); float* tok_g = (float*)(KWS() + WS_ROUTE + 1 * MiB);
    if (tid < 32) HIST[tid] = 0;
    if (tid < 256) { GB[tid] = ((const f32x4*)g1)[tid]; GB[256 + tid] = ((const f32x4*)b1)[tid]; }
    const float rbe = rb[tid & 31];
    bf16x8 rwH[4][2], rwL[4][2];
    { const int q = lane >> 4, e = lane & 15;
#pragma unroll
      for (int s = 0; s < 4; ++s)
#pragma unroll
          for (int nt = 0; nt < 2; ++nt) { union { bf16x8 v; unsigned w[4]; } fh, fl;
#pragma unroll
              for (int j = 0; j < 4; ++j) { const float* p = rw + (size_t)(128 * wave + 32 * s + 8 * q + 2 * j) * NE + 16 * nt + e; const float v0 = p[0], v1 = p[NE];
                  const unsigned h = cvt_pk_bf16(v0, v1); fh.w[j] = h; fl.w[j] = cvt_pk_bf16(v0 - bflo(h), v1 - bfhi(h)); }
              rwH[s][nt] = fh.v; rwL[s][nt] = fl.v; } }
    lds_barrier();
    f32x4 xraw[2][4]; u32x2 xbraw[2][4], hraw[2][4];
#define LN1_LOAD(it_) do { const size_t _tok = (size_t)(it_) * 16 + wave * 2; const u32x2* _hr = (const u32x2*)(HM + _tok * D) + lane; \
        if (l == 0) { const f32x4* _xr = (const f32x4*)(xin + _tok * D) + lane;        \
            _Pragma("unroll") for (int tt = 0; tt < 2; ++tt) _Pragma("unroll") for (int j = 0; j < 4; ++j) xraw[tt][j] = _xr[tt * 256 + 64 * j]; } \
        else { const u32x2* _xbr = (const u32x2*)(xinb + _tok * D) + lane; \
            _Pragma("unroll") for (int tt = 0; tt < 2; ++tt) _Pragma("unroll") for (int j = 0; j < 4; ++j) xbraw[tt][j] = _xbr[tt * 256 + 64 * j]; } \
        _Pragma("unroll") for (int tt = 0; tt < 2; ++tt) _Pragma("unroll") for (int j = 0; j < 4; ++j) hraw[tt][j] = _hr[tt * 256 + 64 * j]; } while (0)
    if (bx < NTOK / 16) LN1_LOAD(bx);
    for (int it = bx; it < NTOK / 16; it += G) {
        f32x4 vv[2][4];
#pragma unroll
        for (int tt = 0; tt < 2; ++tt)
#pragma unroll
            for (int j = 0; j < 4; ++j) { f32x4 xv; if (l == 0) xv = xraw[tt][j]; else { const u32x2 xw = xbraw[tt][j]; xv = (f32x4){bflo(xw.x), bfhi(xw.x), bflo(xw.y), bfhi(xw.y)}; } const u32x2 hw = hraw[tt][j];
                vv[tt][j][0] = DN_ALPHA * xv[0] + bflo(hw.x); vv[tt][j][1] = DN_ALPHA * xv[1] + bfhi(hw.x); vv[tt][j][2] = DN_ALPHA * xv[2] + bflo(hw.y); vv[tt][j][3] = DN_ALPHA * xv[3] + bfhi(hw.y); }
        if (it + G < NTOK / 16) LN1_LOAD(it + G);
#pragma unroll
        for (int tt = 0; tt < 2; ++tt) { const int ti = wave * 2 + tt; const size_t tok = (size_t)it * 16 + ti;
            f32x4 v[4]; float s = 0.f;
#pragma unroll
            for (int j = 0; j < 4; ++j) { v[j] = vv[tt][j]; s += (v[j][0] + v[j][1]) + (v[j][2] + v[j][3]); }
            const float mean = wave_sum(s) * (1.0f / D); float s2 = 0.f;
#pragma unroll
            for (int j = 0; j < 4; ++j) { v[j] = v[j] - mean; s2 += (v[j][0] * v[j][0] + v[j][1] * v[j][1]) + (v[j][2] * v[j][2] + v[j][3] * v[j][3]); }
            const float rstd = 1.0f / sqrtf(wave_sum(s2) * (1.0f / D) + LN_EPS);
#pragma unroll
            for (int j = 0; j < 4; ++j) { const f32x4 gg = GB[lane + 64 * j], bb = GB[256 + lane + 64 * j];
                const f32x4 y = v[j] * rstd * gg + bb;
                *((u32x2*)(X1B + tok * D) + lane + 64 * j) = (u32x2){pk2(y[0], y[1]), pk2(y[2], y[3])};
                { int w = __builtin_amdgcn_cvt_pk_fp8_f32(y[0], y[1], 0, false); w = __builtin_amdgcn_cvt_pk_fp8_f32(y[2], y[3], w, true); *((unsigned*)(X1Q + tok * D) + lane + 64 * j) = (unsigned)w; }
                *(LAS f32x4*)(X + ti * 1028 + 4 * lane + 256 * j) = y; }
        }
        lds_barrier();
        {
            const int q = lane >> 4, r = lane & 15;
            f32x4 acc0 = (f32x4){0.f, 0.f, 0.f, 0.f}, acc1 = (f32x4){0.f, 0.f, 0.f, 0.f};
            const LAS float* xa = X + r * 1028 + 128 * wave + 8 * q;
#pragma unroll
            for (int s = 0; s < 4; ++s) { const f32x4 x0 = *(const LAS f32x4*)(xa + 32 * s), x1 = *(const LAS f32x4*)(xa + 32 * s + 4);
                union { bf16x8 v; unsigned w[4]; } ah, al;
                ah.w[0] = cvt_pk_bf16(x0[0], x0[1]); ah.w[1] = cvt_pk_bf16(x0[2], x0[3]); ah.w[2] = cvt_pk_bf16(x1[0], x1[1]); ah.w[3] = cvt_pk_bf16(x1[2], x1[3]);
                al.w[0] = cvt_pk_bf16(x0[0] - bflo(ah.w[0]), x0[1] - bfhi(ah.w[0])); al.w[1] = cvt_pk_bf16(x0[2] - bflo(ah.w[1]), x0[3] - bfhi(ah.w[1]));
                al.w[2] = cvt_pk_bf16(x1[0] - bflo(ah.w[2]), x1[1] - bfhi(ah.w[2])); al.w[3] = cvt_pk_bf16(x1[2] - bflo(ah.w[3]), x1[3] - bfhi(ah.w[3]));
                acc0 = __builtin_amdgcn_mfma_f32_16x16x32_bf16(ah.v, rwH[s][0], acc0, 0, 0, 0); acc1 = __builtin_amdgcn_mfma_f32_16x16x32_bf16(ah.v, rwH[s][1], acc1, 0, 0, 0);
                acc0 = __builtin_amdgcn_mfma_f32_16x16x32_bf16(ah.v, rwL[s][0], acc0, 0, 0, 0); acc1 = __builtin_amdgcn_mfma_f32_16x16x32_bf16(ah.v, rwL[s][1], acc1, 0, 0, 0);
                acc0 = __builtin_amdgcn_mfma_f32_16x16x32_bf16(al.v, rwH[s][0], acc0, 0, 0, 0); acc1 = __builtin_amdgcn_mfma_f32_16x16x32_bf16(al.v, rwH[s][1], acc1, 0, 0, 0); }
#pragma unroll
            for (int i = 0; i < 4; ++i) { PART[(wave * 16 + 4 * q + i) * 32 + r] = acc0[i]; PART[(wave * 16 + 4 * q + i) * 32 + 16 + r] = acc1[i]; }
        }
        lds_barrier();
        {
            const int ti = tid >> 5, e = tid & 31;
            float lg = rbe;
#pragma unroll
            for (int w = 0; w < 8; ++w) lg += PART[(w * 16 + ti) * 32 + e];
            float tv[4]; int te[4]; float cur = lg;
#pragma unroll
            for (int k = 0; k < 4; ++k) { float bv = cur; int bi = e;
#pragma unroll
                for (int st = 0; st < 5; ++st) { float ov; int oi;
                    const int bvi = __builtin_bit_cast(int, bv);
                    if (st == 0) { ov = __builtin_bit_cast(float, __builtin_amdgcn_update_dpp(bvi, bvi, 0xB1, 0xf, 0xf, false)); oi = __builtin_amdgcn_update_dpp(bi, bi, 0xB1, 0xf, 0xf, false); }
                    else if (st == 1) { ov = __builtin_bit_cast(float, __builtin_amdgcn_update_dpp(bvi, bvi, 0x4E, 0xf, 0xf, false)); oi = __builtin_amdgcn_update_dpp(bi, bi, 0x4E, 0xf, 0xf, false); }
                    else if (st == 2) { ov = __builtin_bit_cast(float, __builtin_amdgcn_update_dpp(bvi, bvi, 0x141, 0xf, 0xf, false)); oi = __builtin_amdgcn_update_dpp(bi, bi, 0x141, 0xf, 0xf, false); }
                    else if (st == 3) { ov = __builtin_bit_cast(float, __builtin_amdgcn_update_dpp(bvi, bvi, 0x140, 0xf, 0xf, false)); oi = __builtin_amdgcn_update_dpp(bi, bi, 0x140, 0xf, 0xf, false); }
                    else { ov = __shfl_xor(bv, 16); oi = __shfl_xor(bi, 16); }
                    if (ov > bv || (ov == bv && oi < bi)) { bv = ov; bi = oi; } }
                tv[k] = bv; te[k] = bi; if (e == bi) cur = -3.0e38f; }
            const float e1 = __expf(tv[1] - tv[0]), e2 = __expf(tv[2] - tv[0]), e3 = __expf(tv[3] - tv[0]); const float inv = 1.0f / (1.0f + e1 + e2 + e3);
            const size_t tok = (size_t)it * 16 + ti;
            if (e < 4) { const int ek = e == 0 ? te[0] : e == 1 ? te[1] : e == 2 ? te[2] : te[3]; const float gk = (e == 0 ? 1.0f : e == 1 ? e1 : e == 2 ? e2 : e3) * inv;
                tok_e[tok * 4 + e] = ek; tok_g[tok * 4 + e] = gk; __hip_atomic_fetch_add(&HIST[ek], 1, __ATOMIC_RELAXED, __HIP_MEMORY_SCOPE_WORKGROUP); }
        }
    }
#undef LN1_LOAD
    lds_barrier();
    if (tid < 32) ((int*)(KWS() + WS_CTL))[CW_HIST + bx * 32 + tid] = HIST[tid];
}

__device__ __forceinline__ void slots_phase(LAS unsigned char* lds, int bx, int G) {
    const int tid = opaque_tid();
    int* ctl = (int*)(KWS() + WS_CTL);
    LAS int* RED = (LAS int*)lds;
    LAS int* TOT = RED + 1024;
    const int* tok_e = (const int*)(KWS() + WS_ROUTE); const float* tok_g = (const float*)(KWS() + WS_ROUTE + 1 * MiB);
    int* tok_slot = (int*)(KWS() + WS_ROUTE + 2 * MiB); int* slot_tok = (int*)(KWS() + WS_ROUTE + 3 * MiB);
    { const int e = tid & 31, part = tid >> 5; int tot = 0, pre = 0;
      for (int b2 = part; b2 < G; b2 += 16) { const int h = ctl[CW_HIST + b2 * 32 + e]; tot += h; if (b2 < bx) pre += h; }
      RED[(part * 32 + e) * 2] = tot; RED[(part * 32 + e) * 2 + 1] = pre; }
    __syncthreads();
    if (tid < 32) { int tot = 0, pre = 0; for (int p = 0; p < 16; ++p) { tot += RED[(p * 32 + tid) * 2]; pre += RED[(p * 32 + tid) * 2 + 1]; } TOT[tid] = tot; TOT[32 + tid] = pre; TOT[96 + tid] = 0; }
    __syncthreads();
    if (tid == 0) { int ps = 0;
#pragma unroll 1
        for (int e = 0; e < 32; ++e) { TOT[64 + e] = ps; ps += (TOT[e] + 255) & ~255; }
        TOT[128] = ps >> 8; if (bx == 0) ctl[CW_NT] = ps >> 8; }
    __syncthreads();
    if (bx == 0) { const int nt = TOT[128];
        for (int t = tid; t < nt; t += NTHR) { int e = 0;
#pragma unroll 1
            for (int k = 1; k < 32; ++k) if (TOT[64 + k] <= t * 256) e = k;
            ctl[CW_TILEE + t] = e; } }
    for (int e = bx; e < 32; e += G) { const int s0 = TOT[64 + e] + TOT[e], s1 = TOT[64 + e] + ((TOT[e] + 255) & ~255); for (int s = s0 + tid; s < s1; s += NTHR) slot_tok[s] = 0; }
    for (int it = bx + G * (tid >> 6); it < NTOK / 16; it += G * 8) {
        const int asg = it * 64 + (tid & 63); const int e = tok_e[asg]; const int rank = __hip_atomic_fetch_add(&TOT[96 + e], 1, __ATOMIC_RELAXED, __HIP_MEMORY_SCOPE_WORKGROUP); const int slot = TOT[64 + e] + TOT[32 + e] + rank;
        tok_slot[asg] = slot; slot_tok[slot] = asg >> 2;
    }
}

__device__ __forceinline__ void combine_phase(int l, int vcu, int G) {
    const int tid = opaque_tid(), lane = tid & 63, wave = __builtin_amdgcn_readfirstlane(tid >> 6);
    const int gw = vcu * NWAVES + wave, NGW = G * NWAVES;
    const bf16* X1B = (const bf16*)(KWS() + WS_X1B); const unsigned char* YB = (const unsigned char*)(KWS() + WS_YB); const int* tok_slot = (const int*)(KWS() + WS_ROUTE + 2 * MiB); const float* tok_gate = (const float*)(KWS() + WS_ROUTE + 1 * MiB);
    float* xo = KOUT(); bf16* XB = (bf16*)(KWS() + WS_XB); unsigned char* X8 = (unsigned char*)(KWS() + WS_X8);
    const float* g2 = KIN(I_LN2G) + l * D; const float* b2 = KIN(I_LN2B) + l * D;
    unsigned wg[128];
    { const unsigned* Wg = (const unsigned*)(KWS() + WS_GLRW) + (size_t)(l + 1 < NL ? l + 1 : l) * 8192 + lane;
#pragma unroll
      for (int i = 0; i < 128; ++i) wg[i] = Wg[i * 64]; }
    bf16* PG = (bf16*)(KWS() + WS_P) + PC_GLR + ((lane >> 2) & 15);
    u32x2 xw[4]; unsigned ya[4][4]; int ns0 = 0, ns1 = 0, ns2 = 0, ns3 = 0; f32x4 gv = {0.f, 0.f, 0.f, 0.f};
#define CMB_SLOTS(t_) do { const int4 _s = *(const int4*)(tok_slot + (size_t)(t_) * 4); ns0 = _s.x; ns1 = _s.y; ns2 = _s.z; ns3 = _s.w; } while (0)
#define CMB_ROWS(t_) do { const u32x2* _xr = (const u32x2*)(X1B + (size_t)(t_) * D) + lane; gv = *(const f32x4*)(tok_gate + (size_t)(t_) * 4); \
        const unsigned* _y0 = (const unsigned*)(YB + (size_t)ns0 * D) + lane; const unsigned* _y1 = (const unsigned*)(YB + (size_t)ns1 * D) + lane; \
        const unsigned* _y2 = (const unsigned*)(YB + (size_t)ns2 * D) + lane; const unsigned* _y3 = (const unsigned*)(YB + (size_t)ns3 * D) + lane; \
        _Pragma("unroll") for (int j = 0; j < 4; ++j) { xw[j] = _xr[64 * j]; ya[0][j] = _y0[64 * j]; ya[1][j] = _y1[64 * j]; ya[2][j] = _y2[64 * j]; ya[3][j] = _y3[64 * j]; } } while (0)
    if (gw < NTOK) { CMB_SLOTS(gw); CMB_ROWS(gw); if (gw + NGW < NTOK) CMB_SLOTS(gw + NGW); }
    for (int tok = gw; tok < NTOK; tok += NGW) {
        f32x4 v[4]; float s = 0.f; const f32x4 gs = gv * 0.0625f;
#pragma unroll
        for (int j = 0; j < 4; ++j) { const f32x4 xv = {bflo(xw[j].x), bfhi(xw[j].x), bflo(xw[j].y), bfhi(xw[j].y)};
            f32x2 lo = __builtin_amdgcn_cvt_pk_f32_fp8(ya[0][j], false) * gs[0], hi = __builtin_amdgcn_cvt_pk_f32_fp8(ya[0][j], true) * gs[0];
#pragma unroll
            for (int k = 1; k < 4; ++k) { lo += __builtin_amdgcn_cvt_pk_f32_fp8(ya[k][j], false) * gs[k]; hi += __builtin_amdgcn_cvt_pk_f32_fp8(ya[k][j], true) * gs[k]; }
            v[j][0] = DN_ALPHA * xv[0] + lo[0]; v[j][1] = DN_ALPHA * xv[1] + lo[1]; v[j][2] = DN_ALPHA * xv[2] + hi[0]; v[j][3] = DN_ALPHA * xv[3] + hi[1];
            s += (v[j][0] + v[j][1]) + (v[j][2] + v[j][3]); }
        if (tok + NGW < NTOK) { CMB_ROWS(tok + NGW); if (tok + 2 * NGW < NTOK) CMB_SLOTS(tok + 2 * NGW); }
        const float mean = wave_sum(s) * (1.0f / D); float q = 0.f;
#pragma unroll
        for (int j = 0; j < 4; ++j) { v[j] = v[j] - mean; q += (v[j][0] * v[j][0] + v[j][1] * v[j][1]) + (v[j][2] * v[j][2] + v[j][3] * v[j][3]); }
        const float rstd = 1.0f / sqrtf(wave_sum(q) * (1.0f / D) + LN_EPS);
        float ga[16];
#pragma unroll
        for (int c = 0; c < 16; ++c) ga[c] = 0.f;
#pragma unroll
        for (int j = 0; j < 4; ++j) { const f32x4 gg = *((const f32x4*)g2 + lane + 64 * j), bb = *((const f32x4*)b2 + lane + 64 * j);
            const f32x4 y = v[j] * rstd * gg + bb;
            if (l == NL - 1) *((f32x4*)(xo + (size_t)tok * D) + lane + 64 * j) = y;
            else { const unsigned p0 = pk2(y[0], y[1]), p1 = pk2(y[2], y[3]); *((u32x2*)(XB + (size_t)tok * D) + lane + 64 * j) = (u32x2){p0, p1};
                store_o4(X8 + (size_t)tok * D + 4 * (lane + 64 * j), y[0], y[1], y[2], y[3]);
#pragma unroll
                for (int c = 0; c < 16; ++c) { ga[c] = __builtin_amdgcn_fdot2_f32_bf16(__builtin_bit_cast(bf16x2_t, p0), __builtin_bit_cast(bf16x2_t, wg[(2 * j) * 16 + c]), ga[c], false);
                                               ga[c] = __builtin_amdgcn_fdot2_f32_bf16(__builtin_bit_cast(bf16x2_t, p1), __builtin_bit_cast(bf16x2_t, wg[(2 * j + 1) * 16 + c]), ga[c], false); } } }
        if (l != NL - 1) {
            const bool h5 = (lane & 32) != 0, h4 = (lane & 16) != 0, h3 = (lane & 8) != 0, h2 = (lane & 4) != 0;
            float r8[8], r4[4], r2[2];
#pragma unroll
            for (int i = 0; i < 8; ++i) { const float keep = h5 ? ga[8 + i] : ga[i], send = h5 ? ga[i] : ga[8 + i]; r8[i] = keep + __shfl_xor(send, 32); }
#pragma unroll
            for (int i = 0; i < 4; ++i) { const float keep = h4 ? r8[4 + i] : r8[i], send = h4 ? r8[i] : r8[4 + i]; r4[i] = keep + __shfl_xor(send, 16); }
#pragma unroll
            for (int i = 0; i < 2; ++i) { const float keep = h3 ? r4[2 + i] : r4[i], send = h3 ? r4[i] : r4[2 + i]; r2[i] = keep + __shfl_xor(send, 8); }
            const float keep = h2 ? r2[1] : r2[0], send = h2 ? r2[0] : r2[1];
            float r1 = keep + __shfl_xor(send, 4);
            r1 = dpp_add(r1, 0); r1 = dpp_add(r1, 1);
            if ((lane & 3) == 0) PG[(size_t)tok * PINP] = (bf16)f2bf(r1);
        }
    }
#undef CMB_SLOTS
#undef CMB_ROWS
}


constexpr int PH_PER_LAYER = 10, NPHASES = 2 + NL * PH_PER_LAYER;
__global__ void __launch_bounds__(NTHR, 2) trunk_fwd(Args args) {
    extern __shared__ __attribute__((aligned(16))) unsigned char lds_raw[];
    LAS unsigned char* lds = (LAS unsigned char*)lds_raw;
    volatile LAS unsigned* MISC = (volatile LAS unsigned*)(lds + MISC_OFF);
    const int tid = threadIdx.x;
    const int G = gridDim.x, bx = blockIdx.x;
    const int vcu = (G % 8 == 0) ? (bx % 8) * (G / 8) + bx / 8 : bx;
    unsigned char* ws = KWS();
    unsigned* ctl = (unsigned*)(ws + WS_CTL);
    for (int u = tid; u < (LDS_BYTES - LDSCTL_OFF) / 4; u += NTHR) ((LAS unsigned*)(lds + LDSCTL_OFF))[u] = 0u;
    __syncthreads();
    XcdBarrier bar; bar.bar = ctl + CW_BAR; bar.x = 0; bar.st = nullptr;
#if !MK_PER_PHASE
    bar = xcd_barrier_post(ctl + CW_BAR, MISC + 8);
#define GRID_BAR() xcd_barrier(bar)
#else
#define GRID_BAR() do { } while (0)
#endif
    const int lo = (int)(unsigned)ka_u64<280>(), hi = (int)(unsigned)(ka_u64<280>() >> 32);
#ifndef PH_MASK
#define PH_MASK 0x1FFF
#endif
#define PHEN(n) (((PH_MASK) >> (n)) & 1)
#define IN(k) (lo <= (k) && (k) < hi)
#define SEAM(k) do { if (rep > 0 || IN((k) + 1)) { GRID_BAR(); if (PHREP(21)) GRID_BAR(); } } while (0)

#define OG opaque_s(G)
#define OBX opaque_s(bx)
#define OVCU opaque_s(vcu)
#define OL opaque_s(l)
    if (PHEN(0) && IN(0)) for (int rep = PHREP(0); rep >= 0; --rep) { prologue_phase(lds, OVCU, OG); SEAM(0); }
    if (PHEN(1) && IN(1)) for (int rep = PHREP(1); rep >= 0; --rep) {
        pg8::DenseOrder S; S.init(KWS() + WS_MEMB, KWS() + WS_WMEM, NB * NMEM, 2048, D, OG, OBX);
        pg8::EpiBf16 E{(bf16*)(KWS() + WS_MKV), 2048};
        pg8::gemm_phase<pg8::EpiBf16, pg8::DenseOrder>(lds, D, S, E);
        SEAM(1);
    }
    for (int l = 0; l < NL; ++l) {
        const int p0 = 2 + l * PH_PER_LAYER;
        if (PHEN(2) && IN(p0 + 0)) for (int rep = PHREP(2); rep >= 0; --rep) {
            pg8::DenseOrder S; S.init(KWS() + WS_X8, KWS() + WS_WIN + (size_t)OL * PINP * D, NTOK, l == 0 ? PINP : PINP - 256, D / 2, OG, OBX);
            pg8::EpiBf16T<123, 125> E{(bf16*)(KWS() + WS_P), PINP};
            pg8::gemm_phase<pg8::EpiBf16T<123, 125>, pg8::DenseOrder, 1>(lds, D, S, E);
            SEAM(p0 + 0);
        }
        if (PHEN(4) && IN(p0 + 1)) for (int rep = PHREP(4); rep >= 0; --rep) { c1_phase(lds, OL, OVCU, OG); SEAM(p0 + 1); }
        if (PHEN(5) && IN(p0 + 2)) for (int rep = PHREP(5); rep >= 0; --rep) { m2_phase(lds, OL, OBX, OG); SEAM(p0 + 2); }
        if (PHEN(6) && IN(p0 + 3)) for (int rep = PHREP(6); rep >= 0; --rep) { m3_gh_phase(lds, OL, OVCU, OG); SEAM(p0 + 3); }
        if (PHEN(7) && IN(p0 + 4)) for (int rep = PHREP(7); rep >= 0; --rep) {
            pg8::DenseOrder S; S.init(KWS() + WS_O, KWS() + WS_WOUT + (size_t)OL * D * D, NTOK, D, D / 2, OG, OBX);
            pg8::EpiBf16T<122, 125> E{(bf16*)(KWS() + WS_HMIX), D};
            pg8::gemm_phase<pg8::EpiBf16T<122, 125>, pg8::DenseOrder, 1>(lds, D, S, E);
            SEAM(p0 + 4);
        }
        if (PHEN(8) && IN(p0 + 5)) for (int rep = PHREP(8); rep >= 0; --rep) { ln1_router_phase(lds, OL, OBX, OG); SEAM(p0 + 5); }
        if (PHEN(9) && IN(p0 + 6)) for (int rep = PHREP(9); rep >= 0; --rep) { slots_phase(lds, OBX, OG); SEAM(p0 + 6); }
        if (PHEN(10) && IN(p0 + 7)) for (int rep = PHREP(10); rep >= 0; --rep) {
            const int ntiles = __builtin_amdgcn_readfirstlane(((const int*)(KWS() + WS_CTL))[CW_NT]);
            pg8::MoeOrder<true> S; S.init(KWS() + WS_XF, KWS() + WS_WGU + (size_t)OL * NE * 2048 * D, (const int*)(KWS() + WS_CTL) + CW_TILEE, (const int*)(KWS() + WS_ROUTE + 3 * MiB), ntiles, 2048, D, OG, OBX);
            pg8::EpiSwiglu E{(unsigned char*)(KWS() + WS_HB), (const float*)(KWS() + WS_BGU) + (size_t)OL * NE * 2048};
            pg8::gemm_phase<pg8::EpiSwiglu, pg8::MoeOrder<true>, 1>(lds, D, S, E);
            SEAM(p0 + 7);
        }
        if (PHEN(11) && IN(p0 + 8)) for (int rep = PHREP(11); rep >= 0; --rep) {
            const int ntiles = __builtin_amdgcn_readfirstlane(((const int*)(KWS() + WS_CTL))[CW_NT]);
            pg8::MoeOrder<false> S; S.init(KWS() + WS_HB, KWS() + WS_WD + (size_t)OL * NE * D * FF, (const int*)(KWS() + WS_CTL) + CW_TILEE, (const int*)(KWS() + WS_ROUTE + 3 * MiB), ntiles, D, FF, OG, OBX);
            pg8::EpiDown E{(unsigned char*)(KWS() + WS_YB), KIN(I_BDN) + (size_t)OL * NE * D};
            pg8::gemm_phase<pg8::EpiDown, pg8::MoeOrder<false>, 1>(lds, FF, S, E);
            SEAM(p0 + 8);
        }
        if (PHEN(12) && IN(p0 + 9)) for (int rep = PHREP(12); rep >= 0; --rep) { combine_phase(OL, OVCU, OG); if (rep > 0 || l + 1 < NL) SEAM(p0 + 9); }
    }
#undef IN
#undef SEAM
}

extern "C" void kernel_launch(void* const* d_in, const int* in_sizes, int n_in, void* d_out, int out_size, void* d_ws, size_t ws_size, hipStream_t stream) {
    static int grid = 0;
    if (grid == 0) {
        if (n_in != 33 || ws_size < WS_END) { fprintf(stderr, "kernel_launch: unexpected inputs (n_in %d, ws %zu need %zu)\n", n_in, ws_size, (size_t)WS_END); grid = -1; return; }
        int dev = 0, cus = 0;
        if (hipGetDevice(&dev) != hipSuccess || hipDeviceGetAttribute(&cus, hipDeviceAttributeMultiprocessorCount, dev) != hipSuccess) { grid = -1; return; }
        if (hipFuncSetAttribute((const void*)trunk_fwd, hipFuncAttributeMaxDynamicSharedMemorySize, LDS_BYTES) != hipSuccess) { grid = -1; return; }
        int per_cu = 0; (void)hipOccupancyMaxActiveBlocksPerMultiprocessor(&per_cu, (const void*)trunk_fwd, NTHR, LDS_BYTES); (void)hipGetLastError();
        grid = cus;
    }
    if (grid < 0) return;
    (void)hipMemsetAsync((char*)d_ws + WS_CTL, 0, CTL_ZERO_BYTES, stream);
    Args a{};
    for (int i = 0; i < 33; ++i) a.in[i] = (const float*)d_in[i];
    a.out = (float*)d_out; a.ws = (unsigned char*)d_ws;
#if MK_PER_PHASE
    for (int p = 0; p < NPHASES; ++p) { a.ph_lo = p; a.ph_hi = p + 1; hipLaunchKernelGGL(trunk_fwd, dim3(grid), dim3(NTHR), LDS_BYTES, stream, a); }
#else
    a.ph_lo = 0; a.ph_hi = NPHASES;
    hipLaunchKernelGGL(trunk_fwd, dim3(grid), dim3(NTHR), LDS_BYTES, stream, a);
#endif
}
```
